# Optimizing an MI355X kernel written in HIP

```python
import jax
import jax.numpy as jnp
from jax import lax
import numpy as np


D_MODEL = 2048
BATCH = 8
SEQ = 4096
DEPTH = 4

GRID_W = 64
CTX_LEN = 256
N_MIXERS = 2
MLA_HEADS = 16
MLA_Q_RANK = 512
MLA_KV_RANK = 512
MLA_NOPE = 128
MLA_ROPE = 64
MLA_V = 128
RET_HEADS = 8
RET_DK = D_MODEL // RET_HEADS
RET_DV = 2 * D_MODEL // RET_HEADS
RET_CHUNK = 128
FFN_DIM = 256 * ((8 * D_MODEL // 3 + 255) // 256)
CONV_W = 3
N_MOD = 6
ROPE_BASE = 10000.0
NORM_EPS = 1e-6
GN_EPS = 1e-5
Q_BLOCK = 128

kernel_name = "hybrid_mla_retention_dit"


def rmsnorm(x, g):
    x32 = x.astype(jnp.float32)
    y = x32 * lax.rsqrt(jnp.mean(x32 * x32, axis=-1, keepdims=True) + NORM_EPS)
    return (y * g.astype(jnp.float32)).astype(x.dtype)


def rope(x, ang):
    m = x.shape[-1] // 2
    cos = jnp.cos(ang).astype(x.dtype)
    sin = jnp.sin(ang).astype(x.dtype)
    x1, x2 = x[..., :m], x[..., m:]
    return jnp.concatenate([x1 * cos - x2 * sin, x2 * cos + x1 * sin], axis=-1)


def axial_rope(x, ang_row, ang_col):
    half = x.shape[-1] // 2
    return jnp.concatenate([rope(x[..., :half], ang_row), rope(x[..., half:], ang_col)], axis=-1)


def merge_heads(y):
    B, H, L, d = y.shape
    return y.transpose(0, 2, 1, 3).reshape(B, L, H * d)


def attend(q, k, v):
    s = jnp.einsum('bhqd,bhkd->bhqk', q, k, preferred_element_type=jnp.float32) * (q.shape[-1] ** -0.5)
    p = jax.nn.softmax(s, axis=-1)
    return jnp.einsum('bhqk,bhkd->bhqd', p.astype(v.dtype), v)


def blocked_attend(q, k, v):
    B, H, L, dq = q.shape
    nb = L // Q_BLOCK
    qb = q.reshape(B, H, nb, Q_BLOCK, dq).transpose(2, 0, 1, 3, 4)
    ob = lax.map(lambda qi: attend(qi, k, v), qb)
    return ob.transpose(1, 2, 0, 3, 4).reshape(B, H, L, v.shape[-1])


def mla_q(h, w_dq, q_g, w_uq, ang_row, ang_col):
    B, L, _ = h.shape
    q = (rmsnorm(h @ w_dq, q_g) @ w_uq).reshape(B, L, MLA_HEADS, MLA_NOPE + MLA_ROPE).transpose(0, 2, 1, 3)
    q_nope, q_rope = q[..., :MLA_NOPE], q[..., MLA_NOPE:]
    if ang_row is not None:
        q_rope = axial_rope(q_rope, ang_row, ang_col)
    return jnp.concatenate([q_nope, q_rope], axis=-1)


def mla_kv(h, w_dkv, kv_g, w_ukv, ang_row, ang_col):
    B, L, _ = h.shape
    kv_in = h @ w_dkv
    c_kv = rmsnorm(kv_in[..., :MLA_KV_RANK], kv_g)
    k_rope = kv_in[..., MLA_KV_RANK:][:, None]
    if ang_row is not None:
        k_rope = axial_rope(k_rope, ang_row, ang_col)
    kv = (c_kv @ w_ukv).reshape(B, L, MLA_HEADS, MLA_NOPE + MLA_V).transpose(0, 2, 1, 3)
    k = jnp.concatenate([kv[..., :MLA_NOPE], jnp.broadcast_to(k_rope, (B, MLA_HEADS, L, MLA_ROPE))], axis=-1)
    return k, kv[..., MLA_NOPE:]


def mla_mixer(hx, hc, last, ang_row, ang_col, w_dq, q_g, w_uq, w_dkv, kv_g, w_ukv, w_o):
    qx = mla_q(hx, w_dq, q_g, w_uq, ang_row, ang_col)
    kx, vx = mla_kv(hx, w_dkv, kv_g, w_ukv, ang_row, ang_col)
    kc, vc = mla_kv(hc, w_dkv, kv_g, w_ukv, None, None)
    k_all = jnp.concatenate([kc, kx], axis=2)
    v_all = jnp.concatenate([vc, vx], axis=2)
    ox = merge_heads(blocked_attend(qx, k_all, v_all)) @ w_o
    if last:
        return ox, None
    qc = mla_q(hc, w_dq, q_g, w_uq, None, None)
    oc = merge_heads(attend(qc, kc, vc)) @ w_o
    return ox, oc


def ret_proj(h, w):
    B, L, _ = h.shape
    return (h @ w).reshape(B, L, RET_HEADS, -1).transpose(0, 2, 1, 3)


def retention_chunkwise(q, k, v, log_gamma, state0):
    B, H, L, _ = q.shape
    dv = v.shape[-1]
    n = L // RET_CHUNK
    pos = jnp.arange(RET_CHUNK, dtype=jnp.float32)
    lg = log_gamma[:, None]
    diff = pos[:, None] - pos[None, :]
    lower = diff >= 0
    intra = jnp.where(lower, jnp.exp(lg[:, :, None] * jnp.where(lower, diff, 0.0)), 0.0)
    xi = jnp.exp(lg * (pos + 1.0))[None, :, :, None]
    zeta = jnp.exp(lg * (RET_CHUNK - 1.0 - pos))[None, :, :, None]
    chunk_decay = jnp.exp(log_gamma * RET_CHUNK)[None, :, None, None]

    def to_chunks(t):
        return t.reshape(B, H, n, RET_CHUNK, t.shape[-1]).transpose(2, 0, 1, 3, 4).astype(jnp.float32)

    def step(state, inp):
        qi, ki, vi = inp
        s = jnp.einsum('bhid,bhjd->bhij', qi, ki) * intra
        y = jnp.einsum('bhij,bhjv->bhiv', s, vi) + jnp.einsum('bhid,bhdv->bhiv', qi, state) * xi
        state = state * chunk_decay + jnp.einsum('bhjd,bhjv->bhdv', ki * zeta, vi)
        return state, y

    state, ys = lax.scan(step, state0, (to_chunks(q), to_chunks(k), to_chunks(v)))
    return ys.transpose(1, 2, 0, 3, 4).reshape(B, H, L, dv), state


def retention_state(k, v, log_gamma):
    L = k.shape[2]
    w = jnp.exp(log_gamma[:, None] * (L - 1.0 - jnp.arange(L, dtype=jnp.float32)))
    return jnp.einsum('bhld,bhlv->bhdv', k.astype(jnp.float32) * w[None, :, :, None], v.astype(jnp.float32))


def head_norm(y):
    mu = jnp.mean(y, axis=-1, keepdims=True)
    var = jnp.mean(jnp.square(y - mu), axis=-1, keepdims=True)
    return (y - mu) * lax.rsqrt(var + GN_EPS)


def ret_output(h, yf, yb, w_gf, w_gb, w_o):
    nf = merge_heads(head_norm(yf)).astype(h.dtype)
    nb = merge_heads(head_norm(yb)).astype(h.dtype)
    return (jax.nn.silu(h @ w_gf) * nf + jax.nn.silu(h @ w_gb) * nb) @ w_o


def retention_mixer(hx, hc, last, ang_seq, w_q, w_k, w_v, w_gf, w_gb, w_o, decay_f, decay_b):
    B = hx.shape[0]
    lgf = -jnp.exp(decay_f.astype(jnp.float32))
    lgb = -jnp.exp(decay_b.astype(jnp.float32))
    k_scale = RET_DK ** -0.5
    flip = lambda t: jnp.flip(t, axis=2)
    qx = rope(ret_proj(hx, w_q), ang_seq)
    kx = rope(ret_proj(hx, w_k), ang_seq) * k_scale
    vx = ret_proj(hx, w_v)
    kc = ret_proj(hc, w_k) * k_scale
    vc = ret_proj(hc, w_v)
    if last:
        sf = retention_state(kc, vc, lgf)
        sb = retention_state(flip(kc), flip(vc), lgb)
        oc = None
    else:
        qc = ret_proj(hc, w_q)
        zero = jnp.zeros((B, RET_HEADS, RET_DK, RET_DV), jnp.float32)
        ycf, sf = retention_chunkwise(qc, kc, vc, lgf, zero)
        ycb, sb = retention_chunkwise(flip(qc), flip(kc), flip(vc), lgb, zero)
        oc = ret_output(hc, ycf, flip(ycb), w_gf, w_gb, w_o)
    yxf, _ = retention_chunkwise(qx, kx, vx, lgf, sf)
    yxb, _ = retention_chunkwise(flip(qx), flip(kx), flip(vx), lgb, sb)
    ox = ret_output(hx, yxf, flip(yxb), w_gf, w_gb, w_o)
    return ox, oc


def conv_ffn(h, w_gate, w_up, conv_w, conv_b, w_down):
    L = h.shape[1]
    g = h @ w_gate
    pad = CONV_W // 2
    gp = jnp.pad(g, ((0, 0), (pad, pad), (0, 0)))
    g = sum(gp[:, j:j + L] * conv_w[j] for j in range(CONV_W)) + conv_b
    return (jax.nn.silu(g) * (h @ w_up)) @ w_down


def setup_inputs(seed: int = 0) -> dict:
    key = jax.random.key(seed)
    keys = iter(jax.random.split(key, 64))
    f32 = jnp.float32
    D, F = D_MODEL, FFN_DIM
    n_a = len(range(0, DEPTH, N_MIXERS))
    n_b = len(range(1, DEPTH, N_MIXERS))

    def w(shape, fan_in, gain=1.0):
        return jax.random.normal(next(keys), shape, f32) * (gain * fan_in ** -0.5)

    def g(shape):
        return 1.0 + 0.02 * jax.random.normal(next(keys), shape, f32)

    def small(shape):
        return 0.01 * jax.random.normal(next(keys), shape, f32)

    heads = jnp.arange(RET_HEADS, dtype=f32)
    decay0 = jnp.log(-jnp.log(1.0 - 2.0 ** (-5.0 - heads)))
    return {
        "x": jax.random.normal(next(keys), (BATCH, SEQ, D), f32),
        "c": jax.random.normal(next(keys), (BATCH, D), f32),
        "ctx": jax.random.normal(next(keys), (BATCH, CTX_LEN, D), f32),
        "c_ctx": jax.random.normal(next(keys), (D,), f32),
        "mod_w": w((DEPTH, D, N_MOD * D), D, 0.5),
        "mod_b": small((DEPTH, N_MOD * D)),
        "norm_mix_g": g((DEPTH, D)),
        "norm_ffn_g": g((DEPTH, D)),
        "mla_w_dq": w((n_a, D, MLA_Q_RANK), D),
        "mla_q_norm_g": g((n_a, MLA_Q_RANK)),
        "mla_w_uq": w((n_a, MLA_Q_RANK, MLA_HEADS * (MLA_NOPE + MLA_ROPE)), MLA_Q_RANK),
        "mla_w_dkv": w((n_a, D, MLA_KV_RANK + MLA_ROPE), D),
        "mla_kv_norm_g": g((n_a, MLA_KV_RANK)),
        "mla_w_ukv": w((n_a, MLA_KV_RANK, MLA_HEADS * (MLA_NOPE + MLA_V)), MLA_KV_RANK),
        "mla_w_o": w((n_a, MLA_HEADS * MLA_V, D), MLA_HEADS * MLA_V),
        "ret_w_q": w((n_b, D, RET_HEADS * RET_DK), D),
        "ret_w_k": w((n_b, D, RET_HEADS * RET_DK), D),
        "ret_w_v": w((n_b, D, RET_HEADS * RET_DV), D),
        "ret_w_gf": w((n_b, D, RET_HEADS * RET_DV), D),
        "ret_w_gb": w((n_b, D, RET_HEADS * RET_DV), D),
        "ret_w_o": w((n_b, RET_HEADS * RET_DV, D), RET_HEADS * RET_DV),
        "ret_decay_f": decay0[None] + 0.1 * jax.random.normal(next(keys), (n_b, RET_HEADS), f32),
        "ret_decay_b": decay0[None] + 0.1 * jax.random.normal(next(keys), (n_b, RET_HEADS), f32),
        "ffn_w_gate": w((DEPTH, D, F), D),
        "ffn_w_up": w((DEPTH, D, F), D),
        "ffn_conv_w": w((DEPTH, CONV_W, F), CONV_W),
        "ffn_conv_b": small((DEPTH, F)),
        "ffn_w_down": w((DEPTH, F, D), F),
        "final_norm_g": g((D,)),
    }


def reference(x, c, ctx, c_ctx, mod_w, mod_b, norm_mix_g, norm_ffn_g,
              mla_w_dq, mla_q_norm_g, mla_w_uq, mla_w_dkv, mla_kv_norm_g, mla_w_ukv, mla_w_o,
              ret_w_q, ret_w_k, ret_w_v, ret_w_gf, ret_w_gb, ret_w_o, ret_decay_f, ret_decay_b,
              ffn_w_gate, ffn_w_up, ffn_conv_w, ffn_conv_b, ffn_w_down, final_norm_g):
    L = x.shape[1]
    rows = L // GRID_W
    f32 = jnp.float32
    row = jnp.repeat(jnp.arange(rows), GRID_W).astype(f32)
    col = jnp.tile(jnp.arange(GRID_W), rows).astype(f32)
    axis_dim = MLA_ROPE // 2
    inv_axis = ROPE_BASE ** (-jnp.arange(0, axis_dim, 2, dtype=f32) / axis_dim)
    ang_row = row[:, None] * inv_axis[None]
    ang_col = col[:, None] * inv_axis[None]
    inv_ret = ROPE_BASE ** (-jnp.arange(0, RET_DK, 2, dtype=f32) / RET_DK)
    ang_seq = jnp.arange(L, dtype=f32)[:, None] * inv_ret[None]

    cond_x = jax.nn.silu(c)
    cond_c = jax.nn.silu(c_ctx)[None]
    for l in range(DEPTH):
        last = l == DEPTH - 1
        i = l // N_MIXERS
        mod_x = (cond_x @ mod_w[l] + mod_b[l])[:, None, :]
        mod_c = (cond_c @ mod_w[l] + mod_b[l])[:, None, :]
        sh1x, sc1x, g1x, sh2x, sc2x, g2x = jnp.split(mod_x, N_MOD, axis=-1)
        sh1c, sc1c, g1c, sh2c, sc2c, g2c = jnp.split(mod_c, N_MOD, axis=-1)
        hx = rmsnorm(x, norm_mix_g[l]) * (1.0 + sc1x) + sh1x
        hc = rmsnorm(ctx, norm_mix_g[l]) * (1.0 + sc1c) + sh1c
        if l % N_MIXERS == 0:
            ox, oc = mla_mixer(hx, hc, last, ang_row, ang_col, mla_w_dq[i], mla_q_norm_g[i], mla_w_uq[i],
                               mla_w_dkv[i], mla_kv_norm_g[i], mla_w_ukv[i], mla_w_o[i])
        else:
            ox, oc = retention_mixer(hx, hc, last, ang_seq, ret_w_q[i], ret_w_k[i], ret_w_v[i],
                                     ret_w_gf[i], ret_w_gb[i], ret_w_o[i], ret_decay_f[i], ret_decay_b[i])
        x = x + g1x * ox
        hx2 = rmsnorm(x, norm_ffn_g[l]) * (1.0 + sc2x) + sh2x
        x = x + g2x * conv_ffn(hx2, ffn_w_gate[l], ffn_w_up[l], ffn_conv_w[l], ffn_conv_b[l], ffn_w_down[l])
        if not last:
            ctx = ctx + g1c * oc
            hc2 = rmsnorm(ctx, norm_ffn_g[l]) * (1.0 + sc2c) + sh2c
            ctx = ctx + g2c * conv_ffn(hc2, ffn_w_gate[l], ffn_w_up[l], ffn_conv_w[l], ffn_conv_b[l], ffn_w_down[l])
    return rmsnorm(x, final_norm_g)
```

```cpp
#include <hip/hip_runtime.h>
#include <cstdio>
#include <cstdint>

#ifndef MK_SINGLE
#define MK_SINGLE 1
#endif

#define GAS __attribute__((address_space(1)))
#define LAS __attribute__((address_space(3)))
typedef unsigned short bf16;
typedef short bf16x8 __attribute__((ext_vector_type(8)));
typedef short s16x4 __attribute__((ext_vector_type(4)));
typedef float f32x2 __attribute__((ext_vector_type(2)));
typedef float f32x4 __attribute__((ext_vector_type(4)));
typedef float f32x16 __attribute__((ext_vector_type(16)));
typedef unsigned u32x2 __attribute__((ext_vector_type(2)));
typedef unsigned u32x4 __attribute__((ext_vector_type(4)));
typedef GAS unsigned gu32;

constexpr int D = 2048, NB = 8, SEQ = 4096, CTXL = 256, DEPTH = 4;
constexpr int MX = NB * SEQ, MC = NB * CTXL, MT = MX + MC;
constexpr int FF = 5632, NMOD = 6 * D;
constexpr int MLA_H = 16, QR = 512, KVR = 512, NOPE = 128, ROPE = 64, DQ = 192;
constexpr int N1 = 1280;
constexpr int RH = 8, RDK = 256, RDV = 512;
constexpr float NORM_EPS = 1e-6f, GN_EPS = 1e-5f;
constexpr float LOG2E = 1.4426950408889634f;

constexpr size_t MiB = 1u << 20;
constexpr size_t WS_CTL = 0, CTL_BYTES = 1 * MiB;
constexpr size_t WS_MODV = 1 * MiB;
constexpr size_t WS_TABM = 3 * MiB;
constexpr size_t WS_TABR = 4 * MiB;
constexpr size_t WS_SSQ = 8 * MiB;
constexpr size_t WS_XC = 12 * MiB;
constexpr size_t WS_KR = 28 * MiB;
constexpr size_t WS_W = 40 * MiB;
constexpr size_t WS_WFFN = WS_W + 84 * MiB;
constexpr size_t WS_H = 200 * MiB;
constexpr size_t WS_BIG = 336 * MiB;
constexpr size_t WS_QKVL = WS_BIG, WS_Q = WS_BIG + 88 * MiB, WS_KV = WS_BIG + 292 * MiB, WS_O = WS_BIG + 564 * MiB;
constexpr size_t WS_QKV = WS_BIG, WS_Y = WS_BIG + 544 * MiB, WS_GATED = WS_BIG;
constexpr size_t WS_G = WS_BIG, WS_U = WS_BIG + 374 * MiB;
constexpr size_t WS_END = WS_BIG + 1088 * MiB;
static_assert((size_t)MT * 8192 * 2 <= 544 * MiB && (size_t)MT * 5632 * 2 <= 374 * MiB && (size_t)MT * N1 * 2 <= 88 * MiB, "ws map");

constexpr int CW_BAR = 4096;

constexpr int RING_BYTES = 131072, MISC_OFF = RING_BYTES + 320, ARGS_OFF = RING_BYTES + 1024, LDS_BYTES = 147456;

__device__ __forceinline__ unsigned cvt_pk_bf16(float lo, float hi) { unsigned r; asm volatile("v_cvt_pk_bf16_f32 %0, %1, %2" : "=v"(r) : "v"(lo), "v"(hi)); return r; }
__device__ __forceinline__ float bf2f(unsigned short b) { return __uint_as_float((unsigned)b << 16); }
__device__ __forceinline__ float bflo(unsigned w) { return __uint_as_float(w << 16); }
__device__ __forceinline__ float bfhi(unsigned w) { return __uint_as_float(w & 0xffff0000u); }
__device__ __forceinline__ float shfl_xor_l(float v, int mask, int lane) { return __builtin_bit_cast(float, __builtin_amdgcn_ds_bpermute((lane ^ mask) << 2, __builtin_bit_cast(int, v))); }
__device__ __forceinline__ float fast_silu(float x) { return x * __builtin_amdgcn_rcpf(1.0f + __builtin_amdgcn_exp2f(-x * LOG2E)); }

__device__ __forceinline__ void glds16_s(const void* sbase, unsigned voff, unsigned lds_dst) {
    unsigned keep;
    asm volatile("s_mov_b32 %0, m0\n\ts_mov_b32 m0, %3\n\ts_nop 0\n\tglobal_load_lds_dwordx4 %1, %2\n\ts_mov_b32 m0, %0" : "=&s"(keep) : "v"(voff), "s"(sbase), "s"(lds_dst) : "memory");
}
__device__ __forceinline__ const char* uni_ptr(const void* p) {
    const unsigned long long v = (unsigned long long)p; const unsigned lo = __builtin_amdgcn_readfirstlane((unsigned)v), hi = __builtin_amdgcn_readfirstlane((unsigned)(v >> 32));
    return (const char*)(((unsigned long long)hi << 32) | lo);
}
namespace pg8 {
constexpr int BM = 256, BK = 64, HALF = 128, HTB = HALF * BK * 2, STAGE_BYTES = 8 * HTB, NXCD = 8, WGM = 8;
__host__ __device__ __forceinline__ int lds_byte(int r, int c) { const int st = (r >> 4) * 2 + (c >> 5), rr = r & 15, cc = c & 31, ob = rr * 64 + cc * 2; return st * 1024 + (ob ^ (((ob >> 9) & 1) << 5)); }
__host__ __device__ __forceinline__ void stage_rc(int b, int& R, int& C) { const int st = b / 1024, sb = b % 1024, swz = sb ^ (((sb >> 9) & 1) << 5); R = (st >> 1) * 16 + swz / 64; C = (st & 1) * 32 + (swz % 64) / 2; }
__host__ __device__ __forceinline__ int perm32(int rho) { const int n = rho >> 4, i = rho & 15; return 8 * (i >> 2) + 4 * n + (i & 3); }
struct Unit { int pm, pn; };
struct Gemm { const bf16* A; const bf16* Bt; int M, N, K, lda; };
struct StaticOrder {
    int nM, nN, nwg, G, c;
    __device__ void init(int M, int N, int G_, int c_) { nM = M / BM; nN = N / BM; nwg = nM * nN; G = G_; c = c_; }
    __device__ bool next(int i, Unit& u) const {
        const long L = (long)i * G + c; if (L >= nwg) return false;
        int wgid = (int)L; { const int q = nwg / NXCD, r = nwg % NXCD, xcd = wgid % NXCD, off = wgid / NXCD; wgid = (xcd < r ? xcd * (q + 1) : r * (q + 1) + (xcd - r) * q) + off; }
        const int nig = WGM * nN, gid = wgid / nig, fm = gid * WGM, gsz = (nM - fm) < WGM ? (nM - fm) : WGM;
        u.pm = fm + ((wgid % nig) % gsz); u.pn = (wgid % nig) / gsz; return true;
    }
};
template <class Epi>
__device__ __forceinline__ void gemm_phase(LAS unsigned char* lds, const Gemm g, const StaticOrder& S, const Epi& E) {
    int tid = threadIdx.x; asm volatile("" : "+v"(tid));
    const int wid = __builtin_amdgcn_readfirstlane(tid >> 6), lane = tid & 63, wr = wid >> 2, wc = wid & 3, fr = lane & 15, fq = lane >> 4;
    const int K = g.K, nt = K / BK;
    unsigned voffA[2], voffB[2];
#pragma unroll
    for (int i = 0; i < 2; ++i) { int R, C; stage_rc(tid * 16 + i * 8192, R, C); const int Rb = Epi::PERM ? ((R & ~31) + perm32(R & 31)) : R;
        voffA[i] = (unsigned)(R * g.lda + C) * 2u; voffB[i] = (unsigned)(Rb * K + C) * 2u; }
    const size_t kstep = (size_t)(BK * 2);
    const size_t hstepA = (size_t)HALF * g.lda * 2, hstepB = (size_t)HALF * K * 2;
    const size_t tstepA = 2 * hstepA, tstepB = 2 * hstepB;
    const unsigned ldsbase = (unsigned)__builtin_amdgcn_readfirstlane((unsigned)(uintptr_t)lds + (unsigned)wid * 1024u);
    const int aoff = lds_byte(wr * 64 + fr, fq * 8), boff = lds_byte(wc * 32 + fr, fq * 8);
#define PG8_SA(b, h) (((b) * 2 + (h)) * HTB)
#define PG8_SB(b, h) ((4 + (b) * 2 + (h)) * HTB)
#define PG8_STAGE(bufoff, gbase, voff) do { const char* _gb = uni_ptr(gbase); _Pragma("unroll") for (int _i = 0; _i < 2; ++_i) \
        glds16_s(_gb, (voff)[_i], ldsbase + (unsigned)((bufoff) + _i * 8192)); } while (0)
#define PG8_LDA(dst, b, h) do { _Pragma("unroll") for (int m = 0; m < 4; ++m) _Pragma("unroll") for (int k = 0; k < 2; ++k) dst[m][k] = *(const LAS bf16x8*)(lds + PG8_SA(b, h) + aoff + m * 2048 + k * 1024); } while (0)
#define PG8_LDB(dst, b, h) do { _Pragma("unroll") for (int n = 0; n < 2; ++n) _Pragma("unroll") for (int k = 0; k < 2; ++k) dst[n][k] = *(const LAS bf16x8*)(lds + PG8_SB(b, h) + boff + n * 2048 + k * 1024); } while (0)
#define PG8_MMA(ai, bj, At, Bt) do { __builtin_amdgcn_s_setprio(1); _Pragma("unroll") for (int m = 0; m < 4; ++m) _Pragma("unroll") for (int n = 0; n < 2; ++n) _Pragma("unroll") for (int k = 0; k < 2; ++k) \
        acc[ai][bj][m][n] = __builtin_amdgcn_mfma_f32_16x16x32_bf16(Bt[n][k], At[m][k], acc[ai][bj][m][n], 0, 0, 0); __builtin_amdgcn_s_setprio(0); } while (0)
#define PG8_WAIT_V(n) asm volatile("s_waitcnt vmcnt(" #n ")" ::: "memory")
#define PG8_WAIT_L(n) asm volatile("s_waitcnt lgkmcnt(" #n ")" ::: "memory")
#define PG8_BAR __builtin_amdgcn_s_barrier()
#define PG8_SCHED __builtin_amdgcn_sched_barrier(0)
    Unit cur, nxt; int ui = 0;
    if (!S.next(0, cur)) return;
    f32x4 acc[2][2][4][2];
#pragma unroll
    for (int a = 0; a < 2; ++a)
#pragma unroll
        for (int b = 0; b < 2; ++b)
#pragma unroll
            for (int m = 0; m < 4; ++m)
#pragma unroll
                for (int n = 0; n < 2; ++n) acc[a][b][m][n] = (f32x4){0.f, 0.f, 0.f, 0.f};
    bf16x8 At[4][2], B0[2][2], B1[2][2];
    const char* cA = (const char*)g.A + (size_t)cur.pm * tstepA; const char* cB = (const char*)g.Bt + (size_t)cur.pn * tstepB;
    PG8_STAGE(PG8_SB(0, 0), cB, voffB); PG8_STAGE(PG8_SB(0, 1), cB + hstepB, voffB); PG8_STAGE(PG8_SA(0, 0), cA, voffA); PG8_STAGE(PG8_SA(0, 1), cA + hstepA, voffA);
    if (wr == 1) PG8_BAR;
    PG8_WAIT_V(2); PG8_BAR;
    PG8_STAGE(PG8_SB(1, 0), cB + kstep, voffB); PG8_STAGE(PG8_SA(1, 0), cA + kstep, voffA); PG8_STAGE(PG8_SB(1, 1), cB + hstepB + kstep, voffB);
    PG8_WAIT_V(6); PG8_BAR;
    for (;;) {
        const bool has_next = S.next(ui + 1, nxt);
        const char* nA = has_next ? (const char*)g.A + (size_t)nxt.pm * tstepA : cA; const char* nB = has_next ? (const char*)g.Bt + (size_t)nxt.pn * tstepB : cB;
        for (int t = 0; t < nt; t += 2) {
            const bool last = (t == nt - 2);
            const char* a1 = cA + (size_t)(t + 1) * kstep;
            const char* a2 = last ? nA : cA + (size_t)(t + 2) * kstep; const char* b2 = last ? nB : cB + (size_t)(t + 2) * kstep;
            const char* a3 = a2 + kstep; const char* b3 = b2 + kstep;
            PG8_LDB(B0, 0, 0); PG8_LDB(B1, 0, 1); PG8_SCHED; PG8_LDA(At, 0, 0); PG8_STAGE(PG8_SA(1, 1), a1 + hstepA, voffA);
            PG8_WAIT_V(8); PG8_WAIT_L(0); PG8_BAR; PG8_MMA(0, 0, At, B0); PG8_MMA(0, 1, At, B1); PG8_BAR; PG8_SCHED;
            PG8_LDA(At, 0, 1); PG8_STAGE(PG8_SB(0, 0), b2, voffB); PG8_STAGE(PG8_SB(0, 1), b2 + hstepB, voffB); PG8_STAGE(PG8_SA(0, 0), a2, voffA);
            PG8_WAIT_V(8); PG8_WAIT_L(0); PG8_BAR; PG8_MMA(1, 0, At, B0); PG8_MMA(1, 1, At, B1); PG8_BAR; PG8_SCHED;
            PG8_LDB(B0, 1, 0); PG8_LDB(B1, 1, 1); PG8_SCHED; PG8_LDA(At, 1, 0); PG8_STAGE(PG8_SA(0, 1), a2 + hstepA, voffA);
            PG8_WAIT_V(8); PG8_WAIT_L(0); PG8_BAR; PG8_MMA(0, 0, At, B0); PG8_MMA(0, 1, At, B1); PG8_BAR; PG8_SCHED;
            PG8_LDA(At, 1, 1); PG8_STAGE(PG8_SB(1, 0), b3, voffB); PG8_STAGE(PG8_SB(1, 1), b3 + hstepB, voffB); PG8_STAGE(PG8_SA(1, 0), a3, voffA);
            PG8_WAIT_V(8); PG8_WAIT_L(0); PG8_BAR; PG8_MMA(1, 0, At, B0); PG8_MMA(1, 1, At, B1); PG8_BAR; PG8_SCHED;
        }
        if (wr == 0) PG8_BAR;
        E(acc, cur, wr, wc, fr, fq);
        if (!has_next) break;
#pragma unroll
        for (int a = 0; a < 2; ++a)
#pragma unroll
            for (int b = 0; b < 2; ++b)
#pragma unroll
                for (int m = 0; m < 4; ++m)
#pragma unroll
                    for (int n = 0; n < 2; ++n) acc[a][b][m][n] = (f32x4){0.f, 0.f, 0.f, 0.f};
        cur = nxt; cA = nA; cB = nB; ++ui;
        if (wr == 1) PG8_BAR;
    }
    PG8_WAIT_V(0);
    PG8_BAR;
#undef PG8_SA
#undef PG8_SB
#undef PG8_STAGE
#undef PG8_LDA
#undef PG8_LDB
#undef PG8_MMA
#undef PG8_WAIT_V
#undef PG8_WAIT_L
#undef PG8_BAR
#undef PG8_SCHED
}
}
using pg8::Unit;

__device__ __forceinline__ u32x4 pack8(const f32x4 a, const f32x4 b) { u32x4 w; w.x = cvt_pk_bf16(a[0], a[1]); w.y = cvt_pk_bf16(a[2], a[3]); w.z = cvt_pk_bf16(b[0], b[1]); w.w = cvt_pk_bf16(b[2], b[3]); return w; }
__device__ __forceinline__ f32x4 rot2(const f32x4 v, const f32x4 cs) { f32x4 o; o[0] = v[0] * cs[0] - v[1] * cs[1]; o[1] = v[1] * cs[0] + v[0] * cs[1]; o[2] = v[2] * cs[2] - v[3] * cs[3]; o[3] = v[3] * cs[2] + v[2] * cs[3]; return o; }

__device__ __forceinline__ f32x4 mla_cs(const float* tabm, int t, int c4) {
    const int p0 = c4 >> 1; const int pos = (p0 < 16) ? (t >> 6) : (t & 63); const int f = p0 & 15;
    return *(const f32x4*)(tabm + ((size_t)pos * 16 + f) * 2);
}

struct EpiG1 {
    static constexpr bool PERM = true;
    bf16* QKVL; float* SSQ; bf16* KR; const float* tabm;
    __device__ __forceinline__ void operator()(const f32x4 (&acc)[2][2][4][2], const Unit& u, int wr, int wc, int fr, int fq) const {
        const int row0 = u.pm * 256 + wr * 64 + fr;
        if (u.pn < 4) {
            const int col0 = u.pn * 256 + wc * 32 + 8 * fq;
#pragma unroll
            for (int ai = 0; ai < 2; ++ai)
#pragma unroll
                for (int m = 0; m < 4; ++m) { const int row = row0 + ai * 128 + m * 16; float ss = 0.f;
#pragma unroll
                    for (int bj = 0; bj < 2; ++bj) { const f32x4 v0 = acc[ai][bj][m][0], v1 = acc[ai][bj][m][1];
                        ss += (v0[0] * v0[0] + v0[1] * v0[1]) + (v0[2] * v0[2] + v0[3] * v0[3]) + (v1[0] * v1[0] + v1[1] * v1[1]) + (v1[2] * v1[2] + v1[3] * v1[3]);
                        *(u32x4*)(QKVL + (size_t)row * N1 + col0 + bj * 128) = pack8(v0, v1); }
                    { const int ln_ = fr + 16 * fq; ss += shfl_xor_l(ss, 16, ln_); ss += shfl_xor_l(ss, 32, ln_); }
                    if (fq == 0) SSQ[(size_t)row * 16 + u.pn * 4 + wc] = ss; asm volatile("" ::: "memory"); }
        } else if (wc < 2) {
            const int c8 = wc * 32 + 8 * fq;
#pragma unroll
            for (int ai = 0; ai < 2; ++ai)
#pragma unroll
                for (int m = 0; m < 4; ++m) { const int row = row0 + ai * 128 + m * 16; f32x4 v0 = acc[ai][0][m][0], v1 = acc[ai][0][m][1];
                    if (row < MX) { const int t = row & (SEQ - 1); v0 = rot2(v0, mla_cs(tabm, t, c8)); v1 = rot2(v1, mla_cs(tabm, t, c8 + 4)); }
                    *(u32x4*)(KR + (size_t)row * 64 + c8) = pack8(v0, v1); asm volatile("" ::: "memory"); }
        }
    }
};
struct EpiUq {
    static constexpr bool PERM = true;
    bf16* Q; const float* SSQ; const float* tabm;
    __device__ __forceinline__ void operator()(const f32x4 (&acc)[2][2][4][2], const Unit& u, int wr, int wc, int fr, int fq) const {
        const int row0 = u.pm * 256 + wr * 64 + fr;
        int col8[2], dd[2];
#pragma unroll
        for (int bj = 0; bj < 2; ++bj) { col8[bj] = u.pn * 256 + bj * 128 + wc * 32 + 8 * fq; dd[bj] = col8[bj] % DQ; }
#pragma unroll
        for (int ai = 0; ai < 2; ++ai)
#pragma unroll
            for (int m = 0; m < 4; ++m) { const int row = row0 + ai * 128 + m * 16;
                const f32x4 s0 = *(const f32x4*)(SSQ + (size_t)row * 16), s1 = *(const f32x4*)(SSQ + (size_t)row * 16 + 4);
                const float ss = ((s0[0] + s0[1]) + (s0[2] + s0[3])) + ((s1[0] + s1[1]) + (s1[2] + s1[3]));
                const float r = 1.0f / sqrtf(ss * (1.0f / QR) + NORM_EPS);
#pragma unroll
                for (int bj = 0; bj < 2; ++bj) { f32x4 v0 = acc[ai][bj][m][0] * r, v1 = acc[ai][bj][m][1] * r;
                    if (dd[bj] >= NOPE && row < MX) { const int t = row & (SEQ - 1), c8 = dd[bj] - NOPE; v0 = rot2(v0, mla_cs(tabm, t, c8)); v1 = rot2(v1, mla_cs(tabm, t, c8 + 4)); }
                    *(u32x4*)(Q + (size_t)row * 3072 + col8[bj]) = pack8(v0, v1); } asm volatile("" ::: "memory"); }
    }
};
struct EpiUkv {
    static constexpr bool PERM = true;
    bf16* KV; const float* SSQ;
    __device__ __forceinline__ void operator()(const f32x4 (&acc)[2][2][4][2], const Unit& u, int wr, int wc, int fr, int fq) const {
        const int row0 = u.pm * 256 + wr * 64 + fr; const int col0 = u.pn * 256 + wc * 32 + 8 * fq;
#pragma unroll
        for (int ai = 0; ai < 2; ++ai)
#pragma unroll
            for (int m = 0; m < 4; ++m) { const int row = row0 + ai * 128 + m * 16;
                const f32x4 s0 = *(const f32x4*)(SSQ + (size_t)row * 16 + 8), s1 = *(const f32x4*)(SSQ + (size_t)row * 16 + 12);
                const float ss = ((s0[0] + s0[1]) + (s0[2] + s0[3])) + ((s1[0] + s1[1]) + (s1[2] + s1[3]));
                const float r = 1.0f / sqrtf(ss * (1.0f / KVR) + NORM_EPS);
#pragma unroll
                for (int bj = 0; bj < 2; ++bj) *(u32x4*)(KV + (size_t)row * 4096 + col0 + bj * 128) = pack8(acc[ai][bj][m][0] * r, acc[ai][bj][m][1] * r); asm volatile("" ::: "memory"); }
    }
};
struct EpiResid {
    static constexpr bool PERM = false;
    const float* xin; float* xout; const float* cin; float* cout; const float* modv; int gofs;
    __device__ __forceinline__ void operator()(const f32x4 (&acc)[2][2][4][2], const Unit& u, int wr, int wc, int fr, int fq) const {
        const bool isx = u.pm < (MX / 256);
        const int rloc = (isx ? u.pm * 256 : (u.pm * 256 - MX)) + wr * 64 + fr;
        const float* base = isx ? xin : cin; float* out = isx ? xout : cout;
        const float* gv = modv + (size_t)(isx ? (u.pm >> 4) : 8) * NMOD + gofs;
        const int col0 = u.pn * 256 + wc * 32 + 4 * fq;
        f32x4 g4[2][2];
#pragma unroll
        for (int bj = 0; bj < 2; ++bj)
#pragma unroll
            for (int n = 0; n < 2; ++n) g4[bj][n] = *(const f32x4*)(gv + col0 + bj * 128 + n * 16);
#pragma unroll
        for (int ai = 0; ai < 2; ++ai)
#pragma unroll
            for (int m = 0; m < 4; ++m) { const size_t off = (size_t)(rloc + ai * 128 + m * 16) * D + col0;
#pragma unroll
                for (int bj = 0; bj < 2; ++bj)
#pragma unroll
                    for (int n = 0; n < 2; ++n) { const f32x4 b = *(const f32x4*)(base + off + bj * 128 + n * 16); *(f32x4*)(out + off + bj * 128 + n * 16) = b + g4[bj][n] * acc[ai][bj][m][n]; }
                if (m & 1) asm volatile("" ::: "memory"); }
    }
};
struct EpiGU {
    static constexpr bool PERM = true;
    bf16* G; bf16* U;
    __device__ __forceinline__ void operator()(const f32x4 (&acc)[2][2][4][2], const Unit& u, int wr, int wc, int fr, int fq) const {
        const int row0 = u.pm * 256 + wr * 64 + fr; const int f0 = u.pn * 128 + wc * 32 + 8 * fq;
#pragma unroll
        for (int ai = 0; ai < 2; ++ai)
#pragma unroll
            for (int m = 0; m < 4; ++m) { const size_t off = (size_t)(row0 + ai * 128 + m * 16) * FF + f0;
                *(u32x4*)(G + off) = pack8(acc[ai][0][m][0], acc[ai][0][m][1]); *(u32x4*)(U + off) = pack8(acc[ai][1][m][0], acc[ai][1][m][1]); }
    }
};
struct EpiQKV {
    static constexpr bool PERM = true;
    bf16* QKV; const float* tabr;
    __device__ __forceinline__ void operator()(const f32x4 (&acc)[2][2][4][2], const Unit& u, int wr, int wc, int fr, int fq) const {
        const int row0 = u.pm * 256 + wr * 64 + fr; const int col0 = u.pn * 256 + wc * 32 + 8 * fq;
        const bool rope = (u.pn < 16) && (u.pm < MX / 256);
#pragma unroll
        for (int ai = 0; ai < 2; ++ai)
#pragma unroll
            for (int m = 0; m < 4; ++m) { const int row = row0 + ai * 128 + m * 16;
#pragma unroll
                for (int bj = 0; bj < 2; ++bj) { f32x4 v0 = acc[ai][bj][m][0], v1 = acc[ai][bj][m][1]; const int col = col0 + bj * 128;
                    if (rope) { const int t = row & (SEQ - 1); const float* tp = tabr + ((size_t)t * 128 + ((col & 255) >> 1)) * 2;
                        v0 = rot2(v0, *(const f32x4*)tp); v1 = rot2(v1, *(const f32x4*)(tp + 4)); }
                    *(u32x4*)(QKV + (size_t)row * 8192 + col) = pack8(v0, v1); } asm volatile("" ::: "memory"); }
    }
};
struct EpiGate {
    static constexpr bool PERM = true;
    bf16* GATED; const bf16* YF; const bf16* YB;
    __device__ __forceinline__ void operator()(const f32x4 (&acc)[2][2][4][2], const Unit& u, int wr, int wc, int fr, int fq) const {
        const int row0 = u.pm * 256 + wr * 64 + fr; const int f0 = u.pn * 128 + wc * 32 + 8 * fq;
#pragma unroll
        for (int ai = 0; ai < 2; ++ai)
#pragma unroll
            for (int m = 0; m < 4; ++m) { const size_t off = (size_t)(row0 + ai * 128 + m * 16) * 4096 + f0;
                const u32x4 nf = *(const u32x4*)(YF + off), nb = *(const u32x4*)(YB + off);
                const f32x4 a0 = acc[ai][0][m][0], a1 = acc[ai][0][m][1], b0 = acc[ai][1][m][0], b1 = acc[ai][1][m][1];
                f32x4 o0, o1;
                o0[0] = fast_silu(a0[0]) * bflo(nf.x) + fast_silu(b0[0]) * bflo(nb.x); o0[1] = fast_silu(a0[1]) * bfhi(nf.x) + fast_silu(b0[1]) * bfhi(nb.x);
                o0[2] = fast_silu(a0[2]) * bflo(nf.y) + fast_silu(b0[2]) * bflo(nb.y); o0[3] = fast_silu(a0[3]) * bfhi(nf.y) + fast_silu(b0[3]) * bfhi(nb.y);
                o1[0] = fast_silu(a1[0]) * bflo(nf.z) + fast_silu(b1[0]) * bflo(nb.z); o1[1] = fast_silu(a1[1]) * bfhi(nf.z) + fast_silu(b1[1]) * bfhi(nb.z);
                o1[2] = fast_silu(a1[2]) * bflo(nf.w) + fast_silu(b1[2]) * bflo(nb.w); o1[3] = fast_silu(a1[3]) * bfhi(nf.w) + fast_silu(b1[3]) * bfhi(nb.w);
                *(u32x4*)(GATED + off) = pack8(o0, o1); asm volatile("" ::: "memory"); }
    }
};

namespace att {
constexpr int NW = 8, QBLK = 32, KVBLK = 64;
constexpr int SHM_V = 16384, SHM_KN = 16384, SHM_KR = 8192;
constexpr int OFF_V = 0, OFF_KN = 3 * SHM_V, OFF_KR = OFF_KN + 2 * SHM_KN, OFF_WS = OFF_KR + 2 * SHM_KR, SHM_ATTN = OFF_WS + NW * 64 * 4;
constexpr float THR2 = 11.5f;
#define KSWZ(row, colB) ((row) * 256 + ((colB) ^ (((row) & 7) << 4)))
#define KRSWZ(row, colB) ((row) * 128 + ((colB) ^ ((((row) >> 1) & 7) << 4)))
#define SBAR() __builtin_amdgcn_sched_barrier(0)
__device__ __forceinline__ int crow(int r, int hi) { return (r & 3) + 8 * (r >> 2) + 4 * hi; }
__device__ __forceinline__ void partialSM(f32x16& p0, f32x16& p1, float& m_reg, float& alpha) {
  float pmax = p0[0];
#pragma unroll
  for (int r = 1; r < 16; ++r) pmax = fmaxf(pmax, p0[r]);
#pragma unroll
  for (int r = 0; r < 16; ++r) pmax = fmaxf(pmax, p1[r]);
  { auto rr = __builtin_amdgcn_permlane32_swap(__float_as_uint(pmax), __float_as_uint(pmax), false, false); pmax = fmaxf(__uint_as_float(rr[0]), __uint_as_float(rr[1])); }
  float mn;
  if (__builtin_expect(__all(pmax - m_reg <= THR2), 1)) { mn = m_reg; alpha = 1.f; }
  else { mn = fmaxf(m_reg, pmax); alpha = __builtin_amdgcn_exp2f(m_reg - mn); m_reg = mn; }
#pragma unroll
  for (int r = 0; r < 16; ++r) p0[r] = p0[r] - mn;
#pragma unroll
  for (int r = 0; r < 16; ++r) p1[r] = p1[r] - mn;
#pragma unroll
  for (int r = 0; r < 16; ++r) p0[r] = __builtin_amdgcn_exp2f(p0[r]);
}
__device__ __forceinline__ void finishSM(f32x16& p0, f32x16& p1, float alpha, float& l_reg, bf16x8& pa0, bf16x8& pa1, bf16x8& pa2, bf16x8& pa3) {
#pragma unroll
  for (int r = 0; r < 16; ++r) p1[r] = __builtin_amdgcn_exp2f(p1[r]);
  float ps = 0;
#pragma unroll
  for (int r = 0; r < 16; ++r) ps += p0[r];
#pragma unroll
  for (int r = 0; r < 16; ++r) ps += p1[r];
  { auto rr = __builtin_amdgcn_permlane32_swap(__float_as_uint(ps), __float_as_uint(ps), false, false); ps = __uint_as_float(rr[0]) + __uint_as_float(rr[1]); }
  l_reg = l_reg * alpha + ps;
#define PK4(P, BASE, OUT) do { unsigned a0 = cvt_pk_bf16(P[BASE + 0], P[BASE + 1]), a1 = cvt_pk_bf16(P[BASE + 2], P[BASE + 3]);   \
    unsigned b0 = cvt_pk_bf16(P[BASE + 4], P[BASE + 5]), b1 = cvt_pk_bf16(P[BASE + 6], P[BASE + 7]);                              \
    auto r0 = __builtin_amdgcn_permlane32_swap(a0, b0, false, false); auto r1 = __builtin_amdgcn_permlane32_swap(a1, b1, false, false); \
    u32x4 w = {r0[0], r1[0], r0[1], r1[1]}; OUT = __builtin_bit_cast(bf16x8, w); } while (0)
  PK4(p0, 0, pa0); PK4(p0, 8, pa1); PK4(p1, 0, pa2); PK4(p1, 8, pa3);
#undef PK4
}
__device__ __forceinline__ void qkt(f32x16& p0, f32x16& p1, const char* Kn, const char* Kr, const bf16x8* qr, int r32, int hi) {
  p0 = f32x16{}; p1 = f32x16{};
#pragma unroll
  for (int d0 = 0; d0 < 8; ++d0) { const int cb = (d0 * 16 + hi * 8) * 2;
    const bf16x8 b0 = *reinterpret_cast<const bf16x8*>(Kn + KSWZ(r32, cb));
    const bf16x8 b1 = *reinterpret_cast<const bf16x8*>(Kn + KSWZ(32 + r32, cb));
    p0 = __builtin_amdgcn_mfma_f32_32x32x16_bf16(b0, qr[d0], p0, 0, 0, 0);
    p1 = __builtin_amdgcn_mfma_f32_32x32x16_bf16(b1, qr[d0], p1, 0, 0, 0); }
#pragma unroll
  for (int d0 = 0; d0 < 4; ++d0) { const int cb = (d0 * 16 + hi * 8) * 2;
    const bf16x8 b0 = *reinterpret_cast<const bf16x8*>(Kr + KRSWZ(r32, cb));
    const bf16x8 b1 = *reinterpret_cast<const bf16x8*>(Kr + KRSWZ(32 + r32, cb));
    p0 = __builtin_amdgcn_mfma_f32_32x32x16_bf16(b0, qr[8 + d0], p0, 0, 0, 0);
    p1 = __builtin_amdgcn_mfma_f32_32x32x16_bf16(b1, qr[8 + d0], p1, 0, 0, 0); }
}
__device__ __forceinline__ int v_st(int k, int c) { const int kk = (k & ~0xC) | ((k & 4) << 1) | ((k & 8) >> 1); return ((kk >> 3) * 4 + (c >> 5)) * 512 + ((kk & 7) * 32 + (c & 31)) * 2; }
__device__ __forceinline__ int v_rd_base(int lane) { return ((lane & 3) << 3) | (((lane >> 2) & 3) << 6) | (((lane >> 4) & 1) << 5) | (((lane >> 5) & 1) << 8); }
constexpr int v_rd_off(int d0, int ks, int half) { return d0 * 512 + ks * 4096 + half * 2048; }
template <int OFF> __device__ __forceinline__ s16x4 tr_read(int vb) { s16x4 r; asm volatile("ds_read_b64_tr_b16 %0, %1 offset:%2" : "=&v"(r) : "v"(vb), "i"(OFF) : "memory"); return r; }
template <int D0> __device__ __forceinline__ void pv_one(f32x16& od, int vb, bf16x8 pa0, bf16x8 pa1, bf16x8 pa2, bf16x8 pa3) {
  const s16x4 l0 = tr_read<v_rd_off(D0, 0, 0)>(vb), h0 = tr_read<v_rd_off(D0, 0, 1)>(vb), l1 = tr_read<v_rd_off(D0, 1, 0)>(vb), h1 = tr_read<v_rd_off(D0, 1, 1)>(vb);
  const s16x4 l2 = tr_read<v_rd_off(D0, 2, 0)>(vb), h2 = tr_read<v_rd_off(D0, 2, 1)>(vb), l3 = tr_read<v_rd_off(D0, 3, 0)>(vb), h3 = tr_read<v_rd_off(D0, 3, 1)>(vb);
  asm volatile("s_waitcnt lgkmcnt(0)" ::: "memory"); SBAR();
#define PK(L, H) (bf16x8){L[0], L[1], L[2], L[3], H[0], H[1], H[2], H[3]}
  od = __builtin_amdgcn_mfma_f32_32x32x16_bf16(pa0, PK(l0, h0), od, 0, 0, 0);
  od = __builtin_amdgcn_mfma_f32_32x32x16_bf16(pa1, PK(l1, h1), od, 0, 0, 0);
  od = __builtin_amdgcn_mfma_f32_32x32x16_bf16(pa2, PK(l2, h2), od, 0, 0, 0);
  od = __builtin_amdgcn_mfma_f32_32x32x16_bf16(pa3, PK(l3, h3), od, 0, 0, 0);
#undef PK
}
__device__ __forceinline__ void pv_d0(f32x16* o, int vb, bf16x8 pa0, bf16x8 pa1, bf16x8 pa2, bf16x8 pa3) {
  pv_one<0>(o[0], vb, pa0, pa1, pa2, pa3); pv_one<1>(o[1], vb, pa0, pa1, pa2, pa3); pv_one<2>(o[2], vb, pa0, pa1, pa2, pa3); pv_one<3>(o[3], vb, pa0, pa1, pa2, pa3);
}
__device__ __forceinline__ void attn_unit(const bf16* __restrict__ Qb, const bf16* __restrict__ KVh, const bf16* __restrict__ KRp, bf16* __restrict__ Ob,
                                          int NT, int nc, int cbase, int xbase, char* lds) {
  int tid = threadIdx.x; asm volatile("" : "+v"(tid));
  const int wid = __builtin_amdgcn_readfirstlane(tid >> 6), lane = tid & 63, r32 = lane & 31, hi = lane >> 5;
  char* V_lds = lds + OFF_V; char* Kn_lds = lds + OFF_KN; char* Kr_lds = lds + OFF_KR;
  float* ws = (float*)(lds + OFF_WS) + wid * 64; float* li_l = ws; float* al_l = ws + 32;
  float m_reg = -1e30f, l_reg = 0; f32x16 o[4] = {}; bf16x8 qr[12];
  const bf16* Qw = Qb + (long)(wid * QBLK + r32) * 3072 + hi * 8;
#pragma unroll
  for (int d0 = 0; d0 < 12; ++d0) qr[d0] = *reinterpret_cast<const bf16x8*>(Qw + d0 * 16);
  const int vb0 = (int)(uintptr_t)V_lds + v_rd_base(lane);
  unsigned vofK[2], vofV[2], vofR;
#pragma unroll
  for (int i = 0; i < 2; ++i) { const int pc = wid * 2 + i;
      { const int row = pc * 4 + (lane >> 4), ch = (lane & 15) ^ (row & 7); vofK[i] = (unsigned)((row * 4096 + ch * 8) * 2); }
      { const int ob = pc * 1024 + lane * 16, st = ob >> 9, w = ob & 511, kk = (st >> 2) * 8 + (w >> 6); const int k = (kk & ~0xC) | ((kk & 4) << 1) | ((kk & 8) >> 1);
        const int c = (st & 3) * 32 + 8 * ((w & 63) >> 4); vofV[i] = (unsigned)((k * 4096 + 128 + c) * 2); } }
  { const int row = wid * 8 + (lane >> 3), ch = (lane & 7) ^ ((row >> 1) & 7); vofR = (unsigned)((row * 64 + ch * 8) * 2); }
  const unsigned ldsK = (unsigned)__builtin_amdgcn_readfirstlane((unsigned)(uintptr_t)Kn_lds + (unsigned)wid * 2048u);
  const unsigned ldsV = (unsigned)__builtin_amdgcn_readfirstlane((unsigned)(uintptr_t)V_lds + (unsigned)wid * 2048u);
  const unsigned ldsR = (unsigned)__builtin_amdgcn_readfirstlane((unsigned)(uintptr_t)Kr_lds + (unsigned)wid * 1024u);
#define KROW(j) ((j) < nc ? cbase + (j) * KVBLK : xbase + ((j) - nc) * KVBLK)
#define DMA_TILE(j, kslot, vslot) do { const long k0_ = KROW(j); const char* kb_ = uni_ptr(KVh + k0_ * 4096); const char* rb_ = uni_ptr(KRp + k0_ * 64); \
    glds16_s(kb_, vofK[0], ldsK + (kslot) * SHM_KN); glds16_s(kb_, vofK[1], ldsK + (kslot) * SHM_KN + 1024u); \
    glds16_s(rb_, vofR, ldsR + (kslot) * SHM_KR); \
    glds16_s(kb_, vofV[0], ldsV + (vslot) * SHM_V); glds16_s(kb_, vofV[1], ldsV + (vslot) * SHM_V + 1024u); } while (0)
#define WAIT_SYNC() do { asm volatile("s_waitcnt vmcnt(0)" ::: "memory"); __syncthreads(); } while (0)
#define RESC(a) do { if (__any((a) < 1.f)) { if (hi == 0) al_l[r32] = (a); asm volatile("s_waitcnt lgkmcnt(0)" ::: "memory"); \
    _Pragma("unroll") for (int d = 0; d < 4; ++d) _Pragma("unroll") for (int r = 0; r < 16; ++r) o[d][r] *= al_l[crow(r, hi)]; } } while (0)
  f32x16 pA0, pA1, pB0, pB1; float alA, alB; bf16x8 pa0, pa1, pa2, pa3;
  DMA_TILE(0, 0, 0); DMA_TILE(1, 1, 1); WAIT_SYNC();
  qkt(pA0, pA1, Kn_lds, Kr_lds, qr, r32, hi); partialSM(pA0, pA1, m_reg, alA);
  __syncthreads();
  int vprev = 0, vcur = 1, vnext = 2;
  for (int j = 1; j + 1 < NT; j += 2) {
    DMA_TILE(j + 1, 0, vnext);
    SBAR(); qkt(pB0, pB1, Kn_lds + SHM_KN, Kr_lds + SHM_KR, qr, r32, hi);
    finishSM(pA0, pA1, alA, l_reg, pa0, pa1, pa2, pa3); SBAR();
    pv_d0(o, vb0 + vprev * SHM_V, pa0, pa1, pa2, pa3); partialSM(pB0, pB1, m_reg, alB);
    RESC(alB); WAIT_SYNC();
    { const int t_ = vprev; vprev = vcur; vcur = vnext; vnext = t_; }
    if (j + 2 < NT) DMA_TILE(j + 2, 1, vnext);
    SBAR(); qkt(pA0, pA1, Kn_lds, Kr_lds, qr, r32, hi);
    finishSM(pB0, pB1, alB, l_reg, pa0, pa1, pa2, pa3); SBAR();
    pv_d0(o, vb0 + vprev * SHM_V, pa0, pa1, pa2, pa3); partialSM(pA0, pA1, m_reg, alA);
    RESC(alA); WAIT_SYNC();
    { const int t_ = vprev; vprev = vcur; vcur = vnext; vnext = t_; }
  }
  SBAR(); qkt(pB0, pB1, Kn_lds + SHM_KN, Kr_lds + SHM_KR, qr, r32, hi);
  finishSM(pA0, pA1, alA, l_reg, pa0, pa1, pa2, pa3); SBAR();
  pv_d0(o, vb0 + vprev * SHM_V, pa0, pa1, pa2, pa3); partialSM(pB0, pB1, m_reg, alB);
  RESC(alB);
  finishSM(pB0, pB1, alB, l_reg, pa0, pa1, pa2, pa3); SBAR();
  pv_d0(o, vb0 + vcur * SHM_V, pa0, pa1, pa2, pa3);
  if (hi == 0) li_l[r32] = l_reg; asm volatile("s_waitcnt lgkmcnt(0)" ::: "memory");
  float rli[16];
#pragma unroll
  for (int r = 0; r < 16; ++r) rli[r] = __builtin_amdgcn_rcpf(li_l[crow(r, hi)]);
  bf16* Ow = Ob + (long)(wid * QBLK) * 2048;
#pragma unroll
  for (int r = 0; r < 16; ++r) { const int orow = crow(r, hi);
#pragma unroll
    for (int d0 = 0; d0 < 4; ++d0) Ow[(long)orow * 2048 + d0 * 32 + r32] = (bf16)(cvt_pk_bf16(o[d0][r] * rli[r], 0.f) & 0xffffu); }
  __syncthreads();
#undef KROW
#undef DMA_TILE
#undef WAIT_SYNC
#undef RESC
}
#undef SBAR
}

namespace scan {
constexpr int CH = 64;
constexpr int OFF_Q = 0, OFF_K = 32768, OFF_V = 65536, OFF_P = 98304, SHM_SCAN = 98304 + 8192;
__device__ __forceinline__ unsigned off_b(unsigned row, unsigned ch) { return 256u * row + 16u * (ch ^ (((row & 3) << 2) | ((row >> 2) & 3))); }
__device__ __forceinline__ unsigned p_off(unsigned i, unsigned chunk) { return 128u * i + 16u * (chunk ^ ((i >> 1) & 7)); }
__device__ __forceinline__ int crow(int r, int hi) { return (r & 3) + 8 * (r >> 2) + 4 * hi; }
__device__ __forceinline__ s16x4 vtr(const LAS char* p) { typedef short v4i16_t __attribute__((ext_vector_type(4))); return __builtin_bit_cast(s16x4, __builtin_amdgcn_ds_read_tr16_b64_v4i16((LAS v4i16_t*)p)); }
__device__ __forceinline__ bf16x8 tr_frag(const LAS char* img, int lane, int c, int ks) {
    const unsigned h = lane >> 5, blk = (lane >> 4) & 1, q = (lane & 15) >> 2, p = lane & 3;
    const unsigned r0 = 16 * ks + 8 * h + q, chn = 4 * c + 2 * blk + (p >> 1);
    const s16x4 lo = vtr(img + off_b(r0, chn) + 8 * (p & 1)), hi = vtr(img + off_b(r0 + 4, chn) + 8 * (p & 1));
    return (bf16x8){lo[0], lo[1], lo[2], lo[3], hi[0], hi[1], hi[2], hi[3]};
}
__device__ __forceinline__ bf16x8 pack_step(const f32x16& x, int s) {
    u32x4 p; p.x = cvt_pk_bf16(x[8 * s + 0], x[8 * s + 1]); p.y = cvt_pk_bf16(x[8 * s + 2], x[8 * s + 3]); p.z = cvt_pk_bf16(x[8 * s + 4], x[8 * s + 5]); p.w = cvt_pk_bf16(x[8 * s + 6], x[8 * s + 7]);
    return __builtin_bit_cast(bf16x8, p);
}
__device__ __forceinline__ void dma_mat(const bf16* src, int ld, LAS unsigned char* dst, int wid, int lane) {
    const char* sb = uni_ptr(src); const unsigned d0 = (unsigned)__builtin_amdgcn_readfirstlane((unsigned)(uintptr_t)dst + (unsigned)wid * 4096u);
#pragma unroll
    for (int k = 0; k < 4; ++k) { const int pc = wid * 4 + k, img = pc >> 4, row = 4 * (pc & 15) + (lane >> 4), pos = lane & 15;
        const int ch = pos ^ (((row & 3) << 2) | ((row >> 2) & 3));
        glds16_s(sb, (unsigned)((row * ld + img * 128 + ch * 8) * 2), d0 + (unsigned)k * 1024u); }
}
__device__ __forceinline__ void scan_unit(const bf16* __restrict__ QKV, bf16* __restrict__ Y, int b, int hd, int dir, int dvh, float lg2, bool skip_ctx_y, LAS unsigned char* lds) {
    int tid = threadIdx.x; asm volatile("" : "+v"(tid));
    const int wid = __builtin_amdgcn_readfirstlane(tid >> 6), lane0 = tid & 63;
    const LAS char* QI = (const LAS char*)lds + OFF_Q; const LAS char* KI = (const LAS char*)lds + OFF_K; const LAS char* VI = (const LAS char*)lds + OFF_V;
    LAS char* PI = (LAS char*)lds + OFF_P;
    f32x16 S[8];
#pragma unroll
    for (int i = 0; i < 8; ++i) S[i] = f32x16{};
    const float g64 = __builtin_amdgcn_exp2f(64.f * lg2);
    const int qcol = hd * RDK, kcol = 2048 + hd * RDK, vcol = 4096 + hd * RDV + dvh * 256;
    for (int n = 0; n < 68; ++n) {
        int lane = lane0; asm volatile("" : "+v"(lane));
        const int r = lane & 31, h = lane >> 5;
        const int ycol = hd * RDV + dvh * 256 + wid * 32 + r;
        int rowbase;
        if (n < 4) rowbase = MX + b * CTXL + (dir ? 3 - n : n) * CH; else rowbase = b * SEQ + (dir ? 67 - n : n - 4) * CH;
        const bf16* src = QKV + (size_t)rowbase * 8192;
        dma_mat(src + qcol, 8192, lds + OFF_Q, wid, lane); dma_mat(src + kcol, 8192, lds + OFF_K, wid, lane); dma_mat(src + vcol, 8192, lds + OFF_V, wid, lane);
        asm volatile("s_waitcnt vmcnt(0)" ::: "memory"); __syncthreads();
        if (wid < 4) {
            const int jb = wid >> 1, ib = wid & 1; f32x16 pt = f32x16{};
#pragma unroll
            for (int ks = 0; ks < 16; ++ks) { const int img = ks >> 3, s = ks & 7;
                const bf16x8 a = *(const LAS bf16x8*)(KI + img * 16384 + off_b(jb * 32 + r, 2 * s + h));
                const bf16x8 bq = *(const LAS bf16x8*)(QI + img * 16384 + off_b(ib * 32 + r, 2 * s + h));
                pt = __builtin_amdgcn_mfma_f32_32x32x16_bf16(a, bq, pt, 0, 0, 0); }
            const int i = ib * 32 + r;
#pragma unroll
            for (int g = 0; g < 4; ++g) { float v[4];
#pragma unroll
                for (int e = 0; e < 4; ++e) { const int j = jb * 32 + 8 * g + 4 * h + e; const int dd = dir ? (j - i) : (i - j);
                    v[e] = dd >= 0 ? pt[4 * g + e] * __builtin_amdgcn_exp2f((float)dd * lg2) : 0.f; }
                const int j0 = jb * 32 + 8 * g + 4 * h;
                u32x2 w; w.x = cvt_pk_bf16(v[0], v[1]); w.y = cvt_pk_bf16(v[2], v[3]);
                *(LAS u32x2*)(PI + p_off(i, j0 >> 3) + ((j0 >> 2) & 1) * 8) = w; }
        }
        f32x16 Yt[2]; Yt[0] = f32x16{}; Yt[1] = f32x16{};
#pragma unroll
        for (int dkb = 0; dkb < 8; ++dkb)
#pragma unroll
            for (int s = 0; s < 2; ++s) { const bf16x8 bf = pack_step(S[dkb], s);
                const int cl = (32 * dkb + 16 * s) & 127, img = dkb >> 2;
#pragma unroll
                for (int it = 0; it < 2; ++it) { const LAS char* rp = QI + img * 16384;
                    const s16x4 lo = *(const LAS s16x4*)(rp + off_b(it * 32 + r, cl >> 3) + 8 * h), hi4 = *(const LAS s16x4*)(rp + off_b(it * 32 + r, (cl >> 3) + 1) + 8 * h);
                    const bf16x8 af = (bf16x8){lo[0], lo[1], lo[2], lo[3], hi4[0], hi4[1], hi4[2], hi4[3]};
                    Yt[it] = __builtin_amdgcn_mfma_f32_32x32x16_bf16(af, bf, Yt[it], 0, 0, 0); } }
#pragma unroll
        for (int it = 0; it < 2; ++it)
#pragma unroll
            for (int rg = 0; rg < 16; ++rg) { const int i = it * 32 + crow(rg, h); const int tau = dir ? 63 - i : i; Yt[it][rg] *= __builtin_amdgcn_exp2f((float)(tau + 1) * lg2); }
        __syncthreads();
#pragma unroll
        for (int i = 0; i < 8; ++i)
#pragma unroll
            for (int rg = 0; rg < 16; ++rg) S[i][rg] *= g64;
#pragma unroll
        for (int ks = 0; ks < 4; ++ks) {
            const bf16x8 vf = tr_frag(VI + (wid >> 2) * 16384, lane, wid & 3, ks);
#pragma unroll
            for (int it = 0; it < 2; ++it) { const bf16x8 pa = *(const LAS bf16x8*)(PI + p_off(it * 32 + r, 2 * ks + h));
                Yt[it] = __builtin_amdgcn_mfma_f32_32x32x16_bf16(pa, vf, Yt[it], 0, 0, 0); }
            bf16x8 vz;
#pragma unroll
            for (int jj = 0; jj < 8; ++jj) { const int j = 16 * ks + 8 * h + jj; const int tau = dir ? 63 - j : j;
                const float f = __builtin_amdgcn_exp2f((float)(63 - tau) * lg2); vz[jj] = (short)(cvt_pk_bf16(bf2f((unsigned short)vf[jj]) * f, 0.f) & 0xffffu); }
#pragma unroll
            for (int dkb = 0; dkb < 8; ++dkb) { const bf16x8 ka = tr_frag(KI + (dkb >> 2) * 16384, lane, dkb & 3, ks);
                S[dkb] = __builtin_amdgcn_mfma_f32_32x32x16_bf16(ka, vz, S[dkb], 0, 0, 0); }
            __builtin_amdgcn_sched_barrier(0);
        }
        if (!(skip_ctx_y && n < 4)) {
#pragma unroll
            for (int it = 0; it < 2; ++it)
#pragma unroll
                for (int rg = 0; rg < 16; ++rg) { const int i = it * 32 + crow(rg, h);
                    Y[(size_t)(rowbase + i) * 4096 + ycol] = (bf16)(cvt_pk_bf16(Yt[it][rg], 0.f) & 0xffffu); }
        }
        __syncthreads();
    }
}
}

#define XB_TMO      128
#define XB_XCNT(j)  (256  + 64 * (j))
#define XB_XSUB(j)  (1280 + 64 * (j))
#define XB_XGEN(j)  (2304 + 64 * (j))
#define XB_TOP      3328
#define XB_TOPGEN   3392
#define XCD_BAR_WORDS 3456
#define XB_SPIN_CAP (1u << 22)
__device__ __forceinline__ unsigned xb_ld(unsigned* p)              { return __hip_atomic_load(p, __ATOMIC_RELAXED, __HIP_MEMORY_SCOPE_AGENT); }
__device__ __forceinline__ unsigned xb_add(unsigned* p, unsigned v) { return __hip_atomic_fetch_add(p, v, __ATOMIC_RELAXED, __HIP_MEMORY_SCOPE_AGENT); }
__device__ __forceinline__ unsigned xb_xcc_id() { return (unsigned)__builtin_amdgcn_s_getreg((3 << 11) | 20) & 0xFu; }
#define XB_SPIN(cond, bar) do { unsigned _sp = 0; while (cond) { __builtin_amdgcn_s_sleep(1); \
    if ((++_sp & 255u) == 0u) { if (xb_ld(&(bar)[XB_TMO])) break; if (_sp > XB_SPIN_CAP) { atomicAdd(&(bar)[XB_TMO], 1u); break; } } } } while (0)
struct XcdBarrier { unsigned* bar; unsigned x; volatile LAS unsigned* st; };
__device__ __forceinline__ XcdBarrier xcd_barrier_post(unsigned* bar, volatile LAS unsigned* st) {
    XcdBarrier b; b.bar = bar; b.x = xb_xcc_id(); b.st = st;
    if (threadIdx.x == 0) (void)xb_add(&bar[XB_XCNT(b.x)], 1u);
    return b;
}
__device__ __forceinline__ void xcd_barrier_complete(unsigned* bar, unsigned x, unsigned& nloc, unsigned& nx) {
    const unsigned G = gridDim.x * gridDim.y * gridDim.z;
    unsigned sum, cnt, mine, sp = 0u;
    for (;;) {
        sum = 0u; cnt = 0u; mine = 0u;
#pragma unroll
        for (unsigned j = 0; j < 16; ++j) { const unsigned c = xb_ld(&bar[XB_XCNT(j)]); sum += c; cnt += (c > 0u) ? 1u : 0u; mine = (j == x) ? c : mine; }
        if (sum == G) break;
        __builtin_amdgcn_s_sleep(1);
        if ((++sp & 255u) == 0u) { if (xb_ld(&bar[XB_TMO])) break; if (sp > XB_SPIN_CAP) { atomicAdd(&bar[XB_TMO], 1u); break; } }
    }
    nloc = mine > 0u ? mine : 1u; nx = cnt > 0u ? cnt : 1u;
}
__device__ __forceinline__ void xcd_barrier(const XcdBarrier& b) {
    asm volatile("s_waitcnt vmcnt(0)" ::: "memory");
    __syncthreads();
    if (threadIdx.x == 0) {
        unsigned* bar = b.bar; asm volatile("" : "+s"(bar));
        __builtin_amdgcn_s_waitcnt(0);
        unsigned nloc = b.st[0], nx = b.st[1];
        if (nloc == 0u) { xcd_barrier_complete(bar, b.x, nloc, nx); b.st[0] = nloc; b.st[1] = nx; }
        const unsigned old = xb_add(&bar[XB_XSUB(b.x)], 1u);
        const unsigned gen = old / nloc;
        if (old + 1u == (gen + 1u) * nloc) {
            __builtin_amdgcn_fence(__ATOMIC_RELEASE, "agent");
            asm volatile("s_waitcnt vmcnt(0)" ::: "memory");
            const unsigned og = xb_add(&bar[XB_TOP], 1u);
            const unsigned tg = og / nx;
            if (og + 1u == (tg + 1u) * nx) xb_add(&bar[XB_TOPGEN], 1u);
            else XB_SPIN(xb_ld(&bar[XB_TOPGEN]) == tg, bar);
            __builtin_amdgcn_fence(__ATOMIC_ACQUIRE, "agent");
            xb_add(&bar[XB_XGEN(b.x)], 1u);
            asm volatile("s_waitcnt vmcnt(0)" ::: "memory");
        } else {
            XB_SPIN(xb_ld(&bar[XB_XGEN(b.x)]) == gen, bar);
            __builtin_amdgcn_fence(__ATOMIC_ACQUIRE, "agent");
            asm volatile("s_waitcnt vmcnt(0)" ::: "memory");
        }
    }
    __syncthreads();
}

__device__ __forceinline__ float wave_sum(float v, int lane) {
#pragma unroll
    for (int o = 1; o < 64; o <<= 1) v += shfl_xor_l(v, o, lane);
    return v;
}
__device__ __forceinline__ void cvt_item(const float* colptr, int ldw, int k0, bf16* WTrow0, int K, const float* kscale, float gscale, LAS float* scr, int lane) {
#pragma unroll 8
    for (int i = 0; i < 32; ++i) { const int kk = 2 * i + (lane >> 5); float v = colptr ? colptr[(size_t)(k0 + kk) * ldw] : 0.f;
        if (kscale) v *= kscale[k0 + kk];
        scr[kk * 33 + (lane & 31)] = v * gscale; }
    asm volatile("s_waitcnt lgkmcnt(0)" ::: "memory");
    const int c = lane & 7;
#pragma unroll
    for (int j = 0; j < 4; ++j) { const int n = (lane >> 3) + 8 * j; const LAS float* s = scr + (8 * c) * 33 + n;
        u32x4 o; o.x = cvt_pk_bf16(s[0 * 33], s[1 * 33]); o.y = cvt_pk_bf16(s[2 * 33], s[3 * 33]); o.z = cvt_pk_bf16(s[4 * 33], s[5 * 33]); o.w = cvt_pk_bf16(s[6 * 33], s[7 * 33]);
        *(u32x4*)(WTrow0 + (size_t)n * K + k0 + 8 * c) = o; }
    asm volatile("s_waitcnt lgkmcnt(0)" ::: "memory");
}
__device__ __forceinline__ int ropeperm64(int c) { const int p = c >> 1, e = c & 1; return (p < 16) ? (p + 16 * e) : (32 + (p - 16) + 16 * e); }
__device__ __forceinline__ const float* src_col(int kind, const float* W0, const float* W1, int aux, int n) {
    switch (kind) {
        case 0: return W0 + aux + n;
        case 1: return W0 + aux + ropeperm64(n);
        case 2: { const int hh = n / DQ, d = n % DQ; return W0 + hh * DQ + (d < NOPE ? d : NOPE + ropeperm64(d - NOPE)); }
        case 3: { const int hh = n >> 8, d = n & 255; return W0 + hh * 256 + (d >> 1) + 128 * (d & 1); }
        case 4: { const int tl = n >> 8, j = n & 255; return (j < 128 ? W0 : W1) + tl * 128 + (j & 127); }
        default: return nullptr;
    }
}
struct CvtJob { const float* W0; const float* W1; const float* kscale; bf16* WT; int ldw, K, nrows, kind, aux; float gscale; };
__device__ __forceinline__ bool cvt_try(const CvtJob& J, int& it, LAS float* scr, int lane) {
    const int nblk = J.nrows / 32, items = (J.K / 64) * nblk;
    if (it >= items) { it -= items; return false; }
    const int kb = it / nblk, nb = it % nblk;
    const float* cp = src_col(J.kind, J.W0, J.W1, J.aux, nb * 32 + (lane & 31));
    cvt_item(cp, J.ldw, kb * 64, J.WT + (size_t)(nb * 32) * J.K, J.K, J.kscale, J.gscale, scr, lane);
    return true;
}
__device__ __forceinline__ int cvt_items(const CvtJob& J) { return (J.K / 64) * (J.nrows / 32); }

__device__ __forceinline__ void norm_mod_row(const float* xrow, const float* g, const float* sc, const float* sh, bf16* orow, int lane) {
    f32x4 v[8]; float s = 0.f;
#pragma unroll
    for (int j = 0; j < 8; ++j) { v[j] = *(const f32x4*)(xrow + 4 * lane + 256 * j); s += (v[j][0] * v[j][0] + v[j][1] * v[j][1]) + (v[j][2] * v[j][2] + v[j][3] * v[j][3]); }
    const float rstd = 1.0f / sqrtf(wave_sum(s, lane) * (1.0f / D) + NORM_EPS);
#pragma unroll
    for (int j = 0; j < 8; ++j) { const int c = 4 * lane + 256 * j; const f32x4 gg = *(const f32x4*)(g + c), s1 = *(const f32x4*)(sc + c), s0 = *(const f32x4*)(sh + c);
        const f32x4 y = (v[j] * rstd) * gg * (1.0f + s1) + s0;
        u32x2 w; w.x = cvt_pk_bf16(y[0], y[1]); w.y = cvt_pk_bf16(y[2], y[3]); *(u32x2*)(orow + c) = w; }
}

__device__ __forceinline__ unsigned long long ld_arg(LAS unsigned char* lds, int i) {
    const volatile LAS unsigned* p = (const volatile LAS unsigned*)(lds + ARGS_OFF) + 2 * i;
    const unsigned lo = __builtin_amdgcn_readfirstlane(p[0]), hi = __builtin_amdgcn_readfirstlane(p[1]);
    return ((unsigned long long)hi << 32) | lo;
}
struct Args { const float* in[29]; float* out; unsigned char* ws; int ph_lo, ph_hi; };
constexpr int PH_PER_LAYER = 10, PH_FINAL = 1 + PH_PER_LAYER * DEPTH, PH_COUNT = PH_FINAL + 1;

template <unsigned MK_EN_T>
__global__ void __launch_bounds__(512, 2) mk_fwd(Args args) {
    extern __shared__ __attribute__((aligned(16))) unsigned char lds_raw[];
    LAS unsigned char* lds = (LAS unsigned char*)lds_raw;
    volatile LAS unsigned* MISC = (volatile LAS unsigned*)(lds + MISC_OFF);
    const int G = gridDim.x; const int bx = blockIdx.x; const int vcu = (G % 8 == 0) ? (bx % 8) * (G / 8) + bx / 8 : bx;
    const int NGW = G * 8;
    unsigned char* ws = args.ws; float* X = args.out;
    const int lo = args.ph_lo, hi = args.ph_hi;
    { const int tid0 = threadIdx.x;
      for (int u = tid0; u < (LDS_BYTES - RING_BYTES) / 4; u += 512) ((LAS unsigned*)(lds + RING_BYTES))[u] = 0u;
      __syncthreads();
      if (tid0 < 29) ((volatile LAS unsigned long long*)(lds + ARGS_OFF))[tid0] = (unsigned long long)args.in[tid0];
      __syncthreads(); }
#define ARGF(i) ((const float*)ld_arg(lds, (i)))
    XcdBarrier bar; bar.bar = (unsigned*)(ws + WS_CTL) + CW_BAR; bar.x = 0; bar.st = nullptr;
    if (hi - lo > 1) bar = xcd_barrier_post((unsigned*)(ws + WS_CTL) + CW_BAR, MISC + 8);
#define EN(b) (((MK_EN_T) >> (b)) & 1u)
#define IN(k) (lo <= (k) && (k) < hi)
#define PHASE_END(k) do { if (hi > (k) + 1) xcd_barrier(bar); } while (0)
#define PH_IDS int tid = threadIdx.x; asm volatile("" : "+v"(tid)); const int lane = tid & 63; const int wave = __builtin_amdgcn_readfirstlane(tid >> 6); const int gw = vcu * 8 + wave; (void)lane; (void)gw;
#define XC_    ((float*)(ws + WS_XC))
#define MODV_  ((float*)(ws + WS_MODV))
#define TABM_  ((float*)(ws + WS_TABM))
#define TABR_  ((float*)(ws + WS_TABR))
#define SSQ_   ((float*)(ws + WS_SSQ))
#define KR_    ((bf16*)(ws + WS_KR))
#define H_     ((bf16*)(ws + WS_H))
#define WB_    ((bf16*)(ws + WS_W))
#define W1T_   WB_
#define WUQT_  (WB_ + (size_t)N1 * D)
#define WUKVT_ (WUQT_ + (size_t)3072 * 512)
#define WOTM_  (WUKVT_ + (size_t)4096 * 512)
#define WQKVT_ WB_
#define WGT_   (WB_ + (size_t)8192 * D)
#define WOTR_  (WGT_ + (size_t)8192 * D)
#define WGUT_  ((bf16*)(ws + WS_WFFN))
#define WDT_   (WGUT_ + (size_t)11264 * D)
#define QKVL_  ((bf16*)(ws + WS_QKVL))
#define Q_     ((bf16*)(ws + WS_Q))
#define KV_    ((bf16*)(ws + WS_KV))
#define O_     ((bf16*)(ws + WS_O))
#define QKV_   ((bf16*)(ws + WS_QKV))
#define Y_     ((bf16*)(ws + WS_Y))
#define GATED_ ((bf16*)(ws + WS_GATED))
#define GB_    ((bf16*)(ws + WS_G))
#define UB_    ((bf16*)(ws + WS_U))
#define MODL_  (MODV_ + (size_t)l * 9 * NMOD)

    if (EN(0) && IN(0)) {
        PH_IDS
        LAS float* cond = (LAS float*)lds;
        LAS float* red = (LAS float*)(lds + 73728);
        { const float* cin = ARGF(1); const float* cc = ARGF(3);
          for (int i = tid; i < 9 * D; i += 512) { const int r = i >> 11, k = i & (D - 1); const float c = (r < 8) ? cin[r * D + k] : cc[k]; cond[i] = c / (1.0f + __expf(-c)); } }
        __syncthreads();
        for (int it = bx; it < DEPTH * 96; it += G) {
            const int l = it / 96, cb = it % 96; const int n = cb * 128 + 2 * lane;
            const float* W = ARGF(4) + (size_t)l * D * NMOD + n; const float* mb = ARGF(5) + (size_t)l * NMOD + cb * 128;
            float a0[9], a1[9];
#pragma unroll
            for (int r = 0; r < 9; ++r) { a0[r] = 0.f; a1[r] = 0.f; }
            for (int k = wave * 256; k < wave * 256 + 256; k += 4) {
                f32x2 w[4];
#pragma unroll
                for (int q = 0; q < 4; ++q) w[q] = *(const f32x2*)(W + (size_t)(k + q) * NMOD);
#pragma unroll
                for (int r = 0; r < 9; ++r) { const f32x4 c4 = *(const LAS f32x4*)(cond + r * D + k);
#pragma unroll
                    for (int q = 0; q < 4; ++q) { a0[r] += c4[q] * w[q][0]; a1[r] += c4[q] * w[q][1]; } }
            }
#pragma unroll
            for (int r = 0; r < 9; ++r) { red[(wave * 9 + r) * 128 + 2 * lane] = a0[r]; red[(wave * 9 + r) * 128 + 2 * lane + 1] = a1[r]; }
            __syncthreads();
            for (int i = tid; i < 9 * 128; i += 512) { const int r = i >> 7, cc = i & 127; float s = 0.f;
#pragma unroll
                for (int w8 = 0; w8 < 8; ++w8) s += red[(w8 * 9 + r) * 128 + cc];
                MODV_[((size_t)l * 9 + r) * NMOD + cb * 128 + cc] = s + mb[cc]; }
            __syncthreads();
        }
        for (int i = bx * 512 + tid; i < 64 * 16 + SEQ * 128; i += G * 512) {
            float inv, pos; float* dst;
            if (i < 1024) { const int p = i >> 4, f = i & 15; inv = __builtin_amdgcn_exp2f(-(float)(2 * f) * (13.287712379549449f / 32.0f)); pos = (float)p; dst = TABM_ + 2 * i; }
            else { const int j = i - 1024, t = j >> 7, f = j & 127; inv = __builtin_amdgcn_exp2f(-(float)(2 * f) * (13.287712379549449f / 256.0f)); pos = (float)t; dst = TABR_ + 2 * j; }
            const float ang = pos * inv; const double rev = (double)ang * 0.15915494309189535; const float fr = (float)(rev - floor(rev));
            dst[0] = __builtin_amdgcn_cosf(fr); dst[1] = __builtin_amdgcn_sinf(fr);
        }
        PHASE_END(0);
    }

    for (int l = 0; l < DEPTH; ++l) {
        const int P = 1 + PH_PER_LAYER * l; const int li = l >> 1; const bool is_ret = (l & 1) != 0; const bool last = (l == DEPTH - 1);
        const int Mrows = last ? MX : MT;

        if (EN(1) && IN(P + 0)) {
            PH_IDS
            LAS float* scr = (LAS float*)(lds + wave * 16384);
            CvtJob J[7]; int nj;
            if (!is_ret) {
                const float* wdq = ARGF(8) + (size_t)li * D * QR; const float* wdkv = ARGF(11) + (size_t)li * D * (KVR + ROPE);
                J[0] = CvtJob{wdq, nullptr, nullptr, W1T_, QR, D, 512, 0, 0, 1.f};
                J[1] = CvtJob{wdkv, nullptr, nullptr, W1T_ + (size_t)512 * D, KVR + ROPE, D, 512, 0, 0, 1.f};
                J[2] = CvtJob{wdkv, nullptr, nullptr, W1T_ + (size_t)1024 * D, KVR + ROPE, D, 64, 1, 512, 1.f};
                J[3] = CvtJob{nullptr, nullptr, nullptr, W1T_ + (size_t)1088 * D, 1, D, 192, 5, 0, 1.f};
                J[4] = CvtJob{ARGF(10) + (size_t)li * QR * 3072, nullptr, ARGF(9) + li * QR, WUQT_, 3072, QR, 3072, 2, 0, 0.07216878364870322f * LOG2E};
                J[5] = CvtJob{ARGF(13) + (size_t)li * KVR * 4096, nullptr, ARGF(12) + li * KVR, WUKVT_, 4096, KVR, 4096, 0, 0, 1.f};
                J[6] = CvtJob{ARGF(14) + (size_t)li * D * D, nullptr, nullptr, WOTM_, D, D, D, 0, 0, 1.f};
                nj = 7;
            } else {
                J[0] = CvtJob{ARGF(15) + (size_t)li * D * D, nullptr, nullptr, WQKVT_, D, D, 2048, 3, 0, 1.f};
                J[1] = CvtJob{ARGF(16) + (size_t)li * D * D, nullptr, nullptr, WQKVT_ + (size_t)2048 * D, D, D, 2048, 3, 0, 0.0625f};
                J[2] = CvtJob{ARGF(17) + (size_t)li * D * 4096, nullptr, nullptr, WQKVT_ + (size_t)4096 * D, 4096, D, 4096, 0, 0, 1.f};
                J[3] = CvtJob{ARGF(18) + (size_t)li * D * 4096, ARGF(19) + (size_t)li * D * 4096, nullptr, WGT_, 4096, D, 8192, 4, 0, 1.f};
                J[4] = CvtJob{ARGF(20) + (size_t)li * 4096 * D, nullptr, nullptr, WOTR_, D, 4096, D, 0, 0, 1.f};
                J[5] = CvtJob{nullptr, nullptr, nullptr, nullptr, 1, 64, 0, 5, 0, 1.f};
                J[6] = J[5];
                nj = 5;
            }
            CvtJob F0 = CvtJob{ARGF(23) + (size_t)l * D * FF, ARGF(24) + (size_t)l * D * FF, nullptr, WGUT_, FF, D, 11264, 4, 0, 1.f};
            CvtJob F1 = CvtJob{ARGF(27) + (size_t)l * FF * D, nullptr, nullptr, WDT_, D, FF, D, 0, 0, 1.f};
            int total = cvt_items(F0) + cvt_items(F1);
#pragma unroll
            for (int j = 0; j < 7; ++j) if (j < nj) total += cvt_items(J[j]);
            for (int it0 = gw; it0 < total; it0 += NGW) {
                int it = it0; bool done = false;
#pragma unroll
                for (int j = 0; j < 7; ++j) if (!done && j < nj) done = cvt_try(J[j], it, scr, lane);
                if (!done) done = cvt_try(F0, it, scr, lane);
                if (!done) done = cvt_try(F1, it, scr, lane);
            }
            const float* g = ARGF(6) + l * D; const float* xsrc = (l == 0) ? ARGF(0) : X; const float* csrc = (l == 0) ? ARGF(2) : XC_;
            for (int m = gw; m < MT; m += NGW) { const bool isx = m < MX; const float* mr = MODL_ + (size_t)(isx ? (m >> 12) : 8) * NMOD;
                norm_mod_row(isx ? xsrc + (size_t)m * D : csrc + (size_t)(m - MX) * D, g, mr + D, mr, H_ + (size_t)m * D, lane); }
            PHASE_END(P + 0);
        }

        if (!is_ret) {
            if (EN(2) && IN(P + 1)) {
                pg8::Gemm g{H_, W1T_, MT, N1, D, D}; pg8::StaticOrder S; S.init(MT, N1, G, bx);
                EpiG1 E{QKVL_, SSQ_, KR_, TABM_};
                pg8::gemm_phase<EpiG1>(lds, g, S, E);
                PHASE_END(P + 1);
            }
            if (EN(3) && IN(P + 2)) {
                { pg8::Gemm g{QKVL_, WUQT_, MT, 3072, QR, N1}; pg8::StaticOrder S; S.init(MT, 3072, G, bx); EpiUq E{Q_, SSQ_, TABM_}; pg8::gemm_phase<EpiUq>(lds, g, S, E); }
                { pg8::Gemm g{QKVL_ + 512, WUKVT_, MT, 4096, KVR, N1}; pg8::StaticOrder S; S.init(MT, 4096, G, bx); EpiUkv E{KV_, SSQ_}; pg8::gemm_phase<EpiUkv>(lds, g, S, E); }
                PHASE_END(P + 2);
            }
            if (EN(4) && IN(P + 3)) {
                const int nun = 2048 + 128;
                for (int ui = vcu; ui < nun; ui += G) {
                    if (ui < 2048) { const int xcd = (ui & 255) >> 5, j = ui & 31, rnd = ui >> 8; const int bh = xcd * 16 + 2 * rnd + (j >> 4), qb = j & 15; const int b = bh >> 4, hd = bh & 15;
                        att::attn_unit(Q_ + (size_t)(b * SEQ + qb * 256) * 3072 + hd * DQ, KV_ + hd * 256, KR_, O_ + (size_t)(b * SEQ + qb * 256) * D + hd * 128, 68, 4, MX + b * CTXL, b * SEQ, (char*)lds_raw);
                    } else { const int bh = ui - 2048, b = bh >> 4, hd = bh & 15;
                        att::attn_unit(Q_ + (size_t)(MX + b * CTXL) * 3072 + hd * DQ, KV_ + hd * 256, KR_, O_ + (size_t)(MX + b * CTXL) * D + hd * 128, 4, 4, MX + b * CTXL, 0, (char*)lds_raw); }
                }
                PHASE_END(P + 3);
            }
        } else {
            if (EN(5) && IN(P + 1)) {
                pg8::Gemm g{H_, WQKVT_, MT, 8192, D, D}; pg8::StaticOrder S; S.init(MT, 8192, G, bx);
                EpiQKV E{QKV_, TABR_};
                pg8::gemm_phase<EpiQKV>(lds, g, S, E);
                PHASE_END(P + 1);
            }
            if (EN(6) && IN(P + 2)) {
                for (int ui = vcu; ui < 256; ui += G) {
                    const int bh = ui >> 2, dir = (ui >> 1) & 1, dvh = ui & 1; const int b = bh >> 3, hd = bh & 7;
                    const float dec = (dir ? ARGF(22) : ARGF(21))[li * RH + hd];
                    const float lg2 = -__expf(dec) * LOG2E;
                    scan::scan_unit(QKV_, Y_ + (size_t)dir * MT * 4096, b, hd, dir, dvh, lg2, last, lds);
                }
                PHASE_END(P + 2);
            }
            if (EN(7) && IN(P + 3)) {
                PH_IDS
                const int nitems = Mrows * RH * 2;
                for (int it = gw; it < nitems; it += NGW) { const int dir = it & 1, hd = (it >> 1) & 7, row = it >> 4;
                    bf16* p = Y_ + (size_t)dir * MT * 4096 + (size_t)row * 4096 + hd * RDV + lane * 8;
                    const u32x4 w = *(const u32x4*)p; float v[8] = {bflo(w.x), bfhi(w.x), bflo(w.y), bfhi(w.y), bflo(w.z), bfhi(w.z), bflo(w.w), bfhi(w.w)};
                    float s = 0.f;
#pragma unroll
                    for (int e = 0; e < 8; ++e) s += v[e];
                    const float mu = wave_sum(s, lane) * (1.0f / RDV); float q = 0.f;
#pragma unroll
                    for (int e = 0; e < 8; ++e) { v[e] -= mu; q += v[e] * v[e]; }
                    const float rstd = 1.0f / sqrtf(wave_sum(q, lane) * (1.0f / RDV) + GN_EPS);
                    u32x4 o; o.x = cvt_pk_bf16(v[0] * rstd, v[1] * rstd); o.y = cvt_pk_bf16(v[2] * rstd, v[3] * rstd); o.z = cvt_pk_bf16(v[4] * rstd, v[5] * rstd); o.w = cvt_pk_bf16(v[6] * rstd, v[7] * rstd);
                    *(u32x4*)p = o; }
                PHASE_END(P + 3);
            }
            if (EN(8) && IN(P + 4)) {
                pg8::Gemm g{H_, WGT_, Mrows, 8192, D, D}; pg8::StaticOrder S; S.init(Mrows, 8192, G, bx);
                EpiGate E{GATED_, Y_, Y_ + (size_t)MT * 4096};
                pg8::gemm_phase<EpiGate>(lds, g, S, E);
                PHASE_END(P + 4);
            }
        }
        if (EN(9) && IN(P + 5)) {
            pg8::Gemm g = is_ret ? pg8::Gemm{GATED_, WOTR_, Mrows, D, 4096, 4096} : pg8::Gemm{O_, WOTM_, Mrows, D, D, D};
            pg8::StaticOrder S; S.init(Mrows, D, G, bx);
            const float* xsrc = (l == 0) ? ARGF(0) : X; const float* csrc = (l == 0) ? ARGF(2) : XC_;
            EpiResid E{xsrc, X, csrc, XC_, MODL_, 2 * D};
            pg8::gemm_phase<EpiResid>(lds, g, S, E);
            PHASE_END(P + 5);
        }
        if (EN(10) && IN(P + 6)) {
            PH_IDS
            const float* g = ARGF(7) + l * D;
            for (int m = gw; m < Mrows; m += NGW) { const bool isx = m < MX; const float* mr = MODL_ + (size_t)(isx ? (m >> 12) : 8) * NMOD;
                norm_mod_row(isx ? X + (size_t)m * D : XC_ + (size_t)(m - MX) * D, g, mr + 4 * D, mr + 3 * D, H_ + (size_t)m * D, lane); }
            PHASE_END(P + 6);
        }
        if (EN(11) && IN(P + 7)) {
            pg8::Gemm g{H_, WGUT_, Mrows, 11264, D, D}; pg8::StaticOrder S; S.init(Mrows, 11264, G, bx);
            EpiGU E{GB_, UB_};
            pg8::gemm_phase<EpiGU>(lds, g, S, E);
            PHASE_END(P + 7);
        }
        if (EN(12) && IN(P + 8)) {
            PH_IDS
            const float* cw = ARGF(25) + (size_t)l * 3 * FF; const float* cb = ARGF(26) + (size_t)l * FF;
            bf16* Gb = GB_; bf16* Ub = UB_;
            const int nch = FF / 8;
            for (size_t i = (size_t)bx * 512 + tid; i < (size_t)Mrows * nch; i += (size_t)G * 512) {
                const int row = (int)(i / nch), f = (int)(i % nch) * 8;
                const int t = row < MX ? (row & (SEQ - 1)) : ((row - MX) & (CTXL - 1)); const int L = row < MX ? SEQ : CTXL;
                const u32x4 z = {0u, 0u, 0u, 0u};
                const u32x4 g0 = (t > 0) ? *(const u32x4*)(Gb + (size_t)(row - 1) * FF + f) : z;
                const u32x4 g1 = *(const u32x4*)(Gb + (size_t)row * FF + f);
                const u32x4 g2 = (t < L - 1) ? *(const u32x4*)(Gb + (size_t)(row + 1) * FF + f) : z;
                const u32x4 uu = *(const u32x4*)(Ub + (size_t)row * FF + f);
                const f32x4 w0a = *(const f32x4*)(cw + f), w0b = *(const f32x4*)(cw + f + 4), w1a = *(const f32x4*)(cw + FF + f), w1b = *(const f32x4*)(cw + FF + f + 4);
                const f32x4 w2a = *(const f32x4*)(cw + 2 * FF + f), w2b = *(const f32x4*)(cw + 2 * FF + f + 4), ba = *(const f32x4*)(cb + f), bb = *(const f32x4*)(cb + f + 4);
                const unsigned a0[4] = {g0.x, g0.y, g0.z, g0.w}, a1[4] = {g1.x, g1.y, g1.z, g1.w}, a2[4] = {g2.x, g2.y, g2.z, g2.w}, au[4] = {uu.x, uu.y, uu.z, uu.w};
                unsigned o[4];
#pragma unroll
                for (int q = 0; q < 4; ++q) {
                    const float wl0 = q < 2 ? w0a[2 * q] : w0b[2 * q - 4], wh0 = q < 2 ? w0a[2 * q + 1] : w0b[2 * q - 3];
                    const float wl1 = q < 2 ? w1a[2 * q] : w1b[2 * q - 4], wh1 = q < 2 ? w1a[2 * q + 1] : w1b[2 * q - 3];
                    const float wl2 = q < 2 ? w2a[2 * q] : w2b[2 * q - 4], wh2 = q < 2 ? w2a[2 * q + 1] : w2b[2 * q - 3];
                    const float bl = q < 2 ? ba[2 * q] : bb[2 * q - 4], bh = q < 2 ? ba[2 * q + 1] : bb[2 * q - 3];
                    const float cl = bflo(a0[q]) * wl0 + bflo(a1[q]) * wl1 + bflo(a2[q]) * wl2 + bl;
                    const float chh = bfhi(a0[q]) * wh0 + bfhi(a1[q]) * wh1 + bfhi(a2[q]) * wh2 + bh;
                    o[q] = cvt_pk_bf16(fast_silu(cl) * bflo(au[q]), fast_silu(chh) * bfhi(au[q]));
                }
                *(u32x4*)(Ub + (size_t)row * FF + f) = (u32x4){o[0], o[1], o[2], o[3]};
            }
            PHASE_END(P + 8);
        }
        if (EN(13) && IN(P + 9)) {
            pg8::Gemm g{UB_, WDT_, Mrows, D, FF, FF}; pg8::StaticOrder S; S.init(Mrows, D, G, bx);
            EpiResid E{X, X, XC_, XC_, MODL_, 5 * D};
            pg8::gemm_phase<EpiResid>(lds, g, S, E);
            PHASE_END(P + 9);
        }
    }
    if (EN(14) && IN(PH_FINAL)) {
        PH_IDS
        const float* g = ARGF(28);
        for (int m = gw; m < MX; m += NGW) { float* xr = X + (size_t)m * D;
            f32x4 v[8]; float s = 0.f;
#pragma unroll
            for (int j = 0; j < 8; ++j) { v[j] = *(const f32x4*)(xr + 4 * lane + 256 * j); s += (v[j][0] * v[j][0] + v[j][1] * v[j][1]) + (v[j][2] * v[j][2] + v[j][3] * v[j][3]); }
            const float rstd = 1.0f / sqrtf(wave_sum(s, lane) * (1.0f / D) + NORM_EPS);
#pragma unroll
            for (int j = 0; j < 8; ++j) { const int c = 4 * lane + 256 * j; *(f32x4*)(xr + c) = (v[j] * rstd) * *(const f32x4*)(g + c); } }
    }
#undef IN
#undef PHASE_END
}

typedef void (*KernFn)(Args);
static KernFn phase_kernel(int bit) {
    switch (bit) {
        case 0: return mk_fwd<1u << 0>;  case 1: return mk_fwd<1u << 1>;  case 2: return mk_fwd<1u << 2>;  case 3: return mk_fwd<1u << 3>;
        case 4: return mk_fwd<1u << 4>;  case 5: return mk_fwd<1u << 5>;  case 6: return mk_fwd<1u << 6>;  case 7: return mk_fwd<1u << 7>;
        case 8: return mk_fwd<1u << 8>;  case 9: return mk_fwd<1u << 9>;  case 10: return mk_fwd<1u << 10>; case 11: return mk_fwd<1u << 11>;
        case 12: return mk_fwd<1u << 12>; case 13: return mk_fwd<1u << 13>; default: return mk_fwd<1u << 14>;
    }
}
static int phase_bit(int p) {
    if (p == 0) return 0; if (p == PH_FINAL) return 14;
    const int l = (p - 1) / PH_PER_LAYER, slot = (p - 1) % PH_PER_LAYER; const bool ret = (l & 1) != 0;
    if (slot == 0) return 1;
    if (slot >= 5) return 4 + slot;
    if (!ret) return slot == 4 ? -1 : 1 + slot;
    return 4 + slot;
}
extern "C" void kernel_launch(void* const* d_in, const int* in_sizes, int n_in, void* d_out, int out_size, void* d_ws, size_t ws_size, hipStream_t stream) {
    static int grid = 0;
    if (grid == 0) {
        if (n_in != 29 || out_size != MX * D || ws_size < WS_END) { fprintf(stderr, "kernel_launch: unexpected shapes: n_in %d out %d ws %zu (need %zu)\n", n_in, out_size, ws_size, (size_t)WS_END); grid = -1; return; }
        int dev = 0, cus = 0;
        if (hipGetDevice(&dev) != hipSuccess || hipDeviceGetAttribute(&cus, hipDeviceAttributeMultiprocessorCount, dev) != hipSuccess) { grid = -1; return; }
#if MK_SINGLE
        if (hipFuncSetAttribute((const void*)mk_fwd<0xFFFFFFFFu>, hipFuncAttributeMaxDynamicSharedMemorySize, LDS_BYTES) != hipSuccess) { fprintf(stderr, "kernel_launch: hipFuncSetAttribute failed\n"); grid = -1; return; }
#else
        for (int b = 0; b < 15; ++b) if (hipFuncSetAttribute((const void*)phase_kernel(b), hipFuncAttributeMaxDynamicSharedMemorySize, LDS_BYTES) != hipSuccess) { fprintf(stderr, "kernel_launch: hipFuncSetAttribute failed\n"); grid = -1; return; }
#endif
        (void)hipGetLastError();
        grid = cus;
    }
    if (grid < 0) return;
    if (hipMemsetAsync((char*)d_ws + WS_CTL, 0, CTL_BYTES, stream) != hipSuccess) return;
    Args a{};
    for (int i = 0; i < 29; ++i) a.in[i] = (const float*)d_in[i];
    a.out = (float*)d_out; a.ws = (unsigned char*)d_ws;
#if MK_SINGLE
    a.ph_lo = 0; a.ph_hi = PH_COUNT;
    hipLaunchKernelGGL(mk_fwd<0xFFFFFFFFu>, dim3(grid), dim3(512), LDS_BYTES, stream, a);
#else
    for (int p = 0; p < PH_COUNT; ++p) {
        const int bit = phase_bit(p); if (bit < 0) continue;
        a.ph_lo = p; a.ph_hi = p + 1;
        hipLaunchKernelGGL(phase_kernel(bit), dim3(grid), dim3(512), LDS_BYTES, stream, a);
    }
#endif
    const hipError_t le = hipPeekAtLastError();
    if (le != hipSuccess) fprintf(stderr, "kernel_launch: launch failed: %s\n", hipGetErrorName(le));
}
```

```cpp
#include <hip/hip_runtime.h>
#include <cstdio>
#include <cstdint>

#ifndef MK_SINGLE
#define MK_SINGLE 1
#endif

#ifndef PROBE_MASK
#define PROBE_MASK 0u
#endif
#define GAS __attribute__((address_space(1)))
#define LAS __attribute__((address_space(3)))
typedef unsigned short bf16;
typedef short bf16x8 __attribute__((ext_vector_type(8)));
typedef short s16x4 __attribute__((ext_vector_type(4)));
typedef float f32x2 __attribute__((ext_vector_type(2)));
typedef float f32x4 __attribute__((ext_vector_type(4)));
typedef float f32x16 __attribute__((ext_vector_type(16)));
typedef unsigned u32x2 __attribute__((ext_vector_type(2)));
typedef unsigned u32x4 __attribute__((ext_vector_type(4)));
typedef GAS unsigned gu32;

constexpr int D = 2048, NB = 8, SEQ = 4096, CTXL = 256, DEPTH = 4;
constexpr int MX = NB * SEQ, MC = NB * CTXL, MT = MX + MC;
constexpr int FF = 5632, NMOD = 6 * D;
constexpr int MLA_H = 16, QR = 512, KVR = 512, NOPE = 128, ROPE = 64, DQ = 192;
constexpr int N1 = 1280;
constexpr int RH = 8, RDK = 256, RDV = 512;
constexpr float NORM_EPS = 1e-6f, GN_EPS = 1e-5f;
constexpr float LOG2E = 1.4426950408889634f;

constexpr size_t MiB = 1u << 20;
constexpr size_t WS_CTL = 0, CTL_BYTES = 1 * MiB;
constexpr size_t WS_MODV = 1 * MiB;
constexpr size_t WS_TABM = 3 * MiB;
constexpr size_t WS_TABR = 4 * MiB;
constexpr size_t WS_SSQ = 8 * MiB;
constexpr size_t WS_XC = 12 * MiB;
constexpr size_t WS_KR = 28 * MiB;
constexpr size_t WS_W = 40 * MiB;
constexpr size_t WS_WFFN = WS_W + 84 * MiB;
constexpr size_t WS_H = 200 * MiB;
constexpr size_t WS_BIG = 336 * MiB;
constexpr size_t WS_QKVL = WS_BIG, WS_Q = WS_BIG + 88 * MiB, WS_KV = WS_BIG + 292 * MiB, WS_O = WS_BIG + 564 * MiB;
constexpr size_t WS_QKV = WS_BIG, WS_Y = WS_BIG + 544 * MiB, WS_GATED = WS_BIG;
constexpr size_t WS_G = WS_BIG, WS_U = WS_BIG + 374 * MiB;
constexpr size_t WS_END = WS_BIG + 1088 * MiB;
static_assert((size_t)MT * 8192 * 2 <= 544 * MiB && (size_t)MT * 5632 * 2 <= 374 * MiB && (size_t)MT * N1 * 2 <= 88 * MiB, "ws map");

constexpr int CW_BAR = 4096;

constexpr int RING_BYTES = 131072, MISC_OFF = RING_BYTES + 320, ARGS_OFF = RING_BYTES + 1024, EDGE_OFF = RING_BYTES + 4096, LDS_BYTES = 147456;

__device__ __forceinline__ unsigned cvt_pk_bf16(float lo, float hi) { unsigned r; asm volatile("v_cvt_pk_bf16_f32 %0, %1, %2" : "=v"(r) : "v"(lo), "v"(hi)); return r; }
__device__ __forceinline__ float bf2f(unsigned short b) { return __uint_as_float((unsigned)b << 16); }
__device__ __forceinline__ float bflo(unsigned w) { return __uint_as_float(w << 16); }
__device__ __forceinline__ float bfhi(unsigned w) { return __uint_as_float(w & 0xffff0000u); }
__device__ __forceinline__ float shfl_xor_l(float v, int mask, int lane) { return __builtin_bit_cast(float, __builtin_amdgcn_ds_bpermute((lane ^ mask) << 2, __builtin_bit_cast(int, v))); }
__device__ __forceinline__ float fast_silu(float x) { return x * __builtin_amdgcn_rcpf(1.0f + __builtin_amdgcn_exp2f(-x * LOG2E)); }

__device__ __forceinline__ void glds16_s(const void* sbase, unsigned voff, unsigned lds_dst) {
    unsigned keep;
    asm volatile("s_mov_b32 %0, m0\n\ts_mov_b32 m0, %3\n\ts_nop 0\n\tglobal_load_lds_dwordx4 %1, %2\n\ts_mov_b32 m0, %0" : "=&s"(keep) : "v"(voff), "s"(sbase), "s"(lds_dst) : "memory");
}
__device__ __forceinline__ const char* uni_ptr(const void* p) {
    const unsigned long long v = (unsigned long long)p; const unsigned lo = __builtin_amdgcn_readfirstlane((unsigned)v), hi = __builtin_amdgcn_readfirstlane((unsigned)(v >> 32));
    return (const char*)(((unsigned long long)hi << 32) | lo);
}
namespace pg8 {
constexpr int BM = 256, BK = 64, HALF = 128, HTB = HALF * BK * 2, STAGE_BYTES = 8 * HTB, NXCD = 8, WGM = 8;
__host__ __device__ __forceinline__ int lds_byte(int r, int c) { const int st = (r >> 4) * 2 + (c >> 5), rr = r & 15, cc = c & 31, ob = rr * 64 + cc * 2; return st * 1024 + (ob ^ (((ob >> 9) & 1) << 5)); }
__host__ __device__ __forceinline__ void stage_rc(int b, int& R, int& C) { const int st = b / 1024, sb = b % 1024, swz = sb ^ (((sb >> 9) & 1) << 5); R = (st >> 1) * 16 + swz / 64; C = (st & 1) * 32 + (swz % 64) / 2; }
__host__ __device__ __forceinline__ int perm32(int rho) { const int n = rho >> 4, i = rho & 15; return 8 * (i >> 2) + 4 * n + (i & 3); }
struct Unit { int pm, pn; };
struct Gemm { const bf16* A; const bf16* Bt; int M, N, K, lda; };
struct StaticOrder {
    int nM, nN, nwg, G, c;
    __device__ void init(int M, int N, int G_, int c_) { nM = M / BM; nN = N / BM; nwg = nM * nN; G = G_; c = c_; }
    __device__ bool next(int i, Unit& u) const {
        const long L = (long)i * G + c; if (L >= nwg) return false;
        int wgid = (int)L; { const int q = nwg / NXCD, r = nwg % NXCD, xcd = wgid % NXCD, off = wgid / NXCD; wgid = (xcd < r ? xcd * (q + 1) : r * (q + 1) + (xcd - r) * q) + off; }
        const int nig = WGM * nN, gid = wgid / nig, fm = gid * WGM, gsz = (nM - fm) < WGM ? (nM - fm) : WGM;
        u.pm = fm + ((wgid % nig) % gsz); u.pn = (wgid % nig) / gsz; return true;
    }
};
template <class Epi>
__device__ __forceinline__ void gemm_phase(LAS unsigned char* lds, const Gemm g, const StaticOrder& S, const Epi& E) {
    int tid = threadIdx.x; asm volatile("" : "+v"(tid));
    const int wid = __builtin_amdgcn_readfirstlane(tid >> 6), lane = tid & 63, wr = wid >> 2, wc = wid & 3, fr = lane & 15, fq = lane >> 4;
    const int K = g.K, nt = K / BK;
    unsigned voffA[2], voffB[2];
#pragma unroll
    for (int i = 0; i < 2; ++i) { int R, C; stage_rc(tid * 16 + i * 8192, R, C); const int Rb = Epi::PERM ? ((R & ~31) + perm32(R & 31)) : R;
        voffA[i] = (unsigned)(R * g.lda + C) * 2u; voffB[i] = (unsigned)(Rb * K + C) * 2u; }
    const size_t kstep = (size_t)(BK * 2);
    const size_t hstepA = (size_t)HALF * g.lda * 2, hstepB = (size_t)HALF * K * 2;
    const size_t tstepA = 2 * hstepA, tstepB = 2 * hstepB;
    const unsigned ldsbase = (unsigned)__builtin_amdgcn_readfirstlane((unsigned)(uintptr_t)lds + (unsigned)wid * 1024u);
    const int aoff = lds_byte(wr * 64 + fr, fq * 8), boff = lds_byte(wc * 32 + fr, fq * 8);
#define PG8_SA(b, h) (((b) * 2 + (h)) * HTB)
#define PG8_SB(b, h) ((4 + (b) * 2 + (h)) * HTB)
#define PG8_STAGE(bufoff, gbase, voff) do { const char* _gb = uni_ptr(gbase); _Pragma("unroll") for (int _i = 0; _i < 2; ++_i) \
        glds16_s(_gb, (voff)[_i], ldsbase + (unsigned)((bufoff) + _i * 8192)); } while (0)
#define PG8_LDA(dst, b, h) do { _Pragma("unroll") for (int m = 0; m < 4; ++m) _Pragma("unroll") for (int k = 0; k < 2; ++k) dst[m][k] = *(const LAS bf16x8*)(lds + PG8_SA(b, h) + aoff + m * 2048 + k * 1024); } while (0)
#define PG8_LDB(dst, b, h) do { _Pragma("unroll") for (int n = 0; n < 2; ++n) _Pragma("unroll") for (int k = 0; k < 2; ++k) dst[n][k] = *(const LAS bf16x8*)(lds + PG8_SB(b, h) + boff + n * 2048 + k * 1024); } while (0)
#define PG8_MMA(ai, bj, At, Bt) do { __builtin_amdgcn_s_setprio(1); _Pragma("unroll") for (int m = 0; m < 4; ++m) _Pragma("unroll") for (int n = 0; n < 2; ++n) _Pragma("unroll") for (int k = 0; k < 2; ++k) \
        acc[ai][bj][m][n] = __builtin_amdgcn_mfma_f32_16x16x32_bf16(Bt[n][k], At[m][k], acc[ai][bj][m][n], 0, 0, 0); __builtin_amdgcn_s_setprio(0); } while (0)
#define PG8_WAIT_V(n) asm volatile("s_waitcnt vmcnt(" #n ")" ::: "memory")
#define PG8_WAIT_L(n) asm volatile("s_waitcnt lgkmcnt(" #n ")" ::: "memory")
#define PG8_BAR __builtin_amdgcn_s_barrier()
#define PG8_SCHED __builtin_amdgcn_sched_barrier(0)
    Unit cur, nxt; int ui = 0;
    if (!S.next(0, cur)) return;
    f32x4 acc[2][2][4][2];
#pragma unroll
    for (int a = 0; a < 2; ++a)
#pragma unroll
        for (int b = 0; b < 2; ++b)
#pragma unroll
            for (int m = 0; m < 4; ++m)
#pragma unroll
                for (int n = 0; n < 2; ++n) acc[a][b][m][n] = (f32x4){0.f, 0.f, 0.f, 0.f};
    bf16x8 At[4][2], B0[2][2], B1[2][2];
    const char* cA = (const char*)g.A + (size_t)cur.pm * tstepA; const char* cB = (const char*)g.Bt + (size_t)cur.pn * tstepB;
    PG8_STAGE(PG8_SB(0, 0), cB, voffB); PG8_STAGE(PG8_SB(0, 1), cB + hstepB, voffB); PG8_STAGE(PG8_SA(0, 0), cA, voffA); PG8_STAGE(PG8_SA(0, 1), cA + hstepA, voffA);
    if (wr == 1) PG8_BAR;
    PG8_WAIT_V(2); PG8_BAR;
    PG8_STAGE(PG8_SB(1, 0), cB + kstep, voffB); PG8_STAGE(PG8_SA(1, 0), cA + kstep, voffA); PG8_STAGE(PG8_SB(1, 1), cB + hstepB + kstep, voffB);
    PG8_WAIT_V(6); PG8_BAR;
    for (;;) {
        const bool has_next = S.next(ui + 1, nxt);
        const char* nA = has_next ? (const char*)g.A + (size_t)nxt.pm * tstepA : cA; const char* nB = has_next ? (const char*)g.Bt + (size_t)nxt.pn * tstepB : cB;
        for (int t = 0; t < nt; t += 2) {
            const bool last = (t == nt - 2);
            const char* a1 = cA + (size_t)(t + 1) * kstep;
            const char* a2 = last ? nA : cA + (size_t)(t + 2) * kstep; const char* b2 = last ? nB : cB + (size_t)(t + 2) * kstep;
            const char* a3 = a2 + kstep; const char* b3 = b2 + kstep;
            PG8_LDB(B0, 0, 0); PG8_LDB(B1, 0, 1); PG8_SCHED; PG8_LDA(At, 0, 0); PG8_STAGE(PG8_SA(1, 1), a1 + hstepA, voffA);
            PG8_WAIT_V(8); PG8_WAIT_L(0); PG8_BAR; PG8_MMA(0, 0, At, B0); PG8_MMA(0, 1, At, B1); PG8_BAR; PG8_SCHED;
            PG8_LDA(At, 0, 1); PG8_STAGE(PG8_SB(0, 0), b2, voffB); PG8_STAGE(PG8_SB(0, 1), b2 + hstepB, voffB); PG8_STAGE(PG8_SA(0, 0), a2, voffA);
            PG8_WAIT_V(8); PG8_WAIT_L(0); PG8_BAR; PG8_MMA(1, 0, At, B0); PG8_MMA(1, 1, At, B1); PG8_BAR; PG8_SCHED;
            PG8_LDB(B0, 1, 0); PG8_LDB(B1, 1, 1); PG8_SCHED; PG8_LDA(At, 1, 0); PG8_STAGE(PG8_SA(0, 1), a2 + hstepA, voffA);
            PG8_WAIT_V(8); PG8_WAIT_L(0); PG8_BAR; PG8_MMA(0, 0, At, B0); PG8_MMA(0, 1, At, B1); PG8_BAR; PG8_SCHED;
            PG8_LDA(At, 1, 1); PG8_STAGE(PG8_SB(1, 0), b3, voffB); PG8_STAGE(PG8_SB(1, 1), b3 + hstepB, voffB); PG8_STAGE(PG8_SA(1, 0), a3, voffA);
            PG8_WAIT_V(8); PG8_WAIT_L(0); PG8_BAR; PG8_MMA(1, 0, At, B0); PG8_MMA(1, 1, At, B1); PG8_BAR; PG8_SCHED;
        }
        if (wr == 0) PG8_BAR;
        E(acc, cur, wr, wc, fr, fq);
        if (!has_next) break;
#pragma unroll
        for (int a = 0; a < 2; ++a)
#pragma unroll
            for (int b = 0; b < 2; ++b)
#pragma unroll
                for (int m = 0; m < 4; ++m)
#pragma unroll
                    for (int n = 0; n < 2; ++n) acc[a][b][m][n] = (f32x4){0.f, 0.f, 0.f, 0.f};
        cur = nxt; cA = nA; cB = nB; ++ui;
        if (wr == 1) PG8_BAR;
    }
    PG8_WAIT_V(0);
    PG8_BAR;
#undef PG8_SA
#undef PG8_SB
#undef PG8_STAGE
#undef PG8_LDA
#undef PG8_LDB
#undef PG8_MMA
#undef PG8_WAIT_V
#undef PG8_WAIT_L
#undef PG8_BAR
#undef PG8_SCHED
}
}
using pg8::Unit;

__device__ __forceinline__ u32x4 pack8(const f32x4 a, const f32x4 b) { u32x4 w; w.x = cvt_pk_bf16(a[0], a[1]); w.y = cvt_pk_bf16(a[2], a[3]); w.z = cvt_pk_bf16(b[0], b[1]); w.w = cvt_pk_bf16(b[2], b[3]); return w; }
__device__ __forceinline__ f32x4 rot2(const f32x4 v, const f32x4 cs) { f32x4 o; o[0] = v[0] * cs[0] - v[1] * cs[1]; o[1] = v[1] * cs[0] + v[0] * cs[1]; o[2] = v[2] * cs[2] - v[3] * cs[3]; o[3] = v[3] * cs[2] + v[2] * cs[3]; return o; }

__device__ __forceinline__ f32x4 mla_cs(const float* tabm, int t, int c4) {
    const int p0 = c4 >> 1; const int pos = (p0 < 16) ? (t >> 6) : (t & 63); const int f = p0 & 15;
    return *(const f32x4*)(tabm + ((size_t)pos * 16 + f) * 2);
}

struct EpiG1 {
    static constexpr bool PERM = true;
    bf16* QKVL; float* SSQ; bf16* KR; const float* tabm;
    __device__ __forceinline__ void operator()(const f32x4 (&acc)[2][2][4][2], const Unit& u, int wr, int wc, int fr, int fq) const {
        const int row0 = u.pm * 256 + wr * 64 + fr;
        if (u.pn < 4) {
            const int col0 = u.pn * 256 + wc * 32 + 8 * fq;
#pragma unroll
            for (int ai = 0; ai < 2; ++ai)
#pragma unroll
                for (int m = 0; m < 4; ++m) { const int row = row0 + ai * 128 + m * 16; float ss = 0.f;
#pragma unroll
                    for (int bj = 0; bj < 2; ++bj) { const f32x4 v0 = acc[ai][bj][m][0], v1 = acc[ai][bj][m][1];
                        ss += (v0[0] * v0[0] + v0[1] * v0[1]) + (v0[2] * v0[2] + v0[3] * v0[3]) + (v1[0] * v1[0] + v1[1] * v1[1]) + (v1[2] * v1[2] + v1[3] * v1[3]);
                        *(u32x4*)(QKVL + (size_t)row * N1 + col0 + bj * 128) = pack8(v0, v1); }
                    { const int ln_ = fr + 16 * fq; ss += shfl_xor_l(ss, 16, ln_); ss += shfl_xor_l(ss, 32, ln_); }
                    if (fq == 0) SSQ[(size_t)row * 16 + u.pn * 4 + wc] = ss; asm volatile("" ::: "memory"); }
        } else if (wc < 2) {
            const int c8 = wc * 32 + 8 * fq;
#pragma unroll
            for (int ai = 0; ai < 2; ++ai)
#pragma unroll
                for (int m = 0; m < 4; ++m) { const int row = row0 + ai * 128 + m * 16; f32x4 v0 = acc[ai][0][m][0], v1 = acc[ai][0][m][1];
                    if (row < MX) { const int t = row & (SEQ - 1); v0 = rot2(v0, mla_cs(tabm, t, c8)); v1 = rot2(v1, mla_cs(tabm, t, c8 + 4)); }
                    *(u32x4*)(KR + (size_t)row * 64 + c8) = pack8(v0, v1); asm volatile("" ::: "memory"); }
        }
    }
};
struct EpiUq {
    static constexpr bool PERM = true;
    bf16* Q; const float* SSQ; const float* tabm;
    __device__ __forceinline__ void operator()(const f32x4 (&acc)[2][2][4][2], const Unit& u, int wr, int wc, int fr, int fq) const {
        const int row0 = u.pm * 256 + wr * 64 + fr;
        int col8[2], dd[2];
#pragma unroll
        for (int bj = 0; bj < 2; ++bj) { col8[bj] = u.pn * 256 + bj * 128 + wc * 32 + 8 * fq; dd[bj] = col8[bj] % DQ; }
#pragma unroll
        for (int ai = 0; ai < 2; ++ai)
#pragma unroll
            for (int m = 0; m < 4; ++m) { const int row = row0 + ai * 128 + m * 16;
                const f32x4 s0 = *(const f32x4*)(SSQ + (size_t)row * 16), s1 = *(const f32x4*)(SSQ + (size_t)row * 16 + 4);
                const float ss = ((s0[0] + s0[1]) + (s0[2] + s0[3])) + ((s1[0] + s1[1]) + (s1[2] + s1[3]));
                const float r = 1.0f / sqrtf(ss * (1.0f / QR) + NORM_EPS);
#pragma unroll
                for (int bj = 0; bj < 2; ++bj) { f32x4 v0 = acc[ai][bj][m][0] * r, v1 = acc[ai][bj][m][1] * r;
                    if (dd[bj] >= NOPE && row < MX) { const int t = row & (SEQ - 1), c8 = dd[bj] - NOPE; v0 = rot2(v0, mla_cs(tabm, t, c8)); v1 = rot2(v1, mla_cs(tabm, t, c8 + 4)); }
                    *(u32x4*)(Q + (size_t)row * 3072 + col8[bj]) = pack8(v0, v1); } asm volatile("" ::: "memory"); }
    }
};
struct EpiUkv {
    static constexpr bool PERM = true;
    bf16* KV; const float* SSQ;
    __device__ __forceinline__ void operator()(const f32x4 (&acc)[2][2][4][2], const Unit& u, int wr, int wc, int fr, int fq) const {
        const int row0 = u.pm * 256 + wr * 64 + fr; const int col0 = u.pn * 256 + wc * 32 + 8 * fq;
#pragma unroll
        for (int ai = 0; ai < 2; ++ai)
#pragma unroll
            for (int m = 0; m < 4; ++m) { const int row = row0 + ai * 128 + m * 16;
                const f32x4 s0 = *(const f32x4*)(SSQ + (size_t)row * 16 + 8), s1 = *(const f32x4*)(SSQ + (size_t)row * 16 + 12);
                const float ss = ((s0[0] + s0[1]) + (s0[2] + s0[3])) + ((s1[0] + s1[1]) + (s1[2] + s1[3]));
                const float r = 1.0f / sqrtf(ss * (1.0f / KVR) + NORM_EPS);
#pragma unroll
                for (int bj = 0; bj < 2; ++bj) *(u32x4*)(KV + (size_t)row * 4096 + col0 + bj * 128) = pack8(acc[ai][bj][m][0] * r, acc[ai][bj][m][1] * r); asm volatile("" ::: "memory"); }
    }
};
struct EpiResid {
    static constexpr bool PERM = false;
    const float* xin; float* xout; const float* cin; float* cout; const float* modv; int gofs;
    __device__ __forceinline__ void operator()(const f32x4 (&acc)[2][2][4][2], const Unit& u, int wr, int wc, int fr, int fq) const {
        const bool isx = u.pm < (MX / 256);
        const int rloc = (isx ? u.pm * 256 : (u.pm * 256 - MX)) + wr * 64 + fr;
        const float* base = isx ? xin : cin; float* out = isx ? xout : cout;
        const float* gv = modv + (size_t)(isx ? (u.pm >> 4) : 8) * NMOD + gofs;
        const int col0 = u.pn * 256 + wc * 32 + 4 * fq;
        f32x4 g4[2][2];
#pragma unroll
        for (int bj = 0; bj < 2; ++bj)
#pragma unroll
            for (int n = 0; n < 2; ++n) g4[bj][n] = *(const f32x4*)(gv + col0 + bj * 128 + n * 16);
#pragma unroll
        for (int ai = 0; ai < 2; ++ai)
#pragma unroll
            for (int m = 0; m < 4; ++m) { const size_t off = (size_t)(rloc + ai * 128 + m * 16) * D + col0;
#pragma unroll
                for (int bj = 0; bj < 2; ++bj)
#pragma unroll
                    for (int n = 0; n < 2; ++n) { const f32x4 b = *(const f32x4*)(base + off + bj * 128 + n * 16); *(f32x4*)(out + off + bj * 128 + n * 16) = b + g4[bj][n] * acc[ai][bj][m][n]; }
                if (m & 1) asm volatile("" ::: "memory"); }
    }
};
template <int CTRL> __device__ __forceinline__ float dpp1(float x) { return __int_as_float(__builtin_amdgcn_update_dpp(0, __float_as_int(x), CTRL, 0xF, 0xF, false)); }
__device__ __forceinline__ f32x4 row_prev(const f32x4 v) { f32x4 o; o.x = dpp1<0x121>(v.x); o.y = dpp1<0x121>(v.y); o.z = dpp1<0x121>(v.z); o.w = dpp1<0x121>(v.w); return o; }
__device__ __forceinline__ f32x4 row_next(const f32x4 v) { f32x4 o; o.x = dpp1<0x12F>(v.x); o.y = dpp1<0x12F>(v.y); o.z = dpp1<0x12F>(v.z); o.w = dpp1<0x12F>(v.w); return o; }
__device__ __forceinline__ f32x4 silu4(const f32x4 v) { f32x4 o;
#pragma unroll
    for (int e = 0; e < 4; ++e) o[e] = fast_silu(v[e]); return o; }
constexpr size_t HALO_STRIDE = (size_t)FF;
struct EpiGUConv {
    static constexpr bool PERM = true;
    bf16* ACT; float* HALO; const float* cw; const float* cb; LAS float* edge;
    __device__ __forceinline__ void operator()(const f32x4 (&acc)[2][2][4][2], const Unit& u, int wr, int wc, int fr, int fq) const {
        const int c8 = wc * 32 + 8 * fq; const int f0 = u.pn * 128 + c8;
#pragma unroll
        for (int ai = 0; ai < 2; ++ai) { const int blk = 2 * ai + wr;
            if (fr == 0)  { *(LAS f32x4*)(edge + (blk * 2 + 0) * 128 + c8) = acc[ai][0][0][0]; *(LAS f32x4*)(edge + (blk * 2 + 0) * 128 + c8 + 4) = acc[ai][0][0][1]; }
            if (fr == 15) { *(LAS f32x4*)(edge + (blk * 2 + 1) * 128 + c8) = acc[ai][0][3][0]; *(LAS f32x4*)(edge + (blk * 2 + 1) * 128 + c8 + 4) = acc[ai][0][3][1]; } }
        asm volatile("s_waitcnt lgkmcnt(0)" ::: "memory"); __builtin_amdgcn_s_barrier(); asm volatile("" ::: "memory");
        f32x4 w0[2], w1[2], w2[2], bb[2];
#pragma unroll
        for (int n = 0; n < 2; ++n) { w0[n] = *(const f32x4*)(cw + f0 + 4 * n); w1[n] = *(const f32x4*)(cw + FF + f0 + 4 * n); w2[n] = *(const f32x4*)(cw + 2 * FF + f0 + 4 * n); bb[n] = *(const f32x4*)(cb + f0 + 4 * n); }
        const f32x4 zero4 = {0.f, 0.f, 0.f, 0.f};
#pragma unroll
        for (int ai = 0; ai < 2; ++ai) { const int blk = 2 * ai + wr;
#pragma unroll
            for (int m = 0; m < 4; ++m) { const int row = u.pm * 256 + ai * 128 + wr * 64 + m * 16 + fr; f32x4 o[2];
#pragma unroll
                for (int n = 0; n < 2; ++n) { const f32x4 cur = acc[ai][0][m][n];
                    f32x4 b, d;
                    if (m > 0) b = row_prev(acc[ai][0][m - 1][n]); else b = (blk > 0) ? *(const LAS f32x4*)(edge + ((blk - 1) * 2 + 1) * 128 + c8 + 4 * n) : zero4;
                    if (m < 3) d = row_next(acc[ai][0][m + 1][n]); else d = (blk < 3) ? *(const LAS f32x4*)(edge + ((blk + 1) * 2 + 0) * 128 + c8 + 4 * n) : zero4;
                    const f32x4 a = row_prev(cur), c = row_next(cur);
                    const f32x4 up = (fr == 0) ? b : a, dn = (fr == 15) ? d : c;
                    const f32x4 cv = w0[n] * up + w1[n] * cur + w2[n] * dn + bb[n]; const f32x4 uu = acc[ai][1][m][n];
                    o[n] = silu4(cv) * uu;
                    if (m == 0 && blk == 0 && fr == 0) { float* hp = HALO + (size_t)((u.pm * 2 + 0) * 3) * HALO_STRIDE + f0 + 4 * n; *(f32x4*)hp = cv; *(f32x4*)(hp + HALO_STRIDE) = cur; *(f32x4*)(hp + 2 * HALO_STRIDE) = uu; }
                    if (m == 3 && blk == 3 && fr == 15) { float* hp = HALO + (size_t)((u.pm * 2 + 1) * 3) * HALO_STRIDE + f0 + 4 * n; *(f32x4*)hp = cv; *(f32x4*)(hp + HALO_STRIDE) = cur; *(f32x4*)(hp + 2 * HALO_STRIDE) = uu; } }
                *(u32x4*)(ACT + (size_t)row * FF + f0) = pack8(o[0], o[1]); asm volatile("" ::: "memory"); } }
        asm volatile("s_waitcnt lgkmcnt(0)" ::: "memory"); __builtin_amdgcn_s_barrier(); asm volatile("" ::: "memory");
    }
};
struct EpiQKV {
    static constexpr bool PERM = true;
    bf16* QKV; const float* tabr;
    __device__ __forceinline__ void operator()(const f32x4 (&acc)[2][2][4][2], const Unit& u, int wr, int wc, int fr, int fq) const {
        const int row0 = u.pm * 256 + wr * 64 + fr; const int col0 = u.pn * 256 + wc * 32 + 8 * fq;
        const bool rope = (u.pn < 16) && (u.pm < MX / 256);
#pragma unroll
        for (int ai = 0; ai < 2; ++ai)
#pragma unroll
            for (int m = 0; m < 4; ++m) { const int row = row0 + ai * 128 + m * 16;
#pragma unroll
                for (int bj = 0; bj < 2; ++bj) { f32x4 v0 = acc[ai][bj][m][0], v1 = acc[ai][bj][m][1]; const int col = col0 + bj * 128;
                    if (rope) { const int t = row & (SEQ - 1); const float* tp = tabr + ((size_t)t * 128 + ((col & 255) >> 1)) * 2;
                        v0 = rot2(v0, *(const f32x4*)tp); v1 = rot2(v1, *(const f32x4*)(tp + 4)); }
                    *(u32x4*)(QKV + (size_t)row * 8192 + col) = pack8(v0, v1); } asm volatile("" ::: "memory"); }
    }
};
struct EpiGate {
    static constexpr bool PERM = true;
    bf16* GATED; const bf16* YF; const bf16* YB;
    __device__ __forceinline__ void operator()(const f32x4 (&acc)[2][2][4][2], const Unit& u, int wr, int wc, int fr, int fq) const {
        const int row0 = u.pm * 256 + wr * 64 + fr; const int f0 = u.pn * 128 + wc * 32 + 8 * fq;
#pragma unroll
        for (int ai = 0; ai < 2; ++ai)
#pragma unroll
            for (int m = 0; m < 4; ++m) { const size_t off = (size_t)(row0 + ai * 128 + m * 16) * 4096 + f0;
                const u32x4 nf = *(const u32x4*)(YF + off), nb = *(const u32x4*)(YB + off);
                const f32x4 a0 = acc[ai][0][m][0], a1 = acc[ai][0][m][1], b0 = acc[ai][1][m][0], b1 = acc[ai][1][m][1];
                f32x4 o0, o1;
                o0[0] = fast_silu(a0[0]) * bflo(nf.x) + fast_silu(b0[0]) * bflo(nb.x); o0[1] = fast_silu(a0[1]) * bfhi(nf.x) + fast_silu(b0[1]) * bfhi(nb.x);
                o0[2] = fast_silu(a0[2]) * bflo(nf.y) + fast_silu(b0[2]) * bflo(nb.y); o0[3] = fast_silu(a0[3]) * bfhi(nf.y) + fast_silu(b0[3]) * bfhi(nb.y);
                o1[0] = fast_silu(a1[0]) * bflo(nf.z) + fast_silu(b1[0]) * bflo(nb.z); o1[1] = fast_silu(a1[1]) * bfhi(nf.z) + fast_silu(b1[1]) * bfhi(nb.z);
                o1[2] = fast_silu(a1[2]) * bflo(nf.w) + fast_silu(b1[2]) * bflo(nb.w); o1[3] = fast_silu(a1[3]) * bfhi(nf.w) + fast_silu(b1[3]) * bfhi(nb.w);
                *(u32x4*)(GATED + off) = pack8(o0, o1); asm volatile("" ::: "memory"); }
    }
};

namespace att {
constexpr int NW = 8, QBLK = 32, KVBLK = 64;
constexpr int SHM_V = 16384, SHM_KN = 16384, SHM_KR = 8192;
constexpr int OFF_V = 0, OFF_KN = 3 * SHM_V, OFF_KR = OFF_KN + 2 * SHM_KN, OFF_WS = OFF_KR + 2 * SHM_KR, SHM_ATTN = OFF_WS + NW * 64 * 4;
constexpr float THR2 = 11.5f;
#define KSWZ(row, colB) ((row) * 256 + ((colB) ^ (((row) & 7) << 4)))
#define KRSWZ(row, colB) ((row) * 128 + ((colB) ^ ((((row) >> 1) & 7) << 4)))
#define SBAR() __builtin_amdgcn_sched_barrier(0)
__device__ __forceinline__ int crow(int r, int hi) { return (r & 3) + 8 * (r >> 2) + 4 * hi; }
__device__ __forceinline__ void partialSM(f32x16& p0, f32x16& p1, float& m_reg, float& alpha) {
  float pmax = p0[0];
#pragma unroll
  for (int r = 1; r < 16; ++r) pmax = fmaxf(pmax, p0[r]);
#pragma unroll
  for (int r = 0; r < 16; ++r) pmax = fmaxf(pmax, p1[r]);
  { auto rr = __builtin_amdgcn_permlane32_swap(__float_as_uint(pmax), __float_as_uint(pmax), false, false); pmax = fmaxf(__uint_as_float(rr[0]), __uint_as_float(rr[1])); }
  float mn;
  if (__builtin_expect(__all(pmax - m_reg <= THR2), 1)) { mn = m_reg; alpha = 1.f; }
  else { mn = fmaxf(m_reg, pmax); alpha = __builtin_amdgcn_exp2f(m_reg - mn); m_reg = mn; }
#pragma unroll
  for (int r = 0; r < 16; ++r) p0[r] = p0[r] - mn;
#pragma unroll
  for (int r = 0; r < 16; ++r) p1[r] = p1[r] - mn;
#pragma unroll
  for (int r = 0; r < 16; ++r) p0[r] = __builtin_amdgcn_exp2f(p0[r]);
}
__device__ __forceinline__ void finishSM(f32x16& p0, f32x16& p1, float alpha, float& l_reg, bf16x8& pa0, bf16x8& pa1, bf16x8& pa2, bf16x8& pa3) {
#pragma unroll
  for (int r = 0; r < 16; ++r) p1[r] = __builtin_amdgcn_exp2f(p1[r]);
  float ps = 0;
#pragma unroll
  for (int r = 0; r < 16; ++r) ps += p0[r];
#pragma unroll
  for (int r = 0; r < 16; ++r) ps += p1[r];
  { auto rr = __builtin_amdgcn_permlane32_swap(__float_as_uint(ps), __float_as_uint(ps), false, false); ps = __uint_as_float(rr[0]) + __uint_as_float(rr[1]); }
  l_reg = l_reg * alpha + ps;
#define PK4(P, BASE, OUT) do { unsigned a0 = cvt_pk_bf16(P[BASE + 0], P[BASE + 1]), a1 = cvt_pk_bf16(P[BASE + 2], P[BASE + 3]);   \
    unsigned b0 = cvt_pk_bf16(P[BASE + 4], P[BASE + 5]), b1 = cvt_pk_bf16(P[BASE + 6], P[BASE + 7]);                              \
    auto r0 = __builtin_amdgcn_permlane32_swap(a0, b0, false, false); auto r1 = __builtin_amdgcn_permlane32_swap(a1, b1, false, false); \
    u32x4 w = {r0[0], r1[0], r0[1], r1[1]}; OUT = __builtin_bit_cast(bf16x8, w); } while (0)
  PK4(p0, 0, pa0); PK4(p0, 8, pa1); PK4(p1, 0, pa2); PK4(p1, 8, pa3);
#undef PK4
}
__device__ __forceinline__ void qkt(f32x16& p0, f32x16& p1, const char* Kn, const char* Kr, const bf16x8* qr, int r32, int hi) {
  p0 = f32x16{}; p1 = f32x16{};
#pragma unroll
  for (int d0 = 0; d0 < 8; ++d0) { const int cb = (d0 * 16 + hi * 8) * 2;
    const bf16x8 b0 = *reinterpret_cast<const bf16x8*>(Kn + KSWZ(r32, cb));
    const bf16x8 b1 = *reinterpret_cast<const bf16x8*>(Kn + KSWZ(32 + r32, cb));
    p0 = __builtin_amdgcn_mfma_f32_32x32x16_bf16(b0, qr[d0], p0, 0, 0, 0);
    p1 = __builtin_amdgcn_mfma_f32_32x32x16_bf16(b1, qr[d0], p1, 0, 0, 0); }
#pragma unroll
  for (int d0 = 0; d0 < 4; ++d0) { const int cb = (d0 * 16 + hi * 8) * 2;
    const bf16x8 b0 = *reinterpret_cast<const bf16x8*>(Kr + KRSWZ(r32, cb));
    const bf16x8 b1 = *reinterpret_cast<const bf16x8*>(Kr + KRSWZ(32 + r32, cb));
    p0 = __builtin_amdgcn_mfma_f32_32x32x16_bf16(b0, qr[8 + d0], p0, 0, 0, 0);
    p1 = __builtin_amdgcn_mfma_f32_32x32x16_bf16(b1, qr[8 + d0], p1, 0, 0, 0); }
}
__device__ __forceinline__ int v_st(int k, int c) { const int kk = (k & ~0xC) | ((k & 4) << 1) | ((k & 8) >> 1); return ((kk >> 3) * 4 + (c >> 5)) * 512 + ((kk & 7) * 32 + (c & 31)) * 2; }
__device__ __forceinline__ int v_rd_base(int lane) { return ((lane & 3) << 3) | (((lane >> 2) & 3) << 6) | (((lane >> 4) & 1) << 5) | (((lane >> 5) & 1) << 8); }
constexpr int v_rd_off(int d0, int ks, int half) { return d0 * 512 + ks * 4096 + half * 2048; }
template <int OFF> __device__ __forceinline__ s16x4 tr_read(int vb) { s16x4 r; asm volatile("ds_read_b64_tr_b16 %0, %1 offset:%2" : "=&v"(r) : "v"(vb), "i"(OFF) : "memory"); return r; }
template <int D0> __device__ __forceinline__ void pv_one(f32x16& od, int vb, bf16x8 pa0, bf16x8 pa1, bf16x8 pa2, bf16x8 pa3) {
  const s16x4 l0 = tr_read<v_rd_off(D0, 0, 0)>(vb), h0 = tr_read<v_rd_off(D0, 0, 1)>(vb), l1 = tr_read<v_rd_off(D0, 1, 0)>(vb), h1 = tr_read<v_rd_off(D0, 1, 1)>(vb);
  const s16x4 l2 = tr_read<v_rd_off(D0, 2, 0)>(vb), h2 = tr_read<v_rd_off(D0, 2, 1)>(vb), l3 = tr_read<v_rd_off(D0, 3, 0)>(vb), h3 = tr_read<v_rd_off(D0, 3, 1)>(vb);
  asm volatile("s_waitcnt lgkmcnt(0)" ::: "memory"); SBAR();
#define PK(L, H) (bf16x8){L[0], L[1], L[2], L[3], H[0], H[1], H[2], H[3]}
  od = __builtin_amdgcn_mfma_f32_32x32x16_bf16(pa0, PK(l0, h0), od, 0, 0, 0);
  od = __builtin_amdgcn_mfma_f32_32x32x16_bf16(pa1, PK(l1, h1), od, 0, 0, 0);
  od = __builtin_amdgcn_mfma_f32_32x32x16_bf16(pa2, PK(l2, h2), od, 0, 0, 0);
  od = __builtin_amdgcn_mfma_f32_32x32x16_bf16(pa3, PK(l3, h3), od, 0, 0, 0);
#undef PK
}
__device__ __forceinline__ void pv_d0(f32x16* o, int vb, bf16x8 pa0, bf16x8 pa1, bf16x8 pa2, bf16x8 pa3) {
  pv_one<0>(o[0], vb, pa0, pa1, pa2, pa3); pv_one<1>(o[1], vb, pa0, pa1, pa2, pa3); pv_one<2>(o[2], vb, pa0, pa1, pa2, pa3); pv_one<3>(o[3], vb, pa0, pa1, pa2, pa3);
}
__device__ __forceinline__ void attn_unit(const bf16* __restrict__ Qb, const bf16* __restrict__ KVh, const bf16* __restrict__ KRp, bf16* __restrict__ Ob,
                                          int NT, int nc, int cbase, int xbase, char* lds) {
  int tid = threadIdx.x; asm volatile("" : "+v"(tid));
  const int wid = __builtin_amdgcn_readfirstlane(tid >> 6), lane = tid & 63, r32 = lane & 31, hi = lane >> 5;
  char* V_lds = lds + OFF_V; char* Kn_lds = lds + OFF_KN; char* Kr_lds = lds + OFF_KR;
  float* ws = (float*)(lds + OFF_WS) + wid * 64; float* li_l = ws; float* al_l = ws + 32;
  float m_reg = -1e30f, l_reg = 0; f32x16 o[4] = {}; bf16x8 qr[12];
  const bf16* Qw = Qb + (long)(wid * QBLK + r32) * 3072 + hi * 8;
#pragma unroll
  for (int d0 = 0; d0 < 12; ++d0) qr[d0] = *reinterpret_cast<const bf16x8*>(Qw + d0 * 16);
  const int vb0 = (int)(uintptr_t)V_lds + v_rd_base(lane);
  unsigned vofK[2], vofV[2], vofR;
#pragma unroll
  for (int i = 0; i < 2; ++i) { const int pc = wid * 2 + i;
      { const int row = pc * 4 + (lane >> 4), ch = (lane & 15) ^ (row & 7); vofK[i] = (unsigned)((row * 4096 + ch * 8) * 2); }
      { const int ob = pc * 1024 + lane * 16, st = ob >> 9, w = ob & 511, kk = (st >> 2) * 8 + (w >> 6); const int k = (kk & ~0xC) | ((kk & 4) << 1) | ((kk & 8) >> 1);
        const int c = (st & 3) * 32 + 8 * ((w & 63) >> 4); vofV[i] = (unsigned)((k * 4096 + 128 + c) * 2); } }
  { const int row = wid * 8 + (lane >> 3), ch = (lane & 7) ^ ((row >> 1) & 7); vofR = (unsigned)((row * 64 + ch * 8) * 2); }
  const unsigned ldsK = (unsigned)__builtin_amdgcn_readfirstlane((unsigned)(uintptr_t)Kn_lds + (unsigned)wid * 2048u);
  const unsigned ldsV = (unsigned)__builtin_amdgcn_readfirstlane((unsigned)(uintptr_t)V_lds + (unsigned)wid * 2048u);
  const unsigned ldsR = (unsigned)__builtin_amdgcn_readfirstlane((unsigned)(uintptr_t)Kr_lds + (unsigned)wid * 1024u);
#define KROW(j) ((j) < nc ? cbase + (j) * KVBLK : xbase + ((j) - nc) * KVBLK)
#define DMA_TILE(j, kslot, vslot) do { const long k0_ = KROW(j); const char* kb_ = uni_ptr(KVh + k0_ * 4096); const char* rb_ = uni_ptr(KRp + k0_ * 64); \
    glds16_s(kb_, vofK[0], ldsK + (kslot) * SHM_KN); glds16_s(kb_, vofK[1], ldsK + (kslot) * SHM_KN + 1024u); \
    glds16_s(rb_, vofR, ldsR + (kslot) * SHM_KR); \
    glds16_s(kb_, vofV[0], ldsV + (vslot) * SHM_V); glds16_s(kb_, vofV[1], ldsV + (vslot) * SHM_V + 1024u); } while (0)
#define WAIT_SYNC() do { asm volatile("s_waitcnt vmcnt(0)" ::: "memory"); __syncthreads(); } while (0)
#define RESC(a) do { if (__any((a) < 1.f)) { if (hi == 0) al_l[r32] = (a); asm volatile("s_waitcnt lgkmcnt(0)" ::: "memory"); \
    _Pragma("unroll") for (int d = 0; d < 4; ++d) _Pragma("unroll") for (int r = 0; r < 16; ++r) o[d][r] *= al_l[crow(r, hi)]; } } while (0)
  f32x16 pA0, pA1, pB0, pB1; float alA, alB; bf16x8 pa0, pa1, pa2, pa3;
  DMA_TILE(0, 0, 0); DMA_TILE(1, 1, 1); WAIT_SYNC();
  qkt(pA0, pA1, Kn_lds, Kr_lds, qr, r32, hi); partialSM(pA0, pA1, m_reg, alA);
  __syncthreads();
  int vprev = 0, vcur = 1, vnext = 2;
  for (int j = 1; j + 1 < NT; j += 2) {
    DMA_TILE(j + 1, 0, vnext);
    SBAR(); qkt(pB0, pB1, Kn_lds + SHM_KN, Kr_lds + SHM_KR, qr, r32, hi);
    finishSM(pA0, pA1, alA, l_reg, pa0, pa1, pa2, pa3); SBAR();
    pv_d0(o, vb0 + vprev * SHM_V, pa0, pa1, pa2, pa3); partialSM(pB0, pB1, m_reg, alB);
    RESC(alB); WAIT_SYNC();
    { const int t_ = vprev; vprev = vcur; vcur = vnext; vnext = t_; }
    if (j + 2 < NT) DMA_TILE(j + 2, 1, vnext);
    SBAR(); qkt(pA0, pA1, Kn_lds, Kr_lds, qr, r32, hi);
    finishSM(pB0, pB1, alB, l_reg, pa0, pa1, pa2, pa3); SBAR();
    pv_d0(o, vb0 + vprev * SHM_V, pa0, pa1, pa2, pa3); partialSM(pA0, pA1, m_reg, alA);
    RESC(alA); WAIT_SYNC();
    { const int t_ = vprev; vprev = vcur; vcur = vnext; vnext = t_; }
  }
  SBAR(); qkt(pB0, pB1, Kn_lds + SHM_KN, Kr_lds + SHM_KR, qr, r32, hi);
  finishSM(pA0, pA1, alA, l_reg, pa0, pa1, pa2, pa3); SBAR();
  pv_d0(o, vb0 + vprev * SHM_V, pa0, pa1, pa2, pa3); partialSM(pB0, pB1, m_reg, alB);
  RESC(alB);
  finishSM(pB0, pB1, alB, l_reg, pa0, pa1, pa2, pa3); SBAR();
  pv_d0(o, vb0 + vcur * SHM_V, pa0, pa1, pa2, pa3);
  if (hi == 0) li_l[r32] = l_reg; asm volatile("s_waitcnt lgkmcnt(0)" ::: "memory");
  float rli[16];
#pragma unroll
  for (int r = 0; r < 16; ++r) rli[r] = __builtin_amdgcn_rcpf(li_l[crow(r, hi)]);
  bf16* Ow = Ob + (long)(wid * QBLK) * 2048;
#pragma unroll
  for (int r = 0; r < 16; ++r) { const int orow = crow(r, hi);
#pragma unroll
    for (int d0 = 0; d0 < 4; ++d0) Ow[(long)orow * 2048 + d0 * 32 + r32] = (bf16)(cvt_pk_bf16(o[d0][r] * rli[r], 0.f) & 0xffffu); }
  __syncthreads();
#undef KROW
#undef DMA_TILE
#undef WAIT_SYNC
#undef RESC
}
#undef SBAR
}

namespace scan {
constexpr int CH = 64;
constexpr int OFF_Q = 0, OFF_K = 32768, OFF_V = 65536, OFF_P = 98304, SHM_SCAN = 98304 + 8192;
__device__ __forceinline__ unsigned off_b(unsigned row, unsigned ch) { return 256u * row + 16u * (ch ^ (((row & 3) << 2) | ((row >> 2) & 3))); }
__device__ __forceinline__ unsigned p_off(unsigned i, unsigned chunk) { return 128u * i + 16u * (chunk ^ ((i >> 1) & 7)); }
__device__ __forceinline__ int crow(int r, int hi) { return (r & 3) + 8 * (r >> 2) + 4 * hi; }
__device__ __forceinline__ s16x4 vtr(const LAS char* p) { typedef short v4i16_t __attribute__((ext_vector_type(4))); return __builtin_bit_cast(s16x4, __builtin_amdgcn_ds_read_tr16_b64_v4i16((LAS v4i16_t*)p)); }
__device__ __forceinline__ bf16x8 tr_frag(const LAS char* img, int lane, int c, int ks) {
    const unsigned h = lane >> 5, blk = (lane >> 4) & 1, q = (lane & 15) >> 2, p = lane & 3;
    const unsigned r0 = 16 * ks + 8 * h + q, chn = 4 * c + 2 * blk + (p >> 1);
    const s16x4 lo = vtr(img + off_b(r0, chn) + 8 * (p & 1)), hi = vtr(img + off_b(r0 + 4, chn) + 8 * (p & 1));
    return (bf16x8){lo[0], lo[1], lo[2], lo[3], hi[0], hi[1], hi[2], hi[3]};
}
__device__ __forceinline__ bf16x8 pack_step(const f32x16& x, int s) {
    u32x4 p; p.x = cvt_pk_bf16(x[8 * s + 0], x[8 * s + 1]); p.y = cvt_pk_bf16(x[8 * s + 2], x[8 * s + 3]); p.z = cvt_pk_bf16(x[8 * s + 4], x[8 * s + 5]); p.w = cvt_pk_bf16(x[8 * s + 6], x[8 * s + 7]);
    return __builtin_bit_cast(bf16x8, p);
}
__device__ __forceinline__ void dma_mat(const bf16* src, int ld, LAS unsigned char* dst, int wid, int lane) {
    const char* sb = uni_ptr(src); const unsigned d0 = (unsigned)__builtin_amdgcn_readfirstlane((unsigned)(uintptr_t)dst + (unsigned)wid * 4096u);
#pragma unroll
    for (int k = 0; k < 4; ++k) { const int pc = wid * 4 + k, img = pc >> 4, row = 4 * (pc & 15) + (lane >> 4), pos = lane & 15;
        const int ch = pos ^ (((row & 3) << 2) | ((row >> 2) & 3));
        glds16_s(sb, (unsigned)((row * ld + img * 128 + ch * 8) * 2), d0 + (unsigned)k * 1024u); }
}
__device__ __forceinline__ void scan_unit(const bf16* __restrict__ QKV, bf16* __restrict__ Y, int b, int hd, int dir, int dvh, float lg2, bool skip_ctx_y, LAS unsigned char* lds) {
    int tid = threadIdx.x; asm volatile("" : "+v"(tid));
    const int wid = __builtin_amdgcn_readfirstlane(tid >> 6), lane0 = tid & 63;
    const LAS char* QI = (const LAS char*)lds + OFF_Q; const LAS char* KI = (const LAS char*)lds + OFF_K; const LAS char* VI = (const LAS char*)lds + OFF_V;
    LAS char* PI = (LAS char*)lds + OFF_P;
    f32x16 S[8];
#pragma unroll
    for (int i = 0; i < 8; ++i) S[i] = f32x16{};
    const float g64 = __builtin_amdgcn_exp2f(64.f * lg2);
    const int qcol = hd * RDK, kcol = 2048 + hd * RDK, vcol = 4096 + hd * RDV + dvh * 256;
    for (int n = 0; n < 68; ++n) {
        int lane = lane0; asm volatile("" : "+v"(lane));
        const int r = lane & 31, h = lane >> 5;
        const int ycol = hd * RDV + dvh * 256 + wid * 32 + r;
        int rowbase;
        if (n < 4) rowbase = MX + b * CTXL + (dir ? 3 - n : n) * CH; else rowbase = b * SEQ + (dir ? 67 - n : n - 4) * CH;
        const bf16* src = QKV + (size_t)rowbase * 8192;
        dma_mat(src + qcol, 8192, lds + OFF_Q, wid, lane); dma_mat(src + kcol, 8192, lds + OFF_K, wid, lane); dma_mat(src + vcol, 8192, lds + OFF_V, wid, lane);
        asm volatile("s_waitcnt vmcnt(0)" ::: "memory"); __syncthreads();
        if (wid < 4) {
            const int jb = wid >> 1, ib = wid & 1; f32x16 pt = f32x16{};
#pragma unroll
            for (int ks = 0; ks < 16; ++ks) { const int img = ks >> 3, s = ks & 7;
                const bf16x8 a = *(const LAS bf16x8*)(KI + img * 16384 + off_b(jb * 32 + r, 2 * s + h));
                const bf16x8 bq = *(const LAS bf16x8*)(QI + img * 16384 + off_b(ib * 32 + r, 2 * s + h));
                pt = __builtin_amdgcn_mfma_f32_32x32x16_bf16(a, bq, pt, 0, 0, 0); }
            const int i = ib * 32 + r;
#pragma unroll
            for (int g = 0; g < 4; ++g) { float v[4];
#pragma unroll
                for (int e = 0; e < 4; ++e) { const int j = jb * 32 + 8 * g + 4 * h + e; const int dd = dir ? (j - i) : (i - j);
                    v[e] = dd >= 0 ? pt[4 * g + e] * __builtin_amdgcn_exp2f((float)dd * lg2) : 0.f; }
                const int j0 = jb * 32 + 8 * g + 4 * h;
                u32x2 w; w.x = cvt_pk_bf16(v[0], v[1]); w.y = cvt_pk_bf16(v[2], v[3]);
                *(LAS u32x2*)(PI + p_off(i, j0 >> 3) + ((j0 >> 2) & 1) * 8) = w; }
        }
        f32x16 Yt[2]; Yt[0] = f32x16{}; Yt[1] = f32x16{};
#pragma unroll
        for (int dkb = 0; dkb < 8; ++dkb)
#pragma unroll
            for (int s = 0; s < 2; ++s) { const bf16x8 bf = pack_step(S[dkb], s);
                const int cl = (32 * dkb + 16 * s) & 127, img = dkb >> 2;
#pragma unroll
                for (int it = 0; it < 2; ++it) { const LAS char* rp = QI + img * 16384;
                    const s16x4 lo = *(const LAS s16x4*)(rp + off_b(it * 32 + r, cl >> 3) + 8 * h), hi4 = *(const LAS s16x4*)(rp + off_b(it * 32 + r, (cl >> 3) + 1) + 8 * h);
                    const bf16x8 af = (bf16x8){lo[0], lo[1], lo[2], lo[3], hi4[0], hi4[1], hi4[2], hi4[3]};
                    Yt[it] = __builtin_amdgcn_mfma_f32_32x32x16_bf16(af, bf, Yt[it], 0, 0, 0); } }
#pragma unroll
        for (int it = 0; it < 2; ++it)
#pragma unroll
            for (int rg = 0; rg < 16; ++rg) { const int i = it * 32 + crow(rg, h); const int tau = dir ? 63 - i : i; Yt[it][rg] *= __builtin_amdgcn_exp2f((float)(tau + 1) * lg2); }
        __syncthreads();
#pragma unroll
        for (int i = 0; i < 8; ++i)
#pragma unroll
            for (int rg = 0; rg < 16; ++rg) S[i][rg] *= g64;
#pragma unroll
        for (int ks = 0; ks < 4; ++ks) {
            const bf16x8 vf = tr_frag(VI + (wid >> 2) * 16384, lane, wid & 3, ks);
#pragma unroll
            for (int it = 0; it < 2; ++it) { const bf16x8 pa = *(const LAS bf16x8*)(PI + p_off(it * 32 + r, 2 * ks + h));
                Yt[it] = __builtin_amdgcn_mfma_f32_32x32x16_bf16(pa, vf, Yt[it], 0, 0, 0); }
            bf16x8 vz;
#pragma unroll
            for (int jj = 0; jj < 8; ++jj) { const int j = 16 * ks + 8 * h + jj; const int tau = dir ? 63 - j : j;
                const float f = __builtin_amdgcn_exp2f((float)(63 - tau) * lg2); vz[jj] = (short)(cvt_pk_bf16(bf2f((unsigned short)vf[jj]) * f, 0.f) & 0xffffu); }
#pragma unroll
            for (int dkb = 0; dkb < 8; ++dkb) { const bf16x8 ka = tr_frag(KI + (dkb >> 2) * 16384, lane, dkb & 3, ks);
                S[dkb] = __builtin_amdgcn_mfma_f32_32x32x16_bf16(ka, vz, S[dkb], 0, 0, 0); }
            __builtin_amdgcn_sched_barrier(0);
        }
        if (!(skip_ctx_y && n < 4)) {
#pragma unroll
            for (int it = 0; it < 2; ++it)
#pragma unroll
                for (int rg = 0; rg < 16; ++rg) { const int i = it * 32 + crow(rg, h);
                    Y[(size_t)(rowbase + i) * 4096 + ycol] = (bf16)(cvt_pk_bf16(Yt[it][rg], 0.f) & 0xffffu); }
        }
        __syncthreads();
    }
}
}

#define XB_TMO      128
#define XB_XCNT(j)  (256  + 64 * (j))
#define XB_XSUB(j)  (1280 + 64 * (j))
#define XB_XGEN(j)  (2304 + 64 * (j))
#define XB_TOP      3328
#define XB_TOPGEN   3392
#define XCD_BAR_WORDS 3456
#define XB_SPIN_CAP (1u << 22)
__device__ __forceinline__ unsigned xb_ld(unsigned* p)              { return __hip_atomic_load(p, __ATOMIC_RELAXED, __HIP_MEMORY_SCOPE_AGENT); }
__device__ __forceinline__ unsigned xb_add(unsigned* p, unsigned v) { return __hip_atomic_fetch_add(p, v, __ATOMIC_RELAXED, __HIP_MEMORY_SCOPE_AGENT); }
__device__ __forceinline__ unsigned xb_xcc_id() { return (unsigned)__builtin_amdgcn_s_getreg((3 << 11) | 20) & 0xFu; }
#define XB_SPIN(cond, bar) do { unsigned _sp = 0; while (cond) { __builtin_amdgcn_s_sleep(1); \
    if ((++_sp & 255u) == 0u) { if (xb_ld(&(bar)[XB_TMO])) break; if (_sp > XB_SPIN_CAP) { atomicAdd(&(bar)[XB_TMO], 1u); break; } } } } while (0)
struct XcdBarrier { unsigned* bar; unsigned x; volatile LAS unsigned* st; };
__device__ __forceinline__ XcdBarrier xcd_barrier_post(unsigned* bar, volatile LAS unsigned* st) {
    XcdBarrier b; b.bar = bar; b.x = xb_xcc_id(); b.st = st;
    if (threadIdx.x == 0) (void)xb_add(&bar[XB_XCNT(b.x)], 1u);
    return b;
}
__device__ __forceinline__ void xcd_barrier_complete(unsigned* bar, unsigned x, unsigned& nloc, unsigned& nx) {
    const unsigned G = gridDim.x * gridDim.y * gridDim.z;
    unsigned sum, cnt, mine, sp = 0u;
    for (;;) {
        sum = 0u; cnt = 0u; mine = 0u;
#pragma unroll
        for (unsigned j = 0; j < 16; ++j) { const unsigned c = xb_ld(&bar[XB_XCNT(j)]); sum += c; cnt += (c > 0u) ? 1u : 0u; mine = (j == x) ? c : mine; }
        if (sum == G) break;
        __builtin_amdgcn_s_sleep(1);
        if ((++sp & 255u) == 0u) { if (xb_ld(&bar[XB_TMO])) break; if (sp > XB_SPIN_CAP) { atomicAdd(&bar[XB_TMO], 1u); break; } }
    }
    nloc = mine > 0u ? mine : 1u; nx = cnt > 0u ? cnt : 1u;
}
__device__ __forceinline__ void xcd_barrier(const XcdBarrier& b) {
    asm volatile("s_waitcnt vmcnt(0)" ::: "memory");
    __syncthreads();
    if (threadIdx.x == 0) {
        unsigned* bar = b.bar; asm volatile("" : "+s"(bar));
        __builtin_amdgcn_s_waitcnt(0);
        unsigned nloc = b.st[0], nx = b.st[1];
        if (nloc == 0u) { xcd_barrier_complete(bar, b.x, nloc, nx); b.st[0] = nloc; b.st[1] = nx; }
        const unsigned old = xb_add(&bar[XB_XSUB(b.x)], 1u);
        const unsigned gen = old / nloc;
        if (old + 1u == (gen + 1u) * nloc) {
            __builtin_amdgcn_fence(__ATOMIC_RELEASE, "agent");
            asm volatile("s_waitcnt vmcnt(0)" ::: "memory");
            const unsigned og = xb_add(&bar[XB_TOP], 1u);
            const unsigned tg = og / nx;
            if (og + 1u == (tg + 1u) * nx) xb_add(&bar[XB_TOPGEN], 1u);
            else XB_SPIN(xb_ld(&bar[XB_TOPGEN]) == tg, bar);
            __builtin_amdgcn_fence(__ATOMIC_ACQUIRE, "agent");
            xb_add(&bar[XB_XGEN(b.x)], 1u);
            asm volatile("s_waitcnt vmcnt(0)" ::: "memory");
        } else {
            XB_SPIN(xb_ld(&bar[XB_XGEN(b.x)]) == gen, bar);
            __builtin_amdgcn_fence(__ATOMIC_ACQUIRE, "agent");
            asm volatile("s_waitcnt vmcnt(0)" ::: "memory");
        }
    }
    __syncthreads();
}

__device__ __forceinline__ float wave_sum(float v, int lane) {
#pragma unroll
    for (int o = 1; o < 64; o <<= 1) v += shfl_xor_l(v, o, lane);
    return v;
}
__device__ __forceinline__ void cvt_item(const float* colptr, int ldw, int k0, bf16* WTrow0, int K, const float* kscale, float gscale, LAS float* scr, int lane) {
#pragma unroll 16
    for (int i = 0; i < 32; ++i) { const int kk = 2 * i + (lane >> 5); float v = colptr ? colptr[(size_t)(k0 + kk) * ldw] : 0.f;
        if (kscale) v *= kscale[k0 + kk];
        scr[kk * 33 + (lane & 31)] = v * gscale; }
    asm volatile("s_waitcnt lgkmcnt(0)" ::: "memory");
    const int c = lane & 7;
#pragma unroll
    for (int j = 0; j < 4; ++j) { const int n = (lane >> 3) + 8 * j; const LAS float* s = scr + (8 * c) * 33 + n;
        u32x4 o; o.x = cvt_pk_bf16(s[0 * 33], s[1 * 33]); o.y = cvt_pk_bf16(s[2 * 33], s[3 * 33]); o.z = cvt_pk_bf16(s[4 * 33], s[5 * 33]); o.w = cvt_pk_bf16(s[6 * 33], s[7 * 33]);
        *(u32x4*)(WTrow0 + (size_t)n * K + k0 + 8 * c) = o; }
    asm volatile("s_waitcnt lgkmcnt(0)" ::: "memory");
}
__device__ __forceinline__ int ropeperm64(int c) { const int p = c >> 1, e = c & 1; return (p < 16) ? (p + 16 * e) : (32 + (p - 16) + 16 * e); }
__device__ __forceinline__ const float* src_col(int kind, const float* W0, const float* W1, int aux, int n) {
    switch (kind) {
        case 0: return W0 + aux + n;
        case 1: return W0 + aux + ropeperm64(n);
        case 2: { const int hh = n / DQ, d = n % DQ; return W0 + hh * DQ + (d < NOPE ? d : NOPE + ropeperm64(d - NOPE)); }
        case 3: { const int hh = n >> 8, d = n & 255; return W0 + hh * 256 + (d >> 1) + 128 * (d & 1); }
        case 4: { const int tl = n >> 8, j = n & 255; return (j < 128 ? W0 : W1) + tl * 128 + (j & 127); }
        default: return nullptr;
    }
}
struct CvtJob { const float* W0; const float* W1; const float* kscale; bf16* WT; int ldw, K, nrows, kind, aux; float gscale; };
__device__ __forceinline__ bool cvt_try(const CvtJob& J, int& it, LAS float* scr, int lane) {
    const int nblk = J.nrows / 32, items = (J.K / 64) * nblk;
    if (it >= items) { it -= items; return false; }
    const int kb = it / nblk, nb = it % nblk;
    const float* cp = src_col(J.kind, J.W0, J.W1, J.aux, nb * 32 + (lane & 31));
    cvt_item(cp, J.ldw, kb * 64, J.WT + (size_t)(nb * 32) * J.K, J.K, J.kscale, J.gscale, scr, lane);
    return true;
}
__device__ __forceinline__ int cvt_items(const CvtJob& J) { return (J.K / 64) * (J.nrows / 32); }

__device__ __forceinline__ void norm_mod_row(const float* xrow, const float* g, const float* sc, const float* sh, bf16* orow, int lane) {
    f32x4 v[8]; float s = 0.f;
#pragma unroll
    for (int j = 0; j < 8; ++j) { v[j] = *(const f32x4*)(xrow + 4 * lane + 256 * j); s += (v[j][0] * v[j][0] + v[j][1] * v[j][1]) + (v[j][2] * v[j][2] + v[j][3] * v[j][3]); }
    const float rstd = 1.0f / sqrtf(wave_sum(s, lane) * (1.0f / D) + NORM_EPS);
#pragma unroll
    for (int j = 0; j < 8; ++j) { const int c = 4 * lane + 256 * j; const f32x4 gg = *(const f32x4*)(g + c), s1 = *(const f32x4*)(sc + c), s0 = *(const f32x4*)(sh + c);
        const f32x4 y = (v[j] * rstd) * gg * (1.0f + s1) + s0;
        u32x2 w; w.x = cvt_pk_bf16(y[0], y[1]); w.y = cvt_pk_bf16(y[2], y[3]); *(u32x2*)(orow + c) = w; }
}

__device__ __forceinline__ unsigned long long ld_arg(LAS unsigned char* lds, int i) {
    const volatile LAS unsigned* p = (const volatile LAS unsigned*)(lds + ARGS_OFF) + 2 * i;
    const unsigned lo = __builtin_amdgcn_readfirstlane(p[0]), hi = __builtin_amdgcn_readfirstlane(p[1]);
    return ((unsigned long long)hi << 32) | lo;
}
struct Args { const float* in[29]; float* out; unsigned char* ws; int ph_lo, ph_hi; };
constexpr int PH_PER_LAYER = 10, PH_FINAL = 1 + PH_PER_LAYER * DEPTH, PH_COUNT = PH_FINAL + 1;

template <unsigned MK_EN_T>
__global__ void __launch_bounds__(512, 2) mk_fwd(Args args) {
    extern __shared__ __attribute__((aligned(16))) unsigned char lds_raw[];
    LAS unsigned char* lds = (LAS unsigned char*)lds_raw;
    volatile LAS unsigned* MISC = (volatile LAS unsigned*)(lds + MISC_OFF);
    const int G = gridDim.x; const int bx = blockIdx.x; const int vcu = (G % 8 == 0) ? (bx % 8) * (G / 8) + bx / 8 : bx;
    const int NGW = G * 8;
    unsigned char* ws = args.ws; float* X = args.out;
    const int lo = args.ph_lo, hi = args.ph_hi;
    { const int tid0 = threadIdx.x;
      for (int u = tid0; u < (LDS_BYTES - RING_BYTES) / 4; u += 512) ((LAS unsigned*)(lds + RING_BYTES))[u] = 0u;
      __syncthreads();
      if (tid0 < 29) ((volatile LAS unsigned long long*)(lds + ARGS_OFF))[tid0] = (unsigned long long)args.in[tid0];
      __syncthreads(); }
#define ARGF(i) ((const float*)ld_arg(lds, (i)))
    XcdBarrier bar; bar.bar = (unsigned*)(ws + WS_CTL) + CW_BAR; bar.x = 0; bar.st = nullptr;
    if (hi - lo > 1) bar = xcd_barrier_post((unsigned*)(ws + WS_CTL) + CW_BAR, MISC + 8);
#define EN(b) (((MK_EN_T) >> (b)) & 1u)
#define IN(k) (lo <= (k) && (k) < hi)
#define PHASE_END(k) do { if (hi > (k) + 1) xcd_barrier(bar); } while (0)
#define PH_IDS int tid = threadIdx.x; asm volatile("" : "+v"(tid)); const int lane = tid & 63; const int wave = __builtin_amdgcn_readfirstlane(tid >> 6); const int gw = vcu * 8 + wave; (void)lane; (void)gw;
#define XC_    ((float*)(ws + WS_XC))
#define MODV_  ((float*)(ws + WS_MODV))
#define TABM_  ((float*)(ws + WS_TABM))
#define TABR_  ((float*)(ws + WS_TABR))
#define SSQ_   ((float*)(ws + WS_SSQ))
#define KR_    ((bf16*)(ws + WS_KR))
#define H_     ((bf16*)(ws + WS_H))
#define WB_    ((bf16*)(ws + WS_W))
#define W1T_   WB_
#define WUQT_  (WB_ + (size_t)N1 * D)
#define WUKVT_ (WUQT_ + (size_t)3072 * 512)
#define WOTM_  (WUKVT_ + (size_t)4096 * 512)
#define WQKVT_ WB_
#define WGT_   (WB_ + (size_t)8192 * D)
#define WOTR_  (WGT_ + (size_t)8192 * D)
#define WGUT_  ((bf16*)(ws + WS_WFFN))
#define WDT_   (WGUT_ + (size_t)11264 * D)
#define QKVL_  ((bf16*)(ws + WS_QKVL))
#define Q_     ((bf16*)(ws + WS_Q))
#define KV_    ((bf16*)(ws + WS_KV))
#define O_     ((bf16*)(ws + WS_O))
#define QKV_   ((bf16*)(ws + WS_QKV))
#define Y_     ((bf16*)(ws + WS_Y))
#define GATED_ ((bf16*)(ws + WS_GATED))
#define GB_    ((bf16*)(ws + WS_G))
#define UB_    ((bf16*)(ws + WS_U))
#define HALO_  ((float*)(ws + WS_G))
#define MODL_  (MODV_ + (size_t)l * 9 * NMOD)

    if (EN(0) && IN(0)) for (int rep_ = 0; rep_ < 1 + (int)((PROBE_MASK >> 0) & 1u); ++rep_) {
        PH_IDS
        LAS float* cond = (LAS float*)lds;
        LAS float* red = (LAS float*)(lds + 73728);
        { const float* cin = ARGF(1); const float* cc = ARGF(3);
          for (int i = tid; i < 9 * D; i += 512) { const int r = i >> 11, k = i & (D - 1); const float c = (r < 8) ? cin[r * D + k] : cc[k]; cond[i] = c / (1.0f + __expf(-c)); } }
        __syncthreads();
        for (int it = bx; it < DEPTH * 96; it += G) {
            const int l = it / 96, cb = it % 96; const int n = cb * 128 + 2 * lane;
            const float* W = ARGF(4) + (size_t)l * D * NMOD + n; const float* mb = ARGF(5) + (size_t)l * NMOD + cb * 128;
            float a0[9], a1[9];
#pragma unroll
            for (int r = 0; r < 9; ++r) { a0[r] = 0.f; a1[r] = 0.f; }
            for (int k = wave * 256; k < wave * 256 + 256; k += 4) {
                f32x2 w[4];
#pragma unroll
                for (int q = 0; q < 4; ++q) w[q] = *(const f32x2*)(W + (size_t)(k + q) * NMOD);
#pragma unroll
                for (int r = 0; r < 9; ++r) { const f32x4 c4 = *(const LAS f32x4*)(cond + r * D + k);
#pragma unroll
                    for (int q = 0; q < 4; ++q) { a0[r] += c4[q] * w[q][0]; a1[r] += c4[q] * w[q][1]; } }
            }
#pragma unroll
            for (int r = 0; r < 9; ++r) { red[(wave * 9 + r) * 128 + 2 * lane] = a0[r]; red[(wave * 9 + r) * 128 + 2 * lane + 1] = a1[r]; }
            __syncthreads();
            for (int i = tid; i < 9 * 128; i += 512) { const int r = i >> 7, cc = i & 127; float s = 0.f;
#pragma unroll
                for (int w8 = 0; w8 < 8; ++w8) s += red[(w8 * 9 + r) * 128 + cc];
                MODV_[((size_t)l * 9 + r) * NMOD + cb * 128 + cc] = s + mb[cc]; }
            __syncthreads();
        }
        for (int i = bx * 512 + tid; i < 64 * 16 + SEQ * 128; i += G * 512) {
            float inv, pos; float* dst;
            if (i < 1024) { const int p = i >> 4, f = i & 15; inv = __builtin_amdgcn_exp2f(-(float)(2 * f) * (13.287712379549449f / 32.0f)); pos = (float)p; dst = TABM_ + 2 * i; }
            else { const int j = i - 1024, t = j >> 7, f = j & 127; inv = __builtin_amdgcn_exp2f(-(float)(2 * f) * (13.287712379549449f / 256.0f)); pos = (float)t; dst = TABR_ + 2 * j; }
            const float ang = pos * inv; const double rev = (double)ang * 0.15915494309189535; const float fr = (float)(rev - floor(rev));
            dst[0] = __builtin_amdgcn_cosf(fr); dst[1] = __builtin_amdgcn_sinf(fr);
        }
        PHASE_END(0);
    }

    for (int l = 0; l < DEPTH; ++l) {
        const int P = 1 + PH_PER_LAYER * l; const int li = l >> 1; const bool is_ret = (l & 1) != 0; const bool last = (l == DEPTH - 1);
        const int Mrows = last ? MX : MT;

        if (EN(1) && IN(P + 0)) for (int rep_ = 0; rep_ < 1 + (int)((PROBE_MASK >> 1) & 1u); ++rep_) {
            PH_IDS
            LAS float* scr = (LAS float*)(lds + wave * 16384);
            CvtJob J[7]; int nj;
            if (!is_ret) {
                const float* wdq = ARGF(8) + (size_t)li * D * QR; const float* wdkv = ARGF(11) + (size_t)li * D * (KVR + ROPE);
                J[0] = CvtJob{wdq, nullptr, nullptr, W1T_, QR, D, 512, 0, 0, 1.f};
                J[1] = CvtJob{wdkv, nullptr, nullptr, W1T_ + (size_t)512 * D, KVR + ROPE, D, 512, 0, 0, 1.f};
                J[2] = CvtJob{wdkv, nullptr, nullptr, W1T_ + (size_t)1024 * D, KVR + ROPE, D, 64, 1, 512, 1.f};
                J[3] = CvtJob{nullptr, nullptr, nullptr, W1T_ + (size_t)1088 * D, 1, D, 192, 5, 0, 1.f};
                J[4] = CvtJob{ARGF(10) + (size_t)li * QR * 3072, nullptr, ARGF(9) + li * QR, WUQT_, 3072, QR, 3072, 2, 0, 0.07216878364870322f * LOG2E};
                J[5] = CvtJob{ARGF(13) + (size_t)li * KVR * 4096, nullptr, ARGF(12) + li * KVR, WUKVT_, 4096, KVR, 4096, 0, 0, 1.f};
                J[6] = CvtJob{ARGF(14) + (size_t)li * D * D, nullptr, nullptr, WOTM_, D, D, D, 0, 0, 1.f};
                nj = 7;
            } else {
                J[0] = CvtJob{ARGF(15) + (size_t)li * D * D, nullptr, nullptr, WQKVT_, D, D, 2048, 3, 0, 1.f};
                J[1] = CvtJob{ARGF(16) + (size_t)li * D * D, nullptr, nullptr, WQKVT_ + (size_t)2048 * D, D, D, 2048, 3, 0, 0.0625f};
                J[2] = CvtJob{ARGF(17) + (size_t)li * D * 4096, nullptr, nullptr, WQKVT_ + (size_t)4096 * D, 4096, D, 4096, 0, 0, 1.f};
                J[3] = CvtJob{ARGF(18) + (size_t)li * D * 4096, ARGF(19) + (size_t)li * D * 4096, nullptr, WGT_, 4096, D, 8192, 4, 0, 1.f};
                J[4] = CvtJob{ARGF(20) + (size_t)li * 4096 * D, nullptr, nullptr, WOTR_, D, 4096, D, 0, 0, 1.f};
                J[5] = CvtJob{nullptr, nullptr, nullptr, nullptr, 1, 64, 0, 5, 0, 1.f};
                J[6] = J[5];
                nj = 5;
            }
            CvtJob F0 = CvtJob{ARGF(23) + (size_t)l * D * FF, ARGF(24) + (size_t)l * D * FF, nullptr, WGUT_, FF, D, 11264, 4, 0, 1.f};
            CvtJob F1 = CvtJob{ARGF(27) + (size_t)l * FF * D, nullptr, nullptr, WDT_, D, FF, D, 0, 0, 1.f};
            int total = cvt_items(F0) + cvt_items(F1);
#pragma unroll
            for (int j = 0; j < 7; ++j) if (j < nj) total += cvt_items(J[j]);
            for (int it0 = gw; it0 < total; it0 += NGW) {
                int it = it0; bool done = false;
#pragma unroll
                for (int j = 0; j < 7; ++j) if (!done && j < nj) done = cvt_try(J[j], it, scr, lane);
                if (!done) done = cvt_try(F0, it, scr, lane);
                if (!done) done = cvt_try(F1, it, scr, lane);
            }
            const float* g = ARGF(6) + l * D; const float* xsrc = (l == 0) ? ARGF(0) : X; const float* csrc = (l == 0) ? ARGF(2) : XC_;
            for (int m = gw; m < MT; m += NGW) { const bool isx = m < MX; const float* mr = MODL_ + (size_t)(isx ? (m >> 12) : 8) * NMOD;
                norm_mod_row(isx ? xsrc + (size_t)m * D : csrc + (size_t)(m - MX) * D, g, mr + D, mr, H_ + (size_t)m * D, lane); }
            PHASE_END(P + 0);
        }

        if (!is_ret) {
            if (EN(2) && IN(P + 1)) for (int rep_ = 0; rep_ < 1 + (int)((PROBE_MASK >> 2) & 1u); ++rep_) {
                pg8::Gemm g{H_, W1T_, MT, N1, D, D}; pg8::StaticOrder S; S.init(MT, N1, G, bx);
                EpiG1 E{QKVL_, SSQ_, KR_, TABM_};
                pg8::gemm_phase<EpiG1>(lds, g, S, E);
                PHASE_END(P + 1);
            }
            if (EN(3) && IN(P + 2)) for (int rep_ = 0; rep_ < 1 + (int)((PROBE_MASK >> 3) & 1u); ++rep_) {
                { pg8::Gemm g{QKVL_, WUQT_, MT, 3072, QR, N1}; pg8::StaticOrder S; S.init(MT, 3072, G, bx); EpiUq E{Q_, SSQ_, TABM_}; pg8::gemm_phase<EpiUq>(lds, g, S, E); }
                { pg8::Gemm g{QKVL_ + 512, WUKVT_, MT, 4096, KVR, N1}; pg8::StaticOrder S; S.init(MT, 4096, G, bx); EpiUkv E{KV_, SSQ_}; pg8::gemm_phase<EpiUkv>(lds, g, S, E); }
                PHASE_END(P + 2);
            }
            if (EN(4) && IN(P + 3)) for (int rep_ = 0; rep_ < 1 + (int)((PROBE_MASK >> 4) & 1u); ++rep_) {
                const int nun = 2048 + 128;
                for (int ui = vcu; ui < nun; ui += G) {
                    if (ui < 2048) { const int xcd = (ui & 255) >> 5, j = ui & 31, rnd = ui >> 8; const int bh = xcd * 16 + 2 * rnd + (j >> 4), qb = j & 15; const int b = bh >> 4, hd = bh & 15;
                        att::attn_unit(Q_ + (size_t)(b * SEQ + qb * 256) * 3072 + hd * DQ, KV_ + hd * 256, KR_, O_ + (size_t)(b * SEQ + qb * 256) * D + hd * 128, 68, 4, MX + b * CTXL, b * SEQ, (char*)lds_raw);
                    } else { const int bh = ui - 2048, b = bh >> 4, hd = bh & 15;
                        att::attn_unit(Q_ + (size_t)(MX + b * CTXL) * 3072 + hd * DQ, KV_ + hd * 256, KR_, O_ + (size_t)(MX + b * CTXL) * D + hd * 128, 4, 4, MX + b * CTXL, 0, (char*)lds_raw); }
                }
                PHASE_END(P + 3);
            }
        } else {
            if (EN(5) && IN(P + 1)) for (int rep_ = 0; rep_ < 1 + (int)((PROBE_MASK >> 5) & 1u); ++rep_) {
                pg8::Gemm g{H_, WQKVT_, MT, 8192, D, D}; pg8::StaticOrder S; S.init(MT, 8192, G, bx);
                EpiQKV E{QKV_, TABR_};
                pg8::gemm_phase<EpiQKV>(lds, g, S, E);
                PHASE_END(P + 1);
            }
            if (EN(6) && IN(P + 2)) for (int rep_ = 0; rep_ < 1 + (int)((PROBE_MASK >> 6) & 1u); ++rep_) {
                for (int ui = vcu; ui < 256; ui += G) {
                    const int bh = ui >> 2, dir = (ui >> 1) & 1, dvh = ui & 1; const int b = bh >> 3, hd = bh & 7;
                    const float dec = (dir ? ARGF(22) : ARGF(21))[li * RH + hd];
                    const float lg2 = -__expf(dec) * LOG2E;
                    scan::scan_unit(QKV_, Y_ + (size_t)dir * MT * 4096, b, hd, dir, dvh, lg2, last, lds);
                }
                PHASE_END(P + 2);
            }
            if (EN(7) && IN(P + 3)) for (int rep_ = 0; rep_ < 1 + (int)((PROBE_MASK >> 7) & 1u); ++rep_) {
                PH_IDS
                const int nitems = Mrows * RH * 2;
                for (int it = gw; it < nitems; it += NGW) { const int dir = it & 1, hd = (it >> 1) & 7, row = it >> 4;
                    bf16* p = Y_ + (size_t)dir * MT * 4096 + (size_t)row * 4096 + hd * RDV + lane * 8;
                    const u32x4 w = *(const u32x4*)p; float v[8] = {bflo(w.x), bfhi(w.x), bflo(w.y), bfhi(w.y), bflo(w.z), bfhi(w.z), bflo(w.w), bfhi(w.w)};
                    float s = 0.f;
#pragma unroll
                    for (int e = 0; e < 8; ++e) s += v[e];
                    const float mu = wave_sum(s, lane) * (1.0f / RDV); float q = 0.f;
#pragma unroll
                    for (int e = 0; e < 8; ++e) { v[e] -= mu; q += v[e] * v[e]; }
                    const float rstd = 1.0f / sqrtf(wave_sum(q, lane) * (1.0f / RDV) + GN_EPS);
                    u32x4 o; o.x = cvt_pk_bf16(v[0] * rstd, v[1] * rstd); o.y = cvt_pk_bf16(v[2] * rstd, v[3] * rstd); o.z = cvt_pk_bf16(v[4] * rstd, v[5] * rstd); o.w = cvt_pk_bf16(v[6] * rstd, v[7] * rstd);
                    *(u32x4*)p = o; }
                PHASE_END(P + 3);
            }
            if (EN(8) && IN(P + 4)) for (int rep_ = 0; rep_ < 1 + (int)((PROBE_MASK >> 8) & 1u); ++rep_) {
                pg8::Gemm g{H_, WGT_, Mrows, 8192, D, D}; pg8::StaticOrder S; S.init(Mrows, 8192, G, bx);
                EpiGate E{GATED_, Y_, Y_ + (size_t)MT * 4096};
                pg8::gemm_phase<EpiGate>(lds, g, S, E);
                PHASE_END(P + 4);
            }
        }
        if (EN(9) && IN(P + 5)) for (int rep_ = 0; rep_ < 1 + (int)((PROBE_MASK >> 9) & 1u); ++rep_) {
            pg8::Gemm g = is_ret ? pg8::Gemm{GATED_, WOTR_, Mrows, D, 4096, 4096} : pg8::Gemm{O_, WOTM_, Mrows, D, D, D};
            pg8::StaticOrder S; S.init(Mrows, D, G, bx);
            const float* xsrc = (l == 0) ? ARGF(0) : X; const float* csrc = (l == 0) ? ARGF(2) : XC_;
            EpiResid E{xsrc, X, csrc, XC_, MODL_, 2 * D};
            pg8::gemm_phase<EpiResid>(lds, g, S, E);
            PHASE_END(P + 5);
        }
        if (EN(10) && IN(P + 6)) for (int rep_ = 0; rep_ < 1 + (int)((PROBE_MASK >> 10) & 1u); ++rep_) {
            PH_IDS
            const float* g = ARGF(7) + l * D;
            for (int m = gw; m < Mrows; m += NGW) { const bool isx = m < MX; const float* mr = MODL_ + (size_t)(isx ? (m >> 12) : 8) * NMOD;
                norm_mod_row(isx ? X + (size_t)m * D : XC_ + (size_t)(m - MX) * D, g, mr + 4 * D, mr + 3 * D, H_ + (size_t)m * D, lane); }
            PHASE_END(P + 6);
        }
        if (EN(11) && IN(P + 7)) for (int rep_ = 0; rep_ < 1 + (int)((PROBE_MASK >> 11) & 1u); ++rep_) {
            pg8::Gemm g{H_, WGUT_, Mrows, 11264, D, D}; pg8::StaticOrder S; S.init(Mrows, 11264, G, bx);
            EpiGUConv E{UB_, HALO_, ARGF(25) + (size_t)l * 3 * FF, ARGF(26) + (size_t)l * FF, (LAS float*)(lds + EDGE_OFF)};
            pg8::gemm_phase<EpiGUConv>(lds, g, S, E);
            PHASE_END(P + 7);
        }
        if (EN(12) && IN(P + 8)) for (int rep_ = 0; rep_ < 1 + (int)((PROBE_MASK >> 12) & 1u); ++rep_) {
            PH_IDS
            const float* cw = ARGF(25) + (size_t)l * 3 * FF; const float* cb = ARGF(26) + (size_t)l * FF; (void)cb;
            const float* HL = HALO_; bf16* ACT = UB_;
            const int nq = FF / 4;
            for (int i = bx * 512 + tid; i < 120 * nq; i += G * 512) {
                const int bi = i / nq, f = (i % nq) * 4; const int pm = (bi / 15) * 16 + (bi % 15) + 1;
                const float* top = HL + (size_t)((pm * 2 + 0) * 3) * HALO_STRIDE + f; const float* bot = HL + (size_t)(((pm - 1) * 2 + 1) * 3) * HALO_STRIDE + f;
                const f32x4 ct = *(const f32x4*)top, gt = *(const f32x4*)(top + HALO_STRIDE), ut = *(const f32x4*)(top + 2 * HALO_STRIDE);
                const f32x4 cbm = *(const f32x4*)bot, gb = *(const f32x4*)(bot + HALO_STRIDE), ub = *(const f32x4*)(bot + 2 * HALO_STRIDE);
                const f32x4 w0 = *(const f32x4*)(cw + f), w2 = *(const f32x4*)(cw + 2 * FF + f);
                const f32x4 ot = silu4(ct + w0 * gb) * ut, ob = silu4(cbm + w2 * gt) * ub;
                u32x2 wt, wb; wt.x = cvt_pk_bf16(ot[0], ot[1]); wt.y = cvt_pk_bf16(ot[2], ot[3]); wb.x = cvt_pk_bf16(ob[0], ob[1]); wb.y = cvt_pk_bf16(ob[2], ob[3]);
                *(u32x2*)(ACT + (size_t)(pm * 256) * FF + f) = wt; *(u32x2*)(ACT + (size_t)(pm * 256 - 1) * FF + f) = wb;
            }
            PHASE_END(P + 8);
        }
        if (EN(13) && IN(P + 9)) for (int rep_ = 0; rep_ < 1 + (int)((PROBE_MASK >> 13) & 1u); ++rep_) {
            pg8::Gemm g{UB_, WDT_, Mrows, D, FF, FF}; pg8::StaticOrder S; S.init(Mrows, D, G, bx);
            EpiResid E{X, X, XC_, XC_, MODL_, 5 * D};
            pg8::gemm_phase<EpiResid>(lds, g, S, E);
            PHASE_END(P + 9);
        }
    }
    if (EN(14) && IN(PH_FINAL)) for (int rep_ = 0; rep_ < 1 + (int)((PROBE_MASK >> 14) & 1u); ++rep_) {
        PH_IDS
        const float* g = ARGF(28);
        for (int m = gw; m < MX; m += NGW) { float* xr = X + (size_t)m * D;
            f32x4 v[8]; float s = 0.f;
#pragma unroll
            for (int j = 0; j < 8; ++j) { v[j] = *(const f32x4*)(xr + 4 * lane + 256 * j); s += (v[j][0] * v[j][0] + v[j][1] * v[j][1]) + (v[j][2] * v[j][2] + v[j][3] * v[j][3]); }
            const float rstd = 1.0f / sqrtf(wave_sum(s, lane) * (1.0f / D) + NORM_EPS);
#pragma unroll
            for (int j = 0; j < 8; ++j) { const int c = 4 * lane + 256 * j; *(f32x4*)(xr + c) = (v[j] * rstd) * *(const f32x4*)(g + c); } }
    }
#undef IN
#undef PHASE_END
}

#if !MK_SINGLE
typedef void (*KernFn)(Args);
static KernFn phase_kernel(int bit) {
    switch (bit) {
        case 0: return mk_fwd<1u << 0>;  case 1: return mk_fwd<1u << 1>;  case 2: return mk_fwd<1u << 2>;  case 3: return mk_fwd<1u << 3>;
        case 4: return mk_fwd<1u << 4>;  case 5: return mk_fwd<1u << 5>;  case 6: return mk_fwd<1u << 6>;  case 7: return mk_fwd<1u << 7>;
        case 8: return mk_fwd<1u << 8>;  case 9: return mk_fwd<1u << 9>;  case 10: return mk_fwd<1u << 10>; case 11: return mk_fwd<1u << 11>;
        case 12: return mk_fwd<1u << 12>; case 13: return mk_fwd<1u << 13>; default: return mk_fwd<1u << 14>;
    }
}
static int phase_bit(int p) {
    if (p == 0) return 0; if (p == PH_FINAL) return 14;
    const int l = (p - 1) / PH_PER_LAYER, slot = (p - 1) % PH_PER_LAYER; const bool ret = (l & 1) != 0;
    if (slot == 0) return 1;
    if (slot >= 5) return 4 + slot;
    if (!ret) return slot == 4 ? -1 : 1 + slot;
    return 4 + slot;
}
#endif
extern "C" void kernel_launch(void* const* d_in, const int* in_sizes, int n_in, void* d_out, int out_size, void* d_ws, size_t ws_size, hipStream_t stream) {
    static int grid = 0;
    if (grid == 0) {
        if (n_in != 29 || out_size != MX * D || ws_size < WS_END) { fprintf(stderr, "kernel_launch: unexpected shapes: n_in %d out %d ws %zu (need %zu)\n", n_in, out_size, ws_size, (size_t)WS_END); grid = -1; return; }
        int dev = 0, cus = 0;
        if (hipGetDevice(&dev) != hipSuccess || hipDeviceGetAttribute(&cus, hipDeviceAttributeMultiprocessorCount, dev) != hipSuccess) { grid = -1; return; }
#if MK_SINGLE
        if (hipFuncSetAttribute((const void*)mk_fwd<0xFFFFFFFFu>, hipFuncAttributeMaxDynamicSharedMemorySize, LDS_BYTES) != hipSuccess) { fprintf(stderr, "kernel_launch: hipFuncSetAttribute failed\n"); grid = -1; return; }
#else
        for (int b = 0; b < 15; ++b) if (hipFuncSetAttribute((const void*)phase_kernel(b), hipFuncAttributeMaxDynamicSharedMemorySize, LDS_BYTES) != hipSuccess) { fprintf(stderr, "kernel_launch: hipFuncSetAttribute failed\n"); grid = -1; return; }
#endif
        (void)hipGetLastError();
        grid = cus;
    }
    if (grid < 0) return;
    if (hipMemsetAsync((char*)d_ws + WS_CTL, 0, CTL_BYTES, stream) != hipSuccess) return;
    Args a{};
    for (int i = 0; i < 29; ++i) a.in[i] = (const float*)d_in[i];
    a.out = (float*)d_out; a.ws = (unsigned char*)d_ws;
#if MK_SINGLE
    a.ph_lo = 0; a.ph_hi = PH_COUNT;
    hipLaunchKernelGGL(mk_fwd<0xFFFFFFFFu>, dim3(grid), dim3(512), LDS_BYTES, stream, a);
#else
    for (int p = 0; p < PH_COUNT; ++p) {
        const int bit = phase_bit(p); if (bit < 0) continue;
        a.ph_lo = p; a.ph_hi = p + 1;
        hipLaunchKernelGGL(phase_kernel(bit), dim3(grid), dim3(512), LDS_BYTES, stream, a);
    }
#endif
    const hipError_t le = hipPeekAtLastError();
    if (le != hipSuccess) fprintf(stderr, "kernel_launch: launch failed: %s\n", hipGetErrorName(le));
}
```

```cpp
#include <hip/hip_runtime.h>
#include <cstdio>
#include <cstdint>

#ifndef MK_SINGLE
#define MK_SINGLE 1
#endif

#ifndef PROBE_MASK
#define PROBE_MASK 0u
#endif
#define GAS __attribute__((address_space(1)))
#define LAS __attribute__((address_space(3)))
typedef unsigned short bf16;
typedef short bf16x8 __attribute__((ext_vector_type(8)));
typedef short s16x4 __attribute__((ext_vector_type(4)));
typedef float f32x2 __attribute__((ext_vector_type(2)));
typedef float f32x4 __attribute__((ext_vector_type(4)));
typedef float f32x16 __attribute__((ext_vector_type(16)));
typedef unsigned u32x2 __attribute__((ext_vector_type(2)));
typedef unsigned u32x4 __attribute__((ext_vector_type(4)));
typedef GAS unsigned gu32;

constexpr int D = 2048, NB = 8, SEQ = 4096, CTXL = 256, DEPTH = 4;
constexpr int MX = NB * SEQ, MC = NB * CTXL, MT = MX + MC;
constexpr int FF = 5632, NMOD = 6 * D;
constexpr int MLA_H = 16, QR = 512, KVR = 512, NOPE = 128, ROPE = 64, DQ = 192;
constexpr int N1 = 1280;
constexpr int RH = 8, RDK = 256, RDV = 512;
constexpr float NORM_EPS = 1e-6f, GN_EPS = 1e-5f;
constexpr float LOG2E = 1.4426950408889634f;

constexpr size_t MiB = 1u << 20;
constexpr size_t WS_CTL = 0, CTL_BYTES = 1 * MiB;
constexpr size_t WS_MODV = 1 * MiB;
constexpr size_t WS_TABM = 3 * MiB;
constexpr size_t WS_TABR = 4 * MiB;
constexpr size_t WS_SSQ = 8 * MiB;
constexpr size_t WS_XC = 12 * MiB;
constexpr size_t WS_KR = 28 * MiB;
constexpr size_t WS_WA = 40 * MiB;
constexpr size_t WS_WB = 128 * MiB;
constexpr size_t WS_H = 276 * MiB;
constexpr size_t WS_BIG = 412 * MiB;
constexpr size_t WS_QKVL = WS_BIG, WS_Q = WS_BIG + 88 * MiB, WS_KV = WS_BIG + 292 * MiB, WS_O = WS_BIG + 564 * MiB;
constexpr size_t WS_QKV = WS_BIG, WS_Y = WS_BIG + 544 * MiB, WS_GATED = WS_BIG;
constexpr size_t WS_G = WS_BIG, WS_U = WS_BIG + 374 * MiB;
constexpr size_t WS_END = WS_BIG + 1088 * MiB;
static_assert((size_t)MT * 8192 * 2 <= 544 * MiB && (size_t)MT * 5632 * 2 <= 374 * MiB && (size_t)MT * N1 * 2 <= 88 * MiB, "ws map");

constexpr int CW_BAR = 4096;

constexpr int RING_BYTES = 131072, MISC_OFF = RING_BYTES + 320, ARGS_OFF = RING_BYTES + 1024, EDGE_OFF = RING_BYTES + 4096, LDS_BYTES = 147456;

__device__ __forceinline__ unsigned cvt_pk_bf16(float lo, float hi) { unsigned r; asm volatile("v_cvt_pk_bf16_f32 %0, %1, %2" : "=v"(r) : "v"(lo), "v"(hi)); return r; }
__device__ __forceinline__ float bf2f(unsigned short b) { return __uint_as_float((unsigned)b << 16); }
__device__ __forceinline__ float bflo(unsigned w) { return __uint_as_float(w << 16); }
__device__ __forceinline__ float bfhi(unsigned w) { return __uint_as_float(w & 0xffff0000u); }
__device__ __forceinline__ float shfl_xor_l(float v, int mask, int lane) { return __builtin_bit_cast(float, __builtin_amdgcn_ds_bpermute((lane ^ mask) << 2, __builtin_bit_cast(int, v))); }
__device__ __forceinline__ float fast_silu(float x) { return x * __builtin_amdgcn_rcpf(1.0f + __builtin_amdgcn_exp2f(-x * LOG2E)); }

__device__ __forceinline__ void glds16_s(const void* sbase, unsigned voff, unsigned lds_dst) {
    unsigned keep;
    asm volatile("s_mov_b32 %0, m0\n\ts_mov_b32 m0, %3\n\ts_nop 0\n\tglobal_load_lds_dwordx4 %1, %2\n\ts_mov_b32 m0, %0" : "=&s"(keep) : "v"(voff), "s"(sbase), "s"(lds_dst) : "memory");
}
__device__ __forceinline__ const char* uni_ptr(const void* p) {
    const unsigned long long v = (unsigned long long)p; const unsigned lo = __builtin_amdgcn_readfirstlane((unsigned)v), hi = __builtin_amdgcn_readfirstlane((unsigned)(v >> 32));
    return (const char*)(((unsigned long long)hi << 32) | lo);
}
namespace pg8 {
constexpr int BM = 256, BK = 64, HALF = 128, HTB = HALF * BK * 2, STAGE_BYTES = 8 * HTB, NXCD = 8, WGM = 8;
__host__ __device__ __forceinline__ int lds_byte(int r, int c) { const int st = (r >> 4) * 2 + (c >> 5), rr = r & 15, cc = c & 31, ob = rr * 64 + cc * 2; return st * 1024 + (ob ^ (((ob >> 9) & 1) << 5)); }
__host__ __device__ __forceinline__ void stage_rc(int b, int& R, int& C) { const int st = b / 1024, sb = b % 1024, swz = sb ^ (((sb >> 9) & 1) << 5); R = (st >> 1) * 16 + swz / 64; C = (st & 1) * 32 + (swz % 64) / 2; }
__host__ __device__ __forceinline__ int perm32(int rho) { const int n = rho >> 4, i = rho & 15; return 8 * (i >> 2) + 4 * n + (i & 3); }
struct Unit { int pm, pn; };
struct Gemm { const bf16* A; const bf16* Bt; int M, N, K, lda; };
struct StaticOrder {
    int nM, nN, nwg, G, c;
    __device__ void init(int M, int N, int G_, int c_) { nM = M / BM; nN = N / BM; nwg = nM * nN; G = G_; c = c_; }
    __device__ bool next(int i, Unit& u) const {
        const long L = (long)i * G + c; if (L >= nwg) return false;
        int wgid = (int)L; { const int q = nwg / NXCD, r = nwg % NXCD, xcd = wgid % NXCD, off = wgid / NXCD; wgid = (xcd < r ? xcd * (q + 1) : r * (q + 1) + (xcd - r) * q) + off; }
        const int nig = WGM * nN, gid = wgid / nig, fm = gid * WGM, gsz = (nM - fm) < WGM ? (nM - fm) : WGM;
        u.pm = fm + ((wgid % nig) % gsz); u.pn = (wgid % nig) / gsz; return true;
    }
};
template <class Epi>
__device__ __forceinline__ void gemm_phase(LAS unsigned char* lds, const Gemm g, const StaticOrder& S, const Epi& E) {
    int tid = threadIdx.x; asm volatile("" : "+v"(tid));
    const int wid = __builtin_amdgcn_readfirstlane(tid >> 6), lane = tid & 63, wr = wid >> 2, wc = wid & 3, fr = lane & 15, fq = lane >> 4;
    const int K = g.K, nt = K / BK;
    unsigned voffA[2], voffB[2];
#pragma unroll
    for (int i = 0; i < 2; ++i) { int R, C; stage_rc(tid * 16 + i * 8192, R, C); const int Rb = Epi::PERM ? ((R & ~31) + perm32(R & 31)) : R;
        voffA[i] = (unsigned)(R * g.lda + C) * 2u; voffB[i] = (unsigned)(Rb * K + C) * 2u; }
    const size_t kstep = (size_t)(BK * 2);
    const size_t hstepA = (size_t)HALF * g.lda * 2, hstepB = (size_t)HALF * K * 2;
    const size_t tstepA = 2 * hstepA, tstepB = 2 * hstepB;
    const unsigned ldsbase = (unsigned)__builtin_amdgcn_readfirstlane((unsigned)(uintptr_t)lds + (unsigned)wid * 1024u);
    const int aoff = lds_byte(wr * 64 + fr, fq * 8), boff = lds_byte(wc * 32 + fr, fq * 8);
#define PG8_SA(b, h) (((b) * 2 + (h)) * HTB)
#define PG8_SB(b, h) ((4 + (b) * 2 + (h)) * HTB)
#define PG8_STAGE(bufoff, gbase, voff) do { const char* _gb = uni_ptr(gbase); _Pragma("unroll") for (int _i = 0; _i < 2; ++_i) \
        glds16_s(_gb, (voff)[_i], ldsbase + (unsigned)((bufoff) + _i * 8192)); } while (0)
#define PG8_LDA(dst, b, h) do { _Pragma("unroll") for (int m = 0; m < 4; ++m) _Pragma("unroll") for (int k = 0; k < 2; ++k) dst[m][k] = *(const LAS bf16x8*)(lds + PG8_SA(b, h) + aoff + m * 2048 + k * 1024); } while (0)
#define PG8_LDB(dst, b, h) do { _Pragma("unroll") for (int n = 0; n < 2; ++n) _Pragma("unroll") for (int k = 0; k < 2; ++k) dst[n][k] = *(const LAS bf16x8*)(lds + PG8_SB(b, h) + boff + n * 2048 + k * 1024); } while (0)
#define PG8_MMA(ai, bj, At, Bt) do { __builtin_amdgcn_s_setprio(1); _Pragma("unroll") for (int m = 0; m < 4; ++m) _Pragma("unroll") for (int n = 0; n < 2; ++n) _Pragma("unroll") for (int k = 0; k < 2; ++k) \
        acc[ai][bj][m][n] = __builtin_amdgcn_mfma_f32_16x16x32_bf16(Bt[n][k], At[m][k], acc[ai][bj][m][n], 0, 0, 0); __builtin_amdgcn_s_setprio(0); } while (0)
#define PG8_WAIT_V(n) asm volatile("s_waitcnt vmcnt(" #n ")" ::: "memory")
#define PG8_WAIT_L(n) asm volatile("s_waitcnt lgkmcnt(" #n ")" ::: "memory")
#define PG8_BAR __builtin_amdgcn_s_barrier()
#define PG8_SCHED __builtin_amdgcn_sched_barrier(0)
    Unit cur, nxt; int ui = 0;
    if (!S.next(0, cur)) return;
    f32x4 acc[2][2][4][2];
#pragma unroll
    for (int a = 0; a < 2; ++a)
#pragma unroll
        for (int b = 0; b < 2; ++b)
#pragma unroll
            for (int m = 0; m < 4; ++m)
#pragma unroll
                for (int n = 0; n < 2; ++n) acc[a][b][m][n] = (f32x4){0.f, 0.f, 0.f, 0.f};
    bf16x8 At[4][2], B0[2][2], B1[2][2];
    const char* cA = (const char*)g.A + (size_t)cur.pm * tstepA; const char* cB = (const char*)g.Bt + (size_t)cur.pn * tstepB;
    PG8_STAGE(PG8_SB(0, 0), cB, voffB); PG8_STAGE(PG8_SB(0, 1), cB + hstepB, voffB); PG8_STAGE(PG8_SA(0, 0), cA, voffA); PG8_STAGE(PG8_SA(0, 1), cA + hstepA, voffA);
    if (wr == 1) PG8_BAR;
    PG8_WAIT_V(2); PG8_BAR;
    PG8_STAGE(PG8_SB(1, 0), cB + kstep, voffB); PG8_STAGE(PG8_SA(1, 0), cA + kstep, voffA); PG8_STAGE(PG8_SB(1, 1), cB + hstepB + kstep, voffB);
    PG8_WAIT_V(6); PG8_BAR;
    for (;;) {
        const bool has_next = S.next(ui + 1, nxt);
        const char* nA = has_next ? (const char*)g.A + (size_t)nxt.pm * tstepA : cA; const char* nB = has_next ? (const char*)g.Bt + (size_t)nxt.pn * tstepB : cB;
        for (int t = 0; t < nt; t += 2) {
            const bool last = (t == nt - 2);
            const char* a1 = cA + (size_t)(t + 1) * kstep;
            const char* a2 = last ? nA : cA + (size_t)(t + 2) * kstep; const char* b2 = last ? nB : cB + (size_t)(t + 2) * kstep;
            const char* a3 = a2 + kstep; const char* b3 = b2 + kstep;
            PG8_LDB(B0, 0, 0); PG8_LDB(B1, 0, 1); PG8_SCHED; PG8_LDA(At, 0, 0); PG8_STAGE(PG8_SA(1, 1), a1 + hstepA, voffA);
            PG8_WAIT_V(8); PG8_WAIT_L(0); PG8_BAR; PG8_MMA(0, 0, At, B0); PG8_MMA(0, 1, At, B1); PG8_BAR; PG8_SCHED;
            PG8_LDA(At, 0, 1); PG8_STAGE(PG8_SB(0, 0), b2, voffB); PG8_STAGE(PG8_SB(0, 1), b2 + hstepB, voffB); PG8_STAGE(PG8_SA(0, 0), a2, voffA);
            PG8_WAIT_V(8); PG8_WAIT_L(0); PG8_BAR; PG8_MMA(1, 0, At, B0); PG8_MMA(1, 1, At, B1); PG8_BAR; PG8_SCHED;
            PG8_LDB(B0, 1, 0); PG8_LDB(B1, 1, 1); PG8_SCHED; PG8_LDA(At, 1, 0); PG8_STAGE(PG8_SA(0, 1), a2 + hstepA, voffA);
            PG8_WAIT_V(8); PG8_WAIT_L(0); PG8_BAR; PG8_MMA(0, 0, At, B0); PG8_MMA(0, 1, At, B1); PG8_BAR; PG8_SCHED;
            PG8_LDA(At, 1, 1); PG8_STAGE(PG8_SB(1, 0), b3, voffB); PG8_STAGE(PG8_SB(1, 1), b3 + hstepB, voffB); PG8_STAGE(PG8_SA(1, 0), a3, voffA);
            PG8_WAIT_V(8); PG8_WAIT_L(0); PG8_BAR; PG8_MMA(1, 0, At, B0); PG8_MMA(1, 1, At, B1); PG8_BAR; PG8_SCHED;
        }
        if (wr == 0) PG8_BAR;
        E(acc, cur, wr, wc, fr, fq);
        if (!has_next) break;
#pragma unroll
        for (int a = 0; a < 2; ++a)
#pragma unroll
            for (int b = 0; b < 2; ++b)
#pragma unroll
                for (int m = 0; m < 4; ++m)
#pragma unroll
                    for (int n = 0; n < 2; ++n) acc[a][b][m][n] = (f32x4){0.f, 0.f, 0.f, 0.f};
        cur = nxt; cA = nA; cB = nB; ++ui;
        if (wr == 1) PG8_BAR;
    }
    PG8_WAIT_V(0);
    PG8_BAR;
#undef PG8_SA
#undef PG8_SB
#undef PG8_STAGE
#undef PG8_LDA
#undef PG8_LDB
#undef PG8_MMA
#undef PG8_WAIT_V
#undef PG8_WAIT_L
#undef PG8_BAR
#undef PG8_SCHED
}
}
using pg8::Unit;

__device__ __forceinline__ u32x4 pack8(const f32x4 a, const f32x4 b) { u32x4 w; w.x = cvt_pk_bf16(a[0], a[1]); w.y = cvt_pk_bf16(a[2], a[3]); w.z = cvt_pk_bf16(b[0], b[1]); w.w = cvt_pk_bf16(b[2], b[3]); return w; }
__device__ __forceinline__ f32x4 rot2(const f32x4 v, const f32x4 cs) { f32x4 o; o[0] = v[0] * cs[0] - v[1] * cs[1]; o[1] = v[1] * cs[0] + v[0] * cs[1]; o[2] = v[2] * cs[2] - v[3] * cs[3]; o[3] = v[3] * cs[2] + v[2] * cs[3]; return o; }

__device__ __forceinline__ f32x4 mla_cs(const float* tabm, int t, int c4) {
    const int p0 = c4 >> 1; const int pos = (p0 < 16) ? (t >> 6) : (t & 63); const int f = p0 & 15;
    return *(const f32x4*)(tabm + ((size_t)pos * 16 + f) * 2);
}

struct EpiG1 {
    static constexpr bool PERM = true;
    bf16* QKVL; float* SSQ; bf16* KR; const float* tabm;
    __device__ __forceinline__ void operator()(const f32x4 (&acc)[2][2][4][2], const Unit& u, int wr, int wc, int fr, int fq) const {
        const int row0 = u.pm * 256 + wr * 64 + fr;
        if (u.pn < 4) {
            const int col0 = u.pn * 256 + wc * 32 + 8 * fq;
#pragma unroll
            for (int ai = 0; ai < 2; ++ai)
#pragma unroll
                for (int m = 0; m < 4; ++m) { const int row = row0 + ai * 128 + m * 16; float ss = 0.f;
#pragma unroll
                    for (int bj = 0; bj < 2; ++bj) { const f32x4 v0 = acc[ai][bj][m][0], v1 = acc[ai][bj][m][1];
                        ss += (v0[0] * v0[0] + v0[1] * v0[1]) + (v0[2] * v0[2] + v0[3] * v0[3]) + (v1[0] * v1[0] + v1[1] * v1[1]) + (v1[2] * v1[2] + v1[3] * v1[3]);
                        *(u32x4*)(QKVL + (size_t)row * N1 + col0 + bj * 128) = pack8(v0, v1); }
                    { const int ln_ = fr + 16 * fq; ss += shfl_xor_l(ss, 16, ln_); ss += shfl_xor_l(ss, 32, ln_); }
                    if (fq == 0) SSQ[(size_t)row * 16 + u.pn * 4 + wc] = ss; asm volatile("" ::: "memory"); }
        } else if (wc < 2) {
            const int c8 = wc * 32 + 8 * fq;
#pragma unroll
            for (int ai = 0; ai < 2; ++ai)
#pragma unroll
                for (int m = 0; m < 4; ++m) { const int row = row0 + ai * 128 + m * 16; f32x4 v0 = acc[ai][0][m][0], v1 = acc[ai][0][m][1];
                    if (row < MX) { const int t = row & (SEQ - 1); v0 = rot2(v0, mla_cs(tabm, t, c8)); v1 = rot2(v1, mla_cs(tabm, t, c8 + 4)); }
                    *(u32x4*)(KR + (size_t)row * 64 + c8) = pack8(v0, v1); asm volatile("" ::: "memory"); }
        }
    }
};
struct EpiUq {
    static constexpr bool PERM = true;
    bf16* Q; const float* SSQ; const float* tabm;
    __device__ __forceinline__ void operator()(const f32x4 (&acc)[2][2][4][2], const Unit& u, int wr, int wc, int fr, int fq) const {
        const int row0 = u.pm * 256 + wr * 64 + fr;
        int col8[2], dd[2];
#pragma unroll
        for (int bj = 0; bj < 2; ++bj) { col8[bj] = u.pn * 256 + bj * 128 + wc * 32 + 8 * fq; dd[bj] = col8[bj] % DQ; }
#pragma unroll
        for (int ai = 0; ai < 2; ++ai)
#pragma unroll
            for (int m = 0; m < 4; ++m) { const int row = row0 + ai * 128 + m * 16;
                const f32x4 s0 = *(const f32x4*)(SSQ + (size_t)row * 16), s1 = *(const f32x4*)(SSQ + (size_t)row * 16 + 4);
                const float ss = ((s0[0] + s0[1]) + (s0[2] + s0[3])) + ((s1[0] + s1[1]) + (s1[2] + s1[3]));
                const float r = 1.0f / sqrtf(ss * (1.0f / QR) + NORM_EPS);
#pragma unroll
                for (int bj = 0; bj < 2; ++bj) { f32x4 v0 = acc[ai][bj][m][0] * r, v1 = acc[ai][bj][m][1] * r;
                    if (dd[bj] >= NOPE && row < MX) { const int t = row & (SEQ - 1), c8 = dd[bj] - NOPE; v0 = rot2(v0, mla_cs(tabm, t, c8)); v1 = rot2(v1, mla_cs(tabm, t, c8 + 4)); }
                    *(u32x4*)(Q + (size_t)row * 3072 + col8[bj]) = pack8(v0, v1); } asm volatile("" ::: "memory"); }
    }
};
struct EpiUkv {
    static constexpr bool PERM = true;
    bf16* KV; const float* SSQ;
    __device__ __forceinline__ void operator()(const f32x4 (&acc)[2][2][4][2], const Unit& u, int wr, int wc, int fr, int fq) const {
        const int row0 = u.pm * 256 + wr * 64 + fr; const int col0 = u.pn * 256 + wc * 32 + 8 * fq;
#pragma unroll
        for (int ai = 0; ai < 2; ++ai)
#pragma unroll
            for (int m = 0; m < 4; ++m) { const int row = row0 + ai * 128 + m * 16;
                const f32x4 s0 = *(const f32x4*)(SSQ + (size_t)row * 16 + 8), s1 = *(const f32x4*)(SSQ + (size_t)row * 16 + 12);
                const float ss = ((s0[0] + s0[1]) + (s0[2] + s0[3])) + ((s1[0] + s1[1]) + (s1[2] + s1[3]));
                const float r = 1.0f / sqrtf(ss * (1.0f / KVR) + NORM_EPS);
#pragma unroll
                for (int bj = 0; bj < 2; ++bj) *(u32x4*)(KV + (size_t)row * 4096 + col0 + bj * 128) = pack8(acc[ai][bj][m][0] * r, acc[ai][bj][m][1] * r); asm volatile("" ::: "memory"); }
    }
};
struct EpiResid {
    static constexpr bool PERM = false;
    const float* xin; float* xout; const float* cin; float* cout; const float* modv; int gofs;
    __device__ __forceinline__ void operator()(const f32x4 (&acc)[2][2][4][2], const Unit& u, int wr, int wc, int fr, int fq) const {
        const bool isx = u.pm < (MX / 256);
        const int rloc = (isx ? u.pm * 256 : (u.pm * 256 - MX)) + wr * 64 + fr;
        const float* base = isx ? xin : cin; float* out = isx ? xout : cout;
        const float* gv = modv + (size_t)(isx ? (u.pm >> 4) : 8) * NMOD + gofs;
        const int col0 = u.pn * 256 + wc * 32 + 4 * fq;
        f32x4 g4[2][2];
#pragma unroll
        for (int bj = 0; bj < 2; ++bj)
#pragma unroll
            for (int n = 0; n < 2; ++n) g4[bj][n] = *(const f32x4*)(gv + col0 + bj * 128 + n * 16);
#pragma unroll
        for (int ai = 0; ai < 2; ++ai)
#pragma unroll
            for (int m = 0; m < 4; ++m) { const size_t off = (size_t)(rloc + ai * 128 + m * 16) * D + col0;
#pragma unroll
                for (int bj = 0; bj < 2; ++bj)
#pragma unroll
                    for (int n = 0; n < 2; ++n) { const f32x4 b = *(const f32x4*)(base + off + bj * 128 + n * 16); *(f32x4*)(out + off + bj * 128 + n * 16) = b + g4[bj][n] * acc[ai][bj][m][n]; }
                if (m & 1) asm volatile("" ::: "memory"); }
    }
};
template <int CTRL> __device__ __forceinline__ float dpp1(float x) { return __int_as_float(__builtin_amdgcn_update_dpp(0, __float_as_int(x), CTRL, 0xF, 0xF, false)); }
__device__ __forceinline__ f32x4 row_prev(const f32x4 v) { f32x4 o; o.x = dpp1<0x121>(v.x); o.y = dpp1<0x121>(v.y); o.z = dpp1<0x121>(v.z); o.w = dpp1<0x121>(v.w); return o; }
__device__ __forceinline__ f32x4 row_next(const f32x4 v) { f32x4 o; o.x = dpp1<0x12F>(v.x); o.y = dpp1<0x12F>(v.y); o.z = dpp1<0x12F>(v.z); o.w = dpp1<0x12F>(v.w); return o; }
__device__ __forceinline__ f32x4 silu4(const f32x4 v) { f32x4 o;
#pragma unroll
    for (int e = 0; e < 4; ++e) o[e] = fast_silu(v[e]); return o; }
constexpr size_t HALO_STRIDE = (size_t)FF;
struct EpiGUConv {
    static constexpr bool PERM = true;
    bf16* ACT; float* HALO; const float* cw; const float* cb; LAS float* edge;
    __device__ __forceinline__ void operator()(const f32x4 (&acc)[2][2][4][2], const Unit& u, int wr, int wc, int fr, int fq) const {
        const int c8 = wc * 32 + 8 * fq; const int f0 = u.pn * 128 + c8;
#pragma unroll
        for (int ai = 0; ai < 2; ++ai) { const int blk = 2 * ai + wr;
            if (fr == 0)  { *(LAS f32x4*)(edge + (blk * 2 + 0) * 128 + c8) = acc[ai][0][0][0]; *(LAS f32x4*)(edge + (blk * 2 + 0) * 128 + c8 + 4) = acc[ai][0][0][1]; }
            if (fr == 15) { *(LAS f32x4*)(edge + (blk * 2 + 1) * 128 + c8) = acc[ai][0][3][0]; *(LAS f32x4*)(edge + (blk * 2 + 1) * 128 + c8 + 4) = acc[ai][0][3][1]; } }
        asm volatile("s_waitcnt lgkmcnt(0)" ::: "memory"); __builtin_amdgcn_s_barrier(); asm volatile("" ::: "memory");
        f32x4 w0[2], w1[2], w2[2], bb[2];
#pragma unroll
        for (int n = 0; n < 2; ++n) { w0[n] = *(const f32x4*)(cw + f0 + 4 * n); w1[n] = *(const f32x4*)(cw + FF + f0 + 4 * n); w2[n] = *(const f32x4*)(cw + 2 * FF + f0 + 4 * n); bb[n] = *(const f32x4*)(cb + f0 + 4 * n); }
        const f32x4 zero4 = {0.f, 0.f, 0.f, 0.f};
#pragma unroll
        for (int ai = 0; ai < 2; ++ai) { const int blk = 2 * ai + wr;
#pragma unroll
            for (int m = 0; m < 4; ++m) { const int row = u.pm * 256 + ai * 128 + wr * 64 + m * 16 + fr; f32x4 o[2];
#pragma unroll
                for (int n = 0; n < 2; ++n) { const f32x4 cur = acc[ai][0][m][n];
                    f32x4 b, d;
                    if (m > 0) b = row_prev(acc[ai][0][m - 1][n]); else b = (blk > 0) ? *(const LAS f32x4*)(edge + ((blk - 1) * 2 + 1) * 128 + c8 + 4 * n) : zero4;
                    if (m < 3) d = row_next(acc[ai][0][m + 1][n]); else d = (blk < 3) ? *(const LAS f32x4*)(edge + ((blk + 1) * 2 + 0) * 128 + c8 + 4 * n) : zero4;
                    const f32x4 a = row_prev(cur), c = row_next(cur);
                    const f32x4 up = (fr == 0) ? b : a, dn = (fr == 15) ? d : c;
                    const f32x4 cv = w0[n] * up + w1[n] * cur + w2[n] * dn + bb[n]; const f32x4 uu = acc[ai][1][m][n];
                    o[n] = silu4(cv) * uu;
                    if (m == 0 && blk == 0 && fr == 0) { float* hp = HALO + (size_t)((u.pm * 2 + 0) * 3) * HALO_STRIDE + f0 + 4 * n; *(f32x4*)hp = cv; *(f32x4*)(hp + HALO_STRIDE) = cur; *(f32x4*)(hp + 2 * HALO_STRIDE) = uu; }
                    if (m == 3 && blk == 3 && fr == 15) { float* hp = HALO + (size_t)((u.pm * 2 + 1) * 3) * HALO_STRIDE + f0 + 4 * n; *(f32x4*)hp = cv; *(f32x4*)(hp + HALO_STRIDE) = cur; *(f32x4*)(hp + 2 * HALO_STRIDE) = uu; } }
                *(u32x4*)(ACT + (size_t)row * FF + f0) = pack8(o[0], o[1]); asm volatile("" ::: "memory"); } }
        asm volatile("s_waitcnt lgkmcnt(0)" ::: "memory"); __builtin_amdgcn_s_barrier(); asm volatile("" ::: "memory");
    }
};
struct EpiQKV {
    static constexpr bool PERM = true;
    bf16* QKV; const float* tabr;
    __device__ __forceinline__ void operator()(const f32x4 (&acc)[2][2][4][2], const Unit& u, int wr, int wc, int fr, int fq) const {
        const int row0 = u.pm * 256 + wr * 64 + fr; const int col0 = u.pn * 256 + wc * 32 + 8 * fq;
        const bool rope = (u.pn < 16) && (u.pm < MX / 256);
#pragma unroll
        for (int ai = 0; ai < 2; ++ai)
#pragma unroll
            for (int m = 0; m < 4; ++m) { const int row = row0 + ai * 128 + m * 16;
#pragma unroll
                for (int bj = 0; bj < 2; ++bj) { f32x4 v0 = acc[ai][bj][m][0], v1 = acc[ai][bj][m][1]; const int col = col0 + bj * 128;
                    if (rope) { const int t = row & (SEQ - 1); const float* tp = tabr + ((size_t)t * 128 + ((col & 255) >> 1)) * 2;
                        v0 = rot2(v0, *(const f32x4*)tp); v1 = rot2(v1, *(const f32x4*)(tp + 4)); }
                    *(u32x4*)(QKV + (size_t)row * 8192 + col) = pack8(v0, v1); } asm volatile("" ::: "memory"); }
    }
};
struct EpiGate {
    static constexpr bool PERM = true;
    bf16* GATED; const bf16* YF; const bf16* YB;
    __device__ __forceinline__ void operator()(const f32x4 (&acc)[2][2][4][2], const Unit& u, int wr, int wc, int fr, int fq) const {
        const int row0 = u.pm * 256 + wr * 64 + fr; const int f0 = u.pn * 128 + wc * 32 + 8 * fq;
#pragma unroll
        for (int ai = 0; ai < 2; ++ai)
#pragma unroll
            for (int m = 0; m < 4; ++m) { const size_t off = (size_t)(row0 + ai * 128 + m * 16) * 4096 + f0;
                const u32x4 nf = *(const u32x4*)(YF + off), nb = *(const u32x4*)(YB + off);
                const f32x4 a0 = acc[ai][0][m][0], a1 = acc[ai][0][m][1], b0 = acc[ai][1][m][0], b1 = acc[ai][1][m][1];
                f32x4 o0, o1;
                o0[0] = fast_silu(a0[0]) * bflo(nf.x) + fast_silu(b0[0]) * bflo(nb.x); o0[1] = fast_silu(a0[1]) * bfhi(nf.x) + fast_silu(b0[1]) * bfhi(nb.x);
                o0[2] = fast_silu(a0[2]) * bflo(nf.y) + fast_silu(b0[2]) * bflo(nb.y); o0[3] = fast_silu(a0[3]) * bfhi(nf.y) + fast_silu(b0[3]) * bfhi(nb.y);
                o1[0] = fast_silu(a1[0]) * bflo(nf.z) + fast_silu(b1[0]) * bflo(nb.z); o1[1] = fast_silu(a1[1]) * bfhi(nf.z) + fast_silu(b1[1]) * bfhi(nb.z);
                o1[2] = fast_silu(a1[2]) * bflo(nf.w) + fast_silu(b1[2]) * bflo(nb.w); o1[3] = fast_silu(a1[3]) * bfhi(nf.w) + fast_silu(b1[3]) * bfhi(nb.w);
                *(u32x4*)(GATED + off) = pack8(o0, o1); asm volatile("" ::: "memory"); }
    }
};

namespace att {
constexpr int NW = 8, QBLK = 32, KVBLK = 64;
constexpr int SHM_V = 16384, SHM_KN = 16384, SHM_KR = 8192;
constexpr int OFF_V = 0, OFF_KN = 3 * SHM_V, OFF_KR = OFF_KN + 2 * SHM_KN, OFF_WS = OFF_KR + 2 * SHM_KR, SHM_ATTN = OFF_WS + NW * 64 * 4;
constexpr float THR2 = 11.5f;
#define KSWZ(row, colB) ((row) * 256 + ((colB) ^ (((row) & 7) << 4)))
#define KRSWZ(row, colB) ((row) * 128 + ((colB) ^ ((((row) >> 1) & 7) << 4)))
#define SBAR() __builtin_amdgcn_sched_barrier(0)
__device__ __forceinline__ int crow(int r, int hi) { return (r & 3) + 8 * (r >> 2) + 4 * hi; }
__device__ __forceinline__ void partialSM(f32x16& p0, f32x16& p1, float& m_reg, float& alpha) {
  float pmax = p0[0];
#pragma unroll
  for (int r = 1; r < 16; ++r) pmax = fmaxf(pmax, p0[r]);
#pragma unroll
  for (int r = 0; r < 16; ++r) pmax = fmaxf(pmax, p1[r]);
  { auto rr = __builtin_amdgcn_permlane32_swap(__float_as_uint(pmax), __float_as_uint(pmax), false, false); pmax = fmaxf(__uint_as_float(rr[0]), __uint_as_float(rr[1])); }
  float mn;
  if (__builtin_expect(__all(pmax - m_reg <= THR2), 1)) { mn = m_reg; alpha = 1.f; }
  else { mn = fmaxf(m_reg, pmax); alpha = __builtin_amdgcn_exp2f(m_reg - mn); m_reg = mn; }
#pragma unroll
  for (int r = 0; r < 16; ++r) p0[r] = p0[r] - mn;
#pragma unroll
  for (int r = 0; r < 16; ++r) p1[r] = p1[r] - mn;
#pragma unroll
  for (int r = 0; r < 16; ++r) p0[r] = __builtin_amdgcn_exp2f(p0[r]);
}
__device__ __forceinline__ void finishSM(f32x16& p0, f32x16& p1, float alpha, float& l_reg, bf16x8& pa0, bf16x8& pa1, bf16x8& pa2, bf16x8& pa3) {
#pragma unroll
  for (int r = 0; r < 16; ++r) p1[r] = __builtin_amdgcn_exp2f(p1[r]);
  float ps = 0;
#pragma unroll
  for (int r = 0; r < 16; ++r) ps += p0[r];
#pragma unroll
  for (int r = 0; r < 16; ++r) ps += p1[r];
  { auto rr = __builtin_amdgcn_permlane32_swap(__float_as_uint(ps), __float_as_uint(ps), false, false); ps = __uint_as_float(rr[0]) + __uint_as_float(rr[1]); }
  l_reg = l_reg * alpha + ps;
#define PK4(P, BASE, OUT) do { unsigned a0 = cvt_pk_bf16(P[BASE + 0], P[BASE + 1]), a1 = cvt_pk_bf16(P[BASE + 2], P[BASE + 3]);   \
    unsigned b0 = cvt_pk_bf16(P[BASE + 4], P[BASE + 5]), b1 = cvt_pk_bf16(P[BASE + 6], P[BASE + 7]);                              \
    auto r0 = __builtin_amdgcn_permlane32_swap(a0, b0, false, false); auto r1 = __builtin_amdgcn_permlane32_swap(a1, b1, false, false); \
    u32x4 w = {r0[0], r1[0], r0[1], r1[1]}; OUT = __builtin_bit_cast(bf16x8, w); } while (0)
  PK4(p0, 0, pa0); PK4(p0, 8, pa1); PK4(p1, 0, pa2); PK4(p1, 8, pa3);
#undef PK4
}
__device__ __forceinline__ void qkt(f32x16& p0, f32x16& p1, const char* Kn, const char* Kr, const bf16x8* qr, int r32, int hi) {
  p0 = f32x16{}; p1 = f32x16{};
#pragma unroll
  for (int d0 = 0; d0 < 8; ++d0) { const int cb = (d0 * 16 + hi * 8) * 2;
    const bf16x8 b0 = *reinterpret_cast<const bf16x8*>(Kn + KSWZ(r32, cb));
    const bf16x8 b1 = *reinterpret_cast<const bf16x8*>(Kn + KSWZ(32 + r32, cb));
    p0 = __builtin_amdgcn_mfma_f32_32x32x16_bf16(b0, qr[d0], p0, 0, 0, 0);
    p1 = __builtin_amdgcn_mfma_f32_32x32x16_bf16(b1, qr[d0], p1, 0, 0, 0); }
#pragma unroll
  for (int d0 = 0; d0 < 4; ++d0) { const int cb = (d0 * 16 + hi * 8) * 2;
    const bf16x8 b0 = *reinterpret_cast<const bf16x8*>(Kr + KRSWZ(r32, cb));
    const bf16x8 b1 = *reinterpret_cast<const bf16x8*>(Kr + KRSWZ(32 + r32, cb));
    p0 = __builtin_amdgcn_mfma_f32_32x32x16_bf16(b0, qr[8 + d0], p0, 0, 0, 0);
    p1 = __builtin_amdgcn_mfma_f32_32x32x16_bf16(b1, qr[8 + d0], p1, 0, 0, 0); }
}
__device__ __forceinline__ int v_st(int k, int c) { const int kk = (k & ~0xC) | ((k & 4) << 1) | ((k & 8) >> 1); return ((kk >> 3) * 4 + (c >> 5)) * 512 + ((kk & 7) * 32 + (c & 31)) * 2; }
__device__ __forceinline__ int v_rd_base(int lane) { return ((lane & 3) << 3) | (((lane >> 2) & 3) << 6) | (((lane >> 4) & 1) << 5) | (((lane >> 5) & 1) << 8); }
constexpr int v_rd_off(int d0, int ks, int half) { return d0 * 512 + ks * 4096 + half * 2048; }
template <int OFF> __device__ __forceinline__ s16x4 tr_read(int vb) { s16x4 r; asm volatile("ds_read_b64_tr_b16 %0, %1 offset:%2" : "=&v"(r) : "v"(vb), "i"(OFF) : "memory"); return r; }
template <int D0> __device__ __forceinline__ void pv_one(f32x16& od, int vb, bf16x8 pa0, bf16x8 pa1, bf16x8 pa2, bf16x8 pa3) {
  const s16x4 l0 = tr_read<v_rd_off(D0, 0, 0)>(vb), h0 = tr_read<v_rd_off(D0, 0, 1)>(vb), l1 = tr_read<v_rd_off(D0, 1, 0)>(vb), h1 = tr_read<v_rd_off(D0, 1, 1)>(vb);
  const s16x4 l2 = tr_read<v_rd_off(D0, 2, 0)>(vb), h2 = tr_read<v_rd_off(D0, 2, 1)>(vb), l3 = tr_read<v_rd_off(D0, 3, 0)>(vb), h3 = tr_read<v_rd_off(D0, 3, 1)>(vb);
  asm volatile("s_waitcnt lgkmcnt(0)" ::: "memory"); SBAR();
#define PK(L, H) (bf16x8){L[0], L[1], L[2], L[3], H[0], H[1], H[2], H[3]}
  od = __builtin_amdgcn_mfma_f32_32x32x16_bf16(pa0, PK(l0, h0), od, 0, 0, 0);
  od = __builtin_amdgcn_mfma_f32_32x32x16_bf16(pa1, PK(l1, h1), od, 0, 0, 0);
  od = __builtin_amdgcn_mfma_f32_32x32x16_bf16(pa2, PK(l2, h2), od, 0, 0, 0);
  od = __builtin_amdgcn_mfma_f32_32x32x16_bf16(pa3, PK(l3, h3), od, 0, 0, 0);
#undef PK
}
__device__ __forceinline__ void pv_d0(f32x16* o, int vb, bf16x8 pa0, bf16x8 pa1, bf16x8 pa2, bf16x8 pa3) {
  pv_one<0>(o[0], vb, pa0, pa1, pa2, pa3); pv_one<1>(o[1], vb, pa0, pa1, pa2, pa3); pv_one<2>(o[2], vb, pa0, pa1, pa2, pa3); pv_one<3>(o[3], vb, pa0, pa1, pa2, pa3);
}
__device__ __forceinline__ void attn_unit(const bf16* __restrict__ Qb, const bf16* __restrict__ KVh, const bf16* __restrict__ KRp, bf16* __restrict__ Ob,
                                          int NT, int nc, int cbase, int xbase, char* lds) {
  int tid = threadIdx.x; asm volatile("" : "+v"(tid));
  const int wid = __builtin_amdgcn_readfirstlane(tid >> 6), lane = tid & 63, r32 = lane & 31, hi = lane >> 5;
  char* V_lds = lds + OFF_V; char* Kn_lds = lds + OFF_KN; char* Kr_lds = lds + OFF_KR;
  float* ws = (float*)(lds + OFF_WS) + wid * 64; float* li_l = ws; float* al_l = ws + 32;
  float m_reg = -1e30f, l_reg = 0; f32x16 o[4] = {}; bf16x8 qr[12];
  const bf16* Qw = Qb + (long)(wid * QBLK + r32) * 3072 + hi * 8;
#pragma unroll
  for (int d0 = 0; d0 < 12; ++d0) qr[d0] = *reinterpret_cast<const bf16x8*>(Qw + d0 * 16);
  const int vb0 = (int)(uintptr_t)V_lds + v_rd_base(lane);
  unsigned vofK[2], vofV[2], vofR;
#pragma unroll
  for (int i = 0; i < 2; ++i) { const int pc = wid * 2 + i;
      { const int row = pc * 4 + (lane >> 4), ch = (lane & 15) ^ (row & 7); vofK[i] = (unsigned)((row * 4096 + ch * 8) * 2); }
      { const int ob = pc * 1024 + lane * 16, st = ob >> 9, w = ob & 511, kk = (st >> 2) * 8 + (w >> 6); const int k = (kk & ~0xC) | ((kk & 4) << 1) | ((kk & 8) >> 1);
        const int c = (st & 3) * 32 + 8 * ((w & 63) >> 4); vofV[i] = (unsigned)((k * 4096 + 128 + c) * 2); } }
  { const int row = wid * 8 + (lane >> 3), ch = (lane & 7) ^ ((row >> 1) & 7); vofR = (unsigned)((row * 64 + ch * 8) * 2); }
  const unsigned ldsK = (unsigned)__builtin_amdgcn_readfirstlane((unsigned)(uintptr_t)Kn_lds + (unsigned)wid * 2048u);
  const unsigned ldsV = (unsigned)__builtin_amdgcn_readfirstlane((unsigned)(uintptr_t)V_lds + (unsigned)wid * 2048u);
  const unsigned ldsR = (unsigned)__builtin_amdgcn_readfirstlane((unsigned)(uintptr_t)Kr_lds + (unsigned)wid * 1024u);
#define KROW(j) ((j) < nc ? cbase + (j) * KVBLK : xbase + ((j) - nc) * KVBLK)
#define DMA_TILE(j, kslot, vslot) do { const long k0_ = KROW(j); const char* kb_ = uni_ptr(KVh + k0_ * 4096); const char* rb_ = uni_ptr(KRp + k0_ * 64); \
    glds16_s(kb_, vofK[0], ldsK + (kslot) * SHM_KN); glds16_s(kb_, vofK[1], ldsK + (kslot) * SHM_KN + 1024u); \
    glds16_s(rb_, vofR, ldsR + (kslot) * SHM_KR); \
    glds16_s(kb_, vofV[0], ldsV + (vslot) * SHM_V); glds16_s(kb_, vofV[1], ldsV + (vslot) * SHM_V + 1024u); } while (0)
#define WAIT_SYNC() do { asm volatile("s_waitcnt vmcnt(0)" ::: "memory"); __syncthreads(); } while (0)
#define RESC(a) do { if (__any((a) < 1.f)) { if (hi == 0) al_l[r32] = (a); asm volatile("s_waitcnt lgkmcnt(0)" ::: "memory"); \
    _Pragma("unroll") for (int d = 0; d < 4; ++d) _Pragma("unroll") for (int r = 0; r < 16; ++r) o[d][r] *= al_l[crow(r, hi)]; } } while (0)
  f32x16 pA0, pA1, pB0, pB1; float alA, alB; bf16x8 pa0, pa1, pa2, pa3;
  DMA_TILE(0, 0, 0); DMA_TILE(1, 1, 1); WAIT_SYNC();
  qkt(pA0, pA1, Kn_lds, Kr_lds, qr, r32, hi); partialSM(pA0, pA1, m_reg, alA);
  __syncthreads();
  int vprev = 0, vcur = 1, vnext = 2;
  for (int j = 1; j + 1 < NT; j += 2) {
    DMA_TILE(j + 1, 0, vnext);
    SBAR(); qkt(pB0, pB1, Kn_lds + SHM_KN, Kr_lds + SHM_KR, qr, r32, hi);
    finishSM(pA0, pA1, alA, l_reg, pa0, pa1, pa2, pa3); SBAR();
    pv_d0(o, vb0 + vprev * SHM_V, pa0, pa1, pa2, pa3); partialSM(pB0, pB1, m_reg, alB);
    RESC(alB); WAIT_SYNC();
    { const int t_ = vprev; vprev = vcur; vcur = vnext; vnext = t_; }
    if (j + 2 < NT) DMA_TILE(j + 2, 1, vnext);
    SBAR(); qkt(pA0, pA1, Kn_lds, Kr_lds, qr, r32, hi);
    finishSM(pB0, pB1, alB, l_reg, pa0, pa1, pa2, pa3); SBAR();
    pv_d0(o, vb0 + vprev * SHM_V, pa0, pa1, pa2, pa3); partialSM(pA0, pA1, m_reg, alA);
    RESC(alA); WAIT_SYNC();
    { const int t_ = vprev; vprev = vcur; vcur = vnext; vnext = t_; }
  }
  SBAR(); qkt(pB0, pB1, Kn_lds + SHM_KN, Kr_lds + SHM_KR, qr, r32, hi);
  finishSM(pA0, pA1, alA, l_reg, pa0, pa1, pa2, pa3); SBAR();
  pv_d0(o, vb0 + vprev * SHM_V, pa0, pa1, pa2, pa3); partialSM(pB0, pB1, m_reg, alB);
  RESC(alB);
  finishSM(pB0, pB1, alB, l_reg, pa0, pa1, pa2, pa3); SBAR();
  pv_d0(o, vb0 + vcur * SHM_V, pa0, pa1, pa2, pa3);
  if (hi == 0) li_l[r32] = l_reg; asm volatile("s_waitcnt lgkmcnt(0)" ::: "memory");
  float rli[16];
#pragma unroll
  for (int r = 0; r < 16; ++r) rli[r] = __builtin_amdgcn_rcpf(li_l[crow(r, hi)]);
  bf16* Ow = Ob + (long)(wid * QBLK) * 2048;
#pragma unroll
  for (int r = 0; r < 16; ++r) { const int orow = crow(r, hi);
#pragma unroll
    for (int d0 = 0; d0 < 4; ++d0) Ow[(long)orow * 2048 + d0 * 32 + r32] = (bf16)(cvt_pk_bf16(o[d0][r] * rli[r], 0.f) & 0xffffu); }
  __syncthreads();
#undef KROW
#undef DMA_TILE
#undef WAIT_SYNC
#undef RESC
}
#undef SBAR
}

namespace scan {
constexpr int CH = 64;
constexpr int OFF_Q = 0, OFF_K = 32768, OFF_V = 65536, OFF_P = 98304, SHM_SCAN = 98304 + 8192;
__device__ __forceinline__ unsigned off_b(unsigned row, unsigned ch) { return 256u * row + 16u * (ch ^ (((row & 3) << 2) | ((row >> 2) & 3))); }
__device__ __forceinline__ unsigned p_off(unsigned i, unsigned chunk) { return 128u * i + 16u * (chunk ^ ((i >> 1) & 7)); }
__device__ __forceinline__ int crow(int r, int hi) { return (r & 3) + 8 * (r >> 2) + 4 * hi; }
__device__ __forceinline__ s16x4 vtr(const LAS char* p) { typedef short v4i16_t __attribute__((ext_vector_type(4))); return __builtin_bit_cast(s16x4, __builtin_amdgcn_ds_read_tr16_b64_v4i16((LAS v4i16_t*)p)); }
__device__ __forceinline__ bf16x8 tr_frag(const LAS char* img, int lane, int c, int ks) {
    const unsigned h = lane >> 5, blk = (lane >> 4) & 1, q = (lane & 15) >> 2, p = lane & 3;
    const unsigned r0 = 16 * ks + 8 * h + q, chn = 4 * c + 2 * blk + (p >> 1);
    const s16x4 lo = vtr(img + off_b(r0, chn) + 8 * (p & 1)), hi = vtr(img + off_b(r0 + 4, chn) + 8 * (p & 1));
    return (bf16x8){lo[0], lo[1], lo[2], lo[3], hi[0], hi[1], hi[2], hi[3]};
}
__device__ __forceinline__ bf16x8 pack_step(const f32x16& x, int s) {
    u32x4 p; p.x = cvt_pk_bf16(x[8 * s + 0], x[8 * s + 1]); p.y = cvt_pk_bf16(x[8 * s + 2], x[8 * s + 3]); p.z = cvt_pk_bf16(x[8 * s + 4], x[8 * s + 5]); p.w = cvt_pk_bf16(x[8 * s + 6], x[8 * s + 7]);
    return __builtin_bit_cast(bf16x8, p);
}
__device__ __forceinline__ void dma_mat(const bf16* src, int ld, LAS unsigned char* dst, int wid, int lane) {
    const char* sb = uni_ptr(src); const unsigned d0 = (unsigned)__builtin_amdgcn_readfirstlane((unsigned)(uintptr_t)dst + (unsigned)wid * 4096u);
#pragma unroll
    for (int k = 0; k < 4; ++k) { const int pc = wid * 4 + k, img = pc >> 4, row = 4 * (pc & 15) + (lane >> 4), pos = lane & 15;
        const int ch = pos ^ (((row & 3) << 2) | ((row >> 2) & 3));
        glds16_s(sb, (unsigned)((row * ld + img * 128 + ch * 8) * 2), d0 + (unsigned)k * 1024u); }
}
__device__ __forceinline__ void scan_unit(const bf16* __restrict__ QKV, bf16* __restrict__ Y, int b, int hd, int dir, int dvh, float lg2, bool skip_ctx_y, LAS unsigned char* lds) {
    int tid = threadIdx.x; asm volatile("" : "+v"(tid));
    const int wid = __builtin_amdgcn_readfirstlane(tid >> 6), lane0 = tid & 63;
    const LAS char* QI = (const LAS char*)lds + OFF_Q; const LAS char* KI = (const LAS char*)lds + OFF_K; const LAS char* VI = (const LAS char*)lds + OFF_V;
    LAS char* PI = (LAS char*)lds + OFF_P;
    f32x16 S[8];
#pragma unroll
    for (int i = 0; i < 8; ++i) S[i] = f32x16{};
    const float g64 = __builtin_amdgcn_exp2f(64.f * lg2);
    const int qcol = hd * RDK, kcol = 2048 + hd * RDK, vcol = 4096 + hd * RDV + dvh * 256;
    for (int n = 0; n < 68; ++n) {
        int lane = lane0; asm volatile("" : "+v"(lane));
        const int r = lane & 31, h = lane >> 5;
        const int ycol = hd * RDV + dvh * 256 + wid * 32 + r;
        int rowbase;
        if (n < 4) rowbase = MX + b * CTXL + (dir ? 3 - n : n) * CH; else rowbase = b * SEQ + (dir ? 67 - n : n - 4) * CH;
        const bf16* src = QKV + (size_t)rowbase * 8192;
        dma_mat(src + qcol, 8192, lds + OFF_Q, wid, lane); dma_mat(src + kcol, 8192, lds + OFF_K, wid, lane); dma_mat(src + vcol, 8192, lds + OFF_V, wid, lane);
        asm volatile("s_waitcnt vmcnt(0)" ::: "memory"); __syncthreads();
        if (wid < 4) {
            const int jb = wid >> 1, ib = wid & 1; f32x16 pt = f32x16{};
#pragma unroll
            for (int ks = 0; ks < 16; ++ks) { const int img = ks >> 3, s = ks & 7;
                const bf16x8 a = *(const LAS bf16x8*)(KI + img * 16384 + off_b(jb * 32 + r, 2 * s + h));
                const bf16x8 bq = *(const LAS bf16x8*)(QI + img * 16384 + off_b(ib * 32 + r, 2 * s + h));
                pt = __builtin_amdgcn_mfma_f32_32x32x16_bf16(a, bq, pt, 0, 0, 0); }
            const int i = ib * 32 + r;
#pragma unroll
            for (int g = 0; g < 4; ++g) { float v[4];
#pragma unroll
                for (int e = 0; e < 4; ++e) { const int j = jb * 32 + 8 * g + 4 * h + e; const int dd = dir ? (j - i) : (i - j);
                    v[e] = dd >= 0 ? pt[4 * g + e] * __builtin_amdgcn_exp2f((float)dd * lg2) : 0.f; }
                const int j0 = jb * 32 + 8 * g + 4 * h;
                u32x2 w; w.x = cvt_pk_bf16(v[0], v[1]); w.y = cvt_pk_bf16(v[2], v[3]);
                *(LAS u32x2*)(PI + p_off(i, j0 >> 3) + ((j0 >> 2) & 1) * 8) = w; }
        }
        f32x16 Yt[2]; Yt[0] = f32x16{}; Yt[1] = f32x16{};
#pragma unroll
        for (int dkb = 0; dkb < 8; ++dkb)
#pragma unroll
            for (int s = 0; s < 2; ++s) { const bf16x8 bf = pack_step(S[dkb], s);
                const int cl = (32 * dkb + 16 * s) & 127, img = dkb >> 2;
#pragma unroll
                for (int it = 0; it < 2; ++it) { const LAS char* rp = QI + img * 16384;
                    const s16x4 lo = *(const LAS s16x4*)(rp + off_b(it * 32 + r, cl >> 3) + 8 * h), hi4 = *(const LAS s16x4*)(rp + off_b(it * 32 + r, (cl >> 3) + 1) + 8 * h);
                    const bf16x8 af = (bf16x8){lo[0], lo[1], lo[2], lo[3], hi4[0], hi4[1], hi4[2], hi4[3]};
                    Yt[it] = __builtin_amdgcn_mfma_f32_32x32x16_bf16(af, bf, Yt[it], 0, 0, 0); } }
#pragma unroll
        for (int it = 0; it < 2; ++it)
#pragma unroll
            for (int rg = 0; rg < 16; ++rg) { const int i = it * 32 + crow(rg, h); const int tau = dir ? 63 - i : i; Yt[it][rg] *= __builtin_amdgcn_exp2f((float)(tau + 1) * lg2); }
        __syncthreads();
#pragma unroll
        for (int i = 0; i < 8; ++i)
#pragma unroll
            for (int rg = 0; rg < 16; ++rg) S[i][rg] *= g64;
#pragma unroll
        for (int ks = 0; ks < 4; ++ks) {
            const bf16x8 vf = tr_frag(VI + (wid >> 2) * 16384, lane, wid & 3, ks);
#pragma unroll
            for (int it = 0; it < 2; ++it) { const bf16x8 pa = *(const LAS bf16x8*)(PI + p_off(it * 32 + r, 2 * ks + h));
                Yt[it] = __builtin_amdgcn_mfma_f32_32x32x16_bf16(pa, vf, Yt[it], 0, 0, 0); }
            bf16x8 vz;
#pragma unroll
            for (int jj = 0; jj < 8; ++jj) { const int j = 16 * ks + 8 * h + jj; const int tau = dir ? 63 - j : j;
                const float f = __builtin_amdgcn_exp2f((float)(63 - tau) * lg2); vz[jj] = (short)(cvt_pk_bf16(bf2f((unsigned short)vf[jj]) * f, 0.f) & 0xffffu); }
#pragma unroll
            for (int dkb = 0; dkb < 8; ++dkb) { const bf16x8 ka = tr_frag(KI + (dkb >> 2) * 16384, lane, dkb & 3, ks);
                S[dkb] = __builtin_amdgcn_mfma_f32_32x32x16_bf16(ka, vz, S[dkb], 0, 0, 0); }
            __builtin_amdgcn_sched_barrier(0);
        }
        if (!(skip_ctx_y && n < 4)) {
#pragma unroll
            for (int it = 0; it < 2; ++it)
#pragma unroll
                for (int rg = 0; rg < 16; ++rg) { const int i = it * 32 + crow(rg, h);
                    Y[(size_t)(rowbase + i) * 4096 + ycol] = (bf16)(cvt_pk_bf16(Yt[it][rg], 0.f) & 0xffffu); }
        }
        __syncthreads();
    }
}
}

#define XB_TMO      128
#define XB_XCNT(j)  (256  + 64 * (j))
#define XB_XSUB(j)  (1280 + 64 * (j))
#define XB_XGEN(j)  (2304 + 64 * (j))
#define XB_TOP      3328
#define XB_TOPGEN   3392
#define XCD_BAR_WORDS 3456
#define XB_SPIN_CAP (1u << 22)
__device__ __forceinline__ unsigned xb_ld(unsigned* p)              { return __hip_atomic_load(p, __ATOMIC_RELAXED, __HIP_MEMORY_SCOPE_AGENT); }
__device__ __forceinline__ unsigned xb_add(unsigned* p, unsigned v) { return __hip_atomic_fetch_add(p, v, __ATOMIC_RELAXED, __HIP_MEMORY_SCOPE_AGENT); }
__device__ __forceinline__ unsigned xb_xcc_id() { return (unsigned)__builtin_amdgcn_s_getreg((3 << 11) | 20) & 0xFu; }
#define XB_SPIN(cond, bar) do { unsigned _sp = 0; while (cond) { __builtin_amdgcn_s_sleep(1); \
    if ((++_sp & 255u) == 0u) { if (xb_ld(&(bar)[XB_TMO])) break; if (_sp > XB_SPIN_CAP) { atomicAdd(&(bar)[XB_TMO], 1u); break; } } } } while (0)
struct XcdBarrier { unsigned* bar; unsigned x; volatile LAS unsigned* st; };
__device__ __forceinline__ XcdBarrier xcd_barrier_post(unsigned* bar, volatile LAS unsigned* st) {
    XcdBarrier b; b.bar = bar; b.x = xb_xcc_id(); b.st = st;
    if (threadIdx.x == 0) (void)xb_add(&bar[XB_XCNT(b.x)], 1u);
    return b;
}
__device__ __forceinline__ void xcd_barrier_complete(unsigned* bar, unsigned x, unsigned& nloc, unsigned& nx) {
    const unsigned G = gridDim.x * gridDim.y * gridDim.z;
    unsigned sum, cnt, mine, sp = 0u;
    for (;;) {
        sum = 0u; cnt = 0u; mine = 0u;
#pragma unroll
        for (unsigned j = 0; j < 16; ++j) { const unsigned c = xb_ld(&bar[XB_XCNT(j)]); sum += c; cnt += (c > 0u) ? 1u : 0u; mine = (j == x) ? c : mine; }
        if (sum == G) break;
        __builtin_amdgcn_s_sleep(1);
        if ((++sp & 255u) == 0u) { if (xb_ld(&bar[XB_TMO])) break; if (sp > XB_SPIN_CAP) { atomicAdd(&bar[XB_TMO], 1u); break; } }
    }
    nloc = mine > 0u ? mine : 1u; nx = cnt > 0u ? cnt : 1u;
}
__device__ __forceinline__ void xcd_barrier(const XcdBarrier& b) {
    asm volatile("s_waitcnt vmcnt(0)" ::: "memory");
    __syncthreads();
    if (threadIdx.x == 0) {
        unsigned* bar = b.bar; asm volatile("" : "+s"(bar));
        __builtin_amdgcn_s_waitcnt(0);
        unsigned nloc = b.st[0], nx = b.st[1];
        if (nloc == 0u) { xcd_barrier_complete(bar, b.x, nloc, nx); b.st[0] = nloc; b.st[1] = nx; }
        const unsigned old = xb_add(&bar[XB_XSUB(b.x)], 1u);
        const unsigned gen = old / nloc;
        if (old + 1u == (gen + 1u) * nloc) {
            __builtin_amdgcn_fence(__ATOMIC_RELEASE, "agent");
            asm volatile("s_waitcnt vmcnt(0)" ::: "memory");
            const unsigned og = xb_add(&bar[XB_TOP], 1u);
            const unsigned tg = og / nx;
            if (og + 1u == (tg + 1u) * nx) xb_add(&bar[XB_TOPGEN], 1u);
            else XB_SPIN(xb_ld(&bar[XB_TOPGEN]) == tg, bar);
            __builtin_amdgcn_fence(__ATOMIC_ACQUIRE, "agent");
            xb_add(&bar[XB_XGEN(b.x)], 1u);
            asm volatile("s_waitcnt vmcnt(0)" ::: "memory");
        } else {
            XB_SPIN(xb_ld(&bar[XB_XGEN(b.x)]) == gen, bar);
            __builtin_amdgcn_fence(__ATOMIC_ACQUIRE, "agent");
            asm volatile("s_waitcnt vmcnt(0)" ::: "memory");
        }
    }
    __syncthreads();
}

__device__ __forceinline__ float wave_sum(float v, int lane) {
#pragma unroll
    for (int o = 1; o < 64; o <<= 1) v += shfl_xor_l(v, o, lane);
    return v;
}
struct CvtDesc { const float* colptr; const float* kscale; bf16* WTrow0; int ldw, k0, K; float gscale; };
__device__ __forceinline__ void cvt_load(const CvtDesc& d, int lane, float (&v)[32]) {
#pragma unroll
    for (int i = 0; i < 32; ++i) { const int kk = 2 * i + (lane >> 5); float x = d.colptr ? d.colptr[(size_t)(d.k0 + kk) * d.ldw] : 0.f;
        if (d.kscale) x *= d.kscale[d.k0 + kk];
        v[i] = x * d.gscale; }
}
__device__ __forceinline__ void cvt_store(const CvtDesc& d, int lane, const float (&v)[32], LAS float* scr) {
#pragma unroll
    for (int i = 0; i < 32; ++i) scr[(2 * i + (lane >> 5)) * 33 + (lane & 31)] = v[i];
    asm volatile("s_waitcnt lgkmcnt(0)" ::: "memory");
    const int c = lane & 7;
#pragma unroll
    for (int j = 0; j < 4; ++j) { const int n = (lane >> 3) + 8 * j; const LAS float* s = scr + (8 * c) * 33 + n;
        u32x4 o; o.x = cvt_pk_bf16(s[0 * 33], s[1 * 33]); o.y = cvt_pk_bf16(s[2 * 33], s[3 * 33]); o.z = cvt_pk_bf16(s[4 * 33], s[5 * 33]); o.w = cvt_pk_bf16(s[6 * 33], s[7 * 33]);
        *(u32x4*)(d.WTrow0 + (size_t)n * d.K + d.k0 + 8 * c) = o; }
    asm volatile("s_waitcnt lgkmcnt(0)" ::: "memory");
}
__device__ __forceinline__ int ropeperm64(int c) { const int p = c >> 1, e = c & 1; return (p < 16) ? (p + 16 * e) : (32 + (p - 16) + 16 * e); }
__device__ __forceinline__ const float* src_col(int kind, const float* W0, const float* W1, int aux, int n) {
    switch (kind) {
        case 0: return W0 + aux + n;
        case 1: return W0 + aux + ropeperm64(n);
        case 2: { const int hh = n / DQ, d = n % DQ; return W0 + hh * DQ + (d < NOPE ? d : NOPE + ropeperm64(d - NOPE)); }
        case 3: { const int hh = n >> 8, d = n & 255; return W0 + hh * 256 + (d >> 1) + 128 * (d & 1); }
        case 4: { const int tl = n >> 8, j = n & 255; return (j < 128 ? W0 : W1) + tl * 128 + (j & 127); }
        default: return nullptr;
    }
}
struct CvtJob { const float* W0; const float* W1; const float* kscale; bf16* WT; int ldw, K, nrows, kind, aux; float gscale; };
__device__ __forceinline__ bool cvt_try(const CvtJob& J, int& it, int lane, CvtDesc& d) {
    const int nblk = J.nrows / 32, items = (J.K / 64) * nblk;
    if (it >= items) { it -= items; return false; }
    const int kb = it / nblk, nb = it % nblk;
    d.colptr = src_col(J.kind, J.W0, J.W1, J.aux, nb * 32 + (lane & 31)); d.kscale = J.kscale; d.WTrow0 = J.WT + (size_t)(nb * 32) * J.K; d.ldw = J.ldw; d.k0 = kb * 64; d.K = J.K; d.gscale = J.gscale;
    return true;
}
__device__ __forceinline__ int cvt_items(const CvtJob& J) { return (J.K / 64) * (J.nrows / 32); }

__device__ __forceinline__ void norm_mod_row(const float* xrow, const float* g, const float* sc, const float* sh, bf16* orow, int lane) {
    f32x4 v[8]; float s = 0.f;
#pragma unroll
    for (int j = 0; j < 8; ++j) { v[j] = *(const f32x4*)(xrow + 4 * lane + 256 * j); s += (v[j][0] * v[j][0] + v[j][1] * v[j][1]) + (v[j][2] * v[j][2] + v[j][3] * v[j][3]); }
    const float rstd = 1.0f / sqrtf(wave_sum(s, lane) * (1.0f / D) + NORM_EPS);
#pragma unroll
    for (int j = 0; j < 8; ++j) { const int c = 4 * lane + 256 * j; const f32x4 gg = *(const f32x4*)(g + c), s1 = *(const f32x4*)(sc + c), s0 = *(const f32x4*)(sh + c);
        const f32x4 y = (v[j] * rstd) * gg * (1.0f + s1) + s0;
        u32x2 w; w.x = cvt_pk_bf16(y[0], y[1]); w.y = cvt_pk_bf16(y[2], y[3]); *(u32x2*)(orow + c) = w; }
}

__device__ __forceinline__ unsigned long long ld_arg(LAS unsigned char* lds, int i) {
    const volatile LAS unsigned* p = (const volatile LAS unsigned*)(lds + ARGS_OFF) + 2 * i;
    const unsigned lo = __builtin_amdgcn_readfirstlane(p[0]), hi = __builtin_amdgcn_readfirstlane(p[1]);
    return ((unsigned long long)hi << 32) | lo;
}
__device__ __forceinline__ void cvt_layer(LAS unsigned char* lds, unsigned char* ws, int lc, int rank, int nranks, int wave, int lane) {
#define ARGF(i) ((const float*)ld_arg(lds, (i)))
    const int li = lc >> 1; const bool is_ret = (lc & 1) != 0;
    bf16* WM = (bf16*)(ws + (is_ret ? WS_WB : WS_WA)); bf16* WF = (bf16*)(ws + (is_ret ? WS_WB + 82 * MiB : WS_WA + 22 * MiB));
    LAS float* scr = (LAS float*)(lds + wave * 16384);
    CvtJob J[7]; int nj;
    if (!is_ret) {
        bf16* W1T = WM; bf16* WuqT = W1T + (size_t)N1 * D; bf16* WukvT = WuqT + (size_t)3072 * 512; bf16* WoT = WukvT + (size_t)4096 * 512;
        const float* wdq = ARGF(8) + (size_t)li * D * QR; const float* wdkv = ARGF(11) + (size_t)li * D * (KVR + ROPE);
        J[0] = CvtJob{wdq, nullptr, nullptr, W1T, QR, D, 512, 0, 0, 1.f};
        J[1] = CvtJob{wdkv, nullptr, nullptr, W1T + (size_t)512 * D, KVR + ROPE, D, 512, 0, 0, 1.f};
        J[2] = CvtJob{wdkv, nullptr, nullptr, W1T + (size_t)1024 * D, KVR + ROPE, D, 64, 1, 512, 1.f};
        J[3] = CvtJob{nullptr, nullptr, nullptr, W1T + (size_t)1088 * D, 1, D, 192, 5, 0, 1.f};
        J[4] = CvtJob{ARGF(10) + (size_t)li * QR * 3072, nullptr, ARGF(9) + li * QR, WuqT, 3072, QR, 3072, 2, 0, 0.07216878364870322f * LOG2E};
        J[5] = CvtJob{ARGF(13) + (size_t)li * KVR * 4096, nullptr, ARGF(12) + li * KVR, WukvT, 4096, KVR, 4096, 0, 0, 1.f};
        J[6] = CvtJob{ARGF(14) + (size_t)li * D * D, nullptr, nullptr, WoT, D, D, D, 0, 0, 1.f};
        nj = 7;
    } else {
        bf16* WqkvT = WM; bf16* WgT = WqkvT + (size_t)8192 * D; bf16* WoT = WgT + (size_t)8192 * D;
        J[0] = CvtJob{ARGF(15) + (size_t)li * D * D, nullptr, nullptr, WqkvT, D, D, 2048, 3, 0, 1.f};
        J[1] = CvtJob{ARGF(16) + (size_t)li * D * D, nullptr, nullptr, WqkvT + (size_t)2048 * D, D, D, 2048, 3, 0, 0.0625f};
        J[2] = CvtJob{ARGF(17) + (size_t)li * D * 4096, nullptr, nullptr, WqkvT + (size_t)4096 * D, 4096, D, 4096, 0, 0, 1.f};
        J[3] = CvtJob{ARGF(18) + (size_t)li * D * 4096, ARGF(19) + (size_t)li * D * 4096, nullptr, WgT, 4096, D, 8192, 4, 0, 1.f};
        J[4] = CvtJob{ARGF(20) + (size_t)li * 4096 * D, nullptr, nullptr, WoT, D, 4096, D, 0, 0, 1.f};
        J[5] = CvtJob{nullptr, nullptr, nullptr, nullptr, 1, 64, 0, 5, 0, 1.f};
        J[6] = J[5];
        nj = 5;
    }
    CvtJob F0 = CvtJob{ARGF(23) + (size_t)lc * D * FF, ARGF(24) + (size_t)lc * D * FF, nullptr, WF, FF, D, 11264, 4, 0, 1.f};
    CvtJob F1 = CvtJob{ARGF(27) + (size_t)lc * FF * D, nullptr, nullptr, WF + (size_t)11264 * D, D, FF, D, 0, 0, 1.f};
    int total = cvt_items(F0) + cvt_items(F1);
#pragma unroll
    for (int j = 0; j < 7; ++j) if (j < nj) total += cvt_items(J[j]);
#define CVT_FIND(IT, DD) do { int it_ = (IT); bool done_ = false; \
        _Pragma("unroll") for (int j = 0; j < 7; ++j) if (!done_ && j < nj) done_ = cvt_try(J[j], it_, lane, DD); \
        if (!done_) done_ = cvt_try(F0, it_, lane, DD); if (!done_) done_ = cvt_try(F1, it_, lane, DD); } while (0)
    if (rank < total) {
        float v[32], w[32]; CvtDesc d0, d1; int it0 = rank;
        CVT_FIND(it0, d0); cvt_load(d0, lane, v);
        for (;;) {
            const int it1 = it0 + nranks; const bool has = it1 < total;
            if (has) { CVT_FIND(it1, d1); cvt_load(d1, lane, w); }
            cvt_store(d0, lane, v, scr);
            if (!has) break;
#pragma unroll
            for (int i = 0; i < 32; ++i) v[i] = w[i];
            d0 = d1; it0 = it1;
        }
    }
#undef CVT_FIND
#undef ARGF
}
struct Args { const float* in[29]; float* out; unsigned char* ws; int ph_lo, ph_hi; };
constexpr int PH_PER_LAYER = 10, PH_FINAL = 1 + PH_PER_LAYER * DEPTH, PH_COUNT = PH_FINAL + 1;

template <unsigned MK_EN_T>
__global__ void __launch_bounds__(512, 2) mk_fwd(Args args) {
    extern __shared__ __attribute__((aligned(16))) unsigned char lds_raw[];
    LAS unsigned char* lds = (LAS unsigned char*)lds_raw;
    volatile LAS unsigned* MISC = (volatile LAS unsigned*)(lds + MISC_OFF);
    const int G = gridDim.x; const int bx = blockIdx.x; const int vcu = (G % 8 == 0) ? (bx % 8) * (G / 8) + bx / 8 : bx;
    const int NGW = G * 8;
    unsigned char* ws = args.ws; float* X = args.out;
    const int lo = args.ph_lo, hi = args.ph_hi;
    { const int tid0 = threadIdx.x;
      for (int u = tid0; u < (LDS_BYTES - RING_BYTES) / 4; u += 512) ((LAS unsigned*)(lds + RING_BYTES))[u] = 0u;
      __syncthreads();
      if (tid0 < 29) ((volatile LAS unsigned long long*)(lds + ARGS_OFF))[tid0] = (unsigned long long)args.in[tid0];
      __syncthreads(); }
#define ARGF(i) ((const float*)ld_arg(lds, (i)))
    XcdBarrier bar; bar.bar = (unsigned*)(ws + WS_CTL) + CW_BAR; bar.x = 0; bar.st = nullptr;
    if (hi - lo > 1) bar = xcd_barrier_post((unsigned*)(ws + WS_CTL) + CW_BAR, MISC + 8);
#define EN(b) (((MK_EN_T) >> (b)) & 1u)
#define IN(k) (lo <= (k) && (k) < hi)
#define PHASE_END(k) do { if (hi > (k) + 1) xcd_barrier(bar); } while (0)
#define PH_IDS int tid = threadIdx.x; asm volatile("" : "+v"(tid)); const int lane = tid & 63; const int wave = __builtin_amdgcn_readfirstlane(tid >> 6); const int gw = vcu * 8 + wave; (void)lane; (void)gw;
#define XC_    ((float*)(ws + WS_XC))
#define MODV_  ((float*)(ws + WS_MODV))
#define TABM_  ((float*)(ws + WS_TABM))
#define TABR_  ((float*)(ws + WS_TABR))
#define SSQ_   ((float*)(ws + WS_SSQ))
#define KR_    ((bf16*)(ws + WS_KR))
#define H_     ((bf16*)(ws + WS_H))
#define WMIX_(ll) ((bf16*)(ws + (((ll) & 1) ? WS_WB : WS_WA)))
#define WFFN_(ll) ((bf16*)(ws + (((ll) & 1) ? WS_WB + 82 * MiB : WS_WA + 22 * MiB)))
#define W1T_   WMIX_(l)
#define WUQT_  (W1T_ + (size_t)N1 * D)
#define WUKVT_ (WUQT_ + (size_t)3072 * 512)
#define WOTM_  (WUKVT_ + (size_t)4096 * 512)
#define WQKVT_ WMIX_(l)
#define WGT_   (WQKVT_ + (size_t)8192 * D)
#define WOTR_  (WGT_ + (size_t)8192 * D)
#define WGUT_  WFFN_(l)
#define WDT_   (WGUT_ + (size_t)11264 * D)
#define QKVL_  ((bf16*)(ws + WS_QKVL))
#define Q_     ((bf16*)(ws + WS_Q))
#define KV_    ((bf16*)(ws + WS_KV))
#define O_     ((bf16*)(ws + WS_O))
#define QKV_   ((bf16*)(ws + WS_QKV))
#define Y_     ((bf16*)(ws + WS_Y))
#define GATED_ ((bf16*)(ws + WS_GATED))
#define GB_    ((bf16*)(ws + WS_G))
#define UB_    ((bf16*)(ws + WS_U))
#define HALO_  ((float*)(ws + WS_G))
#define MODL_  (MODV_ + (size_t)l * 9 * NMOD)

    if (EN(0) && IN(0)) for (int rep_ = 0; rep_ < 1 + (int)((PROBE_MASK >> 0) & 1u); ++rep_) {
        PH_IDS
        LAS float* cond = (LAS float*)lds;
        LAS float* red = (LAS float*)(lds + 73728);
        { const float* cin = ARGF(1); const float* cc = ARGF(3);
          for (int i = tid; i < 9 * D; i += 512) { const int r = i >> 11, k = i & (D - 1); const float c = (r < 8) ? cin[r * D + k] : cc[k]; cond[i] = c / (1.0f + __expf(-c)); } }
        __syncthreads();
        for (int it = bx; it < DEPTH * 96; it += G) {
            const int l = it / 96, cb = it % 96; const int n = cb * 128 + 2 * lane;
            const float* W = ARGF(4) + (size_t)l * D * NMOD + n; const float* mb = ARGF(5) + (size_t)l * NMOD + cb * 128;
            float a0[9], a1[9];
#pragma unroll
            for (int r = 0; r < 9; ++r) { a0[r] = 0.f; a1[r] = 0.f; }
            for (int k = wave * 256; k < wave * 256 + 256; k += 4) {
                f32x2 w[4];
#pragma unroll
                for (int q = 0; q < 4; ++q) w[q] = *(const f32x2*)(W + (size_t)(k + q) * NMOD);
#pragma unroll
                for (int r = 0; r < 9; ++r) { const f32x4 c4 = *(const LAS f32x4*)(cond + r * D + k);
#pragma unroll
                    for (int q = 0; q < 4; ++q) { a0[r] += c4[q] * w[q][0]; a1[r] += c4[q] * w[q][1]; } }
            }
#pragma unroll
            for (int r = 0; r < 9; ++r) { red[(wave * 9 + r) * 128 + 2 * lane] = a0[r]; red[(wave * 9 + r) * 128 + 2 * lane + 1] = a1[r]; }
            __syncthreads();
            for (int i = tid; i < 9 * 128; i += 512) { const int r = i >> 7, cc = i & 127; float s = 0.f;
#pragma unroll
                for (int w8 = 0; w8 < 8; ++w8) s += red[(w8 * 9 + r) * 128 + cc];
                MODV_[((size_t)l * 9 + r) * NMOD + cb * 128 + cc] = s + mb[cc]; }
            __syncthreads();
        }
        for (int i = bx * 512 + tid; i < 64 * 16 + SEQ * 128; i += G * 512) {
            float inv, pos; float* dst;
            if (i < 1024) { const int p = i >> 4, f = i & 15; inv = __builtin_amdgcn_exp2f(-(float)(2 * f) * (13.287712379549449f / 32.0f)); pos = (float)p; dst = TABM_ + 2 * i; }
            else { const int j = i - 1024, t = j >> 7, f = j & 127; inv = __builtin_amdgcn_exp2f(-(float)(2 * f) * (13.287712379549449f / 256.0f)); pos = (float)t; dst = TABR_ + 2 * j; }
            const float ang = pos * inv; const double rev = (double)ang * 0.15915494309189535; const float fr = (float)(rev - floor(rev));
            dst[0] = __builtin_amdgcn_cosf(fr); dst[1] = __builtin_amdgcn_sinf(fr);
        }
        PHASE_END(0);
    }

    for (int l = 0; l < DEPTH; ++l) {
        const int P = 1 + PH_PER_LAYER * l; const int li = l >> 1; const bool is_ret = (l & 1) != 0; const bool last = (l == DEPTH - 1);
        const int Mrows = last ? MX : MT;

        if (EN(1) && IN(P + 0)) for (int rep_ = 0; rep_ < 1 + (int)((PROBE_MASK >> 1) & 1u); ++rep_) {
            PH_IDS
            if (l == 0) cvt_layer(lds, ws, 0, gw, NGW, wave, lane);
            const float* g = ARGF(6) + l * D; const float* xsrc = (l == 0) ? ARGF(0) : X; const float* csrc = (l == 0) ? ARGF(2) : XC_;
            for (int m = gw; m < MT; m += NGW) { const bool isx = m < MX; const float* mr = MODL_ + (size_t)(isx ? (m >> 12) : 8) * NMOD;
                norm_mod_row(isx ? xsrc + (size_t)m * D : csrc + (size_t)(m - MX) * D, g, mr + D, mr, H_ + (size_t)m * D, lane); }
            PHASE_END(P + 0);
        }

        if (!is_ret) {
            if (EN(2) && IN(P + 1)) for (int rep_ = 0; rep_ < 1 + (int)((PROBE_MASK >> 2) & 1u); ++rep_) {
                pg8::Gemm g{H_, W1T_, MT, N1, D, D}; pg8::StaticOrder S; S.init(MT, N1, G, bx);
                EpiG1 E{QKVL_, SSQ_, KR_, TABM_};
                pg8::gemm_phase<EpiG1>(lds, g, S, E);
                PHASE_END(P + 1);
            }
            if (EN(3) && IN(P + 2)) for (int rep_ = 0; rep_ < 1 + (int)((PROBE_MASK >> 3) & 1u); ++rep_) {
                { pg8::Gemm g{QKVL_, WUQT_, MT, 3072, QR, N1}; pg8::StaticOrder S; S.init(MT, 3072, G, bx); EpiUq E{Q_, SSQ_, TABM_}; pg8::gemm_phase<EpiUq>(lds, g, S, E); }
                { pg8::Gemm g{QKVL_ + 512, WUKVT_, MT, 4096, KVR, N1}; pg8::StaticOrder S; S.init(MT, 4096, G, bx); EpiUkv E{KV_, SSQ_}; pg8::gemm_phase<EpiUkv>(lds, g, S, E); }
                PHASE_END(P + 2);
            }
            if (EN(4) && IN(P + 3)) for (int rep_ = 0; rep_ < 1 + (int)((PROBE_MASK >> 4) & 1u); ++rep_) {
                const int nun = 2048 + 128;
                for (int ui = vcu; ui < nun; ui += G) {
                    if (ui < 2048) { const int xcd = (ui & 255) >> 5, j = ui & 31, rnd = ui >> 8; const int bh = xcd * 16 + 2 * rnd + (j >> 4), qb = j & 15; const int b = bh >> 4, hd = bh & 15;
                        att::attn_unit(Q_ + (size_t)(b * SEQ + qb * 256) * 3072 + hd * DQ, KV_ + hd * 256, KR_, O_ + (size_t)(b * SEQ + qb * 256) * D + hd * 128, 68, 4, MX + b * CTXL, b * SEQ, (char*)lds_raw);
                    } else { const int bh = ui - 2048, b = bh >> 4, hd = bh & 15;
                        att::attn_unit(Q_ + (size_t)(MX + b * CTXL) * 3072 + hd * DQ, KV_ + hd * 256, KR_, O_ + (size_t)(MX + b * CTXL) * D + hd * 128, 4, 4, MX + b * CTXL, 0, (char*)lds_raw); }
                }
                PHASE_END(P + 3);
            }
        } else {
            if (EN(5) && IN(P + 1)) for (int rep_ = 0; rep_ < 1 + (int)((PROBE_MASK >> 5) & 1u); ++rep_) {
                pg8::Gemm g{H_, WQKVT_, MT, 8192, D, D}; pg8::StaticOrder S; S.init(MT, 8192, G, bx);
                EpiQKV E{QKV_, TABR_};
                pg8::gemm_phase<EpiQKV>(lds, g, S, E);
                PHASE_END(P + 1);
            }
            if (EN(6) && IN(P + 2)) for (int rep_ = 0; rep_ < 1 + (int)((PROBE_MASK >> 6) & 1u); ++rep_) {
                for (int ui = vcu; ui < 256; ui += G) {
                    const int bh = ui >> 2, dir = (ui >> 1) & 1, dvh = ui & 1; const int b = bh >> 3, hd = bh & 7;
                    const float dec = (dir ? ARGF(22) : ARGF(21))[li * RH + hd];
                    const float lg2 = -__expf(dec) * LOG2E;
                    scan::scan_unit(QKV_, Y_ + (size_t)dir * MT * 4096, b, hd, dir, dvh, lg2, last, lds);
                }
                PHASE_END(P + 2);
            }
            if (EN(7) && IN(P + 3)) for (int rep_ = 0; rep_ < 1 + (int)((PROBE_MASK >> 7) & 1u); ++rep_) {
                PH_IDS
                const int nitems = Mrows * RH * 2;
                for (int it = gw; it < nitems; it += NGW) { const int dir = it & 1, hd = (it >> 1) & 7, row = it >> 4;
                    bf16* p = Y_ + (size_t)dir * MT * 4096 + (size_t)row * 4096 + hd * RDV + lane * 8;
                    const u32x4 w = *(const u32x4*)p; float v[8] = {bflo(w.x), bfhi(w.x), bflo(w.y), bfhi(w.y), bflo(w.z), bfhi(w.z), bflo(w.w), bfhi(w.w)};
                    float s = 0.f;
#pragma unroll
                    for (int e = 0; e < 8; ++e) s += v[e];
                    const float mu = wave_sum(s, lane) * (1.0f / RDV); float q = 0.f;
#pragma unroll
                    for (int e = 0; e < 8; ++e) { v[e] -= mu; q += v[e] * v[e]; }
                    const float rstd = 1.0f / sqrtf(wave_sum(q, lane) * (1.0f / RDV) + GN_EPS);
                    u32x4 o; o.x = cvt_pk_bf16(v[0] * rstd, v[1] * rstd); o.y = cvt_pk_bf16(v[2] * rstd, v[3] * rstd); o.z = cvt_pk_bf16(v[4] * rstd, v[5] * rstd); o.w = cvt_pk_bf16(v[6] * rstd, v[7] * rstd);
                    *(u32x4*)p = o; }
                PHASE_END(P + 3);
            }
            if (EN(8) && IN(P + 4)) for (int rep_ = 0; rep_ < 1 + (int)((PROBE_MASK >> 8) & 1u); ++rep_) {
                pg8::Gemm g{H_, WGT_, Mrows, 8192, D, D}; pg8::StaticOrder S; S.init(Mrows, 8192, G, bx);
                EpiGate E{GATED_, Y_, Y_ + (size_t)MT * 4096};
                pg8::gemm_phase<EpiGate>(lds, g, S, E);
                PHASE_END(P + 4);
            }
        }
        if (EN(9) && IN(P + 5)) for (int rep_ = 0; rep_ < 1 + (int)((PROBE_MASK >> 9) & 1u); ++rep_) {
            pg8::Gemm g = is_ret ? pg8::Gemm{GATED_, WOTR_, Mrows, D, 4096, 4096} : pg8::Gemm{O_, WOTM_, Mrows, D, D, D};
            pg8::StaticOrder S; S.init(Mrows, D, G, bx);
            const float* xsrc = (l == 0) ? ARGF(0) : X; const float* csrc = (l == 0) ? ARGF(2) : XC_;
            EpiResid E{xsrc, X, csrc, XC_, MODL_, 2 * D};
            pg8::gemm_phase<EpiResid>(lds, g, S, E);
            PHASE_END(P + 5);
        }
        if (EN(10) && IN(P + 6)) for (int rep_ = 0; rep_ < 1 + (int)((PROBE_MASK >> 10) & 1u); ++rep_) {
            PH_IDS
            const float* g = ARGF(7) + l * D;
            for (int m = gw; m < Mrows; m += NGW) { const bool isx = m < MX; const float* mr = MODL_ + (size_t)(isx ? (m >> 12) : 8) * NMOD;
                norm_mod_row(isx ? X + (size_t)m * D : XC_ + (size_t)(m - MX) * D, g, mr + 4 * D, mr + 3 * D, H_ + (size_t)m * D, lane); }
            PHASE_END(P + 6);
        }
        if (EN(11) && IN(P + 7)) for (int rep_ = 0; rep_ < 1 + (int)((PROBE_MASK >> 11) & 1u); ++rep_) {
            pg8::Gemm g{H_, WGUT_, Mrows, 11264, D, D}; pg8::StaticOrder S; S.init(Mrows, 11264, G, bx);
            EpiGUConv E{UB_, HALO_, ARGF(25) + (size_t)l * 3 * FF, ARGF(26) + (size_t)l * FF, (LAS float*)(lds + EDGE_OFF)};
            pg8::gemm_phase<EpiGUConv>(lds, g, S, E);
            PHASE_END(P + 7);
        }
        if (EN(12) && IN(P + 8)) for (int rep_ = 0; rep_ < 1 + (int)((PROBE_MASK >> 12) & 1u); ++rep_) {
            PH_IDS
            const float* cw = ARGF(25) + (size_t)l * 3 * FF; const float* cb = ARGF(26) + (size_t)l * FF; (void)cb;
            const float* HL = HALO_; bf16* ACT = UB_;
            const int nq = FF / 4;
            for (int i = bx * 512 + tid; i < 120 * nq; i += G * 512) {
                const int bi = i / nq, f = (i % nq) * 4; const int pm = (bi / 15) * 16 + (bi % 15) + 1;
                const float* top = HL + (size_t)((pm * 2 + 0) * 3) * HALO_STRIDE + f; const float* bot = HL + (size_t)(((pm - 1) * 2 + 1) * 3) * HALO_STRIDE + f;
                const f32x4 ct = *(const f32x4*)top, gt = *(const f32x4*)(top + HALO_STRIDE), ut = *(const f32x4*)(top + 2 * HALO_STRIDE);
                const f32x4 cbm = *(const f32x4*)bot, gb = *(const f32x4*)(bot + HALO_STRIDE), ub = *(const f32x4*)(bot + 2 * HALO_STRIDE);
                const f32x4 w0 = *(const f32x4*)(cw + f), w2 = *(const f32x4*)(cw + 2 * FF + f);
                const f32x4 ot = silu4(ct + w0 * gb) * ut, ob = silu4(cbm + w2 * gt) * ub;
                u32x2 wt, wb; wt.x = cvt_pk_bf16(ot[0], ot[1]); wt.y = cvt_pk_bf16(ot[2], ot[3]); wb.x = cvt_pk_bf16(ob[0], ob[1]); wb.y = cvt_pk_bf16(ob[2], ob[3]);
                *(u32x2*)(ACT + (size_t)(pm * 256) * FF + f) = wt; *(u32x2*)(ACT + (size_t)(pm * 256 - 1) * FF + f) = wb;
            }
            PHASE_END(P + 8);
        }
        if (EN(13) && IN(P + 9)) for (int rep_ = 0; rep_ < 1 + (int)((PROBE_MASK >> 13) & 1u); ++rep_) {
            pg8::Gemm g{UB_, WDT_, Mrows, D, FF, FF}; pg8::StaticOrder S; S.init(Mrows, D, G, bx);
            EpiResid E{X, X, XC_, XC_, MODL_, 5 * D};
            pg8::gemm_phase<EpiResid>(lds, g, S, E);
            if (l + 1 < DEPTH) {
                PH_IDS
                const int nwg = (Mrows / 256) * (D / 256), rem = nwg % G;
                if (rem == 0) cvt_layer(lds, ws, l + 1, gw, NGW, wave, lane);
                else if (bx >= rem) cvt_layer(lds, ws, l + 1, (bx - rem) * 8 + wave, (G - rem) * 8, wave, lane);
            }
            PHASE_END(P + 9);
        }
    }
    if (EN(14) && IN(PH_FINAL)) for (int rep_ = 0; rep_ < 1 + (int)((PROBE_MASK >> 14) & 1u); ++rep_) {
        PH_IDS
        const float* g = ARGF(28);
        for (int m = gw; m < MX; m += NGW) { float* xr = X + (size_t)m * D;
            f32x4 v[8]; float s = 0.f;
#pragma unroll
            for (int j = 0; j < 8; ++j) { v[j] = *(const f32x4*)(xr + 4 * lane + 256 * j); s += (v[j][0] * v[j][0] + v[j][1] * v[j][1]) + (v[j][2] * v[j][2] + v[j][3] * v[j][3]); }
            const float rstd = 1.0f / sqrtf(wave_sum(s, lane) * (1.0f / D) + NORM_EPS);
#pragma unroll
            for (int j = 0; j < 8; ++j) { const int c = 4 * lane + 256 * j; *(f32x4*)(xr + c) = (v[j] * rstd) * *(const f32x4*)(g + c); } }
    }
#undef IN
#undef PHASE_END
}

#if !MK_SINGLE
typedef void (*KernFn)(Args);
static KernFn phase_kernel(int bit) {
    switch (bit) {
        case 0: return mk_fwd<1u << 0>;  case 1: return mk_fwd<1u << 1>;  case 2: return mk_fwd<1u << 2>;  case 3: return mk_fwd<1u << 3>;
        case 4: return mk_fwd<1u << 4>;  case 5: return mk_fwd<1u << 5>;  case 6: return mk_fwd<1u << 6>;  case 7: return mk_fwd<1u << 7>;
        case 8: return mk_fwd<1u << 8>;  case 9: return mk_fwd<1u << 9>;  case 10: return mk_fwd<1u << 10>; case 11: return mk_fwd<1u << 11>;
        case 12: return mk_fwd<1u << 12>; case 13: return mk_fwd<1u << 13>; default: return mk_fwd<1u << 14>;
    }
}
static int phase_bit(int p) {
    if (p == 0) return 0; if (p == PH_FINAL) return 14;
    const int l = (p - 1) / PH_PER_LAYER, slot = (p - 1) % PH_PER_LAYER; const bool ret = (l & 1) != 0;
    if (slot == 0) return 1;
    if (slot >= 5) return 4 + slot;
    if (!ret) return slot == 4 ? -1 : 1 + slot;
    return 4 + slot;
}
#endif
extern "C" void kernel_launch(void* const* d_in, const int* in_sizes, int n_in, void* d_out, int out_size, void* d_ws, size_t ws_size, hipStream_t stream) {
    static int grid = 0;
    if (grid == 0) {
        if (n_in != 29 || out_size != MX * D || ws_size < WS_END) { fprintf(stderr, "kernel_launch: unexpected shapes: n_in %d out %d ws %zu (need %zu)\n", n_in, out_size, ws_size, (size_t)WS_END); grid = -1; return; }
        int dev = 0, cus = 0;
        if (hipGetDevice(&dev) != hipSuccess || hipDeviceGetAttribute(&cus, hipDeviceAttributeMultiprocessorCount, dev) != hipSuccess) { grid = -1; return; }
#if MK_SINGLE
        if (hipFuncSetAttribute((const void*)mk_fwd<0xFFFFFFFFu>, hipFuncAttributeMaxDynamicSharedMemorySize, LDS_BYTES) != hipSuccess) { fprintf(stderr, "kernel_launch: hipFuncSetAttribute failed\n"); grid = -1; return; }
#else
        for (int b = 0; b < 15; ++b) if (hipFuncSetAttribute((const void*)phase_kernel(b), hipFuncAttributeMaxDynamicSharedMemorySize, LDS_BYTES) != hipSuccess) { fprintf(stderr, "kernel_launch: hipFuncSetAttribute failed\n"); grid = -1; return; }
#endif
        (void)hipGetLastError();
        grid = cus;
    }
    if (grid < 0) return;
    if (hipMemsetAsync((char*)d_ws + WS_CTL, 0, CTL_BYTES, stream) != hipSuccess) return;
    Args a{};
    for (int i = 0; i < 29; ++i) a.in[i] = (const float*)d_in[i];
    a.out = (float*)d_out; a.ws = (unsigned char*)d_ws;
#if MK_SINGLE
    a.ph_lo = 0; a.ph_hi = PH_COUNT;
    hipLaunchKernelGGL(mk_fwd<0xFFFFFFFFu>, dim3(grid), dim3(512), LDS_BYTES, stream, a);
#else
    for (int p = 0; p < PH_COUNT; ++p) {
        const int bit = phase_bit(p); if (bit < 0) continue;
        a.ph_lo = p; a.ph_hi = p + 1;
        hipLaunchKernelGGL(phase_kernel(bit), dim3(grid), dim3(512), LDS_BYTES, stream, a);
    }
#endif
    const hipError_t le = hipPeekAtLastError();
    if (le != hipSuccess) fprintf(stderr, "kernel_launch: launch failed: %s\n", hipGetErrorName(le));
}
```

```cpp
#include <hip/hip_runtime.h>
#include <cstdio>
#include <cstdint>

#ifndef MK_SINGLE
#define MK_SINGLE 1
#endif

#ifndef MK_STAGGER
#define MK_STAGGER 0
#endif
#ifndef PROBE_EPI2
#define PROBE_EPI2 0
#endif
#ifndef PROBE_MASK
#define PROBE_MASK 0u
#endif
#define GAS __attribute__((address_space(1)))
#define LAS __attribute__((address_space(3)))
typedef unsigned short bf16;
typedef short bf16x8 __attribute__((ext_vector_type(8)));
typedef short s16x4 __attribute__((ext_vector_type(4)));
typedef float f32x2 __attribute__((ext_vector_type(2)));
typedef float f32x4 __attribute__((ext_vector_type(4)));
typedef float f32x16 __attribute__((ext_vector_type(16)));
typedef unsigned u32x2 __attribute__((ext_vector_type(2)));
typedef unsigned u32x4 __attribute__((ext_vector_type(4)));
typedef GAS unsigned gu32;

constexpr int D = 2048, NB = 8, SEQ = 4096, CTXL = 256, DEPTH = 4;
constexpr int MX = NB * SEQ, MC = NB * CTXL, MT = MX + MC;
constexpr int FF = 5632, NMOD = 6 * D;
constexpr int MLA_H = 16, QR = 512, KVR = 512, NOPE = 128, ROPE = 64, DQ = 192;
constexpr int N1 = 1280;
constexpr int RH = 8, RDK = 256, RDV = 512;
constexpr float NORM_EPS = 1e-6f, GN_EPS = 1e-5f;
constexpr float LOG2E = 1.4426950408889634f;

constexpr size_t MiB = 1u << 20;
constexpr size_t WS_CTL = 0, CTL_BYTES = 1 * MiB;
constexpr size_t WS_MODV = 1 * MiB;
constexpr size_t WS_TABM = 3 * MiB;
constexpr size_t WS_TABR = 4 * MiB;
constexpr size_t WS_SSQ = 8 * MiB;
constexpr size_t WS_XC = 12 * MiB;
constexpr size_t WS_KR = 28 * MiB;
constexpr size_t WS_WA = 40 * MiB;
constexpr size_t WS_WB = 128 * MiB;
constexpr size_t WS_H = 276 * MiB;
constexpr size_t WS_BIG = 412 * MiB;
constexpr size_t WS_QKVL = WS_BIG, WS_Q = WS_BIG + 88 * MiB, WS_KV = WS_BIG + 292 * MiB, WS_O = WS_BIG + 564 * MiB;
constexpr size_t WS_QKV = WS_BIG, WS_Y = WS_BIG + 544 * MiB, WS_GATED = WS_BIG;
constexpr size_t WS_G = WS_BIG, WS_U = WS_BIG + 374 * MiB;
constexpr size_t WS_END = WS_BIG + 1088 * MiB;
static_assert((size_t)MT * 8192 * 2 <= 544 * MiB && (size_t)MT * 5632 * 2 <= 374 * MiB && (size_t)MT * N1 * 2 <= 88 * MiB, "ws map");

constexpr int CW_BAR = 4096;

constexpr int RING_BYTES = 131072, CTRL_BASE = 155648, MISC_OFF = CTRL_BASE + 320, ARGS_OFF = CTRL_BASE + 1024, EDGE_OFF = CTRL_BASE + 4096, LDS_BYTES = 163840;

__device__ __forceinline__ unsigned cvt_pk_bf16(float lo, float hi) { unsigned r; asm volatile("v_cvt_pk_bf16_f32 %0, %1, %2" : "=v"(r) : "v"(lo), "v"(hi)); return r; }
__device__ __forceinline__ float bf2f(unsigned short b) { return __uint_as_float((unsigned)b << 16); }
__device__ __forceinline__ float bflo(unsigned w) { return __uint_as_float(w << 16); }
__device__ __forceinline__ float bfhi(unsigned w) { return __uint_as_float(w & 0xffff0000u); }
__device__ __forceinline__ float shfl_xor_l(float v, int mask, int lane) { return __builtin_bit_cast(float, __builtin_amdgcn_ds_bpermute((lane ^ mask) << 2, __builtin_bit_cast(int, v))); }
__device__ __forceinline__ float fast_silu(float x) { return x * __builtin_amdgcn_rcpf(1.0f + __builtin_amdgcn_exp2f(-x * LOG2E)); }

__device__ __forceinline__ void glds16_s(const void* sbase, unsigned voff, unsigned lds_dst) {
    unsigned keep;
    asm volatile("s_mov_b32 %0, m0\n\ts_mov_b32 m0, %3\n\ts_nop 0\n\tglobal_load_lds_dwordx4 %1, %2\n\ts_mov_b32 m0, %0" : "=&s"(keep) : "v"(voff), "s"(sbase), "s"(lds_dst) : "memory");
}
__device__ __forceinline__ const char* uni_ptr(const void* p) {
    const unsigned long long v = (unsigned long long)p; const unsigned lo = __builtin_amdgcn_readfirstlane((unsigned)v), hi = __builtin_amdgcn_readfirstlane((unsigned)(v >> 32));
    return (const char*)(((unsigned long long)hi << 32) | lo);
}
namespace pg8 {
constexpr int BM = 256, BK = 64, HALF = 128, HTB = HALF * BK * 2, STAGE_BYTES = 8 * HTB, NXCD = 8, WGM = 8;
__host__ __device__ __forceinline__ int lds_byte(int r, int c) { const int st = (r >> 4) * 2 + (c >> 5), rr = r & 15, cc = c & 31, ob = rr * 64 + cc * 2; return st * 1024 + (ob ^ (((ob >> 9) & 1) << 5)); }
__host__ __device__ __forceinline__ void stage_rc(int b, int& R, int& C) { const int st = b / 1024, sb = b % 1024, swz = sb ^ (((sb >> 9) & 1) << 5); R = (st >> 1) * 16 + swz / 64; C = (st & 1) * 32 + (swz % 64) / 2; }
__host__ __device__ __forceinline__ int perm32(int rho) { const int n = rho >> 4, i = rho & 15; return 8 * (i >> 2) + 4 * n + (i & 3); }
struct Unit { int pm, pn; };
struct Gemm { const bf16* A; const bf16* Bt; int M, N, K, lda; };
struct StaticOrder {
    int nM, nN, nwg, G, c;
    __device__ void init(int M, int N, int G_, int c_) { nM = M / BM; nN = N / BM; nwg = nM * nN; G = G_; c = c_; }
    __device__ bool next(int i, Unit& u) const {
        const long L = (long)i * G + c; if (L >= nwg) return false;
        int wgid = (int)L; { const int q = nwg / NXCD, r = nwg % NXCD, xcd = wgid % NXCD, off = wgid / NXCD; wgid = (xcd < r ? xcd * (q + 1) : r * (q + 1) + (xcd - r) * q) + off; }
        const int nig = WGM * nN, gid = wgid / nig, fm = gid * WGM, gsz = (nM - fm) < WGM ? (nM - fm) : WGM;
        u.pm = fm + ((wgid % nig) % gsz); u.pn = (wgid % nig) / gsz; return true;
    }
};
template <class Epi>
__device__ __forceinline__ void gemm_phase(LAS unsigned char* lds, const Gemm g, const StaticOrder& S, const Epi& E) {
    int tid = threadIdx.x; asm volatile("" : "+v"(tid));
    const int wid = __builtin_amdgcn_readfirstlane(tid >> 6), lane = tid & 63, wr = wid >> 2, wc = wid & 3, fr = lane & 15, fq = lane >> 4;
    const int K = g.K, nt = K / BK;
    unsigned voffA[2], voffB[2];
#pragma unroll
    for (int i = 0; i < 2; ++i) { int R, C; stage_rc(tid * 16 + i * 8192, R, C); const int Rb = Epi::PERM ? ((R & ~31) + perm32(R & 31)) : R;
        voffA[i] = (unsigned)(R * g.lda + C) * 2u; voffB[i] = (unsigned)(Rb * K + C) * 2u; }
    const size_t kstep = (size_t)(BK * 2);
    const size_t hstepA = (size_t)HALF * g.lda * 2, hstepB = (size_t)HALF * K * 2;
    const size_t tstepA = 2 * hstepA, tstepB = 2 * hstepB;
    const unsigned ldsbase = (unsigned)__builtin_amdgcn_readfirstlane((unsigned)(uintptr_t)lds + (unsigned)wid * 1024u);
    const int aoff = lds_byte(wr * 64 + fr, fq * 8), boff = lds_byte(wc * 32 + fr, fq * 8);
#define PG8_SA(b, h) (((b) * 2 + (h)) * HTB)
#define PG8_SB(b, h) ((4 + (b) * 2 + (h)) * HTB)
#define PG8_STAGE(bufoff, gbase, voff) do { const char* _gb = uni_ptr(gbase); _Pragma("unroll") for (int _i = 0; _i < 2; ++_i) \
        glds16_s(_gb, (voff)[_i], ldsbase + (unsigned)((bufoff) + _i * 8192)); } while (0)
#define PG8_LDA(dst, b, h) do { _Pragma("unroll") for (int m = 0; m < 4; ++m) _Pragma("unroll") for (int k = 0; k < 2; ++k) dst[m][k] = *(const LAS bf16x8*)(lds + PG8_SA(b, h) + aoff + m * 2048 + k * 1024); } while (0)
#define PG8_LDB(dst, b, h) do { _Pragma("unroll") for (int n = 0; n < 2; ++n) _Pragma("unroll") for (int k = 0; k < 2; ++k) dst[n][k] = *(const LAS bf16x8*)(lds + PG8_SB(b, h) + boff + n * 2048 + k * 1024); } while (0)
#define PG8_MMA(ai, bj, At, Bt) do { __builtin_amdgcn_s_setprio(1); _Pragma("unroll") for (int m = 0; m < 4; ++m) _Pragma("unroll") for (int n = 0; n < 2; ++n) _Pragma("unroll") for (int k = 0; k < 2; ++k) \
        acc[ai][bj][m][n] = __builtin_amdgcn_mfma_f32_16x16x32_bf16(Bt[n][k], At[m][k], acc[ai][bj][m][n], 0, 0, 0); __builtin_amdgcn_s_setprio(0); } while (0)
#define PG8_WAIT_V(n) asm volatile("s_waitcnt vmcnt(" #n ")" ::: "memory")
#define PG8_WAIT_L(n) asm volatile("s_waitcnt lgkmcnt(" #n ")" ::: "memory")
#define PG8_BAR __builtin_amdgcn_s_barrier()
#define PG8_SCHED __builtin_amdgcn_sched_barrier(0)
    Unit cur, nxt; int ui = 0;
    if (!S.next(0, cur)) return;
#if MK_STAGGER
    if (S.c & 1) {
        const unsigned long long t0 = __builtin_amdgcn_s_memrealtime(); const unsigned long long dt = (unsigned long long)nt * MK_STAGGER;
        while (__builtin_amdgcn_s_memrealtime() - t0 < dt) __builtin_amdgcn_s_sleep(8);
    }
#endif
    f32x4 acc[2][2][4][2];
#pragma unroll
    for (int a = 0; a < 2; ++a)
#pragma unroll
        for (int b = 0; b < 2; ++b)
#pragma unroll
            for (int m = 0; m < 4; ++m)
#pragma unroll
                for (int n = 0; n < 2; ++n) acc[a][b][m][n] = (f32x4){0.f, 0.f, 0.f, 0.f};
    bf16x8 At[4][2], B0[2][2], B1[2][2];
    const char* cA = (const char*)g.A + (size_t)cur.pm * tstepA; const char* cB = (const char*)g.Bt + (size_t)cur.pn * tstepB;
    PG8_STAGE(PG8_SB(0, 0), cB, voffB); PG8_STAGE(PG8_SB(0, 1), cB + hstepB, voffB); PG8_STAGE(PG8_SA(0, 0), cA, voffA); PG8_STAGE(PG8_SA(0, 1), cA + hstepA, voffA);
    if (wr == 1) PG8_BAR;
    PG8_WAIT_V(2); PG8_BAR;
    PG8_STAGE(PG8_SB(1, 0), cB + kstep, voffB); PG8_STAGE(PG8_SA(1, 0), cA + kstep, voffA); PG8_STAGE(PG8_SB(1, 1), cB + hstepB + kstep, voffB);
    PG8_WAIT_V(6); PG8_BAR;
    for (;;) {
        const bool has_next = S.next(ui + 1, nxt);
        const char* nA = has_next ? (const char*)g.A + (size_t)nxt.pm * tstepA : cA; const char* nB = has_next ? (const char*)g.Bt + (size_t)nxt.pn * tstepB : cB;
        for (int t = 0; t < nt; t += 2) {
            const bool last = (t == nt - 2);
            const char* a1 = cA + (size_t)(t + 1) * kstep;
            const char* a2 = last ? nA : cA + (size_t)(t + 2) * kstep; const char* b2 = last ? nB : cB + (size_t)(t + 2) * kstep;
            const char* a3 = a2 + kstep; const char* b3 = b2 + kstep;
            PG8_LDB(B0, 0, 0); PG8_LDB(B1, 0, 1); PG8_SCHED; PG8_LDA(At, 0, 0); PG8_STAGE(PG8_SA(1, 1), a1 + hstepA, voffA);
            PG8_WAIT_V(8); PG8_WAIT_L(0); PG8_BAR; PG8_MMA(0, 0, At, B0); PG8_MMA(0, 1, At, B1); PG8_BAR; PG8_SCHED;
            PG8_LDA(At, 0, 1); PG8_STAGE(PG8_SB(0, 0), b2, voffB); PG8_STAGE(PG8_SB(0, 1), b2 + hstepB, voffB); PG8_STAGE(PG8_SA(0, 0), a2, voffA);
            PG8_WAIT_V(8); PG8_WAIT_L(0); PG8_BAR; PG8_MMA(1, 0, At, B0); PG8_MMA(1, 1, At, B1); PG8_BAR; PG8_SCHED;
            PG8_LDB(B0, 1, 0); PG8_LDB(B1, 1, 1); PG8_SCHED; PG8_LDA(At, 1, 0); PG8_STAGE(PG8_SA(0, 1), a2 + hstepA, voffA);
            PG8_WAIT_V(8); PG8_WAIT_L(0); PG8_BAR; PG8_MMA(0, 0, At, B0); PG8_MMA(0, 1, At, B1); PG8_BAR; PG8_SCHED;
            PG8_LDA(At, 1, 1); PG8_STAGE(PG8_SB(1, 0), b3, voffB); PG8_STAGE(PG8_SB(1, 1), b3 + hstepB, voffB); PG8_STAGE(PG8_SA(1, 0), a3, voffA);
            PG8_WAIT_V(8); PG8_WAIT_L(0); PG8_BAR; PG8_MMA(1, 0, At, B0); PG8_MMA(1, 1, At, B1); PG8_BAR; PG8_SCHED;
        }
        if (wr == 0) PG8_BAR;
        E(acc, cur, wr, wc, fr, fq);
#if PROBE_EPI2
        if (Epi::PROBE2) E(acc, cur, wr, wc, fr, fq);
#endif
        if (!has_next) break;
#pragma unroll
        for (int a = 0; a < 2; ++a)
#pragma unroll
            for (int b = 0; b < 2; ++b)
#pragma unroll
                for (int m = 0; m < 4; ++m)
#pragma unroll
                    for (int n = 0; n < 2; ++n) acc[a][b][m][n] = (f32x4){0.f, 0.f, 0.f, 0.f};
        cur = nxt; cA = nA; cB = nB; ++ui;
        if (wr == 1) PG8_BAR;
    }
    PG8_WAIT_V(0);
    PG8_BAR;
#undef PG8_SA
#undef PG8_SB
#undef PG8_STAGE
#undef PG8_LDA
#undef PG8_LDB
#undef PG8_MMA
#undef PG8_WAIT_V
#undef PG8_WAIT_L
#undef PG8_BAR
#undef PG8_SCHED
}
}
using pg8::Unit;

__device__ __forceinline__ u32x4 pack8(const f32x4 a, const f32x4 b) { u32x4 w; w.x = cvt_pk_bf16(a[0], a[1]); w.y = cvt_pk_bf16(a[2], a[3]); w.z = cvt_pk_bf16(b[0], b[1]); w.w = cvt_pk_bf16(b[2], b[3]); return w; }
__device__ __forceinline__ f32x4 rot2(const f32x4 v, const f32x4 cs) { f32x4 o; o[0] = v[0] * cs[0] - v[1] * cs[1]; o[1] = v[1] * cs[0] + v[0] * cs[1]; o[2] = v[2] * cs[2] - v[3] * cs[3]; o[3] = v[3] * cs[2] + v[2] * cs[3]; return o; }

__device__ __forceinline__ f32x4 mla_cs(const float* tabm, int t, int c4) {
    const int p0 = c4 >> 1; const int pos = (p0 < 16) ? (t >> 6) : (t & 63); const int f = p0 & 15;
    return *(const f32x4*)(tabm + ((size_t)pos * 16 + f) * 2);
}

struct EpiG1 {
    static constexpr bool PERM = true, PROBE2 = false;
    bf16* QKVL; float* SSQ; bf16* KR; const float* tabm;
    __device__ __forceinline__ void operator()(const f32x4 (&acc)[2][2][4][2], const Unit& u, int wr, int wc, int fr, int fq) const {
        const int row0 = u.pm * 256 + wr * 64 + fr;
        if (u.pn < 4) {
            const int col0 = u.pn * 256 + wc * 32 + 8 * fq;
#pragma unroll
            for (int ai = 0; ai < 2; ++ai)
#pragma unroll
                for (int m = 0; m < 4; ++m) { const int row = row0 + ai * 128 + m * 16; float ss = 0.f;
#pragma unroll
                    for (int bj = 0; bj < 2; ++bj) { const f32x4 v0 = acc[ai][bj][m][0], v1 = acc[ai][bj][m][1];
                        ss += (v0[0] * v0[0] + v0[1] * v0[1]) + (v0[2] * v0[2] + v0[3] * v0[3]) + (v1[0] * v1[0] + v1[1] * v1[1]) + (v1[2] * v1[2] + v1[3] * v1[3]);
                        *(u32x4*)(QKVL + (size_t)row * N1 + col0 + bj * 128) = pack8(v0, v1); }
                    { const int ln_ = fr + 16 * fq; ss += shfl_xor_l(ss, 16, ln_); ss += shfl_xor_l(ss, 32, ln_); }
                    if (fq == 0) SSQ[(size_t)row * 16 + u.pn * 4 + wc] = ss; asm volatile("" ::: "memory"); }
        } else if (wc < 2) {
            const int c8 = wc * 32 + 8 * fq;
#pragma unroll
            for (int ai = 0; ai < 2; ++ai)
#pragma unroll
                for (int m = 0; m < 4; ++m) { const int row = row0 + ai * 128 + m * 16; f32x4 v0 = acc[ai][0][m][0], v1 = acc[ai][0][m][1];
                    if (row < MX) { const int t = row & (SEQ - 1); v0 = rot2(v0, mla_cs(tabm, t, c8)); v1 = rot2(v1, mla_cs(tabm, t, c8 + 4)); }
                    *(u32x4*)(KR + (size_t)row * 64 + c8) = pack8(v0, v1); asm volatile("" ::: "memory"); }
        }
    }
};
struct EpiUq {
    static constexpr bool PERM = true, PROBE2 = false;
    bf16* Q; const float* SSQ; const float* tabm;
    __device__ __forceinline__ void operator()(const f32x4 (&acc)[2][2][4][2], const Unit& u, int wr, int wc, int fr, int fq) const {
        const int row0 = u.pm * 256 + wr * 64 + fr;
        int col8[2], dd[2];
#pragma unroll
        for (int bj = 0; bj < 2; ++bj) { col8[bj] = u.pn * 256 + bj * 128 + wc * 32 + 8 * fq; dd[bj] = col8[bj] % DQ; }
#pragma unroll
        for (int ai = 0; ai < 2; ++ai)
#pragma unroll
            for (int m = 0; m < 4; ++m) { const int row = row0 + ai * 128 + m * 16;
                const f32x4 s0 = *(const f32x4*)(SSQ + (size_t)row * 16), s1 = *(const f32x4*)(SSQ + (size_t)row * 16 + 4);
                const float ss = ((s0[0] + s0[1]) + (s0[2] + s0[3])) + ((s1[0] + s1[1]) + (s1[2] + s1[3]));
                const float r = 1.0f / sqrtf(ss * (1.0f / QR) + NORM_EPS);
#pragma unroll
                for (int bj = 0; bj < 2; ++bj) { f32x4 v0 = acc[ai][bj][m][0] * r, v1 = acc[ai][bj][m][1] * r;
                    if (dd[bj] >= NOPE && row < MX) { const int t = row & (SEQ - 1), c8 = dd[bj] - NOPE; v0 = rot2(v0, mla_cs(tabm, t, c8)); v1 = rot2(v1, mla_cs(tabm, t, c8 + 4)); }
                    *(u32x4*)(Q + (size_t)row * 3072 + col8[bj]) = pack8(v0, v1); } asm volatile("" ::: "memory"); }
    }
};
struct EpiUkv {
    static constexpr bool PERM = true, PROBE2 = false;
    bf16* KV; const float* SSQ;
    __device__ __forceinline__ void operator()(const f32x4 (&acc)[2][2][4][2], const Unit& u, int wr, int wc, int fr, int fq) const {
        const int row0 = u.pm * 256 + wr * 64 + fr; const int col0 = u.pn * 256 + wc * 32 + 8 * fq;
#pragma unroll
        for (int ai = 0; ai < 2; ++ai)
#pragma unroll
            for (int m = 0; m < 4; ++m) { const int row = row0 + ai * 128 + m * 16;
                const f32x4 s0 = *(const f32x4*)(SSQ + (size_t)row * 16 + 8), s1 = *(const f32x4*)(SSQ + (size_t)row * 16 + 12);
                const float ss = ((s0[0] + s0[1]) + (s0[2] + s0[3])) + ((s1[0] + s1[1]) + (s1[2] + s1[3]));
                const float r = 1.0f / sqrtf(ss * (1.0f / KVR) + NORM_EPS);
#pragma unroll
                for (int bj = 0; bj < 2; ++bj) *(u32x4*)(KV + (size_t)row * 4096 + col0 + bj * 128) = pack8(acc[ai][bj][m][0] * r, acc[ai][bj][m][1] * r); asm volatile("" ::: "memory"); }
    }
};
struct EpiResid {
    static constexpr bool PERM = false, PROBE2 = false;
    const float* xin; float* xout; const float* cin; float* cout; const float* modv; int gofs;
    __device__ __forceinline__ void operator()(const f32x4 (&acc)[2][2][4][2], const Unit& u, int wr, int wc, int fr, int fq) const {
        const bool isx = u.pm < (MX / 256);
        const int rloc = (isx ? u.pm * 256 : (u.pm * 256 - MX)) + wr * 64 + fr;
        const float* base = isx ? xin : cin; float* out = isx ? xout : cout;
        const float* gv = modv + (size_t)(isx ? (u.pm >> 4) : 8) * NMOD + gofs;
        const int col0 = u.pn * 256 + wc * 32 + 4 * fq;
        f32x4 g4[2][2];
#pragma unroll
        for (int bj = 0; bj < 2; ++bj)
#pragma unroll
            for (int n = 0; n < 2; ++n) g4[bj][n] = *(const f32x4*)(gv + col0 + bj * 128 + n * 16);
#pragma unroll
        for (int ai = 0; ai < 2; ++ai)
#pragma unroll
            for (int m = 0; m < 4; ++m) { const size_t off = (size_t)(rloc + ai * 128 + m * 16) * D + col0;
#pragma unroll
                for (int bj = 0; bj < 2; ++bj)
#pragma unroll
                    for (int n = 0; n < 2; ++n) { const f32x4 b = *(const f32x4*)(base + off + bj * 128 + n * 16); *(f32x4*)(out + off + bj * 128 + n * 16) = b + g4[bj][n] * acc[ai][bj][m][n]; }
                if (m & 1) asm volatile("" ::: "memory"); }
    }
};
template <int CTRL> __device__ __forceinline__ float dpp1(float x) { return __int_as_float(__builtin_amdgcn_update_dpp(0, __float_as_int(x), CTRL, 0xF, 0xF, false)); }
__device__ __forceinline__ f32x4 row_prev(const f32x4 v) { f32x4 o; o.x = dpp1<0x121>(v.x); o.y = dpp1<0x121>(v.y); o.z = dpp1<0x121>(v.z); o.w = dpp1<0x121>(v.w); return o; }
__device__ __forceinline__ f32x4 row_next(const f32x4 v) { f32x4 o; o.x = dpp1<0x12F>(v.x); o.y = dpp1<0x12F>(v.y); o.z = dpp1<0x12F>(v.z); o.w = dpp1<0x12F>(v.w); return o; }
__device__ __forceinline__ f32x4 silu4(const f32x4 v) { f32x4 o;
#pragma unroll
    for (int e = 0; e < 4; ++e) o[e] = fast_silu(v[e]); return o; }
constexpr size_t HALO_STRIDE = (size_t)FF;
struct EpiGUConv {
    static constexpr bool PERM = true, PROBE2 = true;
    bf16* ACT; float* HALO; const float* cw; const float* cb; LAS float* edge;
    __device__ __forceinline__ void operator()(const f32x4 (&acc)[2][2][4][2], const Unit& u, int wr, int wc, int fr, int fq) const {
        const int c8 = wc * 32 + 8 * fq; const int f0 = u.pn * 128 + c8;
#pragma unroll
        for (int ai = 0; ai < 2; ++ai) { const int blk = 2 * ai + wr;
            if (fr == 0)  { *(LAS f32x4*)(edge + (blk * 2 + 0) * 128 + c8) = acc[ai][0][0][0]; *(LAS f32x4*)(edge + (blk * 2 + 0) * 128 + c8 + 4) = acc[ai][0][0][1]; }
            if (fr == 15) { *(LAS f32x4*)(edge + (blk * 2 + 1) * 128 + c8) = acc[ai][0][3][0]; *(LAS f32x4*)(edge + (blk * 2 + 1) * 128 + c8 + 4) = acc[ai][0][3][1]; } }
        asm volatile("s_waitcnt lgkmcnt(0)" ::: "memory"); __builtin_amdgcn_s_barrier(); asm volatile("" ::: "memory");
        f32x4 w0[2], w1[2], w2[2], bb[2];
#pragma unroll
        for (int n = 0; n < 2; ++n) { w0[n] = *(const f32x4*)(cw + f0 + 4 * n); w1[n] = *(const f32x4*)(cw + FF + f0 + 4 * n); w2[n] = *(const f32x4*)(cw + 2 * FF + f0 + 4 * n); bb[n] = *(const f32x4*)(cb + f0 + 4 * n); }
        const f32x4 zero4 = {0.f, 0.f, 0.f, 0.f};
#pragma unroll
        for (int ai = 0; ai < 2; ++ai) { const int blk = 2 * ai + wr;
#pragma unroll
            for (int m = 0; m < 4; ++m) { const int row = u.pm * 256 + ai * 128 + wr * 64 + m * 16 + fr; f32x4 o[2];
#pragma unroll
                for (int n = 0; n < 2; ++n) { const f32x4 cur = acc[ai][0][m][n];
                    f32x4 b, d;
                    if (m > 0) b = row_prev(acc[ai][0][m - 1][n]); else b = (blk > 0) ? *(const LAS f32x4*)(edge + ((blk - 1) * 2 + 1) * 128 + c8 + 4 * n) : zero4;
                    if (m < 3) d = row_next(acc[ai][0][m + 1][n]); else d = (blk < 3) ? *(const LAS f32x4*)(edge + ((blk + 1) * 2 + 0) * 128 + c8 + 4 * n) : zero4;
                    const f32x4 a = row_prev(cur), c = row_next(cur);
                    const f32x4 up = (fr == 0) ? b : a, dn = (fr == 15) ? d : c;
                    const f32x4 cv = w0[n] * up + w1[n] * cur + w2[n] * dn + bb[n]; const f32x4 uu = acc[ai][1][m][n];
                    o[n] = silu4(cv) * uu;
                    if (m == 0 && blk == 0 && fr == 0) { float* hp = HALO + (size_t)((u.pm * 2 + 0) * 3) * HALO_STRIDE + f0 + 4 * n; *(f32x4*)hp = cv; *(f32x4*)(hp + HALO_STRIDE) = cur; *(f32x4*)(hp + 2 * HALO_STRIDE) = uu; }
                    if (m == 3 && blk == 3 && fr == 15) { float* hp = HALO + (size_t)((u.pm * 2 + 1) * 3) * HALO_STRIDE + f0 + 4 * n; *(f32x4*)hp = cv; *(f32x4*)(hp + HALO_STRIDE) = cur; *(f32x4*)(hp + 2 * HALO_STRIDE) = uu; } }
                *(u32x4*)(ACT + (size_t)row * FF + f0) = pack8(o[0], o[1]); asm volatile("" ::: "memory"); } }
        asm volatile("s_waitcnt lgkmcnt(0)" ::: "memory"); __builtin_amdgcn_s_barrier(); asm volatile("" ::: "memory");
    }
};
struct EpiQKV {
    static constexpr bool PERM = true, PROBE2 = false;
    bf16* QKV; const float* tabr;
    __device__ __forceinline__ void operator()(const f32x4 (&acc)[2][2][4][2], const Unit& u, int wr, int wc, int fr, int fq) const {
        const int row0 = u.pm * 256 + wr * 64 + fr; const int col0 = u.pn * 256 + wc * 32 + 8 * fq;
        const bool rope = (u.pn < 16) && (u.pm < MX / 256);
#pragma unroll
        for (int ai = 0; ai < 2; ++ai)
#pragma unroll
            for (int m = 0; m < 4; ++m) { const int row = row0 + ai * 128 + m * 16;
#pragma unroll
                for (int bj = 0; bj < 2; ++bj) { f32x4 v0 = acc[ai][bj][m][0], v1 = acc[ai][bj][m][1]; const int col = col0 + bj * 128;
                    if (rope) { const int t = row & (SEQ - 1); const float* tp = tabr + ((size_t)t * 128 + ((col & 255) >> 1)) * 2;
                        v0 = rot2(v0, *(const f32x4*)tp); v1 = rot2(v1, *(const f32x4*)(tp + 4)); }
                    *(u32x4*)(QKV + (size_t)row * 8192 + col) = pack8(v0, v1); } asm volatile("" ::: "memory"); }
    }
};
struct EpiGate {
    static constexpr bool PERM = true, PROBE2 = false;
    bf16* GATED; const bf16* YF; const bf16* YB;
    __device__ __forceinline__ void operator()(const f32x4 (&acc)[2][2][4][2], const Unit& u, int wr, int wc, int fr, int fq) const {
        const int row0 = u.pm * 256 + wr * 64 + fr; const int f0 = u.pn * 128 + wc * 32 + 8 * fq;
#pragma unroll
        for (int ai = 0; ai < 2; ++ai)
#pragma unroll
            for (int m = 0; m < 4; ++m) { const size_t off = (size_t)(row0 + ai * 128 + m * 16) * 4096 + f0;
                const u32x4 nf = *(const u32x4*)(YF + off), nb = *(const u32x4*)(YB + off);
                const f32x4 a0 = acc[ai][0][m][0], a1 = acc[ai][0][m][1], b0 = acc[ai][1][m][0], b1 = acc[ai][1][m][1];
                f32x4 o0, o1;
                o0[0] = fast_silu(a0[0]) * bflo(nf.x) + fast_silu(b0[0]) * bflo(nb.x); o0[1] = fast_silu(a0[1]) * bfhi(nf.x) + fast_silu(b0[1]) * bfhi(nb.x);
                o0[2] = fast_silu(a0[2]) * bflo(nf.y) + fast_silu(b0[2]) * bflo(nb.y); o0[3] = fast_silu(a0[3]) * bfhi(nf.y) + fast_silu(b0[3]) * bfhi(nb.y);
                o1[0] = fast_silu(a1[0]) * bflo(nf.z) + fast_silu(b1[0]) * bflo(nb.z); o1[1] = fast_silu(a1[1]) * bfhi(nf.z) + fast_silu(b1[1]) * bfhi(nb.z);
                o1[2] = fast_silu(a1[2]) * bflo(nf.w) + fast_silu(b1[2]) * bflo(nb.w); o1[3] = fast_silu(a1[3]) * bfhi(nf.w) + fast_silu(b1[3]) * bfhi(nb.w);
                *(u32x4*)(GATED + off) = pack8(o0, o1); asm volatile("" ::: "memory"); }
    }
};

namespace att {
constexpr int NW = 8, QBLK = 32, KVBLK = 64;
constexpr int SHM_V = 16384, SHM_KN = 16384, SHM_KR = 8192;
constexpr int OFF_V = 0, OFF_KN = 3 * SHM_V, OFF_KR = OFF_KN + 2 * SHM_KN, OFF_WS = OFF_KR + 2 * SHM_KR, SHM_ATTN = OFF_WS + NW * 64 * 4;
constexpr float THR2 = 11.5f;
#define KSWZ(row, colB) ((row) * 256 + ((colB) ^ (((row) & 7) << 4)))
#define KRSWZ(row, colB) ((row) * 128 + ((colB) ^ ((((row) >> 1) & 7) << 4)))
#define SBAR() __builtin_amdgcn_sched_barrier(0)
__device__ __forceinline__ int crow(int r, int hi) { return (r & 3) + 8 * (r >> 2) + 4 * hi; }
__device__ __forceinline__ void partialSM(f32x16& p0, f32x16& p1, float& m_reg, float& alpha) {
  float pmax = p0[0];
#pragma unroll
  for (int r = 1; r < 16; ++r) pmax = fmaxf(pmax, p0[r]);
#pragma unroll
  for (int r = 0; r < 16; ++r) pmax = fmaxf(pmax, p1[r]);
  { auto rr = __builtin_amdgcn_permlane32_swap(__float_as_uint(pmax), __float_as_uint(pmax), false, false); pmax = fmaxf(__uint_as_float(rr[0]), __uint_as_float(rr[1])); }
  float mn;
  if (__builtin_expect(__all(pmax - m_reg <= THR2), 1)) { mn = m_reg; alpha = 1.f; }
  else { mn = fmaxf(m_reg, pmax); alpha = __builtin_amdgcn_exp2f(m_reg - mn); m_reg = mn; }
#pragma unroll
  for (int r = 0; r < 16; ++r) p0[r] = p0[r] - mn;
#pragma unroll
  for (int r = 0; r < 16; ++r) p1[r] = p1[r] - mn;
#pragma unroll
  for (int r = 0; r < 16; ++r) p0[r] = __builtin_amdgcn_exp2f(p0[r]);
}
__device__ __forceinline__ void finishSM(f32x16& p0, f32x16& p1, float alpha, float& l_reg, bf16x8& pa0, bf16x8& pa1, bf16x8& pa2, bf16x8& pa3) {
#pragma unroll
  for (int r = 0; r < 16; ++r) p1[r] = __builtin_amdgcn_exp2f(p1[r]);
  float ps = 0;
#pragma unroll
  for (int r = 0; r < 16; ++r) ps += p0[r];
#pragma unroll
  for (int r = 0; r < 16; ++r) ps += p1[r];
  { auto rr = __builtin_amdgcn_permlane32_swap(__float_as_uint(ps), __float_as_uint(ps), false, false); ps = __uint_as_float(rr[0]) + __uint_as_float(rr[1]); }
  l_reg = l_reg * alpha + ps;
#define PK4(P, BASE, OUT) do { unsigned a0 = cvt_pk_bf16(P[BASE + 0], P[BASE + 1]), a1 = cvt_pk_bf16(P[BASE + 2], P[BASE + 3]);   \
    unsigned b0 = cvt_pk_bf16(P[BASE + 4], P[BASE + 5]), b1 = cvt_pk_bf16(P[BASE + 6], P[BASE + 7]);                              \
    auto r0 = __builtin_amdgcn_permlane32_swap(a0, b0, false, false); auto r1 = __builtin_amdgcn_permlane32_swap(a1, b1, false, false); \
    u32x4 w = {r0[0], r1[0], r0[1], r1[1]}; OUT = __builtin_bit_cast(bf16x8, w); } while (0)
  PK4(p0, 0, pa0); PK4(p0, 8, pa1); PK4(p1, 0, pa2); PK4(p1, 8, pa3);
#undef PK4
}
__device__ __forceinline__ void qkt(f32x16& p0, f32x16& p1, const char* Kn, const char* Kr, const bf16x8* qr, int r32, int hi) {
  p0 = f32x16{}; p1 = f32x16{};
#pragma unroll
  for (int d0 = 0; d0 < 8; ++d0) { const int cb = (d0 * 16 + hi * 8) * 2;
    const bf16x8 b0 = *reinterpret_cast<const bf16x8*>(Kn + KSWZ(r32, cb));
    const bf16x8 b1 = *reinterpret_cast<const bf16x8*>(Kn + KSWZ(32 + r32, cb));
    p0 = __builtin_amdgcn_mfma_f32_32x32x16_bf16(b0, qr[d0], p0, 0, 0, 0);
    p1 = __builtin_amdgcn_mfma_f32_32x32x16_bf16(b1, qr[d0], p1, 0, 0, 0); }
#pragma unroll
  for (int d0 = 0; d0 < 4; ++d0) { const int cb = (d0 * 16 + hi * 8) * 2;
    const bf16x8 b0 = *reinterpret_cast<const bf16x8*>(Kr + KRSWZ(r32, cb));
    const bf16x8 b1 = *reinterpret_cast<const bf16x8*>(Kr + KRSWZ(32 + r32, cb));
    p0 = __builtin_amdgcn_mfma_f32_32x32x16_bf16(b0, qr[8 + d0], p0, 0, 0, 0);
    p1 = __builtin_amdgcn_mfma_f32_32x32x16_bf16(b1, qr[8 + d0], p1, 0, 0, 0); }
}
__device__ __forceinline__ int v_st(int k, int c) { const int kk = (k & ~0xC) | ((k & 4) << 1) | ((k & 8) >> 1); return ((kk >> 3) * 4 + (c >> 5)) * 512 + ((kk & 7) * 32 + (c & 31)) * 2; }
__device__ __forceinline__ int v_rd_base(int lane) { return ((lane & 3) << 3) | (((lane >> 2) & 3) << 6) | (((lane >> 4) & 1) << 5) | (((lane >> 5) & 1) << 8); }
constexpr int v_rd_off(int d0, int ks, int half) { return d0 * 512 + ks * 4096 + half * 2048; }
template <int OFF> __device__ __forceinline__ s16x4 tr_read(int vb) { s16x4 r; asm volatile("ds_read_b64_tr_b16 %0, %1 offset:%2" : "=&v"(r) : "v"(vb), "i"(OFF) : "memory"); return r; }
template <int D0> __device__ __forceinline__ void pv_one(f32x16& od, int vb, bf16x8 pa0, bf16x8 pa1, bf16x8 pa2, bf16x8 pa3) {
  const s16x4 l0 = tr_read<v_rd_off(D0, 0, 0)>(vb), h0 = tr_read<v_rd_off(D0, 0, 1)>(vb), l1 = tr_read<v_rd_off(D0, 1, 0)>(vb), h1 = tr_read<v_rd_off(D0, 1, 1)>(vb);
  const s16x4 l2 = tr_read<v_rd_off(D0, 2, 0)>(vb), h2 = tr_read<v_rd_off(D0, 2, 1)>(vb), l3 = tr_read<v_rd_off(D0, 3, 0)>(vb), h3 = tr_read<v_rd_off(D0, 3, 1)>(vb);
  asm volatile("s_waitcnt lgkmcnt(0)" ::: "memory"); SBAR();
#define PK(L, H) (bf16x8){L[0], L[1], L[2], L[3], H[0], H[1], H[2], H[3]}
  od = __builtin_amdgcn_mfma_f32_32x32x16_bf16(pa0, PK(l0, h0), od, 0, 0, 0);
  od = __builtin_amdgcn_mfma_f32_32x32x16_bf16(pa1, PK(l1, h1), od, 0, 0, 0);
  od = __builtin_amdgcn_mfma_f32_32x32x16_bf16(pa2, PK(l2, h2), od, 0, 0, 0);
  od = __builtin_amdgcn_mfma_f32_32x32x16_bf16(pa3, PK(l3, h3), od, 0, 0, 0);
#undef PK
}
__device__ __forceinline__ void pv_d0(f32x16* o, int vb, bf16x8 pa0, bf16x8 pa1, bf16x8 pa2, bf16x8 pa3) {
  pv_one<0>(o[0], vb, pa0, pa1, pa2, pa3); pv_one<1>(o[1], vb, pa0, pa1, pa2, pa3); pv_one<2>(o[2], vb, pa0, pa1, pa2, pa3); pv_one<3>(o[3], vb, pa0, pa1, pa2, pa3);
}
__device__ __forceinline__ void attn_unit(const bf16* __restrict__ Qb, const bf16* __restrict__ KVh, const bf16* __restrict__ KRp, bf16* __restrict__ Ob,
                                          int NT, int nc, int cbase, int xbase, char* lds) {
  int tid = threadIdx.x; asm volatile("" : "+v"(tid));
  const int wid = __builtin_amdgcn_readfirstlane(tid >> 6), lane = tid & 63, r32 = lane & 31, hi = lane >> 5;
  char* V_lds = lds + OFF_V; char* Kn_lds = lds + OFF_KN; char* Kr_lds = lds + OFF_KR;
  float* ws = (float*)(lds + OFF_WS) + wid * 64; float* li_l = ws; float* al_l = ws + 32;
  float m_reg = -1e30f, l_reg = 0; f32x16 o[4] = {}; bf16x8 qr[12];
  const bf16* Qw = Qb + (long)(wid * QBLK + r32) * 3072 + hi * 8;
#pragma unroll
  for (int d0 = 0; d0 < 12; ++d0) qr[d0] = *reinterpret_cast<const bf16x8*>(Qw + d0 * 16);
  const int vb0 = (int)(uintptr_t)V_lds + v_rd_base(lane);
  unsigned vofK[2], vofV[2], vofR;
#pragma unroll
  for (int i = 0; i < 2; ++i) { const int pc = wid * 2 + i;
      { const int row = pc * 4 + (lane >> 4), ch = (lane & 15) ^ (row & 7); vofK[i] = (unsigned)((row * 4096 + ch * 8) * 2); }
      { const int ob = pc * 1024 + lane * 16, st = ob >> 9, w = ob & 511, kk = (st >> 2) * 8 + (w >> 6); const int k = (kk & ~0xC) | ((kk & 4) << 1) | ((kk & 8) >> 1);
        const int c = (st & 3) * 32 + 8 * ((w & 63) >> 4); vofV[i] = (unsigned)((k * 4096 + 128 + c) * 2); } }
  { const int row = wid * 8 + (lane >> 3), ch = (lane & 7) ^ ((row >> 1) & 7); vofR = (unsigned)((row * 64 + ch * 8) * 2); }
  const unsigned ldsK = (unsigned)__builtin_amdgcn_readfirstlane((unsigned)(uintptr_t)Kn_lds + (unsigned)wid * 2048u);
  const unsigned ldsV = (unsigned)__builtin_amdgcn_readfirstlane((unsigned)(uintptr_t)V_lds + (unsigned)wid * 2048u);
  const unsigned ldsR = (unsigned)__builtin_amdgcn_readfirstlane((unsigned)(uintptr_t)Kr_lds + (unsigned)wid * 1024u);
#define KROW(j) ((j) < nc ? cbase + (j) * KVBLK : xbase + ((j) - nc) * KVBLK)
#define DMA_TILE(j, kslot, vslot) do { const long k0_ = KROW(j); const char* kb_ = uni_ptr(KVh + k0_ * 4096); const char* rb_ = uni_ptr(KRp + k0_ * 64); \
    glds16_s(kb_, vofK[0], ldsK + (kslot) * SHM_KN); glds16_s(kb_, vofK[1], ldsK + (kslot) * SHM_KN + 1024u); \
    glds16_s(rb_, vofR, ldsR + (kslot) * SHM_KR); \
    glds16_s(kb_, vofV[0], ldsV + (vslot) * SHM_V); glds16_s(kb_, vofV[1], ldsV + (vslot) * SHM_V + 1024u); } while (0)
#define WAIT_SYNC() do { asm volatile("s_waitcnt vmcnt(0)" ::: "memory"); __syncthreads(); } while (0)
#define RESC(a) do { if (__any((a) < 1.f)) { if (hi == 0) al_l[r32] = (a); asm volatile("s_waitcnt lgkmcnt(0)" ::: "memory"); \
    _Pragma("unroll") for (int d = 0; d < 4; ++d) _Pragma("unroll") for (int r = 0; r < 16; ++r) o[d][r] *= al_l[crow(r, hi)]; } } while (0)
  f32x16 pA0, pA1, pB0, pB1; float alA, alB; bf16x8 pa0, pa1, pa2, pa3;
  DMA_TILE(0, 0, 0); DMA_TILE(1, 1, 1); WAIT_SYNC();
  qkt(pA0, pA1, Kn_lds, Kr_lds, qr, r32, hi); partialSM(pA0, pA1, m_reg, alA);
  __syncthreads();
  int vprev = 0, vcur = 1, vnext = 2;
  for (int j = 1; j + 1 < NT; j += 2) {
    DMA_TILE(j + 1, 0, vnext);
    SBAR(); qkt(pB0, pB1, Kn_lds + SHM_KN, Kr_lds + SHM_KR, qr, r32, hi);
    finishSM(pA0, pA1, alA, l_reg, pa0, pa1, pa2, pa3); SBAR();
    pv_d0(o, vb0 + vprev * SHM_V, pa0, pa1, pa2, pa3); partialSM(pB0, pB1, m_reg, alB);
    RESC(alB); WAIT_SYNC();
    { const int t_ = vprev; vprev = vcur; vcur = vnext; vnext = t_; }
    if (j + 2 < NT) DMA_TILE(j + 2, 1, vnext);
    SBAR(); qkt(pA0, pA1, Kn_lds, Kr_lds, qr, r32, hi);
    finishSM(pB0, pB1, alB, l_reg, pa0, pa1, pa2, pa3); SBAR();
    pv_d0(o, vb0 + vprev * SHM_V, pa0, pa1, pa2, pa3); partialSM(pA0, pA1, m_reg, alA);
    RESC(alA); WAIT_SYNC();
    { const int t_ = vprev; vprev = vcur; vcur = vnext; vnext = t_; }
  }
  SBAR(); qkt(pB0, pB1, Kn_lds + SHM_KN, Kr_lds + SHM_KR, qr, r32, hi);
  finishSM(pA0, pA1, alA, l_reg, pa0, pa1, pa2, pa3); SBAR();
  pv_d0(o, vb0 + vprev * SHM_V, pa0, pa1, pa2, pa3); partialSM(pB0, pB1, m_reg, alB);
  RESC(alB);
  finishSM(pB0, pB1, alB, l_reg, pa0, pa1, pa2, pa3); SBAR();
  pv_d0(o, vb0 + vcur * SHM_V, pa0, pa1, pa2, pa3);
  if (hi == 0) li_l[r32] = l_reg; asm volatile("s_waitcnt lgkmcnt(0)" ::: "memory");
  float rli[16];
#pragma unroll
  for (int r = 0; r < 16; ++r) rli[r] = __builtin_amdgcn_rcpf(li_l[crow(r, hi)]);
  bf16* Ow = Ob + (long)(wid * QBLK) * 2048;
#pragma unroll
  for (int r = 0; r < 16; ++r) { const int orow = crow(r, hi);
#pragma unroll
    for (int d0 = 0; d0 < 4; ++d0) Ow[(long)orow * 2048 + d0 * 32 + r32] = (bf16)(cvt_pk_bf16(o[d0][r] * rli[r], 0.f) & 0xffffu); }
  __syncthreads();
#undef KROW
#undef DMA_TILE
#undef WAIT_SYNC
#undef RESC
}
#undef SBAR
}

namespace scan {
constexpr int CH = 64;
constexpr int OFF_Q = 0, OFF_K = 32768  , OFF_V = 98304, OFF_P = 131072, SHM_SCAN = 131072 + 8192;
__device__ __forceinline__ unsigned off_b(unsigned row, unsigned ch) { return 256u * row + 16u * (ch ^ (((row & 3) << 2) | ((row >> 2) & 3))); }
__device__ __forceinline__ unsigned p_off(unsigned i, unsigned chunk) { return 128u * i + 16u * (chunk ^ ((i >> 1) & 7)); }
__device__ __forceinline__ int crow(int r, int hi) { return (r & 3) + 8 * (r >> 2) + 4 * hi; }
__device__ __forceinline__ s16x4 vtr(const LAS char* p) { typedef short v4i16_t __attribute__((ext_vector_type(4))); return __builtin_bit_cast(s16x4, __builtin_amdgcn_ds_read_tr16_b64_v4i16((LAS v4i16_t*)p)); }
__device__ __forceinline__ bf16x8 tr_frag(const LAS char* img, int lane, int c, int ks) {
    const unsigned h = lane >> 5, blk = (lane >> 4) & 1, q = (lane & 15) >> 2, p = lane & 3;
    const unsigned r0 = 16 * ks + 8 * h + q, chn = 4 * c + 2 * blk + (p >> 1);
    const s16x4 lo = vtr(img + off_b(r0, chn) + 8 * (p & 1)), hi = vtr(img + off_b(r0 + 4, chn) + 8 * (p & 1));
    return (bf16x8){lo[0], lo[1], lo[2], lo[3], hi[0], hi[1], hi[2], hi[3]};
}
__device__ __forceinline__ bf16x8 pack_step(const f32x16& x, int s) {
    u32x4 p; p.x = cvt_pk_bf16(x[8 * s + 0], x[8 * s + 1]); p.y = cvt_pk_bf16(x[8 * s + 2], x[8 * s + 3]); p.z = cvt_pk_bf16(x[8 * s + 4], x[8 * s + 5]); p.w = cvt_pk_bf16(x[8 * s + 6], x[8 * s + 7]);
    return __builtin_bit_cast(bf16x8, p);
}
__device__ __forceinline__ void dma_mat(const bf16* src, int ld, LAS unsigned char* dst, int wid, int lane) {
    const char* sb = uni_ptr(src); const unsigned d0 = (unsigned)__builtin_amdgcn_readfirstlane((unsigned)(uintptr_t)dst + (unsigned)wid * 4096u);
#pragma unroll
    for (int k = 0; k < 4; ++k) { const int pc = wid * 4 + k, img = pc >> 4, row = 4 * (pc & 15) + (lane >> 4), pos = lane & 15;
        const int ch = pos ^ (((row & 3) << 2) | ((row >> 2) & 3));
        glds16_s(sb, (unsigned)((row * ld + img * 128 + ch * 8) * 2), d0 + (unsigned)k * 1024u); }
}
__device__ __forceinline__ int scan_rowbase(int n, int b, int dir) { return (n < 4) ? MX + b * CTXL + (dir ? 3 - n : n) * CH : b * SEQ + (dir ? 67 - n : n - 4) * CH; }
__device__ __forceinline__ float uni_f(float x) { return __uint_as_float(__builtin_amdgcn_readfirstlane(__float_as_uint(x))); }
typedef const LAS s16x4* lds_s4p;
__device__ __forceinline__ void scan_unit(const bf16* __restrict__ QKV, bf16* __restrict__ Y, int b, int hd, int dir, int dvh, float lg2, bool skip_ctx_y, LAS unsigned char* lds) {
    int tid = threadIdx.x; asm volatile("" : "+v"(tid));
    const int wid = __builtin_amdgcn_readfirstlane(tid >> 6), lane0 = tid & 63;
    const LAS char* QI = (const LAS char*)lds + OFF_Q; const LAS char* VI = (const LAS char*)lds + OFF_V;
    LAS char* PI = (LAS char*)lds + OFF_P;
    f32x16 S[8];
#pragma unroll
    for (int i = 0; i < 8; ++i) S[i] = f32x16{};
    const float lgr = dir ? -lg2 : lg2;
    const float g64 = uni_f(__builtin_amdgcn_exp2f(64.f * lg2));
    const float R1 = uni_f(__builtin_amdgcn_exp2f(lgr)), R8 = uni_f(__builtin_amdgcn_exp2f(8.f * lgr)), R32 = uni_f(__builtin_amdgcn_exp2f(32.f * lgr));
    const float Rm1 = uni_f(__builtin_amdgcn_exp2f(-lgr)), Rm16 = uni_f(__builtin_amdgcn_exp2f(-16.f * lgr));
    const float c0 = uni_f(dir ? g64 : __builtin_amdgcn_exp2f(lg2)), z0 = uni_f(dir ? 1.0f : __builtin_amdgcn_exp2f(63.f * lg2));
    const int qcol = hd * RDK, kcol = 2048 + hd * RDK, vcol = 4096 + hd * RDV + dvh * 256;
    { const bf16* src = QKV + (size_t)scan_rowbase(0, b, dir) * 8192;
      dma_mat(src + qcol, 8192, lds + OFF_Q, wid, lane0); dma_mat(src + kcol, 8192, lds + OFF_K, wid, lane0); dma_mat(src + vcol, 8192, lds + OFF_V, wid, lane0);
      asm volatile("s_waitcnt vmcnt(0)" ::: "memory"); __syncthreads(); }
    for (int n = 0; n < 68; ++n) {
        int lane = lane0; asm volatile("" : "+v"(lane));
        const int r = lane & 31, h = lane >> 5, fr = lane & 15, fq = lane >> 4;
        const int rowbase = scan_rowbase(n, b, dir);
        const bool more = n + 1 < 68;
        const bf16* nsrc = QKV + (size_t)scan_rowbase(more ? n + 1 : n, b, dir) * 8192;
        const LAS char* KI = (const LAS char*)lds + OFF_K + (n & 1) * 32768;
        if (more) dma_mat(nsrc + kcol, 8192, lds + OFF_K + ((n + 1) & 1) * 32768, wid, lane);
        const float LR = c0 * __builtin_amdgcn_exp2f((float)(4 * h) * lgr), LZ = z0 * __builtin_amdgcn_exp2f((float)(-8 * h) * lgr), LP = __builtin_amdgcn_exp2f((float)(fr - 4 * fq) * lgr);
        { const int fH = fr & 3, fL = (fr >> 2) & 3; const int AL = 256 * fr + 16 * (fq ^ fL);
          int AH[4];
#pragma unroll
          for (int k = 0; k < 4; ++k) AH[k] = 64 * (k ^ fH);
#pragma unroll
          for (int tix = 0; tix < 2; ++tix) { const int tt = wid * 2 + tix, jt = tt >> 2, it = tt & 3;
            f32x4 pt = {0.f, 0.f, 0.f, 0.f};
            const bool live = dir ? (jt >= it) : (jt <= it);
            if (live) { const LAS char* ka = KI + 4096 * jt + AL; const LAS char* qa = QI + 4096 * it + AL;
#pragma unroll
                for (int ks = 0; ks < 8; ++ks) { const int o = (ks >> 2) * 16384 + AH[ks & 3];
                    pt = __builtin_amdgcn_mfma_f32_16x16x32_bf16(*(const LAS bf16x8*)(ka + o), *(const LAS bf16x8*)(qa + o), pt, 0, 0, 0); } }
            float we = LP * __builtin_amdgcn_exp2f((float)(16 * (it - jt)) * lgr); float v[4];
            const int mrel = fr - 4 * fq;
#pragma unroll
            for (int e = 0; e < 4; ++e) { float x = live ? pt[e] * we : 0.f; if (jt == it) { const bool keep = dir ? (e >= mrel) : (e <= mrel); x = keep ? x : 0.f; } v[e] = x; we *= Rm1; }
            const int i = it * 16 + fr, j0 = jt * 16 + 4 * fq;
            u32x2 w; w.x = cvt_pk_bf16(v[0], v[1]); w.y = cvt_pk_bf16(v[2], v[3]);
            *(LAS u32x2*)(PI + p_off(i, j0 >> 3) + ((j0 >> 2) & 1) * 8) = w; } }
        f32x16 Yt[2]; Yt[0] = f32x16{}; Yt[1] = f32x16{};
        { const int fH = r & 3, fL = (r >> 2) & 3; int QH[4], QL[4];
#pragma unroll
          for (int k = 0; k < 4; ++k) { QH[k] = 64 * (k ^ fH); QL[k] = 256 * r + 8 * h + 16 * (k ^ fL); }
#pragma unroll
          for (int dkb = 0; dkb < 8; ++dkb)
#pragma unroll
            for (int s = 0; s < 2; ++s) { const bf16x8 bf = pack_step(S[dkb], s);
                const LAS char* rp = QI + (dkb >> 2) * 16384 + QH[dkb & 3];
#pragma unroll
                for (int it = 0; it < 2; ++it) {
                    const u32x2 lo = *(const LAS u32x2*)(rp + it * 8192 + QL[2 * s]), hi2 = *(const LAS u32x2*)(rp + it * 8192 + QL[2 * s + 1]);
                    const u32x4 aw = {lo.x, lo.y, hi2.x, hi2.y};
                    Yt[it] = __builtin_amdgcn_mfma_f32_32x32x16_bf16(__builtin_bit_cast(bf16x8, aw), bf, Yt[it], 0, 0, 0); } } }
        { float fit = LR;
#pragma unroll
          for (int it = 0; it < 2; ++it) { float fa = fit;
#pragma unroll
            for (int a4 = 0; a4 < 4; ++a4) { float fb = fa;
#pragma unroll
                for (int b4 = 0; b4 < 4; ++b4) { Yt[it][4 * a4 + b4] *= fb; fb *= R1; }
                fa *= R8; }
            fit *= R32; } }
        if (more) asm volatile("s_waitcnt vmcnt(4)" ::: "memory"); else asm volatile("s_waitcnt vmcnt(0)" ::: "memory");
        __syncthreads();
        if (more) dma_mat(nsrc + qcol, 8192, lds + OFF_Q, wid, lane);
#pragma unroll
        for (int i = 0; i < 8; ++i)
#pragma unroll
            for (int rg = 0; rg < 16; ++rg) S[i][rg] *= g64;
        {
          const int blk = (lane >> 4) & 1, q = (lane & 15) >> 2, p = lane & 3; int TB[2], CQ[4];
#pragma unroll
          for (int t = 0; t < 2; ++t) TB[t] = 2048 * h + 256 * q + 1024 * t + 16 * ((2 * blk + (p >> 1)) ^ ((2 * h + t) & 3)) + 8 * (p & 1);
#pragma unroll
          for (int c = 0; c < 4; ++c) CQ[c] = 64 * (c ^ q);
          const LAS char* vb = VI + (wid >> 2) * 16384 + CQ[wid & 3];
          float zk = LZ;
#pragma unroll
          for (int ks = 0; ks < 4; ++ks) {
            const s16x4 vlo = vtr(vb + 4096 * ks + TB[0]), vhi = vtr(vb + 4096 * ks + TB[1]);
            const u32x2 vl = __builtin_bit_cast(u32x2, vlo), vh = __builtin_bit_cast(u32x2, vhi);
            const u32x4 vw = {vl.x, vl.y, vh.x, vh.y}; const bf16x8 vf = __builtin_bit_cast(bf16x8, vw);
#pragma unroll
            for (int it = 0; it < 2; ++it) { const bf16x8 pa = *(const LAS bf16x8*)(PI + p_off(it * 32 + r, 2 * ks + h));
                Yt[it] = __builtin_amdgcn_mfma_f32_32x32x16_bf16(pa, vf, Yt[it], 0, 0, 0); }
            float zj = zk; u32x4 zw;
            { const float a0 = bflo(vw.x) * zj; zj *= Rm1; const float a1 = bfhi(vw.x) * zj; zj *= Rm1; zw.x = cvt_pk_bf16(a0, a1); }
            { const float a0 = bflo(vw.y) * zj; zj *= Rm1; const float a1 = bfhi(vw.y) * zj; zj *= Rm1; zw.y = cvt_pk_bf16(a0, a1); }
            { const float a0 = bflo(vw.z) * zj; zj *= Rm1; const float a1 = bfhi(vw.z) * zj; zj *= Rm1; zw.z = cvt_pk_bf16(a0, a1); }
            { const float a0 = bflo(vw.w) * zj; zj *= Rm1; const float a1 = bfhi(vw.w) * zj; zw.w = cvt_pk_bf16(a0, a1); }
            const bf16x8 vz = __builtin_bit_cast(bf16x8, zw);
            zk *= Rm16;
#pragma unroll
            for (int dkb = 0; dkb < 8; ++dkb) { const LAS char* kb_ = KI + (dkb >> 2) * 16384 + 4096 * ks + CQ[dkb & 3];
                const s16x4 klo = vtr(kb_ + TB[0]), khi = vtr(kb_ + TB[1]);
                const u32x2 kl = __builtin_bit_cast(u32x2, klo), kh = __builtin_bit_cast(u32x2, khi); const u32x4 kw = {kl.x, kl.y, kh.x, kh.y};
                S[dkb] = __builtin_amdgcn_mfma_f32_32x32x16_bf16(__builtin_bit_cast(bf16x8, kw), vz, S[dkb], 0, 0, 0); }
            __builtin_amdgcn_sched_barrier(0);
          } }
        if (!(skip_ctx_y && n < 4)) {
            bf16* Yr = Y + (size_t)rowbase * 4096; const unsigned yo = (unsigned)(hd * RDV + dvh * 256 + wid * 32 + r + 4 * h * 4096);
#pragma unroll
            for (int it = 0; it < 2; ++it)
#pragma unroll
                for (int rg = 0; rg < 16; ++rg) { const unsigned i0 = (unsigned)(it * 32 + (rg & 3) + 8 * (rg >> 2));
                    Yr[yo + i0 * 4096u] = (bf16)(cvt_pk_bf16(Yt[it][rg], 0.f) & 0xffffu); }
        }
        asm volatile("s_waitcnt vmcnt(0)" ::: "memory");
        __syncthreads();
        if (more) dma_mat(nsrc + vcol, 8192, lds + OFF_V, wid, lane);
    }
    asm volatile("s_waitcnt vmcnt(0)" ::: "memory"); __syncthreads();
}
}

#define XB_TMO      128
#define XB_XCNT(j)  (256  + 64 * (j))
#define XB_XSUB(j)  (1280 + 64 * (j))
#define XB_XGEN(j)  (2304 + 64 * (j))
#define XB_TOP      3328
#define XB_TOPGEN   3392
#define XCD_BAR_WORDS 3456
#define XB_SPIN_CAP (1u << 22)
__device__ __forceinline__ unsigned xb_ld(unsigned* p)              { return __hip_atomic_load(p, __ATOMIC_RELAXED, __HIP_MEMORY_SCOPE_AGENT); }
__device__ __forceinline__ unsigned xb_add(unsigned* p, unsigned v) { return __hip_atomic_fetch_add(p, v, __ATOMIC_RELAXED, __HIP_MEMORY_SCOPE_AGENT); }
__device__ __forceinline__ unsigned xb_xcc_id() { return (unsigned)__builtin_amdgcn_s_getreg((3 << 11) | 20) & 0xFu; }
#define XB_SPIN(cond, bar) do { unsigned _sp = 0; while (cond) { __builtin_amdgcn_s_sleep(1); \
    if ((++_sp & 255u) == 0u) { if (xb_ld(&(bar)[XB_TMO])) break; if (_sp > XB_SPIN_CAP) { atomicAdd(&(bar)[XB_TMO], 1u); break; } } } } while (0)
struct XcdBarrier { unsigned* bar; unsigned x; volatile LAS unsigned* st; };
__device__ __forceinline__ XcdBarrier xcd_barrier_post(unsigned* bar, volatile LAS unsigned* st) {
    XcdBarrier b; b.bar = bar; b.x = xb_xcc_id(); b.st = st;
    if (threadIdx.x == 0) (void)xb_add(&bar[XB_XCNT(b.x)], 1u);
    return b;
}
__device__ __forceinline__ void xcd_barrier_complete(unsigned* bar, unsigned x, unsigned& nloc, unsigned& nx) {
    const unsigned G = gridDim.x * gridDim.y * gridDim.z;
    unsigned sum, cnt, mine, sp = 0u;
    for (;;) {
        sum = 0u; cnt = 0u; mine = 0u;
#pragma unroll
        for (unsigned j = 0; j < 16; ++j) { const unsigned c = xb_ld(&bar[XB_XCNT(j)]); sum += c; cnt += (c > 0u) ? 1u : 0u; mine = (j == x) ? c : mine; }
        if (sum == G) break;
        __builtin_amdgcn_s_sleep(1);
        if ((++sp & 255u) == 0u) { if (xb_ld(&bar[XB_TMO])) break; if (sp > XB_SPIN_CAP) { atomicAdd(&bar[XB_TMO], 1u); break; } }
    }
    nloc = mine > 0u ? mine : 1u; nx = cnt > 0u ? cnt : 1u;
}
__device__ __forceinline__ void xcd_barrier(const XcdBarrier& b) {
    asm volatile("s_waitcnt vmcnt(0)" ::: "memory");
    __syncthreads();
    if (threadIdx.x == 0) {
        unsigned* bar = b.bar; asm volatile("" : "+s"(bar));
        __builtin_amdgcn_s_waitcnt(0);
        unsigned nloc = b.st[0], nx = b.st[1];
        if (nloc == 0u) { xcd_barrier_complete(bar, b.x, nloc, nx); b.st[0] = nloc; b.st[1] = nx; }
        const unsigned old = xb_add(&bar[XB_XSUB(b.x)], 1u);
        const unsigned gen = old / nloc;
        if (old + 1u == (gen + 1u) * nloc) {
            __builtin_amdgcn_fence(__ATOMIC_RELEASE, "agent");
            asm volatile("s_waitcnt vmcnt(0)" ::: "memory");
            const unsigned og = xb_add(&bar[XB_TOP], 1u);
            const unsigned tg = og / nx;
            if (og + 1u == (tg + 1u) * nx) xb_add(&bar[XB_TOPGEN], 1u);
            else XB_SPIN(xb_ld(&bar[XB_TOPGEN]) == tg, bar);
            __builtin_amdgcn_fence(__ATOMIC_ACQUIRE, "agent");
            xb_add(&bar[XB_XGEN(b.x)], 1u);
            asm volatile("s_waitcnt vmcnt(0)" ::: "memory");
        } else {
            XB_SPIN(xb_ld(&bar[XB_XGEN(b.x)]) == gen, bar);
            __builtin_amdgcn_fence(__ATOMIC_ACQUIRE, "agent");
            asm volatile("s_waitcnt vmcnt(0)" ::: "memory");
        }
    }
    __syncthreads();
}

__device__ __forceinline__ float wave_sum(float v, int lane) {
#pragma unroll
    for (int o = 1; o < 64; o <<= 1) v += shfl_xor_l(v, o, lane);
    return v;
}
struct CvtDesc { const float* colptr; const float* kscale; bf16* WTrow0; int ldw, k0, K; float gscale; };
__device__ __forceinline__ void cvt_load(const CvtDesc& d, int lane, float (&v)[32]) {
#pragma unroll
    for (int i = 0; i < 32; ++i) { const int kk = 2 * i + (lane >> 5); float x = d.colptr ? d.colptr[(size_t)(d.k0 + kk) * d.ldw] : 0.f;
        if (d.kscale) x *= d.kscale[d.k0 + kk];
        v[i] = x * d.gscale; }
}
__device__ __forceinline__ void cvt_store(const CvtDesc& d, int lane, const float (&v)[32], LAS float* scr) {
#pragma unroll
    for (int i = 0; i < 32; ++i) scr[(2 * i + (lane >> 5)) * 33 + (lane & 31)] = v[i];
    asm volatile("s_waitcnt lgkmcnt(0)" ::: "memory");
    const int c = lane & 7;
#pragma unroll
    for (int j = 0; j < 4; ++j) { const int n = (lane >> 3) + 8 * j; const LAS float* s = scr + (8 * c) * 33 + n;
        u32x4 o; o.x = cvt_pk_bf16(s[0 * 33], s[1 * 33]); o.y = cvt_pk_bf16(s[2 * 33], s[3 * 33]); o.z = cvt_pk_bf16(s[4 * 33], s[5 * 33]); o.w = cvt_pk_bf16(s[6 * 33], s[7 * 33]);
        *(u32x4*)(d.WTrow0 + (size_t)n * d.K + d.k0 + 8 * c) = o; }
    asm volatile("s_waitcnt lgkmcnt(0)" ::: "memory");
}
__device__ __forceinline__ int ropeperm64(int c) { const int p = c >> 1, e = c & 1; return (p < 16) ? (p + 16 * e) : (32 + (p - 16) + 16 * e); }
__device__ __forceinline__ const float* src_col(int kind, const float* W0, const float* W1, int aux, int n) {
    switch (kind) {
        case 0: return W0 + aux + n;
        case 1: return W0 + aux + ropeperm64(n);
        case 2: { const int hh = n / DQ, d = n % DQ; return W0 + hh * DQ + (d < NOPE ? d : NOPE + ropeperm64(d - NOPE)); }
        case 3: { const int hh = n >> 8, d = n & 255; return W0 + hh * 256 + (d >> 1) + 128 * (d & 1); }
        case 4: { const int tl = n >> 8, j = n & 255; return (j < 128 ? W0 : W1) + tl * 128 + (j & 127); }
        default: return nullptr;
    }
}
struct CvtJob { const float* W0; const float* W1; const float* kscale; bf16* WT; int ldw, K, nrows, kind, aux; float gscale; };
__device__ __forceinline__ bool cvt_try(const CvtJob& J, int& it, int lane, CvtDesc& d) {
    const int nblk = J.nrows / 32, items = (J.K / 64) * nblk;
    if (it >= items) { it -= items; return false; }
    const int kb = it / nblk, nb = it % nblk;
    d.colptr = src_col(J.kind, J.W0, J.W1, J.aux, nb * 32 + (lane & 31)); d.kscale = J.kscale; d.WTrow0 = J.WT + (size_t)(nb * 32) * J.K; d.ldw = J.ldw; d.k0 = kb * 64; d.K = J.K; d.gscale = J.gscale;
    return true;
}
__device__ __forceinline__ int cvt_items(const CvtJob& J) { return (J.K / 64) * (J.nrows / 32); }

__device__ __forceinline__ void norm_mod_row(const float* xrow, const float* g, const float* sc, const float* sh, bf16* orow, int lane) {
    f32x4 v[8]; float s = 0.f;
#pragma unroll
    for (int j = 0; j < 8; ++j) { v[j] = *(const f32x4*)(xrow + 4 * lane + 256 * j); s += (v[j][0] * v[j][0] + v[j][1] * v[j][1]) + (v[j][2] * v[j][2] + v[j][3] * v[j][3]); }
    const float rstd = 1.0f / sqrtf(wave_sum(s, lane) * (1.0f / D) + NORM_EPS);
#pragma unroll
    for (int j = 0; j < 8; ++j) { const int c = 4 * lane + 256 * j; const f32x4 gg = *(const f32x4*)(g + c), s1 = *(const f32x4*)(sc + c), s0 = *(const f32x4*)(sh + c);
        const f32x4 y = (v[j] * rstd) * gg * (1.0f + s1) + s0;
        u32x2 w; w.x = cvt_pk_bf16(y[0], y[1]); w.y = cvt_pk_bf16(y[2], y[3]); *(u32x2*)(orow + c) = w; }
}

__device__ __forceinline__ unsigned long long ld_arg(LAS unsigned char* lds, int i) {
    const volatile LAS unsigned* p = (const volatile LAS unsigned*)(lds + ARGS_OFF) + 2 * i;
    const unsigned lo = __builtin_amdgcn_readfirstlane(p[0]), hi = __builtin_amdgcn_readfirstlane(p[1]);
    return ((unsigned long long)hi << 32) | lo;
}
__device__ __forceinline__ void cvt_layer(LAS unsigned char* lds, unsigned char* ws, int lc, int rank, int nranks, int wave, int lane) {
#define ARGF(i) ((const float*)ld_arg(lds, (i)))
    const int li = lc >> 1; const bool is_ret = (lc & 1) != 0;
    bf16* WM = (bf16*)(ws + (is_ret ? WS_WB : WS_WA)); bf16* WF = (bf16*)(ws + (is_ret ? WS_WB + 82 * MiB : WS_WA + 22 * MiB));
    LAS float* scr = (LAS float*)(lds + wave * 16384);
    CvtJob J[7]; int nj;
    if (!is_ret) {
        bf16* W1T = WM; bf16* WuqT = W1T + (size_t)N1 * D; bf16* WukvT = WuqT + (size_t)3072 * 512; bf16* WoT = WukvT + (size_t)4096 * 512;
        const float* wdq = ARGF(8) + (size_t)li * D * QR; const float* wdkv = ARGF(11) + (size_t)li * D * (KVR + ROPE);
        J[0] = CvtJob{wdq, nullptr, nullptr, W1T, QR, D, 512, 0, 0, 1.f};
        J[1] = CvtJob{wdkv, nullptr, nullptr, W1T + (size_t)512 * D, KVR + ROPE, D, 512, 0, 0, 1.f};
        J[2] = CvtJob{wdkv, nullptr, nullptr, W1T + (size_t)1024 * D, KVR + ROPE, D, 64, 1, 512, 1.f};
        J[3] = CvtJob{nullptr, nullptr, nullptr, W1T + (size_t)1088 * D, 1, D, 192, 5, 0, 1.f};
        J[4] = CvtJob{ARGF(10) + (size_t)li * QR * 3072, nullptr, ARGF(9) + li * QR, WuqT, 3072, QR, 3072, 2, 0, 0.07216878364870322f * LOG2E};
        J[5] = CvtJob{ARGF(13) + (size_t)li * KVR * 4096, nullptr, ARGF(12) + li * KVR, WukvT, 4096, KVR, 4096, 0, 0, 1.f};
        J[6] = CvtJob{ARGF(14) + (size_t)li * D * D, nullptr, nullptr, WoT, D, D, D, 0, 0, 1.f};
        nj = 7;
    } else {
        bf16* WqkvT = WM; bf16* WgT = WqkvT + (size_t)8192 * D; bf16* WoT = WgT + (size_t)8192 * D;
        J[0] = CvtJob{ARGF(15) + (size_t)li * D * D, nullptr, nullptr, WqkvT, D, D, 2048, 3, 0, 1.f};
        J[1] = CvtJob{ARGF(16) + (size_t)li * D * D, nullptr, nullptr, WqkvT + (size_t)2048 * D, D, D, 2048, 3, 0, 0.0625f};
        J[2] = CvtJob{ARGF(17) + (size_t)li * D * 4096, nullptr, nullptr, WqkvT + (size_t)4096 * D, 4096, D, 4096, 0, 0, 1.f};
        J[3] = CvtJob{ARGF(18) + (size_t)li * D * 4096, ARGF(19) + (size_t)li * D * 4096, nullptr, WgT, 4096, D, 8192, 4, 0, 1.f};
        J[4] = CvtJob{ARGF(20) + (size_t)li * 4096 * D, nullptr, nullptr, WoT, D, 4096, D, 0, 0, 1.f};
        J[5] = CvtJob{nullptr, nullptr, nullptr, nullptr, 1, 64, 0, 5, 0, 1.f};
        J[6] = J[5];
        nj = 5;
    }
    CvtJob F0 = CvtJob{ARGF(23) + (size_t)lc * D * FF, ARGF(24) + (size_t)lc * D * FF, nullptr, WF, FF, D, 11264, 4, 0, 1.f};
    CvtJob F1 = CvtJob{ARGF(27) + (size_t)lc * FF * D, nullptr, nullptr, WF + (size_t)11264 * D, D, FF, D, 0, 0, 1.f};
    int total = cvt_items(F0) + cvt_items(F1);
#pragma unroll
    for (int j = 0; j < 7; ++j) if (j < nj) total += cvt_items(J[j]);
#define CVT_FIND(IT, DD) do { int it_ = (IT); bool done_ = false; \
        _Pragma("unroll") for (int j = 0; j < 7; ++j) if (!done_ && j < nj) done_ = cvt_try(J[j], it_, lane, DD); \
        if (!done_) done_ = cvt_try(F0, it_, lane, DD); if (!done_) done_ = cvt_try(F1, it_, lane, DD); } while (0)
    if (rank < total) {
        float v[32], w[32]; CvtDesc d0, d1; int it0 = rank;
        CVT_FIND(it0, d0); cvt_load(d0, lane, v);
        for (;;) {
            const int it1 = it0 + nranks; const bool has = it1 < total;
            if (has) { CVT_FIND(it1, d1); cvt_load(d1, lane, w); }
            cvt_store(d0, lane, v, scr);
            if (!has) break;
#pragma unroll
            for (int i = 0; i < 32; ++i) v[i] = w[i];
            d0 = d1; it0 = it1;
        }
    }
#undef CVT_FIND
#undef ARGF
}
struct Args { const float* in[29]; float* out; unsigned char* ws; int ph_lo, ph_hi; };
constexpr int PH_PER_LAYER = 10, PH_FINAL = 1 + PH_PER_LAYER * DEPTH, PH_COUNT = PH_FINAL + 1;

template <unsigned MK_EN_T>
__global__ void __launch_bounds__(512, 2) mk_fwd(Args args) {
    extern __shared__ __attribute__((aligned(16))) unsigned char lds_raw[];
    LAS unsigned char* lds = (LAS unsigned char*)lds_raw;
    volatile LAS unsigned* MISC = (volatile LAS unsigned*)(lds + MISC_OFF);
    const int G = gridDim.x; const int bx = blockIdx.x; const int vcu = (G % 8 == 0) ? (bx % 8) * (G / 8) + bx / 8 : bx;
    const int NGW = G * 8;
    unsigned char* ws = args.ws; float* X = args.out;
    const int lo = args.ph_lo, hi = args.ph_hi;
    { const int tid0 = threadIdx.x;
      for (int u = tid0; u < (LDS_BYTES - CTRL_BASE) / 4; u += 512) ((LAS unsigned*)(lds + CTRL_BASE))[u] = 0u;
      __syncthreads();
      if (tid0 < 29) ((volatile LAS unsigned long long*)(lds + ARGS_OFF))[tid0] = (unsigned long long)args.in[tid0];
      __syncthreads(); }
#define ARGF(i) ((const float*)ld_arg(lds, (i)))
    XcdBarrier bar; bar.bar = (unsigned*)(ws + WS_CTL) + CW_BAR; bar.x = 0; bar.st = nullptr;
    if (hi - lo > 1) bar = xcd_barrier_post((unsigned*)(ws + WS_CTL) + CW_BAR, MISC + 8);
#define EN(b) (((MK_EN_T) >> (b)) & 1u)
#define IN(k) (lo <= (k) && (k) < hi)
#define PHASE_END(k) do { if (hi > (k) + 1) xcd_barrier(bar); } while (0)
#define PH_IDS int tid = threadIdx.x; asm volatile("" : "+v"(tid)); const int lane = tid & 63; const int wave = __builtin_amdgcn_readfirstlane(tid >> 6); const int gw = vcu * 8 + wave; (void)lane; (void)gw;
#define XC_    ((float*)(ws + WS_XC))
#define MODV_  ((float*)(ws + WS_MODV))
#define TABM_  ((float*)(ws + WS_TABM))
#define TABR_  ((float*)(ws + WS_TABR))
#define SSQ_   ((float*)(ws + WS_SSQ))
#define KR_    ((bf16*)(ws + WS_KR))
#define H_     ((bf16*)(ws + WS_H))
#define WMIX_(ll) ((bf16*)(ws + (((ll) & 1) ? WS_WB : WS_WA)))
#define WFFN_(ll) ((bf16*)(ws + (((ll) & 1) ? WS_WB + 82 * MiB : WS_WA + 22 * MiB)))
#define W1T_   WMIX_(l)
#define WUQT_  (W1T_ + (size_t)N1 * D)
#define WUKVT_ (WUQT_ + (size_t)3072 * 512)
#define WOTM_  (WUKVT_ + (size_t)4096 * 512)
#define WQKVT_ WMIX_(l)
#define WGT_   (WQKVT_ + (size_t)8192 * D)
#define WOTR_  (WGT_ + (size_t)8192 * D)
#define WGUT_  WFFN_(l)
#define WDT_   (WGUT_ + (size_t)11264 * D)
#define QKVL_  ((bf16*)(ws + WS_QKVL))
#define Q_     ((bf16*)(ws + WS_Q))
#define KV_    ((bf16*)(ws + WS_KV))
#define O_     ((bf16*)(ws + WS_O))
#define QKV_   ((bf16*)(ws + WS_QKV))
#define Y_     ((bf16*)(ws + WS_Y))
#define GATED_ ((bf16*)(ws + WS_GATED))
#define GB_    ((bf16*)(ws + WS_G))
#define UB_    ((bf16*)(ws + WS_U))
#define HALO_  ((float*)(ws + WS_G))
#define MODL_  (MODV_ + (size_t)l * 9 * NMOD)

    if (EN(0) && IN(0)) for (int rep_ = 0; rep_ < 1 + (int)((PROBE_MASK >> 0) & 1u); ++rep_) {
        PH_IDS
        LAS float* cond = (LAS float*)lds;
        LAS float* red = (LAS float*)(lds + 73728);
        { const float* cin = ARGF(1); const float* cc = ARGF(3);
          for (int i = tid; i < 9 * D; i += 512) { const int r = i >> 11, k = i & (D - 1); const float c = (r < 8) ? cin[r * D + k] : cc[k]; cond[i] = c / (1.0f + __expf(-c)); } }
        __syncthreads();
        for (int it = bx; it < DEPTH * 96; it += G) {
            const int l = it / 96, cb = it % 96; const int n = cb * 128 + 2 * lane;
            const float* W = ARGF(4) + (size_t)l * D * NMOD + n; const float* mb = ARGF(5) + (size_t)l * NMOD + cb * 128;
            float a0[9], a1[9];
#pragma unroll
            for (int r = 0; r < 9; ++r) { a0[r] = 0.f; a1[r] = 0.f; }
            for (int k = wave * 256; k < wave * 256 + 256; k += 4) {
                f32x2 w[4];
#pragma unroll
                for (int q = 0; q < 4; ++q) w[q] = *(const f32x2*)(W + (size_t)(k + q) * NMOD);
#pragma unroll
                for (int r = 0; r < 9; ++r) { const f32x4 c4 = *(const LAS f32x4*)(cond + r * D + k);
#pragma unroll
                    for (int q = 0; q < 4; ++q) { a0[r] += c4[q] * w[q][0]; a1[r] += c4[q] * w[q][1]; } }
            }
#pragma unroll
            for (int r = 0; r < 9; ++r) { red[(wave * 9 + r) * 128 + 2 * lane] = a0[r]; red[(wave * 9 + r) * 128 + 2 * lane + 1] = a1[r]; }
            __syncthreads();
            for (int i = tid; i < 9 * 128; i += 512) { const int r = i >> 7, cc = i & 127; float s = 0.f;
#pragma unroll
                for (int w8 = 0; w8 < 8; ++w8) s += red[(w8 * 9 + r) * 128 + cc];
                MODV_[((size_t)l * 9 + r) * NMOD + cb * 128 + cc] = s + mb[cc]; }
            __syncthreads();
        }
        for (int i = bx * 512 + tid; i < 64 * 16 + SEQ * 128; i += G * 512) {
            float inv, pos; float* dst;
            if (i < 1024) { const int p = i >> 4, f = i & 15; inv = __builtin_amdgcn_exp2f(-(float)(2 * f) * (13.287712379549449f / 32.0f)); pos = (float)p; dst = TABM_ + 2 * i; }
            else { const int j = i - 1024, t = j >> 7, f = j & 127; inv = __builtin_amdgcn_exp2f(-(float)(2 * f) * (13.287712379549449f / 256.0f)); pos = (float)t; dst = TABR_ + 2 * j; }
            const float ang = pos * inv; const double rev = (double)ang * 0.15915494309189535; const float fr = (float)(rev - floor(rev));
            dst[0] = __builtin_amdgcn_cosf(fr); dst[1] = __builtin_amdgcn_sinf(fr);
        }
        PHASE_END(0);
    }

    for (int l = 0; l < DEPTH; ++l) {
        const int P = 1 + PH_PER_LAYER * l; const int li = l >> 1; const bool is_ret = (l & 1) != 0; const bool last = (l == DEPTH - 1);
        const int Mrows = last ? MX : MT;

        if (EN(1) && IN(P + 0)) for (int rep_ = 0; rep_ < 1 + (int)((PROBE_MASK >> 1) & 1u); ++rep_) {
            PH_IDS
            if (l == 0) cvt_layer(lds, ws, 0, gw, NGW, wave, lane);
            const float* g = ARGF(6) + l * D; const float* xsrc = (l == 0) ? ARGF(0) : X; const float* csrc = (l == 0) ? ARGF(2) : XC_;
            for (int m = gw; m < MT; m += NGW) { const bool isx = m < MX; const float* mr = MODL_ + (size_t)(isx ? (m >> 12) : 8) * NMOD;
                norm_mod_row(isx ? xsrc + (size_t)m * D : csrc + (size_t)(m - MX) * D, g, mr + D, mr, H_ + (size_t)m * D, lane); }
            PHASE_END(P + 0);
        }

        if (!is_ret) {
            if (EN(2) && IN(P + 1)) for (int rep_ = 0; rep_ < 1 + (int)((PROBE_MASK >> 2) & 1u); ++rep_) {
                pg8::Gemm g{H_, W1T_, MT, N1, D, D}; pg8::StaticOrder S; S.init(MT, N1, G, bx);
                EpiG1 E{QKVL_, SSQ_, KR_, TABM_};
                pg8::gemm_phase<EpiG1>(lds, g, S, E);
                PHASE_END(P + 1);
            }
            if (EN(3) && IN(P + 2)) for (int rep_ = 0; rep_ < 1 + (int)((PROBE_MASK >> 3) & 1u); ++rep_) {
                { pg8::Gemm g{QKVL_, WUQT_, MT, 3072, QR, N1}; pg8::StaticOrder S; S.init(MT, 3072, G, bx); EpiUq E{Q_, SSQ_, TABM_}; pg8::gemm_phase<EpiUq>(lds, g, S, E); }
                { pg8::Gemm g{QKVL_ + 512, WUKVT_, MT, 4096, KVR, N1}; pg8::StaticOrder S; S.init(MT, 4096, G, bx); EpiUkv E{KV_, SSQ_}; pg8::gemm_phase<EpiUkv>(lds, g, S, E); }
                PHASE_END(P + 2);
            }
            if (EN(4) && IN(P + 3)) for (int rep_ = 0; rep_ < 1 + (int)((PROBE_MASK >> 4) & 1u); ++rep_) {
                const int nun = 2048 + 128;
                for (int ui = vcu; ui < nun; ui += G) {
                    if (ui < 2048) { const int xcd = (ui & 255) >> 5, j = ui & 31, rnd = ui >> 8; const int bh = xcd * 16 + 2 * rnd + (j >> 4), qb = j & 15; const int b = bh >> 4, hd = bh & 15;
                        att::attn_unit(Q_ + (size_t)(b * SEQ + qb * 256) * 3072 + hd * DQ, KV_ + hd * 256, KR_, O_ + (size_t)(b * SEQ + qb * 256) * D + hd * 128, 68, 4, MX + b * CTXL, b * SEQ, (char*)lds_raw);
                    } else { const int bh = ui - 2048, b = bh >> 4, hd = bh & 15;
                        att::attn_unit(Q_ + (size_t)(MX + b * CTXL) * 3072 + hd * DQ, KV_ + hd * 256, KR_, O_ + (size_t)(MX + b * CTXL) * D + hd * 128, 4, 4, MX + b * CTXL, 0, (char*)lds_raw); }
                }
                PHASE_END(P + 3);
            }
        } else {
            if (EN(5) && IN(P + 1)) for (int rep_ = 0; rep_ < 1 + (int)((PROBE_MASK >> 5) & 1u); ++rep_) {
                pg8::Gemm g{H_, WQKVT_, MT, 8192, D, D}; pg8::StaticOrder S; S.init(MT, 8192, G, bx);
                EpiQKV E{QKV_, TABR_};
                pg8::gemm_phase<EpiQKV>(lds, g, S, E);
                PHASE_END(P + 1);
            }
            if (EN(6) && IN(P + 2)) for (int rep_ = 0; rep_ < 1 + (int)((PROBE_MASK >> 6) & 1u); ++rep_) {
                for (int ui = vcu; ui < 256; ui += G) {
                    const int bh = ui >> 2, dir = (ui >> 1) & 1, dvh = ui & 1; const int b = bh >> 3, hd = bh & 7;
                    const float dec = (dir ? ARGF(22) : ARGF(21))[li * RH + hd];
                    const float lg2 = -__expf(dec) * LOG2E;
                    scan::scan_unit(QKV_, Y_ + (size_t)dir * MT * 4096, b, hd, dir, dvh, lg2, last, lds);
                }
                PHASE_END(P + 2);
            }
            if (EN(7) && IN(P + 3)) for (int rep_ = 0; rep_ < 1 + (int)((PROBE_MASK >> 7) & 1u); ++rep_) {
                PH_IDS
                const int nitems = Mrows * RH * 2;
                for (int it = gw; it < nitems; it += NGW) { const int dir = it & 1, hd = (it >> 1) & 7, row = it >> 4;
                    bf16* p = Y_ + (size_t)dir * MT * 4096 + (size_t)row * 4096 + hd * RDV + lane * 8;
                    const u32x4 w = *(const u32x4*)p; float v[8] = {bflo(w.x), bfhi(w.x), bflo(w.y), bfhi(w.y), bflo(w.z), bfhi(w.z), bflo(w.w), bfhi(w.w)};
                    float s = 0.f;
#pragma unroll
                    for (int e = 0; e < 8; ++e) s += v[e];
                    const float mu = wave_sum(s, lane) * (1.0f / RDV); float q = 0.f;
#pragma unroll
                    for (int e = 0; e < 8; ++e) { v[e] -= mu; q += v[e] * v[e]; }
                    const float rstd = 1.0f / sqrtf(wave_sum(q, lane) * (1.0f / RDV) + GN_EPS);
                    u32x4 o; o.x = cvt_pk_bf16(v[0] * rstd, v[1] * rstd); o.y = cvt_pk_bf16(v[2] * rstd, v[3] * rstd); o.z = cvt_pk_bf16(v[4] * rstd, v[5] * rstd); o.w = cvt_pk_bf16(v[6] * rstd, v[7] * rstd);
                    *(u32x4*)p = o; }
                PHASE_END(P + 3);
            }
            if (EN(8) && IN(P + 4)) for (int rep_ = 0; rep_ < 1 + (int)((PROBE_MASK >> 8) & 1u); ++rep_) {
                pg8::Gemm g{H_, WGT_, Mrows, 8192, D, D}; pg8::StaticOrder S; S.init(Mrows, 8192, G, bx);
                EpiGate E{GATED_, Y_, Y_ + (size_t)MT * 4096};
                pg8::gemm_phase<EpiGate>(lds, g, S, E);
                PHASE_END(P + 4);
            }
        }
        if (EN(9) && IN(P + 5)) for (int rep_ = 0; rep_ < 1 + (int)((PROBE_MASK >> 9) & 1u); ++rep_) {
            pg8::Gemm g = is_ret ? pg8::Gemm{GATED_, WOTR_, Mrows, D, 4096, 4096} : pg8::Gemm{O_, WOTM_, Mrows, D, D, D};
            pg8::StaticOrder S; S.init(Mrows, D, G, bx);
            const float* xsrc = (l == 0) ? ARGF(0) : X; const float* csrc = (l == 0) ? ARGF(2) : XC_;
            EpiResid E{xsrc, X, csrc, XC_, MODL_, 2 * D};
            pg8::gemm_phase<EpiResid>(lds, g, S, E);
            PHASE_END(P + 5);
        }
        if (EN(10) && IN(P + 6)) for (int rep_ = 0; rep_ < 1 + (int)((PROBE_MASK >> 10) & 1u); ++rep_) {
            PH_IDS
            const float* g = ARGF(7) + l * D;
            for (int m = gw; m < Mrows; m += NGW) { const bool isx = m < MX; const float* mr = MODL_ + (size_t)(isx ? (m >> 12) : 8) * NMOD;
                norm_mod_row(isx ? X + (size_t)m * D : XC_ + (size_t)(m - MX) * D, g, mr + 4 * D, mr + 3 * D, H_ + (size_t)m * D, lane); }
            PHASE_END(P + 6);
        }
        if (EN(11) && IN(P + 7)) for (int rep_ = 0; rep_ < 1 + (int)((PROBE_MASK >> 11) & 1u); ++rep_) {
            pg8::Gemm g{H_, WGUT_, Mrows, 11264, D, D}; pg8::StaticOrder S; S.init(Mrows, 11264, G, bx);
            EpiGUConv E{UB_, HALO_, ARGF(25) + (size_t)l * 3 * FF, ARGF(26) + (size_t)l * FF, (LAS float*)(lds + EDGE_OFF)};
            pg8::gemm_phase<EpiGUConv>(lds, g, S, E);
            PHASE_END(P + 7);
        }
        if (EN(12) && IN(P + 8)) for (int rep_ = 0; rep_ < 1 + (int)((PROBE_MASK >> 12) & 1u); ++rep_) {
            PH_IDS
            const float* cw = ARGF(25) + (size_t)l * 3 * FF; const float* cb = ARGF(26) + (size_t)l * FF; (void)cb;
            const float* HL = HALO_; bf16* ACT = UB_;
            const int nq = FF / 4;
            for (int i = bx * 512 + tid; i < 120 * nq; i += G * 512) {
                const int bi = i / nq, f = (i % nq) * 4; const int pm = (bi / 15) * 16 + (bi % 15) + 1;
                const float* top = HL + (size_t)((pm * 2 + 0) * 3) * HALO_STRIDE + f; const float* bot = HL + (size_t)(((pm - 1) * 2 + 1) * 3) * HALO_STRIDE + f;
                const f32x4 ct = *(const f32x4*)top, gt = *(const f32x4*)(top + HALO_STRIDE), ut = *(const f32x4*)(top + 2 * HALO_STRIDE);
                const f32x4 cbm = *(const f32x4*)bot, gb = *(const f32x4*)(bot + HALO_STRIDE), ub = *(const f32x4*)(bot + 2 * HALO_STRIDE);
                const f32x4 w0 = *(const f32x4*)(cw + f), w2 = *(const f32x4*)(cw + 2 * FF + f);
                const f32x4 ot = silu4(ct + w0 * gb) * ut, ob = silu4(cbm + w2 * gt) * ub;
                u32x2 wt, wb; wt.x = cvt_pk_bf16(ot[0], ot[1]); wt.y = cvt_pk_bf16(ot[2], ot[3]); wb.x = cvt_pk_bf16(ob[0], ob[1]); wb.y = cvt_pk_bf16(ob[2], ob[3]);
                *(u32x2*)(ACT + (size_t)(pm * 256) * FF + f) = wt; *(u32x2*)(ACT + (size_t)(pm * 256 - 1) * FF + f) = wb;
            }
            PHASE_END(P + 8);
        }
        if (EN(13) && IN(P + 9)) for (int rep_ = 0; rep_ < 1 + (int)((PROBE_MASK >> 13) & 1u); ++rep_) {
            pg8::Gemm g{UB_, WDT_, Mrows, D, FF, FF}; pg8::StaticOrder S; S.init(Mrows, D, G, bx);
            EpiResid E{X, X, XC_, XC_, MODL_, 5 * D};
            pg8::gemm_phase<EpiResid>(lds, g, S, E);
            if (l + 1 < DEPTH) {
                PH_IDS
                const int nwg = (Mrows / 256) * (D / 256), rem = nwg % G;
                if (rem == 0) cvt_layer(lds, ws, l + 1, gw, NGW, wave, lane);
                else if (bx >= rem) cvt_layer(lds, ws, l + 1, (bx - rem) * 8 + wave, (G - rem) * 8, wave, lane);
            }
            PHASE_END(P + 9);
        }
    }
    if (EN(14) && IN(PH_FINAL)) for (int rep_ = 0; rep_ < 1 + (int)((PROBE_MASK >> 14) & 1u); ++rep_) {
        PH_IDS
        const float* g = ARGF(28);
        for (int m = gw; m < MX; m += NGW) { float* xr = X + (size_t)m * D;
            f32x4 v[8]; float s = 0.f;
#pragma unroll
            for (int j = 0; j < 8; ++j) { v[j] = *(const f32x4*)(xr + 4 * lane + 256 * j); s += (v[j][0] * v[j][0] + v[j][1] * v[j][1]) + (v[j][2] * v[j][2] + v[j][3] * v[j][3]); }
            const float rstd = 1.0f / sqrtf(wave_sum(s, lane) * (1.0f / D) + NORM_EPS);
#pragma unroll
            for (int j = 0; j < 8; ++j) { const int c = 4 * lane + 256 * j; *(f32x4*)(xr + c) = (v[j] * rstd) * *(const f32x4*)(g + c); } }
    }
#undef IN
#undef PHASE_END
}

#if !MK_SINGLE
typedef void (*KernFn)(Args);
static KernFn phase_kernel(int bit) {
    switch (bit) {
        case 0: return mk_fwd<1u << 0>;  case 1: return mk_fwd<1u << 1>;  case 2: return mk_fwd<1u << 2>;  case 3: return mk_fwd<1u << 3>;
        case 4: return mk_fwd<1u << 4>;  case 5: return mk_fwd<1u << 5>;  case 6: return mk_fwd<1u << 6>;  case 7: return mk_fwd<1u << 7>;
        case 8: return mk_fwd<1u << 8>;  case 9: return mk_fwd<1u << 9>;  case 10: return mk_fwd<1u << 10>; case 11: return mk_fwd<1u << 11>;
        case 12: return mk_fwd<1u << 12>; case 13: return mk_fwd<1u << 13>; default: return mk_fwd<1u << 14>;
    }
}
static int phase_bit(int p) {
    if (p == 0) return 0; if (p == PH_FINAL) return 14;
    const int l = (p - 1) / PH_PER_LAYER, slot = (p - 1) % PH_PER_LAYER; const bool ret = (l & 1) != 0;
    if (slot == 0) return 1;
    if (slot >= 5) return 4 + slot;
    if (!ret) return slot == 4 ? -1 : 1 + slot;
    return 4 + slot;
}
#endif
extern "C" void kernel_launch(void* const* d_in, const int* in_sizes, int n_in, void* d_out, int out_size, void* d_ws, size_t ws_size, hipStream_t stream) {
    static int grid = 0;
    if (grid == 0) {
        if (n_in != 29 || out_size != MX * D || ws_size < WS_END) { fprintf(stderr, "kernel_launch: unexpected shapes: n_in %d out %d ws %zu (need %zu)\n", n_in, out_size, ws_size, (size_t)WS_END); grid = -1; return; }
        int dev = 0, cus = 0;
        if (hipGetDevice(&dev) != hipSuccess || hipDeviceGetAttribute(&cus, hipDeviceAttributeMultiprocessorCount, dev) != hipSuccess) { grid = -1; return; }
#if MK_SINGLE
        if (hipFuncSetAttribute((const void*)mk_fwd<0xFFFFFFFFu>, hipFuncAttributeMaxDynamicSharedMemorySize, LDS_BYTES) != hipSuccess) { fprintf(stderr, "kernel_launch: hipFuncSetAttribute failed\n"); grid = -1; return; }
#else
        for (int b = 0; b < 15; ++b) if (hipFuncSetAttribute((const void*)phase_kernel(b), hipFuncAttributeMaxDynamicSharedMemorySize, LDS_BYTES) != hipSuccess) { fprintf(stderr, "kernel_launch: hipFuncSetAttribute failed\n"); grid = -1; return; }
#endif
        (void)hipGetLastError();
        grid = cus;
    }
    if (grid < 0) return;
    if (hipMemsetAsync((char*)d_ws + WS_CTL, 0, CTL_BYTES, stream) != hipSuccess) return;
    Args a{};
    for (int i = 0; i < 29; ++i) a.in[i] = (const float*)d_in[i];
    a.out = (float*)d_out; a.ws = (unsigned char*)d_ws;
#if MK_SINGLE
    a.ph_lo = 0; a.ph_hi = PH_COUNT;
    hipLaunchKernelGGL(mk_fwd<0xFFFFFFFFu>, dim3(grid), dim3(512), LDS_BYTES, stream, a);
#else
    for (int p = 0; p < PH_COUNT; ++p) {
        const int bit = phase_bit(p); if (bit < 0) continue;
        a.ph_lo = p; a.ph_hi = p + 1;
        hipLaunchKernelGGL(phase_kernel(bit), dim3(grid), dim3(512), LDS_BYTES, stream, a);
    }
#endif
    const hipError_t le = hipPeekAtLastError();
    if (le != hipSuccess) fprintf(stderr, "kernel_launch: launch failed: %s\n", hipGetErrorName(le));
}
```

```cpp
#include <hip/hip_runtime.h>
#include <cstdio>
#include <cstdint>

#ifndef MK_SINGLE
#define MK_SINGLE 1
#endif

#ifndef MK_STAGGER
#define MK_STAGGER 0
#endif
#ifndef PROBE_EPI2
#define PROBE_EPI2 0
#endif
#ifndef PROBE_MASK
#define PROBE_MASK 0u
#endif
#define GAS __attribute__((address_space(1)))
#define LAS __attribute__((address_space(3)))
typedef unsigned short bf16;
typedef short bf16x8 __attribute__((ext_vector_type(8)));
typedef short s16x4 __attribute__((ext_vector_type(4)));
typedef float f32x2 __attribute__((ext_vector_type(2)));
typedef float f32x4 __attribute__((ext_vector_type(4)));
typedef float f32x16 __attribute__((ext_vector_type(16)));
typedef unsigned u32x2 __attribute__((ext_vector_type(2)));
typedef unsigned u32x4 __attribute__((ext_vector_type(4)));
typedef GAS unsigned gu32;

constexpr int D = 2048, NB = 8, SEQ = 4096, CTXL = 256, DEPTH = 4;
constexpr int MX = NB * SEQ, MC = NB * CTXL, MT = MX + MC;
constexpr int FF = 5632, NMOD = 6 * D;
constexpr int MLA_H = 16, QR = 512, KVR = 512, NOPE = 128, ROPE = 64, DQ = 192;
constexpr int N1 = 1280;
constexpr int RH = 8, RDK = 256, RDV = 512;
constexpr float NORM_EPS = 1e-6f, GN_EPS = 1e-5f;
constexpr float LOG2E = 1.4426950408889634f;

constexpr size_t MiB = 1u << 20;
constexpr size_t WS_CTL = 0, CTL_BYTES = 1 * MiB;
constexpr size_t WS_MODV = 1 * MiB;
constexpr size_t WS_TABM = 3 * MiB;
constexpr size_t WS_TABR = 4 * MiB;
constexpr size_t WS_SSQ = 8 * MiB;
constexpr size_t WS_XC = 12 * MiB;
constexpr size_t WS_KR = 28 * MiB;
constexpr size_t WS_STATS = 33 * MiB;
constexpr size_t WS_WA = 40 * MiB;
constexpr size_t WS_WB = 128 * MiB;
constexpr size_t WS_H = 276 * MiB;
constexpr size_t WS_BIG = 412 * MiB;
constexpr size_t WS_QKVL = WS_BIG, WS_Q = WS_BIG + 88 * MiB, WS_KV = WS_BIG + 292 * MiB, WS_O = WS_BIG + 564 * MiB;
constexpr size_t WS_QKV = WS_BIG, WS_Y = WS_BIG + 544 * MiB, WS_GATED = WS_BIG;
constexpr size_t WS_G = WS_BIG, WS_U = WS_BIG + 374 * MiB;
constexpr size_t WS_END = WS_BIG + 1088 * MiB;
static_assert((size_t)MT * 8192 * 2 <= 544 * MiB && (size_t)MT * 5632 * 2 <= 374 * MiB && (size_t)MT * N1 * 2 <= 88 * MiB, "ws map");

constexpr int CW_BAR = 4096;

constexpr int RING_BYTES = 131072, CTRL_BASE = 155648, MISC_OFF = CTRL_BASE + 320, ARGS_OFF = CTRL_BASE + 1024, EDGE_OFF = CTRL_BASE + 4096, LDS_BYTES = 163840;

__device__ __forceinline__ unsigned cvt_pk_bf16(float lo, float hi) { unsigned r; asm volatile("v_cvt_pk_bf16_f32 %0, %1, %2" : "=v"(r) : "v"(lo), "v"(hi)); return r; }
__device__ __forceinline__ float bf2f(unsigned short b) { return __uint_as_float((unsigned)b << 16); }
__device__ __forceinline__ float bflo(unsigned w) { return __uint_as_float(w << 16); }
__device__ __forceinline__ float bfhi(unsigned w) { return __uint_as_float(w & 0xffff0000u); }
__device__ __forceinline__ float shfl_xor_l(float v, int mask, int lane) { return __builtin_bit_cast(float, __builtin_amdgcn_ds_bpermute((lane ^ mask) << 2, __builtin_bit_cast(int, v))); }
__device__ __forceinline__ float fast_silu(float x) { return x * __builtin_amdgcn_rcpf(1.0f + __builtin_amdgcn_exp2f(-x * LOG2E)); }

__device__ __forceinline__ void glds16_s(const void* sbase, unsigned voff, unsigned lds_dst) {
    unsigned keep;
    asm volatile("s_mov_b32 %0, m0\n\ts_mov_b32 m0, %3\n\ts_nop 0\n\tglobal_load_lds_dwordx4 %1, %2\n\ts_mov_b32 m0, %0" : "=&s"(keep) : "v"(voff), "s"(sbase), "s"(lds_dst) : "memory");
}
__device__ __forceinline__ const char* uni_ptr(const void* p) {
    const unsigned long long v = (unsigned long long)p; const unsigned lo = __builtin_amdgcn_readfirstlane((unsigned)v), hi = __builtin_amdgcn_readfirstlane((unsigned)(v >> 32));
    return (const char*)(((unsigned long long)hi << 32) | lo);
}
namespace pg8 {
constexpr int BM = 256, BK = 64, HALF = 128, HTB = HALF * BK * 2, STAGE_BYTES = 8 * HTB, NXCD = 8, WGM = 8;
__host__ __device__ __forceinline__ int lds_byte(int r, int c) { const int st = (r >> 4) * 2 + (c >> 5), rr = r & 15, cc = c & 31, ob = rr * 64 + cc * 2; return st * 1024 + (ob ^ (((ob >> 9) & 1) << 5)); }
__host__ __device__ __forceinline__ void stage_rc(int b, int& R, int& C) { const int st = b / 1024, sb = b % 1024, swz = sb ^ (((sb >> 9) & 1) << 5); R = (st >> 1) * 16 + swz / 64; C = (st & 1) * 32 + (swz % 64) / 2; }
__host__ __device__ __forceinline__ int perm32(int rho) { const int n = rho >> 4, i = rho & 15; return 8 * (i >> 2) + 4 * n + (i & 3); }
struct Unit { int pm, pn; };
struct Gemm { const bf16* A; const bf16* Bt; int M, N, K, lda; };
struct StaticOrder {
    int nM, nN, nwg, G, c;
    __device__ void init(int M, int N, int G_, int c_) { nM = M / BM; nN = N / BM; nwg = nM * nN; G = G_; c = c_; }
    __device__ bool next(int i, Unit& u) const {
        const long L = (long)i * G + c; if (L >= nwg) return false;
        int wgid = (int)L; { const int q = nwg / NXCD, r = nwg % NXCD, xcd = wgid % NXCD, off = wgid / NXCD; wgid = (xcd < r ? xcd * (q + 1) : r * (q + 1) + (xcd - r) * q) + off; }
        const int nig = WGM * nN, gid = wgid / nig, fm = gid * WGM, gsz = (nM - fm) < WGM ? (nM - fm) : WGM;
        u.pm = fm + ((wgid % nig) % gsz); u.pn = (wgid % nig) / gsz; return true;
    }
};
template <class Epi>
__device__ __forceinline__ void gemm_phase(LAS unsigned char* lds, const Gemm g, const StaticOrder& S, const Epi& E) {
    int tid = threadIdx.x; asm volatile("" : "+v"(tid));
    const int wid = __builtin_amdgcn_readfirstlane(tid >> 6), lane = tid & 63, wr = wid >> 2, wc = wid & 3, fr = lane & 15, fq = lane >> 4;
    const int K = g.K, nt = K / BK;
    unsigned voffA[2], voffB[2];
#pragma unroll
    for (int i = 0; i < 2; ++i) { int R, C; stage_rc(tid * 16 + i * 8192, R, C); const int Rb = Epi::PERM ? ((R & ~31) + perm32(R & 31)) : R;
        voffA[i] = (unsigned)(R * g.lda + C) * 2u; voffB[i] = (unsigned)(Rb * K + C) * 2u; }
    const size_t kstep = (size_t)(BK * 2);
    const size_t hstepA = (size_t)HALF * g.lda * 2, hstepB = (size_t)HALF * K * 2;
    const size_t tstepA = 2 * hstepA, tstepB = 2 * hstepB;
    const unsigned ldsbase = (unsigned)__builtin_amdgcn_readfirstlane((unsigned)(uintptr_t)lds + (unsigned)wid * 1024u);
    const int aoff = lds_byte(wr * 64 + fr, fq * 8), boff = lds_byte(wc * 32 + fr, fq * 8);
#define PG8_SA(b, h) (((b) * 2 + (h)) * HTB)
#define PG8_SB(b, h) ((4 + (b) * 2 + (h)) * HTB)
#define PG8_STAGE(bufoff, gbase, voff) do { const char* _gb = uni_ptr(gbase); _Pragma("unroll") for (int _i = 0; _i < 2; ++_i) \
        glds16_s(_gb, (voff)[_i], ldsbase + (unsigned)((bufoff) + _i * 8192)); } while (0)
#define PG8_LDA(dst, b, h) do { _Pragma("unroll") for (int m = 0; m < 4; ++m) _Pragma("unroll") for (int k = 0; k < 2; ++k) dst[m][k] = *(const LAS bf16x8*)(lds + PG8_SA(b, h) + aoff + m * 2048 + k * 1024); } while (0)
#define PG8_LDB(dst, b, h) do { _Pragma("unroll") for (int n = 0; n < 2; ++n) _Pragma("unroll") for (int k = 0; k < 2; ++k) dst[n][k] = *(const LAS bf16x8*)(lds + PG8_SB(b, h) + boff + n * 2048 + k * 1024); } while (0)
#define PG8_MMA(ai, bj, At, Bt) do { __builtin_amdgcn_s_setprio(1); _Pragma("unroll") for (int m = 0; m < 4; ++m) _Pragma("unroll") for (int n = 0; n < 2; ++n) _Pragma("unroll") for (int k = 0; k < 2; ++k) \
        acc[ai][bj][m][n] = __builtin_amdgcn_mfma_f32_16x16x32_bf16(Bt[n][k], At[m][k], acc[ai][bj][m][n], 0, 0, 0); __builtin_amdgcn_s_setprio(0); } while (0)
#define PG8_WAIT_V(n) asm volatile("s_waitcnt vmcnt(" #n ")" ::: "memory")
#define PG8_WAIT_L(n) asm volatile("s_waitcnt lgkmcnt(" #n ")" ::: "memory")
#define PG8_BAR __builtin_amdgcn_s_barrier()
#define PG8_SCHED __builtin_amdgcn_sched_barrier(0)
    Unit cur, nxt; int ui = 0;
    if (!S.next(0, cur)) return;
#if MK_STAGGER
    if (S.c & 1) {
        const unsigned long long t0 = __builtin_amdgcn_s_memrealtime(); const unsigned long long dt = (unsigned long long)nt * MK_STAGGER;
        while (__builtin_amdgcn_s_memrealtime() - t0 < dt) __builtin_amdgcn_s_sleep(8);
    }
#endif
    f32x4 acc[2][2][4][2];
#pragma unroll
    for (int a = 0; a < 2; ++a)
#pragma unroll
        for (int b = 0; b < 2; ++b)
#pragma unroll
            for (int m = 0; m < 4; ++m)
#pragma unroll
                for (int n = 0; n < 2; ++n) acc[a][b][m][n] = (f32x4){0.f, 0.f, 0.f, 0.f};
    bf16x8 At[4][2], B0[2][2], B1[2][2];
    const char* cA = (const char*)g.A + (size_t)cur.pm * tstepA; const char* cB = (const char*)g.Bt + (size_t)cur.pn * tstepB;
    PG8_STAGE(PG8_SB(0, 0), cB, voffB); PG8_STAGE(PG8_SB(0, 1), cB + hstepB, voffB); PG8_STAGE(PG8_SA(0, 0), cA, voffA); PG8_STAGE(PG8_SA(0, 1), cA + hstepA, voffA);
    if (wr == 1) PG8_BAR;
    PG8_WAIT_V(2); PG8_BAR;
    PG8_STAGE(PG8_SB(1, 0), cB + kstep, voffB); PG8_STAGE(PG8_SA(1, 0), cA + kstep, voffA); PG8_STAGE(PG8_SB(1, 1), cB + hstepB + kstep, voffB);
    PG8_WAIT_V(6); PG8_BAR;
    for (;;) {
        const bool has_next = S.next(ui + 1, nxt);
        const char* nA = has_next ? (const char*)g.A + (size_t)nxt.pm * tstepA : cA; const char* nB = has_next ? (const char*)g.Bt + (size_t)nxt.pn * tstepB : cB;
        for (int t = 0; t < nt; t += 2) {
            const bool last = (t == nt - 2);
            const char* a1 = cA + (size_t)(t + 1) * kstep;
            const char* a2 = last ? nA : cA + (size_t)(t + 2) * kstep; const char* b2 = last ? nB : cB + (size_t)(t + 2) * kstep;
            const char* a3 = a2 + kstep; const char* b3 = b2 + kstep;
            PG8_LDB(B0, 0, 0); PG8_LDB(B1, 0, 1); PG8_SCHED; PG8_LDA(At, 0, 0); PG8_STAGE(PG8_SA(1, 1), a1 + hstepA, voffA);
            PG8_WAIT_V(8); PG8_WAIT_L(0); PG8_BAR; PG8_MMA(0, 0, At, B0); PG8_MMA(0, 1, At, B1); PG8_BAR; PG8_SCHED;
            PG8_LDA(At, 0, 1); PG8_STAGE(PG8_SB(0, 0), b2, voffB); PG8_STAGE(PG8_SB(0, 1), b2 + hstepB, voffB); PG8_STAGE(PG8_SA(0, 0), a2, voffA);
            PG8_WAIT_V(8); PG8_WAIT_L(0); PG8_BAR; PG8_MMA(1, 0, At, B0); PG8_MMA(1, 1, At, B1); PG8_BAR; PG8_SCHED;
            PG8_LDB(B0, 1, 0); PG8_LDB(B1, 1, 1); PG8_SCHED; PG8_LDA(At, 1, 0); PG8_STAGE(PG8_SA(0, 1), a2 + hstepA, voffA);
            PG8_WAIT_V(8); PG8_WAIT_L(0); PG8_BAR; PG8_MMA(0, 0, At, B0); PG8_MMA(0, 1, At, B1); PG8_BAR; PG8_SCHED;
            PG8_LDA(At, 1, 1); PG8_STAGE(PG8_SB(1, 0), b3, voffB); PG8_STAGE(PG8_SB(1, 1), b3 + hstepB, voffB); PG8_STAGE(PG8_SA(1, 0), a3, voffA);
            PG8_WAIT_V(8); PG8_WAIT_L(0); PG8_BAR; PG8_MMA(1, 0, At, B0); PG8_MMA(1, 1, At, B1); PG8_BAR; PG8_SCHED;
        }
        if (wr == 0) PG8_BAR;
        E(acc, cur, wr, wc, fr, fq);
#if PROBE_EPI2
        if (Epi::PROBE2) E(acc, cur, wr, wc, fr, fq);
#endif
        if (!has_next) break;
#pragma unroll
        for (int a = 0; a < 2; ++a)
#pragma unroll
            for (int b = 0; b < 2; ++b)
#pragma unroll
                for (int m = 0; m < 4; ++m)
#pragma unroll
                    for (int n = 0; n < 2; ++n) acc[a][b][m][n] = (f32x4){0.f, 0.f, 0.f, 0.f};
        cur = nxt; cA = nA; cB = nB; ++ui;
        if (wr == 1) PG8_BAR;
    }
    PG8_WAIT_V(0);
    PG8_BAR;
#undef PG8_SA
#undef PG8_SB
#undef PG8_STAGE
#undef PG8_LDA
#undef PG8_LDB
#undef PG8_MMA
#undef PG8_WAIT_V
#undef PG8_WAIT_L
#undef PG8_BAR
#undef PG8_SCHED
}
}
using pg8::Unit;

__device__ __forceinline__ u32x4 pack8(const f32x4 a, const f32x4 b) { u32x4 w; w.x = cvt_pk_bf16(a[0], a[1]); w.y = cvt_pk_bf16(a[2], a[3]); w.z = cvt_pk_bf16(b[0], b[1]); w.w = cvt_pk_bf16(b[2], b[3]); return w; }
__device__ __forceinline__ f32x4 rot2(const f32x4 v, const f32x4 cs) { f32x4 o; o[0] = v[0] * cs[0] - v[1] * cs[1]; o[1] = v[1] * cs[0] + v[0] * cs[1]; o[2] = v[2] * cs[2] - v[3] * cs[3]; o[3] = v[3] * cs[2] + v[2] * cs[3]; return o; }

__device__ __forceinline__ f32x4 mla_cs(const float* tabm, int t, int c4) {
    const int p0 = c4 >> 1; const int pos = (p0 < 16) ? (t >> 6) : (t & 63); const int f = p0 & 15;
    return *(const f32x4*)(tabm + ((size_t)pos * 16 + f) * 2);
}

struct EpiG1 {
    static constexpr bool PERM = true, PROBE2 = false;
    bf16* QKVL; float* SSQ; bf16* KR; const float* tabm;
    __device__ __forceinline__ void operator()(const f32x4 (&acc)[2][2][4][2], const Unit& u, int wr, int wc, int fr, int fq) const {
        const int row0 = u.pm * 256 + wr * 64 + fr;
        if (u.pn < 4) {
            const int col0 = u.pn * 256 + wc * 32 + 8 * fq;
#pragma unroll
            for (int ai = 0; ai < 2; ++ai)
#pragma unroll
                for (int m = 0; m < 4; ++m) { const int row = row0 + ai * 128 + m * 16; float ss = 0.f;
#pragma unroll
                    for (int bj = 0; bj < 2; ++bj) { const f32x4 v0 = acc[ai][bj][m][0], v1 = acc[ai][bj][m][1];
                        ss += (v0[0] * v0[0] + v0[1] * v0[1]) + (v0[2] * v0[2] + v0[3] * v0[3]) + (v1[0] * v1[0] + v1[1] * v1[1]) + (v1[2] * v1[2] + v1[3] * v1[3]);
                        *(u32x4*)(QKVL + (size_t)row * N1 + col0 + bj * 128) = pack8(v0, v1); }
                    { const int ln_ = fr + 16 * fq; ss += shfl_xor_l(ss, 16, ln_); ss += shfl_xor_l(ss, 32, ln_); }
                    if (fq == 0) SSQ[(size_t)row * 16 + u.pn * 4 + wc] = ss; asm volatile("" ::: "memory"); }
        } else if (wc < 2) {
            const int c8 = wc * 32 + 8 * fq;
#pragma unroll
            for (int ai = 0; ai < 2; ++ai)
#pragma unroll
                for (int m = 0; m < 4; ++m) { const int row = row0 + ai * 128 + m * 16; f32x4 v0 = acc[ai][0][m][0], v1 = acc[ai][0][m][1];
                    if (row < MX) { const int t = row & (SEQ - 1); v0 = rot2(v0, mla_cs(tabm, t, c8)); v1 = rot2(v1, mla_cs(tabm, t, c8 + 4)); }
                    *(u32x4*)(KR + (size_t)row * 64 + c8) = pack8(v0, v1); asm volatile("" ::: "memory"); }
        }
    }
};
struct EpiUq {
    static constexpr bool PERM = true, PROBE2 = false;
    bf16* Q; const float* SSQ; const float* tabm;
    __device__ __forceinline__ void operator()(const f32x4 (&acc)[2][2][4][2], const Unit& u, int wr, int wc, int fr, int fq) const {
        const int row0 = u.pm * 256 + wr * 64 + fr;
        int col8[2], dd[2];
#pragma unroll
        for (int bj = 0; bj < 2; ++bj) { col8[bj] = u.pn * 256 + bj * 128 + wc * 32 + 8 * fq; dd[bj] = col8[bj] % DQ; }
#pragma unroll
        for (int ai = 0; ai < 2; ++ai)
#pragma unroll
            for (int m = 0; m < 4; ++m) { const int row = row0 + ai * 128 + m * 16;
                const f32x4 s0 = *(const f32x4*)(SSQ + (size_t)row * 16), s1 = *(const f32x4*)(SSQ + (size_t)row * 16 + 4);
                const float ss = ((s0[0] + s0[1]) + (s0[2] + s0[3])) + ((s1[0] + s1[1]) + (s1[2] + s1[3]));
                const float r = 1.0f / sqrtf(ss * (1.0f / QR) + NORM_EPS);
#pragma unroll
                for (int bj = 0; bj < 2; ++bj) { f32x4 v0 = acc[ai][bj][m][0] * r, v1 = acc[ai][bj][m][1] * r;
                    if (dd[bj] >= NOPE && row < MX) { const int t = row & (SEQ - 1), c8 = dd[bj] - NOPE; v0 = rot2(v0, mla_cs(tabm, t, c8)); v1 = rot2(v1, mla_cs(tabm, t, c8 + 4)); }
                    *(u32x4*)(Q + (size_t)row * 3072 + col8[bj]) = pack8(v0, v1); } asm volatile("" ::: "memory"); }
    }
};
struct EpiUkv {
    static constexpr bool PERM = true, PROBE2 = false;
    bf16* KV; const float* SSQ;
    __device__ __forceinline__ void operator()(const f32x4 (&acc)[2][2][4][2], const Unit& u, int wr, int wc, int fr, int fq) const {
        const int row0 = u.pm * 256 + wr * 64 + fr; const int col0 = u.pn * 256 + wc * 32 + 8 * fq;
#pragma unroll
        for (int ai = 0; ai < 2; ++ai)
#pragma unroll
            for (int m = 0; m < 4; ++m) { const int row = row0 + ai * 128 + m * 16;
                const f32x4 s0 = *(const f32x4*)(SSQ + (size_t)row * 16 + 8), s1 = *(const f32x4*)(SSQ + (size_t)row * 16 + 12);
                const float ss = ((s0[0] + s0[1]) + (s0[2] + s0[3])) + ((s1[0] + s1[1]) + (s1[2] + s1[3]));
                const float r = 1.0f / sqrtf(ss * (1.0f / KVR) + NORM_EPS);
#pragma unroll
                for (int bj = 0; bj < 2; ++bj) *(u32x4*)(KV + (size_t)row * 4096 + col0 + bj * 128) = pack8(acc[ai][bj][m][0] * r, acc[ai][bj][m][1] * r); asm volatile("" ::: "memory"); }
    }
};
struct EpiResid {
    static constexpr bool PERM = false, PROBE2 = false;
    const float* xin; float* xout; const float* cin; float* cout; const float* modv; int gofs;
    __device__ __forceinline__ void operator()(const f32x4 (&acc)[2][2][4][2], const Unit& u, int wr, int wc, int fr, int fq) const {
        const bool isx = u.pm < (MX / 256);
        const int rloc = (isx ? u.pm * 256 : (u.pm * 256 - MX)) + wr * 64 + fr;
        const float* base = isx ? xin : cin; float* out = isx ? xout : cout;
        const float* gv = modv + (size_t)(isx ? (u.pm >> 4) : 8) * NMOD + gofs;
        const int col0 = u.pn * 256 + wc * 32 + 4 * fq;
        f32x4 g4[2][2];
#pragma unroll
        for (int bj = 0; bj < 2; ++bj)
#pragma unroll
            for (int n = 0; n < 2; ++n) g4[bj][n] = *(const f32x4*)(gv + col0 + bj * 128 + n * 16);
#pragma unroll
        for (int ai = 0; ai < 2; ++ai)
#pragma unroll
            for (int m = 0; m < 4; ++m) { const size_t off = (size_t)(rloc + ai * 128 + m * 16) * D + col0;
#pragma unroll
                for (int bj = 0; bj < 2; ++bj)
#pragma unroll
                    for (int n = 0; n < 2; ++n) { const f32x4 b = *(const f32x4*)(base + off + bj * 128 + n * 16); *(f32x4*)(out + off + bj * 128 + n * 16) = b + g4[bj][n] * acc[ai][bj][m][n]; }
                if (m & 1) asm volatile("" ::: "memory"); }
    }
};
template <int CTRL> __device__ __forceinline__ float dpp1(float x) { return __int_as_float(__builtin_amdgcn_update_dpp(0, __float_as_int(x), CTRL, 0xF, 0xF, false)); }
__device__ __forceinline__ f32x4 row_prev(const f32x4 v) { f32x4 o; o.x = dpp1<0x121>(v.x); o.y = dpp1<0x121>(v.y); o.z = dpp1<0x121>(v.z); o.w = dpp1<0x121>(v.w); return o; }
__device__ __forceinline__ f32x4 row_next(const f32x4 v) { f32x4 o; o.x = dpp1<0x12F>(v.x); o.y = dpp1<0x12F>(v.y); o.z = dpp1<0x12F>(v.z); o.w = dpp1<0x12F>(v.w); return o; }
__device__ __forceinline__ f32x4 silu4(const f32x4 v) { f32x4 o;
#pragma unroll
    for (int e = 0; e < 4; ++e) o[e] = fast_silu(v[e]); return o; }
constexpr size_t HALO_STRIDE = (size_t)FF;
struct EpiGUConv {
    static constexpr bool PERM = true, PROBE2 = true;
    bf16* ACT; float* HALO; const float* cw; const float* cb; LAS float* edge;
    __device__ __forceinline__ void operator()(const f32x4 (&acc)[2][2][4][2], const Unit& u, int wr, int wc, int fr, int fq) const {
        const int c8 = wc * 32 + 8 * fq; const int f0 = u.pn * 128 + c8;
#pragma unroll
        for (int ai = 0; ai < 2; ++ai) { const int blk = 2 * ai + wr;
            if (fr == 0)  { *(LAS f32x4*)(edge + (blk * 2 + 0) * 128 + c8) = acc[ai][0][0][0]; *(LAS f32x4*)(edge + (blk * 2 + 0) * 128 + c8 + 4) = acc[ai][0][0][1]; }
            if (fr == 15) { *(LAS f32x4*)(edge + (blk * 2 + 1) * 128 + c8) = acc[ai][0][3][0]; *(LAS f32x4*)(edge + (blk * 2 + 1) * 128 + c8 + 4) = acc[ai][0][3][1]; } }
        asm volatile("s_waitcnt lgkmcnt(0)" ::: "memory"); __builtin_amdgcn_s_barrier(); asm volatile("" ::: "memory");
        f32x4 w0[2], w1[2], w2[2], bb[2];
#pragma unroll
        for (int n = 0; n < 2; ++n) { w0[n] = *(const f32x4*)(cw + f0 + 4 * n); w1[n] = *(const f32x4*)(cw + FF + f0 + 4 * n); w2[n] = *(const f32x4*)(cw + 2 * FF + f0 + 4 * n); bb[n] = *(const f32x4*)(cb + f0 + 4 * n); }
        const f32x4 zero4 = {0.f, 0.f, 0.f, 0.f};
#pragma unroll
        for (int ai = 0; ai < 2; ++ai) { const int blk = 2 * ai + wr;
#pragma unroll
            for (int m = 0; m < 4; ++m) { const int row = u.pm * 256 + ai * 128 + wr * 64 + m * 16 + fr; f32x4 o[2];
#pragma unroll
                for (int n = 0; n < 2; ++n) { const f32x4 cur = acc[ai][0][m][n];
                    f32x4 b, d;
                    if (m > 0) b = row_prev(acc[ai][0][m - 1][n]); else b = (blk > 0) ? *(const LAS f32x4*)(edge + ((blk - 1) * 2 + 1) * 128 + c8 + 4 * n) : zero4;
                    if (m < 3) d = row_next(acc[ai][0][m + 1][n]); else d = (blk < 3) ? *(const LAS f32x4*)(edge + ((blk + 1) * 2 + 0) * 128 + c8 + 4 * n) : zero4;
                    const f32x4 a = row_prev(cur), c = row_next(cur);
                    const f32x4 up = (fr == 0) ? b : a, dn = (fr == 15) ? d : c;
                    const f32x4 cv = w0[n] * up + w1[n] * cur + w2[n] * dn + bb[n]; const f32x4 uu = acc[ai][1][m][n];
                    o[n] = silu4(cv) * uu;
                    if (m == 0 && blk == 0 && fr == 0) { float* hp = HALO + (size_t)((u.pm * 2 + 0) * 3) * HALO_STRIDE + f0 + 4 * n; *(f32x4*)hp = cv; *(f32x4*)(hp + HALO_STRIDE) = cur; *(f32x4*)(hp + 2 * HALO_STRIDE) = uu; }
                    if (m == 3 && blk == 3 && fr == 15) { float* hp = HALO + (size_t)((u.pm * 2 + 1) * 3) * HALO_STRIDE + f0 + 4 * n; *(f32x4*)hp = cv; *(f32x4*)(hp + HALO_STRIDE) = cur; *(f32x4*)(hp + 2 * HALO_STRIDE) = uu; } }
                *(u32x4*)(ACT + (size_t)row * FF + f0) = pack8(o[0], o[1]); asm volatile("" ::: "memory"); } }
        asm volatile("s_waitcnt lgkmcnt(0)" ::: "memory"); __builtin_amdgcn_s_barrier(); asm volatile("" ::: "memory");
    }
};
struct EpiQKV {
    static constexpr bool PERM = true, PROBE2 = false;
    bf16* QKV; const float* tabr;
    __device__ __forceinline__ void operator()(const f32x4 (&acc)[2][2][4][2], const Unit& u, int wr, int wc, int fr, int fq) const {
        const int row0 = u.pm * 256 + wr * 64 + fr; const int col0 = u.pn * 256 + wc * 32 + 8 * fq;
        const bool rope = (u.pn < 16) && (u.pm < MX / 256);
#pragma unroll
        for (int ai = 0; ai < 2; ++ai)
#pragma unroll
            for (int m = 0; m < 4; ++m) { const int row = row0 + ai * 128 + m * 16;
#pragma unroll
                for (int bj = 0; bj < 2; ++bj) { f32x4 v0 = acc[ai][bj][m][0], v1 = acc[ai][bj][m][1]; const int col = col0 + bj * 128;
                    if (rope) { const int t = row & (SEQ - 1); const float* tp = tabr + ((size_t)t * 128 + ((col & 255) >> 1)) * 2;
                        v0 = rot2(v0, *(const f32x4*)tp); v1 = rot2(v1, *(const f32x4*)(tp + 4)); }
                    *(u32x4*)(QKV + (size_t)row * 8192 + col) = pack8(v0, v1); } asm volatile("" ::: "memory"); }
    }
};
struct EpiGate {
    static constexpr bool PERM = true, PROBE2 = false;
    bf16* GATED; const bf16* YF; const bf16* YB; const float* ST;
    __device__ __forceinline__ void operator()(const f32x4 (&acc)[2][2][4][2], const Unit& u, int wr, int wc, int fr, int fq) const {
        const int row0 = u.pm * 256 + wr * 64 + fr; const int f0 = u.pn * 128 + wc * 32 + 8 * fq; const int hd = u.pn >> 2;
#pragma unroll
        for (int ai = 0; ai < 2; ++ai)
#pragma unroll
            for (int m = 0; m < 4; ++m) { const int row = row0 + ai * 128 + m * 16; const size_t off = (size_t)row * 4096 + f0;
                const u32x4 yf = *(const u32x4*)(YF + off), yb = *(const u32x4*)(YB + off);
                const f32x2 sf = *(const f32x2*)(ST + ((size_t)row * 8 + hd) * 2), sb = *(const f32x2*)(ST + ((size_t)(MT + row) * 8 + hd) * 2);
                const f32x4 a0 = acc[ai][0][m][0], a1 = acc[ai][0][m][1], b0 = acc[ai][1][m][0], b1 = acc[ai][1][m][1];
#define NF(w, hi_) (((hi_ ? bfhi(w) : bflo(w)) - sf[0]) * sf[1])
#define NB(w, hi_) (((hi_ ? bfhi(w) : bflo(w)) - sb[0]) * sb[1])
                f32x4 o0, o1;
                o0[0] = fast_silu(a0[0]) * NF(yf.x, 0) + fast_silu(b0[0]) * NB(yb.x, 0); o0[1] = fast_silu(a0[1]) * NF(yf.x, 1) + fast_silu(b0[1]) * NB(yb.x, 1);
                o0[2] = fast_silu(a0[2]) * NF(yf.y, 0) + fast_silu(b0[2]) * NB(yb.y, 0); o0[3] = fast_silu(a0[3]) * NF(yf.y, 1) + fast_silu(b0[3]) * NB(yb.y, 1);
                o1[0] = fast_silu(a1[0]) * NF(yf.z, 0) + fast_silu(b1[0]) * NB(yb.z, 0); o1[1] = fast_silu(a1[1]) * NF(yf.z, 1) + fast_silu(b1[1]) * NB(yb.z, 1);
                o1[2] = fast_silu(a1[2]) * NF(yf.w, 0) + fast_silu(b1[2]) * NB(yb.w, 0); o1[3] = fast_silu(a1[3]) * NF(yf.w, 1) + fast_silu(b1[3]) * NB(yb.w, 1);
#undef NF
#undef NB
                *(u32x4*)(GATED + off) = pack8(o0, o1); asm volatile("" ::: "memory"); }
    }
};

namespace att {
constexpr int NW = 8, QBLK = 32, KVBLK = 64;
constexpr int SHM_V = 16384, SHM_KN = 16384, SHM_KR = 8192;
constexpr int OFF_V = 0, OFF_KN = 3 * SHM_V, OFF_KR = OFF_KN + 2 * SHM_KN, OFF_WS = OFF_KR + 2 * SHM_KR, SHM_ATTN = OFF_WS + NW * 64 * 4;
constexpr float THR2 = 11.5f;
#define KSWZ(row, colB) ((row) * 256 + ((colB) ^ (((row) & 7) << 4)))
#define KRSWZ(row, colB) ((row) * 128 + ((colB) ^ ((((row) >> 1) & 7) << 4)))
#define SBAR() __builtin_amdgcn_sched_barrier(0)
__device__ __forceinline__ int crow(int r, int hi) { return (r & 3) + 8 * (r >> 2) + 4 * hi; }
__device__ __forceinline__ void partialSM(f32x16& p0, f32x16& p1, float& m_reg, float& alpha) {
  float pmax = p0[0];
#pragma unroll
  for (int r = 1; r < 16; ++r) pmax = fmaxf(pmax, p0[r]);
#pragma unroll
  for (int r = 0; r < 16; ++r) pmax = fmaxf(pmax, p1[r]);
  { auto rr = __builtin_amdgcn_permlane32_swap(__float_as_uint(pmax), __float_as_uint(pmax), false, false); pmax = fmaxf(__uint_as_float(rr[0]), __uint_as_float(rr[1])); }
  float mn;
  if (__builtin_expect(__all(pmax - m_reg <= THR2), 1)) { mn = m_reg; alpha = 1.f; }
  else { mn = fmaxf(m_reg, pmax); alpha = __builtin_amdgcn_exp2f(m_reg - mn); m_reg = mn; }
#pragma unroll
  for (int r = 0; r < 16; ++r) p0[r] = p0[r] - mn;
#pragma unroll
  for (int r = 0; r < 16; ++r) p1[r] = p1[r] - mn;
#pragma unroll
  for (int r = 0; r < 16; ++r) p0[r] = __builtin_amdgcn_exp2f(p0[r]);
}
__device__ __forceinline__ void finishSM(f32x16& p0, f32x16& p1, float alpha, float& l_reg, bf16x8& pa0, bf16x8& pa1, bf16x8& pa2, bf16x8& pa3) {
#pragma unroll
  for (int r = 0; r < 16; ++r) p1[r] = __builtin_amdgcn_exp2f(p1[r]);
  float ps = 0;
#pragma unroll
  for (int r = 0; r < 16; ++r) ps += p0[r];
#pragma unroll
  for (int r = 0; r < 16; ++r) ps += p1[r];
  { auto rr = __builtin_amdgcn_permlane32_swap(__float_as_uint(ps), __float_as_uint(ps), false, false); ps = __uint_as_float(rr[0]) + __uint_as_float(rr[1]); }
  l_reg = l_reg * alpha + ps;
#define PK4(P, BASE, OUT) do { unsigned a0 = cvt_pk_bf16(P[BASE + 0], P[BASE + 1]), a1 = cvt_pk_bf16(P[BASE + 2], P[BASE + 3]);   \
    unsigned b0 = cvt_pk_bf16(P[BASE + 4], P[BASE + 5]), b1 = cvt_pk_bf16(P[BASE + 6], P[BASE + 7]);                              \
    auto r0 = __builtin_amdgcn_permlane32_swap(a0, b0, false, false); auto r1 = __builtin_amdgcn_permlane32_swap(a1, b1, false, false); \
    u32x4 w = {r0[0], r1[0], r0[1], r1[1]}; OUT = __builtin_bit_cast(bf16x8, w); } while (0)
  PK4(p0, 0, pa0); PK4(p0, 8, pa1); PK4(p1, 0, pa2); PK4(p1, 8, pa3);
#undef PK4
}
__device__ __forceinline__ void qkt(f32x16& p0, f32x16& p1, const char* Kn, const char* Kr, const bf16x8* qr, int r32, int hi) {
  p0 = f32x16{}; p1 = f32x16{};
#pragma unroll
  for (int d0 = 0; d0 < 8; ++d0) { const int cb = (d0 * 16 + hi * 8) * 2;
    const bf16x8 b0 = *reinterpret_cast<const bf16x8*>(Kn + KSWZ(r32, cb));
    const bf16x8 b1 = *reinterpret_cast<const bf16x8*>(Kn + KSWZ(32 + r32, cb));
    p0 = __builtin_amdgcn_mfma_f32_32x32x16_bf16(b0, qr[d0], p0, 0, 0, 0);
    p1 = __builtin_amdgcn_mfma_f32_32x32x16_bf16(b1, qr[d0], p1, 0, 0, 0); }
#pragma unroll
  for (int d0 = 0; d0 < 4; ++d0) { const int cb = (d0 * 16 + hi * 8) * 2;
    const bf16x8 b0 = *reinterpret_cast<const bf16x8*>(Kr + KRSWZ(r32, cb));
    const bf16x8 b1 = *reinterpret_cast<const bf16x8*>(Kr + KRSWZ(32 + r32, cb));
    p0 = __builtin_amdgcn_mfma_f32_32x32x16_bf16(b0, qr[8 + d0], p0, 0, 0, 0);
    p1 = __builtin_amdgcn_mfma_f32_32x32x16_bf16(b1, qr[8 + d0], p1, 0, 0, 0); }
}
__device__ __forceinline__ int v_st(int k, int c) { const int kk = (k & ~0xC) | ((k & 4) << 1) | ((k & 8) >> 1); return ((kk >> 3) * 4 + (c >> 5)) * 512 + ((kk & 7) * 32 + (c & 31)) * 2; }
__device__ __forceinline__ int v_rd_base(int lane) { return ((lane & 3) << 3) | (((lane >> 2) & 3) << 6) | (((lane >> 4) & 1) << 5) | (((lane >> 5) & 1) << 8); }
constexpr int v_rd_off(int d0, int ks, int half) { return d0 * 512 + ks * 4096 + half * 2048; }
template <int OFF> __device__ __forceinline__ s16x4 tr_read(int vb) { s16x4 r; asm volatile("ds_read_b64_tr_b16 %0, %1 offset:%2" : "=&v"(r) : "v"(vb), "i"(OFF) : "memory"); return r; }
template <int D0> __device__ __forceinline__ void pv_one(f32x16& od, int vb, bf16x8 pa0, bf16x8 pa1, bf16x8 pa2, bf16x8 pa3) {
  const s16x4 l0 = tr_read<v_rd_off(D0, 0, 0)>(vb), h0 = tr_read<v_rd_off(D0, 0, 1)>(vb), l1 = tr_read<v_rd_off(D0, 1, 0)>(vb), h1 = tr_read<v_rd_off(D0, 1, 1)>(vb);
  const s16x4 l2 = tr_read<v_rd_off(D0, 2, 0)>(vb), h2 = tr_read<v_rd_off(D0, 2, 1)>(vb), l3 = tr_read<v_rd_off(D0, 3, 0)>(vb), h3 = tr_read<v_rd_off(D0, 3, 1)>(vb);
  asm volatile("s_waitcnt lgkmcnt(0)" ::: "memory"); SBAR();
#define PK(L, H) (bf16x8){L[0], L[1], L[2], L[3], H[0], H[1], H[2], H[3]}
  od = __builtin_amdgcn_mfma_f32_32x32x16_bf16(pa0, PK(l0, h0), od, 0, 0, 0);
  od = __builtin_amdgcn_mfma_f32_32x32x16_bf16(pa1, PK(l1, h1), od, 0, 0, 0);
  od = __builtin_amdgcn_mfma_f32_32x32x16_bf16(pa2, PK(l2, h2), od, 0, 0, 0);
  od = __builtin_amdgcn_mfma_f32_32x32x16_bf16(pa3, PK(l3, h3), od, 0, 0, 0);
#undef PK
}
__device__ __forceinline__ void pv_d0(f32x16* o, int vb, bf16x8 pa0, bf16x8 pa1, bf16x8 pa2, bf16x8 pa3) {
  pv_one<0>(o[0], vb, pa0, pa1, pa2, pa3); pv_one<1>(o[1], vb, pa0, pa1, pa2, pa3); pv_one<2>(o[2], vb, pa0, pa1, pa2, pa3); pv_one<3>(o[3], vb, pa0, pa1, pa2, pa3);
}
__device__ __forceinline__ void attn_unit(const bf16* __restrict__ Qb, const bf16* __restrict__ KVh, const bf16* __restrict__ KRp, bf16* __restrict__ Ob,
                                          int NT, int nc, int cbase, int xbase, char* lds) {
  int tid = threadIdx.x; asm volatile("" : "+v"(tid));
  const int wid = __builtin_amdgcn_readfirstlane(tid >> 6), lane = tid & 63, r32 = lane & 31, hi = lane >> 5;
  char* V_lds = lds + OFF_V; char* Kn_lds = lds + OFF_KN; char* Kr_lds = lds + OFF_KR;
  float* ws = (float*)(lds + OFF_WS) + wid * 64; float* li_l = ws; float* al_l = ws + 32;
  float m_reg = -1e30f, l_reg = 0; f32x16 o[4] = {}; bf16x8 qr[12];
  const bf16* Qw = Qb + (long)(wid * QBLK + r32) * 3072 + hi * 8;
#pragma unroll
  for (int d0 = 0; d0 < 12; ++d0) qr[d0] = *reinterpret_cast<const bf16x8*>(Qw + d0 * 16);
  const int vb0 = (int)(uintptr_t)V_lds + v_rd_base(lane);
  unsigned vofK[2], vofV[2], vofR;
#pragma unroll
  for (int i = 0; i < 2; ++i) { const int pc = wid * 2 + i;
      { const int row = pc * 4 + (lane >> 4), ch = (lane & 15) ^ (row & 7); vofK[i] = (unsigned)((row * 4096 + ch * 8) * 2); }
      { const int ob = pc * 1024 + lane * 16, st = ob >> 9, w = ob & 511, kk = (st >> 2) * 8 + (w >> 6); const int k = (kk & ~0xC) | ((kk & 4) << 1) | ((kk & 8) >> 1);
        const int c = (st & 3) * 32 + 8 * ((w & 63) >> 4); vofV[i] = (unsigned)((k * 4096 + 128 + c) * 2); } }
  { const int row = wid * 8 + (lane >> 3), ch = (lane & 7) ^ ((row >> 1) & 7); vofR = (unsigned)((row * 64 + ch * 8) * 2); }
  const unsigned ldsK = (unsigned)__builtin_amdgcn_readfirstlane((unsigned)(uintptr_t)Kn_lds + (unsigned)wid * 2048u);
  const unsigned ldsV = (unsigned)__builtin_amdgcn_readfirstlane((unsigned)(uintptr_t)V_lds + (unsigned)wid * 2048u);
  const unsigned ldsR = (unsigned)__builtin_amdgcn_readfirstlane((unsigned)(uintptr_t)Kr_lds + (unsigned)wid * 1024u);
#define KROW(j) ((j) < nc ? cbase + (j) * KVBLK : xbase + ((j) - nc) * KVBLK)
#define DMA_TILE(j, kslot, vslot) do { const long k0_ = KROW(j); const char* kb_ = uni_ptr(KVh + k0_ * 4096); const char* rb_ = uni_ptr(KRp + k0_ * 64); \
    glds16_s(kb_, vofK[0], ldsK + (kslot) * SHM_KN); glds16_s(kb_, vofK[1], ldsK + (kslot) * SHM_KN + 1024u); \
    glds16_s(rb_, vofR, ldsR + (kslot) * SHM_KR); \
    glds16_s(kb_, vofV[0], ldsV + (vslot) * SHM_V); glds16_s(kb_, vofV[1], ldsV + (vslot) * SHM_V + 1024u); } while (0)
#define WAIT_SYNC() do { asm volatile("s_waitcnt vmcnt(0)" ::: "memory"); __syncthreads(); } while (0)
#define RESC(a) do { if (__any((a) < 1.f)) { if (hi == 0) al_l[r32] = (a); asm volatile("s_waitcnt lgkmcnt(0)" ::: "memory"); \
    _Pragma("unroll") for (int d = 0; d < 4; ++d) _Pragma("unroll") for (int r = 0; r < 16; ++r) o[d][r] *= al_l[crow(r, hi)]; } } while (0)
  f32x16 pA0, pA1, pB0, pB1; float alA, alB; bf16x8 pa0, pa1, pa2, pa3;
  DMA_TILE(0, 0, 0); DMA_TILE(1, 1, 1); WAIT_SYNC();
  qkt(pA0, pA1, Kn_lds, Kr_lds, qr, r32, hi); partialSM(pA0, pA1, m_reg, alA);
  __syncthreads();
  int vprev = 0, vcur = 1, vnext = 2;
  for (int j = 1; j + 1 < NT; j += 2) {
    DMA_TILE(j + 1, 0, vnext);
    SBAR(); qkt(pB0, pB1, Kn_lds + SHM_KN, Kr_lds + SHM_KR, qr, r32, hi);
    finishSM(pA0, pA1, alA, l_reg, pa0, pa1, pa2, pa3); SBAR();
    pv_d0(o, vb0 + vprev * SHM_V, pa0, pa1, pa2, pa3); partialSM(pB0, pB1, m_reg, alB);
    RESC(alB); WAIT_SYNC();
    { const int t_ = vprev; vprev = vcur; vcur = vnext; vnext = t_; }
    if (j + 2 < NT) DMA_TILE(j + 2, 1, vnext);
    SBAR(); qkt(pA0, pA1, Kn_lds, Kr_lds, qr, r32, hi);
    finishSM(pB0, pB1, alB, l_reg, pa0, pa1, pa2, pa3); SBAR();
    pv_d0(o, vb0 + vprev * SHM_V, pa0, pa1, pa2, pa3); partialSM(pA0, pA1, m_reg, alA);
    RESC(alA); WAIT_SYNC();
    { const int t_ = vprev; vprev = vcur; vcur = vnext; vnext = t_; }
  }
  SBAR(); qkt(pB0, pB1, Kn_lds + SHM_KN, Kr_lds + SHM_KR, qr, r32, hi);
  finishSM(pA0, pA1, alA, l_reg, pa0, pa1, pa2, pa3); SBAR();
  pv_d0(o, vb0 + vprev * SHM_V, pa0, pa1, pa2, pa3); partialSM(pB0, pB1, m_reg, alB);
  RESC(alB);
  finishSM(pB0, pB1, alB, l_reg, pa0, pa1, pa2, pa3); SBAR();
  pv_d0(o, vb0 + vcur * SHM_V, pa0, pa1, pa2, pa3);
  if (hi == 0) li_l[r32] = l_reg; asm volatile("s_waitcnt lgkmcnt(0)" ::: "memory");
  float rli[16];
#pragma unroll
  for (int r = 0; r < 16; ++r) rli[r] = __builtin_amdgcn_rcpf(li_l[crow(r, hi)]);
  bf16* Ow = Ob + (long)(wid * QBLK) * 2048;
#pragma unroll
  for (int r = 0; r < 16; ++r) { const int orow = crow(r, hi);
#pragma unroll
    for (int d0 = 0; d0 < 4; ++d0) Ow[(long)orow * 2048 + d0 * 32 + r32] = (bf16)(cvt_pk_bf16(o[d0][r] * rli[r], 0.f) & 0xffffu); }
  __syncthreads();
#undef KROW
#undef DMA_TILE
#undef WAIT_SYNC
#undef RESC
}
#undef SBAR
}

namespace scan {
constexpr int CH = 64;
constexpr int OFF_Q = 0, OFF_K = 32768  , OFF_V = 98304, OFF_P = 131072, SHM_SCAN = 131072 + 8192;
__device__ __forceinline__ unsigned off_b(unsigned row, unsigned ch) { return 256u * row + 16u * (ch ^ (((row & 3) << 2) | ((row >> 2) & 3))); }
__device__ __forceinline__ unsigned p_off(unsigned i, unsigned chunk) { return 128u * i + 16u * (chunk ^ ((i >> 1) & 7)); }
__device__ __forceinline__ int crow(int r, int hi) { return (r & 3) + 8 * (r >> 2) + 4 * hi; }
__device__ __forceinline__ s16x4 vtr(const LAS char* p) { typedef short v4i16_t __attribute__((ext_vector_type(4))); return __builtin_bit_cast(s16x4, __builtin_amdgcn_ds_read_tr16_b64_v4i16((LAS v4i16_t*)p)); }
__device__ __forceinline__ bf16x8 tr_frag(const LAS char* img, int lane, int c, int ks) {
    const unsigned h = lane >> 5, blk = (lane >> 4) & 1, q = (lane & 15) >> 2, p = lane & 3;
    const unsigned r0 = 16 * ks + 8 * h + q, chn = 4 * c + 2 * blk + (p >> 1);
    const s16x4 lo = vtr(img + off_b(r0, chn) + 8 * (p & 1)), hi = vtr(img + off_b(r0 + 4, chn) + 8 * (p & 1));
    return (bf16x8){lo[0], lo[1], lo[2], lo[3], hi[0], hi[1], hi[2], hi[3]};
}
__device__ __forceinline__ bf16x8 pack_step(const f32x16& x, int s) {
    u32x4 p; p.x = cvt_pk_bf16(x[8 * s + 0], x[8 * s + 1]); p.y = cvt_pk_bf16(x[8 * s + 2], x[8 * s + 3]); p.z = cvt_pk_bf16(x[8 * s + 4], x[8 * s + 5]); p.w = cvt_pk_bf16(x[8 * s + 6], x[8 * s + 7]);
    return __builtin_bit_cast(bf16x8, p);
}
__device__ __forceinline__ void dma_mat(const bf16* src, int ld, LAS unsigned char* dst, int wid, int lane) {
    const char* sb = uni_ptr(src); const unsigned d0 = (unsigned)__builtin_amdgcn_readfirstlane((unsigned)(uintptr_t)dst + (unsigned)wid * 4096u);
#pragma unroll
    for (int k = 0; k < 4; ++k) { const int pc = wid * 4 + k, img = pc >> 4, row = 4 * (pc & 15) + (lane >> 4), pos = lane & 15;
        const int ch = pos ^ (((row & 3) << 2) | ((row >> 2) & 3));
        glds16_s(sb, (unsigned)((row * ld + img * 128 + ch * 8) * 2), d0 + (unsigned)k * 1024u); }
}
__device__ __forceinline__ int scan_rowbase(int n, int b, int dir) { return (n < 4) ? MX + b * CTXL + (dir ? 3 - n : n) * CH : b * SEQ + (dir ? 67 - n : n - 4) * CH; }
__device__ __forceinline__ float uni_f(float x) { return __uint_as_float(__builtin_amdgcn_readfirstlane(__float_as_uint(x))); }
typedef const LAS s16x4* lds_s4p;
__device__ __forceinline__ void scan_unit(const bf16* __restrict__ QKV, bf16* __restrict__ Y, int b, int hd, int dir, int dvh, float lg2, bool skip_ctx_y, LAS unsigned char* lds) {
    int tid = threadIdx.x; asm volatile("" : "+v"(tid));
    const int wid = __builtin_amdgcn_readfirstlane(tid >> 6), lane0 = tid & 63;
    const LAS char* QI = (const LAS char*)lds + OFF_Q; const LAS char* VI = (const LAS char*)lds + OFF_V;
    LAS char* PI = (LAS char*)lds + OFF_P;
    f32x16 S[8];
#pragma unroll
    for (int i = 0; i < 8; ++i) S[i] = f32x16{};
    const float lgr = dir ? -lg2 : lg2;
    const float g64 = uni_f(__builtin_amdgcn_exp2f(64.f * lg2));
    const float R1 = uni_f(__builtin_amdgcn_exp2f(lgr)), R8 = uni_f(__builtin_amdgcn_exp2f(8.f * lgr)), R32 = uni_f(__builtin_amdgcn_exp2f(32.f * lgr));
    const float Rm1 = uni_f(__builtin_amdgcn_exp2f(-lgr)), Rm16 = uni_f(__builtin_amdgcn_exp2f(-16.f * lgr));
    const float c0 = uni_f(dir ? g64 : __builtin_amdgcn_exp2f(lg2)), z0 = uni_f(dir ? 1.0f : __builtin_amdgcn_exp2f(63.f * lg2));
    const int qcol = hd * RDK, kcol = 2048 + hd * RDK, vcol = 4096 + hd * RDV + dvh * 256;
    { const bf16* src = QKV + (size_t)scan_rowbase(0, b, dir) * 8192;
      dma_mat(src + qcol, 8192, lds + OFF_Q, wid, lane0); dma_mat(src + kcol, 8192, lds + OFF_K, wid, lane0); dma_mat(src + vcol, 8192, lds + OFF_V, wid, lane0);
      asm volatile("s_waitcnt vmcnt(0)" ::: "memory"); __syncthreads(); }
    for (int n = 0; n < 68; ++n) {
        int lane = lane0; asm volatile("" : "+v"(lane));
        const int r = lane & 31, h = lane >> 5, fr = lane & 15, fq = lane >> 4;
        const int rowbase = scan_rowbase(n, b, dir);
        const bool more = n + 1 < 68;
        const bf16* nsrc = QKV + (size_t)scan_rowbase(more ? n + 1 : n, b, dir) * 8192;
        const LAS char* KI = (const LAS char*)lds + OFF_K + (n & 1) * 32768;
        if (more) dma_mat(nsrc + kcol, 8192, lds + OFF_K + ((n + 1) & 1) * 32768, wid, lane);
        const float LR = c0 * __builtin_amdgcn_exp2f((float)(4 * h) * lgr), LZ = z0 * __builtin_amdgcn_exp2f((float)(-8 * h) * lgr), LP = __builtin_amdgcn_exp2f((float)(fr - 4 * fq) * lgr);
        { const int fH = fr & 3, fL = (fr >> 2) & 3; const int AL = 256 * fr + 16 * (fq ^ fL);
          int AH[4];
#pragma unroll
          for (int k = 0; k < 4; ++k) AH[k] = 64 * (k ^ fH);
#pragma unroll
          for (int tix = 0; tix < 2; ++tix) { const int tt = wid * 2 + tix, jt = tt >> 2, it = tt & 3;
            f32x4 pt = {0.f, 0.f, 0.f, 0.f};
            const bool live = dir ? (jt >= it) : (jt <= it);
            if (live) { const LAS char* ka = KI + 4096 * jt + AL; const LAS char* qa = QI + 4096 * it + AL;
#pragma unroll
                for (int ks = 0; ks < 8; ++ks) { const int o = (ks >> 2) * 16384 + AH[ks & 3];
                    pt = __builtin_amdgcn_mfma_f32_16x16x32_bf16(*(const LAS bf16x8*)(ka + o), *(const LAS bf16x8*)(qa + o), pt, 0, 0, 0); } }
            float we = LP * __builtin_amdgcn_exp2f((float)(16 * (it - jt)) * lgr); float v[4];
            const int mrel = fr - 4 * fq;
#pragma unroll
            for (int e = 0; e < 4; ++e) { float x = live ? pt[e] * we : 0.f; if (jt == it) { const bool keep = dir ? (e >= mrel) : (e <= mrel); x = keep ? x : 0.f; } v[e] = x; we *= Rm1; }
            const int i = it * 16 + fr, j0 = jt * 16 + 4 * fq;
            u32x2 w; w.x = cvt_pk_bf16(v[0], v[1]); w.y = cvt_pk_bf16(v[2], v[3]);
            *(LAS u32x2*)(PI + p_off(i, j0 >> 3) + ((j0 >> 2) & 1) * 8) = w; } }
        f32x16 Yt[2]; Yt[0] = f32x16{}; Yt[1] = f32x16{};
        { const int fH = r & 3, fL = (r >> 2) & 3; int QH[4], QL[4];
#pragma unroll
          for (int k = 0; k < 4; ++k) { QH[k] = 64 * (k ^ fH); QL[k] = 256 * r + 8 * h + 16 * (k ^ fL); }
#pragma unroll
          for (int dkb = 0; dkb < 8; ++dkb)
#pragma unroll
            for (int s = 0; s < 2; ++s) { const bf16x8 bf = pack_step(S[dkb], s);
                const LAS char* rp = QI + (dkb >> 2) * 16384 + QH[dkb & 3];
#pragma unroll
                for (int it = 0; it < 2; ++it) {
                    const u32x2 lo = *(const LAS u32x2*)(rp + it * 8192 + QL[2 * s]), hi2 = *(const LAS u32x2*)(rp + it * 8192 + QL[2 * s + 1]);
                    const u32x4 aw = {lo.x, lo.y, hi2.x, hi2.y};
                    Yt[it] = __builtin_amdgcn_mfma_f32_32x32x16_bf16(__builtin_bit_cast(bf16x8, aw), bf, Yt[it], 0, 0, 0); } } }
        { float fit = LR;
#pragma unroll
          for (int it = 0; it < 2; ++it) { float fa = fit;
#pragma unroll
            for (int a4 = 0; a4 < 4; ++a4) { float fb = fa;
#pragma unroll
                for (int b4 = 0; b4 < 4; ++b4) { Yt[it][4 * a4 + b4] *= fb; fb *= R1; }
                fa *= R8; }
            fit *= R32; } }
        if (more) asm volatile("s_waitcnt vmcnt(4)" ::: "memory"); else asm volatile("s_waitcnt vmcnt(0)" ::: "memory");
        __syncthreads();
        if (more) dma_mat(nsrc + qcol, 8192, lds + OFF_Q, wid, lane);
#pragma unroll
        for (int i = 0; i < 8; ++i)
#pragma unroll
            for (int rg = 0; rg < 16; ++rg) S[i][rg] *= g64;
        {
          const int blk = (lane >> 4) & 1, q = (lane & 15) >> 2, p = lane & 3; int TB[2], CQ[4];
#pragma unroll
          for (int t = 0; t < 2; ++t) TB[t] = 2048 * h + 256 * q + 1024 * t + 16 * ((2 * blk + (p >> 1)) ^ ((2 * h + t) & 3)) + 8 * (p & 1);
#pragma unroll
          for (int c = 0; c < 4; ++c) CQ[c] = 64 * (c ^ q);
          const LAS char* vb = VI + (wid >> 2) * 16384 + CQ[wid & 3];
          float zk = LZ;
#pragma unroll
          for (int ks = 0; ks < 4; ++ks) {
            const s16x4 vlo = vtr(vb + 4096 * ks + TB[0]), vhi = vtr(vb + 4096 * ks + TB[1]);
            const u32x2 vl = __builtin_bit_cast(u32x2, vlo), vh = __builtin_bit_cast(u32x2, vhi);
            const u32x4 vw = {vl.x, vl.y, vh.x, vh.y}; const bf16x8 vf = __builtin_bit_cast(bf16x8, vw);
#pragma unroll
            for (int it = 0; it < 2; ++it) { const bf16x8 pa = *(const LAS bf16x8*)(PI + p_off(it * 32 + r, 2 * ks + h));
                Yt[it] = __builtin_amdgcn_mfma_f32_32x32x16_bf16(pa, vf, Yt[it], 0, 0, 0); }
            float zj = zk; u32x4 zw;
            { const float a0 = bflo(vw.x) * zj; zj *= Rm1; const float a1 = bfhi(vw.x) * zj; zj *= Rm1; zw.x = cvt_pk_bf16(a0, a1); }
            { const float a0 = bflo(vw.y) * zj; zj *= Rm1; const float a1 = bfhi(vw.y) * zj; zj *= Rm1; zw.y = cvt_pk_bf16(a0, a1); }
            { const float a0 = bflo(vw.z) * zj; zj *= Rm1; const float a1 = bfhi(vw.z) * zj; zj *= Rm1; zw.z = cvt_pk_bf16(a0, a1); }
            { const float a0 = bflo(vw.w) * zj; zj *= Rm1; const float a1 = bfhi(vw.w) * zj; zw.w = cvt_pk_bf16(a0, a1); }
            const bf16x8 vz = __builtin_bit_cast(bf16x8, zw);
            zk *= Rm16;
#pragma unroll
            for (int dkb = 0; dkb < 8; ++dkb) { const LAS char* kb_ = KI + (dkb >> 2) * 16384 + 4096 * ks + CQ[dkb & 3];
                const s16x4 klo = vtr(kb_ + TB[0]), khi = vtr(kb_ + TB[1]);
                const u32x2 kl = __builtin_bit_cast(u32x2, klo), kh = __builtin_bit_cast(u32x2, khi); const u32x4 kw = {kl.x, kl.y, kh.x, kh.y};
                S[dkb] = __builtin_amdgcn_mfma_f32_32x32x16_bf16(__builtin_bit_cast(bf16x8, kw), vz, S[dkb], 0, 0, 0); }
            __builtin_amdgcn_sched_barrier(0);
          } }
        if (!(skip_ctx_y && n < 4)) {
            bf16* Yr = Y + (size_t)rowbase * 4096; const unsigned yo = (unsigned)(hd * RDV + dvh * 256 + wid * 32 + r + 4 * h * 4096);
#pragma unroll
            for (int it = 0; it < 2; ++it)
#pragma unroll
                for (int rg = 0; rg < 16; ++rg) { const unsigned i0 = (unsigned)(it * 32 + (rg & 3) + 8 * (rg >> 2));
                    Yr[yo + i0 * 4096u] = (bf16)(cvt_pk_bf16(Yt[it][rg], 0.f) & 0xffffu); }
        }
        asm volatile("s_waitcnt vmcnt(0)" ::: "memory");
        __syncthreads();
        if (more) dma_mat(nsrc + vcol, 8192, lds + OFF_V, wid, lane);
    }
    asm volatile("s_waitcnt vmcnt(0)" ::: "memory"); __syncthreads();
}
}

#define XB_TMO      128
#define XB_XCNT(j)  (256  + 64 * (j))
#define XB_XSUB(j)  (1280 + 64 * (j))
#define XB_XGEN(j)  (2304 + 64 * (j))
#define XB_TOP      3328
#define XB_TOPGEN   3392
#define XCD_BAR_WORDS 3456
#define XB_SPIN_CAP (1u << 22)
__device__ __forceinline__ unsigned xb_ld(unsigned* p)              { return __hip_atomic_load(p, __ATOMIC_RELAXED, __HIP_MEMORY_SCOPE_AGENT); }
__device__ __forceinline__ unsigned xb_add(unsigned* p, unsigned v) { return __hip_atomic_fetch_add(p, v, __ATOMIC_RELAXED, __HIP_MEMORY_SCOPE_AGENT); }
__device__ __forceinline__ unsigned xb_xcc_id() { return (unsigned)__builtin_amdgcn_s_getreg((3 << 11) | 20) & 0xFu; }
#define XB_SPIN(cond, bar) do { unsigned _sp = 0; while (cond) { __builtin_amdgcn_s_sleep(1); \
    if ((++_sp & 255u) == 0u) { if (xb_ld(&(bar)[XB_TMO])) break; if (_sp > XB_SPIN_CAP) { atomicAdd(&(bar)[XB_TMO], 1u); break; } } } } while (0)
struct XcdBarrier { unsigned* bar; unsigned x; volatile LAS unsigned* st; };
__device__ __forceinline__ XcdBarrier xcd_barrier_post(unsigned* bar, volatile LAS unsigned* st) {
    XcdBarrier b; b.bar = bar; b.x = xb_xcc_id(); b.st = st;
    if (threadIdx.x == 0) (void)xb_add(&bar[XB_XCNT(b.x)], 1u);
    return b;
}
__device__ __forceinline__ void xcd_barrier_complete(unsigned* bar, unsigned x, unsigned& nloc, unsigned& nx) {
    const unsigned G = gridDim.x * gridDim.y * gridDim.z;
    unsigned sum, cnt, mine, sp = 0u;
    for (;;) {
        sum = 0u; cnt = 0u; mine = 0u;
#pragma unroll
        for (unsigned j = 0; j < 16; ++j) { const unsigned c = xb_ld(&bar[XB_XCNT(j)]); sum += c; cnt += (c > 0u) ? 1u : 0u; mine = (j == x) ? c : mine; }
        if (sum == G) break;
        __builtin_amdgcn_s_sleep(1);
        if ((++sp & 255u) == 0u) { if (xb_ld(&bar[XB_TMO])) break; if (sp > XB_SPIN_CAP) { atomicAdd(&bar[XB_TMO], 1u); break; } }
    }
    nloc = mine > 0u ? mine : 1u; nx = cnt > 0u ? cnt : 1u;
}
__device__ __forceinline__ void xcd_barrier(const XcdBarrier& b) {
    asm volatile("s_waitcnt vmcnt(0)" ::: "memory");
    __syncthreads();
    if (threadIdx.x == 0) {
        unsigned* bar = b.bar; asm volatile("" : "+s"(bar));
        __builtin_amdgcn_s_waitcnt(0);
        unsigned nloc = b.st[0], nx = b.st[1];
        if (nloc == 0u) { xcd_barrier_complete(bar, b.x, nloc, nx); b.st[0] = nloc; b.st[1] = nx; }
        const unsigned old = xb_add(&bar[XB_XSUB(b.x)], 1u);
        const unsigned gen = old / nloc;
        if (old + 1u == (gen + 1u) * nloc) {
            __builtin_amdgcn_fence(__ATOMIC_RELEASE, "agent");
            asm volatile("s_waitcnt vmcnt(0)" ::: "memory");
            const unsigned og = xb_add(&bar[XB_TOP], 1u);
            const unsigned tg = og / nx;
            if (og + 1u == (tg + 1u) * nx) xb_add(&bar[XB_TOPGEN], 1u);
            else XB_SPIN(xb_ld(&bar[XB_TOPGEN]) == tg, bar);
            __builtin_amdgcn_fence(__ATOMIC_ACQUIRE, "agent");
            xb_add(&bar[XB_XGEN(b.x)], 1u);
            asm volatile("s_waitcnt vmcnt(0)" ::: "memory");
        } else {
            XB_SPIN(xb_ld(&bar[XB_XGEN(b.x)]) == gen, bar);
            __builtin_amdgcn_fence(__ATOMIC_ACQUIRE, "agent");
            asm volatile("s_waitcnt vmcnt(0)" ::: "memory");
        }
    }
    __syncthreads();
}

__device__ __forceinline__ float wave_sum(float v, int lane) {
#pragma unroll
    for (int o = 1; o < 64; o <<= 1) v += shfl_xor_l(v, o, lane);
    return v;
}
struct CvtDesc { const float* colptr; const float* kscale; bf16* WTrow0; int ldw, k0, K; float gscale; };
__device__ __forceinline__ void cvt_load(const CvtDesc& d, int lane, float (&v)[32]) {
#pragma unroll
    for (int i = 0; i < 32; ++i) { const int kk = 2 * i + (lane >> 5); float x = d.colptr ? d.colptr[(size_t)(d.k0 + kk) * d.ldw] : 0.f;
        if (d.kscale) x *= d.kscale[d.k0 + kk];
        v[i] = x * d.gscale; }
}
__device__ __forceinline__ void cvt_store(const CvtDesc& d, int lane, const float (&v)[32], LAS float* scr) {
#pragma unroll
    for (int i = 0; i < 32; ++i) scr[(2 * i + (lane >> 5)) * 33 + (lane & 31)] = v[i];
    asm volatile("s_waitcnt lgkmcnt(0)" ::: "memory");
    const int c = lane & 7;
#pragma unroll
    for (int j = 0; j < 4; ++j) { const int n = (lane >> 3) + 8 * j; const LAS float* s = scr + (8 * c) * 33 + n;
        u32x4 o; o.x = cvt_pk_bf16(s[0 * 33], s[1 * 33]); o.y = cvt_pk_bf16(s[2 * 33], s[3 * 33]); o.z = cvt_pk_bf16(s[4 * 33], s[5 * 33]); o.w = cvt_pk_bf16(s[6 * 33], s[7 * 33]);
        *(u32x4*)(d.WTrow0 + (size_t)n * d.K + d.k0 + 8 * c) = o; }
    asm volatile("s_waitcnt lgkmcnt(0)" ::: "memory");
}
__device__ __forceinline__ int ropeperm64(int c) { const int p = c >> 1, e = c & 1; return (p < 16) ? (p + 16 * e) : (32 + (p - 16) + 16 * e); }
__device__ __forceinline__ const float* src_col(int kind, const float* W0, const float* W1, int aux, int n) {
    switch (kind) {
        case 0: return W0 + aux + n;
        case 1: return W0 + aux + ropeperm64(n);
        case 2: { const int hh = n / DQ, d = n % DQ; return W0 + hh * DQ + (d < NOPE ? d : NOPE + ropeperm64(d - NOPE)); }
        case 3: { const int hh = n >> 8, d = n & 255; return W0 + hh * 256 + (d >> 1) + 128 * (d & 1); }
        case 4: { const int tl = n >> 8, j = n & 255; return (j < 128 ? W0 : W1) + tl * 128 + (j & 127); }
        default: return nullptr;
    }
}
struct CvtJob { const float* W0; const float* W1; const float* kscale; bf16* WT; int ldw, K, nrows, kind, aux; float gscale; };
__device__ __forceinline__ bool cvt_try(const CvtJob& J, int& it, int lane, CvtDesc& d) {
    const int nblk = J.nrows / 32, items = (J.K / 64) * nblk;
    if (it >= items) { it -= items; return false; }
    const int kb = it / nblk, nb = it % nblk;
    d.colptr = src_col(J.kind, J.W0, J.W1, J.aux, nb * 32 + (lane & 31)); d.kscale = J.kscale; d.WTrow0 = J.WT + (size_t)(nb * 32) * J.K; d.ldw = J.ldw; d.k0 = kb * 64; d.K = J.K; d.gscale = J.gscale;
    return true;
}
__device__ __forceinline__ int cvt_items(const CvtJob& J) { return (J.K / 64) * (J.nrows / 32); }

__device__ __forceinline__ void row_load(const float* xrow, int lane, f32x4 (&v)[8]) {
#pragma unroll
    for (int j = 0; j < 8; ++j) v[j] = *(const f32x4*)(xrow + 4 * lane + 256 * j);
}
__device__ __forceinline__ void norm_mod_finish(const f32x4 (&v)[8], const float* g, const float* sc, const float* sh, bf16* orow, int lane) {
    float s = 0.f;
#pragma unroll
    for (int j = 0; j < 8; ++j) s += (v[j][0] * v[j][0] + v[j][1] * v[j][1]) + (v[j][2] * v[j][2] + v[j][3] * v[j][3]);
    const float rstd = 1.0f / sqrtf(wave_sum(s, lane) * (1.0f / D) + NORM_EPS);
#pragma unroll
    for (int j = 0; j < 8; ++j) { const int c = 4 * lane + 256 * j; const f32x4 gg = *(const f32x4*)(g + c), s1 = *(const f32x4*)(sc + c), s0 = *(const f32x4*)(sh + c);
        const f32x4 y = (v[j] * rstd) * gg * (1.0f + s1) + s0;
        u32x2 w; w.x = cvt_pk_bf16(y[0], y[1]); w.y = cvt_pk_bf16(y[2], y[3]); *(u32x2*)(orow + c) = w; }
}
__device__ __forceinline__ void norm_phase(const float* xsrc, const float* csrc, const float* g, const float* modl, int chunk, bf16* H, int nrows, int gw, int NGW, int lane) {
    if (gw >= nrows) return;
    f32x4 v[8], vn[8]; int m = gw;
    row_load(m < MX ? xsrc + (size_t)m * D : csrc + (size_t)(m - MX) * D, lane, v);
    for (;;) {
        const int mn = m + NGW; const bool has = mn < nrows;
        if (has) row_load(mn < MX ? xsrc + (size_t)mn * D : csrc + (size_t)(mn - MX) * D, lane, vn);
        const float* mr = modl + (size_t)(m < MX ? (m >> 12) : 8) * NMOD + chunk * D;
        norm_mod_finish(v, g, mr + D, mr, H + (size_t)m * D, lane);
        if (!has) break;
#pragma unroll
        for (int j = 0; j < 8; ++j) v[j] = vn[j];
        m = mn;
    }
}

__device__ __forceinline__ unsigned long long ld_arg(LAS unsigned char* lds, int i) {
    const volatile LAS unsigned* p = (const volatile LAS unsigned*)(lds + ARGS_OFF) + 2 * i;
    const unsigned lo = __builtin_amdgcn_readfirstlane(p[0]), hi = __builtin_amdgcn_readfirstlane(p[1]);
    return ((unsigned long long)hi << 32) | lo;
}
__device__ __forceinline__ void mod_layers(LAS unsigned char* lds, unsigned char* ws, int l_lo, int l_hi, int wg, int nwg, int tid, int lane, int wave) {
#define ARGF(i) ((const float*)ld_arg(lds, (i)))
    const int nitems = (l_hi - l_lo) * 96;
    if (wg >= nitems) return;
    LAS float* cond = (LAS float*)lds;
    LAS float* red = (LAS float*)(lds + 73728);
    float* MODV = (float*)(ws + WS_MODV);
    { const float* cin = ARGF(1); const float* cc = ARGF(3);
      for (int i = tid; i < 9 * D; i += 512) { const int r = i >> 11, k = i & (D - 1); const float c = (r < 8) ? cin[r * D + k] : cc[k]; cond[i] = c / (1.0f + __expf(-c)); } }
    __syncthreads();
    for (int it = wg; it < nitems; it += nwg) {
        const int l = l_lo + it / 96, cb = it % 96; const int n = cb * 128 + 2 * lane;
        const float* W = ARGF(4) + (size_t)l * D * NMOD + n; const float* mb = ARGF(5) + (size_t)l * NMOD + cb * 128;
        float a0[9], a1[9];
#pragma unroll
        for (int r = 0; r < 9; ++r) { a0[r] = 0.f; a1[r] = 0.f; }
        for (int k = wave * 256; k < wave * 256 + 256; k += 4) {
            f32x2 w[4];
#pragma unroll
            for (int q = 0; q < 4; ++q) w[q] = *(const f32x2*)(W + (size_t)(k + q) * NMOD);
#pragma unroll
            for (int r = 0; r < 9; ++r) { const f32x4 c4 = *(const LAS f32x4*)(cond + r * D + k);
#pragma unroll
                for (int q = 0; q < 4; ++q) { a0[r] += c4[q] * w[q][0]; a1[r] += c4[q] * w[q][1]; } }
        }
#pragma unroll
        for (int r = 0; r < 9; ++r) { red[(wave * 9 + r) * 128 + 2 * lane] = a0[r]; red[(wave * 9 + r) * 128 + 2 * lane + 1] = a1[r]; }
        __syncthreads();
        for (int i = tid; i < 9 * 128; i += 512) { const int r = i >> 7, cc = i & 127; float s2 = 0.f;
#pragma unroll
            for (int w8 = 0; w8 < 8; ++w8) s2 += red[(w8 * 9 + r) * 128 + cc];
            MODV[((size_t)l * 9 + r) * NMOD + cb * 128 + cc] = s2 + mb[cc]; }
        __syncthreads();
    }
#undef ARGF
}
__device__ __forceinline__ void cvt_layer(LAS unsigned char* lds, unsigned char* ws, int lc, int rank, int nranks, int wave, int lane) {
#define ARGF(i) ((const float*)ld_arg(lds, (i)))
    const int li = lc >> 1; const bool is_ret = (lc & 1) != 0;
    bf16* WM = (bf16*)(ws + (is_ret ? WS_WB : WS_WA)); bf16* WF = (bf16*)(ws + (is_ret ? WS_WB + 82 * MiB : WS_WA + 22 * MiB));
    LAS float* scr = (LAS float*)(lds + wave * 16384);
    CvtJob J[7]; int nj;
    if (!is_ret) {
        bf16* W1T = WM; bf16* WuqT = W1T + (size_t)N1 * D; bf16* WukvT = WuqT + (size_t)3072 * 512; bf16* WoT = WukvT + (size_t)4096 * 512;
        const float* wdq = ARGF(8) + (size_t)li * D * QR; const float* wdkv = ARGF(11) + (size_t)li * D * (KVR + ROPE);
        J[0] = CvtJob{wdq, nullptr, nullptr, W1T, QR, D, 512, 0, 0, 1.f};
        J[1] = CvtJob{wdkv, nullptr, nullptr, W1T + (size_t)512 * D, KVR + ROPE, D, 512, 0, 0, 1.f};
        J[2] = CvtJob{wdkv, nullptr, nullptr, W1T + (size_t)1024 * D, KVR + ROPE, D, 64, 1, 512, 1.f};
        J[3] = CvtJob{nullptr, nullptr, nullptr, W1T + (size_t)1088 * D, 1, D, 192, 5, 0, 1.f};
        J[4] = CvtJob{ARGF(10) + (size_t)li * QR * 3072, nullptr, ARGF(9) + li * QR, WuqT, 3072, QR, 3072, 2, 0, 0.07216878364870322f * LOG2E};
        J[5] = CvtJob{ARGF(13) + (size_t)li * KVR * 4096, nullptr, ARGF(12) + li * KVR, WukvT, 4096, KVR, 4096, 0, 0, 1.f};
        J[6] = CvtJob{ARGF(14) + (size_t)li * D * D, nullptr, nullptr, WoT, D, D, D, 0, 0, 1.f};
        nj = 7;
    } else {
        bf16* WqkvT = WM; bf16* WgT = WqkvT + (size_t)8192 * D; bf16* WoT = WgT + (size_t)8192 * D;
        J[0] = CvtJob{ARGF(15) + (size_t)li * D * D, nullptr, nullptr, WqkvT, D, D, 2048, 3, 0, 1.f};
        J[1] = CvtJob{ARGF(16) + (size_t)li * D * D, nullptr, nullptr, WqkvT + (size_t)2048 * D, D, D, 2048, 3, 0, 0.0625f};
        J[2] = CvtJob{ARGF(17) + (size_t)li * D * 4096, nullptr, nullptr, WqkvT + (size_t)4096 * D, 4096, D, 4096, 0, 0, 1.f};
        J[3] = CvtJob{ARGF(18) + (size_t)li * D * 4096, ARGF(19) + (size_t)li * D * 4096, nullptr, WgT, 4096, D, 8192, 4, 0, 1.f};
        J[4] = CvtJob{ARGF(20) + (size_t)li * 4096 * D, nullptr, nullptr, WoT, D, 4096, D, 0, 0, 1.f};
        J[5] = CvtJob{nullptr, nullptr, nullptr, nullptr, 1, 64, 0, 5, 0, 1.f};
        J[6] = J[5];
        nj = 5;
    }
    CvtJob F0 = CvtJob{ARGF(23) + (size_t)lc * D * FF, ARGF(24) + (size_t)lc * D * FF, nullptr, WF, FF, D, 11264, 4, 0, 1.f};
    CvtJob F1 = CvtJob{ARGF(27) + (size_t)lc * FF * D, nullptr, nullptr, WF + (size_t)11264 * D, D, FF, D, 0, 0, 1.f};
    int total = cvt_items(F0) + cvt_items(F1);
#pragma unroll
    for (int j = 0; j < 7; ++j) if (j < nj) total += cvt_items(J[j]);
#define CVT_FIND(IT, DD) do { int it_ = (IT); bool done_ = false; \
        _Pragma("unroll") for (int j = 0; j < 7; ++j) if (!done_ && j < nj) done_ = cvt_try(J[j], it_, lane, DD); \
        if (!done_) done_ = cvt_try(F0, it_, lane, DD); if (!done_) done_ = cvt_try(F1, it_, lane, DD); } while (0)
    if (rank < total) {
        float v[32], w[32]; CvtDesc d0, d1; int it0 = rank;
        CVT_FIND(it0, d0); cvt_load(d0, lane, v);
        for (;;) {
            const int it1 = it0 + nranks; const bool has = it1 < total;
            if (has) { CVT_FIND(it1, d1); cvt_load(d1, lane, w); }
            cvt_store(d0, lane, v, scr);
            if (!has) break;
#pragma unroll
            for (int i = 0; i < 32; ++i) v[i] = w[i];
            d0 = d1; it0 = it1;
        }
    }
#undef CVT_FIND
#undef ARGF
}
struct Args { const float* in[29]; float* out; unsigned char* ws; int ph_lo, ph_hi; };
constexpr int PH_PER_LAYER = 10, PH_FINAL = 1 + PH_PER_LAYER * DEPTH, PH_COUNT = PH_FINAL + 1;

template <unsigned MK_EN_T>
__global__ void __launch_bounds__(512, 2) mk_fwd(Args args) {
    extern __shared__ __attribute__((aligned(16))) unsigned char lds_raw[];
    LAS unsigned char* lds = (LAS unsigned char*)lds_raw;
    volatile LAS unsigned* MISC = (volatile LAS unsigned*)(lds + MISC_OFF);
    const int G = gridDim.x; const int bx = blockIdx.x; const int vcu = (G % 8 == 0) ? (bx % 8) * (G / 8) + bx / 8 : bx;
    const int NGW = G * 8;
    unsigned char* ws = args.ws; float* X = args.out;
    const int lo = args.ph_lo, hi = args.ph_hi;
    { const int tid0 = threadIdx.x;
      for (int u = tid0; u < (LDS_BYTES - CTRL_BASE) / 4; u += 512) ((LAS unsigned*)(lds + CTRL_BASE))[u] = 0u;
      __syncthreads();
      if (tid0 < 29) ((volatile LAS unsigned long long*)(lds + ARGS_OFF))[tid0] = (unsigned long long)args.in[tid0];
      __syncthreads(); }
#define ARGF(i) ((const float*)ld_arg(lds, (i)))
    XcdBarrier bar; bar.bar = (unsigned*)(ws + WS_CTL) + CW_BAR; bar.x = 0; bar.st = nullptr;
    if (hi - lo > 1) bar = xcd_barrier_post((unsigned*)(ws + WS_CTL) + CW_BAR, MISC + 8);
#define EN(b) (((MK_EN_T) >> (b)) & 1u)
#define IN(k) (lo <= (k) && (k) < hi)
#define PHASE_END(k) do { if (hi > (k) + 1) xcd_barrier(bar); } while (0)
#define PH_IDS int tid = threadIdx.x; asm volatile("" : "+v"(tid)); const int lane = tid & 63; const int wave = __builtin_amdgcn_readfirstlane(tid >> 6); const int gw = vcu * 8 + wave; (void)lane; (void)gw;
#define XC_    ((float*)(ws + WS_XC))
#define MODV_  ((float*)(ws + WS_MODV))
#define TABM_  ((float*)(ws + WS_TABM))
#define TABR_  ((float*)(ws + WS_TABR))
#define SSQ_   ((float*)(ws + WS_SSQ))
#define KR_    ((bf16*)(ws + WS_KR))
#define H_     ((bf16*)(ws + WS_H))
#define WMIX_(ll) ((bf16*)(ws + (((ll) & 1) ? WS_WB : WS_WA)))
#define WFFN_(ll) ((bf16*)(ws + (((ll) & 1) ? WS_WB + 82 * MiB : WS_WA + 22 * MiB)))
#define W1T_   WMIX_(l)
#define WUQT_  (W1T_ + (size_t)N1 * D)
#define WUKVT_ (WUQT_ + (size_t)3072 * 512)
#define WOTM_  (WUKVT_ + (size_t)4096 * 512)
#define WQKVT_ WMIX_(l)
#define WGT_   (WQKVT_ + (size_t)8192 * D)
#define WOTR_  (WGT_ + (size_t)8192 * D)
#define WGUT_  WFFN_(l)
#define WDT_   (WGUT_ + (size_t)11264 * D)
#define QKVL_  ((bf16*)(ws + WS_QKVL))
#define Q_     ((bf16*)(ws + WS_Q))
#define KV_    ((bf16*)(ws + WS_KV))
#define O_     ((bf16*)(ws + WS_O))
#define QKV_   ((bf16*)(ws + WS_QKV))
#define Y_     ((bf16*)(ws + WS_Y))
#define GATED_ ((bf16*)(ws + WS_GATED))
#define GB_    ((bf16*)(ws + WS_G))
#define UB_    ((bf16*)(ws + WS_U))
#define HALO_  ((float*)(ws + WS_G))
#define MODL_  (MODV_ + (size_t)l * 9 * NMOD)

    if (EN(0) && IN(0)) for (int rep_ = 0; rep_ < 1 + (int)((PROBE_MASK >> 0) & 1u); ++rep_) {
        PH_IDS
        mod_layers(lds, ws, 0, 1, bx, G, tid, lane, wave);
        __syncthreads();
        cvt_layer(lds, ws, 0, gw, NGW, wave, lane);
        for (int i = bx * 512 + tid; i < 64 * 16 + SEQ * 128; i += G * 512) {
            float inv, pos; float* dst;
            if (i < 1024) { const int p = i >> 4, f = i & 15; inv = __builtin_amdgcn_exp2f(-(float)(2 * f) * (13.287712379549449f / 32.0f)); pos = (float)p; dst = TABM_ + 2 * i; }
            else { const int j = i - 1024, t = j >> 7, f = j & 127; inv = __builtin_amdgcn_exp2f(-(float)(2 * f) * (13.287712379549449f / 256.0f)); pos = (float)t; dst = TABR_ + 2 * j; }
            const float ang = pos * inv; const double rev = (double)ang * 0.15915494309189535; const float fr = (float)(rev - floor(rev));
            dst[0] = __builtin_amdgcn_cosf(fr); dst[1] = __builtin_amdgcn_sinf(fr);
        }
        PHASE_END(0);
    }

    for (int l = 0; l < DEPTH; ++l) {
        const int P = 1 + PH_PER_LAYER * l; const int li = l >> 1; const bool is_ret = (l & 1) != 0; const bool last = (l == DEPTH - 1);
        const int Mrows = last ? MX : MT;

        if (EN(1) && IN(P + 0)) for (int rep_ = 0; rep_ < 1 + (int)((PROBE_MASK >> 1) & 1u); ++rep_) {
            PH_IDS
            const float* g = ARGF(6) + l * D; const float* xsrc = (l == 0) ? ARGF(0) : X; const float* csrc = (l == 0) ? ARGF(2) : XC_;
            norm_phase(xsrc, csrc, g, MODL_, 0, H_, MT, gw, NGW, lane);
            PHASE_END(P + 0);
        }

        if (!is_ret) {
            if (EN(2) && IN(P + 1)) for (int rep_ = 0; rep_ < 1 + (int)((PROBE_MASK >> 2) & 1u); ++rep_) {
                pg8::Gemm g{H_, W1T_, MT, N1, D, D}; pg8::StaticOrder S; S.init(MT, N1, G, bx);
                EpiG1 E{QKVL_, SSQ_, KR_, TABM_};
                pg8::gemm_phase<EpiG1>(lds, g, S, E);
                PHASE_END(P + 1);
            }
            if (EN(3) && IN(P + 2)) for (int rep_ = 0; rep_ < 1 + (int)((PROBE_MASK >> 3) & 1u); ++rep_) {
                { pg8::Gemm g{QKVL_, WUQT_, MT, 3072, QR, N1}; pg8::StaticOrder S; S.init(MT, 3072, G, bx); EpiUq E{Q_, SSQ_, TABM_}; pg8::gemm_phase<EpiUq>(lds, g, S, E); }
                { pg8::Gemm g{QKVL_ + 512, WUKVT_, MT, 4096, KVR, N1}; pg8::StaticOrder S; S.init(MT, 4096, G, bx); EpiUkv E{KV_, SSQ_}; pg8::gemm_phase<EpiUkv>(lds, g, S, E); }
                PHASE_END(P + 2);
            }
            if (EN(4) && IN(P + 3)) for (int rep_ = 0; rep_ < 1 + (int)((PROBE_MASK >> 4) & 1u); ++rep_) {
                const int nun = 2048 + 128;
                for (int ui = vcu; ui < nun; ui += G) {
                    if (ui < 2048) { const int xcd = (ui & 255) >> 5, j = ui & 31, rnd = ui >> 8; const int bh = xcd * 16 + 2 * rnd + (j >> 4), qb = j & 15; const int b = bh >> 4, hd = bh & 15;
                        att::attn_unit(Q_ + (size_t)(b * SEQ + qb * 256) * 3072 + hd * DQ, KV_ + hd * 256, KR_, O_ + (size_t)(b * SEQ + qb * 256) * D + hd * 128, 68, 4, MX + b * CTXL, b * SEQ, (char*)lds_raw);
                    } else { const int bh = ui - 2048, b = bh >> 4, hd = bh & 15;
                        att::attn_unit(Q_ + (size_t)(MX + b * CTXL) * 3072 + hd * DQ, KV_ + hd * 256, KR_, O_ + (size_t)(MX + b * CTXL) * D + hd * 128, 4, 4, MX + b * CTXL, 0, (char*)lds_raw); }
                }
                PHASE_END(P + 3);
            }
        } else {
            if (EN(5) && IN(P + 1)) for (int rep_ = 0; rep_ < 1 + (int)((PROBE_MASK >> 5) & 1u); ++rep_) {
                pg8::Gemm g{H_, WQKVT_, MT, 8192, D, D}; pg8::StaticOrder S; S.init(MT, 8192, G, bx);
                EpiQKV E{QKV_, TABR_};
                pg8::gemm_phase<EpiQKV>(lds, g, S, E);
                PHASE_END(P + 1);
            }
            if (EN(6) && IN(P + 2)) for (int rep_ = 0; rep_ < 1 + (int)((PROBE_MASK >> 6) & 1u); ++rep_) {
                for (int ui = vcu; ui < 256; ui += G) {
                    const int bh = ui >> 2, dir = (ui >> 1) & 1, dvh = ui & 1; const int b = bh >> 3, hd = bh & 7;
                    const float dec = (dir ? ARGF(22) : ARGF(21))[li * RH + hd];
                    const float lg2 = -__expf(dec) * LOG2E;
                    scan::scan_unit(QKV_, Y_ + (size_t)dir * MT * 4096, b, hd, dir, dvh, lg2, last, lds);
                }
                PHASE_END(P + 2);
            }
            if (EN(7) && IN(P + 3)) for (int rep_ = 0; rep_ < 1 + (int)((PROBE_MASK >> 7) & 1u); ++rep_) {
                PH_IDS
                for (int row = gw; row < Mrows; row += NGW) {
                    u32x4 w[16];
#pragma unroll
                    for (int q = 0; q < 16; ++q) w[q] = *(const u32x4*)(Y_ + (size_t)(q >> 3) * MT * 4096 + (size_t)row * 4096 + (q & 7) * RDV + lane * 8);
                    float mu[16], rs[16];
#pragma unroll
                    for (int q = 0; q < 16; ++q) { const float s = ((bflo(w[q].x) + bfhi(w[q].x)) + (bflo(w[q].y) + bfhi(w[q].y))) + ((bflo(w[q].z) + bfhi(w[q].z)) + (bflo(w[q].w) + bfhi(w[q].w))); mu[q] = s; }
#pragma unroll
                    for (int o = 1; o < 64; o <<= 1)
#pragma unroll
                        for (int q = 0; q < 16; ++q) mu[q] += shfl_xor_l(mu[q], o, lane);
#pragma unroll
                    for (int q = 0; q < 16; ++q) { mu[q] *= (1.0f / RDV); const float m_ = mu[q];
                        const float d0 = bflo(w[q].x) - m_, d1 = bfhi(w[q].x) - m_, d2 = bflo(w[q].y) - m_, d3 = bfhi(w[q].y) - m_, d4 = bflo(w[q].z) - m_, d5 = bfhi(w[q].z) - m_, d6 = bflo(w[q].w) - m_, d7 = bfhi(w[q].w) - m_;
                        rs[q] = ((d0 * d0 + d1 * d1) + (d2 * d2 + d3 * d3)) + ((d4 * d4 + d5 * d5) + (d6 * d6 + d7 * d7)); }
#pragma unroll
                    for (int o = 1; o < 64; o <<= 1)
#pragma unroll
                        for (int q = 0; q < 16; ++q) rs[q] += shfl_xor_l(rs[q], o, lane);
                    float mo = 0.f, ro = 0.f;
#pragma unroll
                    for (int q = 0; q < 16; ++q) { if (lane == q) { mo = mu[q]; ro = rs[q]; } }
                    if (lane < 16) *(f32x2*)((float*)(ws + WS_STATS) + ((size_t)((lane >> 3) * MT + row) * 8 + (lane & 7)) * 2) = (f32x2){mo, 1.0f / sqrtf(ro * (1.0f / RDV) + GN_EPS)};
                }
                PHASE_END(P + 3);
            }
            if (EN(8) && IN(P + 4)) for (int rep_ = 0; rep_ < 1 + (int)((PROBE_MASK >> 8) & 1u); ++rep_) {
                pg8::Gemm g{H_, WGT_, Mrows, 8192, D, D}; pg8::StaticOrder S; S.init(Mrows, 8192, G, bx);
                EpiGate E{GATED_, Y_, Y_ + (size_t)MT * 4096, (const float*)(ws + WS_STATS)};
                pg8::gemm_phase<EpiGate>(lds, g, S, E);
                PHASE_END(P + 4);
            }
        }
        if (EN(9) && IN(P + 5)) for (int rep_ = 0; rep_ < 1 + (int)((PROBE_MASK >> 9) & 1u); ++rep_) {
            pg8::Gemm g = is_ret ? pg8::Gemm{GATED_, WOTR_, Mrows, D, 4096, 4096} : pg8::Gemm{O_, WOTM_, Mrows, D, D, D};
            pg8::StaticOrder S; S.init(Mrows, D, G, bx);
            const float* xsrc = (l == 0) ? ARGF(0) : X; const float* csrc = (l == 0) ? ARGF(2) : XC_;
            EpiResid E{xsrc, X, csrc, XC_, MODL_, 2 * D};
            pg8::gemm_phase<EpiResid>(lds, g, S, E);
            PHASE_END(P + 5);
        }
        if (EN(10) && IN(P + 6)) for (int rep_ = 0; rep_ < 1 + (int)((PROBE_MASK >> 10) & 1u); ++rep_) {
            PH_IDS
            const float* g = ARGF(7) + l * D;
            norm_phase(X, XC_, g, MODL_, 3, H_, Mrows, gw, NGW, lane);
            PHASE_END(P + 6);
        }
        if (EN(11) && IN(P + 7)) for (int rep_ = 0; rep_ < 1 + (int)((PROBE_MASK >> 11) & 1u); ++rep_) {
            pg8::Gemm g{H_, WGUT_, Mrows, 11264, D, D}; pg8::StaticOrder S; S.init(Mrows, 11264, G, bx);
            EpiGUConv E{UB_, HALO_, ARGF(25) + (size_t)l * 3 * FF, ARGF(26) + (size_t)l * FF, (LAS float*)(lds + EDGE_OFF)};
            pg8::gemm_phase<EpiGUConv>(lds, g, S, E);
            PHASE_END(P + 7);
        }
        if (EN(12) && IN(P + 8)) for (int rep_ = 0; rep_ < 1 + (int)((PROBE_MASK >> 12) & 1u); ++rep_) {
            PH_IDS
            const float* cw = ARGF(25) + (size_t)l * 3 * FF; const float* cb = ARGF(26) + (size_t)l * FF; (void)cb;
            const float* HL = HALO_; bf16* ACT = UB_;
            const int nq = FF / 4;
            for (int i = bx * 512 + tid; i < 120 * nq; i += G * 512) {
                const int bi = i / nq, f = (i % nq) * 4; const int pm = (bi / 15) * 16 + (bi % 15) + 1;
                const float* top = HL + (size_t)((pm * 2 + 0) * 3) * HALO_STRIDE + f; const float* bot = HL + (size_t)(((pm - 1) * 2 + 1) * 3) * HALO_STRIDE + f;
                const f32x4 ct = *(const f32x4*)top, gt = *(const f32x4*)(top + HALO_STRIDE), ut = *(const f32x4*)(top + 2 * HALO_STRIDE);
                const f32x4 cbm = *(const f32x4*)bot, gb = *(const f32x4*)(bot + HALO_STRIDE), ub = *(const f32x4*)(bot + 2 * HALO_STRIDE);
                const f32x4 w0 = *(const f32x4*)(cw + f), w2 = *(const f32x4*)(cw + 2 * FF + f);
                const f32x4 ot = silu4(ct + w0 * gb) * ut, ob = silu4(cbm + w2 * gt) * ub;
                u32x2 wt, wb; wt.x = cvt_pk_bf16(ot[0], ot[1]); wt.y = cvt_pk_bf16(ot[2], ot[3]); wb.x = cvt_pk_bf16(ob[0], ob[1]); wb.y = cvt_pk_bf16(ob[2], ob[3]);
                *(u32x2*)(ACT + (size_t)(pm * 256) * FF + f) = wt; *(u32x2*)(ACT + (size_t)(pm * 256 - 1) * FF + f) = wb;
            }
            PHASE_END(P + 8);
        }
        if (EN(13) && IN(P + 9)) for (int rep_ = 0; rep_ < 1 + (int)((PROBE_MASK >> 13) & 1u); ++rep_) {
            pg8::Gemm g{UB_, WDT_, Mrows, D, FF, FF}; pg8::StaticOrder S; S.init(Mrows, D, G, bx);
            EpiResid E{X, X, XC_, XC_, MODL_, 5 * D};
            pg8::gemm_phase<EpiResid>(lds, g, S, E);
            if (l + 1 < DEPTH) {
                PH_IDS
                const int nwg = (Mrows / 256) * (D / 256), rem = nwg % G;
                if (rem == 0) { mod_layers(lds, ws, l + 1, l + 2, bx, G, tid, lane, wave); __syncthreads(); cvt_layer(lds, ws, l + 1, gw, NGW, wave, lane); }
                else if (bx >= rem) { mod_layers(lds, ws, l + 1, l + 2, bx - rem, G - rem, tid, lane, wave); __syncthreads(); cvt_layer(lds, ws, l + 1, (bx - rem) * 8 + wave, (G - rem) * 8, wave, lane); }
            }
            PHASE_END(P + 9);
        }
    }
    if (EN(14) && IN(PH_FINAL)) for (int rep_ = 0; rep_ < 1 + (int)((PROBE_MASK >> 14) & 1u); ++rep_) {
        PH_IDS
        const float* g = ARGF(28);
        if (gw < MX) {
            f32x4 v[8], vn[8]; int m = gw; row_load(X + (size_t)m * D, lane, v);
            for (;;) {
                const int mn = m + NGW; const bool has = mn < MX;
                if (has) row_load(X + (size_t)mn * D, lane, vn);
                float s = 0.f;
#pragma unroll
                for (int j = 0; j < 8; ++j) s += (v[j][0] * v[j][0] + v[j][1] * v[j][1]) + (v[j][2] * v[j][2] + v[j][3] * v[j][3]);
                const float rstd = 1.0f / sqrtf(wave_sum(s, lane) * (1.0f / D) + NORM_EPS);
                float* xr = X + (size_t)m * D;
#pragma unroll
                for (int j = 0; j < 8; ++j) { const int c = 4 * lane + 256 * j; *(f32x4*)(xr + c) = (v[j] * rstd) * *(const f32x4*)(g + c); }
                if (!has) break;
#pragma unroll
                for (int j = 0; j < 8; ++j) v[j] = vn[j];
                m = mn;
            }
        }
    }
#undef IN
#undef PHASE_END
}

#if !MK_SINGLE
typedef void (*KernFn)(Args);
static KernFn phase_kernel(int bit) {
    switch (bit) {
        case 0: return mk_fwd<1u << 0>;  case 1: return mk_fwd<1u << 1>;  case 2: return mk_fwd<1u << 2>;  case 3: return mk_fwd<1u << 3>;
        case 4: return mk_fwd<1u << 4>;  case 5: return mk_fwd<1u << 5>;  case 6: return mk_fwd<1u << 6>;  case 7: return mk_fwd<1u << 7>;
        case 8: return mk_fwd<1u << 8>;  case 9: return mk_fwd<1u << 9>;  case 10: return mk_fwd<1u << 10>; case 11: return mk_fwd<1u << 11>;
        case 12: return mk_fwd<1u << 12>; case 13: return mk_fwd<1u << 13>; default: return mk_fwd<1u << 14>;
    }
}
static int phase_bit(int p) {
    if (p == 0) return 0; if (p == PH_FINAL) return 14;
    const int l = (p - 1) / PH_PER_LAYER, slot = (p - 1) % PH_PER_LAYER; const bool ret = (l & 1) != 0;
    if (slot == 0) return 1;
    if (slot >= 5) return 4 + slot;
    if (!ret) return slot == 4 ? -1 : 1 + slot;
    return 4 + slot;
}
#endif
extern "C" void kernel_launch(void* const* d_in, const int* in_sizes, int n_in, void* d_out, int out_size, void* d_ws, size_t ws_size, hipStream_t stream) {
    static int grid = 0;
    if (grid == 0) {
        if (n_in != 29 || out_size != MX * D || ws_size < WS_END) { fprintf(stderr, "kernel_launch: unexpected shapes: n_in %d out %d ws %zu (need %zu)\n", n_in, out_size, ws_size, (size_t)WS_END); grid = -1; return; }
        int dev = 0, cus = 0;
        if (hipGetDevice(&dev) != hipSuccess || hipDeviceGetAttribute(&cus, hipDeviceAttributeMultiprocessorCount, dev) != hipSuccess) { grid = -1; return; }
#if MK_SINGLE
        if (hipFuncSetAttribute((const void*)mk_fwd<0xFFFFFFFFu>, hipFuncAttributeMaxDynamicSharedMemorySize, LDS_BYTES) != hipSuccess) { fprintf(stderr, "kernel_launch: hipFuncSetAttribute failed\n"); grid = -1; return; }
#else
        for (int b = 0; b < 15; ++b) if (hipFuncSetAttribute((const void*)phase_kernel(b), hipFuncAttributeMaxDynamicSharedMemorySize, LDS_BYTES) != hipSuccess) { fprintf(stderr, "kernel_launch: hipFuncSetAttribute failed\n"); grid = -1; return; }
#endif
        (void)hipGetLastError();
        grid = cus;
    }
    if (grid < 0) return;
    if (hipMemsetAsync((char*)d_ws + WS_CTL, 0, CTL_BYTES, stream) != hipSuccess) return;
    Args a{};
    for (int i = 0; i < 29; ++i) a.in[i] = (const float*)d_in[i];
    a.out = (float*)d_out; a.ws = (unsigned char*)d_ws;
#if MK_SINGLE
    a.ph_lo = 0; a.ph_hi = PH_COUNT;
    hipLaunchKernelGGL(mk_fwd<0xFFFFFFFFu>, dim3(grid), dim3(512), LDS_BYTES, stream, a);
#else
    for (int p = 0; p < PH_COUNT; ++p) {
        const int bit = phase_bit(p); if (bit < 0) continue;
        a.ph_lo = p; a.ph_hi = p + 1;
        hipLaunchKernelGGL(phase_kernel(bit), dim3(grid), dim3(512), LDS_BYTES, stream, a);
    }
#endif
    const hipError_t le = hipPeekAtLastError();
    if (le != hipSuccess) fprintf(stderr, "kernel_launch: launch failed: %s\n", hipGetErrorName(le));
}
```

```cpp
#include <hip/hip_runtime.h>
#include <cstdio>
#include <cstdint>

#ifndef MK_SINGLE
#define MK_SINGLE 1
#endif

#ifndef MK_STAGGER
#define MK_STAGGER 0
#endif
#ifndef PROBE_EPI2
#define PROBE_EPI2 0
#endif
#ifndef MLA_CHECK
#define MLA_CHECK 0
#endif
#ifndef MLA_CHECK_LAYER
#define MLA_CHECK_LAYER 0
#endif
#ifndef MLA_CHECK_TOL
#define MLA_CHECK_TOL 0.03f
#endif
#ifndef PROBE_MASK
#define PROBE_MASK 0u
#endif
#define GAS __attribute__((address_space(1)))
#define LAS __attribute__((address_space(3)))
typedef unsigned short bf16;
typedef short bf16x8 __attribute__((ext_vector_type(8)));
typedef short s16x4 __attribute__((ext_vector_type(4)));
typedef float f32x2 __attribute__((ext_vector_type(2)));
typedef float f32x4 __attribute__((ext_vector_type(4)));
typedef float f32x16 __attribute__((ext_vector_type(16)));
typedef unsigned u32x2 __attribute__((ext_vector_type(2)));
typedef unsigned u32x4 __attribute__((ext_vector_type(4)));
typedef GAS unsigned gu32;

constexpr int D = 2048, NB = 8, SEQ = 4096, CTXL = 256, DEPTH = 4;
constexpr int MX = NB * SEQ, MC = NB * CTXL, MT = MX + MC;
constexpr int FF = 5632, NMOD = 6 * D;
constexpr int MLA_H = 16, QR = 512, KVR = 512, NOPE = 128, ROPE = 64, DQ = 192;
constexpr int N1 = 1280;
constexpr int RH = 8, RDK = 256, RDV = 512;
constexpr float NORM_EPS = 1e-6f, GN_EPS = 1e-5f;
constexpr float LOG2E = 1.4426950408889634f;

constexpr size_t MiB = 1u << 20;
constexpr size_t WS_CTL = 0, CTL_BYTES = 1 * MiB;
constexpr size_t WS_MODV = 1 * MiB;
constexpr size_t WS_TABM = 3 * MiB;
constexpr size_t WS_TABR = 4 * MiB;
constexpr size_t WS_SSQ = 8 * MiB;
constexpr size_t WS_XC = 12 * MiB;
constexpr size_t WS_KR = 28 * MiB;
constexpr size_t WS_STATS = 33 * MiB;
constexpr size_t WS_WA = 40 * MiB;
constexpr size_t WS_WB = 128 * MiB;
constexpr size_t WS_H = 276 * MiB;
constexpr size_t WS_BIG = 412 * MiB;
constexpr size_t WS_QKVL = WS_BIG, WS_Q = WS_BIG + 88 * MiB, WS_KV = WS_BIG + 292 * MiB, WS_O = WS_BIG + 564 * MiB;
constexpr size_t WS_QKV = WS_BIG, WS_Y = WS_BIG + 544 * MiB, WS_GATED = WS_BIG;
constexpr size_t WS_G = WS_BIG, WS_U = WS_BIG + 374 * MiB;
constexpr size_t WS_END = WS_BIG + 1088 * MiB;
static_assert((size_t)MT * 8192 * 2 <= 544 * MiB && (size_t)MT * 5632 * 2 <= 374 * MiB && (size_t)MT * N1 * 2 <= 88 * MiB, "ws map");

constexpr int CW_BAR = 4096;

constexpr int RING_BYTES = 131072, CTRL_BASE = 155648, MISC_OFF = CTRL_BASE + 320, ARGS_OFF = CTRL_BASE + 1024, EDGE_OFF = CTRL_BASE + 4096, LDS_BYTES = 163840;

__device__ __forceinline__ unsigned cvt_pk_bf16(float lo, float hi) { unsigned r; asm volatile("v_cvt_pk_bf16_f32 %0, %1, %2" : "=v"(r) : "v"(lo), "v"(hi)); return r; }
__device__ __forceinline__ float bf2f(unsigned short b) { return __uint_as_float((unsigned)b << 16); }
__device__ __forceinline__ float bflo(unsigned w) { return __uint_as_float(w << 16); }
__device__ __forceinline__ float bfhi(unsigned w) { return __uint_as_float(w & 0xffff0000u); }
__device__ __forceinline__ float shfl_xor_l(float v, int mask, int lane) { return __builtin_bit_cast(float, __builtin_amdgcn_ds_bpermute((lane ^ mask) << 2, __builtin_bit_cast(int, v))); }
__device__ __forceinline__ float fast_silu(float x) { return x * __builtin_amdgcn_rcpf(1.0f + __builtin_amdgcn_exp2f(-x * LOG2E)); }

__device__ __forceinline__ void glds16_s(const void* sbase, unsigned voff, unsigned lds_dst) {
    unsigned keep;
    asm volatile("s_mov_b32 %0, m0\n\ts_mov_b32 m0, %3\n\ts_nop 0\n\tglobal_load_lds_dwordx4 %1, %2\n\ts_mov_b32 m0, %0" : "=&s"(keep) : "v"(voff), "s"(sbase), "s"(lds_dst) : "memory");
}
__device__ __forceinline__ const char* uni_ptr(const void* p) {
    const unsigned long long v = (unsigned long long)p; const unsigned lo = __builtin_amdgcn_readfirstlane((unsigned)v), hi = __builtin_amdgcn_readfirstlane((unsigned)(v >> 32));
    return (const char*)(((unsigned long long)hi << 32) | lo);
}
namespace pg8 {
constexpr int BM = 256, BK = 64, HALF = 128, HTB = HALF * BK * 2, STAGE_BYTES = 8 * HTB, NXCD = 8, WGM = 8;
__host__ __device__ __forceinline__ int lds_byte(int r, int c) { const int st = (r >> 4) * 2 + (c >> 5), rr = r & 15, cc = c & 31, ob = rr * 64 + cc * 2; return st * 1024 + (ob ^ (((ob >> 9) & 1) << 5)); }
__host__ __device__ __forceinline__ void stage_rc(int b, int& R, int& C) { const int st = b / 1024, sb = b % 1024, swz = sb ^ (((sb >> 9) & 1) << 5); R = (st >> 1) * 16 + swz / 64; C = (st & 1) * 32 + (swz % 64) / 2; }
__host__ __device__ __forceinline__ int perm32(int rho) { const int n = rho >> 4, i = rho & 15; return 8 * (i >> 2) + 4 * n + (i & 3); }
struct Unit { int pm, pn; };
struct Gemm { const bf16* A; const bf16* Bt; int M, N, K, lda; };
struct StaticOrder {
    int nM, nN, nwg, G, c;
    __device__ __forceinline__ void init(int M, int N, int G_, int c_) { nM = M / BM; nN = N / BM; nwg = nM * nN; G = G_; c = c_; }
    __device__ __forceinline__ bool next(int i, Unit& u) const {
        const long L = (long)i * G + c; if (L >= nwg) return false;
        int wgid = (int)L; { const int q = nwg / NXCD, r = nwg % NXCD, xcd = wgid % NXCD, off = wgid / NXCD; wgid = (xcd < r ? xcd * (q + 1) : r * (q + 1) + (xcd - r) * q) + off; }
        const int nig = WGM * nN, gid = wgid / nig, fm = gid * WGM, gsz = (nM - fm) < WGM ? (nM - fm) : WGM;
        u.pm = fm + ((wgid % nig) % gsz); u.pn = (wgid % nig) / gsz; return true;
    }
};
template <class Epi>
__device__ __forceinline__ void gemm_phase(LAS unsigned char* lds, const Gemm g, const StaticOrder& S, const Epi& E) {
    int tid = threadIdx.x; asm volatile("" : "+v"(tid));
    const int wid = __builtin_amdgcn_readfirstlane(tid >> 6), lane = tid & 63, wr = wid >> 2, wc = wid & 3, fr = lane & 15, fq = lane >> 4;
    const int K = g.K, nt = K / BK;
    unsigned voffA[2], voffB[2];
#pragma unroll
    for (int i = 0; i < 2; ++i) { int R, C; stage_rc(tid * 16 + i * 8192, R, C); const int Rb = Epi::PERM ? ((R & ~31) + perm32(R & 31)) : R;
        voffA[i] = (unsigned)(R * g.lda + C) * 2u; voffB[i] = (unsigned)(Rb * K + C) * 2u; }
    const size_t kstep = (size_t)(BK * 2);
    const size_t hstepA = (size_t)HALF * g.lda * 2, hstepB = (size_t)HALF * K * 2;
    const size_t tstepA = 2 * hstepA, tstepB = 2 * hstepB;
    const unsigned ldsbase = (unsigned)__builtin_amdgcn_readfirstlane((unsigned)(uintptr_t)lds + (unsigned)wid * 1024u);
    const int aoff = lds_byte(wr * 64 + fr, fq * 8), boff = lds_byte(wc * 32 + fr, fq * 8);
#define PG8_SA(b, h) (((b) * 2 + (h)) * HTB)
#define PG8_SB(b, h) ((4 + (b) * 2 + (h)) * HTB)
#define PG8_STAGE(bufoff, gbase, voff) do { const char* _gb = uni_ptr(gbase); _Pragma("unroll") for (int _i = 0; _i < 2; ++_i) \
        glds16_s(_gb, (voff)[_i], ldsbase + (unsigned)((bufoff) + _i * 8192)); } while (0)
#define PG8_LDA(dst, b, h) do { _Pragma("unroll") for (int m = 0; m < 4; ++m) _Pragma("unroll") for (int k = 0; k < 2; ++k) dst[m][k] = *(const LAS bf16x8*)(lds + PG8_SA(b, h) + aoff + m * 2048 + k * 1024); } while (0)
#define PG8_LDB(dst, b, h) do { _Pragma("unroll") for (int n = 0; n < 2; ++n) _Pragma("unroll") for (int k = 0; k < 2; ++k) dst[n][k] = *(const LAS bf16x8*)(lds + PG8_SB(b, h) + boff + n * 2048 + k * 1024); } while (0)
#define PG8_MMA(ai, bj, At, Bt) do { __builtin_amdgcn_s_setprio(1); _Pragma("unroll") for (int m = 0; m < 4; ++m) _Pragma("unroll") for (int n = 0; n < 2; ++n) _Pragma("unroll") for (int k = 0; k < 2; ++k) \
        acc[ai][bj][m][n] = __builtin_amdgcn_mfma_f32_16x16x32_bf16(Bt[n][k], At[m][k], acc[ai][bj][m][n], 0, 0, 0); __builtin_amdgcn_s_setprio(0); } while (0)
#define PG8_WAIT_V(n) asm volatile("s_waitcnt vmcnt(" #n ")" ::: "memory")
#define PG8_WAIT_L(n) asm volatile("s_waitcnt lgkmcnt(" #n ")" ::: "memory")
#define PG8_BAR __builtin_amdgcn_s_barrier()
#define PG8_SCHED __builtin_amdgcn_sched_barrier(0)
    Unit cur, nxt; int ui = 0;
    if (!S.next(0, cur)) return;
#if MK_STAGGER
    if (S.c & 1) {
        const unsigned long long t0 = __builtin_amdgcn_s_memrealtime(); const unsigned long long dt = (unsigned long long)nt * MK_STAGGER;
        while (__builtin_amdgcn_s_memrealtime() - t0 < dt) __builtin_amdgcn_s_sleep(8);
    }
#endif
    f32x4 acc[2][2][4][2];
#pragma unroll
    for (int a = 0; a < 2; ++a)
#pragma unroll
        for (int b = 0; b < 2; ++b)
#pragma unroll
            for (int m = 0; m < 4; ++m)
#pragma unroll
                for (int n = 0; n < 2; ++n) acc[a][b][m][n] = (f32x4){0.f, 0.f, 0.f, 0.f};
    bf16x8 At[4][2], B0[2][2], B1[2][2];
    const char* cA = (const char*)g.A + (size_t)cur.pm * tstepA; const char* cB = (const char*)g.Bt + (size_t)cur.pn * tstepB;
    PG8_STAGE(PG8_SB(0, 0), cB, voffB); PG8_STAGE(PG8_SB(0, 1), cB + hstepB, voffB); PG8_STAGE(PG8_SA(0, 0), cA, voffA); PG8_STAGE(PG8_SA(0, 1), cA + hstepA, voffA);
    if (wr == 1) PG8_BAR;
    PG8_WAIT_V(2); PG8_BAR;
    PG8_STAGE(PG8_SB(1, 0), cB + kstep, voffB); PG8_STAGE(PG8_SA(1, 0), cA + kstep, voffA); PG8_STAGE(PG8_SB(1, 1), cB + hstepB + kstep, voffB);
    PG8_WAIT_V(6); PG8_BAR;
    for (;;) {
        const bool has_next = S.next(ui + 1, nxt);
        const char* nA = has_next ? (const char*)g.A + (size_t)nxt.pm * tstepA : cA; const char* nB = has_next ? (const char*)g.Bt + (size_t)nxt.pn * tstepB : cB;
        for (int t = 0; t < nt; t += 2) {
            const bool last = (t == nt - 2);
            const char* a1 = cA + (size_t)(t + 1) * kstep;
            const char* a2 = last ? nA : cA + (size_t)(t + 2) * kstep; const char* b2 = last ? nB : cB + (size_t)(t + 2) * kstep;
            const char* a3 = a2 + kstep; const char* b3 = b2 + kstep;
            PG8_LDB(B0, 0, 0); PG8_LDB(B1, 0, 1); PG8_SCHED; PG8_LDA(At, 0, 0); PG8_STAGE(PG8_SA(1, 1), a1 + hstepA, voffA);
            PG8_WAIT_V(8); PG8_WAIT_L(0); PG8_BAR; PG8_MMA(0, 0, At, B0); PG8_MMA(0, 1, At, B1); PG8_BAR; PG8_SCHED;
            PG8_LDA(At, 0, 1); PG8_STAGE(PG8_SB(0, 0), b2, voffB); PG8_STAGE(PG8_SB(0, 1), b2 + hstepB, voffB); PG8_STAGE(PG8_SA(0, 0), a2, voffA);
            PG8_WAIT_V(8); PG8_WAIT_L(0); PG8_BAR; PG8_MMA(1, 0, At, B0); PG8_MMA(1, 1, At, B1); PG8_BAR; PG8_SCHED;
            PG8_LDB(B0, 1, 0); PG8_LDB(B1, 1, 1); PG8_SCHED; PG8_LDA(At, 1, 0); PG8_STAGE(PG8_SA(0, 1), a2 + hstepA, voffA);
            PG8_WAIT_V(8); PG8_WAIT_L(0); PG8_BAR; PG8_MMA(0, 0, At, B0); PG8_MMA(0, 1, At, B1); PG8_BAR; PG8_SCHED;
            PG8_LDA(At, 1, 1); PG8_STAGE(PG8_SB(1, 0), b3, voffB); PG8_STAGE(PG8_SB(1, 1), b3 + hstepB, voffB); PG8_STAGE(PG8_SA(1, 0), a3, voffA);
            PG8_WAIT_V(8); PG8_WAIT_L(0); PG8_BAR; PG8_MMA(1, 0, At, B0); PG8_MMA(1, 1, At, B1); PG8_BAR; PG8_SCHED;
        }
        if (wr == 0) PG8_BAR;
        E(acc, cur, wr, wc, fr, fq);
#if PROBE_EPI2
        if (Epi::PROBE2) E(acc, cur, wr, wc, fr, fq);
#endif
        if (!has_next) break;
#pragma unroll
        for (int a = 0; a < 2; ++a)
#pragma unroll
            for (int b = 0; b < 2; ++b)
#pragma unroll
                for (int m = 0; m < 4; ++m)
#pragma unroll
                    for (int n = 0; n < 2; ++n) acc[a][b][m][n] = (f32x4){0.f, 0.f, 0.f, 0.f};
        cur = nxt; cA = nA; cB = nB; ++ui;
        if (wr == 1) PG8_BAR;
    }
    PG8_WAIT_V(0);
    PG8_BAR;
#undef PG8_SA
#undef PG8_SB
#undef PG8_STAGE
#undef PG8_LDA
#undef PG8_LDB
#undef PG8_MMA
#undef PG8_WAIT_V
#undef PG8_WAIT_L
#undef PG8_BAR
#undef PG8_SCHED
}
}
using pg8::Unit;

__device__ __forceinline__ u32x4 pack8(const f32x4 a, const f32x4 b) { u32x4 w; w.x = cvt_pk_bf16(a[0], a[1]); w.y = cvt_pk_bf16(a[2], a[3]); w.z = cvt_pk_bf16(b[0], b[1]); w.w = cvt_pk_bf16(b[2], b[3]); return w; }
__device__ __forceinline__ f32x4 rot2(const f32x4 v, const f32x4 cs) { f32x4 o; o[0] = v[0] * cs[0] - v[1] * cs[1]; o[1] = v[1] * cs[0] + v[0] * cs[1]; o[2] = v[2] * cs[2] - v[3] * cs[3]; o[3] = v[3] * cs[2] + v[2] * cs[3]; return o; }

__device__ __forceinline__ f32x4 mla_cs(const float* tabm, int t, int c4) {
    const int p0 = c4 >> 1; const int pos = (p0 < 16) ? (t >> 6) : (t & 63); const int f = p0 & 15;
    return *(const f32x4*)(tabm + ((size_t)pos * 16 + f) * 2);
}

struct EpiG1 {
    static constexpr bool PERM = true, PROBE2 = false;
    bf16* QKVL; float* SSQ; bf16* KR; const float* tabm;
    __device__ __forceinline__ void operator()(const f32x4 (&acc)[2][2][4][2], const Unit& u, int wr, int wc, int fr, int fq) const {
        const int row0 = u.pm * 256 + wr * 64 + fr;
        if (u.pn < 4) {
            const int col0 = u.pn * 256 + wc * 32 + 8 * fq;
#pragma unroll
            for (int ai = 0; ai < 2; ++ai)
#pragma unroll
                for (int m = 0; m < 4; ++m) { const int row = row0 + ai * 128 + m * 16; float ss = 0.f;
#pragma unroll
                    for (int bj = 0; bj < 2; ++bj) { const f32x4 v0 = acc[ai][bj][m][0], v1 = acc[ai][bj][m][1];
                        ss += (v0[0] * v0[0] + v0[1] * v0[1]) + (v0[2] * v0[2] + v0[3] * v0[3]) + (v1[0] * v1[0] + v1[1] * v1[1]) + (v1[2] * v1[2] + v1[3] * v1[3]);
                        *(u32x4*)(QKVL + (size_t)row * N1 + col0 + bj * 128) = pack8(v0, v1); }
                    { const int ln_ = fr + 16 * fq; ss += shfl_xor_l(ss, 16, ln_); ss += shfl_xor_l(ss, 32, ln_); }
                    if (fq == 0) SSQ[(size_t)row * 16 + u.pn * 4 + wc] = ss; asm volatile("" ::: "memory"); }
        } else if (wc < 2) {
            const int c8 = wc * 32 + 8 * fq;
#pragma unroll
            for (int ai = 0; ai < 2; ++ai)
#pragma unroll
                for (int m = 0; m < 4; ++m) { const int row = row0 + ai * 128 + m * 16; f32x4 v0 = acc[ai][0][m][0], v1 = acc[ai][0][m][1];
                    if (row < MX) { const int t = row & (SEQ - 1); v0 = rot2(v0, mla_cs(tabm, t, c8)); v1 = rot2(v1, mla_cs(tabm, t, c8 + 4)); }
                    *(u32x4*)(KR + (size_t)row * 64 + c8) = pack8(v0, v1); asm volatile("" ::: "memory"); }
        }
    }
};
struct EpiUq {
    static constexpr bool PERM = true, PROBE2 = false;
    bf16* Q; const float* SSQ; const float* tabm;
    __device__ __forceinline__ void operator()(const f32x4 (&acc)[2][2][4][2], const Unit& u, int wr, int wc, int fr, int fq) const {
        const int row0 = u.pm * 256 + wr * 64 + fr;
        int col8[2], dd[2];
#pragma unroll
        for (int bj = 0; bj < 2; ++bj) { col8[bj] = u.pn * 256 + bj * 128 + wc * 32 + 8 * fq; dd[bj] = col8[bj] % DQ; }
#pragma unroll
        for (int ai = 0; ai < 2; ++ai)
#pragma unroll
            for (int m = 0; m < 4; ++m) { const int row = row0 + ai * 128 + m * 16;
                const f32x4 s0 = *(const f32x4*)(SSQ + (size_t)row * 16), s1 = *(const f32x4*)(SSQ + (size_t)row * 16 + 4);
                const float ss = ((s0[0] + s0[1]) + (s0[2] + s0[3])) + ((s1[0] + s1[1]) + (s1[2] + s1[3]));
                const float r = 1.0f / sqrtf(ss * (1.0f / QR) + NORM_EPS);
#pragma unroll
                for (int bj = 0; bj < 2; ++bj) { f32x4 v0 = acc[ai][bj][m][0] * r, v1 = acc[ai][bj][m][1] * r;
                    if (dd[bj] >= NOPE && row < MX) { const int t = row & (SEQ - 1), c8 = dd[bj] - NOPE; v0 = rot2(v0, mla_cs(tabm, t, c8)); v1 = rot2(v1, mla_cs(tabm, t, c8 + 4)); }
                    *(u32x4*)(Q + (size_t)row * 3072 + col8[bj]) = pack8(v0, v1); } asm volatile("" ::: "memory"); }
    }
};
struct EpiUkv {
    static constexpr bool PERM = true, PROBE2 = false;
    bf16* KV; const float* SSQ;
    __device__ __forceinline__ void operator()(const f32x4 (&acc)[2][2][4][2], const Unit& u, int wr, int wc, int fr, int fq) const {
        const int row0 = u.pm * 256 + wr * 64 + fr; const int col0 = u.pn * 256 + wc * 32 + 8 * fq;
#pragma unroll
        for (int ai = 0; ai < 2; ++ai)
#pragma unroll
            for (int m = 0; m < 4; ++m) { const int row = row0 + ai * 128 + m * 16;
                const f32x4 s0 = *(const f32x4*)(SSQ + (size_t)row * 16 + 8), s1 = *(const f32x4*)(SSQ + (size_t)row * 16 + 12);
                const float ss = ((s0[0] + s0[1]) + (s0[2] + s0[3])) + ((s1[0] + s1[1]) + (s1[2] + s1[3]));
                const float r = 1.0f / sqrtf(ss * (1.0f / KVR) + NORM_EPS);
#pragma unroll
                for (int bj = 0; bj < 2; ++bj) *(u32x4*)(KV + (size_t)row * 4096 + col0 + bj * 128) = pack8(acc[ai][bj][m][0] * r, acc[ai][bj][m][1] * r); asm volatile("" ::: "memory"); }
    }
};
struct EpiResid {
    static constexpr bool PERM = false, PROBE2 = false;
    const float* xin; float* xout; const float* cin; float* cout; const float* modv; int gofs;
    __device__ __forceinline__ void operator()(const f32x4 (&acc)[2][2][4][2], const Unit& u, int wr, int wc, int fr, int fq) const {
        const bool isx = u.pm < (MX / 256);
        const int rloc = (isx ? u.pm * 256 : (u.pm * 256 - MX)) + wr * 64 + fr;
        const float* base = isx ? xin : cin; float* out = isx ? xout : cout;
        const float* gv = modv + (size_t)(isx ? (u.pm >> 4) : 8) * NMOD + gofs;
        const int col0 = u.pn * 256 + wc * 32 + 4 * fq;
        f32x4 g4[2][2];
#pragma unroll
        for (int bj = 0; bj < 2; ++bj)
#pragma unroll
            for (int n = 0; n < 2; ++n) g4[bj][n] = *(const f32x4*)(gv + col0 + bj * 128 + n * 16);
#pragma unroll
        for (int ai = 0; ai < 2; ++ai)
#pragma unroll
            for (int m = 0; m < 4; ++m) { const size_t off = (size_t)(rloc + ai * 128 + m * 16) * D + col0;
#pragma unroll
                for (int bj = 0; bj < 2; ++bj)
#pragma unroll
                    for (int n = 0; n < 2; ++n) { const f32x4 b = *(const f32x4*)(base + off + bj * 128 + n * 16); *(f32x4*)(out + off + bj * 128 + n * 16) = b + g4[bj][n] * acc[ai][bj][m][n]; }
                if (m & 1) asm volatile("" ::: "memory"); }
    }
};
template <int CTRL> __device__ __forceinline__ float dpp1(float x) { return __int_as_float(__builtin_amdgcn_update_dpp(0, __float_as_int(x), CTRL, 0xF, 0xF, false)); }
__device__ __forceinline__ f32x4 row_prev(const f32x4 v) { f32x4 o; o.x = dpp1<0x121>(v.x); o.y = dpp1<0x121>(v.y); o.z = dpp1<0x121>(v.z); o.w = dpp1<0x121>(v.w); return o; }
__device__ __forceinline__ f32x4 row_next(const f32x4 v) { f32x4 o; o.x = dpp1<0x12F>(v.x); o.y = dpp1<0x12F>(v.y); o.z = dpp1<0x12F>(v.z); o.w = dpp1<0x12F>(v.w); return o; }
__device__ __forceinline__ f32x4 silu4(const f32x4 v) { f32x4 o;
#pragma unroll
    for (int e = 0; e < 4; ++e) o[e] = fast_silu(v[e]); return o; }
constexpr size_t HALO_STRIDE = (size_t)FF;
struct EpiGUConv {
    static constexpr bool PERM = true, PROBE2 = true;
    bf16* ACT; float* HALO; const float* cw; const float* cb; LAS float* edge;
    __device__ __forceinline__ void operator()(const f32x4 (&acc)[2][2][4][2], const Unit& u, int wr, int wc, int fr, int fq) const {
        const int c8 = wc * 32 + 8 * fq; const int f0 = u.pn * 128 + c8;
#pragma unroll
        for (int ai = 0; ai < 2; ++ai) { const int blk = 2 * ai + wr;
            if (fr == 0)  { *(LAS f32x4*)(edge + (blk * 2 + 0) * 128 + c8) = acc[ai][0][0][0]; *(LAS f32x4*)(edge + (blk * 2 + 0) * 128 + c8 + 4) = acc[ai][0][0][1]; }
            if (fr == 15) { *(LAS f32x4*)(edge + (blk * 2 + 1) * 128 + c8) = acc[ai][0][3][0]; *(LAS f32x4*)(edge + (blk * 2 + 1) * 128 + c8 + 4) = acc[ai][0][3][1]; } }
        asm volatile("s_waitcnt lgkmcnt(0)" ::: "memory"); __builtin_amdgcn_s_barrier(); asm volatile("" ::: "memory");
        f32x4 w0[2], w1[2], w2[2], bb[2];
#pragma unroll
        for (int n = 0; n < 2; ++n) { w0[n] = *(const f32x4*)(cw + f0 + 4 * n); w1[n] = *(const f32x4*)(cw + FF + f0 + 4 * n); w2[n] = *(const f32x4*)(cw + 2 * FF + f0 + 4 * n); bb[n] = *(const f32x4*)(cb + f0 + 4 * n); }
        const f32x4 zero4 = {0.f, 0.f, 0.f, 0.f};
#pragma unroll
        for (int ai = 0; ai < 2; ++ai) { const int blk = 2 * ai + wr;
#pragma unroll
            for (int m = 0; m < 4; ++m) { const int row = u.pm * 256 + ai * 128 + wr * 64 + m * 16 + fr; f32x4 o[2];
#pragma unroll
                for (int n = 0; n < 2; ++n) { const f32x4 cur = acc[ai][0][m][n];
                    f32x4 b, d;
                    if (m > 0) b = row_prev(acc[ai][0][m - 1][n]); else b = (blk > 0) ? *(const LAS f32x4*)(edge + ((blk - 1) * 2 + 1) * 128 + c8 + 4 * n) : zero4;
                    if (m < 3) d = row_next(acc[ai][0][m + 1][n]); else d = (blk < 3) ? *(const LAS f32x4*)(edge + ((blk + 1) * 2 + 0) * 128 + c8 + 4 * n) : zero4;
                    const f32x4 a = row_prev(cur), c = row_next(cur);
                    const f32x4 up = (fr == 0) ? b : a, dn = (fr == 15) ? d : c;
                    const f32x4 cv = w0[n] * up + w1[n] * cur + w2[n] * dn + bb[n]; const f32x4 uu = acc[ai][1][m][n];
                    o[n] = silu4(cv) * uu;
                    if (m == 0 && blk == 0 && fr == 0) { float* hp = HALO + (size_t)((u.pm * 2 + 0) * 3) * HALO_STRIDE + f0 + 4 * n; *(f32x4*)hp = cv; *(f32x4*)(hp + HALO_STRIDE) = cur; *(f32x4*)(hp + 2 * HALO_STRIDE) = uu; }
                    if (m == 3 && blk == 3 && fr == 15) { float* hp = HALO + (size_t)((u.pm * 2 + 1) * 3) * HALO_STRIDE + f0 + 4 * n; *(f32x4*)hp = cv; *(f32x4*)(hp + HALO_STRIDE) = cur; *(f32x4*)(hp + 2 * HALO_STRIDE) = uu; } }
                *(u32x4*)(ACT + (size_t)row * FF + f0) = pack8(o[0], o[1]); asm volatile("" ::: "memory"); } }
        asm volatile("s_waitcnt lgkmcnt(0)" ::: "memory"); __builtin_amdgcn_s_barrier(); asm volatile("" ::: "memory");
    }
};
struct EpiQKV {
    static constexpr bool PERM = true, PROBE2 = false;
    bf16* QKV; const float* tabr;
    __device__ __forceinline__ void operator()(const f32x4 (&acc)[2][2][4][2], const Unit& u, int wr, int wc, int fr, int fq) const {
        const int row0 = u.pm * 256 + wr * 64 + fr; const int col0 = u.pn * 256 + wc * 32 + 8 * fq;
        const bool rope = (u.pn < 16) && (u.pm < MX / 256);
#pragma unroll
        for (int ai = 0; ai < 2; ++ai)
#pragma unroll
            for (int m = 0; m < 4; ++m) { const int row = row0 + ai * 128 + m * 16;
#pragma unroll
                for (int bj = 0; bj < 2; ++bj) { f32x4 v0 = acc[ai][bj][m][0], v1 = acc[ai][bj][m][1]; const int col = col0 + bj * 128;
                    if (rope) { const int t = row & (SEQ - 1); const float* tp = tabr + ((size_t)t * 128 + ((col & 255) >> 1)) * 2;
                        v0 = rot2(v0, *(const f32x4*)tp); v1 = rot2(v1, *(const f32x4*)(tp + 4)); }
                    *(u32x4*)(QKV + (size_t)row * 8192 + col) = pack8(v0, v1); } asm volatile("" ::: "memory"); }
    }
};
struct EpiGate {
    static constexpr bool PERM = true, PROBE2 = false;
    bf16* GATED; const bf16* YF; const bf16* YB; const float* ST;
    __device__ __forceinline__ void operator()(const f32x4 (&acc)[2][2][4][2], const Unit& u, int wr, int wc, int fr, int fq) const {
        const int row0 = u.pm * 256 + wr * 64 + fr; const int f0 = u.pn * 128 + wc * 32 + 8 * fq; const int hd = u.pn >> 2;
#pragma unroll
        for (int ai = 0; ai < 2; ++ai)
#pragma unroll
            for (int m = 0; m < 4; ++m) { const int row = row0 + ai * 128 + m * 16; const size_t off = (size_t)row * 4096 + f0;
                const u32x4 yf = *(const u32x4*)(YF + off), yb = *(const u32x4*)(YB + off);
                const f32x2 sf = *(const f32x2*)(ST + ((size_t)row * 8 + hd) * 2), sb = *(const f32x2*)(ST + ((size_t)(MT + row) * 8 + hd) * 2);
                const f32x4 a0 = acc[ai][0][m][0], a1 = acc[ai][0][m][1], b0 = acc[ai][1][m][0], b1 = acc[ai][1][m][1];
#define NF(w, hi_) (((hi_ ? bfhi(w) : bflo(w)) - sf[0]) * sf[1])
#define NB(w, hi_) (((hi_ ? bfhi(w) : bflo(w)) - sb[0]) * sb[1])
                f32x4 o0, o1;
                o0[0] = fast_silu(a0[0]) * NF(yf.x, 0) + fast_silu(b0[0]) * NB(yb.x, 0); o0[1] = fast_silu(a0[1]) * NF(yf.x, 1) + fast_silu(b0[1]) * NB(yb.x, 1);
                o0[2] = fast_silu(a0[2]) * NF(yf.y, 0) + fast_silu(b0[2]) * NB(yb.y, 0); o0[3] = fast_silu(a0[3]) * NF(yf.y, 1) + fast_silu(b0[3]) * NB(yb.y, 1);
                o1[0] = fast_silu(a1[0]) * NF(yf.z, 0) + fast_silu(b1[0]) * NB(yb.z, 0); o1[1] = fast_silu(a1[1]) * NF(yf.z, 1) + fast_silu(b1[1]) * NB(yb.z, 1);
                o1[2] = fast_silu(a1[2]) * NF(yf.w, 0) + fast_silu(b1[2]) * NB(yb.w, 0); o1[3] = fast_silu(a1[3]) * NF(yf.w, 1) + fast_silu(b1[3]) * NB(yb.w, 1);
#undef NF
#undef NB
                *(u32x4*)(GATED + off) = pack8(o0, o1); asm volatile("" ::: "memory"); }
    }
};

namespace att {
constexpr int NW = 8, QBLK = 32, KVBLK = 64;
constexpr int SHM_V = 16384, SHM_KN = 16384, SHM_KR = 8192;
constexpr int OFF_V = 0, OFF_KN = 3 * SHM_V, OFF_KR = OFF_KN + 2 * SHM_KN, OFF_WS = OFF_KR + 2 * SHM_KR, SHM_ATTN = OFF_WS + NW * 64 * 4;
constexpr float THR2 = 11.5f;
#define KSWZ(row, colB) ((row) * 256 + ((colB) ^ (((row) & 7) << 4)))
#define KRSWZ(row, colB) ((row) * 128 + ((colB) ^ ((((row) >> 1) & 7) << 4)))
#define SBAR() __builtin_amdgcn_sched_barrier(0)
__device__ __forceinline__ int crow(int r, int hi) { return (r & 3) + 8 * (r >> 2) + 4 * hi; }
__device__ __forceinline__ void partialSM(f32x16& p0, f32x16& p1, float& m_reg, float& alpha) {
  float pmax = p0[0];
#pragma unroll
  for (int r = 1; r < 16; ++r) pmax = fmaxf(pmax, p0[r]);
#pragma unroll
  for (int r = 0; r < 16; ++r) pmax = fmaxf(pmax, p1[r]);
  { auto rr = __builtin_amdgcn_permlane32_swap(__float_as_uint(pmax), __float_as_uint(pmax), false, false); pmax = fmaxf(__uint_as_float(rr[0]), __uint_as_float(rr[1])); }
  float mn;
  if (__builtin_expect(__all(pmax - m_reg <= THR2), 1)) { mn = m_reg; alpha = 1.f; }
  else { mn = fmaxf(m_reg, pmax); alpha = __builtin_amdgcn_exp2f(m_reg - mn); m_reg = mn; }
#pragma unroll
  for (int r = 0; r < 16; ++r) p0[r] = p0[r] - mn;
#pragma unroll
  for (int r = 0; r < 16; ++r) p1[r] = p1[r] - mn;
#pragma unroll
  for (int r = 0; r < 16; ++r) p0[r] = __builtin_amdgcn_exp2f(p0[r]);
}
__device__ __forceinline__ void finishSM(f32x16& p0, f32x16& p1, float alpha, float& l_reg, bf16x8& pa0, bf16x8& pa1, bf16x8& pa2, bf16x8& pa3) {
#pragma unroll
  for (int r = 0; r < 16; ++r) p1[r] = __builtin_amdgcn_exp2f(p1[r]);
  float ps = 0;
#pragma unroll
  for (int r = 0; r < 16; ++r) ps += p0[r];
#pragma unroll
  for (int r = 0; r < 16; ++r) ps += p1[r];
  { auto rr = __builtin_amdgcn_permlane32_swap(__float_as_uint(ps), __float_as_uint(ps), false, false); ps = __uint_as_float(rr[0]) + __uint_as_float(rr[1]); }
  l_reg = l_reg * alpha + ps;
#define PK4(P, BASE, OUT) do { unsigned a0 = cvt_pk_bf16(P[BASE + 0], P[BASE + 1]), a1 = cvt_pk_bf16(P[BASE + 2], P[BASE + 3]);   \
    unsigned b0 = cvt_pk_bf16(P[BASE + 4], P[BASE + 5]), b1 = cvt_pk_bf16(P[BASE + 6], P[BASE + 7]);                              \
    auto r0 = __builtin_amdgcn_permlane32_swap(a0, b0, false, false); auto r1 = __builtin_amdgcn_permlane32_swap(a1, b1, false, false); \
    u32x4 w = {r0[0], r1[0], r0[1], r1[1]}; OUT = __builtin_bit_cast(bf16x8, w); } while (0)
  PK4(p0, 0, pa0); PK4(p0, 8, pa1); PK4(p1, 0, pa2); PK4(p1, 8, pa3);
#undef PK4
}
__device__ __forceinline__ void qkt(f32x16& p0, f32x16& p1, const char* Kn, const char* Kr, const bf16x8* qr, int r32, int hi) {
  p0 = f32x16{}; p1 = f32x16{};
#pragma unroll
  for (int d0 = 0; d0 < 8; ++d0) { const int cb = (d0 * 16 + hi * 8) * 2;
    const bf16x8 b0 = *reinterpret_cast<const bf16x8*>(Kn + KSWZ(r32, cb));
    const bf16x8 b1 = *reinterpret_cast<const bf16x8*>(Kn + KSWZ(32 + r32, cb));
    p0 = __builtin_amdgcn_mfma_f32_32x32x16_bf16(b0, qr[d0], p0, 0, 0, 0);
    p1 = __builtin_amdgcn_mfma_f32_32x32x16_bf16(b1, qr[d0], p1, 0, 0, 0); }
#pragma unroll
  for (int d0 = 0; d0 < 4; ++d0) { const int cb = (d0 * 16 + hi * 8) * 2;
    const bf16x8 b0 = *reinterpret_cast<const bf16x8*>(Kr + KRSWZ(r32, cb));
    const bf16x8 b1 = *reinterpret_cast<const bf16x8*>(Kr + KRSWZ(32 + r32, cb));
    p0 = __builtin_amdgcn_mfma_f32_32x32x16_bf16(b0, qr[8 + d0], p0, 0, 0, 0);
    p1 = __builtin_amdgcn_mfma_f32_32x32x16_bf16(b1, qr[8 + d0], p1, 0, 0, 0); }
}
__device__ __forceinline__ int v_st(int k, int c) { const int kk = (k & ~0xC) | ((k & 4) << 1) | ((k & 8) >> 1); return ((kk >> 3) * 4 + (c >> 5)) * 512 + ((kk & 7) * 32 + (c & 31)) * 2; }
__device__ __forceinline__ int v_rd_base(int lane) { return ((lane & 3) << 3) | (((lane >> 2) & 3) << 6) | (((lane >> 4) & 1) << 5) | (((lane >> 5) & 1) << 8); }
constexpr int v_rd_off(int d0, int ks, int half) { return d0 * 512 + ks * 4096 + half * 2048; }
template <int OFF> __device__ __forceinline__ s16x4 tr_read(int vb) { s16x4 r; asm volatile("ds_read_b64_tr_b16 %0, %1 offset:%2" : "=&v"(r) : "v"(vb), "i"(OFF) : "memory"); return r; }
template <int D0> __device__ __forceinline__ void pv_one(f32x16& od, int vb, bf16x8 pa0, bf16x8 pa1, bf16x8 pa2, bf16x8 pa3) {
  const s16x4 l0 = tr_read<v_rd_off(D0, 0, 0)>(vb), h0 = tr_read<v_rd_off(D0, 0, 1)>(vb), l1 = tr_read<v_rd_off(D0, 1, 0)>(vb), h1 = tr_read<v_rd_off(D0, 1, 1)>(vb);
  const s16x4 l2 = tr_read<v_rd_off(D0, 2, 0)>(vb), h2 = tr_read<v_rd_off(D0, 2, 1)>(vb), l3 = tr_read<v_rd_off(D0, 3, 0)>(vb), h3 = tr_read<v_rd_off(D0, 3, 1)>(vb);
  asm volatile("s_waitcnt lgkmcnt(0)" ::: "memory"); SBAR();
#define PK(L, H) (bf16x8){L[0], L[1], L[2], L[3], H[0], H[1], H[2], H[3]}
  od = __builtin_amdgcn_mfma_f32_32x32x16_bf16(pa0, PK(l0, h0), od, 0, 0, 0);
  od = __builtin_amdgcn_mfma_f32_32x32x16_bf16(pa1, PK(l1, h1), od, 0, 0, 0);
  od = __builtin_amdgcn_mfma_f32_32x32x16_bf16(pa2, PK(l2, h2), od, 0, 0, 0);
  od = __builtin_amdgcn_mfma_f32_32x32x16_bf16(pa3, PK(l3, h3), od, 0, 0, 0);
#undef PK
}
__device__ __forceinline__ void pv_d0(f32x16* o, int vb, bf16x8 pa0, bf16x8 pa1, bf16x8 pa2, bf16x8 pa3) {
  pv_one<0>(o[0], vb, pa0, pa1, pa2, pa3); pv_one<1>(o[1], vb, pa0, pa1, pa2, pa3); pv_one<2>(o[2], vb, pa0, pa1, pa2, pa3); pv_one<3>(o[3], vb, pa0, pa1, pa2, pa3);
}
__device__ __forceinline__ void attn_unit(const bf16* __restrict__ Qb, const bf16* __restrict__ KVh, const bf16* __restrict__ KRp, bf16* __restrict__ Ob,
                                          int NT, int nc, int cbase, int xbase, char* lds) {
  int tid = threadIdx.x; asm volatile("" : "+v"(tid));
  const int wid = __builtin_amdgcn_readfirstlane(tid >> 6), lane = tid & 63, r32 = lane & 31, hi = lane >> 5;
  char* V_lds = lds + OFF_V; char* Kn_lds = lds + OFF_KN; char* Kr_lds = lds + OFF_KR;
  float* ws = (float*)(lds + OFF_WS) + wid * 64; float* li_l = ws; float* al_l = ws + 32;
  float m_reg = -1e30f, l_reg = 0; f32x16 o[4] = {}; bf16x8 qr[12];
  const bf16* Qw = Qb + (long)(wid * QBLK + r32) * 3072 + hi * 8;
#pragma unroll
  for (int d0 = 0; d0 < 12; ++d0) qr[d0] = *reinterpret_cast<const bf16x8*>(Qw + d0 * 16);
  const int vb0 = (int)(uintptr_t)V_lds + v_rd_base(lane);
  unsigned vofK[2], vofV[2], vofR;
#pragma unroll
  for (int i = 0; i < 2; ++i) { const int pc = wid * 2 + i;
      { const int row = pc * 4 + (lane >> 4), ch = (lane & 15) ^ (row & 7); vofK[i] = (unsigned)((row * 4096 + ch * 8) * 2); }
      { const int ob = pc * 1024 + lane * 16, st = ob >> 9, w = ob & 511, kk = (st >> 2) * 8 + (w >> 6); const int k = (kk & ~0xC) | ((kk & 4) << 1) | ((kk & 8) >> 1);
        const int c = (st & 3) * 32 + 8 * ((w & 63) >> 4); vofV[i] = (unsigned)((k * 4096 + 128 + c) * 2); } }
  { const int row = wid * 8 + (lane >> 3), ch = (lane & 7) ^ ((row >> 1) & 7); vofR = (unsigned)((row * 64 + ch * 8) * 2); }
  const unsigned ldsK = (unsigned)__builtin_amdgcn_readfirstlane((unsigned)(uintptr_t)Kn_lds + (unsigned)wid * 2048u);
  const unsigned ldsV = (unsigned)__builtin_amdgcn_readfirstlane((unsigned)(uintptr_t)V_lds + (unsigned)wid * 2048u);
  const unsigned ldsR = (unsigned)__builtin_amdgcn_readfirstlane((unsigned)(uintptr_t)Kr_lds + (unsigned)wid * 1024u);
#define KROW(j) ((j) < nc ? cbase + (j) * KVBLK : xbase + ((j) - nc) * KVBLK)
#define DMA_TILE(j, kslot, vslot) do { const long k0_ = KROW(j); const char* kb_ = uni_ptr(KVh + k0_ * 4096); const char* rb_ = uni_ptr(KRp + k0_ * 64); \
    glds16_s(kb_, vofK[0], ldsK + (kslot) * SHM_KN); glds16_s(kb_, vofK[1], ldsK + (kslot) * SHM_KN + 1024u); \
    glds16_s(rb_, vofR, ldsR + (kslot) * SHM_KR); \
    glds16_s(kb_, vofV[0], ldsV + (vslot) * SHM_V); glds16_s(kb_, vofV[1], ldsV + (vslot) * SHM_V + 1024u); } while (0)
#ifndef ATT_SKEW
#define ATT_SKEW 0
#endif
#define WAIT_SYNC() do { asm volatile("s_waitcnt vmcnt(0)" ::: "memory"); __syncthreads(); if (ATT_SKEW && wid >= 4) __builtin_amdgcn_s_sleep(ATT_SKEW); } while (0)
#define RESC(a) do { if (__any((a) < 1.f)) { if (hi == 0) al_l[r32] = (a); asm volatile("s_waitcnt lgkmcnt(0)" ::: "memory"); \
    _Pragma("unroll") for (int d = 0; d < 4; ++d) _Pragma("unroll") for (int r = 0; r < 16; ++r) o[d][r] *= al_l[crow(r, hi)]; } } while (0)
  f32x16 pA0, pA1, pB0, pB1; float alA, alB; bf16x8 pa0, pa1, pa2, pa3;
  DMA_TILE(0, 0, 0); DMA_TILE(1, 1, 1); WAIT_SYNC();
  qkt(pA0, pA1, Kn_lds, Kr_lds, qr, r32, hi); partialSM(pA0, pA1, m_reg, alA);
  __syncthreads();
  int vprev = 0, vcur = 1, vnext = 2;
  for (int j = 1; j + 1 < NT; j += 2) {
    DMA_TILE(j + 1, 0, vnext);
    SBAR(); qkt(pB0, pB1, Kn_lds + SHM_KN, Kr_lds + SHM_KR, qr, r32, hi);
    finishSM(pA0, pA1, alA, l_reg, pa0, pa1, pa2, pa3); SBAR();
    pv_d0(o, vb0 + vprev * SHM_V, pa0, pa1, pa2, pa3); partialSM(pB0, pB1, m_reg, alB);
    RESC(alB); WAIT_SYNC();
    { const int t_ = vprev; vprev = vcur; vcur = vnext; vnext = t_; }
    if (j + 2 < NT) DMA_TILE(j + 2, 1, vnext);
    SBAR(); qkt(pA0, pA1, Kn_lds, Kr_lds, qr, r32, hi);
    finishSM(pB0, pB1, alB, l_reg, pa0, pa1, pa2, pa3); SBAR();
    pv_d0(o, vb0 + vprev * SHM_V, pa0, pa1, pa2, pa3); partialSM(pA0, pA1, m_reg, alA);
    RESC(alA); WAIT_SYNC();
    { const int t_ = vprev; vprev = vcur; vcur = vnext; vnext = t_; }
  }
  SBAR(); qkt(pB0, pB1, Kn_lds + SHM_KN, Kr_lds + SHM_KR, qr, r32, hi);
  finishSM(pA0, pA1, alA, l_reg, pa0, pa1, pa2, pa3); SBAR();
  pv_d0(o, vb0 + vprev * SHM_V, pa0, pa1, pa2, pa3); partialSM(pB0, pB1, m_reg, alB);
  RESC(alB);
  finishSM(pB0, pB1, alB, l_reg, pa0, pa1, pa2, pa3); SBAR();
  pv_d0(o, vb0 + vcur * SHM_V, pa0, pa1, pa2, pa3);
  if (hi == 0) li_l[r32] = l_reg; asm volatile("s_waitcnt lgkmcnt(0)" ::: "memory");
  float rli[16];
#pragma unroll
  for (int r = 0; r < 16; ++r) rli[r] = __builtin_amdgcn_rcpf(li_l[crow(r, hi)]);
  bf16* Ow = Ob + (long)(wid * QBLK) * 2048;
#pragma unroll
  for (int r = 0; r < 16; ++r) { const int orow = crow(r, hi);
#pragma unroll
    for (int d0 = 0; d0 < 4; ++d0) Ow[(long)orow * 2048 + d0 * 32 + r32] = (bf16)(cvt_pk_bf16(o[d0][r] * rli[r], 0.f) & 0xffffu); }
  __syncthreads();
#undef KROW
#undef DMA_TILE
#undef WAIT_SYNC
#undef RESC
}
#undef SBAR
}

namespace scan {
constexpr int CH = 64;
constexpr int OFF_Q = 0, OFF_K = 32768  , OFF_V = 98304, OFF_P = 131072, SHM_SCAN = 131072 + 8192;
__device__ __forceinline__ unsigned off_b(unsigned row, unsigned ch) { return 256u * row + 16u * (ch ^ (((row & 3) << 2) | ((row >> 2) & 3))); }
__device__ __forceinline__ unsigned p_off(unsigned i, unsigned chunk) { return 128u * i + 16u * (chunk ^ ((i >> 1) & 7)); }
__device__ __forceinline__ int crow(int r, int hi) { return (r & 3) + 8 * (r >> 2) + 4 * hi; }
__device__ __forceinline__ s16x4 vtr(const LAS char* p) { typedef short v4i16_t __attribute__((ext_vector_type(4))); return __builtin_bit_cast(s16x4, __builtin_amdgcn_ds_read_tr16_b64_v4i16((LAS v4i16_t*)p)); }
__device__ __forceinline__ bf16x8 tr_frag(const LAS char* img, int lane, int c, int ks) {
    const unsigned h = lane >> 5, blk = (lane >> 4) & 1, q = (lane & 15) >> 2, p = lane & 3;
    const unsigned r0 = 16 * ks + 8 * h + q, chn = 4 * c + 2 * blk + (p >> 1);
    const s16x4 lo = vtr(img + off_b(r0, chn) + 8 * (p & 1)), hi = vtr(img + off_b(r0 + 4, chn) + 8 * (p & 1));
    return (bf16x8){lo[0], lo[1], lo[2], lo[3], hi[0], hi[1], hi[2], hi[3]};
}
__device__ __forceinline__ bf16x8 pack_step(const f32x16& x, int s) {
    u32x4 p; p.x = cvt_pk_bf16(x[8 * s + 0], x[8 * s + 1]); p.y = cvt_pk_bf16(x[8 * s + 2], x[8 * s + 3]); p.z = cvt_pk_bf16(x[8 * s + 4], x[8 * s + 5]); p.w = cvt_pk_bf16(x[8 * s + 6], x[8 * s + 7]);
    return __builtin_bit_cast(bf16x8, p);
}
__device__ __forceinline__ void dma_mat(const bf16* src, int ld, LAS unsigned char* dst, int wid, int lane) {
    const char* sb = uni_ptr(src); const unsigned d0 = (unsigned)__builtin_amdgcn_readfirstlane((unsigned)(uintptr_t)dst + (unsigned)wid * 4096u);
#pragma unroll
    for (int k = 0; k < 4; ++k) { const int pc = wid * 4 + k, img = pc >> 4, row = 4 * (pc & 15) + (lane >> 4), pos = lane & 15;
        const int ch = pos ^ (((row & 3) << 2) | ((row >> 2) & 3));
        glds16_s(sb, (unsigned)((row * ld + img * 128 + ch * 8) * 2), d0 + (unsigned)k * 1024u); }
}
__device__ __forceinline__ int scan_rowbase(int n, int b, int dir) { return (n < 4) ? MX + b * CTXL + (dir ? 3 - n : n) * CH : b * SEQ + (dir ? 67 - n : n - 4) * CH; }
__device__ __forceinline__ float uni_f(float x) { return __uint_as_float(__builtin_amdgcn_readfirstlane(__float_as_uint(x))); }
typedef const LAS s16x4* lds_s4p;
__device__ __forceinline__ void scan_unit(const bf16* __restrict__ QKV, bf16* __restrict__ Y, int b, int hd, int dir, int dvh, float lg2, bool skip_ctx_y, LAS unsigned char* lds) {
    int tid = threadIdx.x; asm volatile("" : "+v"(tid));
    const int wid = __builtin_amdgcn_readfirstlane(tid >> 6), lane0 = tid & 63;
    const LAS char* QI = (const LAS char*)lds + OFF_Q; const LAS char* VI = (const LAS char*)lds + OFF_V;
    LAS char* PI = (LAS char*)lds + OFF_P;
    f32x16 S[8];
#pragma unroll
    for (int i = 0; i < 8; ++i) S[i] = f32x16{};
    const float lgr = dir ? -lg2 : lg2;
    const float g64 = uni_f(__builtin_amdgcn_exp2f(64.f * lg2));
    const float R1 = uni_f(__builtin_amdgcn_exp2f(lgr)), R8 = uni_f(__builtin_amdgcn_exp2f(8.f * lgr)), R32 = uni_f(__builtin_amdgcn_exp2f(32.f * lgr));
    const float Rm1 = uni_f(__builtin_amdgcn_exp2f(-lgr)), Rm16 = uni_f(__builtin_amdgcn_exp2f(-16.f * lgr));
    const float c0 = uni_f(dir ? g64 : __builtin_amdgcn_exp2f(lg2)), z0 = uni_f(dir ? 1.0f : __builtin_amdgcn_exp2f(63.f * lg2));
    const int qcol = hd * RDK, kcol = 2048 + hd * RDK, vcol = 4096 + hd * RDV + dvh * 256;
    { const bf16* src = QKV + (size_t)scan_rowbase(0, b, dir) * 8192;
      dma_mat(src + qcol, 8192, lds + OFF_Q, wid, lane0); dma_mat(src + kcol, 8192, lds + OFF_K, wid, lane0); dma_mat(src + vcol, 8192, lds + OFF_V, wid, lane0);
      asm volatile("s_waitcnt vmcnt(0)" ::: "memory"); __syncthreads(); }
    for (int n = 0; n < 68; ++n) {
        int lane = lane0; asm volatile("" : "+v"(lane));
        const int r = lane & 31, h = lane >> 5, fr = lane & 15, fq = lane >> 4;
        const int rowbase = scan_rowbase(n, b, dir);
        const bool more = n + 1 < 68;
        const bf16* nsrc = QKV + (size_t)scan_rowbase(more ? n + 1 : n, b, dir) * 8192;
        const LAS char* KI = (const LAS char*)lds + OFF_K + (n & 1) * 32768;
        if (more) dma_mat(nsrc + kcol, 8192, lds + OFF_K + ((n + 1) & 1) * 32768, wid, lane);
        const float LR = c0 * __builtin_amdgcn_exp2f((float)(4 * h) * lgr), LZ = z0 * __builtin_amdgcn_exp2f((float)(-8 * h) * lgr), LP = __builtin_amdgcn_exp2f((float)(fr - 4 * fq) * lgr);
        { const int fH = fr & 3, fL = (fr >> 2) & 3; const int AL = 256 * fr + 16 * (fq ^ fL);
          int AH[4];
#pragma unroll
          for (int k = 0; k < 4; ++k) AH[k] = 64 * (k ^ fH);
#pragma unroll
          for (int tix = 0; tix < 2; ++tix) { const int tt = wid * 2 + tix, jt = tt >> 2, it = tt & 3;
            f32x4 pt = {0.f, 0.f, 0.f, 0.f};
            const bool live = dir ? (jt >= it) : (jt <= it);
            if (live) { const LAS char* ka = KI + 4096 * jt + AL; const LAS char* qa = QI + 4096 * it + AL;
#pragma unroll
                for (int ks = 0; ks < 8; ++ks) { const int o = (ks >> 2) * 16384 + AH[ks & 3];
                    pt = __builtin_amdgcn_mfma_f32_16x16x32_bf16(*(const LAS bf16x8*)(ka + o), *(const LAS bf16x8*)(qa + o), pt, 0, 0, 0); } }
            float we = LP * __builtin_amdgcn_exp2f((float)(16 * (it - jt)) * lgr); float v[4];
            const int mrel = fr - 4 * fq;
#pragma unroll
            for (int e = 0; e < 4; ++e) { float x = live ? pt[e] * we : 0.f; if (jt == it) { const bool keep = dir ? (e >= mrel) : (e <= mrel); x = keep ? x : 0.f; } v[e] = x; we *= Rm1; }
            const int i = it * 16 + fr, j0 = jt * 16 + 4 * fq;
            u32x2 w; w.x = cvt_pk_bf16(v[0], v[1]); w.y = cvt_pk_bf16(v[2], v[3]);
            *(LAS u32x2*)(PI + p_off(i, j0 >> 3) + ((j0 >> 2) & 1) * 8) = w; } }
        f32x16 Yt[2]; Yt[0] = f32x16{}; Yt[1] = f32x16{};
        { const int fH = r & 3, fL = (r >> 2) & 3; int QH[4], QL[4];
#pragma unroll
          for (int k = 0; k < 4; ++k) { QH[k] = 64 * (k ^ fH); QL[k] = 256 * r + 8 * h + 16 * (k ^ fL); }
#pragma unroll
          for (int dkb = 0; dkb < 8; ++dkb)
#pragma unroll
            for (int s = 0; s < 2; ++s) { const bf16x8 bf = pack_step(S[dkb], s);
                const LAS char* rp = QI + (dkb >> 2) * 16384 + QH[dkb & 3];
#pragma unroll
                for (int it = 0; it < 2; ++it) {
                    const u32x2 lo = *(const LAS u32x2*)(rp + it * 8192 + QL[2 * s]), hi2 = *(const LAS u32x2*)(rp + it * 8192 + QL[2 * s + 1]);
                    const u32x4 aw = {lo.x, lo.y, hi2.x, hi2.y};
                    Yt[it] = __builtin_amdgcn_mfma_f32_32x32x16_bf16(__builtin_bit_cast(bf16x8, aw), bf, Yt[it], 0, 0, 0); } } }
        { float fit = LR;
#pragma unroll
          for (int it = 0; it < 2; ++it) { float fa = fit;
#pragma unroll
            for (int a4 = 0; a4 < 4; ++a4) { float fb = fa;
#pragma unroll
                for (int b4 = 0; b4 < 4; ++b4) { Yt[it][4 * a4 + b4] *= fb; fb *= R1; }
                fa *= R8; }
            fit *= R32; } }
        if (more) asm volatile("s_waitcnt vmcnt(4)" ::: "memory"); else asm volatile("s_waitcnt vmcnt(0)" ::: "memory");
        __syncthreads();
        if (more) dma_mat(nsrc + qcol, 8192, lds + OFF_Q, wid, lane);
#pragma unroll
        for (int i = 0; i < 8; ++i)
#pragma unroll
            for (int rg = 0; rg < 16; ++rg) S[i][rg] *= g64;
        {
          const int blk = (lane >> 4) & 1, q = (lane & 15) >> 2, p = lane & 3; int TB[2], CQ[4];
#pragma unroll
          for (int t = 0; t < 2; ++t) TB[t] = 2048 * h + 256 * q + 1024 * t + 16 * ((2 * blk + (p >> 1)) ^ ((2 * h + t) & 3)) + 8 * (p & 1);
#pragma unroll
          for (int c = 0; c < 4; ++c) CQ[c] = 64 * (c ^ q);
          const LAS char* vb = VI + (wid >> 2) * 16384 + CQ[wid & 3];
          float zk = LZ;
#pragma unroll
          for (int ks = 0; ks < 4; ++ks) {
            const s16x4 vlo = vtr(vb + 4096 * ks + TB[0]), vhi = vtr(vb + 4096 * ks + TB[1]);
            const u32x2 vl = __builtin_bit_cast(u32x2, vlo), vh = __builtin_bit_cast(u32x2, vhi);
            const u32x4 vw = {vl.x, vl.y, vh.x, vh.y}; const bf16x8 vf = __builtin_bit_cast(bf16x8, vw);
#pragma unroll
            for (int it = 0; it < 2; ++it) { const bf16x8 pa = *(const LAS bf16x8*)(PI + p_off(it * 32 + r, 2 * ks + h));
                Yt[it] = __builtin_amdgcn_mfma_f32_32x32x16_bf16(pa, vf, Yt[it], 0, 0, 0); }
            float zj = zk; u32x4 zw;
            { const float a0 = bflo(vw.x) * zj; zj *= Rm1; const float a1 = bfhi(vw.x) * zj; zj *= Rm1; zw.x = cvt_pk_bf16(a0, a1); }
            { const float a0 = bflo(vw.y) * zj; zj *= Rm1; const float a1 = bfhi(vw.y) * zj; zj *= Rm1; zw.y = cvt_pk_bf16(a0, a1); }
            { const float a0 = bflo(vw.z) * zj; zj *= Rm1; const float a1 = bfhi(vw.z) * zj; zj *= Rm1; zw.z = cvt_pk_bf16(a0, a1); }
            { const float a0 = bflo(vw.w) * zj; zj *= Rm1; const float a1 = bfhi(vw.w) * zj; zw.w = cvt_pk_bf16(a0, a1); }
            const bf16x8 vz = __builtin_bit_cast(bf16x8, zw);
            zk *= Rm16;
#pragma unroll
            for (int dkb = 0; dkb < 8; ++dkb) { const LAS char* kb_ = KI + (dkb >> 2) * 16384 + 4096 * ks + CQ[dkb & 3];
                const s16x4 klo = vtr(kb_ + TB[0]), khi = vtr(kb_ + TB[1]);
                const u32x2 kl = __builtin_bit_cast(u32x2, klo), kh = __builtin_bit_cast(u32x2, khi); const u32x4 kw = {kl.x, kl.y, kh.x, kh.y};
                S[dkb] = __builtin_amdgcn_mfma_f32_32x32x16_bf16(__builtin_bit_cast(bf16x8, kw), vz, S[dkb], 0, 0, 0); }
            __builtin_amdgcn_sched_barrier(0);
          } }
        if (!(skip_ctx_y && n < 4)) {
            bf16* Yr = Y + (size_t)rowbase * 4096; const unsigned yo = (unsigned)(hd * RDV + dvh * 256 + wid * 32 + r + 4 * h * 4096);
#pragma unroll
            for (int it = 0; it < 2; ++it)
#pragma unroll
                for (int rg = 0; rg < 16; ++rg) { const unsigned i0 = (unsigned)(it * 32 + (rg & 3) + 8 * (rg >> 2));
                    Yr[yo + i0 * 4096u] = (bf16)(cvt_pk_bf16(Yt[it][rg], 0.f) & 0xffffu); }
        }
        asm volatile("s_waitcnt vmcnt(0)" ::: "memory");
        __syncthreads();
        if (more) dma_mat(nsrc + vcol, 8192, lds + OFF_V, wid, lane);
    }
    asm volatile("s_waitcnt vmcnt(0)" ::: "memory"); __syncthreads();
}
}

#define XB_TMO      128
#define XB_XCNT(j)  (256  + 64 * (j))
#define XB_XSUB(j)  (1280 + 64 * (j))
#define XB_XGEN(j)  (2304 + 64 * (j))
#define XB_TOP      3328
#define XB_TOPGEN   3392
#define XCD_BAR_WORDS 3456
#define XB_SPIN_CAP (1u << 22)
__device__ __forceinline__ unsigned xb_ld(unsigned* p)              { return __hip_atomic_load(p, __ATOMIC_RELAXED, __HIP_MEMORY_SCOPE_AGENT); }
__device__ __forceinline__ unsigned xb_add(unsigned* p, unsigned v) { return __hip_atomic_fetch_add(p, v, __ATOMIC_RELAXED, __HIP_MEMORY_SCOPE_AGENT); }
__device__ __forceinline__ unsigned xb_xcc_id() { return (unsigned)__builtin_amdgcn_s_getreg((3 << 11) | 20) & 0xFu; }
#define XB_SPIN(cond, bar) do { unsigned _sp = 0; while (cond) { __builtin_amdgcn_s_sleep(1); \
    if ((++_sp & 255u) == 0u) { if (xb_ld(&(bar)[XB_TMO])) break; if (_sp > XB_SPIN_CAP) { atomicAdd(&(bar)[XB_TMO], 1u); break; } } } } while (0)
struct XcdBarrier { unsigned* bar; unsigned x; volatile LAS unsigned* st; };
__device__ __forceinline__ XcdBarrier xcd_barrier_post(unsigned* bar, volatile LAS unsigned* st) {
    XcdBarrier b; b.bar = bar; b.x = xb_xcc_id(); b.st = st;
    if (threadIdx.x == 0) (void)xb_add(&bar[XB_XCNT(b.x)], 1u);
    return b;
}
__device__ __forceinline__ void xcd_barrier_complete(unsigned* bar, unsigned x, unsigned& nloc, unsigned& nx) {
    const unsigned G = gridDim.x * gridDim.y * gridDim.z;
    unsigned sum, cnt, mine, sp = 0u;
    for (;;) {
        sum = 0u; cnt = 0u; mine = 0u;
#pragma unroll
        for (unsigned j = 0; j < 16; ++j) { const unsigned c = xb_ld(&bar[XB_XCNT(j)]); sum += c; cnt += (c > 0u) ? 1u : 0u; mine = (j == x) ? c : mine; }
        if (sum == G) break;
        __builtin_amdgcn_s_sleep(1);
        if ((++sp & 255u) == 0u) { if (xb_ld(&bar[XB_TMO])) break; if (sp > XB_SPIN_CAP) { atomicAdd(&bar[XB_TMO], 1u); break; } }
    }
    nloc = mine > 0u ? mine : 1u; nx = cnt > 0u ? cnt : 1u;
}
__device__ __forceinline__ void xcd_barrier(const XcdBarrier& b) {
    asm volatile("s_waitcnt vmcnt(0)" ::: "memory");
    __syncthreads();
    if (threadIdx.x == 0) {
        unsigned* bar = b.bar; asm volatile("" : "+s"(bar));
        __builtin_amdgcn_s_waitcnt(0);
        unsigned nloc = b.st[0], nx = b.st[1];
        if (nloc == 0u) { xcd_barrier_complete(bar, b.x, nloc, nx); b.st[0] = nloc; b.st[1] = nx; }
        const unsigned old = xb_add(&bar[XB_XSUB(b.x)], 1u);
        const unsigned gen = old / nloc;
        if (old + 1u == (gen + 1u) * nloc) {
            __builtin_amdgcn_fence(__ATOMIC_RELEASE, "agent");
            asm volatile("s_waitcnt vmcnt(0)" ::: "memory");
            const unsigned og = xb_add(&bar[XB_TOP], 1u);
            const unsigned tg = og / nx;
            if (og + 1u == (tg + 1u) * nx) xb_add(&bar[XB_TOPGEN], 1u);
            else XB_SPIN(xb_ld(&bar[XB_TOPGEN]) == tg, bar);
            __builtin_amdgcn_fence(__ATOMIC_ACQUIRE, "agent");
            xb_add(&bar[XB_XGEN(b.x)], 1u);
            asm volatile("s_waitcnt vmcnt(0)" ::: "memory");
        } else {
            XB_SPIN(xb_ld(&bar[XB_XGEN(b.x)]) == gen, bar);
            __builtin_amdgcn_fence(__ATOMIC_ACQUIRE, "agent");
            asm volatile("s_waitcnt vmcnt(0)" ::: "memory");
        }
    }
    __syncthreads();
}

__device__ __forceinline__ float wave_sum(float v, int lane) {
#pragma unroll
    for (int o = 1; o < 64; o <<= 1) v += shfl_xor_l(v, o, lane);
    return v;
}
struct CvtDesc { const float* colptr; const float* kscale; bf16* WTrow0; int ldw, k0, K; float gscale; };
__device__ __forceinline__ void cvt_load(const CvtDesc& d, int lane, float (&v)[32]) {
#pragma unroll
    for (int i = 0; i < 32; ++i) { const int kk = 2 * i + (lane >> 5); float x = d.colptr ? d.colptr[(size_t)(d.k0 + kk) * d.ldw] : 0.f;
        if (d.kscale) x *= d.kscale[d.k0 + kk];
        v[i] = x * d.gscale; }
}
__device__ __forceinline__ void cvt_store(const CvtDesc& d, int lane, const float (&v)[32], LAS float* scr) {
#pragma unroll
    for (int i = 0; i < 32; ++i) scr[(2 * i + (lane >> 5)) * 33 + (lane & 31)] = v[i];
    asm volatile("s_waitcnt lgkmcnt(0)" ::: "memory");
    const int c = lane & 7;
#pragma unroll
    for (int j = 0; j < 4; ++j) { const int n = (lane >> 3) + 8 * j; const LAS float* s = scr + (8 * c) * 33 + n;
        u32x4 o; o.x = cvt_pk_bf16(s[0 * 33], s[1 * 33]); o.y = cvt_pk_bf16(s[2 * 33], s[3 * 33]); o.z = cvt_pk_bf16(s[4 * 33], s[5 * 33]); o.w = cvt_pk_bf16(s[6 * 33], s[7 * 33]);
        *(u32x4*)(d.WTrow0 + (size_t)n * d.K + d.k0 + 8 * c) = o; }
    asm volatile("s_waitcnt lgkmcnt(0)" ::: "memory");
}
__device__ __forceinline__ int ropeperm64(int c) { const int p = c >> 1, e = c & 1; return (p < 16) ? (p + 16 * e) : (32 + (p - 16) + 16 * e); }
__device__ __forceinline__ const float* src_col(int kind, const float* W0, const float* W1, int aux, int n) {
    switch (kind) {
        case 0: return W0 + aux + n;
        case 1: return W0 + aux + ropeperm64(n);
        case 2: { const int hh = n / DQ, d = n % DQ; return W0 + hh * DQ + (d < NOPE ? d : NOPE + ropeperm64(d - NOPE)); }
        case 3: { const int hh = n >> 8, d = n & 255; return W0 + hh * 256 + (d >> 1) + 128 * (d & 1); }
        case 4: { const int tl = n >> 8, j = n & 255; return (j < 128 ? W0 : W1) + tl * 128 + (j & 127); }
        default: return nullptr;
    }
}
struct CvtJob { const float* W0; const float* W1; const float* kscale; bf16* WT; int ldw, K, nrows, kind, aux; float gscale; };
__device__ __forceinline__ bool cvt_try(const CvtJob& J, int& it, int lane, CvtDesc& d) {
    const int nblk = J.nrows / 32, items = (J.K / 64) * nblk;
    if (it >= items) { it -= items; return false; }
    const int kb = it / nblk, nb = it % nblk;
    d.colptr = src_col(J.kind, J.W0, J.W1, J.aux, nb * 32 + (lane & 31)); d.kscale = J.kscale; d.WTrow0 = J.WT + (size_t)(nb * 32) * J.K; d.ldw = J.ldw; d.k0 = kb * 64; d.K = J.K; d.gscale = J.gscale;
    return true;
}
__device__ __forceinline__ int cvt_items(const CvtJob& J) { return (J.K / 64) * (J.nrows / 32); }

__device__ __forceinline__ void row_load(const float* xrow, int lane, f32x4 (&v)[8]) {
#pragma unroll
    for (int j = 0; j < 8; ++j) v[j] = *(const f32x4*)(xrow + 4 * lane + 256 * j);
}
__device__ __forceinline__ void norm_mod_finish(const f32x4 (&v)[8], const float* g, const float* sc, const float* sh, bf16* orow, int lane) {
    float s = 0.f;
#pragma unroll
    for (int j = 0; j < 8; ++j) s += (v[j][0] * v[j][0] + v[j][1] * v[j][1]) + (v[j][2] * v[j][2] + v[j][3] * v[j][3]);
    const float rstd = 1.0f / sqrtf(wave_sum(s, lane) * (1.0f / D) + NORM_EPS);
#pragma unroll
    for (int j = 0; j < 8; ++j) { const int c = 4 * lane + 256 * j; const f32x4 gg = *(const f32x4*)(g + c), s1 = *(const f32x4*)(sc + c), s0 = *(const f32x4*)(sh + c);
        const f32x4 y = (v[j] * rstd) * gg * (1.0f + s1) + s0;
        u32x2 w; w.x = cvt_pk_bf16(y[0], y[1]); w.y = cvt_pk_bf16(y[2], y[3]); *(u32x2*)(orow + c) = w; }
}
__device__ __forceinline__ void norm_phase(const float* xsrc, const float* csrc, const float* g, const float* modl, int chunk, bf16* H, int nrows, int gw, int NGW, int lane) {
    if (gw >= nrows) return;
    f32x4 v[8], vn[8]; int m = gw;
    row_load(m < MX ? xsrc + (size_t)m * D : csrc + (size_t)(m - MX) * D, lane, v);
    for (;;) {
        const int mn = m + NGW; const bool has = mn < nrows;
        if (has) row_load(mn < MX ? xsrc + (size_t)mn * D : csrc + (size_t)(mn - MX) * D, lane, vn);
        const float* mr = modl + (size_t)(m < MX ? (m >> 12) : 8) * NMOD + chunk * D;
        norm_mod_finish(v, g, mr + D, mr, H + (size_t)m * D, lane);
        if (!has) break;
#pragma unroll
        for (int j = 0; j < 8; ++j) v[j] = vn[j];
        m = mn;
    }
}

__device__ __forceinline__ unsigned long long ld_arg(LAS unsigned char* lds, int i) {
    const volatile LAS unsigned* p = (const volatile LAS unsigned*)(lds + ARGS_OFF) + 2 * i;
    const unsigned lo = __builtin_amdgcn_readfirstlane(p[0]), hi = __builtin_amdgcn_readfirstlane(p[1]);
    return ((unsigned long long)hi << 32) | lo;
}
__device__ __forceinline__ void mod_layers(LAS unsigned char* lds, unsigned char* ws, int l_lo, int l_hi, int wg, int nwg, int tid, int lane, int wave) {
#define ARGF(i) ((const float*)ld_arg(lds, (i)))
    const int nitems = (l_hi - l_lo) * 96;
    if (wg >= nitems) return;
    LAS float* cond = (LAS float*)lds;
    LAS float* red = (LAS float*)(lds + 73728);
    float* MODV = (float*)(ws + WS_MODV);
    { const float* cin = ARGF(1); const float* cc = ARGF(3);
      for (int i = tid; i < 9 * D; i += 512) { const int r = i >> 11, k = i & (D - 1); const float c = (r < 8) ? cin[r * D + k] : cc[k]; cond[i] = c / (1.0f + __expf(-c)); } }
    __syncthreads();
    for (int it = wg; it < nitems; it += nwg) {
        const int l = l_lo + it / 96, cb = it % 96; const int n = cb * 128 + 2 * lane;
        const float* W = ARGF(4) + (size_t)l * D * NMOD + n; const float* mb = ARGF(5) + (size_t)l * NMOD + cb * 128;
        float a0[9], a1[9];
#pragma unroll
        for (int r = 0; r < 9; ++r) { a0[r] = 0.f; a1[r] = 0.f; }
        for (int k = wave * 256; k < wave * 256 + 256; k += 8) {
            f32x2 w[8];
#pragma unroll
            for (int q = 0; q < 8; ++q) w[q] = *(const f32x2*)(W + (size_t)(k + q) * NMOD);
#pragma unroll
            for (int q4 = 0; q4 < 2; ++q4)
#pragma unroll
                for (int r = 0; r < 9; ++r) { const f32x4 c4 = *(const LAS f32x4*)(cond + r * D + k + 4 * q4);
#pragma unroll
                    for (int q = 0; q < 4; ++q) { a0[r] += c4[q] * w[4 * q4 + q][0]; a1[r] += c4[q] * w[4 * q4 + q][1]; } }
        }
#pragma unroll
        for (int r = 0; r < 9; ++r) { red[(wave * 9 + r) * 128 + 2 * lane] = a0[r]; red[(wave * 9 + r) * 128 + 2 * lane + 1] = a1[r]; }
        __syncthreads();
        for (int i = tid; i < 9 * 128; i += 512) { const int r = i >> 7, cc = i & 127; float s2 = 0.f;
#pragma unroll
            for (int w8 = 0; w8 < 8; ++w8) s2 += red[(w8 * 9 + r) * 128 + cc];
            MODV[((size_t)l * 9 + r) * NMOD + cb * 128 + cc] = s2 + mb[cc]; }
        __syncthreads();
    }
#undef ARGF
}
__device__ __forceinline__ void cvt_layer(LAS unsigned char* lds, unsigned char* ws, int lc, int rank, int nranks, int wave, int lane) {
#define ARGF(i) ((const float*)ld_arg(lds, (i)))
    const int li = lc >> 1; const bool is_ret = (lc & 1) != 0;
    bf16* WM = (bf16*)(ws + (is_ret ? WS_WB : WS_WA)); bf16* WF = (bf16*)(ws + (is_ret ? WS_WB + 82 * MiB : WS_WA + 22 * MiB));
    LAS float* scr = (LAS float*)(lds + wave * 16384);
    CvtJob J[7]; int nj;
    if (!is_ret) {
        bf16* W1T = WM; bf16* WuqT = W1T + (size_t)N1 * D; bf16* WukvT = WuqT + (size_t)3072 * 512; bf16* WoT = WukvT + (size_t)4096 * 512;
        const float* wdq = ARGF(8) + (size_t)li * D * QR; const float* wdkv = ARGF(11) + (size_t)li * D * (KVR + ROPE);
        J[0] = CvtJob{wdq, nullptr, nullptr, W1T, QR, D, 512, 0, 0, 1.f};
        J[1] = CvtJob{wdkv, nullptr, nullptr, W1T + (size_t)512 * D, KVR + ROPE, D, 512, 0, 0, 1.f};
        J[2] = CvtJob{wdkv, nullptr, nullptr, W1T + (size_t)1024 * D, KVR + ROPE, D, 64, 1, 512, 1.f};
        J[3] = CvtJob{nullptr, nullptr, nullptr, W1T + (size_t)1088 * D, 1, D, 192, 5, 0, 1.f};
        J[4] = CvtJob{ARGF(10) + (size_t)li * QR * 3072, nullptr, ARGF(9) + li * QR, WuqT, 3072, QR, 3072, 2, 0, 0.07216878364870322f * LOG2E};
        J[5] = CvtJob{ARGF(13) + (size_t)li * KVR * 4096, nullptr, ARGF(12) + li * KVR, WukvT, 4096, KVR, 4096, 0, 0, 1.f};
        J[6] = CvtJob{ARGF(14) + (size_t)li * D * D, nullptr, nullptr, WoT, D, D, D, 0, 0, 1.f};
        nj = 7;
    } else {
        bf16* WqkvT = WM; bf16* WgT = WqkvT + (size_t)8192 * D; bf16* WoT = WgT + (size_t)8192 * D;
        J[0] = CvtJob{ARGF(15) + (size_t)li * D * D, nullptr, nullptr, WqkvT, D, D, 2048, 3, 0, 1.f};
        J[1] = CvtJob{ARGF(16) + (size_t)li * D * D, nullptr, nullptr, WqkvT + (size_t)2048 * D, D, D, 2048, 3, 0, 0.0625f};
        J[2] = CvtJob{ARGF(17) + (size_t)li * D * 4096, nullptr, nullptr, WqkvT + (size_t)4096 * D, 4096, D, 4096, 0, 0, 1.f};
        J[3] = CvtJob{ARGF(18) + (size_t)li * D * 4096, ARGF(19) + (size_t)li * D * 4096, nullptr, WgT, 4096, D, 8192, 4, 0, 1.f};
        J[4] = CvtJob{ARGF(20) + (size_t)li * 4096 * D, nullptr, nullptr, WoT, D, 4096, D, 0, 0, 1.f};
        J[5] = CvtJob{nullptr, nullptr, nullptr, nullptr, 1, 64, 0, 5, 0, 1.f};
        J[6] = J[5];
        nj = 5;
    }
    CvtJob F0 = CvtJob{ARGF(23) + (size_t)lc * D * FF, ARGF(24) + (size_t)lc * D * FF, nullptr, WF, FF, D, 11264, 4, 0, 1.f};
    CvtJob F1 = CvtJob{ARGF(27) + (size_t)lc * FF * D, nullptr, nullptr, WF + (size_t)11264 * D, D, FF, D, 0, 0, 1.f};
    int total = cvt_items(F0) + cvt_items(F1);
#pragma unroll
    for (int j = 0; j < 7; ++j) if (j < nj) total += cvt_items(J[j]);
#define CVT_FIND(IT, DD) do { int it_ = (IT); bool done_ = false; \
        _Pragma("unroll") for (int j = 0; j < 7; ++j) if (!done_ && j < nj) done_ = cvt_try(J[j], it_, lane, DD); \
        if (!done_) done_ = cvt_try(F0, it_, lane, DD); if (!done_) done_ = cvt_try(F1, it_, lane, DD); } while (0)
    if (rank < total) {
        float v[32], w[32]; CvtDesc d0, d1; int it0 = rank;
        CVT_FIND(it0, d0); cvt_load(d0, lane, v);
        for (;;) {
            const int it1 = it0 + nranks; const bool has = it1 < total;
            if (has) { CVT_FIND(it1, d1); cvt_load(d1, lane, w); }
            cvt_store(d0, lane, v, scr);
            if (!has) break;
#pragma unroll
            for (int i = 0; i < 32; ++i) v[i] = w[i];
            d0 = d1; it0 = it1;
        }
    }
#undef CVT_FIND
#undef ARGF
}

#if MLA_CHECK
constexpr int CW_CHK = 2048;
__device__ __forceinline__ float wave_max(float v, int lane) {
#pragma unroll
    for (int o = 1; o < 64; o <<= 1) v = fmaxf(v, shfl_xor_l(v, o, lane));
    return v;
}
__device__ __forceinline__ void mla_check(LAS unsigned char* lds, unsigned char* ws, int li, int gw, int wave, int lane) {
#define ARGF(i) ((const float*)ld_arg(lds, (i)))
    LAS float* sc = (LAS float*)(lds + wave * 19456);
    const bf16* H = (const bf16*)(ws + WS_H); const bf16* Qb = (const bf16*)(ws + WS_Q); const bf16* KVb = (const bf16*)(ws + WS_KV); const bf16* KRb = (const bf16*)(ws + WS_KR); const bf16* Ob = (const bf16*)(ws + WS_O);
    const int t = (int)(((unsigned)gw * 2654435761u) % (unsigned)MT); const int hd = gw & 15;
    const bool isx = t < MX; const int tt = t & (SEQ - 1);
    float err = 0.f;
    {
        const float* wdq = ARGF(8) + (size_t)li * D * QR; const float* wdkv = ARGF(11) + (size_t)li * D * (KVR + ROPE);
        float ql[8], kl[9];
#pragma unroll
        for (int j = 0; j < 8; ++j) ql[j] = 0.f;
#pragma unroll
        for (int j = 0; j < 9; ++j) kl[j] = 0.f;
        for (int k = 0; k < D; ++k) { const float hv = bf2f(H[(size_t)t * D + k]);
#pragma unroll
            for (int j = 0; j < 8; ++j) ql[j] += hv * wdq[(size_t)k * QR + lane + 64 * j];
#pragma unroll
            for (int j = 0; j < 9; ++j) kl[j] += hv * wdkv[(size_t)k * (KVR + ROPE) + lane + 64 * j]; }
        float sq = 0.f, sk = 0.f;
#pragma unroll
        for (int j = 0; j < 8; ++j) { sq += ql[j] * ql[j]; sk += kl[j] * kl[j]; }
        const float rq = 1.0f / sqrtf(wave_sum(sq, lane) * (1.0f / QR) + NORM_EPS), rk = 1.0f / sqrtf(wave_sum(sk, lane) * (1.0f / KVR) + NORM_EPS);
        const float* qg = ARGF(9) + li * QR; const float* kg = ARGF(12) + li * KVR;
#pragma unroll
        for (int j = 0; j < 8; ++j) { sc[lane + 64 * j] = ql[j] * rq * qg[lane + 64 * j]; sc[512 + lane + 64 * j] = kl[j] * rk * kg[lane + 64 * j]; }
        sc[1024 + lane] = kl[8];
        asm volatile("s_waitcnt lgkmcnt(0)" ::: "memory");
        const float* wuq = ARGF(10) + (size_t)li * QR * 3072 + hd * DQ; const float* wukv = ARGF(13) + (size_t)li * KVR * 4096 + hd * 256;
        float qv[3] = {0.f, 0.f, 0.f}, kv[4] = {0.f, 0.f, 0.f, 0.f};
        for (int c = 0; c < 512; ++c) { const float a = sc[c], bq = sc[512 + c];
#pragma unroll
            for (int j = 0; j < 3; ++j) qv[j] += a * wuq[(size_t)c * 3072 + lane + 64 * j];
#pragma unroll
            for (int j = 0; j < 4; ++j) kv[j] += bq * wukv[(size_t)c * 4096 + lane + 64 * j]; }
#pragma unroll
        for (int j = 0; j < 3; ++j) sc[1100 + lane + 64 * j] = qv[j];
        asm volatile("s_waitcnt lgkmcnt(0)" ::: "memory");
        float qref[3]; float kr_ref = 0.f;
#pragma unroll
        for (int j = 0; j < 3; ++j) { const int d = lane + 64 * j; float v = sc[1100 + d];
            if (d >= NOPE && isx) { const int e = d - NOPE, half = e >> 5, i = e & 15, second = (e >> 4) & 1; const float pos = half ? (float)(tt & 63) : (float)(tt >> 6);
                const float ang = pos * __builtin_amdgcn_exp2f(-(float)(2 * i) * (13.287712379549449f / 32.0f)); const float rev = ang * 0.15915494309189535f; const float fr_ = rev - floorf(rev);
                const float cs = __builtin_amdgcn_cosf(fr_), sn = __builtin_amdgcn_sinf(fr_); const float other = sc[1100 + NOPE + half * 32 + i + (second ? 0 : 16)];
                v = second ? (v * cs + other * sn) : (v * cs - other * sn); }
            qref[j] = v * (0.07216878364870322f * LOG2E); }
        { const int e = lane, half = e >> 5, i = e & 15, second = (e >> 4) & 1; float v = sc[1024 + e];
          if (isx) { const float pos = half ? (float)(tt & 63) : (float)(tt >> 6);
              const float ang = pos * __builtin_amdgcn_exp2f(-(float)(2 * i) * (13.287712379549449f / 32.0f)); const float rev = ang * 0.15915494309189535f; const float fr_ = rev - floorf(rev);
              const float cs = __builtin_amdgcn_cosf(fr_), sn = __builtin_amdgcn_sinf(fr_); const float other = sc[1024 + half * 32 + i + (second ? 0 : 16)];
              v = second ? (v * cs + other * sn) : (v * cs - other * sn); }
          kr_ref = v; }
#pragma unroll
        for (int j = 0; j < 3; ++j) sc[1400 + lane + 64 * j] = qref[j];
        sc[1600 + lane] = kr_ref;
        asm volatile("s_waitcnt lgkmcnt(0)" ::: "memory");
        float mx = 0.f, df = 0.f;
#pragma unroll
        for (int j = 0; j < 3; ++j) { const int p = lane + 64 * j; const int od = p < NOPE ? p : NOPE + ropeperm64(p - NOPE); const float ref = sc[1400 + od]; const float mine = bf2f(Qb[(size_t)t * 3072 + hd * DQ + p]);
            mx = fmaxf(mx, fabsf(ref)); df = fmaxf(df, fabsf(ref - mine)); }
        err = fmaxf(err, wave_max(df, lane) / (wave_max(mx, lane) + 1e-20f));
        mx = 0.f; df = 0.f;
#pragma unroll
        for (int j = 0; j < 4; ++j) { const float ref = kv[j]; const float mine = bf2f(KVb[(size_t)t * 4096 + hd * 256 + lane + 64 * j]); mx = fmaxf(mx, fabsf(ref)); df = fmaxf(df, fabsf(ref - mine)); }
        err = fmaxf(err, wave_max(df, lane) / (wave_max(mx, lane) + 1e-20f));
        { const float ref = sc[1600 + ropeperm64(lane)]; const float mine = bf2f(KRb[(size_t)t * 64 + lane]); err = fmaxf(err, wave_max(fabsf(ref - mine), lane) / (wave_max(fabsf(ref), lane) + 1e-20f)); }
    }
    {
        const int b = isx ? (t >> 12) : ((t - MX) >> 8); const int nk = isx ? 4352 : 256;
        for (int d = lane; d < DQ; d += 64) sc[d] = bf2f(Qb[(size_t)t * 3072 + hd * DQ + d]);
        asm volatile("s_waitcnt lgkmcnt(0)" ::: "memory");
        float mxs = -1e30f;
        for (int j = lane; j < nk; j += 64) { const int row = j < 256 ? MX + b * CTXL + j : b * SEQ + (j - 256); float sdot = 0.f;
            for (int d = 0; d < NOPE; ++d) sdot += sc[d] * bf2f(KVb[(size_t)row * 4096 + hd * 256 + d]);
            for (int d = 0; d < ROPE; ++d) sdot += sc[NOPE + d] * bf2f(KRb[(size_t)row * 64 + d]);
            sc[256 + j] = sdot; mxs = fmaxf(mxs, sdot); }
        mxs = wave_max(mxs, lane); float sum = 0.f;
        for (int j = lane; j < nk; j += 64) { const float p = __builtin_amdgcn_exp2f(sc[256 + j] - mxs); sc[256 + j] = p; sum += p; }
        sum = wave_sum(sum, lane);
        asm volatile("s_waitcnt lgkmcnt(0)" ::: "memory");
        float o0 = 0.f, o1 = 0.f;
        for (int j = 0; j < nk; ++j) { const int row = j < 256 ? MX + b * CTXL + j : b * SEQ + (j - 256); const float p = sc[256 + j];
            o0 += p * bf2f(KVb[(size_t)row * 4096 + hd * 256 + 128 + lane]); o1 += p * bf2f(KVb[(size_t)row * 4096 + hd * 256 + 128 + 64 + lane]); }
        o0 /= sum; o1 /= sum;
        const float m0 = bf2f(Ob[(size_t)t * D + hd * 128 + lane]), m1 = bf2f(Ob[(size_t)t * D + hd * 128 + 64 + lane]);
        const float df = fmaxf(fabsf(o0 - m0), fabsf(o1 - m1)), mx = fmaxf(fabsf(o0), fabsf(o1));
        err = fmaxf(err, wave_max(df, lane) / (wave_max(mx, lane) + 1e-20f));
    }
    if (lane == 0) atomicMax((unsigned*)(ws + WS_CTL) + CW_CHK, __float_as_uint(err));
#undef ARGF
}
#endif
struct Args { const float* in[29]; float* out; unsigned char* ws; int ph_lo, ph_hi; };
constexpr int PH_PER_LAYER = 10, PH_FINAL = 1 + PH_PER_LAYER * DEPTH, PH_COUNT = PH_FINAL + 1;

template <unsigned MK_EN_T>
__global__ void __launch_bounds__(512, 2) mk_fwd(Args args) {
    extern __shared__ __attribute__((aligned(16))) unsigned char lds_raw[];
    LAS unsigned char* lds = (LAS unsigned char*)lds_raw;
    volatile LAS unsigned* MISC = (volatile LAS unsigned*)(lds + MISC_OFF);
    const int G = gridDim.x; const int bx = blockIdx.x; const int vcu = (G % 8 == 0) ? (bx % 8) * (G / 8) + bx / 8 : bx;
    const int NGW = G * 8;
    unsigned char* ws = args.ws; float* X = args.out;
    const int lo = args.ph_lo, hi = args.ph_hi;
    { const int tid0 = threadIdx.x;
      for (int u = tid0; u < (LDS_BYTES - CTRL_BASE) / 4; u += 512) ((LAS unsigned*)(lds + CTRL_BASE))[u] = 0u;
      __syncthreads();
      if (tid0 < 29) ((volatile LAS unsigned long long*)(lds + ARGS_OFF))[tid0] = (unsigned long long)args.in[tid0];
      __syncthreads(); }
#define ARGF(i) ((const float*)ld_arg(lds, (i)))
    XcdBarrier bar; bar.bar = (unsigned*)(ws + WS_CTL) + CW_BAR; bar.x = 0; bar.st = nullptr;
    if (hi - lo > 1) bar = xcd_barrier_post((unsigned*)(ws + WS_CTL) + CW_BAR, MISC + 8);
#define EN(b) (((MK_EN_T) >> (b)) & 1u)
#define IN(k) (lo <= (k) && (k) < hi)
#define PHASE_END(k) do { if (hi > (k) + 1) xcd_barrier(bar); } while (0)
#define PH_IDS int tid = threadIdx.x; asm volatile("" : "+v"(tid)); const int lane = tid & 63; const int wave = __builtin_amdgcn_readfirstlane(tid >> 6); const int gw = vcu * 8 + wave; (void)lane; (void)gw;
#define XC_    ((float*)(ws + WS_XC))
#define MODV_  ((float*)(ws + WS_MODV))
#define TABM_  ((float*)(ws + WS_TABM))
#define TABR_  ((float*)(ws + WS_TABR))
#define SSQ_   ((float*)(ws + WS_SSQ))
#define KR_    ((bf16*)(ws + WS_KR))
#define H_     ((bf16*)(ws + WS_H))
#define WMIX_(ll) ((bf16*)(ws + (((ll) & 1) ? WS_WB : WS_WA)))
#define WFFN_(ll) ((bf16*)(ws + (((ll) & 1) ? WS_WB + 82 * MiB : WS_WA + 22 * MiB)))
#define W1T_   WMIX_(l)
#define WUQT_  (W1T_ + (size_t)N1 * D)
#define WUKVT_ (WUQT_ + (size_t)3072 * 512)
#define WOTM_  (WUKVT_ + (size_t)4096 * 512)
#define WQKVT_ WMIX_(l)
#define WGT_   (WQKVT_ + (size_t)8192 * D)
#define WOTR_  (WGT_ + (size_t)8192 * D)
#define WGUT_  WFFN_(l)
#define WDT_   (WGUT_ + (size_t)11264 * D)
#define QKVL_  ((bf16*)(ws + WS_QKVL))
#define Q_     ((bf16*)(ws + WS_Q))
#define KV_    ((bf16*)(ws + WS_KV))
#define O_     ((bf16*)(ws + WS_O))
#define QKV_   ((bf16*)(ws + WS_QKV))
#define Y_     ((bf16*)(ws + WS_Y))
#define GATED_ ((bf16*)(ws + WS_GATED))
#define GB_    ((bf16*)(ws + WS_G))
#define UB_    ((bf16*)(ws + WS_U))
#define HALO_  ((float*)(ws + WS_G))
#define MODL_  (MODV_ + (size_t)l * 9 * NMOD)

    if (EN(0) && IN(0)) for (int rep_ = 0; rep_ < 1 + (int)((PROBE_MASK >> 0) & 1u); ++rep_) {
        PH_IDS
        mod_layers(lds, ws, 0, 1, bx, G, tid, lane, wave);
        __syncthreads();
        cvt_layer(lds, ws, 0, gw, NGW, wave, lane);
        for (int i = bx * 512 + tid; i < 64 * 16 + SEQ * 128; i += G * 512) {
            float inv, pos; float* dst;
            if (i < 1024) { const int p = i >> 4, f = i & 15; inv = __builtin_amdgcn_exp2f(-(float)(2 * f) * (13.287712379549449f / 32.0f)); pos = (float)p; dst = TABM_ + 2 * i; }
            else { const int j = i - 1024, t = j >> 7, f = j & 127; inv = __builtin_amdgcn_exp2f(-(float)(2 * f) * (13.287712379549449f / 256.0f)); pos = (float)t; dst = TABR_ + 2 * j; }
            const float ang = pos * inv; const double rev = (double)ang * 0.15915494309189535; const float fr = (float)(rev - floor(rev));
            dst[0] = __builtin_amdgcn_cosf(fr); dst[1] = __builtin_amdgcn_sinf(fr);
        }
        PHASE_END(0);
    }

    for (int l = 0; l < DEPTH; ++l) {
        const int P = 1 + PH_PER_LAYER * l; const int li = l >> 1; const bool is_ret = (l & 1) != 0; const bool last = (l == DEPTH - 1);
        const int Mrows = last ? MX : MT;

        if (EN(1) && IN(P + 0)) for (int rep_ = 0; rep_ < 1 + (int)((PROBE_MASK >> 1) & 1u); ++rep_) {
            PH_IDS
            const float* g = ARGF(6) + l * D; const float* xsrc = (l == 0) ? ARGF(0) : X; const float* csrc = (l == 0) ? ARGF(2) : XC_;
            norm_phase(xsrc, csrc, g, MODL_, 0, H_, MT, gw, NGW, lane);
            PHASE_END(P + 0);
        }

        if (!is_ret) {
            if (EN(2) && IN(P + 1)) for (int rep_ = 0; rep_ < 1 + (int)((PROBE_MASK >> 2) & 1u); ++rep_) {
                pg8::Gemm g{H_, W1T_, MT, N1, D, D}; pg8::StaticOrder S; S.init(MT, N1, G, bx);
                EpiG1 E{QKVL_, SSQ_, KR_, TABM_};
                pg8::gemm_phase<EpiG1>(lds, g, S, E);
                PHASE_END(P + 1);
            }
            if (EN(3) && IN(P + 2)) for (int rep_ = 0; rep_ < 1 + (int)((PROBE_MASK >> 3) & 1u); ++rep_) {
                { pg8::Gemm g{QKVL_, WUQT_, MT, 3072, QR, N1}; pg8::StaticOrder S; S.init(MT, 3072, G, bx); EpiUq E{Q_, SSQ_, TABM_}; pg8::gemm_phase<EpiUq>(lds, g, S, E); }
                { pg8::Gemm g{QKVL_ + 512, WUKVT_, MT, 4096, KVR, N1}; pg8::StaticOrder S; S.init(MT, 4096, G, bx); EpiUkv E{KV_, SSQ_}; pg8::gemm_phase<EpiUkv>(lds, g, S, E); }
                PHASE_END(P + 2);
            }
            if (EN(4) && IN(P + 3)) for (int rep_ = 0; rep_ < 1 + (int)((PROBE_MASK >> 4) & 1u); ++rep_) {
                const int nun = 2048 + 128;
                for (int ui = vcu; ui < nun; ui += G) {
                    if (ui < 2048) { const int xcd = (ui & 255) >> 5, j = ui & 31, rnd = ui >> 8; const int bh = xcd * 16 + 2 * rnd + (j >> 4), qb = j & 15; const int b = bh >> 4, hd = bh & 15;
                        att::attn_unit(Q_ + (size_t)(b * SEQ + qb * 256) * 3072 + hd * DQ, KV_ + hd * 256, KR_, O_ + (size_t)(b * SEQ + qb * 256) * D + hd * 128, 68, 4, MX + b * CTXL, b * SEQ, (char*)lds_raw);
                    } else { const int bh = ui - 2048, b = bh >> 4, hd = bh & 15;
                        att::attn_unit(Q_ + (size_t)(MX + b * CTXL) * 3072 + hd * DQ, KV_ + hd * 256, KR_, O_ + (size_t)(MX + b * CTXL) * D + hd * 128, 4, 4, MX + b * CTXL, 0, (char*)lds_raw); }
                }
                PHASE_END(P + 3);
            }
        } else {
            if (EN(5) && IN(P + 1)) for (int rep_ = 0; rep_ < 1 + (int)((PROBE_MASK >> 5) & 1u); ++rep_) {
                pg8::Gemm g{H_, WQKVT_, MT, 8192, D, D}; pg8::StaticOrder S; S.init(MT, 8192, G, bx);
                EpiQKV E{QKV_, TABR_};
                pg8::gemm_phase<EpiQKV>(lds, g, S, E);
                PHASE_END(P + 1);
            }
            if (EN(6) && IN(P + 2)) for (int rep_ = 0; rep_ < 1 + (int)((PROBE_MASK >> 6) & 1u); ++rep_) {
                for (int ui = vcu; ui < 256; ui += G) {
                    const int bh = ui >> 2, dir = (ui >> 1) & 1, dvh = ui & 1; const int b = bh >> 3, hd = bh & 7;
                    const float dec = (dir ? ARGF(22) : ARGF(21))[li * RH + hd];
                    const float lg2 = -__expf(dec) * LOG2E;
                    scan::scan_unit(QKV_, Y_ + (size_t)dir * MT * 4096, b, hd, dir, dvh, lg2, last, lds);
                }
                PHASE_END(P + 2);
            }
            if (EN(7) && IN(P + 3)) for (int rep_ = 0; rep_ < 1 + (int)((PROBE_MASK >> 7) & 1u); ++rep_) {
                PH_IDS
                for (int row = gw; row < Mrows; row += NGW) {
                    u32x4 w[16];
#pragma unroll
                    for (int q = 0; q < 16; ++q) w[q] = *(const u32x4*)(Y_ + (size_t)(q >> 3) * MT * 4096 + (size_t)row * 4096 + (q & 7) * RDV + lane * 8);
                    float mu[16], rs[16];
#pragma unroll
                    for (int q = 0; q < 16; ++q) { const float s = ((bflo(w[q].x) + bfhi(w[q].x)) + (bflo(w[q].y) + bfhi(w[q].y))) + ((bflo(w[q].z) + bfhi(w[q].z)) + (bflo(w[q].w) + bfhi(w[q].w))); mu[q] = s; }
#pragma unroll
                    for (int o = 1; o < 64; o <<= 1)
#pragma unroll
                        for (int q = 0; q < 16; ++q) mu[q] += shfl_xor_l(mu[q], o, lane);
#pragma unroll
                    for (int q = 0; q < 16; ++q) { mu[q] *= (1.0f / RDV); const float m_ = mu[q];
                        const float d0 = bflo(w[q].x) - m_, d1 = bfhi(w[q].x) - m_, d2 = bflo(w[q].y) - m_, d3 = bfhi(w[q].y) - m_, d4 = bflo(w[q].z) - m_, d5 = bfhi(w[q].z) - m_, d6 = bflo(w[q].w) - m_, d7 = bfhi(w[q].w) - m_;
                        rs[q] = ((d0 * d0 + d1 * d1) + (d2 * d2 + d3 * d3)) + ((d4 * d4 + d5 * d5) + (d6 * d6 + d7 * d7)); }
#pragma unroll
                    for (int o = 1; o < 64; o <<= 1)
#pragma unroll
                        for (int q = 0; q < 16; ++q) rs[q] += shfl_xor_l(rs[q], o, lane);
                    float mo = 0.f, ro = 0.f;
#pragma unroll
                    for (int q = 0; q < 16; ++q) { if (lane == q) { mo = mu[q]; ro = rs[q]; } }
                    if (lane < 16) *(f32x2*)((float*)(ws + WS_STATS) + ((size_t)((lane >> 3) * MT + row) * 8 + (lane & 7)) * 2) = (f32x2){mo, 1.0f / sqrtf(ro * (1.0f / RDV) + GN_EPS)};
                }
                PHASE_END(P + 3);
            }
            if (EN(8) && IN(P + 4)) for (int rep_ = 0; rep_ < 1 + (int)((PROBE_MASK >> 8) & 1u); ++rep_) {
                pg8::Gemm g{H_, WGT_, Mrows, 8192, D, D}; pg8::StaticOrder S; S.init(Mrows, 8192, G, bx);
                EpiGate E{GATED_, Y_, Y_ + (size_t)MT * 4096, (const float*)(ws + WS_STATS)};
                pg8::gemm_phase<EpiGate>(lds, g, S, E);
                PHASE_END(P + 4);
            }
        }
        if (EN(9) && IN(P + 5)) for (int rep_ = 0; rep_ < 1 + (int)((PROBE_MASK >> 9) & 1u); ++rep_) {
#if MLA_CHECK
            if (l == MLA_CHECK_LAYER) { PH_IDS mla_check(lds, ws, li, gw, wave, lane); __syncthreads(); }
#endif
            pg8::Gemm g = is_ret ? pg8::Gemm{GATED_, WOTR_, Mrows, D, 4096, 4096} : pg8::Gemm{O_, WOTM_, Mrows, D, D, D};
            pg8::StaticOrder S; S.init(Mrows, D, G, bx);
            const float* xsrc = (l == 0) ? ARGF(0) : X; const float* csrc = (l == 0) ? ARGF(2) : XC_;
            EpiResid E{xsrc, X, csrc, XC_, MODL_, 2 * D};
            pg8::gemm_phase<EpiResid>(lds, g, S, E);
            PHASE_END(P + 5);
        }
        if (EN(10) && IN(P + 6)) for (int rep_ = 0; rep_ < 1 + (int)((PROBE_MASK >> 10) & 1u); ++rep_) {
            PH_IDS
            const float* g = ARGF(7) + l * D;
            norm_phase(X, XC_, g, MODL_, 3, H_, Mrows, gw, NGW, lane);
            PHASE_END(P + 6);
        }
        if (EN(11) && IN(P + 7)) for (int rep_ = 0; rep_ < 1 + (int)((PROBE_MASK >> 11) & 1u); ++rep_) {
            pg8::Gemm g{H_, WGUT_, Mrows, 11264, D, D}; pg8::StaticOrder S; S.init(Mrows, 11264, G, bx);
            EpiGUConv E{UB_, HALO_, ARGF(25) + (size_t)l * 3 * FF, ARGF(26) + (size_t)l * FF, (LAS float*)(lds + EDGE_OFF)};
            pg8::gemm_phase<EpiGUConv>(lds, g, S, E);
            PHASE_END(P + 7);
        }
        if (EN(13) && IN(P + 9)) for (int rep_ = 0; rep_ < 1 + (int)((PROBE_MASK >> 13) & 1u); ++rep_) {
            pg8::Gemm g{UB_, WDT_, Mrows, D, FF, FF}; pg8::StaticOrder S; S.init(Mrows, D, G, bx);
            {
                PH_IDS
                const float* cw = ARGF(25) + (size_t)l * 3 * FF; const float* HL = HALO_; bf16* ACT = UB_;
                pg8::Unit uu; int prev_pm = -1;
                for (int i = 0; S.next(i, uu); ++i) { const int pm = uu.pm; if (pm == prev_pm || pm >= MX / 256) { prev_pm = pm; continue; } prev_pm = pm;
                    const bool top = (pm & 15) != 0, bot = ((pm + 1) & 15) != 0;
                    for (int q = tid; q < FF / 4; q += 512) { const int f = q * 4;
                        if (top) { const float* t0 = HL + (size_t)((pm * 2 + 0) * 3) * HALO_STRIDE + f; const float* b1 = HL + (size_t)(((pm - 1) * 2 + 1) * 3) * HALO_STRIDE + f;
                            const f32x4 o = silu4(*(const f32x4*)t0 + *(const f32x4*)(cw + f) * *(const f32x4*)(b1 + HALO_STRIDE)) * *(const f32x4*)(t0 + 2 * HALO_STRIDE);
                            u32x2 w; w.x = cvt_pk_bf16(o[0], o[1]); w.y = cvt_pk_bf16(o[2], o[3]); *(u32x2*)(ACT + (size_t)(pm * 256) * FF + f) = w; }
                        if (bot) { const float* b0 = HL + (size_t)((pm * 2 + 1) * 3) * HALO_STRIDE + f; const float* t1 = HL + (size_t)(((pm + 1) * 2 + 0) * 3) * HALO_STRIDE + f;
                            const f32x4 o = silu4(*(const f32x4*)b0 + *(const f32x4*)(cw + 2 * FF + f) * *(const f32x4*)(t1 + HALO_STRIDE)) * *(const f32x4*)(b0 + 2 * HALO_STRIDE);
                            u32x2 w; w.x = cvt_pk_bf16(o[0], o[1]); w.y = cvt_pk_bf16(o[2], o[3]); *(u32x2*)(ACT + (size_t)(pm * 256 + 255) * FF + f) = w; } } }
                asm volatile("s_waitcnt vmcnt(0)" ::: "memory"); __syncthreads();
            }
            EpiResid E{X, X, XC_, XC_, MODL_, 5 * D};
            pg8::gemm_phase<EpiResid>(lds, g, S, E);
            if (l + 1 < DEPTH) {
                PH_IDS
                const int nwg = (Mrows / 256) * (D / 256), rem = nwg % G;
                if (rem == 0) { mod_layers(lds, ws, l + 1, l + 2, bx, G, tid, lane, wave); __syncthreads(); cvt_layer(lds, ws, l + 1, gw, NGW, wave, lane); }
                else if (bx >= rem) { mod_layers(lds, ws, l + 1, l + 2, bx - rem, G - rem, tid, lane, wave); __syncthreads(); cvt_layer(lds, ws, l + 1, (bx - rem) * 8 + wave, (G - rem) * 8, wave, lane); }
            }
            PHASE_END(P + 9);
        }
    }
    if (EN(14) && IN(PH_FINAL)) for (int rep_ = 0; rep_ < 1 + (int)((PROBE_MASK >> 14) & 1u); ++rep_) {
        PH_IDS
        const float* g = ARGF(28);
#if MLA_CHECK
        const bool chk_bad = __uint_as_float(__hip_atomic_load((unsigned*)(ws + WS_CTL) + CW_CHK, __ATOMIC_RELAXED, __HIP_MEMORY_SCOPE_AGENT)) > MLA_CHECK_TOL;
#endif
        if (gw < MX) {
            f32x4 v[8], vn[8]; int m = gw; row_load(X + (size_t)m * D, lane, v);
            for (;;) {
                const int mn = m + NGW; const bool has = mn < MX;
                if (has) row_load(X + (size_t)mn * D, lane, vn);
                float s = 0.f;
#pragma unroll
                for (int j = 0; j < 8; ++j) s += (v[j][0] * v[j][0] + v[j][1] * v[j][1]) + (v[j][2] * v[j][2] + v[j][3] * v[j][3]);
                const float rstd = 1.0f / sqrtf(wave_sum(s, lane) * (1.0f / D) + NORM_EPS);
                float* xr = X + (size_t)m * D;
#pragma unroll
                for (int j = 0; j < 8; ++j) { const int c = 4 * lane + 256 * j; f32x4 o_ = (v[j] * rstd) * *(const f32x4*)(g + c);
#if MLA_CHECK
                    if (chk_bad) o_ = (f32x4){__builtin_nanf(""), __builtin_nanf(""), __builtin_nanf(""), __builtin_nanf("")};
#endif
                    *(f32x4*)(xr + c) = o_; }
                if (!has) break;
#pragma unroll
                for (int j = 0; j < 8; ++j) v[j] = vn[j];
                m = mn;
            }
        }
    }
#undef IN
#undef PHASE_END
}

#if !MK_SINGLE
typedef void (*KernFn)(Args);
static KernFn phase_kernel(int bit) {
    switch (bit) {
        case 0: return mk_fwd<1u << 0>;  case 1: return mk_fwd<1u << 1>;  case 2: return mk_fwd<1u << 2>;  case 3: return mk_fwd<1u << 3>;
        case 4: return mk_fwd<1u << 4>;  case 5: return mk_fwd<1u << 5>;  case 6: return mk_fwd<1u << 6>;  case 7: return mk_fwd<1u << 7>;
        case 8: return mk_fwd<1u << 8>;  case 9: return mk_fwd<1u << 9>;  case 10: return mk_fwd<1u << 10>; case 11: return mk_fwd<1u << 11>;
        case 12: return mk_fwd<1u << 12>; case 13: return mk_fwd<1u << 13>; default: return mk_fwd<1u << 14>;
    }
}
static int phase_bit(int p) {
    if (p == 0) return 0; if (p == PH_FINAL) return 14;
    const int l = (p - 1) / PH_PER_LAYER, slot = (p - 1) % PH_PER_LAYER; const bool ret = (l & 1) != 0;
    if (slot == 0) return 1;
    if (slot >= 5) return 4 + slot;
    if (!ret) return slot == 4 ? -1 : 1 + slot;
    return 4 + slot;
}
#endif
extern "C" void kernel_launch(void* const* d_in, const int* in_sizes, int n_in, void* d_out, int out_size, void* d_ws, size_t ws_size, hipStream_t stream) {
    static int grid = 0;
    if (grid == 0) {
        if (n_in != 29 || out_size != MX * D || ws_size < WS_END) { fprintf(stderr, "kernel_launch: unexpected shapes: n_in %d out %d ws %zu (need %zu)\n", n_in, out_size, ws_size, (size_t)WS_END); grid = -1; return; }
        int dev = 0, cus = 0;
        if (hipGetDevice(&dev) != hipSuccess || hipDeviceGetAttribute(&cus, hipDeviceAttributeMultiprocessorCount, dev) != hipSuccess) { grid = -1; return; }
#if MK_SINGLE
        if (hipFuncSetAttribute((const void*)mk_fwd<0xFFFFFFFFu>, hipFuncAttributeMaxDynamicSharedMemorySize, LDS_BYTES) != hipSuccess) { fprintf(stderr, "kernel_launch: hipFuncSetAttribute failed\n"); grid = -1; return; }
#else
        for (int b = 0; b < 15; ++b) if (hipFuncSetAttribute((const void*)phase_kernel(b), hipFuncAttributeMaxDynamicSharedMemorySize, LDS_BYTES) != hipSuccess) { fprintf(stderr, "kernel_launch: hipFuncSetAttribute failed\n"); grid = -1; return; }
#endif
        (void)hipGetLastError();
        grid = cus;
    }
    if (grid < 0) return;
    if (hipMemsetAsync((char*)d_ws + WS_CTL, 0, CTL_BYTES, stream) != hipSuccess) return;
    Args a{};
    for (int i = 0; i < 29; ++i) a.in[i] = (const float*)d_in[i];
    a.out = (float*)d_out; a.ws = (unsigned char*)d_ws;
#if MK_SINGLE
    a.ph_lo = 0; a.ph_hi = PH_COUNT;
    hipLaunchKernelGGL(mk_fwd<0xFFFFFFFFu>, dim3(grid), dim3(512), LDS_BYTES, stream, a);
#else
    for (int p = 0; p < PH_COUNT; ++p) {
        const int bit = phase_bit(p); if (bit < 0) continue;
        a.ph_lo = p; a.ph_hi = p + 1;
        hipLaunchKernelGGL(phase_kernel(bit), dim3(grid), dim3(512), LDS_BYTES, stream, a);
    }
#endif
    const hipError_t le = hipPeekAtLastError();
    if (le != hipSuccess) fprintf(stderr, "kernel_launch: launch failed: %s\n", hipGetErrorName(le));
}
```

```cpp
#include <hip/hip_runtime.h>
#include <cstdio>
#include <cstdint>

#ifndef MK_SINGLE
#define MK_SINGLE 1
#endif

#ifndef MK_STAGGER
#define MK_STAGGER 0
#endif
#ifndef PROBE_EPI2
#define PROBE_EPI2 0
#endif
#ifndef MLA_CHECK
#define MLA_CHECK 0
#endif
#ifndef MLA_CHECK_LAYER
#define MLA_CHECK_LAYER 0
#endif
#ifndef MLA_CHECK_TOL
#define MLA_CHECK_TOL 0.03f
#endif
#ifndef PROBE_TS
#define PROBE_TS 0
#endif
#ifndef TS_CLASS1
#define TS_CLASS1 0
#endif
#ifndef TS_CLASS2
#define TS_CLASS2 1
#endif
#ifndef PROBE_MASK
#define PROBE_MASK 0u
#endif
#define GAS __attribute__((address_space(1)))
#define LAS __attribute__((address_space(3)))
typedef unsigned short bf16;
typedef short bf16x8 __attribute__((ext_vector_type(8)));
typedef short s16x4 __attribute__((ext_vector_type(4)));
typedef float f32x2 __attribute__((ext_vector_type(2)));
typedef float f32x4 __attribute__((ext_vector_type(4)));
typedef float f32x16 __attribute__((ext_vector_type(16)));
typedef unsigned u32x2 __attribute__((ext_vector_type(2)));
typedef unsigned u32x4 __attribute__((ext_vector_type(4)));
typedef GAS unsigned gu32;

constexpr int D = 2048, NB = 8, SEQ = 4096, CTXL = 256, DEPTH = 4;
constexpr int MX = NB * SEQ, MC = NB * CTXL, MT = MX + MC;
constexpr int FF = 5632, NMOD = 6 * D;
constexpr int MLA_H = 16, QR = 512, KVR = 512, NOPE = 128, ROPE = 64, DQ = 192;
constexpr int N1 = 1280;
constexpr int RH = 8, RDK = 256, RDV = 512;
constexpr float NORM_EPS = 1e-6f, GN_EPS = 1e-5f;
constexpr float LOG2E = 1.4426950408889634f;

constexpr size_t MiB = 1u << 20;
constexpr size_t WS_CTL = 0, CTL_BYTES = 1 * MiB;
constexpr size_t WS_MODV = 1 * MiB;
constexpr size_t WS_TABM = 3 * MiB;
constexpr size_t WS_TABR = 4 * MiB;
constexpr size_t WS_SSQ = 8 * MiB;
constexpr size_t WS_XC = 12 * MiB;
constexpr size_t WS_KR = 28 * MiB;
constexpr size_t WS_STATS = 33 * MiB;
constexpr size_t WS_WA = 40 * MiB;
constexpr size_t WS_WB = 128 * MiB;
constexpr size_t WS_H = 276 * MiB;
constexpr size_t WS_BIG = 412 * MiB;
constexpr size_t WS_QKVL = WS_BIG, WS_Q = WS_BIG + 88 * MiB, WS_KV = WS_BIG + 292 * MiB, WS_O = WS_BIG + 564 * MiB;
constexpr size_t WS_QKV = WS_BIG, WS_Y = WS_BIG + 544 * MiB, WS_GATED = WS_BIG;
constexpr size_t WS_G = WS_BIG, WS_U = WS_BIG + 374 * MiB;
constexpr size_t WS_END = WS_BIG + 1088 * MiB;
static_assert((size_t)MT * 8192 * 2 <= 544 * MiB && (size_t)MT * 5632 * 2 <= 374 * MiB && (size_t)MT * N1 * 2 <= 88 * MiB, "ws map");

constexpr int CW_BAR = 4096;

constexpr int RING_BYTES = 131072, CTRL_BASE = 155648, MISC_OFF = CTRL_BASE + 320, ARGS_OFF = CTRL_BASE + 1024, EDGE_OFF = CTRL_BASE + 4096, LDS_BYTES = 163840;

__device__ __forceinline__ unsigned cvt_pk_bf16(float lo, float hi) { unsigned r; asm volatile("v_cvt_pk_bf16_f32 %0, %1, %2" : "=v"(r) : "v"(lo), "v"(hi)); return r; }
__device__ __forceinline__ float bf2f(unsigned short b) { return __uint_as_float((unsigned)b << 16); }
__device__ __forceinline__ float bflo(unsigned w) { return __uint_as_float(w << 16); }
__device__ __forceinline__ float bfhi(unsigned w) { return __uint_as_float(w & 0xffff0000u); }
__device__ __forceinline__ float shfl_xor_l(float v, int mask, int lane) { return __builtin_bit_cast(float, __builtin_amdgcn_ds_bpermute((lane ^ mask) << 2, __builtin_bit_cast(int, v))); }
__device__ __forceinline__ float fast_silu(float x) { return x * __builtin_amdgcn_rcpf(1.0f + __builtin_amdgcn_exp2f(-x * LOG2E)); }

__device__ __forceinline__ void glds16_s(const void* sbase, unsigned voff, unsigned lds_dst) {
    unsigned keep;
    asm volatile("s_mov_b32 %0, m0\n\ts_mov_b32 m0, %3\n\ts_nop 0\n\tglobal_load_lds_dwordx4 %1, %2\n\ts_mov_b32 m0, %0" : "=&s"(keep) : "v"(voff), "s"(sbase), "s"(lds_dst) : "memory");
}
__device__ __forceinline__ const char* uni_ptr(const void* p) {
    const unsigned long long v = (unsigned long long)p; const unsigned lo = __builtin_amdgcn_readfirstlane((unsigned)v), hi = __builtin_amdgcn_readfirstlane((unsigned)(v >> 32));
    return (const char*)(((unsigned long long)hi << 32) | lo);
}
namespace pg8 {
constexpr int BM = 256, BK = 64, HALF = 128, HTB = HALF * BK * 2, STAGE_BYTES = 8 * HTB, NXCD = 8, WGM = 8;
__host__ __device__ __forceinline__ int lds_byte(int r, int c) { const int st = (r >> 4) * 2 + (c >> 5), rr = r & 15, cc = c & 31, ob = rr * 64 + cc * 2; return st * 1024 + (ob ^ (((ob >> 9) & 1) << 5)); }
__host__ __device__ __forceinline__ void stage_rc(int b, int& R, int& C) { const int st = b / 1024, sb = b % 1024, swz = sb ^ (((sb >> 9) & 1) << 5); R = (st >> 1) * 16 + swz / 64; C = (st & 1) * 32 + (swz % 64) / 2; }
__host__ __device__ __forceinline__ int perm32(int rho) { const int n = rho >> 4, i = rho & 15; return 8 * (i >> 2) + 4 * n + (i & 3); }
struct Unit { int pm, pn; };
struct Gemm { const bf16* A; const bf16* Bt; int M, N, K, lda; };
struct StaticOrder {
    int nM, nN, nwg, G, c, wgm; bool rev;
    __device__ __forceinline__ void init(int M, int N, int G_, int c_, int wgm_ = WGM, bool rev_ = false) { nM = M / BM; nN = N / BM; nwg = nM * nN; G = G_; c = c_; wgm = wgm_; rev = rev_; }
    __device__ __forceinline__ bool next(int i, Unit& u) const {
        const long L = (long)i * G + c; if (L >= nwg) return false;
        int wgid = (int)L; { const int q = nwg / NXCD, r = nwg % NXCD, xcd = wgid % NXCD, off = wgid / NXCD; wgid = (xcd < r ? xcd * (q + 1) : r * (q + 1) + (xcd - r) * q) + off; }
        const int nig = wgm * nN, gid = wgid / nig, fm = gid * wgm, gsz = (nM - fm) < wgm ? (nM - fm) : wgm;
        u.pm = fm + ((wgid % nig) % gsz); u.pn = (wgid % nig) / gsz; if (rev) u.pm = nM - 1 - u.pm; return true;
    }
};
template <class Epi>
__device__ __forceinline__ void gemm_phase(LAS unsigned char* lds, const Gemm g, const StaticOrder& S, const Epi& E) {
    int tid = threadIdx.x; asm volatile("" : "+v"(tid));
    const int wid = __builtin_amdgcn_readfirstlane(tid >> 6), lane = tid & 63, wr = wid >> 2, wc = wid & 3, fr = lane & 15, fq = lane >> 4;
    const int K = g.K, nt = K / BK;
    unsigned voffA[2], voffB[2];
#pragma unroll
    for (int i = 0; i < 2; ++i) { int R, C; stage_rc(tid * 16 + i * 8192, R, C); const int Rb = Epi::PERM ? ((R & ~31) + perm32(R & 31)) : R;
        voffA[i] = (unsigned)(R * g.lda + C) * 2u; voffB[i] = (unsigned)(Rb * K + C) * 2u; }
    const size_t kstep = (size_t)(BK * 2);
    const size_t hstepA = (size_t)HALF * g.lda * 2, hstepB = (size_t)HALF * K * 2;
    const size_t tstepA = 2 * hstepA, tstepB = 2 * hstepB;
    const unsigned ldsbase = (unsigned)__builtin_amdgcn_readfirstlane((unsigned)(uintptr_t)lds + (unsigned)wid * 1024u);
    const int aoff = lds_byte(wr * 64 + fr, fq * 8), boff = lds_byte(wc * 32 + fr, fq * 8);
#define PG8_SA(b, h) (((b) * 2 + (h)) * HTB)
#define PG8_SB(b, h) ((4 + (b) * 2 + (h)) * HTB)
#define PG8_STAGE(bufoff, gbase, voff) do { const char* _gb = uni_ptr(gbase); _Pragma("unroll") for (int _i = 0; _i < 2; ++_i) \
        glds16_s(_gb, (voff)[_i], ldsbase + (unsigned)((bufoff) + _i * 8192)); } while (0)
#define PG8_LDA(dst, b, h) do { _Pragma("unroll") for (int m = 0; m < 4; ++m) _Pragma("unroll") for (int k = 0; k < 2; ++k) dst[m][k] = *(const LAS bf16x8*)(lds + PG8_SA(b, h) + aoff + m * 2048 + k * 1024); } while (0)
#define PG8_LDB(dst, b, h) do { _Pragma("unroll") for (int n = 0; n < 2; ++n) _Pragma("unroll") for (int k = 0; k < 2; ++k) dst[n][k] = *(const LAS bf16x8*)(lds + PG8_SB(b, h) + boff + n * 2048 + k * 1024); } while (0)
#define PG8_MMA(ai, bj, At, Bt) do { __builtin_amdgcn_s_setprio(1); _Pragma("unroll") for (int m = 0; m < 4; ++m) _Pragma("unroll") for (int n = 0; n < 2; ++n) _Pragma("unroll") for (int k = 0; k < 2; ++k) \
        acc[ai][bj][m][n] = __builtin_amdgcn_mfma_f32_16x16x32_bf16(Bt[n][k], At[m][k], acc[ai][bj][m][n], 0, 0, 0); __builtin_amdgcn_s_setprio(0); } while (0)
#define PG8_WAIT_V(n) asm volatile("s_waitcnt vmcnt(" #n ")" ::: "memory")
#define PG8_WAIT_L(n) asm volatile("s_waitcnt lgkmcnt(" #n ")" ::: "memory")
#define PG8_BAR __builtin_amdgcn_s_barrier()
#define PG8_SCHED __builtin_amdgcn_sched_barrier(0)
    Unit cur, nxt; int ui = 0;
    if (!S.next(0, cur)) return;
#if MK_STAGGER
    if (S.c & 1) {
        const unsigned long long t0 = __builtin_amdgcn_s_memrealtime(); const unsigned long long dt = (unsigned long long)nt * MK_STAGGER;
        while (__builtin_amdgcn_s_memrealtime() - t0 < dt) __builtin_amdgcn_s_sleep(8);
    }
#endif
    f32x4 acc[2][2][4][2];
#pragma unroll
    for (int a = 0; a < 2; ++a)
#pragma unroll
        for (int b = 0; b < 2; ++b)
#pragma unroll
            for (int m = 0; m < 4; ++m)
#pragma unroll
                for (int n = 0; n < 2; ++n) acc[a][b][m][n] = (f32x4){0.f, 0.f, 0.f, 0.f};
    bf16x8 At[4][2], B0[2][2], B1[2][2];
    const char* cA = (const char*)g.A + (size_t)cur.pm * tstepA; const char* cB = (const char*)g.Bt + (size_t)cur.pn * tstepB;
    PG8_STAGE(PG8_SB(0, 0), cB, voffB); PG8_STAGE(PG8_SB(0, 1), cB + hstepB, voffB); PG8_STAGE(PG8_SA(0, 0), cA, voffA); PG8_STAGE(PG8_SA(0, 1), cA + hstepA, voffA);
    if (wr == 1) PG8_BAR;
    PG8_WAIT_V(2); PG8_BAR;
    PG8_STAGE(PG8_SB(1, 0), cB + kstep, voffB); PG8_STAGE(PG8_SA(1, 0), cA + kstep, voffA); PG8_STAGE(PG8_SB(1, 1), cB + hstepB + kstep, voffB);
    PG8_WAIT_V(6); PG8_BAR;
    for (;;) {
        const bool has_next = S.next(ui + 1, nxt);
        const char* nA = has_next ? (const char*)g.A + (size_t)nxt.pm * tstepA : cA; const char* nB = has_next ? (const char*)g.Bt + (size_t)nxt.pn * tstepB : cB;
        for (int t = 0; t < nt; t += 2) {
            const bool last = (t == nt - 2);
            const char* a1 = cA + (size_t)(t + 1) * kstep;
            const char* a2 = last ? nA : cA + (size_t)(t + 2) * kstep; const char* b2 = last ? nB : cB + (size_t)(t + 2) * kstep;
            const char* a3 = a2 + kstep; const char* b3 = b2 + kstep;
            PG8_LDB(B0, 0, 0); PG8_LDB(B1, 0, 1); PG8_SCHED; PG8_LDA(At, 0, 0); PG8_STAGE(PG8_SA(1, 1), a1 + hstepA, voffA);
            PG8_WAIT_V(8); PG8_WAIT_L(0); PG8_BAR; PG8_MMA(0, 0, At, B0); PG8_MMA(0, 1, At, B1); PG8_BAR; PG8_SCHED;
            PG8_LDA(At, 0, 1); PG8_STAGE(PG8_SB(0, 0), b2, voffB); PG8_STAGE(PG8_SB(0, 1), b2 + hstepB, voffB); PG8_STAGE(PG8_SA(0, 0), a2, voffA);
            PG8_WAIT_V(8); PG8_WAIT_L(0); PG8_BAR; PG8_MMA(1, 0, At, B0); PG8_MMA(1, 1, At, B1); PG8_BAR; PG8_SCHED;
            PG8_LDB(B0, 1, 0); PG8_LDB(B1, 1, 1); PG8_SCHED; PG8_LDA(At, 1, 0); PG8_STAGE(PG8_SA(0, 1), a2 + hstepA, voffA);
            PG8_WAIT_V(8); PG8_WAIT_L(0); PG8_BAR; PG8_MMA(0, 0, At, B0); PG8_MMA(0, 1, At, B1); PG8_BAR; PG8_SCHED;
            PG8_LDA(At, 1, 1); PG8_STAGE(PG8_SB(1, 0), b3, voffB); PG8_STAGE(PG8_SB(1, 1), b3 + hstepB, voffB); PG8_STAGE(PG8_SA(1, 0), a3, voffA);
            PG8_WAIT_V(8); PG8_WAIT_L(0); PG8_BAR; PG8_MMA(1, 0, At, B0); PG8_MMA(1, 1, At, B1); PG8_BAR; PG8_SCHED;
        }
        if (wr == 0) PG8_BAR;
        E(acc, cur, wr, wc, fr, fq);
#if PROBE_EPI2
        if (Epi::PROBE2) E(acc, cur, wr, wc, fr, fq);
#endif
        if (!has_next) break;
#pragma unroll
        for (int a = 0; a < 2; ++a)
#pragma unroll
            for (int b = 0; b < 2; ++b)
#pragma unroll
                for (int m = 0; m < 4; ++m)
#pragma unroll
                    for (int n = 0; n < 2; ++n) acc[a][b][m][n] = (f32x4){0.f, 0.f, 0.f, 0.f};
        cur = nxt; cA = nA; cB = nB; ++ui;
        if (wr == 1) PG8_BAR;
    }
    PG8_WAIT_V(0);
    PG8_BAR;
#undef PG8_SA
#undef PG8_SB
#undef PG8_STAGE
#undef PG8_LDA
#undef PG8_LDB
#undef PG8_MMA
#undef PG8_WAIT_V
#undef PG8_WAIT_L
#undef PG8_BAR
#undef PG8_SCHED
}
}
using pg8::Unit;

__device__ __forceinline__ u32x4 pack8(const f32x4 a, const f32x4 b) { u32x4 w; w.x = cvt_pk_bf16(a[0], a[1]); w.y = cvt_pk_bf16(a[2], a[3]); w.z = cvt_pk_bf16(b[0], b[1]); w.w = cvt_pk_bf16(b[2], b[3]); return w; }
__device__ __forceinline__ f32x4 rot2(const f32x4 v, const f32x4 cs) { f32x4 o; o[0] = v[0] * cs[0] - v[1] * cs[1]; o[1] = v[1] * cs[0] + v[0] * cs[1]; o[2] = v[2] * cs[2] - v[3] * cs[3]; o[3] = v[3] * cs[2] + v[2] * cs[3]; return o; }

__device__ __forceinline__ f32x4 mla_cs(const float* tabm, int t, int c4) {
    const int p0 = c4 >> 1; const int pos = (p0 < 16) ? (t >> 6) : (t & 63); const int f = p0 & 15;
    return *(const f32x4*)(tabm + ((size_t)pos * 16 + f) * 2);
}

struct EpiG1 {
    static constexpr bool PERM = true, PROBE2 = false;
    bf16* QKVL; float* SSQ; bf16* KR; const float* tabm;
    __device__ __forceinline__ void operator()(const f32x4 (&acc)[2][2][4][2], const Unit& u, int wr, int wc, int fr, int fq) const {
        const int row0 = u.pm * 256 + wr * 64 + fr;
        if (u.pn < 4) {
            const int col0 = u.pn * 256 + wc * 32 + 8 * fq;
#pragma unroll
            for (int ai = 0; ai < 2; ++ai)
#pragma unroll
                for (int m = 0; m < 4; ++m) { const int row = row0 + ai * 128 + m * 16; float ss = 0.f;
#pragma unroll
                    for (int bj = 0; bj < 2; ++bj) { const f32x4 v0 = acc[ai][bj][m][0], v1 = acc[ai][bj][m][1];
                        ss += (v0[0] * v0[0] + v0[1] * v0[1]) + (v0[2] * v0[2] + v0[3] * v0[3]) + (v1[0] * v1[0] + v1[1] * v1[1]) + (v1[2] * v1[2] + v1[3] * v1[3]);
                        *(u32x4*)(QKVL + (size_t)row * N1 + col0 + bj * 128) = pack8(v0, v1); }
                    { const int ln_ = fr + 16 * fq; ss += shfl_xor_l(ss, 16, ln_); ss += shfl_xor_l(ss, 32, ln_); }
                    if (fq == 0) SSQ[(size_t)row * 16 + u.pn * 4 + wc] = ss; asm volatile("" ::: "memory"); }
        } else if (wc < 2) {
            const int c8 = wc * 32 + 8 * fq;
#pragma unroll
            for (int ai = 0; ai < 2; ++ai)
#pragma unroll
                for (int m = 0; m < 4; ++m) { const int row = row0 + ai * 128 + m * 16; f32x4 v0 = acc[ai][0][m][0], v1 = acc[ai][0][m][1];
                    if (row < MX) { const int t = row & (SEQ - 1); v0 = rot2(v0, mla_cs(tabm, t, c8)); v1 = rot2(v1, mla_cs(tabm, t, c8 + 4)); }
                    *(u32x4*)(KR + (size_t)row * 64 + c8) = pack8(v0, v1); asm volatile("" ::: "memory"); }
        }
    }
};
struct EpiUq {
    static constexpr bool PERM = true, PROBE2 = false;
    bf16* Q; const float* SSQ; const float* tabm;
    __device__ __forceinline__ void operator()(const f32x4 (&acc)[2][2][4][2], const Unit& u, int wr, int wc, int fr, int fq) const {
        const int row0 = u.pm * 256 + wr * 64 + fr;
        int col8[2], dd[2];
#pragma unroll
        for (int bj = 0; bj < 2; ++bj) { col8[bj] = u.pn * 256 + bj * 128 + wc * 32 + 8 * fq; dd[bj] = col8[bj] % DQ; }
#pragma unroll
        for (int ai = 0; ai < 2; ++ai)
#pragma unroll
            for (int m = 0; m < 4; ++m) { const int row = row0 + ai * 128 + m * 16;
                const f32x4 s0 = *(const f32x4*)(SSQ + (size_t)row * 16), s1 = *(const f32x4*)(SSQ + (size_t)row * 16 + 4);
                const float ss = ((s0[0] + s0[1]) + (s0[2] + s0[3])) + ((s1[0] + s1[1]) + (s1[2] + s1[3]));
                const float r = 1.0f / sqrtf(ss * (1.0f / QR) + NORM_EPS);
#pragma unroll
                for (int bj = 0; bj < 2; ++bj) { f32x4 v0 = acc[ai][bj][m][0] * r, v1 = acc[ai][bj][m][1] * r;
                    if (dd[bj] >= NOPE && row < MX) { const int t = row & (SEQ - 1), c8 = dd[bj] - NOPE; v0 = rot2(v0, mla_cs(tabm, t, c8)); v1 = rot2(v1, mla_cs(tabm, t, c8 + 4)); }
                    *(u32x4*)(Q + (size_t)row * 3072 + col8[bj]) = pack8(v0, v1); } asm volatile("" ::: "memory"); }
    }
};
struct EpiUkv {
    static constexpr bool PERM = true, PROBE2 = false;
    bf16* KV; const float* SSQ;
    __device__ __forceinline__ void operator()(const f32x4 (&acc)[2][2][4][2], const Unit& u, int wr, int wc, int fr, int fq) const {
        const int row0 = u.pm * 256 + wr * 64 + fr; const int col0 = u.pn * 256 + wc * 32 + 8 * fq;
#pragma unroll
        for (int ai = 0; ai < 2; ++ai)
#pragma unroll
            for (int m = 0; m < 4; ++m) { const int row = row0 + ai * 128 + m * 16;
                const f32x4 s0 = *(const f32x4*)(SSQ + (size_t)row * 16 + 8), s1 = *(const f32x4*)(SSQ + (size_t)row * 16 + 12);
                const float ss = ((s0[0] + s0[1]) + (s0[2] + s0[3])) + ((s1[0] + s1[1]) + (s1[2] + s1[3]));
                const float r = 1.0f / sqrtf(ss * (1.0f / KVR) + NORM_EPS);
#pragma unroll
                for (int bj = 0; bj < 2; ++bj) *(u32x4*)(KV + (size_t)row * 4096 + col0 + bj * 128) = pack8(acc[ai][bj][m][0] * r, acc[ai][bj][m][1] * r); asm volatile("" ::: "memory"); }
    }
};
struct EpiResid {
    static constexpr bool PERM = false, PROBE2 = false;
    const float* xin; float* xout; const float* cin; float* cout; const float* modv; int gofs;
    __device__ __forceinline__ void operator()(const f32x4 (&acc)[2][2][4][2], const Unit& u, int wr, int wc, int fr, int fq) const {
        const bool isx = u.pm < (MX / 256);
        const int rloc = (isx ? u.pm * 256 : (u.pm * 256 - MX)) + wr * 64 + fr;
        const float* base = isx ? xin : cin; float* out = isx ? xout : cout;
        const float* gv = modv + (size_t)(isx ? (u.pm >> 4) : 8) * NMOD + gofs;
        const int col0 = u.pn * 256 + wc * 32 + 4 * fq;
        f32x4 g4[2][2];
#pragma unroll
        for (int bj = 0; bj < 2; ++bj)
#pragma unroll
            for (int n = 0; n < 2; ++n) g4[bj][n] = *(const f32x4*)(gv + col0 + bj * 128 + n * 16);
#pragma unroll
        for (int ai = 0; ai < 2; ++ai)
#pragma unroll
            for (int m = 0; m < 4; ++m) { const size_t off = (size_t)(rloc + ai * 128 + m * 16) * D + col0;
#pragma unroll
                for (int bj = 0; bj < 2; ++bj)
#pragma unroll
                    for (int n = 0; n < 2; ++n) { const f32x4 b = *(const f32x4*)(base + off + bj * 128 + n * 16); *(f32x4*)(out + off + bj * 128 + n * 16) = b + g4[bj][n] * acc[ai][bj][m][n]; }
                if (m & 1) asm volatile("" ::: "memory"); }
    }
};
template <int CTRL> __device__ __forceinline__ float dpp1(float x) { return __int_as_float(__builtin_amdgcn_update_dpp(0, __float_as_int(x), CTRL, 0xF, 0xF, false)); }
__device__ __forceinline__ f32x4 row_prev(const f32x4 v) { f32x4 o; o.x = dpp1<0x121>(v.x); o.y = dpp1<0x121>(v.y); o.z = dpp1<0x121>(v.z); o.w = dpp1<0x121>(v.w); return o; }
__device__ __forceinline__ f32x4 row_next(const f32x4 v) { f32x4 o; o.x = dpp1<0x12F>(v.x); o.y = dpp1<0x12F>(v.y); o.z = dpp1<0x12F>(v.z); o.w = dpp1<0x12F>(v.w); return o; }
__device__ __forceinline__ f32x4 silu4(const f32x4 v) { f32x4 o;
#pragma unroll
    for (int e = 0; e < 4; ++e) o[e] = fast_silu(v[e]); return o; }
constexpr size_t HALO_STRIDE = (size_t)FF;
struct EpiGUConv {
    static constexpr bool PERM = true, PROBE2 = true;
    bf16* ACT; float* HALO; const float* cw; const float* cb; LAS float* edge;
    __device__ __forceinline__ void operator()(const f32x4 (&acc)[2][2][4][2], const Unit& u, int wr, int wc, int fr, int fq) const {
        const int c8 = wc * 32 + 8 * fq; const int f0 = u.pn * 128 + c8;
#pragma unroll
        for (int ai = 0; ai < 2; ++ai) { const int blk = 2 * ai + wr;
            if (fr == 0)  { *(LAS f32x4*)(edge + (blk * 2 + 0) * 128 + c8) = acc[ai][0][0][0]; *(LAS f32x4*)(edge + (blk * 2 + 0) * 128 + c8 + 4) = acc[ai][0][0][1]; }
            if (fr == 15) { *(LAS f32x4*)(edge + (blk * 2 + 1) * 128 + c8) = acc[ai][0][3][0]; *(LAS f32x4*)(edge + (blk * 2 + 1) * 128 + c8 + 4) = acc[ai][0][3][1]; } }
        asm volatile("s_waitcnt lgkmcnt(0)" ::: "memory"); __builtin_amdgcn_s_barrier(); asm volatile("" ::: "memory");
        f32x4 w0[2], w1[2], w2[2], bb[2];
#pragma unroll
        for (int n = 0; n < 2; ++n) { w0[n] = *(const f32x4*)(cw + f0 + 4 * n); w1[n] = *(const f32x4*)(cw + FF + f0 + 4 * n); w2[n] = *(const f32x4*)(cw + 2 * FF + f0 + 4 * n); bb[n] = *(const f32x4*)(cb + f0 + 4 * n); }
        const f32x4 zero4 = {0.f, 0.f, 0.f, 0.f};
#pragma unroll
        for (int ai = 0; ai < 2; ++ai) { const int blk = 2 * ai + wr;
#pragma unroll
            for (int m = 0; m < 4; ++m) { const int row = u.pm * 256 + ai * 128 + wr * 64 + m * 16 + fr; f32x4 o[2];
#pragma unroll
                for (int n = 0; n < 2; ++n) { const f32x4 cur = acc[ai][0][m][n];
                    f32x4 b, d;
                    if (m > 0) b = row_prev(acc[ai][0][m - 1][n]); else b = (blk > 0) ? *(const LAS f32x4*)(edge + ((blk - 1) * 2 + 1) * 128 + c8 + 4 * n) : zero4;
                    if (m < 3) d = row_next(acc[ai][0][m + 1][n]); else d = (blk < 3) ? *(const LAS f32x4*)(edge + ((blk + 1) * 2 + 0) * 128 + c8 + 4 * n) : zero4;
                    const f32x4 a = row_prev(cur), c = row_next(cur);
                    const f32x4 up = (fr == 0) ? b : a, dn = (fr == 15) ? d : c;
                    const f32x4 cv = w0[n] * up + w1[n] * cur + w2[n] * dn + bb[n]; const f32x4 uu = acc[ai][1][m][n];
                    o[n] = silu4(cv) * uu;
                    if (m == 0 && blk == 0 && fr == 0) { float* hp = HALO + (size_t)((u.pm * 2 + 0) * 3) * HALO_STRIDE + f0 + 4 * n; *(f32x4*)hp = cv; *(f32x4*)(hp + HALO_STRIDE) = cur; *(f32x4*)(hp + 2 * HALO_STRIDE) = uu; }
                    if (m == 3 && blk == 3 && fr == 15) { float* hp = HALO + (size_t)((u.pm * 2 + 1) * 3) * HALO_STRIDE + f0 + 4 * n; *(f32x4*)hp = cv; *(f32x4*)(hp + HALO_STRIDE) = cur; *(f32x4*)(hp + 2 * HALO_STRIDE) = uu; } }
                *(u32x4*)(ACT + (size_t)row * FF + f0) = pack8(o[0], o[1]); asm volatile("" ::: "memory"); } }
        asm volatile("s_waitcnt lgkmcnt(0)" ::: "memory"); __builtin_amdgcn_s_barrier(); asm volatile("" ::: "memory");
    }
};
struct EpiQKV {
    static constexpr bool PERM = true, PROBE2 = false;
    bf16* QKV; const float* tabr;
    __device__ __forceinline__ void operator()(const f32x4 (&acc)[2][2][4][2], const Unit& u, int wr, int wc, int fr, int fq) const {
        const int row0 = u.pm * 256 + wr * 64 + fr; const int col0 = u.pn * 256 + wc * 32 + 8 * fq;
        const bool rope = (u.pn < 16) && (u.pm < MX / 256);
#pragma unroll
        for (int ai = 0; ai < 2; ++ai)
#pragma unroll
            for (int m = 0; m < 4; ++m) { const int row = row0 + ai * 128 + m * 16;
#pragma unroll
                for (int bj = 0; bj < 2; ++bj) { f32x4 v0 = acc[ai][bj][m][0], v1 = acc[ai][bj][m][1]; const int col = col0 + bj * 128;
                    if (rope) { const int t = row & (SEQ - 1); const float* tp = tabr + ((size_t)t * 128 + ((col & 255) >> 1)) * 2;
                        v0 = rot2(v0, *(const f32x4*)tp); v1 = rot2(v1, *(const f32x4*)(tp + 4)); }
                    *(u32x4*)(QKV + (size_t)row * 8192 + col) = pack8(v0, v1); } asm volatile("" ::: "memory"); }
    }
};
struct EpiGate {
    static constexpr bool PERM = true, PROBE2 = false;
    bf16* GATED; const bf16* YF; const bf16* YB; const float* ST;
    __device__ __forceinline__ void operator()(const f32x4 (&acc)[2][2][4][2], const Unit& u, int wr, int wc, int fr, int fq) const {
        const int row0 = u.pm * 256 + wr * 64 + fr; const int f0 = u.pn * 128 + wc * 32 + 8 * fq; const int hd = u.pn >> 2;
#pragma unroll
        for (int ai = 0; ai < 2; ++ai)
#pragma unroll
            for (int m = 0; m < 4; ++m) { const int row = row0 + ai * 128 + m * 16; const size_t off = (size_t)row * 4096 + f0;
                const u32x4 yf = *(const u32x4*)(YF + off), yb = *(const u32x4*)(YB + off);
                const f32x2 sf = *(const f32x2*)(ST + ((size_t)row * 8 + hd) * 2), sb = *(const f32x2*)(ST + ((size_t)(MT + row) * 8 + hd) * 2);
                const f32x4 a0 = acc[ai][0][m][0], a1 = acc[ai][0][m][1], b0 = acc[ai][1][m][0], b1 = acc[ai][1][m][1];
#define NF(w, hi_) (((hi_ ? bfhi(w) : bflo(w)) - sf[0]) * sf[1])
#define NB(w, hi_) (((hi_ ? bfhi(w) : bflo(w)) - sb[0]) * sb[1])
                f32x4 o0, o1;
                o0[0] = fast_silu(a0[0]) * NF(yf.x, 0) + fast_silu(b0[0]) * NB(yb.x, 0); o0[1] = fast_silu(a0[1]) * NF(yf.x, 1) + fast_silu(b0[1]) * NB(yb.x, 1);
                o0[2] = fast_silu(a0[2]) * NF(yf.y, 0) + fast_silu(b0[2]) * NB(yb.y, 0); o0[3] = fast_silu(a0[3]) * NF(yf.y, 1) + fast_silu(b0[3]) * NB(yb.y, 1);
                o1[0] = fast_silu(a1[0]) * NF(yf.z, 0) + fast_silu(b1[0]) * NB(yb.z, 0); o1[1] = fast_silu(a1[1]) * NF(yf.z, 1) + fast_silu(b1[1]) * NB(yb.z, 1);
                o1[2] = fast_silu(a1[2]) * NF(yf.w, 0) + fast_silu(b1[2]) * NB(yb.w, 0); o1[3] = fast_silu(a1[3]) * NF(yf.w, 1) + fast_silu(b1[3]) * NB(yb.w, 1);
#undef NF
#undef NB
                *(u32x4*)(GATED + off) = pack8(o0, o1); asm volatile("" ::: "memory"); }
    }
};

namespace att {
constexpr int NW = 8, QBLK = 32, KVBLK = 64;
constexpr int SHM_V = 16384, SHM_KN = 16384, SHM_KR = 8192;
constexpr int OFF_V = 0, OFF_KN = 3 * SHM_V, OFF_KR = OFF_KN + 2 * SHM_KN, OFF_WS = OFF_KR + 2 * SHM_KR, SHM_ATTN = OFF_WS + NW * 64 * 4;
constexpr float THR2 = 11.5f;
#define KSWZ(row, colB) ((row) * 256 + ((colB) ^ (((row) & 7) << 4)))
#define KRSWZ(row, colB) ((row) * 128 + ((colB) ^ ((((row) >> 1) & 7) << 4)))
#define SBAR() __builtin_amdgcn_sched_barrier(0)
__device__ __forceinline__ int crow(int r, int hi) { return (r & 3) + 8 * (r >> 2) + 4 * hi; }
__device__ __forceinline__ void partialSM(f32x16& p0, f32x16& p1, float& m_reg, float& alpha) {
  float pmax = p0[0];
#pragma unroll
  for (int r = 1; r < 16; ++r) pmax = fmaxf(pmax, p0[r]);
#pragma unroll
  for (int r = 0; r < 16; ++r) pmax = fmaxf(pmax, p1[r]);
  { auto rr = __builtin_amdgcn_permlane32_swap(__float_as_uint(pmax), __float_as_uint(pmax), false, false); pmax = fmaxf(__uint_as_float(rr[0]), __uint_as_float(rr[1])); }
  float mn;
  if (__builtin_expect(__all(pmax - m_reg <= THR2), 1)) { mn = m_reg; alpha = 1.f; }
  else { mn = fmaxf(m_reg, pmax); alpha = __builtin_amdgcn_exp2f(m_reg - mn); m_reg = mn; }
#pragma unroll
  for (int r = 0; r < 16; ++r) p0[r] = p0[r] - mn;
#pragma unroll
  for (int r = 0; r < 16; ++r) p1[r] = p1[r] - mn;
#pragma unroll
  for (int r = 0; r < 16; ++r) p0[r] = __builtin_amdgcn_exp2f(p0[r]);
}
__device__ __forceinline__ void finishSM(f32x16& p0, f32x16& p1, float alpha, float& l_reg, bf16x8& pa0, bf16x8& pa1, bf16x8& pa2, bf16x8& pa3) {
#pragma unroll
  for (int r = 0; r < 16; ++r) p1[r] = __builtin_amdgcn_exp2f(p1[r]);
  float ps = 0;
#pragma unroll
  for (int r = 0; r < 16; ++r) ps += p0[r];
#pragma unroll
  for (int r = 0; r < 16; ++r) ps += p1[r];
  { auto rr = __builtin_amdgcn_permlane32_swap(__float_as_uint(ps), __float_as_uint(ps), false, false); ps = __uint_as_float(rr[0]) + __uint_as_float(rr[1]); }
  l_reg = l_reg * alpha + ps;
#define PK4(P, BASE, OUT) do { unsigned a0 = cvt_pk_bf16(P[BASE + 0], P[BASE + 1]), a1 = cvt_pk_bf16(P[BASE + 2], P[BASE + 3]);   \
    unsigned b0 = cvt_pk_bf16(P[BASE + 4], P[BASE + 5]), b1 = cvt_pk_bf16(P[BASE + 6], P[BASE + 7]);                              \
    auto r0 = __builtin_amdgcn_permlane32_swap(a0, b0, false, false); auto r1 = __builtin_amdgcn_permlane32_swap(a1, b1, false, false); \
    u32x4 w = {r0[0], r1[0], r0[1], r1[1]}; OUT = __builtin_bit_cast(bf16x8, w); } while (0)
  PK4(p0, 0, pa0); PK4(p0, 8, pa1); PK4(p1, 0, pa2); PK4(p1, 8, pa3);
#undef PK4
}
__device__ __forceinline__ void qkt(f32x16& p0, f32x16& p1, const char* Kn, const char* Kr, const bf16x8* qr, int r32, int hi) {
  p0 = f32x16{}; p1 = f32x16{};
#pragma unroll
  for (int d0 = 0; d0 < 8; ++d0) { const int cb = (d0 * 16 + hi * 8) * 2;
    const bf16x8 b0 = *reinterpret_cast<const bf16x8*>(Kn + KSWZ(r32, cb));
    const bf16x8 b1 = *reinterpret_cast<const bf16x8*>(Kn + KSWZ(32 + r32, cb));
    p0 = __builtin_amdgcn_mfma_f32_32x32x16_bf16(b0, qr[d0], p0, 0, 0, 0);
    p1 = __builtin_amdgcn_mfma_f32_32x32x16_bf16(b1, qr[d0], p1, 0, 0, 0); }
#pragma unroll
  for (int d0 = 0; d0 < 4; ++d0) { const int cb = (d0 * 16 + hi * 8) * 2;
    const bf16x8 b0 = *reinterpret_cast<const bf16x8*>(Kr + KRSWZ(r32, cb));
    const bf16x8 b1 = *reinterpret_cast<const bf16x8*>(Kr + KRSWZ(32 + r32, cb));
    p0 = __builtin_amdgcn_mfma_f32_32x32x16_bf16(b0, qr[8 + d0], p0, 0, 0, 0);
    p1 = __builtin_amdgcn_mfma_f32_32x32x16_bf16(b1, qr[8 + d0], p1, 0, 0, 0); }
}
__device__ __forceinline__ int v_st(int k, int c) { const int kk = (k & ~0xC) | ((k & 4) << 1) | ((k & 8) >> 1); return ((kk >> 3) * 4 + (c >> 5)) * 512 + ((kk & 7) * 32 + (c & 31)) * 2; }
__device__ __forceinline__ int v_rd_base(int lane) { return ((lane & 3) << 3) | (((lane >> 2) & 3) << 6) | (((lane >> 4) & 1) << 5) | (((lane >> 5) & 1) << 8); }
constexpr int v_rd_off(int d0, int ks, int half) { return d0 * 512 + ks * 4096 + half * 2048; }
template <int OFF> __device__ __forceinline__ s16x4 tr_read(int vb) { s16x4 r; asm volatile("ds_read_b64_tr_b16 %0, %1 offset:%2" : "=&v"(r) : "v"(vb), "i"(OFF) : "memory"); return r; }
template <int D0> __device__ __forceinline__ void pv_one(f32x16& od, int vb, bf16x8 pa0, bf16x8 pa1, bf16x8 pa2, bf16x8 pa3) {
  const s16x4 l0 = tr_read<v_rd_off(D0, 0, 0)>(vb), h0 = tr_read<v_rd_off(D0, 0, 1)>(vb), l1 = tr_read<v_rd_off(D0, 1, 0)>(vb), h1 = tr_read<v_rd_off(D0, 1, 1)>(vb);
  const s16x4 l2 = tr_read<v_rd_off(D0, 2, 0)>(vb), h2 = tr_read<v_rd_off(D0, 2, 1)>(vb), l3 = tr_read<v_rd_off(D0, 3, 0)>(vb), h3 = tr_read<v_rd_off(D0, 3, 1)>(vb);
  asm volatile("s_waitcnt lgkmcnt(0)" ::: "memory"); SBAR();
#define PK(L, H) (bf16x8){L[0], L[1], L[2], L[3], H[0], H[1], H[2], H[3]}
  od = __builtin_amdgcn_mfma_f32_32x32x16_bf16(pa0, PK(l0, h0), od, 0, 0, 0);
  od = __builtin_amdgcn_mfma_f32_32x32x16_bf16(pa1, PK(l1, h1), od, 0, 0, 0);
  od = __builtin_amdgcn_mfma_f32_32x32x16_bf16(pa2, PK(l2, h2), od, 0, 0, 0);
  od = __builtin_amdgcn_mfma_f32_32x32x16_bf16(pa3, PK(l3, h3), od, 0, 0, 0);
#undef PK
}
__device__ __forceinline__ void pv_d0(f32x16* o, int vb, bf16x8 pa0, bf16x8 pa1, bf16x8 pa2, bf16x8 pa3) {
  pv_one<0>(o[0], vb, pa0, pa1, pa2, pa3); pv_one<1>(o[1], vb, pa0, pa1, pa2, pa3); pv_one<2>(o[2], vb, pa0, pa1, pa2, pa3); pv_one<3>(o[3], vb, pa0, pa1, pa2, pa3);
}
__device__ __forceinline__ void attn_unit(const bf16* __restrict__ Qb, const bf16* __restrict__ KVh, const bf16* __restrict__ KRp, bf16* __restrict__ Ob,
                                          int NT, int nc, int cbase, int xbase, char* lds) {
  int tid = threadIdx.x; asm volatile("" : "+v"(tid));
  const int wid = __builtin_amdgcn_readfirstlane(tid >> 6), lane = tid & 63, r32 = lane & 31, hi = lane >> 5;
  char* V_lds = lds + OFF_V; char* Kn_lds = lds + OFF_KN; char* Kr_lds = lds + OFF_KR;
  float* ws = (float*)(lds + OFF_WS) + wid * 64; float* li_l = ws; float* al_l = ws + 32;
  float m_reg = -1e30f, l_reg = 0; f32x16 o[4] = {}; bf16x8 qr[12];
  const bf16* Qw = Qb + (long)(wid * QBLK + r32) * 3072 + hi * 8;
#pragma unroll
  for (int d0 = 0; d0 < 12; ++d0) qr[d0] = *reinterpret_cast<const bf16x8*>(Qw + d0 * 16);
  const int vb0 = (int)(uintptr_t)V_lds + v_rd_base(lane);
  unsigned vofK[2], vofV[2], vofR;
#pragma unroll
  for (int i = 0; i < 2; ++i) { const int pc = wid * 2 + i;
      { const int row = pc * 4 + (lane >> 4), ch = (lane & 15) ^ (row & 7); vofK[i] = (unsigned)((row * 4096 + ch * 8) * 2); }
      { const int ob = pc * 1024 + lane * 16, st = ob >> 9, w = ob & 511, kk = (st >> 2) * 8 + (w >> 6); const int k = (kk & ~0xC) | ((kk & 4) << 1) | ((kk & 8) >> 1);
        const int c = (st & 3) * 32 + 8 * ((w & 63) >> 4); vofV[i] = (unsigned)((k * 4096 + 128 + c) * 2); } }
  { const int row = wid * 8 + (lane >> 3), ch = (lane & 7) ^ ((row >> 1) & 7); vofR = (unsigned)((row * 64 + ch * 8) * 2); }
  const unsigned ldsK = (unsigned)__builtin_amdgcn_readfirstlane((unsigned)(uintptr_t)Kn_lds + (unsigned)wid * 2048u);
  const unsigned ldsV = (unsigned)__builtin_amdgcn_readfirstlane((unsigned)(uintptr_t)V_lds + (unsigned)wid * 2048u);
  const unsigned ldsR = (unsigned)__builtin_amdgcn_readfirstlane((unsigned)(uintptr_t)Kr_lds + (unsigned)wid * 1024u);
#define KROW(j) ((j) < nc ? cbase + (j) * KVBLK : xbase + ((j) - nc) * KVBLK)
#define DMA_TILE(j, kslot, vslot) do { const long k0_ = KROW(j); const char* kb_ = uni_ptr(KVh + k0_ * 4096); const char* rb_ = uni_ptr(KRp + k0_ * 64); \
    glds16_s(kb_, vofK[0], ldsK + (kslot) * SHM_KN); glds16_s(kb_, vofK[1], ldsK + (kslot) * SHM_KN + 1024u); \
    glds16_s(rb_, vofR, ldsR + (kslot) * SHM_KR); \
    glds16_s(kb_, vofV[0], ldsV + (vslot) * SHM_V); glds16_s(kb_, vofV[1], ldsV + (vslot) * SHM_V + 1024u); } while (0)
#ifndef ATT_SKEW
#define ATT_SKEW 0
#endif
#define WAIT_SYNC() do { asm volatile("s_waitcnt vmcnt(0)" ::: "memory"); __syncthreads(); if (ATT_SKEW && wid >= 4) __builtin_amdgcn_s_sleep(ATT_SKEW); } while (0)
#define RESC(a) do { if (__any((a) < 1.f)) { if (hi == 0) al_l[r32] = (a); asm volatile("s_waitcnt lgkmcnt(0)" ::: "memory"); \
    _Pragma("unroll") for (int d = 0; d < 4; ++d) _Pragma("unroll") for (int r = 0; r < 16; ++r) o[d][r] *= al_l[crow(r, hi)]; } } while (0)
  f32x16 pA0, pA1, pB0, pB1; float alA, alB; bf16x8 pa0, pa1, pa2, pa3;
  DMA_TILE(0, 0, 0); DMA_TILE(1, 1, 1); WAIT_SYNC();
  qkt(pA0, pA1, Kn_lds, Kr_lds, qr, r32, hi); partialSM(pA0, pA1, m_reg, alA);
  __syncthreads();
  int vprev = 0, vcur = 1, vnext = 2;
  for (int j = 1; j + 1 < NT; j += 2) {
    DMA_TILE(j + 1, 0, vnext);
    SBAR(); qkt(pB0, pB1, Kn_lds + SHM_KN, Kr_lds + SHM_KR, qr, r32, hi);
    finishSM(pA0, pA1, alA, l_reg, pa0, pa1, pa2, pa3); SBAR();
    pv_d0(o, vb0 + vprev * SHM_V, pa0, pa1, pa2, pa3); partialSM(pB0, pB1, m_reg, alB);
    RESC(alB); WAIT_SYNC();
    { const int t_ = vprev; vprev = vcur; vcur = vnext; vnext = t_; }
    if (j + 2 < NT) DMA_TILE(j + 2, 1, vnext);
    SBAR(); qkt(pA0, pA1, Kn_lds, Kr_lds, qr, r32, hi);
    finishSM(pB0, pB1, alB, l_reg, pa0, pa1, pa2, pa3); SBAR();
    pv_d0(o, vb0 + vprev * SHM_V, pa0, pa1, pa2, pa3); partialSM(pA0, pA1, m_reg, alA);
    RESC(alA); WAIT_SYNC();
    { const int t_ = vprev; vprev = vcur; vcur = vnext; vnext = t_; }
  }
  SBAR(); qkt(pB0, pB1, Kn_lds + SHM_KN, Kr_lds + SHM_KR, qr, r32, hi);
  finishSM(pA0, pA1, alA, l_reg, pa0, pa1, pa2, pa3); SBAR();
  pv_d0(o, vb0 + vprev * SHM_V, pa0, pa1, pa2, pa3); partialSM(pB0, pB1, m_reg, alB);
  RESC(alB);
  finishSM(pB0, pB1, alB, l_reg, pa0, pa1, pa2, pa3); SBAR();
  pv_d0(o, vb0 + vcur * SHM_V, pa0, pa1, pa2, pa3);
  if (hi == 0) li_l[r32] = l_reg; asm volatile("s_waitcnt lgkmcnt(0)" ::: "memory");
  float rli[16];
#pragma unroll
  for (int r = 0; r < 16; ++r) rli[r] = __builtin_amdgcn_rcpf(li_l[crow(r, hi)]);
  bf16* Ow = Ob + (long)(wid * QBLK) * 2048;
#pragma unroll
  for (int r = 0; r < 16; ++r) { const int orow = crow(r, hi);
#pragma unroll
    for (int d0 = 0; d0 < 4; ++d0) Ow[(long)orow * 2048 + d0 * 32 + r32] = (bf16)(cvt_pk_bf16(o[d0][r] * rli[r], 0.f) & 0xffffu); }
  __syncthreads();
#undef KROW
#undef DMA_TILE
#undef WAIT_SYNC
#undef RESC
}
#undef SBAR
}

namespace scan {
constexpr int CH = 64;
constexpr int OFF_Q = 0, OFF_K = 32768  , OFF_V = 98304, OFF_P = 131072, SHM_SCAN = 131072 + 8192;
__device__ __forceinline__ unsigned off_b(unsigned row, unsigned ch) { return 256u * row + 16u * (ch ^ (((row & 3) << 2) | ((row >> 2) & 3))); }
__device__ __forceinline__ unsigned p_off(unsigned i, unsigned chunk) { return 128u * i + 16u * (chunk ^ ((i >> 1) & 7)); }
__device__ __forceinline__ int crow(int r, int hi) { return (r & 3) + 8 * (r >> 2) + 4 * hi; }
__device__ __forceinline__ s16x4 vtr(const LAS char* p) { typedef short v4i16_t __attribute__((ext_vector_type(4))); return __builtin_bit_cast(s16x4, __builtin_amdgcn_ds_read_tr16_b64_v4i16((LAS v4i16_t*)p)); }
__device__ __forceinline__ bf16x8 tr_frag(const LAS char* img, int lane, int c, int ks) {
    const unsigned h = lane >> 5, blk = (lane >> 4) & 1, q = (lane & 15) >> 2, p = lane & 3;
    const unsigned r0 = 16 * ks + 8 * h + q, chn = 4 * c + 2 * blk + (p >> 1);
    const s16x4 lo = vtr(img + off_b(r0, chn) + 8 * (p & 1)), hi = vtr(img + off_b(r0 + 4, chn) + 8 * (p & 1));
    return (bf16x8){lo[0], lo[1], lo[2], lo[3], hi[0], hi[1], hi[2], hi[3]};
}
__device__ __forceinline__ bf16x8 pack_step(const f32x16& x, int s) {
    u32x4 p; p.x = cvt_pk_bf16(x[8 * s + 0], x[8 * s + 1]); p.y = cvt_pk_bf16(x[8 * s + 2], x[8 * s + 3]); p.z = cvt_pk_bf16(x[8 * s + 4], x[8 * s + 5]); p.w = cvt_pk_bf16(x[8 * s + 6], x[8 * s + 7]);
    return __builtin_bit_cast(bf16x8, p);
}
__device__ __forceinline__ void dma_mat(const bf16* src, int ld, LAS unsigned char* dst, int wid, int lane) {
    const char* sb = uni_ptr(src); const unsigned d0 = (unsigned)__builtin_amdgcn_readfirstlane((unsigned)(uintptr_t)dst + (unsigned)wid * 4096u);
#pragma unroll
    for (int k = 0; k < 4; ++k) { const int pc = wid * 4 + k, img = pc >> 4, row = 4 * (pc & 15) + (lane >> 4), pos = lane & 15;
        const int ch = pos ^ (((row & 3) << 2) | ((row >> 2) & 3));
        glds16_s(sb, (unsigned)((row * ld + img * 128 + ch * 8) * 2), d0 + (unsigned)k * 1024u); }
}
__device__ __forceinline__ int scan_rowbase(int n, int b, int dir) { return (n < 4) ? MX + b * CTXL + (dir ? 3 - n : n) * CH : b * SEQ + (dir ? 67 - n : n - 4) * CH; }
__device__ __forceinline__ float uni_f(float x) { return __uint_as_float(__builtin_amdgcn_readfirstlane(__float_as_uint(x))); }
typedef const LAS s16x4* lds_s4p;
__device__ __forceinline__ void scan_unit(const bf16* __restrict__ QKV, bf16* __restrict__ Y, int b, int hd, int dir, int dvh, float lg2, bool skip_ctx_y, LAS unsigned char* lds) {
    int tid = threadIdx.x; asm volatile("" : "+v"(tid));
    const int wid = __builtin_amdgcn_readfirstlane(tid >> 6), lane0 = tid & 63;
    const LAS char* QI = (const LAS char*)lds + OFF_Q; const LAS char* VI = (const LAS char*)lds + OFF_V;
    LAS char* PI = (LAS char*)lds + OFF_P;
    f32x16 S[8];
#pragma unroll
    for (int i = 0; i < 8; ++i) S[i] = f32x16{};
    const float lgr = dir ? -lg2 : lg2;
    const float g64 = uni_f(__builtin_amdgcn_exp2f(64.f * lg2));
    const float R1 = uni_f(__builtin_amdgcn_exp2f(lgr)), R8 = uni_f(__builtin_amdgcn_exp2f(8.f * lgr)), R32 = uni_f(__builtin_amdgcn_exp2f(32.f * lgr));
    const float Rm1 = uni_f(__builtin_amdgcn_exp2f(-lgr)), Rm16 = uni_f(__builtin_amdgcn_exp2f(-16.f * lgr));
    const float c0 = uni_f(dir ? g64 : __builtin_amdgcn_exp2f(lg2)), z0 = uni_f(dir ? 1.0f : __builtin_amdgcn_exp2f(63.f * lg2));
    const int qcol = hd * RDK, kcol = 2048 + hd * RDK, vcol = 4096 + hd * RDV + dvh * 256;
    { const bf16* src = QKV + (size_t)scan_rowbase(0, b, dir) * 8192;
      dma_mat(src + qcol, 8192, lds + OFF_Q, wid, lane0); dma_mat(src + kcol, 8192, lds + OFF_K, wid, lane0); dma_mat(src + vcol, 8192, lds + OFF_V, wid, lane0);
      asm volatile("s_waitcnt vmcnt(0)" ::: "memory"); __syncthreads(); }
    for (int n = 0; n < 68; ++n) {
        int lane = lane0; asm volatile("" : "+v"(lane));
        const int r = lane & 31, h = lane >> 5, fr = lane & 15, fq = lane >> 4;
        const int rowbase = scan_rowbase(n, b, dir);
        const bool more = n + 1 < 68;
        const bf16* nsrc = QKV + (size_t)scan_rowbase(more ? n + 1 : n, b, dir) * 8192;
        const LAS char* KI = (const LAS char*)lds + OFF_K + (n & 1) * 32768;
        if (more) dma_mat(nsrc + kcol, 8192, lds + OFF_K + ((n + 1) & 1) * 32768, wid, lane);
        const float LR = c0 * __builtin_amdgcn_exp2f((float)(4 * h) * lgr), LZ = z0 * __builtin_amdgcn_exp2f((float)(-8 * h) * lgr), LP = __builtin_amdgcn_exp2f((float)(fr - 4 * fq) * lgr);
        { const int fH = fr & 3, fL = (fr >> 2) & 3; const int AL = 256 * fr + 16 * (fq ^ fL);
          int AH[4];
#pragma unroll
          for (int k = 0; k < 4; ++k) AH[k] = 64 * (k ^ fH);
#pragma unroll
          for (int tix = 0; tix < 2; ++tix) { const int tt = wid * 2 + tix, jt = tt >> 2, it = tt & 3;
            f32x4 pt = {0.f, 0.f, 0.f, 0.f};
            const bool live = dir ? (jt >= it) : (jt <= it);
            if (live) { const LAS char* ka = KI + 4096 * jt + AL; const LAS char* qa = QI + 4096 * it + AL;
#pragma unroll
                for (int ks = 0; ks < 8; ++ks) { const int o = (ks >> 2) * 16384 + AH[ks & 3];
                    pt = __builtin_amdgcn_mfma_f32_16x16x32_bf16(*(const LAS bf16x8*)(ka + o), *(const LAS bf16x8*)(qa + o), pt, 0, 0, 0); } }
            float we = LP * __builtin_amdgcn_exp2f((float)(16 * (it - jt)) * lgr); float v[4];
            const int mrel = fr - 4 * fq;
#pragma unroll
            for (int e = 0; e < 4; ++e) { float x = live ? pt[e] * we : 0.f; if (jt == it) { const bool keep = dir ? (e >= mrel) : (e <= mrel); x = keep ? x : 0.f; } v[e] = x; we *= Rm1; }
            const int i = it * 16 + fr, j0 = jt * 16 + 4 * fq;
            u32x2 w; w.x = cvt_pk_bf16(v[0], v[1]); w.y = cvt_pk_bf16(v[2], v[3]);
            *(LAS u32x2*)(PI + p_off(i, j0 >> 3) + ((j0 >> 2) & 1) * 8) = w; } }
        f32x16 Yt[2]; Yt[0] = f32x16{}; Yt[1] = f32x16{};
        { const int fH = r & 3, fL = (r >> 2) & 3; int QH[4], QL[4];
#pragma unroll
          for (int k = 0; k < 4; ++k) { QH[k] = 64 * (k ^ fH); QL[k] = 256 * r + 8 * h + 16 * (k ^ fL); }
#pragma unroll
          for (int dkb = 0; dkb < 8; ++dkb)
#pragma unroll
            for (int s = 0; s < 2; ++s) { const bf16x8 bf = pack_step(S[dkb], s);
                const LAS char* rp = QI + (dkb >> 2) * 16384 + QH[dkb & 3];
#pragma unroll
                for (int it = 0; it < 2; ++it) {
                    const u32x2 lo = *(const LAS u32x2*)(rp + it * 8192 + QL[2 * s]), hi2 = *(const LAS u32x2*)(rp + it * 8192 + QL[2 * s + 1]);
                    const u32x4 aw = {lo.x, lo.y, hi2.x, hi2.y};
                    Yt[it] = __builtin_amdgcn_mfma_f32_32x32x16_bf16(__builtin_bit_cast(bf16x8, aw), bf, Yt[it], 0, 0, 0); } } }
        { float fit = LR;
#pragma unroll
          for (int it = 0; it < 2; ++it) { float fa = fit;
#pragma unroll
            for (int a4 = 0; a4 < 4; ++a4) { float fb = fa;
#pragma unroll
                for (int b4 = 0; b4 < 4; ++b4) { Yt[it][4 * a4 + b4] *= fb; fb *= R1; }
                fa *= R8; }
            fit *= R32; } }
        if (more) asm volatile("s_waitcnt vmcnt(4)" ::: "memory"); else asm volatile("s_waitcnt vmcnt(0)" ::: "memory");
        __syncthreads();
        if (more) dma_mat(nsrc + qcol, 8192, lds + OFF_Q, wid, lane);
#pragma unroll
        for (int i = 0; i < 8; ++i)
#pragma unroll
            for (int rg = 0; rg < 16; ++rg) S[i][rg] *= g64;
        {
          const int blk = (lane >> 4) & 1, q = (lane & 15) >> 2, p = lane & 3; int TB[2], CQ[4];
#pragma unroll
          for (int t = 0; t < 2; ++t) TB[t] = 2048 * h + 256 * q + 1024 * t + 16 * ((2 * blk + (p >> 1)) ^ ((2 * h + t) & 3)) + 8 * (p & 1);
#pragma unroll
          for (int c = 0; c < 4; ++c) CQ[c] = 64 * (c ^ q);
          const LAS char* vb = VI + (wid >> 2) * 16384 + CQ[wid & 3];
          float zk = LZ;
#pragma unroll
          for (int ks = 0; ks < 4; ++ks) {
            const s16x4 vlo = vtr(vb + 4096 * ks + TB[0]), vhi = vtr(vb + 4096 * ks + TB[1]);
            const u32x2 vl = __builtin_bit_cast(u32x2, vlo), vh = __builtin_bit_cast(u32x2, vhi);
            const u32x4 vw = {vl.x, vl.y, vh.x, vh.y}; const bf16x8 vf = __builtin_bit_cast(bf16x8, vw);
#pragma unroll
            for (int it = 0; it < 2; ++it) { const bf16x8 pa = *(const LAS bf16x8*)(PI + p_off(it * 32 + r, 2 * ks + h));
                Yt[it] = __builtin_amdgcn_mfma_f32_32x32x16_bf16(pa, vf, Yt[it], 0, 0, 0); }
            float zj = zk; u32x4 zw;
            { const float a0 = bflo(vw.x) * zj; zj *= Rm1; const float a1 = bfhi(vw.x) * zj; zj *= Rm1; zw.x = cvt_pk_bf16(a0, a1); }
            { const float a0 = bflo(vw.y) * zj; zj *= Rm1; const float a1 = bfhi(vw.y) * zj; zj *= Rm1; zw.y = cvt_pk_bf16(a0, a1); }
            { const float a0 = bflo(vw.z) * zj; zj *= Rm1; const float a1 = bfhi(vw.z) * zj; zj *= Rm1; zw.z = cvt_pk_bf16(a0, a1); }
            { const float a0 = bflo(vw.w) * zj; zj *= Rm1; const float a1 = bfhi(vw.w) * zj; zw.w = cvt_pk_bf16(a0, a1); }
            const bf16x8 vz = __builtin_bit_cast(bf16x8, zw);
            zk *= Rm16;
#pragma unroll
            for (int dkb = 0; dkb < 8; ++dkb) { const LAS char* kb_ = KI + (dkb >> 2) * 16384 + 4096 * ks + CQ[dkb & 3];
                const s16x4 klo = vtr(kb_ + TB[0]), khi = vtr(kb_ + TB[1]);
                const u32x2 kl = __builtin_bit_cast(u32x2, klo), kh = __builtin_bit_cast(u32x2, khi); const u32x4 kw = {kl.x, kl.y, kh.x, kh.y};
                S[dkb] = __builtin_amdgcn_mfma_f32_32x32x16_bf16(__builtin_bit_cast(bf16x8, kw), vz, S[dkb], 0, 0, 0); }
            __builtin_amdgcn_sched_barrier(0);
          } }
        if (!(skip_ctx_y && n < 4)) {
            bf16* Yr = Y + (size_t)rowbase * 4096; const unsigned yo = (unsigned)(hd * RDV + dvh * 256 + wid * 32 + r + 4 * h * 4096);
#pragma unroll
            for (int it = 0; it < 2; ++it)
#pragma unroll
                for (int rg = 0; rg < 16; ++rg) { const unsigned i0 = (unsigned)(it * 32 + (rg & 3) + 8 * (rg >> 2));
                    Yr[yo + i0 * 4096u] = (bf16)(cvt_pk_bf16(Yt[it][rg], 0.f) & 0xffffu); }
        }
        asm volatile("s_waitcnt vmcnt(0)" ::: "memory");
        __syncthreads();
        if (more) dma_mat(nsrc + vcol, 8192, lds + OFF_V, wid, lane);
    }
    asm volatile("s_waitcnt vmcnt(0)" ::: "memory"); __syncthreads();
}
}

#define XB_TMO      128
#define XB_XCNT(j)  (256  + 64 * (j))
#define XB_XSUB(j)  (1280 + 64 * (j))
#define XB_XGEN(j)  (2304 + 64 * (j))
#define XB_TOP      3328
#define XB_TOPGEN   3392
#define XCD_BAR_WORDS 3456
#define XB_SPIN_CAP (1u << 22)
__device__ __forceinline__ unsigned xb_ld(unsigned* p)              { return __hip_atomic_load(p, __ATOMIC_RELAXED, __HIP_MEMORY_SCOPE_AGENT); }
__device__ __forceinline__ unsigned xb_add(unsigned* p, unsigned v) { return __hip_atomic_fetch_add(p, v, __ATOMIC_RELAXED, __HIP_MEMORY_SCOPE_AGENT); }
__device__ __forceinline__ unsigned xb_xcc_id() { return (unsigned)__builtin_amdgcn_s_getreg((3 << 11) | 20) & 0xFu; }
#define XB_SPIN(cond, bar) do { unsigned _sp = 0; while (cond) { __builtin_amdgcn_s_sleep(1); \
    if ((++_sp & 255u) == 0u) { if (xb_ld(&(bar)[XB_TMO])) break; if (_sp > XB_SPIN_CAP) { atomicAdd(&(bar)[XB_TMO], 1u); break; } } } } while (0)
struct XcdBarrier { unsigned* bar; unsigned x; volatile LAS unsigned* st; };
__device__ __forceinline__ XcdBarrier xcd_barrier_post(unsigned* bar, volatile LAS unsigned* st) {
    XcdBarrier b; b.bar = bar; b.x = xb_xcc_id(); b.st = st;
    if (threadIdx.x == 0) (void)xb_add(&bar[XB_XCNT(b.x)], 1u);
    return b;
}
__device__ __forceinline__ void xcd_barrier_complete(unsigned* bar, unsigned x, unsigned& nloc, unsigned& nx) {
    const unsigned G = gridDim.x * gridDim.y * gridDim.z;
    unsigned sum, cnt, mine, sp = 0u;
    for (;;) {
        sum = 0u; cnt = 0u; mine = 0u;
#pragma unroll
        for (unsigned j = 0; j < 16; ++j) { const unsigned c = xb_ld(&bar[XB_XCNT(j)]); sum += c; cnt += (c > 0u) ? 1u : 0u; mine = (j == x) ? c : mine; }
        if (sum == G) break;
        __builtin_amdgcn_s_sleep(1);
        if ((++sp & 255u) == 0u) { if (xb_ld(&bar[XB_TMO])) break; if (sp > XB_SPIN_CAP) { atomicAdd(&bar[XB_TMO], 1u); break; } }
    }
    nloc = mine > 0u ? mine : 1u; nx = cnt > 0u ? cnt : 1u;
}
__device__ __forceinline__ void xcd_barrier(const XcdBarrier& b) {
    asm volatile("s_waitcnt vmcnt(0)" ::: "memory");
    __syncthreads();
    if (threadIdx.x == 0) {
        unsigned* bar = b.bar; asm volatile("" : "+s"(bar));
        __builtin_amdgcn_s_waitcnt(0);
        unsigned nloc = b.st[0], nx = b.st[1];
        if (nloc == 0u) { xcd_barrier_complete(bar, b.x, nloc, nx); b.st[0] = nloc; b.st[1] = nx; }
        const unsigned old = xb_add(&bar[XB_XSUB(b.x)], 1u);
        const unsigned gen = old / nloc;
        if (old + 1u == (gen + 1u) * nloc) {
            __builtin_amdgcn_fence(__ATOMIC_RELEASE, "agent");
            asm volatile("s_waitcnt vmcnt(0)" ::: "memory");
            const unsigned og = xb_add(&bar[XB_TOP], 1u);
            const unsigned tg = og / nx;
            if (og + 1u == (tg + 1u) * nx) xb_add(&bar[XB_TOPGEN], 1u);
            else XB_SPIN(xb_ld(&bar[XB_TOPGEN]) == tg, bar);
            __builtin_amdgcn_fence(__ATOMIC_ACQUIRE, "agent");
            xb_add(&bar[XB_XGEN(b.x)], 1u);
            asm volatile("s_waitcnt vmcnt(0)" ::: "memory");
        } else {
            XB_SPIN(xb_ld(&bar[XB_XGEN(b.x)]) == gen, bar);
            __builtin_amdgcn_fence(__ATOMIC_ACQUIRE, "agent");
            asm volatile("s_waitcnt vmcnt(0)" ::: "memory");
        }
    }
    __syncthreads();
}

__device__ __forceinline__ float wave_sum(float v, int lane) {
#pragma unroll
    for (int o = 1; o < 64; o <<= 1) v += shfl_xor_l(v, o, lane);
    return v;
}
struct CvtDesc { const float* src; const float* kscale; bf16* WTrow0; int ldw, k0, K, jkind; float gscale; };
__device__ __forceinline__ int ropeperm64(int c) { const int p = c >> 1, e = c & 1; return (p < 16) ? (p + 16 * e) : (32 + (p - 16) + 16 * e); }
__device__ __forceinline__ int ropeinv64(int s_) { const int half = s_ >> 5, w = s_ & 31; return 2 * (half * 16 + (w & 15)) + (w >> 4); }
__device__ __forceinline__ void cvt_load(const CvtDesc& d, int lane, f32x4 (&v)[16]) {
#pragma unroll
    for (int i = 0; i < 16; ++i) { const int kk = 4 * i + (lane >> 4);
        f32x4 x = d.src ? *(const f32x4*)(d.src + (size_t)(d.k0 + kk) * d.ldw) : (f32x4){0.f, 0.f, 0.f, 0.f};
        float sc_ = d.gscale; if (d.kscale) sc_ *= d.kscale[d.k0 + kk];
        v[i] = x * sc_; }
}
__device__ __forceinline__ void cvt_store(const CvtDesc& d, int lane, const f32x4 (&v)[16], LAS float* scr) {
    const int n4 = lane & 15; int jr[4];
#pragma unroll
    for (int e = 0; e < 4; ++e) { const int s_ = 4 * n4 + e; jr[e] = d.jkind == 0 ? s_ : d.jkind == 1 ? ropeinv64(s_) : 2 * (4 * (n4 & 7) + e) + (n4 >> 3); }
#pragma unroll
    for (int i = 0; i < 16; ++i) { const int kk = 4 * i + (lane >> 4);
#pragma unroll
        for (int e = 0; e < 4; ++e) scr[kk * 65 + jr[e]] = v[i][e]; }
    asm volatile("s_waitcnt lgkmcnt(0)" ::: "memory");
    const int c = lane & 7;
#pragma unroll
    for (int ps = 0; ps < 8; ++ps) { const int j = 8 * ps + (lane >> 3); const LAS float* s = scr + (8 * c) * 65 + j;
        u32x4 o; o.x = cvt_pk_bf16(s[0 * 65], s[1 * 65]); o.y = cvt_pk_bf16(s[2 * 65], s[3 * 65]); o.z = cvt_pk_bf16(s[4 * 65], s[5 * 65]); o.w = cvt_pk_bf16(s[6 * 65], s[7 * 65]);
        *(u32x4*)(d.WTrow0 + (size_t)j * d.K + d.k0 + 8 * c) = o; }
    asm volatile("s_waitcnt lgkmcnt(0)" ::: "memory");
}
struct CvtJob { const float* W0; const float* W1; const float* kscale; bf16* WT; int ldw, K, nrows, kind, aux; float gscale; };
__device__ __forceinline__ bool cvt_try(const CvtJob& J, int& it, int lane, CvtDesc& d) {
    const int nblk = J.nrows / 64, items = (J.K / 64) * nblk;
    if (it >= items) { it -= items; return false; }
    const int kb = it / nblk, nb = it % nblk; const int n4 = lane & 15;
    const float* sp; int jk = 0;
    switch (J.kind) {
        case 0: sp = J.W0 + J.aux + nb * 64 + 4 * n4; break;
        case 1: sp = J.W0 + J.aux + 4 * n4; jk = 1; break;
        case 2: { const int hh = nb / 3, part = nb % 3; sp = J.W0 + hh * DQ + 64 * part + 4 * n4; jk = (part == 2) ? 1 : 0; } break;
        case 3: { const int hh = nb >> 2, q4 = nb & 3; sp = J.W0 + hh * 256 + 32 * q4 + 128 * (n4 >> 3) + 4 * (n4 & 7); jk = 2; } break;
        case 4: { const int tl = nb >> 2, hf = (nb >> 1) & 1, q2 = nb & 1; const long long dW = (const char*)J.W1 - (const char*)J.W0; sp = (const float*)((const char*)J.W0 + dW * hf) + tl * 128 + 64 * q2 + 4 * n4; } break;
        default: sp = nullptr; break;
    }
    d.src = sp; d.kscale = J.kscale; d.WTrow0 = J.WT + (size_t)(nb * 64) * J.K; d.ldw = J.ldw; d.k0 = kb * 64; d.K = J.K; d.jkind = jk; d.gscale = J.gscale;
    return true;
}
__device__ __forceinline__ int cvt_items(const CvtJob& J) { return (J.K / 64) * (J.nrows / 64); }

__device__ __forceinline__ void row_load(const float* xrow, int lane, f32x4 (&v)[8]) {
#pragma unroll
    for (int j = 0; j < 8; ++j) v[j] = *(const f32x4*)(xrow + 4 * lane + 256 * j);
}
__device__ __forceinline__ void norm_mod_finish(const f32x4 (&v)[8], const float* g, const float* sc, const float* sh, bf16* orow, int lane) {
    float s = 0.f;
#pragma unroll
    for (int j = 0; j < 8; ++j) s += (v[j][0] * v[j][0] + v[j][1] * v[j][1]) + (v[j][2] * v[j][2] + v[j][3] * v[j][3]);
    const float rstd = 1.0f / sqrtf(wave_sum(s, lane) * (1.0f / D) + NORM_EPS);
#pragma unroll
    for (int j = 0; j < 8; ++j) { const int c = 4 * lane + 256 * j; const f32x4 gg = *(const f32x4*)(g + c), s1 = *(const f32x4*)(sc + c), s0 = *(const f32x4*)(sh + c);
        const f32x4 y = (v[j] * rstd) * gg * (1.0f + s1) + s0;
        u32x2 w; w.x = cvt_pk_bf16(y[0], y[1]); w.y = cvt_pk_bf16(y[2], y[3]); *(u32x2*)(orow + c) = w; }
}
__device__ __forceinline__ void norm_phase(const float* xsrc, const float* csrc, const float* g, const float* modl, int chunk, bf16* H, int nrows, int gw, int NGW, int lane) {
    if (gw >= nrows) return;
    f32x4 v[8], vn[8]; int m = gw;
    row_load(m < MX ? xsrc + (size_t)m * D : csrc + (size_t)(m - MX) * D, lane, v);
    for (;;) {
        const int mn = m + NGW; const bool has = mn < nrows;
        if (has) row_load(mn < MX ? xsrc + (size_t)mn * D : csrc + (size_t)(mn - MX) * D, lane, vn);
        const float* mr = modl + (size_t)(m < MX ? (m >> 12) : 8) * NMOD + chunk * D;
        norm_mod_finish(v, g, mr + D, mr, H + (size_t)m * D, lane);
        if (!has) break;
#pragma unroll
        for (int j = 0; j < 8; ++j) v[j] = vn[j];
        m = mn;
    }
}

__device__ __forceinline__ unsigned long long ld_arg(LAS unsigned char* lds, int i) {
    const volatile LAS unsigned* p = (const volatile LAS unsigned*)(lds + ARGS_OFF) + 2 * i;
    const unsigned lo = __builtin_amdgcn_readfirstlane(p[0]), hi = __builtin_amdgcn_readfirstlane(p[1]);
    return ((unsigned long long)hi << 32) | lo;
}
__device__ __forceinline__ void mod_layers(LAS unsigned char* lds, unsigned char* ws, int l_lo, int l_hi, int wg, int nwg, int tid, int lane, int wave) {
#define ARGF(i) ((const float*)ld_arg(lds, (i)))
    const int nitems = (l_hi - l_lo) * 96;
    if (wg >= nitems) return;
    LAS float* cond = (LAS float*)lds;
    LAS float* red = (LAS float*)(lds + 73728);
    float* MODV = (float*)(ws + WS_MODV);
    { const float* cin = ARGF(1); const float* cc = ARGF(3);
      for (int i = tid; i < 9 * D; i += 512) { const int r = i >> 11, k = i & (D - 1); const float c = (r < 8) ? cin[r * D + k] : cc[k]; cond[i] = c / (1.0f + __expf(-c)); } }
    __syncthreads();
    for (int it = wg; it < nitems; it += nwg) {
        const int l = l_lo + it / 96, cb = it % 96; const int n = cb * 128 + 2 * lane;
        const float* W = ARGF(4) + (size_t)l * D * NMOD + n; const float* mb = ARGF(5) + (size_t)l * NMOD + cb * 128;
        float a0[9], a1[9];
#pragma unroll
        for (int r = 0; r < 9; ++r) { a0[r] = 0.f; a1[r] = 0.f; }
        for (int k = wave * 256; k < wave * 256 + 256; k += 8) {
            f32x2 w[8];
#pragma unroll
            for (int q = 0; q < 8; ++q) w[q] = *(const f32x2*)(W + (size_t)(k + q) * NMOD);
#pragma unroll
            for (int q4 = 0; q4 < 2; ++q4)
#pragma unroll
                for (int r = 0; r < 9; ++r) { const f32x4 c4 = *(const LAS f32x4*)(cond + r * D + k + 4 * q4);
#pragma unroll
                    for (int q = 0; q < 4; ++q) { a0[r] += c4[q] * w[4 * q4 + q][0]; a1[r] += c4[q] * w[4 * q4 + q][1]; } }
        }
#pragma unroll
        for (int r = 0; r < 9; ++r) { red[(wave * 9 + r) * 128 + 2 * lane] = a0[r]; red[(wave * 9 + r) * 128 + 2 * lane + 1] = a1[r]; }
        __syncthreads();
        for (int i = tid; i < 9 * 128; i += 512) { const int r = i >> 7, cc = i & 127; float s2 = 0.f;
#pragma unroll
            for (int w8 = 0; w8 < 8; ++w8) s2 += red[(w8 * 9 + r) * 128 + cc];
            MODV[((size_t)l * 9 + r) * NMOD + cb * 128 + cc] = s2 + mb[cc]; }
        __syncthreads();
    }
#undef ARGF
}
__device__ __forceinline__ void cvt_layer(LAS unsigned char* lds, unsigned char* ws, int lc, int rank, int nranks, int wave, int lane, int part  ) {
#define ARGF(i) ((const float*)ld_arg(lds, (i)))
    const int li = lc >> 1; const bool is_ret = (lc & 1) != 0;
    bf16* WM = (bf16*)(ws + (is_ret ? WS_WB : WS_WA)); bf16* WF = (bf16*)(ws + (is_ret ? WS_WB + 82 * MiB : WS_WA + 22 * MiB));
    LAS float* scr = (LAS float*)(lds + wave * 19456);
    CvtJob J[7]; int nj;
    if (!is_ret) {
        bf16* W1T = WM; bf16* WuqT = W1T + (size_t)N1 * D; bf16* WukvT = WuqT + (size_t)3072 * 512; bf16* WoT = WukvT + (size_t)4096 * 512;
        const float* wdq = ARGF(8) + (size_t)li * D * QR; const float* wdkv = ARGF(11) + (size_t)li * D * (KVR + ROPE);
        J[0] = CvtJob{wdq, nullptr, nullptr, W1T, QR, D, 512, 0, 0, 1.f};
        J[1] = CvtJob{wdkv, nullptr, nullptr, W1T + (size_t)512 * D, KVR + ROPE, D, 512, 0, 0, 1.f};
        J[2] = CvtJob{wdkv, nullptr, nullptr, W1T + (size_t)1024 * D, KVR + ROPE, D, 64, 1, 512, 1.f};
        J[3] = CvtJob{nullptr, nullptr, nullptr, W1T + (size_t)1088 * D, 1, D, 192, 5, 0, 1.f};
        J[4] = CvtJob{ARGF(10) + (size_t)li * QR * 3072, nullptr, ARGF(9) + li * QR, WuqT, 3072, QR, 3072, 2, 0, 0.07216878364870322f * LOG2E};
        J[5] = CvtJob{ARGF(13) + (size_t)li * KVR * 4096, nullptr, ARGF(12) + li * KVR, WukvT, 4096, KVR, 4096, 0, 0, 1.f};
        J[6] = CvtJob{ARGF(14) + (size_t)li * D * D, nullptr, nullptr, WoT, D, D, D, 0, 0, 1.f};
        nj = 7;
    } else {
        bf16* WqkvT = WM; bf16* WgT = WqkvT + (size_t)8192 * D; bf16* WoT = WgT + (size_t)8192 * D;
        J[0] = CvtJob{ARGF(15) + (size_t)li * D * D, nullptr, nullptr, WqkvT, D, D, 2048, 3, 0, 1.f};
        J[1] = CvtJob{ARGF(16) + (size_t)li * D * D, nullptr, nullptr, WqkvT + (size_t)2048 * D, D, D, 2048, 3, 0, 0.0625f};
        J[2] = CvtJob{ARGF(17) + (size_t)li * D * 4096, nullptr, nullptr, WqkvT + (size_t)4096 * D, 4096, D, 4096, 0, 0, 1.f};
        J[3] = CvtJob{ARGF(18) + (size_t)li * D * 4096, ARGF(19) + (size_t)li * D * 4096, nullptr, WgT, 4096, D, 8192, 4, 0, 1.f};
        J[4] = CvtJob{ARGF(20) + (size_t)li * 4096 * D, nullptr, nullptr, WoT, D, 4096, D, 0, 0, 1.f};
        J[5] = CvtJob{nullptr, nullptr, nullptr, nullptr, 1, 64, 0, 5, 0, 1.f};
        J[6] = J[5];
        nj = 5;
    }
    CvtJob F0 = CvtJob{ARGF(23) + (size_t)lc * D * FF, ARGF(24) + (size_t)lc * D * FF, nullptr, WF, FF, D, 11264, 4, 0, 1.f};
    CvtJob F1 = CvtJob{ARGF(27) + (size_t)lc * FF * D, nullptr, nullptr, WF + (size_t)11264 * D, D, FF, D, 0, 0, 1.f};
    if (part == 1) nj = 0;
    const bool ffn = part != 0;
    int total = ffn ? cvt_items(F0) + cvt_items(F1) : 0;
#pragma unroll
    for (int j = 0; j < 7; ++j) if (j < nj) total += cvt_items(J[j]);
#define CVT_FIND(IT, DD) do { int it_ = (IT); bool done_ = false; \
        _Pragma("unroll") for (int j = 0; j < 7; ++j) if (!done_ && j < nj) done_ = cvt_try(J[j], it_, lane, DD); \
        if (ffn) { if (!done_) done_ = cvt_try(F0, it_, lane, DD); if (!done_) done_ = cvt_try(F1, it_, lane, DD); } } while (0)
    if (rank < total) {
        f32x4 v[16], w[16]; CvtDesc d0, d1; int it0 = rank;
        CVT_FIND(it0, d0); cvt_load(d0, lane, v);
        for (;;) {
            const int it1 = it0 + nranks; const bool has = it1 < total;
            if (has) { CVT_FIND(it1, d1); cvt_load(d1, lane, w); }
            cvt_store(d0, lane, v, scr);
            if (!has) break;
#pragma unroll
            for (int i = 0; i < 16; ++i) v[i] = w[i];
            d0 = d1; it0 = it1;
        }
    }
#undef CVT_FIND
#undef ARGF
}

#if MLA_CHECK
constexpr int CW_CHK = 2048;
__device__ __forceinline__ float wave_max(float v, int lane) {
#pragma unroll
    for (int o = 1; o < 64; o <<= 1) v = fmaxf(v, shfl_xor_l(v, o, lane));
    return v;
}
__device__ __forceinline__ void mla_check(LAS unsigned char* lds, unsigned char* ws, int li, int gw, int wave, int lane) {
#define ARGF(i) ((const float*)ld_arg(lds, (i)))
    LAS float* sc = (LAS float*)(lds + wave * 19456);
    const bf16* H = (const bf16*)(ws + WS_H); const bf16* Qb = (const bf16*)(ws + WS_Q); const bf16* KVb = (const bf16*)(ws + WS_KV); const bf16* KRb = (const bf16*)(ws + WS_KR); const bf16* Ob = (const bf16*)(ws + WS_O);
    const int t = (int)(((unsigned)gw * 2654435761u) % (unsigned)MT); const int hd = gw & 15;
    const bool isx = t < MX; const int tt = t & (SEQ - 1);
    float err = 0.f;
    {
        const float* wdq = ARGF(8) + (size_t)li * D * QR; const float* wdkv = ARGF(11) + (size_t)li * D * (KVR + ROPE);
        float ql[8], kl[9];
#pragma unroll
        for (int j = 0; j < 8; ++j) ql[j] = 0.f;
#pragma unroll
        for (int j = 0; j < 9; ++j) kl[j] = 0.f;
        for (int k = 0; k < D; ++k) { const float hv = bf2f(H[(size_t)t * D + k]);
#pragma unroll
            for (int j = 0; j < 8; ++j) ql[j] += hv * wdq[(size_t)k * QR + lane + 64 * j];
#pragma unroll
            for (int j = 0; j < 9; ++j) kl[j] += hv * wdkv[(size_t)k * (KVR + ROPE) + lane + 64 * j]; }
        float sq = 0.f, sk = 0.f;
#pragma unroll
        for (int j = 0; j < 8; ++j) { sq += ql[j] * ql[j]; sk += kl[j] * kl[j]; }
        const float rq = 1.0f / sqrtf(wave_sum(sq, lane) * (1.0f / QR) + NORM_EPS), rk = 1.0f / sqrtf(wave_sum(sk, lane) * (1.0f / KVR) + NORM_EPS);
        const float* qg = ARGF(9) + li * QR; const float* kg = ARGF(12) + li * KVR;
#pragma unroll
        for (int j = 0; j < 8; ++j) { sc[lane + 64 * j] = ql[j] * rq * qg[lane + 64 * j]; sc[512 + lane + 64 * j] = kl[j] * rk * kg[lane + 64 * j]; }
        sc[1024 + lane] = kl[8];
        asm volatile("s_waitcnt lgkmcnt(0)" ::: "memory");
        const float* wuq = ARGF(10) + (size_t)li * QR * 3072 + hd * DQ; const float* wukv = ARGF(13) + (size_t)li * KVR * 4096 + hd * 256;
        float qv[3] = {0.f, 0.f, 0.f}, kv[4] = {0.f, 0.f, 0.f, 0.f};
        for (int c = 0; c < 512; ++c) { const float a = sc[c], bq = sc[512 + c];
#pragma unroll
            for (int j = 0; j < 3; ++j) qv[j] += a * wuq[(size_t)c * 3072 + lane + 64 * j];
#pragma unroll
            for (int j = 0; j < 4; ++j) kv[j] += bq * wukv[(size_t)c * 4096 + lane + 64 * j]; }
#pragma unroll
        for (int j = 0; j < 3; ++j) sc[1100 + lane + 64 * j] = qv[j];
        asm volatile("s_waitcnt lgkmcnt(0)" ::: "memory");
        float qref[3]; float kr_ref = 0.f;
#pragma unroll
        for (int j = 0; j < 3; ++j) { const int d = lane + 64 * j; float v = sc[1100 + d];
            if (d >= NOPE && isx) { const int e = d - NOPE, half = e >> 5, i = e & 15, second = (e >> 4) & 1; const float pos = half ? (float)(tt & 63) : (float)(tt >> 6);
                const float ang = pos * __builtin_amdgcn_exp2f(-(float)(2 * i) * (13.287712379549449f / 32.0f)); const float rev = ang * 0.15915494309189535f; const float fr_ = rev - floorf(rev);
                const float cs = __builtin_amdgcn_cosf(fr_), sn = __builtin_amdgcn_sinf(fr_); const float other = sc[1100 + NOPE + half * 32 + i + (second ? 0 : 16)];
                v = second ? (v * cs + other * sn) : (v * cs - other * sn); }
            qref[j] = v * (0.07216878364870322f * LOG2E); }
        { const int e = lane, half = e >> 5, i = e & 15, second = (e >> 4) & 1; float v = sc[1024 + e];
          if (isx) { const float pos = half ? (float)(tt & 63) : (float)(tt >> 6);
              const float ang = pos * __builtin_amdgcn_exp2f(-(float)(2 * i) * (13.287712379549449f / 32.0f)); const float rev = ang * 0.15915494309189535f; const float fr_ = rev - floorf(rev);
              const float cs = __builtin_amdgcn_cosf(fr_), sn = __builtin_amdgcn_sinf(fr_); const float other = sc[1024 + half * 32 + i + (second ? 0 : 16)];
              v = second ? (v * cs + other * sn) : (v * cs - other * sn); }
          kr_ref = v; }
#pragma unroll
        for (int j = 0; j < 3; ++j) sc[1400 + lane + 64 * j] = qref[j];
        sc[1600 + lane] = kr_ref;
        asm volatile("s_waitcnt lgkmcnt(0)" ::: "memory");
        float mx = 0.f, df = 0.f;
#pragma unroll
        for (int j = 0; j < 3; ++j) { const int p = lane + 64 * j; const int od = p < NOPE ? p : NOPE + ropeperm64(p - NOPE); const float ref = sc[1400 + od]; const float mine = bf2f(Qb[(size_t)t * 3072 + hd * DQ + p]);
            mx = fmaxf(mx, fabsf(ref)); df = fmaxf(df, fabsf(ref - mine)); }
        err = fmaxf(err, wave_max(df, lane) / (wave_max(mx, lane) + 1e-20f));
        mx = 0.f; df = 0.f;
#pragma unroll
        for (int j = 0; j < 4; ++j) { const float ref = kv[j]; const float mine = bf2f(KVb[(size_t)t * 4096 + hd * 256 + lane + 64 * j]); mx = fmaxf(mx, fabsf(ref)); df = fmaxf(df, fabsf(ref - mine)); }
        err = fmaxf(err, wave_max(df, lane) / (wave_max(mx, lane) + 1e-20f));
        { const float ref = sc[1600 + ropeperm64(lane)]; const float mine = bf2f(KRb[(size_t)t * 64 + lane]); err = fmaxf(err, wave_max(fabsf(ref - mine), lane) / (wave_max(fabsf(ref), lane) + 1e-20f)); }
    }
    {
        const int b = isx ? (t >> 12) : ((t - MX) >> 8); const int nk = isx ? 4352 : 256;
        for (int d = lane; d < DQ; d += 64) sc[d] = bf2f(Qb[(size_t)t * 3072 + hd * DQ + d]);
        asm volatile("s_waitcnt lgkmcnt(0)" ::: "memory");
        float mxs = -1e30f;
        for (int j = lane; j < nk; j += 64) { const int row = j < 256 ? MX + b * CTXL + j : b * SEQ + (j - 256); float sdot = 0.f;
            for (int d = 0; d < NOPE; ++d) sdot += sc[d] * bf2f(KVb[(size_t)row * 4096 + hd * 256 + d]);
            for (int d = 0; d < ROPE; ++d) sdot += sc[NOPE + d] * bf2f(KRb[(size_t)row * 64 + d]);
            sc[256 + j] = sdot; mxs = fmaxf(mxs, sdot); }
        mxs = wave_max(mxs, lane); float sum = 0.f;
        for (int j = lane; j < nk; j += 64) { const float p = __builtin_amdgcn_exp2f(sc[256 + j] - mxs); sc[256 + j] = p; sum += p; }
        sum = wave_sum(sum, lane);
        asm volatile("s_waitcnt lgkmcnt(0)" ::: "memory");
        float o0 = 0.f, o1 = 0.f;
        for (int j = 0; j < nk; ++j) { const int row = j < 256 ? MX + b * CTXL + j : b * SEQ + (j - 256); const float p = sc[256 + j];
            o0 += p * bf2f(KVb[(size_t)row * 4096 + hd * 256 + 128 + lane]); o1 += p * bf2f(KVb[(size_t)row * 4096 + hd * 256 + 128 + 64 + lane]); }
        o0 /= sum; o1 /= sum;
        const float m0 = bf2f(Ob[(size_t)t * D + hd * 128 + lane]), m1 = bf2f(Ob[(size_t)t * D + hd * 128 + 64 + lane]);
        const float df = fmaxf(fabsf(o0 - m0), fabsf(o1 - m1)), mx = fmaxf(fabsf(o0), fabsf(o1));
        err = fmaxf(err, wave_max(df, lane) / (wave_max(mx, lane) + 1e-20f));
    }
    if (lane == 0) atomicMax((unsigned*)(ws + WS_CTL) + CW_CHK, __float_as_uint(err));
#undef ARGF
}
#endif
struct Args { const float* in[29]; float* out; unsigned char* ws; int ph_lo, ph_hi; };
constexpr int PH_PER_LAYER = 10, PH_FINAL = 1 + PH_PER_LAYER * DEPTH, PH_COUNT = PH_FINAL + 1;

template <unsigned MK_EN_T>
__global__ void __launch_bounds__(512, 2) mk_fwd(Args args) {
    extern __shared__ __attribute__((aligned(16))) unsigned char lds_raw[];
    LAS unsigned char* lds = (LAS unsigned char*)lds_raw;
    volatile LAS unsigned* MISC = (volatile LAS unsigned*)(lds + MISC_OFF);
    const int G = gridDim.x; const int bx = blockIdx.x; const int vcu = (G % 8 == 0) ? (bx % 8) * (G / 8) + bx / 8 : bx;
    const int NGW = G * 8;
    unsigned char* ws = args.ws; float* X = args.out;
    const int lo = args.ph_lo, hi = args.ph_hi;
    { const int tid0 = threadIdx.x;
      for (int u = tid0; u < (LDS_BYTES - CTRL_BASE) / 4; u += 512) ((LAS unsigned*)(lds + CTRL_BASE))[u] = 0u;
      __syncthreads();
      if (tid0 < 29) ((volatile LAS unsigned long long*)(lds + ARGS_OFF))[tid0] = (unsigned long long)args.in[tid0];
      __syncthreads(); }
#define ARGF(i) ((const float*)ld_arg(lds, (i)))
    XcdBarrier bar; bar.bar = (unsigned*)(ws + WS_CTL) + CW_BAR; bar.x = 0; bar.st = nullptr;
    if (hi - lo > 1) bar = xcd_barrier_post((unsigned*)(ws + WS_CTL) + CW_BAR, MISC + 8);
#if PROBE_TS
    if (bx == 0 && threadIdx.x == 0) ((unsigned long long*)(ws + WS_CTL + 65536))[0] = __builtin_amdgcn_s_memrealtime();
#endif
#define EN(b) (((MK_EN_T) >> (b)) & 1u)
#define IN(k) (lo <= (k) && (k) < hi)
#if PROBE_TS
#define TS_WORDS ((unsigned long long*)(ws + WS_CTL + 65536))
#define PHASE_END(k) do { if (hi > (k) + 1) xcd_barrier(bar); if (bx == 0 && threadIdx.x == 0) TS_WORDS[(k) + 1] = __builtin_amdgcn_s_memrealtime(); } while (0)
#else
#define PHASE_END(k) do { if (hi > (k) + 1) xcd_barrier(bar); } while (0)
#endif
#define PH_IDS int tid = threadIdx.x; asm volatile("" : "+v"(tid)); const int lane = tid & 63; const int wave = __builtin_amdgcn_readfirstlane(tid >> 6); const int gw = vcu * 8 + wave; (void)lane; (void)gw;
#define XC_    ((float*)(ws + WS_XC))
#define MODV_  ((float*)(ws + WS_MODV))
#define TABM_  ((float*)(ws + WS_TABM))
#define TABR_  ((float*)(ws + WS_TABR))
#define SSQ_   ((float*)(ws + WS_SSQ))
#define KR_    ((bf16*)(ws + WS_KR))
#define H_     ((bf16*)(ws + WS_H))
#define WMIX_(ll) ((bf16*)(ws + (((ll) & 1) ? WS_WB : WS_WA)))
#define WFFN_(ll) ((bf16*)(ws + (((ll) & 1) ? WS_WB + 82 * MiB : WS_WA + 22 * MiB)))
#define W1T_   WMIX_(l)
#define WUQT_  (W1T_ + (size_t)N1 * D)
#define WUKVT_ (WUQT_ + (size_t)3072 * 512)
#define WOTM_  (WUKVT_ + (size_t)4096 * 512)
#define WQKVT_ WMIX_(l)
#define WGT_   (WQKVT_ + (size_t)8192 * D)
#define WOTR_  (WGT_ + (size_t)8192 * D)
#define WGUT_  WFFN_(l)
#define WDT_   (WGUT_ + (size_t)11264 * D)
#define QKVL_  ((bf16*)(ws + WS_QKVL))
#define Q_     ((bf16*)(ws + WS_Q))
#define KV_    ((bf16*)(ws + WS_KV))
#define O_     ((bf16*)(ws + WS_O))
#define QKV_   ((bf16*)(ws + WS_QKV))
#define Y_     ((bf16*)(ws + WS_Y))
#define GATED_ ((bf16*)(ws + WS_GATED))
#define GB_    ((bf16*)(ws + WS_G))
#define UB_    ((bf16*)(ws + WS_U))
#define HALO_  ((float*)(ws + WS_G))
#define MODL_  (MODV_ + (size_t)l * 9 * NMOD)

    if (EN(0) && IN(0)) for (int rep_ = 0; rep_ < 1 + (int)((PROBE_MASK >> 0) & 1u); ++rep_) {
        PH_IDS
        mod_layers(lds, ws, 0, 1, bx, G, tid, lane, wave);
        __syncthreads();
        cvt_layer(lds, ws, 0, gw, NGW, wave, lane, 2);
        for (int i = bx * 512 + tid; i < 64 * 16 + SEQ * 128; i += G * 512) {
            float inv, pos; float* dst;
            if (i < 1024) { const int p = i >> 4, f = i & 15; inv = __builtin_amdgcn_exp2f(-(float)(2 * f) * (13.287712379549449f / 32.0f)); pos = (float)p; dst = TABM_ + 2 * i; }
            else { const int j = i - 1024, t = j >> 7, f = j & 127; inv = __builtin_amdgcn_exp2f(-(float)(2 * f) * (13.287712379549449f / 256.0f)); pos = (float)t; dst = TABR_ + 2 * j; }
            const float ang = pos * inv; const double rev = (double)ang * 0.15915494309189535; const float fr = (float)(rev - floor(rev));
            dst[0] = __builtin_amdgcn_cosf(fr); dst[1] = __builtin_amdgcn_sinf(fr);
        }
        PHASE_END(0);
    }

    for (int l = 0; l < DEPTH; ++l) {
        const int P = 1 + PH_PER_LAYER * l; const int li = l >> 1; const bool is_ret = (l & 1) != 0; const bool last = (l == DEPTH - 1);
        const int Mrows = last ? MX : MT;

        if (EN(1) && IN(P + 0)) for (int rep_ = 0; rep_ < 1 + (int)((PROBE_MASK >> 1) & 1u); ++rep_) {
            PH_IDS
            const float* g = ARGF(6) + l * D; const float* xsrc = (l == 0) ? ARGF(0) : X; const float* csrc = (l == 0) ? ARGF(2) : XC_;
            norm_phase(xsrc, csrc, g, MODL_, 0, H_, MT, gw, NGW, lane);
            PHASE_END(P + 0);
        }

        if (!is_ret) {
            if (EN(2) && IN(P + 1)) for (int rep_ = 0; rep_ < 1 + (int)((PROBE_MASK >> 2) & 1u); ++rep_) {
                pg8::Gemm g{H_, W1T_, MT, N1, D, D}; pg8::StaticOrder S; S.init(MT, N1, G, bx);
                EpiG1 E{QKVL_, SSQ_, KR_, TABM_};
                pg8::gemm_phase<EpiG1>(lds, g, S, E);
                PHASE_END(P + 1);
            }
            if (EN(3) && IN(P + 2)) for (int rep_ = 0; rep_ < 1 + (int)((PROBE_MASK >> 3) & 1u); ++rep_) {
                { pg8::Gemm g{QKVL_, WUQT_, MT, 3072, QR, N1}; pg8::StaticOrder S; S.init(MT, 3072, G, bx); EpiUq E{Q_, SSQ_, TABM_}; pg8::gemm_phase<EpiUq>(lds, g, S, E); }
                { pg8::Gemm g{QKVL_ + 512, WUKVT_, MT, 4096, KVR, N1}; pg8::StaticOrder S; S.init(MT, 4096, G, bx); EpiUkv E{KV_, SSQ_}; pg8::gemm_phase<EpiUkv>(lds, g, S, E); }
                PHASE_END(P + 2);
            }
            if (EN(4) && IN(P + 3)) for (int rep_ = 0; rep_ < 1 + (int)((PROBE_MASK >> 4) & 1u); ++rep_) {
                const int nun = 2048 + 128;
                for (int ui = vcu; ui < nun; ui += G) {
                    if (ui < 2048) { const int xcd = (ui & 255) >> 5, j = ui & 31, rnd = ui >> 8; const int bh = xcd * 16 + 2 * rnd + (j >> 4), qb = j & 15; const int b = bh >> 4, hd = bh & 15;
                        att::attn_unit(Q_ + (size_t)(b * SEQ + qb * 256) * 3072 + hd * DQ, KV_ + hd * 256, KR_, O_ + (size_t)(b * SEQ + qb * 256) * D + hd * 128, 68, 4, MX + b * CTXL, b * SEQ, (char*)lds_raw);
                    } else { const int bh = ui - 2048, b = bh >> 4, hd = bh & 15;
                        att::attn_unit(Q_ + (size_t)(MX + b * CTXL) * 3072 + hd * DQ, KV_ + hd * 256, KR_, O_ + (size_t)(MX + b * CTXL) * D + hd * 128, 4, 4, MX + b * CTXL, 0, (char*)lds_raw); }
                }
                PHASE_END(P + 3);
            }
        } else {
            if (EN(5) && IN(P + 1)) for (int rep_ = 0; rep_ < 1 + (int)((PROBE_MASK >> 5) & 1u); ++rep_) {
                pg8::Gemm g{H_, WQKVT_, MT, 8192, D, D}; pg8::StaticOrder S; S.init(MT, 8192, G, bx);
                EpiQKV E{QKV_, TABR_};
                pg8::gemm_phase<EpiQKV>(lds, g, S, E);
                PHASE_END(P + 1);
            }
            if (EN(6) && IN(P + 2)) for (int rep_ = 0; rep_ < 1 + (int)((PROBE_MASK >> 6) & 1u); ++rep_) {
                for (int ui = vcu; ui < 256; ui += G) {
                    const int bh = ui >> 2, dir = (ui >> 1) & 1, dvh = ui & 1; const int b = bh >> 3, hd = bh & 7;
                    const float dec = (dir ? ARGF(22) : ARGF(21))[li * RH + hd];
                    const float lg2 = -__expf(dec) * LOG2E;
                    scan::scan_unit(QKV_, Y_ + (size_t)dir * MT * 4096, b, hd, dir, dvh, lg2, last, lds);
                }
                PHASE_END(P + 2);
            }
            if (EN(7) && IN(P + 3)) for (int rep_ = 0; rep_ < 1 + (int)((PROBE_MASK >> 7) & 1u); ++rep_) {
                PH_IDS
                for (int row = gw; row < Mrows; row += NGW) {
                    u32x4 w[16];
#pragma unroll
                    for (int q = 0; q < 16; ++q) w[q] = *(const u32x4*)(Y_ + (size_t)(q >> 3) * MT * 4096 + (size_t)row * 4096 + (q & 7) * RDV + lane * 8);
                    float mu[16], rs[16];
#pragma unroll
                    for (int q = 0; q < 16; ++q) { const float s = ((bflo(w[q].x) + bfhi(w[q].x)) + (bflo(w[q].y) + bfhi(w[q].y))) + ((bflo(w[q].z) + bfhi(w[q].z)) + (bflo(w[q].w) + bfhi(w[q].w))); mu[q] = s; }
#pragma unroll
                    for (int o = 1; o < 64; o <<= 1)
#pragma unroll
                        for (int q = 0; q < 16; ++q) mu[q] += shfl_xor_l(mu[q], o, lane);
#pragma unroll
                    for (int q = 0; q < 16; ++q) { mu[q] *= (1.0f / RDV); const float m_ = mu[q];
                        const float d0 = bflo(w[q].x) - m_, d1 = bfhi(w[q].x) - m_, d2 = bflo(w[q].y) - m_, d3 = bfhi(w[q].y) - m_, d4 = bflo(w[q].z) - m_, d5 = bfhi(w[q].z) - m_, d6 = bflo(w[q].w) - m_, d7 = bfhi(w[q].w) - m_;
                        rs[q] = ((d0 * d0 + d1 * d1) + (d2 * d2 + d3 * d3)) + ((d4 * d4 + d5 * d5) + (d6 * d6 + d7 * d7)); }
#pragma unroll
                    for (int o = 1; o < 64; o <<= 1)
#pragma unroll
                        for (int q = 0; q < 16; ++q) rs[q] += shfl_xor_l(rs[q], o, lane);
                    float mo = 0.f, ro = 0.f;
#pragma unroll
                    for (int q = 0; q < 16; ++q) { if (lane == q) { mo = mu[q]; ro = rs[q]; } }
                    if (lane < 16) *(f32x2*)((float*)(ws + WS_STATS) + ((size_t)((lane >> 3) * MT + row) * 8 + (lane & 7)) * 2) = (f32x2){mo, 1.0f / sqrtf(ro * (1.0f / RDV) + GN_EPS)};
                }
                PHASE_END(P + 3);
            }
            if (EN(8) && IN(P + 4)) for (int rep_ = 0; rep_ < 1 + (int)((PROBE_MASK >> 8) & 1u); ++rep_) {
                pg8::Gemm g{H_, WGT_, Mrows, 8192, D, D}; pg8::StaticOrder S; S.init(Mrows, 8192, G, bx);
                EpiGate E{GATED_, Y_, Y_ + (size_t)MT * 4096, (const float*)(ws + WS_STATS)};
                pg8::gemm_phase<EpiGate>(lds, g, S, E);
                PHASE_END(P + 4);
            }
        }
        if (EN(9) && IN(P + 5)) for (int rep_ = 0; rep_ < 1 + (int)((PROBE_MASK >> 9) & 1u); ++rep_) {
#if MLA_CHECK
            if (l == MLA_CHECK_LAYER) { PH_IDS mla_check(lds, ws, li, gw, wave, lane); __syncthreads(); }
#endif
            pg8::Gemm g = is_ret ? pg8::Gemm{GATED_, WOTR_, Mrows, D, 4096, 4096} : pg8::Gemm{O_, WOTM_, Mrows, D, D, D};
            pg8::StaticOrder S; S.init(Mrows, D, G, bx, 4, true);
            const float* xsrc = (l == 0) ? ARGF(0) : X; const float* csrc = (l == 0) ? ARGF(2) : XC_;
            EpiResid E{xsrc, X, csrc, XC_, MODL_, 2 * D};
            pg8::gemm_phase<EpiResid>(lds, g, S, E);
            if (l + 1 < DEPTH) {
                PH_IDS
                const int nwg = (Mrows / 256) * (D / 256), rem = nwg % G;
                if (rem == 0) cvt_layer(lds, ws, l + 1, gw, NGW, wave, lane, 0);
                else if (bx >= rem) cvt_layer(lds, ws, l + 1, (bx - rem) * 8 + wave, (G - rem) * 8, wave, lane, 0);
            }
            PHASE_END(P + 5);
        }
        if (EN(10) && IN(P + 6)) for (int rep_ = 0; rep_ < 1 + (int)((PROBE_MASK >> 10) & 1u); ++rep_) {
            PH_IDS
            const float* g = ARGF(7) + l * D;
            norm_phase(X, XC_, g, MODL_, 3, H_, Mrows, gw, NGW, lane);
            PHASE_END(P + 6);
        }
        if (EN(11) && IN(P + 7)) for (int rep_ = 0; rep_ < 1 + (int)((PROBE_MASK >> 11) & 1u); ++rep_) {
            pg8::Gemm g{H_, WGUT_, Mrows, 11264, D, D}; pg8::StaticOrder S; S.init(Mrows, 11264, G, bx);
            EpiGUConv E{UB_, HALO_, ARGF(25) + (size_t)l * 3 * FF, ARGF(26) + (size_t)l * FF, (LAS float*)(lds + EDGE_OFF)};
            pg8::gemm_phase<EpiGUConv>(lds, g, S, E);
            PHASE_END(P + 7);
        }
        if (EN(13) && IN(P + 9)) for (int rep_ = 0; rep_ < 1 + (int)((PROBE_MASK >> 13) & 1u); ++rep_) {
            pg8::Gemm g{UB_, WDT_, Mrows, D, FF, FF}; pg8::StaticOrder S; S.init(Mrows, D, G, bx, 4, true);
            {
                PH_IDS
                const float* cw = ARGF(25) + (size_t)l * 3 * FF; const float* HL = HALO_; bf16* ACT = UB_;
                pg8::Unit uu; int prev_pm = -1;
                for (int i = 0; S.next(i, uu); ++i) { const int pm = uu.pm; if (pm == prev_pm || pm >= MX / 256) { prev_pm = pm; continue; } prev_pm = pm;
                    const bool top = (pm & 15) != 0, bot = ((pm + 1) & 15) != 0;
                    for (int q = tid; q < FF / 4; q += 512) { const int f = q * 4;
                        if (top) { const float* t0 = HL + (size_t)((pm * 2 + 0) * 3) * HALO_STRIDE + f; const float* b1 = HL + (size_t)(((pm - 1) * 2 + 1) * 3) * HALO_STRIDE + f;
                            const f32x4 o = silu4(*(const f32x4*)t0 + *(const f32x4*)(cw + f) * *(const f32x4*)(b1 + HALO_STRIDE)) * *(const f32x4*)(t0 + 2 * HALO_STRIDE);
                            u32x2 w; w.x = cvt_pk_bf16(o[0], o[1]); w.y = cvt_pk_bf16(o[2], o[3]); *(u32x2*)(ACT + (size_t)(pm * 256) * FF + f) = w; }
                        if (bot) { const float* b0 = HL + (size_t)((pm * 2 + 1) * 3) * HALO_STRIDE + f; const float* t1 = HL + (size_t)(((pm + 1) * 2 + 0) * 3) * HALO_STRIDE + f;
                            const f32x4 o = silu4(*(const f32x4*)b0 + *(const f32x4*)(cw + 2 * FF + f) * *(const f32x4*)(t1 + HALO_STRIDE)) * *(const f32x4*)(b0 + 2 * HALO_STRIDE);
                            u32x2 w; w.x = cvt_pk_bf16(o[0], o[1]); w.y = cvt_pk_bf16(o[2], o[3]); *(u32x2*)(ACT + (size_t)(pm * 256 + 255) * FF + f) = w; } } }
                asm volatile("s_waitcnt vmcnt(0)" ::: "memory"); __syncthreads();
            }
            EpiResid E{X, X, XC_, XC_, MODL_, 5 * D};
            pg8::gemm_phase<EpiResid>(lds, g, S, E);
#if PROBE_TS
            if (threadIdx.x == 0 && bx == 0) TS_WORDS[64 + l] = __builtin_amdgcn_s_memrealtime();
            if (threadIdx.x == 0 && bx == G - 1) TS_WORDS[72 + l] = __builtin_amdgcn_s_memrealtime();
#endif
            if (l + 1 < DEPTH) {
                PH_IDS
                const int nwg = (Mrows / 256) * (D / 256), rem = nwg % G;
                if (rem == 0) { mod_layers(lds, ws, l + 1, l + 2, bx, G, tid, lane, wave); __syncthreads(); cvt_layer(lds, ws, l + 1, gw, NGW, wave, lane, 1); }
                else if (bx >= rem) { mod_layers(lds, ws, l + 1, l + 2, bx - rem, G - rem, tid, lane, wave); __syncthreads(); cvt_layer(lds, ws, l + 1, (bx - rem) * 8 + wave, (G - rem) * 8, wave, lane, 1); }
            }
#if PROBE_TS
            __syncthreads(); if (threadIdx.x == 0 && bx == G - 1) TS_WORDS[80 + l] = __builtin_amdgcn_s_memrealtime();
#endif
            PHASE_END(P + 9);
        }
    }
    if (EN(14) && IN(PH_FINAL)) for (int rep_ = 0; rep_ < 1 + (int)((PROBE_MASK >> 14) & 1u); ++rep_) {
        PH_IDS
        const float* g = ARGF(28);
#if PROBE_TS
        float ts_c = 0.f, ts_a = 0.f;
        { const unsigned long long* TS = (const unsigned long long*)(ws + WS_CTL + 65536); unsigned long long last = TS[0]; const unsigned long long t0 = last; float d1 = 0.f, d2 = 0.f;
          for (int k = 0; k < PH_FINAL; ++k) { const unsigned long long te = TS[k + 1]; if (te == 0ull) continue; const float d = (float)(te - last); last = te;
              int cls; if (k == 0) cls = 0; else { const int slot = (k - 1) % PH_PER_LAYER, ll = (k - 1) / PH_PER_LAYER; const bool ret = (ll & 1) != 0;
                  cls = slot == 0 ? 1 : slot >= 5 ? 5 + slot : (!ret ? 1 + slot : 4 + slot); }
              if (cls == TS_CLASS1) d1 += d; if (cls == TS_CLASS2) d2 += d; }
          float tot = (float)(last - t0);
          if (TS_CLASS1 >= 100) { float ph = 0.f, x0 = 0.f, x1 = 0.f, x2 = 0.f;
              for (int ll = 0; ll < 3; ++ll) { const unsigned long long st = TS[(1 + PH_PER_LAYER * ll + 7) + 1], en = TS[(1 + PH_PER_LAYER * ll + 9) + 1];
                  ph += (float)(en - st); x0 += (float)(TS[64 + ll] - st); x1 += (float)(TS[72 + ll] - st); x2 += (float)(TS[80 + ll] - st); }
              d1 = (TS_CLASS1 == 100) ? x0 : (TS_CLASS1 == 101) ? x1 : x2; d2 = (TS_CLASS2 == 100) ? x0 : (TS_CLASS2 == 101) ? x1 : x2; tot = ph; }
          ts_c = sqrtf(d1 / tot); ts_a = 2.0f + 10.0f * d2 / tot; }
#endif
#if MLA_CHECK
        const bool chk_bad = __uint_as_float(__hip_atomic_load((unsigned*)(ws + WS_CTL) + CW_CHK, __ATOMIC_RELAXED, __HIP_MEMORY_SCOPE_AGENT)) > MLA_CHECK_TOL;
#endif
        if (gw < MX) {
            f32x4 v[8], vn[8]; int m = gw; row_load(X + (size_t)m * D, lane, v);
            for (;;) {
                const int mn = m + NGW; const bool has = mn < MX;
                if (has) row_load(X + (size_t)mn * D, lane, vn);
                float s = 0.f;
#pragma unroll
                for (int j = 0; j < 8; ++j) s += (v[j][0] * v[j][0] + v[j][1] * v[j][1]) + (v[j][2] * v[j][2] + v[j][3] * v[j][3]);
                const float rstd = 1.0f / sqrtf(wave_sum(s, lane) * (1.0f / D) + NORM_EPS);
                float* xr = X + (size_t)m * D;
#pragma unroll
                for (int j = 0; j < 8; ++j) { const int c = 4 * lane + 256 * j; f32x4 o_ = (v[j] * rstd) * *(const f32x4*)(g + c);
#if MLA_CHECK
                    if (chk_bad) o_ = (f32x4){__builtin_nanf(""), __builtin_nanf(""), __builtin_nanf(""), __builtin_nanf("")};
#endif
#if PROBE_TS
                    if (m < 328) { o_ = o_ + ts_c; if (m == 0 && c == 0) o_[0] += ts_a - ts_c; }
#endif
                    *(f32x4*)(xr + c) = o_; }
                if (!has) break;
#pragma unroll
                for (int j = 0; j < 8; ++j) v[j] = vn[j];
                m = mn;
            }
        }
    }
#undef IN
#undef PHASE_END
}

#if !MK_SINGLE
typedef void (*KernFn)(Args);
static KernFn phase_kernel(int bit) {
    switch (bit) {
        case 0: return mk_fwd<1u << 0>;  case 1: return mk_fwd<1u << 1>;  case 2: return mk_fwd<1u << 2>;  case 3: return mk_fwd<1u << 3>;
        case 4: return mk_fwd<1u << 4>;  case 5: return mk_fwd<1u << 5>;  case 6: return mk_fwd<1u << 6>;  case 7: return mk_fwd<1u << 7>;
        case 8: return mk_fwd<1u << 8>;  case 9: return mk_fwd<1u << 9>;  case 10: return mk_fwd<1u << 10>; case 11: return mk_fwd<1u << 11>;
        case 12: return mk_fwd<1u << 12>; case 13: return mk_fwd<1u << 13>; default: return mk_fwd<1u << 14>;
    }
}
static int phase_bit(int p) {
    if (p == 0) return 0; if (p == PH_FINAL) return 14;
    const int l = (p - 1) / PH_PER_LAYER, slot = (p - 1) % PH_PER_LAYER; const bool ret = (l & 1) != 0;
    if (slot == 0) return 1;
    if (slot >= 5) return 4 + slot;
    if (!ret) return slot == 4 ? -1 : 1 + slot;
    return 4 + slot;
}
#endif
extern "C" void kernel_launch(void* const* d_in, const int* in_sizes, int n_in, void* d_out, int out_size, void* d_ws, size_t ws_size, hipStream_t stream) {
    static int grid = 0;
    if (grid == 0) {
        if (n_in != 29 || out_size != MX * D || ws_size < WS_END) { fprintf(stderr, "kernel_launch: unexpected shapes: n_in %d out %d ws %zu (need %zu)\n", n_in, out_size, ws_size, (size_t)WS_END); grid = -1; return; }
        int dev = 0, cus = 0;
        if (hipGetDevice(&dev) != hipSuccess || hipDeviceGetAttribute(&cus, hipDeviceAttributeMultiprocessorCount, dev) != hipSuccess) { grid = -1; return; }
#if MK_SINGLE
        if (hipFuncSetAttribute((const void*)mk_fwd<0xFFFFFFFFu>, hipFuncAttributeMaxDynamicSharedMemorySize, LDS_BYTES) != hipSuccess) { fprintf(stderr, "kernel_launch: hipFuncSetAttribute failed\n"); grid = -1; return; }
#else
        for (int b = 0; b < 15; ++b) if (hipFuncSetAttribute((const void*)phase_kernel(b), hipFuncAttributeMaxDynamicSharedMemorySize, LDS_BYTES) != hipSuccess) { fprintf(stderr, "kernel_launch: hipFuncSetAttribute failed\n"); grid = -1; return; }
#endif
        (void)hipGetLastError();
        grid = cus;
    }
    if (grid < 0) return;
    if (hipMemsetAsync((char*)d_ws + WS_CTL, 0, CTL_BYTES, stream) != hipSuccess) return;
    Args a{};
    for (int i = 0; i < 29; ++i) a.in[i] = (const float*)d_in[i];
    a.out = (float*)d_out; a.ws = (unsigned char*)d_ws;
#if MK_SINGLE
    a.ph_lo = 0; a.ph_hi = PH_COUNT;
    hipLaunchKernelGGL(mk_fwd<0xFFFFFFFFu>, dim3(grid), dim3(512), LDS_BYTES, stream, a);
#else
    for (int p = 0; p < PH_COUNT; ++p) {
        const int bit = phase_bit(p); if (bit < 0) continue;
        a.ph_lo = p; a.ph_hi = p + 1;
        hipLaunchKernelGGL(phase_kernel(bit), dim3(grid), dim3(512), LDS_BYTES, stream, a);
    }
#endif
    const hipError_t le = hipPeekAtLastError();
    if (le != hipSuccess) fprintf(stderr, "kernel_launch: launch failed: %s\n", hipGetErrorName(le));
}
```

```cpp
#include <hip/hip_runtime.h>
#include <cstdio>
#include <cstdint>

#ifndef MK_SINGLE
#define MK_SINGLE 1
#endif

#ifndef MK_STAGGER
#define MK_STAGGER 0
#endif
#ifndef PROBE_EPI2
#define PROBE_EPI2 0
#endif
#ifndef MLA_CHECK
#define MLA_CHECK 0
#endif
#ifndef MLA_CHECK_LAYER
#define MLA_CHECK_LAYER 0
#endif
#ifndef MLA_CHECK_TOL
#define MLA_CHECK_TOL 0.03f
#endif
#ifndef PROBE_TS
#define PROBE_TS 0
#endif
#ifndef TS_CLASS1
#define TS_CLASS1 0
#endif
#ifndef TS_CLASS2
#define TS_CLASS2 1
#endif
#ifndef PROBE_MASK
#define PROBE_MASK 0u
#endif
#define GAS __attribute__((address_space(1)))
#define LAS __attribute__((address_space(3)))
typedef unsigned short bf16;
typedef short bf16x8 __attribute__((ext_vector_type(8)));
typedef short s16x4 __attribute__((ext_vector_type(4)));
typedef float f32x2 __attribute__((ext_vector_type(2)));
typedef float f32x4 __attribute__((ext_vector_type(4)));
typedef float f32x16 __attribute__((ext_vector_type(16)));
typedef unsigned u32x2 __attribute__((ext_vector_type(2)));
typedef unsigned u32x4 __attribute__((ext_vector_type(4)));
typedef GAS unsigned gu32;

constexpr int D = 2048, NB = 8, SEQ = 4096, CTXL = 256, DEPTH = 4;
constexpr int MX = NB * SEQ, MC = NB * CTXL, MT = MX + MC;
constexpr int FF = 5632, NMOD = 6 * D;
constexpr int MLA_H = 16, QR = 512, KVR = 512, NOPE = 128, ROPE = 64, DQ = 192;
constexpr int N1 = 1280;
constexpr int RH = 8, RDK = 256, RDV = 512;
constexpr float NORM_EPS = 1e-6f, GN_EPS = 1e-5f;
constexpr float LOG2E = 1.4426950408889634f;

constexpr size_t MiB = 1u << 20;
constexpr size_t WS_CTL = 0, CTL_BYTES = 1 * MiB;
constexpr size_t WS_MODV = 1 * MiB;
constexpr size_t WS_TABM = 3 * MiB;
constexpr size_t WS_TABR = 4 * MiB;
constexpr size_t WS_SSQ = 8 * MiB;
constexpr size_t WS_XC = 12 * MiB;
constexpr size_t WS_KR = 28 * MiB;
constexpr size_t WS_STATS = 33 * MiB;
constexpr size_t WS_WA = 40 * MiB;
constexpr size_t WS_WB = 128 * MiB;
constexpr size_t WS_H = 276 * MiB;
constexpr size_t WS_BIG = 412 * MiB;
constexpr size_t WS_QKVL = WS_BIG, WS_Q = WS_BIG + 88 * MiB, WS_KV = WS_BIG + 292 * MiB, WS_O = WS_BIG + 564 * MiB;
constexpr size_t WS_QKV = WS_BIG, WS_Y = WS_BIG + 544 * MiB, WS_GATED = WS_BIG;
constexpr size_t WS_G = WS_BIG, WS_U = WS_BIG + 374 * MiB;
constexpr size_t WS_END = WS_BIG + 1088 * MiB;
static_assert((size_t)MT * 8192 * 2 <= 544 * MiB && (size_t)MT * 5632 * 2 <= 374 * MiB && (size_t)MT * N1 * 2 <= 88 * MiB, "ws map");

constexpr int CW_BAR = 4096;

constexpr int RING_BYTES = 131072, CTRL_BASE = 155648, MISC_OFF = CTRL_BASE + 320, ARGS_OFF = CTRL_BASE + 1024, EDGE_OFF = CTRL_BASE + 4096, LDS_BYTES = 163840;

__device__ __forceinline__ unsigned cvt_pk_bf16(float lo, float hi) { unsigned r; asm volatile("v_cvt_pk_bf16_f32 %0, %1, %2" : "=v"(r) : "v"(lo), "v"(hi)); return r; }
__device__ __forceinline__ float bf2f(unsigned short b) { return __uint_as_float((unsigned)b << 16); }
__device__ __forceinline__ float bflo(unsigned w) { return __uint_as_float(w << 16); }
__device__ __forceinline__ float bfhi(unsigned w) { return __uint_as_float(w & 0xffff0000u); }
__device__ __forceinline__ float shfl_xor_l(float v, int mask, int lane) { return __builtin_bit_cast(float, __builtin_amdgcn_ds_bpermute((lane ^ mask) << 2, __builtin_bit_cast(int, v))); }
__device__ __forceinline__ float fast_silu(float x) { return x * __builtin_amdgcn_rcpf(1.0f + __builtin_amdgcn_exp2f(-x * LOG2E)); }

__device__ __forceinline__ void glds16_s(const void* sbase, unsigned voff, unsigned lds_dst) {
    unsigned keep;
    asm volatile("s_mov_b32 %0, m0\n\ts_mov_b32 m0, %3\n\ts_nop 0\n\tglobal_load_lds_dwordx4 %1, %2\n\ts_mov_b32 m0, %0" : "=&s"(keep) : "v"(voff), "s"(sbase), "s"(lds_dst) : "memory");
}
__device__ __forceinline__ const char* uni_ptr(const void* p) {
    const unsigned long long v = (unsigned long long)p; const unsigned lo = __builtin_amdgcn_readfirstlane((unsigned)v), hi = __builtin_amdgcn_readfirstlane((unsigned)(v >> 32));
    return (const char*)(((unsigned long long)hi << 32) | lo);
}
namespace pg8 {
constexpr int BM = 256, BK = 64, HALF = 128, HTB = HALF * BK * 2, STAGE_BYTES = 8 * HTB, NXCD = 8, WGM = 8;
__host__ __device__ __forceinline__ int lds_byte(int r, int c) { const int st = (r >> 4) * 2 + (c >> 5), rr = r & 15, cc = c & 31, ob = rr * 64 + cc * 2; return st * 1024 + (ob ^ (((ob >> 9) & 1) << 5)); }
__host__ __device__ __forceinline__ void stage_rc(int b, int& R, int& C) { const int st = b / 1024, sb = b % 1024, swz = sb ^ (((sb >> 9) & 1) << 5); R = (st >> 1) * 16 + swz / 64; C = (st & 1) * 32 + (swz % 64) / 2; }
__host__ __device__ __forceinline__ int perm32(int rho) { const int n = rho >> 4, i = rho & 15; return 8 * (i >> 2) + 4 * n + (i & 3); }
struct Unit { int pm, pn; };
struct Gemm { const bf16* A; const bf16* Bt; int M, N, K, lda; };
struct StaticOrder {
    int nM, nN, nwg, G, c, wgm, delay = 0, probe = 0; bool rev; unsigned long long* tsw = nullptr;
    __device__ __forceinline__ void init(int M, int N, int G_, int c_, int wgm_ = WGM, bool rev_ = false) { nM = M / BM; nN = N / BM; nwg = nM * nN; G = G_; c = c_; wgm = wgm_; rev = rev_; }
    __device__ __forceinline__ bool next(int i, Unit& u) const {
        const long L = (long)i * G + c; if (L >= nwg) return false;
        int wgid = (int)L; { const int q = nwg / NXCD, r = nwg % NXCD, xcd = wgid % NXCD, off = wgid / NXCD; wgid = (xcd < r ? xcd * (q + 1) : r * (q + 1) + (xcd - r) * q) + off; }
        const int nig = wgm * nN, gid = wgid / nig, fm = gid * wgm, gsz = (nM - fm) < wgm ? (nM - fm) : wgm;
        u.pm = fm + ((wgid % nig) % gsz); u.pn = (wgid % nig) / gsz; if (rev) u.pm = nM - 1 - u.pm; return true;
    }
};
template <class Epi>
__device__ __forceinline__ void gemm_phase(LAS unsigned char* lds, const Gemm g, const StaticOrder& S, const Epi& E) {
    int tid = threadIdx.x; asm volatile("" : "+v"(tid));
    const int wid = __builtin_amdgcn_readfirstlane(tid >> 6), lane = tid & 63, wr = wid >> 2, wc = wid & 3, fr = lane & 15, fq = lane >> 4;
    const int K = g.K, nt = K / BK;
    unsigned voffA[2], voffB[2];
#pragma unroll
    for (int i = 0; i < 2; ++i) { int R, C; stage_rc(tid * 16 + i * 8192, R, C); const int Rb = Epi::PERM ? ((R & ~31) + perm32(R & 31)) : R;
        voffA[i] = (unsigned)(R * g.lda + C) * 2u; voffB[i] = (unsigned)(Rb * K + C) * 2u; }
    const size_t kstep = (size_t)(BK * 2);
    const size_t hstepA = (size_t)HALF * g.lda * 2, hstepB = (size_t)HALF * K * 2;
    const size_t tstepA = 2 * hstepA, tstepB = 2 * hstepB;
    const unsigned ldsbase = (unsigned)__builtin_amdgcn_readfirstlane((unsigned)(uintptr_t)lds + (unsigned)wid * 1024u);
    const int aoff = lds_byte(wr * 64 + fr, fq * 8), boff = lds_byte(wc * 32 + fr, fq * 8);
#define PG8_SA(b, h) (((b) * 2 + (h)) * HTB)
#define PG8_SB(b, h) ((4 + (b) * 2 + (h)) * HTB)
#define PG8_STAGE(bufoff, gbase, voff) do { const char* _gb = uni_ptr(gbase); _Pragma("unroll") for (int _i = 0; _i < 2; ++_i) \
        glds16_s(_gb, (voff)[_i], ldsbase + (unsigned)((bufoff) + _i * 8192)); } while (0)
#define PG8_LDA(dst, b, h) do { _Pragma("unroll") for (int m = 0; m < 4; ++m) _Pragma("unroll") for (int k = 0; k < 2; ++k) dst[m][k] = *(const LAS bf16x8*)(lds + PG8_SA(b, h) + aoff + m * 2048 + k * 1024); } while (0)
#define PG8_LDB(dst, b, h) do { _Pragma("unroll") for (int n = 0; n < 2; ++n) _Pragma("unroll") for (int k = 0; k < 2; ++k) dst[n][k] = *(const LAS bf16x8*)(lds + PG8_SB(b, h) + boff + n * 2048 + k * 1024); } while (0)
#define PG8_MMA(ai, bj, At, Bt) do { __builtin_amdgcn_s_setprio(1); _Pragma("unroll") for (int m = 0; m < 4; ++m) _Pragma("unroll") for (int n = 0; n < 2; ++n) _Pragma("unroll") for (int k = 0; k < 2; ++k) \
        acc[ai][bj][m][n] = __builtin_amdgcn_mfma_f32_16x16x32_bf16(Bt[n][k], At[m][k], acc[ai][bj][m][n], 0, 0, 0); __builtin_amdgcn_s_setprio(0); } while (0)
#define PG8_WAIT_V(n) asm volatile("s_waitcnt vmcnt(" #n ")" ::: "memory")
#define PG8_WAIT_L(n) asm volatile("s_waitcnt lgkmcnt(" #n ")" ::: "memory")
#define PG8_BAR __builtin_amdgcn_s_barrier()
#define PG8_SCHED __builtin_amdgcn_sched_barrier(0)
    Unit cur, nxt; int ui = 0;
    if (!S.next(0, cur)) return;
    if (S.delay) { const unsigned long long t0 = __builtin_amdgcn_s_memrealtime(); while (__builtin_amdgcn_s_memrealtime() - t0 < (unsigned long long)S.delay) __builtin_amdgcn_s_sleep(8); }
#if MK_STAGGER
    if (S.c & 1) {
        const unsigned long long t0 = __builtin_amdgcn_s_memrealtime(); const unsigned long long dt = (unsigned long long)nt * MK_STAGGER;
        while (__builtin_amdgcn_s_memrealtime() - t0 < dt) __builtin_amdgcn_s_sleep(8);
    }
#endif
    f32x4 acc[2][2][4][2];
#pragma unroll
    for (int a = 0; a < 2; ++a)
#pragma unroll
        for (int b = 0; b < 2; ++b)
#pragma unroll
            for (int m = 0; m < 4; ++m)
#pragma unroll
                for (int n = 0; n < 2; ++n) acc[a][b][m][n] = (f32x4){0.f, 0.f, 0.f, 0.f};
    bf16x8 At[4][2], B0[2][2], B1[2][2];
    const char* cA = (const char*)g.A + (size_t)cur.pm * tstepA; const char* cB = (const char*)g.Bt + (size_t)cur.pn * tstepB;
    PG8_STAGE(PG8_SB(0, 0), cB, voffB); PG8_STAGE(PG8_SB(0, 1), cB + hstepB, voffB); PG8_STAGE(PG8_SA(0, 0), cA, voffA); PG8_STAGE(PG8_SA(0, 1), cA + hstepA, voffA);
    if (wr == 1) PG8_BAR;
    PG8_WAIT_V(2); PG8_BAR;
    PG8_STAGE(PG8_SB(1, 0), cB + kstep, voffB); PG8_STAGE(PG8_SA(1, 0), cA + kstep, voffA); PG8_STAGE(PG8_SB(1, 1), cB + hstepB + kstep, voffB);
    PG8_WAIT_V(6); PG8_BAR;
#if PROBE_TS
    unsigned long long pt_loop = 0, pt_epi = 0, pt_n = 0, pt_t0 = __builtin_amdgcn_s_memrealtime();
#endif
    for (;;) {
        const bool has_next = S.next(ui + 1, nxt);
        const char* nA = has_next ? (const char*)g.A + (size_t)nxt.pm * tstepA : cA; const char* nB = has_next ? (const char*)g.Bt + (size_t)nxt.pn * tstepB : cB;
        for (int t = 0; t < nt; t += 2) {
            const bool last = (t == nt - 2);
            const char* a1 = cA + (size_t)(t + 1) * kstep;
            const char* a2 = last ? nA : cA + (size_t)(t + 2) * kstep; const char* b2 = last ? nB : cB + (size_t)(t + 2) * kstep;
            const char* a3 = a2 + kstep; const char* b3 = b2 + kstep;
            PG8_LDB(B0, 0, 0); PG8_LDB(B1, 0, 1); PG8_SCHED; PG8_LDA(At, 0, 0); PG8_STAGE(PG8_SA(1, 1), a1 + hstepA, voffA);
            PG8_WAIT_V(8); PG8_WAIT_L(0); PG8_BAR; PG8_MMA(0, 0, At, B0); PG8_MMA(0, 1, At, B1); PG8_BAR; PG8_SCHED;
            PG8_LDA(At, 0, 1); PG8_STAGE(PG8_SB(0, 0), b2, voffB); PG8_STAGE(PG8_SB(0, 1), b2 + hstepB, voffB); PG8_STAGE(PG8_SA(0, 0), a2, voffA);
            PG8_WAIT_V(8); PG8_WAIT_L(0); PG8_BAR; PG8_MMA(1, 0, At, B0); PG8_MMA(1, 1, At, B1); PG8_BAR; PG8_SCHED;
            PG8_LDB(B0, 1, 0); PG8_LDB(B1, 1, 1); PG8_SCHED; PG8_LDA(At, 1, 0); PG8_STAGE(PG8_SA(0, 1), a2 + hstepA, voffA);
            PG8_WAIT_V(8); PG8_WAIT_L(0); PG8_BAR; PG8_MMA(0, 0, At, B0); PG8_MMA(0, 1, At, B1); PG8_BAR; PG8_SCHED;
            PG8_LDA(At, 1, 1); PG8_STAGE(PG8_SB(1, 0), b3, voffB); PG8_STAGE(PG8_SB(1, 1), b3 + hstepB, voffB); PG8_STAGE(PG8_SA(1, 0), a3, voffA);
            PG8_WAIT_V(8); PG8_WAIT_L(0); PG8_BAR; PG8_MMA(1, 0, At, B0); PG8_MMA(1, 1, At, B1); PG8_BAR; PG8_SCHED;
        }
        if (wr == 0) PG8_BAR;
#if PROBE_TS
        const unsigned long long pt_t1 = __builtin_amdgcn_s_memrealtime();
#endif
        E(acc, cur, wr, wc, fr, fq);
#if PROBE_TS
        { asm volatile("s_waitcnt vmcnt(0)" ::: "memory"); const unsigned long long pt_t2 = __builtin_amdgcn_s_memrealtime(); pt_loop += pt_t1 - pt_t0; pt_epi += pt_t2 - pt_t1; pt_n += 1; pt_t0 = pt_t2; }
#endif
#if PROBE_EPI2
        if (Epi::PROBE2) E(acc, cur, wr, wc, fr, fq);
#endif
        if (!has_next) break;
#pragma unroll
        for (int a = 0; a < 2; ++a)
#pragma unroll
            for (int b = 0; b < 2; ++b)
#pragma unroll
                for (int m = 0; m < 4; ++m)
#pragma unroll
                    for (int n = 0; n < 2; ++n) acc[a][b][m][n] = (f32x4){0.f, 0.f, 0.f, 0.f};
        cur = nxt; cA = nA; cB = nB; ++ui;
        if (wr == 1) PG8_BAR;
    }
    PG8_WAIT_V(0);
    PG8_BAR;
#if PROBE_TS
    if (S.probe && S.c == 0 && tid == 0) { unsigned long long* tw = S.tsw + 90 + 3 * (S.probe - 1); tw[0] += pt_loop; tw[1] += pt_epi; tw[2] += pt_n; }
#endif
#undef PG8_SA
#undef PG8_SB
#undef PG8_STAGE
#undef PG8_LDA
#undef PG8_LDB
#undef PG8_MMA
#undef PG8_WAIT_V
#undef PG8_WAIT_L
#undef PG8_BAR
#undef PG8_SCHED
}
}
using pg8::Unit;

__device__ __forceinline__ int slack_delay(int nwg, int G, int c, int unit_ticks) {
    const int rem = nwg % G; if (rem == 0 || c < rem) return 0;
    return (int)(((long long)(c - rem) * unit_ticks * 4) / ((long long)(G - rem) * 5));
}
__device__ __forceinline__ u32x4 pack8(const f32x4 a, const f32x4 b) { u32x4 w; w.x = cvt_pk_bf16(a[0], a[1]); w.y = cvt_pk_bf16(a[2], a[3]); w.z = cvt_pk_bf16(b[0], b[1]); w.w = cvt_pk_bf16(b[2], b[3]); return w; }
__device__ __forceinline__ f32x4 rot2(const f32x4 v, const f32x4 cs) { f32x4 o; o[0] = v[0] * cs[0] - v[1] * cs[1]; o[1] = v[1] * cs[0] + v[0] * cs[1]; o[2] = v[2] * cs[2] - v[3] * cs[3]; o[3] = v[3] * cs[2] + v[2] * cs[3]; return o; }

__device__ __forceinline__ f32x4 mla_cs(const float* tabm, int t, int c4) {
    const int p0 = c4 >> 1; const int pos = (p0 < 16) ? (t >> 6) : (t & 63); const int f = p0 & 15;
    return *(const f32x4*)(tabm + ((size_t)pos * 16 + f) * 2);
}

struct EpiG1 {
    static constexpr bool PERM = true, PROBE2 = false;
    bf16* QKVL; float* SSQ; bf16* KR; const float* tabm;
    __device__ __forceinline__ void operator()(const f32x4 (&acc)[2][2][4][2], const Unit& u, int wr, int wc, int fr, int fq) const {
        const int row0 = u.pm * 256 + wr * 64 + fr;
        if (u.pn < 4) {
            const int col0 = u.pn * 256 + wc * 32 + 8 * fq;
#pragma unroll
            for (int ai = 0; ai < 2; ++ai)
#pragma unroll
                for (int m = 0; m < 4; ++m) { const int row = row0 + ai * 128 + m * 16; float ss = 0.f;
#pragma unroll
                    for (int bj = 0; bj < 2; ++bj) { const f32x4 v0 = acc[ai][bj][m][0], v1 = acc[ai][bj][m][1];
                        ss += (v0[0] * v0[0] + v0[1] * v0[1]) + (v0[2] * v0[2] + v0[3] * v0[3]) + (v1[0] * v1[0] + v1[1] * v1[1]) + (v1[2] * v1[2] + v1[3] * v1[3]);
                        *(u32x4*)(QKVL + (size_t)row * N1 + col0 + bj * 128) = pack8(v0, v1); }
                    { const int ln_ = fr + 16 * fq; ss += shfl_xor_l(ss, 16, ln_); ss += shfl_xor_l(ss, 32, ln_); }
                    if (fq == 0) SSQ[(size_t)row * 16 + u.pn * 4 + wc] = ss; asm volatile("" ::: "memory"); }
        } else if (wc < 2) {
            const int c8 = wc * 32 + 8 * fq;
#pragma unroll
            for (int ai = 0; ai < 2; ++ai)
#pragma unroll
                for (int m = 0; m < 4; ++m) { const int row = row0 + ai * 128 + m * 16; f32x4 v0 = acc[ai][0][m][0], v1 = acc[ai][0][m][1];
                    if (row < MX) { const int t = row & (SEQ - 1); v0 = rot2(v0, mla_cs(tabm, t, c8)); v1 = rot2(v1, mla_cs(tabm, t, c8 + 4)); }
                    *(u32x4*)(KR + (size_t)row * 64 + c8) = pack8(v0, v1); asm volatile("" ::: "memory"); }
        }
    }
};
struct EpiUq {
    static constexpr bool PERM = true, PROBE2 = false;
    bf16* Q; const float* SSQ; const float* tabm;
    __device__ __forceinline__ void operator()(const f32x4 (&acc)[2][2][4][2], const Unit& u, int wr, int wc, int fr, int fq) const {
        const int row0 = u.pm * 256 + wr * 64 + fr;
        int col8[2], dd[2];
#pragma unroll
        for (int bj = 0; bj < 2; ++bj) { col8[bj] = u.pn * 256 + bj * 128 + wc * 32 + 8 * fq; dd[bj] = col8[bj] % DQ; }
#pragma unroll
        for (int ai = 0; ai < 2; ++ai)
#pragma unroll
            for (int m = 0; m < 4; ++m) { const int row = row0 + ai * 128 + m * 16;
                const f32x4 s0 = *(const f32x4*)(SSQ + (size_t)row * 16), s1 = *(const f32x4*)(SSQ + (size_t)row * 16 + 4);
                const float ss = ((s0[0] + s0[1]) + (s0[2] + s0[3])) + ((s1[0] + s1[1]) + (s1[2] + s1[3]));
                const float r = 1.0f / sqrtf(ss * (1.0f / QR) + NORM_EPS);
#pragma unroll
                for (int bj = 0; bj < 2; ++bj) { f32x4 v0 = acc[ai][bj][m][0] * r, v1 = acc[ai][bj][m][1] * r;
                    if (dd[bj] >= NOPE && row < MX) { const int t = row & (SEQ - 1), c8 = dd[bj] - NOPE; v0 = rot2(v0, mla_cs(tabm, t, c8)); v1 = rot2(v1, mla_cs(tabm, t, c8 + 4)); }
                    *(u32x4*)(Q + (size_t)row * 3072 + col8[bj]) = pack8(v0, v1); } asm volatile("" ::: "memory"); }
    }
};
struct EpiUkv {
    static constexpr bool PERM = true, PROBE2 = false;
    bf16* KV; const float* SSQ;
    __device__ __forceinline__ void operator()(const f32x4 (&acc)[2][2][4][2], const Unit& u, int wr, int wc, int fr, int fq) const {
        const int row0 = u.pm * 256 + wr * 64 + fr; const int col0 = u.pn * 256 + wc * 32 + 8 * fq;
#pragma unroll
        for (int ai = 0; ai < 2; ++ai)
#pragma unroll
            for (int m = 0; m < 4; ++m) { const int row = row0 + ai * 128 + m * 16;
                const f32x4 s0 = *(const f32x4*)(SSQ + (size_t)row * 16 + 8), s1 = *(const f32x4*)(SSQ + (size_t)row * 16 + 12);
                const float ss = ((s0[0] + s0[1]) + (s0[2] + s0[3])) + ((s1[0] + s1[1]) + (s1[2] + s1[3]));
                const float r = 1.0f / sqrtf(ss * (1.0f / KVR) + NORM_EPS);
#pragma unroll
                for (int bj = 0; bj < 2; ++bj) *(u32x4*)(KV + (size_t)row * 4096 + col0 + bj * 128) = pack8(acc[ai][bj][m][0] * r, acc[ai][bj][m][1] * r); asm volatile("" ::: "memory"); }
    }
};
struct EpiResid {
    static constexpr bool PERM = false, PROBE2 = false;
    const float* xin; float* xout; const float* cin; float* cout; const float* modv; int gofs;
    __device__ __forceinline__ void operator()(const f32x4 (&acc)[2][2][4][2], const Unit& u, int wr, int wc, int fr, int fq) const {
        const bool isx = u.pm < (MX / 256);
        const int rloc = (isx ? u.pm * 256 : (u.pm * 256 - MX)) + wr * 64 + fr;
        const float* base = isx ? xin : cin; float* out = isx ? xout : cout;
        const float* gv = modv + (size_t)(isx ? (u.pm >> 4) : 8) * NMOD + gofs;
        const int col0 = u.pn * 256 + wc * 32 + 4 * fq;
        f32x4 g4[2][2];
#pragma unroll
        for (int bj = 0; bj < 2; ++bj)
#pragma unroll
            for (int n = 0; n < 2; ++n) g4[bj][n] = *(const f32x4*)(gv + col0 + bj * 128 + n * 16);
        f32x4 pre[3][2][2];
#define RES_LOAD(G_, SLOT_) do { const size_t off_ = (size_t)(rloc + ((G_) >> 2) * 128 + ((G_) & 3) * 16) * D + col0; \
            _Pragma("unroll") for (int bj = 0; bj < 2; ++bj) _Pragma("unroll") for (int n = 0; n < 2; ++n) pre[SLOT_][bj][n] = *(const f32x4*)(base + off_ + bj * 128 + n * 16); } while (0)
        RES_LOAD(0, 0); RES_LOAD(1, 1); RES_LOAD(2, 2);
#pragma unroll
        for (int g = 0; g < 8; ++g) { const int ai = g >> 2, m = g & 3; const size_t off = (size_t)(rloc + ai * 128 + m * 16) * D + col0;
#pragma unroll
            for (int bj = 0; bj < 2; ++bj)
#pragma unroll
                for (int n = 0; n < 2; ++n) *(f32x4*)(out + off + bj * 128 + n * 16) = pre[g % 3][bj][n] + g4[bj][n] * acc[ai][bj][m][n];
            asm volatile("" ::: "memory");
            if (g + 3 < 8) RES_LOAD(g + 3, g % 3); }
#undef RES_LOAD
    }
};
template <int CTRL> __device__ __forceinline__ float dpp1(float x) { return __int_as_float(__builtin_amdgcn_update_dpp(0, __float_as_int(x), CTRL, 0xF, 0xF, false)); }
__device__ __forceinline__ f32x4 row_prev(const f32x4 v) { f32x4 o; o.x = dpp1<0x121>(v.x); o.y = dpp1<0x121>(v.y); o.z = dpp1<0x121>(v.z); o.w = dpp1<0x121>(v.w); return o; }
__device__ __forceinline__ f32x4 row_next(const f32x4 v) { f32x4 o; o.x = dpp1<0x12F>(v.x); o.y = dpp1<0x12F>(v.y); o.z = dpp1<0x12F>(v.z); o.w = dpp1<0x12F>(v.w); return o; }
__device__ __forceinline__ f32x4 silu4(const f32x4 v) { f32x4 o;
#pragma unroll
    for (int e = 0; e < 4; ++e) o[e] = fast_silu(v[e]); return o; }
constexpr size_t HALO_STRIDE = (size_t)FF;
struct EpiGUConv {
    static constexpr bool PERM = true, PROBE2 = true;
    bf16* ACT; float* HALO; const float* cw; const float* cb; LAS float* edge;
    __device__ __forceinline__ void operator()(const f32x4 (&acc)[2][2][4][2], const Unit& u, int wr, int wc, int fr, int fq) const {
        const int c8 = wc * 32 + 8 * fq; const int f0 = u.pn * 128 + c8;
#pragma unroll
        for (int ai = 0; ai < 2; ++ai) { const int blk = 2 * ai + wr;
            if (fr == 0)  { *(LAS f32x4*)(edge + (blk * 2 + 0) * 128 + c8) = acc[ai][0][0][0]; *(LAS f32x4*)(edge + (blk * 2 + 0) * 128 + c8 + 4) = acc[ai][0][0][1]; }
            if (fr == 15) { *(LAS f32x4*)(edge + (blk * 2 + 1) * 128 + c8) = acc[ai][0][3][0]; *(LAS f32x4*)(edge + (blk * 2 + 1) * 128 + c8 + 4) = acc[ai][0][3][1]; } }
        asm volatile("s_waitcnt lgkmcnt(0)" ::: "memory"); __builtin_amdgcn_s_barrier(); asm volatile("" ::: "memory");
        f32x4 w0[2], w1[2], w2[2], bb[2];
#pragma unroll
        for (int n = 0; n < 2; ++n) { w0[n] = *(const f32x4*)(cw + f0 + 4 * n); w1[n] = *(const f32x4*)(cw + FF + f0 + 4 * n); w2[n] = *(const f32x4*)(cw + 2 * FF + f0 + 4 * n); bb[n] = *(const f32x4*)(cb + f0 + 4 * n); }
        const f32x4 zero4 = {0.f, 0.f, 0.f, 0.f};
#pragma unroll
        for (int ai = 0; ai < 2; ++ai) { const int blk = 2 * ai + wr;
#pragma unroll
            for (int m = 0; m < 4; ++m) { const int row = u.pm * 256 + ai * 128 + wr * 64 + m * 16 + fr; f32x4 o[2];
#pragma unroll
                for (int n = 0; n < 2; ++n) { const f32x4 cur = acc[ai][0][m][n];
                    f32x4 b, d;
                    if (m > 0) b = row_prev(acc[ai][0][m - 1][n]); else b = (blk > 0) ? *(const LAS f32x4*)(edge + ((blk - 1) * 2 + 1) * 128 + c8 + 4 * n) : zero4;
                    if (m < 3) d = row_next(acc[ai][0][m + 1][n]); else d = (blk < 3) ? *(const LAS f32x4*)(edge + ((blk + 1) * 2 + 0) * 128 + c8 + 4 * n) : zero4;
                    const f32x4 a = row_prev(cur), c = row_next(cur);
                    const f32x4 up = (fr == 0) ? b : a, dn = (fr == 15) ? d : c;
                    const f32x4 cv = w0[n] * up + w1[n] * cur + w2[n] * dn + bb[n]; const f32x4 uu = acc[ai][1][m][n];
                    o[n] = silu4(cv) * uu;
                    if (m == 0 && blk == 0 && fr == 0) { float* hp = HALO + (size_t)((u.pm * 2 + 0) * 3) * HALO_STRIDE + f0 + 4 * n; *(f32x4*)hp = cv; *(f32x4*)(hp + HALO_STRIDE) = cur; *(f32x4*)(hp + 2 * HALO_STRIDE) = uu; }
                    if (m == 3 && blk == 3 && fr == 15) { float* hp = HALO + (size_t)((u.pm * 2 + 1) * 3) * HALO_STRIDE + f0 + 4 * n; *(f32x4*)hp = cv; *(f32x4*)(hp + HALO_STRIDE) = cur; *(f32x4*)(hp + 2 * HALO_STRIDE) = uu; } }
                *(u32x4*)(ACT + (size_t)row * FF + f0) = pack8(o[0], o[1]); asm volatile("" ::: "memory"); } }
        asm volatile("s_waitcnt lgkmcnt(0)" ::: "memory"); __builtin_amdgcn_s_barrier(); asm volatile("" ::: "memory");
    }
};
struct EpiQKV {
    static constexpr bool PERM = true, PROBE2 = false;
    bf16* QKV; const float* tabr;
    __device__ __forceinline__ void operator()(const f32x4 (&acc)[2][2][4][2], const Unit& u, int wr, int wc, int fr, int fq) const {
        const int row0 = u.pm * 256 + wr * 64 + fr; const int col0 = u.pn * 256 + wc * 32 + 8 * fq;
        const bool rope = (u.pn < 16) && (u.pm < MX / 256);
#pragma unroll
        for (int ai = 0; ai < 2; ++ai)
#pragma unroll
            for (int m = 0; m < 4; ++m) { const int row = row0 + ai * 128 + m * 16;
#pragma unroll
                for (int bj = 0; bj < 2; ++bj) { f32x4 v0 = acc[ai][bj][m][0], v1 = acc[ai][bj][m][1]; const int col = col0 + bj * 128;
                    if (rope) { const int t = row & (SEQ - 1); const float* tp = tabr + ((size_t)t * 128 + ((col & 255) >> 1)) * 2;
                        v0 = rot2(v0, *(const f32x4*)tp); v1 = rot2(v1, *(const f32x4*)(tp + 4)); }
                    *(u32x4*)(QKV + (size_t)row * 8192 + col) = pack8(v0, v1); } asm volatile("" ::: "memory"); }
    }
};
struct EpiGate {
    static constexpr bool PERM = true, PROBE2 = false;
    bf16* GATED; const bf16* YF; const bf16* YB; const float* ST;
    __device__ __forceinline__ void operator()(const f32x4 (&acc)[2][2][4][2], const Unit& u, int wr, int wc, int fr, int fq) const {
        const int row0 = u.pm * 256 + wr * 64 + fr; const int f0 = u.pn * 128 + wc * 32 + 8 * fq; const int hd = u.pn >> 2;
#pragma unroll
        for (int ai = 0; ai < 2; ++ai)
#pragma unroll
            for (int m = 0; m < 4; ++m) { const int row = row0 + ai * 128 + m * 16; const size_t off = (size_t)row * 4096 + f0;
                const u32x4 yf = *(const u32x4*)(YF + off), yb = *(const u32x4*)(YB + off);
                const f32x2 sf = *(const f32x2*)(ST + ((size_t)row * 8 + hd) * 2), sb = *(const f32x2*)(ST + ((size_t)(MT + row) * 8 + hd) * 2);
                const f32x4 a0 = acc[ai][0][m][0], a1 = acc[ai][0][m][1], b0 = acc[ai][1][m][0], b1 = acc[ai][1][m][1];
#define NF(w, hi_) (((hi_ ? bfhi(w) : bflo(w)) - sf[0]) * sf[1])
#define NB(w, hi_) (((hi_ ? bfhi(w) : bflo(w)) - sb[0]) * sb[1])
                f32x4 o0, o1;
                o0[0] = fast_silu(a0[0]) * NF(yf.x, 0) + fast_silu(b0[0]) * NB(yb.x, 0); o0[1] = fast_silu(a0[1]) * NF(yf.x, 1) + fast_silu(b0[1]) * NB(yb.x, 1);
                o0[2] = fast_silu(a0[2]) * NF(yf.y, 0) + fast_silu(b0[2]) * NB(yb.y, 0); o0[3] = fast_silu(a0[3]) * NF(yf.y, 1) + fast_silu(b0[3]) * NB(yb.y, 1);
                o1[0] = fast_silu(a1[0]) * NF(yf.z, 0) + fast_silu(b1[0]) * NB(yb.z, 0); o1[1] = fast_silu(a1[1]) * NF(yf.z, 1) + fast_silu(b1[1]) * NB(yb.z, 1);
                o1[2] = fast_silu(a1[2]) * NF(yf.w, 0) + fast_silu(b1[2]) * NB(yb.w, 0); o1[3] = fast_silu(a1[3]) * NF(yf.w, 1) + fast_silu(b1[3]) * NB(yb.w, 1);
#undef NF
#undef NB
                *(u32x4*)(GATED + off) = pack8(o0, o1); asm volatile("" ::: "memory"); }
    }
};

namespace att {
constexpr int NW = 8, QBLK = 32, KVBLK = 64;
constexpr int SHM_V = 16384, SHM_KN = 16384, SHM_KR = 8192;
constexpr int OFF_V = 0, OFF_KN = 3 * SHM_V, OFF_KR = OFF_KN + 2 * SHM_KN, OFF_WS = OFF_KR + 2 * SHM_KR, SHM_ATTN = OFF_WS + NW * 64 * 4;
constexpr float THR2 = 11.5f;
#define KSWZ(row, colB) ((row) * 256 + ((colB) ^ (((row) & 7) << 4)))
#define KRSWZ(row, colB) ((row) * 128 + ((colB) ^ ((((row) >> 1) & 7) << 4)))
#define SBAR() __builtin_amdgcn_sched_barrier(0)
__device__ __forceinline__ int crow(int r, int hi) { return (r & 3) + 8 * (r >> 2) + 4 * hi; }
__device__ __forceinline__ void partialSM(f32x16& p0, f32x16& p1, float& m_reg, float& alpha) {
  float pmax = p0[0];
#pragma unroll
  for (int r = 1; r < 16; ++r) pmax = fmaxf(pmax, p0[r]);
#pragma unroll
  for (int r = 0; r < 16; ++r) pmax = fmaxf(pmax, p1[r]);
  { auto rr = __builtin_amdgcn_permlane32_swap(__float_as_uint(pmax), __float_as_uint(pmax), false, false); pmax = fmaxf(__uint_as_float(rr[0]), __uint_as_float(rr[1])); }
  float mn;
  if (__builtin_expect(__all(pmax - m_reg <= THR2), 1)) { mn = m_reg; alpha = 1.f; }
  else { mn = fmaxf(m_reg, pmax); alpha = __builtin_amdgcn_exp2f(m_reg - mn); m_reg = mn; }
#pragma unroll
  for (int r = 0; r < 16; ++r) p0[r] = p0[r] - mn;
#pragma unroll
  for (int r = 0; r < 16; ++r) p1[r] = p1[r] - mn;
#pragma unroll
  for (int r = 0; r < 16; ++r) p0[r] = __builtin_amdgcn_exp2f(p0[r]);
}
__device__ __forceinline__ void finishSM(f32x16& p0, f32x16& p1, float alpha, float& l_reg, bf16x8& pa0, bf16x8& pa1, bf16x8& pa2, bf16x8& pa3) {
#pragma unroll
  for (int r = 0; r < 16; ++r) p1[r] = __builtin_amdgcn_exp2f(p1[r]);
  float ps = 0;
#pragma unroll
  for (int r = 0; r < 16; ++r) ps += p0[r];
#pragma unroll
  for (int r = 0; r < 16; ++r) ps += p1[r];
  { auto rr = __builtin_amdgcn_permlane32_swap(__float_as_uint(ps), __float_as_uint(ps), false, false); ps = __uint_as_float(rr[0]) + __uint_as_float(rr[1]); }
  l_reg = l_reg * alpha + ps;
#define PK4(P, BASE, OUT) do { unsigned a0 = cvt_pk_bf16(P[BASE + 0], P[BASE + 1]), a1 = cvt_pk_bf16(P[BASE + 2], P[BASE + 3]);   \
    unsigned b0 = cvt_pk_bf16(P[BASE + 4], P[BASE + 5]), b1 = cvt_pk_bf16(P[BASE + 6], P[BASE + 7]);                              \
    auto r0 = __builtin_amdgcn_permlane32_swap(a0, b0, false, false); auto r1 = __builtin_amdgcn_permlane32_swap(a1, b1, false, false); \
    u32x4 w = {r0[0], r1[0], r0[1], r1[1]}; OUT = __builtin_bit_cast(bf16x8, w); } while (0)
  PK4(p0, 0, pa0); PK4(p0, 8, pa1); PK4(p1, 0, pa2); PK4(p1, 8, pa3);
#undef PK4
}
__device__ __forceinline__ void qkt(f32x16& p0, f32x16& p1, const char* Kn, const char* Kr, const bf16x8* qr, int r32, int hi) {
  p0 = f32x16{}; p1 = f32x16{};
#pragma unroll
  for (int d0 = 0; d0 < 8; ++d0) { const int cb = (d0 * 16 + hi * 8) * 2;
    const bf16x8 b0 = *reinterpret_cast<const bf16x8*>(Kn + KSWZ(r32, cb));
    const bf16x8 b1 = *reinterpret_cast<const bf16x8*>(Kn + KSWZ(32 + r32, cb));
    p0 = __builtin_amdgcn_mfma_f32_32x32x16_bf16(b0, qr[d0], p0, 0, 0, 0);
    p1 = __builtin_amdgcn_mfma_f32_32x32x16_bf16(b1, qr[d0], p1, 0, 0, 0); }
#pragma unroll
  for (int d0 = 0; d0 < 4; ++d0) { const int cb = (d0 * 16 + hi * 8) * 2;
    const bf16x8 b0 = *reinterpret_cast<const bf16x8*>(Kr + KRSWZ(r32, cb));
    const bf16x8 b1 = *reinterpret_cast<const bf16x8*>(Kr + KRSWZ(32 + r32, cb));
    p0 = __builtin_amdgcn_mfma_f32_32x32x16_bf16(b0, qr[8 + d0], p0, 0, 0, 0);
    p1 = __builtin_amdgcn_mfma_f32_32x32x16_bf16(b1, qr[8 + d0], p1, 0, 0, 0); }
}
__device__ __forceinline__ int v_st(int k, int c) { const int kk = (k & ~0xC) | ((k & 4) << 1) | ((k & 8) >> 1); return ((kk >> 3) * 4 + (c >> 5)) * 512 + ((kk & 7) * 32 + (c & 31)) * 2; }
__device__ __forceinline__ int v_rd_base(int lane) { return ((lane & 3) << 3) | (((lane >> 2) & 3) << 6) | (((lane >> 4) & 1) << 5) | (((lane >> 5) & 1) << 8); }
constexpr int v_rd_off(int d0, int ks, int half) { return d0 * 512 + ks * 4096 + half * 2048; }
template <int OFF> __device__ __forceinline__ s16x4 tr_read(int vb) { s16x4 r; asm volatile("ds_read_b64_tr_b16 %0, %1 offset:%2" : "=&v"(r) : "v"(vb), "i"(OFF) : "memory"); return r; }
template <int D0> __device__ __forceinline__ void pv_one(f32x16& od, int vb, bf16x8 pa0, bf16x8 pa1, bf16x8 pa2, bf16x8 pa3) {
  const s16x4 l0 = tr_read<v_rd_off(D0, 0, 0)>(vb), h0 = tr_read<v_rd_off(D0, 0, 1)>(vb), l1 = tr_read<v_rd_off(D0, 1, 0)>(vb), h1 = tr_read<v_rd_off(D0, 1, 1)>(vb);
  const s16x4 l2 = tr_read<v_rd_off(D0, 2, 0)>(vb), h2 = tr_read<v_rd_off(D0, 2, 1)>(vb), l3 = tr_read<v_rd_off(D0, 3, 0)>(vb), h3 = tr_read<v_rd_off(D0, 3, 1)>(vb);
  asm volatile("s_waitcnt lgkmcnt(0)" ::: "memory"); SBAR();
#define PK(L, H) (bf16x8){L[0], L[1], L[2], L[3], H[0], H[1], H[2], H[3]}
  od = __builtin_amdgcn_mfma_f32_32x32x16_bf16(pa0, PK(l0, h0), od, 0, 0, 0);
  od = __builtin_amdgcn_mfma_f32_32x32x16_bf16(pa1, PK(l1, h1), od, 0, 0, 0);
  od = __builtin_amdgcn_mfma_f32_32x32x16_bf16(pa2, PK(l2, h2), od, 0, 0, 0);
  od = __builtin_amdgcn_mfma_f32_32x32x16_bf16(pa3, PK(l3, h3), od, 0, 0, 0);
#undef PK
}
__device__ __forceinline__ void pv_d0(f32x16* o, int vb, bf16x8 pa0, bf16x8 pa1, bf16x8 pa2, bf16x8 pa3) {
  pv_one<0>(o[0], vb, pa0, pa1, pa2, pa3); pv_one<1>(o[1], vb, pa0, pa1, pa2, pa3); pv_one<2>(o[2], vb, pa0, pa1, pa2, pa3); pv_one<3>(o[3], vb, pa0, pa1, pa2, pa3);
}
__device__ __forceinline__ void attn_unit(const bf16* __restrict__ Qb, const bf16* __restrict__ KVh, const bf16* __restrict__ KRp, bf16* __restrict__ Ob,
                                          int NT, int nc, int cbase, int xbase, char* lds) {
  int tid = threadIdx.x; asm volatile("" : "+v"(tid));
  const int wid = __builtin_amdgcn_readfirstlane(tid >> 6), lane = tid & 63, r32 = lane & 31, hi = lane >> 5;
  char* V_lds = lds + OFF_V; char* Kn_lds = lds + OFF_KN; char* Kr_lds = lds + OFF_KR;
  float* ws = (float*)(lds + OFF_WS) + wid * 64; float* li_l = ws; float* al_l = ws + 32;
  float m_reg = -1e30f, l_reg = 0; f32x16 o[4] = {}; bf16x8 qr[12];
  const bf16* Qw = Qb + (long)(wid * QBLK + r32) * 3072 + hi * 8;
#pragma unroll
  for (int d0 = 0; d0 < 12; ++d0) qr[d0] = *reinterpret_cast<const bf16x8*>(Qw + d0 * 16);
  const int vb0 = (int)(uintptr_t)V_lds + v_rd_base(lane);
  unsigned vofK[2], vofV[2], vofR;
#pragma unroll
  for (int i = 0; i < 2; ++i) { const int pc = wid * 2 + i;
      { const int row = pc * 4 + (lane >> 4), ch = (lane & 15) ^ (row & 7); vofK[i] = (unsigned)((row * 4096 + ch * 8) * 2); }
      { const int ob = pc * 1024 + lane * 16, st = ob >> 9, w = ob & 511, kk = (st >> 2) * 8 + (w >> 6); const int k = (kk & ~0xC) | ((kk & 4) << 1) | ((kk & 8) >> 1);
        const int c = (st & 3) * 32 + 8 * ((w & 63) >> 4); vofV[i] = (unsigned)((k * 4096 + 128 + c) * 2); } }
  { const int row = wid * 8 + (lane >> 3), ch = (lane & 7) ^ ((row >> 1) & 7); vofR = (unsigned)((row * 64 + ch * 8) * 2); }
  const unsigned ldsK = (unsigned)__builtin_amdgcn_readfirstlane((unsigned)(uintptr_t)Kn_lds + (unsigned)wid * 2048u);
  const unsigned ldsV = (unsigned)__builtin_amdgcn_readfirstlane((unsigned)(uintptr_t)V_lds + (unsigned)wid * 2048u);
  const unsigned ldsR = (unsigned)__builtin_amdgcn_readfirstlane((unsigned)(uintptr_t)Kr_lds + (unsigned)wid * 1024u);
#define KROW(j) ((j) < nc ? cbase + (j) * KVBLK : xbase + ((j) - nc) * KVBLK)
#define DMA_TILE(j, kslot, vslot) do { const long k0_ = KROW(j); const char* kb_ = uni_ptr(KVh + k0_ * 4096); const char* rb_ = uni_ptr(KRp + k0_ * 64); \
    glds16_s(kb_, vofK[0], ldsK + (kslot) * SHM_KN); glds16_s(kb_, vofK[1], ldsK + (kslot) * SHM_KN + 1024u); \
    glds16_s(rb_, vofR, ldsR + (kslot) * SHM_KR); \
    glds16_s(kb_, vofV[0], ldsV + (vslot) * SHM_V); glds16_s(kb_, vofV[1], ldsV + (vslot) * SHM_V + 1024u); } while (0)
#ifndef ATT_SKEW
#define ATT_SKEW 0
#endif
#define WAIT_SYNC() do { asm volatile("s_waitcnt vmcnt(0)" ::: "memory"); __syncthreads(); if (ATT_SKEW && wid >= 4) __builtin_amdgcn_s_sleep(ATT_SKEW); } while (0)
#define RESC(a) do { if (__any((a) < 1.f)) { if (hi == 0) al_l[r32] = (a); asm volatile("s_waitcnt lgkmcnt(0)" ::: "memory"); \
    _Pragma("unroll") for (int d = 0; d < 4; ++d) _Pragma("unroll") for (int r = 0; r < 16; ++r) o[d][r] *= al_l[crow(r, hi)]; } } while (0)
  f32x16 pA0, pA1, pB0, pB1; float alA, alB; bf16x8 pa0, pa1, pa2, pa3;
  DMA_TILE(0, 0, 0); DMA_TILE(1, 1, 1); WAIT_SYNC();
  qkt(pA0, pA1, Kn_lds, Kr_lds, qr, r32, hi); partialSM(pA0, pA1, m_reg, alA);
  __syncthreads();
  int vprev = 0, vcur = 1, vnext = 2;
  for (int j = 1; j + 1 < NT; j += 2) {
    DMA_TILE(j + 1, 0, vnext);
    SBAR(); qkt(pB0, pB1, Kn_lds + SHM_KN, Kr_lds + SHM_KR, qr, r32, hi);
    finishSM(pA0, pA1, alA, l_reg, pa0, pa1, pa2, pa3); SBAR();
    pv_d0(o, vb0 + vprev * SHM_V, pa0, pa1, pa2, pa3); partialSM(pB0, pB1, m_reg, alB);
    RESC(alB); WAIT_SYNC();
    { const int t_ = vprev; vprev = vcur; vcur = vnext; vnext = t_; }
    if (j + 2 < NT) DMA_TILE(j + 2, 1, vnext);
    SBAR(); qkt(pA0, pA1, Kn_lds, Kr_lds, qr, r32, hi);
    finishSM(pB0, pB1, alB, l_reg, pa0, pa1, pa2, pa3); SBAR();
    pv_d0(o, vb0 + vprev * SHM_V, pa0, pa1, pa2, pa3); partialSM(pA0, pA1, m_reg, alA);
    RESC(alA); WAIT_SYNC();
    { const int t_ = vprev; vprev = vcur; vcur = vnext; vnext = t_; }
  }
  SBAR(); qkt(pB0, pB1, Kn_lds + SHM_KN, Kr_lds + SHM_KR, qr, r32, hi);
  finishSM(pA0, pA1, alA, l_reg, pa0, pa1, pa2, pa3); SBAR();
  pv_d0(o, vb0 + vprev * SHM_V, pa0, pa1, pa2, pa3); partialSM(pB0, pB1, m_reg, alB);
  RESC(alB);
  finishSM(pB0, pB1, alB, l_reg, pa0, pa1, pa2, pa3); SBAR();
  pv_d0(o, vb0 + vcur * SHM_V, pa0, pa1, pa2, pa3);
  if (hi == 0) li_l[r32] = l_reg; asm volatile("s_waitcnt lgkmcnt(0)" ::: "memory");
  float rli[16];
#pragma unroll
  for (int r = 0; r < 16; ++r) rli[r] = __builtin_amdgcn_rcpf(li_l[crow(r, hi)]);
  bf16* Ow = Ob + (long)(wid * QBLK) * 2048;
#pragma unroll
  for (int r = 0; r < 16; ++r) { const int orow = crow(r, hi);
#pragma unroll
    for (int d0 = 0; d0 < 4; ++d0) Ow[(long)orow * 2048 + d0 * 32 + r32] = (bf16)(cvt_pk_bf16(o[d0][r] * rli[r], 0.f) & 0xffffu); }
  __syncthreads();
#undef KROW
#undef DMA_TILE
#undef WAIT_SYNC
#undef RESC
}
#undef SBAR
}

namespace scan {
constexpr int CH = 64;
constexpr int OFF_Q = 0, OFF_K = 32768  , OFF_V = 98304, OFF_P = 131072, SHM_SCAN = 131072 + 8192;
__device__ __forceinline__ unsigned off_b(unsigned row, unsigned ch) { return 256u * row + 16u * (ch ^ (((row & 3) << 2) | ((row >> 2) & 3))); }
__device__ __forceinline__ unsigned p_off(unsigned i, unsigned chunk) { return 128u * i + 16u * (chunk ^ ((i >> 1) & 7)); }
__device__ __forceinline__ int crow(int r, int hi) { return (r & 3) + 8 * (r >> 2) + 4 * hi; }
__device__ __forceinline__ s16x4 vtr(const LAS char* p) { typedef short v4i16_t __attribute__((ext_vector_type(4))); return __builtin_bit_cast(s16x4, __builtin_amdgcn_ds_read_tr16_b64_v4i16((LAS v4i16_t*)p)); }
__device__ __forceinline__ bf16x8 tr_frag(const LAS char* img, int lane, int c, int ks) {
    const unsigned h = lane >> 5, blk = (lane >> 4) & 1, q = (lane & 15) >> 2, p = lane & 3;
    const unsigned r0 = 16 * ks + 8 * h + q, chn = 4 * c + 2 * blk + (p >> 1);
    const s16x4 lo = vtr(img + off_b(r0, chn) + 8 * (p & 1)), hi = vtr(img + off_b(r0 + 4, chn) + 8 * (p & 1));
    return (bf16x8){lo[0], lo[1], lo[2], lo[3], hi[0], hi[1], hi[2], hi[3]};
}
__device__ __forceinline__ bf16x8 pack_step(const f32x16& x, int s) {
    u32x4 p; p.x = cvt_pk_bf16(x[8 * s + 0], x[8 * s + 1]); p.y = cvt_pk_bf16(x[8 * s + 2], x[8 * s + 3]); p.z = cvt_pk_bf16(x[8 * s + 4], x[8 * s + 5]); p.w = cvt_pk_bf16(x[8 * s + 6], x[8 * s + 7]);
    return __builtin_bit_cast(bf16x8, p);
}
__device__ __forceinline__ void dma_mat(const bf16* src, int ld, LAS unsigned char* dst, int wid, int lane) {
    const char* sb = uni_ptr(src); const unsigned d0 = (unsigned)__builtin_amdgcn_readfirstlane((unsigned)(uintptr_t)dst + (unsigned)wid * 4096u);
#pragma unroll
    for (int k = 0; k < 4; ++k) { const int pc = wid * 4 + k, img = pc >> 4, row = 4 * (pc & 15) + (lane >> 4), pos = lane & 15;
        const int ch = pos ^ (((row & 3) << 2) | ((row >> 2) & 3));
        glds16_s(sb, (unsigned)((row * ld + img * 128 + ch * 8) * 2), d0 + (unsigned)k * 1024u); }
}
__device__ __forceinline__ int scan_rowbase(int n, int b, int dir) { return (n < 4) ? MX + b * CTXL + (dir ? 3 - n : n) * CH : b * SEQ + (dir ? 67 - n : n - 4) * CH; }
__device__ __forceinline__ float uni_f(float x) { return __uint_as_float(__builtin_amdgcn_readfirstlane(__float_as_uint(x))); }
typedef const LAS s16x4* lds_s4p;
__device__ __forceinline__ void scan_unit(const bf16* __restrict__ QKV, bf16* __restrict__ Y, int b, int hd, int dir, int dvh, float lg2, bool skip_ctx_y, LAS unsigned char* lds) {
    int tid = threadIdx.x; asm volatile("" : "+v"(tid));
    const int wid = __builtin_amdgcn_readfirstlane(tid >> 6), lane0 = tid & 63;
    const LAS char* QI = (const LAS char*)lds + OFF_Q; const LAS char* VI = (const LAS char*)lds + OFF_V;
    LAS char* PI = (LAS char*)lds + OFF_P;
    f32x16 S[8];
#pragma unroll
    for (int i = 0; i < 8; ++i) S[i] = f32x16{};
    const float lgr = dir ? -lg2 : lg2;
    const float g64 = uni_f(__builtin_amdgcn_exp2f(64.f * lg2));
    const float R1 = uni_f(__builtin_amdgcn_exp2f(lgr)), R8 = uni_f(__builtin_amdgcn_exp2f(8.f * lgr)), R32 = uni_f(__builtin_amdgcn_exp2f(32.f * lgr));
    const float Rm1 = uni_f(__builtin_amdgcn_exp2f(-lgr)), Rm16 = uni_f(__builtin_amdgcn_exp2f(-16.f * lgr));
    const float c0 = uni_f(dir ? g64 : __builtin_amdgcn_exp2f(lg2)), z0 = uni_f(dir ? 1.0f : __builtin_amdgcn_exp2f(63.f * lg2));
    const int qcol = hd * RDK, kcol = 2048 + hd * RDK, vcol = 4096 + hd * RDV + dvh * 256;
    { const bf16* src = QKV + (size_t)scan_rowbase(0, b, dir) * 8192;
      dma_mat(src + qcol, 8192, lds + OFF_Q, wid, lane0); dma_mat(src + kcol, 8192, lds + OFF_K, wid, lane0); dma_mat(src + vcol, 8192, lds + OFF_V, wid, lane0);
      asm volatile("s_waitcnt vmcnt(0)" ::: "memory"); __syncthreads(); }
    for (int n = 0; n < 68; ++n) {
        int lane = lane0; asm volatile("" : "+v"(lane));
        const int r = lane & 31, h = lane >> 5, fr = lane & 15, fq = lane >> 4;
        const int rowbase = scan_rowbase(n, b, dir);
        const bool more = n + 1 < 68;
        const bf16* nsrc = QKV + (size_t)scan_rowbase(more ? n + 1 : n, b, dir) * 8192;
        const LAS char* KI = (const LAS char*)lds + OFF_K + (n & 1) * 32768;
        if (more) dma_mat(nsrc + kcol, 8192, lds + OFF_K + ((n + 1) & 1) * 32768, wid, lane);
        const float LR = c0 * __builtin_amdgcn_exp2f((float)(4 * h) * lgr), LZ = z0 * __builtin_amdgcn_exp2f((float)(-8 * h) * lgr), LP = __builtin_amdgcn_exp2f((float)(fr - 4 * fq) * lgr);
        { const int fH = fr & 3, fL = (fr >> 2) & 3; const int AL = 256 * fr + 16 * (fq ^ fL);
          int AH[4];
#pragma unroll
          for (int k = 0; k < 4; ++k) AH[k] = 64 * (k ^ fH);
#pragma unroll
          for (int tix = 0; tix < 2; ++tix) { const int tt = wid * 2 + tix, jt = tt >> 2, it = tt & 3;
            f32x4 pt = {0.f, 0.f, 0.f, 0.f};
            const bool live = dir ? (jt >= it) : (jt <= it);
            if (live) { const LAS char* ka = KI + 4096 * jt + AL; const LAS char* qa = QI + 4096 * it + AL;
#pragma unroll
                for (int ks = 0; ks < 8; ++ks) { const int o = (ks >> 2) * 16384 + AH[ks & 3];
                    pt = __builtin_amdgcn_mfma_f32_16x16x32_bf16(*(const LAS bf16x8*)(ka + o), *(const LAS bf16x8*)(qa + o), pt, 0, 0, 0); } }
            float we = LP * __builtin_amdgcn_exp2f((float)(16 * (it - jt)) * lgr); float v[4];
            const int mrel = fr - 4 * fq;
#pragma unroll
            for (int e = 0; e < 4; ++e) { float x = live ? pt[e] * we : 0.f; if (jt == it) { const bool keep = dir ? (e >= mrel) : (e <= mrel); x = keep ? x : 0.f; } v[e] = x; we *= Rm1; }
            const int i = it * 16 + fr, j0 = jt * 16 + 4 * fq;
            u32x2 w; w.x = cvt_pk_bf16(v[0], v[1]); w.y = cvt_pk_bf16(v[2], v[3]);
            *(LAS u32x2*)(PI + p_off(i, j0 >> 3) + ((j0 >> 2) & 1) * 8) = w; } }
        f32x16 Yt[2]; Yt[0] = f32x16{}; Yt[1] = f32x16{};
        { const int fH = r & 3, fL = (r >> 2) & 3; int QH[4], QL[4];
#pragma unroll
          for (int k = 0; k < 4; ++k) { QH[k] = 64 * (k ^ fH); QL[k] = 256 * r + 8 * h + 16 * (k ^ fL); }
#pragma unroll
          for (int dkb = 0; dkb < 8; ++dkb)
#pragma unroll
            for (int s = 0; s < 2; ++s) { const bf16x8 bf = pack_step(S[dkb], s);
                const LAS char* rp = QI + (dkb >> 2) * 16384 + QH[dkb & 3];
#pragma unroll
                for (int it = 0; it < 2; ++it) {
                    const u32x2 lo = *(const LAS u32x2*)(rp + it * 8192 + QL[2 * s]), hi2 = *(const LAS u32x2*)(rp + it * 8192 + QL[2 * s + 1]);
                    const u32x4 aw = {lo.x, lo.y, hi2.x, hi2.y};
                    Yt[it] = __builtin_amdgcn_mfma_f32_32x32x16_bf16(__builtin_bit_cast(bf16x8, aw), bf, Yt[it], 0, 0, 0); } } }
        { float fit = LR;
#pragma unroll
          for (int it = 0; it < 2; ++it) { float fa = fit;
#pragma unroll
            for (int a4 = 0; a4 < 4; ++a4) { float fb = fa;
#pragma unroll
                for (int b4 = 0; b4 < 4; ++b4) { Yt[it][4 * a4 + b4] *= fb; fb *= R1; }
                fa *= R8; }
            fit *= R32; } }
        if (more) asm volatile("s_waitcnt vmcnt(4)" ::: "memory"); else asm volatile("s_waitcnt vmcnt(0)" ::: "memory");
        __syncthreads();
        if (more) dma_mat(nsrc + qcol, 8192, lds + OFF_Q, wid, lane);
#pragma unroll
        for (int i = 0; i < 8; ++i)
#pragma unroll
            for (int rg = 0; rg < 16; ++rg) S[i][rg] *= g64;
        {
          const int blk = (lane >> 4) & 1, q = (lane & 15) >> 2, p = lane & 3; int TB[2], CQ[4];
#pragma unroll
          for (int t = 0; t < 2; ++t) TB[t] = 2048 * h + 256 * q + 1024 * t + 16 * ((2 * blk + (p >> 1)) ^ ((2 * h + t) & 3)) + 8 * (p & 1);
#pragma unroll
          for (int c = 0; c < 4; ++c) CQ[c] = 64 * (c ^ q);
          const LAS char* vb = VI + (wid >> 2) * 16384 + CQ[wid & 3];
          float zk = LZ;
#pragma unroll
          for (int ks = 0; ks < 4; ++ks) {
            const s16x4 vlo = vtr(vb + 4096 * ks + TB[0]), vhi = vtr(vb + 4096 * ks + TB[1]);
            const u32x2 vl = __builtin_bit_cast(u32x2, vlo), vh = __builtin_bit_cast(u32x2, vhi);
            const u32x4 vw = {vl.x, vl.y, vh.x, vh.y}; const bf16x8 vf = __builtin_bit_cast(bf16x8, vw);
#pragma unroll
            for (int it = 0; it < 2; ++it) { const bf16x8 pa = *(const LAS bf16x8*)(PI + p_off(it * 32 + r, 2 * ks + h));
                Yt[it] = __builtin_amdgcn_mfma_f32_32x32x16_bf16(pa, vf, Yt[it], 0, 0, 0); }
            float zj = zk; u32x4 zw;
            { const float a0 = bflo(vw.x) * zj; zj *= Rm1; const float a1 = bfhi(vw.x) * zj; zj *= Rm1; zw.x = cvt_pk_bf16(a0, a1); }
            { const float a0 = bflo(vw.y) * zj; zj *= Rm1; const float a1 = bfhi(vw.y) * zj; zj *= Rm1; zw.y = cvt_pk_bf16(a0, a1); }
            { const float a0 = bflo(vw.z) * zj; zj *= Rm1; const float a1 = bfhi(vw.z) * zj; zj *= Rm1; zw.z = cvt_pk_bf16(a0, a1); }
            { const float a0 = bflo(vw.w) * zj; zj *= Rm1; const float a1 = bfhi(vw.w) * zj; zw.w = cvt_pk_bf16(a0, a1); }
            const bf16x8 vz = __builtin_bit_cast(bf16x8, zw);
            zk *= Rm16;
#pragma unroll
            for (int dkb = 0; dkb < 8; ++dkb) { const LAS char* kb_ = KI + (dkb >> 2) * 16384 + 4096 * ks + CQ[dkb & 3];
                const s16x4 klo = vtr(kb_ + TB[0]), khi = vtr(kb_ + TB[1]);
                const u32x2 kl = __builtin_bit_cast(u32x2, klo), kh = __builtin_bit_cast(u32x2, khi); const u32x4 kw = {kl.x, kl.y, kh.x, kh.y};
                S[dkb] = __builtin_amdgcn_mfma_f32_32x32x16_bf16(__builtin_bit_cast(bf16x8, kw), vz, S[dkb], 0, 0, 0); }
            __builtin_amdgcn_sched_barrier(0);
          } }
        if (!(skip_ctx_y && n < 4)) {
            bf16* Yr = Y + (size_t)rowbase * 4096; const unsigned yo = (unsigned)(hd * RDV + dvh * 256 + wid * 32 + r + 4 * h * 4096);
#pragma unroll
            for (int it = 0; it < 2; ++it)
#pragma unroll
                for (int rg = 0; rg < 16; ++rg) { const unsigned i0 = (unsigned)(it * 32 + (rg & 3) + 8 * (rg >> 2));
                    Yr[yo + i0 * 4096u] = (bf16)(cvt_pk_bf16(Yt[it][rg], 0.f) & 0xffffu); }
        }
        asm volatile("s_waitcnt vmcnt(0)" ::: "memory");
        __syncthreads();
        if (more) dma_mat(nsrc + vcol, 8192, lds + OFF_V, wid, lane);
    }
    asm volatile("s_waitcnt vmcnt(0)" ::: "memory"); __syncthreads();
}
}

#define XB_TMO      128
#define XB_XCNT(j)  (256  + 64 * (j))
#define XB_XSUB(j)  (1280 + 64 * (j))
#define XB_XGEN(j)  (2304 + 64 * (j))
#define XB_TOP      3328
#define XB_TOPGEN   3392
#define XCD_BAR_WORDS 3456
#define XB_SPIN_CAP (1u << 22)
__device__ __forceinline__ unsigned xb_ld(unsigned* p)              { return __hip_atomic_load(p, __ATOMIC_RELAXED, __HIP_MEMORY_SCOPE_AGENT); }
__device__ __forceinline__ unsigned xb_add(unsigned* p, unsigned v) { return __hip_atomic_fetch_add(p, v, __ATOMIC_RELAXED, __HIP_MEMORY_SCOPE_AGENT); }
__device__ __forceinline__ unsigned xb_xcc_id() { return (unsigned)__builtin_amdgcn_s_getreg((3 << 11) | 20) & 0xFu; }
#define XB_SPIN(cond, bar) do { unsigned _sp = 0; while (cond) { __builtin_amdgcn_s_sleep(1); \
    if ((++_sp & 255u) == 0u) { if (xb_ld(&(bar)[XB_TMO])) break; if (_sp > XB_SPIN_CAP) { atomicAdd(&(bar)[XB_TMO], 1u); break; } } } } while (0)
struct XcdBarrier { unsigned* bar; unsigned x; volatile LAS unsigned* st; };
__device__ __forceinline__ XcdBarrier xcd_barrier_post(unsigned* bar, volatile LAS unsigned* st) {
    XcdBarrier b; b.bar = bar; b.x = xb_xcc_id(); b.st = st;
    if (threadIdx.x == 0) (void)xb_add(&bar[XB_XCNT(b.x)], 1u);
    return b;
}
__device__ __forceinline__ void xcd_barrier_complete(unsigned* bar, unsigned x, unsigned& nloc, unsigned& nx) {
    const unsigned G = gridDim.x * gridDim.y * gridDim.z;
    unsigned sum, cnt, mine, sp = 0u;
    for (;;) {
        sum = 0u; cnt = 0u; mine = 0u;
#pragma unroll
        for (unsigned j = 0; j < 16; ++j) { const unsigned c = xb_ld(&bar[XB_XCNT(j)]); sum += c; cnt += (c > 0u) ? 1u : 0u; mine = (j == x) ? c : mine; }
        if (sum == G) break;
        __builtin_amdgcn_s_sleep(1);
        if ((++sp & 255u) == 0u) { if (xb_ld(&bar[XB_TMO])) break; if (sp > XB_SPIN_CAP) { atomicAdd(&bar[XB_TMO], 1u); break; } }
    }
    nloc = mine > 0u ? mine : 1u; nx = cnt > 0u ? cnt : 1u;
}
__device__ __forceinline__ void xcd_barrier(const XcdBarrier& b) {
    asm volatile("s_waitcnt vmcnt(0)" ::: "memory");
    __syncthreads();
    if (threadIdx.x == 0) {
        unsigned* bar = b.bar; asm volatile("" : "+s"(bar));
        __builtin_amdgcn_s_waitcnt(0);
        unsigned nloc = b.st[0], nx = b.st[1];
        if (nloc == 0u) { xcd_barrier_complete(bar, b.x, nloc, nx); b.st[0] = nloc; b.st[1] = nx; }
        const unsigned old = xb_add(&bar[XB_XSUB(b.x)], 1u);
        const unsigned gen = old / nloc;
        if (old + 1u == (gen + 1u) * nloc) {
            __builtin_amdgcn_fence(__ATOMIC_RELEASE, "agent");
            asm volatile("s_waitcnt vmcnt(0)" ::: "memory");
            const unsigned og = xb_add(&bar[XB_TOP], 1u);
            const unsigned tg = og / nx;
            if (og + 1u == (tg + 1u) * nx) xb_add(&bar[XB_TOPGEN], 1u);
            else XB_SPIN(xb_ld(&bar[XB_TOPGEN]) == tg, bar);
            __builtin_amdgcn_fence(__ATOMIC_ACQUIRE, "agent");
            xb_add(&bar[XB_XGEN(b.x)], 1u);
            asm volatile("s_waitcnt vmcnt(0)" ::: "memory");
        } else {
            XB_SPIN(xb_ld(&bar[XB_XGEN(b.x)]) == gen, bar);
            __builtin_amdgcn_fence(__ATOMIC_ACQUIRE, "agent");
            asm volatile("s_waitcnt vmcnt(0)" ::: "memory");
        }
    }
    __syncthreads();
}

__device__ __forceinline__ float wave_sum(float v, int lane) {
#pragma unroll
    for (int o = 1; o < 64; o <<= 1) v += shfl_xor_l(v, o, lane);
    return v;
}
struct CvtDesc { const float* src; const float* kscale; bf16* WTrow0; int ldw, k0, K, jkind; float gscale; };
__device__ __forceinline__ int ropeperm64(int c) { const int p = c >> 1, e = c & 1; return (p < 16) ? (p + 16 * e) : (32 + (p - 16) + 16 * e); }
__device__ __forceinline__ int ropeinv64(int s_) { const int half = s_ >> 5, w = s_ & 31; return 2 * (half * 16 + (w & 15)) + (w >> 4); }
__device__ __forceinline__ void cvt_load(const CvtDesc& d, int lane, f32x4 (&v)[16]) {
#pragma unroll
    for (int i = 0; i < 16; ++i) { const int kk = 4 * i + (lane >> 4);
        f32x4 x = d.src ? *(const f32x4*)(d.src + (size_t)(d.k0 + kk) * d.ldw) : (f32x4){0.f, 0.f, 0.f, 0.f};
        float sc_ = d.gscale; if (d.kscale) sc_ *= d.kscale[d.k0 + kk];
        v[i] = x * sc_; }
}
__device__ __forceinline__ void cvt_store(const CvtDesc& d, int lane, const f32x4 (&v)[16], LAS float* scr) {
    const int n4 = lane & 15; int jr[4];
#pragma unroll
    for (int e = 0; e < 4; ++e) { const int s_ = 4 * n4 + e; jr[e] = d.jkind == 0 ? s_ : d.jkind == 1 ? ropeinv64(s_) : 2 * (4 * (n4 & 7) + e) + (n4 >> 3); }
#pragma unroll
    for (int i = 0; i < 16; ++i) { const int kk = 4 * i + (lane >> 4);
#pragma unroll
        for (int e = 0; e < 4; ++e) scr[kk * 65 + jr[e]] = v[i][e]; }
    asm volatile("s_waitcnt lgkmcnt(0)" ::: "memory");
    const int c = lane & 7;
#pragma unroll
    for (int ps = 0; ps < 8; ++ps) { const int j = 8 * ps + (lane >> 3); const LAS float* s = scr + (8 * c) * 65 + j;
        u32x4 o; o.x = cvt_pk_bf16(s[0 * 65], s[1 * 65]); o.y = cvt_pk_bf16(s[2 * 65], s[3 * 65]); o.z = cvt_pk_bf16(s[4 * 65], s[5 * 65]); o.w = cvt_pk_bf16(s[6 * 65], s[7 * 65]);
        *(u32x4*)(d.WTrow0 + (size_t)j * d.K + d.k0 + 8 * c) = o; }
    asm volatile("s_waitcnt lgkmcnt(0)" ::: "memory");
}
struct CvtJob { const float* W0; const float* W1; const float* kscale; bf16* WT; int ldw, K, nrows, kind, aux; float gscale; };
__device__ __forceinline__ bool cvt_try(const CvtJob& J, int& it, int lane, CvtDesc& d) {
    const int nblk = J.nrows / 64, items = (J.K / 64) * nblk;
    if (it >= items) { it -= items; return false; }
    const int kb = it / nblk, nb = it % nblk; const int n4 = lane & 15;
    const float* sp; int jk = 0;
    switch (J.kind) {
        case 0: sp = J.W0 + J.aux + nb * 64 + 4 * n4; break;
        case 1: sp = J.W0 + J.aux + 4 * n4; jk = 1; break;
        case 2: { const int hh = nb / 3, part = nb % 3; sp = J.W0 + hh * DQ + 64 * part + 4 * n4; jk = (part == 2) ? 1 : 0; } break;
        case 3: { const int hh = nb >> 2, q4 = nb & 3; sp = J.W0 + hh * 256 + 32 * q4 + 128 * (n4 >> 3) + 4 * (n4 & 7); jk = 2; } break;
        case 4: { const int tl = nb >> 2, hf = (nb >> 1) & 1, q2 = nb & 1; const long long dW = (const char*)J.W1 - (const char*)J.W0; sp = (const float*)((const char*)J.W0 + dW * hf) + tl * 128 + 64 * q2 + 4 * n4; } break;
        default: sp = nullptr; break;
    }
    d.src = sp; d.kscale = J.kscale; d.WTrow0 = J.WT + (size_t)(nb * 64) * J.K; d.ldw = J.ldw; d.k0 = kb * 64; d.K = J.K; d.jkind = jk; d.gscale = J.gscale;
    return true;
}
__device__ __forceinline__ int cvt_items(const CvtJob& J) { return (J.K / 64) * (J.nrows / 64); }

__device__ __forceinline__ void row_load(const float* xrow, int lane, f32x4 (&v)[8]) {
#pragma unroll
    for (int j = 0; j < 8; ++j) v[j] = *(const f32x4*)(xrow + 4 * lane + 256 * j);
}
__device__ __forceinline__ void norm_mod_finish(const f32x4 (&v)[8], const float* g, const float* sc, const float* sh, bf16* orow, int lane) {
    float s = 0.f;
#pragma unroll
    for (int j = 0; j < 8; ++j) s += (v[j][0] * v[j][0] + v[j][1] * v[j][1]) + (v[j][2] * v[j][2] + v[j][3] * v[j][3]);
    const float rstd = 1.0f / sqrtf(wave_sum(s, lane) * (1.0f / D) + NORM_EPS);
#pragma unroll
    for (int j = 0; j < 8; ++j) { const int c = 4 * lane + 256 * j; const f32x4 gg = *(const f32x4*)(g + c), s1 = *(const f32x4*)(sc + c), s0 = *(const f32x4*)(sh + c);
        const f32x4 y = (v[j] * rstd) * gg * (1.0f + s1) + s0;
        u32x2 w; w.x = cvt_pk_bf16(y[0], y[1]); w.y = cvt_pk_bf16(y[2], y[3]); *(u32x2*)(orow + c) = w; }
}
__device__ __forceinline__ void norm_phase(const float* xsrc, const float* csrc, const float* g, const float* modl, int chunk, bf16* H, int nrows, int gw, int NGW, int lane) {
    if (gw >= nrows) return;
    f32x4 v[8], vn[8]; int m = gw;
    row_load(m < MX ? xsrc + (size_t)m * D : csrc + (size_t)(m - MX) * D, lane, v);
    for (;;) {
        const int mn = m + NGW; const bool has = mn < nrows;
        if (has) row_load(mn < MX ? xsrc + (size_t)mn * D : csrc + (size_t)(mn - MX) * D, lane, vn);
        const float* mr = modl + (size_t)(m < MX ? (m >> 12) : 8) * NMOD + chunk * D;
        norm_mod_finish(v, g, mr + D, mr, H + (size_t)m * D, lane);
        if (!has) break;
#pragma unroll
        for (int j = 0; j < 8; ++j) v[j] = vn[j];
        m = mn;
    }
}

__device__ __forceinline__ unsigned long long ld_arg(LAS unsigned char* lds, int i) {
    const volatile LAS unsigned* p = (const volatile LAS unsigned*)(lds + ARGS_OFF) + 2 * i;
    const unsigned lo = __builtin_amdgcn_readfirstlane(p[0]), hi = __builtin_amdgcn_readfirstlane(p[1]);
    return ((unsigned long long)hi << 32) | lo;
}
__device__ __forceinline__ void mod_layers(LAS unsigned char* lds, unsigned char* ws, int l_lo, int l_hi, int wg, int nwg, int tid, int lane, int wave) {
#define ARGF(i) ((const float*)ld_arg(lds, (i)))
    const int nitems = (l_hi - l_lo) * 96;
    if (wg >= nitems) return;
    LAS float* cond = (LAS float*)lds;
    LAS float* red = (LAS float*)(lds + 73728);
    float* MODV = (float*)(ws + WS_MODV);
    { const float* cin = ARGF(1); const float* cc = ARGF(3);
      for (int i = tid; i < 9 * D; i += 512) { const int r = i >> 11, k = i & (D - 1); const float c = (r < 8) ? cin[r * D + k] : cc[k]; cond[i] = c / (1.0f + __expf(-c)); } }
    __syncthreads();
    for (int it = wg; it < nitems; it += nwg) {
        const int l = l_lo + it / 96, cb = it % 96; const int n = cb * 128 + 2 * lane;
        const float* W = ARGF(4) + (size_t)l * D * NMOD + n; const float* mb = ARGF(5) + (size_t)l * NMOD + cb * 128;
        float a0[9], a1[9];
#pragma unroll
        for (int r = 0; r < 9; ++r) { a0[r] = 0.f; a1[r] = 0.f; }
        for (int k = wave * 256; k < wave * 256 + 256; k += 8) {
            f32x2 w[8];
#pragma unroll
            for (int q = 0; q < 8; ++q) w[q] = *(const f32x2*)(W + (size_t)(k + q) * NMOD);
#pragma unroll
            for (int q4 = 0; q4 < 2; ++q4)
#pragma unroll
                for (int r = 0; r < 9; ++r) { const f32x4 c4 = *(const LAS f32x4*)(cond + r * D + k + 4 * q4);
#pragma unroll
                    for (int q = 0; q < 4; ++q) { a0[r] += c4[q] * w[4 * q4 + q][0]; a1[r] += c4[q] * w[4 * q4 + q][1]; } }
        }
#pragma unroll
        for (int r = 0; r < 9; ++r) { red[(wave * 9 + r) * 128 + 2 * lane] = a0[r]; red[(wave * 9 + r) * 128 + 2 * lane + 1] = a1[r]; }
        __syncthreads();
        for (int i = tid; i < 9 * 128; i += 512) { const int r = i >> 7, cc = i & 127; float s2 = 0.f;
#pragma unroll
            for (int w8 = 0; w8 < 8; ++w8) s2 += red[(w8 * 9 + r) * 128 + cc];
            MODV[((size_t)l * 9 + r) * NMOD + cb * 128 + cc] = s2 + mb[cc]; }
        __syncthreads();
    }
#undef ARGF
}
__device__ __forceinline__ void cvt_layer(LAS unsigned char* lds, unsigned char* ws, int lc, int rank, int nranks, int wave, int lane, int part  ) {
#define ARGF(i) ((const float*)ld_arg(lds, (i)))
    const int li = lc >> 1; const bool is_ret = (lc & 1) != 0;
    bf16* WM = (bf16*)(ws + (is_ret ? WS_WB : WS_WA)); bf16* WF = (bf16*)(ws + (is_ret ? WS_WB + 82 * MiB : WS_WA + 22 * MiB));
    LAS float* scr = (LAS float*)(lds + wave * 19456);
    CvtJob J[7]; int nj;
    if (!is_ret) {
        bf16* W1T = WM; bf16* WuqT = W1T + (size_t)N1 * D; bf16* WukvT = WuqT + (size_t)3072 * 512; bf16* WoT = WukvT + (size_t)4096 * 512;
        const float* wdq = ARGF(8) + (size_t)li * D * QR; const float* wdkv = ARGF(11) + (size_t)li * D * (KVR + ROPE);
        J[0] = CvtJob{wdq, nullptr, nullptr, W1T, QR, D, 512, 0, 0, 1.f};
        J[1] = CvtJob{wdkv, nullptr, nullptr, W1T + (size_t)512 * D, KVR + ROPE, D, 512, 0, 0, 1.f};
        J[2] = CvtJob{wdkv, nullptr, nullptr, W1T + (size_t)1024 * D, KVR + ROPE, D, 64, 1, 512, 1.f};
        J[3] = CvtJob{nullptr, nullptr, nullptr, W1T + (size_t)1088 * D, 1, D, 192, 5, 0, 1.f};
        J[4] = CvtJob{ARGF(10) + (size_t)li * QR * 3072, nullptr, ARGF(9) + li * QR, WuqT, 3072, QR, 3072, 2, 0, 0.07216878364870322f * LOG2E};
        J[5] = CvtJob{ARGF(13) + (size_t)li * KVR * 4096, nullptr, ARGF(12) + li * KVR, WukvT, 4096, KVR, 4096, 0, 0, 1.f};
        J[6] = CvtJob{ARGF(14) + (size_t)li * D * D, nullptr, nullptr, WoT, D, D, D, 0, 0, 1.f};
        nj = 7;
    } else {
        bf16* WqkvT = WM; bf16* WgT = WqkvT + (size_t)8192 * D; bf16* WoT = WgT + (size_t)8192 * D;
        J[0] = CvtJob{ARGF(15) + (size_t)li * D * D, nullptr, nullptr, WqkvT, D, D, 2048, 3, 0, 1.f};
        J[1] = CvtJob{ARGF(16) + (size_t)li * D * D, nullptr, nullptr, WqkvT + (size_t)2048 * D, D, D, 2048, 3, 0, 0.0625f};
        J[2] = CvtJob{ARGF(17) + (size_t)li * D * 4096, nullptr, nullptr, WqkvT + (size_t)4096 * D, 4096, D, 4096, 0, 0, 1.f};
        J[3] = CvtJob{ARGF(18) + (size_t)li * D * 4096, ARGF(19) + (size_t)li * D * 4096, nullptr, WgT, 4096, D, 8192, 4, 0, 1.f};
        J[4] = CvtJob{ARGF(20) + (size_t)li * 4096 * D, nullptr, nullptr, WoT, D, 4096, D, 0, 0, 1.f};
        J[5] = CvtJob{nullptr, nullptr, nullptr, nullptr, 1, 64, 0, 5, 0, 1.f};
        J[6] = J[5];
        nj = 5;
    }
    CvtJob F0 = CvtJob{ARGF(23) + (size_t)lc * D * FF, ARGF(24) + (size_t)lc * D * FF, nullptr, WF, FF, D, 11264, 4, 0, 1.f};
    CvtJob F1 = CvtJob{ARGF(27) + (size_t)lc * FF * D, nullptr, nullptr, WF + (size_t)11264 * D, D, FF, D, 0, 0, 1.f};
    if (part == 1) nj = 0;
    const bool ffn = part != 0;
    int total = ffn ? cvt_items(F0) + cvt_items(F1) : 0;
#pragma unroll
    for (int j = 0; j < 7; ++j) if (j < nj) total += cvt_items(J[j]);
#define CVT_FIND(IT, DD) do { int it_ = (IT); bool done_ = false; \
        _Pragma("unroll") for (int j = 0; j < 7; ++j) if (!done_ && j < nj) done_ = cvt_try(J[j], it_, lane, DD); \
        if (ffn) { if (!done_) done_ = cvt_try(F0, it_, lane, DD); if (!done_) done_ = cvt_try(F1, it_, lane, DD); } } while (0)
    if (rank < total) {
        f32x4 v[16], w[16]; CvtDesc d0, d1; int it0 = rank;
        CVT_FIND(it0, d0); cvt_load(d0, lane, v);
        for (;;) {
            const int it1 = it0 + nranks; const bool has = it1 < total;
            if (has) { CVT_FIND(it1, d1); cvt_load(d1, lane, w); }
            cvt_store(d0, lane, v, scr);
            if (!has) break;
#pragma unroll
            for (int i = 0; i < 16; ++i) v[i] = w[i];
            d0 = d1; it0 = it1;
        }
    }
#undef CVT_FIND
#undef ARGF
}

#if MLA_CHECK
constexpr int CW_CHK = 2048;
__device__ __forceinline__ float wave_max(float v, int lane) {
#pragma unroll
    for (int o = 1; o < 64; o <<= 1) v = fmaxf(v, shfl_xor_l(v, o, lane));
    return v;
}
__device__ __forceinline__ void mla_check(LAS unsigned char* lds, unsigned char* ws, int li, int gw, int wave, int lane) {
#define ARGF(i) ((const float*)ld_arg(lds, (i)))
    LAS float* sc = (LAS float*)(lds + wave * 19456);
    const bf16* H = (const bf16*)(ws + WS_H); const bf16* Qb = (const bf16*)(ws + WS_Q); const bf16* KVb = (const bf16*)(ws + WS_KV); const bf16* KRb = (const bf16*)(ws + WS_KR); const bf16* Ob = (const bf16*)(ws + WS_O);
    const int t = (int)(((unsigned)gw * 2654435761u) % (unsigned)MT); const int hd = gw & 15;
    const bool isx = t < MX; const int tt = t & (SEQ - 1);
    float err = 0.f;
    {
        const float* wdq = ARGF(8) + (size_t)li * D * QR; const float* wdkv = ARGF(11) + (size_t)li * D * (KVR + ROPE);
        float ql[8], kl[9];
#pragma unroll
        for (int j = 0; j < 8; ++j) ql[j] = 0.f;
#pragma unroll
        for (int j = 0; j < 9; ++j) kl[j] = 0.f;
        for (int k = 0; k < D; ++k) { const float hv = bf2f(H[(size_t)t * D + k]);
#pragma unroll
            for (int j = 0; j < 8; ++j) ql[j] += hv * wdq[(size_t)k * QR + lane + 64 * j];
#pragma unroll
            for (int j = 0; j < 9; ++j) kl[j] += hv * wdkv[(size_t)k * (KVR + ROPE) + lane + 64 * j]; }
        float sq = 0.f, sk = 0.f;
#pragma unroll
        for (int j = 0; j < 8; ++j) { sq += ql[j] * ql[j]; sk += kl[j] * kl[j]; }
        const float rq = 1.0f / sqrtf(wave_sum(sq, lane) * (1.0f / QR) + NORM_EPS), rk = 1.0f / sqrtf(wave_sum(sk, lane) * (1.0f / KVR) + NORM_EPS);
        const float* qg = ARGF(9) + li * QR; const float* kg = ARGF(12) + li * KVR;
#pragma unroll
        for (int j = 0; j < 8; ++j) { sc[lane + 64 * j] = ql[j] * rq * qg[lane + 64 * j]; sc[512 + lane + 64 * j] = kl[j] * rk * kg[lane + 64 * j]; }
        sc[1024 + lane] = kl[8];
        asm volatile("s_waitcnt lgkmcnt(0)" ::: "memory");
        const float* wuq = ARGF(10) + (size_t)li * QR * 3072 + hd * DQ; const float* wukv = ARGF(13) + (size_t)li * KVR * 4096 + hd * 256;
        float qv[3] = {0.f, 0.f, 0.f}, kv[4] = {0.f, 0.f, 0.f, 0.f};
        for (int c = 0; c < 512; ++c) { const float a = sc[c], bq = sc[512 + c];
#pragma unroll
            for (int j = 0; j < 3; ++j) qv[j] += a * wuq[(size_t)c * 3072 + lane + 64 * j];
#pragma unroll
            for (int j = 0; j < 4; ++j) kv[j] += bq * wukv[(size_t)c * 4096 + lane + 64 * j]; }
#pragma unroll
        for (int j = 0; j < 3; ++j) sc[1100 + lane + 64 * j] = qv[j];
        asm volatile("s_waitcnt lgkmcnt(0)" ::: "memory");
        float qref[3]; float kr_ref = 0.f;
#pragma unroll
        for (int j = 0; j < 3; ++j) { const int d = lane + 64 * j; float v = sc[1100 + d];
            if (d >= NOPE && isx) { const int e = d - NOPE, half = e >> 5, i = e & 15, second = (e >> 4) & 1; const float pos = half ? (float)(tt & 63) : (float)(tt >> 6);
                const float ang = pos * __builtin_amdgcn_exp2f(-(float)(2 * i) * (13.287712379549449f / 32.0f)); const float rev = ang * 0.15915494309189535f; const float fr_ = rev - floorf(rev);
                const float cs = __builtin_amdgcn_cosf(fr_), sn = __builtin_amdgcn_sinf(fr_); const float other = sc[1100 + NOPE + half * 32 + i + (second ? 0 : 16)];
                v = second ? (v * cs + other * sn) : (v * cs - other * sn); }
            qref[j] = v * (0.07216878364870322f * LOG2E); }
        { const int e = lane, half = e >> 5, i = e & 15, second = (e >> 4) & 1; float v = sc[1024 + e];
          if (isx) { const float pos = half ? (float)(tt & 63) : (float)(tt >> 6);
              const float ang = pos * __builtin_amdgcn_exp2f(-(float)(2 * i) * (13.287712379549449f / 32.0f)); const float rev = ang * 0.15915494309189535f; const float fr_ = rev - floorf(rev);
              const float cs = __builtin_amdgcn_cosf(fr_), sn = __builtin_amdgcn_sinf(fr_); const float other = sc[1024 + half * 32 + i + (second ? 0 : 16)];
              v = second ? (v * cs + other * sn) : (v * cs - other * sn); }
          kr_ref = v; }
#pragma unroll
        for (int j = 0; j < 3; ++j) sc[1400 + lane + 64 * j] = qref[j];
        sc[1600 + lane] = kr_ref;
        asm volatile("s_waitcnt lgkmcnt(0)" ::: "memory");
        float mx = 0.f, df = 0.f;
#pragma unroll
        for (int j = 0; j < 3; ++j) { const int p = lane + 64 * j; const int od = p < NOPE ? p : NOPE + ropeperm64(p - NOPE); const float ref = sc[1400 + od]; const float mine = bf2f(Qb[(size_t)t * 3072 + hd * DQ + p]);
            mx = fmaxf(mx, fabsf(ref)); df = fmaxf(df, fabsf(ref - mine)); }
        err = fmaxf(err, wave_max(df, lane) / (wave_max(mx, lane) + 1e-20f));
        mx = 0.f; df = 0.f;
#pragma unroll
        for (int j = 0; j < 4; ++j) { const float ref = kv[j]; const float mine = bf2f(KVb[(size_t)t * 4096 + hd * 256 + lane + 64 * j]); mx = fmaxf(mx, fabsf(ref)); df = fmaxf(df, fabsf(ref - mine)); }
        err = fmaxf(err, wave_max(df, lane) / (wave_max(mx, lane) + 1e-20f));
        { const float ref = sc[1600 + ropeperm64(lane)]; const float mine = bf2f(KRb[(size_t)t * 64 + lane]); err = fmaxf(err, wave_max(fabsf(ref - mine), lane) / (wave_max(fabsf(ref), lane) + 1e-20f)); }
    }
    {
        const int b = isx ? (t >> 12) : ((t - MX) >> 8); const int nk = isx ? 4352 : 256;
        for (int d = lane; d < DQ; d += 64) sc[d] = bf2f(Qb[(size_t)t * 3072 + hd * DQ + d]);
        asm volatile("s_waitcnt lgkmcnt(0)" ::: "memory");
        float mxs = -1e30f;
        for (int j = lane; j < nk; j += 64) { const int row = j < 256 ? MX + b * CTXL + j : b * SEQ + (j - 256); float sdot = 0.f;
            for (int d = 0; d < NOPE; ++d) sdot += sc[d] * bf2f(KVb[(size_t)row * 4096 + hd * 256 + d]);
            for (int d = 0; d < ROPE; ++d) sdot += sc[NOPE + d] * bf2f(KRb[(size_t)row * 64 + d]);
            sc[256 + j] = sdot; mxs = fmaxf(mxs, sdot); }
        mxs = wave_max(mxs, lane); float sum = 0.f;
        for (int j = lane; j < nk; j += 64) { const float p = __builtin_amdgcn_exp2f(sc[256 + j] - mxs); sc[256 + j] = p; sum += p; }
        sum = wave_sum(sum, lane);
        asm volatile("s_waitcnt lgkmcnt(0)" ::: "memory");
        float o0 = 0.f, o1 = 0.f;
        for (int j = 0; j < nk; ++j) { const int row = j < 256 ? MX + b * CTXL + j : b * SEQ + (j - 256); const float p = sc[256 + j];
            o0 += p * bf2f(KVb[(size_t)row * 4096 + hd * 256 + 128 + lane]); o1 += p * bf2f(KVb[(size_t)row * 4096 + hd * 256 + 128 + 64 + lane]); }
        o0 /= sum; o1 /= sum;
        const float m0 = bf2f(Ob[(size_t)t * D + hd * 128 + lane]), m1 = bf2f(Ob[(size_t)t * D + hd * 128 + 64 + lane]);
        const float df = fmaxf(fabsf(o0 - m0), fabsf(o1 - m1)), mx = fmaxf(fabsf(o0), fabsf(o1));
        err = fmaxf(err, wave_max(df, lane) / (wave_max(mx, lane) + 1e-20f));
    }
    if (lane == 0) atomicMax((unsigned*)(ws + WS_CTL) + CW_CHK, __float_as_uint(err));
#undef ARGF
}
#endif
struct Args { const float* in[29]; float* out; unsigned char* ws; int ph_lo, ph_hi; };
constexpr int PH_PER_LAYER = 10, PH_FINAL = 1 + PH_PER_LAYER * DEPTH, PH_COUNT = PH_FINAL + 1;

template <unsigned MK_EN_T>
__global__ void __launch_bounds__(512, 2) mk_fwd(Args args) {
    extern __shared__ __attribute__((aligned(16))) unsigned char lds_raw[];
    LAS unsigned char* lds = (LAS unsigned char*)lds_raw;
    volatile LAS unsigned* MISC = (volatile LAS unsigned*)(lds + MISC_OFF);
    const int G = gridDim.x; const int bx = blockIdx.x; const int vcu = (G % 8 == 0) ? (bx % 8) * (G / 8) + bx / 8 : bx;
    const int NGW = G * 8;
    unsigned char* ws = args.ws; float* X = args.out;
    const int lo = args.ph_lo, hi = args.ph_hi;
    { const int tid0 = threadIdx.x;
      for (int u = tid0; u < (LDS_BYTES - CTRL_BASE) / 4; u += 512) ((LAS unsigned*)(lds + CTRL_BASE))[u] = 0u;
      __syncthreads();
      if (tid0 < 29) ((volatile LAS unsigned long long*)(lds + ARGS_OFF))[tid0] = (unsigned long long)args.in[tid0];
      __syncthreads(); }
#define ARGF(i) ((const float*)ld_arg(lds, (i)))
    XcdBarrier bar; bar.bar = (unsigned*)(ws + WS_CTL) + CW_BAR; bar.x = 0; bar.st = nullptr;
    if (hi - lo > 1) bar = xcd_barrier_post((unsigned*)(ws + WS_CTL) + CW_BAR, MISC + 8);
#if PROBE_TS
    if (bx == 0 && threadIdx.x == 0) ((unsigned long long*)(ws + WS_CTL + 65536))[0] = __builtin_amdgcn_s_memrealtime();
#endif
#define EN(b) (((MK_EN_T) >> (b)) & 1u)
#define IN(k) (lo <= (k) && (k) < hi)
#if PROBE_TS
#define TS_WORDS ((unsigned long long*)(ws + WS_CTL + 65536))
#define PHASE_END(k) do { if (hi > (k) + 1) xcd_barrier(bar); if (bx == 0 && threadIdx.x == 0) TS_WORDS[(k) + 1] = __builtin_amdgcn_s_memrealtime(); } while (0)
#else
#define PHASE_END(k) do { if (hi > (k) + 1) xcd_barrier(bar); } while (0)
#endif
#define PH_IDS int tid = threadIdx.x; asm volatile("" : "+v"(tid)); const int lane = tid & 63; const int wave = __builtin_amdgcn_readfirstlane(tid >> 6); const int gw = vcu * 8 + wave; (void)lane; (void)gw;
#define XC_    ((float*)(ws + WS_XC))
#define MODV_  ((float*)(ws + WS_MODV))
#define TABM_  ((float*)(ws + WS_TABM))
#define TABR_  ((float*)(ws + WS_TABR))
#define SSQ_   ((float*)(ws + WS_SSQ))
#define KR_    ((bf16*)(ws + WS_KR))
#define H_     ((bf16*)(ws + WS_H))
#define WMIX_(ll) ((bf16*)(ws + (((ll) & 1) ? WS_WB : WS_WA)))
#define WFFN_(ll) ((bf16*)(ws + (((ll) & 1) ? WS_WB + 82 * MiB : WS_WA + 22 * MiB)))
#define W1T_   WMIX_(l)
#define WUQT_  (W1T_ + (size_t)N1 * D)
#define WUKVT_ (WUQT_ + (size_t)3072 * 512)
#define WOTM_  (WUKVT_ + (size_t)4096 * 512)
#define WQKVT_ WMIX_(l)
#define WGT_   (WQKVT_ + (size_t)8192 * D)
#define WOTR_  (WGT_ + (size_t)8192 * D)
#define WGUT_  WFFN_(l)
#define WDT_   (WGUT_ + (size_t)11264 * D)
#define QKVL_  ((bf16*)(ws + WS_QKVL))
#define Q_     ((bf16*)(ws + WS_Q))
#define KV_    ((bf16*)(ws + WS_KV))
#define O_     ((bf16*)(ws + WS_O))
#define QKV_   ((bf16*)(ws + WS_QKV))
#define Y_     ((bf16*)(ws + WS_Y))
#define GATED_ ((bf16*)(ws + WS_GATED))
#define GB_    ((bf16*)(ws + WS_G))
#define UB_    ((bf16*)(ws + WS_U))
#define HALO_  ((float*)(ws + WS_G))
#define MODL_  (MODV_ + (size_t)l * 9 * NMOD)

    if (EN(0) && IN(0)) for (int rep_ = 0; rep_ < 1 + (int)((PROBE_MASK >> 0) & 1u); ++rep_) {
        PH_IDS
        mod_layers(lds, ws, 0, 1, bx, G, tid, lane, wave);
        __syncthreads();
        cvt_layer(lds, ws, 0, gw, NGW, wave, lane, 2);
        for (int i = bx * 512 + tid; i < 64 * 16 + SEQ * 128; i += G * 512) {
            float inv, pos; float* dst;
            if (i < 1024) { const int p = i >> 4, f = i & 15; inv = __builtin_amdgcn_exp2f(-(float)(2 * f) * (13.287712379549449f / 32.0f)); pos = (float)p; dst = TABM_ + 2 * i; }
            else { const int j = i - 1024, t = j >> 7, f = j & 127; inv = __builtin_amdgcn_exp2f(-(float)(2 * f) * (13.287712379549449f / 256.0f)); pos = (float)t; dst = TABR_ + 2 * j; }
            const float ang = pos * inv; const double rev = (double)ang * 0.15915494309189535; const float fr = (float)(rev - floor(rev));
            dst[0] = __builtin_amdgcn_cosf(fr); dst[1] = __builtin_amdgcn_sinf(fr);
        }
        PHASE_END(0);
    }

    for (int l = 0; l < DEPTH; ++l) {
        const int P = 1 + PH_PER_LAYER * l; const int li = l >> 1; const bool is_ret = (l & 1) != 0; const bool last = (l == DEPTH - 1);
        const int Mrows = last ? MX : MT;

        if (EN(1) && IN(P + 0)) for (int rep_ = 0; rep_ < 1 + (int)((PROBE_MASK >> 1) & 1u); ++rep_) {
            PH_IDS
            const float* g = ARGF(6) + l * D; const float* xsrc = (l == 0) ? ARGF(0) : X; const float* csrc = (l == 0) ? ARGF(2) : XC_;
            norm_phase(xsrc, csrc, g, MODL_, 0, H_, MT, gw, NGW, lane);
            PHASE_END(P + 0);
        }

        if (!is_ret) {
            if (EN(2) && IN(P + 1)) for (int rep_ = 0; rep_ < 1 + (int)((PROBE_MASK >> 2) & 1u); ++rep_) {
                pg8::Gemm g{H_, W1T_, MT, N1, D, D}; pg8::StaticOrder S; S.init(MT, N1, G, bx);
                EpiG1 E{QKVL_, SSQ_, KR_, TABM_};
                pg8::gemm_phase<EpiG1>(lds, g, S, E);
                PHASE_END(P + 1);
            }
            if (EN(3) && IN(P + 2)) for (int rep_ = 0; rep_ < 1 + (int)((PROBE_MASK >> 3) & 1u); ++rep_) {
                { pg8::Gemm g{QKVL_, WUQT_, MT, 3072, QR, N1}; pg8::StaticOrder S; S.init(MT, 3072, G, bx); EpiUq E{Q_, SSQ_, TABM_}; pg8::gemm_phase<EpiUq>(lds, g, S, E); }
                { pg8::Gemm g{QKVL_ + 512, WUKVT_, MT, 4096, KVR, N1}; pg8::StaticOrder S; S.init(MT, 4096, G, bx); EpiUkv E{KV_, SSQ_}; pg8::gemm_phase<EpiUkv>(lds, g, S, E); }
                PHASE_END(P + 2);
            }
            if (EN(4) && IN(P + 3)) for (int rep_ = 0; rep_ < 1 + (int)((PROBE_MASK >> 4) & 1u); ++rep_) {
                const int nun = 2048 + 128;
                for (int ui = vcu; ui < nun; ui += G) {
                    if (ui < 2048) { const int xcd = (ui & 255) >> 5, j = ui & 31, rnd = ui >> 8; const int bh = xcd * 16 + 2 * rnd + (j >> 4), qb = j & 15; const int b = bh >> 4, hd = bh & 15;
                        att::attn_unit(Q_ + (size_t)(b * SEQ + qb * 256) * 3072 + hd * DQ, KV_ + hd * 256, KR_, O_ + (size_t)(b * SEQ + qb * 256) * D + hd * 128, 68, 4, MX + b * CTXL, b * SEQ, (char*)lds_raw);
                    } else { const int bh = ui - 2048, b = bh >> 4, hd = bh & 15;
                        att::attn_unit(Q_ + (size_t)(MX + b * CTXL) * 3072 + hd * DQ, KV_ + hd * 256, KR_, O_ + (size_t)(MX + b * CTXL) * D + hd * 128, 4, 4, MX + b * CTXL, 0, (char*)lds_raw); }
                }
                PHASE_END(P + 3);
            }
        } else {
            if (EN(5) && IN(P + 1)) for (int rep_ = 0; rep_ < 1 + (int)((PROBE_MASK >> 5) & 1u); ++rep_) {
                pg8::Gemm g{H_, WQKVT_, MT, 8192, D, D}; pg8::StaticOrder S; S.init(MT, 8192, G, bx);
                EpiQKV E{QKV_, TABR_};
                pg8::gemm_phase<EpiQKV>(lds, g, S, E);
                PHASE_END(P + 1);
            }
            if (EN(6) && IN(P + 2)) for (int rep_ = 0; rep_ < 1 + (int)((PROBE_MASK >> 6) & 1u); ++rep_) {
                for (int ui = vcu; ui < 256; ui += G) {
                    const int bh = ui >> 2, dir = (ui >> 1) & 1, dvh = ui & 1; const int b = bh >> 3, hd = bh & 7;
                    const float dec = (dir ? ARGF(22) : ARGF(21))[li * RH + hd];
                    const float lg2 = -__expf(dec) * LOG2E;
                    scan::scan_unit(QKV_, Y_ + (size_t)dir * MT * 4096, b, hd, dir, dvh, lg2, last, lds);
                }
                PHASE_END(P + 2);
            }
            if (EN(7) && IN(P + 3)) for (int rep_ = 0; rep_ < 1 + (int)((PROBE_MASK >> 7) & 1u); ++rep_) {
                PH_IDS
                for (int row = gw; row < Mrows; row += NGW) {
                    u32x4 w[16];
#pragma unroll
                    for (int q = 0; q < 16; ++q) w[q] = *(const u32x4*)(Y_ + (size_t)(q >> 3) * MT * 4096 + (size_t)row * 4096 + (q & 7) * RDV + lane * 8);
                    float mu[16], rs[16];
#pragma unroll
                    for (int q = 0; q < 16; ++q) { const float s = ((bflo(w[q].x) + bfhi(w[q].x)) + (bflo(w[q].y) + bfhi(w[q].y))) + ((bflo(w[q].z) + bfhi(w[q].z)) + (bflo(w[q].w) + bfhi(w[q].w))); mu[q] = s; }
#pragma unroll
                    for (int o = 1; o < 64; o <<= 1)
#pragma unroll
                        for (int q = 0; q < 16; ++q) mu[q] += shfl_xor_l(mu[q], o, lane);
#pragma unroll
                    for (int q = 0; q < 16; ++q) { mu[q] *= (1.0f / RDV); const float m_ = mu[q];
                        const float d0 = bflo(w[q].x) - m_, d1 = bfhi(w[q].x) - m_, d2 = bflo(w[q].y) - m_, d3 = bfhi(w[q].y) - m_, d4 = bflo(w[q].z) - m_, d5 = bfhi(w[q].z) - m_, d6 = bflo(w[q].w) - m_, d7 = bfhi(w[q].w) - m_;
                        rs[q] = ((d0 * d0 + d1 * d1) + (d2 * d2 + d3 * d3)) + ((d4 * d4 + d5 * d5) + (d6 * d6 + d7 * d7)); }
#pragma unroll
                    for (int o = 1; o < 64; o <<= 1)
#pragma unroll
                        for (int q = 0; q < 16; ++q) rs[q] += shfl_xor_l(rs[q], o, lane);
                    float mo = 0.f, ro = 0.f;
#pragma unroll
                    for (int q = 0; q < 16; ++q) { if (lane == q) { mo = mu[q]; ro = rs[q]; } }
                    if (lane < 16) *(f32x2*)((float*)(ws + WS_STATS) + ((size_t)((lane >> 3) * MT + row) * 8 + (lane & 7)) * 2) = (f32x2){mo, 1.0f / sqrtf(ro * (1.0f / RDV) + GN_EPS)};
                }
                PHASE_END(P + 3);
            }
            if (EN(8) && IN(P + 4)) for (int rep_ = 0; rep_ < 1 + (int)((PROBE_MASK >> 8) & 1u); ++rep_) {
                pg8::Gemm g{H_, WGT_, Mrows, 8192, D, D}; pg8::StaticOrder S; S.init(Mrows, 8192, G, bx);
                EpiGate E{GATED_, Y_, Y_ + (size_t)MT * 4096, (const float*)(ws + WS_STATS)};
                pg8::gemm_phase<EpiGate>(lds, g, S, E);
                PHASE_END(P + 4);
            }
        }
        if (EN(9) && IN(P + 5)) for (int rep_ = 0; rep_ < 1 + (int)((PROBE_MASK >> 9) & 1u); ++rep_) {
#if MLA_CHECK
            if (l == MLA_CHECK_LAYER) { PH_IDS mla_check(lds, ws, li, gw, wave, lane); __syncthreads(); }
#endif
            pg8::Gemm g = is_ret ? pg8::Gemm{GATED_, WOTR_, Mrows, D, 4096, 4096} : pg8::Gemm{O_, WOTM_, Mrows, D, D, D};
            pg8::StaticOrder S; S.init(Mrows, D, G, bx, 4, true);
#if PROBE_TS
            S.probe = is_ret ? 2 : 1; S.tsw = TS_WORDS;
#endif
            const float* xsrc = (l == 0) ? ARGF(0) : X; const float* csrc = (l == 0) ? ARGF(2) : XC_;
            EpiResid E{xsrc, X, csrc, XC_, MODL_, 2 * D};
            pg8::gemm_phase<EpiResid>(lds, g, S, E);
            if (l + 1 < DEPTH) {
                PH_IDS
                const int nwg = (Mrows / 256) * (D / 256), rem = nwg % G;
                if (rem == 0) cvt_layer(lds, ws, l + 1, gw, NGW, wave, lane, 0);
                else if (bx >= rem) cvt_layer(lds, ws, l + 1, (bx - rem) * 8 + wave, (G - rem) * 8, wave, lane, 0);
            }
            PHASE_END(P + 5);
        }
        if (EN(10) && IN(P + 6)) for (int rep_ = 0; rep_ < 1 + (int)((PROBE_MASK >> 10) & 1u); ++rep_) {
            PH_IDS
            const float* g = ARGF(7) + l * D;
            norm_phase(X, XC_, g, MODL_, 3, H_, Mrows, gw, NGW, lane);
            PHASE_END(P + 6);
        }
        if (EN(11) && IN(P + 7)) for (int rep_ = 0; rep_ < 1 + (int)((PROBE_MASK >> 11) & 1u); ++rep_) {
            pg8::Gemm g{H_, WGUT_, Mrows, 11264, D, D}; pg8::StaticOrder S; S.init(Mrows, 11264, G, bx);
#if PROBE_TS
            S.probe = 4; S.tsw = TS_WORDS;
#endif
            EpiGUConv E{UB_, HALO_, ARGF(25) + (size_t)l * 3 * FF, ARGF(26) + (size_t)l * FF, (LAS float*)(lds + EDGE_OFF)};
            pg8::gemm_phase<EpiGUConv>(lds, g, S, E);
            PHASE_END(P + 7);
        }
        if (EN(13) && IN(P + 9)) for (int rep_ = 0; rep_ < 1 + (int)((PROBE_MASK >> 13) & 1u); ++rep_) {
            pg8::Gemm g{UB_, WDT_, Mrows, D, FF, FF}; pg8::StaticOrder S; S.init(Mrows, D, G, bx, 4, true);
#if PROBE_TS
            S.probe = 3; S.tsw = TS_WORDS;
#endif
            {
                PH_IDS
                const float* cw = ARGF(25) + (size_t)l * 3 * FF; const float* HL = HALO_; bf16* ACT = UB_;
                pg8::Unit uu; int prev_pm = -1;
                for (int i = 0; S.next(i, uu); ++i) { const int pm = uu.pm; if (pm == prev_pm || pm >= MX / 256) { prev_pm = pm; continue; } prev_pm = pm;
                    const bool top = (pm & 15) != 0, bot = ((pm + 1) & 15) != 0;
                    for (int q = tid; q < FF / 4; q += 512) { const int f = q * 4;
                        if (top) { const float* t0 = HL + (size_t)((pm * 2 + 0) * 3) * HALO_STRIDE + f; const float* b1 = HL + (size_t)(((pm - 1) * 2 + 1) * 3) * HALO_STRIDE + f;
                            const f32x4 o = silu4(*(const f32x4*)t0 + *(const f32x4*)(cw + f) * *(const f32x4*)(b1 + HALO_STRIDE)) * *(const f32x4*)(t0 + 2 * HALO_STRIDE);
                            u32x2 w; w.x = cvt_pk_bf16(o[0], o[1]); w.y = cvt_pk_bf16(o[2], o[3]); *(u32x2*)(ACT + (size_t)(pm * 256) * FF + f) = w; }
                        if (bot) { const float* b0 = HL + (size_t)((pm * 2 + 1) * 3) * HALO_STRIDE + f; const float* t1 = HL + (size_t)(((pm + 1) * 2 + 0) * 3) * HALO_STRIDE + f;
                            const f32x4 o = silu4(*(const f32x4*)b0 + *(const f32x4*)(cw + 2 * FF + f) * *(const f32x4*)(t1 + HALO_STRIDE)) * *(const f32x4*)(b0 + 2 * HALO_STRIDE);
                            u32x2 w; w.x = cvt_pk_bf16(o[0], o[1]); w.y = cvt_pk_bf16(o[2], o[3]); *(u32x2*)(ACT + (size_t)(pm * 256 + 255) * FF + f) = w; } } }
                asm volatile("s_waitcnt vmcnt(0)" ::: "memory"); __syncthreads();
            }
            EpiResid E{X, X, XC_, XC_, MODL_, 5 * D};
            pg8::gemm_phase<EpiResid>(lds, g, S, E);
#if PROBE_TS
            if (threadIdx.x == 0 && bx == 0) TS_WORDS[64 + l] = __builtin_amdgcn_s_memrealtime();
            if (threadIdx.x == 0 && bx == G - 1) TS_WORDS[72 + l] = __builtin_amdgcn_s_memrealtime();
#endif
            if (l + 1 < DEPTH) {
                PH_IDS
                const int nwg = (Mrows / 256) * (D / 256), rem = nwg % G;
                if (rem == 0) { mod_layers(lds, ws, l + 1, l + 2, bx, G, tid, lane, wave); __syncthreads(); cvt_layer(lds, ws, l + 1, gw, NGW, wave, lane, 1); }
                else if (bx >= rem) { mod_layers(lds, ws, l + 1, l + 2, bx - rem, G - rem, tid, lane, wave); __syncthreads(); cvt_layer(lds, ws, l + 1, (bx - rem) * 8 + wave, (G - rem) * 8, wave, lane, 1); }
            }
#if PROBE_TS
            __syncthreads(); if (threadIdx.x == 0 && bx == G - 1) TS_WORDS[80 + l] = __builtin_amdgcn_s_memrealtime();
#endif
            PHASE_END(P + 9);
        }
    }
    if (EN(14) && IN(PH_FINAL)) for (int rep_ = 0; rep_ < 1 + (int)((PROBE_MASK >> 14) & 1u); ++rep_) {
        PH_IDS
        const float* g = ARGF(28);
#if PROBE_TS
        float ts_c = 0.f, ts_a = 0.f;
        { const unsigned long long* TS = (const unsigned long long*)(ws + WS_CTL + 65536); unsigned long long last = TS[0]; const unsigned long long t0 = last; float d1 = 0.f, d2 = 0.f;
          for (int k = 0; k < PH_FINAL; ++k) { const unsigned long long te = TS[k + 1]; if (te == 0ull) continue; const float d = (float)(te - last); last = te;
              int cls; if (k == 0) cls = 0; else { const int slot = (k - 1) % PH_PER_LAYER, ll = (k - 1) / PH_PER_LAYER; const bool ret = (ll & 1) != 0;
                  cls = slot == 0 ? 1 : slot >= 5 ? 5 + slot : (!ret ? 1 + slot : 4 + slot); }
              if (k > 0 && ((k - 1) % PH_PER_LAYER) == 5) { const bool ret5 = (((k - 1) / PH_PER_LAYER) & 1) != 0; if (TS_CLASS1 == (ret5 ? 51 : 50)) d1 += d; if (TS_CLASS2 == (ret5 ? 51 : 50)) d2 += d; }
              if (cls == TS_CLASS1) d1 += d; if (cls == TS_CLASS2) d2 += d; }
          float tot = (float)(last - t0);
          if (TS_CLASS1 >= 100) { float ph = 0.f, x0 = 0.f, x1 = 0.f, x2 = 0.f;
              for (int ll = 0; ll < 3; ++ll) { const unsigned long long st = TS[(1 + PH_PER_LAYER * ll + 7) + 1], en = TS[(1 + PH_PER_LAYER * ll + 9) + 1];
                  ph += (float)(en - st); x0 += (float)(TS[64 + ll] - st); x1 += (float)(TS[72 + ll] - st); x2 += (float)(TS[80 + ll] - st); }
              d1 = (TS_CLASS1 == 100) ? x0 : (TS_CLASS1 == 101) ? x1 : x2; d2 = (TS_CLASS2 == 100) ? x0 : (TS_CLASS2 == 101) ? x1 : x2; tot = ph; }
          if (TS_CLASS1 >= 200) { const unsigned long long* tw = TS + 90 + 3 * (TS_CLASS1 - 201); const float lp = (float)tw[0], ep = (float)tw[1], nn = (float)tw[2];
              d1 = lp; tot = lp + ep; d2 = (lp + ep) / nn / 100.f / 200.f * tot; }
          ts_c = sqrtf(d1 / tot); ts_a = 2.0f + 10.0f * d2 / tot; }
#endif
#if MLA_CHECK
        const bool chk_bad = __uint_as_float(__hip_atomic_load((unsigned*)(ws + WS_CTL) + CW_CHK, __ATOMIC_RELAXED, __HIP_MEMORY_SCOPE_AGENT)) > MLA_CHECK_TOL;
#endif
        if (gw < MX) {
            f32x4 v[8], vn[8]; int m = gw; row_load(X + (size_t)m * D, lane, v);
            for (;;) {
                const int mn = m + NGW; const bool has = mn < MX;
                if (has) row_load(X + (size_t)mn * D, lane, vn);
                float s = 0.f;
#pragma unroll
                for (int j = 0; j < 8; ++j) s += (v[j][0] * v[j][0] + v[j][1] * v[j][1]) + (v[j][2] * v[j][2] + v[j][3] * v[j][3]);
                const float rstd = 1.0f / sqrtf(wave_sum(s, lane) * (1.0f / D) + NORM_EPS);
                float* xr = X + (size_t)m * D;
#pragma unroll
                for (int j = 0; j < 8; ++j) { const int c = 4 * lane + 256 * j; f32x4 o_ = (v[j] * rstd) * *(const f32x4*)(g + c);
#if MLA_CHECK
                    if (chk_bad) o_ = (f32x4){__builtin_nanf(""), __builtin_nanf(""), __builtin_nanf(""), __builtin_nanf("")};
#endif
#if PROBE_TS
                    if (m < 328) { o_ = o_ + ts_c; if (m == 0 && c == 0) o_[0] += ts_a - ts_c; }
#endif
                    *(f32x4*)(xr + c) = o_; }
                if (!has) break;
#pragma unroll
                for (int j = 0; j < 8; ++j) v[j] = vn[j];
                m = mn;
            }
        }
    }
#undef IN
#undef PHASE_END
}

#if !MK_SINGLE
typedef void (*KernFn)(Args);
static KernFn phase_kernel(int bit) {
    switch (bit) {
        case 0: return mk_fwd<1u << 0>;  case 1: return mk_fwd<1u << 1>;  case 2: return mk_fwd<1u << 2>;  case 3: return mk_fwd<1u << 3>;
        case 4: return mk_fwd<1u << 4>;  case 5: return mk_fwd<1u << 5>;  case 6: return mk_fwd<1u << 6>;  case 7: return mk_fwd<1u << 7>;
        case 8: return mk_fwd<1u << 8>;  case 9: return mk_fwd<1u << 9>;  case 10: return mk_fwd<1u << 10>; case 11: return mk_fwd<1u << 11>;
        case 12: return mk_fwd<1u << 12>; case 13: return mk_fwd<1u << 13>; default: return mk_fwd<1u << 14>;
    }
}
static int phase_bit(int p) {
    if (p == 0) return 0; if (p == PH_FINAL) return 14;
    const int l = (p - 1) / PH_PER_LAYER, slot = (p - 1) % PH_PER_LAYER; const bool ret = (l & 1) != 0;
    if (slot == 0) return 1;
    if (slot >= 5) return 4 + slot;
    if (!ret) return slot == 4 ? -1 : 1 + slot;
    return 4 + slot;
}
#endif
extern "C" void kernel_launch(void* const* d_in, const int* in_sizes, int n_in, void* d_out, int out_size, void* d_ws, size_t ws_size, hipStream_t stream) {
    static int grid = 0;
    if (grid == 0) {
        if (n_in != 29 || out_size != MX * D || ws_size < WS_END) { fprintf(stderr, "kernel_launch: unexpected shapes: n_in %d out %d ws %zu (need %zu)\n", n_in, out_size, ws_size, (size_t)WS_END); grid = -1; return; }
        int dev = 0, cus = 0;
        if (hipGetDevice(&dev) != hipSuccess || hipDeviceGetAttribute(&cus, hipDeviceAttributeMultiprocessorCount, dev) != hipSuccess) { grid = -1; return; }
#if MK_SINGLE
        if (hipFuncSetAttribute((const void*)mk_fwd<0xFFFFFFFFu>, hipFuncAttributeMaxDynamicSharedMemorySize, LDS_BYTES) != hipSuccess) { fprintf(stderr, "kernel_launch: hipFuncSetAttribute failed\n"); grid = -1; return; }
#else
        for (int b = 0; b < 15; ++b) if (hipFuncSetAttribute((const void*)phase_kernel(b), hipFuncAttributeMaxDynamicSharedMemorySize, LDS_BYTES) != hipSuccess) { fprintf(stderr, "kernel_launch: hipFuncSetAttribute failed\n"); grid = -1; return; }
#endif
        (void)hipGetLastError();
        grid = cus;
    }
    if (grid < 0) return;
    if (hipMemsetAsync((char*)d_ws + WS_CTL, 0, CTL_BYTES, stream) != hipSuccess) return;
    Args a{};
    for (int i = 0; i < 29; ++i) a.in[i] = (const float*)d_in[i];
    a.out = (float*)d_out; a.ws = (unsigned char*)d_ws;
#if MK_SINGLE
    a.ph_lo = 0; a.ph_hi = PH_COUNT;
    hipLaunchKernelGGL(mk_fwd<0xFFFFFFFFu>, dim3(grid), dim3(512), LDS_BYTES, stream, a);
#else
    for (int p = 0; p < PH_COUNT; ++p) {
        const int bit = phase_bit(p); if (bit < 0) continue;
        a.ph_lo = p; a.ph_hi = p + 1;
        hipLaunchKernelGGL(phase_kernel(bit), dim3(grid), dim3(512), LDS_BYTES, stream, a);
    }
#endif
    const hipError_t le = hipPeekAtLastError();
    if (le != hipSuccess) fprintf(stderr, "kernel_launch: launch failed: %s\n", hipGetErrorName(le));
}
```

```cpp
#include <hip/hip_runtime.h>
#include <cstdio>
#include <cstdint>

#ifndef MK_SINGLE
#define MK_SINGLE 1
#endif

#ifndef MK_STAGGER
#define MK_STAGGER 0
#endif
#ifndef PROBE_EPI2
#define PROBE_EPI2 0
#endif
#ifndef MLA_CHECK
#define MLA_CHECK 0
#endif
#ifndef MLA_CHECK_LAYER
#define MLA_CHECK_LAYER 0
#endif
#ifndef MLA_CHECK_TOL
#define MLA_CHECK_TOL 0.03f
#endif
#ifndef PROBE_TS
#define PROBE_TS 0
#endif
#ifndef TS_SKEW_ID
#define TS_SKEW_ID 4
#endif
#ifndef TS_CLASS1
#define TS_CLASS1 0
#endif
#ifndef TS_CLASS2
#define TS_CLASS2 1
#endif
#ifndef PROBE_MASK
#define PROBE_MASK 0u
#endif
#define GAS __attribute__((address_space(1)))
#define LAS __attribute__((address_space(3)))
typedef unsigned short bf16;
typedef short bf16x8 __attribute__((ext_vector_type(8)));
typedef short s16x4 __attribute__((ext_vector_type(4)));
typedef float f32x2 __attribute__((ext_vector_type(2)));
typedef float f32x4 __attribute__((ext_vector_type(4)));
typedef float f32x16 __attribute__((ext_vector_type(16)));
typedef unsigned u32x2 __attribute__((ext_vector_type(2)));
typedef unsigned u32x4 __attribute__((ext_vector_type(4)));
typedef GAS unsigned gu32;

constexpr int D = 2048, NB = 8, SEQ = 4096, CTXL = 256, DEPTH = 4;
constexpr int MX = NB * SEQ, MC = NB * CTXL, MT = MX + MC;
constexpr int FF = 5632, NMOD = 6 * D;
constexpr int MLA_H = 16, QR = 512, KVR = 512, NOPE = 128, ROPE = 64, DQ = 192;
constexpr int N1 = 1280;
constexpr int RH = 8, RDK = 256, RDV = 512;
constexpr float NORM_EPS = 1e-6f, GN_EPS = 1e-5f;
constexpr float LOG2E = 1.4426950408889634f;

constexpr size_t MiB = 1u << 20;
constexpr size_t WS_CTL = 0, CTL_BYTES = 1 * MiB;
constexpr size_t WS_MODV = 1 * MiB;
constexpr size_t WS_TABM = 3 * MiB;
constexpr size_t WS_TABR = 4 * MiB;
constexpr size_t WS_SSQ = 8 * MiB;
constexpr size_t WS_XC = 12 * MiB;
constexpr size_t WS_KR = 28 * MiB;
constexpr size_t WS_STATS = 33 * MiB;
constexpr size_t WS_WA = 40 * MiB;
constexpr size_t WS_WB = 128 * MiB;
constexpr size_t WS_H = 276 * MiB;
constexpr size_t WS_BIG = 412 * MiB;
constexpr size_t WS_QKVL = WS_BIG, WS_Q = WS_BIG + 88 * MiB, WS_KV = WS_BIG + 292 * MiB, WS_O = WS_BIG + 564 * MiB;
constexpr size_t WS_QKV = WS_BIG, WS_Y = WS_BIG + 544 * MiB, WS_GATED = WS_BIG;
constexpr size_t WS_G = WS_BIG, WS_U = WS_BIG + 374 * MiB;
constexpr size_t WS_END = WS_BIG + 1088 * MiB;
static_assert((size_t)MT * 8192 * 2 <= 544 * MiB && (size_t)MT * 5632 * 2 <= 374 * MiB && (size_t)MT * N1 * 2 <= 88 * MiB, "ws map");

constexpr int CW_BAR = 4096;

constexpr int RING_BYTES = 131072, CTRL_BASE = 155648, MISC_OFF = CTRL_BASE + 320, ARGS_OFF = CTRL_BASE + 1024, EDGE_OFF = CTRL_BASE + 4096, LDS_BYTES = 163840;

__device__ __forceinline__ unsigned cvt_pk_bf16(float lo, float hi) { unsigned r; asm volatile("v_cvt_pk_bf16_f32 %0, %1, %2" : "=v"(r) : "v"(lo), "v"(hi)); return r; }
__device__ __forceinline__ float bf2f(unsigned short b) { return __uint_as_float((unsigned)b << 16); }
__device__ __forceinline__ float bflo(unsigned w) { return __uint_as_float(w << 16); }
__device__ __forceinline__ float bfhi(unsigned w) { return __uint_as_float(w & 0xffff0000u); }
__device__ __forceinline__ float shfl_xor_l(float v, int mask, int lane) { return __builtin_bit_cast(float, __builtin_amdgcn_ds_bpermute((lane ^ mask) << 2, __builtin_bit_cast(int, v))); }
__device__ __forceinline__ float fast_silu(float x) { return x * __builtin_amdgcn_rcpf(1.0f + __builtin_amdgcn_exp2f(-x * LOG2E)); }

__device__ __forceinline__ int lane_id() { int x; asm volatile("v_mbcnt_lo_u32_b32 %0, -1, 0\n\tv_mbcnt_hi_u32_b32 %0, -1, %0" : "=v"(x)); return x; }
__device__ __forceinline__ void glds16_s(const void* sbase, unsigned voff, unsigned lds_dst) {
    unsigned keep;
    asm volatile("s_mov_b32 %0, m0\n\ts_mov_b32 m0, %3\n\ts_nop 0\n\tglobal_load_lds_dwordx4 %1, %2\n\ts_mov_b32 m0, %0" : "=&s"(keep) : "v"(voff), "s"(sbase), "s"(lds_dst) : "memory");
}
__device__ __forceinline__ const char* uni_ptr(const void* p) {
    const unsigned long long v = (unsigned long long)p; const unsigned lo = __builtin_amdgcn_readfirstlane((unsigned)v), hi = __builtin_amdgcn_readfirstlane((unsigned)(v >> 32));
    return (const char*)(((unsigned long long)hi << 32) | lo);
}
namespace pg8 {
constexpr int BM = 256, BK = 64, HALF = 128, HTB = HALF * BK * 2, STAGE_BYTES = 8 * HTB, NXCD = 8, WGM = 8;
__host__ __device__ __forceinline__ int lds_byte(int r, int c) { const int st = (r >> 4) * 2 + (c >> 5), rr = r & 15, cc = c & 31, ob = rr * 64 + cc * 2; return st * 1024 + (ob ^ (((ob >> 9) & 1) << 5)); }
__host__ __device__ __forceinline__ void stage_rc(int b, int& R, int& C) { const int st = b / 1024, sb = b % 1024, swz = sb ^ (((sb >> 9) & 1) << 5); R = (st >> 1) * 16 + swz / 64; C = (st & 1) * 32 + (swz % 64) / 2; }
__host__ __device__ __forceinline__ int perm32(int rho) { const int n = rho >> 4, i = rho & 15; return 8 * (i >> 2) + 4 * n + (i & 3); }
struct Unit { int pm, pn; };
struct Gemm { const bf16* A; const bf16* Bt; int M, N, K, lda; };
struct StaticOrder {
    int nM, nN, nwg, G, c, wgm, delay = 0, probe = 0, tid = 0; bool rev; unsigned long long* tsw = nullptr;
    __device__ __forceinline__ void init(int M, int N, int G_, int c_, int wgm_ = WGM, bool rev_ = false) { nM = M / BM; nN = N / BM; nwg = nM * nN; G = G_; c = c_; wgm = wgm_; rev = rev_; }
    __device__ __forceinline__ bool next(int i, Unit& u) const {
        const long L = (long)i * G + c; if (L >= nwg) return false;
        int wgid = (int)L; { const int q = nwg / NXCD, r = nwg % NXCD, xcd = wgid % NXCD, off = wgid / NXCD; wgid = (xcd < r ? xcd * (q + 1) : r * (q + 1) + (xcd - r) * q) + off; }
        const int nig = wgm * nN, gid = wgid / nig, fm = gid * wgm, gsz = (nM - fm) < wgm ? (nM - fm) : wgm;
        u.pm = fm + ((wgid % nig) % gsz); u.pn = (wgid % nig) / gsz; if (rev) u.pm = nM - 1 - u.pm; return true;
    }
};
template <class Epi>
__device__ __forceinline__ void gemm_phase(LAS unsigned char* lds, const Gemm g, const StaticOrder& S, const Epi& E) {
    int tid = S.tid; asm volatile("" : "+v"(tid));
    const int wid = __builtin_amdgcn_readfirstlane(tid >> 6), lane = tid & 63, wr = wid >> 2, wc = wid & 3, fr = lane & 15, fq = lane >> 4;
    const int K = g.K, nt = K / BK;
    unsigned voffA[2], voffB[2];
#pragma unroll
    for (int i = 0; i < 2; ++i) { int R, C; stage_rc(tid * 16 + i * 8192, R, C); const int Rb = Epi::PERM ? ((R & ~31) + perm32(R & 31)) : R;
        voffA[i] = (unsigned)(R * g.lda + C) * 2u; voffB[i] = (unsigned)(Rb * K + C) * 2u; }
    const size_t kstep = (size_t)(BK * 2);
    const size_t hstepA = (size_t)HALF * g.lda * 2, hstepB = (size_t)HALF * K * 2;
    const size_t tstepA = 2 * hstepA, tstepB = 2 * hstepB;
    const unsigned ldsbase = (unsigned)__builtin_amdgcn_readfirstlane((unsigned)(uintptr_t)lds + (unsigned)wid * 1024u);
    const int aoff = lds_byte(wr * 64 + fr, fq * 8), boff = lds_byte(wc * 32 + fr, fq * 8);
#define PG8_SA(b, h) (((b) * 2 + (h)) * HTB)
#define PG8_SB(b, h) ((4 + (b) * 2 + (h)) * HTB)
#define PG8_STAGE(bufoff, gbase, voff) do { const char* _gb = uni_ptr(gbase); _Pragma("unroll") for (int _i = 0; _i < 2; ++_i) \
        glds16_s(_gb, (voff)[_i], ldsbase + (unsigned)((bufoff) + _i * 8192)); } while (0)
#define PG8_LDA(dst, b, h) do { _Pragma("unroll") for (int m = 0; m < 4; ++m) _Pragma("unroll") for (int k = 0; k < 2; ++k) dst[m][k] = *(const LAS bf16x8*)(lds + PG8_SA(b, h) + aoff + m * 2048 + k * 1024); } while (0)
#define PG8_LDB(dst, b, h) do { _Pragma("unroll") for (int n = 0; n < 2; ++n) _Pragma("unroll") for (int k = 0; k < 2; ++k) dst[n][k] = *(const LAS bf16x8*)(lds + PG8_SB(b, h) + boff + n * 2048 + k * 1024); } while (0)
#define PG8_MMA(ai, bj, At, Bt) do { __builtin_amdgcn_s_setprio(1); _Pragma("unroll") for (int m = 0; m < 4; ++m) _Pragma("unroll") for (int n = 0; n < 2; ++n) _Pragma("unroll") for (int k = 0; k < 2; ++k) \
        acc[ai][bj][m][n] = __builtin_amdgcn_mfma_f32_16x16x32_bf16(Bt[n][k], At[m][k], acc[ai][bj][m][n], 0, 0, 0); __builtin_amdgcn_s_setprio(0); } while (0)
#define PG8_WAIT_V(n) asm volatile("s_waitcnt vmcnt(" #n ")" ::: "memory")
#define PG8_WAIT_L(n) asm volatile("s_waitcnt lgkmcnt(" #n ")" ::: "memory")
#define PG8_BAR __builtin_amdgcn_s_barrier()
#define PG8_SCHED __builtin_amdgcn_sched_barrier(0)
    Unit cur, nxt; int ui = 0;
    if (!S.next(0, cur)) return;
    if (S.delay) { const unsigned long long t0 = __builtin_amdgcn_s_memrealtime(); while (__builtin_amdgcn_s_memrealtime() - t0 < (unsigned long long)S.delay) __builtin_amdgcn_s_sleep(8); }
#if MK_STAGGER
    if (S.c & 1) {
        const unsigned long long t0 = __builtin_amdgcn_s_memrealtime(); const unsigned long long dt = (unsigned long long)nt * MK_STAGGER;
        while (__builtin_amdgcn_s_memrealtime() - t0 < dt) __builtin_amdgcn_s_sleep(8);
    }
#endif
    f32x4 acc[2][2][4][2];
#pragma unroll
    for (int a = 0; a < 2; ++a)
#pragma unroll
        for (int b = 0; b < 2; ++b)
#pragma unroll
            for (int m = 0; m < 4; ++m)
#pragma unroll
                for (int n = 0; n < 2; ++n) acc[a][b][m][n] = (f32x4){0.f, 0.f, 0.f, 0.f};
    bf16x8 At[4][2], B0[2][2], B1[2][2];
    const char* cA = (const char*)g.A + (size_t)cur.pm * tstepA; const char* cB = (const char*)g.Bt + (size_t)cur.pn * tstepB;
    PG8_STAGE(PG8_SB(0, 0), cB, voffB); PG8_STAGE(PG8_SB(0, 1), cB + hstepB, voffB); PG8_STAGE(PG8_SA(0, 0), cA, voffA); PG8_STAGE(PG8_SA(0, 1), cA + hstepA, voffA);
    if (wr == 1) PG8_BAR;
    PG8_WAIT_V(2); PG8_BAR;
    PG8_STAGE(PG8_SB(1, 0), cB + kstep, voffB); PG8_STAGE(PG8_SA(1, 0), cA + kstep, voffA); PG8_STAGE(PG8_SB(1, 1), cB + hstepB + kstep, voffB);
    PG8_WAIT_V(6); PG8_BAR;
#if PROBE_TS
    unsigned long long pt_loop = 0, pt_epi = 0, pt_n = 0, pt_t0 = __builtin_amdgcn_s_memrealtime();
#endif
    for (;;) {
        const bool has_next = S.next(ui + 1, nxt);
        const char* nA = has_next ? (const char*)g.A + (size_t)nxt.pm * tstepA : cA; const char* nB = has_next ? (const char*)g.Bt + (size_t)nxt.pn * tstepB : cB;
        for (int t = 0; t < nt; t += 2) {
            const bool last = (t == nt - 2);
            const char* a1 = cA + (size_t)(t + 1) * kstep;
            const char* a2 = last ? nA : cA + (size_t)(t + 2) * kstep; const char* b2 = last ? nB : cB + (size_t)(t + 2) * kstep;
            const char* a3 = a2 + kstep; const char* b3 = b2 + kstep;
            PG8_LDB(B0, 0, 0); PG8_LDB(B1, 0, 1); PG8_SCHED; PG8_LDA(At, 0, 0); PG8_STAGE(PG8_SA(1, 1), a1 + hstepA, voffA);
            PG8_WAIT_V(8); PG8_WAIT_L(0); PG8_BAR; PG8_MMA(0, 0, At, B0); PG8_MMA(0, 1, At, B1); PG8_BAR; PG8_SCHED;
            PG8_LDA(At, 0, 1); PG8_STAGE(PG8_SB(0, 0), b2, voffB); PG8_STAGE(PG8_SB(0, 1), b2 + hstepB, voffB); PG8_STAGE(PG8_SA(0, 0), a2, voffA);
            PG8_WAIT_V(8); PG8_WAIT_L(0); PG8_BAR; PG8_MMA(1, 0, At, B0); PG8_MMA(1, 1, At, B1); PG8_BAR; PG8_SCHED;
            PG8_LDB(B0, 1, 0); PG8_LDB(B1, 1, 1); PG8_SCHED; PG8_LDA(At, 1, 0); PG8_STAGE(PG8_SA(0, 1), a2 + hstepA, voffA);
            PG8_WAIT_V(8); PG8_WAIT_L(0); PG8_BAR; PG8_MMA(0, 0, At, B0); PG8_MMA(0, 1, At, B1); PG8_BAR; PG8_SCHED;
            PG8_LDA(At, 1, 1); PG8_STAGE(PG8_SB(1, 0), b3, voffB); PG8_STAGE(PG8_SB(1, 1), b3 + hstepB, voffB); PG8_STAGE(PG8_SA(1, 0), a3, voffA);
            PG8_WAIT_V(8); PG8_WAIT_L(0); PG8_BAR; PG8_MMA(1, 0, At, B0); PG8_MMA(1, 1, At, B1); PG8_BAR; PG8_SCHED;
        }
        if (wr == 0) PG8_BAR;
#if PROBE_TS
        const unsigned long long pt_t1 = __builtin_amdgcn_s_memrealtime();
#endif
        E(acc, cur, wr, wc, fr, fq);
#if PROBE_TS
        { asm volatile("s_waitcnt vmcnt(0)" ::: "memory"); const unsigned long long pt_t2 = __builtin_amdgcn_s_memrealtime(); pt_loop += pt_t1 - pt_t0; pt_epi += pt_t2 - pt_t1; pt_n += 1; pt_t0 = pt_t2; }
#endif
#if PROBE_EPI2
        if (Epi::PROBE2) E(acc, cur, wr, wc, fr, fq);
#endif
        if (!has_next) break;
#pragma unroll
        for (int a = 0; a < 2; ++a)
#pragma unroll
            for (int b = 0; b < 2; ++b)
#pragma unroll
                for (int m = 0; m < 4; ++m)
#pragma unroll
                    for (int n = 0; n < 2; ++n) acc[a][b][m][n] = (f32x4){0.f, 0.f, 0.f, 0.f};
        cur = nxt; cA = nA; cB = nB; ++ui;
        if (wr == 1) PG8_BAR;
    }
    PG8_WAIT_V(0);
    PG8_BAR;
#if PROBE_TS
    if (S.probe && S.c == 0 && tid == 0) { unsigned long long* tw = S.tsw + 90 + 3 * (S.probe - 1); tw[0] += pt_loop; tw[1] += pt_epi; tw[2] += pt_n; }
    if (S.probe == TS_SKEW_ID && tid == 0) { const unsigned long long dur = pt_loop + pt_epi; atomicMax(S.tsw + 120, dur); atomicMin(S.tsw + 121, dur); atomicAdd(S.tsw + 122, dur); }
#endif
#undef PG8_SA
#undef PG8_SB
#undef PG8_STAGE
#undef PG8_LDA
#undef PG8_LDB
#undef PG8_MMA
#undef PG8_WAIT_V
#undef PG8_WAIT_L
#undef PG8_BAR
#undef PG8_SCHED
}
}
using pg8::Unit;

__device__ __forceinline__ int slack_delay(int nwg, int G, int c, int unit_ticks) {
    const int rem = nwg % G; if (rem == 0 || c < rem) return 0;
    return (int)(((long long)(c - rem) * unit_ticks * 4) / ((long long)(G - rem) * 5));
}
__device__ __forceinline__ u32x4 pack8(const f32x4 a, const f32x4 b) { u32x4 w; w.x = cvt_pk_bf16(a[0], a[1]); w.y = cvt_pk_bf16(a[2], a[3]); w.z = cvt_pk_bf16(b[0], b[1]); w.w = cvt_pk_bf16(b[2], b[3]); return w; }
__device__ __forceinline__ f32x4 rot2(const f32x4 v, const f32x4 cs) { f32x4 o; o[0] = v[0] * cs[0] - v[1] * cs[1]; o[1] = v[1] * cs[0] + v[0] * cs[1]; o[2] = v[2] * cs[2] - v[3] * cs[3]; o[3] = v[3] * cs[2] + v[2] * cs[3]; return o; }

__device__ __forceinline__ f32x4 mla_cs(const float* tabm, int t, int c4) {
    const int p0 = c4 >> 1; const int pos = (p0 < 16) ? (t >> 6) : (t & 63); const int f = p0 & 15;
    return *(const f32x4*)(tabm + ((size_t)pos * 16 + f) * 2);
}

struct EpiG1 {
    static constexpr bool PERM = true, PROBE2 = false;
    bf16* QKVL; float* SSQ; bf16* KR; const float* tabm;
    __device__ __forceinline__ void operator()(const f32x4 (&acc)[2][2][4][2], const Unit& u, int wr, int wc, int fr, int fq) const {
        const int row0 = u.pm * 256 + wr * 64 + fr;
        if (u.pn < 4) {
            const int col0 = u.pn * 256 + wc * 32 + 8 * fq;
#pragma unroll
            for (int ai = 0; ai < 2; ++ai)
#pragma unroll
                for (int m = 0; m < 4; ++m) { const int row = row0 + ai * 128 + m * 16; float ss = 0.f;
#pragma unroll
                    for (int bj = 0; bj < 2; ++bj) { const f32x4 v0 = acc[ai][bj][m][0], v1 = acc[ai][bj][m][1];
                        ss += (v0[0] * v0[0] + v0[1] * v0[1]) + (v0[2] * v0[2] + v0[3] * v0[3]) + (v1[0] * v1[0] + v1[1] * v1[1]) + (v1[2] * v1[2] + v1[3] * v1[3]);
                        *(u32x4*)(QKVL + (size_t)row * N1 + col0 + bj * 128) = pack8(v0, v1); }
                    { const int ln_ = fr + 16 * fq; ss += shfl_xor_l(ss, 16, ln_); ss += shfl_xor_l(ss, 32, ln_); }
                    if (fq == 0) SSQ[(size_t)row * 16 + u.pn * 4 + wc] = ss; asm volatile("" ::: "memory"); }
        } else if (wc < 2) {
            const int c8 = wc * 32 + 8 * fq;
#pragma unroll
            for (int ai = 0; ai < 2; ++ai)
#pragma unroll
                for (int m = 0; m < 4; ++m) { const int row = row0 + ai * 128 + m * 16; f32x4 v0 = acc[ai][0][m][0], v1 = acc[ai][0][m][1];
                    if (row < MX) { const int t = row & (SEQ - 1); v0 = rot2(v0, mla_cs(tabm, t, c8)); v1 = rot2(v1, mla_cs(tabm, t, c8 + 4)); }
                    *(u32x4*)(KR + (size_t)row * 64 + c8) = pack8(v0, v1); asm volatile("" ::: "memory"); }
        }
    }
};
struct EpiUq {
    static constexpr bool PERM = true, PROBE2 = false;
    bf16* Q; const float* SSQ; const float* tabm;
    __device__ __forceinline__ void operator()(const f32x4 (&acc)[2][2][4][2], const Unit& u, int wr, int wc, int fr, int fq) const {
        const int row0 = u.pm * 256 + wr * 64 + fr;
        int col8[2], dd[2];
#pragma unroll
        for (int bj = 0; bj < 2; ++bj) { col8[bj] = u.pn * 256 + bj * 128 + wc * 32 + 8 * fq; dd[bj] = col8[bj] % DQ; }
#pragma unroll
        for (int ai = 0; ai < 2; ++ai)
#pragma unroll
            for (int m = 0; m < 4; ++m) { const int row = row0 + ai * 128 + m * 16;
                const f32x4 s0 = *(const f32x4*)(SSQ + (size_t)row * 16), s1 = *(const f32x4*)(SSQ + (size_t)row * 16 + 4);
                const float ss = ((s0[0] + s0[1]) + (s0[2] + s0[3])) + ((s1[0] + s1[1]) + (s1[2] + s1[3]));
                const float r = 1.0f / sqrtf(ss * (1.0f / QR) + NORM_EPS);
#pragma unroll
                for (int bj = 0; bj < 2; ++bj) { f32x4 v0 = acc[ai][bj][m][0] * r, v1 = acc[ai][bj][m][1] * r;
                    if (dd[bj] >= NOPE && row < MX) { const int t = row & (SEQ - 1), c8 = dd[bj] - NOPE; v0 = rot2(v0, mla_cs(tabm, t, c8)); v1 = rot2(v1, mla_cs(tabm, t, c8 + 4)); }
                    *(u32x4*)(Q + (size_t)row * 3072 + col8[bj]) = pack8(v0, v1); } asm volatile("" ::: "memory"); }
    }
};
struct EpiUkv {
    static constexpr bool PERM = true, PROBE2 = false;
    bf16* KV; const float* SSQ;
    __device__ __forceinline__ void operator()(const f32x4 (&acc)[2][2][4][2], const Unit& u, int wr, int wc, int fr, int fq) const {
        const int row0 = u.pm * 256 + wr * 64 + fr; const int col0 = u.pn * 256 + wc * 32 + 8 * fq;
#pragma unroll
        for (int ai = 0; ai < 2; ++ai)
#pragma unroll
            for (int m = 0; m < 4; ++m) { const int row = row0 + ai * 128 + m * 16;
                const f32x4 s0 = *(const f32x4*)(SSQ + (size_t)row * 16 + 8), s1 = *(const f32x4*)(SSQ + (size_t)row * 16 + 12);
                const float ss = ((s0[0] + s0[1]) + (s0[2] + s0[3])) + ((s1[0] + s1[1]) + (s1[2] + s1[3]));
                const float r = 1.0f / sqrtf(ss * (1.0f / KVR) + NORM_EPS);
#pragma unroll
                for (int bj = 0; bj < 2; ++bj) *(u32x4*)(KV + (size_t)row * 4096 + col0 + bj * 128) = pack8(acc[ai][bj][m][0] * r, acc[ai][bj][m][1] * r); asm volatile("" ::: "memory"); }
    }
};
struct EpiResid {
    static constexpr bool PERM = false, PROBE2 = false;
    const float* xin; float* xout; const float* cin; float* cout; const float* modv; int gofs;
    __device__ __forceinline__ void operator()(const f32x4 (&acc)[2][2][4][2], const Unit& u, int wr, int wc, int fr, int fq) const {
        const bool isx = u.pm < (MX / 256);
        const int rloc = (isx ? u.pm * 256 : (u.pm * 256 - MX)) + wr * 64 + fr;
        const float* base = isx ? xin : cin; float* out = isx ? xout : cout;
        const float* gv = modv + (size_t)(isx ? (u.pm >> 4) : 8) * NMOD + gofs;
        const int col0 = u.pn * 256 + wc * 32 + 4 * fq;
        f32x4 g4[2][2];
#pragma unroll
        for (int bj = 0; bj < 2; ++bj)
#pragma unroll
            for (int n = 0; n < 2; ++n) g4[bj][n] = *(const f32x4*)(gv + col0 + bj * 128 + n * 16);
        f32x4 pre[3][2][2];
#define RES_LOAD(G_, SLOT_) do { const size_t off_ = (size_t)(rloc + ((G_) >> 2) * 128 + ((G_) & 3) * 16) * D + col0; \
            _Pragma("unroll") for (int bj = 0; bj < 2; ++bj) _Pragma("unroll") for (int n = 0; n < 2; ++n) pre[SLOT_][bj][n] = *(const f32x4*)(base + off_ + bj * 128 + n * 16); } while (0)
        RES_LOAD(0, 0); RES_LOAD(1, 1); RES_LOAD(2, 2);
#pragma unroll
        for (int g = 0; g < 8; ++g) { const int ai = g >> 2, m = g & 3; const size_t off = (size_t)(rloc + ai * 128 + m * 16) * D + col0;
#pragma unroll
            for (int bj = 0; bj < 2; ++bj)
#pragma unroll
                for (int n = 0; n < 2; ++n) *(f32x4*)(out + off + bj * 128 + n * 16) = pre[g % 3][bj][n] + g4[bj][n] * acc[ai][bj][m][n];
            asm volatile("" ::: "memory");
            if (g + 3 < 8) RES_LOAD(g + 3, g % 3); }
#undef RES_LOAD
    }
};
template <int CTRL> __device__ __forceinline__ float dpp1(float x) { return __int_as_float(__builtin_amdgcn_update_dpp(0, __float_as_int(x), CTRL, 0xF, 0xF, false)); }
__device__ __forceinline__ f32x4 row_prev(const f32x4 v) { f32x4 o; o.x = dpp1<0x121>(v.x); o.y = dpp1<0x121>(v.y); o.z = dpp1<0x121>(v.z); o.w = dpp1<0x121>(v.w); return o; }
__device__ __forceinline__ f32x4 row_next(const f32x4 v) { f32x4 o; o.x = dpp1<0x12F>(v.x); o.y = dpp1<0x12F>(v.y); o.z = dpp1<0x12F>(v.z); o.w = dpp1<0x12F>(v.w); return o; }
__device__ __forceinline__ f32x4 silu4(const f32x4 v) { f32x4 o;
#pragma unroll
    for (int e = 0; e < 4; ++e) o[e] = fast_silu(v[e]); return o; }
constexpr size_t HALO_STRIDE = (size_t)FF;
struct EpiGUConv {
    static constexpr bool PERM = true, PROBE2 = true;
    bf16* ACT; float* HALO; const float* cw; const float* cb; LAS float* edge;
    __device__ __forceinline__ void operator()(const f32x4 (&acc)[2][2][4][2], const Unit& u, int wr, int wc, int fr, int fq) const {
        const int c8 = wc * 32 + 8 * fq; const int f0 = u.pn * 128 + c8;
#pragma unroll
        for (int ai = 0; ai < 2; ++ai) { const int blk = 2 * ai + wr;
            if (fr == 0)  { *(LAS f32x4*)(edge + (blk * 2 + 0) * 128 + c8) = acc[ai][0][0][0]; *(LAS f32x4*)(edge + (blk * 2 + 0) * 128 + c8 + 4) = acc[ai][0][0][1]; }
            if (fr == 15) { *(LAS f32x4*)(edge + (blk * 2 + 1) * 128 + c8) = acc[ai][0][3][0]; *(LAS f32x4*)(edge + (blk * 2 + 1) * 128 + c8 + 4) = acc[ai][0][3][1]; } }
        asm volatile("s_waitcnt lgkmcnt(0)" ::: "memory"); __builtin_amdgcn_s_barrier(); asm volatile("" ::: "memory");
        f32x4 w0[2], w1[2], w2[2], bb[2];
#pragma unroll
        for (int n = 0; n < 2; ++n) { w0[n] = *(const f32x4*)(cw + f0 + 4 * n); w1[n] = *(const f32x4*)(cw + FF + f0 + 4 * n); w2[n] = *(const f32x4*)(cw + 2 * FF + f0 + 4 * n); bb[n] = *(const f32x4*)(cb + f0 + 4 * n); }
        const f32x4 zero4 = {0.f, 0.f, 0.f, 0.f};
#pragma unroll
        for (int ai = 0; ai < 2; ++ai) { const int blk = 2 * ai + wr;
#pragma unroll
            for (int m = 0; m < 4; ++m) { const int row = u.pm * 256 + ai * 128 + wr * 64 + m * 16 + fr; f32x4 o[2];
#pragma unroll
                for (int n = 0; n < 2; ++n) { const f32x4 cur = acc[ai][0][m][n];
                    f32x4 b, d;
                    if (m > 0) b = row_prev(acc[ai][0][m - 1][n]); else b = (blk > 0) ? *(const LAS f32x4*)(edge + ((blk - 1) * 2 + 1) * 128 + c8 + 4 * n) : zero4;
                    if (m < 3) d = row_next(acc[ai][0][m + 1][n]); else d = (blk < 3) ? *(const LAS f32x4*)(edge + ((blk + 1) * 2 + 0) * 128 + c8 + 4 * n) : zero4;
                    const f32x4 a = row_prev(cur), c = row_next(cur);
                    const f32x4 up = (fr == 0) ? b : a, dn = (fr == 15) ? d : c;
                    const f32x4 cv = w0[n] * up + w1[n] * cur + w2[n] * dn + bb[n]; const f32x4 uu = acc[ai][1][m][n];
                    o[n] = silu4(cv) * uu;
                    if (m == 0 && blk == 0 && fr == 0) { float* hp = HALO + (size_t)((u.pm * 2 + 0) * 3) * HALO_STRIDE + f0 + 4 * n; *(f32x4*)hp = cv; *(f32x4*)(hp + HALO_STRIDE) = cur; *(f32x4*)(hp + 2 * HALO_STRIDE) = uu; }
                    if (m == 3 && blk == 3 && fr == 15) { float* hp = HALO + (size_t)((u.pm * 2 + 1) * 3) * HALO_STRIDE + f0 + 4 * n; *(f32x4*)hp = cv; *(f32x4*)(hp + HALO_STRIDE) = cur; *(f32x4*)(hp + 2 * HALO_STRIDE) = uu; } }
                *(u32x4*)(ACT + (size_t)row * FF + f0) = pack8(o[0], o[1]); asm volatile("" ::: "memory"); } }
        asm volatile("s_waitcnt lgkmcnt(0)" ::: "memory"); __builtin_amdgcn_s_barrier(); asm volatile("" ::: "memory");
    }
};
struct EpiQKV {
    static constexpr bool PERM = true, PROBE2 = false;
    bf16* QKV; const float* tabr;
    __device__ __forceinline__ void operator()(const f32x4 (&acc)[2][2][4][2], const Unit& u, int wr, int wc, int fr, int fq) const {
        const int row0 = u.pm * 256 + wr * 64 + fr; const int col0 = u.pn * 256 + wc * 32 + 8 * fq;
        const bool rope = (u.pn < 16) && (u.pm < MX / 256);
#pragma unroll
        for (int ai = 0; ai < 2; ++ai)
#pragma unroll
            for (int m = 0; m < 4; ++m) { const int row = row0 + ai * 128 + m * 16;
#pragma unroll
                for (int bj = 0; bj < 2; ++bj) { f32x4 v0 = acc[ai][bj][m][0], v1 = acc[ai][bj][m][1]; const int col = col0 + bj * 128;
                    if (rope) { const int t = row & (SEQ - 1); const float* tp = tabr + ((size_t)t * 128 + ((col & 255) >> 1)) * 2;
                        v0 = rot2(v0, *(const f32x4*)tp); v1 = rot2(v1, *(const f32x4*)(tp + 4)); }
                    *(u32x4*)(QKV + (size_t)row * 8192 + col) = pack8(v0, v1); } asm volatile("" ::: "memory"); }
    }
};
struct EpiGate {
    static constexpr bool PERM = true, PROBE2 = false;
    bf16* GATED; const bf16* YF; const bf16* YB; const float* ST;
    __device__ __forceinline__ void operator()(const f32x4 (&acc)[2][2][4][2], const Unit& u, int wr, int wc, int fr, int fq) const {
        const int row0 = u.pm * 256 + wr * 64 + fr; const int f0 = u.pn * 128 + wc * 32 + 8 * fq; const int hd = u.pn >> 2;
#pragma unroll
        for (int ai = 0; ai < 2; ++ai)
#pragma unroll
            for (int m = 0; m < 4; ++m) { const int row = row0 + ai * 128 + m * 16; const size_t off = (size_t)row * 4096 + f0;
                const u32x4 yf = *(const u32x4*)(YF + off), yb = *(const u32x4*)(YB + off);
                const f32x2 sf = *(const f32x2*)(ST + ((size_t)row * 8 + hd) * 2), sb = *(const f32x2*)(ST + ((size_t)(MT + row) * 8 + hd) * 2);
                const f32x4 a0 = acc[ai][0][m][0], a1 = acc[ai][0][m][1], b0 = acc[ai][1][m][0], b1 = acc[ai][1][m][1];
#define NF(w, hi_) (((hi_ ? bfhi(w) : bflo(w)) - sf[0]) * sf[1])
#define NB(w, hi_) (((hi_ ? bfhi(w) : bflo(w)) - sb[0]) * sb[1])
                f32x4 o0, o1;
                o0[0] = fast_silu(a0[0]) * NF(yf.x, 0) + fast_silu(b0[0]) * NB(yb.x, 0); o0[1] = fast_silu(a0[1]) * NF(yf.x, 1) + fast_silu(b0[1]) * NB(yb.x, 1);
                o0[2] = fast_silu(a0[2]) * NF(yf.y, 0) + fast_silu(b0[2]) * NB(yb.y, 0); o0[3] = fast_silu(a0[3]) * NF(yf.y, 1) + fast_silu(b0[3]) * NB(yb.y, 1);
                o1[0] = fast_silu(a1[0]) * NF(yf.z, 0) + fast_silu(b1[0]) * NB(yb.z, 0); o1[1] = fast_silu(a1[1]) * NF(yf.z, 1) + fast_silu(b1[1]) * NB(yb.z, 1);
                o1[2] = fast_silu(a1[2]) * NF(yf.w, 0) + fast_silu(b1[2]) * NB(yb.w, 0); o1[3] = fast_silu(a1[3]) * NF(yf.w, 1) + fast_silu(b1[3]) * NB(yb.w, 1);
#undef NF
#undef NB
                *(u32x4*)(GATED + off) = pack8(o0, o1); asm volatile("" ::: "memory"); }
    }
};

namespace att {
constexpr int NW = 8, QBLK = 32, KVBLK = 64;
constexpr int SHM_V = 16384, SHM_KN = 16384, SHM_KR = 8192;
constexpr int OFF_V = 0, OFF_KN = 3 * SHM_V, OFF_KR = OFF_KN + 2 * SHM_KN, OFF_WS = OFF_KR + 2 * SHM_KR, SHM_ATTN = OFF_WS + NW * 64 * 4;
constexpr float THR2 = 11.5f;
#define KSWZ(row, colB) ((row) * 256 + ((colB) ^ (((row) & 7) << 4)))
#define KRSWZ(row, colB) ((row) * 128 + ((colB) ^ ((((row) >> 1) & 7) << 4)))
#define SBAR() __builtin_amdgcn_sched_barrier(0)
__device__ __forceinline__ int crow(int r, int hi) { return (r & 3) + 8 * (r >> 2) + 4 * hi; }
__device__ __forceinline__ void partialSM(f32x16& p0, f32x16& p1, float& m_reg, float& alpha) {
  float pmax = p0[0];
#pragma unroll
  for (int r = 1; r < 16; ++r) pmax = fmaxf(pmax, p0[r]);
#pragma unroll
  for (int r = 0; r < 16; ++r) pmax = fmaxf(pmax, p1[r]);
  { auto rr = __builtin_amdgcn_permlane32_swap(__float_as_uint(pmax), __float_as_uint(pmax), false, false); pmax = fmaxf(__uint_as_float(rr[0]), __uint_as_float(rr[1])); }
  float mn;
  if (__builtin_expect(__all(pmax - m_reg <= THR2), 1)) { mn = m_reg; alpha = 1.f; }
  else { mn = fmaxf(m_reg, pmax); alpha = __builtin_amdgcn_exp2f(m_reg - mn); m_reg = mn; }
#pragma unroll
  for (int r = 0; r < 16; ++r) p0[r] = p0[r] - mn;
#pragma unroll
  for (int r = 0; r < 16; ++r) p1[r] = p1[r] - mn;
#pragma unroll
  for (int r = 0; r < 16; ++r) p0[r] = __builtin_amdgcn_exp2f(p0[r]);
}
__device__ __forceinline__ void finishSM(f32x16& p0, f32x16& p1, float alpha, float& l_reg, bf16x8& pa0, bf16x8& pa1, bf16x8& pa2, bf16x8& pa3) {
#pragma unroll
  for (int r = 0; r < 16; ++r) p1[r] = __builtin_amdgcn_exp2f(p1[r]);
  float ps = 0;
#pragma unroll
  for (int r = 0; r < 16; ++r) ps += p0[r];
#pragma unroll
  for (int r = 0; r < 16; ++r) ps += p1[r];
  { auto rr = __builtin_amdgcn_permlane32_swap(__float_as_uint(ps), __float_as_uint(ps), false, false); ps = __uint_as_float(rr[0]) + __uint_as_float(rr[1]); }
  l_reg = l_reg * alpha + ps;
#define PK4(P, BASE, OUT) do { unsigned a0 = cvt_pk_bf16(P[BASE + 0], P[BASE + 1]), a1 = cvt_pk_bf16(P[BASE + 2], P[BASE + 3]);   \
    unsigned b0 = cvt_pk_bf16(P[BASE + 4], P[BASE + 5]), b1 = cvt_pk_bf16(P[BASE + 6], P[BASE + 7]);                              \
    auto r0 = __builtin_amdgcn_permlane32_swap(a0, b0, false, false); auto r1 = __builtin_amdgcn_permlane32_swap(a1, b1, false, false); \
    u32x4 w = {r0[0], r1[0], r0[1], r1[1]}; OUT = __builtin_bit_cast(bf16x8, w); } while (0)
  PK4(p0, 0, pa0); PK4(p0, 8, pa1); PK4(p1, 0, pa2); PK4(p1, 8, pa3);
#undef PK4
}
__device__ __forceinline__ void qkt(f32x16& p0, f32x16& p1, const char* Kn, const char* Kr, const bf16x8* qr, int r32, int hi) {
  p0 = f32x16{}; p1 = f32x16{};
#pragma unroll
  for (int d0 = 0; d0 < 8; ++d0) { const int cb = (d0 * 16 + hi * 8) * 2;
    const bf16x8 b0 = *reinterpret_cast<const bf16x8*>(Kn + KSWZ(r32, cb));
    const bf16x8 b1 = *reinterpret_cast<const bf16x8*>(Kn + KSWZ(32 + r32, cb));
    p0 = __builtin_amdgcn_mfma_f32_32x32x16_bf16(b0, qr[d0], p0, 0, 0, 0);
    p1 = __builtin_amdgcn_mfma_f32_32x32x16_bf16(b1, qr[d0], p1, 0, 0, 0); }
#pragma unroll
  for (int d0 = 0; d0 < 4; ++d0) { const int cb = (d0 * 16 + hi * 8) * 2;
    const bf16x8 b0 = *reinterpret_cast<const bf16x8*>(Kr + KRSWZ(r32, cb));
    const bf16x8 b1 = *reinterpret_cast<const bf16x8*>(Kr + KRSWZ(32 + r32, cb));
    p0 = __builtin_amdgcn_mfma_f32_32x32x16_bf16(b0, qr[8 + d0], p0, 0, 0, 0);
    p1 = __builtin_amdgcn_mfma_f32_32x32x16_bf16(b1, qr[8 + d0], p1, 0, 0, 0); }
}
__device__ __forceinline__ int v_st(int k, int c) { const int kk = (k & ~0xC) | ((k & 4) << 1) | ((k & 8) >> 1); return ((kk >> 3) * 4 + (c >> 5)) * 512 + ((kk & 7) * 32 + (c & 31)) * 2; }
__device__ __forceinline__ int v_rd_base(int lane) { return ((lane & 3) << 3) | (((lane >> 2) & 3) << 6) | (((lane >> 4) & 1) << 5) | (((lane >> 5) & 1) << 8); }
constexpr int v_rd_off(int d0, int ks, int half) { return d0 * 512 + ks * 4096 + half * 2048; }
template <int OFF> __device__ __forceinline__ s16x4 tr_read(int vb) { s16x4 r; asm volatile("ds_read_b64_tr_b16 %0, %1 offset:%2" : "=&v"(r) : "v"(vb), "i"(OFF) : "memory"); return r; }
template <int D0> __device__ __forceinline__ void pv_one(f32x16& od, int vb, bf16x8 pa0, bf16x8 pa1, bf16x8 pa2, bf16x8 pa3) {
  const s16x4 l0 = tr_read<v_rd_off(D0, 0, 0)>(vb), h0 = tr_read<v_rd_off(D0, 0, 1)>(vb), l1 = tr_read<v_rd_off(D0, 1, 0)>(vb), h1 = tr_read<v_rd_off(D0, 1, 1)>(vb);
  const s16x4 l2 = tr_read<v_rd_off(D0, 2, 0)>(vb), h2 = tr_read<v_rd_off(D0, 2, 1)>(vb), l3 = tr_read<v_rd_off(D0, 3, 0)>(vb), h3 = tr_read<v_rd_off(D0, 3, 1)>(vb);
  asm volatile("s_waitcnt lgkmcnt(0)" ::: "memory"); SBAR();
#define PK(L, H) (bf16x8){L[0], L[1], L[2], L[3], H[0], H[1], H[2], H[3]}
  od = __builtin_amdgcn_mfma_f32_32x32x16_bf16(pa0, PK(l0, h0), od, 0, 0, 0);
  od = __builtin_amdgcn_mfma_f32_32x32x16_bf16(pa1, PK(l1, h1), od, 0, 0, 0);
  od = __builtin_amdgcn_mfma_f32_32x32x16_bf16(pa2, PK(l2, h2), od, 0, 0, 0);
  od = __builtin_amdgcn_mfma_f32_32x32x16_bf16(pa3, PK(l3, h3), od, 0, 0, 0);
#undef PK
}
__device__ __forceinline__ void pv_d0(f32x16* o, int vb, bf16x8 pa0, bf16x8 pa1, bf16x8 pa2, bf16x8 pa3) {
  pv_one<0>(o[0], vb, pa0, pa1, pa2, pa3); pv_one<1>(o[1], vb, pa0, pa1, pa2, pa3); pv_one<2>(o[2], vb, pa0, pa1, pa2, pa3); pv_one<3>(o[3], vb, pa0, pa1, pa2, pa3);
}
__device__ __forceinline__ void attn_unit(const bf16* __restrict__ Qb, const bf16* __restrict__ KVh, const bf16* __restrict__ KRp, bf16* __restrict__ Ob,
                                          int NT, int nc, int cbase, int xbase, char* lds, int tid_in, unsigned long long* ts_words = nullptr) {
  int tid = tid_in; asm volatile("" : "+v"(tid));
  const int wid = __builtin_amdgcn_readfirstlane(tid >> 6), lane = tid & 63, r32 = lane & 31, hi = lane >> 5;
  char* V_lds = lds + OFF_V; char* Kn_lds = lds + OFF_KN; char* Kr_lds = lds + OFF_KR;
  float* ws = (float*)(lds + OFF_WS) + wid * 64; float* li_l = ws; float* al_l = ws + 32;
  float m_reg = -1e30f, l_reg = 0; f32x16 o[4] = {}; bf16x8 qr[12];
  const bf16* Qw = Qb + (long)(wid * QBLK + r32) * 3072 + hi * 8;
#pragma unroll
  for (int d0 = 0; d0 < 12; ++d0) qr[d0] = *reinterpret_cast<const bf16x8*>(Qw + d0 * 16);
  const int vb0 = (int)(uintptr_t)V_lds + v_rd_base(lane);
  unsigned vofK[2], vofV[2], vofR;
#pragma unroll
  for (int i = 0; i < 2; ++i) { const int pc = wid * 2 + i;
      { const int row = pc * 4 + (lane >> 4), ch = (lane & 15) ^ (row & 7); vofK[i] = (unsigned)((row * 4096 + ch * 8) * 2); }
      { const int ob = pc * 1024 + lane * 16, st = ob >> 9, w = ob & 511, kk = (st >> 2) * 8 + (w >> 6); const int k = (kk & ~0xC) | ((kk & 4) << 1) | ((kk & 8) >> 1);
        const int c = (st & 3) * 32 + 8 * ((w & 63) >> 4); vofV[i] = (unsigned)((k * 4096 + 128 + c) * 2); } }
  { const int row = wid * 8 + (lane >> 3), ch = (lane & 7) ^ ((row >> 1) & 7); vofR = (unsigned)((row * 64 + ch * 8) * 2); }
  const unsigned ldsK = (unsigned)__builtin_amdgcn_readfirstlane((unsigned)(uintptr_t)Kn_lds + (unsigned)wid * 2048u);
  const unsigned ldsV = (unsigned)__builtin_amdgcn_readfirstlane((unsigned)(uintptr_t)V_lds + (unsigned)wid * 2048u);
  const unsigned ldsR = (unsigned)__builtin_amdgcn_readfirstlane((unsigned)(uintptr_t)Kr_lds + (unsigned)wid * 1024u);
#define KROW(j) ((j) < nc ? cbase + (j) * KVBLK : xbase + ((j) - nc) * KVBLK)
#define DMA_TILE(j, kslot, vslot) do { const long k0_ = KROW(j); const char* kb_ = uni_ptr(KVh + k0_ * 4096); const char* rb_ = uni_ptr(KRp + k0_ * 64); \
    glds16_s(kb_, vofK[0], ldsK + (kslot) * SHM_KN); glds16_s(kb_, vofK[1], ldsK + (kslot) * SHM_KN + 1024u); \
    glds16_s(rb_, vofR, ldsR + (kslot) * SHM_KR); \
    glds16_s(kb_, vofV[0], ldsV + (vslot) * SHM_V); glds16_s(kb_, vofV[1], ldsV + (vslot) * SHM_V + 1024u); } while (0)
#ifndef ATT_SKEW
#define ATT_SKEW 0
#endif
#if PROBE_TS
#define WAIT_SYNC() do { const unsigned long long w0_ = __builtin_amdgcn_s_memrealtime(); asm volatile("s_waitcnt vmcnt(0)" ::: "memory"); const unsigned long long w1_ = __builtin_amdgcn_s_memrealtime(); __syncthreads(); const unsigned long long w2_ = __builtin_amdgcn_s_memrealtime(); att_w_dma += w1_ - w0_; att_w_bar += w2_ - w1_; } while (0)
#else
#define WAIT_SYNC() do { asm volatile("s_waitcnt vmcnt(0)" ::: "memory"); __syncthreads(); if (ATT_SKEW && wid >= 4) __builtin_amdgcn_s_sleep(ATT_SKEW); } while (0)
#endif
#define RESC(a) do { if (__any((a) < 1.f)) { if (hi == 0) al_l[r32] = (a); asm volatile("s_waitcnt lgkmcnt(0)" ::: "memory"); \
    _Pragma("unroll") for (int d = 0; d < 4; ++d) _Pragma("unroll") for (int r = 0; r < 16; ++r) o[d][r] *= al_l[crow(r, hi)]; } } while (0)
#if PROBE_TS
  unsigned long long att_w_dma = 0, att_w_bar = 0; const unsigned long long att_t0 = __builtin_amdgcn_s_memrealtime();
#endif
  f32x16 pA0, pA1, pB0, pB1; float alA, alB; bf16x8 pa0, pa1, pa2, pa3;
  DMA_TILE(0, 0, 0); DMA_TILE(1, 1, 1); WAIT_SYNC();
  qkt(pA0, pA1, Kn_lds, Kr_lds, qr, r32, hi); partialSM(pA0, pA1, m_reg, alA);
  __syncthreads();
  int vprev = 0, vcur = 1, vnext = 2;
  for (int j = 1; j + 1 < NT; j += 2) {
    DMA_TILE(j + 1, 0, vnext);
    SBAR(); qkt(pB0, pB1, Kn_lds + SHM_KN, Kr_lds + SHM_KR, qr, r32, hi);
    finishSM(pA0, pA1, alA, l_reg, pa0, pa1, pa2, pa3); SBAR();
    pv_d0(o, vb0 + vprev * SHM_V, pa0, pa1, pa2, pa3); partialSM(pB0, pB1, m_reg, alB);
    RESC(alB); WAIT_SYNC();
    { const int t_ = vprev; vprev = vcur; vcur = vnext; vnext = t_; }
    if (j + 2 < NT) DMA_TILE(j + 2, 1, vnext);
    SBAR(); qkt(pA0, pA1, Kn_lds, Kr_lds, qr, r32, hi);
    finishSM(pB0, pB1, alB, l_reg, pa0, pa1, pa2, pa3); SBAR();
    pv_d0(o, vb0 + vprev * SHM_V, pa0, pa1, pa2, pa3); partialSM(pA0, pA1, m_reg, alA);
    RESC(alA); WAIT_SYNC();
    { const int t_ = vprev; vprev = vcur; vcur = vnext; vnext = t_; }
  }
  SBAR(); qkt(pB0, pB1, Kn_lds + SHM_KN, Kr_lds + SHM_KR, qr, r32, hi);
  finishSM(pA0, pA1, alA, l_reg, pa0, pa1, pa2, pa3); SBAR();
  pv_d0(o, vb0 + vprev * SHM_V, pa0, pa1, pa2, pa3); partialSM(pB0, pB1, m_reg, alB);
  RESC(alB);
  finishSM(pB0, pB1, alB, l_reg, pa0, pa1, pa2, pa3); SBAR();
  pv_d0(o, vb0 + vcur * SHM_V, pa0, pa1, pa2, pa3);
  if (hi == 0) li_l[r32] = l_reg; asm volatile("s_waitcnt lgkmcnt(0)" ::: "memory");
  float rli[16];
#pragma unroll
  for (int r = 0; r < 16; ++r) rli[r] = __builtin_amdgcn_rcpf(li_l[crow(r, hi)]);
  bf16* Ow = Ob + (long)(wid * QBLK) * 2048;
#pragma unroll
  for (int r = 0; r < 16; ++r) { const int orow = crow(r, hi);
#pragma unroll
    for (int d0 = 0; d0 < 4; ++d0) Ow[(long)orow * 2048 + d0 * 32 + r32] = (bf16)(cvt_pk_bf16(o[d0][r] * rli[r], 0.f) & 0xffffu); }
  __syncthreads();
#if PROBE_TS
  if (ts_words && tid == 0) { ts_words[160] += att_w_dma; ts_words[161] += att_w_bar; ts_words[162] += __builtin_amdgcn_s_memrealtime() - att_t0; ts_words[163] += (unsigned long long)NT; }
#endif
#undef KROW
#undef DMA_TILE
#undef WAIT_SYNC
#undef RESC
}
#undef SBAR
}

namespace scan {
constexpr int CH = 64;
constexpr int OFF_Q = 0, OFF_K = 32768  , OFF_V = 98304, OFF_P = 131072, SHM_SCAN = 131072 + 8192;
__device__ __forceinline__ unsigned off_b(unsigned row, unsigned ch) { return 256u * row + 16u * (ch ^ (((row & 3) << 2) | ((row >> 2) & 3))); }
__device__ __forceinline__ unsigned p_off(unsigned i, unsigned chunk) { return 128u * i + 16u * (chunk ^ ((i >> 1) & 7)); }
__device__ __forceinline__ int crow(int r, int hi) { return (r & 3) + 8 * (r >> 2) + 4 * hi; }
__device__ __forceinline__ s16x4 vtr(const LAS char* p) { typedef short v4i16_t __attribute__((ext_vector_type(4))); return __builtin_bit_cast(s16x4, __builtin_amdgcn_ds_read_tr16_b64_v4i16((LAS v4i16_t*)p)); }
__device__ __forceinline__ bf16x8 tr_frag(const LAS char* img, int lane, int c, int ks) {
    const unsigned h = lane >> 5, blk = (lane >> 4) & 1, q = (lane & 15) >> 2, p = lane & 3;
    const unsigned r0 = 16 * ks + 8 * h + q, chn = 4 * c + 2 * blk + (p >> 1);
    const s16x4 lo = vtr(img + off_b(r0, chn) + 8 * (p & 1)), hi = vtr(img + off_b(r0 + 4, chn) + 8 * (p & 1));
    return (bf16x8){lo[0], lo[1], lo[2], lo[3], hi[0], hi[1], hi[2], hi[3]};
}
__device__ __forceinline__ bf16x8 pack_step(const f32x16& x, int s) {
    u32x4 p; p.x = cvt_pk_bf16(x[8 * s + 0], x[8 * s + 1]); p.y = cvt_pk_bf16(x[8 * s + 2], x[8 * s + 3]); p.z = cvt_pk_bf16(x[8 * s + 4], x[8 * s + 5]); p.w = cvt_pk_bf16(x[8 * s + 6], x[8 * s + 7]);
    return __builtin_bit_cast(bf16x8, p);
}
__device__ __forceinline__ void dma_mat(const bf16* src, int ld, LAS unsigned char* dst, int wid, int lane) {
    const char* sb = uni_ptr(src); const unsigned d0 = (unsigned)__builtin_amdgcn_readfirstlane((unsigned)(uintptr_t)dst + (unsigned)wid * 4096u);
#pragma unroll
    for (int k = 0; k < 4; ++k) { const int pc = wid * 4 + k, img = pc >> 4, row = 4 * (pc & 15) + (lane >> 4), pos = lane & 15;
        const int ch = pos ^ (((row & 3) << 2) | ((row >> 2) & 3));
        glds16_s(sb, (unsigned)((row * ld + img * 128 + ch * 8) * 2), d0 + (unsigned)k * 1024u); }
}
__device__ __forceinline__ int scan_rowbase(int n, int b, int dir) { return (n < 4) ? MX + b * CTXL + (dir ? 3 - n : n) * CH : b * SEQ + (dir ? 67 - n : n - 4) * CH; }
__device__ __forceinline__ float uni_f(float x) { return __uint_as_float(__builtin_amdgcn_readfirstlane(__float_as_uint(x))); }
typedef const LAS s16x4* lds_s4p;
__device__ __forceinline__ void scan_unit(const bf16* __restrict__ QKV, bf16* __restrict__ Y, int b, int hd, int dir, int dvh, float lg2, bool skip_ctx_y, LAS unsigned char* lds, int tid_in, unsigned long long* lds_ts = nullptr) {
    int tid = tid_in; asm volatile("" : "+v"(tid));
    const int wid = __builtin_amdgcn_readfirstlane(tid >> 6), lane0 = tid & 63;
    const LAS char* QI = (const LAS char*)lds + OFF_Q; const LAS char* VI = (const LAS char*)lds + OFF_V;
    LAS char* PI = (LAS char*)lds + OFF_P;
    f32x16 S[8];
#pragma unroll
    for (int i = 0; i < 8; ++i) S[i] = f32x16{};
    const float lgr = dir ? -lg2 : lg2;
    const float g64 = uni_f(__builtin_amdgcn_exp2f(64.f * lg2));
    const float R1 = uni_f(__builtin_amdgcn_exp2f(lgr)), R8 = uni_f(__builtin_amdgcn_exp2f(8.f * lgr)), R32 = uni_f(__builtin_amdgcn_exp2f(32.f * lgr));
    const float Rm1 = uni_f(__builtin_amdgcn_exp2f(-lgr)), Rm16 = uni_f(__builtin_amdgcn_exp2f(-16.f * lgr));
    const float c0 = uni_f(dir ? g64 : __builtin_amdgcn_exp2f(lg2)), z0 = uni_f(dir ? 1.0f : __builtin_amdgcn_exp2f(63.f * lg2));
    const int qcol = hd * RDK, kcol = 2048 + hd * RDK, vcol = 4096 + hd * RDV + dvh * 256;
    { const bf16* src = QKV + (size_t)scan_rowbase(0, b, dir) * 8192;
      dma_mat(src + qcol, 8192, lds + OFF_Q, wid, lane0); dma_mat(src + kcol, 8192, lds + OFF_K, wid, lane0); dma_mat(src + vcol, 8192, lds + OFF_V, wid, lane0);
      asm volatile("s_waitcnt vmcnt(0)" ::: "memory"); __syncthreads(); }
#if PROBE_TS
    unsigned long long sc_w1 = 0, sc_w2 = 0; const unsigned long long sc_tb = __builtin_amdgcn_s_memrealtime();
#endif
    for (int n = 0; n < 68; ++n) {
        int lane = lane0; asm volatile("" : "+v"(lane));
        const int r = lane & 31, h = lane >> 5, fr = lane & 15, fq = lane >> 4;
        const int rowbase = scan_rowbase(n, b, dir);
        const bool more = n + 1 < 68;
        const bf16* nsrc = QKV + (size_t)scan_rowbase(more ? n + 1 : n, b, dir) * 8192;
        const LAS char* KI = (const LAS char*)lds + OFF_K + (n & 1) * 32768;
        if (more) dma_mat(nsrc + kcol, 8192, lds + OFF_K + ((n + 1) & 1) * 32768, wid, lane);
        const float LR = c0 * __builtin_amdgcn_exp2f((float)(4 * h) * lgr), LZ = z0 * __builtin_amdgcn_exp2f((float)(-8 * h) * lgr), LP = __builtin_amdgcn_exp2f((float)(fr - 4 * fq) * lgr);
        { const int fH = fr & 3, fL = (fr >> 2) & 3; const int AL = 256 * fr + 16 * (fq ^ fL);
          int AH[4];
#pragma unroll
          for (int k = 0; k < 4; ++k) AH[k] = 64 * (k ^ fH);
#pragma unroll
          for (int tix = 0; tix < 2; ++tix) { const int tt = wid * 2 + tix, jt = tt >> 2, it = tt & 3;
            f32x4 pt = {0.f, 0.f, 0.f, 0.f};
            const bool live = dir ? (jt >= it) : (jt <= it);
            if (live) { const LAS char* ka = KI + 4096 * jt + AL; const LAS char* qa = QI + 4096 * it + AL;
#pragma unroll
                for (int ks = 0; ks < 8; ++ks) { const int o = (ks >> 2) * 16384 + AH[ks & 3];
                    pt = __builtin_amdgcn_mfma_f32_16x16x32_bf16(*(const LAS bf16x8*)(ka + o), *(const LAS bf16x8*)(qa + o), pt, 0, 0, 0); } }
            float we = LP * __builtin_amdgcn_exp2f((float)(16 * (it - jt)) * lgr); float v[4];
            const int mrel = fr - 4 * fq;
#pragma unroll
            for (int e = 0; e < 4; ++e) { float x = live ? pt[e] * we : 0.f; if (jt == it) { const bool keep = dir ? (e >= mrel) : (e <= mrel); x = keep ? x : 0.f; } v[e] = x; we *= Rm1; }
            const int i = it * 16 + fr, j0 = jt * 16 + 4 * fq;
            u32x2 w; w.x = cvt_pk_bf16(v[0], v[1]); w.y = cvt_pk_bf16(v[2], v[3]);
            *(LAS u32x2*)(PI + p_off(i, j0 >> 3) + ((j0 >> 2) & 1) * 8) = w; } }
        f32x16 Yt[2]; Yt[0] = f32x16{}; Yt[1] = f32x16{};
        { const int fH = r & 3, fL = (r >> 2) & 3; int QH[4], QL[4];
#pragma unroll
          for (int k = 0; k < 4; ++k) { QH[k] = 64 * (k ^ fH); QL[k] = 256 * r + 8 * h + 16 * (k ^ fL); }
#pragma unroll
          for (int dkb = 0; dkb < 8; ++dkb)
#pragma unroll
            for (int s = 0; s < 2; ++s) { const bf16x8 bf = pack_step(S[dkb], s);
                const LAS char* rp = QI + (dkb >> 2) * 16384 + QH[dkb & 3];
#pragma unroll
                for (int it = 0; it < 2; ++it) {
                    const u32x2 lo = *(const LAS u32x2*)(rp + it * 8192 + QL[2 * s]), hi2 = *(const LAS u32x2*)(rp + it * 8192 + QL[2 * s + 1]);
                    const u32x4 aw = {lo.x, lo.y, hi2.x, hi2.y};
                    Yt[it] = __builtin_amdgcn_mfma_f32_32x32x16_bf16(__builtin_bit_cast(bf16x8, aw), bf, Yt[it], 0, 0, 0); } } }
        { float fit = LR;
#pragma unroll
          for (int it = 0; it < 2; ++it) { float fa = fit;
#pragma unroll
            for (int a4 = 0; a4 < 4; ++a4) { float fb = fa;
#pragma unroll
                for (int b4 = 0; b4 < 4; ++b4) { Yt[it][4 * a4 + b4] *= fb; fb *= R1; }
                fa *= R8; }
            fit *= R32; } }
#if PROBE_TS
        const unsigned long long sc_t0 = __builtin_amdgcn_s_memrealtime();
#endif
        if (more) asm volatile("s_waitcnt vmcnt(4)" ::: "memory"); else asm volatile("s_waitcnt vmcnt(0)" ::: "memory");
        __syncthreads();
#if PROBE_TS
        sc_w1 += __builtin_amdgcn_s_memrealtime() - sc_t0;
#endif
        if (more) dma_mat(nsrc + qcol, 8192, lds + OFF_Q, wid, lane);
#pragma unroll
        for (int i = 0; i < 8; ++i)
#pragma unroll
            for (int rg = 0; rg < 16; ++rg) S[i][rg] *= g64;
        {
          const int blk = (lane >> 4) & 1, q = (lane & 15) >> 2, p = lane & 3; int TB[2], CQ[4];
#pragma unroll
          for (int t = 0; t < 2; ++t) TB[t] = 2048 * h + 256 * q + 1024 * t + 16 * ((2 * blk + (p >> 1)) ^ ((2 * h + t) & 3)) + 8 * (p & 1);
#pragma unroll
          for (int c = 0; c < 4; ++c) CQ[c] = 64 * (c ^ q);
          const LAS char* vb = VI + (wid >> 2) * 16384 + CQ[wid & 3];
          float zk = LZ;
#pragma unroll
          for (int ks = 0; ks < 4; ++ks) {
            const s16x4 vlo = vtr(vb + 4096 * ks + TB[0]), vhi = vtr(vb + 4096 * ks + TB[1]);
            const u32x2 vl = __builtin_bit_cast(u32x2, vlo), vh = __builtin_bit_cast(u32x2, vhi);
            const u32x4 vw = {vl.x, vl.y, vh.x, vh.y}; const bf16x8 vf = __builtin_bit_cast(bf16x8, vw);
#pragma unroll
            for (int it = 0; it < 2; ++it) { const bf16x8 pa = *(const LAS bf16x8*)(PI + p_off(it * 32 + r, 2 * ks + h));
                Yt[it] = __builtin_amdgcn_mfma_f32_32x32x16_bf16(pa, vf, Yt[it], 0, 0, 0); }
            float zj = zk; u32x4 zw;
            { const float a0 = bflo(vw.x) * zj; zj *= Rm1; const float a1 = bfhi(vw.x) * zj; zj *= Rm1; zw.x = cvt_pk_bf16(a0, a1); }
            { const float a0 = bflo(vw.y) * zj; zj *= Rm1; const float a1 = bfhi(vw.y) * zj; zj *= Rm1; zw.y = cvt_pk_bf16(a0, a1); }
            { const float a0 = bflo(vw.z) * zj; zj *= Rm1; const float a1 = bfhi(vw.z) * zj; zj *= Rm1; zw.z = cvt_pk_bf16(a0, a1); }
            { const float a0 = bflo(vw.w) * zj; zj *= Rm1; const float a1 = bfhi(vw.w) * zj; zw.w = cvt_pk_bf16(a0, a1); }
            const bf16x8 vz = __builtin_bit_cast(bf16x8, zw);
            zk *= Rm16;
#pragma unroll
            for (int dkb = 0; dkb < 8; ++dkb) { const LAS char* kb_ = KI + (dkb >> 2) * 16384 + 4096 * ks + CQ[dkb & 3];
                const s16x4 klo = vtr(kb_ + TB[0]), khi = vtr(kb_ + TB[1]);
                const u32x2 kl = __builtin_bit_cast(u32x2, klo), kh = __builtin_bit_cast(u32x2, khi); const u32x4 kw = {kl.x, kl.y, kh.x, kh.y};
                S[dkb] = __builtin_amdgcn_mfma_f32_32x32x16_bf16(__builtin_bit_cast(bf16x8, kw), vz, S[dkb], 0, 0, 0); }
            __builtin_amdgcn_sched_barrier(0);
          } }
        if (!(skip_ctx_y && n < 4)) {
            bf16* Yr = Y + (size_t)rowbase * 4096; const unsigned yo = (unsigned)(hd * RDV + dvh * 256 + wid * 32 + r + 4 * h * 4096);
#pragma unroll
            for (int it = 0; it < 2; ++it)
#pragma unroll
                for (int rg = 0; rg < 16; ++rg) { const unsigned i0 = (unsigned)(it * 32 + (rg & 3) + 8 * (rg >> 2));
                    Yr[yo + i0 * 4096u] = (bf16)(cvt_pk_bf16(Yt[it][rg], 0.f) & 0xffffu); }
        }
#if PROBE_TS
        const unsigned long long sc_t1 = __builtin_amdgcn_s_memrealtime();
#endif
        asm volatile("s_waitcnt vmcnt(0)" ::: "memory");
        __syncthreads();
#if PROBE_TS
        sc_w2 += __builtin_amdgcn_s_memrealtime() - sc_t1;
#endif
        if (more) dma_mat(nsrc + vcol, 8192, lds + OFF_V, wid, lane);
    }
    asm volatile("s_waitcnt vmcnt(0)" ::: "memory"); __syncthreads();
#if PROBE_TS
    if (blockIdx.x == 0 && tid == 0) { unsigned long long* tw = (unsigned long long*)(lds_ts); tw[170] += sc_w1; tw[171] += sc_w2; tw[172] += __builtin_amdgcn_s_memrealtime() - sc_tb; }
#endif
}
}

#define XB_TMO      128
#define XB_XCNT(j)  (256  + 64 * (j))
#define XB_XSUB(j)  (1280 + 64 * (j))
#define XB_XGEN(j)  (2304 + 64 * (j))
#define XB_TOP      3328
#define XB_TOPGEN   3392
#define XCD_BAR_WORDS 3456
#define XB_SPIN_CAP (1u << 22)
__device__ __forceinline__ unsigned xb_ld(unsigned* p)              { return __hip_atomic_load(p, __ATOMIC_RELAXED, __HIP_MEMORY_SCOPE_AGENT); }
__device__ __forceinline__ unsigned xb_add(unsigned* p, unsigned v) { return __hip_atomic_fetch_add(p, v, __ATOMIC_RELAXED, __HIP_MEMORY_SCOPE_AGENT); }
__device__ __forceinline__ unsigned xb_xcc_id() { return (unsigned)__builtin_amdgcn_s_getreg((3 << 11) | 20) & 0xFu; }
#define XB_SPIN(cond, bar) do { unsigned _sp = 0; while (cond) { __builtin_amdgcn_s_sleep(1); \
    if ((++_sp & 255u) == 0u) { if (xb_ld(&(bar)[XB_TMO])) break; if (_sp > XB_SPIN_CAP) { atomicAdd(&(bar)[XB_TMO], 1u); break; } } } } while (0)
struct XcdBarrier { unsigned* bar; unsigned x; volatile LAS unsigned* st; int wave; };
__device__ __forceinline__ XcdBarrier xcd_barrier_post(unsigned* bar, volatile LAS unsigned* st, int wave) {
    XcdBarrier b; b.bar = bar; b.x = xb_xcc_id(); b.st = st; b.wave = wave;
    if (wave == 0 && lane_id() == 0) (void)xb_add(&bar[XB_XCNT(b.x)], 1u);
    return b;
}
__device__ __forceinline__ void xcd_barrier_complete(unsigned* bar, unsigned x, unsigned& nloc, unsigned& nx) {
    const unsigned G = gridDim.x * gridDim.y * gridDim.z;
    unsigned sum, cnt, mine, sp = 0u;
    for (;;) {
        sum = 0u; cnt = 0u; mine = 0u;
#pragma unroll
        for (unsigned j = 0; j < 16; ++j) { const unsigned c = xb_ld(&bar[XB_XCNT(j)]); sum += c; cnt += (c > 0u) ? 1u : 0u; mine = (j == x) ? c : mine; }
        if (sum == G) break;
        __builtin_amdgcn_s_sleep(1);
        if ((++sp & 255u) == 0u) { if (xb_ld(&bar[XB_TMO])) break; if (sp > XB_SPIN_CAP) { atomicAdd(&bar[XB_TMO], 1u); break; } }
    }
    nloc = mine > 0u ? mine : 1u; nx = cnt > 0u ? cnt : 1u;
}
__device__ __forceinline__ void xcd_barrier(const XcdBarrier& b) {
    asm volatile("s_waitcnt vmcnt(0)" ::: "memory");
    __syncthreads();
    if (b.wave == 0 && lane_id() == 0) {
        unsigned* bar = b.bar; asm volatile("" : "+s"(bar));
        __builtin_amdgcn_s_waitcnt(0);
        unsigned nloc = b.st[0], nx = b.st[1];
        if (nloc == 0u) { xcd_barrier_complete(bar, b.x, nloc, nx); b.st[0] = nloc; b.st[1] = nx; }
        const unsigned old = xb_add(&bar[XB_XSUB(b.x)], 1u);
        const unsigned gen = old / nloc;
        if (old + 1u == (gen + 1u) * nloc) {
            __builtin_amdgcn_fence(__ATOMIC_RELEASE, "agent");
            asm volatile("s_waitcnt vmcnt(0)" ::: "memory");
            const unsigned og = xb_add(&bar[XB_TOP], 1u);
            const unsigned tg = og / nx;
            if (og + 1u == (tg + 1u) * nx) xb_add(&bar[XB_TOPGEN], 1u);
            else XB_SPIN(xb_ld(&bar[XB_TOPGEN]) == tg, bar);
            __builtin_amdgcn_fence(__ATOMIC_ACQUIRE, "agent");
            xb_add(&bar[XB_XGEN(b.x)], 1u);
            asm volatile("s_waitcnt vmcnt(0)" ::: "memory");
        } else {
            XB_SPIN(xb_ld(&bar[XB_XGEN(b.x)]) == gen, bar);
            __builtin_amdgcn_fence(__ATOMIC_ACQUIRE, "agent");
            asm volatile("s_waitcnt vmcnt(0)" ::: "memory");
        }
    }
    __syncthreads();
}

__device__ __forceinline__ float wave_sum(float v, int lane) {
#pragma unroll
    for (int o = 1; o < 64; o <<= 1) v += shfl_xor_l(v, o, lane);
    return v;
}
struct CvtDesc { const float* src; const float* kscale; bf16* WTrow0; int ldw, k0, K, jkind; float gscale; };
__device__ __forceinline__ int ropeperm64(int c) { const int p = c >> 1, e = c & 1; return (p < 16) ? (p + 16 * e) : (32 + (p - 16) + 16 * e); }
__device__ __forceinline__ int ropeinv64(int s_) { const int half = s_ >> 5, w = s_ & 31; return 2 * (half * 16 + (w & 15)) + (w >> 4); }
__device__ __forceinline__ void cvt_load(const CvtDesc& d, int lane, f32x4 (&v)[16]) {
#pragma unroll
    for (int i = 0; i < 16; ++i) { const int kk = 4 * i + (lane >> 4);
        f32x4 x = d.src ? *(const f32x4*)(d.src + (size_t)(d.k0 + kk) * d.ldw) : (f32x4){0.f, 0.f, 0.f, 0.f};
        float sc_ = d.gscale; if (d.kscale) sc_ *= d.kscale[d.k0 + kk];
        v[i] = x * sc_; }
}
__device__ __forceinline__ void cvt_store(const CvtDesc& d, int lane, const f32x4 (&v)[16], LAS float* scr) {
    const int n4 = lane & 15; int jr[4];
#pragma unroll
    for (int e = 0; e < 4; ++e) { const int s_ = 4 * n4 + e; jr[e] = d.jkind == 0 ? s_ : d.jkind == 1 ? ropeinv64(s_) : 2 * (4 * (n4 & 7) + e) + (n4 >> 3); }
#pragma unroll
    for (int i = 0; i < 16; ++i) { const int kk = 4 * i + (lane >> 4);
#pragma unroll
        for (int e = 0; e < 4; ++e) scr[kk * 65 + jr[e]] = v[i][e]; }
    asm volatile("s_waitcnt lgkmcnt(0)" ::: "memory");
    const int c = lane & 7;
#pragma unroll
    for (int ps = 0; ps < 8; ++ps) { const int j = 8 * ps + (lane >> 3); const LAS float* s = scr + (8 * c) * 65 + j;
        u32x4 o; o.x = cvt_pk_bf16(s[0 * 65], s[1 * 65]); o.y = cvt_pk_bf16(s[2 * 65], s[3 * 65]); o.z = cvt_pk_bf16(s[4 * 65], s[5 * 65]); o.w = cvt_pk_bf16(s[6 * 65], s[7 * 65]);
        *(u32x4*)(d.WTrow0 + (size_t)j * d.K + d.k0 + 8 * c) = o; }
    asm volatile("s_waitcnt lgkmcnt(0)" ::: "memory");
}
struct CvtJob { const float* W0; const float* W1; const float* kscale; bf16* WT; int ldw, K, nrows, kind, aux; float gscale; };
__device__ __forceinline__ bool cvt_try(const CvtJob& J, int& it, int lane, CvtDesc& d) {
    const int nblk = J.nrows / 64, items = (J.K / 64) * nblk;
    if (it >= items) { it -= items; return false; }
    const int kb = it / nblk, nb = it % nblk; const int n4 = lane & 15;
    const float* sp; int jk = 0;
    switch (J.kind) {
        case 0: sp = J.W0 + J.aux + nb * 64 + 4 * n4; break;
        case 1: sp = J.W0 + J.aux + 4 * n4; jk = 1; break;
        case 2: { const int hh = nb / 3, part = nb % 3; sp = J.W0 + hh * DQ + 64 * part + 4 * n4; jk = (part == 2) ? 1 : 0; } break;
        case 3: { const int hh = nb >> 2, q4 = nb & 3; sp = J.W0 + hh * 256 + 32 * q4 + 128 * (n4 >> 3) + 4 * (n4 & 7); jk = 2; } break;
        case 4: { const int tl = nb >> 2, hf = (nb >> 1) & 1, q2 = nb & 1; const long long dW = (const char*)J.W1 - (const char*)J.W0; sp = (const float*)((const char*)J.W0 + dW * hf) + tl * 128 + 64 * q2 + 4 * n4; } break;
        default: sp = nullptr; break;
    }
    d.src = sp; d.kscale = J.kscale; d.WTrow0 = J.WT + (size_t)(nb * 64) * J.K; d.ldw = J.ldw; d.k0 = kb * 64; d.K = J.K; d.jkind = jk; d.gscale = J.gscale;
    return true;
}
__device__ __forceinline__ int cvt_items(const CvtJob& J) { return (J.K / 64) * (J.nrows / 64); }

__device__ __forceinline__ void row_load(const float* xrow, int lane, f32x4 (&v)[8]) {
#pragma unroll
    for (int j = 0; j < 8; ++j) v[j] = *(const f32x4*)(xrow + 4 * lane + 256 * j);
}
__device__ __forceinline__ void norm_mod_finish(const f32x4 (&v)[8], const float* g, const float* sc, const float* sh, bf16* orow, int lane) {
    float s = 0.f;
#pragma unroll
    for (int j = 0; j < 8; ++j) s += (v[j][0] * v[j][0] + v[j][1] * v[j][1]) + (v[j][2] * v[j][2] + v[j][3] * v[j][3]);
    const float rstd = 1.0f / sqrtf(wave_sum(s, lane) * (1.0f / D) + NORM_EPS);
#pragma unroll
    for (int j = 0; j < 8; ++j) { const int c = 4 * lane + 256 * j; const f32x4 gg = *(const f32x4*)(g + c), s1 = *(const f32x4*)(sc + c), s0 = *(const f32x4*)(sh + c);
        const f32x4 y = (v[j] * rstd) * gg * (1.0f + s1) + s0;
        u32x2 w; w.x = cvt_pk_bf16(y[0], y[1]); w.y = cvt_pk_bf16(y[2], y[3]); *(u32x2*)(orow + c) = w; }
}
__device__ __forceinline__ void norm_phase(const float* xsrc, const float* csrc, const float* g, const float* modl, int chunk, bf16* H, int nrows, int gw, int NGW, int lane) {
    if (gw >= nrows) return;
    f32x4 v[8], vn[8]; int m = gw;
    row_load(m < MX ? xsrc + (size_t)m * D : csrc + (size_t)(m - MX) * D, lane, v);
    for (;;) {
        const int mn = m + NGW; const bool has = mn < nrows;
        if (has) row_load(mn < MX ? xsrc + (size_t)mn * D : csrc + (size_t)(mn - MX) * D, lane, vn);
        const float* mr = modl + (size_t)(m < MX ? (m >> 12) : 8) * NMOD + chunk * D;
        norm_mod_finish(v, g, mr + D, mr, H + (size_t)m * D, lane);
        if (!has) break;
#pragma unroll
        for (int j = 0; j < 8; ++j) v[j] = vn[j];
        m = mn;
    }
}

__device__ __forceinline__ unsigned long long ld_arg(LAS unsigned char* lds, int i) {
    const volatile LAS unsigned* p = (const volatile LAS unsigned*)(lds + ARGS_OFF) + 2 * i;
    const unsigned lo = __builtin_amdgcn_readfirstlane(p[0]), hi = __builtin_amdgcn_readfirstlane(p[1]);
    return ((unsigned long long)hi << 32) | lo;
}
__device__ __forceinline__ void mod_layers(LAS unsigned char* lds, unsigned char* ws, int l_lo, int l_hi, int wg, int nwg, int tid, int lane, int wave) {
#define ARGF(i) ((const float*)ld_arg(lds, (i)))
    const int nitems = (l_hi - l_lo) * 96;
    if (wg >= nitems) return;
    LAS float* cond = (LAS float*)lds;
    LAS float* red = (LAS float*)(lds + 73728);
    float* MODV = (float*)(ws + WS_MODV);
    { const float* cin = ARGF(1); const float* cc = ARGF(3);
      for (int i = tid; i < 9 * D; i += 512) { const int r = i >> 11, k = i & (D - 1); const float c = (r < 8) ? cin[r * D + k] : cc[k]; cond[i] = c / (1.0f + __expf(-c)); } }
    __syncthreads();
    for (int it = wg; it < nitems; it += nwg) {
        const int l = l_lo + it / 96, cb = it % 96; const int n = cb * 128 + 2 * lane;
        const float* W = ARGF(4) + (size_t)l * D * NMOD + n; const float* mb = ARGF(5) + (size_t)l * NMOD + cb * 128;
        float a0[9], a1[9];
#pragma unroll
        for (int r = 0; r < 9; ++r) { a0[r] = 0.f; a1[r] = 0.f; }
        for (int k = wave * 256; k < wave * 256 + 256; k += 8) {
            f32x2 w[8];
#pragma unroll
            for (int q = 0; q < 8; ++q) w[q] = *(const f32x2*)(W + (size_t)(k + q) * NMOD);
#pragma unroll
            for (int q4 = 0; q4 < 2; ++q4)
#pragma unroll
                for (int r = 0; r < 9; ++r) { const f32x4 c4 = *(const LAS f32x4*)(cond + r * D + k + 4 * q4);
#pragma unroll
                    for (int q = 0; q < 4; ++q) { a0[r] += c4[q] * w[4 * q4 + q][0]; a1[r] += c4[q] * w[4 * q4 + q][1]; } }
        }
#pragma unroll
        for (int r = 0; r < 9; ++r) { red[(wave * 9 + r) * 128 + 2 * lane] = a0[r]; red[(wave * 9 + r) * 128 + 2 * lane + 1] = a1[r]; }
        __syncthreads();
        for (int i = tid; i < 9 * 128; i += 512) { const int r = i >> 7, cc = i & 127; float s2 = 0.f;
#pragma unroll
            for (int w8 = 0; w8 < 8; ++w8) s2 += red[(w8 * 9 + r) * 128 + cc];
            MODV[((size_t)l * 9 + r) * NMOD + cb * 128 + cc] = s2 + mb[cc]; }
        __syncthreads();
    }
#undef ARGF
}
__device__ __forceinline__ void cvt_layer(LAS unsigned char* lds, unsigned char* ws, int lc, int rank, int nranks, int wave, int lane, int part  ) {
#define ARGF(i) ((const float*)ld_arg(lds, (i)))
    const int li = lc >> 1; const bool is_ret = (lc & 1) != 0;
    bf16* WM = (bf16*)(ws + (is_ret ? WS_WB : WS_WA)); bf16* WF = (bf16*)(ws + (is_ret ? WS_WB + 82 * MiB : WS_WA + 22 * MiB));
    LAS float* scr = (LAS float*)(lds + wave * 19456);
    CvtJob J[7]; int nj;
    if (!is_ret) {
        bf16* W1T = WM; bf16* WuqT = W1T + (size_t)N1 * D; bf16* WukvT = WuqT + (size_t)3072 * 512; bf16* WoT = WukvT + (size_t)4096 * 512;
        const float* wdq = ARGF(8) + (size_t)li * D * QR; const float* wdkv = ARGF(11) + (size_t)li * D * (KVR + ROPE);
        J[0] = CvtJob{wdq, nullptr, nullptr, W1T, QR, D, 512, 0, 0, 1.f};
        J[1] = CvtJob{wdkv, nullptr, nullptr, W1T + (size_t)512 * D, KVR + ROPE, D, 512, 0, 0, 1.f};
        J[2] = CvtJob{wdkv, nullptr, nullptr, W1T + (size_t)1024 * D, KVR + ROPE, D, 64, 1, 512, 1.f};
        J[3] = CvtJob{nullptr, nullptr, nullptr, W1T + (size_t)1088 * D, 1, D, 192, 5, 0, 1.f};
        J[4] = CvtJob{ARGF(10) + (size_t)li * QR * 3072, nullptr, ARGF(9) + li * QR, WuqT, 3072, QR, 3072, 2, 0, 0.07216878364870322f * LOG2E};
        J[5] = CvtJob{ARGF(13) + (size_t)li * KVR * 4096, nullptr, ARGF(12) + li * KVR, WukvT, 4096, KVR, 4096, 0, 0, 1.f};
        J[6] = CvtJob{ARGF(14) + (size_t)li * D * D, nullptr, nullptr, WoT, D, D, D, 0, 0, 1.f};
        nj = 7;
    } else {
        bf16* WqkvT = WM; bf16* WgT = WqkvT + (size_t)8192 * D; bf16* WoT = WgT + (size_t)8192 * D;
        J[0] = CvtJob{ARGF(15) + (size_t)li * D * D, nullptr, nullptr, WqkvT, D, D, 2048, 3, 0, 1.f};
        J[1] = CvtJob{ARGF(16) + (size_t)li * D * D, nullptr, nullptr, WqkvT + (size_t)2048 * D, D, D, 2048, 3, 0, 0.0625f};
        J[2] = CvtJob{ARGF(17) + (size_t)li * D * 4096, nullptr, nullptr, WqkvT + (size_t)4096 * D, 4096, D, 4096, 0, 0, 1.f};
        J[3] = CvtJob{ARGF(18) + (size_t)li * D * 4096, ARGF(19) + (size_t)li * D * 4096, nullptr, WgT, 4096, D, 8192, 4, 0, 1.f};
        J[4] = CvtJob{ARGF(20) + (size_t)li * 4096 * D, nullptr, nullptr, WoT, D, 4096, D, 0, 0, 1.f};
        J[5] = CvtJob{nullptr, nullptr, nullptr, nullptr, 1, 64, 0, 5, 0, 1.f};
        J[6] = J[5];
        nj = 5;
    }
    CvtJob F0 = CvtJob{ARGF(23) + (size_t)lc * D * FF, ARGF(24) + (size_t)lc * D * FF, nullptr, WF, FF, D, 11264, 4, 0, 1.f};
    CvtJob F1 = CvtJob{ARGF(27) + (size_t)lc * FF * D, nullptr, nullptr, WF + (size_t)11264 * D, D, FF, D, 0, 0, 1.f};
    if (part == 1) nj = 0;
    const bool ffn = part != 0;
    int total = ffn ? cvt_items(F0) + cvt_items(F1) : 0;
#pragma unroll
    for (int j = 0; j < 7; ++j) if (j < nj) total += cvt_items(J[j]);
#define CVT_FIND(IT, DD) do { int it_ = (IT); bool done_ = false; \
        _Pragma("unroll") for (int j = 0; j < 7; ++j) if (!done_ && j < nj) done_ = cvt_try(J[j], it_, lane, DD); \
        if (ffn) { if (!done_) done_ = cvt_try(F0, it_, lane, DD); if (!done_) done_ = cvt_try(F1, it_, lane, DD); } } while (0)
    if (rank < total) {
        f32x4 v[16], w[16]; CvtDesc d0, d1; int it0 = rank;
        CVT_FIND(it0, d0); cvt_load(d0, lane, v);
        for (;;) {
            const int it1 = it0 + nranks; const bool has = it1 < total;
            if (has) { CVT_FIND(it1, d1); cvt_load(d1, lane, w); }
            cvt_store(d0, lane, v, scr);
            if (!has) break;
#pragma unroll
            for (int i = 0; i < 16; ++i) v[i] = w[i];
            d0 = d1; it0 = it1;
        }
    }
#undef CVT_FIND
#undef ARGF
}

#if MLA_CHECK
constexpr int CW_CHK = 2048;
__device__ __forceinline__ float wave_max(float v, int lane) {
#pragma unroll
    for (int o = 1; o < 64; o <<= 1) v = fmaxf(v, shfl_xor_l(v, o, lane));
    return v;
}
__device__ __forceinline__ void mla_check(LAS unsigned char* lds, unsigned char* ws, int li, int gw, int wave, int lane) {
#define ARGF(i) ((const float*)ld_arg(lds, (i)))
    LAS float* sc = (LAS float*)(lds + wave * 19456);
    const bf16* H = (const bf16*)(ws + WS_H); const bf16* Qb = (const bf16*)(ws + WS_Q); const bf16* KVb = (const bf16*)(ws + WS_KV); const bf16* KRb = (const bf16*)(ws + WS_KR); const bf16* Ob = (const bf16*)(ws + WS_O);
    const int t = (int)(((unsigned)gw * 2654435761u) % (unsigned)MT); const int hd = gw & 15;
    const bool isx = t < MX; const int tt = t & (SEQ - 1);
    float err = 0.f;
    {
        const float* wdq = ARGF(8) + (size_t)li * D * QR; const float* wdkv = ARGF(11) + (size_t)li * D * (KVR + ROPE);
        float ql[8], kl[9];
#pragma unroll
        for (int j = 0; j < 8; ++j) ql[j] = 0.f;
#pragma unroll
        for (int j = 0; j < 9; ++j) kl[j] = 0.f;
        for (int k = 0; k < D; ++k) { const float hv = bf2f(H[(size_t)t * D + k]);
#pragma unroll
            for (int j = 0; j < 8; ++j) ql[j] += hv * wdq[(size_t)k * QR + lane + 64 * j];
#pragma unroll
            for (int j = 0; j < 9; ++j) kl[j] += hv * wdkv[(size_t)k * (KVR + ROPE) + lane + 64 * j]; }
        float sq = 0.f, sk = 0.f;
#pragma unroll
        for (int j = 0; j < 8; ++j) { sq += ql[j] * ql[j]; sk += kl[j] * kl[j]; }
        const float rq = 1.0f / sqrtf(wave_sum(sq, lane) * (1.0f / QR) + NORM_EPS), rk = 1.0f / sqrtf(wave_sum(sk, lane) * (1.0f / KVR) + NORM_EPS);
        const float* qg = ARGF(9) + li * QR; const float* kg = ARGF(12) + li * KVR;
#pragma unroll
        for (int j = 0; j < 8; ++j) { sc[lane + 64 * j] = ql[j] * rq * qg[lane + 64 * j]; sc[512 + lane + 64 * j] = kl[j] * rk * kg[lane + 64 * j]; }
        sc[1024 + lane] = kl[8];
        asm volatile("s_waitcnt lgkmcnt(0)" ::: "memory");
        const float* wuq = ARGF(10) + (size_t)li * QR * 3072 + hd * DQ; const float* wukv = ARGF(13) + (size_t)li * KVR * 4096 + hd * 256;
        float qv[3] = {0.f, 0.f, 0.f}, kv[4] = {0.f, 0.f, 0.f, 0.f};
        for (int c = 0; c < 512; ++c) { const float a = sc[c], bq = sc[512 + c];
#pragma unroll
            for (int j = 0; j < 3; ++j) qv[j] += a * wuq[(size_t)c * 3072 + lane + 64 * j];
#pragma unroll
            for (int j = 0; j < 4; ++j) kv[j] += bq * wukv[(size_t)c * 4096 + lane + 64 * j]; }
#pragma unroll
        for (int j = 0; j < 3; ++j) sc[1100 + lane + 64 * j] = qv[j];
        asm volatile("s_waitcnt lgkmcnt(0)" ::: "memory");
        float qref[3]; float kr_ref = 0.f;
#pragma unroll
        for (int j = 0; j < 3; ++j) { const int d = lane + 64 * j; float v = sc[1100 + d];
            if (d >= NOPE && isx) { const int e = d - NOPE, half = e >> 5, i = e & 15, second = (e >> 4) & 1; const float pos = half ? (float)(tt & 63) : (float)(tt >> 6);
                const float ang = pos * __builtin_amdgcn_exp2f(-(float)(2 * i) * (13.287712379549449f / 32.0f)); const float rev = ang * 0.15915494309189535f; const float fr_ = rev - floorf(rev);
                const float cs = __builtin_amdgcn_cosf(fr_), sn = __builtin_amdgcn_sinf(fr_); const float other = sc[1100 + NOPE + half * 32 + i + (second ? 0 : 16)];
                v = second ? (v * cs + other * sn) : (v * cs - other * sn); }
            qref[j] = v * (0.07216878364870322f * LOG2E); }
        { const int e = lane, half = e >> 5, i = e & 15, second = (e >> 4) & 1; float v = sc[1024 + e];
          if (isx) { const float pos = half ? (float)(tt & 63) : (float)(tt >> 6);
              const float ang = pos * __builtin_amdgcn_exp2f(-(float)(2 * i) * (13.287712379549449f / 32.0f)); const float rev = ang * 0.15915494309189535f; const float fr_ = rev - floorf(rev);
              const float cs = __builtin_amdgcn_cosf(fr_), sn = __builtin_amdgcn_sinf(fr_); const float other = sc[1024 + half * 32 + i + (second ? 0 : 16)];
              v = second ? (v * cs + other * sn) : (v * cs - other * sn); }
          kr_ref = v; }
#pragma unroll
        for (int j = 0; j < 3; ++j) sc[1400 + lane + 64 * j] = qref[j];
        sc[1600 + lane] = kr_ref;
        asm volatile("s_waitcnt lgkmcnt(0)" ::: "memory");
        float mx = 0.f, df = 0.f;
#pragma unroll
        for (int j = 0; j < 3; ++j) { const int p = lane + 64 * j; const int od = p < NOPE ? p : NOPE + ropeperm64(p - NOPE); const float ref = sc[1400 + od]; const float mine = bf2f(Qb[(size_t)t * 3072 + hd * DQ + p]);
            mx = fmaxf(mx, fabsf(ref)); df = fmaxf(df, fabsf(ref - mine)); }
        err = fmaxf(err, wave_max(df, lane) / (wave_max(mx, lane) + 1e-20f));
        mx = 0.f; df = 0.f;
#pragma unroll
        for (int j = 0; j < 4; ++j) { const float ref = kv[j]; const float mine = bf2f(KVb[(size_t)t * 4096 + hd * 256 + lane + 64 * j]); mx = fmaxf(mx, fabsf(ref)); df = fmaxf(df, fabsf(ref - mine)); }
        err = fmaxf(err, wave_max(df, lane) / (wave_max(mx, lane) + 1e-20f));
        { const float ref = sc[1600 + ropeperm64(lane)]; const float mine = bf2f(KRb[(size_t)t * 64 + lane]); err = fmaxf(err, wave_max(fabsf(ref - mine), lane) / (wave_max(fabsf(ref), lane) + 1e-20f)); }
    }
    {
        const int b = isx ? (t >> 12) : ((t - MX) >> 8); const int nk = isx ? 4352 : 256;
        for (int d = lane; d < DQ; d += 64) sc[d] = bf2f(Qb[(size_t)t * 3072 + hd * DQ + d]);
        asm volatile("s_waitcnt lgkmcnt(0)" ::: "memory");
        float mxs = -1e30f;
        for (int j = lane; j < nk; j += 64) { const int row = j < 256 ? MX + b * CTXL + j : b * SEQ + (j - 256); float sdot = 0.f;
            for (int d = 0; d < NOPE; ++d) sdot += sc[d] * bf2f(KVb[(size_t)row * 4096 + hd * 256 + d]);
            for (int d = 0; d < ROPE; ++d) sdot += sc[NOPE + d] * bf2f(KRb[(size_t)row * 64 + d]);
            sc[256 + j] = sdot; mxs = fmaxf(mxs, sdot); }
        mxs = wave_max(mxs, lane); float sum = 0.f;
        for (int j = lane; j < nk; j += 64) { const float p = __builtin_amdgcn_exp2f(sc[256 + j] - mxs); sc[256 + j] = p; sum += p; }
        sum = wave_sum(sum, lane);
        asm volatile("s_waitcnt lgkmcnt(0)" ::: "memory");
        float o0 = 0.f, o1 = 0.f;
        for (int j = 0; j < nk; ++j) { const int row = j < 256 ? MX + b * CTXL + j : b * SEQ + (j - 256); const float p = sc[256 + j];
            o0 += p * bf2f(KVb[(size_t)row * 4096 + hd * 256 + 128 + lane]); o1 += p * bf2f(KVb[(size_t)row * 4096 + hd * 256 + 128 + 64 + lane]); }
        o0 /= sum; o1 /= sum;
        const float m0 = bf2f(Ob[(size_t)t * D + hd * 128 + lane]), m1 = bf2f(Ob[(size_t)t * D + hd * 128 + 64 + lane]);
        const float df = fmaxf(fabsf(o0 - m0), fabsf(o1 - m1)), mx = fmaxf(fabsf(o0), fabsf(o1));
        err = fmaxf(err, wave_max(df, lane) / (wave_max(mx, lane) + 1e-20f));
    }
    if (lane == 0) atomicMax((unsigned*)(ws + WS_CTL) + CW_CHK, __float_as_uint(err));
#undef ARGF
}
#endif
struct Args { const float* in[29]; float* out; unsigned char* ws; int ph_lo, ph_hi; };
constexpr int PH_PER_LAYER = 10, PH_FINAL = 1 + PH_PER_LAYER * DEPTH, PH_COUNT = PH_FINAL + 1;

template <unsigned MK_EN_T>
__global__ void __launch_bounds__(512, 2) mk_fwd(Args args) {
    extern __shared__ __attribute__((aligned(16))) unsigned char lds_raw[];
    LAS unsigned char* lds = (LAS unsigned char*)lds_raw;
    volatile LAS unsigned* MISC = (volatile LAS unsigned*)(lds + MISC_OFF);
    const int G = gridDim.x; const int bx = blockIdx.x; const int vcu = (G % 8 == 0) ? (bx % 8) * (G / 8) + bx / 8 : bx;
    const int NGW = G * 8;
    unsigned char* ws = args.ws; float* X = args.out;
    const int lo = args.ph_lo, hi = args.ph_hi;
    const int wave_s = __builtin_amdgcn_readfirstlane((int)threadIdx.x >> 6);
#define TID() (wave_s * 64 + lane_id())
    { const int tid0 = threadIdx.x;
      for (int u = tid0; u < (LDS_BYTES - CTRL_BASE) / 4; u += 512) ((LAS unsigned*)(lds + CTRL_BASE))[u] = 0u;
      __syncthreads();
      if (tid0 < 29) ((volatile LAS unsigned long long*)(lds + ARGS_OFF))[tid0] = (unsigned long long)args.in[tid0];
      __syncthreads(); }
#define ARGF(i) ((const float*)ld_arg(lds, (i)))
    XcdBarrier bar; bar.bar = (unsigned*)(ws + WS_CTL) + CW_BAR; bar.x = 0; bar.st = nullptr; bar.wave = wave_s;
    if (hi - lo > 1) bar = xcd_barrier_post((unsigned*)(ws + WS_CTL) + CW_BAR, MISC + 8, wave_s);
#if PROBE_TS
    if (bx == 0 && TID() == 0) { ((unsigned long long*)(ws + WS_CTL + 65536))[0] = __builtin_amdgcn_s_memrealtime(); ((unsigned long long*)(ws + WS_CTL + 65536))[121] = ~0ull; }
#endif
#define EN(b) (((MK_EN_T) >> (b)) & 1u)
#define IN(k) (lo <= (k) && (k) < hi)
#if PROBE_TS
#define TS_WORDS ((unsigned long long*)(ws + WS_CTL + 65536))
#define PHASE_END(k) do { if (hi > (k) + 1) xcd_barrier(bar); if (bx == 0 && TID() == 0) TS_WORDS[(k) + 1] = __builtin_amdgcn_s_memrealtime(); } while (0)
#else
#define PHASE_END(k) do { if (hi > (k) + 1) xcd_barrier(bar); } while (0)
#endif
#define PH_IDS int tid = TID(); asm volatile("" : "+v"(tid)); const int lane = tid & 63; const int wave = wave_s; const int gw = vcu * 8 + wave; (void)lane; (void)gw;
#define XC_    ((float*)(ws + WS_XC))
#define MODV_  ((float*)(ws + WS_MODV))
#define TABM_  ((float*)(ws + WS_TABM))
#define TABR_  ((float*)(ws + WS_TABR))
#define SSQ_   ((float*)(ws + WS_SSQ))
#define KR_    ((bf16*)(ws + WS_KR))
#define H_     ((bf16*)(ws + WS_H))
#define WMIX_(ll) ((bf16*)(ws + (((ll) & 1) ? WS_WB : WS_WA)))
#define WFFN_(ll) ((bf16*)(ws + (((ll) & 1) ? WS_WB + 82 * MiB : WS_WA + 22 * MiB)))
#define W1T_   WMIX_(l)
#define WUQT_  (W1T_ + (size_t)N1 * D)
#define WUKVT_ (WUQT_ + (size_t)3072 * 512)
#define WOTM_  (WUKVT_ + (size_t)4096 * 512)
#define WQKVT_ WMIX_(l)
#define WGT_   (WQKVT_ + (size_t)8192 * D)
#define WOTR_  (WGT_ + (size_t)8192 * D)
#define WGUT_  WFFN_(l)
#define WDT_   (WGUT_ + (size_t)11264 * D)
#define QKVL_  ((bf16*)(ws + WS_QKVL))
#define Q_     ((bf16*)(ws + WS_Q))
#define KV_    ((bf16*)(ws + WS_KV))
#define O_     ((bf16*)(ws + WS_O))
#define QKV_   ((bf16*)(ws + WS_QKV))
#define Y_     ((bf16*)(ws + WS_Y))
#define GATED_ ((bf16*)(ws + WS_GATED))
#define GB_    ((bf16*)(ws + WS_G))
#define UB_    ((bf16*)(ws + WS_U))
#define HALO_  ((float*)(ws + WS_G))
#define MODL_  (MODV_ + (size_t)l * 9 * NMOD)

    if (EN(0) && IN(0)) for (int rep_ = 0; rep_ < 1 + (int)((PROBE_MASK >> 0) & 1u); ++rep_) {
        PH_IDS
        mod_layers(lds, ws, 0, 1, bx, G, tid, lane, wave);
        __syncthreads();
        cvt_layer(lds, ws, 0, gw, NGW, wave, lane, 2);
        for (int i = bx * 512 + tid; i < 64 * 16 + SEQ * 128; i += G * 512) {
            float inv, pos; float* dst;
            if (i < 1024) { const int p = i >> 4, f = i & 15; inv = __builtin_amdgcn_exp2f(-(float)(2 * f) * (13.287712379549449f / 32.0f)); pos = (float)p; dst = TABM_ + 2 * i; }
            else { const int j = i - 1024, t = j >> 7, f = j & 127; inv = __builtin_amdgcn_exp2f(-(float)(2 * f) * (13.287712379549449f / 256.0f)); pos = (float)t; dst = TABR_ + 2 * j; }
            const float ang = pos * inv; const double rev = (double)ang * 0.15915494309189535; const float fr = (float)(rev - floor(rev));
            dst[0] = __builtin_amdgcn_cosf(fr); dst[1] = __builtin_amdgcn_sinf(fr);
        }
        PHASE_END(0);
    }

    for (int l = 0; l < DEPTH; ++l) {
        const int P = 1 + PH_PER_LAYER * l; const int li = l >> 1; const bool is_ret = (l & 1) != 0; const bool last = (l == DEPTH - 1);
        const int Mrows = last ? MX : MT;

        if (EN(1) && IN(P + 0)) for (int rep_ = 0; rep_ < 1 + (int)((PROBE_MASK >> 1) & 1u); ++rep_) {
            PH_IDS
            const float* g = ARGF(6) + l * D; const float* xsrc = (l == 0) ? ARGF(0) : X; const float* csrc = (l == 0) ? ARGF(2) : XC_;
            norm_phase(xsrc, csrc, g, MODL_, 0, H_, MT, gw, NGW, lane);
            PHASE_END(P + 0);
        }

        if (!is_ret) {
            if (EN(2) && IN(P + 1)) for (int rep_ = 0; rep_ < 1 + (int)((PROBE_MASK >> 2) & 1u); ++rep_) {
                pg8::Gemm g{H_, W1T_, MT, N1, D, D}; pg8::StaticOrder S; S.init(MT, N1, G, bx); S.tid = TID();
                EpiG1 E{QKVL_, SSQ_, KR_, TABM_};
                pg8::gemm_phase<EpiG1>(lds, g, S, E);
                PHASE_END(P + 1);
            }
            if (EN(3) && IN(P + 2)) for (int rep_ = 0; rep_ < 1 + (int)((PROBE_MASK >> 3) & 1u); ++rep_) {
                { pg8::Gemm g{QKVL_, WUQT_, MT, 3072, QR, N1}; pg8::StaticOrder S; S.init(MT, 3072, G, bx); S.tid = TID(); EpiUq E{Q_, SSQ_, TABM_}; pg8::gemm_phase<EpiUq>(lds, g, S, E); }
                { pg8::Gemm g{QKVL_ + 512, WUKVT_, MT, 4096, KVR, N1}; pg8::StaticOrder S; S.init(MT, 4096, G, bx); S.tid = TID(); EpiUkv E{KV_, SSQ_}; pg8::gemm_phase<EpiUkv>(lds, g, S, E); }
                PHASE_END(P + 2);
            }
            if (EN(4) && IN(P + 3)) for (int rep_ = 0; rep_ < 1 + (int)((PROBE_MASK >> 4) & 1u); ++rep_) {
                const int nun = 2048 + 128;
                for (int ui = vcu; ui < nun; ui += G) {
                    if (ui < 2048) { const int xcd = (ui & 255) >> 5, j = ui & 31, rnd = ui >> 8; const int bh = xcd * 16 + 2 * rnd + (j >> 4), qb = j & 15; const int b = bh >> 4, hd = bh & 15;
                        att::attn_unit(Q_ + (size_t)(b * SEQ + qb * 256) * 3072 + hd * DQ, KV_ + hd * 256, KR_, O_ + (size_t)(b * SEQ + qb * 256) * D + hd * 128, 68, 4, MX + b * CTXL, b * SEQ, (char*)lds_raw, TID()
#if PROBE_TS
                            , bx == 0 ? TS_WORDS : nullptr
#endif
                            );
                    } else { const int bh = ui - 2048, b = bh >> 4, hd = bh & 15;
                        att::attn_unit(Q_ + (size_t)(MX + b * CTXL) * 3072 + hd * DQ, KV_ + hd * 256, KR_, O_ + (size_t)(MX + b * CTXL) * D + hd * 128, 4, 4, MX + b * CTXL, 0, (char*)lds_raw, TID()); }
                }
                PHASE_END(P + 3);
            }
        } else {
            if (EN(5) && IN(P + 1)) for (int rep_ = 0; rep_ < 1 + (int)((PROBE_MASK >> 5) & 1u); ++rep_) {
                pg8::Gemm g{H_, WQKVT_, MT, 8192, D, D}; pg8::StaticOrder S; S.init(MT, 8192, G, bx); S.tid = TID();
                EpiQKV E{QKV_, TABR_};
                pg8::gemm_phase<EpiQKV>(lds, g, S, E);
                PHASE_END(P + 1);
            }
            if (EN(6) && IN(P + 2)) for (int rep_ = 0; rep_ < 1 + (int)((PROBE_MASK >> 6) & 1u); ++rep_) {
                for (int ui = vcu; ui < 256; ui += G) {
                    const int bh = ui >> 2, dir = (ui >> 1) & 1, dvh = ui & 1; const int b = bh >> 3, hd = bh & 7;
                    const float dec = (dir ? ARGF(22) : ARGF(21))[li * RH + hd];
                    const float lg2 = -__expf(dec) * LOG2E;
                    scan::scan_unit(QKV_, Y_ + (size_t)dir * MT * 4096, b, hd, dir, dvh, lg2, last, lds, TID()
#if PROBE_TS
                                    , TS_WORDS
#endif
                                    );
                }
                PHASE_END(P + 2);
            }
            if (EN(7) && IN(P + 3)) for (int rep_ = 0; rep_ < 1 + (int)((PROBE_MASK >> 7) & 1u); ++rep_) {
                PH_IDS
                for (int row = gw; row < Mrows; row += NGW) {
                    u32x4 w[16];
#pragma unroll
                    for (int q = 0; q < 16; ++q) w[q] = *(const u32x4*)(Y_ + (size_t)(q >> 3) * MT * 4096 + (size_t)row * 4096 + (q & 7) * RDV + lane * 8);
                    float mu[16], rs[16];
#pragma unroll
                    for (int q = 0; q < 16; ++q) { const float s = ((bflo(w[q].x) + bfhi(w[q].x)) + (bflo(w[q].y) + bfhi(w[q].y))) + ((bflo(w[q].z) + bfhi(w[q].z)) + (bflo(w[q].w) + bfhi(w[q].w))); mu[q] = s; }
#pragma unroll
                    for (int o = 1; o < 64; o <<= 1)
#pragma unroll
                        for (int q = 0; q < 16; ++q) mu[q] += shfl_xor_l(mu[q], o, lane);
#pragma unroll
                    for (int q = 0; q < 16; ++q) { mu[q] *= (1.0f / RDV); const float m_ = mu[q];
                        const float d0 = bflo(w[q].x) - m_, d1 = bfhi(w[q].x) - m_, d2 = bflo(w[q].y) - m_, d3 = bfhi(w[q].y) - m_, d4 = bflo(w[q].z) - m_, d5 = bfhi(w[q].z) - m_, d6 = bflo(w[q].w) - m_, d7 = bfhi(w[q].w) - m_;
                        rs[q] = ((d0 * d0 + d1 * d1) + (d2 * d2 + d3 * d3)) + ((d4 * d4 + d5 * d5) + (d6 * d6 + d7 * d7)); }
#pragma unroll
                    for (int o = 1; o < 64; o <<= 1)
#pragma unroll
                        for (int q = 0; q < 16; ++q) rs[q] += shfl_xor_l(rs[q], o, lane);
                    float mo = 0.f, ro = 0.f;
#pragma unroll
                    for (int q = 0; q < 16; ++q) { if (lane == q) { mo = mu[q]; ro = rs[q]; } }
                    if (lane < 16) *(f32x2*)((float*)(ws + WS_STATS) + ((size_t)((lane >> 3) * MT + row) * 8 + (lane & 7)) * 2) = (f32x2){mo, 1.0f / sqrtf(ro * (1.0f / RDV) + GN_EPS)};
                }
                PHASE_END(P + 3);
            }
            if (EN(8) && IN(P + 4)) for (int rep_ = 0; rep_ < 1 + (int)((PROBE_MASK >> 8) & 1u); ++rep_) {
                pg8::Gemm g{H_, WGT_, Mrows, 8192, D, D}; pg8::StaticOrder S; S.init(Mrows, 8192, G, bx); S.tid = TID();
                EpiGate E{GATED_, Y_, Y_ + (size_t)MT * 4096, (const float*)(ws + WS_STATS)};
                pg8::gemm_phase<EpiGate>(lds, g, S, E);
                PHASE_END(P + 4);
            }
        }
        if (EN(9) && IN(P + 5)) for (int rep_ = 0; rep_ < 1 + (int)((PROBE_MASK >> 9) & 1u); ++rep_) {
#if MLA_CHECK
            if (l == MLA_CHECK_LAYER) { PH_IDS mla_check(lds, ws, li, gw, wave, lane); __syncthreads(); }
#endif
            pg8::Gemm g = is_ret ? pg8::Gemm{GATED_, WOTR_, Mrows, D, 4096, 4096} : pg8::Gemm{O_, WOTM_, Mrows, D, D, D};
            pg8::StaticOrder S; S.init(Mrows, D, G, bx, 4, true); S.tid = TID();
#if PROBE_TS
            S.probe = is_ret ? 2 : 1; S.tsw = TS_WORDS;
#endif
            const float* xsrc = (l == 0) ? ARGF(0) : X; const float* csrc = (l == 0) ? ARGF(2) : XC_;
            EpiResid E{xsrc, X, csrc, XC_, MODL_, 2 * D};
            pg8::gemm_phase<EpiResid>(lds, g, S, E);
            if (l + 1 < DEPTH) {
                PH_IDS
                const int nwg = (Mrows / 256) * (D / 256), rem = nwg % G;
                if (rem == 0) cvt_layer(lds, ws, l + 1, gw, NGW, wave, lane, 0);
                else if (bx >= rem) cvt_layer(lds, ws, l + 1, (bx - rem) * 8 + wave, (G - rem) * 8, wave, lane, 0);
            }
            PHASE_END(P + 5);
        }
        if (EN(10) && IN(P + 6)) for (int rep_ = 0; rep_ < 1 + (int)((PROBE_MASK >> 10) & 1u); ++rep_) {
            PH_IDS
            const float* g = ARGF(7) + l * D;
            norm_phase(X, XC_, g, MODL_, 3, H_, Mrows, gw, NGW, lane);
            PHASE_END(P + 6);
        }
        if (EN(11) && IN(P + 7)) for (int rep_ = 0; rep_ < 1 + (int)((PROBE_MASK >> 11) & 1u); ++rep_) {
            pg8::Gemm g{H_, WGUT_, Mrows, 11264, D, D}; pg8::StaticOrder S; S.init(Mrows, 11264, G, bx); S.tid = TID();
#if PROBE_TS
            S.probe = 4; S.tsw = TS_WORDS;
#endif
            EpiGUConv E{UB_, HALO_, ARGF(25) + (size_t)l * 3 * FF, ARGF(26) + (size_t)l * FF, (LAS float*)(lds + EDGE_OFF)};
            pg8::gemm_phase<EpiGUConv>(lds, g, S, E);
#if PROBE_TS
            if (TID() == 0 && bx == 0) TS_WORDS[140 + l] = __builtin_amdgcn_s_memrealtime();
            if (TID() == 0 && bx == G - 1) TS_WORDS[148 + l] = __builtin_amdgcn_s_memrealtime();
#endif
            PHASE_END(P + 7);
        }
        if (EN(13) && IN(P + 9)) for (int rep_ = 0; rep_ < 1 + (int)((PROBE_MASK >> 13) & 1u); ++rep_) {
            pg8::Gemm g{UB_, WDT_, Mrows, D, FF, FF}; pg8::StaticOrder S; S.init(Mrows, D, G, bx, 4, true); S.tid = TID();
#if PROBE_TS
            S.probe = 3; S.tsw = TS_WORDS;
#endif
            {
                PH_IDS
                const float* cw = ARGF(25) + (size_t)l * 3 * FF; const float* HL = HALO_; bf16* ACT = UB_;
                pg8::Unit uu; int prev_pm = -1;
                for (int i = 0; S.next(i, uu); ++i) { const int pm = uu.pm; if (pm == prev_pm || pm >= MX / 256) { prev_pm = pm; continue; } prev_pm = pm;
                    const bool top = (pm & 15) != 0, bot = ((pm + 1) & 15) != 0;
                    for (int q = tid; q < FF / 4; q += 512) { const int f = q * 4;
                        if (top) { const float* t0 = HL + (size_t)((pm * 2 + 0) * 3) * HALO_STRIDE + f; const float* b1 = HL + (size_t)(((pm - 1) * 2 + 1) * 3) * HALO_STRIDE + f;
                            const f32x4 o = silu4(*(const f32x4*)t0 + *(const f32x4*)(cw + f) * *(const f32x4*)(b1 + HALO_STRIDE)) * *(const f32x4*)(t0 + 2 * HALO_STRIDE);
                            u32x2 w; w.x = cvt_pk_bf16(o[0], o[1]); w.y = cvt_pk_bf16(o[2], o[3]); *(u32x2*)(ACT + (size_t)(pm * 256) * FF + f) = w; }
                        if (bot) { const float* b0 = HL + (size_t)((pm * 2 + 1) * 3) * HALO_STRIDE + f; const float* t1 = HL + (size_t)(((pm + 1) * 2 + 0) * 3) * HALO_STRIDE + f;
                            const f32x4 o = silu4(*(const f32x4*)b0 + *(const f32x4*)(cw + 2 * FF + f) * *(const f32x4*)(t1 + HALO_STRIDE)) * *(const f32x4*)(b0 + 2 * HALO_STRIDE);
                            u32x2 w; w.x = cvt_pk_bf16(o[0], o[1]); w.y = cvt_pk_bf16(o[2], o[3]); *(u32x2*)(ACT + (size_t)(pm * 256 + 255) * FF + f) = w; } } }
                asm volatile("s_waitcnt vmcnt(0)" ::: "memory"); __syncthreads();
            }
            EpiResid E{X, X, XC_, XC_, MODL_, 5 * D};
            pg8::gemm_phase<EpiResid>(lds, g, S, E);
#if PROBE_TS
            if (TID() == 0 && bx == 0) TS_WORDS[64 + l] = __builtin_amdgcn_s_memrealtime();
            if (TID() == 0 && bx == G - 1) TS_WORDS[72 + l] = __builtin_amdgcn_s_memrealtime();
#endif
            if (l + 1 < DEPTH) {
                PH_IDS
                const int nwg = (Mrows / 256) * (D / 256), rem = nwg % G;
                if (rem == 0) { mod_layers(lds, ws, l + 1, l + 2, bx, G, tid, lane, wave); __syncthreads(); cvt_layer(lds, ws, l + 1, gw, NGW, wave, lane, 1); }
                else if (bx >= rem) { mod_layers(lds, ws, l + 1, l + 2, bx - rem, G - rem, tid, lane, wave); __syncthreads(); cvt_layer(lds, ws, l + 1, (bx - rem) * 8 + wave, (G - rem) * 8, wave, lane, 1); }
            }
#if PROBE_TS
            __syncthreads(); if (TID() == 0 && bx == G - 1) TS_WORDS[80 + l] = __builtin_amdgcn_s_memrealtime();
#endif
            PHASE_END(P + 9);
        }
    }
    if (EN(14) && IN(PH_FINAL)) for (int rep_ = 0; rep_ < 1 + (int)((PROBE_MASK >> 14) & 1u); ++rep_) {
        PH_IDS
        const float* g = ARGF(28);
#if PROBE_TS
        float ts_c = 0.f, ts_a = 0.f;
        { const unsigned long long* TS = (const unsigned long long*)(ws + WS_CTL + 65536); unsigned long long last = TS[0]; const unsigned long long t0 = last; float d1 = 0.f, d2 = 0.f;
          for (int k = 0; k < PH_FINAL; ++k) { const unsigned long long te = TS[k + 1]; if (te == 0ull) continue; const float d = (float)(te - last); last = te;
              int cls; if (k == 0) cls = 0; else { const int slot = (k - 1) % PH_PER_LAYER, ll = (k - 1) / PH_PER_LAYER; const bool ret = (ll & 1) != 0;
                  cls = slot == 0 ? 1 : slot >= 5 ? 5 + slot : (!ret ? 1 + slot : 4 + slot); }
              if (k > 0 && ((k - 1) % PH_PER_LAYER) == 5) { const bool ret5 = (((k - 1) / PH_PER_LAYER) & 1) != 0; if (TS_CLASS1 == (ret5 ? 51 : 50)) d1 += d; if (TS_CLASS2 == (ret5 ? 51 : 50)) d2 += d; }
              if (cls == TS_CLASS1) d1 += d; if (cls == TS_CLASS2) d2 += d; }
          float tot = (float)(last - t0);
          if (TS_CLASS1 >= 100) { float ph = 0.f, x0 = 0.f, x1 = 0.f, x2 = 0.f;
              for (int ll = 0; ll < 3; ++ll) { const unsigned long long st = TS[(1 + PH_PER_LAYER * ll + 7) + 1], en = TS[(1 + PH_PER_LAYER * ll + 9) + 1];
                  ph += (float)(en - st); x0 += (float)(TS[64 + ll] - st); x1 += (float)(TS[72 + ll] - st); x2 += (float)(TS[80 + ll] - st); }
              d1 = (TS_CLASS1 == 100) ? x0 : (TS_CLASS1 == 101) ? x1 : x2; d2 = (TS_CLASS2 == 100) ? x0 : (TS_CLASS2 == 101) ? x1 : x2; tot = ph; }
          if (TS_CLASS1 >= 200) { const unsigned long long* tw = TS + 90 + 3 * (TS_CLASS1 - 201); const float lp = (float)tw[0], ep = (float)tw[1], nn = (float)tw[2];
              d1 = lp; tot = lp + ep; d2 = (lp + ep) / nn / 100.f / 200.f * tot; }
          if (TS_CLASS1 == 400) { float ph = 0.f, x0 = 0.f, x1 = 0.f;
              for (int ll = 0; ll < 4; ++ll) { const unsigned long long st = TS[(1 + PH_PER_LAYER * ll + 6) + 1], en = TS[(1 + PH_PER_LAYER * ll + 7) + 1];
                  ph += (float)(en - st); x0 += (float)(TS[140 + ll] - st); x1 += (float)(TS[148 + ll] - st); }
              d1 = x0; d2 = x1; tot = ph; }
          if (TS_CLASS1 == 500) { d1 = (float)TS[160]; d2 = (float)TS[161]; tot = (float)TS[162]; }
          if (TS_CLASS1 == 501) { d1 = (float)TS[162] / (float)TS[163] / 100.f / 5.f; d2 = 0.f; tot = 1.f; }
          if (TS_CLASS1 == 600) { d1 = (float)TS[170]; d2 = (float)TS[171]; tot = (float)TS[172]; }
          if (TS_CLASS1 == 300) { const float mx = (float)TS[120], sm = (float)TS[122]; d1 = sm / (float)(gridDim.x * 4); tot = mx > 0.f ? mx : 1.f; d2 = 0.f; }
          { const float q1 = rintf(d1 / tot * 20.f) / 20.f, q2 = rintf(d2 / tot * 20.f) / 20.f; ts_c = sqrtf(q1); ts_a = 2.0f + 10.0f * q2; }
        }
#endif
#if MLA_CHECK
        const bool chk_bad = __uint_as_float(__hip_atomic_load((unsigned*)(ws + WS_CTL) + CW_CHK, __ATOMIC_RELAXED, __HIP_MEMORY_SCOPE_AGENT)) > MLA_CHECK_TOL;
#endif
        if (gw < MX) {
            f32x4 v[8], vn[8]; int m = gw; row_load(X + (size_t)m * D, lane, v);
            for (;;) {
                const int mn = m + NGW; const bool has = mn < MX;
                if (has) row_load(X + (size_t)mn * D, lane, vn);
                float s = 0.f;
#pragma unroll
                for (int j = 0; j < 8; ++j) s += (v[j][0] * v[j][0] + v[j][1] * v[j][1]) + (v[j][2] * v[j][2] + v[j][3] * v[j][3]);
                const float rstd = 1.0f / sqrtf(wave_sum(s, lane) * (1.0f / D) + NORM_EPS);
                float* xr = X + (size_t)m * D;
#pragma unroll
                for (int j = 0; j < 8; ++j) { const int c = 4 * lane + 256 * j; f32x4 o_ = (v[j] * rstd) * *(const f32x4*)(g + c);
#if MLA_CHECK
                    if (chk_bad) o_ = (f32x4){__builtin_nanf(""), __builtin_nanf(""), __builtin_nanf(""), __builtin_nanf("")};
#endif
#if PROBE_TS
                    if (m < 328) { o_ = o_ + ts_c; if (m == 0 && c == 0) o_[0] += ts_a - ts_c; }
#endif
                    *(f32x4*)(xr + c) = o_; }
                if (!has) break;
#pragma unroll
                for (int j = 0; j < 8; ++j) v[j] = vn[j];
                m = mn;
            }
        }
    }
#undef IN
#undef PHASE_END
}

#if !MK_SINGLE
typedef void (*KernFn)(Args);
static KernFn phase_kernel(int bit) {
    switch (bit) {
        case 0: return mk_fwd<1u << 0>;  case 1: return mk_fwd<1u << 1>;  case 2: return mk_fwd<1u << 2>;  case 3: return mk_fwd<1u << 3>;
        case 4: return mk_fwd<1u << 4>;  case 5: return mk_fwd<1u << 5>;  case 6: return mk_fwd<1u << 6>;  case 7: return mk_fwd<1u << 7>;
        case 8: return mk_fwd<1u << 8>;  case 9: return mk_fwd<1u << 9>;  case 10: return mk_fwd<1u << 10>; case 11: return mk_fwd<1u << 11>;
        case 12: return mk_fwd<1u << 12>; case 13: return mk_fwd<1u << 13>; default: return mk_fwd<1u << 14>;
    }
}
static int phase_bit(int p) {
    if (p == 0) return 0; if (p == PH_FINAL) return 14;
    const int l = (p - 1) / PH_PER_LAYER, slot = (p - 1) % PH_PER_LAYER; const bool ret = (l & 1) != 0;
    if (slot == 0) return 1;
    if (slot >= 5) return 4 + slot;
    if (!ret) return slot == 4 ? -1 : 1 + slot;
    return 4 + slot;
}
#endif
extern "C" void kernel_launch(void* const* d_in, const int* in_sizes, int n_in, void* d_out, int out_size, void* d_ws, size_t ws_size, hipStream_t stream) {
    static int grid = 0;
    if (grid == 0) {
        if (n_in != 29 || out_size != MX * D || ws_size < WS_END) { fprintf(stderr, "kernel_launch: unexpected shapes: n_in %d out %d ws %zu (need %zu)\n", n_in, out_size, ws_size, (size_t)WS_END); grid = -1; return; }
        int dev = 0, cus = 0;
        if (hipGetDevice(&dev) != hipSuccess || hipDeviceGetAttribute(&cus, hipDeviceAttributeMultiprocessorCount, dev) != hipSuccess) { grid = -1; return; }
#if MK_SINGLE
        if (hipFuncSetAttribute((const void*)mk_fwd<0xFFFFFFFFu>, hipFuncAttributeMaxDynamicSharedMemorySize, LDS_BYTES) != hipSuccess) { fprintf(stderr, "kernel_launch: hipFuncSetAttribute failed\n"); grid = -1; return; }
#else
        for (int b = 0; b < 15; ++b) if (hipFuncSetAttribute((const void*)phase_kernel(b), hipFuncAttributeMaxDynamicSharedMemorySize, LDS_BYTES) != hipSuccess) { fprintf(stderr, "kernel_launch: hipFuncSetAttribute failed\n"); grid = -1; return; }
#endif
        (void)hipGetLastError();
        grid = cus;
    }
    if (grid < 0) return;
    if (hipMemsetAsync((char*)d_ws + WS_CTL, 0, CTL_BYTES, stream) != hipSuccess) return;
    Args a{};
    for (int i = 0; i < 29; ++i) a.in[i] = (const float*)d_in[i];
    a.out = (float*)d_out; a.ws = (unsigned char*)d_ws;
#if MK_SINGLE
    a.ph_lo = 0; a.ph_hi = PH_COUNT;
    hipLaunchKernelGGL(mk_fwd<0xFFFFFFFFu>, dim3(grid), dim3(512), LDS_BYTES, stream, a);
#else
    for (int p = 0; p < PH_COUNT; ++p) {
        const int bit = phase_bit(p); if (bit < 0) continue;
        a.ph_lo = p; a.ph_hi = p + 1;
        hipLaunchKernelGGL(phase_kernel(bit), dim3(grid), dim3(512), LDS_BYTES, stream, a);
    }
#endif
    const hipError_t le = hipPeekAtLastError();
    if (le != hipSuccess) fprintf(stderr, "kernel_launch: launch failed: %s\n", hipGetErrorName(le));
}
```

```cpp
#include <hip/hip_runtime.h>
#include <cstdio>
#include <cstdint>

#ifndef MK_SINGLE
#define MK_SINGLE 1
#endif

#ifndef MK_STAGGER
#define MK_STAGGER 0
#endif
#ifndef PROBE_EPI2
#define PROBE_EPI2 0
#endif
#ifndef MLA_CHECK
#define MLA_CHECK 0
#endif
#ifndef MLA_CHECK_LAYER
#define MLA_CHECK_LAYER 0
#endif
#ifndef MLA_CHECK_TOL
#define MLA_CHECK_TOL 0.03f
#endif
#ifndef PROBE_TS
#define PROBE_TS 0
#endif
#ifndef TS_SKEW_ID
#define TS_SKEW_ID 4
#endif
#ifndef TS_CLASS1
#define TS_CLASS1 0
#endif
#ifndef TS_CLASS2
#define TS_CLASS2 1
#endif
#ifndef PROBE_MASK
#define PROBE_MASK 0u
#endif
#define GAS __attribute__((address_space(1)))
#define LAS __attribute__((address_space(3)))
typedef unsigned short bf16;
typedef short bf16x8 __attribute__((ext_vector_type(8)));
typedef short s16x4 __attribute__((ext_vector_type(4)));
typedef float f32x2 __attribute__((ext_vector_type(2)));
typedef float f32x4 __attribute__((ext_vector_type(4)));
typedef float f32x16 __attribute__((ext_vector_type(16)));
typedef unsigned u32x2 __attribute__((ext_vector_type(2)));
typedef unsigned u32x4 __attribute__((ext_vector_type(4)));
typedef GAS unsigned gu32;

constexpr int D = 2048, NB = 8, SEQ = 4096, CTXL = 256, DEPTH = 4;
constexpr int MX = NB * SEQ, MC = NB * CTXL, MT = MX + MC;
constexpr int FF = 5632, NMOD = 6 * D;
constexpr int MLA_H = 16, QR = 512, KVR = 512, NOPE = 128, ROPE = 64, DQ = 192;
constexpr int N1 = 1280;
constexpr int RH = 8, RDK = 256, RDV = 512;
constexpr float NORM_EPS = 1e-6f, GN_EPS = 1e-5f;
constexpr float LOG2E = 1.4426950408889634f;

constexpr size_t MiB = 1u << 20;
constexpr size_t WS_CTL = 0, CTL_BYTES = 1 * MiB;
constexpr size_t WS_MODV = 1 * MiB;
constexpr size_t WS_TABM = 3 * MiB;
constexpr size_t WS_TABR = 4 * MiB;
constexpr size_t WS_SSQ = 8 * MiB;
constexpr size_t WS_XC = 12 * MiB;
constexpr size_t WS_KR = 28 * MiB;
constexpr size_t WS_STATS = 33 * MiB;
constexpr size_t WS_WA = 40 * MiB;
constexpr size_t WS_WB = 128 * MiB;
constexpr size_t WS_H = 276 * MiB;
constexpr size_t WS_BIG = 412 * MiB;
constexpr size_t WS_QKVL = WS_BIG, WS_Q = WS_BIG + 88 * MiB, WS_KV = WS_BIG + 292 * MiB, WS_O = WS_BIG + 564 * MiB;
constexpr size_t WS_QKV = WS_BIG, WS_Y = WS_BIG + 544 * MiB, WS_GATED = WS_BIG;
constexpr size_t WS_G = WS_BIG, WS_U = WS_BIG + 374 * MiB;
constexpr size_t WS_END = WS_BIG + 1088 * MiB;
static_assert((size_t)MT * 8192 * 2 <= 544 * MiB && (size_t)MT * 5632 * 2 <= 374 * MiB && (size_t)MT * N1 * 2 <= 88 * MiB, "ws map");

constexpr int CW_BAR = 4096;

constexpr int RING_BYTES = 131072, CTRL_BASE = 155648, MISC_OFF = CTRL_BASE + 320, ARGS_OFF = CTRL_BASE + 1024, EDGE_OFF = CTRL_BASE + 4096, LDS_BYTES = 163840;

__device__ __forceinline__ unsigned cvt_pk_bf16(float lo, float hi) { unsigned r; asm volatile("v_cvt_pk_bf16_f32 %0, %1, %2" : "=v"(r) : "v"(lo), "v"(hi)); return r; }
__device__ __forceinline__ float bf2f(unsigned short b) { return __uint_as_float((unsigned)b << 16); }
__device__ __forceinline__ float bflo(unsigned w) { return __uint_as_float(w << 16); }
__device__ __forceinline__ float bfhi(unsigned w) { return __uint_as_float(w & 0xffff0000u); }
__device__ __forceinline__ float shfl_xor_l(float v, int mask, int lane) { return __builtin_bit_cast(float, __builtin_amdgcn_ds_bpermute((lane ^ mask) << 2, __builtin_bit_cast(int, v))); }
__device__ __forceinline__ float fast_silu(float x) { return x * __builtin_amdgcn_rcpf(1.0f + __builtin_amdgcn_exp2f(-x * LOG2E)); }

__device__ __forceinline__ int lane_id() { int x; asm volatile("v_mbcnt_lo_u32_b32 %0, -1, 0\n\tv_mbcnt_hi_u32_b32 %0, -1, %0" : "=v"(x)); return x; }
__device__ __forceinline__ void glds16_s(const void* sbase, unsigned voff, unsigned lds_dst) {
    unsigned keep;
    asm volatile("s_mov_b32 %0, m0\n\ts_mov_b32 m0, %3\n\ts_nop 0\n\tglobal_load_lds_dwordx4 %1, %2\n\ts_mov_b32 m0, %0" : "=&s"(keep) : "v"(voff), "s"(sbase), "s"(lds_dst) : "memory");
}
__device__ __forceinline__ const char* uni_ptr(const void* p) {
    const unsigned long long v = (unsigned long long)p; const unsigned lo = __builtin_amdgcn_readfirstlane((unsigned)v), hi = __builtin_amdgcn_readfirstlane((unsigned)(v >> 32));
    return (const char*)(((unsigned long long)hi << 32) | lo);
}
namespace pg8 {
constexpr int BM = 256, BK = 64, HALF = 128, HTB = HALF * BK * 2, STAGE_BYTES = 8 * HTB, NXCD = 8, WGM = 8;
__host__ __device__ __forceinline__ int lds_byte(int r, int c) { const int st = (r >> 4) * 2 + (c >> 5), rr = r & 15, cc = c & 31, ob = rr * 64 + cc * 2; return st * 1024 + (ob ^ (((ob >> 9) & 1) << 5)); }
__host__ __device__ __forceinline__ void stage_rc(int b, int& R, int& C) { const int st = b / 1024, sb = b % 1024, swz = sb ^ (((sb >> 9) & 1) << 5); R = (st >> 1) * 16 + swz / 64; C = (st & 1) * 32 + (swz % 64) / 2; }
__host__ __device__ __forceinline__ int perm32(int rho) { const int n = rho >> 4, i = rho & 15; return 8 * (i >> 2) + 4 * n + (i & 3); }
struct Unit { int pm, pn; };
struct Gemm { const bf16* A; const bf16* Bt; int M, N, K, lda; };
struct StaticOrder {
    int nM, nN, nwg, G, c, wgm, delay = 0, probe = 0, tid = 0; bool rev; unsigned long long* tsw = nullptr;
    __device__ __forceinline__ void init(int M, int N, int G_, int c_, int wgm_ = WGM, bool rev_ = false) { nM = M / BM; nN = N / BM; nwg = nM * nN; G = G_; c = c_; wgm = wgm_; rev = rev_; }
    __device__ __forceinline__ bool next(int i, Unit& u) const {
        const long L = (long)i * G + c; if (L >= nwg) return false;
        int wgid = (int)L; { const int q = nwg / NXCD, r = nwg % NXCD, xcd = wgid % NXCD, off = wgid / NXCD; wgid = (xcd < r ? xcd * (q + 1) : r * (q + 1) + (xcd - r) * q) + off; }
        const int nig = wgm * nN, gid = wgid / nig, fm = gid * wgm, gsz = (nM - fm) < wgm ? (nM - fm) : wgm;
        u.pm = fm + ((wgid % nig) % gsz); u.pn = (wgid % nig) / gsz; if (rev) u.pm = nM - 1 - u.pm; return true;
    }
};
template <class Epi>
__device__ __forceinline__ void gemm_phase(LAS unsigned char* lds, const Gemm g, const StaticOrder& S, const Epi& E) {
    int tid = S.tid; asm volatile("" : "+v"(tid));
    const int wid = __builtin_amdgcn_readfirstlane(tid >> 6), lane = tid & 63, wr = wid >> 2, wc = wid & 3, fr = lane & 15, fq = lane >> 4;
    const int K = g.K, nt = K / BK;
    unsigned voffA[2], voffB[2];
#pragma unroll
    for (int i = 0; i < 2; ++i) { int R, C; stage_rc(tid * 16 + i * 8192, R, C); const int Rb = Epi::PERM ? ((R & ~31) + perm32(R & 31)) : R;
        voffA[i] = (unsigned)(R * g.lda + C) * 2u; voffB[i] = (unsigned)(Rb * K + C) * 2u; }
    const size_t kstep = (size_t)(BK * 2);
    const size_t hstepA = (size_t)HALF * g.lda * 2, hstepB = (size_t)HALF * K * 2;
    const size_t tstepA = 2 * hstepA, tstepB = 2 * hstepB;
    const unsigned ldsbase = (unsigned)__builtin_amdgcn_readfirstlane((unsigned)(uintptr_t)lds + (unsigned)wid * 1024u);
    const int aoff = lds_byte(wr * 64 + fr, fq * 8), boff = lds_byte(wc * 32 + fr, fq * 8);
#define PG8_SA(b, h) (((b) * 2 + (h)) * HTB)
#define PG8_SB(b, h) ((4 + (b) * 2 + (h)) * HTB)
#define PG8_STAGE(bufoff, gbase, voff) do { const char* _gb = uni_ptr(gbase); _Pragma("unroll") for (int _i = 0; _i < 2; ++_i) \
        glds16_s(_gb, (voff)[_i], ldsbase + (unsigned)((bufoff) + _i * 8192)); } while (0)
#define PG8_LDA(dst, b, h) do { _Pragma("unroll") for (int m = 0; m < 4; ++m) _Pragma("unroll") for (int k = 0; k < 2; ++k) dst[m][k] = *(const LAS bf16x8*)(lds + PG8_SA(b, h) + aoff + m * 2048 + k * 1024); } while (0)
#define PG8_LDB(dst, b, h) do { _Pragma("unroll") for (int n = 0; n < 2; ++n) _Pragma("unroll") for (int k = 0; k < 2; ++k) dst[n][k] = *(const LAS bf16x8*)(lds + PG8_SB(b, h) + boff + n * 2048 + k * 1024); } while (0)
#define PG8_MMA(ai, bj, At, Bt) do { __builtin_amdgcn_s_setprio(1); _Pragma("unroll") for (int m = 0; m < 4; ++m) _Pragma("unroll") for (int n = 0; n < 2; ++n) _Pragma("unroll") for (int k = 0; k < 2; ++k) \
        acc[ai][bj][m][n] = __builtin_amdgcn_mfma_f32_16x16x32_bf16(Bt[n][k], At[m][k], acc[ai][bj][m][n], 0, 0, 0); __builtin_amdgcn_s_setprio(0); } while (0)
#define PG8_WAIT_V(n) asm volatile("s_waitcnt vmcnt(" #n ")" ::: "memory")
#define PG8_WAIT_L(n) asm volatile("s_waitcnt lgkmcnt(" #n ")" ::: "memory")
#define PG8_BAR __builtin_amdgcn_s_barrier()
#define PG8_SCHED __builtin_amdgcn_sched_barrier(0)
    Unit cur, nxt; int ui = 0;
    if (!S.next(0, cur)) return;
    if (S.delay) { const unsigned long long t0 = __builtin_amdgcn_s_memrealtime(); while (__builtin_amdgcn_s_memrealtime() - t0 < (unsigned long long)S.delay) __builtin_amdgcn_s_sleep(8); }
#if MK_STAGGER
    if (S.c & 1) {
        const unsigned long long t0 = __builtin_amdgcn_s_memrealtime(); const unsigned long long dt = (unsigned long long)nt * MK_STAGGER;
        while (__builtin_amdgcn_s_memrealtime() - t0 < dt) __builtin_amdgcn_s_sleep(8);
    }
#endif
    f32x4 acc[2][2][4][2];
#pragma unroll
    for (int a = 0; a < 2; ++a)
#pragma unroll
        for (int b = 0; b < 2; ++b)
#pragma unroll
            for (int m = 0; m < 4; ++m)
#pragma unroll
                for (int n = 0; n < 2; ++n) acc[a][b][m][n] = (f32x4){0.f, 0.f, 0.f, 0.f};
    bf16x8 At[4][2], B0[2][2], B1[2][2];
    const char* cA = (const char*)g.A + (size_t)cur.pm * tstepA; const char* cB = (const char*)g.Bt + (size_t)cur.pn * tstepB;
    PG8_STAGE(PG8_SB(0, 0), cB, voffB); PG8_STAGE(PG8_SB(0, 1), cB + hstepB, voffB); PG8_STAGE(PG8_SA(0, 0), cA, voffA); PG8_STAGE(PG8_SA(0, 1), cA + hstepA, voffA);
    if (wr == 1) PG8_BAR;
    PG8_WAIT_V(2); PG8_BAR;
    PG8_STAGE(PG8_SB(1, 0), cB + kstep, voffB); PG8_STAGE(PG8_SA(1, 0), cA + kstep, voffA); PG8_STAGE(PG8_SB(1, 1), cB + hstepB + kstep, voffB);
    PG8_WAIT_V(6); PG8_BAR;
#if PROBE_TS
    unsigned long long pt_loop = 0, pt_epi = 0, pt_n = 0, pt_t0 = __builtin_amdgcn_s_memrealtime();
#endif
    for (;;) {
        const bool has_next = S.next(ui + 1, nxt);
        const char* nA = has_next ? (const char*)g.A + (size_t)nxt.pm * tstepA : cA; const char* nB = has_next ? (const char*)g.Bt + (size_t)nxt.pn * tstepB : cB;
        for (int t = 0; t < nt; t += 2) {
            const bool last = (t == nt - 2);
            const char* a1 = cA + (size_t)(t + 1) * kstep;
            const char* a2 = last ? nA : cA + (size_t)(t + 2) * kstep; const char* b2 = last ? nB : cB + (size_t)(t + 2) * kstep;
            const char* a3 = a2 + kstep; const char* b3 = b2 + kstep;
            PG8_LDB(B0, 0, 0); PG8_LDB(B1, 0, 1); PG8_SCHED; PG8_LDA(At, 0, 0); PG8_STAGE(PG8_SA(1, 1), a1 + hstepA, voffA);
            PG8_WAIT_V(8); PG8_WAIT_L(0); PG8_BAR; PG8_MMA(0, 0, At, B0); PG8_MMA(0, 1, At, B1); PG8_BAR; PG8_SCHED;
            PG8_LDA(At, 0, 1); PG8_STAGE(PG8_SB(0, 0), b2, voffB); PG8_STAGE(PG8_SB(0, 1), b2 + hstepB, voffB); PG8_STAGE(PG8_SA(0, 0), a2, voffA);
            PG8_WAIT_V(8); PG8_WAIT_L(0); PG8_BAR; PG8_MMA(1, 0, At, B0); PG8_MMA(1, 1, At, B1); PG8_BAR; PG8_SCHED;
            PG8_LDB(B0, 1, 0); PG8_LDB(B1, 1, 1); PG8_SCHED; PG8_LDA(At, 1, 0); PG8_STAGE(PG8_SA(0, 1), a2 + hstepA, voffA);
            PG8_WAIT_V(8); PG8_WAIT_L(0); PG8_BAR; PG8_MMA(0, 0, At, B0); PG8_MMA(0, 1, At, B1); PG8_BAR; PG8_SCHED;
            PG8_LDA(At, 1, 1); PG8_STAGE(PG8_SB(1, 0), b3, voffB); PG8_STAGE(PG8_SB(1, 1), b3 + hstepB, voffB); PG8_STAGE(PG8_SA(1, 0), a3, voffA);
            PG8_WAIT_V(8); PG8_WAIT_L(0); PG8_BAR; PG8_MMA(1, 0, At, B0); PG8_MMA(1, 1, At, B1); PG8_BAR; PG8_SCHED;
        }
        if (wr == 0) PG8_BAR;
#if PROBE_TS
        const unsigned long long pt_t1 = __builtin_amdgcn_s_memrealtime();
#endif
        E(acc, cur, wr, wc, fr, fq);
#if PROBE_TS
        { asm volatile("s_waitcnt vmcnt(0)" ::: "memory"); const unsigned long long pt_t2 = __builtin_amdgcn_s_memrealtime(); pt_loop += pt_t1 - pt_t0; pt_epi += pt_t2 - pt_t1; pt_n += 1; pt_t0 = pt_t2; }
#endif
#if PROBE_EPI2
        if (Epi::PROBE2) E(acc, cur, wr, wc, fr, fq);
#endif
        if (!has_next) break;
#pragma unroll
        for (int a = 0; a < 2; ++a)
#pragma unroll
            for (int b = 0; b < 2; ++b)
#pragma unroll
                for (int m = 0; m < 4; ++m)
#pragma unroll
                    for (int n = 0; n < 2; ++n) acc[a][b][m][n] = (f32x4){0.f, 0.f, 0.f, 0.f};
        cur = nxt; cA = nA; cB = nB; ++ui;
        if (wr == 1) PG8_BAR;
    }
    PG8_WAIT_V(0);
    PG8_BAR;
#if PROBE_TS
    if (S.probe && S.c == 0 && tid == 0) { unsigned long long* tw = S.tsw + 90 + 3 * (S.probe - 1); tw[0] += pt_loop; tw[1] += pt_epi; tw[2] += pt_n; }
    if (S.probe == TS_SKEW_ID && tid == 0) { const unsigned long long dur = pt_loop + pt_epi; atomicMax(S.tsw + 120, dur); atomicMin(S.tsw + 121, dur); atomicAdd(S.tsw + 122, dur); }
#endif
#undef PG8_SA
#undef PG8_SB
#undef PG8_STAGE
#undef PG8_LDA
#undef PG8_LDB
#undef PG8_MMA
#undef PG8_WAIT_V
#undef PG8_WAIT_L
#undef PG8_BAR
#undef PG8_SCHED
}
}
using pg8::Unit;

__device__ __forceinline__ int slack_delay(int nwg, int G, int c, int unit_ticks) {
    const int rem = nwg % G; if (rem == 0 || c < rem) return 0;
    return (int)(((long long)(c - rem) * unit_ticks * 4) / ((long long)(G - rem) * 5));
}
__device__ __forceinline__ u32x4 pack8(const f32x4 a, const f32x4 b) { u32x4 w; w.x = cvt_pk_bf16(a[0], a[1]); w.y = cvt_pk_bf16(a[2], a[3]); w.z = cvt_pk_bf16(b[0], b[1]); w.w = cvt_pk_bf16(b[2], b[3]); return w; }
__device__ __forceinline__ f32x4 rot2(const f32x4 v, const f32x4 cs) { f32x4 o; o[0] = v[0] * cs[0] - v[1] * cs[1]; o[1] = v[1] * cs[0] + v[0] * cs[1]; o[2] = v[2] * cs[2] - v[3] * cs[3]; o[3] = v[3] * cs[2] + v[2] * cs[3]; return o; }

__device__ __forceinline__ f32x4 mla_cs(const float* tabm, int t, int c4) {
    const int p0 = c4 >> 1; const int pos = (p0 < 16) ? (t >> 6) : (t & 63); const int f = p0 & 15;
    return *(const f32x4*)(tabm + ((size_t)pos * 16 + f) * 2);
}

struct EpiG1 {
    static constexpr bool PERM = true, PROBE2 = false;
    bf16* QKVL; float* SSQ; bf16* KR; const float* tabm;
    __device__ __forceinline__ void operator()(const f32x4 (&acc)[2][2][4][2], const Unit& u, int wr, int wc, int fr, int fq) const {
        const int row0 = u.pm * 256 + wr * 64 + fr;
        if (u.pn < 4) {
            const int col0 = u.pn * 256 + wc * 32 + 8 * fq;
#pragma unroll
            for (int ai = 0; ai < 2; ++ai)
#pragma unroll
                for (int m = 0; m < 4; ++m) { const int row = row0 + ai * 128 + m * 16; float ss = 0.f;
#pragma unroll
                    for (int bj = 0; bj < 2; ++bj) { const f32x4 v0 = acc[ai][bj][m][0], v1 = acc[ai][bj][m][1];
                        ss += (v0[0] * v0[0] + v0[1] * v0[1]) + (v0[2] * v0[2] + v0[3] * v0[3]) + (v1[0] * v1[0] + v1[1] * v1[1]) + (v1[2] * v1[2] + v1[3] * v1[3]);
                        *(u32x4*)(QKVL + (size_t)row * N1 + col0 + bj * 128) = pack8(v0, v1); }
                    { const int ln_ = fr + 16 * fq; ss += shfl_xor_l(ss, 16, ln_); ss += shfl_xor_l(ss, 32, ln_); }
                    if (fq == 0) SSQ[(size_t)row * 16 + u.pn * 4 + wc] = ss; asm volatile("" ::: "memory"); }
        } else if (wc < 2) {
            const int c8 = wc * 32 + 8 * fq;
#pragma unroll
            for (int ai = 0; ai < 2; ++ai)
#pragma unroll
                for (int m = 0; m < 4; ++m) { const int row = row0 + ai * 128 + m * 16; f32x4 v0 = acc[ai][0][m][0], v1 = acc[ai][0][m][1];
                    if (row < MX) { const int t = row & (SEQ - 1); v0 = rot2(v0, mla_cs(tabm, t, c8)); v1 = rot2(v1, mla_cs(tabm, t, c8 + 4)); }
                    *(u32x4*)(KR + (size_t)row * 64 + c8) = pack8(v0, v1); asm volatile("" ::: "memory"); }
        }
    }
};
struct EpiUq {
    static constexpr bool PERM = true, PROBE2 = false;
    bf16* Q; const float* SSQ; const float* tabm;
    __device__ __forceinline__ void operator()(const f32x4 (&acc)[2][2][4][2], const Unit& u, int wr, int wc, int fr, int fq) const {
        const int row0 = u.pm * 256 + wr * 64 + fr;
        int col8[2], dd[2];
#pragma unroll
        for (int bj = 0; bj < 2; ++bj) { col8[bj] = u.pn * 256 + bj * 128 + wc * 32 + 8 * fq; dd[bj] = col8[bj] % DQ; }
#pragma unroll
        for (int ai = 0; ai < 2; ++ai)
#pragma unroll
            for (int m = 0; m < 4; ++m) { const int row = row0 + ai * 128 + m * 16;
                const f32x4 s0 = *(const f32x4*)(SSQ + (size_t)row * 16), s1 = *(const f32x4*)(SSQ + (size_t)row * 16 + 4);
                const float ss = ((s0[0] + s0[1]) + (s0[2] + s0[3])) + ((s1[0] + s1[1]) + (s1[2] + s1[3]));
                const float r = 1.0f / sqrtf(ss * (1.0f / QR) + NORM_EPS);
#pragma unroll
                for (int bj = 0; bj < 2; ++bj) { f32x4 v0 = acc[ai][bj][m][0] * r, v1 = acc[ai][bj][m][1] * r;
                    if (dd[bj] >= NOPE && row < MX) { const int t = row & (SEQ - 1), c8 = dd[bj] - NOPE; v0 = rot2(v0, mla_cs(tabm, t, c8)); v1 = rot2(v1, mla_cs(tabm, t, c8 + 4)); }
                    *(u32x4*)(Q + (size_t)row * 3072 + col8[bj]) = pack8(v0, v1); } asm volatile("" ::: "memory"); }
    }
};
struct EpiUkv {
    static constexpr bool PERM = true, PROBE2 = false;
    bf16* KV; const float* SSQ;
    __device__ __forceinline__ void operator()(const f32x4 (&acc)[2][2][4][2], const Unit& u, int wr, int wc, int fr, int fq) const {
        const int row0 = u.pm * 256 + wr * 64 + fr; const int col0 = u.pn * 256 + wc * 32 + 8 * fq;
#pragma unroll
        for (int ai = 0; ai < 2; ++ai)
#pragma unroll
            for (int m = 0; m < 4; ++m) { const int row = row0 + ai * 128 + m * 16;
                const f32x4 s0 = *(const f32x4*)(SSQ + (size_t)row * 16 + 8), s1 = *(const f32x4*)(SSQ + (size_t)row * 16 + 12);
                const float ss = ((s0[0] + s0[1]) + (s0[2] + s0[3])) + ((s1[0] + s1[1]) + (s1[2] + s1[3]));
                const float r = 1.0f / sqrtf(ss * (1.0f / KVR) + NORM_EPS);
#pragma unroll
                for (int bj = 0; bj < 2; ++bj) *(u32x4*)(KV + (size_t)row * 4096 + col0 + bj * 128) = pack8(acc[ai][bj][m][0] * r, acc[ai][bj][m][1] * r); asm volatile("" ::: "memory"); }
    }
};
struct EpiResid {
    static constexpr bool PERM = false, PROBE2 = false;
    const float* xin; float* xout; const float* cin; float* cout; const float* modv; int gofs;
    __device__ __forceinline__ void operator()(const f32x4 (&acc)[2][2][4][2], const Unit& u, int wr, int wc, int fr, int fq) const {
        const bool isx = u.pm < (MX / 256);
        const int rloc = (isx ? u.pm * 256 : (u.pm * 256 - MX)) + wr * 64 + fr;
        const float* base = isx ? xin : cin; float* out = isx ? xout : cout;
        const float* gv = modv + (size_t)(isx ? (u.pm >> 4) : 8) * NMOD + gofs;
        const int col0 = u.pn * 256 + wc * 32 + 4 * fq;
        f32x4 g4[2][2];
#pragma unroll
        for (int bj = 0; bj < 2; ++bj)
#pragma unroll
            for (int n = 0; n < 2; ++n) g4[bj][n] = *(const f32x4*)(gv + col0 + bj * 128 + n * 16);
        f32x4 pre[3][2][2];
#define RES_LOAD(G_, SLOT_) do { const size_t off_ = (size_t)(rloc + ((G_) >> 2) * 128 + ((G_) & 3) * 16) * D + col0; \
            _Pragma("unroll") for (int bj = 0; bj < 2; ++bj) _Pragma("unroll") for (int n = 0; n < 2; ++n) pre[SLOT_][bj][n] = *(const f32x4*)(base + off_ + bj * 128 + n * 16); } while (0)
        RES_LOAD(0, 0); RES_LOAD(1, 1); RES_LOAD(2, 2);
#pragma unroll
        for (int g = 0; g < 8; ++g) { const int ai = g >> 2, m = g & 3; const size_t off = (size_t)(rloc + ai * 128 + m * 16) * D + col0;
#pragma unroll
            for (int bj = 0; bj < 2; ++bj)
#pragma unroll
                for (int n = 0; n < 2; ++n) *(f32x4*)(out + off + bj * 128 + n * 16) = pre[g % 3][bj][n] + g4[bj][n] * acc[ai][bj][m][n];
            asm volatile("" ::: "memory");
            if (g + 3 < 8) RES_LOAD(g + 3, g % 3); }
#undef RES_LOAD
    }
};
template <int CTRL> __device__ __forceinline__ float dpp1(float x) { return __int_as_float(__builtin_amdgcn_update_dpp(0, __float_as_int(x), CTRL, 0xF, 0xF, false)); }
__device__ __forceinline__ f32x4 row_prev(const f32x4 v) { f32x4 o; o.x = dpp1<0x121>(v.x); o.y = dpp1<0x121>(v.y); o.z = dpp1<0x121>(v.z); o.w = dpp1<0x121>(v.w); return o; }
__device__ __forceinline__ f32x4 row_next(const f32x4 v) { f32x4 o; o.x = dpp1<0x12F>(v.x); o.y = dpp1<0x12F>(v.y); o.z = dpp1<0x12F>(v.z); o.w = dpp1<0x12F>(v.w); return o; }
__device__ __forceinline__ f32x4 silu4(const f32x4 v) { f32x4 o;
#pragma unroll
    for (int e = 0; e < 4; ++e) o[e] = fast_silu(v[e]); return o; }
constexpr size_t HALO_STRIDE = (size_t)FF;
struct EpiGUConv {
    static constexpr bool PERM = true, PROBE2 = true;
    bf16* ACT; float* HALO; const float* cw; const float* cb; LAS float* edge;
    __device__ __forceinline__ void operator()(const f32x4 (&acc)[2][2][4][2], const Unit& u, int wr, int wc, int fr, int fq) const {
        const int c8 = wc * 32 + 8 * fq; const int f0 = u.pn * 128 + c8;
#pragma unroll
        for (int ai = 0; ai < 2; ++ai) { const int blk = 2 * ai + wr;
            if (fr == 0)  { *(LAS f32x4*)(edge + (blk * 2 + 0) * 128 + c8) = acc[ai][0][0][0]; *(LAS f32x4*)(edge + (blk * 2 + 0) * 128 + c8 + 4) = acc[ai][0][0][1]; }
            if (fr == 15) { *(LAS f32x4*)(edge + (blk * 2 + 1) * 128 + c8) = acc[ai][0][3][0]; *(LAS f32x4*)(edge + (blk * 2 + 1) * 128 + c8 + 4) = acc[ai][0][3][1]; } }
        asm volatile("s_waitcnt lgkmcnt(0)" ::: "memory"); __builtin_amdgcn_s_barrier(); asm volatile("" ::: "memory");
        f32x4 w0[2], w1[2], w2[2], bb[2];
#pragma unroll
        for (int n = 0; n < 2; ++n) { w0[n] = *(const f32x4*)(cw + f0 + 4 * n); w1[n] = *(const f32x4*)(cw + FF + f0 + 4 * n); w2[n] = *(const f32x4*)(cw + 2 * FF + f0 + 4 * n); bb[n] = *(const f32x4*)(cb + f0 + 4 * n); }
        const f32x4 zero4 = {0.f, 0.f, 0.f, 0.f};
#pragma unroll
        for (int ai = 0; ai < 2; ++ai) { const int blk = 2 * ai + wr;
#pragma unroll
            for (int m = 0; m < 4; ++m) { const int row = u.pm * 256 + ai * 128 + wr * 64 + m * 16 + fr; f32x4 o[2];
#pragma unroll
                for (int n = 0; n < 2; ++n) { const f32x4 cur = acc[ai][0][m][n];
                    f32x4 b, d;
                    if (m > 0) b = row_prev(acc[ai][0][m - 1][n]); else b = (blk > 0) ? *(const LAS f32x4*)(edge + ((blk - 1) * 2 + 1) * 128 + c8 + 4 * n) : zero4;
                    if (m < 3) d = row_next(acc[ai][0][m + 1][n]); else d = (blk < 3) ? *(const LAS f32x4*)(edge + ((blk + 1) * 2 + 0) * 128 + c8 + 4 * n) : zero4;
                    const f32x4 a = row_prev(cur), c = row_next(cur);
                    const f32x4 up = (fr == 0) ? b : a, dn = (fr == 15) ? d : c;
                    const f32x4 cv = w0[n] * up + w1[n] * cur + w2[n] * dn + bb[n]; const f32x4 uu = acc[ai][1][m][n];
                    o[n] = silu4(cv) * uu;
                    if (m == 0 && blk == 0 && fr == 0) { float* hp = HALO + (size_t)((u.pm * 2 + 0) * 3) * HALO_STRIDE + f0 + 4 * n; *(f32x4*)hp = cv; *(f32x4*)(hp + HALO_STRIDE) = cur; *(f32x4*)(hp + 2 * HALO_STRIDE) = uu; }
                    if (m == 3 && blk == 3 && fr == 15) { float* hp = HALO + (size_t)((u.pm * 2 + 1) * 3) * HALO_STRIDE + f0 + 4 * n; *(f32x4*)hp = cv; *(f32x4*)(hp + HALO_STRIDE) = cur; *(f32x4*)(hp + 2 * HALO_STRIDE) = uu; } }
                *(u32x4*)(ACT + (size_t)row * FF + f0) = pack8(o[0], o[1]); asm volatile("" ::: "memory"); } }
        asm volatile("s_waitcnt lgkmcnt(0)" ::: "memory"); __builtin_amdgcn_s_barrier(); asm volatile("" ::: "memory");
    }
};
struct EpiQKV {
    static constexpr bool PERM = true, PROBE2 = false;
    bf16* QKV; const float* tabr;
    __device__ __forceinline__ void operator()(const f32x4 (&acc)[2][2][4][2], const Unit& u, int wr, int wc, int fr, int fq) const {
        const int row0 = u.pm * 256 + wr * 64 + fr; const int col0 = u.pn * 256 + wc * 32 + 8 * fq;
        const bool rope = (u.pn < 16) && (u.pm < MX / 256);
#pragma unroll
        for (int ai = 0; ai < 2; ++ai)
#pragma unroll
            for (int m = 0; m < 4; ++m) { const int row = row0 + ai * 128 + m * 16;
#pragma unroll
                for (int bj = 0; bj < 2; ++bj) { f32x4 v0 = acc[ai][bj][m][0], v1 = acc[ai][bj][m][1]; const int col = col0 + bj * 128;
                    if (rope) { const int t = row & (SEQ - 1); const float* tp = tabr + ((size_t)t * 128 + ((col & 255) >> 1)) * 2;
                        v0 = rot2(v0, *(const f32x4*)tp); v1 = rot2(v1, *(const f32x4*)(tp + 4)); }
                    *(u32x4*)(QKV + (size_t)row * 8192 + col) = pack8(v0, v1); } asm volatile("" ::: "memory"); }
    }
};
struct EpiGate {
    static constexpr bool PERM = true, PROBE2 = false;
    bf16* GATED; const bf16* YF; const bf16* YB; const float* ST;
    __device__ __forceinline__ void operator()(const f32x4 (&acc)[2][2][4][2], const Unit& u, int wr, int wc, int fr, int fq) const {
        const int row0 = u.pm * 256 + wr * 64 + fr; const int f0 = u.pn * 128 + wc * 32 + 8 * fq; const int hd = u.pn >> 2;
#pragma unroll
        for (int ai = 0; ai < 2; ++ai)
#pragma unroll
            for (int m = 0; m < 4; ++m) { const int row = row0 + ai * 128 + m * 16; const size_t off = (size_t)row * 4096 + f0;
                const u32x4 yf = *(const u32x4*)(YF + off), yb = *(const u32x4*)(YB + off);
                const f32x2 sf = *(const f32x2*)(ST + ((size_t)row * 8 + hd) * 2), sb = *(const f32x2*)(ST + ((size_t)(MT + row) * 8 + hd) * 2);
                const f32x4 a0 = acc[ai][0][m][0], a1 = acc[ai][0][m][1], b0 = acc[ai][1][m][0], b1 = acc[ai][1][m][1];
#define NF(w, hi_) (((hi_ ? bfhi(w) : bflo(w)) - sf[0]) * sf[1])
#define NB(w, hi_) (((hi_ ? bfhi(w) : bflo(w)) - sb[0]) * sb[1])
                f32x4 o0, o1;
                o0[0] = fast_silu(a0[0]) * NF(yf.x, 0) + fast_silu(b0[0]) * NB(yb.x, 0); o0[1] = fast_silu(a0[1]) * NF(yf.x, 1) + fast_silu(b0[1]) * NB(yb.x, 1);
                o0[2] = fast_silu(a0[2]) * NF(yf.y, 0) + fast_silu(b0[2]) * NB(yb.y, 0); o0[3] = fast_silu(a0[3]) * NF(yf.y, 1) + fast_silu(b0[3]) * NB(yb.y, 1);
                o1[0] = fast_silu(a1[0]) * NF(yf.z, 0) + fast_silu(b1[0]) * NB(yb.z, 0); o1[1] = fast_silu(a1[1]) * NF(yf.z, 1) + fast_silu(b1[1]) * NB(yb.z, 1);
                o1[2] = fast_silu(a1[2]) * NF(yf.w, 0) + fast_silu(b1[2]) * NB(yb.w, 0); o1[3] = fast_silu(a1[3]) * NF(yf.w, 1) + fast_silu(b1[3]) * NB(yb.w, 1);
#undef NF
#undef NB
                *(u32x4*)(GATED + off) = pack8(o0, o1); asm volatile("" ::: "memory"); }
    }
};

namespace att {
constexpr int NW = 8, QBLK = 32, KVBLK = 64;
constexpr int SHM_V = 16384, SHM_KN = 16384, SHM_KR = 8192;
constexpr int OFF_V = 0, OFF_KN = 3 * SHM_V, OFF_KR = OFF_KN + 2 * SHM_KN, OFF_WS = OFF_KR + 2 * SHM_KR, SHM_ATTN = OFF_WS + NW * 64 * 4;
constexpr float THR2 = 11.5f;
#define KSWZ(row, colB) ((row) * 256 + ((colB) ^ (((row) & 7) << 4)))
#define KRSWZ(row, colB) ((row) * 128 + ((colB) ^ ((((row) >> 1) & 7) << 4)))
#define SBAR() __builtin_amdgcn_sched_barrier(0)
__device__ __forceinline__ int crow(int r, int hi) { return (r & 3) + 8 * (r >> 2) + 4 * hi; }
__device__ __forceinline__ void partialSM(f32x16& p0, f32x16& p1, float& m_reg, float& alpha) {
  float pmax = p0[0];
#pragma unroll
  for (int r = 1; r < 16; ++r) pmax = fmaxf(pmax, p0[r]);
#pragma unroll
  for (int r = 0; r < 16; ++r) pmax = fmaxf(pmax, p1[r]);
  { auto rr = __builtin_amdgcn_permlane32_swap(__float_as_uint(pmax), __float_as_uint(pmax), false, false); pmax = fmaxf(__uint_as_float(rr[0]), __uint_as_float(rr[1])); }
  float mn;
  if (__builtin_expect(__all(pmax - m_reg <= THR2), 1)) { mn = m_reg; alpha = 1.f; }
  else { mn = fmaxf(m_reg, pmax); alpha = __builtin_amdgcn_exp2f(m_reg - mn); m_reg = mn; }
#pragma unroll
  for (int r = 0; r < 16; ++r) p0[r] = p0[r] - mn;
#pragma unroll
  for (int r = 0; r < 16; ++r) p1[r] = p1[r] - mn;
#pragma unroll
  for (int r = 0; r < 16; ++r) p0[r] = __builtin_amdgcn_exp2f(p0[r]);
}
__device__ __forceinline__ void finishSM(f32x16& p0, f32x16& p1, float alpha, float& l_reg, bf16x8& pa0, bf16x8& pa1, bf16x8& pa2, bf16x8& pa3) {
#pragma unroll
  for (int r = 0; r < 16; ++r) p1[r] = __builtin_amdgcn_exp2f(p1[r]);
  float ps = 0;
#pragma unroll
  for (int r = 0; r < 16; ++r) ps += p0[r];
#pragma unroll
  for (int r = 0; r < 16; ++r) ps += p1[r];
  { auto rr = __builtin_amdgcn_permlane32_swap(__float_as_uint(ps), __float_as_uint(ps), false, false); ps = __uint_as_float(rr[0]) + __uint_as_float(rr[1]); }
  l_reg = l_reg * alpha + ps;
#define PK4(P, BASE, OUT) do { unsigned a0 = cvt_pk_bf16(P[BASE + 0], P[BASE + 1]), a1 = cvt_pk_bf16(P[BASE + 2], P[BASE + 3]);   \
    unsigned b0 = cvt_pk_bf16(P[BASE + 4], P[BASE + 5]), b1 = cvt_pk_bf16(P[BASE + 6], P[BASE + 7]);                              \
    auto r0 = __builtin_amdgcn_permlane32_swap(a0, b0, false, false); auto r1 = __builtin_amdgcn_permlane32_swap(a1, b1, false, false); \
    u32x4 w = {r0[0], r1[0], r0[1], r1[1]}; OUT = __builtin_bit_cast(bf16x8, w); } while (0)
  PK4(p0, 0, pa0); PK4(p0, 8, pa1); PK4(p1, 0, pa2); PK4(p1, 8, pa3);
#undef PK4
}
__device__ __forceinline__ void qkt(f32x16& p0, f32x16& p1, const char* Kn, const char* Kr, const bf16x8* qr, int r32, int hi) {
  p0 = f32x16{}; p1 = f32x16{};
#pragma unroll
  for (int d0 = 0; d0 < 8; ++d0) { const int cb = (d0 * 16 + hi * 8) * 2;
    const bf16x8 b0 = *reinterpret_cast<const bf16x8*>(Kn + KSWZ(r32, cb));
    const bf16x8 b1 = *reinterpret_cast<const bf16x8*>(Kn + KSWZ(32 + r32, cb));
    p0 = __builtin_amdgcn_mfma_f32_32x32x16_bf16(b0, qr[d0], p0, 0, 0, 0);
    p1 = __builtin_amdgcn_mfma_f32_32x32x16_bf16(b1, qr[d0], p1, 0, 0, 0); }
#pragma unroll
  for (int d0 = 0; d0 < 4; ++d0) { const int cb = (d0 * 16 + hi * 8) * 2;
    const bf16x8 b0 = *reinterpret_cast<const bf16x8*>(Kr + KRSWZ(r32, cb));
    const bf16x8 b1 = *reinterpret_cast<const bf16x8*>(Kr + KRSWZ(32 + r32, cb));
    p0 = __builtin_amdgcn_mfma_f32_32x32x16_bf16(b0, qr[8 + d0], p0, 0, 0, 0);
    p1 = __builtin_amdgcn_mfma_f32_32x32x16_bf16(b1, qr[8 + d0], p1, 0, 0, 0); }
}
__device__ __forceinline__ int v_st(int k, int c) { const int kk = (k & ~0xC) | ((k & 4) << 1) | ((k & 8) >> 1); return ((kk >> 3) * 4 + (c >> 5)) * 512 + ((kk & 7) * 32 + (c & 31)) * 2; }
__device__ __forceinline__ int v_rd_base(int lane) { return ((lane & 3) << 3) | (((lane >> 2) & 3) << 6) | (((lane >> 4) & 1) << 5) | (((lane >> 5) & 1) << 8); }
constexpr int v_rd_off(int d0, int ks, int half) { return d0 * 512 + ks * 4096 + half * 2048; }
template <int OFF> __device__ __forceinline__ s16x4 tr_read(int vb) { s16x4 r; asm volatile("ds_read_b64_tr_b16 %0, %1 offset:%2" : "=&v"(r) : "v"(vb), "i"(OFF) : "memory"); return r; }
template <int D0> __device__ __forceinline__ void pv_one(f32x16& od, int vb, bf16x8 pa0, bf16x8 pa1, bf16x8 pa2, bf16x8 pa3) {
  const s16x4 l0 = tr_read<v_rd_off(D0, 0, 0)>(vb), h0 = tr_read<v_rd_off(D0, 0, 1)>(vb), l1 = tr_read<v_rd_off(D0, 1, 0)>(vb), h1 = tr_read<v_rd_off(D0, 1, 1)>(vb);
  const s16x4 l2 = tr_read<v_rd_off(D0, 2, 0)>(vb), h2 = tr_read<v_rd_off(D0, 2, 1)>(vb), l3 = tr_read<v_rd_off(D0, 3, 0)>(vb), h3 = tr_read<v_rd_off(D0, 3, 1)>(vb);
  asm volatile("s_waitcnt lgkmcnt(0)" ::: "memory"); SBAR();
#define PK(L, H) (bf16x8){L[0], L[1], L[2], L[3], H[0], H[1], H[2], H[3]}
  od = __builtin_amdgcn_mfma_f32_32x32x16_bf16(PK(l0, h0), pa0, od, 0, 0, 0);
  od = __builtin_amdgcn_mfma_f32_32x32x16_bf16(PK(l1, h1), pa1, od, 0, 0, 0);
  od = __builtin_amdgcn_mfma_f32_32x32x16_bf16(PK(l2, h2), pa2, od, 0, 0, 0);
  od = __builtin_amdgcn_mfma_f32_32x32x16_bf16(PK(l3, h3), pa3, od, 0, 0, 0);
#undef PK
}
__device__ __forceinline__ void pv_d0(f32x16* o, int vb, bf16x8 pa0, bf16x8 pa1, bf16x8 pa2, bf16x8 pa3) {
  pv_one<0>(o[0], vb, pa0, pa1, pa2, pa3); pv_one<1>(o[1], vb, pa0, pa1, pa2, pa3); pv_one<2>(o[2], vb, pa0, pa1, pa2, pa3); pv_one<3>(o[3], vb, pa0, pa1, pa2, pa3);
}
__device__ __forceinline__ void attn_unit(const bf16* __restrict__ Qb, const bf16* __restrict__ KVh, const bf16* __restrict__ KRp, bf16* __restrict__ Ob,
                                          int NT, int nc, int cbase, int xbase, char* lds, int tid_in, unsigned long long* ts_words = nullptr) {
  int tid = tid_in; asm volatile("" : "+v"(tid));
  const int wid = __builtin_amdgcn_readfirstlane(tid >> 6), lane = tid & 63, r32 = lane & 31, hi = lane >> 5;
  char* V_lds = lds + OFF_V; char* Kn_lds = lds + OFF_KN; char* Kr_lds = lds + OFF_KR;
  float* ws = (float*)(lds + OFF_WS) + wid * 64; float* li_l = ws; float* al_l = ws + 32;
  float m_reg = -1e30f, l_reg = 0; f32x16 o[4] = {}; bf16x8 qr[12];
  const bf16* Qw = Qb + (long)(wid * QBLK + r32) * 3072 + hi * 8;
#pragma unroll
  for (int d0 = 0; d0 < 12; ++d0) qr[d0] = *reinterpret_cast<const bf16x8*>(Qw + d0 * 16);
  const int vb0 = (int)(uintptr_t)V_lds + v_rd_base(lane);
  unsigned vofK[2], vofV[2], vofR;
#pragma unroll
  for (int i = 0; i < 2; ++i) { const int pc = wid * 2 + i;
      { const int row = pc * 4 + (lane >> 4), ch = (lane & 15) ^ (row & 7); vofK[i] = (unsigned)((row * 4096 + ch * 8) * 2); }
      { const int ob = pc * 1024 + lane * 16, st = ob >> 9, w = ob & 511, kk = (st >> 2) * 8 + (w >> 6); const int k = (kk & ~0xC) | ((kk & 4) << 1) | ((kk & 8) >> 1);
        const int c = (st & 3) * 32 + 8 * ((w & 63) >> 4); vofV[i] = (unsigned)((k * 4096 + 128 + c) * 2); } }
  { const int row = wid * 8 + (lane >> 3), ch = (lane & 7) ^ ((row >> 1) & 7); vofR = (unsigned)((row * 64 + ch * 8) * 2); }
  const unsigned ldsK = (unsigned)__builtin_amdgcn_readfirstlane((unsigned)(uintptr_t)Kn_lds + (unsigned)wid * 2048u);
  const unsigned ldsV = (unsigned)__builtin_amdgcn_readfirstlane((unsigned)(uintptr_t)V_lds + (unsigned)wid * 2048u);
  const unsigned ldsR = (unsigned)__builtin_amdgcn_readfirstlane((unsigned)(uintptr_t)Kr_lds + (unsigned)wid * 1024u);
#define KROW(j) ((j) < nc ? cbase + (j) * KVBLK : xbase + ((j) - nc) * KVBLK)
#define DMA_TILE(j, kslot, vslot) do { const long k0_ = KROW(j); const char* kb_ = uni_ptr(KVh + k0_ * 4096); const char* rb_ = uni_ptr(KRp + k0_ * 64); \
    glds16_s(kb_, vofK[0], ldsK + (kslot) * SHM_KN); glds16_s(kb_, vofK[1], ldsK + (kslot) * SHM_KN + 1024u); \
    glds16_s(rb_, vofR, ldsR + (kslot) * SHM_KR); \
    glds16_s(kb_, vofV[0], ldsV + (vslot) * SHM_V); glds16_s(kb_, vofV[1], ldsV + (vslot) * SHM_V + 1024u); } while (0)
#ifndef ATT_SKEW
#define ATT_SKEW 0
#endif
#if PROBE_TS
#define WAIT_SYNC() do { const unsigned long long w0_ = __builtin_amdgcn_s_memrealtime(); asm volatile("s_waitcnt vmcnt(0)" ::: "memory"); const unsigned long long w1_ = __builtin_amdgcn_s_memrealtime(); __syncthreads(); const unsigned long long w2_ = __builtin_amdgcn_s_memrealtime(); att_w_dma += w1_ - w0_; att_w_bar += w2_ - w1_; } while (0)
#else
#define WAIT_SYNC() do { asm volatile("s_waitcnt vmcnt(0)" ::: "memory"); __syncthreads(); if (ATT_SKEW && wid >= 4) __builtin_amdgcn_s_sleep(ATT_SKEW); } while (0)
#endif
#define RESC(a) do { if (__any((a) < 1.f)) { const float a_ = (a); \
    _Pragma("unroll") for (int d = 0; d < 4; ++d) _Pragma("unroll") for (int r = 0; r < 16; ++r) o[d][r] *= a_; } } while (0)
#if PROBE_TS
  unsigned long long att_w_dma = 0, att_w_bar = 0; const unsigned long long att_t0 = __builtin_amdgcn_s_memrealtime();
#endif
  f32x16 pA0, pA1, pB0, pB1; float alA, alB; bf16x8 pa0, pa1, pa2, pa3;
  DMA_TILE(0, 0, 0); DMA_TILE(1, 1, 1); WAIT_SYNC();
  qkt(pA0, pA1, Kn_lds, Kr_lds, qr, r32, hi); partialSM(pA0, pA1, m_reg, alA);
  __syncthreads();
  int vprev = 0, vcur = 1, vnext = 2;
  for (int j = 1; j + 1 < NT; j += 2) {
    DMA_TILE(j + 1, 0, vnext);
    SBAR(); qkt(pB0, pB1, Kn_lds + SHM_KN, Kr_lds + SHM_KR, qr, r32, hi);
    finishSM(pA0, pA1, alA, l_reg, pa0, pa1, pa2, pa3); SBAR();
    pv_d0(o, vb0 + vprev * SHM_V, pa0, pa1, pa2, pa3); partialSM(pB0, pB1, m_reg, alB);
    RESC(alB); WAIT_SYNC();
    { const int t_ = vprev; vprev = vcur; vcur = vnext; vnext = t_; }
    if (j + 2 < NT) DMA_TILE(j + 2, 1, vnext);
    SBAR(); qkt(pA0, pA1, Kn_lds, Kr_lds, qr, r32, hi);
    finishSM(pB0, pB1, alB, l_reg, pa0, pa1, pa2, pa3); SBAR();
    pv_d0(o, vb0 + vprev * SHM_V, pa0, pa1, pa2, pa3); partialSM(pA0, pA1, m_reg, alA);
    RESC(alA); WAIT_SYNC();
    { const int t_ = vprev; vprev = vcur; vcur = vnext; vnext = t_; }
  }
  SBAR(); qkt(pB0, pB1, Kn_lds + SHM_KN, Kr_lds + SHM_KR, qr, r32, hi);
  finishSM(pA0, pA1, alA, l_reg, pa0, pa1, pa2, pa3); SBAR();
  pv_d0(o, vb0 + vprev * SHM_V, pa0, pa1, pa2, pa3); partialSM(pB0, pB1, m_reg, alB);
  RESC(alB);
  finishSM(pB0, pB1, alB, l_reg, pa0, pa1, pa2, pa3); SBAR();
  pv_d0(o, vb0 + vcur * SHM_V, pa0, pa1, pa2, pa3);
  { const float inv = __builtin_amdgcn_rcpf(l_reg);
    bf16* Orow = Ob + (long)(wid * QBLK + r32) * 2048 + (hi ? 8 : 0);
#pragma unroll
    for (int d0 = 0; d0 < 4; ++d0)
#pragma unroll
      for (int g = 0; g < 4; g += 2) {
        unsigned ax = cvt_pk_bf16(o[d0][4 * g + 0] * inv, o[d0][4 * g + 1] * inv), ay = cvt_pk_bf16(o[d0][4 * g + 2] * inv, o[d0][4 * g + 3] * inv);
        unsigned bx_ = cvt_pk_bf16(o[d0][4 * g + 4] * inv, o[d0][4 * g + 5] * inv), by = cvt_pk_bf16(o[d0][4 * g + 6] * inv, o[d0][4 * g + 7] * inv);
        { auto r_ = __builtin_amdgcn_permlane32_swap(ax, bx_, false, false); ax = r_[0]; bx_ = r_[1]; }
        { auto r_ = __builtin_amdgcn_permlane32_swap(ay, by, false, false); ay = r_[0]; by = r_[1]; }
        *(u32x4*)(Orow + 32 * d0 + 8 * g) = (u32x4){ax, ay, bx_, by}; } }
  __syncthreads();
#if PROBE_TS
  if (ts_words && tid == 0) { ts_words[160] += att_w_dma; ts_words[161] += att_w_bar; ts_words[162] += __builtin_amdgcn_s_memrealtime() - att_t0; ts_words[163] += (unsigned long long)NT; }
#endif
#undef KROW
#undef DMA_TILE
#undef WAIT_SYNC
#undef RESC
}
#undef SBAR
}

namespace scan {
constexpr int CH = 64;
constexpr int OFF_Q = 0, OFF_K = 32768  , OFF_V = 98304, OFF_P = 131072, SHM_SCAN = 131072 + 8192;
__device__ __forceinline__ unsigned off_b(unsigned row, unsigned ch) { return 256u * row + 16u * (ch ^ (((row & 3) << 2) | ((row >> 2) & 3))); }
__device__ __forceinline__ unsigned p_off(unsigned i, unsigned chunk) { return 128u * i + 16u * (chunk ^ ((i >> 1) & 7)); }
__device__ __forceinline__ int crow(int r, int hi) { return (r & 3) + 8 * (r >> 2) + 4 * hi; }
__device__ __forceinline__ s16x4 vtr(const LAS char* p) { typedef short v4i16_t __attribute__((ext_vector_type(4))); return __builtin_bit_cast(s16x4, __builtin_amdgcn_ds_read_tr16_b64_v4i16((LAS v4i16_t*)p)); }
__device__ __forceinline__ bf16x8 tr_frag(const LAS char* img, int lane, int c, int ks) {
    const unsigned h = lane >> 5, blk = (lane >> 4) & 1, q = (lane & 15) >> 2, p = lane & 3;
    const unsigned r0 = 16 * ks + 8 * h + q, chn = 4 * c + 2 * blk + (p >> 1);
    const s16x4 lo = vtr(img + off_b(r0, chn) + 8 * (p & 1)), hi = vtr(img + off_b(r0 + 4, chn) + 8 * (p & 1));
    return (bf16x8){lo[0], lo[1], lo[2], lo[3], hi[0], hi[1], hi[2], hi[3]};
}
__device__ __forceinline__ bf16x8 pack_step(const f32x16& x, int s) {
    u32x4 p; p.x = cvt_pk_bf16(x[8 * s + 0], x[8 * s + 1]); p.y = cvt_pk_bf16(x[8 * s + 2], x[8 * s + 3]); p.z = cvt_pk_bf16(x[8 * s + 4], x[8 * s + 5]); p.w = cvt_pk_bf16(x[8 * s + 6], x[8 * s + 7]);
    return __builtin_bit_cast(bf16x8, p);
}
__device__ __forceinline__ void dma_mat(const bf16* src, int ld, LAS unsigned char* dst, int wid, int lane) {
    const char* sb = uni_ptr(src); const unsigned d0 = (unsigned)__builtin_amdgcn_readfirstlane((unsigned)(uintptr_t)dst + (unsigned)wid * 4096u);
#pragma unroll
    for (int k = 0; k < 4; ++k) { const int pc = wid * 4 + k, img = pc >> 4, row = 4 * (pc & 15) + (lane >> 4), pos = lane & 15;
        const int ch = pos ^ (((row & 3) << 2) | ((row >> 2) & 3));
        glds16_s(sb, (unsigned)((row * ld + img * 128 + ch * 8) * 2), d0 + (unsigned)k * 1024u); }
}
__device__ __forceinline__ int scan_rowbase(int n, int b, int dir) { return (n < 4) ? MX + b * CTXL + (dir ? 3 - n : n) * CH : b * SEQ + (dir ? 67 - n : n - 4) * CH; }
__device__ __forceinline__ float uni_f(float x) { return __uint_as_float(__builtin_amdgcn_readfirstlane(__float_as_uint(x))); }
typedef const LAS s16x4* lds_s4p;
__device__ __forceinline__ void scan_unit(const bf16* __restrict__ QKV, bf16* __restrict__ Y, int b, int hd, int dir, int dvh, float lg2, bool skip_ctx_y, LAS unsigned char* lds, int tid_in, unsigned long long* lds_ts = nullptr) {
    int tid = tid_in; asm volatile("" : "+v"(tid));
    const int wid = __builtin_amdgcn_readfirstlane(tid >> 6), lane0 = tid & 63;
    const LAS char* QI = (const LAS char*)lds + OFF_Q; const LAS char* VI = (const LAS char*)lds + OFF_V;
    LAS char* PI = (LAS char*)lds + OFF_P;
    f32x16 S[8];
#pragma unroll
    for (int i = 0; i < 8; ++i) S[i] = f32x16{};
    const float lgr = dir ? -lg2 : lg2;
    const float g64 = uni_f(__builtin_amdgcn_exp2f(64.f * lg2));
    const float R1 = uni_f(__builtin_amdgcn_exp2f(lgr)), R8 = uni_f(__builtin_amdgcn_exp2f(8.f * lgr)), R32 = uni_f(__builtin_amdgcn_exp2f(32.f * lgr));
    const float Rm1 = uni_f(__builtin_amdgcn_exp2f(-lgr)), Rm16 = uni_f(__builtin_amdgcn_exp2f(-16.f * lgr));
    const float c0 = uni_f(dir ? g64 : __builtin_amdgcn_exp2f(lg2)), z0 = uni_f(dir ? 1.0f : __builtin_amdgcn_exp2f(63.f * lg2));
    const int qcol = hd * RDK, kcol = 2048 + hd * RDK, vcol = 4096 + hd * RDV + dvh * 256;
    { const bf16* src = QKV + (size_t)scan_rowbase(0, b, dir) * 8192;
      dma_mat(src + qcol, 8192, lds + OFF_Q, wid, lane0); dma_mat(src + kcol, 8192, lds + OFF_K, wid, lane0); dma_mat(src + vcol, 8192, lds + OFF_V, wid, lane0);
      asm volatile("s_waitcnt vmcnt(0)" ::: "memory"); __syncthreads(); }
#if PROBE_TS
    unsigned long long sc_w1 = 0, sc_w2 = 0; const unsigned long long sc_tb = __builtin_amdgcn_s_memrealtime();
#endif
    for (int n = 0; n < 68; ++n) {
        int lane = lane0; asm volatile("" : "+v"(lane));
        const int r = lane & 31, h = lane >> 5, fr = lane & 15, fq = lane >> 4;
        const int rowbase = scan_rowbase(n, b, dir);
        const bool more = n + 1 < 68;
        const bf16* nsrc = QKV + (size_t)scan_rowbase(more ? n + 1 : n, b, dir) * 8192;
        const LAS char* KI = (const LAS char*)lds + OFF_K + (n & 1) * 32768;
        if (more) dma_mat(nsrc + kcol, 8192, lds + OFF_K + ((n + 1) & 1) * 32768, wid, lane);
        const float LR = c0 * __builtin_amdgcn_exp2f((float)(4 * h) * lgr), LZ = z0 * __builtin_amdgcn_exp2f((float)(-8 * h) * lgr), LP = __builtin_amdgcn_exp2f((float)(fr - 4 * fq) * lgr);
        { const int fH = fr & 3, fL = (fr >> 2) & 3; const int AL = 256 * fr + 16 * (fq ^ fL);
          int AH[4];
#pragma unroll
          for (int k = 0; k < 4; ++k) AH[k] = 64 * (k ^ fH);
#pragma unroll
          for (int tix = 0; tix < 2; ++tix) { const int tt = wid * 2 + tix, jt = tt >> 2, it = tt & 3;
            f32x4 pt = {0.f, 0.f, 0.f, 0.f};
            const bool live = dir ? (jt >= it) : (jt <= it);
            if (live) { const LAS char* ka = KI + 4096 * jt + AL; const LAS char* qa = QI + 4096 * it + AL;
#pragma unroll
                for (int ks = 0; ks < 8; ++ks) { const int o = (ks >> 2) * 16384 + AH[ks & 3];
                    pt = __builtin_amdgcn_mfma_f32_16x16x32_bf16(*(const LAS bf16x8*)(ka + o), *(const LAS bf16x8*)(qa + o), pt, 0, 0, 0); } }
            float we = LP * __builtin_amdgcn_exp2f((float)(16 * (it - jt)) * lgr); float v[4];
            const int mrel = fr - 4 * fq;
#pragma unroll
            for (int e = 0; e < 4; ++e) { float x = live ? pt[e] * we : 0.f; if (jt == it) { const bool keep = dir ? (e >= mrel) : (e <= mrel); x = keep ? x : 0.f; } v[e] = x; we *= Rm1; }
            const int i = it * 16 + fr, j0 = jt * 16 + 4 * fq;
            u32x2 w; w.x = cvt_pk_bf16(v[0], v[1]); w.y = cvt_pk_bf16(v[2], v[3]);
            *(LAS u32x2*)(PI + p_off(i, j0 >> 3) + ((j0 >> 2) & 1) * 8) = w; } }
        f32x16 Yt[2]; Yt[0] = f32x16{}; Yt[1] = f32x16{};
        { const int fH = r & 3, fL = (r >> 2) & 3; int QH[4], QL[4];
#pragma unroll
          for (int k = 0; k < 4; ++k) { QH[k] = 64 * (k ^ fH); QL[k] = 256 * r + 8 * h + 16 * (k ^ fL); }
#pragma unroll
          for (int dkb = 0; dkb < 8; ++dkb)
#pragma unroll
            for (int s = 0; s < 2; ++s) { const bf16x8 bf = pack_step(S[dkb], s);
                const LAS char* rp = QI + (dkb >> 2) * 16384 + QH[dkb & 3];
#pragma unroll
                for (int it = 0; it < 2; ++it) {
                    const u32x2 lo = *(const LAS u32x2*)(rp + it * 8192 + QL[2 * s]), hi2 = *(const LAS u32x2*)(rp + it * 8192 + QL[2 * s + 1]);
                    const u32x4 aw = {lo.x, lo.y, hi2.x, hi2.y};
                    Yt[it] = __builtin_amdgcn_mfma_f32_32x32x16_bf16(__builtin_bit_cast(bf16x8, aw), bf, Yt[it], 0, 0, 0); } } }
        { float fit = LR;
#pragma unroll
          for (int it = 0; it < 2; ++it) { float fa = fit;
#pragma unroll
            for (int a4 = 0; a4 < 4; ++a4) { float fb = fa;
#pragma unroll
                for (int b4 = 0; b4 < 4; ++b4) { Yt[it][4 * a4 + b4] *= fb; fb *= R1; }
                fa *= R8; }
            fit *= R32; } }
#if PROBE_TS
        const unsigned long long sc_t0 = __builtin_amdgcn_s_memrealtime();
#endif
        if (more) asm volatile("s_waitcnt vmcnt(4)" ::: "memory"); else asm volatile("s_waitcnt vmcnt(0)" ::: "memory");
        __syncthreads();
#if PROBE_TS
        sc_w1 += __builtin_amdgcn_s_memrealtime() - sc_t0;
#endif
        if (more) dma_mat(nsrc + qcol, 8192, lds + OFF_Q, wid, lane);
#pragma unroll
        for (int i = 0; i < 8; ++i)
#pragma unroll
            for (int rg = 0; rg < 16; ++rg) S[i][rg] *= g64;
        {
          const int blk = (lane >> 4) & 1, q = (lane & 15) >> 2, p = lane & 3; int TB[2], CQ[4];
#pragma unroll
          for (int t = 0; t < 2; ++t) TB[t] = 2048 * h + 256 * q + 1024 * t + 16 * ((2 * blk + (p >> 1)) ^ ((2 * h + t) & 3)) + 8 * (p & 1);
#pragma unroll
          for (int c = 0; c < 4; ++c) CQ[c] = 64 * (c ^ q);
          const LAS char* vb = VI + (wid >> 2) * 16384 + CQ[wid & 3];
          float zk = LZ;
#pragma unroll
          for (int ks = 0; ks < 4; ++ks) {
            const s16x4 vlo = vtr(vb + 4096 * ks + TB[0]), vhi = vtr(vb + 4096 * ks + TB[1]);
            const u32x2 vl = __builtin_bit_cast(u32x2, vlo), vh = __builtin_bit_cast(u32x2, vhi);
            const u32x4 vw = {vl.x, vl.y, vh.x, vh.y}; const bf16x8 vf = __builtin_bit_cast(bf16x8, vw);
#pragma unroll
            for (int it = 0; it < 2; ++it) { const bf16x8 pa = *(const LAS bf16x8*)(PI + p_off(it * 32 + r, 2 * ks + h));
                Yt[it] = __builtin_amdgcn_mfma_f32_32x32x16_bf16(pa, vf, Yt[it], 0, 0, 0); }
            float zj = zk; u32x4 zw;
            { const float a0 = bflo(vw.x) * zj; zj *= Rm1; const float a1 = bfhi(vw.x) * zj; zj *= Rm1; zw.x = cvt_pk_bf16(a0, a1); }
            { const float a0 = bflo(vw.y) * zj; zj *= Rm1; const float a1 = bfhi(vw.y) * zj; zj *= Rm1; zw.y = cvt_pk_bf16(a0, a1); }
            { const float a0 = bflo(vw.z) * zj; zj *= Rm1; const float a1 = bfhi(vw.z) * zj; zj *= Rm1; zw.z = cvt_pk_bf16(a0, a1); }
            { const float a0 = bflo(vw.w) * zj; zj *= Rm1; const float a1 = bfhi(vw.w) * zj; zw.w = cvt_pk_bf16(a0, a1); }
            const bf16x8 vz = __builtin_bit_cast(bf16x8, zw);
            zk *= Rm16;
#pragma unroll
            for (int dkb = 0; dkb < 8; ++dkb) { const LAS char* kb_ = KI + (dkb >> 2) * 16384 + 4096 * ks + CQ[dkb & 3];
                const s16x4 klo = vtr(kb_ + TB[0]), khi = vtr(kb_ + TB[1]);
                const u32x2 kl = __builtin_bit_cast(u32x2, klo), kh = __builtin_bit_cast(u32x2, khi); const u32x4 kw = {kl.x, kl.y, kh.x, kh.y};
                S[dkb] = __builtin_amdgcn_mfma_f32_32x32x16_bf16(__builtin_bit_cast(bf16x8, kw), vz, S[dkb], 0, 0, 0); }
            __builtin_amdgcn_sched_barrier(0);
          } }
        if (!(skip_ctx_y && n < 4)) {
            bf16* Yr = Y + (size_t)rowbase * 4096; const unsigned yo = (unsigned)(hd * RDV + dvh * 256 + wid * 32 + r + 4 * h * 4096);
#pragma unroll
            for (int it = 0; it < 2; ++it)
#pragma unroll
                for (int rg = 0; rg < 16; ++rg) { const unsigned i0 = (unsigned)(it * 32 + (rg & 3) + 8 * (rg >> 2));
                    Yr[yo + i0 * 4096u] = (bf16)(cvt_pk_bf16(Yt[it][rg], 0.f) & 0xffffu); }
        }
#if PROBE_TS
        const unsigned long long sc_t1 = __builtin_amdgcn_s_memrealtime();
#endif
        asm volatile("s_waitcnt vmcnt(0)" ::: "memory");
        __syncthreads();
#if PROBE_TS
        sc_w2 += __builtin_amdgcn_s_memrealtime() - sc_t1;
#endif
        if (more) dma_mat(nsrc + vcol, 8192, lds + OFF_V, wid, lane);
    }
    asm volatile("s_waitcnt vmcnt(0)" ::: "memory"); __syncthreads();
#if PROBE_TS
    if (blockIdx.x == 0 && tid == 0) { unsigned long long* tw = (unsigned long long*)(lds_ts); tw[170] += sc_w1; tw[171] += sc_w2; tw[172] += __builtin_amdgcn_s_memrealtime() - sc_tb; }
#endif
}
}

#define XB_TMO      128
#define XB_XCNT(j)  (256  + 64 * (j))
#define XB_XSUB(j)  (1280 + 64 * (j))
#define XB_XGEN(j)  (2304 + 64 * (j))
#define XB_TOP      3328
#define XB_TOPGEN   3392
#define XCD_BAR_WORDS 3456
#define XB_SPIN_CAP (1u << 22)
__device__ __forceinline__ unsigned xb_ld(unsigned* p)              { return __hip_atomic_load(p, __ATOMIC_RELAXED, __HIP_MEMORY_SCOPE_AGENT); }
__device__ __forceinline__ unsigned xb_add(unsigned* p, unsigned v) { return __hip_atomic_fetch_add(p, v, __ATOMIC_RELAXED, __HIP_MEMORY_SCOPE_AGENT); }
__device__ __forceinline__ unsigned xb_xcc_id() { return (unsigned)__builtin_amdgcn_s_getreg((3 << 11) | 20) & 0xFu; }
#define XB_SPIN(cond, bar) do { unsigned _sp = 0; while (cond) { __builtin_amdgcn_s_sleep(1); \
    if ((++_sp & 255u) == 0u) { if (xb_ld(&(bar)[XB_TMO])) break; if (_sp > XB_SPIN_CAP) { atomicAdd(&(bar)[XB_TMO], 1u); break; } } } } while (0)
struct XcdBarrier { unsigned* bar; unsigned x; volatile LAS unsigned* st; int wave; };
__device__ __forceinline__ XcdBarrier xcd_barrier_post(unsigned* bar, volatile LAS unsigned* st, int wave) {
    XcdBarrier b; b.bar = bar; b.x = xb_xcc_id(); b.st = st; b.wave = wave;
    if (wave == 0 && lane_id() == 0) (void)xb_add(&bar[XB_XCNT(b.x)], 1u);
    return b;
}
__device__ __forceinline__ void xcd_barrier_complete(unsigned* bar, unsigned x, unsigned& nloc, unsigned& nx) {
    const unsigned G = gridDim.x * gridDim.y * gridDim.z;
    unsigned sum, cnt, mine, sp = 0u;
    for (;;) {
        sum = 0u; cnt = 0u; mine = 0u;
#pragma unroll
        for (unsigned j = 0; j < 16; ++j) { const unsigned c = xb_ld(&bar[XB_XCNT(j)]); sum += c; cnt += (c > 0u) ? 1u : 0u; mine = (j == x) ? c : mine; }
        if (sum == G) break;
        __builtin_amdgcn_s_sleep(1);
        if ((++sp & 255u) == 0u) { if (xb_ld(&bar[XB_TMO])) break; if (sp > XB_SPIN_CAP) { atomicAdd(&bar[XB_TMO], 1u); break; } }
    }
    nloc = mine > 0u ? mine : 1u; nx = cnt > 0u ? cnt : 1u;
}
__device__ __forceinline__ void xcd_barrier(const XcdBarrier& b) {
    asm volatile("s_waitcnt vmcnt(0)" ::: "memory");
    __syncthreads();
    if (b.wave == 0 && lane_id() == 0) {
        unsigned* bar = b.bar; asm volatile("" : "+s"(bar));
        __builtin_amdgcn_s_waitcnt(0);
        unsigned nloc = b.st[0], nx = b.st[1];
        if (nloc == 0u) { xcd_barrier_complete(bar, b.x, nloc, nx); b.st[0] = nloc; b.st[1] = nx; }
        const unsigned old = xb_add(&bar[XB_XSUB(b.x)], 1u);
        const unsigned gen = old / nloc;
        if (old + 1u == (gen + 1u) * nloc) {
            __builtin_amdgcn_fence(__ATOMIC_RELEASE, "agent");
            asm volatile("s_waitcnt vmcnt(0)" ::: "memory");
            const unsigned og = xb_add(&bar[XB_TOP], 1u);
            const unsigned tg = og / nx;
            if (og + 1u == (tg + 1u) * nx) xb_add(&bar[XB_TOPGEN], 1u);
            else XB_SPIN(xb_ld(&bar[XB_TOPGEN]) == tg, bar);
            __builtin_amdgcn_fence(__ATOMIC_ACQUIRE, "agent");
            xb_add(&bar[XB_XGEN(b.x)], 1u);
            asm volatile("s_waitcnt vmcnt(0)" ::: "memory");
        } else {
            XB_SPIN(xb_ld(&bar[XB_XGEN(b.x)]) == gen, bar);
            __builtin_amdgcn_fence(__ATOMIC_ACQUIRE, "agent");
            asm volatile("s_waitcnt vmcnt(0)" ::: "memory");
        }
    }
    __syncthreads();
}

__device__ __forceinline__ float wave_sum(float v, int lane) {
#pragma unroll
    for (int o = 1; o < 64; o <<= 1) v += shfl_xor_l(v, o, lane);
    return v;
}
struct CvtDesc { const float* src; const float* kscale; bf16* WTrow0; int ldw, k0, K, jkind; float gscale; };
__device__ __forceinline__ int ropeperm64(int c) { const int p = c >> 1, e = c & 1; return (p < 16) ? (p + 16 * e) : (32 + (p - 16) + 16 * e); }
__device__ __forceinline__ int ropeinv64(int s_) { const int half = s_ >> 5, w = s_ & 31; return 2 * (half * 16 + (w & 15)) + (w >> 4); }
__device__ __forceinline__ void cvt_load(const CvtDesc& d, int lane, f32x4 (&v)[16]) {
#pragma unroll
    for (int i = 0; i < 16; ++i) { const int kk = 4 * i + (lane >> 4);
        f32x4 x = d.src ? *(const f32x4*)(d.src + (size_t)(d.k0 + kk) * d.ldw) : (f32x4){0.f, 0.f, 0.f, 0.f};
        float sc_ = d.gscale; if (d.kscale) sc_ *= d.kscale[d.k0 + kk];
        v[i] = x * sc_; }
}
__device__ __forceinline__ void cvt_store(const CvtDesc& d, int lane, const f32x4 (&v)[16], LAS float* scr) {
    const int n4 = lane & 15; int jr[4];
#pragma unroll
    for (int e = 0; e < 4; ++e) { const int s_ = 4 * n4 + e; jr[e] = d.jkind == 0 ? s_ : d.jkind == 1 ? ropeinv64(s_) : 2 * (4 * (n4 & 7) + e) + (n4 >> 3); }
#pragma unroll
    for (int i = 0; i < 16; ++i) { const int kk = 4 * i + (lane >> 4);
#pragma unroll
        for (int e = 0; e < 4; ++e) scr[kk * 65 + jr[e]] = v[i][e]; }
    asm volatile("s_waitcnt lgkmcnt(0)" ::: "memory");
    const int c = lane & 7;
#pragma unroll
    for (int ps = 0; ps < 8; ++ps) { const int j = 8 * ps + (lane >> 3); const LAS float* s = scr + (8 * c) * 65 + j;
        u32x4 o; o.x = cvt_pk_bf16(s[0 * 65], s[1 * 65]); o.y = cvt_pk_bf16(s[2 * 65], s[3 * 65]); o.z = cvt_pk_bf16(s[4 * 65], s[5 * 65]); o.w = cvt_pk_bf16(s[6 * 65], s[7 * 65]);
        *(u32x4*)(d.WTrow0 + (size_t)j * d.K + d.k0 + 8 * c) = o; }
    asm volatile("s_waitcnt lgkmcnt(0)" ::: "memory");
}
struct CvtJob { const float* W0; const float* W1; const float* kscale; bf16* WT; int ldw, K, nrows, kind, aux; float gscale; };
__device__ __forceinline__ bool cvt_try(const CvtJob& J, int& it, int lane, CvtDesc& d) {
    const int nblk = J.nrows / 64, items = (J.K / 64) * nblk;
    if (it >= items) { it -= items; return false; }
    const int kb = it / nblk, nb = it % nblk; const int n4 = lane & 15;
    const float* sp; int jk = 0;
    switch (J.kind) {
        case 0: sp = J.W0 + J.aux + nb * 64 + 4 * n4; break;
        case 1: sp = J.W0 + J.aux + 4 * n4; jk = 1; break;
        case 2: { const int hh = nb / 3, part = nb % 3; sp = J.W0 + hh * DQ + 64 * part + 4 * n4; jk = (part == 2) ? 1 : 0; } break;
        case 3: { const int hh = nb >> 2, q4 = nb & 3; sp = J.W0 + hh * 256 + 32 * q4 + 128 * (n4 >> 3) + 4 * (n4 & 7); jk = 2; } break;
        case 4: { const int tl = nb >> 2, hf = (nb >> 1) & 1, q2 = nb & 1; const long long dW = (const char*)J.W1 - (const char*)J.W0; sp = (const float*)((const char*)J.W0 + dW * hf) + tl * 128 + 64 * q2 + 4 * n4; } break;
        default: sp = nullptr; break;
    }
    d.src = sp; d.kscale = J.kscale; d.WTrow0 = J.WT + (size_t)(nb * 64) * J.K; d.ldw = J.ldw; d.k0 = kb * 64; d.K = J.K; d.jkind = jk; d.gscale = J.gscale;
    return true;
}
__device__ __forceinline__ int cvt_items(const CvtJob& J) { return (J.K / 64) * (J.nrows / 64); }

__device__ __forceinline__ void row_load(const float* xrow, int lane, f32x4 (&v)[8]) {
#pragma unroll
    for (int j = 0; j < 8; ++j) v[j] = *(const f32x4*)(xrow + 4 * lane + 256 * j);
}
__device__ __forceinline__ void norm_mod_finish(const f32x4 (&v)[8], const float* g, const float* sc, const float* sh, bf16* orow, int lane) {
    float s = 0.f;
#pragma unroll
    for (int j = 0; j < 8; ++j) s += (v[j][0] * v[j][0] + v[j][1] * v[j][1]) + (v[j][2] * v[j][2] + v[j][3] * v[j][3]);
    const float rstd = 1.0f / sqrtf(wave_sum(s, lane) * (1.0f / D) + NORM_EPS);
#pragma unroll
    for (int j = 0; j < 8; ++j) { const int c = 4 * lane + 256 * j; const f32x4 gg = *(const f32x4*)(g + c), s1 = *(const f32x4*)(sc + c), s0 = *(const f32x4*)(sh + c);
        const f32x4 y = (v[j] * rstd) * gg * (1.0f + s1) + s0;
        u32x2 w; w.x = cvt_pk_bf16(y[0], y[1]); w.y = cvt_pk_bf16(y[2], y[3]); *(u32x2*)(orow + c) = w; }
}
__device__ __forceinline__ void norm_phase(const float* xsrc, const float* csrc, const float* g, const float* modl, int chunk, bf16* H, int nrows, int gw, int NGW, int lane) {
    if (gw >= nrows) return;
    f32x4 v[8], vn[8]; int m = gw;
    row_load(m < MX ? xsrc + (size_t)m * D : csrc + (size_t)(m - MX) * D, lane, v);
    for (;;) {
        const int mn = m + NGW; const bool has = mn < nrows;
        if (has) row_load(mn < MX ? xsrc + (size_t)mn * D : csrc + (size_t)(mn - MX) * D, lane, vn);
        const float* mr = modl + (size_t)(m < MX ? (m >> 12) : 8) * NMOD + chunk * D;
        norm_mod_finish(v, g, mr + D, mr, H + (size_t)m * D, lane);
        if (!has) break;
#pragma unroll
        for (int j = 0; j < 8; ++j) v[j] = vn[j];
        m = mn;
    }
}

__device__ __forceinline__ unsigned long long ld_arg(LAS unsigned char* lds, int i) {
    const volatile LAS unsigned* p = (const volatile LAS unsigned*)(lds + ARGS_OFF) + 2 * i;
    const unsigned lo = __builtin_amdgcn_readfirstlane(p[0]), hi = __builtin_amdgcn_readfirstlane(p[1]);
    return ((unsigned long long)hi << 32) | lo;
}
__device__ __forceinline__ void mod_layers(LAS unsigned char* lds, unsigned char* ws, int l_lo, int l_hi, int wg, int nwg, int tid, int lane, int wave) {
#define ARGF(i) ((const float*)ld_arg(lds, (i)))
    const int nitems = (l_hi - l_lo) * 96;
    if (wg >= nitems) return;
    LAS float* cond = (LAS float*)lds;
    LAS float* red = (LAS float*)(lds + 73728);
    float* MODV = (float*)(ws + WS_MODV);
    { const float* cin = ARGF(1); const float* cc = ARGF(3);
      for (int i = tid; i < 9 * D; i += 512) { const int r = i >> 11, k = i & (D - 1); const float c = (r < 8) ? cin[r * D + k] : cc[k]; cond[i] = c / (1.0f + __expf(-c)); } }
    __syncthreads();
    for (int it = wg; it < nitems; it += nwg) {
        const int l = l_lo + it / 96, cb = it % 96; const int n = cb * 128 + 2 * lane;
        const float* W = ARGF(4) + (size_t)l * D * NMOD + n; const float* mb = ARGF(5) + (size_t)l * NMOD + cb * 128;
        float a0[9], a1[9];
#pragma unroll
        for (int r = 0; r < 9; ++r) { a0[r] = 0.f; a1[r] = 0.f; }
        for (int k = wave * 256; k < wave * 256 + 256; k += 8) {
            f32x2 w[8];
#pragma unroll
            for (int q = 0; q < 8; ++q) w[q] = *(const f32x2*)(W + (size_t)(k + q) * NMOD);
#pragma unroll
            for (int q4 = 0; q4 < 2; ++q4)
#pragma unroll
                for (int r = 0; r < 9; ++r) { const f32x4 c4 = *(const LAS f32x4*)(cond + r * D + k + 4 * q4);
#pragma unroll
                    for (int q = 0; q < 4; ++q) { a0[r] += c4[q] * w[4 * q4 + q][0]; a1[r] += c4[q] * w[4 * q4 + q][1]; } }
        }
#pragma unroll
        for (int r = 0; r < 9; ++r) { red[(wave * 9 + r) * 128 + 2 * lane] = a0[r]; red[(wave * 9 + r) * 128 + 2 * lane + 1] = a1[r]; }
        __syncthreads();
        for (int i = tid; i < 9 * 128; i += 512) { const int r = i >> 7, cc = i & 127; float s2 = 0.f;
#pragma unroll
            for (int w8 = 0; w8 < 8; ++w8) s2 += red[(w8 * 9 + r) * 128 + cc];
            MODV[((size_t)l * 9 + r) * NMOD + cb * 128 + cc] = s2 + mb[cc]; }
        __syncthreads();
    }
#undef ARGF
}
__device__ __forceinline__ void cvt_layer(LAS unsigned char* lds, unsigned char* ws, int lc, int rank, int nranks, int wave, int lane, int part  ) {
#define ARGF(i) ((const float*)ld_arg(lds, (i)))
    const int li = lc >> 1; const bool is_ret = (lc & 1) != 0;
    bf16* WM = (bf16*)(ws + (is_ret ? WS_WB : WS_WA)); bf16* WF = (bf16*)(ws + (is_ret ? WS_WB + 82 * MiB : WS_WA + 22 * MiB));
    LAS float* scr = (LAS float*)(lds + wave * 19456);
    CvtJob J[7]; int nj;
    if (!is_ret) {
        bf16* W1T = WM; bf16* WuqT = W1T + (size_t)N1 * D; bf16* WukvT = WuqT + (size_t)3072 * 512; bf16* WoT = WukvT + (size_t)4096 * 512;
        const float* wdq = ARGF(8) + (size_t)li * D * QR; const float* wdkv = ARGF(11) + (size_t)li * D * (KVR + ROPE);
        J[0] = CvtJob{wdq, nullptr, nullptr, W1T, QR, D, 512, 0, 0, 1.f};
        J[1] = CvtJob{wdkv, nullptr, nullptr, W1T + (size_t)512 * D, KVR + ROPE, D, 512, 0, 0, 1.f};
        J[2] = CvtJob{wdkv, nullptr, nullptr, W1T + (size_t)1024 * D, KVR + ROPE, D, 64, 1, 512, 1.f};
        J[3] = CvtJob{nullptr, nullptr, nullptr, W1T + (size_t)1088 * D, 1, D, 192, 5, 0, 1.f};
        J[4] = CvtJob{ARGF(10) + (size_t)li * QR * 3072, nullptr, ARGF(9) + li * QR, WuqT, 3072, QR, 3072, 2, 0, 0.07216878364870322f * LOG2E};
        J[5] = CvtJob{ARGF(13) + (size_t)li * KVR * 4096, nullptr, ARGF(12) + li * KVR, WukvT, 4096, KVR, 4096, 0, 0, 1.f};
        J[6] = CvtJob{ARGF(14) + (size_t)li * D * D, nullptr, nullptr, WoT, D, D, D, 0, 0, 1.f};
        nj = 7;
    } else {
        bf16* WqkvT = WM; bf16* WgT = WqkvT + (size_t)8192 * D; bf16* WoT = WgT + (size_t)8192 * D;
        J[0] = CvtJob{ARGF(15) + (size_t)li * D * D, nullptr, nullptr, WqkvT, D, D, 2048, 3, 0, 1.f};
        J[1] = CvtJob{ARGF(16) + (size_t)li * D * D, nullptr, nullptr, WqkvT + (size_t)2048 * D, D, D, 2048, 3, 0, 0.0625f};
        J[2] = CvtJob{ARGF(17) + (size_t)li * D * 4096, nullptr, nullptr, WqkvT + (size_t)4096 * D, 4096, D, 4096, 0, 0, 1.f};
        J[3] = CvtJob{ARGF(18) + (size_t)li * D * 4096, ARGF(19) + (size_t)li * D * 4096, nullptr, WgT, 4096, D, 8192, 4, 0, 1.f};
        J[4] = CvtJob{ARGF(20) + (size_t)li * 4096 * D, nullptr, nullptr, WoT, D, 4096, D, 0, 0, 1.f};
        J[5] = CvtJob{nullptr, nullptr, nullptr, nullptr, 1, 64, 0, 5, 0, 1.f};
        J[6] = J[5];
        nj = 5;
    }
    CvtJob F0 = CvtJob{ARGF(23) + (size_t)lc * D * FF, ARGF(24) + (size_t)lc * D * FF, nullptr, WF, FF, D, 11264, 4, 0, 1.f};
    CvtJob F1 = CvtJob{ARGF(27) + (size_t)lc * FF * D, nullptr, nullptr, WF + (size_t)11264 * D, D, FF, D, 0, 0, 1.f};
    if (part == 1) nj = 0;
    const bool ffn = part != 0;
    int total = ffn ? cvt_items(F0) + cvt_items(F1) : 0;
#pragma unroll
    for (int j = 0; j < 7; ++j) if (j < nj) total += cvt_items(J[j]);
#define CVT_FIND(IT, DD) do { int it_ = (IT); bool done_ = false; \
        _Pragma("unroll") for (int j = 0; j < 7; ++j) if (!done_ && j < nj) done_ = cvt_try(J[j], it_, lane, DD); \
        if (ffn) { if (!done_) done_ = cvt_try(F0, it_, lane, DD); if (!done_) done_ = cvt_try(F1, it_, lane, DD); } } while (0)
    if (rank < total) {
        f32x4 v[16], w[16]; CvtDesc d0, d1; int it0 = rank;
        CVT_FIND(it0, d0); cvt_load(d0, lane, v);
        for (;;) {
            const int it1 = it0 + nranks; const bool has = it1 < total;
            if (has) { CVT_FIND(it1, d1); cvt_load(d1, lane, w); }
            cvt_store(d0, lane, v, scr);
            if (!has) break;
#pragma unroll
            for (int i = 0; i < 16; ++i) v[i] = w[i];
            d0 = d1; it0 = it1;
        }
    }
#undef CVT_FIND
#undef ARGF
}

#if MLA_CHECK
constexpr int CW_CHK = 2048;
__device__ __forceinline__ float wave_max(float v, int lane) {
#pragma unroll
    for (int o = 1; o < 64; o <<= 1) v = fmaxf(v, shfl_xor_l(v, o, lane));
    return v;
}
__device__ __forceinline__ void mla_check(LAS unsigned char* lds, unsigned char* ws, int li, int gw, int wave, int lane) {
#define ARGF(i) ((const float*)ld_arg(lds, (i)))
    LAS float* sc = (LAS float*)(lds + wave * 19456);
    const bf16* H = (const bf16*)(ws + WS_H); const bf16* Qb = (const bf16*)(ws + WS_Q); const bf16* KVb = (const bf16*)(ws + WS_KV); const bf16* KRb = (const bf16*)(ws + WS_KR); const bf16* Ob = (const bf16*)(ws + WS_O);
    const int t = (int)(((unsigned)gw * 2654435761u) % (unsigned)MT); const int hd = gw & 15;
    const bool isx = t < MX; const int tt = t & (SEQ - 1);
    float err = 0.f;
    {
        const float* wdq = ARGF(8) + (size_t)li * D * QR; const float* wdkv = ARGF(11) + (size_t)li * D * (KVR + ROPE);
        float ql[8], kl[9];
#pragma unroll
        for (int j = 0; j < 8; ++j) ql[j] = 0.f;
#pragma unroll
        for (int j = 0; j < 9; ++j) kl[j] = 0.f;
        for (int k = 0; k < D; ++k) { const float hv = bf2f(H[(size_t)t * D + k]);
#pragma unroll
            for (int j = 0; j < 8; ++j) ql[j] += hv * wdq[(size_t)k * QR + lane + 64 * j];
#pragma unroll
            for (int j = 0; j < 9; ++j) kl[j] += hv * wdkv[(size_t)k * (KVR + ROPE) + lane + 64 * j]; }
        float sq = 0.f, sk = 0.f;
#pragma unroll
        for (int j = 0; j < 8; ++j) { sq += ql[j] * ql[j]; sk += kl[j] * kl[j]; }
        const float rq = 1.0f / sqrtf(wave_sum(sq, lane) * (1.0f / QR) + NORM_EPS), rk = 1.0f / sqrtf(wave_sum(sk, lane) * (1.0f / KVR) + NORM_EPS);
        const float* qg = ARGF(9) + li * QR; const float* kg = ARGF(12) + li * KVR;
#pragma unroll
        for (int j = 0; j < 8; ++j) { sc[lane + 64 * j] = ql[j] * rq * qg[lane + 64 * j]; sc[512 + lane + 64 * j] = kl[j] * rk * kg[lane + 64 * j]; }
        sc[1024 + lane] = kl[8];
        asm volatile("s_waitcnt lgkmcnt(0)" ::: "memory");
        const float* wuq = ARGF(10) + (size_t)li * QR * 3072 + hd * DQ; const float* wukv = ARGF(13) + (size_t)li * KVR * 4096 + hd * 256;
        float qv[3] = {0.f, 0.f, 0.f}, kv[4] = {0.f, 0.f, 0.f, 0.f};
        for (int c = 0; c < 512; ++c) { const float a = sc[c], bq = sc[512 + c];
#pragma unroll
            for (int j = 0; j < 3; ++j) qv[j] += a * wuq[(size_t)c * 3072 + lane + 64 * j];
#pragma unroll
            for (int j = 0; j < 4; ++j) kv[j] += bq * wukv[(size_t)c * 4096 + lane + 64 * j]; }
#pragma unroll
        for (int j = 0; j < 3; ++j) sc[1100 + lane + 64 * j] = qv[j];
        asm volatile("s_waitcnt lgkmcnt(0)" ::: "memory");
        float qref[3]; float kr_ref = 0.f;
#pragma unroll
        for (int j = 0; j < 3; ++j) { const int d = lane + 64 * j; float v = sc[1100 + d];
            if (d >= NOPE && isx) { const int e = d - NOPE, half = e >> 5, i = e & 15, second = (e >> 4) & 1; const float pos = half ? (float)(tt & 63) : (float)(tt >> 6);
                const float ang = pos * __builtin_amdgcn_exp2f(-(float)(2 * i) * (13.287712379549449f / 32.0f)); const float rev = ang * 0.15915494309189535f; const float fr_ = rev - floorf(rev);
                const float cs = __builtin_amdgcn_cosf(fr_), sn = __builtin_amdgcn_sinf(fr_); const float other = sc[1100 + NOPE + half * 32 + i + (second ? 0 : 16)];
                v = second ? (v * cs + other * sn) : (v * cs - other * sn); }
            qref[j] = v * (0.07216878364870322f * LOG2E); }
        { const int e = lane, half = e >> 5, i = e & 15, second = (e >> 4) & 1; float v = sc[1024 + e];
          if (isx) { const float pos = half ? (float)(tt & 63) : (float)(tt >> 6);
              const float ang = pos * __builtin_amdgcn_exp2f(-(float)(2 * i) * (13.287712379549449f / 32.0f)); const float rev = ang * 0.15915494309189535f; const float fr_ = rev - floorf(rev);
              const float cs = __builtin_amdgcn_cosf(fr_), sn = __builtin_amdgcn_sinf(fr_); const float other = sc[1024 + half * 32 + i + (second ? 0 : 16)];
              v = second ? (v * cs + other * sn) : (v * cs - other * sn); }
          kr_ref = v; }
#pragma unroll
        for (int j = 0; j < 3; ++j) sc[1400 + lane + 64 * j] = qref[j];
        sc[1600 + lane] = kr_ref;
        asm volatile("s_waitcnt lgkmcnt(0)" ::: "memory");
        float mx = 0.f, df = 0.f;
#pragma unroll
        for (int j = 0; j < 3; ++j) { const int p = lane + 64 * j; const int od = p < NOPE ? p : NOPE + ropeperm64(p - NOPE); const float ref = sc[1400 + od]; const float mine = bf2f(Qb[(size_t)t * 3072 + hd * DQ + p]);
            mx = fmaxf(mx, fabsf(ref)); df = fmaxf(df, fabsf(ref - mine)); }
        err = fmaxf(err, wave_max(df, lane) / (wave_max(mx, lane) + 1e-20f));
        mx = 0.f; df = 0.f;
#pragma unroll
        for (int j = 0; j < 4; ++j) { const float ref = kv[j]; const float mine = bf2f(KVb[(size_t)t * 4096 + hd * 256 + lane + 64 * j]); mx = fmaxf(mx, fabsf(ref)); df = fmaxf(df, fabsf(ref - mine)); }
        err = fmaxf(err, wave_max(df, lane) / (wave_max(mx, lane) + 1e-20f));
        { const float ref = sc[1600 + ropeperm64(lane)]; const float mine = bf2f(KRb[(size_t)t * 64 + lane]); err = fmaxf(err, wave_max(fabsf(ref - mine), lane) / (wave_max(fabsf(ref), lane) + 1e-20f)); }
    }
    {
        const int b = isx ? (t >> 12) : ((t - MX) >> 8); const int nk = isx ? 4352 : 256;
        for (int d = lane; d < DQ; d += 64) sc[d] = bf2f(Qb[(size_t)t * 3072 + hd * DQ + d]);
        asm volatile("s_waitcnt lgkmcnt(0)" ::: "memory");
        float mxs = -1e30f;
        for (int j = lane; j < nk; j += 64) { const int row = j < 256 ? MX + b * CTXL + j : b * SEQ + (j - 256); float sdot = 0.f;
            for (int d = 0; d < NOPE; ++d) sdot += sc[d] * bf2f(KVb[(size_t)row * 4096 + hd * 256 + d]);
            for (int d = 0; d < ROPE; ++d) sdot += sc[NOPE + d] * bf2f(KRb[(size_t)row * 64 + d]);
            sc[256 + j] = sdot; mxs = fmaxf(mxs, sdot); }
        mxs = wave_max(mxs, lane); float sum = 0.f;
        for (int j = lane; j < nk; j += 64) { const float p = __builtin_amdgcn_exp2f(sc[256 + j] - mxs); sc[256 + j] = p; sum += p; }
        sum = wave_sum(sum, lane);
        asm volatile("s_waitcnt lgkmcnt(0)" ::: "memory");
        float o0 = 0.f, o1 = 0.f;
        for (int j = 0; j < nk; ++j) { const int row = j < 256 ? MX + b * CTXL + j : b * SEQ + (j - 256); const float p = sc[256 + j];
            o0 += p * bf2f(KVb[(size_t)row * 4096 + hd * 256 + 128 + lane]); o1 += p * bf2f(KVb[(size_t)row * 4096 + hd * 256 + 128 + 64 + lane]); }
        o0 /= sum; o1 /= sum;
        const float m0 = bf2f(Ob[(size_t)t * D + hd * 128 + lane]), m1 = bf2f(Ob[(size_t)t * D + hd * 128 + 64 + lane]);
        const float df = fmaxf(fabsf(o0 - m0), fabsf(o1 - m1)), mx = fmaxf(fabsf(o0), fabsf(o1));
        err = fmaxf(err, wave_max(df, lane) / (wave_max(mx, lane) + 1e-20f));
    }
    if (lane == 0) atomicMax((unsigned*)(ws + WS_CTL) + CW_CHK, __float_as_uint(err));
#undef ARGF
}
#endif
struct Args { const float* in[29]; float* out; unsigned char* ws; int ph_lo, ph_hi; };
constexpr int PH_PER_LAYER = 10, PH_FINAL = 1 + PH_PER_LAYER * DEPTH, PH_COUNT = PH_FINAL + 1;

template <unsigned MK_EN_T>
__global__ void __launch_bounds__(512, 2) mk_fwd(Args args) {
    extern __shared__ __attribute__((aligned(16))) unsigned char lds_raw[];
    LAS unsigned char* lds = (LAS unsigned char*)lds_raw;
    volatile LAS unsigned* MISC = (volatile LAS unsigned*)(lds + MISC_OFF);
    const int G = gridDim.x; const int bx = blockIdx.x; const int vcu = (G % 8 == 0) ? (bx % 8) * (G / 8) + bx / 8 : bx;
    const int NGW = G * 8;
    unsigned char* ws = args.ws; float* X = args.out;
    const int lo = args.ph_lo, hi = args.ph_hi;
    const int wave_s = __builtin_amdgcn_readfirstlane((int)threadIdx.x >> 6);
#define TID() (wave_s * 64 + lane_id())
    { const int tid0 = threadIdx.x;
      for (int u = tid0; u < (LDS_BYTES - CTRL_BASE) / 4; u += 512) ((LAS unsigned*)(lds + CTRL_BASE))[u] = 0u;
      __syncthreads();
      if (tid0 < 29) ((volatile LAS unsigned long long*)(lds + ARGS_OFF))[tid0] = (unsigned long long)args.in[tid0];
      __syncthreads(); }
#define ARGF(i) ((const float*)ld_arg(lds, (i)))
    XcdBarrier bar; bar.bar = (unsigned*)(ws + WS_CTL) + CW_BAR; bar.x = 0; bar.st = nullptr; bar.wave = wave_s;
    if (hi - lo > 1) bar = xcd_barrier_post((unsigned*)(ws + WS_CTL) + CW_BAR, MISC + 8, wave_s);
#if PROBE_TS
    if (bx == 0 && TID() == 0) { ((unsigned long long*)(ws + WS_CTL + 65536))[0] = __builtin_amdgcn_s_memrealtime(); ((unsigned long long*)(ws + WS_CTL + 65536))[121] = ~0ull; }
#endif
#define EN(b) (((MK_EN_T) >> (b)) & 1u)
#define IN(k) (lo <= (k) && (k) < hi)
#if PROBE_TS
#define TS_WORDS ((unsigned long long*)(ws + WS_CTL + 65536))
#define PHASE_END(k) do { if (hi > (k) + 1) xcd_barrier(bar); if (bx == 0 && TID() == 0) TS_WORDS[(k) + 1] = __builtin_amdgcn_s_memrealtime(); } while (0)
#else
#define PHASE_END(k) do { if (hi > (k) + 1) xcd_barrier(bar); } while (0)
#endif
#define PH_IDS int tid = TID(); asm volatile("" : "+v"(tid)); const int lane = tid & 63; const int wave = wave_s; const int gw = vcu * 8 + wave; (void)lane; (void)gw;
#define XC_    ((float*)(ws + WS_XC))
#define MODV_  ((float*)(ws + WS_MODV))
#define TABM_  ((float*)(ws + WS_TABM))
#define TABR_  ((float*)(ws + WS_TABR))
#define SSQ_   ((float*)(ws + WS_SSQ))
#define KR_    ((bf16*)(ws + WS_KR))
#define H_     ((bf16*)(ws + WS_H))
#define WMIX_(ll) ((bf16*)(ws + (((ll) & 1) ? WS_WB : WS_WA)))
#define WFFN_(ll) ((bf16*)(ws + (((ll) & 1) ? WS_WB + 82 * MiB : WS_WA + 22 * MiB)))
#define W1T_   WMIX_(l)
#define WUQT_  (W1T_ + (size_t)N1 * D)
#define WUKVT_ (WUQT_ + (size_t)3072 * 512)
#define WOTM_  (WUKVT_ + (size_t)4096 * 512)
#define WQKVT_ WMIX_(l)
#define WGT_   (WQKVT_ + (size_t)8192 * D)
#define WOTR_  (WGT_ + (size_t)8192 * D)
#define WGUT_  WFFN_(l)
#define WDT_   (WGUT_ + (size_t)11264 * D)
#define QKVL_  ((bf16*)(ws + WS_QKVL))
#define Q_     ((bf16*)(ws + WS_Q))
#define KV_    ((bf16*)(ws + WS_KV))
#define O_     ((bf16*)(ws + WS_O))
#define QKV_   ((bf16*)(ws + WS_QKV))
#define Y_     ((bf16*)(ws + WS_Y))
#define GATED_ ((bf16*)(ws + WS_GATED))
#define GB_    ((bf16*)(ws + WS_G))
#define UB_    ((bf16*)(ws + WS_U))
#define HALO_  ((float*)(ws + WS_G))
#define MODL_  (MODV_ + (size_t)l * 9 * NMOD)

    if (EN(0) && IN(0)) for (int rep_ = 0; rep_ < 1 + (int)((PROBE_MASK >> 0) & 1u); ++rep_) {
        PH_IDS
        mod_layers(lds, ws, 0, 1, bx, G, tid, lane, wave);
        __syncthreads();
        cvt_layer(lds, ws, 0, gw, NGW, wave, lane, 2);
        for (int i = bx * 512 + tid; i < 64 * 16 + SEQ * 128; i += G * 512) {
            float inv, pos; float* dst;
            if (i < 1024) { const int p = i >> 4, f = i & 15; inv = __builtin_amdgcn_exp2f(-(float)(2 * f) * (13.287712379549449f / 32.0f)); pos = (float)p; dst = TABM_ + 2 * i; }
            else { const int j = i - 1024, t = j >> 7, f = j & 127; inv = __builtin_amdgcn_exp2f(-(float)(2 * f) * (13.287712379549449f / 256.0f)); pos = (float)t; dst = TABR_ + 2 * j; }
            const float ang = pos * inv; const double rev = (double)ang * 0.15915494309189535; const float fr = (float)(rev - floor(rev));
            dst[0] = __builtin_amdgcn_cosf(fr); dst[1] = __builtin_amdgcn_sinf(fr);
        }
        PHASE_END(0);
    }

    for (int l = 0; l < DEPTH; ++l) {
        const int P = 1 + PH_PER_LAYER * l; const int li = l >> 1; const bool is_ret = (l & 1) != 0; const bool last = (l == DEPTH - 1);
        const int Mrows = last ? MX : MT;

        if (EN(1) && IN(P + 0)) for (int rep_ = 0; rep_ < 1 + (int)((PROBE_MASK >> 1) & 1u); ++rep_) {
            PH_IDS
            const float* g = ARGF(6) + l * D; const float* xsrc = (l == 0) ? ARGF(0) : X; const float* csrc = (l == 0) ? ARGF(2) : XC_;
            norm_phase(xsrc, csrc, g, MODL_, 0, H_, MT, gw, NGW, lane);
            PHASE_END(P + 0);
        }

        if (!is_ret) {
            if (EN(2) && IN(P + 1)) for (int rep_ = 0; rep_ < 1 + (int)((PROBE_MASK >> 2) & 1u); ++rep_) {
                pg8::Gemm g{H_, W1T_, MT, N1, D, D}; pg8::StaticOrder S; S.init(MT, N1, G, bx); S.tid = TID();
                EpiG1 E{QKVL_, SSQ_, KR_, TABM_};
                pg8::gemm_phase<EpiG1>(lds, g, S, E);
                PHASE_END(P + 1);
            }
            if (EN(3) && IN(P + 2)) for (int rep_ = 0; rep_ < 1 + (int)((PROBE_MASK >> 3) & 1u); ++rep_) {
                { pg8::Gemm g{QKVL_, WUQT_, MT, 3072, QR, N1}; pg8::StaticOrder S; S.init(MT, 3072, G, bx); S.tid = TID(); EpiUq E{Q_, SSQ_, TABM_}; pg8::gemm_phase<EpiUq>(lds, g, S, E); }
                { pg8::Gemm g{QKVL_ + 512, WUKVT_, MT, 4096, KVR, N1}; pg8::StaticOrder S; S.init(MT, 4096, G, bx); S.tid = TID(); EpiUkv E{KV_, SSQ_}; pg8::gemm_phase<EpiUkv>(lds, g, S, E); }
                PHASE_END(P + 2);
            }
            if (EN(4) && IN(P + 3)) for (int rep_ = 0; rep_ < 1 + (int)((PROBE_MASK >> 4) & 1u); ++rep_) {
                const int nun = 2048 + 128;
                for (int ui = vcu; ui < nun; ui += G) {
                    if (ui < 2048) { const int xcd = (ui & 255) >> 5, j = ui & 31, rnd = ui >> 8; const int bh = xcd * 16 + 2 * rnd + (j >> 4), qb = j & 15; const int b = bh >> 4, hd = bh & 15;
                        att::attn_unit(Q_ + (size_t)(b * SEQ + qb * 256) * 3072 + hd * DQ, KV_ + hd * 256, KR_, O_ + (size_t)(b * SEQ + qb * 256) * D + hd * 128, 68, 4, MX + b * CTXL, b * SEQ, (char*)lds_raw, TID()
#if PROBE_TS
                            , bx == 0 ? TS_WORDS : nullptr
#endif
                            );
                    } else { const int bh = ui - 2048, b = bh >> 4, hd = bh & 15;
                        att::attn_unit(Q_ + (size_t)(MX + b * CTXL) * 3072 + hd * DQ, KV_ + hd * 256, KR_, O_ + (size_t)(MX + b * CTXL) * D + hd * 128, 4, 4, MX + b * CTXL, 0, (char*)lds_raw, TID()); }
                }
                PHASE_END(P + 3);
            }
        } else {
            if (EN(5) && IN(P + 1)) for (int rep_ = 0; rep_ < 1 + (int)((PROBE_MASK >> 5) & 1u); ++rep_) {
                pg8::Gemm g{H_, WQKVT_, MT, 8192, D, D}; pg8::StaticOrder S; S.init(MT, 8192, G, bx); S.tid = TID();
                EpiQKV E{QKV_, TABR_};
                pg8::gemm_phase<EpiQKV>(lds, g, S, E);
                PHASE_END(P + 1);
            }
            if (EN(6) && IN(P + 2)) for (int rep_ = 0; rep_ < 1 + (int)((PROBE_MASK >> 6) & 1u); ++rep_) {
                for (int ui = vcu; ui < 256; ui += G) {
                    const int bh = ui >> 2, dir = (ui >> 1) & 1, dvh = ui & 1; const int b = bh >> 3, hd = bh & 7;
                    const float dec = (dir ? ARGF(22) : ARGF(21))[li * RH + hd];
                    const float lg2 = -__expf(dec) * LOG2E;
                    scan::scan_unit(QKV_, Y_ + (size_t)dir * MT * 4096, b, hd, dir, dvh, lg2, last, lds, TID()
#if PROBE_TS
                                    , TS_WORDS
#endif
                                    );
                }
                PHASE_END(P + 2);
            }
            if (EN(7) && IN(P + 3)) for (int rep_ = 0; rep_ < 1 + (int)((PROBE_MASK >> 7) & 1u); ++rep_) {
                PH_IDS
                for (int row = gw; row < Mrows; row += NGW) {
                    u32x4 w[16];
#pragma unroll
                    for (int q = 0; q < 16; ++q) w[q] = *(const u32x4*)(Y_ + (size_t)(q >> 3) * MT * 4096 + (size_t)row * 4096 + (q & 7) * RDV + lane * 8);
                    float mu[16], rs[16];
#pragma unroll
                    for (int q = 0; q < 16; ++q) { const float s = ((bflo(w[q].x) + bfhi(w[q].x)) + (bflo(w[q].y) + bfhi(w[q].y))) + ((bflo(w[q].z) + bfhi(w[q].z)) + (bflo(w[q].w) + bfhi(w[q].w))); mu[q] = s; }
#pragma unroll
                    for (int o = 1; o < 64; o <<= 1)
#pragma unroll
                        for (int q = 0; q < 16; ++q) mu[q] += shfl_xor_l(mu[q], o, lane);
#pragma unroll
                    for (int q = 0; q < 16; ++q) { mu[q] *= (1.0f / RDV); const float m_ = mu[q];
                        const float d0 = bflo(w[q].x) - m_, d1 = bfhi(w[q].x) - m_, d2 = bflo(w[q].y) - m_, d3 = bfhi(w[q].y) - m_, d4 = bflo(w[q].z) - m_, d5 = bfhi(w[q].z) - m_, d6 = bflo(w[q].w) - m_, d7 = bfhi(w[q].w) - m_;
                        rs[q] = ((d0 * d0 + d1 * d1) + (d2 * d2 + d3 * d3)) + ((d4 * d4 + d5 * d5) + (d6 * d6 + d7 * d7)); }
#pragma unroll
                    for (int o = 1; o < 64; o <<= 1)
#pragma unroll
                        for (int q = 0; q < 16; ++q) rs[q] += shfl_xor_l(rs[q], o, lane);
                    float mo = 0.f, ro = 0.f;
#pragma unroll
                    for (int q = 0; q < 16; ++q) { if (lane == q) { mo = mu[q]; ro = rs[q]; } }
                    if (lane < 16) *(f32x2*)((float*)(ws + WS_STATS) + ((size_t)((lane >> 3) * MT + row) * 8 + (lane & 7)) * 2) = (f32x2){mo, 1.0f / sqrtf(ro * (1.0f / RDV) + GN_EPS)};
                }
                PHASE_END(P + 3);
            }
            if (EN(8) && IN(P + 4)) for (int rep_ = 0; rep_ < 1 + (int)((PROBE_MASK >> 8) & 1u); ++rep_) {
                pg8::Gemm g{H_, WGT_, Mrows, 8192, D, D}; pg8::StaticOrder S; S.init(Mrows, 8192, G, bx); S.tid = TID();
                EpiGate E{GATED_, Y_, Y_ + (size_t)MT * 4096, (const float*)(ws + WS_STATS)};
                pg8::gemm_phase<EpiGate>(lds, g, S, E);
                PHASE_END(P + 4);
            }
        }
        if (EN(9) && IN(P + 5)) for (int rep_ = 0; rep_ < 1 + (int)((PROBE_MASK >> 9) & 1u); ++rep_) {
#if MLA_CHECK
            if (l == MLA_CHECK_LAYER) { PH_IDS mla_check(lds, ws, li, gw, wave, lane); __syncthreads(); }
#endif
            pg8::Gemm g = is_ret ? pg8::Gemm{GATED_, WOTR_, Mrows, D, 4096, 4096} : pg8::Gemm{O_, WOTM_, Mrows, D, D, D};
            pg8::StaticOrder S; S.init(Mrows, D, G, bx, 4, true); S.tid = TID();
#if PROBE_TS
            S.probe = is_ret ? 2 : 1; S.tsw = TS_WORDS;
#endif
            const float* xsrc = (l == 0) ? ARGF(0) : X; const float* csrc = (l == 0) ? ARGF(2) : XC_;
            EpiResid E{xsrc, X, csrc, XC_, MODL_, 2 * D};
            pg8::gemm_phase<EpiResid>(lds, g, S, E);
            if (l + 1 < DEPTH) {
                PH_IDS
                const int nwg = (Mrows / 256) * (D / 256), rem = nwg % G;
                if (rem == 0) cvt_layer(lds, ws, l + 1, gw, NGW, wave, lane, 0);
                else if (bx >= rem) cvt_layer(lds, ws, l + 1, (bx - rem) * 8 + wave, (G - rem) * 8, wave, lane, 0);
            }
            PHASE_END(P + 5);
        }
        if (EN(10) && IN(P + 6)) for (int rep_ = 0; rep_ < 1 + (int)((PROBE_MASK >> 10) & 1u); ++rep_) {
            PH_IDS
            const float* g = ARGF(7) + l * D;
            norm_phase(X, XC_, g, MODL_, 3, H_, Mrows, gw, NGW, lane);
            PHASE_END(P + 6);
        }
        if (EN(11) && IN(P + 7)) for (int rep_ = 0; rep_ < 1 + (int)((PROBE_MASK >> 11) & 1u); ++rep_) {
            pg8::Gemm g{H_, WGUT_, Mrows, 11264, D, D}; pg8::StaticOrder S; S.init(Mrows, 11264, G, bx); S.tid = TID();
#if PROBE_TS
            S.probe = 4; S.tsw = TS_WORDS;
#endif
            EpiGUConv E{UB_, HALO_, ARGF(25) + (size_t)l * 3 * FF, ARGF(26) + (size_t)l * FF, (LAS float*)(lds + EDGE_OFF)};
            pg8::gemm_phase<EpiGUConv>(lds, g, S, E);
#if PROBE_TS
            if (TID() == 0 && bx == 0) TS_WORDS[140 + l] = __builtin_amdgcn_s_memrealtime();
            if (TID() == 0 && bx == G - 1) TS_WORDS[148 + l] = __builtin_amdgcn_s_memrealtime();
#endif
            PHASE_END(P + 7);
        }
        if (EN(13) && IN(P + 9)) for (int rep_ = 0; rep_ < 1 + (int)((PROBE_MASK >> 13) & 1u); ++rep_) {
            pg8::Gemm g{UB_, WDT_, Mrows, D, FF, FF}; pg8::StaticOrder S; S.init(Mrows, D, G, bx, 4, true); S.tid = TID();
#if PROBE_TS
            S.probe = 3; S.tsw = TS_WORDS;
#endif
            {
                PH_IDS
                const float* cw = ARGF(25) + (size_t)l * 3 * FF; const float* HL = HALO_; bf16* ACT = UB_;
                pg8::Unit uu; int prev_pm = -1;
                for (int i = 0; S.next(i, uu); ++i) { const int pm = uu.pm; if (pm == prev_pm || pm >= MX / 256) { prev_pm = pm; continue; } prev_pm = pm;
                    const bool top = (pm & 15) != 0, bot = ((pm + 1) & 15) != 0;
                    for (int q = tid; q < FF / 4; q += 512) { const int f = q * 4;
                        if (top) { const float* t0 = HL + (size_t)((pm * 2 + 0) * 3) * HALO_STRIDE + f; const float* b1 = HL + (size_t)(((pm - 1) * 2 + 1) * 3) * HALO_STRIDE + f;
                            const f32x4 o = silu4(*(const f32x4*)t0 + *(const f32x4*)(cw + f) * *(const f32x4*)(b1 + HALO_STRIDE)) * *(const f32x4*)(t0 + 2 * HALO_STRIDE);
                            u32x2 w; w.x = cvt_pk_bf16(o[0], o[1]); w.y = cvt_pk_bf16(o[2], o[3]); *(u32x2*)(ACT + (size_t)(pm * 256) * FF + f) = w; }
                        if (bot) { const float* b0 = HL + (size_t)((pm * 2 + 1) * 3) * HALO_STRIDE + f; const float* t1 = HL + (size_t)(((pm + 1) * 2 + 0) * 3) * HALO_STRIDE + f;
                            const f32x4 o = silu4(*(const f32x4*)b0 + *(const f32x4*)(cw + 2 * FF + f) * *(const f32x4*)(t1 + HALO_STRIDE)) * *(const f32x4*)(b0 + 2 * HALO_STRIDE);
                            u32x2 w; w.x = cvt_pk_bf16(o[0], o[1]); w.y = cvt_pk_bf16(o[2], o[3]); *(u32x2*)(ACT + (size_t)(pm * 256 + 255) * FF + f) = w; } } }
                asm volatile("s_waitcnt vmcnt(0)" ::: "memory"); __syncthreads();
            }
            EpiResid E{X, X, XC_, XC_, MODL_, 5 * D};
            pg8::gemm_phase<EpiResid>(lds, g, S, E);
#if PROBE_TS
            if (TID() == 0 && bx == 0) TS_WORDS[64 + l] = __builtin_amdgcn_s_memrealtime();
            if (TID() == 0 && bx == G - 1) TS_WORDS[72 + l] = __builtin_amdgcn_s_memrealtime();
#endif
            if (l + 1 < DEPTH) {
                PH_IDS
                const int nwg = (Mrows / 256) * (D / 256), rem = nwg % G;
                if (rem == 0) { mod_layers(lds, ws, l + 1, l + 2, bx, G, tid, lane, wave); __syncthreads(); cvt_layer(lds, ws, l + 1, gw, NGW, wave, lane, 1); }
                else if (bx >= rem) { mod_layers(lds, ws, l + 1, l + 2, bx - rem, G - rem, tid, lane, wave); __syncthreads(); cvt_layer(lds, ws, l + 1, (bx - rem) * 8 + wave, (G - rem) * 8, wave, lane, 1); }
            }
#if PROBE_TS
            __syncthreads(); if (TID() == 0 && bx == G - 1) TS_WORDS[80 + l] = __builtin_amdgcn_s_memrealtime();
#endif
            PHASE_END(P + 9);
        }
    }
    if (EN(14) && IN(PH_FINAL)) for (int rep_ = 0; rep_ < 1 + (int)((PROBE_MASK >> 14) & 1u); ++rep_) {
        PH_IDS
        const float* g = ARGF(28);
#if PROBE_TS
        float ts_c = 0.f, ts_a = 0.f;
        { const unsigned long long* TS = (const unsigned long long*)(ws + WS_CTL + 65536); unsigned long long last = TS[0]; const unsigned long long t0 = last; float d1 = 0.f, d2 = 0.f;
          for (int k = 0; k < PH_FINAL; ++k) { const unsigned long long te = TS[k + 1]; if (te == 0ull) continue; const float d = (float)(te - last); last = te;
              int cls; if (k == 0) cls = 0; else { const int slot = (k - 1) % PH_PER_LAYER, ll = (k - 1) / PH_PER_LAYER; const bool ret = (ll & 1) != 0;
                  cls = slot == 0 ? 1 : slot >= 5 ? 5 + slot : (!ret ? 1 + slot : 4 + slot); }
              if (k > 0 && ((k - 1) % PH_PER_LAYER) == 5) { const bool ret5 = (((k - 1) / PH_PER_LAYER) & 1) != 0; if (TS_CLASS1 == (ret5 ? 51 : 50)) d1 += d; if (TS_CLASS2 == (ret5 ? 51 : 50)) d2 += d; }
              if (cls == TS_CLASS1) d1 += d; if (cls == TS_CLASS2) d2 += d; }
          float tot = (float)(last - t0);
          if (TS_CLASS1 >= 100) { float ph = 0.f, x0 = 0.f, x1 = 0.f, x2 = 0.f;
              for (int ll = 0; ll < 3; ++ll) { const unsigned long long st = TS[(1 + PH_PER_LAYER * ll + 7) + 1], en = TS[(1 + PH_PER_LAYER * ll + 9) + 1];
                  ph += (float)(en - st); x0 += (float)(TS[64 + ll] - st); x1 += (float)(TS[72 + ll] - st); x2 += (float)(TS[80 + ll] - st); }
              d1 = (TS_CLASS1 == 100) ? x0 : (TS_CLASS1 == 101) ? x1 : x2; d2 = (TS_CLASS2 == 100) ? x0 : (TS_CLASS2 == 101) ? x1 : x2; tot = ph; }
          if (TS_CLASS1 >= 200) { const unsigned long long* tw = TS + 90 + 3 * (TS_CLASS1 - 201); const float lp = (float)tw[0], ep = (float)tw[1], nn = (float)tw[2];
              d1 = lp; tot = lp + ep; d2 = (lp + ep) / nn / 100.f / 200.f * tot; }
          if (TS_CLASS1 == 400) { float ph = 0.f, x0 = 0.f, x1 = 0.f;
              for (int ll = 0; ll < 4; ++ll) { const unsigned long long st = TS[(1 + PH_PER_LAYER * ll + 6) + 1], en = TS[(1 + PH_PER_LAYER * ll + 7) + 1];
                  ph += (float)(en - st); x0 += (float)(TS[140 + ll] - st); x1 += (float)(TS[148 + ll] - st); }
              d1 = x0; d2 = x1; tot = ph; }
          if (TS_CLASS1 == 500) { d1 = (float)TS[160]; d2 = (float)TS[161]; tot = (float)TS[162]; }
          if (TS_CLASS1 == 501) { d1 = (float)TS[162] / (float)TS[163] / 100.f / 5.f; d2 = 0.f; tot = 1.f; }
          if (TS_CLASS1 == 600) { d1 = (float)TS[170]; d2 = (float)TS[171]; tot = (float)TS[172]; }
          if (TS_CLASS1 == 300) { const float mx = (float)TS[120], sm = (float)TS[122]; d1 = sm / (float)(gridDim.x * 4); tot = mx > 0.f ? mx : 1.f; d2 = 0.f; }
          { const float q1 = rintf(d1 / tot * 20.f) / 20.f, q2 = rintf(d2 / tot * 20.f) / 20.f; ts_c = sqrtf(q1); ts_a = 2.0f + 10.0f * q2; }
        }
#endif
#if MLA_CHECK
        const bool chk_bad = __uint_as_float(__hip_atomic_load((unsigned*)(ws + WS_CTL) + CW_CHK, __ATOMIC_RELAXED, __HIP_MEMORY_SCOPE_AGENT)) > MLA_CHECK_TOL;
#endif
        if (gw < MX) {
            f32x4 v[8], vn[8]; int m = gw; row_load(X + (size_t)m * D, lane, v);
            for (;;) {
                const int mn = m + NGW; const bool has = mn < MX;
                if (has) row_load(X + (size_t)mn * D, lane, vn);
                float s = 0.f;
#pragma unroll
                for (int j = 0; j < 8; ++j) s += (v[j][0] * v[j][0] + v[j][1] * v[j][1]) + (v[j][2] * v[j][2] + v[j][3] * v[j][3]);
                const float rstd = 1.0f / sqrtf(wave_sum(s, lane) * (1.0f / D) + NORM_EPS);
                float* xr = X + (size_t)m * D;
#pragma unroll
                for (int j = 0; j < 8; ++j) { const int c = 4 * lane + 256 * j; f32x4 o_ = (v[j] * rstd) * *(const f32x4*)(g + c);
#if MLA_CHECK
                    if (chk_bad) o_ = (f32x4){__builtin_nanf(""), __builtin_nanf(""), __builtin_nanf(""), __builtin_nanf("")};
#endif
#if PROBE_TS
                    if (m < 328) { o_ = o_ + ts_c; if (m == 0 && c == 0) o_[0] += ts_a - ts_c; }
#endif
                    *(f32x4*)(xr + c) = o_; }
                if (!has) break;
#pragma unroll
                for (int j = 0; j < 8; ++j) v[j] = vn[j];
                m = mn;
            }
        }
    }
#undef IN
#undef PHASE_END
}

#if !MK_SINGLE
typedef void (*KernFn)(Args);
static KernFn phase_kernel(int bit) {
    switch (bit) {
        case 0: return mk_fwd<1u << 0>;  case 1: return mk_fwd<1u << 1>;  case 2: return mk_fwd<1u << 2>;  case 3: return mk_fwd<1u << 3>;
        case 4: return mk_fwd<1u << 4>;  case 5: return mk_fwd<1u << 5>;  case 6: return mk_fwd<1u << 6>;  case 7: return mk_fwd<1u << 7>;
        case 8: return mk_fwd<1u << 8>;  case 9: return mk_fwd<1u << 9>;  case 10: return mk_fwd<1u << 10>; case 11: return mk_fwd<1u << 11>;
        case 12: return mk_fwd<1u << 12>; case 13: return mk_fwd<1u << 13>; default: return mk_fwd<1u << 14>;
    }
}
static int phase_bit(int p) {
    if (p == 0) return 0; if (p == PH_FINAL) return 14;
    const int l = (p - 1) / PH_PER_LAYER, slot = (p - 1) % PH_PER_LAYER; const bool ret = (l & 1) != 0;
    if (slot == 0) return 1;
    if (slot >= 5) return 4 + slot;
    if (!ret) return slot == 4 ? -1 : 1 + slot;
    return 4 + slot;
}
#endif
extern "C" void kernel_launch(void* const* d_in, const int* in_sizes, int n_in, void* d_out, int out_size, void* d_ws, size_t ws_size, hipStream_t stream) {
    static int grid = 0;
    if (grid == 0) {
        if (n_in != 29 || out_size != MX * D || ws_size < WS_END) { fprintf(stderr, "kernel_launch: unexpected shapes: n_in %d out %d ws %zu (need %zu)\n", n_in, out_size, ws_size, (size_t)WS_END); grid = -1; return; }
        int dev = 0, cus = 0;
        if (hipGetDevice(&dev) != hipSuccess || hipDeviceGetAttribute(&cus, hipDeviceAttributeMultiprocessorCount, dev) != hipSuccess) { grid = -1; return; }
#if MK_SINGLE
        if (hipFuncSetAttribute((const void*)mk_fwd<0xFFFFFFFFu>, hipFuncAttributeMaxDynamicSharedMemorySize, LDS_BYTES) != hipSuccess) { fprintf(stderr, "kernel_launch: hipFuncSetAttribute failed\n"); grid = -1; return; }
#else
        for (int b = 0; b < 15; ++b) if (hipFuncSetAttribute((const void*)phase_kernel(b), hipFuncAttributeMaxDynamicSharedMemorySize, LDS_BYTES) != hipSuccess) { fprintf(stderr, "kernel_launch: hipFuncSetAttribute failed\n"); grid = -1; return; }
#endif
        (void)hipGetLastError();
        grid = cus;
    }
    if (grid < 0) return;
    if (hipMemsetAsync((char*)d_ws + WS_CTL, 0, CTL_BYTES, stream) != hipSuccess) return;
    Args a{};
    for (int i = 0; i < 29; ++i) a.in[i] = (const float*)d_in[i];
    a.out = (float*)d_out; a.ws = (unsigned char*)d_ws;
#if MK_SINGLE
    a.ph_lo = 0; a.ph_hi = PH_COUNT;
    hipLaunchKernelGGL(mk_fwd<0xFFFFFFFFu>, dim3(grid), dim3(512), LDS_BYTES, stream, a);
#else
    for (int p = 0; p < PH_COUNT; ++p) {
        const int bit = phase_bit(p); if (bit < 0) continue;
        a.ph_lo = p; a.ph_hi = p + 1;
        hipLaunchKernelGGL(phase_kernel(bit), dim3(grid), dim3(512), LDS_BYTES, stream, a);
    }
#endif
    const hipError_t le = hipPeekAtLastError();
    if (le != hipSuccess) fprintf(stderr, "kernel_launch: launch failed: %s\n", hipGetErrorName(le));
}
```

```cpp
#include <hip/hip_runtime.h>
#include <cstdio>
#include <cstdint>

#ifndef MK_SINGLE
#define MK_SINGLE 1
#endif

#ifndef MK_STAGGER
#define MK_STAGGER 0
#endif
#ifndef PROBE_EPI2
#define PROBE_EPI2 0
#endif
#ifndef MLA_CHECK
#define MLA_CHECK 0
#endif
#ifndef MLA_CHECK_LAYER
#define MLA_CHECK_LAYER 0
#endif
#ifndef MLA_CHECK_TOL
#define MLA_CHECK_TOL 0.03f
#endif
#ifndef PROBE_TS
#define PROBE_TS 0
#endif
#ifndef TS_SKEW_ID
#define TS_SKEW_ID 4
#endif
#ifndef TS_CLASS1
#define TS_CLASS1 0
#endif
#ifndef TS_CLASS2
#define TS_CLASS2 1
#endif
#ifndef PROBE_MASK
#define PROBE_MASK 0u
#endif
#define GAS __attribute__((address_space(1)))
#define LAS __attribute__((address_space(3)))
typedef unsigned short bf16;
typedef short bf16x8 __attribute__((ext_vector_type(8)));
typedef short s16x4 __attribute__((ext_vector_type(4)));
typedef float f32x2 __attribute__((ext_vector_type(2)));
typedef float f32x4 __attribute__((ext_vector_type(4)));
typedef float f32x16 __attribute__((ext_vector_type(16)));
typedef unsigned u32x2 __attribute__((ext_vector_type(2)));
typedef unsigned u32x4 __attribute__((ext_vector_type(4)));
typedef GAS unsigned gu32;

constexpr int D = 2048, NB = 8, SEQ = 4096, CTXL = 256, DEPTH = 4;
constexpr int MX = NB * SEQ, MC = NB * CTXL, MT = MX + MC;
constexpr int FF = 5632, NMOD = 6 * D;
constexpr int MLA_H = 16, QR = 512, KVR = 512, NOPE = 128, ROPE = 64, DQ = 192;
constexpr int N1 = 1280;
constexpr int RH = 8, RDK = 256, RDV = 512;
constexpr float NORM_EPS = 1e-6f, GN_EPS = 1e-5f;
constexpr float LOG2E = 1.4426950408889634f;

constexpr size_t MiB = 1u << 20;
constexpr size_t WS_CTL = 0, CTL_BYTES = 1 * MiB;
constexpr size_t WS_MODV = 1 * MiB;
constexpr size_t WS_TABM = 3 * MiB;
constexpr size_t WS_TABR = 4 * MiB;
constexpr size_t WS_SSQ = 8 * MiB;
constexpr size_t WS_XC = 12 * MiB;
constexpr size_t WS_KR = 28 * MiB;
constexpr size_t WS_STATS = 33 * MiB;
constexpr size_t WS_WA = 40 * MiB;
constexpr size_t WS_WB = 128 * MiB;
constexpr size_t WS_H = 276 * MiB;
constexpr size_t WS_BIG = 412 * MiB;
constexpr size_t WS_QKVL = WS_BIG, WS_Q = WS_BIG + 88 * MiB, WS_KV = WS_BIG + 292 * MiB, WS_O = WS_BIG + 564 * MiB;
constexpr size_t WS_QKV = WS_BIG, WS_Y = WS_BIG + 544 * MiB, WS_GATED = WS_BIG;
constexpr size_t WS_G = WS_BIG, WS_U = WS_BIG + 374 * MiB;
constexpr size_t WS_END = WS_BIG + 1088 * MiB;
static_assert((size_t)MT * 8192 * 2 <= 544 * MiB && (size_t)MT * 5632 * 2 <= 374 * MiB && (size_t)MT * N1 * 2 <= 88 * MiB, "ws map");

constexpr int CW_BAR = 4096;

constexpr int RING_BYTES = 131072, CTRL_BASE = 155648, MISC_OFF = CTRL_BASE + 320, ARGS_OFF = CTRL_BASE + 1024, EDGE_OFF = CTRL_BASE + 4096, LDS_BYTES = 163840;

__device__ __forceinline__ unsigned cvt_pk_bf16(float lo, float hi) { unsigned r; asm volatile("v_cvt_pk_bf16_f32 %0, %1, %2" : "=v"(r) : "v"(lo), "v"(hi)); return r; }
__device__ __forceinline__ float bf2f(unsigned short b) { return __uint_as_float((unsigned)b << 16); }
__device__ __forceinline__ float bflo(unsigned w) { return __uint_as_float(w << 16); }
__device__ __forceinline__ float bfhi(unsigned w) { return __uint_as_float(w & 0xffff0000u); }
__device__ __forceinline__ float shfl_xor_l(float v, int mask, int lane) { return __builtin_bit_cast(float, __builtin_amdgcn_ds_bpermute((lane ^ mask) << 2, __builtin_bit_cast(int, v))); }
__device__ __forceinline__ float fast_silu(float x) { return x * __builtin_amdgcn_rcpf(1.0f + __builtin_amdgcn_exp2f(-x * LOG2E)); }

__device__ __forceinline__ int lane_id() { int x; asm volatile("v_mbcnt_lo_u32_b32 %0, -1, 0\n\tv_mbcnt_hi_u32_b32 %0, -1, %0" : "=v"(x)); return x; }
__device__ __forceinline__ void glds16_s(const void* sbase, unsigned voff, unsigned lds_dst) {
    unsigned keep;
    asm volatile("s_mov_b32 %0, m0\n\ts_mov_b32 m0, %3\n\ts_nop 0\n\tglobal_load_lds_dwordx4 %1, %2\n\ts_mov_b32 m0, %0" : "=&s"(keep) : "v"(voff), "s"(sbase), "s"(lds_dst) : "memory");
}
__device__ __forceinline__ const char* uni_ptr(const void* p) {
    const unsigned long long v = (unsigned long long)p; const unsigned lo = __builtin_amdgcn_readfirstlane((unsigned)v), hi = __builtin_amdgcn_readfirstlane((unsigned)(v >> 32));
    return (const char*)(((unsigned long long)hi << 32) | lo);
}
namespace pg8 {
constexpr int BM = 256, BK = 64, HALF = 128, HTB = HALF * BK * 2, STAGE_BYTES = 8 * HTB, NXCD = 8, WGM = 8;
__host__ __device__ __forceinline__ int lds_byte(int r, int c) { const int st = (r >> 4) * 2 + (c >> 5), rr = r & 15, cc = c & 31, ob = rr * 64 + cc * 2; return st * 1024 + (ob ^ (((ob >> 9) & 1) << 5)); }
__host__ __device__ __forceinline__ void stage_rc(int b, int& R, int& C) { const int st = b / 1024, sb = b % 1024, swz = sb ^ (((sb >> 9) & 1) << 5); R = (st >> 1) * 16 + swz / 64; C = (st & 1) * 32 + (swz % 64) / 2; }
__host__ __device__ __forceinline__ int perm32(int rho) { const int n = rho >> 4, i = rho & 15; return 8 * (i >> 2) + 4 * n + (i & 3); }
struct Unit { int pm, pn; };
struct Gemm { const bf16* A; const bf16* Bt; int M, N, K, lda; };
struct StaticOrder {
    int nM, nN, nwg, G, c, wgm, delay = 0, probe = 0, tid = 0; bool rev; unsigned long long* tsw = nullptr;
    __device__ __forceinline__ void init(int M, int N, int G_, int c_, int wgm_ = WGM, bool rev_ = false) { nM = M / BM; nN = N / BM; nwg = nM * nN; G = G_; c = c_; wgm = wgm_; rev = rev_; }
    __device__ __forceinline__ bool next(int i, Unit& u) const {
        const long L = (long)i * G + c; if (L >= nwg) return false;
        int wgid = (int)L; { const int q = nwg / NXCD, r = nwg % NXCD, xcd = wgid % NXCD, off = wgid / NXCD; wgid = (xcd < r ? xcd * (q + 1) : r * (q + 1) + (xcd - r) * q) + off; }
        const int nig = wgm * nN, gid = wgid / nig, fm = gid * wgm, gsz = (nM - fm) < wgm ? (nM - fm) : wgm;
        u.pm = fm + ((wgid % nig) % gsz); u.pn = (wgid % nig) / gsz; if (rev) u.pm = nM - 1 - u.pm; return true;
    }
};
template <class Epi>
__device__ __forceinline__ void gemm_phase(LAS unsigned char* lds, const Gemm g, const StaticOrder& S, const Epi& E) {
    int tid = S.tid; asm volatile("" : "+v"(tid));
    const int wid = __builtin_amdgcn_readfirstlane(tid >> 6), lane = tid & 63, wr = wid >> 2, wc = wid & 3, fr = lane & 15, fq = lane >> 4;
    const int K = g.K, nt = K / BK;
    unsigned voffA[2], voffB[2];
#pragma unroll
    for (int i = 0; i < 2; ++i) { int R, C; stage_rc(tid * 16 + i * 8192, R, C); const int Rb = Epi::PERM ? ((R & ~31) + perm32(R & 31)) : R;
        voffA[i] = (unsigned)(R * g.lda + C) * 2u; voffB[i] = (unsigned)(Rb * K + C) * 2u; }
    const size_t kstep = (size_t)(BK * 2);
    const size_t hstepA = (size_t)HALF * g.lda * 2, hstepB = (size_t)HALF * K * 2;
    const size_t tstepA = 2 * hstepA, tstepB = 2 * hstepB;
    const unsigned ldsbase = (unsigned)__builtin_amdgcn_readfirstlane((unsigned)(uintptr_t)lds + (unsigned)wid * 1024u);
    const int aoff = lds_byte(wr * 64 + fr, fq * 8), boff = lds_byte(wc * 32 + fr, fq * 8);
#define PG8_SA(b, h) (((b) * 2 + (h)) * HTB)
#define PG8_SB(b, h) ((4 + (b) * 2 + (h)) * HTB)
#define PG8_STAGE(bufoff, gbase, voff) do { const char* _gb = uni_ptr(gbase); _Pragma("unroll") for (int _i = 0; _i < 2; ++_i) \
        glds16_s(_gb, (voff)[_i], ldsbase + (unsigned)((bufoff) + _i * 8192)); } while (0)
#define PG8_LDA(dst, b, h) do { _Pragma("unroll") for (int m = 0; m < 4; ++m) _Pragma("unroll") for (int k = 0; k < 2; ++k) dst[m][k] = *(const LAS bf16x8*)(lds + PG8_SA(b, h) + aoff + m * 2048 + k * 1024); } while (0)
#define PG8_LDB(dst, b, h) do { _Pragma("unroll") for (int n = 0; n < 2; ++n) _Pragma("unroll") for (int k = 0; k < 2; ++k) dst[n][k] = *(const LAS bf16x8*)(lds + PG8_SB(b, h) + boff + n * 2048 + k * 1024); } while (0)
#define PG8_MMA(ai, bj, At, Bt) do { __builtin_amdgcn_s_setprio(1); _Pragma("unroll") for (int m = 0; m < 4; ++m) _Pragma("unroll") for (int n = 0; n < 2; ++n) _Pragma("unroll") for (int k = 0; k < 2; ++k) \
        acc[ai][bj][m][n] = __builtin_amdgcn_mfma_f32_16x16x32_bf16(Bt[n][k], At[m][k], acc[ai][bj][m][n], 0, 0, 0); __builtin_amdgcn_s_setprio(0); } while (0)
#define PG8_WAIT_V(n) asm volatile("s_waitcnt vmcnt(" #n ")" ::: "memory")
#define PG8_WAIT_L(n) asm volatile("s_waitcnt lgkmcnt(" #n ")" ::: "memory")
#define PG8_BAR __builtin_amdgcn_s_barrier()
#define PG8_SCHED __builtin_amdgcn_sched_barrier(0)
    Unit cur, nxt; int ui = 0;
    if (!S.next(0, cur)) return;
    if (S.delay) { const unsigned long long t0 = __builtin_amdgcn_s_memrealtime(); while (__builtin_amdgcn_s_memrealtime() - t0 < (unsigned long long)S.delay) __builtin_amdgcn_s_sleep(8); }
#if MK_STAGGER
    if (S.c & 1) {
        const unsigned long long t0 = __builtin_amdgcn_s_memrealtime(); const unsigned long long dt = (unsigned long long)nt * MK_STAGGER;
        while (__builtin_amdgcn_s_memrealtime() - t0 < dt) __builtin_amdgcn_s_sleep(8);
    }
#endif
    f32x4 acc[2][2][4][2];
#pragma unroll
    for (int a = 0; a < 2; ++a)
#pragma unroll
        for (int b = 0; b < 2; ++b)
#pragma unroll
            for (int m = 0; m < 4; ++m)
#pragma unroll
                for (int n = 0; n < 2; ++n) acc[a][b][m][n] = (f32x4){0.f, 0.f, 0.f, 0.f};
    bf16x8 At[4][2], B0[2][2], B1[2][2];
    const char* cA = (const char*)g.A + (size_t)cur.pm * tstepA; const char* cB = (const char*)g.Bt + (size_t)cur.pn * tstepB;
    PG8_STAGE(PG8_SB(0, 0), cB, voffB); PG8_STAGE(PG8_SB(0, 1), cB + hstepB, voffB); PG8_STAGE(PG8_SA(0, 0), cA, voffA); PG8_STAGE(PG8_SA(0, 1), cA + hstepA, voffA);
    if (wr == 1) PG8_BAR;
    PG8_WAIT_V(2); PG8_BAR;
    PG8_STAGE(PG8_SB(1, 0), cB + kstep, voffB); PG8_STAGE(PG8_SA(1, 0), cA + kstep, voffA); PG8_STAGE(PG8_SB(1, 1), cB + hstepB + kstep, voffB);
    PG8_WAIT_V(6); PG8_BAR;
#if PROBE_TS
    unsigned long long pt_loop = 0, pt_epi = 0, pt_n = 0, pt_t0 = __builtin_amdgcn_s_memrealtime();
#endif
    for (;;) {
        const bool has_next = S.next(ui + 1, nxt);
        const char* nA = has_next ? (const char*)g.A + (size_t)nxt.pm * tstepA : cA; const char* nB = has_next ? (const char*)g.Bt + (size_t)nxt.pn * tstepB : cB;
        for (int t = 0; t < nt; t += 2) {
            const bool last = (t == nt - 2);
            const char* a1 = cA + (size_t)(t + 1) * kstep;
            const char* a2 = last ? nA : cA + (size_t)(t + 2) * kstep; const char* b2 = last ? nB : cB + (size_t)(t + 2) * kstep;
            const char* a3 = a2 + kstep; const char* b3 = b2 + kstep;
            PG8_LDB(B0, 0, 0); PG8_LDB(B1, 0, 1); PG8_SCHED; PG8_LDA(At, 0, 0); PG8_STAGE(PG8_SA(1, 1), a1 + hstepA, voffA);
            PG8_WAIT_V(8); PG8_WAIT_L(0); PG8_BAR; PG8_MMA(0, 0, At, B0); PG8_MMA(0, 1, At, B1); PG8_BAR; PG8_SCHED;
            PG8_LDA(At, 0, 1); PG8_STAGE(PG8_SB(0, 0), b2, voffB); PG8_STAGE(PG8_SB(0, 1), b2 + hstepB, voffB); PG8_STAGE(PG8_SA(0, 0), a2, voffA);
            PG8_WAIT_V(8); PG8_WAIT_L(0); PG8_BAR; PG8_MMA(1, 0, At, B0); PG8_MMA(1, 1, At, B1); PG8_BAR; PG8_SCHED;
            PG8_LDB(B0, 1, 0); PG8_LDB(B1, 1, 1); PG8_SCHED; PG8_LDA(At, 1, 0); PG8_STAGE(PG8_SA(0, 1), a2 + hstepA, voffA);
            PG8_WAIT_V(8); PG8_WAIT_L(0); PG8_BAR; PG8_MMA(0, 0, At, B0); PG8_MMA(0, 1, At, B1); PG8_BAR; PG8_SCHED;
            PG8_LDA(At, 1, 1); PG8_STAGE(PG8_SB(1, 0), b3, voffB); PG8_STAGE(PG8_SB(1, 1), b3 + hstepB, voffB); PG8_STAGE(PG8_SA(1, 0), a3, voffA);
            PG8_WAIT_V(8); PG8_WAIT_L(0); PG8_BAR; PG8_MMA(1, 0, At, B0); PG8_MMA(1, 1, At, B1); PG8_BAR; PG8_SCHED;
        }
        if (wr == 0) PG8_BAR;
#if PROBE_TS
        const unsigned long long pt_t1 = __builtin_amdgcn_s_memrealtime();
#endif
        E(acc, cur, wr, wc, fr, fq);
#if PROBE_TS
        { asm volatile("s_waitcnt vmcnt(0)" ::: "memory"); const unsigned long long pt_t2 = __builtin_amdgcn_s_memrealtime(); pt_loop += pt_t1 - pt_t0; pt_epi += pt_t2 - pt_t1; pt_n += 1; pt_t0 = pt_t2; }
#endif
#if PROBE_EPI2
        if (Epi::PROBE2) E(acc, cur, wr, wc, fr, fq);
#endif
        if (!has_next) break;
#pragma unroll
        for (int a = 0; a < 2; ++a)
#pragma unroll
            for (int b = 0; b < 2; ++b)
#pragma unroll
                for (int m = 0; m < 4; ++m)
#pragma unroll
                    for (int n = 0; n < 2; ++n) acc[a][b][m][n] = (f32x4){0.f, 0.f, 0.f, 0.f};
        cur = nxt; cA = nA; cB = nB; ++ui;
        if (wr == 1) PG8_BAR;
    }
    PG8_WAIT_V(0);
    PG8_BAR;
#if PROBE_TS
    if (S.probe && S.c == 0 && tid == 0) { unsigned long long* tw = S.tsw + 90 + 3 * (S.probe - 1); tw[0] += pt_loop; tw[1] += pt_epi; tw[2] += pt_n; }
    if (S.probe == TS_SKEW_ID && tid == 0) { const unsigned long long dur = pt_loop + pt_epi; atomicMax(S.tsw + 120, dur); atomicMin(S.tsw + 121, dur); atomicAdd(S.tsw + 122, dur); }
#endif
#undef PG8_SA
#undef PG8_SB
#undef PG8_STAGE
#undef PG8_LDA
#undef PG8_LDB
#undef PG8_MMA
#undef PG8_WAIT_V
#undef PG8_WAIT_L
#undef PG8_BAR
#undef PG8_SCHED
}
}
using pg8::Unit;

__device__ __forceinline__ int slack_delay(int nwg, int G, int c, int unit_ticks) {
    const int rem = nwg % G; if (rem == 0 || c < rem) return 0;
    return (int)(((long long)(c - rem) * unit_ticks * 4) / ((long long)(G - rem) * 5));
}
__device__ __forceinline__ u32x4 pack8(const f32x4 a, const f32x4 b) { u32x4 w; w.x = cvt_pk_bf16(a[0], a[1]); w.y = cvt_pk_bf16(a[2], a[3]); w.z = cvt_pk_bf16(b[0], b[1]); w.w = cvt_pk_bf16(b[2], b[3]); return w; }
__device__ __forceinline__ f32x4 rot2(const f32x4 v, const f32x4 cs) { f32x4 o; o[0] = v[0] * cs[0] - v[1] * cs[1]; o[1] = v[1] * cs[0] + v[0] * cs[1]; o[2] = v[2] * cs[2] - v[3] * cs[3]; o[3] = v[3] * cs[2] + v[2] * cs[3]; return o; }

__device__ __forceinline__ f32x4 mla_cs(const float* tabm, int t, int c4) {
    const int p0 = c4 >> 1; const int pos = (p0 < 16) ? (t >> 6) : (t & 63); const int f = p0 & 15;
    return *(const f32x4*)(tabm + ((size_t)pos * 16 + f) * 2);
}

struct EpiG1 {
    static constexpr bool PERM = true, PROBE2 = false;
    bf16* QKVL; float* SSQ; bf16* KR; const float* tabm;
    __device__ __forceinline__ void operator()(const f32x4 (&acc)[2][2][4][2], const Unit& u, int wr, int wc, int fr, int fq) const {
        const int row0 = u.pm * 256 + wr * 64 + fr;
        if (u.pn < 4) {
            const int col0 = u.pn * 256 + wc * 32 + 8 * fq;
#pragma unroll
            for (int ai = 0; ai < 2; ++ai)
#pragma unroll
                for (int m = 0; m < 4; ++m) { const int row = row0 + ai * 128 + m * 16; float ss = 0.f;
#pragma unroll
                    for (int bj = 0; bj < 2; ++bj) { const f32x4 v0 = acc[ai][bj][m][0], v1 = acc[ai][bj][m][1];
                        ss += (v0[0] * v0[0] + v0[1] * v0[1]) + (v0[2] * v0[2] + v0[3] * v0[3]) + (v1[0] * v1[0] + v1[1] * v1[1]) + (v1[2] * v1[2] + v1[3] * v1[3]);
                        *(u32x4*)(QKVL + (size_t)row * N1 + col0 + bj * 128) = pack8(v0, v1); }
                    { const int ln_ = fr + 16 * fq; ss += shfl_xor_l(ss, 16, ln_); ss += shfl_xor_l(ss, 32, ln_); }
                    if (fq == 0) SSQ[(size_t)row * 16 + u.pn * 4 + wc] = ss; asm volatile("" ::: "memory"); }
        } else if (wc < 2) {
            const int c8 = wc * 32 + 8 * fq;
#pragma unroll
            for (int ai = 0; ai < 2; ++ai)
#pragma unroll
                for (int m = 0; m < 4; ++m) { const int row = row0 + ai * 128 + m * 16; f32x4 v0 = acc[ai][0][m][0], v1 = acc[ai][0][m][1];
                    if (row < MX) { const int t = row & (SEQ - 1); v0 = rot2(v0, mla_cs(tabm, t, c8)); v1 = rot2(v1, mla_cs(tabm, t, c8 + 4)); }
                    *(u32x4*)(KR + (size_t)row * 64 + c8) = pack8(v0, v1); asm volatile("" ::: "memory"); }
        }
    }
};
struct EpiUq {
    static constexpr bool PERM = true, PROBE2 = false;
    bf16* Q; const float* SSQ; const float* tabm;
    __device__ __forceinline__ void operator()(const f32x4 (&acc)[2][2][4][2], const Unit& u, int wr, int wc, int fr, int fq) const {
        const int row0 = u.pm * 256 + wr * 64 + fr;
        int col8[2], dd[2];
#pragma unroll
        for (int bj = 0; bj < 2; ++bj) { col8[bj] = u.pn * 256 + bj * 128 + wc * 32 + 8 * fq; dd[bj] = col8[bj] % DQ; }
#pragma unroll
        for (int ai = 0; ai < 2; ++ai)
#pragma unroll
            for (int m = 0; m < 4; ++m) { const int row = row0 + ai * 128 + m * 16;
                const f32x4 s0 = *(const f32x4*)(SSQ + (size_t)row * 16), s1 = *(const f32x4*)(SSQ + (size_t)row * 16 + 4);
                const float ss = ((s0[0] + s0[1]) + (s0[2] + s0[3])) + ((s1[0] + s1[1]) + (s1[2] + s1[3]));
                const float r = 1.0f / sqrtf(ss * (1.0f / QR) + NORM_EPS);
#pragma unroll
                for (int bj = 0; bj < 2; ++bj) { f32x4 v0 = acc[ai][bj][m][0] * r, v1 = acc[ai][bj][m][1] * r;
                    if (dd[bj] >= NOPE && row < MX) { const int t = row & (SEQ - 1), c8 = dd[bj] - NOPE; v0 = rot2(v0, mla_cs(tabm, t, c8)); v1 = rot2(v1, mla_cs(tabm, t, c8 + 4)); }
                    *(u32x4*)(Q + (size_t)row * 3072 + col8[bj]) = pack8(v0, v1); } asm volatile("" ::: "memory"); }
    }
};
struct EpiUkv {
    static constexpr bool PERM = true, PROBE2 = false;
    bf16* KV; const float* SSQ;
    __device__ __forceinline__ void operator()(const f32x4 (&acc)[2][2][4][2], const Unit& u, int wr, int wc, int fr, int fq) const {
        const int row0 = u.pm * 256 + wr * 64 + fr; const int col0 = u.pn * 256 + wc * 32 + 8 * fq;
#pragma unroll
        for (int ai = 0; ai < 2; ++ai)
#pragma unroll
            for (int m = 0; m < 4; ++m) { const int row = row0 + ai * 128 + m * 16;
                const f32x4 s0 = *(const f32x4*)(SSQ + (size_t)row * 16 + 8), s1 = *(const f32x4*)(SSQ + (size_t)row * 16 + 12);
                const float ss = ((s0[0] + s0[1]) + (s0[2] + s0[3])) + ((s1[0] + s1[1]) + (s1[2] + s1[3]));
                const float r = 1.0f / sqrtf(ss * (1.0f / KVR) + NORM_EPS);
#pragma unroll
                for (int bj = 0; bj < 2; ++bj) *(u32x4*)(KV + (size_t)row * 4096 + col0 + bj * 128) = pack8(acc[ai][bj][m][0] * r, acc[ai][bj][m][1] * r); asm volatile("" ::: "memory"); }
    }
};
struct EpiResid {
    static constexpr bool PERM = false, PROBE2 = false;
    const float* xin; float* xout; const float* cin; float* cout; const float* modv; int gofs;
    __device__ __forceinline__ void operator()(const f32x4 (&acc)[2][2][4][2], const Unit& u, int wr, int wc, int fr, int fq) const {
        const bool isx = u.pm < (MX / 256);
        const int rloc = (isx ? u.pm * 256 : (u.pm * 256 - MX)) + wr * 64 + fr;
        const float* base = isx ? xin : cin; float* out = isx ? xout : cout;
        const float* gv = modv + (size_t)(isx ? (u.pm >> 4) : 8) * NMOD + gofs;
        const int col0 = u.pn * 256 + wc * 32 + 4 * fq;
        f32x4 g4[2][2];
#pragma unroll
        for (int bj = 0; bj < 2; ++bj)
#pragma unroll
            for (int n = 0; n < 2; ++n) g4[bj][n] = *(const f32x4*)(gv + col0 + bj * 128 + n * 16);
        f32x4 pre[3][2][2];
#define RES_LOAD(G_, SLOT_) do { const size_t off_ = (size_t)(rloc + ((G_) >> 2) * 128 + ((G_) & 3) * 16) * D + col0; \
            _Pragma("unroll") for (int bj = 0; bj < 2; ++bj) _Pragma("unroll") for (int n = 0; n < 2; ++n) pre[SLOT_][bj][n] = *(const f32x4*)(base + off_ + bj * 128 + n * 16); } while (0)
        RES_LOAD(0, 0); RES_LOAD(1, 1); RES_LOAD(2, 2);
#pragma unroll
        for (int g = 0; g < 8; ++g) { const int ai = g >> 2, m = g & 3; const size_t off = (size_t)(rloc + ai * 128 + m * 16) * D + col0;
#pragma unroll
            for (int bj = 0; bj < 2; ++bj)
#pragma unroll
                for (int n = 0; n < 2; ++n) *(f32x4*)(out + off + bj * 128 + n * 16) = pre[g % 3][bj][n] + g4[bj][n] * acc[ai][bj][m][n];
            asm volatile("" ::: "memory");
            if (g + 3 < 8) RES_LOAD(g + 3, g % 3); }
#undef RES_LOAD
    }
};
template <int CTRL> __device__ __forceinline__ float dpp1(float x) { return __int_as_float(__builtin_amdgcn_update_dpp(0, __float_as_int(x), CTRL, 0xF, 0xF, false)); }
__device__ __forceinline__ f32x4 row_prev(const f32x4 v) { f32x4 o; o.x = dpp1<0x121>(v.x); o.y = dpp1<0x121>(v.y); o.z = dpp1<0x121>(v.z); o.w = dpp1<0x121>(v.w); return o; }
__device__ __forceinline__ f32x4 row_next(const f32x4 v) { f32x4 o; o.x = dpp1<0x12F>(v.x); o.y = dpp1<0x12F>(v.y); o.z = dpp1<0x12F>(v.z); o.w = dpp1<0x12F>(v.w); return o; }
__device__ __forceinline__ f32x4 silu4(const f32x4 v) { f32x4 o;
#pragma unroll
    for (int e = 0; e < 4; ++e) o[e] = fast_silu(v[e]); return o; }
constexpr size_t HALO_STRIDE = (size_t)FF;
struct EpiGUConv {
    static constexpr bool PERM = true, PROBE2 = true;
    bf16* ACT; float* HALO; const float* cw; const float* cb; LAS float* edge;
    __device__ __forceinline__ void operator()(const f32x4 (&acc)[2][2][4][2], const Unit& u, int wr, int wc, int fr, int fq) const {
        const int c8 = wc * 32 + 8 * fq; const int f0 = u.pn * 128 + c8;
#pragma unroll
        for (int ai = 0; ai < 2; ++ai) { const int blk = 2 * ai + wr;
            if (fr == 0)  { *(LAS f32x4*)(edge + (blk * 2 + 0) * 128 + c8) = acc[ai][0][0][0]; *(LAS f32x4*)(edge + (blk * 2 + 0) * 128 + c8 + 4) = acc[ai][0][0][1]; }
            if (fr == 15) { *(LAS f32x4*)(edge + (blk * 2 + 1) * 128 + c8) = acc[ai][0][3][0]; *(LAS f32x4*)(edge + (blk * 2 + 1) * 128 + c8 + 4) = acc[ai][0][3][1]; } }
        asm volatile("s_waitcnt lgkmcnt(0)" ::: "memory"); __builtin_amdgcn_s_barrier(); asm volatile("" ::: "memory");
        f32x4 w0[2], w1[2], w2[2], bb[2];
#pragma unroll
        for (int n = 0; n < 2; ++n) { w0[n] = *(const f32x4*)(cw + f0 + 4 * n); w1[n] = *(const f32x4*)(cw + FF + f0 + 4 * n); w2[n] = *(const f32x4*)(cw + 2 * FF + f0 + 4 * n); bb[n] = *(const f32x4*)(cb + f0 + 4 * n); }
        const f32x4 zero4 = {0.f, 0.f, 0.f, 0.f};
#pragma unroll
        for (int ai = 0; ai < 2; ++ai) { const int blk = 2 * ai + wr;
#pragma unroll
            for (int m = 0; m < 4; ++m) { const int row = u.pm * 256 + ai * 128 + wr * 64 + m * 16 + fr; f32x4 o[2];
#pragma unroll
                for (int n = 0; n < 2; ++n) { const f32x4 cur = acc[ai][0][m][n];
                    f32x4 b, d;
                    if (m > 0) b = row_prev(acc[ai][0][m - 1][n]); else b = (blk > 0) ? *(const LAS f32x4*)(edge + ((blk - 1) * 2 + 1) * 128 + c8 + 4 * n) : zero4;
                    if (m < 3) d = row_next(acc[ai][0][m + 1][n]); else d = (blk < 3) ? *(const LAS f32x4*)(edge + ((blk + 1) * 2 + 0) * 128 + c8 + 4 * n) : zero4;
                    const f32x4 a = row_prev(cur), c = row_next(cur);
                    const f32x4 up = (fr == 0) ? b : a, dn = (fr == 15) ? d : c;
                    const f32x4 cv = w0[n] * up + w1[n] * cur + w2[n] * dn + bb[n]; const f32x4 uu = acc[ai][1][m][n];
                    o[n] = silu4(cv) * uu;
                    if (m == 0 && blk == 0 && fr == 0) { float* hp = HALO + (size_t)((u.pm * 2 + 0) * 3) * HALO_STRIDE + f0 + 4 * n; *(f32x4*)hp = cv; *(f32x4*)(hp + HALO_STRIDE) = cur; *(f32x4*)(hp + 2 * HALO_STRIDE) = uu; }
                    if (m == 3 && blk == 3 && fr == 15) { float* hp = HALO + (size_t)((u.pm * 2 + 1) * 3) * HALO_STRIDE + f0 + 4 * n; *(f32x4*)hp = cv; *(f32x4*)(hp + HALO_STRIDE) = cur; *(f32x4*)(hp + 2 * HALO_STRIDE) = uu; } }
                *(u32x4*)(ACT + (size_t)row * FF + f0) = pack8(o[0], o[1]); asm volatile("" ::: "memory"); } }
        asm volatile("s_waitcnt lgkmcnt(0)" ::: "memory"); __builtin_amdgcn_s_barrier(); asm volatile("" ::: "memory");
    }
};
struct EpiQKV {
    static constexpr bool PERM = true, PROBE2 = false;
    bf16* QKV; const float* tabr;
    __device__ __forceinline__ void operator()(const f32x4 (&acc)[2][2][4][2], const Unit& u, int wr, int wc, int fr, int fq) const {
        const int row0 = u.pm * 256 + wr * 64 + fr; const int col0 = u.pn * 256 + wc * 32 + 8 * fq;
        const bool rope = (u.pn < 16) && (u.pm < MX / 256);
#pragma unroll
        for (int ai = 0; ai < 2; ++ai)
#pragma unroll
            for (int m = 0; m < 4; ++m) { const int row = row0 + ai * 128 + m * 16;
#pragma unroll
                for (int bj = 0; bj < 2; ++bj) { f32x4 v0 = acc[ai][bj][m][0], v1 = acc[ai][bj][m][1]; const int col = col0 + bj * 128;
                    if (rope) { const int t = row & (SEQ - 1); const float* tp = tabr + ((size_t)t * 128 + ((col & 255) >> 1)) * 2;
                        v0 = rot2(v0, *(const f32x4*)tp); v1 = rot2(v1, *(const f32x4*)(tp + 4)); }
                    *(u32x4*)(QKV + (size_t)row * 8192 + col) = pack8(v0, v1); } asm volatile("" ::: "memory"); }
    }
};
struct EpiGate {
    static constexpr bool PERM = true, PROBE2 = false;
    bf16* GATED; const bf16* YF; const bf16* YB; const float* ST;
    __device__ __forceinline__ void operator()(const f32x4 (&acc)[2][2][4][2], const Unit& u, int wr, int wc, int fr, int fq) const {
        const int row0 = u.pm * 256 + wr * 64 + fr; const int f0 = u.pn * 128 + wc * 32 + 8 * fq; const int hd = u.pn >> 2;
#pragma unroll
        for (int ai = 0; ai < 2; ++ai)
#pragma unroll
            for (int m = 0; m < 4; ++m) { const int row = row0 + ai * 128 + m * 16; const size_t off = (size_t)row * 4096 + f0;
                const u32x4 yf = *(const u32x4*)(YF + off), yb = *(const u32x4*)(YB + off);
                const f32x2 sf = *(const f32x2*)(ST + ((size_t)row * 8 + hd) * 2), sb = *(const f32x2*)(ST + ((size_t)(MT + row) * 8 + hd) * 2);
                const f32x4 a0 = acc[ai][0][m][0], a1 = acc[ai][0][m][1], b0 = acc[ai][1][m][0], b1 = acc[ai][1][m][1];
#define NF(w, hi_) (((hi_ ? bfhi(w) : bflo(w)) - sf[0]) * sf[1])
#define NB(w, hi_) (((hi_ ? bfhi(w) : bflo(w)) - sb[0]) * sb[1])
                f32x4 o0, o1;
                o0[0] = fast_silu(a0[0]) * NF(yf.x, 0) + fast_silu(b0[0]) * NB(yb.x, 0); o0[1] = fast_silu(a0[1]) * NF(yf.x, 1) + fast_silu(b0[1]) * NB(yb.x, 1);
                o0[2] = fast_silu(a0[2]) * NF(yf.y, 0) + fast_silu(b0[2]) * NB(yb.y, 0); o0[3] = fast_silu(a0[3]) * NF(yf.y, 1) + fast_silu(b0[3]) * NB(yb.y, 1);
                o1[0] = fast_silu(a1[0]) * NF(yf.z, 0) + fast_silu(b1[0]) * NB(yb.z, 0); o1[1] = fast_silu(a1[1]) * NF(yf.z, 1) + fast_silu(b1[1]) * NB(yb.z, 1);
                o1[2] = fast_silu(a1[2]) * NF(yf.w, 0) + fast_silu(b1[2]) * NB(yb.w, 0); o1[3] = fast_silu(a1[3]) * NF(yf.w, 1) + fast_silu(b1[3]) * NB(yb.w, 1);
#undef NF
#undef NB
                *(u32x4*)(GATED + off) = pack8(o0, o1); asm volatile("" ::: "memory"); }
    }
};

namespace att {
constexpr int NW = 8, QBLK = 32, KVBLK = 64;
constexpr int SHM_V = 16384, SHM_KN = 16384, SHM_KR = 8192;
constexpr int OFF_V = 0, OFF_KN = 3 * SHM_V, OFF_KR = OFF_KN + 2 * SHM_KN, OFF_WS = OFF_KR + 2 * SHM_KR, SHM_ATTN = OFF_WS + NW * 64 * 4;
constexpr float THR2 = 11.5f;
#define KSWZ(row, colB) ((row) * 256 + ((colB) ^ (((row) & 7) << 4)))
#define KRSWZ(row, colB) ((row) * 128 + ((colB) ^ ((((row) >> 1) & 7) << 4)))
#define SBAR() __builtin_amdgcn_sched_barrier(0)
__device__ __forceinline__ int crow(int r, int hi) { return (r & 3) + 8 * (r >> 2) + 4 * hi; }
__device__ __forceinline__ void partialSM(f32x16& p0, f32x16& p1, float& m_reg, float& alpha) {
  float pmax = p0[0];
#pragma unroll
  for (int r = 1; r < 16; ++r) pmax = fmaxf(pmax, p0[r]);
#pragma unroll
  for (int r = 0; r < 16; ++r) pmax = fmaxf(pmax, p1[r]);
  { auto rr = __builtin_amdgcn_permlane32_swap(__float_as_uint(pmax), __float_as_uint(pmax), false, false); pmax = fmaxf(__uint_as_float(rr[0]), __uint_as_float(rr[1])); }
  float mn;
  if (__builtin_expect(__all(pmax - m_reg <= THR2), 1)) { mn = m_reg; alpha = 1.f; }
  else { mn = fmaxf(m_reg, pmax); alpha = __builtin_amdgcn_exp2f(m_reg - mn); m_reg = mn; }
#pragma unroll
  for (int r = 0; r < 16; ++r) p0[r] = p0[r] - mn;
#pragma unroll
  for (int r = 0; r < 16; ++r) p1[r] = p1[r] - mn;
#pragma unroll
  for (int r = 0; r < 16; ++r) p0[r] = __builtin_amdgcn_exp2f(p0[r]);
}
__device__ __forceinline__ void finishSM(f32x16& p0, f32x16& p1, float alpha, float& l_reg, bf16x8& pa0, bf16x8& pa1, bf16x8& pa2, bf16x8& pa3) {
#pragma unroll
  for (int r = 0; r < 16; ++r) p1[r] = __builtin_amdgcn_exp2f(p1[r]);
  float ps = 0;
#pragma unroll
  for (int r = 0; r < 16; ++r) ps += p0[r];
#pragma unroll
  for (int r = 0; r < 16; ++r) ps += p1[r];
  { auto rr = __builtin_amdgcn_permlane32_swap(__float_as_uint(ps), __float_as_uint(ps), false, false); ps = __uint_as_float(rr[0]) + __uint_as_float(rr[1]); }
  l_reg = l_reg * alpha + ps;
#define PK4(P, BASE, OUT) do { unsigned a0 = cvt_pk_bf16(P[BASE + 0], P[BASE + 1]), a1 = cvt_pk_bf16(P[BASE + 2], P[BASE + 3]);   \
    unsigned b0 = cvt_pk_bf16(P[BASE + 4], P[BASE + 5]), b1 = cvt_pk_bf16(P[BASE + 6], P[BASE + 7]);                              \
    auto r0 = __builtin_amdgcn_permlane32_swap(a0, b0, false, false); auto r1 = __builtin_amdgcn_permlane32_swap(a1, b1, false, false); \
    u32x4 w = {r0[0], r1[0], r0[1], r1[1]}; OUT = __builtin_bit_cast(bf16x8, w); } while (0)
  PK4(p0, 0, pa0); PK4(p0, 8, pa1); PK4(p1, 0, pa2); PK4(p1, 8, pa3);
#undef PK4
}
__device__ __forceinline__ void qkt(f32x16& p0, f32x16& p1, const char* Kn, const char* Kr, const bf16x8* qr, int r32, int hi) {
  p0 = f32x16{}; p1 = f32x16{};
#pragma unroll
  for (int d0 = 0; d0 < 8; ++d0) { const int cb = (d0 * 16 + hi * 8) * 2;
    const bf16x8 b0 = *reinterpret_cast<const bf16x8*>(Kn + KSWZ(r32, cb));
    const bf16x8 b1 = *reinterpret_cast<const bf16x8*>(Kn + KSWZ(32 + r32, cb));
    p0 = __builtin_amdgcn_mfma_f32_32x32x16_bf16(b0, qr[d0], p0, 0, 0, 0);
    p1 = __builtin_amdgcn_mfma_f32_32x32x16_bf16(b1, qr[d0], p1, 0, 0, 0); }
#pragma unroll
  for (int d0 = 0; d0 < 4; ++d0) { const int cb = (d0 * 16 + hi * 8) * 2;
    const bf16x8 b0 = *reinterpret_cast<const bf16x8*>(Kr + KRSWZ(r32, cb));
    const bf16x8 b1 = *reinterpret_cast<const bf16x8*>(Kr + KRSWZ(32 + r32, cb));
    p0 = __builtin_amdgcn_mfma_f32_32x32x16_bf16(b0, qr[8 + d0], p0, 0, 0, 0);
    p1 = __builtin_amdgcn_mfma_f32_32x32x16_bf16(b1, qr[8 + d0], p1, 0, 0, 0); }
}
__device__ __forceinline__ int v_st(int k, int c) { const int kk = (k & ~0xC) | ((k & 4) << 1) | ((k & 8) >> 1); return ((kk >> 3) * 4 + (c >> 5)) * 512 + ((kk & 7) * 32 + (c & 31)) * 2; }
__device__ __forceinline__ int v_rd_base(int lane) { return ((lane & 3) << 3) | (((lane >> 2) & 3) << 6) | (((lane >> 4) & 1) << 5) | (((lane >> 5) & 1) << 8); }
constexpr int v_rd_off(int d0, int ks, int half) { return d0 * 512 + ks * 4096 + half * 2048; }
template <int OFF> __device__ __forceinline__ s16x4 tr_read(int vb) { s16x4 r; asm volatile("ds_read_b64_tr_b16 %0, %1 offset:%2" : "=&v"(r) : "v"(vb), "i"(OFF) : "memory"); return r; }
template <int D0> __device__ __forceinline__ void pv_one(f32x16& od, int vb, bf16x8 pa0, bf16x8 pa1, bf16x8 pa2, bf16x8 pa3) {
  const s16x4 l0 = tr_read<v_rd_off(D0, 0, 0)>(vb), h0 = tr_read<v_rd_off(D0, 0, 1)>(vb), l1 = tr_read<v_rd_off(D0, 1, 0)>(vb), h1 = tr_read<v_rd_off(D0, 1, 1)>(vb);
  const s16x4 l2 = tr_read<v_rd_off(D0, 2, 0)>(vb), h2 = tr_read<v_rd_off(D0, 2, 1)>(vb), l3 = tr_read<v_rd_off(D0, 3, 0)>(vb), h3 = tr_read<v_rd_off(D0, 3, 1)>(vb);
  asm volatile("s_waitcnt lgkmcnt(0)" ::: "memory"); SBAR();
#define PK(L, H) (bf16x8){L[0], L[1], L[2], L[3], H[0], H[1], H[2], H[3]}
  od = __builtin_amdgcn_mfma_f32_32x32x16_bf16(pa0, PK(l0, h0), od, 0, 0, 0);
  od = __builtin_amdgcn_mfma_f32_32x32x16_bf16(pa1, PK(l1, h1), od, 0, 0, 0);
  od = __builtin_amdgcn_mfma_f32_32x32x16_bf16(pa2, PK(l2, h2), od, 0, 0, 0);
  od = __builtin_amdgcn_mfma_f32_32x32x16_bf16(pa3, PK(l3, h3), od, 0, 0, 0);
#undef PK
}
__device__ __forceinline__ void pv_d0(f32x16* o, int vb, bf16x8 pa0, bf16x8 pa1, bf16x8 pa2, bf16x8 pa3) {
  pv_one<0>(o[0], vb, pa0, pa1, pa2, pa3); pv_one<1>(o[1], vb, pa0, pa1, pa2, pa3); pv_one<2>(o[2], vb, pa0, pa1, pa2, pa3); pv_one<3>(o[3], vb, pa0, pa1, pa2, pa3);
}
__device__ __forceinline__ void attn_unit(const bf16* __restrict__ Qb, const bf16* __restrict__ KVh, const bf16* __restrict__ KRp, bf16* __restrict__ Ob,
                                          int NT, int nc, int cbase, int xbase, char* lds, int tid_in, unsigned long long* ts_words = nullptr) {
  int tid = tid_in; asm volatile("" : "+v"(tid));
  const int wid = __builtin_amdgcn_readfirstlane(tid >> 6), lane = tid & 63, r32 = lane & 31, hi = lane >> 5;
  char* V_lds = lds + OFF_V; char* Kn_lds = lds + OFF_KN; char* Kr_lds = lds + OFF_KR;
  float* ws = (float*)(lds + OFF_WS) + wid * 64; float* li_l = ws; float* al_l = ws + 32;
  float m_reg = -1e30f, l_reg = 0; f32x16 o[4] = {}; bf16x8 qr[12];
  const bf16* Qw = Qb + (long)(wid * QBLK + r32) * 3072 + hi * 8;
#pragma unroll
  for (int d0 = 0; d0 < 12; ++d0) qr[d0] = *reinterpret_cast<const bf16x8*>(Qw + d0 * 16);
  const int vb0 = (int)(uintptr_t)V_lds + v_rd_base(lane);
  unsigned vofK[2], vofV[2], vofR;
#pragma unroll
  for (int i = 0; i < 2; ++i) { const int pc = wid * 2 + i;
      { const int row = pc * 4 + (lane >> 4), ch = (lane & 15) ^ (row & 7); vofK[i] = (unsigned)((row * 4096 + ch * 8) * 2); }
      { const int ob = pc * 1024 + lane * 16, st = ob >> 9, w = ob & 511, kk = (st >> 2) * 8 + (w >> 6); const int k = (kk & ~0xC) | ((kk & 4) << 1) | ((kk & 8) >> 1);
        const int c = (st & 3) * 32 + 8 * ((w & 63) >> 4); vofV[i] = (unsigned)((k * 4096 + 128 + c) * 2); } }
  { const int row = wid * 8 + (lane >> 3), ch = (lane & 7) ^ ((row >> 1) & 7); vofR = (unsigned)((row * 64 + ch * 8) * 2); }
  const unsigned ldsK = (unsigned)__builtin_amdgcn_readfirstlane((unsigned)(uintptr_t)Kn_lds + (unsigned)wid * 2048u);
  const unsigned ldsV = (unsigned)__builtin_amdgcn_readfirstlane((unsigned)(uintptr_t)V_lds + (unsigned)wid * 2048u);
  const unsigned ldsR = (unsigned)__builtin_amdgcn_readfirstlane((unsigned)(uintptr_t)Kr_lds + (unsigned)wid * 1024u);
#define KROW(j) ((j) < nc ? cbase + (j) * KVBLK : xbase + ((j) - nc) * KVBLK)
#define DMA_TILE(j, kslot, vslot) do { const long k0_ = KROW(j); const char* kb_ = uni_ptr(KVh + k0_ * 4096); const char* rb_ = uni_ptr(KRp + k0_ * 64); \
    glds16_s(kb_, vofK[0], ldsK + (kslot) * SHM_KN); glds16_s(kb_, vofK[1], ldsK + (kslot) * SHM_KN + 1024u); \
    glds16_s(rb_, vofR, ldsR + (kslot) * SHM_KR); \
    glds16_s(kb_, vofV[0], ldsV + (vslot) * SHM_V); glds16_s(kb_, vofV[1], ldsV + (vslot) * SHM_V + 1024u); } while (0)
#ifndef ATT_SKEW
#define ATT_SKEW 0
#endif
#if PROBE_TS
#define WAIT_SYNC() do { const unsigned long long w0_ = __builtin_amdgcn_s_memrealtime(); asm volatile("s_waitcnt vmcnt(0)" ::: "memory"); const unsigned long long w1_ = __builtin_amdgcn_s_memrealtime(); __syncthreads(); const unsigned long long w2_ = __builtin_amdgcn_s_memrealtime(); att_w_dma += w1_ - w0_; att_w_bar += w2_ - w1_; } while (0)
#else
#define WAIT_SYNC() do { asm volatile("s_waitcnt vmcnt(0)" ::: "memory"); __syncthreads(); if (ATT_SKEW && wid >= 4) __builtin_amdgcn_s_sleep(ATT_SKEW); } while (0)
#endif
#define RESC(a) do { if (__any((a) < 1.f)) { if (hi == 0) al_l[r32] = (a); asm volatile("s_waitcnt lgkmcnt(0)" ::: "memory"); \
    _Pragma("unroll") for (int d = 0; d < 4; ++d) _Pragma("unroll") for (int r = 0; r < 16; ++r) o[d][r] *= al_l[crow(r, hi)]; } } while (0)
#if PROBE_TS
  unsigned long long att_w_dma = 0, att_w_bar = 0; const unsigned long long att_t0 = __builtin_amdgcn_s_memrealtime();
#endif
  f32x16 pA0, pA1, pB0, pB1; float alA, alB; bf16x8 pa0, pa1, pa2, pa3;
  DMA_TILE(0, 0, 0); DMA_TILE(1, 1, 1); WAIT_SYNC();
  qkt(pA0, pA1, Kn_lds, Kr_lds, qr, r32, hi); partialSM(pA0, pA1, m_reg, alA);
  __syncthreads();
  int vprev = 0, vcur = 1, vnext = 2;
  for (int j = 1; j + 1 < NT; j += 2) {
    DMA_TILE(j + 1, 0, vnext);
    SBAR(); qkt(pB0, pB1, Kn_lds + SHM_KN, Kr_lds + SHM_KR, qr, r32, hi);
    finishSM(pA0, pA1, alA, l_reg, pa0, pa1, pa2, pa3); SBAR();
    pv_d0(o, vb0 + vprev * SHM_V, pa0, pa1, pa2, pa3); partialSM(pB0, pB1, m_reg, alB);
    RESC(alB); WAIT_SYNC();
    { const int t_ = vprev; vprev = vcur; vcur = vnext; vnext = t_; }
    if (j + 2 < NT) DMA_TILE(j + 2, 1, vnext);
    SBAR(); qkt(pA0, pA1, Kn_lds, Kr_lds, qr, r32, hi);
    finishSM(pB0, pB1, alB, l_reg, pa0, pa1, pa2, pa3); SBAR();
    pv_d0(o, vb0 + vprev * SHM_V, pa0, pa1, pa2, pa3); partialSM(pA0, pA1, m_reg, alA);
    RESC(alA); WAIT_SYNC();
    { const int t_ = vprev; vprev = vcur; vcur = vnext; vnext = t_; }
  }
  SBAR(); qkt(pB0, pB1, Kn_lds + SHM_KN, Kr_lds + SHM_KR, qr, r32, hi);
  finishSM(pA0, pA1, alA, l_reg, pa0, pa1, pa2, pa3); SBAR();
  pv_d0(o, vb0 + vprev * SHM_V, pa0, pa1, pa2, pa3); partialSM(pB0, pB1, m_reg, alB);
  RESC(alB);
  finishSM(pB0, pB1, alB, l_reg, pa0, pa1, pa2, pa3); SBAR();
  pv_d0(o, vb0 + vcur * SHM_V, pa0, pa1, pa2, pa3);
  if (hi == 0) li_l[r32] = l_reg; asm volatile("s_waitcnt lgkmcnt(0)" ::: "memory");
  float rli[16];
#pragma unroll
  for (int r = 0; r < 16; ++r) rli[r] = __builtin_amdgcn_rcpf(li_l[crow(r, hi)]);
  bf16* Ow = Ob + (long)(wid * QBLK) * 2048;
#pragma unroll
  for (int r = 0; r < 16; ++r) { const int orow = crow(r, hi);
#pragma unroll
    for (int d0 = 0; d0 < 4; ++d0) Ow[(long)orow * 2048 + d0 * 32 + r32] = (bf16)(cvt_pk_bf16(o[d0][r] * rli[r], 0.f) & 0xffffu); }
  __syncthreads();
#if PROBE_TS
  if (ts_words && tid == 0) { ts_words[160] += att_w_dma; ts_words[161] += att_w_bar; ts_words[162] += __builtin_amdgcn_s_memrealtime() - att_t0; ts_words[163] += (unsigned long long)NT; }
#endif
#undef KROW
#undef DMA_TILE
#undef WAIT_SYNC
#undef RESC
}
#undef SBAR
}

namespace scan {
constexpr int CH = 64;
constexpr int OFF_Q = 0, OFF_K = 32768  , OFF_V = 98304, OFF_P = 131072, SHM_SCAN = 131072 + 8192;
__device__ __forceinline__ unsigned off_b(unsigned row, unsigned ch) { return 256u * row + 16u * (ch ^ (((row & 3) << 2) | ((row >> 2) & 3))); }
__device__ __forceinline__ unsigned p_off(unsigned i, unsigned chunk) { return 128u * i + 16u * (chunk ^ ((i >> 1) & 7)); }
__device__ __forceinline__ int crow(int r, int hi) { return (r & 3) + 8 * (r >> 2) + 4 * hi; }
__device__ __forceinline__ s16x4 vtr(const LAS char* p) { typedef short v4i16_t __attribute__((ext_vector_type(4))); return __builtin_bit_cast(s16x4, __builtin_amdgcn_ds_read_tr16_b64_v4i16((LAS v4i16_t*)p)); }
__device__ __forceinline__ bf16x8 tr_frag(const LAS char* img, int lane, int c, int ks) {
    const unsigned h = lane >> 5, blk = (lane >> 4) & 1, q = (lane & 15) >> 2, p = lane & 3;
    const unsigned r0 = 16 * ks + 8 * h + q, chn = 4 * c + 2 * blk + (p >> 1);
    const s16x4 lo = vtr(img + off_b(r0, chn) + 8 * (p & 1)), hi = vtr(img + off_b(r0 + 4, chn) + 8 * (p & 1));
    return (bf16x8){lo[0], lo[1], lo[2], lo[3], hi[0], hi[1], hi[2], hi[3]};
}
__device__ __forceinline__ bf16x8 pack_step(const f32x16& x, int s) {
    u32x4 p; p.x = cvt_pk_bf16(x[8 * s + 0], x[8 * s + 1]); p.y = cvt_pk_bf16(x[8 * s + 2], x[8 * s + 3]); p.z = cvt_pk_bf16(x[8 * s + 4], x[8 * s + 5]); p.w = cvt_pk_bf16(x[8 * s + 6], x[8 * s + 7]);
    return __builtin_bit_cast(bf16x8, p);
}
__device__ __forceinline__ void dma_mat(const bf16* src, int ld, LAS unsigned char* dst, int wid, int lane) {
    const char* sb = uni_ptr(src); const unsigned d0 = (unsigned)__builtin_amdgcn_readfirstlane((unsigned)(uintptr_t)dst + (unsigned)wid * 4096u);
#pragma unroll
    for (int k = 0; k < 4; ++k) { const int pc = wid * 4 + k, img = pc >> 4, row = 4 * (pc & 15) + (lane >> 4), pos = lane & 15;
        const int ch = pos ^ (((row & 3) << 2) | ((row >> 2) & 3));
        glds16_s(sb, (unsigned)((row * ld + img * 128 + ch * 8) * 2), d0 + (unsigned)k * 1024u); }
}
__device__ __forceinline__ int scan_rowbase(int n, int b, int dir) { return (n < 4) ? MX + b * CTXL + (dir ? 3 - n : n) * CH : b * SEQ + (dir ? 67 - n : n - 4) * CH; }
__device__ __forceinline__ float uni_f(float x) { return __uint_as_float(__builtin_amdgcn_readfirstlane(__float_as_uint(x))); }
typedef const LAS s16x4* lds_s4p;
__device__ __forceinline__ void scan_unit(const bf16* __restrict__ QKV, bf16* __restrict__ Y, int b, int hd, int dir, int dvh, float lg2, bool skip_ctx_y, LAS unsigned char* lds, int tid_in, unsigned long long* lds_ts = nullptr) {
    int tid = tid_in; asm volatile("" : "+v"(tid));
    const int wid = __builtin_amdgcn_readfirstlane(tid >> 6), lane0 = tid & 63;
    const LAS char* QI = (const LAS char*)lds + OFF_Q; const LAS char* VI = (const LAS char*)lds + OFF_V;
    LAS char* PI = (LAS char*)lds + OFF_P;
    f32x16 S[8];
#pragma unroll
    for (int i = 0; i < 8; ++i) S[i] = f32x16{};
    const float lgr = dir ? -lg2 : lg2;
    const float g64 = uni_f(__builtin_amdgcn_exp2f(64.f * lg2));
    const float R1 = uni_f(__builtin_amdgcn_exp2f(lgr)), R8 = uni_f(__builtin_amdgcn_exp2f(8.f * lgr)), R32 = uni_f(__builtin_amdgcn_exp2f(32.f * lgr));
    const float Rm1 = uni_f(__builtin_amdgcn_exp2f(-lgr)), Rm16 = uni_f(__builtin_amdgcn_exp2f(-16.f * lgr));
    const float c0 = uni_f(dir ? g64 : __builtin_amdgcn_exp2f(lg2)), z0 = uni_f(dir ? 1.0f : __builtin_amdgcn_exp2f(63.f * lg2));
    const int qcol = hd * RDK, kcol = 2048 + hd * RDK, vcol = 4096 + hd * RDV + dvh * 256;
    { const bf16* src = QKV + (size_t)scan_rowbase(0, b, dir) * 8192;
      dma_mat(src + qcol, 8192, lds + OFF_Q, wid, lane0); dma_mat(src + kcol, 8192, lds + OFF_K, wid, lane0); dma_mat(src + vcol, 8192, lds + OFF_V, wid, lane0);
      asm volatile("s_waitcnt vmcnt(0)" ::: "memory"); __syncthreads(); }
#if PROBE_TS
    unsigned long long sc_w1 = 0, sc_w2 = 0; const unsigned long long sc_tb = __builtin_amdgcn_s_memrealtime();
#endif
    for (int n = 0; n < 68; ++n) {
        int lane = lane0; asm volatile("" : "+v"(lane));
        const int r = lane & 31, h = lane >> 5, fr = lane & 15, fq = lane >> 4;
        const int rowbase = scan_rowbase(n, b, dir);
        const bool more = n + 1 < 68;
        const bf16* nsrc = QKV + (size_t)scan_rowbase(more ? n + 1 : n, b, dir) * 8192;
        const LAS char* KI = (const LAS char*)lds + OFF_K + (n & 1) * 32768;
        if (more) dma_mat(nsrc + kcol, 8192, lds + OFF_K + ((n + 1) & 1) * 32768, wid, lane);
        const float LR = c0 * __builtin_amdgcn_exp2f((float)(4 * h) * lgr), LZ = z0 * __builtin_amdgcn_exp2f((float)(-8 * h) * lgr), LP = __builtin_amdgcn_exp2f((float)(fr - 4 * fq) * lgr);
        { const int fH = fr & 3, fL = (fr >> 2) & 3; const int AL = 256 * fr + 16 * (fq ^ fL);
          int AH[4];
#pragma unroll
          for (int k = 0; k < 4; ++k) AH[k] = 64 * (k ^ fH);
#pragma unroll
          for (int tix = 0; tix < 2; ++tix) { const int tt = wid * 2 + tix, jt = tt >> 2, it = tt & 3;
            f32x4 pt = {0.f, 0.f, 0.f, 0.f};
            const bool live = dir ? (jt >= it) : (jt <= it);
            if (live) { const LAS char* ka = KI + 4096 * jt + AL; const LAS char* qa = QI + 4096 * it + AL;
#pragma unroll
                for (int ks = 0; ks < 8; ++ks) { const int o = (ks >> 2) * 16384 + AH[ks & 3];
                    pt = __builtin_amdgcn_mfma_f32_16x16x32_bf16(*(const LAS bf16x8*)(ka + o), *(const LAS bf16x8*)(qa + o), pt, 0, 0, 0); } }
            float we = LP * __builtin_amdgcn_exp2f((float)(16 * (it - jt)) * lgr); float v[4];
            const int mrel = fr - 4 * fq;
#pragma unroll
            for (int e = 0; e < 4; ++e) { float x = live ? pt[e] * we : 0.f; if (jt == it) { const bool keep = dir ? (e >= mrel) : (e <= mrel); x = keep ? x : 0.f; } v[e] = x; we *= Rm1; }
            const int i = it * 16 + fr, j0 = jt * 16 + 4 * fq;
            u32x2 w; w.x = cvt_pk_bf16(v[0], v[1]); w.y = cvt_pk_bf16(v[2], v[3]);
            *(LAS u32x2*)(PI + p_off(i, j0 >> 3) + ((j0 >> 2) & 1) * 8) = w; } }
        f32x16 Yt[2]; Yt[0] = f32x16{}; Yt[1] = f32x16{};
        { const int fH = r & 3, fL = (r >> 2) & 3; int QH[4], QL[4];
#pragma unroll
          for (int k = 0; k < 4; ++k) { QH[k] = 64 * (k ^ fH); QL[k] = 256 * r + 8 * h + 16 * (k ^ fL); }
#pragma unroll
          for (int dkb = 0; dkb < 8; ++dkb)
#pragma unroll
            for (int s = 0; s < 2; ++s) { const bf16x8 bf = pack_step(S[dkb], s);
                const LAS char* rp = QI + (dkb >> 2) * 16384 + QH[dkb & 3];
#pragma unroll
                for (int it = 0; it < 2; ++it) {
                    const u32x2 lo = *(const LAS u32x2*)(rp + it * 8192 + QL[2 * s]), hi2 = *(const LAS u32x2*)(rp + it * 8192 + QL[2 * s + 1]);
                    const u32x4 aw = {lo.x, lo.y, hi2.x, hi2.y};
                    Yt[it] = __builtin_amdgcn_mfma_f32_32x32x16_bf16(__builtin_bit_cast(bf16x8, aw), bf, Yt[it], 0, 0, 0); } } }
        { float fit = LR;
#pragma unroll
          for (int it = 0; it < 2; ++it) { float fa = fit;
#pragma unroll
            for (int a4 = 0; a4 < 4; ++a4) { float fb = fa;
#pragma unroll
                for (int b4 = 0; b4 < 4; ++b4) { Yt[it][4 * a4 + b4] *= fb; fb *= R1; }
                fa *= R8; }
            fit *= R32; } }
#if PROBE_TS
        const unsigned long long sc_t0 = __builtin_amdgcn_s_memrealtime();
#endif
        if (more) asm volatile("s_waitcnt vmcnt(4)" ::: "memory"); else asm volatile("s_waitcnt vmcnt(0)" ::: "memory");
        __syncthreads();
#if PROBE_TS
        sc_w1 += __builtin_amdgcn_s_memrealtime() - sc_t0;
#endif
        if (more) dma_mat(nsrc + qcol, 8192, lds + OFF_Q, wid, lane);
#pragma unroll
        for (int i = 0; i < 8; ++i)
#pragma unroll
            for (int rg = 0; rg < 16; ++rg) S[i][rg] *= g64;
        {
          const int blk = (lane >> 4) & 1, q = (lane & 15) >> 2, p = lane & 3; int TB[2], CQ[4];
#pragma unroll
          for (int t = 0; t < 2; ++t) TB[t] = 2048 * h + 256 * q + 1024 * t + 16 * ((2 * blk + (p >> 1)) ^ ((2 * h + t) & 3)) + 8 * (p & 1);
#pragma unroll
          for (int c = 0; c < 4; ++c) CQ[c] = 64 * (c ^ q);
          const LAS char* vb = VI + (wid >> 2) * 16384 + CQ[wid & 3];
          float zk = LZ;
#pragma unroll
          for (int ks = 0; ks < 4; ++ks) {
            const s16x4 vlo = vtr(vb + 4096 * ks + TB[0]), vhi = vtr(vb + 4096 * ks + TB[1]);
            const u32x2 vl = __builtin_bit_cast(u32x2, vlo), vh = __builtin_bit_cast(u32x2, vhi);
            const u32x4 vw = {vl.x, vl.y, vh.x, vh.y}; const bf16x8 vf = __builtin_bit_cast(bf16x8, vw);
#pragma unroll
            for (int it = 0; it < 2; ++it) { const bf16x8 pa = *(const LAS bf16x8*)(PI + p_off(it * 32 + r, 2 * ks + h));
                Yt[it] = __builtin_amdgcn_mfma_f32_32x32x16_bf16(pa, vf, Yt[it], 0, 0, 0); }
            float zj = zk; u32x4 zw;
            { const float a0 = bflo(vw.x) * zj; zj *= Rm1; const float a1 = bfhi(vw.x) * zj; zj *= Rm1; zw.x = cvt_pk_bf16(a0, a1); }
            { const float a0 = bflo(vw.y) * zj; zj *= Rm1; const float a1 = bfhi(vw.y) * zj; zj *= Rm1; zw.y = cvt_pk_bf16(a0, a1); }
            { const float a0 = bflo(vw.z) * zj; zj *= Rm1; const float a1 = bfhi(vw.z) * zj; zj *= Rm1; zw.z = cvt_pk_bf16(a0, a1); }
            { const float a0 = bflo(vw.w) * zj; zj *= Rm1; const float a1 = bfhi(vw.w) * zj; zw.w = cvt_pk_bf16(a0, a1); }
            const bf16x8 vz = __builtin_bit_cast(bf16x8, zw);
            zk *= Rm16;
#pragma unroll
            for (int dkb = 0; dkb < 8; ++dkb) { const LAS char* kb_ = KI + (dkb >> 2) * 16384 + 4096 * ks + CQ[dkb & 3];
                const s16x4 klo = vtr(kb_ + TB[0]), khi = vtr(kb_ + TB[1]);
                const u32x2 kl = __builtin_bit_cast(u32x2, klo), kh = __builtin_bit_cast(u32x2, khi); const u32x4 kw = {kl.x, kl.y, kh.x, kh.y};
                S[dkb] = __builtin_amdgcn_mfma_f32_32x32x16_bf16(__builtin_bit_cast(bf16x8, kw), vz, S[dkb], 0, 0, 0); }
            __builtin_amdgcn_sched_barrier(0);
          } }
        if (!(skip_ctx_y && n < 4)) {
            bf16* Yr = Y + (size_t)rowbase * 4096; const unsigned yo = (unsigned)(hd * RDV + dvh * 256 + wid * 32 + r + 4 * h * 4096);
#pragma unroll
            for (int it = 0; it < 2; ++it)
#pragma unroll
                for (int rg = 0; rg < 16; ++rg) { const unsigned i0 = (unsigned)(it * 32 + (rg & 3) + 8 * (rg >> 2));
                    Yr[yo + i0 * 4096u] = (bf16)(cvt_pk_bf16(Yt[it][rg], 0.f) & 0xffffu); }
        }
#if PROBE_TS
        const unsigned long long sc_t1 = __builtin_amdgcn_s_memrealtime();
#endif
        asm volatile("s_waitcnt vmcnt(0)" ::: "memory");
        __syncthreads();
#if PROBE_TS
        sc_w2 += __builtin_amdgcn_s_memrealtime() - sc_t1;
#endif
        if (more) dma_mat(nsrc + vcol, 8192, lds + OFF_V, wid, lane);
    }
    asm volatile("s_waitcnt vmcnt(0)" ::: "memory"); __syncthreads();
#if PROBE_TS
    if (blockIdx.x == 0 && tid == 0) { unsigned long long* tw = (unsigned long long*)(lds_ts); tw[170] += sc_w1; tw[171] += sc_w2; tw[172] += __builtin_amdgcn_s_memrealtime() - sc_tb; }
#endif
}
}

#define XB_TMO      128
#define XB_XCNT(j)  (256  + 64 * (j))
#define XB_XSUB(j)  (1280 + 64 * (j))
#define XB_XGEN(j)  (2304 + 64 * (j))
#define XB_TOP      3328
#define XB_TOPGEN   3392
#define XCD_BAR_WORDS 3456
#define XB_SPIN_CAP (1u << 22)
__device__ __forceinline__ unsigned xb_ld(unsigned* p)              { return __hip_atomic_load(p, __ATOMIC_RELAXED, __HIP_MEMORY_SCOPE_AGENT); }
__device__ __forceinline__ unsigned xb_add(unsigned* p, unsigned v) { return __hip_atomic_fetch_add(p, v, __ATOMIC_RELAXED, __HIP_MEMORY_SCOPE_AGENT); }
__device__ __forceinline__ unsigned xb_xcc_id() { return (unsigned)__builtin_amdgcn_s_getreg((3 << 11) | 20) & 0xFu; }
#define XB_SPIN(cond, bar) do { unsigned _sp = 0; while (cond) { __builtin_amdgcn_s_sleep(1); \
    if ((++_sp & 255u) == 0u) { if (xb_ld(&(bar)[XB_TMO])) break; if (_sp > XB_SPIN_CAP) { atomicAdd(&(bar)[XB_TMO], 1u); break; } } } } while (0)
struct XcdBarrier { unsigned* bar; unsigned x; volatile LAS unsigned* st; int wave; };
__device__ __forceinline__ XcdBarrier xcd_barrier_post(unsigned* bar, volatile LAS unsigned* st, int wave) {
    XcdBarrier b; b.bar = bar; b.x = xb_xcc_id(); b.st = st; b.wave = wave;
    if (wave == 0 && lane_id() == 0) (void)xb_add(&bar[XB_XCNT(b.x)], 1u);
    return b;
}
__device__ __forceinline__ void xcd_barrier_complete(unsigned* bar, unsigned x, unsigned& nloc, unsigned& nx) {
    const unsigned G = gridDim.x * gridDim.y * gridDim.z;
    unsigned sum, cnt, mine, sp = 0u;
    for (;;) {
        sum = 0u; cnt = 0u; mine = 0u;
#pragma unroll
        for (unsigned j = 0; j < 16; ++j) { const unsigned c = xb_ld(&bar[XB_XCNT(j)]); sum += c; cnt += (c > 0u) ? 1u : 0u; mine = (j == x) ? c : mine; }
        if (sum == G) break;
        __builtin_amdgcn_s_sleep(1);
        if ((++sp & 255u) == 0u) { if (xb_ld(&bar[XB_TMO])) break; if (sp > XB_SPIN_CAP) { atomicAdd(&bar[XB_TMO], 1u); break; } }
    }
    nloc = mine > 0u ? mine : 1u; nx = cnt > 0u ? cnt : 1u;
}
__device__ __forceinline__ void xcd_barrier(const XcdBarrier& b) {
    asm volatile("s_waitcnt vmcnt(0)" ::: "memory");
    __syncthreads();
    if (b.wave == 0 && lane_id() == 0) {
        unsigned* bar = b.bar; asm volatile("" : "+s"(bar));
        __builtin_amdgcn_s_waitcnt(0);
        unsigned nloc = b.st[0], nx = b.st[1];
        if (nloc == 0u) { xcd_barrier_complete(bar, b.x, nloc, nx); b.st[0] = nloc; b.st[1] = nx; }
        const unsigned old = xb_add(&bar[XB_XSUB(b.x)], 1u);
        const unsigned gen = old / nloc;
        if (old + 1u == (gen + 1u) * nloc) {
            __builtin_amdgcn_fence(__ATOMIC_RELEASE, "agent");
            asm volatile("s_waitcnt vmcnt(0)" ::: "memory");
            const unsigned og = xb_add(&bar[XB_TOP], 1u);
            const unsigned tg = og / nx;
            if (og + 1u == (tg + 1u) * nx) xb_add(&bar[XB_TOPGEN], 1u);
            else XB_SPIN(xb_ld(&bar[XB_TOPGEN]) == tg, bar);
            __builtin_amdgcn_fence(__ATOMIC_ACQUIRE, "agent");
            xb_add(&bar[XB_XGEN(b.x)], 1u);
            asm volatile("s_waitcnt vmcnt(0)" ::: "memory");
        } else {
            XB_SPIN(xb_ld(&bar[XB_XGEN(b.x)]) == gen, bar);
            __builtin_amdgcn_fence(__ATOMIC_ACQUIRE, "agent");
            asm volatile("s_waitcnt vmcnt(0)" ::: "memory");
        }
    }
    __syncthreads();
}

__device__ __forceinline__ float wave_sum(float v, int lane) {
#pragma unroll
    for (int o = 1; o < 64; o <<= 1) v += shfl_xor_l(v, o, lane);
    return v;
}
struct CvtDesc { const float* src; const float* kscale; bf16* WTrow0; int ldw, k0, K, jkind; float gscale; };
__device__ __forceinline__ int ropeperm64(int c) { const int p = c >> 1, e = c & 1; return (p < 16) ? (p + 16 * e) : (32 + (p - 16) + 16 * e); }
__device__ __forceinline__ int ropeinv64(int s_) { const int half = s_ >> 5, w = s_ & 31; return 2 * (half * 16 + (w & 15)) + (w >> 4); }
__device__ __forceinline__ void cvt_load(const CvtDesc& d, int lane, f32x4 (&v)[16]) {
#pragma unroll
    for (int i = 0; i < 16; ++i) { const int kk = 4 * i + (lane >> 4);
        f32x4 x = d.src ? *(const f32x4*)(d.src + (size_t)(d.k0 + kk) * d.ldw) : (f32x4){0.f, 0.f, 0.f, 0.f};
        float sc_ = d.gscale; if (d.kscale) sc_ *= d.kscale[d.k0 + kk];
        v[i] = x * sc_; }
}
__device__ __forceinline__ void cvt_store(const CvtDesc& d, int lane, const f32x4 (&v)[16], LAS float* scr) {
    const int n4 = lane & 15; int jr[4];
#pragma unroll
    for (int e = 0; e < 4; ++e) { const int s_ = 4 * n4 + e; jr[e] = d.jkind == 0 ? s_ : d.jkind == 1 ? ropeinv64(s_) : 2 * (4 * (n4 & 7) + e) + (n4 >> 3); }
#pragma unroll
    for (int i = 0; i < 16; ++i) { const int kk = 4 * i + (lane >> 4);
#pragma unroll
        for (int e = 0; e < 4; ++e) scr[kk * 65 + jr[e]] = v[i][e]; }
    asm volatile("s_waitcnt lgkmcnt(0)" ::: "memory");
    const int c = lane & 7;
#pragma unroll
    for (int ps = 0; ps < 8; ++ps) { const int j = 8 * ps + (lane >> 3); const LAS float* s = scr + (8 * c) * 65 + j;
        u32x4 o; o.x = cvt_pk_bf16(s[0 * 65], s[1 * 65]); o.y = cvt_pk_bf16(s[2 * 65], s[3 * 65]); o.z = cvt_pk_bf16(s[4 * 65], s[5 * 65]); o.w = cvt_pk_bf16(s[6 * 65], s[7 * 65]);
        *(u32x4*)(d.WTrow0 + (size_t)j * d.K + d.k0 + 8 * c) = o; }
    asm volatile("s_waitcnt lgkmcnt(0)" ::: "memory");
}
struct CvtJob { const float* W0; const float* W1; const float* kscale; bf16* WT; int ldw, K, nrows, kind, aux; float gscale; };
__device__ __forceinline__ bool cvt_try(const CvtJob& J, int& it, int lane, CvtDesc& d) {
    const int nblk = J.nrows / 64, items = (J.K / 64) * nblk;
    if (it >= items) { it -= items; return false; }
    const int kb = it / nblk, nb = it % nblk; const int n4 = lane & 15;
    const float* sp; int jk = 0;
    switch (J.kind) {
        case 0: sp = J.W0 + J.aux + nb * 64 + 4 * n4; break;
        case 1: sp = J.W0 + J.aux + 4 * n4; jk = 1; break;
        case 2: { const int hh = nb / 3, part = nb % 3; sp = J.W0 + hh * DQ + 64 * part + 4 * n4; jk = (part == 2) ? 1 : 0; } break;
        case 3: { const int hh = nb >> 2, q4 = nb & 3; sp = J.W0 + hh * 256 + 32 * q4 + 128 * (n4 >> 3) + 4 * (n4 & 7); jk = 2; } break;
        case 4: { const int tl = nb >> 2, hf = (nb >> 1) & 1, q2 = nb & 1; const long long dW = (const char*)J.W1 - (const char*)J.W0; sp = (const float*)((const char*)J.W0 + dW * hf) + tl * 128 + 64 * q2 + 4 * n4; } break;
        default: sp = nullptr; break;
    }
    d.src = sp; d.kscale = J.kscale; d.WTrow0 = J.WT + (size_t)(nb * 64) * J.K; d.ldw = J.ldw; d.k0 = kb * 64; d.K = J.K; d.jkind = jk; d.gscale = J.gscale;
    return true;
}
__device__ __forceinline__ int cvt_items(const CvtJob& J) { return (J.K / 64) * (J.nrows / 64); }

__device__ __forceinline__ void row_load(const float* xrow, int lane, f32x4 (&v)[8]) {
#pragma unroll
    for (int j = 0; j < 8; ++j) v[j] = *(const f32x4*)(xrow + 4 * lane + 256 * j);
}
__device__ __forceinline__ void norm_mod_finish(const f32x4 (&v)[8], const float* g, const float* sc, const float* sh, bf16* orow, int lane) {
    float s = 0.f;
#pragma unroll
    for (int j = 0; j < 8; ++j) s += (v[j][0] * v[j][0] + v[j][1] * v[j][1]) + (v[j][2] * v[j][2] + v[j][3] * v[j][3]);
    const float rstd = 1.0f / sqrtf(wave_sum(s, lane) * (1.0f / D) + NORM_EPS);
#pragma unroll
    for (int j = 0; j < 8; ++j) { const int c = 4 * lane + 256 * j; const f32x4 gg = *(const f32x4*)(g + c), s1 = *(const f32x4*)(sc + c), s0 = *(const f32x4*)(sh + c);
        const f32x4 y = (v[j] * rstd) * gg * (1.0f + s1) + s0;
        u32x2 w; w.x = cvt_pk_bf16(y[0], y[1]); w.y = cvt_pk_bf16(y[2], y[3]); *(u32x2*)(orow + c) = w; }
}
__device__ __forceinline__ void norm_phase(const float* xsrc, const float* csrc, const float* g, const float* modl, int chunk, bf16* H, int nrows, int gw, int NGW, int lane) {
    if (gw >= nrows) return;
    f32x4 v[8], vn[8]; int m = gw;
    row_load(m < MX ? xsrc + (size_t)m * D : csrc + (size_t)(m - MX) * D, lane, v);
    for (;;) {
        const int mn = m + NGW; const bool has = mn < nrows;
        if (has) row_load(mn < MX ? xsrc + (size_t)mn * D : csrc + (size_t)(mn - MX) * D, lane, vn);
        const float* mr = modl + (size_t)(m < MX ? (m >> 12) : 8) * NMOD + chunk * D;
        norm_mod_finish(v, g, mr + D, mr, H + (size_t)m * D, lane);
        if (!has) break;
#pragma unroll
        for (int j = 0; j < 8; ++j) v[j] = vn[j];
        m = mn;
    }
}

__device__ __forceinline__ unsigned long long ld_arg(LAS unsigned char* lds, int i) {
    const volatile LAS unsigned* p = (const volatile LAS unsigned*)(lds + ARGS_OFF) + 2 * i;
    const unsigned lo = __builtin_amdgcn_readfirstlane(p[0]), hi = __builtin_amdgcn_readfirstlane(p[1]);
    return ((unsigned long long)hi << 32) | lo;
}
__device__ __forceinline__ void mod_layers(LAS unsigned char* lds, unsigned char* ws, int l_lo, int l_hi, int wg, int nwg, int tid, int lane, int wave) {
#define ARGF(i) ((const float*)ld_arg(lds, (i)))
    const int nitems = (l_hi - l_lo) * 96;
    if (wg >= nitems) return;
    LAS float* cond = (LAS float*)lds;
    LAS float* red = (LAS float*)(lds + 73728);
    float* MODV = (float*)(ws + WS_MODV);
    { const float* cin = ARGF(1); const float* cc = ARGF(3);
      for (int i = tid; i < 9 * D; i += 512) { const int r = i >> 11, k = i & (D - 1); const float c = (r < 8) ? cin[r * D + k] : cc[k]; cond[i] = c / (1.0f + __expf(-c)); } }
    __syncthreads();
    for (int it = wg; it < nitems; it += nwg) {
        const int l = l_lo + it / 96, cb = it % 96; const int n = cb * 128 + 2 * lane;
        const float* W = ARGF(4) + (size_t)l * D * NMOD + n; const float* mb = ARGF(5) + (size_t)l * NMOD + cb * 128;
        float a0[9], a1[9];
#pragma unroll
        for (int r = 0; r < 9; ++r) { a0[r] = 0.f; a1[r] = 0.f; }
        for (int k = wave * 256; k < wave * 256 + 256; k += 8) {
            f32x2 w[8];
#pragma unroll
            for (int q = 0; q < 8; ++q) w[q] = *(const f32x2*)(W + (size_t)(k + q) * NMOD);
#pragma unroll
            for (int q4 = 0; q4 < 2; ++q4)
#pragma unroll
                for (int r = 0; r < 9; ++r) { const f32x4 c4 = *(const LAS f32x4*)(cond + r * D + k + 4 * q4);
#pragma unroll
                    for (int q = 0; q < 4; ++q) { a0[r] += c4[q] * w[4 * q4 + q][0]; a1[r] += c4[q] * w[4 * q4 + q][1]; } }
        }
#pragma unroll
        for (int r = 0; r < 9; ++r) { red[(wave * 9 + r) * 128 + 2 * lane] = a0[r]; red[(wave * 9 + r) * 128 + 2 * lane + 1] = a1[r]; }
        __syncthreads();
        for (int i = tid; i < 9 * 128; i += 512) { const int r = i >> 7, cc = i & 127; float s2 = 0.f;
#pragma unroll
            for (int w8 = 0; w8 < 8; ++w8) s2 += red[(w8 * 9 + r) * 128 + cc];
            MODV[((size_t)l * 9 + r) * NMOD + cb * 128 + cc] = s2 + mb[cc]; }
        __syncthreads();
    }
#undef ARGF
}
__device__ __forceinline__ void cvt_layer(LAS unsigned char* lds, unsigned char* ws, int lc, int rank, int nranks, int wave, int lane, int part  ) {
#define ARGF(i) ((const float*)ld_arg(lds, (i)))
    const int li = lc >> 1; const bool is_ret = (lc & 1) != 0;
    bf16* WM = (bf16*)(ws + (is_ret ? WS_WB : WS_WA)); bf16* WF = (bf16*)(ws + (is_ret ? WS_WB + 82 * MiB : WS_WA + 22 * MiB));
    LAS float* scr = (LAS float*)(lds + wave * 19456);
    CvtJob J[7]; int nj;
    if (!is_ret) {
        bf16* W1T = WM; bf16* WuqT = W1T + (size_t)N1 * D; bf16* WukvT = WuqT + (size_t)3072 * 512; bf16* WoT = WukvT + (size_t)4096 * 512;
        const float* wdq = ARGF(8) + (size_t)li * D * QR; const float* wdkv = ARGF(11) + (size_t)li * D * (KVR + ROPE);
        J[0] = CvtJob{wdq, nullptr, nullptr, W1T, QR, D, 512, 0, 0, 1.f};
        J[1] = CvtJob{wdkv, nullptr, nullptr, W1T + (size_t)512 * D, KVR + ROPE, D, 512, 0, 0, 1.f};
        J[2] = CvtJob{wdkv, nullptr, nullptr, W1T + (size_t)1024 * D, KVR + ROPE, D, 64, 1, 512, 1.f};
        J[3] = CvtJob{nullptr, nullptr, nullptr, W1T + (size_t)1088 * D, 1, D, 192, 5, 0, 1.f};
        J[4] = CvtJob{ARGF(10) + (size_t)li * QR * 3072, nullptr, ARGF(9) + li * QR, WuqT, 3072, QR, 3072, 2, 0, 0.07216878364870322f * LOG2E};
        J[5] = CvtJob{ARGF(13) + (size_t)li * KVR * 4096, nullptr, ARGF(12) + li * KVR, WukvT, 4096, KVR, 4096, 0, 0, 1.f};
        J[6] = CvtJob{ARGF(14) + (size_t)li * D * D, nullptr, nullptr, WoT, D, D, D, 0, 0, 1.f};
        nj = 7;
    } else {
        bf16* WqkvT = WM; bf16* WgT = WqkvT + (size_t)8192 * D; bf16* WoT = WgT + (size_t)8192 * D;
        J[0] = CvtJob{ARGF(15) + (size_t)li * D * D, nullptr, nullptr, WqkvT, D, D, 2048, 3, 0, 1.f};
        J[1] = CvtJob{ARGF(16) + (size_t)li * D * D, nullptr, nullptr, WqkvT + (size_t)2048 * D, D, D, 2048, 3, 0, 0.0625f};
        J[2] = CvtJob{ARGF(17) + (size_t)li * D * 4096, nullptr, nullptr, WqkvT + (size_t)4096 * D, 4096, D, 4096, 0, 0, 1.f};
        J[3] = CvtJob{ARGF(18) + (size_t)li * D * 4096, ARGF(19) + (size_t)li * D * 4096, nullptr, WgT, 4096, D, 8192, 4, 0, 1.f};
        J[4] = CvtJob{ARGF(20) + (size_t)li * 4096 * D, nullptr, nullptr, WoT, D, 4096, D, 0, 0, 1.f};
        J[5] = CvtJob{nullptr, nullptr, nullptr, nullptr, 1, 64, 0, 5, 0, 1.f};
        J[6] = J[5];
        nj = 5;
    }
    CvtJob F0 = CvtJob{ARGF(23) + (size_t)lc * D * FF, ARGF(24) + (size_t)lc * D * FF, nullptr, WF, FF, D, 11264, 4, 0, 1.f};
    CvtJob F1 = CvtJob{ARGF(27) + (size_t)lc * FF * D, nullptr, nullptr, WF + (size_t)11264 * D, D, FF, D, 0, 0, 1.f};
    if (part == 1) nj = 0;
    const bool ffn = part != 0;
    int total = ffn ? cvt_items(F0) + cvt_items(F1) : 0;
#pragma unroll
    for (int j = 0; j < 7; ++j) if (j < nj) total += cvt_items(J[j]);
#define CVT_FIND(IT, DD) do { int it_ = (IT); bool done_ = false; \
        _Pragma("unroll") for (int j = 0; j < 7; ++j) if (!done_ && j < nj) done_ = cvt_try(J[j], it_, lane, DD); \
        if (ffn) { if (!done_) done_ = cvt_try(F0, it_, lane, DD); if (!done_) done_ = cvt_try(F1, it_, lane, DD); } } while (0)
    if (rank < total) {
        f32x4 v[16], w[16]; CvtDesc d0, d1; int it0 = rank;
        CVT_FIND(it0, d0); cvt_load(d0, lane, v);
        for (;;) {
            const int it1 = it0 + nranks; const bool has = it1 < total;
            if (has) { CVT_FIND(it1, d1); cvt_load(d1, lane, w); }
            cvt_store(d0, lane, v, scr);
            if (!has) break;
#pragma unroll
            for (int i = 0; i < 16; ++i) v[i] = w[i];
            d0 = d1; it0 = it1;
        }
    }
#undef CVT_FIND
#undef ARGF
}

#if MLA_CHECK
constexpr int CW_CHK = 2048;
__device__ __forceinline__ float wave_max(float v, int lane) {
#pragma unroll
    for (int o = 1; o < 64; o <<= 1) v = fmaxf(v, shfl_xor_l(v, o, lane));
    return v;
}
__device__ __forceinline__ void mla_check(LAS unsigned char* lds, unsigned char* ws, int li, int gw, int wave, int lane) {
#define ARGF(i) ((const float*)ld_arg(lds, (i)))
    LAS float* sc = (LAS float*)(lds + wave * 19456);
    const bf16* H = (const bf16*)(ws + WS_H); const bf16* Qb = (const bf16*)(ws + WS_Q); const bf16* KVb = (const bf16*)(ws + WS_KV); const bf16* KRb = (const bf16*)(ws + WS_KR); const bf16* Ob = (const bf16*)(ws + WS_O);
    const int t = (int)(((unsigned)gw * 2654435761u) % (unsigned)MT); const int hd = gw & 15;
    const bool isx = t < MX; const int tt = t & (SEQ - 1);
    float err = 0.f;
    {
        const float* wdq = ARGF(8) + (size_t)li * D * QR; const float* wdkv = ARGF(11) + (size_t)li * D * (KVR + ROPE);
        float ql[8], kl[9];
#pragma unroll
        for (int j = 0; j < 8; ++j) ql[j] = 0.f;
#pragma unroll
        for (int j = 0; j < 9; ++j) kl[j] = 0.f;
        for (int k = 0; k < D; ++k) { const float hv = bf2f(H[(size_t)t * D + k]);
#pragma unroll
            for (int j = 0; j < 8; ++j) ql[j] += hv * wdq[(size_t)k * QR + lane + 64 * j];
#pragma unroll
            for (int j = 0; j < 9; ++j) kl[j] += hv * wdkv[(size_t)k * (KVR + ROPE) + lane + 64 * j]; }
        float sq = 0.f, sk = 0.f;
#pragma unroll
        for (int j = 0; j < 8; ++j) { sq += ql[j] * ql[j]; sk += kl[j] * kl[j]; }
        const float rq = 1.0f / sqrtf(wave_sum(sq, lane) * (1.0f / QR) + NORM_EPS), rk = 1.0f / sqrtf(wave_sum(sk, lane) * (1.0f / KVR) + NORM_EPS);
        const float* qg = ARGF(9) + li * QR; const float* kg = ARGF(12) + li * KVR;
#pragma unroll
        for (int j = 0; j < 8; ++j) { sc[lane + 64 * j] = ql[j] * rq * qg[lane + 64 * j]; sc[512 + lane + 64 * j] = kl[j] * rk * kg[lane + 64 * j]; }
        sc[1024 + lane] = kl[8];
        asm volatile("s_waitcnt lgkmcnt(0)" ::: "memory");
        const float* wuq = ARGF(10) + (size_t)li * QR * 3072 + hd * DQ; const float* wukv = ARGF(13) + (size_t)li * KVR * 4096 + hd * 256;
        float qv[3] = {0.f, 0.f, 0.f}, kv[4] = {0.f, 0.f, 0.f, 0.f};
        for (int c = 0; c < 512; ++c) { const float a = sc[c], bq = sc[512 + c];
#pragma unroll
            for (int j = 0; j < 3; ++j) qv[j] += a * wuq[(size_t)c * 3072 + lane + 64 * j];
#pragma unroll
            for (int j = 0; j < 4; ++j) kv[j] += bq * wukv[(size_t)c * 4096 + lane + 64 * j]; }
#pragma unroll
        for (int j = 0; j < 3; ++j) sc[1100 + lane + 64 * j] = qv[j];
        asm volatile("s_waitcnt lgkmcnt(0)" ::: "memory");
        float qref[3]; float kr_ref = 0.f;
#pragma unroll
        for (int j = 0; j < 3; ++j) { const int d = lane + 64 * j; float v = sc[1100 + d];
            if (d >= NOPE && isx) { const int e = d - NOPE, half = e >> 5, i = e & 15, second = (e >> 4) & 1; const float pos = half ? (float)(tt & 63) : (float)(tt >> 6);
                const float ang = pos * __builtin_amdgcn_exp2f(-(float)(2 * i) * (13.287712379549449f / 32.0f)); const float rev = ang * 0.15915494309189535f; const float fr_ = rev - floorf(rev);
                const float cs = __builtin_amdgcn_cosf(fr_), sn = __builtin_amdgcn_sinf(fr_); const float other = sc[1100 + NOPE + half * 32 + i + (second ? 0 : 16)];
                v = second ? (v * cs + other * sn) : (v * cs - other * sn); }
            qref[j] = v * (0.07216878364870322f * LOG2E); }
        { const int e = lane, half = e >> 5, i = e & 15, second = (e >> 4) & 1; float v = sc[1024 + e];
          if (isx) { const float pos = half ? (float)(tt & 63) : (float)(tt >> 6);
              const float ang = pos * __builtin_amdgcn_exp2f(-(float)(2 * i) * (13.287712379549449f / 32.0f)); const float rev = ang * 0.15915494309189535f; const float fr_ = rev - floorf(rev);
              const float cs = __builtin_amdgcn_cosf(fr_), sn = __builtin_amdgcn_sinf(fr_); const float other = sc[1024 + half * 32 + i + (second ? 0 : 16)];
              v = second ? (v * cs + other * sn) : (v * cs - other * sn); }
          kr_ref = v; }
#pragma unroll
        for (int j = 0; j < 3; ++j) sc[1400 + lane + 64 * j] = qref[j];
        sc[1600 + lane] = kr_ref;
        asm volatile("s_waitcnt lgkmcnt(0)" ::: "memory");
        float mx = 0.f, df = 0.f;
#pragma unroll
        for (int j = 0; j < 3; ++j) { const int p = lane + 64 * j; const int od = p < NOPE ? p : NOPE + ropeperm64(p - NOPE); const float ref = sc[1400 + od]; const float mine = bf2f(Qb[(size_t)t * 3072 + hd * DQ + p]);
            mx = fmaxf(mx, fabsf(ref)); df = fmaxf(df, fabsf(ref - mine)); }
        err = fmaxf(err, wave_max(df, lane) / (wave_max(mx, lane) + 1e-20f));
        mx = 0.f; df = 0.f;
#pragma unroll
        for (int j = 0; j < 4; ++j) { const float ref = kv[j]; const float mine = bf2f(KVb[(size_t)t * 4096 + hd * 256 + lane + 64 * j]); mx = fmaxf(mx, fabsf(ref)); df = fmaxf(df, fabsf(ref - mine)); }
        err = fmaxf(err, wave_max(df, lane) / (wave_max(mx, lane) + 1e-20f));
        { const float ref = sc[1600 + ropeperm64(lane)]; const float mine = bf2f(KRb[(size_t)t * 64 + lane]); err = fmaxf(err, wave_max(fabsf(ref - mine), lane) / (wave_max(fabsf(ref), lane) + 1e-20f)); }
    }
    {
        const int b = isx ? (t >> 12) : ((t - MX) >> 8); const int nk = isx ? 4352 : 256;
        for (int d = lane; d < DQ; d += 64) sc[d] = bf2f(Qb[(size_t)t * 3072 + hd * DQ + d]);
        asm volatile("s_waitcnt lgkmcnt(0)" ::: "memory");
        float mxs = -1e30f;
        for (int j = lane; j < nk; j += 64) { const int row = j < 256 ? MX + b * CTXL + j : b * SEQ + (j - 256); float sdot = 0.f;
            for (int d = 0; d < NOPE; ++d) sdot += sc[d] * bf2f(KVb[(size_t)row * 4096 + hd * 256 + d]);
            for (int d = 0; d < ROPE; ++d) sdot += sc[NOPE + d] * bf2f(KRb[(size_t)row * 64 + d]);
            sc[256 + j] = sdot; mxs = fmaxf(mxs, sdot); }
        mxs = wave_max(mxs, lane); float sum = 0.f;
        for (int j = lane; j < nk; j += 64) { const float p = __builtin_amdgcn_exp2f(sc[256 + j] - mxs); sc[256 + j] = p; sum += p; }
        sum = wave_sum(sum, lane);
        asm volatile("s_waitcnt lgkmcnt(0)" ::: "memory");
        float o0 = 0.f, o1 = 0.f;
        for (int j = 0; j < nk; ++j) { const int row = j < 256 ? MX + b * CTXL + j : b * SEQ + (j - 256); const float p = sc[256 + j];
            o0 += p * bf2f(KVb[(size_t)row * 4096 + hd * 256 + 128 + lane]); o1 += p * bf2f(KVb[(size_t)row * 4096 + hd * 256 + 128 + 64 + lane]); }
        o0 /= sum; o1 /= sum;
        const float m0 = bf2f(Ob[(size_t)t * D + hd * 128 + lane]), m1 = bf2f(Ob[(size_t)t * D + hd * 128 + 64 + lane]);
        const float df = fmaxf(fabsf(o0 - m0), fabsf(o1 - m1)), mx = fmaxf(fabsf(o0), fabsf(o1));
        err = fmaxf(err, wave_max(df, lane) / (wave_max(mx, lane) + 1e-20f));
    }
    if (lane == 0) atomicMax((unsigned*)(ws + WS_CTL) + CW_CHK, __float_as_uint(err));
#undef ARGF
}
#endif
struct Args { const float* in[29]; float* out; unsigned char* ws; int ph_lo, ph_hi; };
constexpr int PH_PER_LAYER = 10, PH_FINAL = 1 + PH_PER_LAYER * DEPTH, PH_COUNT = PH_FINAL + 1;

template <unsigned MK_EN_T>
__global__ void __launch_bounds__(512, 2) mk_fwd(Args args) {
    extern __shared__ __attribute__((aligned(16))) unsigned char lds_raw[];
    LAS unsigned char* lds = (LAS unsigned char*)lds_raw;
    volatile LAS unsigned* MISC = (volatile LAS unsigned*)(lds + MISC_OFF);
    const int G = gridDim.x; const int bx = blockIdx.x; const int vcu = (G % 8 == 0) ? (bx % 8) * (G / 8) + bx / 8 : bx;
    const int NGW = G * 8;
    unsigned char* ws = args.ws; float* X = args.out;
    const int lo = args.ph_lo, hi = args.ph_hi;
    const int wave_s = __builtin_amdgcn_readfirstlane((int)threadIdx.x >> 6);
#define TID() (wave_s * 64 + lane_id())
    { const int tid0 = threadIdx.x;
      for (int u = tid0; u < (LDS_BYTES - CTRL_BASE) / 4; u += 512) ((LAS unsigned*)(lds + CTRL_BASE))[u] = 0u;
      __syncthreads();
      if (tid0 < 29) ((volatile LAS unsigned long long*)(lds + ARGS_OFF))[tid0] = (unsigned long long)args.in[tid0];
      __syncthreads(); }
#define ARGF(i) ((const float*)ld_arg(lds, (i)))
    XcdBarrier bar; bar.bar = (unsigned*)(ws + WS_CTL) + CW_BAR; bar.x = 0; bar.st = nullptr; bar.wave = wave_s;
    if (hi - lo > 1) bar = xcd_barrier_post((unsigned*)(ws + WS_CTL) + CW_BAR, MISC + 8, wave_s);
#if PROBE_TS
    if (bx == 0 && TID() == 0) { ((unsigned long long*)(ws + WS_CTL + 65536))[0] = __builtin_amdgcn_s_memrealtime(); ((unsigned long long*)(ws + WS_CTL + 65536))[121] = ~0ull; }
#endif
#define EN(b) (((MK_EN_T) >> (b)) & 1u)
#define IN(k) (lo <= (k) && (k) < hi)
#if PROBE_TS
#define TS_WORDS ((unsigned long long*)(ws + WS_CTL + 65536))
#define PHASE_END(k) do { if (hi > (k) + 1) xcd_barrier(bar); if (bx == 0 && TID() == 0) TS_WORDS[(k) + 1] = __builtin_amdgcn_s_memrealtime(); } while (0)
#else
#define PHASE_END(k) do { if (hi > (k) + 1) xcd_barrier(bar); } while (0)
#endif
#define PH_IDS int tid = TID(); asm volatile("" : "+v"(tid)); const int lane = tid & 63; const int wave = wave_s; const int gw = vcu * 8 + wave; (void)lane; (void)gw;
#define XC_    ((float*)(ws + WS_XC))
#define MODV_  ((float*)(ws + WS_MODV))
#define TABM_  ((float*)(ws + WS_TABM))
#define TABR_  ((float*)(ws + WS_TABR))
#define SSQ_   ((float*)(ws + WS_SSQ))
#define KR_    ((bf16*)(ws + WS_KR))
#define H_     ((bf16*)(ws + WS_H))
#define WMIX_(ll) ((bf16*)(ws + (((ll) & 1) ? WS_WB : WS_WA)))
#define WFFN_(ll) ((bf16*)(ws + (((ll) & 1) ? WS_WB + 82 * MiB : WS_WA + 22 * MiB)))
#define W1T_   WMIX_(l)
#define WUQT_  (W1T_ + (size_t)N1 * D)
#define WUKVT_ (WUQT_ + (size_t)3072 * 512)
#define WOTM_  (WUKVT_ + (size_t)4096 * 512)
#define WQKVT_ WMIX_(l)
#define WGT_   (WQKVT_ + (size_t)8192 * D)
#define WOTR_  (WGT_ + (size_t)8192 * D)
#define WGUT_  WFFN_(l)
#define WDT_   (WGUT_ + (size_t)11264 * D)
#define QKVL_  ((bf16*)(ws + WS_QKVL))
#define Q_     ((bf16*)(ws + WS_Q))
#define KV_    ((bf16*)(ws + WS_KV))
#define O_     ((bf16*)(ws + WS_O))
#define QKV_   ((bf16*)(ws + WS_QKV))
#define Y_     ((bf16*)(ws + WS_Y))
#define GATED_ ((bf16*)(ws + WS_GATED))
#define GB_    ((bf16*)(ws + WS_G))
#define UB_    ((bf16*)(ws + WS_U))
#define HALO_  ((float*)(ws + WS_G))
#define MODL_  (MODV_ + (size_t)l * 9 * NMOD)

    if (EN(0) && IN(0)) for (int rep_ = 0; rep_ < 1 + (int)((PROBE_MASK >> 0) & 1u); ++rep_) {
        PH_IDS
        mod_layers(lds, ws, 0, 1, bx, G, tid, lane, wave);
        __syncthreads();
        cvt_layer(lds, ws, 0, gw, NGW, wave, lane, 2);
        for (int i = bx * 512 + tid; i < 64 * 16 + SEQ * 128; i += G * 512) {
            float inv, pos; float* dst;
            if (i < 1024) { const int p = i >> 4, f = i & 15; inv = __builtin_amdgcn_exp2f(-(float)(2 * f) * (13.287712379549449f / 32.0f)); pos = (float)p; dst = TABM_ + 2 * i; }
            else { const int j = i - 1024, t = j >> 7, f = j & 127; inv = __builtin_amdgcn_exp2f(-(float)(2 * f) * (13.287712379549449f / 256.0f)); pos = (float)t; dst = TABR_ + 2 * j; }
            const float ang = pos * inv; const double rev = (double)ang * 0.15915494309189535; const float fr = (float)(rev - floor(rev));
            dst[0] = __builtin_amdgcn_cosf(fr); dst[1] = __builtin_amdgcn_sinf(fr);
        }
        PHASE_END(0);
    }

    for (int l = 0; l < DEPTH; ++l) {
        const int P = 1 + PH_PER_LAYER * l; const int li = l >> 1; const bool is_ret = (l & 1) != 0; const bool last = (l == DEPTH - 1);
        const int Mrows = last ? MX : MT;

        if (EN(1) && IN(P + 0)) for (int rep_ = 0; rep_ < 1 + (int)((PROBE_MASK >> 1) & 1u); ++rep_) {
            PH_IDS
            const float* g = ARGF(6) + l * D; const float* xsrc = (l == 0) ? ARGF(0) : X; const float* csrc = (l == 0) ? ARGF(2) : XC_;
            norm_phase(xsrc, csrc, g, MODL_, 0, H_, MT, gw, NGW, lane);
            PHASE_END(P + 0);
        }

        if (!is_ret) {
            if (EN(2) && IN(P + 1)) for (int rep_ = 0; rep_ < 1 + (int)((PROBE_MASK >> 2) & 1u); ++rep_) {
                pg8::Gemm g{H_, W1T_, MT, N1, D, D}; pg8::StaticOrder S; S.init(MT, N1, G, bx); S.tid = TID();
                EpiG1 E{QKVL_, SSQ_, KR_, TABM_};
                pg8::gemm_phase<EpiG1>(lds, g, S, E);
                PHASE_END(P + 1);
            }
            if (EN(3) && IN(P + 2)) for (int rep_ = 0; rep_ < 1 + (int)((PROBE_MASK >> 3) & 1u); ++rep_) {
                { pg8::Gemm g{QKVL_, WUQT_, MT, 3072, QR, N1}; pg8::StaticOrder S; S.init(MT, 3072, G, bx); S.tid = TID(); EpiUq E{Q_, SSQ_, TABM_}; pg8::gemm_phase<EpiUq>(lds, g, S, E); }
                { pg8::Gemm g{QKVL_ + 512, WUKVT_, MT, 4096, KVR, N1}; pg8::StaticOrder S; S.init(MT, 4096, G, (G % 16 == 0) ? (bx + G / 2) % G : bx)  ; S.tid = TID(); EpiUkv E{KV_, SSQ_}; pg8::gemm_phase<EpiUkv>(lds, g, S, E); }
                PHASE_END(P + 2);
            }
            if (EN(4) && IN(P + 3)) for (int rep_ = 0; rep_ < 1 + (int)((PROBE_MASK >> 4) & 1u); ++rep_) {
                const int nun = 2048 + 128;
                for (int ui = vcu; ui < nun; ui += G) {
                    if (ui < 2048) { const int xcd = (ui & 255) >> 5, j = ui & 31, rnd = ui >> 8; const int bh = xcd * 16 + 2 * rnd + (j >> 4), qb = j & 15; const int b = bh >> 4, hd = bh & 15;
                        att::attn_unit(Q_ + (size_t)(b * SEQ + qb * 256) * 3072 + hd * DQ, KV_ + hd * 256, KR_, O_ + (size_t)(b * SEQ + qb * 256) * D + hd * 128, 68, 4, MX + b * CTXL, b * SEQ, (char*)lds_raw, TID()
#if PROBE_TS
                            , bx == 0 ? TS_WORDS : nullptr
#endif
                            );
                    } else { const int bh = ui - 2048, b = bh >> 4, hd = bh & 15;
                        att::attn_unit(Q_ + (size_t)(MX + b * CTXL) * 3072 + hd * DQ, KV_ + hd * 256, KR_, O_ + (size_t)(MX + b * CTXL) * D + hd * 128, 4, 4, MX + b * CTXL, 0, (char*)lds_raw, TID()); }
                }
                PHASE_END(P + 3);
            }
        } else {
            if (EN(5) && IN(P + 1)) for (int rep_ = 0; rep_ < 1 + (int)((PROBE_MASK >> 5) & 1u); ++rep_) {
                pg8::Gemm g{H_, WQKVT_, MT, 8192, D, D}; pg8::StaticOrder S; S.init(MT, 8192, G, bx); S.tid = TID();
                EpiQKV E{QKV_, TABR_};
                pg8::gemm_phase<EpiQKV>(lds, g, S, E);
                PHASE_END(P + 1);
            }
            if (EN(6) && IN(P + 2)) for (int rep_ = 0; rep_ < 1 + (int)((PROBE_MASK >> 6) & 1u); ++rep_) {
                for (int ui = vcu; ui < 256; ui += G) {
                    const int bh = ui >> 2, dir = (ui >> 1) & 1, dvh = ui & 1; const int b = bh >> 3, hd = bh & 7;
                    const float dec = (dir ? ARGF(22) : ARGF(21))[li * RH + hd];
                    const float lg2 = -__expf(dec) * LOG2E;
                    scan::scan_unit(QKV_, Y_ + (size_t)dir * MT * 4096, b, hd, dir, dvh, lg2, last, lds, TID()
#if PROBE_TS
                                    , TS_WORDS
#endif
                                    );
                }
                PHASE_END(P + 2);
            }
            if (EN(7) && IN(P + 3)) for (int rep_ = 0; rep_ < 1 + (int)((PROBE_MASK >> 7) & 1u); ++rep_) {
                PH_IDS
                for (int row = gw; row < Mrows; row += NGW) {
                    u32x4 w[16];
#pragma unroll
                    for (int q = 0; q < 16; ++q) w[q] = *(const u32x4*)(Y_ + (size_t)(q >> 3) * MT * 4096 + (size_t)row * 4096 + (q & 7) * RDV + lane * 8);
                    float mu[16], rs[16];
#pragma unroll
                    for (int q = 0; q < 16; ++q) { const float s = ((bflo(w[q].x) + bfhi(w[q].x)) + (bflo(w[q].y) + bfhi(w[q].y))) + ((bflo(w[q].z) + bfhi(w[q].z)) + (bflo(w[q].w) + bfhi(w[q].w))); mu[q] = s; }
#pragma unroll
                    for (int o = 1; o < 64; o <<= 1)
#pragma unroll
                        for (int q = 0; q < 16; ++q) mu[q] += shfl_xor_l(mu[q], o, lane);
#pragma unroll
                    for (int q = 0; q < 16; ++q) { mu[q] *= (1.0f / RDV); const float m_ = mu[q];
                        const float d0 = bflo(w[q].x) - m_, d1 = bfhi(w[q].x) - m_, d2 = bflo(w[q].y) - m_, d3 = bfhi(w[q].y) - m_, d4 = bflo(w[q].z) - m_, d5 = bfhi(w[q].z) - m_, d6 = bflo(w[q].w) - m_, d7 = bfhi(w[q].w) - m_;
                        rs[q] = ((d0 * d0 + d1 * d1) + (d2 * d2 + d3 * d3)) + ((d4 * d4 + d5 * d5) + (d6 * d6 + d7 * d7)); }
#pragma unroll
                    for (int o = 1; o < 64; o <<= 1)
#pragma unroll
                        for (int q = 0; q < 16; ++q) rs[q] += shfl_xor_l(rs[q], o, lane);
                    float mo = 0.f, ro = 0.f;
#pragma unroll
                    for (int q = 0; q < 16; ++q) { if (lane == q) { mo = mu[q]; ro = rs[q]; } }
                    if (lane < 16) *(f32x2*)((float*)(ws + WS_STATS) + ((size_t)((lane >> 3) * MT + row) * 8 + (lane & 7)) * 2) = (f32x2){mo, 1.0f / sqrtf(ro * (1.0f / RDV) + GN_EPS)};
                }
                PHASE_END(P + 3);
            }
            if (EN(8) && IN(P + 4)) for (int rep_ = 0; rep_ < 1 + (int)((PROBE_MASK >> 8) & 1u); ++rep_) {
                pg8::Gemm g{H_, WGT_, Mrows, 8192, D, D}; pg8::StaticOrder S; S.init(Mrows, 8192, G, bx); S.tid = TID();
                EpiGate E{GATED_, Y_, Y_ + (size_t)MT * 4096, (const float*)(ws + WS_STATS)};
                pg8::gemm_phase<EpiGate>(lds, g, S, E);
                PHASE_END(P + 4);
            }
        }
        if (EN(9) && IN(P + 5)) for (int rep_ = 0; rep_ < 1 + (int)((PROBE_MASK >> 9) & 1u); ++rep_) {
#if MLA_CHECK
            if (l == MLA_CHECK_LAYER) { PH_IDS mla_check(lds, ws, li, gw, wave, lane); __syncthreads(); }
#endif
            pg8::Gemm g = is_ret ? pg8::Gemm{GATED_, WOTR_, Mrows, D, 4096, 4096} : pg8::Gemm{O_, WOTM_, Mrows, D, D, D};
            pg8::StaticOrder S; S.init(Mrows, D, G, bx, 4, true); S.tid = TID();
#if PROBE_TS
            S.probe = is_ret ? 2 : 1; S.tsw = TS_WORDS;
#endif
            const float* xsrc = (l == 0) ? ARGF(0) : X; const float* csrc = (l == 0) ? ARGF(2) : XC_;
            EpiResid E{xsrc, X, csrc, XC_, MODL_, 2 * D};
            pg8::gemm_phase<EpiResid>(lds, g, S, E);
            if (l + 1 < DEPTH) {
                PH_IDS
                const int nwg = (Mrows / 256) * (D / 256), rem = nwg % G;
                if (rem == 0) cvt_layer(lds, ws, l + 1, gw, NGW, wave, lane, 0);
                else if (bx >= rem) cvt_layer(lds, ws, l + 1, (bx - rem) * 8 + wave, (G - rem) * 8, wave, lane, 0);
            }
            PHASE_END(P + 5);
        }
        if (EN(10) && IN(P + 6)) for (int rep_ = 0; rep_ < 1 + (int)((PROBE_MASK >> 10) & 1u); ++rep_) {
            PH_IDS
            const float* g = ARGF(7) + l * D;
            norm_phase(X, XC_, g, MODL_, 3, H_, Mrows, gw, NGW, lane);
            PHASE_END(P + 6);
        }
        if (EN(11) && IN(P + 7)) for (int rep_ = 0; rep_ < 1 + (int)((PROBE_MASK >> 11) & 1u); ++rep_) {
            pg8::Gemm g{H_, WGUT_, Mrows, 11264, D, D}; pg8::StaticOrder S; S.init(Mrows, 11264, G, bx); S.tid = TID();
#if PROBE_TS
            S.probe = 4; S.tsw = TS_WORDS;
#endif
            EpiGUConv E{UB_, HALO_, ARGF(25) + (size_t)l * 3 * FF, ARGF(26) + (size_t)l * FF, (LAS float*)(lds + EDGE_OFF)};
            pg8::gemm_phase<EpiGUConv>(lds, g, S, E);
#if PROBE_TS
            if (TID() == 0 && bx == 0) TS_WORDS[140 + l] = __builtin_amdgcn_s_memrealtime();
            if (TID() == 0 && bx == G - 1) TS_WORDS[148 + l] = __builtin_amdgcn_s_memrealtime();
#endif
            PHASE_END(P + 7);
        }
        if (EN(13) && IN(P + 9)) for (int rep_ = 0; rep_ < 1 + (int)((PROBE_MASK >> 13) & 1u); ++rep_) {
            pg8::Gemm g{UB_, WDT_, Mrows, D, FF, FF}; pg8::StaticOrder S; S.init(Mrows, D, G, bx, 4, true); S.tid = TID();
#if PROBE_TS
            S.probe = 3; S.tsw = TS_WORDS;
#endif
            {
                PH_IDS
                const float* cw = ARGF(25) + (size_t)l * 3 * FF; const float* HL = HALO_; bf16* ACT = UB_;
                pg8::Unit uu; int prev_pm = -1;
                for (int i = 0; S.next(i, uu); ++i) { const int pm = uu.pm; if (pm == prev_pm || pm >= MX / 256) { prev_pm = pm; continue; } prev_pm = pm;
                    const bool top = (pm & 15) != 0, bot = ((pm + 1) & 15) != 0;
                    for (int q = tid; q < FF / 4; q += 512) { const int f = q * 4;
                        if (top) { const float* t0 = HL + (size_t)((pm * 2 + 0) * 3) * HALO_STRIDE + f; const float* b1 = HL + (size_t)(((pm - 1) * 2 + 1) * 3) * HALO_STRIDE + f;
                            const f32x4 o = silu4(*(const f32x4*)t0 + *(const f32x4*)(cw + f) * *(const f32x4*)(b1 + HALO_STRIDE)) * *(const f32x4*)(t0 + 2 * HALO_STRIDE);
                            u32x2 w; w.x = cvt_pk_bf16(o[0], o[1]); w.y = cvt_pk_bf16(o[2], o[3]); *(u32x2*)(ACT + (size_t)(pm * 256) * FF + f) = w; }
                        if (bot) { const float* b0 = HL + (size_t)((pm * 2 + 1) * 3) * HALO_STRIDE + f; const float* t1 = HL + (size_t)(((pm + 1) * 2 + 0) * 3) * HALO_STRIDE + f;
                            const f32x4 o = silu4(*(const f32x4*)b0 + *(const f32x4*)(cw + 2 * FF + f) * *(const f32x4*)(t1 + HALO_STRIDE)) * *(const f32x4*)(b0 + 2 * HALO_STRIDE);
                            u32x2 w; w.x = cvt_pk_bf16(o[0], o[1]); w.y = cvt_pk_bf16(o[2], o[3]); *(u32x2*)(ACT + (size_t)(pm * 256 + 255) * FF + f) = w; } } }
                asm volatile("s_waitcnt vmcnt(0)" ::: "memory"); __syncthreads();
            }
            EpiResid E{X, X, XC_, XC_, MODL_, 5 * D};
            pg8::gemm_phase<EpiResid>(lds, g, S, E);
#if PROBE_TS
            if (TID() == 0 && bx == 0) TS_WORDS[64 + l] = __builtin_amdgcn_s_memrealtime();
            if (TID() == 0 && bx == G - 1) TS_WORDS[72 + l] = __builtin_amdgcn_s_memrealtime();
#endif
            if (l + 1 < DEPTH) {
                PH_IDS
                const int nwg = (Mrows / 256) * (D / 256), rem = nwg % G;
                if (rem == 0) { mod_layers(lds, ws, l + 1, l + 2, bx, G, tid, lane, wave); __syncthreads(); cvt_layer(lds, ws, l + 1, gw, NGW, wave, lane, 1); }
                else if (bx >= rem) { mod_layers(lds, ws, l + 1, l + 2, bx - rem, G - rem, tid, lane, wave); __syncthreads(); cvt_layer(lds, ws, l + 1, (bx - rem) * 8 + wave, (G - rem) * 8, wave, lane, 1); }
            }
#if PROBE_TS
            __syncthreads(); if (TID() == 0 && bx == G - 1) TS_WORDS[80 + l] = __builtin_amdgcn_s_memrealtime();
#endif
            PHASE_END(P + 9);
        }
    }
    if (EN(14) && IN(PH_FINAL)) for (int rep_ = 0; rep_ < 1 + (int)((PROBE_MASK >> 14) & 1u); ++rep_) {
        PH_IDS
        const float* g = ARGF(28);
#if PROBE_TS
        float ts_c = 0.f, ts_a = 0.f;
        { const unsigned long long* TS = (const unsigned long long*)(ws + WS_CTL + 65536); unsigned long long last = TS[0]; const unsigned long long t0 = last; float d1 = 0.f, d2 = 0.f;
          for (int k = 0; k < PH_FINAL; ++k) { const unsigned long long te = TS[k + 1]; if (te == 0ull) continue; const float d = (float)(te - last); last = te;
              int cls; if (k == 0) cls = 0; else { const int slot = (k - 1) % PH_PER_LAYER, ll = (k - 1) / PH_PER_LAYER; const bool ret = (ll & 1) != 0;
                  cls = slot == 0 ? 1 : slot >= 5 ? 5 + slot : (!ret ? 1 + slot : 4 + slot); }
              if (k > 0 && ((k - 1) % PH_PER_LAYER) == 5) { const bool ret5 = (((k - 1) / PH_PER_LAYER) & 1) != 0; if (TS_CLASS1 == (ret5 ? 51 : 50)) d1 += d; if (TS_CLASS2 == (ret5 ? 51 : 50)) d2 += d; }
              if (cls == TS_CLASS1) d1 += d; if (cls == TS_CLASS2) d2 += d; }
          float tot = (float)(last - t0);
          if (TS_CLASS1 >= 100) { float ph = 0.f, x0 = 0.f, x1 = 0.f, x2 = 0.f;
              for (int ll = 0; ll < 3; ++ll) { const unsigned long long st = TS[(1 + PH_PER_LAYER * ll + 7) + 1], en = TS[(1 + PH_PER_LAYER * ll + 9) + 1];
                  ph += (float)(en - st); x0 += (float)(TS[64 + ll] - st); x1 += (float)(TS[72 + ll] - st); x2 += (float)(TS[80 + ll] - st); }
              d1 = (TS_CLASS1 == 100) ? x0 : (TS_CLASS1 == 101) ? x1 : x2; d2 = (TS_CLASS2 == 100) ? x0 : (TS_CLASS2 == 101) ? x1 : x2; tot = ph; }
          if (TS_CLASS1 >= 200) { const unsigned long long* tw = TS + 90 + 3 * (TS_CLASS1 - 201); const float lp = (float)tw[0], ep = (float)tw[1], nn = (float)tw[2];
              d1 = lp; tot = lp + ep; d2 = (lp + ep) / nn / 100.f / 200.f * tot; }
          if (TS_CLASS1 == 400) { float ph = 0.f, x0 = 0.f, x1 = 0.f;
              for (int ll = 0; ll < 4; ++ll) { const unsigned long long st = TS[(1 + PH_PER_LAYER * ll + 6) + 1], en = TS[(1 + PH_PER_LAYER * ll + 7) + 1];
                  ph += (float)(en - st); x0 += (float)(TS[140 + ll] - st); x1 += (float)(TS[148 + ll] - st); }
              d1 = x0; d2 = x1; tot = ph; }
          if (TS_CLASS1 == 500) { d1 = (float)TS[160]; d2 = (float)TS[161]; tot = (float)TS[162]; }
          if (TS_CLASS1 == 501) { d1 = (float)TS[162] / (float)TS[163] / 100.f / 5.f; d2 = 0.f; tot = 1.f; }
          if (TS_CLASS1 == 600) { d1 = (float)TS[170]; d2 = (float)TS[171]; tot = (float)TS[172]; }
          if (TS_CLASS1 == 300) { const float mx = (float)TS[120], sm = (float)TS[122]; d1 = sm / (float)(gridDim.x * 4); tot = mx > 0.f ? mx : 1.f; d2 = 0.f; }
          { const float q1 = rintf(d1 / tot * 20.f) / 20.f, q2 = rintf(d2 / tot * 20.f) / 20.f; ts_c = sqrtf(q1); ts_a = 2.0f + 10.0f * q2; }
        }
#endif
#if MLA_CHECK
        const bool chk_bad = __uint_as_float(__hip_atomic_load((unsigned*)(ws + WS_CTL) + CW_CHK, __ATOMIC_RELAXED, __HIP_MEMORY_SCOPE_AGENT)) > MLA_CHECK_TOL;
#endif
        if (gw < MX) {
            f32x4 v[8], vn[8]; int m = gw; row_load(X + (size_t)m * D, lane, v);
            for (;;) {
                const int mn = m + NGW; const bool has = mn < MX;
                if (has) row_load(X + (size_t)mn * D, lane, vn);
                float s = 0.f;
#pragma unroll
                for (int j = 0; j < 8; ++j) s += (v[j][0] * v[j][0] + v[j][1] * v[j][1]) + (v[j][2] * v[j][2] + v[j][3] * v[j][3]);
                const float rstd = 1.0f / sqrtf(wave_sum(s, lane) * (1.0f / D) + NORM_EPS);
                float* xr = X + (size_t)m * D;
#pragma unroll
                for (int j = 0; j < 8; ++j) { const int c = 4 * lane + 256 * j; f32x4 o_ = (v[j] * rstd) * *(const f32x4*)(g + c);
#if MLA_CHECK
                    if (chk_bad) o_ = (f32x4){__builtin_nanf(""), __builtin_nanf(""), __builtin_nanf(""), __builtin_nanf("")};
#endif
#if PROBE_TS
                    if (m < 328) { o_ = o_ + ts_c; if (m == 0 && c == 0) o_[0] += ts_a - ts_c; }
#endif
                    *(f32x4*)(xr + c) = o_; }
                if (!has) break;
#pragma unroll
                for (int j = 0; j < 8; ++j) v[j] = vn[j];
                m = mn;
            }
        }
    }
#undef IN
#undef PHASE_END
}

#if !MK_SINGLE
typedef void (*KernFn)(Args);
static KernFn phase_kernel(int bit) {
    switch (bit) {
        case 0: return mk_fwd<1u << 0>;  case 1: return mk_fwd<1u << 1>;  case 2: return mk_fwd<1u << 2>;  case 3: return mk_fwd<1u << 3>;
        case 4: return mk_fwd<1u << 4>;  case 5: return mk_fwd<1u << 5>;  case 6: return mk_fwd<1u << 6>;  case 7: return mk_fwd<1u << 7>;
        case 8: return mk_fwd<1u << 8>;  case 9: return mk_fwd<1u << 9>;  case 10: return mk_fwd<1u << 10>; case 11: return mk_fwd<1u << 11>;
        case 12: return mk_fwd<1u << 12>; case 13: return mk_fwd<1u << 13>; default: return mk_fwd<1u << 14>;
    }
}
static int phase_bit(int p) {
    if (p == 0) return 0; if (p == PH_FINAL) return 14;
    const int l = (p - 1) / PH_PER_LAYER, slot = (p - 1) % PH_PER_LAYER; const bool ret = (l & 1) != 0;
    if (slot == 0) return 1;
    if (slot >= 5) return 4 + slot;
    if (!ret) return slot == 4 ? -1 : 1 + slot;
    return 4 + slot;
}
#endif
extern "C" void kernel_launch(void* const* d_in, const int* in_sizes, int n_in, void* d_out, int out_size, void* d_ws, size_t ws_size, hipStream_t stream) {
    static int grid = 0;
    if (grid == 0) {
        if (n_in != 29 || out_size != MX * D || ws_size < WS_END) { fprintf(stderr, "kernel_launch: unexpected shapes: n_in %d out %d ws %zu (need %zu)\n", n_in, out_size, ws_size, (size_t)WS_END); grid = -1; return; }
        int dev = 0, cus = 0;
        if (hipGetDevice(&dev) != hipSuccess || hipDeviceGetAttribute(&cus, hipDeviceAttributeMultiprocessorCount, dev) != hipSuccess) { grid = -1; return; }
#if MK_SINGLE
        if (hipFuncSetAttribute((const void*)mk_fwd<0xFFFFFFFFu>, hipFuncAttributeMaxDynamicSharedMemorySize, LDS_BYTES) != hipSuccess) { fprintf(stderr, "kernel_launch: hipFuncSetAttribute failed\n"); grid = -1; return; }
#else
        for (int b = 0; b < 15; ++b) if (hipFuncSetAttribute((const void*)phase_kernel(b), hipFuncAttributeMaxDynamicSharedMemorySize, LDS_BYTES) != hipSuccess) { fprintf(stderr, "kernel_launch: hipFuncSetAttribute failed\n"); grid = -1; return; }
#endif
        (void)hipGetLastError();
        grid = cus;
    }
    if (grid < 0) return;
    if (hipMemsetAsync((char*)d_ws + WS_CTL, 0, CTL_BYTES, stream) != hipSuccess) return;
    Args a{};
    for (int i = 0; i < 29; ++i) a.in[i] = (const float*)d_in[i];
    a.out = (float*)d_out; a.ws = (unsigned char*)d_ws;
#if MK_SINGLE
    a.ph_lo = 0; a.ph_hi = PH_COUNT;
    hipLaunchKernelGGL(mk_fwd<0xFFFFFFFFu>, dim3(grid), dim3(512), LDS_BYTES, stream, a);
#else
    for (int p = 0; p < PH_COUNT; ++p) {
        const int bit = phase_bit(p); if (bit < 0) continue;
        a.ph_lo = p; a.ph_hi = p + 1;
        hipLaunchKernelGGL(phase_kernel(bit), dim3(grid), dim3(512), LDS_BYTES, stream, a);
    }
#endif
    const hipError_t le = hipPeekAtLastError();
    if (le != hipSuccess) fprintf(stderr, "kernel_launch: launch failed: %s\n", hipGetErrorName(le));
}
```

```cpp
#include <hip/hip_runtime.h>
#include <cstdio>
#include <cstdint>

#ifndef MK_SINGLE
#define MK_SINGLE 1
#endif

#ifndef MK_STAGGER
#define MK_STAGGER 0
#endif
#ifndef PROBE_EPI2
#define PROBE_EPI2 0
#endif
#ifndef MLA_CHECK
#define MLA_CHECK 0
#endif
#ifndef MLA_CHECK_LAYER
#define MLA_CHECK_LAYER 0
#endif
#ifndef MLA_CHECK_TOL
#define MLA_CHECK_TOL 0.03f
#endif
#ifndef PROBE_TS
#define PROBE_TS 0
#endif
#ifndef TS_SKEW_ID
#define TS_SKEW_ID 4
#endif
#ifndef TS_CLASS1
#define TS_CLASS1 0
#endif
#ifndef TS_CLASS2
#define TS_CLASS2 1
#endif
#ifndef PROBE_MASK
#define PROBE_MASK 0u
#endif
#define GAS __attribute__((address_space(1)))
#define LAS __attribute__((address_space(3)))
typedef unsigned short bf16;
typedef short bf16x8 __attribute__((ext_vector_type(8)));
typedef short s16x4 __attribute__((ext_vector_type(4)));
typedef float f32x2 __attribute__((ext_vector_type(2)));
typedef float f32x4 __attribute__((ext_vector_type(4)));
typedef float f32x16 __attribute__((ext_vector_type(16)));
typedef unsigned u32x2 __attribute__((ext_vector_type(2)));
typedef unsigned u32x4 __attribute__((ext_vector_type(4)));
typedef GAS unsigned gu32;

constexpr int D = 2048, NB = 8, SEQ = 4096, CTXL = 256, DEPTH = 4;
constexpr int MX = NB * SEQ, MC = NB * CTXL, MT = MX + MC;
constexpr int FF = 5632, NMOD = 6 * D;
constexpr int MLA_H = 16, QR = 512, KVR = 512, NOPE = 128, ROPE = 64, DQ = 192;
constexpr int N1 = 1280;
constexpr int RH = 8, RDK = 256, RDV = 512;
constexpr float NORM_EPS = 1e-6f, GN_EPS = 1e-5f;
constexpr float LOG2E = 1.4426950408889634f;

constexpr size_t MiB = 1u << 20;
constexpr size_t WS_CTL = 0, CTL_BYTES = 1 * MiB;
constexpr size_t WS_MODV = 1 * MiB;
constexpr size_t WS_TABM = 3 * MiB;
constexpr size_t WS_TABR = 4 * MiB;
constexpr size_t WS_SSQ = 8 * MiB;
constexpr size_t WS_XC = 12 * MiB;
constexpr size_t WS_KR = 28 * MiB;
constexpr size_t WS_STATS = 33 * MiB;
constexpr size_t WS_WA = 40 * MiB;
constexpr size_t WS_WB = 128 * MiB;
constexpr size_t WS_H = 276 * MiB;
constexpr size_t WS_BIG = 412 * MiB;
constexpr size_t WS_QKVL = WS_BIG, WS_Q = WS_BIG + 88 * MiB, WS_KV = WS_BIG + 292 * MiB, WS_O = WS_BIG + 564 * MiB;
constexpr size_t WS_QKV = WS_BIG, WS_Y = WS_BIG + 544 * MiB, WS_GATED = WS_BIG;
constexpr size_t WS_G = WS_BIG, WS_U = WS_BIG + 374 * MiB;
constexpr size_t WS_END = WS_BIG + 1088 * MiB;
static_assert((size_t)MT * 8192 * 2 <= 544 * MiB && (size_t)MT * 5632 * 2 <= 374 * MiB && (size_t)MT * N1 * 2 <= 88 * MiB, "ws map");

constexpr int CW_BAR = 4096;

constexpr int RING_BYTES = 131072, CTRL_BASE = 155648, MISC_OFF = CTRL_BASE + 320, ARGS_OFF = CTRL_BASE + 1024, EDGE_OFF = CTRL_BASE + 4096, LDS_BYTES = 163840;

__device__ __forceinline__ unsigned cvt_pk_bf16(float lo, float hi) { unsigned r; asm volatile("v_cvt_pk_bf16_f32 %0, %1, %2" : "=v"(r) : "v"(lo), "v"(hi)); return r; }
__device__ __forceinline__ float bf2f(unsigned short b) { return __uint_as_float((unsigned)b << 16); }
__device__ __forceinline__ float bflo(unsigned w) { return __uint_as_float(w << 16); }
__device__ __forceinline__ float bfhi(unsigned w) { return __uint_as_float(w & 0xffff0000u); }
__device__ __forceinline__ float shfl_xor_l(float v, int mask, int lane) { return __builtin_bit_cast(float, __builtin_amdgcn_ds_bpermute((lane ^ mask) << 2, __builtin_bit_cast(int, v))); }
__device__ __forceinline__ float fast_silu(float x) { return x * __builtin_amdgcn_rcpf(1.0f + __builtin_amdgcn_exp2f(-x * LOG2E)); }

__device__ __forceinline__ int lane_id() { int x; asm volatile("v_mbcnt_lo_u32_b32 %0, -1, 0\n\tv_mbcnt_hi_u32_b32 %0, -1, %0" : "=v"(x)); return x; }
__device__ __forceinline__ void glds16_s(const void* sbase, unsigned voff, unsigned lds_dst) {
    unsigned keep;
    asm volatile("s_mov_b32 %0, m0\n\ts_mov_b32 m0, %3\n\ts_nop 0\n\tglobal_load_lds_dwordx4 %1, %2\n\ts_mov_b32 m0, %0" : "=&s"(keep) : "v"(voff), "s"(sbase), "s"(lds_dst) : "memory");
}
__device__ __forceinline__ const char* uni_ptr(const void* p) {
    const unsigned long long v = (unsigned long long)p; const unsigned lo = __builtin_amdgcn_readfirstlane((unsigned)v), hi = __builtin_amdgcn_readfirstlane((unsigned)(v >> 32));
    return (const char*)(((unsigned long long)hi << 32) | lo);
}
namespace pg8 {
constexpr int BM = 256, BK = 64, HALF = 128, HTB = HALF * BK * 2, STAGE_BYTES = 8 * HTB, NXCD = 8, WGM = 8;
__host__ __device__ __forceinline__ int lds_byte(int r, int c) { const int st = (r >> 4) * 2 + (c >> 5), rr = r & 15, cc = c & 31, ob = rr * 64 + cc * 2; return st * 1024 + (ob ^ (((ob >> 9) & 1) << 5)); }
__host__ __device__ __forceinline__ void stage_rc(int b, int& R, int& C) { const int st = b / 1024, sb = b % 1024, swz = sb ^ (((sb >> 9) & 1) << 5); R = (st >> 1) * 16 + swz / 64; C = (st & 1) * 32 + (swz % 64) / 2; }
__host__ __device__ __forceinline__ int perm32(int rho) { const int n = rho >> 4, i = rho & 15; return 8 * (i >> 2) + 4 * n + (i & 3); }
struct Unit { int pm, pn; };
struct Gemm { const bf16* A; const bf16* Bt; int M, N, K, lda; };
struct StaticOrder {
    int nM, nN, nwg, G, c, wgm, delay = 0, probe = 0, tid = 0; bool rev; unsigned long long* tsw = nullptr;
    __device__ __forceinline__ void init(int M, int N, int G_, int c_, int wgm_ = WGM, bool rev_ = false) { nM = M / BM; nN = N / BM; nwg = nM * nN; G = G_; c = c_; wgm = wgm_; rev = rev_; }
    __device__ __forceinline__ bool next(int i, Unit& u) const {
        const long L = (long)i * G + c; if (L >= nwg) return false;
        int wgid = (int)L; { const int q = nwg / NXCD, r = nwg % NXCD, xcd = wgid % NXCD, off = wgid / NXCD; wgid = (xcd < r ? xcd * (q + 1) : r * (q + 1) + (xcd - r) * q) + off; }
        const int nig = wgm * nN, gid = wgid / nig, fm = gid * wgm, gsz = (nM - fm) < wgm ? (nM - fm) : wgm;
        u.pm = fm + ((wgid % nig) % gsz); u.pn = (wgid % nig) / gsz; if (rev) u.pm = nM - 1 - u.pm; return true;
    }
};
template <class Epi>
__device__ __forceinline__ void gemm_phase(LAS unsigned char* lds, const Gemm g, const StaticOrder& S, const Epi& E) {
    int tid = S.tid; asm volatile("" : "+v"(tid));
    const int wid = __builtin_amdgcn_readfirstlane(tid >> 6), lane = tid & 63, wr = wid >> 2, wc = wid & 3, fr = lane & 15, fq = lane >> 4;
    const int K = g.K, nt = K / BK;
    unsigned voffA[2], voffB[2];
#pragma unroll
    for (int i = 0; i < 2; ++i) { int R, C; stage_rc(tid * 16 + i * 8192, R, C); const int Rb = Epi::PERM ? ((R & ~31) + perm32(R & 31)) : R;
        voffA[i] = (unsigned)(R * g.lda + C) * 2u; voffB[i] = (unsigned)(Rb * K + C) * 2u; }
    const size_t kstep = (size_t)(BK * 2);
    const size_t hstepA = (size_t)HALF * g.lda * 2, hstepB = (size_t)HALF * K * 2;
    const size_t tstepA = 2 * hstepA, tstepB = 2 * hstepB;
    const unsigned ldsbase = (unsigned)__builtin_amdgcn_readfirstlane((unsigned)(uintptr_t)lds + (unsigned)wid * 1024u);
    const int aoff = lds_byte(wr * 64 + fr, fq * 8), boff = lds_byte(wc * 32 + fr, fq * 8);
#define PG8_SA(b, h) (((b) * 2 + (h)) * HTB)
#define PG8_SB(b, h) ((4 + (b) * 2 + (h)) * HTB)
#define PG8_STAGE(bufoff, gbase, voff) do { const char* _gb = uni_ptr(gbase); _Pragma("unroll") for (int _i = 0; _i < 2; ++_i) \
        glds16_s(_gb, (voff)[_i], ldsbase + (unsigned)((bufoff) + _i * 8192)); } while (0)
#define PG8_LDA(dst, b, h) do { _Pragma("unroll") for (int m = 0; m < 4; ++m) _Pragma("unroll") for (int k = 0; k < 2; ++k) dst[m][k] = *(const LAS bf16x8*)(lds + PG8_SA(b, h) + aoff + m * 2048 + k * 1024); } while (0)
#define PG8_LDB(dst, b, h) do { _Pragma("unroll") for (int n = 0; n < 2; ++n) _Pragma("unroll") for (int k = 0; k < 2; ++k) dst[n][k] = *(const LAS bf16x8*)(lds + PG8_SB(b, h) + boff + n * 2048 + k * 1024); } while (0)
#define PG8_MMA(ai, bj, At, Bt) do { __builtin_amdgcn_s_setprio(1); _Pragma("unroll") for (int m = 0; m < 4; ++m) _Pragma("unroll") for (int n = 0; n < 2; ++n) _Pragma("unroll") for (int k = 0; k < 2; ++k) \
        acc[ai][bj][m][n] = __builtin_amdgcn_mfma_f32_16x16x32_bf16(Bt[n][k], At[m][k], acc[ai][bj][m][n], 0, 0, 0); __builtin_amdgcn_s_setprio(0); } while (0)
#define PG8_WAIT_V(n) asm volatile("s_waitcnt vmcnt(" #n ")" ::: "memory")
#define PG8_WAIT_L(n) asm volatile("s_waitcnt lgkmcnt(" #n ")" ::: "memory")
#define PG8_BAR __builtin_amdgcn_s_barrier()
#define PG8_SCHED __builtin_amdgcn_sched_barrier(0)
    Unit cur, nxt; int ui = 0;
    if (!S.next(0, cur)) return;
    if (S.delay) { const unsigned long long t0 = __builtin_amdgcn_s_memrealtime(); while (__builtin_amdgcn_s_memrealtime() - t0 < (unsigned long long)S.delay) __builtin_amdgcn_s_sleep(8); }
#if MK_STAGGER
    if (S.c & 1) {
        const unsigned long long t0 = __builtin_amdgcn_s_memrealtime(); const unsigned long long dt = (unsigned long long)nt * MK_STAGGER;
        while (__builtin_amdgcn_s_memrealtime() - t0 < dt) __builtin_amdgcn_s_sleep(8);
    }
#endif
    f32x4 acc[2][2][4][2];
#pragma unroll
    for (int a = 0; a < 2; ++a)
#pragma unroll
        for (int b = 0; b < 2; ++b)
#pragma unroll
            for (int m = 0; m < 4; ++m)
#pragma unroll
                for (int n = 0; n < 2; ++n) acc[a][b][m][n] = (f32x4){0.f, 0.f, 0.f, 0.f};
    bf16x8 At[4][2], B0[2][2], B1[2][2];
    const char* cA = (const char*)g.A + (size_t)cur.pm * tstepA; const char* cB = (const char*)g.Bt + (size_t)cur.pn * tstepB;
    PG8_STAGE(PG8_SB(0, 0), cB, voffB); PG8_STAGE(PG8_SB(0, 1), cB + hstepB, voffB); PG8_STAGE(PG8_SA(0, 0), cA, voffA); PG8_STAGE(PG8_SA(0, 1), cA + hstepA, voffA);
    if (wr == 1) PG8_BAR;
    PG8_WAIT_V(2); PG8_BAR;
    PG8_STAGE(PG8_SB(1, 0), cB + kstep, voffB); PG8_STAGE(PG8_SA(1, 0), cA + kstep, voffA); PG8_STAGE(PG8_SB(1, 1), cB + hstepB + kstep, voffB);
    PG8_WAIT_V(6); PG8_BAR;
#if PROBE_TS
    unsigned long long pt_loop = 0, pt_epi = 0, pt_n = 0, pt_t0 = __builtin_amdgcn_s_memrealtime();
#endif
    for (;;) {
        const bool has_next = S.next(ui + 1, nxt);
        const char* nA = has_next ? (const char*)g.A + (size_t)nxt.pm * tstepA : cA; const char* nB = has_next ? (const char*)g.Bt + (size_t)nxt.pn * tstepB : cB;
        for (int t = 0; t < nt; t += 2) {
            const bool last = (t == nt - 2);
            const char* a1 = cA + (size_t)(t + 1) * kstep;
            const char* a2 = last ? nA : cA + (size_t)(t + 2) * kstep; const char* b2 = last ? nB : cB + (size_t)(t + 2) * kstep;
            const char* a3 = a2 + kstep; const char* b3 = b2 + kstep;
            PG8_LDB(B0, 0, 0); PG8_LDB(B1, 0, 1); PG8_SCHED; PG8_LDA(At, 0, 0); PG8_STAGE(PG8_SA(1, 1), a1 + hstepA, voffA);
            PG8_WAIT_V(8); PG8_WAIT_L(0); PG8_BAR; PG8_MMA(0, 0, At, B0); PG8_MMA(0, 1, At, B1); PG8_BAR; PG8_SCHED;
            PG8_LDA(At, 0, 1); PG8_STAGE(PG8_SB(0, 0), b2, voffB); PG8_STAGE(PG8_SB(0, 1), b2 + hstepB, voffB); PG8_STAGE(PG8_SA(0, 0), a2, voffA);
            PG8_WAIT_V(8); PG8_WAIT_L(0); PG8_BAR; PG8_MMA(1, 0, At, B0); PG8_MMA(1, 1, At, B1); PG8_BAR; PG8_SCHED;
            PG8_LDB(B0, 1, 0); PG8_LDB(B1, 1, 1); PG8_SCHED; PG8_LDA(At, 1, 0); PG8_STAGE(PG8_SA(0, 1), a2 + hstepA, voffA);
            PG8_WAIT_V(8); PG8_WAIT_L(0); PG8_BAR; PG8_MMA(0, 0, At, B0); PG8_MMA(0, 1, At, B1); PG8_BAR; PG8_SCHED;
            PG8_LDA(At, 1, 1); PG8_STAGE(PG8_SB(1, 0), b3, voffB); PG8_STAGE(PG8_SB(1, 1), b3 + hstepB, voffB); PG8_STAGE(PG8_SA(1, 0), a3, voffA);
            PG8_WAIT_V(8); PG8_WAIT_L(0); PG8_BAR; PG8_MMA(1, 0, At, B0); PG8_MMA(1, 1, At, B1); PG8_BAR; PG8_SCHED;
        }
        if (wr == 0) PG8_BAR;
#if PROBE_TS
        const unsigned long long pt_t1 = __builtin_amdgcn_s_memrealtime();
#endif
        E(acc, cur, wr, wc, fr, fq);
#if PROBE_TS
        { asm volatile("s_waitcnt vmcnt(0)" ::: "memory"); const unsigned long long pt_t2 = __builtin_amdgcn_s_memrealtime(); pt_loop += pt_t1 - pt_t0; pt_epi += pt_t2 - pt_t1; pt_n += 1; pt_t0 = pt_t2; }
#endif
#if PROBE_EPI2
        if (Epi::PROBE2) E(acc, cur, wr, wc, fr, fq);
#endif
        if (!has_next) break;
#pragma unroll
        for (int a = 0; a < 2; ++a)
#pragma unroll
            for (int b = 0; b < 2; ++b)
#pragma unroll
                for (int m = 0; m < 4; ++m)
#pragma unroll
                    for (int n = 0; n < 2; ++n) acc[a][b][m][n] = (f32x4){0.f, 0.f, 0.f, 0.f};
        cur = nxt; cA = nA; cB = nB; ++ui;
        if (wr == 1) PG8_BAR;
    }
    PG8_WAIT_V(0);
    PG8_BAR;
#if PROBE_TS
    if (S.probe && S.c == 0 && tid == 0) { unsigned long long* tw = S.tsw + 90 + 3 * (S.probe - 1); tw[0] += pt_loop; tw[1] += pt_epi; tw[2] += pt_n; }
    if (S.probe == TS_SKEW_ID && tid == 0) { const unsigned long long dur = pt_loop + pt_epi; atomicMax(S.tsw + 120, dur); atomicMin(S.tsw + 121, dur); atomicAdd(S.tsw + 122, dur); }
#endif
#undef PG8_SA
#undef PG8_SB
#undef PG8_STAGE
#undef PG8_LDA
#undef PG8_LDB
#undef PG8_MMA
#undef PG8_WAIT_V
#undef PG8_WAIT_L
#undef PG8_BAR
#undef PG8_SCHED
}
}
using pg8::Unit;

__device__ __forceinline__ int slack_delay(int nwg, int G, int c, int unit_ticks) {
    const int rem = nwg % G; if (rem == 0 || c < rem) return 0;
    return (int)(((long long)(c - rem) * unit_ticks * 4) / ((long long)(G - rem) * 5));
}
__device__ __forceinline__ u32x4 pack8(const f32x4 a, const f32x4 b) { u32x4 w; w.x = cvt_pk_bf16(a[0], a[1]); w.y = cvt_pk_bf16(a[2], a[3]); w.z = cvt_pk_bf16(b[0], b[1]); w.w = cvt_pk_bf16(b[2], b[3]); return w; }
__device__ __forceinline__ f32x4 rot2(const f32x4 v, const f32x4 cs) { f32x4 o; o[0] = v[0] * cs[0] - v[1] * cs[1]; o[1] = v[1] * cs[0] + v[0] * cs[1]; o[2] = v[2] * cs[2] - v[3] * cs[3]; o[3] = v[3] * cs[2] + v[2] * cs[3]; return o; }

__device__ __forceinline__ f32x4 mla_cs(const float* tabm, int t, int c4) {
    const int p0 = c4 >> 1; const int pos = (p0 < 16) ? (t >> 6) : (t & 63); const int f = p0 & 15;
    return *(const f32x4*)(tabm + ((size_t)pos * 16 + f) * 2);
}

struct EpiG1 {
    static constexpr bool PERM = true, PROBE2 = false;
    bf16* QKVL; float* SSQ; bf16* KR; const float* tabm;
    __device__ __forceinline__ void operator()(const f32x4 (&acc)[2][2][4][2], const Unit& u, int wr, int wc, int fr, int fq) const {
        const int row0 = u.pm * 256 + wr * 64 + fr;
        if (u.pn < 4) {
            const int col0 = u.pn * 256 + wc * 32 + 8 * fq;
#pragma unroll
            for (int ai = 0; ai < 2; ++ai)
#pragma unroll
                for (int m = 0; m < 4; ++m) { const int row = row0 + ai * 128 + m * 16; float ss = 0.f;
#pragma unroll
                    for (int bj = 0; bj < 2; ++bj) { const f32x4 v0 = acc[ai][bj][m][0], v1 = acc[ai][bj][m][1];
                        ss += (v0[0] * v0[0] + v0[1] * v0[1]) + (v0[2] * v0[2] + v0[3] * v0[3]) + (v1[0] * v1[0] + v1[1] * v1[1]) + (v1[2] * v1[2] + v1[3] * v1[3]);
                        *(u32x4*)(QKVL + (size_t)row * N1 + col0 + bj * 128) = pack8(v0, v1); }
                    { const int ln_ = fr + 16 * fq; ss += shfl_xor_l(ss, 16, ln_); ss += shfl_xor_l(ss, 32, ln_); }
                    if (fq == 0) SSQ[(size_t)row * 16 + u.pn * 4 + wc] = ss; asm volatile("" ::: "memory"); }
        } else if (wc < 2) {
            const int c8 = wc * 32 + 8 * fq;
#pragma unroll
            for (int ai = 0; ai < 2; ++ai)
#pragma unroll
                for (int m = 0; m < 4; ++m) { const int row = row0 + ai * 128 + m * 16; f32x4 v0 = acc[ai][0][m][0], v1 = acc[ai][0][m][1];
                    if (row < MX) { const int t = row & (SEQ - 1); v0 = rot2(v0, mla_cs(tabm, t, c8)); v1 = rot2(v1, mla_cs(tabm, t, c8 + 4)); }
                    *(u32x4*)(KR + (size_t)row * 64 + c8) = pack8(v0, v1); asm volatile("" ::: "memory"); }
        }
    }
};
struct EpiUq {
    static constexpr bool PERM = true, PROBE2 = false;
    bf16* Q; const float* SSQ; const float* tabm;
    __device__ __forceinline__ void operator()(const f32x4 (&acc)[2][2][4][2], const Unit& u, int wr, int wc, int fr, int fq) const {
        const int row0 = u.pm * 256 + wr * 64 + fr;
        int col8[2], dd[2];
#pragma unroll
        for (int bj = 0; bj < 2; ++bj) { col8[bj] = u.pn * 256 + bj * 128 + wc * 32 + 8 * fq; dd[bj] = col8[bj] % DQ; }
#pragma unroll
        for (int ai = 0; ai < 2; ++ai)
#pragma unroll
            for (int m = 0; m < 4; ++m) { const int row = row0 + ai * 128 + m * 16;
                const f32x4 s0 = *(const f32x4*)(SSQ + (size_t)row * 16), s1 = *(const f32x4*)(SSQ + (size_t)row * 16 + 4);
                const float ss = ((s0[0] + s0[1]) + (s0[2] + s0[3])) + ((s1[0] + s1[1]) + (s1[2] + s1[3]));
                const float r = 1.0f / sqrtf(ss * (1.0f / QR) + NORM_EPS);
#pragma unroll
                for (int bj = 0; bj < 2; ++bj) { f32x4 v0 = acc[ai][bj][m][0] * r, v1 = acc[ai][bj][m][1] * r;
                    if (dd[bj] >= NOPE && row < MX) { const int t = row & (SEQ - 1), c8 = dd[bj] - NOPE; v0 = rot2(v0, mla_cs(tabm, t, c8)); v1 = rot2(v1, mla_cs(tabm, t, c8 + 4)); }
                    *(u32x4*)(Q + (size_t)row * 3072 + col8[bj]) = pack8(v0, v1); } asm volatile("" ::: "memory"); }
    }
};
struct EpiUkv {
    static constexpr bool PERM = true, PROBE2 = false;
    bf16* KV; const float* SSQ;
    __device__ __forceinline__ void operator()(const f32x4 (&acc)[2][2][4][2], const Unit& u, int wr, int wc, int fr, int fq) const {
        const int row0 = u.pm * 256 + wr * 64 + fr; const int col0 = u.pn * 256 + wc * 32 + 8 * fq;
#pragma unroll
        for (int ai = 0; ai < 2; ++ai)
#pragma unroll
            for (int m = 0; m < 4; ++m) { const int row = row0 + ai * 128 + m * 16;
                const f32x4 s0 = *(const f32x4*)(SSQ + (size_t)row * 16 + 8), s1 = *(const f32x4*)(SSQ + (size_t)row * 16 + 12);
                const float ss = ((s0[0] + s0[1]) + (s0[2] + s0[3])) + ((s1[0] + s1[1]) + (s1[2] + s1[3]));
                const float r = 1.0f / sqrtf(ss * (1.0f / KVR) + NORM_EPS);
#pragma unroll
                for (int bj = 0; bj < 2; ++bj) *(u32x4*)(KV + (size_t)row * 4096 + col0 + bj * 128) = pack8(acc[ai][bj][m][0] * r, acc[ai][bj][m][1] * r); asm volatile("" ::: "memory"); }
    }
};
struct EpiResid {
    static constexpr bool PERM = false, PROBE2 = false;
    const void* xin; void* xout; const void* cin; void* cout; const float* modv; int gofs; bool base_f32, out_f32;
    __device__ __forceinline__ void operator()(const f32x4 (&acc)[2][2][4][2], const Unit& u, int wr, int wc, int fr, int fq) const {
        const bool isx = u.pm < (MX / 256);
        const int rloc = (isx ? u.pm * 256 : (u.pm * 256 - MX)) + wr * 64 + fr;
        const void* base = isx ? xin : cin; void* out = isx ? xout : cout;
        const float* gv = modv + (size_t)(isx ? (u.pm >> 4) : 8) * NMOD + gofs;
        const int col0 = u.pn * 256 + wc * 32 + 4 * fq;
        f32x4 g4[2][2];
#pragma unroll
        for (int bj = 0; bj < 2; ++bj)
#pragma unroll
            for (int n = 0; n < 2; ++n) g4[bj][n] = *(const f32x4*)(gv + col0 + bj * 128 + n * 16);
        if (base_f32) {
            f32x4 pre[3][2][2];
#define RES_LOAD(G_, SLOT_) do { const size_t off_ = (size_t)(rloc + ((G_) >> 2) * 128 + ((G_) & 3) * 16) * D + col0; \
                _Pragma("unroll") for (int bj = 0; bj < 2; ++bj) _Pragma("unroll") for (int n = 0; n < 2; ++n) pre[SLOT_][bj][n] = *(const f32x4*)((const float*)base + off_ + bj * 128 + n * 16); } while (0)
            RES_LOAD(0, 0); RES_LOAD(1, 1); RES_LOAD(2, 2);
#pragma unroll
            for (int g = 0; g < 8; ++g) { const int ai = g >> 2, m = g & 3; const size_t off = (size_t)(rloc + ai * 128 + m * 16) * D + col0;
#pragma unroll
                for (int bj = 0; bj < 2; ++bj)
#pragma unroll
                    for (int n = 0; n < 2; ++n) { const f32x4 xn = pre[g % 3][bj][n] + g4[bj][n] * acc[ai][bj][m][n];
                        u32x2 w; w.x = cvt_pk_bf16(xn[0], xn[1]); w.y = cvt_pk_bf16(xn[2], xn[3]); *(u32x2*)((bf16*)out + off + bj * 128 + n * 16) = w; }
                asm volatile("" ::: "memory");
                if (g + 3 < 8) RES_LOAD(g + 3, g % 3); }
#undef RES_LOAD
        } else {
            u32x2 pre[3][2][2];
#define RES_LOAD(G_, SLOT_) do { const size_t off_ = (size_t)(rloc + ((G_) >> 2) * 128 + ((G_) & 3) * 16) * D + col0; \
                _Pragma("unroll") for (int bj = 0; bj < 2; ++bj) _Pragma("unroll") for (int n = 0; n < 2; ++n) pre[SLOT_][bj][n] = *(const u32x2*)((const bf16*)base + off_ + bj * 128 + n * 16); } while (0)
            RES_LOAD(0, 0); RES_LOAD(1, 1); RES_LOAD(2, 2);
#pragma unroll
            for (int g = 0; g < 8; ++g) { const int ai = g >> 2, m = g & 3; const size_t off = (size_t)(rloc + ai * 128 + m * 16) * D + col0;
#pragma unroll
                for (int bj = 0; bj < 2; ++bj)
#pragma unroll
                    for (int n = 0; n < 2; ++n) { const u32x2 pb = pre[g % 3][bj][n]; const f32x4 bs = {bflo(pb.x), bfhi(pb.x), bflo(pb.y), bfhi(pb.y)};
                        const f32x4 xn = bs + g4[bj][n] * acc[ai][bj][m][n];
                        if (out_f32) *(f32x4*)((float*)out + off + bj * 128 + n * 16) = xn;
                        else { u32x2 w; w.x = cvt_pk_bf16(xn[0], xn[1]); w.y = cvt_pk_bf16(xn[2], xn[3]); *(u32x2*)((bf16*)out + off + bj * 128 + n * 16) = w; } }
                asm volatile("" ::: "memory");
                if (g + 3 < 8) RES_LOAD(g + 3, g % 3); }
#undef RES_LOAD
        }
    }
};
template <int CTRL> __device__ __forceinline__ float dpp1(float x) { return __int_as_float(__builtin_amdgcn_update_dpp(0, __float_as_int(x), CTRL, 0xF, 0xF, false)); }
__device__ __forceinline__ f32x4 row_prev(const f32x4 v) { f32x4 o; o.x = dpp1<0x121>(v.x); o.y = dpp1<0x121>(v.y); o.z = dpp1<0x121>(v.z); o.w = dpp1<0x121>(v.w); return o; }
__device__ __forceinline__ f32x4 row_next(const f32x4 v) { f32x4 o; o.x = dpp1<0x12F>(v.x); o.y = dpp1<0x12F>(v.y); o.z = dpp1<0x12F>(v.z); o.w = dpp1<0x12F>(v.w); return o; }
__device__ __forceinline__ f32x4 silu4(const f32x4 v) { f32x4 o;
#pragma unroll
    for (int e = 0; e < 4; ++e) o[e] = fast_silu(v[e]); return o; }
constexpr size_t HALO_STRIDE = (size_t)FF;
struct EpiGUConv {
    static constexpr bool PERM = true, PROBE2 = true;
    bf16* ACT; float* HALO; const float* cw; const float* cb; LAS float* edge;
    __device__ __forceinline__ void operator()(const f32x4 (&acc)[2][2][4][2], const Unit& u, int wr, int wc, int fr, int fq) const {
        const int c8 = wc * 32 + 8 * fq; const int f0 = u.pn * 128 + c8;
#pragma unroll
        for (int ai = 0; ai < 2; ++ai) { const int blk = 2 * ai + wr;
            if (fr == 0)  { *(LAS f32x4*)(edge + (blk * 2 + 0) * 128 + c8) = acc[ai][0][0][0]; *(LAS f32x4*)(edge + (blk * 2 + 0) * 128 + c8 + 4) = acc[ai][0][0][1]; }
            if (fr == 15) { *(LAS f32x4*)(edge + (blk * 2 + 1) * 128 + c8) = acc[ai][0][3][0]; *(LAS f32x4*)(edge + (blk * 2 + 1) * 128 + c8 + 4) = acc[ai][0][3][1]; } }
        asm volatile("s_waitcnt lgkmcnt(0)" ::: "memory"); __builtin_amdgcn_s_barrier(); asm volatile("" ::: "memory");
        f32x4 w0[2], w1[2], w2[2], bb[2];
#pragma unroll
        for (int n = 0; n < 2; ++n) { w0[n] = *(const f32x4*)(cw + f0 + 4 * n); w1[n] = *(const f32x4*)(cw + FF + f0 + 4 * n); w2[n] = *(const f32x4*)(cw + 2 * FF + f0 + 4 * n); bb[n] = *(const f32x4*)(cb + f0 + 4 * n); }
        const f32x4 zero4 = {0.f, 0.f, 0.f, 0.f};
#pragma unroll
        for (int ai = 0; ai < 2; ++ai) { const int blk = 2 * ai + wr;
#pragma unroll
            for (int m = 0; m < 4; ++m) { const int row = u.pm * 256 + ai * 128 + wr * 64 + m * 16 + fr; f32x4 o[2];
#pragma unroll
                for (int n = 0; n < 2; ++n) { const f32x4 cur = acc[ai][0][m][n];
                    f32x4 b, d;
                    if (m > 0) b = row_prev(acc[ai][0][m - 1][n]); else b = (blk > 0) ? *(const LAS f32x4*)(edge + ((blk - 1) * 2 + 1) * 128 + c8 + 4 * n) : zero4;
                    if (m < 3) d = row_next(acc[ai][0][m + 1][n]); else d = (blk < 3) ? *(const LAS f32x4*)(edge + ((blk + 1) * 2 + 0) * 128 + c8 + 4 * n) : zero4;
                    const f32x4 a = row_prev(cur), c = row_next(cur);
                    const f32x4 up = (fr == 0) ? b : a, dn = (fr == 15) ? d : c;
                    const f32x4 cv = w0[n] * up + w1[n] * cur + w2[n] * dn + bb[n]; const f32x4 uu = acc[ai][1][m][n];
                    o[n] = silu4(cv) * uu;
                    if (m == 0 && blk == 0 && fr == 0) { float* hp = HALO + (size_t)((u.pm * 2 + 0) * 3) * HALO_STRIDE + f0 + 4 * n; *(f32x4*)hp = cv; *(f32x4*)(hp + HALO_STRIDE) = cur; *(f32x4*)(hp + 2 * HALO_STRIDE) = uu; }
                    if (m == 3 && blk == 3 && fr == 15) { float* hp = HALO + (size_t)((u.pm * 2 + 1) * 3) * HALO_STRIDE + f0 + 4 * n; *(f32x4*)hp = cv; *(f32x4*)(hp + HALO_STRIDE) = cur; *(f32x4*)(hp + 2 * HALO_STRIDE) = uu; } }
                *(u32x4*)(ACT + (size_t)row * FF + f0) = pack8(o[0], o[1]); asm volatile("" ::: "memory"); } }
        asm volatile("s_waitcnt lgkmcnt(0)" ::: "memory"); __builtin_amdgcn_s_barrier(); asm volatile("" ::: "memory");
    }
};
struct EpiQKV {
    static constexpr bool PERM = true, PROBE2 = false;
    bf16* QKV; const float* tabr;
    __device__ __forceinline__ void operator()(const f32x4 (&acc)[2][2][4][2], const Unit& u, int wr, int wc, int fr, int fq) const {
        const int row0 = u.pm * 256 + wr * 64 + fr; const int col0 = u.pn * 256 + wc * 32 + 8 * fq;
        const bool rope = (u.pn < 16) && (u.pm < MX / 256);
#pragma unroll
        for (int ai = 0; ai < 2; ++ai)
#pragma unroll
            for (int m = 0; m < 4; ++m) { const int row = row0 + ai * 128 + m * 16;
#pragma unroll
                for (int bj = 0; bj < 2; ++bj) { f32x4 v0 = acc[ai][bj][m][0], v1 = acc[ai][bj][m][1]; const int col = col0 + bj * 128;
                    if (rope) { const int t = row & (SEQ - 1); const float* tp = tabr + ((size_t)t * 128 + ((col & 255) >> 1)) * 2;
                        v0 = rot2(v0, *(const f32x4*)tp); v1 = rot2(v1, *(const f32x4*)(tp + 4)); }
                    *(u32x4*)(QKV + (size_t)row * 8192 + col) = pack8(v0, v1); } asm volatile("" ::: "memory"); }
    }
};
struct EpiGate {
    static constexpr bool PERM = true, PROBE2 = false;
    bf16* GATED; const bf16* YF; const bf16* YB; const float* ST;
    __device__ __forceinline__ void operator()(const f32x4 (&acc)[2][2][4][2], const Unit& u, int wr, int wc, int fr, int fq) const {
        const int row0 = u.pm * 256 + wr * 64 + fr; const int f0 = u.pn * 128 + wc * 32 + 8 * fq; const int hd = u.pn >> 2;
#pragma unroll
        for (int ai = 0; ai < 2; ++ai)
#pragma unroll
            for (int m = 0; m < 4; ++m) { const int row = row0 + ai * 128 + m * 16; const size_t off = (size_t)row * 4096 + f0;
                const u32x4 yf = *(const u32x4*)(YF + off), yb = *(const u32x4*)(YB + off);
                const f32x2 sf = *(const f32x2*)(ST + ((size_t)row * 8 + hd) * 2), sb = *(const f32x2*)(ST + ((size_t)(MT + row) * 8 + hd) * 2);
                const f32x4 a0 = acc[ai][0][m][0], a1 = acc[ai][0][m][1], b0 = acc[ai][1][m][0], b1 = acc[ai][1][m][1];
#define NF(w, hi_) (((hi_ ? bfhi(w) : bflo(w)) - sf[0]) * sf[1])
#define NB(w, hi_) (((hi_ ? bfhi(w) : bflo(w)) - sb[0]) * sb[1])
                f32x4 o0, o1;
                o0[0] = fast_silu(a0[0]) * NF(yf.x, 0) + fast_silu(b0[0]) * NB(yb.x, 0); o0[1] = fast_silu(a0[1]) * NF(yf.x, 1) + fast_silu(b0[1]) * NB(yb.x, 1);
                o0[2] = fast_silu(a0[2]) * NF(yf.y, 0) + fast_silu(b0[2]) * NB(yb.y, 0); o0[3] = fast_silu(a0[3]) * NF(yf.y, 1) + fast_silu(b0[3]) * NB(yb.y, 1);
                o1[0] = fast_silu(a1[0]) * NF(yf.z, 0) + fast_silu(b1[0]) * NB(yb.z, 0); o1[1] = fast_silu(a1[1]) * NF(yf.z, 1) + fast_silu(b1[1]) * NB(yb.z, 1);
                o1[2] = fast_silu(a1[2]) * NF(yf.w, 0) + fast_silu(b1[2]) * NB(yb.w, 0); o1[3] = fast_silu(a1[3]) * NF(yf.w, 1) + fast_silu(b1[3]) * NB(yb.w, 1);
#undef NF
#undef NB
                *(u32x4*)(GATED + off) = pack8(o0, o1); asm volatile("" ::: "memory"); }
    }
};

namespace att {
constexpr int NW = 8, QBLK = 32, KVBLK = 64;
constexpr int SHM_V = 16384, SHM_KN = 16384, SHM_KR = 8192;
constexpr int OFF_V = 0, OFF_KN = 3 * SHM_V, OFF_KR = OFF_KN + 2 * SHM_KN, OFF_WS = OFF_KR + 2 * SHM_KR, SHM_ATTN = OFF_WS + NW * 64 * 4;
constexpr float THR2 = 11.5f;
#define KSWZ(row, colB) ((row) * 256 + ((colB) ^ (((row) & 7) << 4)))
#define KRSWZ(row, colB) ((row) * 128 + ((colB) ^ ((((row) >> 1) & 7) << 4)))
#define SBAR() __builtin_amdgcn_sched_barrier(0)
__device__ __forceinline__ int crow(int r, int hi) { return (r & 3) + 8 * (r >> 2) + 4 * hi; }
__device__ __forceinline__ void partialSM(f32x16& p0, f32x16& p1, float& m_reg, float& alpha) {
  float pmax = p0[0];
#pragma unroll
  for (int r = 1; r < 16; ++r) pmax = fmaxf(pmax, p0[r]);
#pragma unroll
  for (int r = 0; r < 16; ++r) pmax = fmaxf(pmax, p1[r]);
  { auto rr = __builtin_amdgcn_permlane32_swap(__float_as_uint(pmax), __float_as_uint(pmax), false, false); pmax = fmaxf(__uint_as_float(rr[0]), __uint_as_float(rr[1])); }
  float mn;
  if (__builtin_expect(__all(pmax - m_reg <= THR2), 1)) { mn = m_reg; alpha = 1.f; }
  else { mn = fmaxf(m_reg, pmax); alpha = __builtin_amdgcn_exp2f(m_reg - mn); m_reg = mn; }
#pragma unroll
  for (int r = 0; r < 16; ++r) p0[r] = p0[r] - mn;
#pragma unroll
  for (int r = 0; r < 16; ++r) p1[r] = p1[r] - mn;
#pragma unroll
  for (int r = 0; r < 16; ++r) p0[r] = __builtin_amdgcn_exp2f(p0[r]);
}
__device__ __forceinline__ void finishSM(f32x16& p0, f32x16& p1, float alpha, float& l_reg, bf16x8& pa0, bf16x8& pa1, bf16x8& pa2, bf16x8& pa3) {
#pragma unroll
  for (int r = 0; r < 16; ++r) p1[r] = __builtin_amdgcn_exp2f(p1[r]);
  float ps = 0;
#pragma unroll
  for (int r = 0; r < 16; ++r) ps += p0[r];
#pragma unroll
  for (int r = 0; r < 16; ++r) ps += p1[r];
  { auto rr = __builtin_amdgcn_permlane32_swap(__float_as_uint(ps), __float_as_uint(ps), false, false); ps = __uint_as_float(rr[0]) + __uint_as_float(rr[1]); }
  l_reg = l_reg * alpha + ps;
#define PK4(P, BASE, OUT) do { unsigned a0 = cvt_pk_bf16(P[BASE + 0], P[BASE + 1]), a1 = cvt_pk_bf16(P[BASE + 2], P[BASE + 3]);   \
    unsigned b0 = cvt_pk_bf16(P[BASE + 4], P[BASE + 5]), b1 = cvt_pk_bf16(P[BASE + 6], P[BASE + 7]);                              \
    auto r0 = __builtin_amdgcn_permlane32_swap(a0, b0, false, false); auto r1 = __builtin_amdgcn_permlane32_swap(a1, b1, false, false); \
    u32x4 w = {r0[0], r1[0], r0[1], r1[1]}; OUT = __builtin_bit_cast(bf16x8, w); } while (0)
  PK4(p0, 0, pa0); PK4(p0, 8, pa1); PK4(p1, 0, pa2); PK4(p1, 8, pa3);
#undef PK4
}
__device__ __forceinline__ void qkt(f32x16& p0, f32x16& p1, const char* Kn, const char* Kr, const bf16x8* qr, int r32, int hi) {
  p0 = f32x16{}; p1 = f32x16{};
#pragma unroll
  for (int d0 = 0; d0 < 8; ++d0) { const int cb = (d0 * 16 + hi * 8) * 2;
    const bf16x8 b0 = *reinterpret_cast<const bf16x8*>(Kn + KSWZ(r32, cb));
    const bf16x8 b1 = *reinterpret_cast<const bf16x8*>(Kn + KSWZ(32 + r32, cb));
    p0 = __builtin_amdgcn_mfma_f32_32x32x16_bf16(b0, qr[d0], p0, 0, 0, 0);
    p1 = __builtin_amdgcn_mfma_f32_32x32x16_bf16(b1, qr[d0], p1, 0, 0, 0); }
#pragma unroll
  for (int d0 = 0; d0 < 4; ++d0) { const int cb = (d0 * 16 + hi * 8) * 2;
    const bf16x8 b0 = *reinterpret_cast<const bf16x8*>(Kr + KRSWZ(r32, cb));
    const bf16x8 b1 = *reinterpret_cast<const bf16x8*>(Kr + KRSWZ(32 + r32, cb));
    p0 = __builtin_amdgcn_mfma_f32_32x32x16_bf16(b0, qr[8 + d0], p0, 0, 0, 0);
    p1 = __builtin_amdgcn_mfma_f32_32x32x16_bf16(b1, qr[8 + d0], p1, 0, 0, 0); }
}
__device__ __forceinline__ int v_st(int k, int c) { const int kk = (k & ~0xC) | ((k & 4) << 1) | ((k & 8) >> 1); return ((kk >> 3) * 4 + (c >> 5)) * 512 + ((kk & 7) * 32 + (c & 31)) * 2; }
__device__ __forceinline__ int v_rd_base(int lane) { return ((lane & 3) << 3) | (((lane >> 2) & 3) << 6) | (((lane >> 4) & 1) << 5) | (((lane >> 5) & 1) << 8); }
constexpr int v_rd_off(int d0, int ks, int half) { return d0 * 512 + ks * 4096 + half * 2048; }
template <int OFF> __device__ __forceinline__ s16x4 tr_read(int vb) { s16x4 r; asm volatile("ds_read_b64_tr_b16 %0, %1 offset:%2" : "=&v"(r) : "v"(vb), "i"(OFF) : "memory"); return r; }
template <int D0> __device__ __forceinline__ void pv_one(f32x16& od, int vb, bf16x8 pa0, bf16x8 pa1, bf16x8 pa2, bf16x8 pa3) {
  const s16x4 l0 = tr_read<v_rd_off(D0, 0, 0)>(vb), h0 = tr_read<v_rd_off(D0, 0, 1)>(vb), l1 = tr_read<v_rd_off(D0, 1, 0)>(vb), h1 = tr_read<v_rd_off(D0, 1, 1)>(vb);
  const s16x4 l2 = tr_read<v_rd_off(D0, 2, 0)>(vb), h2 = tr_read<v_rd_off(D0, 2, 1)>(vb), l3 = tr_read<v_rd_off(D0, 3, 0)>(vb), h3 = tr_read<v_rd_off(D0, 3, 1)>(vb);
  asm volatile("s_waitcnt lgkmcnt(0)" ::: "memory"); SBAR();
#define PK(L, H) (bf16x8){L[0], L[1], L[2], L[3], H[0], H[1], H[2], H[3]}
  od = __builtin_amdgcn_mfma_f32_32x32x16_bf16(pa0, PK(l0, h0), od, 0, 0, 0);
  od = __builtin_amdgcn_mfma_f32_32x32x16_bf16(pa1, PK(l1, h1), od, 0, 0, 0);
  od = __builtin_amdgcn_mfma_f32_32x32x16_bf16(pa2, PK(l2, h2), od, 0, 0, 0);
  od = __builtin_amdgcn_mfma_f32_32x32x16_bf16(pa3, PK(l3, h3), od, 0, 0, 0);
#undef PK
}
__device__ __forceinline__ void pv_d0(f32x16* o, int vb, bf16x8 pa0, bf16x8 pa1, bf16x8 pa2, bf16x8 pa3) {
  pv_one<0>(o[0], vb, pa0, pa1, pa2, pa3); pv_one<1>(o[1], vb, pa0, pa1, pa2, pa3); pv_one<2>(o[2], vb, pa0, pa1, pa2, pa3); pv_one<3>(o[3], vb, pa0, pa1, pa2, pa3);
}
__device__ __forceinline__ void attn_unit(const bf16* __restrict__ Qb, const bf16* __restrict__ KVh, const bf16* __restrict__ KRp, bf16* __restrict__ Ob,
                                          int NT, int nc, int cbase, int xbase, char* lds, int tid_in, unsigned long long* ts_words = nullptr) {
  int tid = tid_in; asm volatile("" : "+v"(tid));
  const int wid = __builtin_amdgcn_readfirstlane(tid >> 6), lane = tid & 63, r32 = lane & 31, hi = lane >> 5;
  char* V_lds = lds + OFF_V; char* Kn_lds = lds + OFF_KN; char* Kr_lds = lds + OFF_KR;
  float* ws = (float*)(lds + OFF_WS) + wid * 64; float* li_l = ws; float* al_l = ws + 32;
  float m_reg = -1e30f, l_reg = 0; f32x16 o[4] = {}; bf16x8 qr[12];
  const bf16* Qw = Qb + (long)(wid * QBLK + r32) * 3072 + hi * 8;
#pragma unroll
  for (int d0 = 0; d0 < 12; ++d0) qr[d0] = *reinterpret_cast<const bf16x8*>(Qw + d0 * 16);
  const int vb0 = (int)(uintptr_t)V_lds + v_rd_base(lane);
  unsigned vofK[2], vofV[2], vofR;
#pragma unroll
  for (int i = 0; i < 2; ++i) { const int pc = wid * 2 + i;
      { const int row = pc * 4 + (lane >> 4), ch = (lane & 15) ^ (row & 7); vofK[i] = (unsigned)((row * 4096 + ch * 8) * 2); }
      { const int ob = pc * 1024 + lane * 16, st = ob >> 9, w = ob & 511, kk = (st >> 2) * 8 + (w >> 6); const int k = (kk & ~0xC) | ((kk & 4) << 1) | ((kk & 8) >> 1);
        const int c = (st & 3) * 32 + 8 * ((w & 63) >> 4); vofV[i] = (unsigned)((k * 4096 + 128 + c) * 2); } }
  { const int row = wid * 8 + (lane >> 3), ch = (lane & 7) ^ ((row >> 1) & 7); vofR = (unsigned)((row * 64 + ch * 8) * 2); }
  const unsigned ldsK = (unsigned)__builtin_amdgcn_readfirstlane((unsigned)(uintptr_t)Kn_lds + (unsigned)wid * 2048u);
  const unsigned ldsV = (unsigned)__builtin_amdgcn_readfirstlane((unsigned)(uintptr_t)V_lds + (unsigned)wid * 2048u);
  const unsigned ldsR = (unsigned)__builtin_amdgcn_readfirstlane((unsigned)(uintptr_t)Kr_lds + (unsigned)wid * 1024u);
#define KROW(j) ((j) < nc ? cbase + (j) * KVBLK : xbase + ((j) - nc) * KVBLK)
#define DMA_TILE(j, kslot, vslot) do { const long k0_ = KROW(j); const char* kb_ = uni_ptr(KVh + k0_ * 4096); const char* rb_ = uni_ptr(KRp + k0_ * 64); \
    glds16_s(kb_, vofK[0], ldsK + (kslot) * SHM_KN); glds16_s(kb_, vofK[1], ldsK + (kslot) * SHM_KN + 1024u); \
    glds16_s(rb_, vofR, ldsR + (kslot) * SHM_KR); \
    glds16_s(kb_, vofV[0], ldsV + (vslot) * SHM_V); glds16_s(kb_, vofV[1], ldsV + (vslot) * SHM_V + 1024u); } while (0)
#ifndef ATT_SKEW
#define ATT_SKEW 0
#endif
#if PROBE_TS
#define WAIT_SYNC() do { const unsigned long long w0_ = __builtin_amdgcn_s_memrealtime(); asm volatile("s_waitcnt vmcnt(0)" ::: "memory"); const unsigned long long w1_ = __builtin_amdgcn_s_memrealtime(); __syncthreads(); const unsigned long long w2_ = __builtin_amdgcn_s_memrealtime(); att_w_dma += w1_ - w0_; att_w_bar += w2_ - w1_; } while (0)
#else
#define WAIT_SYNC() do { asm volatile("s_waitcnt vmcnt(0)" ::: "memory"); __syncthreads(); if (ATT_SKEW && wid >= 4) __builtin_amdgcn_s_sleep(ATT_SKEW); } while (0)
#endif
#define RESC(a) do { if (__any((a) < 1.f)) { if (hi == 0) al_l[r32] = (a); asm volatile("s_waitcnt lgkmcnt(0)" ::: "memory"); \
    _Pragma("unroll") for (int d = 0; d < 4; ++d) _Pragma("unroll") for (int r = 0; r < 16; ++r) o[d][r] *= al_l[crow(r, hi)]; } } while (0)
#if PROBE_TS
  unsigned long long att_w_dma = 0, att_w_bar = 0; const unsigned long long att_t0 = __builtin_amdgcn_s_memrealtime();
#endif
  f32x16 pA0, pA1, pB0, pB1; float alA, alB; bf16x8 pa0, pa1, pa2, pa3;
  DMA_TILE(0, 0, 0); DMA_TILE(1, 1, 1); WAIT_SYNC();
  qkt(pA0, pA1, Kn_lds, Kr_lds, qr, r32, hi); partialSM(pA0, pA1, m_reg, alA);
  __syncthreads();
  int vprev = 0, vcur = 1, vnext = 2;
  for (int j = 1; j + 1 < NT; j += 2) {
    DMA_TILE(j + 1, 0, vnext);
    SBAR(); qkt(pB0, pB1, Kn_lds + SHM_KN, Kr_lds + SHM_KR, qr, r32, hi);
    finishSM(pA0, pA1, alA, l_reg, pa0, pa1, pa2, pa3); SBAR();
    pv_d0(o, vb0 + vprev * SHM_V, pa0, pa1, pa2, pa3); partialSM(pB0, pB1, m_reg, alB);
    RESC(alB); WAIT_SYNC();
    { const int t_ = vprev; vprev = vcur; vcur = vnext; vnext = t_; }
    if (j + 2 < NT) DMA_TILE(j + 2, 1, vnext);
    SBAR(); qkt(pA0, pA1, Kn_lds, Kr_lds, qr, r32, hi);
    finishSM(pB0, pB1, alB, l_reg, pa0, pa1, pa2, pa3); SBAR();
    pv_d0(o, vb0 + vprev * SHM_V, pa0, pa1, pa2, pa3); partialSM(pA0, pA1, m_reg, alA);
    RESC(alA); WAIT_SYNC();
    { const int t_ = vprev; vprev = vcur; vcur = vnext; vnext = t_; }
  }
  SBAR(); qkt(pB0, pB1, Kn_lds + SHM_KN, Kr_lds + SHM_KR, qr, r32, hi);
  finishSM(pA0, pA1, alA, l_reg, pa0, pa1, pa2, pa3); SBAR();
  pv_d0(o, vb0 + vprev * SHM_V, pa0, pa1, pa2, pa3); partialSM(pB0, pB1, m_reg, alB);
  RESC(alB);
  finishSM(pB0, pB1, alB, l_reg, pa0, pa1, pa2, pa3); SBAR();
  pv_d0(o, vb0 + vcur * SHM_V, pa0, pa1, pa2, pa3);
  if (hi == 0) li_l[r32] = l_reg; asm volatile("s_waitcnt lgkmcnt(0)" ::: "memory");
  float rli[16];
#pragma unroll
  for (int r = 0; r < 16; ++r) rli[r] = __builtin_amdgcn_rcpf(li_l[crow(r, hi)]);
  bf16* Ow = Ob + (long)(wid * QBLK) * 2048;
#pragma unroll
  for (int r = 0; r < 16; ++r) { const int orow = crow(r, hi);
#pragma unroll
    for (int d0 = 0; d0 < 4; ++d0) Ow[(long)orow * 2048 + d0 * 32 + r32] = (bf16)(cvt_pk_bf16(o[d0][r] * rli[r], 0.f) & 0xffffu); }
  __syncthreads();
#if PROBE_TS
  if (ts_words && tid == 0) { ts_words[160] += att_w_dma; ts_words[161] += att_w_bar; ts_words[162] += __builtin_amdgcn_s_memrealtime() - att_t0; ts_words[163] += (unsigned long long)NT; }
#endif
#undef KROW
#undef DMA_TILE
#undef WAIT_SYNC
#undef RESC
}
#undef SBAR
}

namespace scan {
constexpr int CH = 64;
constexpr int OFF_Q = 0, OFF_K = 32768  , OFF_V = 98304, OFF_P = 131072, SHM_SCAN = 131072 + 8192;
__device__ __forceinline__ unsigned off_b(unsigned row, unsigned ch) { return 256u * row + 16u * (ch ^ (((row & 3) << 2) | ((row >> 2) & 3))); }
__device__ __forceinline__ unsigned p_off(unsigned i, unsigned chunk) { return 128u * i + 16u * (chunk ^ ((i >> 1) & 7)); }
__device__ __forceinline__ int crow(int r, int hi) { return (r & 3) + 8 * (r >> 2) + 4 * hi; }
__device__ __forceinline__ s16x4 vtr(const LAS char* p) { typedef short v4i16_t __attribute__((ext_vector_type(4))); return __builtin_bit_cast(s16x4, __builtin_amdgcn_ds_read_tr16_b64_v4i16((LAS v4i16_t*)p)); }
__device__ __forceinline__ bf16x8 tr_frag(const LAS char* img, int lane, int c, int ks) {
    const unsigned h = lane >> 5, blk = (lane >> 4) & 1, q = (lane & 15) >> 2, p = lane & 3;
    const unsigned r0 = 16 * ks + 8 * h + q, chn = 4 * c + 2 * blk + (p >> 1);
    const s16x4 lo = vtr(img + off_b(r0, chn) + 8 * (p & 1)), hi = vtr(img + off_b(r0 + 4, chn) + 8 * (p & 1));
    return (bf16x8){lo[0], lo[1], lo[2], lo[3], hi[0], hi[1], hi[2], hi[3]};
}
__device__ __forceinline__ bf16x8 pack_step(const f32x16& x, int s) {
    u32x4 p; p.x = cvt_pk_bf16(x[8 * s + 0], x[8 * s + 1]); p.y = cvt_pk_bf16(x[8 * s + 2], x[8 * s + 3]); p.z = cvt_pk_bf16(x[8 * s + 4], x[8 * s + 5]); p.w = cvt_pk_bf16(x[8 * s + 6], x[8 * s + 7]);
    return __builtin_bit_cast(bf16x8, p);
}
__device__ __forceinline__ void dma_mat(const bf16* src, int ld, LAS unsigned char* dst, int wid, int lane) {
    const char* sb = uni_ptr(src); const unsigned d0 = (unsigned)__builtin_amdgcn_readfirstlane((unsigned)(uintptr_t)dst + (unsigned)wid * 4096u);
#pragma unroll
    for (int k = 0; k < 4; ++k) { const int pc = wid * 4 + k, img = pc >> 4, row = 4 * (pc & 15) + (lane >> 4), pos = lane & 15;
        const int ch = pos ^ (((row & 3) << 2) | ((row >> 2) & 3));
        glds16_s(sb, (unsigned)((row * ld + img * 128 + ch * 8) * 2), d0 + (unsigned)k * 1024u); }
}
__device__ __forceinline__ int scan_rowbase(int n, int b, int dir) { return (n < 4) ? MX + b * CTXL + (dir ? 3 - n : n) * CH : b * SEQ + (dir ? 67 - n : n - 4) * CH; }
__device__ __forceinline__ float uni_f(float x) { return __uint_as_float(__builtin_amdgcn_readfirstlane(__float_as_uint(x))); }
typedef const LAS s16x4* lds_s4p;
__device__ __forceinline__ void scan_unit(const bf16* __restrict__ QKV, bf16* __restrict__ Y, int b, int hd, int dir, int dvh, float lg2, bool skip_ctx_y, LAS unsigned char* lds, int tid_in, unsigned long long* lds_ts = nullptr) {
    int tid = tid_in; asm volatile("" : "+v"(tid));
    const int wid = __builtin_amdgcn_readfirstlane(tid >> 6), lane0 = tid & 63;
    const LAS char* QI = (const LAS char*)lds + OFF_Q; const LAS char* VI = (const LAS char*)lds + OFF_V;
    LAS char* PI = (LAS char*)lds + OFF_P;
    f32x16 S[8];
#pragma unroll
    for (int i = 0; i < 8; ++i) S[i] = f32x16{};
    const float lgr = dir ? -lg2 : lg2;
    const float g64 = uni_f(__builtin_amdgcn_exp2f(64.f * lg2));
    const float R1 = uni_f(__builtin_amdgcn_exp2f(lgr)), R8 = uni_f(__builtin_amdgcn_exp2f(8.f * lgr)), R32 = uni_f(__builtin_amdgcn_exp2f(32.f * lgr));
    const float Rm1 = uni_f(__builtin_amdgcn_exp2f(-lgr)), Rm16 = uni_f(__builtin_amdgcn_exp2f(-16.f * lgr));
    const float c0 = uni_f(dir ? g64 : __builtin_amdgcn_exp2f(lg2)), z0 = uni_f(dir ? 1.0f : __builtin_amdgcn_exp2f(63.f * lg2));
    const int qcol = hd * RDK, kcol = 2048 + hd * RDK, vcol = 4096 + hd * RDV + dvh * 256;
    { const bf16* src = QKV + (size_t)scan_rowbase(0, b, dir) * 8192;
      dma_mat(src + qcol, 8192, lds + OFF_Q, wid, lane0); dma_mat(src + kcol, 8192, lds + OFF_K, wid, lane0); dma_mat(src + vcol, 8192, lds + OFF_V, wid, lane0);
      asm volatile("s_waitcnt vmcnt(0)" ::: "memory"); __syncthreads(); }
#if PROBE_TS
    unsigned long long sc_w1 = 0, sc_w2 = 0; const unsigned long long sc_tb = __builtin_amdgcn_s_memrealtime();
#endif
    for (int n = 0; n < 68; ++n) {
        int lane = lane0; asm volatile("" : "+v"(lane));
        const int r = lane & 31, h = lane >> 5, fr = lane & 15, fq = lane >> 4;
        const int rowbase = scan_rowbase(n, b, dir);
        const bool more = n + 1 < 68;
        const bf16* nsrc = QKV + (size_t)scan_rowbase(more ? n + 1 : n, b, dir) * 8192;
        const LAS char* KI = (const LAS char*)lds + OFF_K + (n & 1) * 32768;
        if (more) dma_mat(nsrc + kcol, 8192, lds + OFF_K + ((n + 1) & 1) * 32768, wid, lane);
        const float LR = c0 * __builtin_amdgcn_exp2f((float)(4 * h) * lgr), LZ = z0 * __builtin_amdgcn_exp2f((float)(-8 * h) * lgr), LP = __builtin_amdgcn_exp2f((float)(fr - 4 * fq) * lgr);
        { const int fH = fr & 3, fL = (fr >> 2) & 3; const int AL = 256 * fr + 16 * (fq ^ fL);
          int AH[4];
#pragma unroll
          for (int k = 0; k < 4; ++k) AH[k] = 64 * (k ^ fH);
#pragma unroll
          for (int tix = 0; tix < 2; ++tix) { const int tt = wid * 2 + tix, jt = tt >> 2, it = tt & 3;
            f32x4 pt = {0.f, 0.f, 0.f, 0.f};
            const bool live = dir ? (jt >= it) : (jt <= it);
            if (live) { const LAS char* ka = KI + 4096 * jt + AL; const LAS char* qa = QI + 4096 * it + AL;
#pragma unroll
                for (int ks = 0; ks < 8; ++ks) { const int o = (ks >> 2) * 16384 + AH[ks & 3];
                    pt = __builtin_amdgcn_mfma_f32_16x16x32_bf16(*(const LAS bf16x8*)(ka + o), *(const LAS bf16x8*)(qa + o), pt, 0, 0, 0); } }
            float we = LP * __builtin_amdgcn_exp2f((float)(16 * (it - jt)) * lgr); float v[4];
            const int mrel = fr - 4 * fq;
#pragma unroll
            for (int e = 0; e < 4; ++e) { float x = live ? pt[e] * we : 0.f; if (jt == it) { const bool keep = dir ? (e >= mrel) : (e <= mrel); x = keep ? x : 0.f; } v[e] = x; we *= Rm1; }
            const int i = it * 16 + fr, j0 = jt * 16 + 4 * fq;
            u32x2 w; w.x = cvt_pk_bf16(v[0], v[1]); w.y = cvt_pk_bf16(v[2], v[3]);
            *(LAS u32x2*)(PI + p_off(i, j0 >> 3) + ((j0 >> 2) & 1) * 8) = w; } }
        f32x16 Yt[2]; Yt[0] = f32x16{}; Yt[1] = f32x16{};
        { const int fH = r & 3, fL = (r >> 2) & 3; int QH[4], QL[4];
#pragma unroll
          for (int k = 0; k < 4; ++k) { QH[k] = 64 * (k ^ fH); QL[k] = 256 * r + 8 * h + 16 * (k ^ fL); }
#pragma unroll
          for (int dkb = 0; dkb < 8; ++dkb)
#pragma unroll
            for (int s = 0; s < 2; ++s) { const bf16x8 bf = pack_step(S[dkb], s);
                const LAS char* rp = QI + (dkb >> 2) * 16384 + QH[dkb & 3];
#pragma unroll
                for (int it = 0; it < 2; ++it) {
                    const u32x2 lo = *(const LAS u32x2*)(rp + it * 8192 + QL[2 * s]), hi2 = *(const LAS u32x2*)(rp + it * 8192 + QL[2 * s + 1]);
                    const u32x4 aw = {lo.x, lo.y, hi2.x, hi2.y};
                    Yt[it] = __builtin_amdgcn_mfma_f32_32x32x16_bf16(__builtin_bit_cast(bf16x8, aw), bf, Yt[it], 0, 0, 0); } } }
        { float fit = LR;
#pragma unroll
          for (int it = 0; it < 2; ++it) { float fa = fit;
#pragma unroll
            for (int a4 = 0; a4 < 4; ++a4) { float fb = fa;
#pragma unroll
                for (int b4 = 0; b4 < 4; ++b4) { Yt[it][4 * a4 + b4] *= fb; fb *= R1; }
                fa *= R8; }
            fit *= R32; } }
#if PROBE_TS
        const unsigned long long sc_t0 = __builtin_amdgcn_s_memrealtime();
#endif
        if (more) asm volatile("s_waitcnt vmcnt(4)" ::: "memory"); else asm volatile("s_waitcnt vmcnt(0)" ::: "memory");
        __syncthreads();
#if PROBE_TS
        sc_w1 += __builtin_amdgcn_s_memrealtime() - sc_t0;
#endif
        if (more) dma_mat(nsrc + qcol, 8192, lds + OFF_Q, wid, lane);
#pragma unroll
        for (int i = 0; i < 8; ++i)
#pragma unroll
            for (int rg = 0; rg < 16; ++rg) S[i][rg] *= g64;
        {
          const int blk = (lane >> 4) & 1, q = (lane & 15) >> 2, p = lane & 3; int TB[2], CQ[4];
#pragma unroll
          for (int t = 0; t < 2; ++t) TB[t] = 2048 * h + 256 * q + 1024 * t + 16 * ((2 * blk + (p >> 1)) ^ ((2 * h + t) & 3)) + 8 * (p & 1);
#pragma unroll
          for (int c = 0; c < 4; ++c) CQ[c] = 64 * (c ^ q);
          const LAS char* vb = VI + (wid >> 2) * 16384 + CQ[wid & 3];
          float zk = LZ;
#pragma unroll
          for (int ks = 0; ks < 4; ++ks) {
            const s16x4 vlo = vtr(vb + 4096 * ks + TB[0]), vhi = vtr(vb + 4096 * ks + TB[1]);
            const u32x2 vl = __builtin_bit_cast(u32x2, vlo), vh = __builtin_bit_cast(u32x2, vhi);
            const u32x4 vw = {vl.x, vl.y, vh.x, vh.y}; const bf16x8 vf = __builtin_bit_cast(bf16x8, vw);
#pragma unroll
            for (int it = 0; it < 2; ++it) { const bf16x8 pa = *(const LAS bf16x8*)(PI + p_off(it * 32 + r, 2 * ks + h));
                Yt[it] = __builtin_amdgcn_mfma_f32_32x32x16_bf16(pa, vf, Yt[it], 0, 0, 0); }
            float zj = zk; u32x4 zw;
            { const float a0 = bflo(vw.x) * zj; zj *= Rm1; const float a1 = bfhi(vw.x) * zj; zj *= Rm1; zw.x = cvt_pk_bf16(a0, a1); }
            { const float a0 = bflo(vw.y) * zj; zj *= Rm1; const float a1 = bfhi(vw.y) * zj; zj *= Rm1; zw.y = cvt_pk_bf16(a0, a1); }
            { const float a0 = bflo(vw.z) * zj; zj *= Rm1; const float a1 = bfhi(vw.z) * zj; zj *= Rm1; zw.z = cvt_pk_bf16(a0, a1); }
            { const float a0 = bflo(vw.w) * zj; zj *= Rm1; const float a1 = bfhi(vw.w) * zj; zw.w = cvt_pk_bf16(a0, a1); }
            const bf16x8 vz = __builtin_bit_cast(bf16x8, zw);
            zk *= Rm16;
#pragma unroll
            for (int dkb = 0; dkb < 8; ++dkb) { const LAS char* kb_ = KI + (dkb >> 2) * 16384 + 4096 * ks + CQ[dkb & 3];
                const s16x4 klo = vtr(kb_ + TB[0]), khi = vtr(kb_ + TB[1]);
                const u32x2 kl = __builtin_bit_cast(u32x2, klo), kh = __builtin_bit_cast(u32x2, khi); const u32x4 kw = {kl.x, kl.y, kh.x, kh.y};
                S[dkb] = __builtin_amdgcn_mfma_f32_32x32x16_bf16(__builtin_bit_cast(bf16x8, kw), vz, S[dkb], 0, 0, 0); }
            __builtin_amdgcn_sched_barrier(0);
          } }
        if (!(skip_ctx_y && n < 4)) {
            bf16* Yr = Y + (size_t)rowbase * 4096; const unsigned yo = (unsigned)(hd * RDV + dvh * 256 + wid * 32 + r + 4 * h * 4096);
#pragma unroll
            for (int it = 0; it < 2; ++it)
#pragma unroll
                for (int rg = 0; rg < 16; ++rg) { const unsigned i0 = (unsigned)(it * 32 + (rg & 3) + 8 * (rg >> 2));
                    Yr[yo + i0 * 4096u] = (bf16)(cvt_pk_bf16(Yt[it][rg], 0.f) & 0xffffu); }
        }
#if PROBE_TS
        const unsigned long long sc_t1 = __builtin_amdgcn_s_memrealtime();
#endif
        asm volatile("s_waitcnt vmcnt(0)" ::: "memory");
        __syncthreads();
#if PROBE_TS
        sc_w2 += __builtin_amdgcn_s_memrealtime() - sc_t1;
#endif
        if (more) dma_mat(nsrc + vcol, 8192, lds + OFF_V, wid, lane);
    }
    asm volatile("s_waitcnt vmcnt(0)" ::: "memory"); __syncthreads();
#if PROBE_TS
    if (blockIdx.x == 0 && tid == 0) { unsigned long long* tw = (unsigned long long*)(lds_ts); tw[170] += sc_w1; tw[171] += sc_w2; tw[172] += __builtin_amdgcn_s_memrealtime() - sc_tb; }
#endif
}
}

#define XB_TMO      128
#define XB_XCNT(j)  (256  + 64 * (j))
#define XB_XSUB(j)  (1280 + 64 * (j))
#define XB_XGEN(j)  (2304 + 64 * (j))
#define XB_TOP      3328
#define XB_TOPGEN   3392
#define XCD_BAR_WORDS 3456
#define XB_SPIN_CAP (1u << 22)
__device__ __forceinline__ unsigned xb_ld(unsigned* p)              { return __hip_atomic_load(p, __ATOMIC_RELAXED, __HIP_MEMORY_SCOPE_AGENT); }
__device__ __forceinline__ unsigned xb_add(unsigned* p, unsigned v) { return __hip_atomic_fetch_add(p, v, __ATOMIC_RELAXED, __HIP_MEMORY_SCOPE_AGENT); }
__device__ __forceinline__ unsigned xb_xcc_id() { return (unsigned)__builtin_amdgcn_s_getreg((3 << 11) | 20) & 0xFu; }
#define XB_SPIN(cond, bar) do { unsigned _sp = 0; while (cond) { __builtin_amdgcn_s_sleep(1); \
    if ((++_sp & 255u) == 0u) { if (xb_ld(&(bar)[XB_TMO])) break; if (_sp > XB_SPIN_CAP) { atomicAdd(&(bar)[XB_TMO], 1u); break; } } } } while (0)
struct XcdBarrier { unsigned* bar; unsigned x; volatile LAS unsigned* st; int wave; };
__device__ __forceinline__ XcdBarrier xcd_barrier_post(unsigned* bar, volatile LAS unsigned* st, int wave) {
    XcdBarrier b; b.bar = bar; b.x = xb_xcc_id(); b.st = st; b.wave = wave;
    if (wave == 0 && lane_id() == 0) (void)xb_add(&bar[XB_XCNT(b.x)], 1u);
    return b;
}
__device__ __forceinline__ void xcd_barrier_complete(unsigned* bar, unsigned x, unsigned& nloc, unsigned& nx) {
    const unsigned G = gridDim.x * gridDim.y * gridDim.z;
    unsigned sum, cnt, mine, sp = 0u;
    for (;;) {
        sum = 0u; cnt = 0u; mine = 0u;
#pragma unroll
        for (unsigned j = 0; j < 16; ++j) { const unsigned c = xb_ld(&bar[XB_XCNT(j)]); sum += c; cnt += (c > 0u) ? 1u : 0u; mine = (j == x) ? c : mine; }
        if (sum == G) break;
        __builtin_amdgcn_s_sleep(1);
        if ((++sp & 255u) == 0u) { if (xb_ld(&bar[XB_TMO])) break; if (sp > XB_SPIN_CAP) { atomicAdd(&bar[XB_TMO], 1u); break; } }
    }
    nloc = mine > 0u ? mine : 1u; nx = cnt > 0u ? cnt : 1u;
}
__device__ __forceinline__ void xcd_barrier(const XcdBarrier& b) {
    asm volatile("s_waitcnt vmcnt(0)" ::: "memory");
    __syncthreads();
    if (b.wave == 0 && lane_id() == 0) {
        unsigned* bar = b.bar; asm volatile("" : "+s"(bar));
        __builtin_amdgcn_s_waitcnt(0);
        unsigned nloc = b.st[0], nx = b.st[1];
        if (nloc == 0u) { xcd_barrier_complete(bar, b.x, nloc, nx); b.st[0] = nloc; b.st[1] = nx; }
        const unsigned old = xb_add(&bar[XB_XSUB(b.x)], 1u);
        const unsigned gen = old / nloc;
        if (old + 1u == (gen + 1u) * nloc) {
            __builtin_amdgcn_fence(__ATOMIC_RELEASE, "agent");
            asm volatile("s_waitcnt vmcnt(0)" ::: "memory");
            const unsigned og = xb_add(&bar[XB_TOP], 1u);
            const unsigned tg = og / nx;
            if (og + 1u == (tg + 1u) * nx) xb_add(&bar[XB_TOPGEN], 1u);
            else XB_SPIN(xb_ld(&bar[XB_TOPGEN]) == tg, bar);
            __builtin_amdgcn_fence(__ATOMIC_ACQUIRE, "agent");
            xb_add(&bar[XB_XGEN(b.x)], 1u);
            asm volatile("s_waitcnt vmcnt(0)" ::: "memory");
        } else {
            XB_SPIN(xb_ld(&bar[XB_XGEN(b.x)]) == gen, bar);
            __builtin_amdgcn_fence(__ATOMIC_ACQUIRE, "agent");
            asm volatile("s_waitcnt vmcnt(0)" ::: "memory");
        }
    }
    __syncthreads();
}

__device__ __forceinline__ float wave_sum(float v, int lane) {
#pragma unroll
    for (int o = 1; o < 64; o <<= 1) v += shfl_xor_l(v, o, lane);
    return v;
}
struct CvtDesc { const float* src; const float* kscale; bf16* WTrow0; int ldw, k0, K, jkind; float gscale; };
__device__ __forceinline__ int ropeperm64(int c) { const int p = c >> 1, e = c & 1; return (p < 16) ? (p + 16 * e) : (32 + (p - 16) + 16 * e); }
__device__ __forceinline__ int ropeinv64(int s_) { const int half = s_ >> 5, w = s_ & 31; return 2 * (half * 16 + (w & 15)) + (w >> 4); }
__device__ __forceinline__ void cvt_load(const CvtDesc& d, int lane, f32x4 (&v)[16]) {
#pragma unroll
    for (int i = 0; i < 16; ++i) { const int kk = 4 * i + (lane >> 4);
        f32x4 x = d.src ? *(const f32x4*)(d.src + (size_t)(d.k0 + kk) * d.ldw) : (f32x4){0.f, 0.f, 0.f, 0.f};
        float sc_ = d.gscale; if (d.kscale) sc_ *= d.kscale[d.k0 + kk];
        v[i] = x * sc_; }
}
__device__ __forceinline__ void cvt_store(const CvtDesc& d, int lane, const f32x4 (&v)[16], LAS float* scr) {
    const int n4 = lane & 15; int jr[4];
#pragma unroll
    for (int e = 0; e < 4; ++e) { const int s_ = 4 * n4 + e; jr[e] = d.jkind == 0 ? s_ : d.jkind == 1 ? ropeinv64(s_) : 2 * (4 * (n4 & 7) + e) + (n4 >> 3); }
#pragma unroll
    for (int i = 0; i < 16; ++i) { const int kk = 4 * i + (lane >> 4);
#pragma unroll
        for (int e = 0; e < 4; ++e) scr[kk * 65 + jr[e]] = v[i][e]; }
    asm volatile("s_waitcnt lgkmcnt(0)" ::: "memory");
    const int c = lane & 7;
#pragma unroll
    for (int ps = 0; ps < 8; ++ps) { const int j = 8 * ps + (lane >> 3); const LAS float* s = scr + (8 * c) * 65 + j;
        u32x4 o; o.x = cvt_pk_bf16(s[0 * 65], s[1 * 65]); o.y = cvt_pk_bf16(s[2 * 65], s[3 * 65]); o.z = cvt_pk_bf16(s[4 * 65], s[5 * 65]); o.w = cvt_pk_bf16(s[6 * 65], s[7 * 65]);
        *(u32x4*)(d.WTrow0 + (size_t)j * d.K + d.k0 + 8 * c) = o; }
    asm volatile("s_waitcnt lgkmcnt(0)" ::: "memory");
}
struct CvtJob { const float* W0; const float* W1; const float* kscale; bf16* WT; int ldw, K, nrows, kind, aux; float gscale; };
__device__ __forceinline__ bool cvt_try(const CvtJob& J, int& it, int lane, CvtDesc& d) {
    const int nblk = J.nrows / 64, items = (J.K / 64) * nblk;
    if (it >= items) { it -= items; return false; }
    const int kb = it / nblk, nb = it % nblk; const int n4 = lane & 15;
    const float* sp; int jk = 0;
    switch (J.kind) {
        case 0: sp = J.W0 + J.aux + nb * 64 + 4 * n4; break;
        case 1: sp = J.W0 + J.aux + 4 * n4; jk = 1; break;
        case 2: { const int hh = nb / 3, part = nb % 3; sp = J.W0 + hh * DQ + 64 * part + 4 * n4; jk = (part == 2) ? 1 : 0; } break;
        case 3: { const int hh = nb >> 2, q4 = nb & 3; sp = J.W0 + hh * 256 + 32 * q4 + 128 * (n4 >> 3) + 4 * (n4 & 7); jk = 2; } break;
        case 4: { const int tl = nb >> 2, hf = (nb >> 1) & 1, q2 = nb & 1; const long long dW = (const char*)J.W1 - (const char*)J.W0; sp = (const float*)((const char*)J.W0 + dW * hf) + tl * 128 + 64 * q2 + 4 * n4; } break;
        default: sp = nullptr; break;
    }
    d.src = sp; d.kscale = J.kscale; d.WTrow0 = J.WT + (size_t)(nb * 64) * J.K; d.ldw = J.ldw; d.k0 = kb * 64; d.K = J.K; d.jkind = jk; d.gscale = J.gscale;
    return true;
}
__device__ __forceinline__ int cvt_items(const CvtJob& J) { return (J.K / 64) * (J.nrows / 64); }

__device__ __forceinline__ void row_load(const float* xrow, int lane, f32x4 (&v)[8]) {
#pragma unroll
    for (int j = 0; j < 8; ++j) v[j] = *(const f32x4*)(xrow + 4 * lane + 256 * j);
}
__device__ __forceinline__ void norm_mod_finish(const f32x4 (&v)[8], const float* g, const float* sc, const float* sh, bf16* orow, int lane) {
    float s = 0.f;
#pragma unroll
    for (int j = 0; j < 8; ++j) s += (v[j][0] * v[j][0] + v[j][1] * v[j][1]) + (v[j][2] * v[j][2] + v[j][3] * v[j][3]);
    const float rstd = 1.0f / sqrtf(wave_sum(s, lane) * (1.0f / D) + NORM_EPS);
#pragma unroll
    for (int j = 0; j < 8; ++j) { const int c = 4 * lane + 256 * j; const f32x4 gg = *(const f32x4*)(g + c), s1 = *(const f32x4*)(sc + c), s0 = *(const f32x4*)(sh + c);
        const f32x4 y = (v[j] * rstd) * gg * (1.0f + s1) + s0;
        u32x2 w; w.x = cvt_pk_bf16(y[0], y[1]); w.y = cvt_pk_bf16(y[2], y[3]); *(u32x2*)(orow + c) = w; }
}
__device__ __forceinline__ void norm_phase(const float* xsrc, const float* csrc, const float* g, const float* modl, int chunk, bf16* H, int nrows, int gw, int NGW, int lane) {
    if (gw >= nrows) return;
    f32x4 v[8], vn[8]; int m = gw;
    row_load(m < MX ? xsrc + (size_t)m * D : csrc + (size_t)(m - MX) * D, lane, v);
    for (;;) {
        const int mn = m + NGW; const bool has = mn < nrows;
        if (has) row_load(mn < MX ? xsrc + (size_t)mn * D : csrc + (size_t)(mn - MX) * D, lane, vn);
        const float* mr = modl + (size_t)(m < MX ? (m >> 12) : 8) * NMOD + chunk * D;
        norm_mod_finish(v, g, mr + D, mr, H + (size_t)m * D, lane);
        if (!has) break;
#pragma unroll
        for (int j = 0; j < 8; ++j) v[j] = vn[j];
        m = mn;
    }
}

__device__ __forceinline__ void row_load_b16(const bf16* xrow, int lane, u32x4 (&v)[4]) {
#pragma unroll
    for (int j = 0; j < 4; ++j) v[j] = *(const u32x4*)(xrow + 8 * lane + 512 * j);
}
__device__ __forceinline__ void norm_phase_b16(const bf16* xsrc, const bf16* csrc, const float* g, const float* modl, int chunk, bf16* H, int nrows, int gw, int NGW, int lane) {
    if (gw >= nrows) return;
    u32x4 v[4], vn[4]; int m = gw;
    row_load_b16(m < MX ? xsrc + (size_t)m * D : csrc + (size_t)(m - MX) * D, lane, v);
    for (;;) {
        const int mn = m + NGW; const bool has = mn < nrows;
        if (has) row_load_b16(mn < MX ? xsrc + (size_t)mn * D : csrc + (size_t)(mn - MX) * D, lane, vn);
        const float* mr = modl + (size_t)(m < MX ? (m >> 12) : 8) * NMOD + chunk * D; const float* sc = mr + D; const float* sh = mr;
        float x[4][8]; float ss = 0.f;
#pragma unroll
        for (int j = 0; j < 4; ++j) { x[j][0] = bflo(v[j].x); x[j][1] = bfhi(v[j].x); x[j][2] = bflo(v[j].y); x[j][3] = bfhi(v[j].y); x[j][4] = bflo(v[j].z); x[j][5] = bfhi(v[j].z); x[j][6] = bflo(v[j].w); x[j][7] = bfhi(v[j].w);
#pragma unroll
            for (int e = 0; e < 8; ++e) ss += x[j][e] * x[j][e]; }
        const float rstd = 1.0f / sqrtf(wave_sum(ss, lane) * (1.0f / D) + NORM_EPS);
        bf16* orow = H + (size_t)m * D;
#pragma unroll
        for (int j = 0; j < 4; ++j) { const int c = 8 * lane + 512 * j;
            const f32x4 g0 = *(const f32x4*)(g + c), g1 = *(const f32x4*)(g + c + 4), s10 = *(const f32x4*)(sc + c), s11 = *(const f32x4*)(sc + c + 4), s00 = *(const f32x4*)(sh + c), s01 = *(const f32x4*)(sh + c + 4);
            const f32x4 xa = {x[j][0], x[j][1], x[j][2], x[j][3]}, xb = {x[j][4], x[j][5], x[j][6], x[j][7]};
            const f32x4 ya = (xa * rstd) * g0 * (1.0f + s10) + s00, yb = (xb * rstd) * g1 * (1.0f + s11) + s01;
            *(u32x4*)(orow + c) = pack8(ya, yb); }
        if (!has) break;
#pragma unroll
        for (int j = 0; j < 4; ++j) v[j] = vn[j];
        m = mn;
    }
}

__device__ __forceinline__ unsigned long long ld_arg(LAS unsigned char* lds, int i) {
    const volatile LAS unsigned* p = (const volatile LAS unsigned*)(lds + ARGS_OFF) + 2 * i;
    const unsigned lo = __builtin_amdgcn_readfirstlane(p[0]), hi = __builtin_amdgcn_readfirstlane(p[1]);
    return ((unsigned long long)hi << 32) | lo;
}
__device__ __forceinline__ void mod_layers(LAS unsigned char* lds, unsigned char* ws, int l_lo, int l_hi, int wg, int nwg, int tid, int lane, int wave) {
#define ARGF(i) ((const float*)ld_arg(lds, (i)))
    const int nitems = (l_hi - l_lo) * 96;
    if (wg >= nitems) return;
    LAS float* cond = (LAS float*)lds;
    LAS float* red = (LAS float*)(lds + 73728);
    float* MODV = (float*)(ws + WS_MODV);
    { const float* cin = ARGF(1); const float* cc = ARGF(3);
      for (int i = tid; i < 9 * D; i += 512) { const int r = i >> 11, k = i & (D - 1); const float c = (r < 8) ? cin[r * D + k] : cc[k]; cond[i] = c / (1.0f + __expf(-c)); } }
    __syncthreads();
    for (int it = wg; it < nitems; it += nwg) {
        const int l = l_lo + it / 96, cb = it % 96; const int n = cb * 128 + 2 * lane;
        const float* W = ARGF(4) + (size_t)l * D * NMOD + n; const float* mb = ARGF(5) + (size_t)l * NMOD + cb * 128;
        float a0[9], a1[9];
#pragma unroll
        for (int r = 0; r < 9; ++r) { a0[r] = 0.f; a1[r] = 0.f; }
        for (int k = wave * 256; k < wave * 256 + 256; k += 8) {
            f32x2 w[8];
#pragma unroll
            for (int q = 0; q < 8; ++q) w[q] = *(const f32x2*)(W + (size_t)(k + q) * NMOD);
#pragma unroll
            for (int q4 = 0; q4 < 2; ++q4)
#pragma unroll
                for (int r = 0; r < 9; ++r) { const f32x4 c4 = *(const LAS f32x4*)(cond + r * D + k + 4 * q4);
#pragma unroll
                    for (int q = 0; q < 4; ++q) { a0[r] += c4[q] * w[4 * q4 + q][0]; a1[r] += c4[q] * w[4 * q4 + q][1]; } }
        }
#pragma unroll
        for (int r = 0; r < 9; ++r) { red[(wave * 9 + r) * 128 + 2 * lane] = a0[r]; red[(wave * 9 + r) * 128 + 2 * lane + 1] = a1[r]; }
        __syncthreads();
        for (int i = tid; i < 9 * 128; i += 512) { const int r = i >> 7, cc = i & 127; float s2 = 0.f;
#pragma unroll
            for (int w8 = 0; w8 < 8; ++w8) s2 += red[(w8 * 9 + r) * 128 + cc];
            MODV[((size_t)l * 9 + r) * NMOD + cb * 128 + cc] = s2 + mb[cc]; }
        __syncthreads();
    }
#undef ARGF
}
__device__ __forceinline__ void cvt_layer(LAS unsigned char* lds, unsigned char* ws, int lc, int rank, int nranks, int wave, int lane, int part  ) {
#define ARGF(i) ((const float*)ld_arg(lds, (i)))
    const int li = lc >> 1; const bool is_ret = (lc & 1) != 0;
    bf16* WM = (bf16*)(ws + (is_ret ? WS_WB : WS_WA)); bf16* WF = (bf16*)(ws + (is_ret ? WS_WB + 82 * MiB : WS_WA + 22 * MiB));
    LAS float* scr = (LAS float*)(lds + wave * 19456);
    CvtJob J[7]; int nj;
    if (!is_ret) {
        bf16* W1T = WM; bf16* WuqT = W1T + (size_t)N1 * D; bf16* WukvT = WuqT + (size_t)3072 * 512; bf16* WoT = WukvT + (size_t)4096 * 512;
        const float* wdq = ARGF(8) + (size_t)li * D * QR; const float* wdkv = ARGF(11) + (size_t)li * D * (KVR + ROPE);
        J[0] = CvtJob{wdq, nullptr, nullptr, W1T, QR, D, 512, 0, 0, 1.f};
        J[1] = CvtJob{wdkv, nullptr, nullptr, W1T + (size_t)512 * D, KVR + ROPE, D, 512, 0, 0, 1.f};
        J[2] = CvtJob{wdkv, nullptr, nullptr, W1T + (size_t)1024 * D, KVR + ROPE, D, 64, 1, 512, 1.f};
        J[3] = CvtJob{nullptr, nullptr, nullptr, W1T + (size_t)1088 * D, 1, D, 192, 5, 0, 1.f};
        J[4] = CvtJob{ARGF(10) + (size_t)li * QR * 3072, nullptr, ARGF(9) + li * QR, WuqT, 3072, QR, 3072, 2, 0, 0.07216878364870322f * LOG2E};
        J[5] = CvtJob{ARGF(13) + (size_t)li * KVR * 4096, nullptr, ARGF(12) + li * KVR, WukvT, 4096, KVR, 4096, 0, 0, 1.f};
        J[6] = CvtJob{ARGF(14) + (size_t)li * D * D, nullptr, nullptr, WoT, D, D, D, 0, 0, 1.f};
        nj = 7;
    } else {
        bf16* WqkvT = WM; bf16* WgT = WqkvT + (size_t)8192 * D; bf16* WoT = WgT + (size_t)8192 * D;
        J[0] = CvtJob{ARGF(15) + (size_t)li * D * D, nullptr, nullptr, WqkvT, D, D, 2048, 3, 0, 1.f};
        J[1] = CvtJob{ARGF(16) + (size_t)li * D * D, nullptr, nullptr, WqkvT + (size_t)2048 * D, D, D, 2048, 3, 0, 0.0625f};
        J[2] = CvtJob{ARGF(17) + (size_t)li * D * 4096, nullptr, nullptr, WqkvT + (size_t)4096 * D, 4096, D, 4096, 0, 0, 1.f};
        J[3] = CvtJob{ARGF(18) + (size_t)li * D * 4096, ARGF(19) + (size_t)li * D * 4096, nullptr, WgT, 4096, D, 8192, 4, 0, 1.f};
        J[4] = CvtJob{ARGF(20) + (size_t)li * 4096 * D, nullptr, nullptr, WoT, D, 4096, D, 0, 0, 1.f};
        J[5] = CvtJob{nullptr, nullptr, nullptr, nullptr, 1, 64, 0, 5, 0, 1.f};
        J[6] = J[5];
        nj = 5;
    }
    CvtJob F0 = CvtJob{ARGF(23) + (size_t)lc * D * FF, ARGF(24) + (size_t)lc * D * FF, nullptr, WF, FF, D, 11264, 4, 0, 1.f};
    CvtJob F1 = CvtJob{ARGF(27) + (size_t)lc * FF * D, nullptr, nullptr, WF + (size_t)11264 * D, D, FF, D, 0, 0, 1.f};
    if (part == 1) nj = 0;
    const bool ffn = part != 0;
    int total = ffn ? cvt_items(F0) + cvt_items(F1) : 0;
#pragma unroll
    for (int j = 0; j < 7; ++j) if (j < nj) total += cvt_items(J[j]);
#define CVT_FIND(IT, DD) do { int it_ = (IT); bool done_ = false; \
        _Pragma("unroll") for (int j = 0; j < 7; ++j) if (!done_ && j < nj) done_ = cvt_try(J[j], it_, lane, DD); \
        if (ffn) { if (!done_) done_ = cvt_try(F0, it_, lane, DD); if (!done_) done_ = cvt_try(F1, it_, lane, DD); } } while (0)
    if (rank < total) {
        f32x4 v[16], w[16]; CvtDesc d0, d1; int it0 = rank;
        CVT_FIND(it0, d0); cvt_load(d0, lane, v);
        for (;;) {
            const int it1 = it0 + nranks; const bool has = it1 < total;
            if (has) { CVT_FIND(it1, d1); cvt_load(d1, lane, w); }
            cvt_store(d0, lane, v, scr);
            if (!has) break;
#pragma unroll
            for (int i = 0; i < 16; ++i) v[i] = w[i];
            d0 = d1; it0 = it1;
        }
    }
#undef CVT_FIND
#undef ARGF
}

#if MLA_CHECK
constexpr int CW_CHK = 2048;
__device__ __forceinline__ float wave_max(float v, int lane) {
#pragma unroll
    for (int o = 1; o < 64; o <<= 1) v = fmaxf(v, shfl_xor_l(v, o, lane));
    return v;
}
__device__ __forceinline__ void mla_check(LAS unsigned char* lds, unsigned char* ws, int li, int gw, int wave, int lane) {
#define ARGF(i) ((const float*)ld_arg(lds, (i)))
    LAS float* sc = (LAS float*)(lds + wave * 19456);
    const bf16* H = (const bf16*)(ws + WS_H); const bf16* Qb = (const bf16*)(ws + WS_Q); const bf16* KVb = (const bf16*)(ws + WS_KV); const bf16* KRb = (const bf16*)(ws + WS_KR); const bf16* Ob = (const bf16*)(ws + WS_O);
    const int t = (int)(((unsigned)gw * 2654435761u) % (unsigned)MT); const int hd = gw & 15;
    const bool isx = t < MX; const int tt = t & (SEQ - 1);
    float err = 0.f;
    {
        const float* wdq = ARGF(8) + (size_t)li * D * QR; const float* wdkv = ARGF(11) + (size_t)li * D * (KVR + ROPE);
        float ql[8], kl[9];
#pragma unroll
        for (int j = 0; j < 8; ++j) ql[j] = 0.f;
#pragma unroll
        for (int j = 0; j < 9; ++j) kl[j] = 0.f;
        for (int k = 0; k < D; ++k) { const float hv = bf2f(H[(size_t)t * D + k]);
#pragma unroll
            for (int j = 0; j < 8; ++j) ql[j] += hv * wdq[(size_t)k * QR + lane + 64 * j];
#pragma unroll
            for (int j = 0; j < 9; ++j) kl[j] += hv * wdkv[(size_t)k * (KVR + ROPE) + lane + 64 * j]; }
        float sq = 0.f, sk = 0.f;
#pragma unroll
        for (int j = 0; j < 8; ++j) { sq += ql[j] * ql[j]; sk += kl[j] * kl[j]; }
        const float rq = 1.0f / sqrtf(wave_sum(sq, lane) * (1.0f / QR) + NORM_EPS), rk = 1.0f / sqrtf(wave_sum(sk, lane) * (1.0f / KVR) + NORM_EPS);
        const float* qg = ARGF(9) + li * QR; const float* kg = ARGF(12) + li * KVR;
#pragma unroll
        for (int j = 0; j < 8; ++j) { sc[lane + 64 * j] = ql[j] * rq * qg[lane + 64 * j]; sc[512 + lane + 64 * j] = kl[j] * rk * kg[lane + 64 * j]; }
        sc[1024 + lane] = kl[8];
        asm volatile("s_waitcnt lgkmcnt(0)" ::: "memory");
        const float* wuq = ARGF(10) + (size_t)li * QR * 3072 + hd * DQ; const float* wukv = ARGF(13) + (size_t)li * KVR * 4096 + hd * 256;
        float qv[3] = {0.f, 0.f, 0.f}, kv[4] = {0.f, 0.f, 0.f, 0.f};
        for (int c = 0; c < 512; ++c) { const float a = sc[c], bq = sc[512 + c];
#pragma unroll
            for (int j = 0; j < 3; ++j) qv[j] += a * wuq[(size_t)c * 3072 + lane + 64 * j];
#pragma unroll
            for (int j = 0; j < 4; ++j) kv[j] += bq * wukv[(size_t)c * 4096 + lane + 64 * j]; }
#pragma unroll
        for (int j = 0; j < 3; ++j) sc[1100 + lane + 64 * j] = qv[j];
        asm volatile("s_waitcnt lgkmcnt(0)" ::: "memory");
        float qref[3]; float kr_ref = 0.f;
#pragma unroll
        for (int j = 0; j < 3; ++j) { const int d = lane + 64 * j; float v = sc[1100 + d];
            if (d >= NOPE && isx) { const int e = d - NOPE, half = e >> 5, i = e & 15, second = (e >> 4) & 1; const float pos = half ? (float)(tt & 63) : (float)(tt >> 6);
                const float ang = pos * __builtin_amdgcn_exp2f(-(float)(2 * i) * (13.287712379549449f / 32.0f)); const float rev = ang * 0.15915494309189535f; const float fr_ = rev - floorf(rev);
                const float cs = __builtin_amdgcn_cosf(fr_), sn = __builtin_amdgcn_sinf(fr_); const float other = sc[1100 + NOPE + half * 32 + i + (second ? 0 : 16)];
                v = second ? (v * cs + other * sn) : (v * cs - other * sn); }
            qref[j] = v * (0.07216878364870322f * LOG2E); }
        { const int e = lane, half = e >> 5, i = e & 15, second = (e >> 4) & 1; float v = sc[1024 + e];
          if (isx) { const float pos = half ? (float)(tt & 63) : (float)(tt >> 6);
              const float ang = pos * __builtin_amdgcn_exp2f(-(float)(2 * i) * (13.287712379549449f / 32.0f)); const float rev = ang * 0.15915494309189535f; const float fr_ = rev - floorf(rev);
              const float cs = __builtin_amdgcn_cosf(fr_), sn = __builtin_amdgcn_sinf(fr_); const float other = sc[1024 + half * 32 + i + (second ? 0 : 16)];
              v = second ? (v * cs + other * sn) : (v * cs - other * sn); }
          kr_ref = v; }
#pragma unroll
        for (int j = 0; j < 3; ++j) sc[1400 + lane + 64 * j] = qref[j];
        sc[1600 + lane] = kr_ref;
        asm volatile("s_waitcnt lgkmcnt(0)" ::: "memory");
        float mx = 0.f, df = 0.f;
#pragma unroll
        for (int j = 0; j < 3; ++j) { const int p = lane + 64 * j; const int od = p < NOPE ? p : NOPE + ropeperm64(p - NOPE); const float ref = sc[1400 + od]; const float mine = bf2f(Qb[(size_t)t * 3072 + hd * DQ + p]);
            mx = fmaxf(mx, fabsf(ref)); df = fmaxf(df, fabsf(ref - mine)); }
        err = fmaxf(err, wave_max(df, lane) / (wave_max(mx, lane) + 1e-20f));
        mx = 0.f; df = 0.f;
#pragma unroll
        for (int j = 0; j < 4; ++j) { const float ref = kv[j]; const float mine = bf2f(KVb[(size_t)t * 4096 + hd * 256 + lane + 64 * j]); mx = fmaxf(mx, fabsf(ref)); df = fmaxf(df, fabsf(ref - mine)); }
        err = fmaxf(err, wave_max(df, lane) / (wave_max(mx, lane) + 1e-20f));
        { const float ref = sc[1600 + ropeperm64(lane)]; const float mine = bf2f(KRb[(size_t)t * 64 + lane]); err = fmaxf(err, wave_max(fabsf(ref - mine), lane) / (wave_max(fabsf(ref), lane) + 1e-20f)); }
    }
    {
        const int b = isx ? (t >> 12) : ((t - MX) >> 8); const int nk = isx ? 4352 : 256;
        for (int d = lane; d < DQ; d += 64) sc[d] = bf2f(Qb[(size_t)t * 3072 + hd * DQ + d]);
        asm volatile("s_waitcnt lgkmcnt(0)" ::: "memory");
        float mxs = -1e30f;
        for (int j = lane; j < nk; j += 64) { const int row = j < 256 ? MX + b * CTXL + j : b * SEQ + (j - 256); float sdot = 0.f;
            for (int d = 0; d < NOPE; ++d) sdot += sc[d] * bf2f(KVb[(size_t)row * 4096 + hd * 256 + d]);
            for (int d = 0; d < ROPE; ++d) sdot += sc[NOPE + d] * bf2f(KRb[(size_t)row * 64 + d]);
            sc[256 + j] = sdot; mxs = fmaxf(mxs, sdot); }
        mxs = wave_max(mxs, lane); float sum = 0.f;
        for (int j = lane; j < nk; j += 64) { const float p = __builtin_amdgcn_exp2f(sc[256 + j] - mxs); sc[256 + j] = p; sum += p; }
        sum = wave_sum(sum, lane);
        asm volatile("s_waitcnt lgkmcnt(0)" ::: "memory");
        float o0 = 0.f, o1 = 0.f;
        for (int j = 0; j < nk; ++j) { const int row = j < 256 ? MX + b * CTXL + j : b * SEQ + (j - 256); const float p = sc[256 + j];
            o0 += p * bf2f(KVb[(size_t)row * 4096 + hd * 256 + 128 + lane]); o1 += p * bf2f(KVb[(size_t)row * 4096 + hd * 256 + 128 + 64 + lane]); }
        o0 /= sum; o1 /= sum;
        const float m0 = bf2f(Ob[(size_t)t * D + hd * 128 + lane]), m1 = bf2f(Ob[(size_t)t * D + hd * 128 + 64 + lane]);
        const float df = fmaxf(fabsf(o0 - m0), fabsf(o1 - m1)), mx = fmaxf(fabsf(o0), fabsf(o1));
        err = fmaxf(err, wave_max(df, lane) / (wave_max(mx, lane) + 1e-20f));
    }
    if (lane == 0) atomicMax((unsigned*)(ws + WS_CTL) + CW_CHK, __float_as_uint(err));
#undef ARGF
}
#endif
struct Args { const float* in[29]; float* out; unsigned char* ws; int ph_lo, ph_hi; };
constexpr int PH_PER_LAYER = 10, PH_FINAL = 1 + PH_PER_LAYER * DEPTH, PH_COUNT = PH_FINAL + 1;

template <unsigned MK_EN_T>
__global__ void __launch_bounds__(512, 2) mk_fwd(Args args) {
    extern __shared__ __attribute__((aligned(16))) unsigned char lds_raw[];
    LAS unsigned char* lds = (LAS unsigned char*)lds_raw;
    volatile LAS unsigned* MISC = (volatile LAS unsigned*)(lds + MISC_OFF);
    const int G = gridDim.x; const int bx = blockIdx.x; const int vcu = (G % 8 == 0) ? (bx % 8) * (G / 8) + bx / 8 : bx;
    const int NGW = G * 8;
    unsigned char* ws = args.ws; float* X = args.out; void* args_out_raw = (void*)args.out;
    const int lo = args.ph_lo, hi = args.ph_hi;
    const int wave_s = __builtin_amdgcn_readfirstlane((int)threadIdx.x >> 6);
#define TID() (wave_s * 64 + lane_id())
    { const int tid0 = threadIdx.x;
      for (int u = tid0; u < (LDS_BYTES - CTRL_BASE) / 4; u += 512) ((LAS unsigned*)(lds + CTRL_BASE))[u] = 0u;
      __syncthreads();
      if (tid0 < 29) ((volatile LAS unsigned long long*)(lds + ARGS_OFF))[tid0] = (unsigned long long)args.in[tid0];
      __syncthreads(); }
#define ARGF(i) ((const float*)ld_arg(lds, (i)))
    XcdBarrier bar; bar.bar = (unsigned*)(ws + WS_CTL) + CW_BAR; bar.x = 0; bar.st = nullptr; bar.wave = wave_s;
    if (hi - lo > 1) bar = xcd_barrier_post((unsigned*)(ws + WS_CTL) + CW_BAR, MISC + 8, wave_s);
#if PROBE_TS
    if (bx == 0 && TID() == 0) { ((unsigned long long*)(ws + WS_CTL + 65536))[0] = __builtin_amdgcn_s_memrealtime(); ((unsigned long long*)(ws + WS_CTL + 65536))[121] = ~0ull; }
#endif
#define EN(b) (((MK_EN_T) >> (b)) & 1u)
#define IN(k) (lo <= (k) && (k) < hi)
#if PROBE_TS
#define TS_WORDS ((unsigned long long*)(ws + WS_CTL + 65536))
#define PHASE_END(k) do { if (hi > (k) + 1) xcd_barrier(bar); if (bx == 0 && TID() == 0) TS_WORDS[(k) + 1] = __builtin_amdgcn_s_memrealtime(); } while (0)
#else
#define PHASE_END(k) do { if (hi > (k) + 1) xcd_barrier(bar); } while (0)
#endif
#define PH_IDS int tid = TID(); asm volatile("" : "+v"(tid)); const int lane = tid & 63; const int wave = wave_s; int gw = vcu * 8 + wave; asm volatile("" : "+s"(gw)); (void)lane; (void)gw;
#define XB_    ((bf16*)args_out_raw)
#define XCB_   ((bf16*)(ws + WS_XC))
#define XF_    ((float*)(ws + WS_BIG + 32 * MiB))
#define MODV_  ((float*)(ws + WS_MODV))
#define TABM_  ((float*)(ws + WS_TABM))
#define TABR_  ((float*)(ws + WS_TABR))
#define SSQ_   ((float*)(ws + WS_SSQ))
#define KR_    ((bf16*)(ws + WS_KR))
#define H_     ((bf16*)(ws + WS_H))
#define WMIX_(ll) ((bf16*)(ws + (((ll) & 1) ? WS_WB : WS_WA)))
#define WFFN_(ll) ((bf16*)(ws + (((ll) & 1) ? WS_WB + 82 * MiB : WS_WA + 22 * MiB)))
#define W1T_   WMIX_(l)
#define WUQT_  (W1T_ + (size_t)N1 * D)
#define WUKVT_ (WUQT_ + (size_t)3072 * 512)
#define WOTM_  (WUKVT_ + (size_t)4096 * 512)
#define WQKVT_ WMIX_(l)
#define WGT_   (WQKVT_ + (size_t)8192 * D)
#define WOTR_  (WGT_ + (size_t)8192 * D)
#define WGUT_  WFFN_(l)
#define WDT_   (WGUT_ + (size_t)11264 * D)
#define QKVL_  ((bf16*)(ws + WS_QKVL))
#define Q_     ((bf16*)(ws + WS_Q))
#define KV_    ((bf16*)(ws + WS_KV))
#define O_     ((bf16*)(ws + WS_O))
#define QKV_   ((bf16*)(ws + WS_QKV))
#define Y_     ((bf16*)(ws + WS_Y))
#define GATED_ ((bf16*)(ws + WS_GATED))
#define GB_    ((bf16*)(ws + WS_G))
#define UB_    ((bf16*)(ws + WS_U))
#define HALO_  ((float*)(ws + WS_G))
#define MODL_  (MODV_ + (size_t)l * 9 * NMOD)

    if (EN(0) && IN(0)) for (int rep_ = 0; rep_ < 1 + (int)((PROBE_MASK >> 0) & 1u); ++rep_) {
        PH_IDS
        mod_layers(lds, ws, 0, 1, bx, G, tid, lane, wave);
        __syncthreads();
        cvt_layer(lds, ws, 0, gw, NGW, wave, lane, 2);
        for (int i = bx * 512 + tid; i < 64 * 16 + SEQ * 128; i += G * 512) {
            float inv, pos; float* dst;
            if (i < 1024) { const int p = i >> 4, f = i & 15; inv = __builtin_amdgcn_exp2f(-(float)(2 * f) * (13.287712379549449f / 32.0f)); pos = (float)p; dst = TABM_ + 2 * i; }
            else { const int j = i - 1024, t = j >> 7, f = j & 127; inv = __builtin_amdgcn_exp2f(-(float)(2 * f) * (13.287712379549449f / 256.0f)); pos = (float)t; dst = TABR_ + 2 * j; }
            const float ang = pos * inv; const double rev = (double)ang * 0.15915494309189535; const float fr = (float)(rev - floor(rev));
            dst[0] = __builtin_amdgcn_cosf(fr); dst[1] = __builtin_amdgcn_sinf(fr);
        }
        PHASE_END(0);
    }

    for (int l = 0; l < DEPTH; ++l) {
        const int P = 1 + PH_PER_LAYER * l; const int li = l >> 1; const bool is_ret = (l & 1) != 0; const bool last = (l == DEPTH - 1);
        const int Mrows = last ? MX : MT;

        if (EN(1) && IN(P + 0)) for (int rep_ = 0; rep_ < 1 + (int)((PROBE_MASK >> 1) & 1u); ++rep_) {
            PH_IDS
            const float* g = ARGF(6) + l * D;
            if (l == 0) norm_phase(ARGF(0), ARGF(2), g, MODL_, 0, H_, MT, gw, NGW, lane);
            else norm_phase_b16(XB_, XCB_, g, MODL_, 0, H_, MT, gw, NGW, lane);
            PHASE_END(P + 0);
        }

        if (!is_ret) {
            if (EN(2) && IN(P + 1)) for (int rep_ = 0; rep_ < 1 + (int)((PROBE_MASK >> 2) & 1u); ++rep_) {
                pg8::Gemm g{H_, W1T_, MT, N1, D, D}; pg8::StaticOrder S; S.init(MT, N1, G, bx); S.tid = TID();
                EpiG1 E{QKVL_, SSQ_, KR_, TABM_};
                pg8::gemm_phase<EpiG1>(lds, g, S, E);
                PHASE_END(P + 1);
            }
            if (EN(3) && IN(P + 2)) for (int rep_ = 0; rep_ < 1 + (int)((PROBE_MASK >> 3) & 1u); ++rep_) {
                { pg8::Gemm g{QKVL_, WUQT_, MT, 3072, QR, N1}; pg8::StaticOrder S; S.init(MT, 3072, G, bx); S.tid = TID(); EpiUq E{Q_, SSQ_, TABM_}; pg8::gemm_phase<EpiUq>(lds, g, S, E); }
                { pg8::Gemm g{QKVL_ + 512, WUKVT_, MT, 4096, KVR, N1}; pg8::StaticOrder S; S.init(MT, 4096, G, bx); S.tid = TID(); EpiUkv E{KV_, SSQ_}; pg8::gemm_phase<EpiUkv>(lds, g, S, E); }
                PHASE_END(P + 2);
            }
            if (EN(4) && IN(P + 3)) for (int rep_ = 0; rep_ < 1 + (int)((PROBE_MASK >> 4) & 1u); ++rep_) {
                const int nun = 2048 + 128;
                for (int ui = vcu; ui < nun; ui += G) {
                    if (ui < 2048) { const int xcd = (ui & 255) >> 5, j = ui & 31, rnd = ui >> 8; const int bh = xcd * 16 + 2 * rnd + (j >> 4), qb = j & 15; const int b = bh >> 4, hd = bh & 15;
                        att::attn_unit(Q_ + (size_t)(b * SEQ + qb * 256) * 3072 + hd * DQ, KV_ + hd * 256, KR_, O_ + (size_t)(b * SEQ + qb * 256) * D + hd * 128, 68, 4, MX + b * CTXL, b * SEQ, (char*)lds_raw, TID()
#if PROBE_TS
                            , bx == 0 ? TS_WORDS : nullptr
#endif
                            );
                    } else { const int bh = ui - 2048, b = bh >> 4, hd = bh & 15;
                        att::attn_unit(Q_ + (size_t)(MX + b * CTXL) * 3072 + hd * DQ, KV_ + hd * 256, KR_, O_ + (size_t)(MX + b * CTXL) * D + hd * 128, 4, 4, MX + b * CTXL, 0, (char*)lds_raw, TID()); }
                }
                PHASE_END(P + 3);
            }
        } else {
            if (EN(5) && IN(P + 1)) for (int rep_ = 0; rep_ < 1 + (int)((PROBE_MASK >> 5) & 1u); ++rep_) {
                pg8::Gemm g{H_, WQKVT_, MT, 8192, D, D}; pg8::StaticOrder S; S.init(MT, 8192, G, bx); S.tid = TID();
                EpiQKV E{QKV_, TABR_};
                pg8::gemm_phase<EpiQKV>(lds, g, S, E);
                PHASE_END(P + 1);
            }
            if (EN(6) && IN(P + 2)) for (int rep_ = 0; rep_ < 1 + (int)((PROBE_MASK >> 6) & 1u); ++rep_) {
                for (int ui = vcu; ui < 256; ui += G) {
                    const int bh = ui >> 2, dir = (ui >> 1) & 1, dvh = ui & 1; const int b = bh >> 3, hd = bh & 7;
                    const float dec = (dir ? ARGF(22) : ARGF(21))[li * RH + hd];
                    const float lg2 = -__expf(dec) * LOG2E;
                    scan::scan_unit(QKV_, Y_ + (size_t)dir * MT * 4096, b, hd, dir, dvh, lg2, last, lds, TID()
#if PROBE_TS
                                    , TS_WORDS
#endif
                                    );
                }
                PHASE_END(P + 2);
            }
            if (EN(7) && IN(P + 3)) for (int rep_ = 0; rep_ < 1 + (int)((PROBE_MASK >> 7) & 1u); ++rep_) {
                PH_IDS
                for (int row = gw; row < Mrows; row += NGW) {
                    u32x4 w[16];
#pragma unroll
                    for (int q = 0; q < 16; ++q) w[q] = *(const u32x4*)(Y_ + (size_t)(q >> 3) * MT * 4096 + (size_t)row * 4096 + (q & 7) * RDV + lane * 8);
                    float mu[16], rs[16];
#pragma unroll
                    for (int q = 0; q < 16; ++q) { const float s = ((bflo(w[q].x) + bfhi(w[q].x)) + (bflo(w[q].y) + bfhi(w[q].y))) + ((bflo(w[q].z) + bfhi(w[q].z)) + (bflo(w[q].w) + bfhi(w[q].w))); mu[q] = s; }
#pragma unroll
                    for (int o = 1; o < 64; o <<= 1)
#pragma unroll
                        for (int q = 0; q < 16; ++q) mu[q] += shfl_xor_l(mu[q], o, lane);
#pragma unroll
                    for (int q = 0; q < 16; ++q) { mu[q] *= (1.0f / RDV); const float m_ = mu[q];
                        const float d0 = bflo(w[q].x) - m_, d1 = bfhi(w[q].x) - m_, d2 = bflo(w[q].y) - m_, d3 = bfhi(w[q].y) - m_, d4 = bflo(w[q].z) - m_, d5 = bfhi(w[q].z) - m_, d6 = bflo(w[q].w) - m_, d7 = bfhi(w[q].w) - m_;
                        rs[q] = ((d0 * d0 + d1 * d1) + (d2 * d2 + d3 * d3)) + ((d4 * d4 + d5 * d5) + (d6 * d6 + d7 * d7)); }
#pragma unroll
                    for (int o = 1; o < 64; o <<= 1)
#pragma unroll
                        for (int q = 0; q < 16; ++q) rs[q] += shfl_xor_l(rs[q], o, lane);
                    float mo = 0.f, ro = 0.f;
#pragma unroll
                    for (int q = 0; q < 16; ++q) { if (lane == q) { mo = mu[q]; ro = rs[q]; } }
                    if (lane < 16) *(f32x2*)((float*)(ws + WS_STATS) + ((size_t)((lane >> 3) * MT + row) * 8 + (lane & 7)) * 2) = (f32x2){mo, 1.0f / sqrtf(ro * (1.0f / RDV) + GN_EPS)};
                }
                PHASE_END(P + 3);
            }
            if (EN(8) && IN(P + 4)) for (int rep_ = 0; rep_ < 1 + (int)((PROBE_MASK >> 8) & 1u); ++rep_) {
                pg8::Gemm g{H_, WGT_, Mrows, 8192, D, D}; pg8::StaticOrder S; S.init(Mrows, 8192, G, bx); S.tid = TID();
                EpiGate E{GATED_, Y_, Y_ + (size_t)MT * 4096, (const float*)(ws + WS_STATS)};
                pg8::gemm_phase<EpiGate>(lds, g, S, E);
                PHASE_END(P + 4);
            }
        }
        if (EN(9) && IN(P + 5)) for (int rep_ = 0; rep_ < 1 + (int)((PROBE_MASK >> 9) & 1u); ++rep_) {
#if MLA_CHECK
            if (l == MLA_CHECK_LAYER) { PH_IDS mla_check(lds, ws, li, gw, wave, lane); __syncthreads(); }
#endif
            pg8::Gemm g = is_ret ? pg8::Gemm{GATED_, WOTR_, Mrows, D, 4096, 4096} : pg8::Gemm{O_, WOTM_, Mrows, D, D, D};
            pg8::StaticOrder S; S.init(Mrows, D, G, bx, 4, true); S.tid = TID();
#if PROBE_TS
            S.probe = is_ret ? 2 : 1; S.tsw = TS_WORDS;
#endif
            const void* xsrc = (l == 0) ? (const void*)ARGF(0) : (const void*)XB_; const void* csrc = (l == 0) ? (const void*)ARGF(2) : (const void*)XCB_;
            EpiResid E{xsrc, XB_, csrc, XCB_, MODL_, 2 * D, l == 0, false};
            pg8::gemm_phase<EpiResid>(lds, g, S, E);
            if (l + 1 < DEPTH) {
                PH_IDS
                const int nwg = (Mrows / 256) * (D / 256), rem = nwg % G;
                if (rem == 0) cvt_layer(lds, ws, l + 1, gw, NGW, wave, lane, 0);
                else if (bx >= rem) cvt_layer(lds, ws, l + 1, (bx - rem) * 8 + wave, (G - rem) * 8, wave, lane, 0);
            }
            PHASE_END(P + 5);
        }
        if (EN(10) && IN(P + 6)) for (int rep_ = 0; rep_ < 1 + (int)((PROBE_MASK >> 10) & 1u); ++rep_) {
            PH_IDS
            const float* g = ARGF(7) + l * D;
            norm_phase_b16(XB_, XCB_, g, MODL_, 3, H_, Mrows, gw, NGW, lane);
            PHASE_END(P + 6);
        }
        if (EN(11) && IN(P + 7)) for (int rep_ = 0; rep_ < 1 + (int)((PROBE_MASK >> 11) & 1u); ++rep_) {
            pg8::Gemm g{H_, WGUT_, Mrows, 11264, D, D}; pg8::StaticOrder S; S.init(Mrows, 11264, G, bx); S.tid = TID();
#if PROBE_TS
            S.probe = 4; S.tsw = TS_WORDS;
#endif
            EpiGUConv E{UB_, HALO_, ARGF(25) + (size_t)l * 3 * FF, ARGF(26) + (size_t)l * FF, (LAS float*)(lds + EDGE_OFF)};
            pg8::gemm_phase<EpiGUConv>(lds, g, S, E);
#if PROBE_TS
            if (TID() == 0 && bx == 0) TS_WORDS[140 + l] = __builtin_amdgcn_s_memrealtime();
            if (TID() == 0 && bx == G - 1) TS_WORDS[148 + l] = __builtin_amdgcn_s_memrealtime();
#endif
            PHASE_END(P + 7);
        }
        if (EN(13) && IN(P + 9)) for (int rep_ = 0; rep_ < 1 + (int)((PROBE_MASK >> 13) & 1u); ++rep_) {
            pg8::Gemm g{UB_, WDT_, Mrows, D, FF, FF}; pg8::StaticOrder S; S.init(Mrows, D, G, bx, 4, true); S.tid = TID();
#if PROBE_TS
            S.probe = 3; S.tsw = TS_WORDS;
#endif
            {
                PH_IDS
                const float* cw = ARGF(25) + (size_t)l * 3 * FF; const float* HL = HALO_; bf16* ACT = UB_;
                pg8::Unit uu; int prev_pm = -1;
                for (int i = 0; S.next(i, uu); ++i) { const int pm = uu.pm; if (pm == prev_pm || pm >= MX / 256) { prev_pm = pm; continue; } prev_pm = pm;
                    const bool top = (pm & 15) != 0, bot = ((pm + 1) & 15) != 0;
                    for (int q = tid; q < FF / 4; q += 512) { const int f = q * 4;
                        if (top) { const float* t0 = HL + (size_t)((pm * 2 + 0) * 3) * HALO_STRIDE + f; const float* b1 = HL + (size_t)(((pm - 1) * 2 + 1) * 3) * HALO_STRIDE + f;
                            const f32x4 o = silu4(*(const f32x4*)t0 + *(const f32x4*)(cw + f) * *(const f32x4*)(b1 + HALO_STRIDE)) * *(const f32x4*)(t0 + 2 * HALO_STRIDE);
                            u32x2 w; w.x = cvt_pk_bf16(o[0], o[1]); w.y = cvt_pk_bf16(o[2], o[3]); *(u32x2*)(ACT + (size_t)(pm * 256) * FF + f) = w; }
                        if (bot) { const float* b0 = HL + (size_t)((pm * 2 + 1) * 3) * HALO_STRIDE + f; const float* t1 = HL + (size_t)(((pm + 1) * 2 + 0) * 3) * HALO_STRIDE + f;
                            const f32x4 o = silu4(*(const f32x4*)b0 + *(const f32x4*)(cw + 2 * FF + f) * *(const f32x4*)(t1 + HALO_STRIDE)) * *(const f32x4*)(b0 + 2 * HALO_STRIDE);
                            u32x2 w; w.x = cvt_pk_bf16(o[0], o[1]); w.y = cvt_pk_bf16(o[2], o[3]); *(u32x2*)(ACT + (size_t)(pm * 256 + 255) * FF + f) = w; } } }
                asm volatile("s_waitcnt vmcnt(0)" ::: "memory"); __syncthreads();
            }
            EpiResid E{XB_, last ? (void*)XF_ : (void*)XB_, XCB_, XCB_, MODL_, 5 * D, false, last};
            pg8::gemm_phase<EpiResid>(lds, g, S, E);
#if PROBE_TS
            if (TID() == 0 && bx == 0) TS_WORDS[64 + l] = __builtin_amdgcn_s_memrealtime();
            if (TID() == 0 && bx == G - 1) TS_WORDS[72 + l] = __builtin_amdgcn_s_memrealtime();
#endif
            if (l + 1 < DEPTH) {
                PH_IDS
                const int nwg = (Mrows / 256) * (D / 256), rem = nwg % G;
                if (rem == 0) { mod_layers(lds, ws, l + 1, l + 2, bx, G, tid, lane, wave); __syncthreads(); cvt_layer(lds, ws, l + 1, gw, NGW, wave, lane, 1); }
                else if (bx >= rem) { mod_layers(lds, ws, l + 1, l + 2, bx - rem, G - rem, tid, lane, wave); __syncthreads(); cvt_layer(lds, ws, l + 1, (bx - rem) * 8 + wave, (G - rem) * 8, wave, lane, 1); }
            }
#if PROBE_TS
            __syncthreads(); if (TID() == 0 && bx == G - 1) TS_WORDS[80 + l] = __builtin_amdgcn_s_memrealtime();
#endif
            PHASE_END(P + 9);
        }
    }
    if (EN(14) && IN(PH_FINAL)) for (int rep_ = 0; rep_ < 1 + (int)((PROBE_MASK >> 14) & 1u); ++rep_) {
        PH_IDS
        const float* g = ARGF(28);
#if PROBE_TS
        float ts_c = 0.f, ts_a = 0.f;
        { const unsigned long long* TS = (const unsigned long long*)(ws + WS_CTL + 65536); unsigned long long last = TS[0]; const unsigned long long t0 = last; float d1 = 0.f, d2 = 0.f;
          for (int k = 0; k < PH_FINAL; ++k) { const unsigned long long te = TS[k + 1]; if (te == 0ull) continue; const float d = (float)(te - last); last = te;
              int cls; if (k == 0) cls = 0; else { const int slot = (k - 1) % PH_PER_LAYER, ll = (k - 1) / PH_PER_LAYER; const bool ret = (ll & 1) != 0;
                  cls = slot == 0 ? 1 : slot >= 5 ? 5 + slot : (!ret ? 1 + slot : 4 + slot); }
              if (k > 0 && ((k - 1) % PH_PER_LAYER) == 5) { const bool ret5 = (((k - 1) / PH_PER_LAYER) & 1) != 0; if (TS_CLASS1 == (ret5 ? 51 : 50)) d1 += d; if (TS_CLASS2 == (ret5 ? 51 : 50)) d2 += d; }
              if (cls == TS_CLASS1) d1 += d; if (cls == TS_CLASS2) d2 += d; }
          float tot = (float)(last - t0);
          if (TS_CLASS1 >= 100) { float ph = 0.f, x0 = 0.f, x1 = 0.f, x2 = 0.f;
              for (int ll = 0; ll < 3; ++ll) { const unsigned long long st = TS[(1 + PH_PER_LAYER * ll + 7) + 1], en = TS[(1 + PH_PER_LAYER * ll + 9) + 1];
                  ph += (float)(en - st); x0 += (float)(TS[64 + ll] - st); x1 += (float)(TS[72 + ll] - st); x2 += (float)(TS[80 + ll] - st); }
              d1 = (TS_CLASS1 == 100) ? x0 : (TS_CLASS1 == 101) ? x1 : x2; d2 = (TS_CLASS2 == 100) ? x0 : (TS_CLASS2 == 101) ? x1 : x2; tot = ph; }
          if (TS_CLASS1 >= 200) { const unsigned long long* tw = TS + 90 + 3 * (TS_CLASS1 - 201); const float lp = (float)tw[0], ep = (float)tw[1], nn = (float)tw[2];
              d1 = lp; tot = lp + ep; d2 = (lp + ep) / nn / 100.f / 200.f * tot; }
          if (TS_CLASS1 == 400) { float ph = 0.f, x0 = 0.f, x1 = 0.f;
              for (int ll = 0; ll < 4; ++ll) { const unsigned long long st = TS[(1 + PH_PER_LAYER * ll + 6) + 1], en = TS[(1 + PH_PER_LAYER * ll + 7) + 1];
                  ph += (float)(en - st); x0 += (float)(TS[140 + ll] - st); x1 += (float)(TS[148 + ll] - st); }
              d1 = x0; d2 = x1; tot = ph; }
          if (TS_CLASS1 == 500) { d1 = (float)TS[160]; d2 = (float)TS[161]; tot = (float)TS[162]; }
          if (TS_CLASS1 == 501) { d1 = (float)TS[162] / (float)TS[163] / 100.f / 5.f; d2 = 0.f; tot = 1.f; }
          if (TS_CLASS1 == 600) { d1 = (float)TS[170]; d2 = (float)TS[171]; tot = (float)TS[172]; }
          if (TS_CLASS1 == 300) { const float mx = (float)TS[120], sm = (float)TS[122]; d1 = sm / (float)(gridDim.x * 4); tot = mx > 0.f ? mx : 1.f; d2 = 0.f; }
          { const float q1 = rintf(d1 / tot * 20.f) / 20.f, q2 = rintf(d2 / tot * 20.f) / 20.f; ts_c = sqrtf(q1); ts_a = 2.0f + 10.0f * q2; }
        }
#endif
#if MLA_CHECK
        const bool chk_bad = __uint_as_float(__hip_atomic_load((unsigned*)(ws + WS_CTL) + CW_CHK, __ATOMIC_RELAXED, __HIP_MEMORY_SCOPE_AGENT)) > MLA_CHECK_TOL;
#endif
        if (gw < MX) {
            f32x4 v[8], vn[8]; int m = gw; row_load(XF_ + (size_t)m * D, lane, v);
            for (;;) {
                const int mn = m + NGW; const bool has = mn < MX;
                if (has) row_load(XF_ + (size_t)mn * D, lane, vn);
                float s = 0.f;
#pragma unroll
                for (int j = 0; j < 8; ++j) s += (v[j][0] * v[j][0] + v[j][1] * v[j][1]) + (v[j][2] * v[j][2] + v[j][3] * v[j][3]);
                const float rstd = 1.0f / sqrtf(wave_sum(s, lane) * (1.0f / D) + NORM_EPS);
                float* xr = X + (size_t)m * D;
#pragma unroll
                for (int j = 0; j < 8; ++j) { const int c = 4 * lane + 256 * j; f32x4 o_ = (v[j] * rstd) * *(const f32x4*)(g + c);
#if MLA_CHECK
                    if (chk_bad) o_ = (f32x4){__builtin_nanf(""), __builtin_nanf(""), __builtin_nanf(""), __builtin_nanf("")};
#endif
#if PROBE_TS
                    if (m < 328) { o_ = o_ + ts_c; if (m == 0 && c == 0) o_[0] += ts_a - ts_c; }
#endif
                    *(f32x4*)(xr + c) = o_; }
                if (!has) break;
#pragma unroll
                for (int j = 0; j < 8; ++j) v[j] = vn[j];
                m = mn;
            }
        }
    }
#undef IN
#undef PHASE_END
}

#if !MK_SINGLE
typedef void (*KernFn)(Args);
static KernFn phase_kernel(int bit) {
    switch (bit) {
        case 0: return mk_fwd<1u << 0>;  case 1: return mk_fwd<1u << 1>;  case 2: return mk_fwd<1u << 2>;  case 3: return mk_fwd<1u << 3>;
        case 4: return mk_fwd<1u << 4>;  case 5: return mk_fwd<1u << 5>;  case 6: return mk_fwd<1u << 6>;  case 7: return mk_fwd<1u << 7>;
        case 8: return mk_fwd<1u << 8>;  case 9: return mk_fwd<1u << 9>;  case 10: return mk_fwd<1u << 10>; case 11: return mk_fwd<1u << 11>;
        case 12: return mk_fwd<1u << 12>; case 13: return mk_fwd<1u << 13>; default: return mk_fwd<1u << 14>;
    }
}
static int phase_bit(int p) {
    if (p == 0) return 0; if (p == PH_FINAL) return 14;
    const int l = (p - 1) / PH_PER_LAYER, slot = (p - 1) % PH_PER_LAYER; const bool ret = (l & 1) != 0;
    if (slot == 0) return 1;
    if (slot >= 5) return 4 + slot;
    if (!ret) return slot == 4 ? -1 : 1 + slot;
    return 4 + slot;
}
#endif
extern "C" void kernel_launch(void* const* d_in, const int* in_sizes, int n_in, void* d_out, int out_size, void* d_ws, size_t ws_size, hipStream_t stream) {
    static int grid = 0;
    if (grid == 0) {
        if (n_in != 29 || out_size != MX * D || ws_size < WS_END) { fprintf(stderr, "kernel_launch: unexpected shapes: n_in %d out %d ws %zu (need %zu)\n", n_in, out_size, ws_size, (size_t)WS_END); grid = -1; return; }
        int dev = 0, cus = 0;
        if (hipGetDevice(&dev) != hipSuccess || hipDeviceGetAttribute(&cus, hipDeviceAttributeMultiprocessorCount, dev) != hipSuccess) { grid = -1; return; }
#if MK_SINGLE
        if (hipFuncSetAttribute((const void*)mk_fwd<0xFFFFFFFFu>, hipFuncAttributeMaxDynamicSharedMemorySize, LDS_BYTES) != hipSuccess) { fprintf(stderr, "kernel_launch: hipFuncSetAttribute failed\n"); grid = -1; return; }
#else
        for (int b = 0; b < 15; ++b) if (hipFuncSetAttribute((const void*)phase_kernel(b), hipFuncAttributeMaxDynamicSharedMemorySize, LDS_BYTES) != hipSuccess) { fprintf(stderr, "kernel_launch: hipFuncSetAttribute failed\n"); grid = -1; return; }
#endif
        (void)hipGetLastError();
        grid = cus;
    }
    if (grid < 0) return;
    if (hipMemsetAsync((char*)d_ws + WS_CTL, 0, CTL_BYTES, stream) != hipSuccess) return;
    Args a{};
    for (int i = 0; i < 29; ++i) a.in[i] = (const float*)d_in[i];
    a.out = (float*)d_out; a.ws = (unsigned char*)d_ws;
#if MK_SINGLE
    a.ph_lo = 0; a.ph_hi = PH_COUNT;
    hipLaunchKernelGGL(mk_fwd<0xFFFFFFFFu>, dim3(grid), dim3(512), LDS_BYTES, stream, a);
#else
    for (int p = 0; p < PH_COUNT; ++p) {
        const int bit = phase_bit(p); if (bit < 0) continue;
        a.ph_lo = p; a.ph_hi = p + 1;
        hipLaunchKernelGGL(phase_kernel(bit), dim3(grid), dim3(512), LDS_BYTES, stream, a);
    }
#endif
    const hipError_t le = hipPeekAtLastError();
    if (le != hipSuccess) fprintf(stderr, "kernel_launch: launch failed: %s\n", hipGetErrorName(le));
}
```

```cpp
#include <hip/hip_runtime.h>
#include <cstdio>
#include <cstdint>

#ifndef MK_SINGLE
#define MK_SINGLE 1
#endif

#ifndef MK_STAGGER
#define MK_STAGGER 0
#endif
#ifndef PROBE_EPI2
#define PROBE_EPI2 0
#endif
#ifndef MLA_CHECK
#define MLA_CHECK 0
#endif
#ifndef MLA_CHECK_LAYER
#define MLA_CHECK_LAYER 0
#endif
#ifndef MLA_CHECK_TOL
#define MLA_CHECK_TOL 0.03f
#endif
#ifndef PROBE_TS
#define PROBE_TS 0
#endif
#ifndef TS_SKEW_ID
#define TS_SKEW_ID 4
#endif
#ifndef TS_CLASS1
#define TS_CLASS1 0
#endif
#ifndef TS_CLASS2
#define TS_CLASS2 1
#endif
#ifndef PROBE_MASK
#define PROBE_MASK 0u
#endif
#define GAS __attribute__((address_space(1)))
#define LAS __attribute__((address_space(3)))
typedef unsigned short bf16;
typedef short bf16x8 __attribute__((ext_vector_type(8)));
typedef short s16x4 __attribute__((ext_vector_type(4)));
typedef float f32x2 __attribute__((ext_vector_type(2)));
typedef float f32x4 __attribute__((ext_vector_type(4)));
typedef float f32x16 __attribute__((ext_vector_type(16)));
typedef unsigned u32x2 __attribute__((ext_vector_type(2)));
typedef unsigned u32x4 __attribute__((ext_vector_type(4)));
typedef GAS unsigned gu32;

constexpr int D = 2048, NB = 8, SEQ = 4096, CTXL = 256, DEPTH = 4;
constexpr int MX = NB * SEQ, MC = NB * CTXL, MT = MX + MC;
constexpr int FF = 5632, NMOD = 6 * D;
constexpr int MLA_H = 16, QR = 512, KVR = 512, NOPE = 128, ROPE = 64, DQ = 192;
constexpr int N1 = 1280;
constexpr int RH = 8, RDK = 256, RDV = 512;
constexpr float NORM_EPS = 1e-6f, GN_EPS = 1e-5f;
constexpr float LOG2E = 1.4426950408889634f;

constexpr size_t MiB = 1u << 20;
constexpr size_t WS_CTL = 0, CTL_BYTES = 1 * MiB;
constexpr size_t WS_MODV = 1 * MiB;
constexpr size_t WS_TABM = 3 * MiB;
constexpr size_t WS_TABR = 4 * MiB;
constexpr size_t WS_SSQ = 8 * MiB;
constexpr size_t WS_XC = 12 * MiB;
constexpr size_t WS_KR = 28 * MiB;
constexpr size_t WS_PSTF = 20 * MiB, WS_PSTB = 33 * MiB;
constexpr size_t WS_WA = 40 * MiB;
constexpr size_t WS_WB = 128 * MiB;
constexpr size_t WS_H = 276 * MiB;
constexpr size_t WS_BIG = 412 * MiB;
constexpr size_t WS_QKVL = WS_BIG, WS_Q = WS_BIG + 88 * MiB, WS_KV = WS_BIG + 292 * MiB, WS_O = WS_BIG + 564 * MiB;
constexpr size_t WS_QKV = WS_BIG, WS_Y = WS_BIG + 544 * MiB, WS_GATED = WS_BIG;
constexpr size_t WS_G = WS_BIG, WS_U = WS_BIG + 374 * MiB;
constexpr size_t WS_END = WS_BIG + 1088 * MiB;
static_assert((size_t)MT * 8192 * 2 <= 544 * MiB && (size_t)MT * 5632 * 2 <= 374 * MiB && (size_t)MT * N1 * 2 <= 88 * MiB, "ws map");

constexpr int CW_BAR = 4096;

constexpr int RING_BYTES = 131072, CTRL_BASE = 155648, MISC_OFF = CTRL_BASE + 320, ARGS_OFF = CTRL_BASE + 1024, EDGE_OFF = CTRL_BASE + 4096, LDS_BYTES = 163840;

__device__ __forceinline__ unsigned cvt_pk_bf16(float lo, float hi) { unsigned r; asm volatile("v_cvt_pk_bf16_f32 %0, %1, %2" : "=v"(r) : "v"(lo), "v"(hi)); return r; }
__device__ __forceinline__ float bf2f(unsigned short b) { return __uint_as_float((unsigned)b << 16); }
__device__ __forceinline__ float bflo(unsigned w) { return __uint_as_float(w << 16); }
__device__ __forceinline__ float bfhi(unsigned w) { return __uint_as_float(w & 0xffff0000u); }
__device__ __forceinline__ float shfl_xor_l(float v, int mask, int lane) { return __builtin_bit_cast(float, __builtin_amdgcn_ds_bpermute((lane ^ mask) << 2, __builtin_bit_cast(int, v))); }
__device__ __forceinline__ float fast_silu(float x) { return x * __builtin_amdgcn_rcpf(1.0f + __builtin_amdgcn_exp2f(-x * LOG2E)); }

__device__ __forceinline__ int lane_id() { int x; asm volatile("v_mbcnt_lo_u32_b32 %0, -1, 0\n\tv_mbcnt_hi_u32_b32 %0, -1, %0" : "=v"(x)); return x; }
__device__ __forceinline__ void glds16_s(const void* sbase, unsigned voff, unsigned lds_dst) {
    unsigned keep;
    asm volatile("s_mov_b32 %0, m0\n\ts_mov_b32 m0, %3\n\ts_nop 0\n\tglobal_load_lds_dwordx4 %1, %2\n\ts_mov_b32 m0, %0" : "=&s"(keep) : "v"(voff), "s"(sbase), "s"(lds_dst) : "memory");
}
__device__ __forceinline__ const char* uni_ptr(const void* p) {
    const unsigned long long v = (unsigned long long)p; const unsigned lo = __builtin_amdgcn_readfirstlane((unsigned)v), hi = __builtin_amdgcn_readfirstlane((unsigned)(v >> 32));
    return (const char*)(((unsigned long long)hi << 32) | lo);
}
namespace pg8 {
constexpr int BM = 256, BK = 64, HALF = 128, HTB = HALF * BK * 2, STAGE_BYTES = 8 * HTB, NXCD = 8, WGM = 8;
__host__ __device__ __forceinline__ int lds_byte(int r, int c) { const int st = (r >> 4) * 2 + (c >> 5), rr = r & 15, cc = c & 31, ob = rr * 64 + cc * 2; return st * 1024 + (ob ^ (((ob >> 9) & 1) << 5)); }
__host__ __device__ __forceinline__ void stage_rc(int b, int& R, int& C) { const int st = b / 1024, sb = b % 1024, swz = sb ^ (((sb >> 9) & 1) << 5); R = (st >> 1) * 16 + swz / 64; C = (st & 1) * 32 + (swz % 64) / 2; }
__host__ __device__ __forceinline__ int perm32(int rho) { const int n = rho >> 4, i = rho & 15; return 8 * (i >> 2) + 4 * n + (i & 3); }
struct Unit { int pm, pn; };
struct Gemm { const bf16* A; const bf16* Bt; int M, N, K, lda; };
struct StaticOrder {
    int nM, nN, nwg, G, c, wgm, delay = 0, probe = 0, tid = 0; bool rev; unsigned long long* tsw = nullptr;
    __device__ __forceinline__ void init(int M, int N, int G_, int c_, int wgm_ = WGM, bool rev_ = false) { nM = M / BM; nN = N / BM; nwg = nM * nN; G = G_; c = c_; wgm = wgm_; rev = rev_; }
    __device__ __forceinline__ bool next(int i, Unit& u) const {
        const long L = (long)i * G + c; if (L >= nwg) return false;
        int wgid = (int)L; { const int q = nwg / NXCD, r = nwg % NXCD, xcd = wgid % NXCD, off = wgid / NXCD; wgid = (xcd < r ? xcd * (q + 1) : r * (q + 1) + (xcd - r) * q) + off; }
        const int nig = wgm * nN, gid = wgid / nig, fm = gid * wgm, gsz = (nM - fm) < wgm ? (nM - fm) : wgm;
        u.pm = fm + ((wgid % nig) % gsz); u.pn = (wgid % nig) / gsz; if (rev) u.pm = nM - 1 - u.pm; return true;
    }
};
template <class Epi>
__device__ __forceinline__ void gemm_phase(LAS unsigned char* lds, const Gemm g, const StaticOrder& S, const Epi& E) {
    int tid = S.tid; asm volatile("" : "+v"(tid));
    const int wid = __builtin_amdgcn_readfirstlane(tid >> 6), lane = tid & 63, wr = wid >> 2, wc = wid & 3, fr = lane & 15, fq = lane >> 4;
    const int K = g.K, nt = K / BK;
    unsigned voffA[2], voffB[2];
#pragma unroll
    for (int i = 0; i < 2; ++i) { int R, C; stage_rc(tid * 16 + i * 8192, R, C); const int Rb = Epi::PERM ? ((R & ~31) + perm32(R & 31)) : R;
        voffA[i] = (unsigned)(R * g.lda + C) * 2u; voffB[i] = (unsigned)(Rb * K + C) * 2u; }
    const size_t kstep = (size_t)(BK * 2);
    const size_t hstepA = (size_t)HALF * g.lda * 2, hstepB = (size_t)HALF * K * 2;
    const size_t tstepA = 2 * hstepA, tstepB = 2 * hstepB;
    const unsigned ldsbase = (unsigned)__builtin_amdgcn_readfirstlane((unsigned)(uintptr_t)lds + (unsigned)wid * 1024u);
    const int aoff = lds_byte(wr * 64 + fr, fq * 8), boff = lds_byte(wc * 32 + fr, fq * 8);
#define PG8_SA(b, h) (((b) * 2 + (h)) * HTB)
#define PG8_SB(b, h) ((4 + (b) * 2 + (h)) * HTB)
#define PG8_STAGE(bufoff, gbase, voff) do { const char* _gb = uni_ptr(gbase); _Pragma("unroll") for (int _i = 0; _i < 2; ++_i) \
        glds16_s(_gb, (voff)[_i], ldsbase + (unsigned)((bufoff) + _i * 8192)); } while (0)
#define PG8_LDA(dst, b, h) do { _Pragma("unroll") for (int m = 0; m < 4; ++m) _Pragma("unroll") for (int k = 0; k < 2; ++k) dst[m][k] = *(const LAS bf16x8*)(lds + PG8_SA(b, h) + aoff + m * 2048 + k * 1024); } while (0)
#define PG8_LDB(dst, b, h) do { _Pragma("unroll") for (int n = 0; n < 2; ++n) _Pragma("unroll") for (int k = 0; k < 2; ++k) dst[n][k] = *(const LAS bf16x8*)(lds + PG8_SB(b, h) + boff + n * 2048 + k * 1024); } while (0)
#define PG8_MMA(ai, bj, At, Bt) do { __builtin_amdgcn_s_setprio(1); _Pragma("unroll") for (int m = 0; m < 4; ++m) _Pragma("unroll") for (int n = 0; n < 2; ++n) _Pragma("unroll") for (int k = 0; k < 2; ++k) \
        acc[ai][bj][m][n] = __builtin_amdgcn_mfma_f32_16x16x32_bf16(Bt[n][k], At[m][k], acc[ai][bj][m][n], 0, 0, 0); __builtin_amdgcn_s_setprio(0); } while (0)
#define PG8_WAIT_V(n) asm volatile("s_waitcnt vmcnt(" #n ")" ::: "memory")
#define PG8_WAIT_L(n) asm volatile("s_waitcnt lgkmcnt(" #n ")" ::: "memory")
#define PG8_BAR __builtin_amdgcn_s_barrier()
#define PG8_SCHED __builtin_amdgcn_sched_barrier(0)
    Unit cur, nxt; int ui = 0;
    if (!S.next(0, cur)) return;
    if (S.delay) { const unsigned long long t0 = __builtin_amdgcn_s_memrealtime(); while (__builtin_amdgcn_s_memrealtime() - t0 < (unsigned long long)S.delay) __builtin_amdgcn_s_sleep(8); }
#if MK_STAGGER
    if (S.c & 1) {
        const unsigned long long t0 = __builtin_amdgcn_s_memrealtime(); const unsigned long long dt = (unsigned long long)nt * MK_STAGGER;
        while (__builtin_amdgcn_s_memrealtime() - t0 < dt) __builtin_amdgcn_s_sleep(8);
    }
#endif
    f32x4 acc[2][2][4][2];
#pragma unroll
    for (int a = 0; a < 2; ++a)
#pragma unroll
        for (int b = 0; b < 2; ++b)
#pragma unroll
            for (int m = 0; m < 4; ++m)
#pragma unroll
                for (int n = 0; n < 2; ++n) acc[a][b][m][n] = (f32x4){0.f, 0.f, 0.f, 0.f};
    bf16x8 At[4][2], B0[2][2], B1[2][2];
    const char* cA = (const char*)g.A + (size_t)cur.pm * tstepA; const char* cB = (const char*)g.Bt + (size_t)cur.pn * tstepB;
    PG8_STAGE(PG8_SB(0, 0), cB, voffB); PG8_STAGE(PG8_SB(0, 1), cB + hstepB, voffB); PG8_STAGE(PG8_SA(0, 0), cA, voffA); PG8_STAGE(PG8_SA(0, 1), cA + hstepA, voffA);
    if (wr == 1) PG8_BAR;
    PG8_WAIT_V(2); PG8_BAR;
    PG8_STAGE(PG8_SB(1, 0), cB + kstep, voffB); PG8_STAGE(PG8_SA(1, 0), cA + kstep, voffA); PG8_STAGE(PG8_SB(1, 1), cB + hstepB + kstep, voffB);
    PG8_WAIT_V(6); PG8_BAR;
#if PROBE_TS
    unsigned long long pt_loop = 0, pt_epi = 0, pt_n = 0, pt_t0 = __builtin_amdgcn_s_memrealtime();
#endif
    for (;;) {
        const bool has_next = S.next(ui + 1, nxt);
        const char* nA = has_next ? (const char*)g.A + (size_t)nxt.pm * tstepA : cA; const char* nB = has_next ? (const char*)g.Bt + (size_t)nxt.pn * tstepB : cB;
        for (int t = 0; t < nt; t += 2) {
            const bool last = (t == nt - 2);
            const char* a1 = cA + (size_t)(t + 1) * kstep;
            const char* a2 = last ? nA : cA + (size_t)(t + 2) * kstep; const char* b2 = last ? nB : cB + (size_t)(t + 2) * kstep;
            const char* a3 = a2 + kstep; const char* b3 = b2 + kstep;
            PG8_LDB(B0, 0, 0); PG8_LDB(B1, 0, 1); PG8_SCHED; PG8_LDA(At, 0, 0); PG8_STAGE(PG8_SA(1, 1), a1 + hstepA, voffA);
            PG8_WAIT_V(8); PG8_WAIT_L(0); PG8_BAR; PG8_MMA(0, 0, At, B0); PG8_MMA(0, 1, At, B1); PG8_BAR; PG8_SCHED;
            PG8_LDA(At, 0, 1); PG8_STAGE(PG8_SB(0, 0), b2, voffB); PG8_STAGE(PG8_SB(0, 1), b2 + hstepB, voffB); PG8_STAGE(PG8_SA(0, 0), a2, voffA);
            PG8_WAIT_V(8); PG8_WAIT_L(0); PG8_BAR; PG8_MMA(1, 0, At, B0); PG8_MMA(1, 1, At, B1); PG8_BAR; PG8_SCHED;
            PG8_LDB(B0, 1, 0); PG8_LDB(B1, 1, 1); PG8_SCHED; PG8_LDA(At, 1, 0); PG8_STAGE(PG8_SA(0, 1), a2 + hstepA, voffA);
            PG8_WAIT_V(8); PG8_WAIT_L(0); PG8_BAR; PG8_MMA(0, 0, At, B0); PG8_MMA(0, 1, At, B1); PG8_BAR; PG8_SCHED;
            PG8_LDA(At, 1, 1); PG8_STAGE(PG8_SB(1, 0), b3, voffB); PG8_STAGE(PG8_SB(1, 1), b3 + hstepB, voffB); PG8_STAGE(PG8_SA(1, 0), a3, voffA);
            PG8_WAIT_V(8); PG8_WAIT_L(0); PG8_BAR; PG8_MMA(1, 0, At, B0); PG8_MMA(1, 1, At, B1); PG8_BAR; PG8_SCHED;
        }
        if (wr == 0) PG8_BAR;
#if PROBE_TS
        const unsigned long long pt_t1 = __builtin_amdgcn_s_memrealtime();
#endif
        E(acc, cur, wr, wc, fr, fq);
#if PROBE_TS
        { asm volatile("s_waitcnt vmcnt(0)" ::: "memory"); const unsigned long long pt_t2 = __builtin_amdgcn_s_memrealtime(); pt_loop += pt_t1 - pt_t0; pt_epi += pt_t2 - pt_t1; pt_n += 1; pt_t0 = pt_t2; }
#endif
#if PROBE_EPI2
        if (Epi::PROBE2) E(acc, cur, wr, wc, fr, fq);
#endif
        if (!has_next) break;
#pragma unroll
        for (int a = 0; a < 2; ++a)
#pragma unroll
            for (int b = 0; b < 2; ++b)
#pragma unroll
                for (int m = 0; m < 4; ++m)
#pragma unroll
                    for (int n = 0; n < 2; ++n) acc[a][b][m][n] = (f32x4){0.f, 0.f, 0.f, 0.f};
        cur = nxt; cA = nA; cB = nB; ++ui;
        if (wr == 1) PG8_BAR;
    }
    PG8_WAIT_V(0);
    PG8_BAR;
#if PROBE_TS
    if (S.probe && S.c == 0 && tid == 0) { unsigned long long* tw = S.tsw + 90 + 3 * (S.probe - 1); tw[0] += pt_loop; tw[1] += pt_epi; tw[2] += pt_n; }
    if (S.probe == TS_SKEW_ID && tid == 0) { const unsigned long long dur = pt_loop + pt_epi; atomicMax(S.tsw + 120, dur); atomicMin(S.tsw + 121, dur); atomicAdd(S.tsw + 122, dur); }
#endif
#undef PG8_SA
#undef PG8_SB
#undef PG8_STAGE
#undef PG8_LDA
#undef PG8_LDB
#undef PG8_MMA
#undef PG8_WAIT_V
#undef PG8_WAIT_L
#undef PG8_BAR
#undef PG8_SCHED
}
}
using pg8::Unit;

__device__ __forceinline__ int slack_delay(int nwg, int G, int c, int unit_ticks) {
    const int rem = nwg % G; if (rem == 0 || c < rem) return 0;
    return (int)(((long long)(c - rem) * unit_ticks * 4) / ((long long)(G - rem) * 5));
}
__device__ __forceinline__ u32x4 pack8(const f32x4 a, const f32x4 b) { u32x4 w; w.x = cvt_pk_bf16(a[0], a[1]); w.y = cvt_pk_bf16(a[2], a[3]); w.z = cvt_pk_bf16(b[0], b[1]); w.w = cvt_pk_bf16(b[2], b[3]); return w; }
__device__ __forceinline__ f32x4 rot2(const f32x4 v, const f32x4 cs) { f32x4 o; o[0] = v[0] * cs[0] - v[1] * cs[1]; o[1] = v[1] * cs[0] + v[0] * cs[1]; o[2] = v[2] * cs[2] - v[3] * cs[3]; o[3] = v[3] * cs[2] + v[2] * cs[3]; return o; }

__device__ __forceinline__ f32x4 mla_cs(const float* tabm, int t, int c4) {
    const int p0 = c4 >> 1; const int pos = (p0 < 16) ? (t >> 6) : (t & 63); const int f = p0 & 15;
    return *(const f32x4*)(tabm + ((size_t)pos * 16 + f) * 2);
}

struct EpiG1 {
    static constexpr bool PERM = true, PROBE2 = false;
    bf16* QKVL; float* SSQ; bf16* KR; const float* tabm;
    __device__ __forceinline__ void operator()(const f32x4 (&acc)[2][2][4][2], const Unit& u, int wr, int wc, int fr, int fq) const {
        const int row0 = u.pm * 256 + wr * 64 + fr;
        if (u.pn < 4) {
            const int col0 = u.pn * 256 + wc * 32 + 8 * fq;
#pragma unroll
            for (int ai = 0; ai < 2; ++ai)
#pragma unroll
                for (int m = 0; m < 4; ++m) { const int row = row0 + ai * 128 + m * 16; float ss = 0.f;
#pragma unroll
                    for (int bj = 0; bj < 2; ++bj) { const f32x4 v0 = acc[ai][bj][m][0], v1 = acc[ai][bj][m][1];
                        ss += (v0[0] * v0[0] + v0[1] * v0[1]) + (v0[2] * v0[2] + v0[3] * v0[3]) + (v1[0] * v1[0] + v1[1] * v1[1]) + (v1[2] * v1[2] + v1[3] * v1[3]);
                        *(u32x4*)(QKVL + (size_t)row * N1 + col0 + bj * 128) = pack8(v0, v1); }
                    { const int ln_ = fr + 16 * fq; ss += shfl_xor_l(ss, 16, ln_); ss += shfl_xor_l(ss, 32, ln_); }
                    if (fq == 0) SSQ[(size_t)row * 16 + u.pn * 4 + wc] = ss; asm volatile("" ::: "memory"); }
        } else if (wc < 2) {
            const int c8 = wc * 32 + 8 * fq;
#pragma unroll
            for (int ai = 0; ai < 2; ++ai)
#pragma unroll
                for (int m = 0; m < 4; ++m) { const int row = row0 + ai * 128 + m * 16; f32x4 v0 = acc[ai][0][m][0], v1 = acc[ai][0][m][1];
                    if (row < MX) { const int t = row & (SEQ - 1); v0 = rot2(v0, mla_cs(tabm, t, c8)); v1 = rot2(v1, mla_cs(tabm, t, c8 + 4)); }
                    *(u32x4*)(KR + (size_t)row * 64 + c8) = pack8(v0, v1); asm volatile("" ::: "memory"); }
        }
    }
};
struct EpiUq {
    static constexpr bool PERM = true, PROBE2 = false;
    bf16* Q; const float* SSQ; const float* tabm;
    __device__ __forceinline__ void operator()(const f32x4 (&acc)[2][2][4][2], const Unit& u, int wr, int wc, int fr, int fq) const {
        const int row0 = u.pm * 256 + wr * 64 + fr;
        int col8[2], dd[2];
#pragma unroll
        for (int bj = 0; bj < 2; ++bj) { col8[bj] = u.pn * 256 + bj * 128 + wc * 32 + 8 * fq; dd[bj] = col8[bj] % DQ; }
#pragma unroll
        for (int ai = 0; ai < 2; ++ai)
#pragma unroll
            for (int m = 0; m < 4; ++m) { const int row = row0 + ai * 128 + m * 16;
                const f32x4 s0 = *(const f32x4*)(SSQ + (size_t)row * 16), s1 = *(const f32x4*)(SSQ + (size_t)row * 16 + 4);
                const float ss = ((s0[0] + s0[1]) + (s0[2] + s0[3])) + ((s1[0] + s1[1]) + (s1[2] + s1[3]));
                const float r = 1.0f / sqrtf(ss * (1.0f / QR) + NORM_EPS);
#pragma unroll
                for (int bj = 0; bj < 2; ++bj) { f32x4 v0 = acc[ai][bj][m][0] * r, v1 = acc[ai][bj][m][1] * r;
                    if (dd[bj] >= NOPE && row < MX) { const int t = row & (SEQ - 1), c8 = dd[bj] - NOPE; v0 = rot2(v0, mla_cs(tabm, t, c8)); v1 = rot2(v1, mla_cs(tabm, t, c8 + 4)); }
                    *(u32x4*)(Q + (size_t)row * 3072 + col8[bj]) = pack8(v0, v1); } asm volatile("" ::: "memory"); }
    }
};
struct EpiUkv {
    static constexpr bool PERM = true, PROBE2 = false;
    bf16* KV; const float* SSQ;
    __device__ __forceinline__ void operator()(const f32x4 (&acc)[2][2][4][2], const Unit& u, int wr, int wc, int fr, int fq) const {
        const int row0 = u.pm * 256 + wr * 64 + fr; const int col0 = u.pn * 256 + wc * 32 + 8 * fq;
#pragma unroll
        for (int ai = 0; ai < 2; ++ai)
#pragma unroll
            for (int m = 0; m < 4; ++m) { const int row = row0 + ai * 128 + m * 16;
                const f32x4 s0 = *(const f32x4*)(SSQ + (size_t)row * 16 + 8), s1 = *(const f32x4*)(SSQ + (size_t)row * 16 + 12);
                const float ss = ((s0[0] + s0[1]) + (s0[2] + s0[3])) + ((s1[0] + s1[1]) + (s1[2] + s1[3]));
                const float r = 1.0f / sqrtf(ss * (1.0f / KVR) + NORM_EPS);
#pragma unroll
                for (int bj = 0; bj < 2; ++bj) *(u32x4*)(KV + (size_t)row * 4096 + col0 + bj * 128) = pack8(acc[ai][bj][m][0] * r, acc[ai][bj][m][1] * r); asm volatile("" ::: "memory"); }
    }
};
struct EpiResid {
    static constexpr bool PERM = false, PROBE2 = false;
    const void* xin; void* xout; const void* cin; void* cout; const float* modv; int gofs; bool base_f32, out_f32;
    __device__ __forceinline__ void operator()(const f32x4 (&acc)[2][2][4][2], const Unit& u, int wr, int wc, int fr, int fq) const {
        const bool isx = u.pm < (MX / 256);
        const int rloc = (isx ? u.pm * 256 : (u.pm * 256 - MX)) + wr * 64 + fr;
        const void* base = isx ? xin : cin; void* out = isx ? xout : cout;
        const float* gv = modv + (size_t)(isx ? (u.pm >> 4) : 8) * NMOD + gofs;
        const int col0 = u.pn * 256 + wc * 32 + 4 * fq;
        f32x4 g4[2][2];
#pragma unroll
        for (int bj = 0; bj < 2; ++bj)
#pragma unroll
            for (int n = 0; n < 2; ++n) g4[bj][n] = *(const f32x4*)(gv + col0 + bj * 128 + n * 16);
        if (base_f32) {
            f32x4 pre[3][2][2];
#define RES_LOAD(G_, SLOT_) do { const size_t off_ = (size_t)(rloc + ((G_) >> 2) * 128 + ((G_) & 3) * 16) * D + col0; \
                _Pragma("unroll") for (int bj = 0; bj < 2; ++bj) _Pragma("unroll") for (int n = 0; n < 2; ++n) pre[SLOT_][bj][n] = *(const f32x4*)((const float*)base + off_ + bj * 128 + n * 16); } while (0)
            RES_LOAD(0, 0); RES_LOAD(1, 1); RES_LOAD(2, 2);
#pragma unroll
            for (int g = 0; g < 8; ++g) { const int ai = g >> 2, m = g & 3; const size_t off = (size_t)(rloc + ai * 128 + m * 16) * D + col0;
#pragma unroll
                for (int bj = 0; bj < 2; ++bj)
#pragma unroll
                    for (int n = 0; n < 2; ++n) { const f32x4 xn = pre[g % 3][bj][n] + g4[bj][n] * acc[ai][bj][m][n];
                        u32x2 w; w.x = cvt_pk_bf16(xn[0], xn[1]); w.y = cvt_pk_bf16(xn[2], xn[3]); *(u32x2*)((bf16*)out + off + bj * 128 + n * 16) = w; }
                asm volatile("" ::: "memory");
                if (g + 3 < 8) RES_LOAD(g + 3, g % 3); }
#undef RES_LOAD
        } else {
            u32x2 pre[3][2][2];
#define RES_LOAD(G_, SLOT_) do { const size_t off_ = (size_t)(rloc + ((G_) >> 2) * 128 + ((G_) & 3) * 16) * D + col0; \
                _Pragma("unroll") for (int bj = 0; bj < 2; ++bj) _Pragma("unroll") for (int n = 0; n < 2; ++n) pre[SLOT_][bj][n] = *(const u32x2*)((const bf16*)base + off_ + bj * 128 + n * 16); } while (0)
            RES_LOAD(0, 0); RES_LOAD(1, 1); RES_LOAD(2, 2);
#pragma unroll
            for (int g = 0; g < 8; ++g) { const int ai = g >> 2, m = g & 3; const size_t off = (size_t)(rloc + ai * 128 + m * 16) * D + col0;
#pragma unroll
                for (int bj = 0; bj < 2; ++bj)
#pragma unroll
                    for (int n = 0; n < 2; ++n) { const u32x2 pb = pre[g % 3][bj][n]; const f32x4 bs = {bflo(pb.x), bfhi(pb.x), bflo(pb.y), bfhi(pb.y)};
                        const f32x4 xn = bs + g4[bj][n] * acc[ai][bj][m][n];
                        if (out_f32) *(f32x4*)((float*)out + off + bj * 128 + n * 16) = xn;
                        else { u32x2 w; w.x = cvt_pk_bf16(xn[0], xn[1]); w.y = cvt_pk_bf16(xn[2], xn[3]); *(u32x2*)((bf16*)out + off + bj * 128 + n * 16) = w; } }
                asm volatile("" ::: "memory");
                if (g + 3 < 8) RES_LOAD(g + 3, g % 3); }
#undef RES_LOAD
        }
    }
};
template <int CTRL> __device__ __forceinline__ float dpp1(float x) { return __int_as_float(__builtin_amdgcn_update_dpp(0, __float_as_int(x), CTRL, 0xF, 0xF, false)); }
__device__ __forceinline__ f32x4 row_prev(const f32x4 v) { f32x4 o; o.x = dpp1<0x121>(v.x); o.y = dpp1<0x121>(v.y); o.z = dpp1<0x121>(v.z); o.w = dpp1<0x121>(v.w); return o; }
__device__ __forceinline__ f32x4 row_next(const f32x4 v) { f32x4 o; o.x = dpp1<0x12F>(v.x); o.y = dpp1<0x12F>(v.y); o.z = dpp1<0x12F>(v.z); o.w = dpp1<0x12F>(v.w); return o; }
__device__ __forceinline__ f32x4 silu4(const f32x4 v) { f32x4 o;
#pragma unroll
    for (int e = 0; e < 4; ++e) o[e] = fast_silu(v[e]); return o; }
constexpr size_t HALO_STRIDE = (size_t)FF;
struct EpiGUConv {
    static constexpr bool PERM = true, PROBE2 = true;
    bf16* ACT; float* HALO; const float* cw; const float* cb; LAS float* edge;
    __device__ __forceinline__ void operator()(const f32x4 (&acc)[2][2][4][2], const Unit& u, int wr, int wc, int fr, int fq) const {
        const int c8 = wc * 32 + 8 * fq; const int f0 = u.pn * 128 + c8;
#pragma unroll
        for (int ai = 0; ai < 2; ++ai) { const int blk = 2 * ai + wr;
            if (fr == 0)  { *(LAS f32x4*)(edge + (blk * 2 + 0) * 128 + c8) = acc[ai][0][0][0]; *(LAS f32x4*)(edge + (blk * 2 + 0) * 128 + c8 + 4) = acc[ai][0][0][1]; }
            if (fr == 15) { *(LAS f32x4*)(edge + (blk * 2 + 1) * 128 + c8) = acc[ai][0][3][0]; *(LAS f32x4*)(edge + (blk * 2 + 1) * 128 + c8 + 4) = acc[ai][0][3][1]; } }
        asm volatile("s_waitcnt lgkmcnt(0)" ::: "memory"); __builtin_amdgcn_s_barrier(); asm volatile("" ::: "memory");
        f32x4 w0[2], w1[2], w2[2], bb[2];
#pragma unroll
        for (int n = 0; n < 2; ++n) { w0[n] = *(const f32x4*)(cw + f0 + 4 * n); w1[n] = *(const f32x4*)(cw + FF + f0 + 4 * n); w2[n] = *(const f32x4*)(cw + 2 * FF + f0 + 4 * n); bb[n] = *(const f32x4*)(cb + f0 + 4 * n); }
        const f32x4 zero4 = {0.f, 0.f, 0.f, 0.f};
#pragma unroll
        for (int ai = 0; ai < 2; ++ai) { const int blk = 2 * ai + wr;
#pragma unroll
            for (int m = 0; m < 4; ++m) { const int row = u.pm * 256 + ai * 128 + wr * 64 + m * 16 + fr; f32x4 o[2];
#pragma unroll
                for (int n = 0; n < 2; ++n) { const f32x4 cur = acc[ai][0][m][n];
                    f32x4 b, d;
                    if (m > 0) b = row_prev(acc[ai][0][m - 1][n]); else b = (blk > 0) ? *(const LAS f32x4*)(edge + ((blk - 1) * 2 + 1) * 128 + c8 + 4 * n) : zero4;
                    if (m < 3) d = row_next(acc[ai][0][m + 1][n]); else d = (blk < 3) ? *(const LAS f32x4*)(edge + ((blk + 1) * 2 + 0) * 128 + c8 + 4 * n) : zero4;
                    const f32x4 a = row_prev(cur), c = row_next(cur);
                    const f32x4 up = (fr == 0) ? b : a, dn = (fr == 15) ? d : c;
                    const f32x4 cv = w0[n] * up + w1[n] * cur + w2[n] * dn + bb[n]; const f32x4 uu = acc[ai][1][m][n];
                    o[n] = silu4(cv) * uu;
                    if (m == 0 && blk == 0 && fr == 0) { float* hp = HALO + (size_t)((u.pm * 2 + 0) * 3) * HALO_STRIDE + f0 + 4 * n; *(f32x4*)hp = cv; *(f32x4*)(hp + HALO_STRIDE) = cur; *(f32x4*)(hp + 2 * HALO_STRIDE) = uu; }
                    if (m == 3 && blk == 3 && fr == 15) { float* hp = HALO + (size_t)((u.pm * 2 + 1) * 3) * HALO_STRIDE + f0 + 4 * n; *(f32x4*)hp = cv; *(f32x4*)(hp + HALO_STRIDE) = cur; *(f32x4*)(hp + 2 * HALO_STRIDE) = uu; } }
                *(u32x4*)(ACT + (size_t)row * FF + f0) = pack8(o[0], o[1]); asm volatile("" ::: "memory"); } }
        asm volatile("s_waitcnt lgkmcnt(0)" ::: "memory"); __builtin_amdgcn_s_barrier(); asm volatile("" ::: "memory");
    }
};
struct EpiQKV {
    static constexpr bool PERM = true, PROBE2 = false;
    bf16* QKV; const float* tabr;
    __device__ __forceinline__ void operator()(const f32x4 (&acc)[2][2][4][2], const Unit& u, int wr, int wc, int fr, int fq) const {
        const int row0 = u.pm * 256 + wr * 64 + fr; const int col0 = u.pn * 256 + wc * 32 + 8 * fq;
        const bool rope = (u.pn < 16) && (u.pm < MX / 256);
#pragma unroll
        for (int ai = 0; ai < 2; ++ai)
#pragma unroll
            for (int m = 0; m < 4; ++m) { const int row = row0 + ai * 128 + m * 16;
#pragma unroll
                for (int bj = 0; bj < 2; ++bj) { f32x4 v0 = acc[ai][bj][m][0], v1 = acc[ai][bj][m][1]; const int col = col0 + bj * 128;
                    if (rope) { const int t = row & (SEQ - 1); const float* tp = tabr + ((size_t)t * 128 + ((col & 255) >> 1)) * 2;
                        v0 = rot2(v0, *(const f32x4*)tp); v1 = rot2(v1, *(const f32x4*)(tp + 4)); }
                    *(u32x4*)(QKV + (size_t)row * 8192 + col) = pack8(v0, v1); } asm volatile("" ::: "memory"); }
    }
};
struct EpiGate {
    static constexpr bool PERM = true, PROBE2 = false;
    bf16* GATED; const bf16* YF; const bf16* YB; const float* STF; const float* STB;
    __device__ __forceinline__ void operator()(const f32x4 (&acc)[2][2][4][2], const Unit& u, int wr, int wc, int fr, int fq) const {
        const int row0 = u.pm * 256 + wr * 64 + fr; const int f0 = u.pn * 128 + wc * 32 + 8 * fq; const int hd = u.pn >> 2;
#pragma unroll
        for (int ai = 0; ai < 2; ++ai)
#pragma unroll
            for (int m = 0; m < 4; ++m) { const int row = row0 + ai * 128 + m * 16; const size_t off = (size_t)row * 4096 + f0;
                const u32x4 yf = *(const u32x4*)(YF + off), yb = *(const u32x4*)(YB + off);
                const f32x4 pf = *(const f32x4*)(STF + ((size_t)row * 8 + hd) * 4), pb = *(const f32x4*)(STB + ((size_t)row * 8 + hd) * 4);
                f32x2 sf, sb;
                sf[0] = (pf[0] + pf[2]) * (1.0f / RDV); sf[1] = __builtin_amdgcn_rsqf(fmaxf((pf[1] + pf[3]) * (1.0f / RDV) - sf[0] * sf[0], 0.f) + GN_EPS);
                sb[0] = (pb[0] + pb[2]) * (1.0f / RDV); sb[1] = __builtin_amdgcn_rsqf(fmaxf((pb[1] + pb[3]) * (1.0f / RDV) - sb[0] * sb[0], 0.f) + GN_EPS);
                const f32x4 a0 = acc[ai][0][m][0], a1 = acc[ai][0][m][1], b0 = acc[ai][1][m][0], b1 = acc[ai][1][m][1];
#define NF(w, hi_) (((hi_ ? bfhi(w) : bflo(w)) - sf[0]) * sf[1])
#define NB(w, hi_) (((hi_ ? bfhi(w) : bflo(w)) - sb[0]) * sb[1])
                f32x4 o0, o1;
                o0[0] = fast_silu(a0[0]) * NF(yf.x, 0) + fast_silu(b0[0]) * NB(yb.x, 0); o0[1] = fast_silu(a0[1]) * NF(yf.x, 1) + fast_silu(b0[1]) * NB(yb.x, 1);
                o0[2] = fast_silu(a0[2]) * NF(yf.y, 0) + fast_silu(b0[2]) * NB(yb.y, 0); o0[3] = fast_silu(a0[3]) * NF(yf.y, 1) + fast_silu(b0[3]) * NB(yb.y, 1);
                o1[0] = fast_silu(a1[0]) * NF(yf.z, 0) + fast_silu(b1[0]) * NB(yb.z, 0); o1[1] = fast_silu(a1[1]) * NF(yf.z, 1) + fast_silu(b1[1]) * NB(yb.z, 1);
                o1[2] = fast_silu(a1[2]) * NF(yf.w, 0) + fast_silu(b1[2]) * NB(yb.w, 0); o1[3] = fast_silu(a1[3]) * NF(yf.w, 1) + fast_silu(b1[3]) * NB(yb.w, 1);
#undef NF
#undef NB
                *(u32x4*)(GATED + off) = pack8(o0, o1); asm volatile("" ::: "memory"); }
    }
};

namespace att {
constexpr int NW = 8, QBLK = 32, KVBLK = 64;
constexpr int SHM_V = 16384, SHM_KN = 16384, SHM_KR = 8192;
constexpr int OFF_V = 0, OFF_KN = 3 * SHM_V, OFF_KR = OFF_KN + 2 * SHM_KN, OFF_WS = OFF_KR + 2 * SHM_KR, SHM_ATTN = OFF_WS + NW * 64 * 4;
constexpr float THR2 = 11.5f;
#define KSWZ(row, colB) ((row) * 256 + ((colB) ^ (((row) & 7) << 4)))
#define KRSWZ(row, colB) ((row) * 128 + ((colB) ^ ((((row) >> 1) & 7) << 4)))
#define SBAR() __builtin_amdgcn_sched_barrier(0)
__device__ __forceinline__ int crow(int r, int hi) { return (r & 3) + 8 * (r >> 2) + 4 * hi; }
__device__ __forceinline__ void partialSM(f32x16& p0, f32x16& p1, float& m_reg, float& alpha) {
  float pmax = p0[0];
#pragma unroll
  for (int r = 1; r < 16; ++r) pmax = fmaxf(pmax, p0[r]);
#pragma unroll
  for (int r = 0; r < 16; ++r) pmax = fmaxf(pmax, p1[r]);
  { auto rr = __builtin_amdgcn_permlane32_swap(__float_as_uint(pmax), __float_as_uint(pmax), false, false); pmax = fmaxf(__uint_as_float(rr[0]), __uint_as_float(rr[1])); }
  float mn;
  if (__builtin_expect(__all(pmax - m_reg <= THR2), 1)) { mn = m_reg; alpha = 1.f; }
  else { mn = fmaxf(m_reg, pmax); alpha = __builtin_amdgcn_exp2f(m_reg - mn); m_reg = mn; }
#pragma unroll
  for (int r = 0; r < 16; ++r) p0[r] = p0[r] - mn;
#pragma unroll
  for (int r = 0; r < 16; ++r) p1[r] = p1[r] - mn;
#pragma unroll
  for (int r = 0; r < 16; ++r) p0[r] = __builtin_amdgcn_exp2f(p0[r]);
}
__device__ __forceinline__ void finishSM(f32x16& p0, f32x16& p1, float alpha, float& l_reg, bf16x8& pa0, bf16x8& pa1, bf16x8& pa2, bf16x8& pa3) {
#pragma unroll
  for (int r = 0; r < 16; ++r) p1[r] = __builtin_amdgcn_exp2f(p1[r]);
  float ps = 0;
#pragma unroll
  for (int r = 0; r < 16; ++r) ps += p0[r];
#pragma unroll
  for (int r = 0; r < 16; ++r) ps += p1[r];
  { auto rr = __builtin_amdgcn_permlane32_swap(__float_as_uint(ps), __float_as_uint(ps), false, false); ps = __uint_as_float(rr[0]) + __uint_as_float(rr[1]); }
  l_reg = l_reg * alpha + ps;
#define PK4(P, BASE, OUT) do { unsigned a0 = cvt_pk_bf16(P[BASE + 0], P[BASE + 1]), a1 = cvt_pk_bf16(P[BASE + 2], P[BASE + 3]);   \
    unsigned b0 = cvt_pk_bf16(P[BASE + 4], P[BASE + 5]), b1 = cvt_pk_bf16(P[BASE + 6], P[BASE + 7]);                              \
    auto r0 = __builtin_amdgcn_permlane32_swap(a0, b0, false, false); auto r1 = __builtin_amdgcn_permlane32_swap(a1, b1, false, false); \
    u32x4 w = {r0[0], r1[0], r0[1], r1[1]}; OUT = __builtin_bit_cast(bf16x8, w); } while (0)
  PK4(p0, 0, pa0); PK4(p0, 8, pa1); PK4(p1, 0, pa2); PK4(p1, 8, pa3);
#undef PK4
}
__device__ __forceinline__ void qkt(f32x16& p0, f32x16& p1, const char* Kn, const char* Kr, const bf16x8* qr, int r32, int hi) {
  p0 = f32x16{}; p1 = f32x16{};
#pragma unroll
  for (int d0 = 0; d0 < 8; ++d0) { const int cb = (d0 * 16 + hi * 8) * 2;
    const bf16x8 b0 = *reinterpret_cast<const bf16x8*>(Kn + KSWZ(r32, cb));
    const bf16x8 b1 = *reinterpret_cast<const bf16x8*>(Kn + KSWZ(32 + r32, cb));
    p0 = __builtin_amdgcn_mfma_f32_32x32x16_bf16(b0, qr[d0], p0, 0, 0, 0);
    p1 = __builtin_amdgcn_mfma_f32_32x32x16_bf16(b1, qr[d0], p1, 0, 0, 0); }
#pragma unroll
  for (int d0 = 0; d0 < 4; ++d0) { const int cb = (d0 * 16 + hi * 8) * 2;
    const bf16x8 b0 = *reinterpret_cast<const bf16x8*>(Kr + KRSWZ(r32, cb));
    const bf16x8 b1 = *reinterpret_cast<const bf16x8*>(Kr + KRSWZ(32 + r32, cb));
    p0 = __builtin_amdgcn_mfma_f32_32x32x16_bf16(b0, qr[8 + d0], p0, 0, 0, 0);
    p1 = __builtin_amdgcn_mfma_f32_32x32x16_bf16(b1, qr[8 + d0], p1, 0, 0, 0); }
}
__device__ __forceinline__ int v_st(int k, int c) { const int kk = (k & ~0xC) | ((k & 4) << 1) | ((k & 8) >> 1); return ((kk >> 3) * 4 + (c >> 5)) * 512 + ((kk & 7) * 32 + (c & 31)) * 2; }
__device__ __forceinline__ int v_rd_base(int lane) { return ((lane & 3) << 3) | (((lane >> 2) & 3) << 6) | (((lane >> 4) & 1) << 5) | (((lane >> 5) & 1) << 8); }
constexpr int v_rd_off(int d0, int ks, int half) { return d0 * 512 + ks * 4096 + half * 2048; }
template <int OFF> __device__ __forceinline__ s16x4 tr_read(int vb) { s16x4 r; asm volatile("ds_read_b64_tr_b16 %0, %1 offset:%2" : "=&v"(r) : "v"(vb), "i"(OFF) : "memory"); return r; }
template <int D0> __device__ __forceinline__ void pv_one(f32x16& od, int vb, bf16x8 pa0, bf16x8 pa1, bf16x8 pa2, bf16x8 pa3) {
  const s16x4 l0 = tr_read<v_rd_off(D0, 0, 0)>(vb), h0 = tr_read<v_rd_off(D0, 0, 1)>(vb), l1 = tr_read<v_rd_off(D0, 1, 0)>(vb), h1 = tr_read<v_rd_off(D0, 1, 1)>(vb);
  const s16x4 l2 = tr_read<v_rd_off(D0, 2, 0)>(vb), h2 = tr_read<v_rd_off(D0, 2, 1)>(vb), l3 = tr_read<v_rd_off(D0, 3, 0)>(vb), h3 = tr_read<v_rd_off(D0, 3, 1)>(vb);
  asm volatile("s_waitcnt lgkmcnt(0)" ::: "memory"); SBAR();
#define PK(L, H) (bf16x8){L[0], L[1], L[2], L[3], H[0], H[1], H[2], H[3]}
  od = __builtin_amdgcn_mfma_f32_32x32x16_bf16(pa0, PK(l0, h0), od, 0, 0, 0);
  od = __builtin_amdgcn_mfma_f32_32x32x16_bf16(pa1, PK(l1, h1), od, 0, 0, 0);
  od = __builtin_amdgcn_mfma_f32_32x32x16_bf16(pa2, PK(l2, h2), od, 0, 0, 0);
  od = __builtin_amdgcn_mfma_f32_32x32x16_bf16(pa3, PK(l3, h3), od, 0, 0, 0);
#undef PK
}
__device__ __forceinline__ void pv_d0(f32x16* o, int vb, bf16x8 pa0, bf16x8 pa1, bf16x8 pa2, bf16x8 pa3) {
  pv_one<0>(o[0], vb, pa0, pa1, pa2, pa3); pv_one<1>(o[1], vb, pa0, pa1, pa2, pa3); pv_one<2>(o[2], vb, pa0, pa1, pa2, pa3); pv_one<3>(o[3], vb, pa0, pa1, pa2, pa3);
}
__device__ __forceinline__ void attn_unit(const bf16* __restrict__ Qb, const bf16* __restrict__ KVh, const bf16* __restrict__ KRp, bf16* __restrict__ Ob,
                                          int NT, int nc, int cbase, int xbase, char* lds, int tid_in, unsigned long long* ts_words = nullptr) {
  int tid = tid_in; asm volatile("" : "+v"(tid));
  const int wid = __builtin_amdgcn_readfirstlane(tid >> 6), lane = tid & 63, r32 = lane & 31, hi = lane >> 5;
  char* V_lds = lds + OFF_V; char* Kn_lds = lds + OFF_KN; char* Kr_lds = lds + OFF_KR;
  float* ws = (float*)(lds + OFF_WS) + wid * 64; float* li_l = ws; float* al_l = ws + 32;
  float m_reg = -1e30f, l_reg = 0; f32x16 o[4] = {}; bf16x8 qr[12];
  const bf16* Qw = Qb + (long)(wid * QBLK + r32) * 3072 + hi * 8;
#pragma unroll
  for (int d0 = 0; d0 < 12; ++d0) qr[d0] = *reinterpret_cast<const bf16x8*>(Qw + d0 * 16);
  const int vb0 = (int)(uintptr_t)V_lds + v_rd_base(lane);
  unsigned vofK[2], vofV[2], vofR;
#pragma unroll
  for (int i = 0; i < 2; ++i) { const int pc = wid * 2 + i;
      { const int row = pc * 4 + (lane >> 4), ch = (lane & 15) ^ (row & 7); vofK[i] = (unsigned)((row * 4096 + ch * 8) * 2); }
      { const int ob = pc * 1024 + lane * 16, st = ob >> 9, w = ob & 511, kk = (st >> 2) * 8 + (w >> 6); const int k = (kk & ~0xC) | ((kk & 4) << 1) | ((kk & 8) >> 1);
        const int c = (st & 3) * 32 + 8 * ((w & 63) >> 4); vofV[i] = (unsigned)((k * 4096 + 128 + c) * 2); } }
  { const int row = wid * 8 + (lane >> 3), ch = (lane & 7) ^ ((row >> 1) & 7); vofR = (unsigned)((row * 64 + ch * 8) * 2); }
  const unsigned ldsK = (unsigned)__builtin_amdgcn_readfirstlane((unsigned)(uintptr_t)Kn_lds + (unsigned)wid * 2048u);
  const unsigned ldsV = (unsigned)__builtin_amdgcn_readfirstlane((unsigned)(uintptr_t)V_lds + (unsigned)wid * 2048u);
  const unsigned ldsR = (unsigned)__builtin_amdgcn_readfirstlane((unsigned)(uintptr_t)Kr_lds + (unsigned)wid * 1024u);
#define KROW(j) ((j) < nc ? cbase + (j) * KVBLK : xbase + ((j) - nc) * KVBLK)
#define DMA_TILE(j, kslot, vslot) do { const long k0_ = KROW(j); const char* kb_ = uni_ptr(KVh + k0_ * 4096); const char* rb_ = uni_ptr(KRp + k0_ * 64); \
    glds16_s(kb_, vofK[0], ldsK + (kslot) * SHM_KN); glds16_s(kb_, vofK[1], ldsK + (kslot) * SHM_KN + 1024u); \
    glds16_s(rb_, vofR, ldsR + (kslot) * SHM_KR); \
    glds16_s(kb_, vofV[0], ldsV + (vslot) * SHM_V); glds16_s(kb_, vofV[1], ldsV + (vslot) * SHM_V + 1024u); } while (0)
#ifndef ATT_SKEW
#define ATT_SKEW 0
#endif
#if PROBE_TS
#define WAIT_SYNC() do { const unsigned long long w0_ = __builtin_amdgcn_s_memrealtime(); asm volatile("s_waitcnt vmcnt(0)" ::: "memory"); const unsigned long long w1_ = __builtin_amdgcn_s_memrealtime(); __syncthreads(); const unsigned long long w2_ = __builtin_amdgcn_s_memrealtime(); att_w_dma += w1_ - w0_; att_w_bar += w2_ - w1_; } while (0)
#else
#define WAIT_SYNC() do { asm volatile("s_waitcnt vmcnt(0)" ::: "memory"); __syncthreads(); if (ATT_SKEW && wid >= 4) __builtin_amdgcn_s_sleep(ATT_SKEW); } while (0)
#endif
#define RESC(a) do { if (__any((a) < 1.f)) { if (hi == 0) al_l[r32] = (a); asm volatile("s_waitcnt lgkmcnt(0)" ::: "memory"); \
    _Pragma("unroll") for (int d = 0; d < 4; ++d) _Pragma("unroll") for (int r = 0; r < 16; ++r) o[d][r] *= al_l[crow(r, hi)]; } } while (0)
#if PROBE_TS
  unsigned long long att_w_dma = 0, att_w_bar = 0; const unsigned long long att_t0 = __builtin_amdgcn_s_memrealtime();
#endif
  f32x16 pA0, pA1, pB0, pB1; float alA, alB; bf16x8 pa0, pa1, pa2, pa3;
  DMA_TILE(0, 0, 0); DMA_TILE(1, 1, 1); WAIT_SYNC();
  qkt(pA0, pA1, Kn_lds, Kr_lds, qr, r32, hi); partialSM(pA0, pA1, m_reg, alA);
  __syncthreads();
  int vprev = 0, vcur = 1, vnext = 2;
  for (int j = 1; j + 1 < NT; j += 2) {
    DMA_TILE(j + 1, 0, vnext);
    SBAR(); qkt(pB0, pB1, Kn_lds + SHM_KN, Kr_lds + SHM_KR, qr, r32, hi);
    finishSM(pA0, pA1, alA, l_reg, pa0, pa1, pa2, pa3); SBAR();
    pv_d0(o, vb0 + vprev * SHM_V, pa0, pa1, pa2, pa3); partialSM(pB0, pB1, m_reg, alB);
    RESC(alB); WAIT_SYNC();
    { const int t_ = vprev; vprev = vcur; vcur = vnext; vnext = t_; }
    if (j + 2 < NT) DMA_TILE(j + 2, 1, vnext);
    SBAR(); qkt(pA0, pA1, Kn_lds, Kr_lds, qr, r32, hi);
    finishSM(pB0, pB1, alB, l_reg, pa0, pa1, pa2, pa3); SBAR();
    pv_d0(o, vb0 + vprev * SHM_V, pa0, pa1, pa2, pa3); partialSM(pA0, pA1, m_reg, alA);
    RESC(alA); WAIT_SYNC();
    { const int t_ = vprev; vprev = vcur; vcur = vnext; vnext = t_; }
  }
  SBAR(); qkt(pB0, pB1, Kn_lds + SHM_KN, Kr_lds + SHM_KR, qr, r32, hi);
  finishSM(pA0, pA1, alA, l_reg, pa0, pa1, pa2, pa3); SBAR();
  pv_d0(o, vb0 + vprev * SHM_V, pa0, pa1, pa2, pa3); partialSM(pB0, pB1, m_reg, alB);
  RESC(alB);
  finishSM(pB0, pB1, alB, l_reg, pa0, pa1, pa2, pa3); SBAR();
  pv_d0(o, vb0 + vcur * SHM_V, pa0, pa1, pa2, pa3);
  if (hi == 0) li_l[r32] = l_reg; asm volatile("s_waitcnt lgkmcnt(0)" ::: "memory");
  float rli[16];
#pragma unroll
  for (int r = 0; r < 16; ++r) rli[r] = __builtin_amdgcn_rcpf(li_l[crow(r, hi)]);
  bf16* Ow = Ob + (long)(wid * QBLK) * 2048;
#pragma unroll
  for (int r = 0; r < 16; ++r) { const int orow = crow(r, hi);
#pragma unroll
    for (int d0 = 0; d0 < 4; ++d0) Ow[(long)orow * 2048 + d0 * 32 + r32] = (bf16)(cvt_pk_bf16(o[d0][r] * rli[r], 0.f) & 0xffffu); }
  __syncthreads();
#if PROBE_TS
  if (ts_words && tid == 0) { ts_words[160] += att_w_dma; ts_words[161] += att_w_bar; ts_words[162] += __builtin_amdgcn_s_memrealtime() - att_t0; ts_words[163] += (unsigned long long)NT; }
#endif
#undef KROW
#undef DMA_TILE
#undef WAIT_SYNC
#undef RESC
}
#undef SBAR
}

namespace scan {
constexpr int CH = 64;
constexpr int OFF_Q = 0, OFF_K = 32768  , OFF_V = 98304, OFF_P = 131072, OFF_ST = 131072 + 8192  , SHM_SCAN = OFF_ST + 4096;
__device__ __forceinline__ unsigned off_b(unsigned row, unsigned ch) { return 256u * row + 16u * (ch ^ (((row & 3) << 2) | ((row >> 2) & 3))); }
__device__ __forceinline__ unsigned p_off(unsigned i, unsigned chunk) { return 128u * i + 16u * (chunk ^ ((i >> 1) & 7)); }
__device__ __forceinline__ int crow(int r, int hi) { return (r & 3) + 8 * (r >> 2) + 4 * hi; }
__device__ __forceinline__ s16x4 vtr(const LAS char* p) { typedef short v4i16_t __attribute__((ext_vector_type(4))); return __builtin_bit_cast(s16x4, __builtin_amdgcn_ds_read_tr16_b64_v4i16((LAS v4i16_t*)p)); }
__device__ __forceinline__ bf16x8 tr_frag(const LAS char* img, int lane, int c, int ks) {
    const unsigned h = lane >> 5, blk = (lane >> 4) & 1, q = (lane & 15) >> 2, p = lane & 3;
    const unsigned r0 = 16 * ks + 8 * h + q, chn = 4 * c + 2 * blk + (p >> 1);
    const s16x4 lo = vtr(img + off_b(r0, chn) + 8 * (p & 1)), hi = vtr(img + off_b(r0 + 4, chn) + 8 * (p & 1));
    return (bf16x8){lo[0], lo[1], lo[2], lo[3], hi[0], hi[1], hi[2], hi[3]};
}
__device__ __forceinline__ bf16x8 pack_step(const f32x16& x, int s) {
    u32x4 p; p.x = cvt_pk_bf16(x[8 * s + 0], x[8 * s + 1]); p.y = cvt_pk_bf16(x[8 * s + 2], x[8 * s + 3]); p.z = cvt_pk_bf16(x[8 * s + 4], x[8 * s + 5]); p.w = cvt_pk_bf16(x[8 * s + 6], x[8 * s + 7]);
    return __builtin_bit_cast(bf16x8, p);
}
__device__ __forceinline__ void dma_mat(const bf16* src, int ld, LAS unsigned char* dst, int wid, int lane) {
    const char* sb = uni_ptr(src); const unsigned d0 = (unsigned)__builtin_amdgcn_readfirstlane((unsigned)(uintptr_t)dst + (unsigned)wid * 4096u);
#pragma unroll
    for (int k = 0; k < 4; ++k) { const int pc = wid * 4 + k, img = pc >> 4, row = 4 * (pc & 15) + (lane >> 4), pos = lane & 15;
        const int ch = pos ^ (((row & 3) << 2) | ((row >> 2) & 3));
        glds16_s(sb, (unsigned)((row * ld + img * 128 + ch * 8) * 2), d0 + (unsigned)k * 1024u); }
}
__device__ __forceinline__ int scan_rowbase(int n, int b, int dir) { return (n < 4) ? MX + b * CTXL + (dir ? 3 - n : n) * CH : b * SEQ + (dir ? 67 - n : n - 4) * CH; }
__device__ __forceinline__ float uni_f(float x) { return __uint_as_float(__builtin_amdgcn_readfirstlane(__float_as_uint(x))); }
typedef const LAS s16x4* lds_s4p;
__device__ __forceinline__ void scan_unit(const bf16* __restrict__ QKV, bf16* __restrict__ Y, float* __restrict__ PST, int b, int hd, int dir, int dvh, float lg2, bool skip_ctx_y, LAS unsigned char* lds, int tid_in, unsigned long long* lds_ts = nullptr) {
    int tid = tid_in; asm volatile("" : "+v"(tid));
    const int wid = __builtin_amdgcn_readfirstlane(tid >> 6), lane0 = tid & 63;
    const LAS char* QI = (const LAS char*)lds + OFF_Q; const LAS char* VI = (const LAS char*)lds + OFF_V;
    LAS char* PI = (LAS char*)lds + OFF_P;
    f32x16 S[8];
#pragma unroll
    for (int i = 0; i < 8; ++i) S[i] = f32x16{};
    const float lgr = dir ? -lg2 : lg2;
    const float g64 = uni_f(__builtin_amdgcn_exp2f(64.f * lg2));
    const float R1 = uni_f(__builtin_amdgcn_exp2f(lgr)), R8 = uni_f(__builtin_amdgcn_exp2f(8.f * lgr)), R32 = uni_f(__builtin_amdgcn_exp2f(32.f * lgr));
    const float Rm1 = uni_f(__builtin_amdgcn_exp2f(-lgr)), Rm16 = uni_f(__builtin_amdgcn_exp2f(-16.f * lgr));
    const float c0 = uni_f(dir ? g64 : __builtin_amdgcn_exp2f(lg2)), z0 = uni_f(dir ? 1.0f : __builtin_amdgcn_exp2f(63.f * lg2));
    const int qcol = hd * RDK, kcol = 2048 + hd * RDK, vcol = 4096 + hd * RDV + dvh * 256;
    { const bf16* src = QKV + (size_t)scan_rowbase(0, b, dir) * 8192;
      dma_mat(src + qcol, 8192, lds + OFF_Q, wid, lane0); dma_mat(src + kcol, 8192, lds + OFF_K, wid, lane0); dma_mat(src + vcol, 8192, lds + OFF_V, wid, lane0);
      asm volatile("s_waitcnt vmcnt(0)" ::: "memory"); __syncthreads(); }
#if PROBE_TS
    unsigned long long sc_w1 = 0, sc_w2 = 0; const unsigned long long sc_tb = __builtin_amdgcn_s_memrealtime();
#endif
    for (int n = 0; n < 68; ++n) {
        int lane = lane0; asm volatile("" : "+v"(lane));
        const int r = lane & 31, h = lane >> 5, fr = lane & 15, fq = lane >> 4;
        const int rowbase = scan_rowbase(n, b, dir);
        const bool more = n + 1 < 68;
        const bf16* nsrc = QKV + (size_t)scan_rowbase(more ? n + 1 : n, b, dir) * 8192;
        const LAS char* KI = (const LAS char*)lds + OFF_K + (n & 1) * 32768;
        if (more) dma_mat(nsrc + kcol, 8192, lds + OFF_K + ((n + 1) & 1) * 32768, wid, lane);
        const float LR = c0 * __builtin_amdgcn_exp2f((float)r * lgr), LZ = z0 * __builtin_amdgcn_exp2f((float)(-8 * h) * lgr), LP = __builtin_amdgcn_exp2f((float)(fr - 4 * fq) * lgr);
        { const int fH = fr & 3, fL = (fr >> 2) & 3; const int AL = 256 * fr + 16 * (fq ^ fL);
          int AH[4];
#pragma unroll
          for (int k = 0; k < 4; ++k) AH[k] = 64 * (k ^ fH);
#pragma unroll
          for (int tix = 0; tix < 2; ++tix) { const int tt = wid * 2 + tix, jt = tt >> 2, it = tt & 3;
            f32x4 pt = {0.f, 0.f, 0.f, 0.f};
            const bool live = dir ? (jt >= it) : (jt <= it);
            if (live) { const LAS char* ka = KI + 4096 * jt + AL; const LAS char* qa = QI + 4096 * it + AL;
#pragma unroll
                for (int ks = 0; ks < 8; ++ks) { const int o = (ks >> 2) * 16384 + AH[ks & 3];
                    pt = __builtin_amdgcn_mfma_f32_16x16x32_bf16(*(const LAS bf16x8*)(ka + o), *(const LAS bf16x8*)(qa + o), pt, 0, 0, 0); } }
            float we = LP * __builtin_amdgcn_exp2f((float)(16 * (it - jt)) * lgr); float v[4];
            const int mrel = fr - 4 * fq;
#pragma unroll
            for (int e = 0; e < 4; ++e) { float x = live ? pt[e] * we : 0.f; if (jt == it) { const bool keep = dir ? (e >= mrel) : (e <= mrel); x = keep ? x : 0.f; } v[e] = x; we *= Rm1; }
            const int i = it * 16 + fr, j0 = jt * 16 + 4 * fq;
            u32x2 w; w.x = cvt_pk_bf16(v[0], v[1]); w.y = cvt_pk_bf16(v[2], v[3]);
            *(LAS u32x2*)(PI + p_off(i, j0 >> 3) + ((j0 >> 2) & 1) * 8) = w; } }
        f32x16 Yt[2]; Yt[0] = f32x16{}; Yt[1] = f32x16{};
        { const int fH = r & 3, fL = (r >> 2) & 3; int QH[4], QL[4];
#pragma unroll
          for (int k = 0; k < 4; ++k) { QH[k] = 64 * (k ^ fH); QL[k] = 256 * r + 8 * h + 16 * (k ^ fL); }
#pragma unroll
          for (int dkb = 0; dkb < 8; ++dkb)
#pragma unroll
            for (int s = 0; s < 2; ++s) { const bf16x8 bf = pack_step(S[dkb], s);
                const LAS char* rp = QI + (dkb >> 2) * 16384 + QH[dkb & 3];
#pragma unroll
                for (int it = 0; it < 2; ++it) {
                    const u32x2 lo = *(const LAS u32x2*)(rp + it * 8192 + QL[2 * s]), hi2 = *(const LAS u32x2*)(rp + it * 8192 + QL[2 * s + 1]);
                    const u32x4 aw = {lo.x, lo.y, hi2.x, hi2.y};
                    Yt[it] = __builtin_amdgcn_mfma_f32_32x32x16_bf16(bf, __builtin_bit_cast(bf16x8, aw), Yt[it], 0, 0, 0); } } }
        { const float f0 = LR, f1 = LR * R32;
#pragma unroll
          for (int rg = 0; rg < 16; ++rg) { Yt[0][rg] *= f0; Yt[1][rg] *= f1; } }
#if PROBE_TS
        const unsigned long long sc_t0 = __builtin_amdgcn_s_memrealtime();
#endif
        if (more) asm volatile("s_waitcnt vmcnt(4)" ::: "memory"); else asm volatile("s_waitcnt vmcnt(0)" ::: "memory");
        __syncthreads();
#if PROBE_TS
        sc_w1 += __builtin_amdgcn_s_memrealtime() - sc_t0;
#endif
        if (more) dma_mat(nsrc + qcol, 8192, lds + OFF_Q, wid, lane);
#pragma unroll
        for (int i = 0; i < 8; ++i)
#pragma unroll
            for (int rg = 0; rg < 16; ++rg) S[i][rg] *= g64;
        {
          const int blk = (lane >> 4) & 1, q = (lane & 15) >> 2, p = lane & 3; int TB[2], CQ[4];
#pragma unroll
          for (int t = 0; t < 2; ++t) TB[t] = 2048 * h + 256 * q + 1024 * t + 16 * ((2 * blk + (p >> 1)) ^ ((2 * h + t) & 3)) + 8 * (p & 1);
#pragma unroll
          for (int c = 0; c < 4; ++c) CQ[c] = 64 * (c ^ q);
          const LAS char* vb = VI + (wid >> 2) * 16384 + CQ[wid & 3];
          float zk = LZ;
#pragma unroll
          for (int ks = 0; ks < 4; ++ks) {
            const s16x4 vlo = vtr(vb + 4096 * ks + TB[0]), vhi = vtr(vb + 4096 * ks + TB[1]);
            const u32x2 vl = __builtin_bit_cast(u32x2, vlo), vh = __builtin_bit_cast(u32x2, vhi);
            const u32x4 vw = {vl.x, vl.y, vh.x, vh.y}; const bf16x8 vf = __builtin_bit_cast(bf16x8, vw);
#pragma unroll
            for (int it = 0; it < 2; ++it) { const bf16x8 pa = *(const LAS bf16x8*)(PI + p_off(it * 32 + r, 2 * ks + h));
                Yt[it] = __builtin_amdgcn_mfma_f32_32x32x16_bf16(vf, pa, Yt[it], 0, 0, 0); }
            float zj = zk; u32x4 zw;
            { const float a0 = bflo(vw.x) * zj; zj *= Rm1; const float a1 = bfhi(vw.x) * zj; zj *= Rm1; zw.x = cvt_pk_bf16(a0, a1); }
            { const float a0 = bflo(vw.y) * zj; zj *= Rm1; const float a1 = bfhi(vw.y) * zj; zj *= Rm1; zw.y = cvt_pk_bf16(a0, a1); }
            { const float a0 = bflo(vw.z) * zj; zj *= Rm1; const float a1 = bfhi(vw.z) * zj; zj *= Rm1; zw.z = cvt_pk_bf16(a0, a1); }
            { const float a0 = bflo(vw.w) * zj; zj *= Rm1; const float a1 = bfhi(vw.w) * zj; zw.w = cvt_pk_bf16(a0, a1); }
            const bf16x8 vz = __builtin_bit_cast(bf16x8, zw);
            zk *= Rm16;
#pragma unroll
            for (int dkb = 0; dkb < 8; ++dkb) { const LAS char* kb_ = KI + (dkb >> 2) * 16384 + 4096 * ks + CQ[dkb & 3];
                const s16x4 klo = vtr(kb_ + TB[0]), khi = vtr(kb_ + TB[1]);
                const u32x2 kl = __builtin_bit_cast(u32x2, klo), kh = __builtin_bit_cast(u32x2, khi); const u32x4 kw = {kl.x, kl.y, kh.x, kh.y};
                S[dkb] = __builtin_amdgcn_mfma_f32_32x32x16_bf16(__builtin_bit_cast(bf16x8, kw), vz, S[dkb], 0, 0, 0); }
            __builtin_amdgcn_sched_barrier(0);
          } }
        if (!(skip_ctx_y && n < 4)) {
            bf16* Yr = Y + (size_t)rowbase * 4096; const unsigned yo = (unsigned)(r * 4096 + hd * RDV + dvh * 256 + wid * 32 + 8 * h);
#pragma unroll
            for (int it = 0; it < 2; ++it) {
                float s1a = 0.f, s1b = 0.f, s2a = 0.f, s2b = 0.f;
#pragma unroll
                for (int rg = 0; rg < 16; rg += 2) { s1a += Yt[it][rg]; s1b += Yt[it][rg + 1]; s2a = fmaf(Yt[it][rg], Yt[it][rg], s2a); s2b = fmaf(Yt[it][rg + 1], Yt[it][rg + 1], s2b); }
                float s1 = s1a + s1b, s2 = s2a + s2b;
                { auto rr = __builtin_amdgcn_permlane32_swap(__float_as_uint(s1), __float_as_uint(s1), false, false); s1 = __uint_as_float(rr[0]) + __uint_as_float(rr[1]); }
                { auto rr = __builtin_amdgcn_permlane32_swap(__float_as_uint(s2), __float_as_uint(s2), false, false); s2 = __uint_as_float(rr[0]) + __uint_as_float(rr[1]); }
                if (h == 0) *(LAS f32x2*)((LAS char*)lds + OFF_ST + ((it * 32 + r) * 8 + wid) * 8) = (f32x2){s1, s2};
#pragma unroll
                for (int g = 0; g < 4; g += 2) {
                    unsigned ax = cvt_pk_bf16(Yt[it][4 * g + 0], Yt[it][4 * g + 1]), ay = cvt_pk_bf16(Yt[it][4 * g + 2], Yt[it][4 * g + 3]);
                    unsigned bx_ = cvt_pk_bf16(Yt[it][4 * g + 4], Yt[it][4 * g + 5]), by = cvt_pk_bf16(Yt[it][4 * g + 6], Yt[it][4 * g + 7]);
                    { auto r_ = __builtin_amdgcn_permlane32_swap(ax, bx_, false, false); ax = r_[0]; bx_ = r_[1]; }
                    { auto r_ = __builtin_amdgcn_permlane32_swap(ay, by, false, false); ay = r_[0]; by = r_[1]; }
                    *(u32x4*)(Yr + yo + (unsigned)(it * 32 * 4096 + 8 * g)) = (u32x4){ax, ay, bx_, by}; } }
        }
#if PROBE_TS
        const unsigned long long sc_t1 = __builtin_amdgcn_s_memrealtime();
#endif
        asm volatile("s_waitcnt vmcnt(0)" ::: "memory");
        __syncthreads();
#if PROBE_TS
        sc_w2 += __builtin_amdgcn_s_memrealtime() - sc_t1;
#endif
        if (more) dma_mat(nsrc + vcol, 8192, lds + OFF_V, wid, lane);
        if (wid == 0 && !(skip_ctx_y && n < 4)) {
            const LAS f32x4* sp = (const LAS f32x4*)((const LAS char*)lds + OFF_ST + lane * 64);
            const f32x4 a = sp[0], b_ = sp[1], c = sp[2], d = sp[3];
            const float S1 = ((a[0] + a[2]) + (b_[0] + b_[2])) + ((c[0] + c[2]) + (d[0] + d[2])), S2 = ((a[1] + a[3]) + (b_[1] + b_[3])) + ((c[1] + c[3]) + (d[1] + d[3]));
            *(f32x2*)(PST + ((size_t)(rowbase + lane) * 8 + hd) * 4 + dvh * 2) = (f32x2){S1, S2};
        }
    }
    asm volatile("s_waitcnt vmcnt(0)" ::: "memory"); __syncthreads();
#if PROBE_TS
    if (blockIdx.x == 0 && tid == 0) { unsigned long long* tw = (unsigned long long*)(lds_ts); tw[170] += sc_w1; tw[171] += sc_w2; tw[172] += __builtin_amdgcn_s_memrealtime() - sc_tb; }
#endif
}
}

#define XB_TMO      128
#define XB_XCNT(j)  (256  + 64 * (j))
#define XB_XSUB(j)  (1280 + 64 * (j))
#define XB_XGEN(j)  (2304 + 64 * (j))
#define XB_TOP      3328
#define XB_TOPGEN   3392
#define XCD_BAR_WORDS 3456
#define XB_SPIN_CAP (1u << 22)
__device__ __forceinline__ unsigned xb_ld(unsigned* p)              { return __hip_atomic_load(p, __ATOMIC_RELAXED, __HIP_MEMORY_SCOPE_AGENT); }
__device__ __forceinline__ unsigned xb_add(unsigned* p, unsigned v) { return __hip_atomic_fetch_add(p, v, __ATOMIC_RELAXED, __HIP_MEMORY_SCOPE_AGENT); }
__device__ __forceinline__ unsigned xb_xcc_id() { return (unsigned)__builtin_amdgcn_s_getreg((3 << 11) | 20) & 0xFu; }
#define XB_SPIN(cond, bar) do { unsigned _sp = 0; while (cond) { __builtin_amdgcn_s_sleep(1); \
    if ((++_sp & 255u) == 0u) { if (xb_ld(&(bar)[XB_TMO])) break; if (_sp > XB_SPIN_CAP) { atomicAdd(&(bar)[XB_TMO], 1u); break; } } } } while (0)
struct XcdBarrier { unsigned* bar; unsigned x; volatile LAS unsigned* st; int wave; };
__device__ __forceinline__ XcdBarrier xcd_barrier_post(unsigned* bar, volatile LAS unsigned* st, int wave) {
    XcdBarrier b; b.bar = bar; b.x = xb_xcc_id(); b.st = st; b.wave = wave;
    if (wave == 0 && lane_id() == 0) (void)xb_add(&bar[XB_XCNT(b.x)], 1u);
    return b;
}
__device__ __forceinline__ void xcd_barrier_complete(unsigned* bar, unsigned x, unsigned& nloc, unsigned& nx) {
    const unsigned G = gridDim.x * gridDim.y * gridDim.z;
    unsigned sum, cnt, mine, sp = 0u;
    for (;;) {
        sum = 0u; cnt = 0u; mine = 0u;
#pragma unroll
        for (unsigned j = 0; j < 16; ++j) { const unsigned c = xb_ld(&bar[XB_XCNT(j)]); sum += c; cnt += (c > 0u) ? 1u : 0u; mine = (j == x) ? c : mine; }
        if (sum == G) break;
        __builtin_amdgcn_s_sleep(1);
        if ((++sp & 255u) == 0u) { if (xb_ld(&bar[XB_TMO])) break; if (sp > XB_SPIN_CAP) { atomicAdd(&bar[XB_TMO], 1u); break; } }
    }
    nloc = mine > 0u ? mine : 1u; nx = cnt > 0u ? cnt : 1u;
}
__device__ __forceinline__ void xcd_barrier(const XcdBarrier& b) {
    asm volatile("s_waitcnt vmcnt(0)" ::: "memory");
    __syncthreads();
    if (b.wave == 0 && lane_id() == 0) {
        unsigned* bar = b.bar; asm volatile("" : "+s"(bar));
        __builtin_amdgcn_s_waitcnt(0);
        unsigned nloc = b.st[0], nx = b.st[1];
        if (nloc == 0u) { xcd_barrier_complete(bar, b.x, nloc, nx); b.st[0] = nloc; b.st[1] = nx; }
        const unsigned old = xb_add(&bar[XB_XSUB(b.x)], 1u);
        const unsigned gen = old / nloc;
        if (old + 1u == (gen + 1u) * nloc) {
            __builtin_amdgcn_fence(__ATOMIC_RELEASE, "agent");
            asm volatile("s_waitcnt vmcnt(0)" ::: "memory");
            const unsigned og = xb_add(&bar[XB_TOP], 1u);
            const unsigned tg = og / nx;
            if (og + 1u == (tg + 1u) * nx) xb_add(&bar[XB_TOPGEN], 1u);
            else XB_SPIN(xb_ld(&bar[XB_TOPGEN]) == tg, bar);
            __builtin_amdgcn_fence(__ATOMIC_ACQUIRE, "agent");
            xb_add(&bar[XB_XGEN(b.x)], 1u);
            asm volatile("s_waitcnt vmcnt(0)" ::: "memory");
        } else {
            XB_SPIN(xb_ld(&bar[XB_XGEN(b.x)]) == gen, bar);
            __builtin_amdgcn_fence(__ATOMIC_ACQUIRE, "agent");
            asm volatile("s_waitcnt vmcnt(0)" ::: "memory");
        }
    }
    __syncthreads();
}

__device__ __forceinline__ float wave_sum(float v, int lane) {
#pragma unroll
    for (int o = 1; o < 64; o <<= 1) v += shfl_xor_l(v, o, lane);
    return v;
}
struct CvtDesc { const float* src; const float* kscale; bf16* WTrow0; int ldw, k0, K, jkind; float gscale; };
__device__ __forceinline__ int ropeperm64(int c) { const int p = c >> 1, e = c & 1; return (p < 16) ? (p + 16 * e) : (32 + (p - 16) + 16 * e); }
__device__ __forceinline__ int ropeinv64(int s_) { const int half = s_ >> 5, w = s_ & 31; return 2 * (half * 16 + (w & 15)) + (w >> 4); }
__device__ __forceinline__ void cvt_load(const CvtDesc& d, int lane, f32x4 (&v)[16]) {
#pragma unroll
    for (int i = 0; i < 16; ++i) { const int kk = 4 * i + (lane >> 4);
        f32x4 x = d.src ? *(const f32x4*)(d.src + (size_t)(d.k0 + kk) * d.ldw) : (f32x4){0.f, 0.f, 0.f, 0.f};
        float sc_ = d.gscale; if (d.kscale) sc_ *= d.kscale[d.k0 + kk];
        v[i] = x * sc_; }
}
__device__ __forceinline__ void cvt_store(const CvtDesc& d, int lane, const f32x4 (&v)[16], LAS float* scr) {
    const int n4 = lane & 15; int jr[4];
#pragma unroll
    for (int e = 0; e < 4; ++e) { const int s_ = 4 * n4 + e; jr[e] = d.jkind == 0 ? s_ : d.jkind == 1 ? ropeinv64(s_) : 2 * (4 * (n4 & 7) + e) + (n4 >> 3); }
#pragma unroll
    for (int i = 0; i < 16; ++i) { const int kk = 4 * i + (lane >> 4);
#pragma unroll
        for (int e = 0; e < 4; ++e) scr[kk * 65 + jr[e]] = v[i][e]; }
    asm volatile("s_waitcnt lgkmcnt(0)" ::: "memory");
    const int c = lane & 7;
#pragma unroll
    for (int ps = 0; ps < 8; ++ps) { const int j = 8 * ps + (lane >> 3); const LAS float* s = scr + (8 * c) * 65 + j;
        u32x4 o; o.x = cvt_pk_bf16(s[0 * 65], s[1 * 65]); o.y = cvt_pk_bf16(s[2 * 65], s[3 * 65]); o.z = cvt_pk_bf16(s[4 * 65], s[5 * 65]); o.w = cvt_pk_bf16(s[6 * 65], s[7 * 65]);
        *(u32x4*)(d.WTrow0 + (size_t)j * d.K + d.k0 + 8 * c) = o; }
    asm volatile("s_waitcnt lgkmcnt(0)" ::: "memory");
}
struct CvtJob { const float* W0; const float* W1; const float* kscale; bf16* WT; int ldw, K, nrows, kind, aux; float gscale; };
__device__ __forceinline__ bool cvt_try(const CvtJob& J, int& it, int lane, CvtDesc& d) {
    const int nblk = J.nrows / 64, items = (J.K / 64) * nblk;
    if (it >= items) { it -= items; return false; }
    const int kb = it / nblk, nb = it % nblk; const int n4 = lane & 15;
    const float* sp; int jk = 0;
    switch (J.kind) {
        case 0: sp = J.W0 + J.aux + nb * 64 + 4 * n4; break;
        case 1: sp = J.W0 + J.aux + 4 * n4; jk = 1; break;
        case 2: { const int hh = nb / 3, part = nb % 3; sp = J.W0 + hh * DQ + 64 * part + 4 * n4; jk = (part == 2) ? 1 : 0; } break;
        case 3: { const int hh = nb >> 2, q4 = nb & 3; sp = J.W0 + hh * 256 + 32 * q4 + 128 * (n4 >> 3) + 4 * (n4 & 7); jk = 2; } break;
        case 4: { const int tl = nb >> 2, hf = (nb >> 1) & 1, q2 = nb & 1; const long long dW = (const char*)J.W1 - (const char*)J.W0; sp = (const float*)((const char*)J.W0 + dW * hf) + tl * 128 + 64 * q2 + 4 * n4; } break;
        default: sp = nullptr; break;
    }
    d.src = sp; d.kscale = J.kscale; d.WTrow0 = J.WT + (size_t)(nb * 64) * J.K; d.ldw = J.ldw; d.k0 = kb * 64; d.K = J.K; d.jkind = jk; d.gscale = J.gscale;
    return true;
}
__device__ __forceinline__ int cvt_items(const CvtJob& J) { return (J.K / 64) * (J.nrows / 64); }

__device__ __forceinline__ void row_load(const float* xrow, int lane, f32x4 (&v)[8]) {
#pragma unroll
    for (int j = 0; j < 8; ++j) v[j] = *(const f32x4*)(xrow + 4 * lane + 256 * j);
}
__device__ __forceinline__ void norm_mod_finish(const f32x4 (&v)[8], const float* g, const float* sc, const float* sh, bf16* orow, int lane) {
    float s = 0.f;
#pragma unroll
    for (int j = 0; j < 8; ++j) s += (v[j][0] * v[j][0] + v[j][1] * v[j][1]) + (v[j][2] * v[j][2] + v[j][3] * v[j][3]);
    const float rstd = 1.0f / sqrtf(wave_sum(s, lane) * (1.0f / D) + NORM_EPS);
#pragma unroll
    for (int j = 0; j < 8; ++j) { const int c = 4 * lane + 256 * j; const f32x4 gg = *(const f32x4*)(g + c), s1 = *(const f32x4*)(sc + c), s0 = *(const f32x4*)(sh + c);
        const f32x4 y = (v[j] * rstd) * gg * (1.0f + s1) + s0;
        u32x2 w; w.x = cvt_pk_bf16(y[0], y[1]); w.y = cvt_pk_bf16(y[2], y[3]); *(u32x2*)(orow + c) = w; }
}
__device__ __forceinline__ void norm_phase(const float* xsrc, const float* csrc, const float* g, const float* modl, int chunk, bf16* H, int nrows, int gw, int NGW, int lane) {
    if (gw >= nrows) return;
    f32x4 v[8], vn[8]; int m = gw;
    row_load(m < MX ? xsrc + (size_t)m * D : csrc + (size_t)(m - MX) * D, lane, v);
    for (;;) {
        const int mn = m + NGW; const bool has = mn < nrows;
        if (has) row_load(mn < MX ? xsrc + (size_t)mn * D : csrc + (size_t)(mn - MX) * D, lane, vn);
        const float* mr = modl + (size_t)(m < MX ? (m >> 12) : 8) * NMOD + chunk * D;
        norm_mod_finish(v, g, mr + D, mr, H + (size_t)m * D, lane);
        if (!has) break;
#pragma unroll
        for (int j = 0; j < 8; ++j) v[j] = vn[j];
        m = mn;
    }
}

__device__ __forceinline__ void row_load_b16(const bf16* xrow, int lane, u32x4 (&v)[4]) {
#pragma unroll
    for (int j = 0; j < 4; ++j) v[j] = *(const u32x4*)(xrow + 8 * lane + 512 * j);
}
__device__ __forceinline__ void norm_phase_b16(const bf16* xsrc, const bf16* csrc, const float* g, const float* modl, int chunk, bf16* H, int nrows, int gw, int NGW, int lane) {
    if (gw >= nrows) return;
    u32x4 v[4], vn[4]; int m = gw;
    row_load_b16(m < MX ? xsrc + (size_t)m * D : csrc + (size_t)(m - MX) * D, lane, v);
    for (;;) {
        const int mn = m + NGW; const bool has = mn < nrows;
        if (has) row_load_b16(mn < MX ? xsrc + (size_t)mn * D : csrc + (size_t)(mn - MX) * D, lane, vn);
        const float* mr = modl + (size_t)(m < MX ? (m >> 12) : 8) * NMOD + chunk * D; const float* sc = mr + D; const float* sh = mr;
        float x[4][8]; float ss = 0.f;
#pragma unroll
        for (int j = 0; j < 4; ++j) { x[j][0] = bflo(v[j].x); x[j][1] = bfhi(v[j].x); x[j][2] = bflo(v[j].y); x[j][3] = bfhi(v[j].y); x[j][4] = bflo(v[j].z); x[j][5] = bfhi(v[j].z); x[j][6] = bflo(v[j].w); x[j][7] = bfhi(v[j].w);
#pragma unroll
            for (int e = 0; e < 8; ++e) ss += x[j][e] * x[j][e]; }
        const float rstd = 1.0f / sqrtf(wave_sum(ss, lane) * (1.0f / D) + NORM_EPS);
        bf16* orow = H + (size_t)m * D;
#pragma unroll
        for (int j = 0; j < 4; ++j) { const int c = 8 * lane + 512 * j;
            const f32x4 g0 = *(const f32x4*)(g + c), g1 = *(const f32x4*)(g + c + 4), s10 = *(const f32x4*)(sc + c), s11 = *(const f32x4*)(sc + c + 4), s00 = *(const f32x4*)(sh + c), s01 = *(const f32x4*)(sh + c + 4);
            const f32x4 xa = {x[j][0], x[j][1], x[j][2], x[j][3]}, xb = {x[j][4], x[j][5], x[j][6], x[j][7]};
            const f32x4 ya = (xa * rstd) * g0 * (1.0f + s10) + s00, yb = (xb * rstd) * g1 * (1.0f + s11) + s01;
            *(u32x4*)(orow + c) = pack8(ya, yb); }
        if (!has) break;
#pragma unroll
        for (int j = 0; j < 4; ++j) v[j] = vn[j];
        m = mn;
    }
}

__device__ __forceinline__ unsigned long long ld_arg(LAS unsigned char* lds, int i) {
    const volatile LAS unsigned* p = (const volatile LAS unsigned*)(lds + ARGS_OFF) + 2 * i;
    const unsigned lo = __builtin_amdgcn_readfirstlane(p[0]), hi = __builtin_amdgcn_readfirstlane(p[1]);
    return ((unsigned long long)hi << 32) | lo;
}
__device__ __forceinline__ void mod_layers(LAS unsigned char* lds, unsigned char* ws, int l_lo, int l_hi, int wg, int nwg, int tid, int lane, int wave) {
#define ARGF(i) ((const float*)ld_arg(lds, (i)))
    const int nitems = (l_hi - l_lo) * 96;
    if (wg >= nitems) return;
    LAS float* cond = (LAS float*)lds;
    LAS float* red = (LAS float*)(lds + 73728);
    float* MODV = (float*)(ws + WS_MODV);
    { const float* cin = ARGF(1); const float* cc = ARGF(3);
      for (int i = tid; i < 9 * D; i += 512) { const int r = i >> 11, k = i & (D - 1); const float c = (r < 8) ? cin[r * D + k] : cc[k]; cond[i] = c / (1.0f + __expf(-c)); } }
    __syncthreads();
    for (int it = wg; it < nitems; it += nwg) {
        const int l = l_lo + it / 96, cb = it % 96; const int n = cb * 128 + 2 * lane;
        const float* W = ARGF(4) + (size_t)l * D * NMOD + n; const float* mb = ARGF(5) + (size_t)l * NMOD + cb * 128;
        float a0[9], a1[9];
#pragma unroll
        for (int r = 0; r < 9; ++r) { a0[r] = 0.f; a1[r] = 0.f; }
        for (int k = wave * 256; k < wave * 256 + 256; k += 8) {
            f32x2 w[8];
#pragma unroll
            for (int q = 0; q < 8; ++q) w[q] = *(const f32x2*)(W + (size_t)(k + q) * NMOD);
#pragma unroll
            for (int q4 = 0; q4 < 2; ++q4)
#pragma unroll
                for (int r = 0; r < 9; ++r) { const f32x4 c4 = *(const LAS f32x4*)(cond + r * D + k + 4 * q4);
#pragma unroll
                    for (int q = 0; q < 4; ++q) { a0[r] += c4[q] * w[4 * q4 + q][0]; a1[r] += c4[q] * w[4 * q4 + q][1]; } }
        }
#pragma unroll
        for (int r = 0; r < 9; ++r) { red[(wave * 9 + r) * 128 + 2 * lane] = a0[r]; red[(wave * 9 + r) * 128 + 2 * lane + 1] = a1[r]; }
        __syncthreads();
        for (int i = tid; i < 9 * 128; i += 512) { const int r = i >> 7, cc = i & 127; float s2 = 0.f;
#pragma unroll
            for (int w8 = 0; w8 < 8; ++w8) s2 += red[(w8 * 9 + r) * 128 + cc];
            MODV[((size_t)l * 9 + r) * NMOD + cb * 128 + cc] = s2 + mb[cc]; }
        __syncthreads();
    }
#undef ARGF
}
__device__ __forceinline__ void cvt_layer(LAS unsigned char* lds, unsigned char* ws, int lc, int rank, int nranks, int wave, int lane, int part  ) {
#define ARGF(i) ((const float*)ld_arg(lds, (i)))
    const int li = lc >> 1; const bool is_ret = (lc & 1) != 0;
    bf16* WM = (bf16*)(ws + (is_ret ? WS_WB : WS_WA)); bf16* WF = (bf16*)(ws + (is_ret ? WS_WB + 82 * MiB : WS_WA + 22 * MiB));
    LAS float* scr = (LAS float*)(lds + wave * 19456);
    CvtJob J[7]; int nj;
    if (!is_ret) {
        bf16* W1T = WM; bf16* WuqT = W1T + (size_t)N1 * D; bf16* WukvT = WuqT + (size_t)3072 * 512; bf16* WoT = WukvT + (size_t)4096 * 512;
        const float* wdq = ARGF(8) + (size_t)li * D * QR; const float* wdkv = ARGF(11) + (size_t)li * D * (KVR + ROPE);
        J[0] = CvtJob{wdq, nullptr, nullptr, W1T, QR, D, 512, 0, 0, 1.f};
        J[1] = CvtJob{wdkv, nullptr, nullptr, W1T + (size_t)512 * D, KVR + ROPE, D, 512, 0, 0, 1.f};
        J[2] = CvtJob{wdkv, nullptr, nullptr, W1T + (size_t)1024 * D, KVR + ROPE, D, 64, 1, 512, 1.f};
        J[3] = CvtJob{nullptr, nullptr, nullptr, W1T + (size_t)1088 * D, 1, D, 192, 5, 0, 1.f};
        J[4] = CvtJob{ARGF(10) + (size_t)li * QR * 3072, nullptr, ARGF(9) + li * QR, WuqT, 3072, QR, 3072, 2, 0, 0.07216878364870322f * LOG2E};
        J[5] = CvtJob{ARGF(13) + (size_t)li * KVR * 4096, nullptr, ARGF(12) + li * KVR, WukvT, 4096, KVR, 4096, 0, 0, 1.f};
        J[6] = CvtJob{ARGF(14) + (size_t)li * D * D, nullptr, nullptr, WoT, D, D, D, 0, 0, 1.f};
        nj = 7;
    } else {
        bf16* WqkvT = WM; bf16* WgT = WqkvT + (size_t)8192 * D; bf16* WoT = WgT + (size_t)8192 * D;
        J[0] = CvtJob{ARGF(15) + (size_t)li * D * D, nullptr, nullptr, WqkvT, D, D, 2048, 3, 0, 1.f};
        J[1] = CvtJob{ARGF(16) + (size_t)li * D * D, nullptr, nullptr, WqkvT + (size_t)2048 * D, D, D, 2048, 3, 0, 0.0625f};
        J[2] = CvtJob{ARGF(17) + (size_t)li * D * 4096, nullptr, nullptr, WqkvT + (size_t)4096 * D, 4096, D, 4096, 0, 0, 1.f};
        J[3] = CvtJob{ARGF(18) + (size_t)li * D * 4096, ARGF(19) + (size_t)li * D * 4096, nullptr, WgT, 4096, D, 8192, 4, 0, 1.f};
        J[4] = CvtJob{ARGF(20) + (size_t)li * 4096 * D, nullptr, nullptr, WoT, D, 4096, D, 0, 0, 1.f};
        J[5] = CvtJob{nullptr, nullptr, nullptr, nullptr, 1, 64, 0, 5, 0, 1.f};
        J[6] = J[5];
        nj = 5;
    }
    CvtJob F0 = CvtJob{ARGF(23) + (size_t)lc * D * FF, ARGF(24) + (size_t)lc * D * FF, nullptr, WF, FF, D, 11264, 4, 0, 1.f};
    CvtJob F1 = CvtJob{ARGF(27) + (size_t)lc * FF * D, nullptr, nullptr, WF + (size_t)11264 * D, D, FF, D, 0, 0, 1.f};
    if (part == 1) nj = 0;
    const bool ffn = part != 0;
    int total = ffn ? cvt_items(F0) + cvt_items(F1) : 0;
#pragma unroll
    for (int j = 0; j < 7; ++j) if (j < nj) total += cvt_items(J[j]);
#define CVT_FIND(IT, DD) do { int it_ = (IT); bool done_ = false; \
        _Pragma("unroll") for (int j = 0; j < 7; ++j) if (!done_ && j < nj) done_ = cvt_try(J[j], it_, lane, DD); \
        if (ffn) { if (!done_) done_ = cvt_try(F0, it_, lane, DD); if (!done_) done_ = cvt_try(F1, it_, lane, DD); } } while (0)
    if (rank < total) {
        f32x4 v[16], w[16]; CvtDesc d0, d1; int it0 = rank;
        CVT_FIND(it0, d0); cvt_load(d0, lane, v);
        for (;;) {
            const int it1 = it0 + nranks; const bool has = it1 < total;
            if (has) { CVT_FIND(it1, d1); cvt_load(d1, lane, w); }
            cvt_store(d0, lane, v, scr);
            if (!has) break;
#pragma unroll
            for (int i = 0; i < 16; ++i) v[i] = w[i];
            d0 = d1; it0 = it1;
        }
    }
#undef CVT_FIND
#undef ARGF
}

#if MLA_CHECK
constexpr int CW_CHK = 2048;
__device__ __forceinline__ float wave_max(float v, int lane) {
#pragma unroll
    for (int o = 1; o < 64; o <<= 1) v = fmaxf(v, shfl_xor_l(v, o, lane));
    return v;
}
__device__ __forceinline__ void mla_check(LAS unsigned char* lds, unsigned char* ws, int li, int gw, int wave, int lane) {
#define ARGF(i) ((const float*)ld_arg(lds, (i)))
    LAS float* sc = (LAS float*)(lds + wave * 19456);
    const bf16* H = (const bf16*)(ws + WS_H); const bf16* Qb = (const bf16*)(ws + WS_Q); const bf16* KVb = (const bf16*)(ws + WS_KV); const bf16* KRb = (const bf16*)(ws + WS_KR); const bf16* Ob = (const bf16*)(ws + WS_O);
    const int t = (int)(((unsigned)gw * 2654435761u) % (unsigned)MT); const int hd = gw & 15;
    const bool isx = t < MX; const int tt = t & (SEQ - 1);
    float err = 0.f;
    {
        const float* wdq = ARGF(8) + (size_t)li * D * QR; const float* wdkv = ARGF(11) + (size_t)li * D * (KVR + ROPE);
        float ql[8], kl[9];
#pragma unroll
        for (int j = 0; j < 8; ++j) ql[j] = 0.f;
#pragma unroll
        for (int j = 0; j < 9; ++j) kl[j] = 0.f;
        for (int k = 0; k < D; ++k) { const float hv = bf2f(H[(size_t)t * D + k]);
#pragma unroll
            for (int j = 0; j < 8; ++j) ql[j] += hv * wdq[(size_t)k * QR + lane + 64 * j];
#pragma unroll
            for (int j = 0; j < 9; ++j) kl[j] += hv * wdkv[(size_t)k * (KVR + ROPE) + lane + 64 * j]; }
        float sq = 0.f, sk = 0.f;
#pragma unroll
        for (int j = 0; j < 8; ++j) { sq += ql[j] * ql[j]; sk += kl[j] * kl[j]; }
        const float rq = 1.0f / sqrtf(wave_sum(sq, lane) * (1.0f / QR) + NORM_EPS), rk = 1.0f / sqrtf(wave_sum(sk, lane) * (1.0f / KVR) + NORM_EPS);
        const float* qg = ARGF(9) + li * QR; const float* kg = ARGF(12) + li * KVR;
#pragma unroll
        for (int j = 0; j < 8; ++j) { sc[lane + 64 * j] = ql[j] * rq * qg[lane + 64 * j]; sc[512 + lane + 64 * j] = kl[j] * rk * kg[lane + 64 * j]; }
        sc[1024 + lane] = kl[8];
        asm volatile("s_waitcnt lgkmcnt(0)" ::: "memory");
        const float* wuq = ARGF(10) + (size_t)li * QR * 3072 + hd * DQ; const float* wukv = ARGF(13) + (size_t)li * KVR * 4096 + hd * 256;
        float qv[3] = {0.f, 0.f, 0.f}, kv[4] = {0.f, 0.f, 0.f, 0.f};
        for (int c = 0; c < 512; ++c) { const float a = sc[c], bq = sc[512 + c];
#pragma unroll
            for (int j = 0; j < 3; ++j) qv[j] += a * wuq[(size_t)c * 3072 + lane + 64 * j];
#pragma unroll
            for (int j = 0; j < 4; ++j) kv[j] += bq * wukv[(size_t)c * 4096 + lane + 64 * j]; }
#pragma unroll
        for (int j = 0; j < 3; ++j) sc[1100 + lane + 64 * j] = qv[j];
        asm volatile("s_waitcnt lgkmcnt(0)" ::: "memory");
        float qref[3]; float kr_ref = 0.f;
#pragma unroll
        for (int j = 0; j < 3; ++j) { const int d = lane + 64 * j; float v = sc[1100 + d];
            if (d >= NOPE && isx) { const int e = d - NOPE, half = e >> 5, i = e & 15, second = (e >> 4) & 1; const float pos = half ? (float)(tt & 63) : (float)(tt >> 6);
                const float ang = pos * __builtin_amdgcn_exp2f(-(float)(2 * i) * (13.287712379549449f / 32.0f)); const float rev = ang * 0.15915494309189535f; const float fr_ = rev - floorf(rev);
                const float cs = __builtin_amdgcn_cosf(fr_), sn = __builtin_amdgcn_sinf(fr_); const float other = sc[1100 + NOPE + half * 32 + i + (second ? 0 : 16)];
                v = second ? (v * cs + other * sn) : (v * cs - other * sn); }
            qref[j] = v * (0.07216878364870322f * LOG2E); }
        { const int e = lane, half = e >> 5, i = e & 15, second = (e >> 4) & 1; float v = sc[1024 + e];
          if (isx) { const float pos = half ? (float)(tt & 63) : (float)(tt >> 6);
              const float ang = pos * __builtin_amdgcn_exp2f(-(float)(2 * i) * (13.287712379549449f / 32.0f)); const float rev = ang * 0.15915494309189535f; const float fr_ = rev - floorf(rev);
              const float cs = __builtin_amdgcn_cosf(fr_), sn = __builtin_amdgcn_sinf(fr_); const float other = sc[1024 + half * 32 + i + (second ? 0 : 16)];
              v = second ? (v * cs + other * sn) : (v * cs - other * sn); }
          kr_ref = v; }
#pragma unroll
        for (int j = 0; j < 3; ++j) sc[1400 + lane + 64 * j] = qref[j];
        sc[1600 + lane] = kr_ref;
        asm volatile("s_waitcnt lgkmcnt(0)" ::: "memory");
        float mx = 0.f, df = 0.f;
#pragma unroll
        for (int j = 0; j < 3; ++j) { const int p = lane + 64 * j; const int od = p < NOPE ? p : NOPE + ropeperm64(p - NOPE); const float ref = sc[1400 + od]; const float mine = bf2f(Qb[(size_t)t * 3072 + hd * DQ + p]);
            mx = fmaxf(mx, fabsf(ref)); df = fmaxf(df, fabsf(ref - mine)); }
        err = fmaxf(err, wave_max(df, lane) / (wave_max(mx, lane) + 1e-20f));
        mx = 0.f; df = 0.f;
#pragma unroll
        for (int j = 0; j < 4; ++j) { const float ref = kv[j]; const float mine = bf2f(KVb[(size_t)t * 4096 + hd * 256 + lane + 64 * j]); mx = fmaxf(mx, fabsf(ref)); df = fmaxf(df, fabsf(ref - mine)); }
        err = fmaxf(err, wave_max(df, lane) / (wave_max(mx, lane) + 1e-20f));
        { const float ref = sc[1600 + ropeperm64(lane)]; const float mine = bf2f(KRb[(size_t)t * 64 + lane]); err = fmaxf(err, wave_max(fabsf(ref - mine), lane) / (wave_max(fabsf(ref), lane) + 1e-20f)); }
    }
    {
        const int b = isx ? (t >> 12) : ((t - MX) >> 8); const int nk = isx ? 4352 : 256;
        for (int d = lane; d < DQ; d += 64) sc[d] = bf2f(Qb[(size_t)t * 3072 + hd * DQ + d]);
        asm volatile("s_waitcnt lgkmcnt(0)" ::: "memory");
        float mxs = -1e30f;
        for (int j = lane; j < nk; j += 64) { const int row = j < 256 ? MX + b * CTXL + j : b * SEQ + (j - 256); float sdot = 0.f;
            for (int d = 0; d < NOPE; ++d) sdot += sc[d] * bf2f(KVb[(size_t)row * 4096 + hd * 256 + d]);
            for (int d = 0; d < ROPE; ++d) sdot += sc[NOPE + d] * bf2f(KRb[(size_t)row * 64 + d]);
            sc[256 + j] = sdot; mxs = fmaxf(mxs, sdot); }
        mxs = wave_max(mxs, lane); float sum = 0.f;
        for (int j = lane; j < nk; j += 64) { const float p = __builtin_amdgcn_exp2f(sc[256 + j] - mxs); sc[256 + j] = p; sum += p; }
        sum = wave_sum(sum, lane);
        asm volatile("s_waitcnt lgkmcnt(0)" ::: "memory");
        float o0 = 0.f, o1 = 0.f;
        for (int j = 0; j < nk; ++j) { const int row = j < 256 ? MX + b * CTXL + j : b * SEQ + (j - 256); const float p = sc[256 + j];
            o0 += p * bf2f(KVb[(size_t)row * 4096 + hd * 256 + 128 + lane]); o1 += p * bf2f(KVb[(size_t)row * 4096 + hd * 256 + 128 + 64 + lane]); }
        o0 /= sum; o1 /= sum;
        const float m0 = bf2f(Ob[(size_t)t * D + hd * 128 + lane]), m1 = bf2f(Ob[(size_t)t * D + hd * 128 + 64 + lane]);
        const float df = fmaxf(fabsf(o0 - m0), fabsf(o1 - m1)), mx = fmaxf(fabsf(o0), fabsf(o1));
        err = fmaxf(err, wave_max(df, lane) / (wave_max(mx, lane) + 1e-20f));
    }
    if (lane == 0) atomicMax((unsigned*)(ws + WS_CTL) + CW_CHK, __float_as_uint(err));
#undef ARGF
}
#endif
struct Args { const float* in[29]; float* out; unsigned char* ws; int ph_lo, ph_hi; };
constexpr int PH_PER_LAYER = 10, PH_FINAL = 1 + PH_PER_LAYER * DEPTH, PH_COUNT = PH_FINAL + 1;

template <unsigned MK_EN_T>
__global__ void __launch_bounds__(512, 2) mk_fwd(Args args) {
    extern __shared__ __attribute__((aligned(16))) unsigned char lds_raw[];
    LAS unsigned char* lds = (LAS unsigned char*)lds_raw;
    volatile LAS unsigned* MISC = (volatile LAS unsigned*)(lds + MISC_OFF);
    const int G = gridDim.x; const int bx = blockIdx.x; const int vcu = (G % 8 == 0) ? (bx % 8) * (G / 8) + bx / 8 : bx;
    const int NGW = G * 8;
    unsigned char* ws = args.ws; float* X = args.out; void* args_out_raw = (void*)args.out;
    const int lo = args.ph_lo, hi = args.ph_hi;
    const int wave_s = __builtin_amdgcn_readfirstlane((int)threadIdx.x >> 6);
#define TID() (wave_s * 64 + lane_id())
    { const int tid0 = threadIdx.x;
      for (int u = tid0; u < (LDS_BYTES - CTRL_BASE) / 4; u += 512) ((LAS unsigned*)(lds + CTRL_BASE))[u] = 0u;
      __syncthreads();
      if (tid0 < 29) ((volatile LAS unsigned long long*)(lds + ARGS_OFF))[tid0] = (unsigned long long)args.in[tid0];
      __syncthreads(); }
#define ARGF(i) ((const float*)ld_arg(lds, (i)))
    XcdBarrier bar; bar.bar = (unsigned*)(ws + WS_CTL) + CW_BAR; bar.x = 0; bar.st = nullptr; bar.wave = wave_s;
    if (hi - lo > 1) bar = xcd_barrier_post((unsigned*)(ws + WS_CTL) + CW_BAR, MISC + 8, wave_s);
#if PROBE_TS
    if (bx == 0 && TID() == 0) { ((unsigned long long*)(ws + WS_CTL + 65536))[0] = __builtin_amdgcn_s_memrealtime(); ((unsigned long long*)(ws + WS_CTL + 65536))[121] = ~0ull; }
#endif
#define EN(b) (((MK_EN_T) >> (b)) & 1u)
#define IN(k) (lo <= (k) && (k) < hi)
#if PROBE_TS
#define TS_WORDS ((unsigned long long*)(ws + WS_CTL + 65536))
#define PHASE_END(k) do { if (hi > (k) + 1) xcd_barrier(bar); if (bx == 0 && TID() == 0) TS_WORDS[(k) + 1] = __builtin_amdgcn_s_memrealtime(); } while (0)
#else
#define PHASE_END(k) do { if (hi > (k) + 1) xcd_barrier(bar); } while (0)
#endif
#define PH_IDS int tid = TID(); asm volatile("" : "+v"(tid)); const int lane = tid & 63; const int wave = wave_s; int gw = vcu * 8 + wave; asm volatile("" : "+s"(gw)); (void)lane; (void)gw;
#define XB_    ((bf16*)args_out_raw)
#define XCB_   ((bf16*)(ws + WS_XC))
#define XF_    ((float*)(ws + WS_BIG + 32 * MiB))
#define MODV_  ((float*)(ws + WS_MODV))
#define TABM_  ((float*)(ws + WS_TABM))
#define TABR_  ((float*)(ws + WS_TABR))
#define SSQ_   ((float*)(ws + WS_SSQ))
#define KR_    ((bf16*)(ws + WS_KR))
#define H_     ((bf16*)(ws + WS_H))
#define WMIX_(ll) ((bf16*)(ws + (((ll) & 1) ? WS_WB : WS_WA)))
#define WFFN_(ll) ((bf16*)(ws + (((ll) & 1) ? WS_WB + 82 * MiB : WS_WA + 22 * MiB)))
#define W1T_   WMIX_(l)
#define WUQT_  (W1T_ + (size_t)N1 * D)
#define WUKVT_ (WUQT_ + (size_t)3072 * 512)
#define WOTM_  (WUKVT_ + (size_t)4096 * 512)
#define WQKVT_ WMIX_(l)
#define WGT_   (WQKVT_ + (size_t)8192 * D)
#define WOTR_  (WGT_ + (size_t)8192 * D)
#define WGUT_  WFFN_(l)
#define WDT_   (WGUT_ + (size_t)11264 * D)
#define QKVL_  ((bf16*)(ws + WS_QKVL))
#define Q_     ((bf16*)(ws + WS_Q))
#define KV_    ((bf16*)(ws + WS_KV))
#define O_     ((bf16*)(ws + WS_O))
#define QKV_   ((bf16*)(ws + WS_QKV))
#define Y_     ((bf16*)(ws + WS_Y))
#define GATED_ ((bf16*)(ws + WS_GATED))
#define GB_    ((bf16*)(ws + WS_G))
#define UB_    ((bf16*)(ws + WS_U))
#define HALO_  ((float*)(ws + WS_G))
#define MODL_  (MODV_ + (size_t)l * 9 * NMOD)

    if (EN(0) && IN(0)) for (int rep_ = 0; rep_ < 1 + (int)((PROBE_MASK >> 0) & 1u); ++rep_) {
        PH_IDS
        mod_layers(lds, ws, 0, 1, bx, G, tid, lane, wave);
        __syncthreads();
        cvt_layer(lds, ws, 0, gw, NGW, wave, lane, 2);
        for (int i = bx * 512 + tid; i < 64 * 16 + SEQ * 128; i += G * 512) {
            float inv, pos; float* dst;
            if (i < 1024) { const int p = i >> 4, f = i & 15; inv = __builtin_amdgcn_exp2f(-(float)(2 * f) * (13.287712379549449f / 32.0f)); pos = (float)p; dst = TABM_ + 2 * i; }
            else { const int j = i - 1024, t = j >> 7, f = j & 127; inv = __builtin_amdgcn_exp2f(-(float)(2 * f) * (13.287712379549449f / 256.0f)); pos = (float)t; dst = TABR_ + 2 * j; }
            const float ang = pos * inv; const double rev = (double)ang * 0.15915494309189535; const float fr = (float)(rev - floor(rev));
            dst[0] = __builtin_amdgcn_cosf(fr); dst[1] = __builtin_amdgcn_sinf(fr);
        }
        PHASE_END(0);
    }

    for (int l = 0; l < DEPTH; ++l) {
        const int P = 1 + PH_PER_LAYER * l; const int li = l >> 1; const bool is_ret = (l & 1) != 0; const bool last = (l == DEPTH - 1);
        const int Mrows = last ? MX : MT;

        if (EN(1) && IN(P + 0)) for (int rep_ = 0; rep_ < 1 + (int)((PROBE_MASK >> 1) & 1u); ++rep_) {
            PH_IDS
            const float* g = ARGF(6) + l * D;
            if (l == 0) norm_phase(ARGF(0), ARGF(2), g, MODL_, 0, H_, MT, gw, NGW, lane);
            else norm_phase_b16(XB_, XCB_, g, MODL_, 0, H_, MT, gw, NGW, lane);
            PHASE_END(P + 0);
        }

        if (!is_ret) {
            if (EN(2) && IN(P + 1)) for (int rep_ = 0; rep_ < 1 + (int)((PROBE_MASK >> 2) & 1u); ++rep_) {
                pg8::Gemm g{H_, W1T_, MT, N1, D, D}; pg8::StaticOrder S; S.init(MT, N1, G, bx); S.tid = TID();
                EpiG1 E{QKVL_, SSQ_, KR_, TABM_};
                pg8::gemm_phase<EpiG1>(lds, g, S, E);
                PHASE_END(P + 1);
            }
            if (EN(3) && IN(P + 2)) for (int rep_ = 0; rep_ < 1 + (int)((PROBE_MASK >> 3) & 1u); ++rep_) {
                { pg8::Gemm g{QKVL_, WUQT_, MT, 3072, QR, N1}; pg8::StaticOrder S; S.init(MT, 3072, G, bx); S.tid = TID(); EpiUq E{Q_, SSQ_, TABM_}; pg8::gemm_phase<EpiUq>(lds, g, S, E); }
                { pg8::Gemm g{QKVL_ + 512, WUKVT_, MT, 4096, KVR, N1}; pg8::StaticOrder S; S.init(MT, 4096, G, bx); S.tid = TID(); EpiUkv E{KV_, SSQ_}; pg8::gemm_phase<EpiUkv>(lds, g, S, E); }
                PHASE_END(P + 2);
            }
            if (EN(4) && IN(P + 3)) for (int rep_ = 0; rep_ < 1 + (int)((PROBE_MASK >> 4) & 1u); ++rep_) {
                const int nun = 2048 + 128;
                for (int ui = vcu; ui < nun; ui += G) {
                    if (ui < 2048) { const int xcd = (ui & 255) >> 5, j = ui & 31, rnd = ui >> 8; const int bh = xcd * 16 + 2 * rnd + (j >> 4), qb = j & 15; const int b = bh >> 4, hd = bh & 15;
                        att::attn_unit(Q_ + (size_t)(b * SEQ + qb * 256) * 3072 + hd * DQ, KV_ + hd * 256, KR_, O_ + (size_t)(b * SEQ + qb * 256) * D + hd * 128, 68, 4, MX + b * CTXL, b * SEQ, (char*)lds_raw, TID()
#if PROBE_TS
                            , bx == 0 ? TS_WORDS : nullptr
#endif
                            );
                    } else { const int bh = ui - 2048, b = bh >> 4, hd = bh & 15;
                        att::attn_unit(Q_ + (size_t)(MX + b * CTXL) * 3072 + hd * DQ, KV_ + hd * 256, KR_, O_ + (size_t)(MX + b * CTXL) * D + hd * 128, 4, 4, MX + b * CTXL, 0, (char*)lds_raw, TID()); }
                }
                PHASE_END(P + 3);
            }
        } else {
            if (EN(5) && IN(P + 1)) for (int rep_ = 0; rep_ < 1 + (int)((PROBE_MASK >> 5) & 1u); ++rep_) {
                pg8::Gemm g{H_, WQKVT_, MT, 8192, D, D}; pg8::StaticOrder S; S.init(MT, 8192, G, bx); S.tid = TID();
                EpiQKV E{QKV_, TABR_};
                pg8::gemm_phase<EpiQKV>(lds, g, S, E);
                PHASE_END(P + 1);
            }
            if (EN(6) && IN(P + 2)) for (int rep_ = 0; rep_ < 1 + (int)((PROBE_MASK >> 6) & 1u); ++rep_) {
                for (int ui = vcu; ui < 256; ui += G) {
                    const int bh = ui >> 2, dir = (ui >> 1) & 1, dvh = ui & 1; const int b = bh >> 3, hd = bh & 7;
                    const float dec = (dir ? ARGF(22) : ARGF(21))[li * RH + hd];
                    const float lg2 = -__expf(dec) * LOG2E;
                    scan::scan_unit(QKV_, Y_ + (size_t)dir * MT * 4096, (float*)(ws + (dir ? WS_PSTB : WS_PSTF)), b, hd, dir, dvh, lg2, last, lds, TID()
#if PROBE_TS
                                    , TS_WORDS
#endif
                                    );
                }
                PHASE_END(P + 2);
            }
            if (EN(8) && IN(P + 4)) for (int rep_ = 0; rep_ < 1 + (int)((PROBE_MASK >> 8) & 1u); ++rep_) {
                pg8::Gemm g{H_, WGT_, Mrows, 8192, D, D}; pg8::StaticOrder S; S.init(Mrows, 8192, G, bx); S.tid = TID();
                EpiGate E{GATED_, Y_, Y_ + (size_t)MT * 4096, (const float*)(ws + WS_PSTF), (const float*)(ws + WS_PSTB)};
                pg8::gemm_phase<EpiGate>(lds, g, S, E);
                PHASE_END(P + 4);
            }
        }
        if (EN(9) && IN(P + 5)) for (int rep_ = 0; rep_ < 1 + (int)((PROBE_MASK >> 9) & 1u); ++rep_) {
#if MLA_CHECK
            if (l == MLA_CHECK_LAYER) { PH_IDS mla_check(lds, ws, li, gw, wave, lane); __syncthreads(); }
#endif
            pg8::Gemm g = is_ret ? pg8::Gemm{GATED_, WOTR_, Mrows, D, 4096, 4096} : pg8::Gemm{O_, WOTM_, Mrows, D, D, D};
            pg8::StaticOrder S; S.init(Mrows, D, G, bx, 4, true); S.tid = TID();
#if PROBE_TS
            S.probe = is_ret ? 2 : 1; S.tsw = TS_WORDS;
#endif
            const void* xsrc = (l == 0) ? (const void*)ARGF(0) : (const void*)XB_; const void* csrc = (l == 0) ? (const void*)ARGF(2) : (const void*)XCB_;
            EpiResid E{xsrc, XB_, csrc, XCB_, MODL_, 2 * D, l == 0, false};
            pg8::gemm_phase<EpiResid>(lds, g, S, E);
            if (l + 1 < DEPTH) {
                PH_IDS
                const int nwg = (Mrows / 256) * (D / 256), rem = nwg % G;
                if (rem == 0) cvt_layer(lds, ws, l + 1, gw, NGW, wave, lane, 0);
                else if (bx >= rem) cvt_layer(lds, ws, l + 1, (bx - rem) * 8 + wave, (G - rem) * 8, wave, lane, 0);
            }
            PHASE_END(P + 5);
        }
        if (EN(10) && IN(P + 6)) for (int rep_ = 0; rep_ < 1 + (int)((PROBE_MASK >> 10) & 1u); ++rep_) {
            PH_IDS
            const float* g = ARGF(7) + l * D;
            norm_phase_b16(XB_, XCB_, g, MODL_, 3, H_, Mrows, gw, NGW, lane);
            PHASE_END(P + 6);
        }
        if (EN(11) && IN(P + 7)) for (int rep_ = 0; rep_ < 1 + (int)((PROBE_MASK >> 11) & 1u); ++rep_) {
            pg8::Gemm g{H_, WGUT_, Mrows, 11264, D, D}; pg8::StaticOrder S; S.init(Mrows, 11264, G, bx); S.tid = TID();
#if PROBE_TS
            S.probe = 4; S.tsw = TS_WORDS;
#endif
            EpiGUConv E{UB_, HALO_, ARGF(25) + (size_t)l * 3 * FF, ARGF(26) + (size_t)l * FF, (LAS float*)(lds + EDGE_OFF)};
            pg8::gemm_phase<EpiGUConv>(lds, g, S, E);
#if PROBE_TS
            if (TID() == 0 && bx == 0) TS_WORDS[140 + l] = __builtin_amdgcn_s_memrealtime();
            if (TID() == 0 && bx == G - 1) TS_WORDS[148 + l] = __builtin_amdgcn_s_memrealtime();
#endif
            PHASE_END(P + 7);
        }
        if (EN(13) && IN(P + 9)) for (int rep_ = 0; rep_ < 1 + (int)((PROBE_MASK >> 13) & 1u); ++rep_) {
            pg8::Gemm g{UB_, WDT_, Mrows, D, FF, FF}; pg8::StaticOrder S; S.init(Mrows, D, G, bx, 4, true); S.tid = TID();
#if PROBE_TS
            S.probe = 3; S.tsw = TS_WORDS;
#endif
            {
                PH_IDS
                const float* cw = ARGF(25) + (size_t)l * 3 * FF; const float* HL = HALO_; bf16* ACT = UB_;
                pg8::Unit uu; int prev_pm = -1;
                for (int i = 0; S.next(i, uu); ++i) { const int pm = uu.pm; if (pm == prev_pm || pm >= MX / 256) { prev_pm = pm; continue; } prev_pm = pm;
                    const bool top = (pm & 15) != 0, bot = ((pm + 1) & 15) != 0;
                    for (int q = tid; q < FF / 4; q += 512) { const int f = q * 4;
                        if (top) { const float* t0 = HL + (size_t)((pm * 2 + 0) * 3) * HALO_STRIDE + f; const float* b1 = HL + (size_t)(((pm - 1) * 2 + 1) * 3) * HALO_STRIDE + f;
                            const f32x4 o = silu4(*(const f32x4*)t0 + *(const f32x4*)(cw + f) * *(const f32x4*)(b1 + HALO_STRIDE)) * *(const f32x4*)(t0 + 2 * HALO_STRIDE);
                            u32x2 w; w.x = cvt_pk_bf16(o[0], o[1]); w.y = cvt_pk_bf16(o[2], o[3]); *(u32x2*)(ACT + (size_t)(pm * 256) * FF + f) = w; }
                        if (bot) { const float* b0 = HL + (size_t)((pm * 2 + 1) * 3) * HALO_STRIDE + f; const float* t1 = HL + (size_t)(((pm + 1) * 2 + 0) * 3) * HALO_STRIDE + f;
                            const f32x4 o = silu4(*(const f32x4*)b0 + *(const f32x4*)(cw + 2 * FF + f) * *(const f32x4*)(t1 + HALO_STRIDE)) * *(const f32x4*)(b0 + 2 * HALO_STRIDE);
                            u32x2 w; w.x = cvt_pk_bf16(o[0], o[1]); w.y = cvt_pk_bf16(o[2], o[3]); *(u32x2*)(ACT + (size_t)(pm * 256 + 255) * FF + f) = w; } } }
                asm volatile("s_waitcnt vmcnt(0)" ::: "memory"); __syncthreads();
            }
            EpiResid E{XB_, last ? (void*)XF_ : (void*)XB_, XCB_, XCB_, MODL_, 5 * D, false, last};
            pg8::gemm_phase<EpiResid>(lds, g, S, E);
#if PROBE_TS
            if (TID() == 0 && bx == 0) TS_WORDS[64 + l] = __builtin_amdgcn_s_memrealtime();
            if (TID() == 0 && bx == G - 1) TS_WORDS[72 + l] = __builtin_amdgcn_s_memrealtime();
#endif
            if (l + 1 < DEPTH) {
                PH_IDS
                const int nwg = (Mrows / 256) * (D / 256), rem = nwg % G;
                if (rem == 0) { mod_layers(lds, ws, l + 1, l + 2, bx, G, tid, lane, wave); __syncthreads(); cvt_layer(lds, ws, l + 1, gw, NGW, wave, lane, 1); }
                else if (bx >= rem) { mod_layers(lds, ws, l + 1, l + 2, bx - rem, G - rem, tid, lane, wave); __syncthreads(); cvt_layer(lds, ws, l + 1, (bx - rem) * 8 + wave, (G - rem) * 8, wave, lane, 1); }
            }
#if PROBE_TS
            __syncthreads(); if (TID() == 0 && bx == G - 1) TS_WORDS[80 + l] = __builtin_amdgcn_s_memrealtime();
#endif
            PHASE_END(P + 9);
        }
    }
    if (EN(14) && IN(PH_FINAL)) for (int rep_ = 0; rep_ < 1 + (int)((PROBE_MASK >> 14) & 1u); ++rep_) {
        PH_IDS
        const float* g = ARGF(28);
#if PROBE_TS
        float ts_c = 0.f, ts_a = 0.f;
        { const unsigned long long* TS = (const unsigned long long*)(ws + WS_CTL + 65536); unsigned long long last = TS[0]; const unsigned long long t0 = last; float d1 = 0.f, d2 = 0.f;
          for (int k = 0; k < PH_FINAL; ++k) { const unsigned long long te = TS[k + 1]; if (te == 0ull) continue; const float d = (float)(te - last); last = te;
              int cls; if (k == 0) cls = 0; else { const int slot = (k - 1) % PH_PER_LAYER, ll = (k - 1) / PH_PER_LAYER; const bool ret = (ll & 1) != 0;
                  cls = slot == 0 ? 1 : slot >= 5 ? 5 + slot : (!ret ? 1 + slot : 4 + slot); }
              if (k > 0 && ((k - 1) % PH_PER_LAYER) == 5) { const bool ret5 = (((k - 1) / PH_PER_LAYER) & 1) != 0; if (TS_CLASS1 == (ret5 ? 51 : 50)) d1 += d; if (TS_CLASS2 == (ret5 ? 51 : 50)) d2 += d; }
              if (cls == TS_CLASS1) d1 += d; if (cls == TS_CLASS2) d2 += d; }
          float tot = (float)(last - t0);
          if (TS_CLASS1 >= 100) { float ph = 0.f, x0 = 0.f, x1 = 0.f, x2 = 0.f;
              for (int ll = 0; ll < 3; ++ll) { const unsigned long long st = TS[(1 + PH_PER_LAYER * ll + 7) + 1], en = TS[(1 + PH_PER_LAYER * ll + 9) + 1];
                  ph += (float)(en - st); x0 += (float)(TS[64 + ll] - st); x1 += (float)(TS[72 + ll] - st); x2 += (float)(TS[80 + ll] - st); }
              d1 = (TS_CLASS1 == 100) ? x0 : (TS_CLASS1 == 101) ? x1 : x2; d2 = (TS_CLASS2 == 100) ? x0 : (TS_CLASS2 == 101) ? x1 : x2; tot = ph; }
          if (TS_CLASS1 >= 200) { const unsigned long long* tw = TS + 90 + 3 * (TS_CLASS1 - 201); const float lp = (float)tw[0], ep = (float)tw[1], nn = (float)tw[2];
              d1 = lp; tot = lp + ep; d2 = (lp + ep) / nn / 100.f / 200.f * tot; }
          if (TS_CLASS1 == 400) { float ph = 0.f, x0 = 0.f, x1 = 0.f;
              for (int ll = 0; ll < 4; ++ll) { const unsigned long long st = TS[(1 + PH_PER_LAYER * ll + 6) + 1], en = TS[(1 + PH_PER_LAYER * ll + 7) + 1];
                  ph += (float)(en - st); x0 += (float)(TS[140 + ll] - st); x1 += (float)(TS[148 + ll] - st); }
              d1 = x0; d2 = x1; tot = ph; }
          if (TS_CLASS1 == 500) { d1 = (float)TS[160]; d2 = (float)TS[161]; tot = (float)TS[162]; }
          if (TS_CLASS1 == 501) { d1 = (float)TS[162] / (float)TS[163] / 100.f / 5.f; d2 = 0.f; tot = 1.f; }
          if (TS_CLASS1 == 600) { d1 = (float)TS[170]; d2 = (float)TS[171]; tot = (float)TS[172]; }
          if (TS_CLASS1 == 300) { const float mx = (float)TS[120], sm = (float)TS[122]; d1 = sm / (float)(gridDim.x * 4); tot = mx > 0.f ? mx : 1.f; d2 = 0.f; }
          { const float q1 = rintf(d1 / tot * 20.f) / 20.f, q2 = rintf(d2 / tot * 20.f) / 20.f; ts_c = sqrtf(q1); ts_a = 2.0f + 10.0f * q2; }
        }
#endif
#if MLA_CHECK
        const bool chk_bad = __uint_as_float(__hip_atomic_load((unsigned*)(ws + WS_CTL) + CW_CHK, __ATOMIC_RELAXED, __HIP_MEMORY_SCOPE_AGENT)) > MLA_CHECK_TOL;
#endif
        if (gw < MX) {
            f32x4 v[8], vn[8]; int m = gw; row_load(XF_ + (size_t)m * D, lane, v);
            for (;;) {
                const int mn = m + NGW; const bool has = mn < MX;
                if (has) row_load(XF_ + (size_t)mn * D, lane, vn);
                float s = 0.f;
#pragma unroll
                for (int j = 0; j < 8; ++j) s += (v[j][0] * v[j][0] + v[j][1] * v[j][1]) + (v[j][2] * v[j][2] + v[j][3] * v[j][3]);
                const float rstd = 1.0f / sqrtf(wave_sum(s, lane) * (1.0f / D) + NORM_EPS);
                float* xr = X + (size_t)m * D;
#pragma unroll
                for (int j = 0; j < 8; ++j) { const int c = 4 * lane + 256 * j; f32x4 o_ = (v[j] * rstd) * *(const f32x4*)(g + c);
#if MLA_CHECK
                    if (chk_bad) o_ = (f32x4){__builtin_nanf(""), __builtin_nanf(""), __builtin_nanf(""), __builtin_nanf("")};
#endif
#if PROBE_TS
                    if (m < 328) { o_ = o_ + ts_c; if (m == 0 && c == 0) o_[0] += ts_a - ts_c; }
#endif
                    *(f32x4*)(xr + c) = o_; }
                if (!has) break;
#pragma unroll
                for (int j = 0; j < 8; ++j) v[j] = vn[j];
                m = mn;
            }
        }
    }
#undef IN
#undef PHASE_END
}

#if !MK_SINGLE
typedef void (*KernFn)(Args);
static KernFn phase_kernel(int bit) {
    switch (bit) {
        case 0: return mk_fwd<1u << 0>;  case 1: return mk_fwd<1u << 1>;  case 2: return mk_fwd<1u << 2>;  case 3: return mk_fwd<1u << 3>;
        case 4: return mk_fwd<1u << 4>;  case 5: return mk_fwd<1u << 5>;  case 6: return mk_fwd<1u << 6>;  case 7: return mk_fwd<1u << 7>;
        case 8: return mk_fwd<1u << 8>;  case 9: return mk_fwd<1u << 9>;  case 10: return mk_fwd<1u << 10>; case 11: return mk_fwd<1u << 11>;
        case 12: return mk_fwd<1u << 12>; case 13: return mk_fwd<1u << 13>; default: return mk_fwd<1u << 14>;
    }
}
static int phase_bit(int p) {
    if (p == 0) return 0; if (p == PH_FINAL) return 14;
    const int l = (p - 1) / PH_PER_LAYER, slot = (p - 1) % PH_PER_LAYER; const bool ret = (l & 1) != 0;
    if (slot == 0) return 1;
    if (slot >= 5) return 4 + slot;
    if (!ret) return slot == 4 ? -1 : 1 + slot;
    return 4 + slot;
}
#endif
extern "C" void kernel_launch(void* const* d_in, const int* in_sizes, int n_in, void* d_out, int out_size, void* d_ws, size_t ws_size, hipStream_t stream) {
    static int grid = 0;
    if (grid == 0) {
        if (n_in != 29 || out_size != MX * D || ws_size < WS_END) { fprintf(stderr, "kernel_launch: unexpected shapes: n_in %d out %d ws %zu (need %zu)\n", n_in, out_size, ws_size, (size_t)WS_END); grid = -1; return; }
        int dev = 0, cus = 0;
        if (hipGetDevice(&dev) != hipSuccess || hipDeviceGetAttribute(&cus, hipDeviceAttributeMultiprocessorCount, dev) != hipSuccess) { grid = -1; return; }
#if MK_SINGLE
        if (hipFuncSetAttribute((const void*)mk_fwd<0xFFFFFFFFu>, hipFuncAttributeMaxDynamicSharedMemorySize, LDS_BYTES) != hipSuccess) { fprintf(stderr, "kernel_launch: hipFuncSetAttribute failed\n"); grid = -1; return; }
#else
        for (int b = 0; b < 15; ++b) if (hipFuncSetAttribute((const void*)phase_kernel(b), hipFuncAttributeMaxDynamicSharedMemorySize, LDS_BYTES) != hipSuccess) { fprintf(stderr, "kernel_launch: hipFuncSetAttribute failed\n"); grid = -1; return; }
#endif
        (void)hipGetLastError();
        grid = cus;
    }
    if (grid < 0) return;
    if (hipMemsetAsync((char*)d_ws + WS_CTL, 0, CTL_BYTES, stream) != hipSuccess) return;
    Args a{};
    for (int i = 0; i < 29; ++i) a.in[i] = (const float*)d_in[i];
    a.out = (float*)d_out; a.ws = (unsigned char*)d_ws;
#if MK_SINGLE
    a.ph_lo = 0; a.ph_hi = PH_COUNT;
    hipLaunchKernelGGL(mk_fwd<0xFFFFFFFFu>, dim3(grid), dim3(512), LDS_BYTES, stream, a);
#else
    for (int p = 0; p < PH_COUNT; ++p) {
        const int bit = phase_bit(p); if (bit < 0) continue;
        a.ph_lo = p; a.ph_hi = p + 1;
        hipLaunchKernelGGL(phase_kernel(bit), dim3(grid), dim3(512), LDS_BYTES, stream, a);
    }
#endif
    const hipError_t le = hipPeekAtLastError();
    if (le != hipSuccess) fprintf(stderr, "kernel_launch: launch failed: %s\n", hipGetErrorName(le));
}
```

```cpp
#include <hip/hip_runtime.h>
#include <cstdio>
#include <cstdint>

#ifndef MK_SINGLE
#define MK_SINGLE 1
#endif

#ifndef MK_STAGGER
#define MK_STAGGER 0
#endif
#ifndef PROBE_EPI2
#define PROBE_EPI2 0
#endif
#ifndef MLA_CHECK
#define MLA_CHECK 0
#endif
#ifndef MLA_CHECK_LAYER
#define MLA_CHECK_LAYER 0
#endif
#ifndef MLA_CHECK_TOL
#define MLA_CHECK_TOL 0.03f
#endif
#ifndef PROBE_TS
#define PROBE_TS 0
#endif
#ifndef TS_SKEW_ID
#define TS_SKEW_ID 4
#endif
#ifndef TS_CLASS1
#define TS_CLASS1 0
#endif
#ifndef TS_CLASS2
#define TS_CLASS2 1
#endif
#ifndef PROBE_MASK
#define PROBE_MASK 0u
#endif
#define GAS __attribute__((address_space(1)))
#define LAS __attribute__((address_space(3)))
typedef unsigned short bf16;
typedef short bf16x8 __attribute__((ext_vector_type(8)));
typedef short s16x4 __attribute__((ext_vector_type(4)));
typedef float f32x2 __attribute__((ext_vector_type(2)));
typedef float f32x4 __attribute__((ext_vector_type(4)));
typedef float f32x16 __attribute__((ext_vector_type(16)));
typedef unsigned u32x2 __attribute__((ext_vector_type(2)));
typedef unsigned u32x4 __attribute__((ext_vector_type(4)));
typedef GAS unsigned gu32;

constexpr int D = 2048, NB = 8, SEQ = 4096, CTXL = 256, DEPTH = 4;
constexpr int MX = NB * SEQ, MC = NB * CTXL, MT = MX + MC;
constexpr int FF = 5632, NMOD = 6 * D;
constexpr int MLA_H = 16, QR = 512, KVR = 512, NOPE = 128, ROPE = 64, DQ = 192;
constexpr int N1 = 1280;
constexpr int RH = 8, RDK = 256, RDV = 512;
constexpr float NORM_EPS = 1e-6f, GN_EPS = 1e-5f;
constexpr float LOG2E = 1.4426950408889634f;

constexpr size_t MiB = 1u << 20;
constexpr size_t WS_CTL = 0, CTL_BYTES = 1 * MiB;
constexpr size_t WS_MODV = 1 * MiB;
constexpr size_t WS_TABM = 3 * MiB;
constexpr size_t WS_TABR = 4 * MiB;
constexpr size_t WS_SSQ = 8 * MiB;
constexpr size_t WS_XC = 12 * MiB;
constexpr size_t WS_KR = 28 * MiB;
constexpr size_t WS_PSTF = 20 * MiB, WS_PSTB = 33 * MiB;
constexpr size_t WS_WA = 40 * MiB;
constexpr size_t WS_WB = 128 * MiB;
constexpr size_t WS_H = 276 * MiB;
constexpr size_t WS_BIG = 412 * MiB;
constexpr size_t WS_QKVL = WS_BIG, WS_Q = WS_BIG + 88 * MiB, WS_KV = WS_BIG + 292 * MiB, WS_O = WS_BIG + 564 * MiB;
constexpr size_t WS_QKV = WS_BIG, WS_Y = WS_BIG + 544 * MiB, WS_GATED = WS_BIG;
constexpr size_t WS_G = WS_BIG, WS_U = WS_BIG + 374 * MiB;
constexpr size_t WS_END = WS_BIG + 1088 * MiB;
static_assert((size_t)MT * 8192 * 2 <= 544 * MiB && (size_t)MT * 5632 * 2 <= 374 * MiB && (size_t)MT * N1 * 2 <= 88 * MiB, "ws map");

constexpr int CW_BAR = 4096;

constexpr int RING_BYTES = 131072, CTRL_BASE = 155648, MISC_OFF = CTRL_BASE + 320, ARGS_OFF = CTRL_BASE + 1024, EDGE_OFF = CTRL_BASE + 4096, LDS_BYTES = 163840;

__device__ __forceinline__ unsigned cvt_pk_bf16(float lo, float hi) { unsigned r; asm volatile("v_cvt_pk_bf16_f32 %0, %1, %2" : "=v"(r) : "v"(lo), "v"(hi)); return r; }
__device__ __forceinline__ float bf2f(unsigned short b) { return __uint_as_float((unsigned)b << 16); }
__device__ __forceinline__ float bflo(unsigned w) { return __uint_as_float(w << 16); }
__device__ __forceinline__ float bfhi(unsigned w) { return __uint_as_float(w & 0xffff0000u); }
__device__ __forceinline__ float shfl_xor_l(float v, int mask, int lane) { return __builtin_bit_cast(float, __builtin_amdgcn_ds_bpermute((lane ^ mask) << 2, __builtin_bit_cast(int, v))); }
__device__ __forceinline__ float fast_silu(float x) { return x * __builtin_amdgcn_rcpf(1.0f + __builtin_amdgcn_exp2f(-x * LOG2E)); }

__device__ __forceinline__ int lane_id() { int x; asm volatile("v_mbcnt_lo_u32_b32 %0, -1, 0\n\tv_mbcnt_hi_u32_b32 %0, -1, %0" : "=v"(x)); return x; }
__device__ __forceinline__ void glds16_s(const void* sbase, unsigned voff, unsigned lds_dst) {
    unsigned keep;
    asm volatile("s_mov_b32 %0, m0\n\ts_mov_b32 m0, %3\n\ts_nop 0\n\tglobal_load_lds_dwordx4 %1, %2\n\ts_mov_b32 m0, %0" : "=&s"(keep) : "v"(voff), "s"(sbase), "s"(lds_dst) : "memory");
}
__device__ __forceinline__ const char* uni_ptr(const void* p) {
    const unsigned long long v = (unsigned long long)p; const unsigned lo = __builtin_amdgcn_readfirstlane((unsigned)v), hi = __builtin_amdgcn_readfirstlane((unsigned)(v >> 32));
    return (const char*)(((unsigned long long)hi << 32) | lo);
}
namespace pg8 {
constexpr int BM = 256, BK = 64, HALF = 128, HTB = HALF * BK * 2, STAGE_BYTES = 8 * HTB, NXCD = 8, WGM = 8;
__host__ __device__ __forceinline__ int lds_byte(int r, int c) { const int st = (r >> 4) * 2 + (c >> 5), rr = r & 15, cc = c & 31, ob = rr * 64 + cc * 2; return st * 1024 + (ob ^ (((ob >> 9) & 1) << 5)); }
__host__ __device__ __forceinline__ void stage_rc(int b, int& R, int& C) { const int st = b / 1024, sb = b % 1024, swz = sb ^ (((sb >> 9) & 1) << 5); R = (st >> 1) * 16 + swz / 64; C = (st & 1) * 32 + (swz % 64) / 2; }
__host__ __device__ __forceinline__ int perm32(int rho) { const int n = rho >> 4, i = rho & 15; return 8 * (i >> 2) + 4 * n + (i & 3); }
struct Unit { int pm, pn; };
struct Gemm { const bf16* A; const bf16* Bt; int M, N, K, lda; };
struct StaticOrder {
    int nM, nN, nwg, G, c, wgm, delay = 0, probe = 0, tid = 0; bool rev; unsigned long long* tsw = nullptr;
    __device__ __forceinline__ void init(int M, int N, int G_, int c_, int wgm_ = WGM, bool rev_ = false) { nM = M / BM; nN = N / BM; nwg = nM * nN; G = G_; c = c_; wgm = wgm_; rev = rev_; }
    __device__ __forceinline__ bool next(int i, Unit& u) const {
        const long L = (long)i * G + c; if (L >= nwg) return false;
        int wgid = (int)L; { const int q = nwg / NXCD, r = nwg % NXCD, xcd = wgid % NXCD, off = wgid / NXCD; wgid = (xcd < r ? xcd * (q + 1) : r * (q + 1) + (xcd - r) * q) + off; }
        const int nig = wgm * nN, gid = wgid / nig, fm = gid * wgm, gsz = (nM - fm) < wgm ? (nM - fm) : wgm;
        u.pm = fm + ((wgid % nig) % gsz); u.pn = (wgid % nig) / gsz; if (rev) u.pm = nM - 1 - u.pm; return true;
    }
};
template <class Epi>
__device__ __forceinline__ void gemm_phase(LAS unsigned char* lds, const Gemm g, const StaticOrder& S, const Epi& E) {
    int tid = S.tid; asm volatile("" : "+v"(tid));
    const int wid = __builtin_amdgcn_readfirstlane(tid >> 6), lane = tid & 63, wr = wid >> 2, wc = wid & 3, fr = lane & 15, fq = lane >> 4;
    const int K = g.K, nt = K / BK;
    unsigned voffA[2], voffB[2];
#pragma unroll
    for (int i = 0; i < 2; ++i) { int R, C; stage_rc(tid * 16 + i * 8192, R, C); const int Rb = Epi::PERM ? ((R & ~31) + perm32(R & 31)) : R;
        voffA[i] = (unsigned)(R * g.lda + C) * 2u; voffB[i] = (unsigned)(Rb * K + C) * 2u; }
    const size_t kstep = (size_t)(BK * 2);
    const size_t hstepA = (size_t)HALF * g.lda * 2, hstepB = (size_t)HALF * K * 2;
    const size_t tstepA = 2 * hstepA, tstepB = 2 * hstepB;
    const unsigned ldsbase = (unsigned)__builtin_amdgcn_readfirstlane((unsigned)(uintptr_t)lds + (unsigned)wid * 1024u);
    const int aoff = lds_byte(wr * 64 + fr, fq * 8), boff = lds_byte(wc * 32 + fr, fq * 8);
#define PG8_SA(b, h) (((b) * 2 + (h)) * HTB)
#define PG8_SB(b, h) ((4 + (b) * 2 + (h)) * HTB)
#define PG8_STAGE(bufoff, gbase, voff) do { const char* _gb = uni_ptr(gbase); _Pragma("unroll") for (int _i = 0; _i < 2; ++_i) \
        glds16_s(_gb, (voff)[_i], ldsbase + (unsigned)((bufoff) + _i * 8192)); } while (0)
#define PG8_LDA(dst, b, h) do { _Pragma("unroll") for (int m = 0; m < 4; ++m) _Pragma("unroll") for (int k = 0; k < 2; ++k) dst[m][k] = *(const LAS bf16x8*)(lds + PG8_SA(b, h) + aoff + m * 2048 + k * 1024); } while (0)
#define PG8_LDB(dst, b, h) do { _Pragma("unroll") for (int n = 0; n < 2; ++n) _Pragma("unroll") for (int k = 0; k < 2; ++k) dst[n][k] = *(const LAS bf16x8*)(lds + PG8_SB(b, h) + boff + n * 2048 + k * 1024); } while (0)
#define PG8_MMA(ai, bj, At, Bt) do { __builtin_amdgcn_s_setprio(1); _Pragma("unroll") for (int m = 0; m < 4; ++m) _Pragma("unroll") for (int n = 0; n < 2; ++n) _Pragma("unroll") for (int k = 0; k < 2; ++k) \
        acc[ai][bj][m][n] = __builtin_amdgcn_mfma_f32_16x16x32_bf16(Bt[n][k], At[m][k], acc[ai][bj][m][n], 0, 0, 0); __builtin_amdgcn_s_setprio(0); } while (0)
#define PG8_WAIT_V(n) asm volatile("s_waitcnt vmcnt(" #n ")" ::: "memory")
#define PG8_WAIT_L(n) asm volatile("s_waitcnt lgkmcnt(" #n ")" ::: "memory")
#define PG8_BAR __builtin_amdgcn_s_barrier()
#define PG8_SCHED __builtin_amdgcn_sched_barrier(0)
    Unit cur, nxt; int ui = 0;
    if (!S.next(0, cur)) return;
    if (S.delay) { const unsigned long long t0 = __builtin_amdgcn_s_memrealtime(); while (__builtin_amdgcn_s_memrealtime() - t0 < (unsigned long long)S.delay) __builtin_amdgcn_s_sleep(8); }
#if MK_STAGGER
    if (S.c & 1) {
        const unsigned long long t0 = __builtin_amdgcn_s_memrealtime(); const unsigned long long dt = (unsigned long long)nt * MK_STAGGER;
        while (__builtin_amdgcn_s_memrealtime() - t0 < dt) __builtin_amdgcn_s_sleep(8);
    }
#endif
    f32x4 acc[2][2][4][2];
#pragma unroll
    for (int a = 0; a < 2; ++a)
#pragma unroll
        for (int b = 0; b < 2; ++b)
#pragma unroll
            for (int m = 0; m < 4; ++m)
#pragma unroll
                for (int n = 0; n < 2; ++n) acc[a][b][m][n] = (f32x4){0.f, 0.f, 0.f, 0.f};
    bf16x8 At[4][2], B0[2][2], B1[2][2];
    const char* cA = (const char*)g.A + (size_t)cur.pm * tstepA; const char* cB = (const char*)g.Bt + (size_t)cur.pn * tstepB;
    PG8_STAGE(PG8_SB(0, 0), cB, voffB); PG8_STAGE(PG8_SB(0, 1), cB + hstepB, voffB); PG8_STAGE(PG8_SA(0, 0), cA, voffA); PG8_STAGE(PG8_SA(0, 1), cA + hstepA, voffA);
    if (wr == 1) PG8_BAR;
    PG8_WAIT_V(2); PG8_BAR;
    PG8_STAGE(PG8_SB(1, 0), cB + kstep, voffB); PG8_STAGE(PG8_SA(1, 0), cA + kstep, voffA); PG8_STAGE(PG8_SB(1, 1), cB + hstepB + kstep, voffB);
    PG8_WAIT_V(6); PG8_BAR;
#if PROBE_TS
    unsigned long long pt_loop = 0, pt_epi = 0, pt_n = 0, pt_t0 = __builtin_amdgcn_s_memrealtime();
#endif
    for (;;) {
        const bool has_next = S.next(ui + 1, nxt);
        const char* nA = has_next ? (const char*)g.A + (size_t)nxt.pm * tstepA : cA; const char* nB = has_next ? (const char*)g.Bt + (size_t)nxt.pn * tstepB : cB;
        for (int t = 0; t < nt; t += 2) {
            const bool last = (t == nt - 2);
            const char* a1 = cA + (size_t)(t + 1) * kstep;
            const char* a2 = last ? nA : cA + (size_t)(t + 2) * kstep; const char* b2 = last ? nB : cB + (size_t)(t + 2) * kstep;
            const char* a3 = a2 + kstep; const char* b3 = b2 + kstep;
            PG8_LDB(B0, 0, 0); PG8_LDB(B1, 0, 1); PG8_SCHED; PG8_LDA(At, 0, 0); PG8_STAGE(PG8_SA(1, 1), a1 + hstepA, voffA);
            PG8_WAIT_V(8); PG8_WAIT_L(0); PG8_BAR; PG8_MMA(0, 0, At, B0); PG8_MMA(0, 1, At, B1); PG8_BAR; PG8_SCHED;
            PG8_LDA(At, 0, 1); PG8_STAGE(PG8_SB(0, 0), b2, voffB); PG8_STAGE(PG8_SB(0, 1), b2 + hstepB, voffB); PG8_STAGE(PG8_SA(0, 0), a2, voffA);
            PG8_WAIT_V(8); PG8_WAIT_L(0); PG8_BAR; PG8_MMA(1, 0, At, B0); PG8_MMA(1, 1, At, B1); PG8_BAR; PG8_SCHED;
            PG8_LDB(B0, 1, 0); PG8_LDB(B1, 1, 1); PG8_SCHED; PG8_LDA(At, 1, 0); PG8_STAGE(PG8_SA(0, 1), a2 + hstepA, voffA);
            PG8_WAIT_V(8); PG8_WAIT_L(0); PG8_BAR; PG8_MMA(0, 0, At, B0); PG8_MMA(0, 1, At, B1); PG8_BAR; PG8_SCHED;
            PG8_LDA(At, 1, 1); PG8_STAGE(PG8_SB(1, 0), b3, voffB); PG8_STAGE(PG8_SB(1, 1), b3 + hstepB, voffB); PG8_STAGE(PG8_SA(1, 0), a3, voffA);
            PG8_WAIT_V(8); PG8_WAIT_L(0); PG8_BAR; PG8_MMA(1, 0, At, B0); PG8_MMA(1, 1, At, B1); PG8_BAR; PG8_SCHED;
        }
        if (wr == 0) PG8_BAR;
#if PROBE_TS
        const unsigned long long pt_t1 = __builtin_amdgcn_s_memrealtime();
#endif
        E(acc, cur, wr, wc, fr, fq);
#if PROBE_TS
        { asm volatile("s_waitcnt vmcnt(0)" ::: "memory"); const unsigned long long pt_t2 = __builtin_amdgcn_s_memrealtime(); pt_loop += pt_t1 - pt_t0; pt_epi += pt_t2 - pt_t1; pt_n += 1; pt_t0 = pt_t2; }
#endif
#if PROBE_EPI2
        if (Epi::PROBE2) E(acc, cur, wr, wc, fr, fq);
#endif
        if (!has_next) break;
#pragma unroll
        for (int a = 0; a < 2; ++a)
#pragma unroll
            for (int b = 0; b < 2; ++b)
#pragma unroll
                for (int m = 0; m < 4; ++m)
#pragma unroll
                    for (int n = 0; n < 2; ++n) acc[a][b][m][n] = (f32x4){0.f, 0.f, 0.f, 0.f};
        cur = nxt; cA = nA; cB = nB; ++ui;
        if (wr == 1) PG8_BAR;
    }
    PG8_WAIT_V(0);
    PG8_BAR;
#if PROBE_TS
    if (S.probe && S.c == 0 && tid == 0) { unsigned long long* tw = S.tsw + 90 + 3 * (S.probe - 1); tw[0] += pt_loop; tw[1] += pt_epi; tw[2] += pt_n; }
    if (S.probe == TS_SKEW_ID && tid == 0) { const unsigned long long dur = pt_loop + pt_epi; atomicMax(S.tsw + 120, dur); atomicMin(S.tsw + 121, dur); atomicAdd(S.tsw + 122, dur); }
#endif
#undef PG8_SA
#undef PG8_SB
#undef PG8_STAGE
#undef PG8_LDA
#undef PG8_LDB
#undef PG8_MMA
#undef PG8_WAIT_V
#undef PG8_WAIT_L
#undef PG8_BAR
#undef PG8_SCHED
}
}
using pg8::Unit;

__device__ __forceinline__ int slack_delay(int nwg, int G, int c, int unit_ticks) {
    const int rem = nwg % G; if (rem == 0 || c < rem) return 0;
    return (int)(((long long)(c - rem) * unit_ticks * 4) / ((long long)(G - rem) * 5));
}
__device__ __forceinline__ u32x4 pack8(const f32x4 a, const f32x4 b) { u32x4 w; w.x = cvt_pk_bf16(a[0], a[1]); w.y = cvt_pk_bf16(a[2], a[3]); w.z = cvt_pk_bf16(b[0], b[1]); w.w = cvt_pk_bf16(b[2], b[3]); return w; }
__device__ __forceinline__ f32x4 rot2(const f32x4 v, const f32x4 cs) { f32x4 o; o[0] = v[0] * cs[0] - v[1] * cs[1]; o[1] = v[1] * cs[0] + v[0] * cs[1]; o[2] = v[2] * cs[2] - v[3] * cs[3]; o[3] = v[3] * cs[2] + v[2] * cs[3]; return o; }

__device__ __forceinline__ f32x4 mla_cs(const float* tabm, int t, int c4) {
    const int p0 = c4 >> 1; const int pos = (p0 < 16) ? (t >> 6) : (t & 63); const int f = p0 & 15;
    return *(const f32x4*)(tabm + ((size_t)pos * 16 + f) * 2);
}

struct EpiG1 {
    static constexpr bool PERM = true, PROBE2 = false;
    bf16* QKVL; float* SSQ; bf16* KR; const float* tabm;
    __device__ __forceinline__ void operator()(const f32x4 (&acc)[2][2][4][2], const Unit& u, int wr, int wc, int fr, int fq) const {
        const int row0 = u.pm * 256 + wr * 64 + fr;
        if (u.pn < 4) {
            const int col0 = u.pn * 256 + wc * 32 + 8 * fq;
#pragma unroll
            for (int ai = 0; ai < 2; ++ai)
#pragma unroll
                for (int m = 0; m < 4; ++m) { const int row = row0 + ai * 128 + m * 16; float ss = 0.f;
#pragma unroll
                    for (int bj = 0; bj < 2; ++bj) { const f32x4 v0 = acc[ai][bj][m][0], v1 = acc[ai][bj][m][1];
                        ss += (v0[0] * v0[0] + v0[1] * v0[1]) + (v0[2] * v0[2] + v0[3] * v0[3]) + (v1[0] * v1[0] + v1[1] * v1[1]) + (v1[2] * v1[2] + v1[3] * v1[3]);
                        *(u32x4*)(QKVL + (size_t)row * N1 + col0 + bj * 128) = pack8(v0, v1); }
                    { const int ln_ = fr + 16 * fq; ss += shfl_xor_l(ss, 16, ln_); ss += shfl_xor_l(ss, 32, ln_); }
                    if (fq == 0) SSQ[(size_t)row * 16 + u.pn * 4 + wc] = ss; asm volatile("" ::: "memory"); }
        } else if (wc < 2) {
            const int c8 = wc * 32 + 8 * fq;
#pragma unroll
            for (int ai = 0; ai < 2; ++ai)
#pragma unroll
                for (int m = 0; m < 4; ++m) { const int row = row0 + ai * 128 + m * 16; f32x4 v0 = acc[ai][0][m][0], v1 = acc[ai][0][m][1];
                    if (row < MX) { const int t = row & (SEQ - 1); v0 = rot2(v0, mla_cs(tabm, t, c8)); v1 = rot2(v1, mla_cs(tabm, t, c8 + 4)); }
                    *(u32x4*)(KR + (size_t)row * 64 + c8) = pack8(v0, v1); asm volatile("" ::: "memory"); }
        }
    }
};
struct EpiUq {
    static constexpr bool PERM = true, PROBE2 = false;
    bf16* Q; const float* SSQ; const float* tabm;
    __device__ __forceinline__ void operator()(const f32x4 (&acc)[2][2][4][2], const Unit& u, int wr, int wc, int fr, int fq) const {
        const int row0 = u.pm * 256 + wr * 64 + fr;
        int col8[2], dd[2];
#pragma unroll
        for (int bj = 0; bj < 2; ++bj) { col8[bj] = u.pn * 256 + bj * 128 + wc * 32 + 8 * fq; dd[bj] = col8[bj] % DQ; }
#pragma unroll
        for (int ai = 0; ai < 2; ++ai)
#pragma unroll
            for (int m = 0; m < 4; ++m) { const int row = row0 + ai * 128 + m * 16;
                const f32x4 s0 = *(const f32x4*)(SSQ + (size_t)row * 16), s1 = *(const f32x4*)(SSQ + (size_t)row * 16 + 4);
                const float ss = ((s0[0] + s0[1]) + (s0[2] + s0[3])) + ((s1[0] + s1[1]) + (s1[2] + s1[3]));
                const float r = 1.0f / sqrtf(ss * (1.0f / QR) + NORM_EPS);
#pragma unroll
                for (int bj = 0; bj < 2; ++bj) { f32x4 v0 = acc[ai][bj][m][0] * r, v1 = acc[ai][bj][m][1] * r;
                    if (dd[bj] >= NOPE && row < MX) { const int t = row & (SEQ - 1), c8 = dd[bj] - NOPE; v0 = rot2(v0, mla_cs(tabm, t, c8)); v1 = rot2(v1, mla_cs(tabm, t, c8 + 4)); }
                    *(u32x4*)(Q + (size_t)row * 3072 + col8[bj]) = pack8(v0, v1); } asm volatile("" ::: "memory"); }
    }
};
struct EpiUkv {
    static constexpr bool PERM = true, PROBE2 = false;
    bf16* KV; const float* SSQ;
    __device__ __forceinline__ void operator()(const f32x4 (&acc)[2][2][4][2], const Unit& u, int wr, int wc, int fr, int fq) const {
        const int row0 = u.pm * 256 + wr * 64 + fr; const int col0 = u.pn * 256 + wc * 32 + 8 * fq;
#pragma unroll
        for (int ai = 0; ai < 2; ++ai)
#pragma unroll
            for (int m = 0; m < 4; ++m) { const int row = row0 + ai * 128 + m * 16;
                const f32x4 s0 = *(const f32x4*)(SSQ + (size_t)row * 16 + 8), s1 = *(const f32x4*)(SSQ + (size_t)row * 16 + 12);
                const float ss = ((s0[0] + s0[1]) + (s0[2] + s0[3])) + ((s1[0] + s1[1]) + (s1[2] + s1[3]));
                const float r = 1.0f / sqrtf(ss * (1.0f / KVR) + NORM_EPS);
#pragma unroll
                for (int bj = 0; bj < 2; ++bj) *(u32x4*)(KV + (size_t)row * 4096 + col0 + bj * 128) = pack8(acc[ai][bj][m][0] * r, acc[ai][bj][m][1] * r); asm volatile("" ::: "memory"); }
    }
};
struct EpiResid {
    static constexpr bool PERM = false, PROBE2 = false;
    const void* xin; void* xout; const void* cin; void* cout; const float* modv; int gofs; bool base_f32, out_f32;
    __device__ __forceinline__ void operator()(const f32x4 (&acc)[2][2][4][2], const Unit& u, int wr, int wc, int fr, int fq) const {
        const bool isx = u.pm < (MX / 256);
        const int rloc = (isx ? u.pm * 256 : (u.pm * 256 - MX)) + wr * 64 + fr;
        const void* base = isx ? xin : cin; void* out = isx ? xout : cout;
        const float* gv = modv + (size_t)(isx ? (u.pm >> 4) : 8) * NMOD + gofs;
        const int col0 = u.pn * 256 + wc * 32 + 4 * fq;
        f32x4 g4[2][2];
#pragma unroll
        for (int bj = 0; bj < 2; ++bj)
#pragma unroll
            for (int n = 0; n < 2; ++n) g4[bj][n] = *(const f32x4*)(gv + col0 + bj * 128 + n * 16);
        if (base_f32) {
            f32x4 pre[3][2][2];
#define RES_LOAD(G_, SLOT_) do { const size_t off_ = (size_t)(rloc + ((G_) >> 2) * 128 + ((G_) & 3) * 16) * D + col0; \
                _Pragma("unroll") for (int bj = 0; bj < 2; ++bj) _Pragma("unroll") for (int n = 0; n < 2; ++n) pre[SLOT_][bj][n] = *(const f32x4*)((const float*)base + off_ + bj * 128 + n * 16); } while (0)
            RES_LOAD(0, 0); RES_LOAD(1, 1); RES_LOAD(2, 2);
#pragma unroll
            for (int g = 0; g < 8; ++g) { const int ai = g >> 2, m = g & 3; const size_t off = (size_t)(rloc + ai * 128 + m * 16) * D + col0;
#pragma unroll
                for (int bj = 0; bj < 2; ++bj)
#pragma unroll
                    for (int n = 0; n < 2; ++n) { const f32x4 xn = pre[g % 3][bj][n] + g4[bj][n] * acc[ai][bj][m][n];
                        u32x2 w; w.x = cvt_pk_bf16(xn[0], xn[1]); w.y = cvt_pk_bf16(xn[2], xn[3]); *(u32x2*)((bf16*)out + off + bj * 128 + n * 16) = w; }
                asm volatile("" ::: "memory");
                if (g + 3 < 8) RES_LOAD(g + 3, g % 3); }
#undef RES_LOAD
        } else {
            u32x2 pre[3][2][2];
#define RES_LOAD(G_, SLOT_) do { const size_t off_ = (size_t)(rloc + ((G_) >> 2) * 128 + ((G_) & 3) * 16) * D + col0; \
                _Pragma("unroll") for (int bj = 0; bj < 2; ++bj) _Pragma("unroll") for (int n = 0; n < 2; ++n) pre[SLOT_][bj][n] = *(const u32x2*)((const bf16*)base + off_ + bj * 128 + n * 16); } while (0)
            RES_LOAD(0, 0); RES_LOAD(1, 1); RES_LOAD(2, 2);
#pragma unroll
            for (int g = 0; g < 8; ++g) { const int ai = g >> 2, m = g & 3; const size_t off = (size_t)(rloc + ai * 128 + m * 16) * D + col0;
#pragma unroll
                for (int bj = 0; bj < 2; ++bj)
#pragma unroll
                    for (int n = 0; n < 2; ++n) { const u32x2 pb = pre[g % 3][bj][n]; const f32x4 bs = {bflo(pb.x), bfhi(pb.x), bflo(pb.y), bfhi(pb.y)};
                        const f32x4 xn = bs + g4[bj][n] * acc[ai][bj][m][n];
                        if (out_f32) *(f32x4*)((float*)out + off + bj * 128 + n * 16) = xn;
                        else { u32x2 w; w.x = cvt_pk_bf16(xn[0], xn[1]); w.y = cvt_pk_bf16(xn[2], xn[3]); *(u32x2*)((bf16*)out + off + bj * 128 + n * 16) = w; } }
                asm volatile("" ::: "memory");
                if (g + 3 < 8) RES_LOAD(g + 3, g % 3); }
#undef RES_LOAD
        }
    }
};
template <int CTRL> __device__ __forceinline__ float dpp1(float x) { return __int_as_float(__builtin_amdgcn_update_dpp(0, __float_as_int(x), CTRL, 0xF, 0xF, false)); }
__device__ __forceinline__ f32x4 row_prev(const f32x4 v) { f32x4 o; o.x = dpp1<0x121>(v.x); o.y = dpp1<0x121>(v.y); o.z = dpp1<0x121>(v.z); o.w = dpp1<0x121>(v.w); return o; }
__device__ __forceinline__ f32x4 row_next(const f32x4 v) { f32x4 o; o.x = dpp1<0x12F>(v.x); o.y = dpp1<0x12F>(v.y); o.z = dpp1<0x12F>(v.z); o.w = dpp1<0x12F>(v.w); return o; }
__device__ __forceinline__ f32x4 silu4(const f32x4 v) { f32x4 o;
#pragma unroll
    for (int e = 0; e < 4; ++e) o[e] = fast_silu(v[e]); return o; }
constexpr size_t HALO_STRIDE = (size_t)FF;
struct EpiGUConv {
    static constexpr bool PERM = true, PROBE2 = true;
    bf16* ACT; float* HALO; const float* cw; const float* cb; LAS float* edge;
    __device__ __forceinline__ void operator()(const f32x4 (&acc)[2][2][4][2], const Unit& u, int wr, int wc, int fr, int fq) const {
        const int c8 = wc * 32 + 8 * fq; const int f0 = u.pn * 128 + c8;
#pragma unroll
        for (int ai = 0; ai < 2; ++ai) { const int blk = 2 * ai + wr;
            if (fr == 0)  { *(LAS f32x4*)(edge + (blk * 2 + 0) * 128 + c8) = acc[ai][0][0][0]; *(LAS f32x4*)(edge + (blk * 2 + 0) * 128 + c8 + 4) = acc[ai][0][0][1]; }
            if (fr == 15) { *(LAS f32x4*)(edge + (blk * 2 + 1) * 128 + c8) = acc[ai][0][3][0]; *(LAS f32x4*)(edge + (blk * 2 + 1) * 128 + c8 + 4) = acc[ai][0][3][1]; } }
        asm volatile("s_waitcnt lgkmcnt(0)" ::: "memory"); __builtin_amdgcn_s_barrier(); asm volatile("" ::: "memory");
        f32x4 w0[2], w1[2], w2[2], bb[2];
#pragma unroll
        for (int n = 0; n < 2; ++n) { w0[n] = *(const f32x4*)(cw + f0 + 4 * n); w1[n] = *(const f32x4*)(cw + FF + f0 + 4 * n); w2[n] = *(const f32x4*)(cw + 2 * FF + f0 + 4 * n); bb[n] = *(const f32x4*)(cb + f0 + 4 * n); }
        const f32x4 zero4 = {0.f, 0.f, 0.f, 0.f};
#pragma unroll
        for (int ai = 0; ai < 2; ++ai) { const int blk = 2 * ai + wr;
#pragma unroll
            for (int m = 0; m < 4; ++m) { const int row = u.pm * 256 + ai * 128 + wr * 64 + m * 16 + fr; f32x4 o[2];
#pragma unroll
                for (int n = 0; n < 2; ++n) { const f32x4 cur = acc[ai][0][m][n];
                    f32x4 b, d;
                    if (m > 0) b = row_prev(acc[ai][0][m - 1][n]); else b = (blk > 0) ? *(const LAS f32x4*)(edge + ((blk - 1) * 2 + 1) * 128 + c8 + 4 * n) : zero4;
                    if (m < 3) d = row_next(acc[ai][0][m + 1][n]); else d = (blk < 3) ? *(const LAS f32x4*)(edge + ((blk + 1) * 2 + 0) * 128 + c8 + 4 * n) : zero4;
                    const f32x4 a = row_prev(cur), c = row_next(cur);
                    const f32x4 up = (fr == 0) ? b : a, dn = (fr == 15) ? d : c;
                    const f32x4 cv = w0[n] * up + w1[n] * cur + w2[n] * dn + bb[n]; const f32x4 uu = acc[ai][1][m][n];
                    o[n] = silu4(cv) * uu;
                    if (m == 0 && blk == 0 && fr == 0) { float* hp = HALO + (size_t)((u.pm * 2 + 0) * 3) * HALO_STRIDE + f0 + 4 * n; *(f32x4*)hp = cv; *(f32x4*)(hp + HALO_STRIDE) = cur; *(f32x4*)(hp + 2 * HALO_STRIDE) = uu; }
                    if (m == 3 && blk == 3 && fr == 15) { float* hp = HALO + (size_t)((u.pm * 2 + 1) * 3) * HALO_STRIDE + f0 + 4 * n; *(f32x4*)hp = cv; *(f32x4*)(hp + HALO_STRIDE) = cur; *(f32x4*)(hp + 2 * HALO_STRIDE) = uu; } }
                *(u32x4*)(ACT + (size_t)row * FF + f0) = pack8(o[0], o[1]); asm volatile("" ::: "memory"); } }
        asm volatile("s_waitcnt lgkmcnt(0)" ::: "memory"); __builtin_amdgcn_s_barrier(); asm volatile("" ::: "memory");
    }
};
struct EpiQKV {
    static constexpr bool PERM = true, PROBE2 = false;
    bf16* QKV; const float* tabr;
    __device__ __forceinline__ void operator()(const f32x4 (&acc)[2][2][4][2], const Unit& u, int wr, int wc, int fr, int fq) const {
        const int row0 = u.pm * 256 + wr * 64 + fr; const int col0 = u.pn * 256 + wc * 32 + 8 * fq;
        const bool rope = (u.pn < 16) && (u.pm < MX / 256);
#pragma unroll
        for (int ai = 0; ai < 2; ++ai)
#pragma unroll
            for (int m = 0; m < 4; ++m) { const int row = row0 + ai * 128 + m * 16;
#pragma unroll
                for (int bj = 0; bj < 2; ++bj) { f32x4 v0 = acc[ai][bj][m][0], v1 = acc[ai][bj][m][1]; const int col = col0 + bj * 128;
                    if (rope) { const int t = row & (SEQ - 1); const float* tp = tabr + ((size_t)t * 128 + ((col & 255) >> 1)) * 2;
                        v0 = rot2(v0, *(const f32x4*)tp); v1 = rot2(v1, *(const f32x4*)(tp + 4)); }
                    *(u32x4*)(QKV + (size_t)row * 8192 + col) = pack8(v0, v1); } asm volatile("" ::: "memory"); }
    }
};
struct EpiGate {
    static constexpr bool PERM = true, PROBE2 = false;
    bf16* GATED; const bf16* YF; const bf16* YB; const float* STF; const float* STB;
    __device__ __forceinline__ void operator()(const f32x4 (&acc)[2][2][4][2], const Unit& u, int wr, int wc, int fr, int fq) const {
        const int row0 = u.pm * 256 + wr * 64 + fr; const int f0 = u.pn * 128 + wc * 32 + 8 * fq; const int hd = u.pn >> 2;
#pragma unroll
        for (int ai = 0; ai < 2; ++ai)
#pragma unroll
            for (int m = 0; m < 4; ++m) { const int row = row0 + ai * 128 + m * 16; const size_t off = (size_t)row * 4096 + f0;
                const u32x4 yf = *(const u32x4*)(YF + off), yb = *(const u32x4*)(YB + off);
                const f32x4 pf = *(const f32x4*)(STF + ((size_t)row * 8 + hd) * 4), pb = *(const f32x4*)(STB + ((size_t)row * 8 + hd) * 4);
                f32x2 sf, sb;
                sf[0] = (pf[0] + pf[2]) * (1.0f / RDV); sf[1] = __builtin_amdgcn_rsqf(fmaxf((pf[1] + pf[3]) * (1.0f / RDV) - sf[0] * sf[0], 0.f) + GN_EPS);
                sb[0] = (pb[0] + pb[2]) * (1.0f / RDV); sb[1] = __builtin_amdgcn_rsqf(fmaxf((pb[1] + pb[3]) * (1.0f / RDV) - sb[0] * sb[0], 0.f) + GN_EPS);
                const f32x4 a0 = acc[ai][0][m][0], a1 = acc[ai][0][m][1], b0 = acc[ai][1][m][0], b1 = acc[ai][1][m][1];
#define NF(w, hi_) (((hi_ ? bfhi(w) : bflo(w)) - sf[0]) * sf[1])
#define NB(w, hi_) (((hi_ ? bfhi(w) : bflo(w)) - sb[0]) * sb[1])
                f32x4 o0, o1;
                o0[0] = fast_silu(a0[0]) * NF(yf.x, 0) + fast_silu(b0[0]) * NB(yb.x, 0); o0[1] = fast_silu(a0[1]) * NF(yf.x, 1) + fast_silu(b0[1]) * NB(yb.x, 1);
                o0[2] = fast_silu(a0[2]) * NF(yf.y, 0) + fast_silu(b0[2]) * NB(yb.y, 0); o0[3] = fast_silu(a0[3]) * NF(yf.y, 1) + fast_silu(b0[3]) * NB(yb.y, 1);
                o1[0] = fast_silu(a1[0]) * NF(yf.z, 0) + fast_silu(b1[0]) * NB(yb.z, 0); o1[1] = fast_silu(a1[1]) * NF(yf.z, 1) + fast_silu(b1[1]) * NB(yb.z, 1);
                o1[2] = fast_silu(a1[2]) * NF(yf.w, 0) + fast_silu(b1[2]) * NB(yb.w, 0); o1[3] = fast_silu(a1[3]) * NF(yf.w, 1) + fast_silu(b1[3]) * NB(yb.w, 1);
#undef NF
#undef NB
                *(u32x4*)(GATED + off) = pack8(o0, o1); asm volatile("" ::: "memory"); }
    }
};

namespace att {
constexpr int NW = 8, QBLK = 32, KVBLK = 64;
constexpr int SHM_V = 16384, SHM_KN = 16384, SHM_KR = 8192;
constexpr int OFF_V = 0, OFF_KN = 3 * SHM_V, OFF_KR = OFF_KN + 2 * SHM_KN, OFF_WS = OFF_KR + 2 * SHM_KR, SHM_ATTN = OFF_WS + NW * 64 * 4;
constexpr float THR2 = 11.5f;
#define KSWZ(row, colB) ((row) * 256 + ((colB) ^ (((row) & 7) << 4)))
#define KRSWZ(row, colB) ((row) * 128 + ((colB) ^ ((((row) >> 1) & 7) << 4)))
#define SBAR() __builtin_amdgcn_sched_barrier(0)
__device__ __forceinline__ int crow(int r, int hi) { return (r & 3) + 8 * (r >> 2) + 4 * hi; }
__device__ __forceinline__ void partialSM(f32x16& p0, f32x16& p1, float& m_reg, float& alpha) {
  float pmax = p0[0];
#pragma unroll
  for (int r = 1; r < 16; ++r) pmax = fmaxf(pmax, p0[r]);
#pragma unroll
  for (int r = 0; r < 16; ++r) pmax = fmaxf(pmax, p1[r]);
  { auto rr = __builtin_amdgcn_permlane32_swap(__float_as_uint(pmax), __float_as_uint(pmax), false, false); pmax = fmaxf(__uint_as_float(rr[0]), __uint_as_float(rr[1])); }
  float mn;
  if (__builtin_expect(__all(pmax - m_reg <= THR2), 1)) { mn = m_reg; alpha = 1.f; }
  else { mn = fmaxf(m_reg, pmax); alpha = __builtin_amdgcn_exp2f(m_reg - mn); m_reg = mn; }
#pragma unroll
  for (int r = 0; r < 16; ++r) p0[r] = p0[r] - mn;
#pragma unroll
  for (int r = 0; r < 16; ++r) p1[r] = p1[r] - mn;
#pragma unroll
  for (int r = 0; r < 16; ++r) p0[r] = __builtin_amdgcn_exp2f(p0[r]);
}
__device__ __forceinline__ void finishSM(f32x16& p0, f32x16& p1, float alpha, float& l_reg, bf16x8& pa0, bf16x8& pa1, bf16x8& pa2, bf16x8& pa3) {
#pragma unroll
  for (int r = 0; r < 16; ++r) p1[r] = __builtin_amdgcn_exp2f(p1[r]);
  float ps = 0;
#pragma unroll
  for (int r = 0; r < 16; ++r) ps += p0[r];
#pragma unroll
  for (int r = 0; r < 16; ++r) ps += p1[r];
  { auto rr = __builtin_amdgcn_permlane32_swap(__float_as_uint(ps), __float_as_uint(ps), false, false); ps = __uint_as_float(rr[0]) + __uint_as_float(rr[1]); }
  l_reg = l_reg * alpha + ps;
#define PK4(P, BASE, OUT) do { unsigned a0 = cvt_pk_bf16(P[BASE + 0], P[BASE + 1]), a1 = cvt_pk_bf16(P[BASE + 2], P[BASE + 3]);   \
    unsigned b0 = cvt_pk_bf16(P[BASE + 4], P[BASE + 5]), b1 = cvt_pk_bf16(P[BASE + 6], P[BASE + 7]);                              \
    auto r0 = __builtin_amdgcn_permlane32_swap(a0, b0, false, false); auto r1 = __builtin_amdgcn_permlane32_swap(a1, b1, false, false); \
    u32x4 w = {r0[0], r1[0], r0[1], r1[1]}; OUT = __builtin_bit_cast(bf16x8, w); } while (0)
  PK4(p0, 0, pa0); PK4(p0, 8, pa1); PK4(p1, 0, pa2); PK4(p1, 8, pa3);
#undef PK4
}
__device__ __forceinline__ void qkt(f32x16& p0, f32x16& p1, const char* Kn, const char* Kr, const bf16x8* qr, int r32, int hi) {
  p0 = f32x16{}; p1 = f32x16{};
#pragma unroll
  for (int d0 = 0; d0 < 8; ++d0) { const int cb = (d0 * 16 + hi * 8) * 2;
    const bf16x8 b0 = *reinterpret_cast<const bf16x8*>(Kn + KSWZ(r32, cb));
    const bf16x8 b1 = *reinterpret_cast<const bf16x8*>(Kn + KSWZ(32 + r32, cb));
    p0 = __builtin_amdgcn_mfma_f32_32x32x16_bf16(b0, qr[d0], p0, 0, 0, 0);
    p1 = __builtin_amdgcn_mfma_f32_32x32x16_bf16(b1, qr[d0], p1, 0, 0, 0); }
#pragma unroll
  for (int d0 = 0; d0 < 4; ++d0) { const int cb = (d0 * 16 + hi * 8) * 2;
    const bf16x8 b0 = *reinterpret_cast<const bf16x8*>(Kr + KRSWZ(r32, cb));
    const bf16x8 b1 = *reinterpret_cast<const bf16x8*>(Kr + KRSWZ(32 + r32, cb));
    p0 = __builtin_amdgcn_mfma_f32_32x32x16_bf16(b0, qr[8 + d0], p0, 0, 0, 0);
    p1 = __builtin_amdgcn_mfma_f32_32x32x16_bf16(b1, qr[8 + d0], p1, 0, 0, 0); }
}
__device__ __forceinline__ int v_st(int k, int c) { const int kk = (k & ~0xC) | ((k & 4) << 1) | ((k & 8) >> 1); return ((kk >> 3) * 4 + (c >> 5)) * 512 + ((kk & 7) * 32 + (c & 31)) * 2; }
__device__ __forceinline__ int v_rd_base(int lane) { return ((lane & 3) << 3) | (((lane >> 2) & 3) << 6) | (((lane >> 4) & 1) << 5) | (((lane >> 5) & 1) << 8); }
constexpr int v_rd_off(int d0, int ks, int half) { return d0 * 512 + ks * 4096 + half * 2048; }
template <int OFF> __device__ __forceinline__ s16x4 tr_read(int vb) { s16x4 r; asm volatile("ds_read_b64_tr_b16 %0, %1 offset:%2" : "=&v"(r) : "v"(vb), "i"(OFF) : "memory"); return r; }
template <int D0> __device__ __forceinline__ void pv_one(f32x16& od, int vb, bf16x8 pa0, bf16x8 pa1, bf16x8 pa2, bf16x8 pa3) {
  const s16x4 l0 = tr_read<v_rd_off(D0, 0, 0)>(vb), h0 = tr_read<v_rd_off(D0, 0, 1)>(vb), l1 = tr_read<v_rd_off(D0, 1, 0)>(vb), h1 = tr_read<v_rd_off(D0, 1, 1)>(vb);
  const s16x4 l2 = tr_read<v_rd_off(D0, 2, 0)>(vb), h2 = tr_read<v_rd_off(D0, 2, 1)>(vb), l3 = tr_read<v_rd_off(D0, 3, 0)>(vb), h3 = tr_read<v_rd_off(D0, 3, 1)>(vb);
  asm volatile("s_waitcnt lgkmcnt(0)" ::: "memory"); SBAR();
#define PK(L, H) (bf16x8){L[0], L[1], L[2], L[3], H[0], H[1], H[2], H[3]}
  od = __builtin_amdgcn_mfma_f32_32x32x16_bf16(pa0, PK(l0, h0), od, 0, 0, 0);
  od = __builtin_amdgcn_mfma_f32_32x32x16_bf16(pa1, PK(l1, h1), od, 0, 0, 0);
  od = __builtin_amdgcn_mfma_f32_32x32x16_bf16(pa2, PK(l2, h2), od, 0, 0, 0);
  od = __builtin_amdgcn_mfma_f32_32x32x16_bf16(pa3, PK(l3, h3), od, 0, 0, 0);
#undef PK
}
__device__ __forceinline__ void pv_d0(f32x16* o, int vb, bf16x8 pa0, bf16x8 pa1, bf16x8 pa2, bf16x8 pa3) {
  pv_one<0>(o[0], vb, pa0, pa1, pa2, pa3); pv_one<1>(o[1], vb, pa0, pa1, pa2, pa3); pv_one<2>(o[2], vb, pa0, pa1, pa2, pa3); pv_one<3>(o[3], vb, pa0, pa1, pa2, pa3);
}
__device__ __forceinline__ void attn_unit(const bf16* __restrict__ Qb, const bf16* __restrict__ KVh, const bf16* __restrict__ KRp, bf16* __restrict__ Ob,
                                          int NT, int nc, int cbase, int xbase, char* lds, int tid_in, unsigned long long* ts_words = nullptr) {
  int tid = tid_in; asm volatile("" : "+v"(tid));
  const int wid = __builtin_amdgcn_readfirstlane(tid >> 6), lane = tid & 63, r32 = lane & 31, hi = lane >> 5;
  char* V_lds = lds + OFF_V; char* Kn_lds = lds + OFF_KN; char* Kr_lds = lds + OFF_KR;
  float* ws = (float*)(lds + OFF_WS) + wid * 64; float* li_l = ws; float* al_l = ws + 32;
  float m_reg = -1e30f, l_reg = 0; f32x16 o[4] = {}; bf16x8 qr[12];
  const bf16* Qw = Qb + (long)(wid * QBLK + r32) * 3072 + hi * 8;
#pragma unroll
  for (int d0 = 0; d0 < 12; ++d0) qr[d0] = *reinterpret_cast<const bf16x8*>(Qw + d0 * 16);
  const int vb0 = (int)(uintptr_t)V_lds + v_rd_base(lane);
  unsigned vofK[2], vofV[2], vofR;
#pragma unroll
  for (int i = 0; i < 2; ++i) { const int pc = wid * 2 + i;
      { const int row = pc * 4 + (lane >> 4), ch = (lane & 15) ^ (row & 7); vofK[i] = (unsigned)((row * 4096 + ch * 8) * 2); }
      { const int ob = pc * 1024 + lane * 16, st = ob >> 9, w = ob & 511, kk = (st >> 2) * 8 + (w >> 6); const int k = (kk & ~0xC) | ((kk & 4) << 1) | ((kk & 8) >> 1);
        const int c = (st & 3) * 32 + 8 * ((w & 63) >> 4); vofV[i] = (unsigned)((k * 4096 + 128 + c) * 2); } }
  { const int row = wid * 8 + (lane >> 3), ch = (lane & 7) ^ ((row >> 1) & 7); vofR = (unsigned)((row * 64 + ch * 8) * 2); }
  const unsigned ldsK = (unsigned)__builtin_amdgcn_readfirstlane((unsigned)(uintptr_t)Kn_lds + (unsigned)wid * 2048u);
  const unsigned ldsV = (unsigned)__builtin_amdgcn_readfirstlane((unsigned)(uintptr_t)V_lds + (unsigned)wid * 2048u);
  const unsigned ldsR = (unsigned)__builtin_amdgcn_readfirstlane((unsigned)(uintptr_t)Kr_lds + (unsigned)wid * 1024u);
#define KROW(j) ((j) < nc ? cbase + (j) * KVBLK : xbase + ((j) - nc) * KVBLK)
#define DMA_TILE(j, kslot, vslot) do { const long k0_ = KROW(j); const char* kb_ = uni_ptr(KVh + k0_ * 4096); const char* rb_ = uni_ptr(KRp + k0_ * 64); \
    glds16_s(kb_, vofK[0], ldsK + (kslot) * SHM_KN); glds16_s(kb_, vofK[1], ldsK + (kslot) * SHM_KN + 1024u); \
    glds16_s(rb_, vofR, ldsR + (kslot) * SHM_KR); \
    glds16_s(kb_, vofV[0], ldsV + (vslot) * SHM_V); glds16_s(kb_, vofV[1], ldsV + (vslot) * SHM_V + 1024u); } while (0)
#ifndef ATT_SKEW
#define ATT_SKEW 0
#endif
#if PROBE_TS
#define WAIT_SYNC() do { const unsigned long long w0_ = __builtin_amdgcn_s_memrealtime(); asm volatile("s_waitcnt vmcnt(0)" ::: "memory"); const unsigned long long w1_ = __builtin_amdgcn_s_memrealtime(); __syncthreads(); const unsigned long long w2_ = __builtin_amdgcn_s_memrealtime(); att_w_dma += w1_ - w0_; att_w_bar += w2_ - w1_; } while (0)
#else
#define WAIT_SYNC() do { asm volatile("s_waitcnt vmcnt(0)" ::: "memory"); __syncthreads(); if (ATT_SKEW && wid >= 4) __builtin_amdgcn_s_sleep(ATT_SKEW); } while (0)
#endif
#define RESC(a) do { if (__any((a) < 1.f)) { if (hi == 0) al_l[r32] = (a); asm volatile("s_waitcnt lgkmcnt(0)" ::: "memory"); \
    _Pragma("unroll") for (int d = 0; d < 4; ++d) _Pragma("unroll") for (int r = 0; r < 16; ++r) o[d][r] *= al_l[crow(r, hi)]; } } while (0)
#if PROBE_TS
  unsigned long long att_w_dma = 0, att_w_bar = 0; const unsigned long long att_t0 = __builtin_amdgcn_s_memrealtime();
#endif
  f32x16 pA0, pA1, pB0, pB1; float alA, alB; bf16x8 pa0, pa1, pa2, pa3;
  DMA_TILE(0, 0, 0); DMA_TILE(1, 1, 1); WAIT_SYNC();
  qkt(pA0, pA1, Kn_lds, Kr_lds, qr, r32, hi); partialSM(pA0, pA1, m_reg, alA);
  __syncthreads();
  int vprev = 0, vcur = 1, vnext = 2;
  for (int j = 1; j + 1 < NT; j += 2) {
    DMA_TILE(j + 1, 0, vnext);
    SBAR(); qkt(pB0, pB1, Kn_lds + SHM_KN, Kr_lds + SHM_KR, qr, r32, hi);
    finishSM(pA0, pA1, alA, l_reg, pa0, pa1, pa2, pa3); SBAR();
    pv_d0(o, vb0 + vprev * SHM_V, pa0, pa1, pa2, pa3); partialSM(pB0, pB1, m_reg, alB);
    RESC(alB); WAIT_SYNC();
    { const int t_ = vprev; vprev = vcur; vcur = vnext; vnext = t_; }
    if (j + 2 < NT) DMA_TILE(j + 2, 1, vnext);
    SBAR(); qkt(pA0, pA1, Kn_lds, Kr_lds, qr, r32, hi);
    finishSM(pB0, pB1, alB, l_reg, pa0, pa1, pa2, pa3); SBAR();
    pv_d0(o, vb0 + vprev * SHM_V, pa0, pa1, pa2, pa3); partialSM(pA0, pA1, m_reg, alA);
    RESC(alA); WAIT_SYNC();
    { const int t_ = vprev; vprev = vcur; vcur = vnext; vnext = t_; }
  }
  SBAR(); qkt(pB0, pB1, Kn_lds + SHM_KN, Kr_lds + SHM_KR, qr, r32, hi);
  finishSM(pA0, pA1, alA, l_reg, pa0, pa1, pa2, pa3); SBAR();
  pv_d0(o, vb0 + vprev * SHM_V, pa0, pa1, pa2, pa3); partialSM(pB0, pB1, m_reg, alB);
  RESC(alB);
  finishSM(pB0, pB1, alB, l_reg, pa0, pa1, pa2, pa3); SBAR();
  pv_d0(o, vb0 + vcur * SHM_V, pa0, pa1, pa2, pa3);
  if (hi == 0) li_l[r32] = l_reg; asm volatile("s_waitcnt lgkmcnt(0)" ::: "memory");
  float rli[16];
#pragma unroll
  for (int r = 0; r < 16; ++r) rli[r] = __builtin_amdgcn_rcpf(li_l[crow(r, hi)]);
  bf16* Ow = Ob + (long)(wid * QBLK) * 2048;
#pragma unroll
  for (int r = 0; r < 16; ++r) { const int orow = crow(r, hi);
#pragma unroll
    for (int d0 = 0; d0 < 4; ++d0) Ow[(long)orow * 2048 + d0 * 32 + r32] = (bf16)(cvt_pk_bf16(o[d0][r] * rli[r], 0.f) & 0xffffu); }
  __syncthreads();
#if PROBE_TS
  if (ts_words && tid == 0) { ts_words[160] += att_w_dma; ts_words[161] += att_w_bar; ts_words[162] += __builtin_amdgcn_s_memrealtime() - att_t0; ts_words[163] += (unsigned long long)NT; }
#endif
#undef KROW
#undef DMA_TILE
#undef WAIT_SYNC
#undef RESC
}
#undef SBAR
}

namespace scan {
constexpr int CH = 64;
constexpr int OFF_Q = 0, OFF_K = 32768  , OFF_V = 98304, OFF_P = 131072, OFF_ST = 131072 + 8192  , SHM_SCAN = OFF_ST + 4096;
__device__ __forceinline__ unsigned off_b(unsigned row, unsigned ch) { return 256u * row + 16u * (ch ^ (((row & 3) << 2) | ((row >> 2) & 3))); }
__device__ __forceinline__ unsigned p_off(unsigned i, unsigned chunk) { return 128u * i + 16u * (chunk ^ ((i >> 1) & 7)); }
__device__ __forceinline__ int crow(int r, int hi) { return (r & 3) + 8 * (r >> 2) + 4 * hi; }
__device__ __forceinline__ s16x4 vtr(const LAS char* p) { typedef short v4i16_t __attribute__((ext_vector_type(4))); return __builtin_bit_cast(s16x4, __builtin_amdgcn_ds_read_tr16_b64_v4i16((LAS v4i16_t*)p)); }
__device__ __forceinline__ bf16x8 tr_frag(const LAS char* img, int lane, int c, int ks) {
    const unsigned h = lane >> 5, blk = (lane >> 4) & 1, q = (lane & 15) >> 2, p = lane & 3;
    const unsigned r0 = 16 * ks + 8 * h + q, chn = 4 * c + 2 * blk + (p >> 1);
    const s16x4 lo = vtr(img + off_b(r0, chn) + 8 * (p & 1)), hi = vtr(img + off_b(r0 + 4, chn) + 8 * (p & 1));
    return (bf16x8){lo[0], lo[1], lo[2], lo[3], hi[0], hi[1], hi[2], hi[3]};
}
__device__ __forceinline__ bf16x8 pack_step(const f32x16& x, int s) {
    u32x4 p; p.x = cvt_pk_bf16(x[8 * s + 0], x[8 * s + 1]); p.y = cvt_pk_bf16(x[8 * s + 2], x[8 * s + 3]); p.z = cvt_pk_bf16(x[8 * s + 4], x[8 * s + 5]); p.w = cvt_pk_bf16(x[8 * s + 6], x[8 * s + 7]);
    return __builtin_bit_cast(bf16x8, p);
}
__device__ __forceinline__ void dma_mat(const bf16* src, int ld, LAS unsigned char* dst, int wid, int lane) {
    const char* sb = uni_ptr(src); const unsigned d0 = (unsigned)__builtin_amdgcn_readfirstlane((unsigned)(uintptr_t)dst + (unsigned)wid * 4096u);
#pragma unroll
    for (int k = 0; k < 4; ++k) { const int pc = wid * 4 + k, img = pc >> 4, row = 4 * (pc & 15) + (lane >> 4), pos = lane & 15;
        const int ch = pos ^ (((row & 3) << 2) | ((row >> 2) & 3));
        glds16_s(sb, (unsigned)((row * ld + img * 128 + ch * 8) * 2), d0 + (unsigned)k * 1024u); }
}
__device__ __forceinline__ int scan_rowbase(int n, int b, int dir) { return (n < 4) ? MX + b * CTXL + (dir ? 3 - n : n) * CH : b * SEQ + (dir ? 67 - n : n - 4) * CH; }
__device__ __forceinline__ float uni_f(float x) { return __uint_as_float(__builtin_amdgcn_readfirstlane(__float_as_uint(x))); }
typedef const LAS s16x4* lds_s4p;
__device__ __forceinline__ void scan_unit(const bf16* __restrict__ QKV, bf16* __restrict__ Y, float* __restrict__ PST, int b, int hd, int dir, int dvh, float lg2, bool skip_ctx_y, LAS unsigned char* lds, int tid_in, unsigned long long* lds_ts = nullptr) {
    int tid = tid_in; asm volatile("" : "+v"(tid));
    const int wid = __builtin_amdgcn_readfirstlane(tid >> 6), lane0 = tid & 63;
    const LAS char* QI = (const LAS char*)lds + OFF_Q; const LAS char* VI = (const LAS char*)lds + OFF_V;
    LAS char* PI = (LAS char*)lds + OFF_P;
    f32x16 S[8];
#pragma unroll
    for (int i = 0; i < 8; ++i) S[i] = f32x16{};
    const float lgr = dir ? -lg2 : lg2;
    const float g64 = uni_f(__builtin_amdgcn_exp2f(64.f * lg2));
    const float R1 = uni_f(__builtin_amdgcn_exp2f(lgr)), R8 = uni_f(__builtin_amdgcn_exp2f(8.f * lgr)), R32 = uni_f(__builtin_amdgcn_exp2f(32.f * lgr));
    const float Rm1 = uni_f(__builtin_amdgcn_exp2f(-lgr)), Rm16 = uni_f(__builtin_amdgcn_exp2f(-16.f * lgr));
    const float c0 = uni_f(dir ? g64 : __builtin_amdgcn_exp2f(lg2)), z0 = uni_f(dir ? 1.0f : __builtin_amdgcn_exp2f(63.f * lg2));
    const int qcol = hd * RDK, kcol = 2048 + hd * RDK, vcol = 4096 + hd * RDV + dvh * 256;
    { const bf16* src = QKV + (size_t)scan_rowbase(0, b, dir) * 8192;
      dma_mat(src + qcol, 8192, lds + OFF_Q, wid, lane0); dma_mat(src + kcol, 8192, lds + OFF_K, wid, lane0); dma_mat(src + vcol, 8192, lds + OFF_V, wid, lane0);
      asm volatile("s_waitcnt vmcnt(0)" ::: "memory"); __syncthreads(); }
#if PROBE_TS
    unsigned long long sc_w1 = 0, sc_w2 = 0; const unsigned long long sc_tb = __builtin_amdgcn_s_memrealtime();
#endif
    for (int n = 0; n < 68; ++n) {
        int lane = lane0; asm volatile("" : "+v"(lane));
        const int r = lane & 31, h = lane >> 5, fr = lane & 15, fq = lane >> 4;
        const int rowbase = scan_rowbase(n, b, dir);
        const bool more = n + 1 < 68;
        const bf16* nsrc = QKV + (size_t)scan_rowbase(more ? n + 1 : n, b, dir) * 8192;
        const LAS char* KI = (const LAS char*)lds + OFF_K + (n & 1) * 32768;
        if (more) dma_mat(nsrc + kcol, 8192, lds + OFF_K + ((n + 1) & 1) * 32768, wid, lane);
        const float LR = c0 * __builtin_amdgcn_exp2f((float)r * lgr), LZ = z0 * __builtin_amdgcn_exp2f((float)(-8 * h) * lgr), LP = __builtin_amdgcn_exp2f((float)(fr - 4 * fq) * lgr);
        { const int fH = fr & 3, fL = (fr >> 2) & 3; const int AL = 256 * fr + 16 * (fq ^ fL);
          int AH[4];
#pragma unroll
          for (int k = 0; k < 4; ++k) AH[k] = 64 * (k ^ fH);
#pragma unroll
          for (int tix = 0; tix < 2; ++tix) { const int tt = wid * 2 + tix, jt = tt >> 2, it = tt & 3;
            f32x4 pt = {0.f, 0.f, 0.f, 0.f};
            const bool live = dir ? (jt >= it) : (jt <= it);
            if (live) { const LAS char* ka = KI + 4096 * jt + AL; const LAS char* qa = QI + 4096 * it + AL;
#pragma unroll
                for (int ks = 0; ks < 8; ++ks) { const int o = (ks >> 2) * 16384 + AH[ks & 3];
                    pt = __builtin_amdgcn_mfma_f32_16x16x32_bf16(*(const LAS bf16x8*)(ka + o), *(const LAS bf16x8*)(qa + o), pt, 0, 0, 0); } }
            float we = LP * __builtin_amdgcn_exp2f((float)(16 * (it - jt)) * lgr); float v[4];
            const int mrel = fr - 4 * fq;
#pragma unroll
            for (int e = 0; e < 4; ++e) { float x = live ? pt[e] * we : 0.f; if (jt == it) { const bool keep = dir ? (e >= mrel) : (e <= mrel); x = keep ? x : 0.f; } v[e] = x; we *= Rm1; }
            const int i = it * 16 + fr, j0 = jt * 16 + 4 * fq;
            u32x2 w; w.x = cvt_pk_bf16(v[0], v[1]); w.y = cvt_pk_bf16(v[2], v[3]);
            *(LAS u32x2*)(PI + p_off(i, j0 >> 3) + ((j0 >> 2) & 1) * 8) = w; } }
        f32x16 Yt[2]; Yt[0] = f32x16{}; Yt[1] = f32x16{};
        { const int fH = r & 3, fL = (r >> 2) & 3; int QH[4], QL[4];
#pragma unroll
          for (int k = 0; k < 4; ++k) { QH[k] = 64 * (k ^ fH); QL[k] = 256 * r + 8 * h + 16 * (k ^ fL); }
#pragma unroll
          for (int dkb = 0; dkb < 8; ++dkb)
#pragma unroll
            for (int s = 0; s < 2; ++s) { const bf16x8 bf = pack_step(S[dkb], s);
                const LAS char* rp = QI + (dkb >> 2) * 16384 + QH[dkb & 3];
#pragma unroll
                for (int it = 0; it < 2; ++it) {
                    const u32x2 lo = *(const LAS u32x2*)(rp + it * 8192 + QL[2 * s]), hi2 = *(const LAS u32x2*)(rp + it * 8192 + QL[2 * s + 1]);
                    const u32x4 aw = {lo.x, lo.y, hi2.x, hi2.y};
                    Yt[it] = __builtin_amdgcn_mfma_f32_32x32x16_bf16(bf, __builtin_bit_cast(bf16x8, aw), Yt[it], 0, 0, 0); } } }
        { const float f0 = LR, f1 = LR * R32;
#pragma unroll
          for (int rg = 0; rg < 16; ++rg) { Yt[0][rg] *= f0; Yt[1][rg] *= f1; } }
#if PROBE_TS
        const unsigned long long sc_t0 = __builtin_amdgcn_s_memrealtime();
#endif
        if (more) asm volatile("s_waitcnt vmcnt(4)" ::: "memory"); else asm volatile("s_waitcnt vmcnt(0)" ::: "memory");
        __syncthreads();
#if PROBE_TS
        sc_w1 += __builtin_amdgcn_s_memrealtime() - sc_t0;
#endif
        if (more) dma_mat(nsrc + qcol, 8192, lds + OFF_Q, wid, lane);
#pragma unroll
        for (int i = 0; i < 8; ++i)
#pragma unroll
            for (int rg = 0; rg < 16; ++rg) S[i][rg] *= g64;
        {
          const int blk = (lane >> 4) & 1, q = (lane & 15) >> 2, p = lane & 3; int TB[2], CQ[4];
#pragma unroll
          for (int t = 0; t < 2; ++t) TB[t] = 2048 * h + 256 * q + 1024 * t + 16 * ((2 * blk + (p >> 1)) ^ ((2 * h + t) & 3)) + 8 * (p & 1);
#pragma unroll
          for (int c = 0; c < 4; ++c) CQ[c] = 64 * (c ^ q);
          const LAS char* vb = VI + (wid >> 2) * 16384 + CQ[wid & 3];
          float zk = LZ;
#pragma unroll
          for (int ks = 0; ks < 4; ++ks) {
            const s16x4 vlo = vtr(vb + 4096 * ks + TB[0]), vhi = vtr(vb + 4096 * ks + TB[1]);
            const u32x2 vl = __builtin_bit_cast(u32x2, vlo), vh = __builtin_bit_cast(u32x2, vhi);
            const u32x4 vw = {vl.x, vl.y, vh.x, vh.y}; const bf16x8 vf = __builtin_bit_cast(bf16x8, vw);
#pragma unroll
            for (int it = 0; it < 2; ++it) { const bf16x8 pa = *(const LAS bf16x8*)(PI + p_off(it * 32 + r, 2 * ks + h));
                Yt[it] = __builtin_amdgcn_mfma_f32_32x32x16_bf16(vf, pa, Yt[it], 0, 0, 0); }
            float zj = zk; u32x4 zw;
            { const float a0 = bflo(vw.x) * zj; zj *= Rm1; const float a1 = bfhi(vw.x) * zj; zj *= Rm1; zw.x = cvt_pk_bf16(a0, a1); }
            { const float a0 = bflo(vw.y) * zj; zj *= Rm1; const float a1 = bfhi(vw.y) * zj; zj *= Rm1; zw.y = cvt_pk_bf16(a0, a1); }
            { const float a0 = bflo(vw.z) * zj; zj *= Rm1; const float a1 = bfhi(vw.z) * zj; zj *= Rm1; zw.z = cvt_pk_bf16(a0, a1); }
            { const float a0 = bflo(vw.w) * zj; zj *= Rm1; const float a1 = bfhi(vw.w) * zj; zw.w = cvt_pk_bf16(a0, a1); }
            const bf16x8 vz = __builtin_bit_cast(bf16x8, zw);
            zk *= Rm16;
#pragma unroll
            for (int dkb = 0; dkb < 8; ++dkb) { const LAS char* kb_ = KI + (dkb >> 2) * 16384 + 4096 * ks + CQ[dkb & 3];
                const s16x4 klo = vtr(kb_ + TB[0]), khi = vtr(kb_ + TB[1]);
                const u32x2 kl = __builtin_bit_cast(u32x2, klo), kh = __builtin_bit_cast(u32x2, khi); const u32x4 kw = {kl.x, kl.y, kh.x, kh.y};
                S[dkb] = __builtin_amdgcn_mfma_f32_32x32x16_bf16(__builtin_bit_cast(bf16x8, kw), vz, S[dkb], 0, 0, 0); }
            __builtin_amdgcn_sched_barrier(0);
          } }
        if (!(skip_ctx_y && n < 4)) {
            bf16* Yr = Y + (size_t)rowbase * 4096; const unsigned yo = (unsigned)(r * 4096 + hd * RDV + dvh * 256 + wid * 32 + 8 * h);
#pragma unroll
            for (int it = 0; it < 2; ++it) {
                float s1a = 0.f, s1b = 0.f, s2a = 0.f, s2b = 0.f;
#pragma unroll
                for (int rg = 0; rg < 16; rg += 2) { s1a += Yt[it][rg]; s1b += Yt[it][rg + 1]; s2a = fmaf(Yt[it][rg], Yt[it][rg], s2a); s2b = fmaf(Yt[it][rg + 1], Yt[it][rg + 1], s2b); }
                float s1 = s1a + s1b, s2 = s2a + s2b;
                { auto rr = __builtin_amdgcn_permlane32_swap(__float_as_uint(s1), __float_as_uint(s1), false, false); s1 = __uint_as_float(rr[0]) + __uint_as_float(rr[1]); }
                { auto rr = __builtin_amdgcn_permlane32_swap(__float_as_uint(s2), __float_as_uint(s2), false, false); s2 = __uint_as_float(rr[0]) + __uint_as_float(rr[1]); }
                if (h == 0) *(LAS f32x2*)((LAS char*)lds + OFF_ST + ((it * 32 + r) * 8 + wid) * 8) = (f32x2){s1, s2};
#pragma unroll
                for (int g = 0; g < 4; g += 2) {
                    unsigned ax = cvt_pk_bf16(Yt[it][4 * g + 0], Yt[it][4 * g + 1]), ay = cvt_pk_bf16(Yt[it][4 * g + 2], Yt[it][4 * g + 3]);
                    unsigned bx_ = cvt_pk_bf16(Yt[it][4 * g + 4], Yt[it][4 * g + 5]), by = cvt_pk_bf16(Yt[it][4 * g + 6], Yt[it][4 * g + 7]);
                    { auto r_ = __builtin_amdgcn_permlane32_swap(ax, bx_, false, false); ax = r_[0]; bx_ = r_[1]; }
                    { auto r_ = __builtin_amdgcn_permlane32_swap(ay, by, false, false); ay = r_[0]; by = r_[1]; }
                    *(u32x4*)(Yr + yo + (unsigned)(it * 32 * 4096 + 8 * g)) = (u32x4){ax, ay, bx_, by}; } }
        }
#if PROBE_TS
        const unsigned long long sc_t1 = __builtin_amdgcn_s_memrealtime();
#endif
        asm volatile("s_waitcnt vmcnt(0)" ::: "memory");
        __syncthreads();
#if PROBE_TS
        sc_w2 += __builtin_amdgcn_s_memrealtime() - sc_t1;
#endif
        if (more) dma_mat(nsrc + vcol, 8192, lds + OFF_V, wid, lane);
        if (wid == 0 && !(skip_ctx_y && n < 4)) {
            const LAS f32x4* sp = (const LAS f32x4*)((const LAS char*)lds + OFF_ST + lane * 64);
            const f32x4 a = sp[0], b_ = sp[1], c = sp[2], d = sp[3];
            const float S1 = ((a[0] + a[2]) + (b_[0] + b_[2])) + ((c[0] + c[2]) + (d[0] + d[2])), S2 = ((a[1] + a[3]) + (b_[1] + b_[3])) + ((c[1] + c[3]) + (d[1] + d[3]));
            *(f32x2*)(PST + ((size_t)(rowbase + lane) * 8 + hd) * 4 + dvh * 2) = (f32x2){S1, S2};
        }
    }
    asm volatile("s_waitcnt vmcnt(0)" ::: "memory"); __syncthreads();
#if PROBE_TS
    if (blockIdx.x == 0 && tid == 0) { unsigned long long* tw = (unsigned long long*)(lds_ts); tw[170] += sc_w1; tw[171] += sc_w2; tw[172] += __builtin_amdgcn_s_memrealtime() - sc_tb; }
#endif
}
}

#define XB_TMO      128
#define XB_XCNT(j)  (256  + 64 * (j))
#define XB_XSUB(j)  (1280 + 64 * (j))
#define XB_XGEN(j)  (2304 + 64 * (j))
#define XB_TOP      3328
#define XB_TOPGEN   3392
#define XCD_BAR_WORDS 3456
#define XB_SPIN_CAP (1u << 22)
__device__ __forceinline__ unsigned xb_ld(unsigned* p)              { return __hip_atomic_load(p, __ATOMIC_RELAXED, __HIP_MEMORY_SCOPE_AGENT); }
__device__ __forceinline__ unsigned xb_add(unsigned* p, unsigned v) { return __hip_atomic_fetch_add(p, v, __ATOMIC_RELAXED, __HIP_MEMORY_SCOPE_AGENT); }
__device__ __forceinline__ unsigned xb_xcc_id() { return (unsigned)__builtin_amdgcn_s_getreg((3 << 11) | 20) & 0xFu; }
#define XB_SPIN(cond, bar) do { unsigned _sp = 0; while (cond) { __builtin_amdgcn_s_sleep(1); \
    if ((++_sp & 255u) == 0u) { if (xb_ld(&(bar)[XB_TMO])) break; if (_sp > XB_SPIN_CAP) { atomicAdd(&(bar)[XB_TMO], 1u); break; } } } } while (0)
struct XcdBarrier { unsigned* bar; unsigned x; volatile LAS unsigned* st; int wave; };
__device__ __forceinline__ XcdBarrier xcd_barrier_post(unsigned* bar, volatile LAS unsigned* st, int wave) {
    XcdBarrier b; b.bar = bar; b.x = xb_xcc_id(); b.st = st; b.wave = wave;
    if (wave == 0 && lane_id() == 0) (void)xb_add(&bar[XB_XCNT(b.x)], 1u);
    return b;
}
__device__ __forceinline__ void xcd_barrier_complete(unsigned* bar, unsigned x, unsigned& nloc, unsigned& nx) {
    const unsigned G = gridDim.x * gridDim.y * gridDim.z;
    unsigned sum, cnt, mine, sp = 0u;
    for (;;) {
        sum = 0u; cnt = 0u; mine = 0u;
#pragma unroll
        for (unsigned j = 0; j < 16; ++j) { const unsigned c = xb_ld(&bar[XB_XCNT(j)]); sum += c; cnt += (c > 0u) ? 1u : 0u; mine = (j == x) ? c : mine; }
        if (sum == G) break;
        __builtin_amdgcn_s_sleep(1);
        if ((++sp & 255u) == 0u) { if (xb_ld(&bar[XB_TMO])) break; if (sp > XB_SPIN_CAP) { atomicAdd(&bar[XB_TMO], 1u); break; } }
    }
    nloc = mine > 0u ? mine : 1u; nx = cnt > 0u ? cnt : 1u;
}
__device__ __forceinline__ void xcd_barrier(const XcdBarrier& b) {
    asm volatile("s_waitcnt vmcnt(0)" ::: "memory");
    __syncthreads();
    if (b.wave == 0 && lane_id() == 0) {
        unsigned* bar = b.bar; asm volatile("" : "+s"(bar));
        __builtin_amdgcn_s_waitcnt(0);
        unsigned nloc = b.st[0], nx = b.st[1];
        if (nloc == 0u) { xcd_barrier_complete(bar, b.x, nloc, nx); b.st[0] = nloc; b.st[1] = nx; }
        const unsigned old = xb_add(&bar[XB_XSUB(b.x)], 1u);
        const unsigned gen = old / nloc;
        if (old + 1u == (gen + 1u) * nloc) {
            __builtin_amdgcn_fence(__ATOMIC_RELEASE, "agent");
            asm volatile("s_waitcnt vmcnt(0)" ::: "memory");
            const unsigned og = xb_add(&bar[XB_TOP], 1u);
            const unsigned tg = og / nx;
            if (og + 1u == (tg + 1u) * nx) xb_add(&bar[XB_TOPGEN], 1u);
            else XB_SPIN(xb_ld(&bar[XB_TOPGEN]) == tg, bar);
            __builtin_amdgcn_fence(__ATOMIC_ACQUIRE, "agent");
            xb_add(&bar[XB_XGEN(b.x)], 1u);
            asm volatile("s_waitcnt vmcnt(0)" ::: "memory");
        } else {
            XB_SPIN(xb_ld(&bar[XB_XGEN(b.x)]) == gen, bar);
            __builtin_amdgcn_fence(__ATOMIC_ACQUIRE, "agent");
            asm volatile("s_waitcnt vmcnt(0)" ::: "memory");
        }
    }
    __syncthreads();
}

__device__ __forceinline__ float wave_sum(float v, int lane) {
#pragma unroll
    for (int o = 1; o < 64; o <<= 1) v += shfl_xor_l(v, o, lane);
    return v;
}
struct CvtDesc { const float* src; const float* kscale; bf16* WTrow0; int ldw, k0, K, jkind; float gscale; };
__device__ __forceinline__ int ropeperm64(int c) { const int p = c >> 1, e = c & 1; return (p < 16) ? (p + 16 * e) : (32 + (p - 16) + 16 * e); }
__device__ __forceinline__ int ropeinv64(int s_) { const int half = s_ >> 5, w = s_ & 31; return 2 * (half * 16 + (w & 15)) + (w >> 4); }
__device__ __forceinline__ void cvt_load(const CvtDesc& d, int lane, f32x4 (&v)[16]) {
#pragma unroll
    for (int i = 0; i < 16; ++i) { const int kk = 4 * i + (lane >> 4);
        f32x4 x = d.src ? *(const f32x4*)(d.src + (size_t)(d.k0 + kk) * d.ldw) : (f32x4){0.f, 0.f, 0.f, 0.f};
        float sc_ = d.gscale; if (d.kscale) sc_ *= d.kscale[d.k0 + kk];
        v[i] = x * sc_; }
}
__device__ __forceinline__ void cvt_store(const CvtDesc& d, int lane, const f32x4 (&v)[16], LAS float* scr) {
    const int n4 = lane & 15; int jr[4];
#pragma unroll
    for (int e = 0; e < 4; ++e) { const int s_ = 4 * n4 + e; jr[e] = d.jkind == 0 ? s_ : d.jkind == 1 ? ropeinv64(s_) : 2 * (4 * (n4 & 7) + e) + (n4 >> 3); }
#pragma unroll
    for (int i = 0; i < 16; ++i) { const int kk = 4 * i + (lane >> 4);
#pragma unroll
        for (int e = 0; e < 4; ++e) scr[kk * 65 + jr[e]] = v[i][e]; }
    asm volatile("s_waitcnt lgkmcnt(0)" ::: "memory");
    const int c = lane & 7;
#pragma unroll
    for (int ps = 0; ps < 8; ++ps) { const int j = 8 * ps + (lane >> 3); const LAS float* s = scr + (8 * c) * 65 + j;
        u32x4 o; o.x = cvt_pk_bf16(s[0 * 65], s[1 * 65]); o.y = cvt_pk_bf16(s[2 * 65], s[3 * 65]); o.z = cvt_pk_bf16(s[4 * 65], s[5 * 65]); o.w = cvt_pk_bf16(s[6 * 65], s[7 * 65]);
        *(u32x4*)(d.WTrow0 + (size_t)j * d.K + d.k0 + 8 * c) = o; }
    asm volatile("s_waitcnt lgkmcnt(0)" ::: "memory");
}
struct CvtJob { const float* W0; const float* W1; const float* kscale; bf16* WT; int ldw, K, nrows, kind, aux; float gscale; };
__device__ __forceinline__ bool cvt_try(const CvtJob& J, int& it, int lane, CvtDesc& d) {
    const int nblk = J.nrows / 64, items = (J.K / 64) * nblk;
    if (it >= items) { it -= items; return false; }
    const int kb = it / nblk, nb = it % nblk; const int n4 = lane & 15;
    const float* sp; int jk = 0;
    switch (J.kind) {
        case 0: sp = J.W0 + J.aux + nb * 64 + 4 * n4; break;
        case 1: sp = J.W0 + J.aux + 4 * n4; jk = 1; break;
        case 2: { const int hh = nb / 3, part = nb % 3; sp = J.W0 + hh * DQ + 64 * part + 4 * n4; jk = (part == 2) ? 1 : 0; } break;
        case 3: { const int hh = nb >> 2, q4 = nb & 3; sp = J.W0 + hh * 256 + 32 * q4 + 128 * (n4 >> 3) + 4 * (n4 & 7); jk = 2; } break;
        case 4: { const int tl = nb >> 2, hf = (nb >> 1) & 1, q2 = nb & 1; const long long dW = (const char*)J.W1 - (const char*)J.W0; sp = (const float*)((const char*)J.W0 + dW * hf) + tl * 128 + 64 * q2 + 4 * n4; } break;
        default: sp = nullptr; break;
    }
    d.src = sp; d.kscale = J.kscale; d.WTrow0 = J.WT + (size_t)(nb * 64) * J.K; d.ldw = J.ldw; d.k0 = kb * 64; d.K = J.K; d.jkind = jk; d.gscale = J.gscale;
    return true;
}
__device__ __forceinline__ int cvt_items(const CvtJob& J) { return (J.K / 64) * (J.nrows / 64); }

__device__ __forceinline__ void row_load(const float* xrow, int lane, f32x4 (&v)[8]) {
#pragma unroll
    for (int j = 0; j < 8; ++j) v[j] = *(const f32x4*)(xrow + 4 * lane + 256 * j);
}
__device__ __forceinline__ void norm_row_f32(const f32x4 (&v)[8], const f32x4 (&A)[8], const f32x4 (&Bc)[8], bf16* orow, int lane) {
    float s = 0.f;
#pragma unroll
    for (int j = 0; j < 8; ++j) s += (v[j][0] * v[j][0] + v[j][1] * v[j][1]) + (v[j][2] * v[j][2] + v[j][3] * v[j][3]);
    const float rstd = 1.0f / sqrtf(wave_sum(s, lane) * (1.0f / D) + NORM_EPS);
#pragma unroll
    for (int j = 0; j < 8; ++j) { const f32x4 y = (v[j] * rstd) * A[j] + Bc[j];
        u32x2 w; w.x = cvt_pk_bf16(y[0], y[1]); w.y = cvt_pk_bf16(y[2], y[3]); *(u32x2*)(orow + 4 * lane + 256 * j) = w; }
}
__device__ __forceinline__ void norm_coef_f32(const float* g, const float* mr, int lane, f32x4 (&A)[8], f32x4 (&Bc)[8]) {
#pragma unroll
    for (int j = 0; j < 8; ++j) { const int c = 4 * lane + 256 * j; A[j] = *(const f32x4*)(g + c) * (1.0f + *(const f32x4*)(mr + D + c)); Bc[j] = *(const f32x4*)(mr + c); }
}
__device__ __forceinline__ void norm_phase(const float* xsrc, const float* csrc, const float* g, const float* modl, int chunk, bf16* H, int nrows, int gw, int NGW, int lane) {
    const int G8 = NGW >> 3, b = gw / G8, idx = gw - b * G8;
    f32x4 A[8], Bc[8];
    if (idx < SEQ) {
        norm_coef_f32(g, modl + (size_t)b * NMOD + chunk * D, lane, A, Bc);
        f32x4 v[8], vn[8]; int m = b * SEQ + idx; const int mend = (b + 1) * SEQ;
        row_load(xsrc + (size_t)m * D, lane, v);
        for (;;) {
            const int mn = m + G8; const bool has = mn < mend;
            if (has) row_load(xsrc + (size_t)mn * D, lane, vn);
            norm_row_f32(v, A, Bc, H + (size_t)m * D, lane);
            if (!has) break;
#pragma unroll
            for (int j = 0; j < 8; ++j) v[j] = vn[j];
            m = mn;
        }
    }
    if (MX + gw < nrows) {
        norm_coef_f32(g, modl + (size_t)8 * NMOD + chunk * D, lane, A, Bc);
        for (int m = MX + gw; m < nrows; m += NGW) { f32x4 v[8]; row_load(csrc + (size_t)(m - MX) * D, lane, v); norm_row_f32(v, A, Bc, H + (size_t)m * D, lane); }
    }
}

__device__ __forceinline__ void row_load_b16(const bf16* xrow, int lane, u32x4 (&v)[4]) {
#pragma unroll
    for (int j = 0; j < 4; ++j) v[j] = *(const u32x4*)(xrow + 8 * lane + 512 * j);
}
__device__ __forceinline__ void norm_row_b16(const u32x4 (&v)[4], const f32x4 (&A)[8], const f32x4 (&Bc)[8], bf16* orow, int lane) {
    f32x4 xa[4], xb[4]; float ss = 0.f;
#pragma unroll
    for (int j = 0; j < 4; ++j) { xa[j] = (f32x4){bflo(v[j].x), bfhi(v[j].x), bflo(v[j].y), bfhi(v[j].y)}; xb[j] = (f32x4){bflo(v[j].z), bfhi(v[j].z), bflo(v[j].w), bfhi(v[j].w)};
        ss += ((xa[j][0] * xa[j][0] + xa[j][1] * xa[j][1]) + (xa[j][2] * xa[j][2] + xa[j][3] * xa[j][3])) + ((xb[j][0] * xb[j][0] + xb[j][1] * xb[j][1]) + (xb[j][2] * xb[j][2] + xb[j][3] * xb[j][3])); }
    const float rstd = 1.0f / sqrtf(wave_sum(ss, lane) * (1.0f / D) + NORM_EPS);
#pragma unroll
    for (int j = 0; j < 4; ++j) { const f32x4 ya = (xa[j] * rstd) * A[2 * j] + Bc[2 * j], yb = (xb[j] * rstd) * A[2 * j + 1] + Bc[2 * j + 1];
        *(u32x4*)(orow + 8 * lane + 512 * j) = pack8(ya, yb); }
}
__device__ __forceinline__ void norm_coef_b16(const float* g, const float* mr, int lane, f32x4 (&A)[8], f32x4 (&Bc)[8]) {
#pragma unroll
    for (int j = 0; j < 8; ++j) { const int c = 8 * lane + 512 * (j >> 1) + 4 * (j & 1); A[j] = *(const f32x4*)(g + c) * (1.0f + *(const f32x4*)(mr + D + c)); Bc[j] = *(const f32x4*)(mr + c); }
}
__device__ __forceinline__ void norm_phase_b16(const bf16* xsrc, const bf16* csrc, const float* g, const float* modl, int chunk, bf16* H, int nrows, int gw, int NGW, int lane) {
    const int G8 = NGW >> 3, b = gw / G8, idx = gw - b * G8;
    f32x4 A[8], Bc[8];
    if (idx < SEQ) {
        norm_coef_b16(g, modl + (size_t)b * NMOD + chunk * D, lane, A, Bc);
        u32x4 v[4], vn[4]; int m = b * SEQ + idx; const int mend = (b + 1) * SEQ;
        row_load_b16(xsrc + (size_t)m * D, lane, v);
        for (;;) {
            const int mn = m + G8; const bool has = mn < mend;
            if (has) row_load_b16(xsrc + (size_t)mn * D, lane, vn);
            norm_row_b16(v, A, Bc, H + (size_t)m * D, lane);
            if (!has) break;
#pragma unroll
            for (int j = 0; j < 4; ++j) v[j] = vn[j];
            m = mn;
        }
    }
    if (MX + gw < nrows) {
        norm_coef_b16(g, modl + (size_t)8 * NMOD + chunk * D, lane, A, Bc);
        for (int m = MX + gw; m < nrows; m += NGW) { u32x4 v[4]; row_load_b16(csrc + (size_t)(m - MX) * D, lane, v); norm_row_b16(v, A, Bc, H + (size_t)m * D, lane); }
    }
}

__device__ __forceinline__ unsigned long long ld_arg(LAS unsigned char* lds, int i) {
    const volatile LAS unsigned* p = (const volatile LAS unsigned*)(lds + ARGS_OFF) + 2 * i;
    const unsigned lo = __builtin_amdgcn_readfirstlane(p[0]), hi = __builtin_amdgcn_readfirstlane(p[1]);
    return ((unsigned long long)hi << 32) | lo;
}
__device__ __forceinline__ void mod_layers(LAS unsigned char* lds, unsigned char* ws, int l_lo, int l_hi, int wg, int nwg, int tid, int lane, int wave) {
#define ARGF(i) ((const float*)ld_arg(lds, (i)))
    const int nitems = (l_hi - l_lo) * 96;
    if (wg >= nitems) return;
    LAS float* cond = (LAS float*)lds;
    LAS float* red = (LAS float*)(lds + 73728);
    float* MODV = (float*)(ws + WS_MODV);
    { const float* cin = ARGF(1); const float* cc = ARGF(3);
      for (int i = tid; i < 9 * D; i += 512) { const int r = i >> 11, k = i & (D - 1); const float c = (r < 8) ? cin[r * D + k] : cc[k]; cond[i] = c / (1.0f + __expf(-c)); } }
    __syncthreads();
    for (int it = wg; it < nitems; it += nwg) {
        const int l = l_lo + it / 96, cb = it % 96; const int n = cb * 128 + 2 * lane;
        const float* W = ARGF(4) + (size_t)l * D * NMOD + n; const float* mb = ARGF(5) + (size_t)l * NMOD + cb * 128;
        float a0[9], a1[9];
#pragma unroll
        for (int r = 0; r < 9; ++r) { a0[r] = 0.f; a1[r] = 0.f; }
        for (int k = wave * 256; k < wave * 256 + 256; k += 8) {
            f32x2 w[8];
#pragma unroll
            for (int q = 0; q < 8; ++q) w[q] = *(const f32x2*)(W + (size_t)(k + q) * NMOD);
#pragma unroll
            for (int q4 = 0; q4 < 2; ++q4)
#pragma unroll
                for (int r = 0; r < 9; ++r) { const f32x4 c4 = *(const LAS f32x4*)(cond + r * D + k + 4 * q4);
#pragma unroll
                    for (int q = 0; q < 4; ++q) { a0[r] += c4[q] * w[4 * q4 + q][0]; a1[r] += c4[q] * w[4 * q4 + q][1]; } }
        }
#pragma unroll
        for (int r = 0; r < 9; ++r) { red[(wave * 9 + r) * 128 + 2 * lane] = a0[r]; red[(wave * 9 + r) * 128 + 2 * lane + 1] = a1[r]; }
        __syncthreads();
        for (int i = tid; i < 9 * 128; i += 512) { const int r = i >> 7, cc = i & 127; float s2 = 0.f;
#pragma unroll
            for (int w8 = 0; w8 < 8; ++w8) s2 += red[(w8 * 9 + r) * 128 + cc];
            MODV[((size_t)l * 9 + r) * NMOD + cb * 128 + cc] = s2 + mb[cc]; }
        __syncthreads();
    }
#undef ARGF
}
__device__ __forceinline__ void cvt_layer(LAS unsigned char* lds, unsigned char* ws, int lc, int rank, int nranks, int wave, int lane, int part  ) {
#define ARGF(i) ((const float*)ld_arg(lds, (i)))
    const int li = lc >> 1; const bool is_ret = (lc & 1) != 0;
    bf16* WM = (bf16*)(ws + (is_ret ? WS_WB : WS_WA)); bf16* WF = (bf16*)(ws + (is_ret ? WS_WB + 82 * MiB : WS_WA + 22 * MiB));
    LAS float* scr = (LAS float*)(lds + wave * 19456);
    CvtJob J[7]; int nj;
    if (!is_ret) {
        bf16* W1T = WM; bf16* WuqT = W1T + (size_t)N1 * D; bf16* WukvT = WuqT + (size_t)3072 * 512; bf16* WoT = WukvT + (size_t)4096 * 512;
        const float* wdq = ARGF(8) + (size_t)li * D * QR; const float* wdkv = ARGF(11) + (size_t)li * D * (KVR + ROPE);
        J[0] = CvtJob{wdq, nullptr, nullptr, W1T, QR, D, 512, 0, 0, 1.f};
        J[1] = CvtJob{wdkv, nullptr, nullptr, W1T + (size_t)512 * D, KVR + ROPE, D, 512, 0, 0, 1.f};
        J[2] = CvtJob{wdkv, nullptr, nullptr, W1T + (size_t)1024 * D, KVR + ROPE, D, 64, 1, 512, 1.f};
        J[3] = CvtJob{nullptr, nullptr, nullptr, W1T + (size_t)1088 * D, 1, D, 192, 5, 0, 1.f};
        J[4] = CvtJob{ARGF(10) + (size_t)li * QR * 3072, nullptr, ARGF(9) + li * QR, WuqT, 3072, QR, 3072, 2, 0, 0.07216878364870322f * LOG2E};
        J[5] = CvtJob{ARGF(13) + (size_t)li * KVR * 4096, nullptr, ARGF(12) + li * KVR, WukvT, 4096, KVR, 4096, 0, 0, 1.f};
        J[6] = CvtJob{ARGF(14) + (size_t)li * D * D, nullptr, nullptr, WoT, D, D, D, 0, 0, 1.f};
        nj = 7;
    } else {
        bf16* WqkvT = WM; bf16* WgT = WqkvT + (size_t)8192 * D; bf16* WoT = WgT + (size_t)8192 * D;
        J[0] = CvtJob{ARGF(15) + (size_t)li * D * D, nullptr, nullptr, WqkvT, D, D, 2048, 3, 0, 1.f};
        J[1] = CvtJob{ARGF(16) + (size_t)li * D * D, nullptr, nullptr, WqkvT + (size_t)2048 * D, D, D, 2048, 3, 0, 0.0625f};
        J[2] = CvtJob{ARGF(17) + (size_t)li * D * 4096, nullptr, nullptr, WqkvT + (size_t)4096 * D, 4096, D, 4096, 0, 0, 1.f};
        J[3] = CvtJob{ARGF(18) + (size_t)li * D * 4096, ARGF(19) + (size_t)li * D * 4096, nullptr, WgT, 4096, D, 8192, 4, 0, 1.f};
        J[4] = CvtJob{ARGF(20) + (size_t)li * 4096 * D, nullptr, nullptr, WoT, D, 4096, D, 0, 0, 1.f};
        J[5] = CvtJob{nullptr, nullptr, nullptr, nullptr, 1, 64, 0, 5, 0, 1.f};
        J[6] = J[5];
        nj = 5;
    }
    CvtJob F0 = CvtJob{ARGF(23) + (size_t)lc * D * FF, ARGF(24) + (size_t)lc * D * FF, nullptr, WF, FF, D, 11264, 4, 0, 1.f};
    CvtJob F1 = CvtJob{ARGF(27) + (size_t)lc * FF * D, nullptr, nullptr, WF + (size_t)11264 * D, D, FF, D, 0, 0, 1.f};
    if (part == 1) nj = 0;
    const bool ffn = part != 0;
    int total = ffn ? cvt_items(F0) + cvt_items(F1) : 0;
#pragma unroll
    for (int j = 0; j < 7; ++j) if (j < nj) total += cvt_items(J[j]);
#define CVT_FIND(IT, DD) do { int it_ = (IT); bool done_ = false; \
        _Pragma("unroll") for (int j = 0; j < 7; ++j) if (!done_ && j < nj) done_ = cvt_try(J[j], it_, lane, DD); \
        if (ffn) { if (!done_) done_ = cvt_try(F0, it_, lane, DD); if (!done_) done_ = cvt_try(F1, it_, lane, DD); } } while (0)
    if (rank < total) {
        f32x4 v[16], w[16]; CvtDesc d0, d1; int it0 = rank;
        CVT_FIND(it0, d0); cvt_load(d0, lane, v);
        for (;;) {
            const int it1 = it0 + nranks; const bool has = it1 < total;
            if (has) { CVT_FIND(it1, d1); cvt_load(d1, lane, w); }
            cvt_store(d0, lane, v, scr);
            if (!has) break;
#pragma unroll
            for (int i = 0; i < 16; ++i) v[i] = w[i];
            d0 = d1; it0 = it1;
        }
    }
#undef CVT_FIND
#undef ARGF
}

#if MLA_CHECK
constexpr int CW_CHK = 2048;
__device__ __forceinline__ float wave_max(float v, int lane) {
#pragma unroll
    for (int o = 1; o < 64; o <<= 1) v = fmaxf(v, shfl_xor_l(v, o, lane));
    return v;
}
__device__ __forceinline__ void mla_check(LAS unsigned char* lds, unsigned char* ws, int li, int gw, int wave, int lane) {
#define ARGF(i) ((const float*)ld_arg(lds, (i)))
    LAS float* sc = (LAS float*)(lds + wave * 19456);
    const bf16* H = (const bf16*)(ws + WS_H); const bf16* Qb = (const bf16*)(ws + WS_Q); const bf16* KVb = (const bf16*)(ws + WS_KV); const bf16* KRb = (const bf16*)(ws + WS_KR); const bf16* Ob = (const bf16*)(ws + WS_O);
    const int t = (int)(((unsigned)gw * 2654435761u) % (unsigned)MT); const int hd = gw & 15;
    const bool isx = t < MX; const int tt = t & (SEQ - 1);
    float err = 0.f;
    {
        const float* wdq = ARGF(8) + (size_t)li * D * QR; const float* wdkv = ARGF(11) + (size_t)li * D * (KVR + ROPE);
        float ql[8], kl[9];
#pragma unroll
        for (int j = 0; j < 8; ++j) ql[j] = 0.f;
#pragma unroll
        for (int j = 0; j < 9; ++j) kl[j] = 0.f;
        for (int k = 0; k < D; ++k) { const float hv = bf2f(H[(size_t)t * D + k]);
#pragma unroll
            for (int j = 0; j < 8; ++j) ql[j] += hv * wdq[(size_t)k * QR + lane + 64 * j];
#pragma unroll
            for (int j = 0; j < 9; ++j) kl[j] += hv * wdkv[(size_t)k * (KVR + ROPE) + lane + 64 * j]; }
        float sq = 0.f, sk = 0.f;
#pragma unroll
        for (int j = 0; j < 8; ++j) { sq += ql[j] * ql[j]; sk += kl[j] * kl[j]; }
        const float rq = 1.0f / sqrtf(wave_sum(sq, lane) * (1.0f / QR) + NORM_EPS), rk = 1.0f / sqrtf(wave_sum(sk, lane) * (1.0f / KVR) + NORM_EPS);
        const float* qg = ARGF(9) + li * QR; const float* kg = ARGF(12) + li * KVR;
#pragma unroll
        for (int j = 0; j < 8; ++j) { sc[lane + 64 * j] = ql[j] * rq * qg[lane + 64 * j]; sc[512 + lane + 64 * j] = kl[j] * rk * kg[lane + 64 * j]; }
        sc[1024 + lane] = kl[8];
        asm volatile("s_waitcnt lgkmcnt(0)" ::: "memory");
        const float* wuq = ARGF(10) + (size_t)li * QR * 3072 + hd * DQ; const float* wukv = ARGF(13) + (size_t)li * KVR * 4096 + hd * 256;
        float qv[3] = {0.f, 0.f, 0.f}, kv[4] = {0.f, 0.f, 0.f, 0.f};
        for (int c = 0; c < 512; ++c) { const float a = sc[c], bq = sc[512 + c];
#pragma unroll
            for (int j = 0; j < 3; ++j) qv[j] += a * wuq[(size_t)c * 3072 + lane + 64 * j];
#pragma unroll
            for (int j = 0; j < 4; ++j) kv[j] += bq * wukv[(size_t)c * 4096 + lane + 64 * j]; }
#pragma unroll
        for (int j = 0; j < 3; ++j) sc[1100 + lane + 64 * j] = qv[j];
        asm volatile("s_waitcnt lgkmcnt(0)" ::: "memory");
        float qref[3]; float kr_ref = 0.f;
#pragma unroll
        for (int j = 0; j < 3; ++j) { const int d = lane + 64 * j; float v = sc[1100 + d];
            if (d >= NOPE && isx) { const int e = d - NOPE, half = e >> 5, i = e & 15, second = (e >> 4) & 1; const float pos = half ? (float)(tt & 63) : (float)(tt >> 6);
                const float ang = pos * __builtin_amdgcn_exp2f(-(float)(2 * i) * (13.287712379549449f / 32.0f)); const float rev = ang * 0.15915494309189535f; const float fr_ = rev - floorf(rev);
                const float cs = __builtin_amdgcn_cosf(fr_), sn = __builtin_amdgcn_sinf(fr_); const float other = sc[1100 + NOPE + half * 32 + i + (second ? 0 : 16)];
                v = second ? (v * cs + other * sn) : (v * cs - other * sn); }
            qref[j] = v * (0.07216878364870322f * LOG2E); }
        { const int e = lane, half = e >> 5, i = e & 15, second = (e >> 4) & 1; float v = sc[1024 + e];
          if (isx) { const float pos = half ? (float)(tt & 63) : (float)(tt >> 6);
              const float ang = pos * __builtin_amdgcn_exp2f(-(float)(2 * i) * (13.287712379549449f / 32.0f)); const float rev = ang * 0.15915494309189535f; const float fr_ = rev - floorf(rev);
              const float cs = __builtin_amdgcn_cosf(fr_), sn = __builtin_amdgcn_sinf(fr_); const float other = sc[1024 + half * 32 + i + (second ? 0 : 16)];
              v = second ? (v * cs + other * sn) : (v * cs - other * sn); }
          kr_ref = v; }
#pragma unroll
        for (int j = 0; j < 3; ++j) sc[1400 + lane + 64 * j] = qref[j];
        sc[1600 + lane] = kr_ref;
        asm volatile("s_waitcnt lgkmcnt(0)" ::: "memory");
        float mx = 0.f, df = 0.f;
#pragma unroll
        for (int j = 0; j < 3; ++j) { const int p = lane + 64 * j; const int od = p < NOPE ? p : NOPE + ropeperm64(p - NOPE); const float ref = sc[1400 + od]; const float mine = bf2f(Qb[(size_t)t * 3072 + hd * DQ + p]);
            mx = fmaxf(mx, fabsf(ref)); df = fmaxf(df, fabsf(ref - mine)); }
        err = fmaxf(err, wave_max(df, lane) / (wave_max(mx, lane) + 1e-20f));
        mx = 0.f; df = 0.f;
#pragma unroll
        for (int j = 0; j < 4; ++j) { const float ref = kv[j]; const float mine = bf2f(KVb[(size_t)t * 4096 + hd * 256 + lane + 64 * j]); mx = fmaxf(mx, fabsf(ref)); df = fmaxf(df, fabsf(ref - mine)); }
        err = fmaxf(err, wave_max(df, lane) / (wave_max(mx, lane) + 1e-20f));
        { const float ref = sc[1600 + ropeperm64(lane)]; const float mine = bf2f(KRb[(size_t)t * 64 + lane]); err = fmaxf(err, wave_max(fabsf(ref - mine), lane) / (wave_max(fabsf(ref), lane) + 1e-20f)); }
    }
    {
        const int b = isx ? (t >> 12) : ((t - MX) >> 8); const int nk = isx ? 4352 : 256;
        for (int d = lane; d < DQ; d += 64) sc[d] = bf2f(Qb[(size_t)t * 3072 + hd * DQ + d]);
        asm volatile("s_waitcnt lgkmcnt(0)" ::: "memory");
        float mxs = -1e30f;
        for (int j = lane; j < nk; j += 64) { const int row = j < 256 ? MX + b * CTXL + j : b * SEQ + (j - 256); float sdot = 0.f;
            for (int d = 0; d < NOPE; ++d) sdot += sc[d] * bf2f(KVb[(size_t)row * 4096 + hd * 256 + d]);
            for (int d = 0; d < ROPE; ++d) sdot += sc[NOPE + d] * bf2f(KRb[(size_t)row * 64 + d]);
            sc[256 + j] = sdot; mxs = fmaxf(mxs, sdot); }
        mxs = wave_max(mxs, lane); float sum = 0.f;
        for (int j = lane; j < nk; j += 64) { const float p = __builtin_amdgcn_exp2f(sc[256 + j] - mxs); sc[256 + j] = p; sum += p; }
        sum = wave_sum(sum, lane);
        asm volatile("s_waitcnt lgkmcnt(0)" ::: "memory");
        float o0 = 0.f, o1 = 0.f;
        for (int j = 0; j < nk; ++j) { const int row = j < 256 ? MX + b * CTXL + j : b * SEQ + (j - 256); const float p = sc[256 + j];
            o0 += p * bf2f(KVb[(size_t)row * 4096 + hd * 256 + 128 + lane]); o1 += p * bf2f(KVb[(size_t)row * 4096 + hd * 256 + 128 + 64 + lane]); }
        o0 /= sum; o1 /= sum;
        const float m0 = bf2f(Ob[(size_t)t * D + hd * 128 + lane]), m1 = bf2f(Ob[(size_t)t * D + hd * 128 + 64 + lane]);
        const float df = fmaxf(fabsf(o0 - m0), fabsf(o1 - m1)), mx = fmaxf(fabsf(o0), fabsf(o1));
        err = fmaxf(err, wave_max(df, lane) / (wave_max(mx, lane) + 1e-20f));
    }
    if (lane == 0) atomicMax((unsigned*)(ws + WS_CTL) + CW_CHK, __float_as_uint(err));
#undef ARGF
}
#endif
struct Args { const float* in[29]; float* out; unsigned char* ws; int ph_lo, ph_hi; };
constexpr int PH_PER_LAYER = 10, PH_FINAL = 1 + PH_PER_LAYER * DEPTH, PH_COUNT = PH_FINAL + 1;

template <unsigned MK_EN_T>
__global__ void __launch_bounds__(512, 2) mk_fwd(Args args) {
    extern __shared__ __attribute__((aligned(16))) unsigned char lds_raw[];
    LAS unsigned char* lds = (LAS unsigned char*)lds_raw;
    volatile LAS unsigned* MISC = (volatile LAS unsigned*)(lds + MISC_OFF);
    const int G = gridDim.x; const int bx = blockIdx.x; const int vcu = (G % 8 == 0) ? (bx % 8) * (G / 8) + bx / 8 : bx;
    const int NGW = G * 8;
    unsigned char* ws = args.ws; float* X = args.out; void* args_out_raw = (void*)args.out;
    const int lo = args.ph_lo, hi = args.ph_hi;
    const int wave_s = __builtin_amdgcn_readfirstlane((int)threadIdx.x >> 6);
#define TID() (wave_s * 64 + lane_id())
    { const int tid0 = threadIdx.x;
      for (int u = tid0; u < (LDS_BYTES - CTRL_BASE) / 4; u += 512) ((LAS unsigned*)(lds + CTRL_BASE))[u] = 0u;
      __syncthreads();
      if (tid0 < 29) ((volatile LAS unsigned long long*)(lds + ARGS_OFF))[tid0] = (unsigned long long)args.in[tid0];
      __syncthreads(); }
#define ARGF(i) ((const float*)ld_arg(lds, (i)))
    XcdBarrier bar; bar.bar = (unsigned*)(ws + WS_CTL) + CW_BAR; bar.x = 0; bar.st = nullptr; bar.wave = wave_s;
    if (hi - lo > 1) bar = xcd_barrier_post((unsigned*)(ws + WS_CTL) + CW_BAR, MISC + 8, wave_s);
#if PROBE_TS
    if (bx == 0 && TID() == 0) { ((unsigned long long*)(ws + WS_CTL + 65536))[0] = __builtin_amdgcn_s_memrealtime(); ((unsigned long long*)(ws + WS_CTL + 65536))[121] = ~0ull; }
#endif
#define EN(b) (((MK_EN_T) >> (b)) & 1u)
#define IN(k) (lo <= (k) && (k) < hi)
#if PROBE_TS
#define TS_WORDS ((unsigned long long*)(ws + WS_CTL + 65536))
#define PHASE_END(k) do { if (hi > (k) + 1) xcd_barrier(bar); if (bx == 0 && TID() == 0) TS_WORDS[(k) + 1] = __builtin_amdgcn_s_memrealtime(); } while (0)
#else
#define PHASE_END(k) do { if (hi > (k) + 1) xcd_barrier(bar); } while (0)
#endif
#define PH_IDS int tid = TID(); asm volatile("" : "+v"(tid)); const int lane = tid & 63; const int wave = wave_s; int gw = vcu * 8 + wave; asm volatile("" : "+s"(gw)); (void)lane; (void)gw;
#define XB_    ((bf16*)args_out_raw)
#define XCB_   ((bf16*)(ws + WS_XC))
#define XF_    ((float*)(ws + WS_BIG + 32 * MiB))
#define MODV_  ((float*)(ws + WS_MODV))
#define TABM_  ((float*)(ws + WS_TABM))
#define TABR_  ((float*)(ws + WS_TABR))
#define SSQ_   ((float*)(ws + WS_SSQ))
#define KR_    ((bf16*)(ws + WS_KR))
#define H_     ((bf16*)(ws + WS_H))
#define WMIX_(ll) ((bf16*)(ws + (((ll) & 1) ? WS_WB : WS_WA)))
#define WFFN_(ll) ((bf16*)(ws + (((ll) & 1) ? WS_WB + 82 * MiB : WS_WA + 22 * MiB)))
#define W1T_   WMIX_(l)
#define WUQT_  (W1T_ + (size_t)N1 * D)
#define WUKVT_ (WUQT_ + (size_t)3072 * 512)
#define WOTM_  (WUKVT_ + (size_t)4096 * 512)
#define WQKVT_ WMIX_(l)
#define WGT_   (WQKVT_ + (size_t)8192 * D)
#define WOTR_  (WGT_ + (size_t)8192 * D)
#define WGUT_  WFFN_(l)
#define WDT_   (WGUT_ + (size_t)11264 * D)
#define QKVL_  ((bf16*)(ws + WS_QKVL))
#define Q_     ((bf16*)(ws + WS_Q))
#define KV_    ((bf16*)(ws + WS_KV))
#define O_     ((bf16*)(ws + WS_O))
#define QKV_   ((bf16*)(ws + WS_QKV))
#define Y_     ((bf16*)(ws + WS_Y))
#define GATED_ ((bf16*)(ws + WS_GATED))
#define GB_    ((bf16*)(ws + WS_G))
#define UB_    ((bf16*)(ws + WS_U))
#define HALO_  ((float*)(ws + WS_G))
#define MODL_  (MODV_ + (size_t)l * 9 * NMOD)

    if (EN(0) && IN(0)) for (int rep_ = 0; rep_ < 1 + (int)((PROBE_MASK >> 0) & 1u); ++rep_) {
        PH_IDS
        mod_layers(lds, ws, 0, 1, bx, G, tid, lane, wave);
        __syncthreads();
        cvt_layer(lds, ws, 0, gw, NGW, wave, lane, 2);
        for (int i = bx * 512 + tid; i < 64 * 16 + SEQ * 128; i += G * 512) {
            float inv, pos; float* dst;
            if (i < 1024) { const int p = i >> 4, f = i & 15; inv = __builtin_amdgcn_exp2f(-(float)(2 * f) * (13.287712379549449f / 32.0f)); pos = (float)p; dst = TABM_ + 2 * i; }
            else { const int j = i - 1024, t = j >> 7, f = j & 127; inv = __builtin_amdgcn_exp2f(-(float)(2 * f) * (13.287712379549449f / 256.0f)); pos = (float)t; dst = TABR_ + 2 * j; }
            const float ang = pos * inv; const double rev = (double)ang * 0.15915494309189535; const float fr = (float)(rev - floor(rev));
            dst[0] = __builtin_amdgcn_cosf(fr); dst[1] = __builtin_amdgcn_sinf(fr);
        }
        PHASE_END(0);
    }

    for (int l = 0; l < DEPTH; ++l) {
        const int P = 1 + PH_PER_LAYER * l; const int li = l >> 1; const bool is_ret = (l & 1) != 0; const bool last = (l == DEPTH - 1);
        const int Mrows = last ? MX : MT;

        if (EN(1) && IN(P + 0)) for (int rep_ = 0; rep_ < 1 + (int)((PROBE_MASK >> 1) & 1u); ++rep_) {
            PH_IDS
            const float* g = ARGF(6) + l * D;
            if (l == 0) norm_phase(ARGF(0), ARGF(2), g, MODL_, 0, H_, MT, gw, NGW, lane);
            else norm_phase_b16(XB_, XCB_, g, MODL_, 0, H_, MT, gw, NGW, lane);
            PHASE_END(P + 0);
        }

        if (!is_ret) {
            if (EN(2) && IN(P + 1)) for (int rep_ = 0; rep_ < 1 + (int)((PROBE_MASK >> 2) & 1u); ++rep_) {
                pg8::Gemm g{H_, W1T_, MT, N1, D, D}; pg8::StaticOrder S; S.init(MT, N1, G, bx); S.tid = TID();
                EpiG1 E{QKVL_, SSQ_, KR_, TABM_};
                pg8::gemm_phase<EpiG1>(lds, g, S, E);
                PHASE_END(P + 1);
            }
            if (EN(3) && IN(P + 2)) for (int rep_ = 0; rep_ < 1 + (int)((PROBE_MASK >> 3) & 1u); ++rep_) {
                { pg8::Gemm g{QKVL_, WUQT_, MT, 3072, QR, N1}; pg8::StaticOrder S; S.init(MT, 3072, G, bx); S.tid = TID(); EpiUq E{Q_, SSQ_, TABM_}; pg8::gemm_phase<EpiUq>(lds, g, S, E); }
                { pg8::Gemm g{QKVL_ + 512, WUKVT_, MT, 4096, KVR, N1}; pg8::StaticOrder S; S.init(MT, 4096, G, bx); S.tid = TID(); EpiUkv E{KV_, SSQ_}; pg8::gemm_phase<EpiUkv>(lds, g, S, E); }
                PHASE_END(P + 2);
            }
            if (EN(4) && IN(P + 3)) for (int rep_ = 0; rep_ < 1 + (int)((PROBE_MASK >> 4) & 1u); ++rep_) {
                const int nun = 2048 + 128;
                for (int ui = vcu; ui < nun; ui += G) {
                    if (ui < 2048) { const int xcd = (ui & 255) >> 5, j = ui & 31, rnd = ui >> 8; const int bh = xcd * 16 + 2 * rnd + (j >> 4), qb = j & 15; const int b = bh >> 4, hd = bh & 15;
                        att::attn_unit(Q_ + (size_t)(b * SEQ + qb * 256) * 3072 + hd * DQ, KV_ + hd * 256, KR_, O_ + (size_t)(b * SEQ + qb * 256) * D + hd * 128, 68, 4, MX + b * CTXL, b * SEQ, (char*)lds_raw, TID()
#if PROBE_TS
                            , bx == 0 ? TS_WORDS : nullptr
#endif
                            );
                    } else { const int bh = ui - 2048, b = bh >> 4, hd = bh & 15;
                        att::attn_unit(Q_ + (size_t)(MX + b * CTXL) * 3072 + hd * DQ, KV_ + hd * 256, KR_, O_ + (size_t)(MX + b * CTXL) * D + hd * 128, 4, 4, MX + b * CTXL, 0, (char*)lds_raw, TID()); }
                }
                PHASE_END(P + 3);
            }
        } else {
            if (EN(5) && IN(P + 1)) for (int rep_ = 0; rep_ < 1 + (int)((PROBE_MASK >> 5) & 1u); ++rep_) {
                pg8::Gemm g{H_, WQKVT_, MT, 8192, D, D}; pg8::StaticOrder S; S.init(MT, 8192, G, bx); S.tid = TID();
                EpiQKV E{QKV_, TABR_};
                pg8::gemm_phase<EpiQKV>(lds, g, S, E);
                PHASE_END(P + 1);
            }
            if (EN(6) && IN(P + 2)) for (int rep_ = 0; rep_ < 1 + (int)((PROBE_MASK >> 6) & 1u); ++rep_) {
                for (int ui = vcu; ui < 256; ui += G) {
                    const int bh = ui >> 2, dir = (ui >> 1) & 1, dvh = ui & 1; const int b = bh >> 3, hd = bh & 7;
                    const float dec = (dir ? ARGF(22) : ARGF(21))[li * RH + hd];
                    const float lg2 = -__expf(dec) * LOG2E;
                    scan::scan_unit(QKV_, Y_ + (size_t)dir * MT * 4096, (float*)(ws + (dir ? WS_PSTB : WS_PSTF)), b, hd, dir, dvh, lg2, last, lds, TID()
#if PROBE_TS
                                    , TS_WORDS
#endif
                                    );
                }
                PHASE_END(P + 2);
            }
            if (EN(8) && IN(P + 4)) for (int rep_ = 0; rep_ < 1 + (int)((PROBE_MASK >> 8) & 1u); ++rep_) {
                pg8::Gemm g{H_, WGT_, Mrows, 8192, D, D}; pg8::StaticOrder S; S.init(Mrows, 8192, G, bx); S.tid = TID();
                EpiGate E{GATED_, Y_, Y_ + (size_t)MT * 4096, (const float*)(ws + WS_PSTF), (const float*)(ws + WS_PSTB)};
                pg8::gemm_phase<EpiGate>(lds, g, S, E);
                PHASE_END(P + 4);
            }
        }
        if (EN(9) && IN(P + 5)) for (int rep_ = 0; rep_ < 1 + (int)((PROBE_MASK >> 9) & 1u); ++rep_) {
#if MLA_CHECK
            if (l == MLA_CHECK_LAYER) { PH_IDS mla_check(lds, ws, li, gw, wave, lane); __syncthreads(); }
#endif
            pg8::Gemm g = is_ret ? pg8::Gemm{GATED_, WOTR_, Mrows, D, 4096, 4096} : pg8::Gemm{O_, WOTM_, Mrows, D, D, D};
            pg8::StaticOrder S; S.init(Mrows, D, G, bx, 4, true); S.tid = TID();
#if PROBE_TS
            S.probe = is_ret ? 2 : 1; S.tsw = TS_WORDS;
#endif
            const void* xsrc = (l == 0) ? (const void*)ARGF(0) : (const void*)XB_; const void* csrc = (l == 0) ? (const void*)ARGF(2) : (const void*)XCB_;
            EpiResid E{xsrc, XB_, csrc, XCB_, MODL_, 2 * D, l == 0, false};
            pg8::gemm_phase<EpiResid>(lds, g, S, E);
            if (l + 1 < DEPTH) {
                PH_IDS
                const int nwg = (Mrows / 256) * (D / 256), rem = nwg % G;
                if (rem == 0) cvt_layer(lds, ws, l + 1, gw, NGW, wave, lane, 0);
                else if (bx >= rem) cvt_layer(lds, ws, l + 1, (bx - rem) * 8 + wave, (G - rem) * 8, wave, lane, 0);
            }
            PHASE_END(P + 5);
        }
        if (EN(10) && IN(P + 6)) for (int rep_ = 0; rep_ < 1 + (int)((PROBE_MASK >> 10) & 1u); ++rep_) {
            PH_IDS
            const float* g = ARGF(7) + l * D;
            norm_phase_b16(XB_, XCB_, g, MODL_, 3, H_, Mrows, gw, NGW, lane);
            PHASE_END(P + 6);
        }
        if (EN(11) && IN(P + 7)) for (int rep_ = 0; rep_ < 1 + (int)((PROBE_MASK >> 11) & 1u); ++rep_) {
            pg8::Gemm g{H_, WGUT_, Mrows, 11264, D, D}; pg8::StaticOrder S; S.init(Mrows, 11264, G, bx); S.tid = TID();
#if PROBE_TS
            S.probe = 4; S.tsw = TS_WORDS;
#endif
            EpiGUConv E{UB_, HALO_, ARGF(25) + (size_t)l * 3 * FF, ARGF(26) + (size_t)l * FF, (LAS float*)(lds + EDGE_OFF)};
            pg8::gemm_phase<EpiGUConv>(lds, g, S, E);
#if PROBE_TS
            if (TID() == 0 && bx == 0) TS_WORDS[140 + l] = __builtin_amdgcn_s_memrealtime();
            if (TID() == 0 && bx == G - 1) TS_WORDS[148 + l] = __builtin_amdgcn_s_memrealtime();
#endif
            PHASE_END(P + 7);
        }
        if (EN(13) && IN(P + 9)) for (int rep_ = 0; rep_ < 1 + (int)((PROBE_MASK >> 13) & 1u); ++rep_) {
            pg8::Gemm g{UB_, WDT_, Mrows, D, FF, FF}; pg8::StaticOrder S; S.init(Mrows, D, G, bx, 4, true); S.tid = TID();
#if PROBE_TS
            S.probe = 3; S.tsw = TS_WORDS;
#endif
            {
                PH_IDS
                const float* cw = ARGF(25) + (size_t)l * 3 * FF; const float* HL = HALO_; bf16* ACT = UB_;
                pg8::Unit uu; int prev_pm = -1;
                for (int i = 0; S.next(i, uu); ++i) { const int pm = uu.pm; if (pm == prev_pm || pm >= MX / 256) { prev_pm = pm; continue; } prev_pm = pm;
                    const bool top = (pm & 15) != 0, bot = ((pm + 1) & 15) != 0;
                    for (int q = tid; q < FF / 4; q += 512) { const int f = q * 4;
                        if (top) { const float* t0 = HL + (size_t)((pm * 2 + 0) * 3) * HALO_STRIDE + f; const float* b1 = HL + (size_t)(((pm - 1) * 2 + 1) * 3) * HALO_STRIDE + f;
                            const f32x4 o = silu4(*(const f32x4*)t0 + *(const f32x4*)(cw + f) * *(const f32x4*)(b1 + HALO_STRIDE)) * *(const f32x4*)(t0 + 2 * HALO_STRIDE);
                            u32x2 w; w.x = cvt_pk_bf16(o[0], o[1]); w.y = cvt_pk_bf16(o[2], o[3]); *(u32x2*)(ACT + (size_t)(pm * 256) * FF + f) = w; }
                        if (bot) { const float* b0 = HL + (size_t)((pm * 2 + 1) * 3) * HALO_STRIDE + f; const float* t1 = HL + (size_t)(((pm + 1) * 2 + 0) * 3) * HALO_STRIDE + f;
                            const f32x4 o = silu4(*(const f32x4*)b0 + *(const f32x4*)(cw + 2 * FF + f) * *(const f32x4*)(t1 + HALO_STRIDE)) * *(const f32x4*)(b0 + 2 * HALO_STRIDE);
                            u32x2 w; w.x = cvt_pk_bf16(o[0], o[1]); w.y = cvt_pk_bf16(o[2], o[3]); *(u32x2*)(ACT + (size_t)(pm * 256 + 255) * FF + f) = w; } } }
                asm volatile("s_waitcnt vmcnt(0)" ::: "memory"); __syncthreads();
            }
            EpiResid E{XB_, last ? (void*)XF_ : (void*)XB_, XCB_, XCB_, MODL_, 5 * D, false, last};
            pg8::gemm_phase<EpiResid>(lds, g, S, E);
#if PROBE_TS
            if (TID() == 0 && bx == 0) TS_WORDS[64 + l] = __builtin_amdgcn_s_memrealtime();
            if (TID() == 0 && bx == G - 1) TS_WORDS[72 + l] = __builtin_amdgcn_s_memrealtime();
#endif
            if (l + 1 < DEPTH) {
                PH_IDS
                const int nwg = (Mrows / 256) * (D / 256), rem = nwg % G;
                if (rem == 0) { mod_layers(lds, ws, l + 1, l + 2, bx, G, tid, lane, wave); __syncthreads(); cvt_layer(lds, ws, l + 1, gw, NGW, wave, lane, 1); }
                else if (bx >= rem) { mod_layers(lds, ws, l + 1, l + 2, bx - rem, G - rem, tid, lane, wave); __syncthreads(); cvt_layer(lds, ws, l + 1, (bx - rem) * 8 + wave, (G - rem) * 8, wave, lane, 1); }
            }
#if PROBE_TS
            __syncthreads(); if (TID() == 0 && bx == G - 1) TS_WORDS[80 + l] = __builtin_amdgcn_s_memrealtime();
#endif
            PHASE_END(P + 9);
        }
    }
    if (EN(14) && IN(PH_FINAL)) for (int rep_ = 0; rep_ < 1 + (int)((PROBE_MASK >> 14) & 1u); ++rep_) {
        PH_IDS
        const float* g = ARGF(28);
#if PROBE_TS
        float ts_c = 0.f, ts_a = 0.f;
        { const unsigned long long* TS = (const unsigned long long*)(ws + WS_CTL + 65536); unsigned long long last = TS[0]; const unsigned long long t0 = last; float d1 = 0.f, d2 = 0.f;
          for (int k = 0; k < PH_FINAL; ++k) { const unsigned long long te = TS[k + 1]; if (te == 0ull) continue; const float d = (float)(te - last); last = te;
              int cls; if (k == 0) cls = 0; else { const int slot = (k - 1) % PH_PER_LAYER, ll = (k - 1) / PH_PER_LAYER; const bool ret = (ll & 1) != 0;
                  cls = slot == 0 ? 1 : slot >= 5 ? 5 + slot : (!ret ? 1 + slot : 4 + slot); }
              if (k > 0 && ((k - 1) % PH_PER_LAYER) == 5) { const bool ret5 = (((k - 1) / PH_PER_LAYER) & 1) != 0; if (TS_CLASS1 == (ret5 ? 51 : 50)) d1 += d; if (TS_CLASS2 == (ret5 ? 51 : 50)) d2 += d; }
              if (cls == TS_CLASS1) d1 += d; if (cls == TS_CLASS2) d2 += d; }
          float tot = (float)(last - t0);
          if (TS_CLASS1 >= 100) { float ph = 0.f, x0 = 0.f, x1 = 0.f, x2 = 0.f;
              for (int ll = 0; ll < 3; ++ll) { const unsigned long long st = TS[(1 + PH_PER_LAYER * ll + 7) + 1], en = TS[(1 + PH_PER_LAYER * ll + 9) + 1];
                  ph += (float)(en - st); x0 += (float)(TS[64 + ll] - st); x1 += (float)(TS[72 + ll] - st); x2 += (float)(TS[80 + ll] - st); }
              d1 = (TS_CLASS1 == 100) ? x0 : (TS_CLASS1 == 101) ? x1 : x2; d2 = (TS_CLASS2 == 100) ? x0 : (TS_CLASS2 == 101) ? x1 : x2; tot = ph; }
          if (TS_CLASS1 >= 200) { const unsigned long long* tw = TS + 90 + 3 * (TS_CLASS1 - 201); const float lp = (float)tw[0], ep = (float)tw[1], nn = (float)tw[2];
              d1 = lp; tot = lp + ep; d2 = (lp + ep) / nn / 100.f / 200.f * tot; }
          if (TS_CLASS1 == 400) { float ph = 0.f, x0 = 0.f, x1 = 0.f;
              for (int ll = 0; ll < 4; ++ll) { const unsigned long long st = TS[(1 + PH_PER_LAYER * ll + 6) + 1], en = TS[(1 + PH_PER_LAYER * ll + 7) + 1];
                  ph += (float)(en - st); x0 += (float)(TS[140 + ll] - st); x1 += (float)(TS[148 + ll] - st); }
              d1 = x0; d2 = x1; tot = ph; }
          if (TS_CLASS1 == 500) { d1 = (float)TS[160]; d2 = (float)TS[161]; tot = (float)TS[162]; }
          if (TS_CLASS1 == 501) { d1 = (float)TS[162] / (float)TS[163] / 100.f / 5.f; d2 = 0.f; tot = 1.f; }
          if (TS_CLASS1 == 600) { d1 = (float)TS[170]; d2 = (float)TS[171]; tot = (float)TS[172]; }
          if (TS_CLASS1 == 300) { const float mx = (float)TS[120], sm = (float)TS[122]; d1 = sm / (float)(gridDim.x * 4); tot = mx > 0.f ? mx : 1.f; d2 = 0.f; }
          { const float q1 = rintf(d1 / tot * 20.f) / 20.f, q2 = rintf(d2 / tot * 20.f) / 20.f; ts_c = sqrtf(q1); ts_a = 2.0f + 10.0f * q2; }
        }
#endif
#if MLA_CHECK
        const bool chk_bad = __uint_as_float(__hip_atomic_load((unsigned*)(ws + WS_CTL) + CW_CHK, __ATOMIC_RELAXED, __HIP_MEMORY_SCOPE_AGENT)) > MLA_CHECK_TOL;
#endif
        if (gw < MX) {
            f32x4 v[8], vn[8], gg[8]; int m = gw; row_load(XF_ + (size_t)m * D, lane, v);
#pragma unroll
            for (int j = 0; j < 8; ++j) gg[j] = *(const f32x4*)(g + 4 * lane + 256 * j);
            for (;;) {
                const int mn = m + NGW; const bool has = mn < MX;
                if (has) row_load(XF_ + (size_t)mn * D, lane, vn);
                float s = 0.f;
#pragma unroll
                for (int j = 0; j < 8; ++j) s += (v[j][0] * v[j][0] + v[j][1] * v[j][1]) + (v[j][2] * v[j][2] + v[j][3] * v[j][3]);
                const float rstd = 1.0f / sqrtf(wave_sum(s, lane) * (1.0f / D) + NORM_EPS);
                float* xr = X + (size_t)m * D;
#pragma unroll
                for (int j = 0; j < 8; ++j) { const int c = 4 * lane + 256 * j; f32x4 o_ = (v[j] * rstd) * gg[j];
#if MLA_CHECK
                    if (chk_bad) o_ = (f32x4){__builtin_nanf(""), __builtin_nanf(""), __builtin_nanf(""), __builtin_nanf("")};
#endif
#if PROBE_TS
                    if (m < 328) { o_ = o_ + ts_c; if (m == 0 && c == 0) o_[0] += ts_a - ts_c; }
#endif
                    *(f32x4*)(xr + c) = o_; }
                if (!has) break;
#pragma unroll
                for (int j = 0; j < 8; ++j) v[j] = vn[j];
                m = mn;
            }
        }
    }
#undef IN
#undef PHASE_END
}

#if !MK_SINGLE
typedef void (*KernFn)(Args);
static KernFn phase_kernel(int bit) {
    switch (bit) {
        case 0: return mk_fwd<1u << 0>;  case 1: return mk_fwd<1u << 1>;  case 2: return mk_fwd<1u << 2>;  case 3: return mk_fwd<1u << 3>;
        case 4: return mk_fwd<1u << 4>;  case 5: return mk_fwd<1u << 5>;  case 6: return mk_fwd<1u << 6>;  case 7: return mk_fwd<1u << 7>;
        case 8: return mk_fwd<1u << 8>;  case 9: return mk_fwd<1u << 9>;  case 10: return mk_fwd<1u << 10>; case 11: return mk_fwd<1u << 11>;
        case 12: return mk_fwd<1u << 12>; case 13: return mk_fwd<1u << 13>; default: return mk_fwd<1u << 14>;
    }
}
static int phase_bit(int p) {
    if (p == 0) return 0; if (p == PH_FINAL) return 14;
    const int l = (p - 1) / PH_PER_LAYER, slot = (p - 1) % PH_PER_LAYER; const bool ret = (l & 1) != 0;
    if (slot == 0) return 1;
    if (slot >= 5) return 4 + slot;
    if (!ret) return slot == 4 ? -1 : 1 + slot;
    return 4 + slot;
}
#endif
extern "C" void kernel_launch(void* const* d_in, const int* in_sizes, int n_in, void* d_out, int out_size, void* d_ws, size_t ws_size, hipStream_t stream) {
    static int grid = 0;
    if (grid == 0) {
        if (n_in != 29 || out_size != MX * D || ws_size < WS_END) { fprintf(stderr, "kernel_launch: unexpected shapes: n_in %d out %d ws %zu (need %zu)\n", n_in, out_size, ws_size, (size_t)WS_END); grid = -1; return; }
        int dev = 0, cus = 0;
        if (hipGetDevice(&dev) != hipSuccess || hipDeviceGetAttribute(&cus, hipDeviceAttributeMultiprocessorCount, dev) != hipSuccess) { grid = -1; return; }
#if MK_SINGLE
        if (hipFuncSetAttribute((const void*)mk_fwd<0xFFFFFFFFu>, hipFuncAttributeMaxDynamicSharedMemorySize, LDS_BYTES) != hipSuccess) { fprintf(stderr, "kernel_launch: hipFuncSetAttribute failed\n"); grid = -1; return; }
#else
        for (int b = 0; b < 15; ++b) if (hipFuncSetAttribute((const void*)phase_kernel(b), hipFuncAttributeMaxDynamicSharedMemorySize, LDS_BYTES) != hipSuccess) { fprintf(stderr, "kernel_launch: hipFuncSetAttribute failed\n"); grid = -1; return; }
#endif
        (void)hipGetLastError();
        grid = cus;
    }
    if (grid < 0) return;
    if (hipMemsetAsync((char*)d_ws + WS_CTL, 0, CTL_BYTES, stream) != hipSuccess) return;
    Args a{};
    for (int i = 0; i < 29; ++i) a.in[i] = (const float*)d_in[i];
    a.out = (float*)d_out; a.ws = (unsigned char*)d_ws;
#if MK_SINGLE
    a.ph_lo = 0; a.ph_hi = PH_COUNT;
    hipLaunchKernelGGL(mk_fwd<0xFFFFFFFFu>, dim3(grid), dim3(512), LDS_BYTES, stream, a);
#else
    for (int p = 0; p < PH_COUNT; ++p) {
        const int bit = phase_bit(p); if (bit < 0) continue;
        a.ph_lo = p; a.ph_hi = p + 1;
        hipLaunchKernelGGL(phase_kernel(bit), dim3(grid), dim3(512), LDS_BYTES, stream, a);
    }
#endif
    const hipError_t le = hipPeekAtLastError();
    if (le != hipSuccess) fprintf(stderr, "kernel_launch: launch failed: %s\n", hipGetErrorName(le));
}
```

```cpp
#include <hip/hip_runtime.h>
#include <cstdio>
#include <cstdint>

#ifndef MK_SINGLE
#define MK_SINGLE 1
#endif

#ifndef MK_STAGGER
#define MK_STAGGER 0
#endif
#ifndef PROBE_EPI2
#define PROBE_EPI2 0
#endif
#ifndef MLA_CHECK
#define MLA_CHECK 0
#endif
#ifndef MLA_CHECK_LAYER
#define MLA_CHECK_LAYER 0
#endif
#ifndef MLA_CHECK_TOL
#define MLA_CHECK_TOL 0.03f
#endif
#ifndef PROBE_TS
#define PROBE_TS 0
#endif
#ifndef TS_SKEW_ID
#define TS_SKEW_ID 4
#endif
#ifndef TS_CLASS1
#define TS_CLASS1 0
#endif
#ifndef TS_CLASS2
#define TS_CLASS2 1
#endif
#ifndef PROBE_MASK
#define PROBE_MASK 0u
#endif
#define GAS __attribute__((address_space(1)))
#define LAS __attribute__((address_space(3)))
typedef unsigned short bf16;
typedef short bf16x8 __attribute__((ext_vector_type(8)));
typedef short s16x4 __attribute__((ext_vector_type(4)));
typedef float f32x2 __attribute__((ext_vector_type(2)));
typedef float f32x4 __attribute__((ext_vector_type(4)));
typedef float f32x16 __attribute__((ext_vector_type(16)));
typedef unsigned u32x2 __attribute__((ext_vector_type(2)));
typedef unsigned u32x4 __attribute__((ext_vector_type(4)));
typedef GAS unsigned gu32;

constexpr int D = 2048, NB = 8, SEQ = 4096, CTXL = 256, DEPTH = 4;
constexpr int MX = NB * SEQ, MC = NB * CTXL, MT = MX + MC;
constexpr int FF = 5632, NMOD = 6 * D;
constexpr int MLA_H = 16, QR = 512, KVR = 512, NOPE = 128, ROPE = 64, DQ = 192;
constexpr int N1 = 1280;
constexpr int RH = 8, RDK = 256, RDV = 512;
constexpr float NORM_EPS = 1e-6f, GN_EPS = 1e-5f;
constexpr float LOG2E = 1.4426950408889634f;

constexpr size_t MiB = 1u << 20;
constexpr size_t WS_CTL = 0, CTL_BYTES = 1 * MiB;
constexpr size_t WS_MODV = 1 * MiB;
constexpr size_t WS_TABM = 3 * MiB;
constexpr size_t WS_TABR = 4 * MiB;
constexpr size_t WS_SSQ = 8 * MiB;
constexpr size_t WS_XC = 12 * MiB;
constexpr size_t WS_KR = 28 * MiB;
constexpr size_t WS_PSTF = 20 * MiB, WS_PSTB = 33 * MiB;
constexpr size_t WS_WA = 40 * MiB;
constexpr size_t WS_WB = 128 * MiB;
constexpr size_t WS_H = 276 * MiB;
constexpr size_t WS_BIG = 412 * MiB;
constexpr size_t WS_QKVL = WS_BIG, WS_Q = WS_BIG + 88 * MiB, WS_KV = WS_BIG + 292 * MiB, WS_O = WS_BIG + 564 * MiB;
constexpr size_t WS_QKV = WS_BIG, WS_Y = WS_BIG + 544 * MiB, WS_GATED = WS_BIG;
constexpr size_t WS_G = WS_BIG, WS_U = WS_BIG + 374 * MiB;
constexpr size_t WS_END = WS_BIG + 1088 * MiB;
static_assert((size_t)MT * 8192 * 2 <= 544 * MiB && (size_t)MT * 5632 * 2 <= 374 * MiB && (size_t)MT * N1 * 2 <= 88 * MiB, "ws map");

constexpr int CW_BAR = 4096;

constexpr int RING_BYTES = 131072, CTRL_BASE = 155648, MISC_OFF = CTRL_BASE + 320, ARGS_OFF = CTRL_BASE + 1024, EDGE_OFF = CTRL_BASE + 4096, LDS_BYTES = 163840;

__device__ __forceinline__ unsigned cvt_pk_bf16(float lo, float hi) { unsigned r; asm volatile("v_cvt_pk_bf16_f32 %0, %1, %2" : "=v"(r) : "v"(lo), "v"(hi)); return r; }
__device__ __forceinline__ float bf2f(unsigned short b) { return __uint_as_float((unsigned)b << 16); }
__device__ __forceinline__ float bflo(unsigned w) { return __uint_as_float(w << 16); }
__device__ __forceinline__ float bfhi(unsigned w) { return __uint_as_float(w & 0xffff0000u); }
__device__ __forceinline__ float shfl_xor_l(float v, int mask, int lane) { return __builtin_bit_cast(float, __builtin_amdgcn_ds_bpermute((lane ^ mask) << 2, __builtin_bit_cast(int, v))); }
__device__ __forceinline__ float fast_silu(float x) { return x * __builtin_amdgcn_rcpf(1.0f + __builtin_amdgcn_exp2f(-x * LOG2E)); }

__device__ __forceinline__ int lane_id() { int x; asm volatile("v_mbcnt_lo_u32_b32 %0, -1, 0\n\tv_mbcnt_hi_u32_b32 %0, -1, %0" : "=v"(x)); return x; }
__device__ __forceinline__ void glds16_s(const void* sbase, unsigned voff, unsigned lds_dst) {
    unsigned keep;
    asm volatile("s_mov_b32 %0, m0\n\ts_mov_b32 m0, %3\n\ts_nop 0\n\tglobal_load_lds_dwordx4 %1, %2\n\ts_mov_b32 m0, %0" : "=&s"(keep) : "v"(voff), "s"(sbase), "s"(lds_dst) : "memory");
}
__device__ __forceinline__ const char* uni_ptr(const void* p) {
    const unsigned long long v = (unsigned long long)p; const unsigned lo = __builtin_amdgcn_readfirstlane((unsigned)v), hi = __builtin_amdgcn_readfirstlane((unsigned)(v >> 32));
    return (const char*)(((unsigned long long)hi << 32) | lo);
}
namespace pg8 {
constexpr int BM = 256, BK = 64, HALF = 128, HTB = HALF * BK * 2, STAGE_BYTES = 8 * HTB, NXCD = 8, WGM = 8;
__host__ __device__ __forceinline__ int lds_byte(int r, int c) { const int st = (r >> 4) * 2 + (c >> 5), rr = r & 15, cc = c & 31, ob = rr * 64 + cc * 2; return st * 1024 + (ob ^ (((ob >> 9) & 1) << 5)); }
__host__ __device__ __forceinline__ void stage_rc(int b, int& R, int& C) { const int st = b / 1024, sb = b % 1024, swz = sb ^ (((sb >> 9) & 1) << 5); R = (st >> 1) * 16 + swz / 64; C = (st & 1) * 32 + (swz % 64) / 2; }
__host__ __device__ __forceinline__ int perm32(int rho) { const int n = rho >> 4, i = rho & 15; return 8 * (i >> 2) + 4 * n + (i & 3); }
struct Unit { int pm, pn; };
struct Gemm { const bf16* A; const bf16* Bt; int M, N, K, lda; };
struct StaticOrder {
    int nM, nN, nwg, G, c, wgm, delay = 0, probe = 0, tid = 0; bool rev; unsigned long long* tsw = nullptr;
    __device__ __forceinline__ void init(int M, int N, int G_, int c_, int wgm_ = WGM, bool rev_ = false) { nM = M / BM; nN = N / BM; nwg = nM * nN; G = G_; c = c_; wgm = wgm_; rev = rev_; }
    __device__ __forceinline__ bool next(int i, Unit& u) const {
        const long L = (long)i * G + c; if (L >= nwg) return false;
        int wgid = (int)L; { const int q = nwg / NXCD, r = nwg % NXCD, xcd = wgid % NXCD, off = wgid / NXCD; wgid = (xcd < r ? xcd * (q + 1) : r * (q + 1) + (xcd - r) * q) + off; }
        const int nig = wgm * nN, gid = wgid / nig, fm = gid * wgm, gsz = (nM - fm) < wgm ? (nM - fm) : wgm;
        u.pm = fm + ((wgid % nig) % gsz); u.pn = (wgid % nig) / gsz; if (rev) u.pm = nM - 1 - u.pm; return true;
    }
};
template <class Epi>
__device__ __forceinline__ void gemm_phase(LAS unsigned char* lds, const Gemm g, const StaticOrder& S, const Epi& E) {
    int tid = S.tid; asm volatile("" : "+v"(tid));
    const int wid = __builtin_amdgcn_readfirstlane(tid >> 6), lane = tid & 63, wr = wid >> 2, wc = wid & 3, fr = lane & 15, fq = lane >> 4;
    const int K = g.K, nt = K / BK;
    unsigned voffA[2], voffB[2];
#pragma unroll
    for (int i = 0; i < 2; ++i) { int R, C; stage_rc(tid * 16 + i * 8192, R, C); const int Rb = Epi::PERM ? ((R & ~31) + perm32(R & 31)) : R;
        voffA[i] = (unsigned)(R * g.lda + C) * 2u; voffB[i] = (unsigned)(Rb * K + C) * 2u; }
    const size_t kstep = (size_t)(BK * 2);
    const size_t hstepA = (size_t)HALF * g.lda * 2, hstepB = (size_t)HALF * K * 2;
    const size_t tstepA = 2 * hstepA, tstepB = 2 * hstepB;
    const unsigned ldsbase = (unsigned)__builtin_amdgcn_readfirstlane((unsigned)(uintptr_t)lds + (unsigned)wid * 1024u);
    const int aoff = lds_byte(wr * 64 + fr, fq * 8), boff = lds_byte(wc * 32 + fr, fq * 8);
#define PG8_SA(b, h) (((b) * 2 + (h)) * HTB)
#define PG8_SB(b, h) ((4 + (b) * 2 + (h)) * HTB)
#define PG8_STAGE(bufoff, gbase, voff) do { const char* _gb = uni_ptr(gbase); _Pragma("unroll") for (int _i = 0; _i < 2; ++_i) \
        glds16_s(_gb, (voff)[_i], ldsbase + (unsigned)((bufoff) + _i * 8192)); } while (0)
#define PG8_LDA(dst, b, h) do { _Pragma("unroll") for (int m = 0; m < 4; ++m) _Pragma("unroll") for (int k = 0; k < 2; ++k) dst[m][k] = *(const LAS bf16x8*)(lds + PG8_SA(b, h) + aoff + m * 2048 + k * 1024); } while (0)
#define PG8_LDB(dst, b, h) do { _Pragma("unroll") for (int n = 0; n < 2; ++n) _Pragma("unroll") for (int k = 0; k < 2; ++k) dst[n][k] = *(const LAS bf16x8*)(lds + PG8_SB(b, h) + boff + n * 2048 + k * 1024); } while (0)
#define PG8_MMA(ai, bj, At, Bt) do { __builtin_amdgcn_s_setprio(1); _Pragma("unroll") for (int m = 0; m < 4; ++m) _Pragma("unroll") for (int n = 0; n < 2; ++n) _Pragma("unroll") for (int k = 0; k < 2; ++k) \
        acc[ai][bj][m][n] = __builtin_amdgcn_mfma_f32_16x16x32_bf16(Bt[n][k], At[m][k], acc[ai][bj][m][n], 0, 0, 0); __builtin_amdgcn_s_setprio(0); } while (0)
#define PG8_WAIT_V(n) asm volatile("s_waitcnt vmcnt(" #n ")" ::: "memory")
#define PG8_WAIT_L(n) asm volatile("s_waitcnt lgkmcnt(" #n ")" ::: "memory")
#define PG8_BAR __builtin_amdgcn_s_barrier()
#define PG8_SCHED __builtin_amdgcn_sched_barrier(0)
    Unit cur, nxt; int ui = 0;
    if (!S.next(0, cur)) return;
    if (S.delay) { const unsigned long long t0 = __builtin_amdgcn_s_memrealtime(); while (__builtin_amdgcn_s_memrealtime() - t0 < (unsigned long long)S.delay) __builtin_amdgcn_s_sleep(8); }
#if MK_STAGGER
    if (S.c & 1) {
        const unsigned long long t0 = __builtin_amdgcn_s_memrealtime(); const unsigned long long dt = (unsigned long long)nt * MK_STAGGER;
        while (__builtin_amdgcn_s_memrealtime() - t0 < dt) __builtin_amdgcn_s_sleep(8);
    }
#endif
    f32x4 acc[2][2][4][2];
#pragma unroll
    for (int a = 0; a < 2; ++a)
#pragma unroll
        for (int b = 0; b < 2; ++b)
#pragma unroll
            for (int m = 0; m < 4; ++m)
#pragma unroll
                for (int n = 0; n < 2; ++n) acc[a][b][m][n] = (f32x4){0.f, 0.f, 0.f, 0.f};
    bf16x8 At[4][2], B0[2][2], B1[2][2];
    const char* cA = (const char*)g.A + (size_t)cur.pm * tstepA; const char* cB = (const char*)g.Bt + (size_t)cur.pn * tstepB;
    PG8_STAGE(PG8_SB(0, 0), cB, voffB); PG8_STAGE(PG8_SB(0, 1), cB + hstepB, voffB); PG8_STAGE(PG8_SA(0, 0), cA, voffA); PG8_STAGE(PG8_SA(0, 1), cA + hstepA, voffA);
    if (wr == 1) PG8_BAR;
    PG8_WAIT_V(2); PG8_BAR;
    PG8_STAGE(PG8_SB(1, 0), cB + kstep, voffB); PG8_STAGE(PG8_SA(1, 0), cA + kstep, voffA); PG8_STAGE(PG8_SB(1, 1), cB + hstepB + kstep, voffB);
    PG8_WAIT_V(6); PG8_BAR;
#if PROBE_TS
    unsigned long long pt_loop = 0, pt_epi = 0, pt_n = 0, pt_t0 = __builtin_amdgcn_s_memrealtime();
#endif
    for (;;) {
        const bool has_next = S.next(ui + 1, nxt);
        const char* nA = has_next ? (const char*)g.A + (size_t)nxt.pm * tstepA : cA; const char* nB = has_next ? (const char*)g.Bt + (size_t)nxt.pn * tstepB : cB;
        for (int t = 0; t < nt; t += 2) {
            const bool last = (t == nt - 2);
            const char* a1 = cA + (size_t)(t + 1) * kstep;
            const char* a2 = last ? nA : cA + (size_t)(t + 2) * kstep; const char* b2 = last ? nB : cB + (size_t)(t + 2) * kstep;
            const char* a3 = a2 + kstep; const char* b3 = b2 + kstep;
            PG8_LDB(B0, 0, 0); PG8_LDB(B1, 0, 1); PG8_SCHED; PG8_LDA(At, 0, 0); PG8_STAGE(PG8_SA(1, 1), a1 + hstepA, voffA);
            PG8_WAIT_V(8); PG8_WAIT_L(0); PG8_BAR; PG8_MMA(0, 0, At, B0); PG8_MMA(0, 1, At, B1); PG8_BAR; PG8_SCHED;
            PG8_LDA(At, 0, 1); PG8_STAGE(PG8_SB(0, 0), b2, voffB); PG8_STAGE(PG8_SB(0, 1), b2 + hstepB, voffB); PG8_STAGE(PG8_SA(0, 0), a2, voffA);
            PG8_WAIT_V(8); PG8_WAIT_L(0); PG8_BAR; PG8_MMA(1, 0, At, B0); PG8_MMA(1, 1, At, B1); PG8_BAR; PG8_SCHED;
            PG8_LDB(B0, 1, 0); PG8_LDB(B1, 1, 1); PG8_SCHED; PG8_LDA(At, 1, 0); PG8_STAGE(PG8_SA(0, 1), a2 + hstepA, voffA);
            PG8_WAIT_V(8); PG8_WAIT_L(0); PG8_BAR; PG8_MMA(0, 0, At, B0); PG8_MMA(0, 1, At, B1); PG8_BAR; PG8_SCHED;
            PG8_LDA(At, 1, 1); PG8_STAGE(PG8_SB(1, 0), b3, voffB); PG8_STAGE(PG8_SB(1, 1), b3 + hstepB, voffB); PG8_STAGE(PG8_SA(1, 0), a3, voffA);
            PG8_WAIT_V(8); PG8_WAIT_L(0); PG8_BAR; PG8_MMA(1, 0, At, B0); PG8_MMA(1, 1, At, B1); PG8_BAR; PG8_SCHED;
        }
        if (wr == 0) PG8_BAR;
#if PROBE_TS
        const unsigned long long pt_t1 = __builtin_amdgcn_s_memrealtime();
#endif
        E(acc, cur, wr, wc, fr, fq);
#if PROBE_TS
        { asm volatile("s_waitcnt vmcnt(0)" ::: "memory"); const unsigned long long pt_t2 = __builtin_amdgcn_s_memrealtime(); pt_loop += pt_t1 - pt_t0; pt_epi += pt_t2 - pt_t1; pt_n += 1; pt_t0 = pt_t2; }
#endif
#if PROBE_EPI2
        if (Epi::PROBE2) E(acc, cur, wr, wc, fr, fq);
#endif
        if (!has_next) break;
#pragma unroll
        for (int a = 0; a < 2; ++a)
#pragma unroll
            for (int b = 0; b < 2; ++b)
#pragma unroll
                for (int m = 0; m < 4; ++m)
#pragma unroll
                    for (int n = 0; n < 2; ++n) acc[a][b][m][n] = (f32x4){0.f, 0.f, 0.f, 0.f};
        cur = nxt; cA = nA; cB = nB; ++ui;
        if (wr == 1) PG8_BAR;
    }
    PG8_WAIT_V(0);
    PG8_BAR;
#if PROBE_TS
    if (S.probe && S.c == 0 && tid == 0) { unsigned long long* tw = S.tsw + 90 + 3 * (S.probe - 1); tw[0] += pt_loop; tw[1] += pt_epi; tw[2] += pt_n; }
    if (S.probe == TS_SKEW_ID && tid == 0) { const unsigned long long dur = pt_loop + pt_epi; atomicMax(S.tsw + 120, dur); atomicMin(S.tsw + 121, dur); atomicAdd(S.tsw + 122, dur); }
#endif
#undef PG8_SA
#undef PG8_SB
#undef PG8_STAGE
#undef PG8_LDA
#undef PG8_LDB
#undef PG8_MMA
#undef PG8_WAIT_V
#undef PG8_WAIT_L
#undef PG8_BAR
#undef PG8_SCHED
}
}
using pg8::Unit;

__device__ __forceinline__ int slack_delay(int nwg, int G, int c, int unit_ticks) {
    const int rem = nwg % G; if (rem == 0 || c < rem) return 0;
    return (int)(((long long)(c - rem) * unit_ticks * 4) / ((long long)(G - rem) * 5));
}
__device__ __forceinline__ u32x4 pack8(const f32x4 a, const f32x4 b) { u32x4 w; w.x = cvt_pk_bf16(a[0], a[1]); w.y = cvt_pk_bf16(a[2], a[3]); w.z = cvt_pk_bf16(b[0], b[1]); w.w = cvt_pk_bf16(b[2], b[3]); return w; }
__device__ __forceinline__ f32x4 rot2(const f32x4 v, const f32x4 cs) { f32x4 o; o[0] = v[0] * cs[0] - v[1] * cs[1]; o[1] = v[1] * cs[0] + v[0] * cs[1]; o[2] = v[2] * cs[2] - v[3] * cs[3]; o[3] = v[3] * cs[2] + v[2] * cs[3]; return o; }

__device__ __forceinline__ f32x4 mla_cs(const float* tabm, int t, int c4) {
    const int p0 = c4 >> 1; const int pos = (p0 < 16) ? (t >> 6) : (t & 63); const int f = p0 & 15;
    return *(const f32x4*)(tabm + ((size_t)pos * 16 + f) * 2);
}

struct EpiG1 {
    static constexpr bool PERM = true, PROBE2 = false;
    bf16* QKVL; float* SSQ; bf16* KR; const float* tabm;
    __device__ __forceinline__ void operator()(const f32x4 (&acc)[2][2][4][2], const Unit& u, int wr, int wc, int fr, int fq) const {
        const int row0 = u.pm * 256 + wr * 64 + fr;
        if (u.pn < 4) {
            const int col0 = u.pn * 256 + wc * 32 + 8 * fq;
#pragma unroll
            for (int ai = 0; ai < 2; ++ai)
#pragma unroll
                for (int m = 0; m < 4; ++m) { const int row = row0 + ai * 128 + m * 16; float ss = 0.f;
#pragma unroll
                    for (int bj = 0; bj < 2; ++bj) { const f32x4 v0 = acc[ai][bj][m][0], v1 = acc[ai][bj][m][1];
                        ss += (v0[0] * v0[0] + v0[1] * v0[1]) + (v0[2] * v0[2] + v0[3] * v0[3]) + (v1[0] * v1[0] + v1[1] * v1[1]) + (v1[2] * v1[2] + v1[3] * v1[3]);
                        *(u32x4*)(QKVL + (size_t)row * N1 + col0 + bj * 128) = pack8(v0, v1); }
                    { const int ln_ = fr + 16 * fq; ss += shfl_xor_l(ss, 16, ln_); ss += shfl_xor_l(ss, 32, ln_); }
                    if (fq == 0) SSQ[(size_t)row * 16 + u.pn * 4 + wc] = ss; asm volatile("" ::: "memory"); }
        } else if (wc < 2) {
            const int c8 = wc * 32 + 8 * fq;
#pragma unroll
            for (int ai = 0; ai < 2; ++ai)
#pragma unroll
                for (int m = 0; m < 4; ++m) { const int row = row0 + ai * 128 + m * 16; f32x4 v0 = acc[ai][0][m][0], v1 = acc[ai][0][m][1];
                    if (row < MX) { const int t = row & (SEQ - 1); v0 = rot2(v0, mla_cs(tabm, t, c8)); v1 = rot2(v1, mla_cs(tabm, t, c8 + 4)); }
                    *(u32x4*)(KR + (size_t)row * 64 + c8) = pack8(v0, v1); asm volatile("" ::: "memory"); }
        }
    }
};
struct EpiUq {
    static constexpr bool PERM = true, PROBE2 = false;
    bf16* Q; const float* SSQ; const float* tabm;
    __device__ __forceinline__ void operator()(const f32x4 (&acc)[2][2][4][2], const Unit& u, int wr, int wc, int fr, int fq) const {
        const int row0 = u.pm * 256 + wr * 64 + fr;
        int col8[2], dd[2];
#pragma unroll
        for (int bj = 0; bj < 2; ++bj) { col8[bj] = u.pn * 256 + bj * 128 + wc * 32 + 8 * fq; dd[bj] = col8[bj] % DQ; }
#pragma unroll
        for (int ai = 0; ai < 2; ++ai)
#pragma unroll
            for (int m = 0; m < 4; ++m) { const int row = row0 + ai * 128 + m * 16;
                const f32x4 s0 = *(const f32x4*)(SSQ + (size_t)row * 16), s1 = *(const f32x4*)(SSQ + (size_t)row * 16 + 4);
                const float ss = ((s0[0] + s0[1]) + (s0[2] + s0[3])) + ((s1[0] + s1[1]) + (s1[2] + s1[3]));
                const float r = 1.0f / sqrtf(ss * (1.0f / QR) + NORM_EPS);
#pragma unroll
                for (int bj = 0; bj < 2; ++bj) { f32x4 v0 = acc[ai][bj][m][0] * r, v1 = acc[ai][bj][m][1] * r;
                    if (dd[bj] >= NOPE && row < MX) { const int t = row & (SEQ - 1), c8 = dd[bj] - NOPE; v0 = rot2(v0, mla_cs(tabm, t, c8)); v1 = rot2(v1, mla_cs(tabm, t, c8 + 4)); }
                    *(u32x4*)(Q + (size_t)row * 3072 + col8[bj]) = pack8(v0, v1); } asm volatile("" ::: "memory"); }
    }
};
struct EpiUkv {
    static constexpr bool PERM = true, PROBE2 = false;
    bf16* KV; const float* SSQ;
    __device__ __forceinline__ void operator()(const f32x4 (&acc)[2][2][4][2], const Unit& u, int wr, int wc, int fr, int fq) const {
        const int row0 = u.pm * 256 + wr * 64 + fr; const int col0 = u.pn * 256 + wc * 32 + 8 * fq;
#pragma unroll
        for (int ai = 0; ai < 2; ++ai)
#pragma unroll
            for (int m = 0; m < 4; ++m) { const int row = row0 + ai * 128 + m * 16;
                const f32x4 s0 = *(const f32x4*)(SSQ + (size_t)row * 16 + 8), s1 = *(const f32x4*)(SSQ + (size_t)row * 16 + 12);
                const float ss = ((s0[0] + s0[1]) + (s0[2] + s0[3])) + ((s1[0] + s1[1]) + (s1[2] + s1[3]));
                const float r = 1.0f / sqrtf(ss * (1.0f / KVR) + NORM_EPS);
#pragma unroll
                for (int bj = 0; bj < 2; ++bj) *(u32x4*)(KV + (size_t)row * 4096 + col0 + bj * 128) = pack8(acc[ai][bj][m][0] * r, acc[ai][bj][m][1] * r); asm volatile("" ::: "memory"); }
    }
};
struct EpiResid {
    static constexpr bool PERM = true, PROBE2 = false;
    const void* xin; void* xout; const void* cin; void* cout; const float* modv; int gofs; bool base_f32, out_f32;
    __device__ __forceinline__ void operator()(const f32x4 (&acc)[2][2][4][2], const Unit& u, int wr, int wc, int fr, int fq) const {
        const bool isx = u.pm < (MX / 256);
        const int rloc = (isx ? u.pm * 256 : (u.pm * 256 - MX)) + wr * 64 + fr;
        const void* base = isx ? xin : cin; void* out = isx ? xout : cout;
        const float* gv = modv + (size_t)(isx ? (u.pm >> 4) : 8) * NMOD + gofs;
        const int col0 = u.pn * 256 + wc * 32 + 8 * fq;
        f32x4 g4[2][2];
#pragma unroll
        for (int bj = 0; bj < 2; ++bj)
#pragma unroll
            for (int n = 0; n < 2; ++n) g4[bj][n] = *(const f32x4*)(gv + col0 + bj * 128 + n * 4);
        if (base_f32) {
            f32x4 pre[3][2][2];
#define RES_LOAD(G_, SLOT_) do { const size_t off_ = (size_t)(rloc + ((G_) >> 2) * 128 + ((G_) & 3) * 16) * D + col0; \
                _Pragma("unroll") for (int bj = 0; bj < 2; ++bj) _Pragma("unroll") for (int n = 0; n < 2; ++n) pre[SLOT_][bj][n] = *(const f32x4*)((const float*)base + off_ + bj * 128 + n * 4); } while (0)
            RES_LOAD(0, 0); RES_LOAD(1, 1); RES_LOAD(2, 2);
#pragma unroll
            for (int g = 0; g < 8; ++g) { const int ai = g >> 2, m = g & 3; const size_t off = (size_t)(rloc + ai * 128 + m * 16) * D + col0;
#pragma unroll
                for (int bj = 0; bj < 2; ++bj) { const f32x4 x0 = pre[g % 3][bj][0] + g4[bj][0] * acc[ai][bj][m][0], x1 = pre[g % 3][bj][1] + g4[bj][1] * acc[ai][bj][m][1];
                    *(u32x4*)((bf16*)out + off + bj * 128) = pack8(x0, x1); }
                asm volatile("" ::: "memory");
                if (g + 3 < 8) RES_LOAD(g + 3, g % 3); }
#undef RES_LOAD
        } else {
            u32x4 pre[3][2];
#define RES_LOAD(G_, SLOT_) do { const size_t off_ = (size_t)(rloc + ((G_) >> 2) * 128 + ((G_) & 3) * 16) * D + col0; \
                _Pragma("unroll") for (int bj = 0; bj < 2; ++bj) pre[SLOT_][bj] = *(const u32x4*)((const bf16*)base + off_ + bj * 128); } while (0)
            RES_LOAD(0, 0); RES_LOAD(1, 1); RES_LOAD(2, 2);
#pragma unroll
            for (int g = 0; g < 8; ++g) { const int ai = g >> 2, m = g & 3; const size_t off = (size_t)(rloc + ai * 128 + m * 16) * D + col0;
#pragma unroll
                for (int bj = 0; bj < 2; ++bj) { const u32x4 pb = pre[g % 3][bj];
                    const f32x4 b0 = {bflo(pb.x), bfhi(pb.x), bflo(pb.y), bfhi(pb.y)}, b1 = {bflo(pb.z), bfhi(pb.z), bflo(pb.w), bfhi(pb.w)};
                    const f32x4 x0 = b0 + g4[bj][0] * acc[ai][bj][m][0], x1 = b1 + g4[bj][1] * acc[ai][bj][m][1];
                    if (out_f32) { *(f32x4*)((float*)out + off + bj * 128) = x0; *(f32x4*)((float*)out + off + bj * 128 + 4) = x1; }
                    else *(u32x4*)((bf16*)out + off + bj * 128) = pack8(x0, x1); }
                asm volatile("" ::: "memory");
                if (g + 3 < 8) RES_LOAD(g + 3, g % 3); }
#undef RES_LOAD
        }
    }
};
template <int CTRL> __device__ __forceinline__ float dpp1(float x) { return __int_as_float(__builtin_amdgcn_update_dpp(0, __float_as_int(x), CTRL, 0xF, 0xF, false)); }
__device__ __forceinline__ f32x4 row_prev(const f32x4 v) { f32x4 o; o.x = dpp1<0x121>(v.x); o.y = dpp1<0x121>(v.y); o.z = dpp1<0x121>(v.z); o.w = dpp1<0x121>(v.w); return o; }
__device__ __forceinline__ f32x4 row_next(const f32x4 v) { f32x4 o; o.x = dpp1<0x12F>(v.x); o.y = dpp1<0x12F>(v.y); o.z = dpp1<0x12F>(v.z); o.w = dpp1<0x12F>(v.w); return o; }
__device__ __forceinline__ f32x4 silu4(const f32x4 v) { f32x4 o;
#pragma unroll
    for (int e = 0; e < 4; ++e) o[e] = fast_silu(v[e]); return o; }
constexpr size_t HALO_STRIDE = (size_t)FF;
struct EpiGUConv {
    static constexpr bool PERM = true, PROBE2 = true;
    bf16* ACT; float* HALO; const float* cw; const float* cb; LAS float* edge;
    __device__ __forceinline__ void operator()(const f32x4 (&acc)[2][2][4][2], const Unit& u, int wr, int wc, int fr, int fq) const {
        const int c8 = wc * 32 + 8 * fq; const int f0 = u.pn * 128 + c8;
#pragma unroll
        for (int ai = 0; ai < 2; ++ai) { const int blk = 2 * ai + wr;
            if (fr == 0)  { *(LAS f32x4*)(edge + (blk * 2 + 0) * 128 + c8) = acc[ai][0][0][0]; *(LAS f32x4*)(edge + (blk * 2 + 0) * 128 + c8 + 4) = acc[ai][0][0][1]; }
            if (fr == 15) { *(LAS f32x4*)(edge + (blk * 2 + 1) * 128 + c8) = acc[ai][0][3][0]; *(LAS f32x4*)(edge + (blk * 2 + 1) * 128 + c8 + 4) = acc[ai][0][3][1]; } }
        asm volatile("s_waitcnt lgkmcnt(0)" ::: "memory"); __builtin_amdgcn_s_barrier(); asm volatile("" ::: "memory");
        f32x4 w0[2], w1[2], w2[2], bb[2];
#pragma unroll
        for (int n = 0; n < 2; ++n) { w0[n] = *(const f32x4*)(cw + f0 + 4 * n); w1[n] = *(const f32x4*)(cw + FF + f0 + 4 * n); w2[n] = *(const f32x4*)(cw + 2 * FF + f0 + 4 * n); bb[n] = *(const f32x4*)(cb + f0 + 4 * n); }
        const f32x4 zero4 = {0.f, 0.f, 0.f, 0.f};
#pragma unroll
        for (int ai = 0; ai < 2; ++ai) { const int blk = 2 * ai + wr;
#pragma unroll
            for (int m = 0; m < 4; ++m) { const int row = u.pm * 256 + ai * 128 + wr * 64 + m * 16 + fr; f32x4 o[2];
#pragma unroll
                for (int n = 0; n < 2; ++n) { const f32x4 cur = acc[ai][0][m][n];
                    f32x4 b, d;
                    if (m > 0) b = row_prev(acc[ai][0][m - 1][n]); else b = (blk > 0) ? *(const LAS f32x4*)(edge + ((blk - 1) * 2 + 1) * 128 + c8 + 4 * n) : zero4;
                    if (m < 3) d = row_next(acc[ai][0][m + 1][n]); else d = (blk < 3) ? *(const LAS f32x4*)(edge + ((blk + 1) * 2 + 0) * 128 + c8 + 4 * n) : zero4;
                    const f32x4 a = row_prev(cur), c = row_next(cur);
                    const f32x4 up = (fr == 0) ? b : a, dn = (fr == 15) ? d : c;
                    const f32x4 cv = w0[n] * up + w1[n] * cur + w2[n] * dn + bb[n]; const f32x4 uu = acc[ai][1][m][n];
                    o[n] = silu4(cv) * uu;
                    if (m == 0 && blk == 0 && fr == 0) { float* hp = HALO + (size_t)((u.pm * 2 + 0) * 3) * HALO_STRIDE + f0 + 4 * n; *(f32x4*)hp = cv; *(f32x4*)(hp + HALO_STRIDE) = cur; *(f32x4*)(hp + 2 * HALO_STRIDE) = uu; }
                    if (m == 3 && blk == 3 && fr == 15) { float* hp = HALO + (size_t)((u.pm * 2 + 1) * 3) * HALO_STRIDE + f0 + 4 * n; *(f32x4*)hp = cv; *(f32x4*)(hp + HALO_STRIDE) = cur; *(f32x4*)(hp + 2 * HALO_STRIDE) = uu; } }
                *(u32x4*)(ACT + (size_t)row * FF + f0) = pack8(o[0], o[1]); asm volatile("" ::: "memory"); } }
        asm volatile("s_waitcnt lgkmcnt(0)" ::: "memory"); __builtin_amdgcn_s_barrier(); asm volatile("" ::: "memory");
    }
};
struct EpiQKV {
    static constexpr bool PERM = true, PROBE2 = false;
    bf16* QKV; const float* tabr;
    __device__ __forceinline__ void operator()(const f32x4 (&acc)[2][2][4][2], const Unit& u, int wr, int wc, int fr, int fq) const {
        const int row0 = u.pm * 256 + wr * 64 + fr; const int col0 = u.pn * 256 + wc * 32 + 8 * fq;
        const bool rope = (u.pn < 16) && (u.pm < MX / 256);
#pragma unroll
        for (int ai = 0; ai < 2; ++ai)
#pragma unroll
            for (int m = 0; m < 4; ++m) { const int row = row0 + ai * 128 + m * 16;
#pragma unroll
                for (int bj = 0; bj < 2; ++bj) { f32x4 v0 = acc[ai][bj][m][0], v1 = acc[ai][bj][m][1]; const int col = col0 + bj * 128;
                    if (rope) { const int t = row & (SEQ - 1); const float* tp = tabr + ((size_t)t * 128 + ((col & 255) >> 1)) * 2;
                        v0 = rot2(v0, *(const f32x4*)tp); v1 = rot2(v1, *(const f32x4*)(tp + 4)); }
                    *(u32x4*)(QKV + (size_t)row * 8192 + col) = pack8(v0, v1); } asm volatile("" ::: "memory"); }
    }
};
struct EpiGate {
    static constexpr bool PERM = true, PROBE2 = false;
    bf16* GATED; const bf16* YF; const bf16* YB; const float* STF; const float* STB;
    __device__ __forceinline__ void operator()(const f32x4 (&acc)[2][2][4][2], const Unit& u, int wr, int wc, int fr, int fq) const {
        const int row0 = u.pm * 256 + wr * 64 + fr; const int f0 = u.pn * 128 + wc * 32 + 8 * fq; const int hd = u.pn >> 2;
#pragma unroll
        for (int ai = 0; ai < 2; ++ai)
#pragma unroll
            for (int m = 0; m < 4; ++m) { const int row = row0 + ai * 128 + m * 16; const size_t off = (size_t)row * 4096 + f0;
                const u32x4 yf = *(const u32x4*)(YF + off), yb = *(const u32x4*)(YB + off);
                const f32x4 pf = *(const f32x4*)(STF + ((size_t)row * 8 + hd) * 4), pb = *(const f32x4*)(STB + ((size_t)row * 8 + hd) * 4);
                f32x2 sf, sb;
                sf[0] = (pf[0] + pf[2]) * (1.0f / RDV); sf[1] = __builtin_amdgcn_rsqf(fmaxf((pf[1] + pf[3]) * (1.0f / RDV) - sf[0] * sf[0], 0.f) + GN_EPS);
                sb[0] = (pb[0] + pb[2]) * (1.0f / RDV); sb[1] = __builtin_amdgcn_rsqf(fmaxf((pb[1] + pb[3]) * (1.0f / RDV) - sb[0] * sb[0], 0.f) + GN_EPS);
                const f32x4 a0 = acc[ai][0][m][0], a1 = acc[ai][0][m][1], b0 = acc[ai][1][m][0], b1 = acc[ai][1][m][1];
#define NF(w, hi_) (((hi_ ? bfhi(w) : bflo(w)) - sf[0]) * sf[1])
#define NB(w, hi_) (((hi_ ? bfhi(w) : bflo(w)) - sb[0]) * sb[1])
                f32x4 o0, o1;
                o0[0] = fast_silu(a0[0]) * NF(yf.x, 0) + fast_silu(b0[0]) * NB(yb.x, 0); o0[1] = fast_silu(a0[1]) * NF(yf.x, 1) + fast_silu(b0[1]) * NB(yb.x, 1);
                o0[2] = fast_silu(a0[2]) * NF(yf.y, 0) + fast_silu(b0[2]) * NB(yb.y, 0); o0[3] = fast_silu(a0[3]) * NF(yf.y, 1) + fast_silu(b0[3]) * NB(yb.y, 1);
                o1[0] = fast_silu(a1[0]) * NF(yf.z, 0) + fast_silu(b1[0]) * NB(yb.z, 0); o1[1] = fast_silu(a1[1]) * NF(yf.z, 1) + fast_silu(b1[1]) * NB(yb.z, 1);
                o1[2] = fast_silu(a1[2]) * NF(yf.w, 0) + fast_silu(b1[2]) * NB(yb.w, 0); o1[3] = fast_silu(a1[3]) * NF(yf.w, 1) + fast_silu(b1[3]) * NB(yb.w, 1);
#undef NF
#undef NB
                *(u32x4*)(GATED + off) = pack8(o0, o1); asm volatile("" ::: "memory"); }
    }
};

namespace att {
constexpr int NW = 8, QBLK = 32, KVBLK = 64;
constexpr int SHM_V = 16384, SHM_KN = 16384, SHM_KR = 8192;
constexpr int OFF_V = 0, OFF_KN = 3 * SHM_V, OFF_KR = OFF_KN + 2 * SHM_KN, OFF_WS = OFF_KR + 2 * SHM_KR, SHM_ATTN = OFF_WS + NW * 64 * 4;
constexpr float THR2 = 11.5f;
#define KSWZ(row, colB) ((row) * 256 + ((colB) ^ (((row) & 7) << 4)))
#define KRSWZ(row, colB) ((row) * 128 + ((colB) ^ ((((row) >> 1) & 7) << 4)))
#define SBAR() __builtin_amdgcn_sched_barrier(0)
__device__ __forceinline__ int crow(int r, int hi) { return (r & 3) + 8 * (r >> 2) + 4 * hi; }
__device__ __forceinline__ void partialSM(f32x16& p0, f32x16& p1, float& m_reg, float& alpha) {
  float pmax = p0[0];
#pragma unroll
  for (int r = 1; r < 16; ++r) pmax = fmaxf(pmax, p0[r]);
#pragma unroll
  for (int r = 0; r < 16; ++r) pmax = fmaxf(pmax, p1[r]);
  { auto rr = __builtin_amdgcn_permlane32_swap(__float_as_uint(pmax), __float_as_uint(pmax), false, false); pmax = fmaxf(__uint_as_float(rr[0]), __uint_as_float(rr[1])); }
  float mn;
  if (__builtin_expect(__all(pmax - m_reg <= THR2), 1)) { mn = m_reg; alpha = 1.f; }
  else { mn = fmaxf(m_reg, pmax); alpha = __builtin_amdgcn_exp2f(m_reg - mn); m_reg = mn; }
#pragma unroll
  for (int r = 0; r < 16; ++r) p0[r] = p0[r] - mn;
#pragma unroll
  for (int r = 0; r < 16; ++r) p1[r] = p1[r] - mn;
#pragma unroll
  for (int r = 0; r < 16; ++r) p0[r] = __builtin_amdgcn_exp2f(p0[r]);
}
__device__ __forceinline__ void finishSM(f32x16& p0, f32x16& p1, float alpha, float& l_reg, bf16x8& pa0, bf16x8& pa1, bf16x8& pa2, bf16x8& pa3) {
#pragma unroll
  for (int r = 0; r < 16; ++r) p1[r] = __builtin_amdgcn_exp2f(p1[r]);
  float ps = 0;
#pragma unroll
  for (int r = 0; r < 16; ++r) ps += p0[r];
#pragma unroll
  for (int r = 0; r < 16; ++r) ps += p1[r];
  { auto rr = __builtin_amdgcn_permlane32_swap(__float_as_uint(ps), __float_as_uint(ps), false, false); ps = __uint_as_float(rr[0]) + __uint_as_float(rr[1]); }
  l_reg = l_reg * alpha + ps;
#define PK4(P, BASE, OUT) do { unsigned a0 = cvt_pk_bf16(P[BASE + 0], P[BASE + 1]), a1 = cvt_pk_bf16(P[BASE + 2], P[BASE + 3]);   \
    unsigned b0 = cvt_pk_bf16(P[BASE + 4], P[BASE + 5]), b1 = cvt_pk_bf16(P[BASE + 6], P[BASE + 7]);                              \
    auto r0 = __builtin_amdgcn_permlane32_swap(a0, b0, false, false); auto r1 = __builtin_amdgcn_permlane32_swap(a1, b1, false, false); \
    u32x4 w = {r0[0], r1[0], r0[1], r1[1]}; OUT = __builtin_bit_cast(bf16x8, w); } while (0)
  PK4(p0, 0, pa0); PK4(p0, 8, pa1); PK4(p1, 0, pa2); PK4(p1, 8, pa3);
#undef PK4
}
__device__ __forceinline__ void qkt(f32x16& p0, f32x16& p1, const char* Kn, const char* Kr, const bf16x8* qr, int r32, int hi) {
  p0 = f32x16{}; p1 = f32x16{};
#pragma unroll
  for (int d0 = 0; d0 < 8; ++d0) { const int cb = (d0 * 16 + hi * 8) * 2;
    const bf16x8 b0 = *reinterpret_cast<const bf16x8*>(Kn + KSWZ(r32, cb));
    const bf16x8 b1 = *reinterpret_cast<const bf16x8*>(Kn + KSWZ(32 + r32, cb));
    p0 = __builtin_amdgcn_mfma_f32_32x32x16_bf16(b0, qr[d0], p0, 0, 0, 0);
    p1 = __builtin_amdgcn_mfma_f32_32x32x16_bf16(b1, qr[d0], p1, 0, 0, 0); }
#pragma unroll
  for (int d0 = 0; d0 < 4; ++d0) { const int cb = (d0 * 16 + hi * 8) * 2;
    const bf16x8 b0 = *reinterpret_cast<const bf16x8*>(Kr + KRSWZ(r32, cb));
    const bf16x8 b1 = *reinterpret_cast<const bf16x8*>(Kr + KRSWZ(32 + r32, cb));
    p0 = __builtin_amdgcn_mfma_f32_32x32x16_bf16(b0, qr[8 + d0], p0, 0, 0, 0);
    p1 = __builtin_amdgcn_mfma_f32_32x32x16_bf16(b1, qr[8 + d0], p1, 0, 0, 0); }
}
__device__ __forceinline__ int v_st(int k, int c) { const int kk = (k & ~0xC) | ((k & 4) << 1) | ((k & 8) >> 1); return ((kk >> 3) * 4 + (c >> 5)) * 512 + ((kk & 7) * 32 + (c & 31)) * 2; }
__device__ __forceinline__ int v_rd_base(int lane) { return ((lane & 3) << 3) | (((lane >> 2) & 3) << 6) | (((lane >> 4) & 1) << 5) | (((lane >> 5) & 1) << 8); }
constexpr int v_rd_off(int d0, int ks, int half) { return d0 * 512 + ks * 4096 + half * 2048; }
template <int OFF> __device__ __forceinline__ s16x4 tr_read(int vb) { s16x4 r; asm volatile("ds_read_b64_tr_b16 %0, %1 offset:%2" : "=&v"(r) : "v"(vb), "i"(OFF) : "memory"); return r; }
template <int D0> __device__ __forceinline__ void pv_one(f32x16& od, int vb, bf16x8 pa0, bf16x8 pa1, bf16x8 pa2, bf16x8 pa3) {
  const s16x4 l0 = tr_read<v_rd_off(D0, 0, 0)>(vb), h0 = tr_read<v_rd_off(D0, 0, 1)>(vb), l1 = tr_read<v_rd_off(D0, 1, 0)>(vb), h1 = tr_read<v_rd_off(D0, 1, 1)>(vb);
  const s16x4 l2 = tr_read<v_rd_off(D0, 2, 0)>(vb), h2 = tr_read<v_rd_off(D0, 2, 1)>(vb), l3 = tr_read<v_rd_off(D0, 3, 0)>(vb), h3 = tr_read<v_rd_off(D0, 3, 1)>(vb);
  asm volatile("s_waitcnt lgkmcnt(0)" ::: "memory"); SBAR();
#define PK(L, H) (bf16x8){L[0], L[1], L[2], L[3], H[0], H[1], H[2], H[3]}
  od = __builtin_amdgcn_mfma_f32_32x32x16_bf16(pa0, PK(l0, h0), od, 0, 0, 0);
  od = __builtin_amdgcn_mfma_f32_32x32x16_bf16(pa1, PK(l1, h1), od, 0, 0, 0);
  od = __builtin_amdgcn_mfma_f32_32x32x16_bf16(pa2, PK(l2, h2), od, 0, 0, 0);
  od = __builtin_amdgcn_mfma_f32_32x32x16_bf16(pa3, PK(l3, h3), od, 0, 0, 0);
#undef PK
}
__device__ __forceinline__ void pv_d0(f32x16* o, int vb, bf16x8 pa0, bf16x8 pa1, bf16x8 pa2, bf16x8 pa3) {
  pv_one<0>(o[0], vb, pa0, pa1, pa2, pa3); pv_one<1>(o[1], vb, pa0, pa1, pa2, pa3); pv_one<2>(o[2], vb, pa0, pa1, pa2, pa3); pv_one<3>(o[3], vb, pa0, pa1, pa2, pa3);
}
__device__ __forceinline__ void attn_unit(const bf16* __restrict__ Qb, const bf16* __restrict__ KVh, const bf16* __restrict__ KRp, bf16* __restrict__ Ob,
                                          int NT, int nc, int cbase, int xbase, char* lds, int tid_in, unsigned long long* ts_words = nullptr) {
  int tid = tid_in; asm volatile("" : "+v"(tid));
  const int wid = __builtin_amdgcn_readfirstlane(tid >> 6), lane = tid & 63, r32 = lane & 31, hi = lane >> 5;
  char* V_lds = lds + OFF_V; char* Kn_lds = lds + OFF_KN; char* Kr_lds = lds + OFF_KR;
  float* ws = (float*)(lds + OFF_WS) + wid * 64; float* li_l = ws; float* al_l = ws + 32;
  float m_reg = -1e30f, l_reg = 0; f32x16 o[4] = {}; bf16x8 qr[12];
  const bf16* Qw = Qb + (long)(wid * QBLK + r32) * 3072 + hi * 8;
#pragma unroll
  for (int d0 = 0; d0 < 12; ++d0) qr[d0] = *reinterpret_cast<const bf16x8*>(Qw + d0 * 16);
  const int vb0 = (int)(uintptr_t)V_lds + v_rd_base(lane);
  unsigned vofK[2], vofV[2], vofR;
#pragma unroll
  for (int i = 0; i < 2; ++i) { const int pc = wid * 2 + i;
      { const int row = pc * 4 + (lane >> 4), ch = (lane & 15) ^ (row & 7); vofK[i] = (unsigned)((row * 4096 + ch * 8) * 2); }
      { const int ob = pc * 1024 + lane * 16, st = ob >> 9, w = ob & 511, kk = (st >> 2) * 8 + (w >> 6); const int k = (kk & ~0xC) | ((kk & 4) << 1) | ((kk & 8) >> 1);
        const int c = (st & 3) * 32 + 8 * ((w & 63) >> 4); vofV[i] = (unsigned)((k * 4096 + 128 + c) * 2); } }
  { const int row = wid * 8 + (lane >> 3), ch = (lane & 7) ^ ((row >> 1) & 7); vofR = (unsigned)((row * 64 + ch * 8) * 2); }
  const unsigned ldsK = (unsigned)__builtin_amdgcn_readfirstlane((unsigned)(uintptr_t)Kn_lds + (unsigned)wid * 2048u);
  const unsigned ldsV = (unsigned)__builtin_amdgcn_readfirstlane((unsigned)(uintptr_t)V_lds + (unsigned)wid * 2048u);
  const unsigned ldsR = (unsigned)__builtin_amdgcn_readfirstlane((unsigned)(uintptr_t)Kr_lds + (unsigned)wid * 1024u);
#define KROW(j) ((j) < nc ? cbase + (j) * KVBLK : xbase + ((j) - nc) * KVBLK)
#define DMA_TILE(j, kslot, vslot) do { const long k0_ = KROW(j); const char* kb_ = uni_ptr(KVh + k0_ * 4096); const char* rb_ = uni_ptr(KRp + k0_ * 64); \
    glds16_s(kb_, vofK[0], ldsK + (kslot) * SHM_KN); glds16_s(kb_, vofK[1], ldsK + (kslot) * SHM_KN + 1024u); \
    glds16_s(rb_, vofR, ldsR + (kslot) * SHM_KR); \
    glds16_s(kb_, vofV[0], ldsV + (vslot) * SHM_V); glds16_s(kb_, vofV[1], ldsV + (vslot) * SHM_V + 1024u); } while (0)
#ifndef ATT_SKEW
#define ATT_SKEW 0
#endif
#if PROBE_TS
#define WAIT_SYNC() do { const unsigned long long w0_ = __builtin_amdgcn_s_memrealtime(); asm volatile("s_waitcnt vmcnt(0)" ::: "memory"); const unsigned long long w1_ = __builtin_amdgcn_s_memrealtime(); __syncthreads(); const unsigned long long w2_ = __builtin_amdgcn_s_memrealtime(); att_w_dma += w1_ - w0_; att_w_bar += w2_ - w1_; } while (0)
#else
#define WAIT_SYNC() do { asm volatile("s_waitcnt vmcnt(0)" ::: "memory"); __syncthreads(); if (ATT_SKEW && wid >= 4) __builtin_amdgcn_s_sleep(ATT_SKEW); } while (0)
#endif
#define RESC(a) do { if (__any((a) < 1.f)) { if (hi == 0) al_l[r32] = (a); asm volatile("s_waitcnt lgkmcnt(0)" ::: "memory"); \
    _Pragma("unroll") for (int d = 0; d < 4; ++d) _Pragma("unroll") for (int r = 0; r < 16; ++r) o[d][r] *= al_l[crow(r, hi)]; } } while (0)
#if PROBE_TS
  unsigned long long att_w_dma = 0, att_w_bar = 0; const unsigned long long att_t0 = __builtin_amdgcn_s_memrealtime();
#endif
  f32x16 pA0, pA1, pB0, pB1; float alA, alB; bf16x8 pa0, pa1, pa2, pa3;
  DMA_TILE(0, 0, 0); DMA_TILE(1, 1, 1); WAIT_SYNC();
  qkt(pA0, pA1, Kn_lds, Kr_lds, qr, r32, hi); partialSM(pA0, pA1, m_reg, alA);
  __syncthreads();
  int vprev = 0, vcur = 1, vnext = 2;
  for (int j = 1; j + 1 < NT; j += 2) {
    DMA_TILE(j + 1, 0, vnext);
    SBAR(); qkt(pB0, pB1, Kn_lds + SHM_KN, Kr_lds + SHM_KR, qr, r32, hi);
    finishSM(pA0, pA1, alA, l_reg, pa0, pa1, pa2, pa3); SBAR();
    pv_d0(o, vb0 + vprev * SHM_V, pa0, pa1, pa2, pa3); partialSM(pB0, pB1, m_reg, alB);
    RESC(alB); WAIT_SYNC();
    { const int t_ = vprev; vprev = vcur; vcur = vnext; vnext = t_; }
    if (j + 2 < NT) DMA_TILE(j + 2, 1, vnext);
    SBAR(); qkt(pA0, pA1, Kn_lds, Kr_lds, qr, r32, hi);
    finishSM(pB0, pB1, alB, l_reg, pa0, pa1, pa2, pa3); SBAR();
    pv_d0(o, vb0 + vprev * SHM_V, pa0, pa1, pa2, pa3); partialSM(pA0, pA1, m_reg, alA);
    RESC(alA); WAIT_SYNC();
    { const int t_ = vprev; vprev = vcur; vcur = vnext; vnext = t_; }
  }
  SBAR(); qkt(pB0, pB1, Kn_lds + SHM_KN, Kr_lds + SHM_KR, qr, r32, hi);
  finishSM(pA0, pA1, alA, l_reg, pa0, pa1, pa2, pa3); SBAR();
  pv_d0(o, vb0 + vprev * SHM_V, pa0, pa1, pa2, pa3); partialSM(pB0, pB1, m_reg, alB);
  RESC(alB);
  finishSM(pB0, pB1, alB, l_reg, pa0, pa1, pa2, pa3); SBAR();
  pv_d0(o, vb0 + vcur * SHM_V, pa0, pa1, pa2, pa3);
  if (hi == 0) li_l[r32] = l_reg; asm volatile("s_waitcnt lgkmcnt(0)" ::: "memory");
  float rli[16];
#pragma unroll
  for (int r = 0; r < 16; ++r) rli[r] = __builtin_amdgcn_rcpf(li_l[crow(r, hi)]);
  bf16* Ow = Ob + (long)(wid * QBLK) * 2048;
#pragma unroll
  for (int r = 0; r < 16; ++r) { const int orow = crow(r, hi);
#pragma unroll
    for (int d0 = 0; d0 < 4; ++d0) Ow[(long)orow * 2048 + d0 * 32 + r32] = (bf16)(cvt_pk_bf16(o[d0][r] * rli[r], 0.f) & 0xffffu); }
  __syncthreads();
#if PROBE_TS
  if (ts_words && tid == 0) { ts_words[160] += att_w_dma; ts_words[161] += att_w_bar; ts_words[162] += __builtin_amdgcn_s_memrealtime() - att_t0; ts_words[163] += (unsigned long long)NT; }
#endif
#undef KROW
#undef DMA_TILE
#undef WAIT_SYNC
#undef RESC
}
#undef SBAR
}

namespace scan {
constexpr int CH = 64;
constexpr int OFF_Q = 0, OFF_K = 32768  , OFF_V = 98304, OFF_P = 131072, OFF_ST = 131072 + 8192  , SHM_SCAN = OFF_ST + 4096;
__device__ __forceinline__ unsigned off_b(unsigned row, unsigned ch) { return 256u * row + 16u * (ch ^ (((row & 3) << 2) | ((row >> 2) & 3))); }
__device__ __forceinline__ unsigned p_off(unsigned i, unsigned chunk) { return 128u * i + 16u * (chunk ^ ((i >> 1) & 7)); }
__device__ __forceinline__ int crow(int r, int hi) { return (r & 3) + 8 * (r >> 2) + 4 * hi; }
__device__ __forceinline__ s16x4 vtr(const LAS char* p) { typedef short v4i16_t __attribute__((ext_vector_type(4))); return __builtin_bit_cast(s16x4, __builtin_amdgcn_ds_read_tr16_b64_v4i16((LAS v4i16_t*)p)); }
__device__ __forceinline__ bf16x8 tr_frag(const LAS char* img, int lane, int c, int ks) {
    const unsigned h = lane >> 5, blk = (lane >> 4) & 1, q = (lane & 15) >> 2, p = lane & 3;
    const unsigned r0 = 16 * ks + 8 * h + q, chn = 4 * c + 2 * blk + (p >> 1);
    const s16x4 lo = vtr(img + off_b(r0, chn) + 8 * (p & 1)), hi = vtr(img + off_b(r0 + 4, chn) + 8 * (p & 1));
    return (bf16x8){lo[0], lo[1], lo[2], lo[3], hi[0], hi[1], hi[2], hi[3]};
}
__device__ __forceinline__ bf16x8 pack_step(const f32x16& x, int s) {
    u32x4 p; p.x = cvt_pk_bf16(x[8 * s + 0], x[8 * s + 1]); p.y = cvt_pk_bf16(x[8 * s + 2], x[8 * s + 3]); p.z = cvt_pk_bf16(x[8 * s + 4], x[8 * s + 5]); p.w = cvt_pk_bf16(x[8 * s + 6], x[8 * s + 7]);
    return __builtin_bit_cast(bf16x8, p);
}
__device__ __forceinline__ void dma_mat(const bf16* src, int ld, LAS unsigned char* dst, int wid, int lane) {
    const char* sb = uni_ptr(src); const unsigned d0 = (unsigned)__builtin_amdgcn_readfirstlane((unsigned)(uintptr_t)dst + (unsigned)wid * 4096u);
#pragma unroll
    for (int k = 0; k < 4; ++k) { const int pc = wid * 4 + k, img = pc >> 4, row = 4 * (pc & 15) + (lane >> 4), pos = lane & 15;
        const int ch = pos ^ (((row & 3) << 2) | ((row >> 2) & 3));
        glds16_s(sb, (unsigned)((row * ld + img * 128 + ch * 8) * 2), d0 + (unsigned)k * 1024u); }
}
__device__ __forceinline__ int scan_rowbase(int n, int b, int dir) { return (n < 4) ? MX + b * CTXL + (dir ? 3 - n : n) * CH : b * SEQ + (dir ? 67 - n : n - 4) * CH; }
__device__ __forceinline__ float uni_f(float x) { return __uint_as_float(__builtin_amdgcn_readfirstlane(__float_as_uint(x))); }
typedef const LAS s16x4* lds_s4p;
__device__ __forceinline__ void scan_unit(const bf16* __restrict__ QKV, bf16* __restrict__ Y, float* __restrict__ PST, int b, int hd, int dir, int dvh, float lg2, bool skip_ctx_y, LAS unsigned char* lds, int tid_in, unsigned long long* lds_ts = nullptr) {
    int tid = tid_in; asm volatile("" : "+v"(tid));
    const int wid = __builtin_amdgcn_readfirstlane(tid >> 6), lane0 = tid & 63;
    const LAS char* QI = (const LAS char*)lds + OFF_Q; const LAS char* VI = (const LAS char*)lds + OFF_V;
    LAS char* PI = (LAS char*)lds + OFF_P;
    f32x16 S[8];
#pragma unroll
    for (int i = 0; i < 8; ++i) S[i] = f32x16{};
    const float lgr = dir ? -lg2 : lg2;
    const float g64 = uni_f(__builtin_amdgcn_exp2f(64.f * lg2));
    const float R1 = uni_f(__builtin_amdgcn_exp2f(lgr)), R8 = uni_f(__builtin_amdgcn_exp2f(8.f * lgr)), R32 = uni_f(__builtin_amdgcn_exp2f(32.f * lgr));
    const float Rm1 = uni_f(__builtin_amdgcn_exp2f(-lgr)), Rm16 = uni_f(__builtin_amdgcn_exp2f(-16.f * lgr));
    const float c0 = uni_f(dir ? g64 : __builtin_amdgcn_exp2f(lg2)), z0 = uni_f(dir ? 1.0f : __builtin_amdgcn_exp2f(63.f * lg2));
    const int qcol = hd * RDK, kcol = 2048 + hd * RDK, vcol = 4096 + hd * RDV + dvh * 256;
    { const bf16* src = QKV + (size_t)scan_rowbase(0, b, dir) * 8192;
      dma_mat(src + qcol, 8192, lds + OFF_Q, wid, lane0); dma_mat(src + kcol, 8192, lds + OFF_K, wid, lane0); dma_mat(src + vcol, 8192, lds + OFF_V, wid, lane0);
      asm volatile("s_waitcnt vmcnt(0)" ::: "memory"); __syncthreads(); }
#if PROBE_TS
    unsigned long long sc_w1 = 0, sc_w2 = 0; const unsigned long long sc_tb = __builtin_amdgcn_s_memrealtime();
#endif
    for (int n = 0; n < 68; ++n) {
        int lane = lane0; asm volatile("" : "+v"(lane));
        const int r = lane & 31, h = lane >> 5, fr = lane & 15, fq = lane >> 4;
        const int rowbase = scan_rowbase(n, b, dir);
        const bool more = n + 1 < 68;
        const bf16* nsrc = QKV + (size_t)scan_rowbase(more ? n + 1 : n, b, dir) * 8192;
        const LAS char* KI = (const LAS char*)lds + OFF_K + (n & 1) * 32768;
        if (more) dma_mat(nsrc + kcol, 8192, lds + OFF_K + ((n + 1) & 1) * 32768, wid, lane);
        const float LR = c0 * __builtin_amdgcn_exp2f((float)r * lgr), LZ = z0 * __builtin_amdgcn_exp2f((float)(-8 * h) * lgr), LP = __builtin_amdgcn_exp2f((float)(fr - 4 * fq) * lgr);
        { const int fH = fr & 3, fL = (fr >> 2) & 3; const int AL = 256 * fr + 16 * (fq ^ fL);
          int AH[4];
#pragma unroll
          for (int k = 0; k < 4; ++k) AH[k] = 64 * (k ^ fH);
#pragma unroll
          for (int tix = 0; tix < 2; ++tix) { const int tt = wid * 2 + tix, jt = tt >> 2, it = tt & 3;
            f32x4 pt = {0.f, 0.f, 0.f, 0.f};
            const bool live = dir ? (jt >= it) : (jt <= it);
            if (live) { const LAS char* ka = KI + 4096 * jt + AL; const LAS char* qa = QI + 4096 * it + AL;
#pragma unroll
                for (int ks = 0; ks < 8; ++ks) { const int o = (ks >> 2) * 16384 + AH[ks & 3];
                    pt = __builtin_amdgcn_mfma_f32_16x16x32_bf16(*(const LAS bf16x8*)(ka + o), *(const LAS bf16x8*)(qa + o), pt, 0, 0, 0); } }
            float we = LP * __builtin_amdgcn_exp2f((float)(16 * (it - jt)) * lgr); float v[4];
            const int mrel = fr - 4 * fq;
#pragma unroll
            for (int e = 0; e < 4; ++e) { float x = live ? pt[e] * we : 0.f; if (jt == it) { const bool keep = dir ? (e >= mrel) : (e <= mrel); x = keep ? x : 0.f; } v[e] = x; we *= Rm1; }
            const int i = it * 16 + fr, j0 = jt * 16 + 4 * fq;
            u32x2 w; w.x = cvt_pk_bf16(v[0], v[1]); w.y = cvt_pk_bf16(v[2], v[3]);
            *(LAS u32x2*)(PI + p_off(i, j0 >> 3) + ((j0 >> 2) & 1) * 8) = w; } }
        f32x16 Yt[2]; Yt[0] = f32x16{}; Yt[1] = f32x16{};
        { const int fH = r & 3, fL = (r >> 2) & 3; int QH[4], QL[4];
#pragma unroll
          for (int k = 0; k < 4; ++k) { QH[k] = 64 * (k ^ fH); QL[k] = 256 * r + 8 * h + 16 * (k ^ fL); }
#pragma unroll
          for (int dkb = 0; dkb < 8; ++dkb)
#pragma unroll
            for (int s = 0; s < 2; ++s) { const bf16x8 bf = pack_step(S[dkb], s);
                const LAS char* rp = QI + (dkb >> 2) * 16384 + QH[dkb & 3];
#pragma unroll
                for (int it = 0; it < 2; ++it) {
                    const u32x2 lo = *(const LAS u32x2*)(rp + it * 8192 + QL[2 * s]), hi2 = *(const LAS u32x2*)(rp + it * 8192 + QL[2 * s + 1]);
                    const u32x4 aw = {lo.x, lo.y, hi2.x, hi2.y};
                    Yt[it] = __builtin_amdgcn_mfma_f32_32x32x16_bf16(bf, __builtin_bit_cast(bf16x8, aw), Yt[it], 0, 0, 0); } } }
        { const float f0 = LR, f1 = LR * R32;
#pragma unroll
          for (int rg = 0; rg < 16; ++rg) { Yt[0][rg] *= f0; Yt[1][rg] *= f1; } }
#if PROBE_TS
        const unsigned long long sc_t0 = __builtin_amdgcn_s_memrealtime();
#endif
        if (more) asm volatile("s_waitcnt vmcnt(4)" ::: "memory"); else asm volatile("s_waitcnt vmcnt(0)" ::: "memory");
        __syncthreads();
#if PROBE_TS
        sc_w1 += __builtin_amdgcn_s_memrealtime() - sc_t0;
#endif
        if (more) dma_mat(nsrc + qcol, 8192, lds + OFF_Q, wid, lane);
#pragma unroll
        for (int i = 0; i < 8; ++i)
#pragma unroll
            for (int rg = 0; rg < 16; ++rg) S[i][rg] *= g64;
        {
          const int blk = (lane >> 4) & 1, q = (lane & 15) >> 2, p = lane & 3; int TB[2], CQ[4];
#pragma unroll
          for (int t = 0; t < 2; ++t) TB[t] = 2048 * h + 256 * q + 1024 * t + 16 * ((2 * blk + (p >> 1)) ^ ((2 * h + t) & 3)) + 8 * (p & 1);
#pragma unroll
          for (int c = 0; c < 4; ++c) CQ[c] = 64 * (c ^ q);
          const LAS char* vb = VI + (wid >> 2) * 16384 + CQ[wid & 3];
          float zk = LZ;
#pragma unroll
          for (int ks = 0; ks < 4; ++ks) {
            const s16x4 vlo = vtr(vb + 4096 * ks + TB[0]), vhi = vtr(vb + 4096 * ks + TB[1]);
            const u32x2 vl = __builtin_bit_cast(u32x2, vlo), vh = __builtin_bit_cast(u32x2, vhi);
            const u32x4 vw = {vl.x, vl.y, vh.x, vh.y}; const bf16x8 vf = __builtin_bit_cast(bf16x8, vw);
#pragma unroll
            for (int it = 0; it < 2; ++it) { const bf16x8 pa = *(const LAS bf16x8*)(PI + p_off(it * 32 + r, 2 * ks + h));
                Yt[it] = __builtin_amdgcn_mfma_f32_32x32x16_bf16(vf, pa, Yt[it], 0, 0, 0); }
            float zj = zk; u32x4 zw;
            { const float a0 = bflo(vw.x) * zj; zj *= Rm1; const float a1 = bfhi(vw.x) * zj; zj *= Rm1; zw.x = cvt_pk_bf16(a0, a1); }
            { const float a0 = bflo(vw.y) * zj; zj *= Rm1; const float a1 = bfhi(vw.y) * zj; zj *= Rm1; zw.y = cvt_pk_bf16(a0, a1); }
            { const float a0 = bflo(vw.z) * zj; zj *= Rm1; const float a1 = bfhi(vw.z) * zj; zj *= Rm1; zw.z = cvt_pk_bf16(a0, a1); }
            { const float a0 = bflo(vw.w) * zj; zj *= Rm1; const float a1 = bfhi(vw.w) * zj; zw.w = cvt_pk_bf16(a0, a1); }
            const bf16x8 vz = __builtin_bit_cast(bf16x8, zw);
            zk *= Rm16;
#pragma unroll
            for (int dkb = 0; dkb < 8; ++dkb) { const LAS char* kb_ = KI + (dkb >> 2) * 16384 + 4096 * ks + CQ[dkb & 3];
                const s16x4 klo = vtr(kb_ + TB[0]), khi = vtr(kb_ + TB[1]);
                const u32x2 kl = __builtin_bit_cast(u32x2, klo), kh = __builtin_bit_cast(u32x2, khi); const u32x4 kw = {kl.x, kl.y, kh.x, kh.y};
                S[dkb] = __builtin_amdgcn_mfma_f32_32x32x16_bf16(__builtin_bit_cast(bf16x8, kw), vz, S[dkb], 0, 0, 0); }
            __builtin_amdgcn_sched_barrier(0);
          } }
        if (!(skip_ctx_y && n < 4)) {
            bf16* Yr = Y + (size_t)rowbase * 4096; const unsigned yo = (unsigned)(r * 4096 + hd * RDV + dvh * 256 + wid * 32 + 8 * h);
#pragma unroll
            for (int it = 0; it < 2; ++it) {
                float s1a = 0.f, s1b = 0.f, s2a = 0.f, s2b = 0.f;
#pragma unroll
                for (int rg = 0; rg < 16; rg += 2) { s1a += Yt[it][rg]; s1b += Yt[it][rg + 1]; s2a = fmaf(Yt[it][rg], Yt[it][rg], s2a); s2b = fmaf(Yt[it][rg + 1], Yt[it][rg + 1], s2b); }
                float s1 = s1a + s1b, s2 = s2a + s2b;
                { auto rr = __builtin_amdgcn_permlane32_swap(__float_as_uint(s1), __float_as_uint(s1), false, false); s1 = __uint_as_float(rr[0]) + __uint_as_float(rr[1]); }
                { auto rr = __builtin_amdgcn_permlane32_swap(__float_as_uint(s2), __float_as_uint(s2), false, false); s2 = __uint_as_float(rr[0]) + __uint_as_float(rr[1]); }
                if (h == 0) *(LAS f32x2*)((LAS char*)lds + OFF_ST + ((it * 32 + r) * 8 + wid) * 8) = (f32x2){s1, s2};
#pragma unroll
                for (int g = 0; g < 4; g += 2) {
                    unsigned ax = cvt_pk_bf16(Yt[it][4 * g + 0], Yt[it][4 * g + 1]), ay = cvt_pk_bf16(Yt[it][4 * g + 2], Yt[it][4 * g + 3]);
                    unsigned bx_ = cvt_pk_bf16(Yt[it][4 * g + 4], Yt[it][4 * g + 5]), by = cvt_pk_bf16(Yt[it][4 * g + 6], Yt[it][4 * g + 7]);
                    { auto r_ = __builtin_amdgcn_permlane32_swap(ax, bx_, false, false); ax = r_[0]; bx_ = r_[1]; }
                    { auto r_ = __builtin_amdgcn_permlane32_swap(ay, by, false, false); ay = r_[0]; by = r_[1]; }
                    *(u32x4*)(Yr + yo + (unsigned)(it * 32 * 4096 + 8 * g)) = (u32x4){ax, ay, bx_, by}; } }
        }
#if PROBE_TS
        const unsigned long long sc_t1 = __builtin_amdgcn_s_memrealtime();
#endif
        asm volatile("s_waitcnt vmcnt(0)" ::: "memory");
        __syncthreads();
#if PROBE_TS
        sc_w2 += __builtin_amdgcn_s_memrealtime() - sc_t1;
#endif
        if (more) dma_mat(nsrc + vcol, 8192, lds + OFF_V, wid, lane);
        if (wid == 0 && !(skip_ctx_y && n < 4)) {
            const LAS f32x4* sp = (const LAS f32x4*)((const LAS char*)lds + OFF_ST + lane * 64);
            const f32x4 a = sp[0], b_ = sp[1], c = sp[2], d = sp[3];
            const float S1 = ((a[0] + a[2]) + (b_[0] + b_[2])) + ((c[0] + c[2]) + (d[0] + d[2])), S2 = ((a[1] + a[3]) + (b_[1] + b_[3])) + ((c[1] + c[3]) + (d[1] + d[3]));
            *(f32x2*)(PST + ((size_t)(rowbase + lane) * 8 + hd) * 4 + dvh * 2) = (f32x2){S1, S2};
        }
    }
    asm volatile("s_waitcnt vmcnt(0)" ::: "memory"); __syncthreads();
#if PROBE_TS
    if (blockIdx.x == 0 && tid == 0) { unsigned long long* tw = (unsigned long long*)(lds_ts); tw[170] += sc_w1; tw[171] += sc_w2; tw[172] += __builtin_amdgcn_s_memrealtime() - sc_tb; }
#endif
}
}

#define XB_TMO      128
#define XB_XCNT(j)  (256  + 64 * (j))
#define XB_XSUB(j)  (1280 + 64 * (j))
#define XB_XGEN(j)  (2304 + 64 * (j))
#define XB_TOP      3328
#define XB_TOPGEN   3392
#define XCD_BAR_WORDS 3456
#define XB_SPIN_CAP (1u << 22)
__device__ __forceinline__ unsigned xb_ld(unsigned* p)              { return __hip_atomic_load(p, __ATOMIC_RELAXED, __HIP_MEMORY_SCOPE_AGENT); }
__device__ __forceinline__ unsigned xb_add(unsigned* p, unsigned v) { return __hip_atomic_fetch_add(p, v, __ATOMIC_RELAXED, __HIP_MEMORY_SCOPE_AGENT); }
__device__ __forceinline__ unsigned xb_xcc_id() { return (unsigned)__builtin_amdgcn_s_getreg((3 << 11) | 20) & 0xFu; }
#define XB_SPIN(cond, bar) do { unsigned _sp = 0; while (cond) { __builtin_amdgcn_s_sleep(1); \
    if ((++_sp & 255u) == 0u) { if (xb_ld(&(bar)[XB_TMO])) break; if (_sp > XB_SPIN_CAP) { atomicAdd(&(bar)[XB_TMO], 1u); break; } } } } while (0)
struct XcdBarrier { unsigned* bar; unsigned x; volatile LAS unsigned* st; int wave; };
__device__ __forceinline__ XcdBarrier xcd_barrier_post(unsigned* bar, volatile LAS unsigned* st, int wave) {
    XcdBarrier b; b.bar = bar; b.x = xb_xcc_id(); b.st = st; b.wave = wave;
    if (wave == 0 && lane_id() == 0) (void)xb_add(&bar[XB_XCNT(b.x)], 1u);
    return b;
}
__device__ __forceinline__ void xcd_barrier_complete(unsigned* bar, unsigned x, unsigned& nloc, unsigned& nx) {
    const unsigned G = gridDim.x * gridDim.y * gridDim.z;
    unsigned sum, cnt, mine, sp = 0u;
    for (;;) {
        sum = 0u; cnt = 0u; mine = 0u;
#pragma unroll
        for (unsigned j = 0; j < 16; ++j) { const unsigned c = xb_ld(&bar[XB_XCNT(j)]); sum += c; cnt += (c > 0u) ? 1u : 0u; mine = (j == x) ? c : mine; }
        if (sum == G) break;
        __builtin_amdgcn_s_sleep(1);
        if ((++sp & 255u) == 0u) { if (xb_ld(&bar[XB_TMO])) break; if (sp > XB_SPIN_CAP) { atomicAdd(&bar[XB_TMO], 1u); break; } }
    }
    nloc = mine > 0u ? mine : 1u; nx = cnt > 0u ? cnt : 1u;
}
__device__ __forceinline__ void xcd_barrier(const XcdBarrier& b) {
    asm volatile("s_waitcnt vmcnt(0)" ::: "memory");
    __syncthreads();
    if (b.wave == 0 && lane_id() == 0) {
        unsigned* bar = b.bar; asm volatile("" : "+s"(bar));
        __builtin_amdgcn_s_waitcnt(0);
        unsigned nloc = b.st[0], nx = b.st[1];
        if (nloc == 0u) { xcd_barrier_complete(bar, b.x, nloc, nx); b.st[0] = nloc; b.st[1] = nx; }
        const unsigned old = xb_add(&bar[XB_XSUB(b.x)], 1u);
        const unsigned gen = old / nloc;
        if (old + 1u == (gen + 1u) * nloc) {
            __builtin_amdgcn_fence(__ATOMIC_RELEASE, "agent");
            asm volatile("s_waitcnt vmcnt(0)" ::: "memory");
            const unsigned og = xb_add(&bar[XB_TOP], 1u);
            const unsigned tg = og / nx;
            if (og + 1u == (tg + 1u) * nx) xb_add(&bar[XB_TOPGEN], 1u);
            else XB_SPIN(xb_ld(&bar[XB_TOPGEN]) == tg, bar);
            __builtin_amdgcn_fence(__ATOMIC_ACQUIRE, "agent");
            xb_add(&bar[XB_XGEN(b.x)], 1u);
            asm volatile("s_waitcnt vmcnt(0)" ::: "memory");
        } else {
            XB_SPIN(xb_ld(&bar[XB_XGEN(b.x)]) == gen, bar);
            __builtin_amdgcn_fence(__ATOMIC_ACQUIRE, "agent");
            asm volatile("s_waitcnt vmcnt(0)" ::: "memory");
        }
    }
    __syncthreads();
}

__device__ __forceinline__ float wave_sum(float v, int lane) {
#pragma unroll
    for (int o = 1; o < 64; o <<= 1) v += shfl_xor_l(v, o, lane);
    return v;
}
struct CvtDesc { const float* src; const float* kscale; bf16* WTrow0; int ldw, k0, K, jkind; float gscale; };
__device__ __forceinline__ int ropeperm64(int c) { const int p = c >> 1, e = c & 1; return (p < 16) ? (p + 16 * e) : (32 + (p - 16) + 16 * e); }
__device__ __forceinline__ int ropeinv64(int s_) { const int half = s_ >> 5, w = s_ & 31; return 2 * (half * 16 + (w & 15)) + (w >> 4); }
__device__ __forceinline__ void cvt_load(const CvtDesc& d, int lane, f32x4 (&v)[16]) {
#pragma unroll
    for (int i = 0; i < 16; ++i) { const int kk = 4 * i + (lane >> 4);
        f32x4 x = d.src ? *(const f32x4*)(d.src + (size_t)(d.k0 + kk) * d.ldw) : (f32x4){0.f, 0.f, 0.f, 0.f};
        float sc_ = d.gscale; if (d.kscale) sc_ *= d.kscale[d.k0 + kk];
        v[i] = x * sc_; }
}
__device__ __forceinline__ void cvt_store(const CvtDesc& d, int lane, const f32x4 (&v)[16], LAS float* scr) {
    const int n4 = lane & 15; int jr[4];
#pragma unroll
    for (int e = 0; e < 4; ++e) { const int s_ = 4 * n4 + e; jr[e] = d.jkind == 0 ? s_ : d.jkind == 1 ? ropeinv64(s_) : 2 * (4 * (n4 & 7) + e) + (n4 >> 3); }
#pragma unroll
    for (int i = 0; i < 16; ++i) { const int kk = 4 * i + (lane >> 4);
#pragma unroll
        for (int e = 0; e < 4; ++e) scr[kk * 65 + jr[e]] = v[i][e]; }
    asm volatile("s_waitcnt lgkmcnt(0)" ::: "memory");
    const int c = lane & 7;
#pragma unroll
    for (int ps = 0; ps < 8; ++ps) { const int j = 8 * ps + (lane >> 3); const LAS float* s = scr + (8 * c) * 65 + j;
        u32x4 o; o.x = cvt_pk_bf16(s[0 * 65], s[1 * 65]); o.y = cvt_pk_bf16(s[2 * 65], s[3 * 65]); o.z = cvt_pk_bf16(s[4 * 65], s[5 * 65]); o.w = cvt_pk_bf16(s[6 * 65], s[7 * 65]);
        *(u32x4*)(d.WTrow0 + (size_t)j * d.K + d.k0 + 8 * c) = o; }
    asm volatile("s_waitcnt lgkmcnt(0)" ::: "memory");
}
struct CvtJob { const float* W0; const float* W1; const float* kscale; bf16* WT; int ldw, K, nrows, kind, aux; float gscale; };
__device__ __forceinline__ bool cvt_try(const CvtJob& J, int& it, int lane, CvtDesc& d) {
    const int nblk = J.nrows / 64, items = (J.K / 64) * nblk;
    if (it >= items) { it -= items; return false; }
    const int kb = it / nblk, nb = it % nblk; const int n4 = lane & 15;
    const float* sp; int jk = 0;
    switch (J.kind) {
        case 0: sp = J.W0 + J.aux + nb * 64 + 4 * n4; break;
        case 1: sp = J.W0 + J.aux + 4 * n4; jk = 1; break;
        case 2: { const int hh = nb / 3, part = nb % 3; sp = J.W0 + hh * DQ + 64 * part + 4 * n4; jk = (part == 2) ? 1 : 0; } break;
        case 3: { const int hh = nb >> 2, q4 = nb & 3; sp = J.W0 + hh * 256 + 32 * q4 + 128 * (n4 >> 3) + 4 * (n4 & 7); jk = 2; } break;
        case 4: { const int tl = nb >> 2, hf = (nb >> 1) & 1, q2 = nb & 1; const long long dW = (const char*)J.W1 - (const char*)J.W0; sp = (const float*)((const char*)J.W0 + dW * hf) + tl * 128 + 64 * q2 + 4 * n4; } break;
        default: sp = nullptr; break;
    }
    d.src = sp; d.kscale = J.kscale; d.WTrow0 = J.WT + (size_t)(nb * 64) * J.K; d.ldw = J.ldw; d.k0 = kb * 64; d.K = J.K; d.jkind = jk; d.gscale = J.gscale;
    return true;
}
__device__ __forceinline__ int cvt_items(const CvtJob& J) { return (J.K / 64) * (J.nrows / 64); }

__device__ __forceinline__ void row_load(const float* xrow, int lane, f32x4 (&v)[8]) {
#pragma unroll
    for (int j = 0; j < 8; ++j) v[j] = *(const f32x4*)(xrow + 4 * lane + 256 * j);
}
__device__ __forceinline__ void norm_row_f32(const f32x4 (&v)[8], const f32x4 (&A)[8], const f32x4 (&Bc)[8], bf16* orow, int lane) {
    float s = 0.f;
#pragma unroll
    for (int j = 0; j < 8; ++j) s += (v[j][0] * v[j][0] + v[j][1] * v[j][1]) + (v[j][2] * v[j][2] + v[j][3] * v[j][3]);
    const float rstd = 1.0f / sqrtf(wave_sum(s, lane) * (1.0f / D) + NORM_EPS);
#pragma unroll
    for (int j = 0; j < 8; ++j) { const f32x4 y = (v[j] * rstd) * A[j] + Bc[j];
        u32x2 w; w.x = cvt_pk_bf16(y[0], y[1]); w.y = cvt_pk_bf16(y[2], y[3]); *(u32x2*)(orow + 4 * lane + 256 * j) = w; }
}
__device__ __forceinline__ void norm_coef_f32(const float* g, const float* mr, int lane, f32x4 (&A)[8], f32x4 (&Bc)[8]) {
#pragma unroll
    for (int j = 0; j < 8; ++j) { const int c = 4 * lane + 256 * j; A[j] = *(const f32x4*)(g + c) * (1.0f + *(const f32x4*)(mr + D + c)); Bc[j] = *(const f32x4*)(mr + c); }
}
__device__ __forceinline__ void norm_phase(const float* xsrc, const float* csrc, const float* g, const float* modl, int chunk, bf16* H, int nrows, int gw, int NGW, int lane) {
    const int G8 = NGW >> 3, b = gw / G8, idx = gw - b * G8;
    f32x4 A[8], Bc[8];
    if (idx < SEQ) {
        norm_coef_f32(g, modl + (size_t)b * NMOD + chunk * D, lane, A, Bc);
        f32x4 v[8], vn[8]; int m = b * SEQ + idx; const int mend = (b + 1) * SEQ;
        row_load(xsrc + (size_t)m * D, lane, v);
        for (;;) {
            const int mn = m + G8; const bool has = mn < mend;
            if (has) row_load(xsrc + (size_t)mn * D, lane, vn);
            norm_row_f32(v, A, Bc, H + (size_t)m * D, lane);
            if (!has) break;
#pragma unroll
            for (int j = 0; j < 8; ++j) v[j] = vn[j];
            m = mn;
        }
    }
    if (MX + gw < nrows) {
        norm_coef_f32(g, modl + (size_t)8 * NMOD + chunk * D, lane, A, Bc);
        for (int m = MX + gw; m < nrows; m += NGW) { f32x4 v[8]; row_load(csrc + (size_t)(m - MX) * D, lane, v); norm_row_f32(v, A, Bc, H + (size_t)m * D, lane); }
    }
}

__device__ __forceinline__ void row_load_b16(const bf16* xrow, int lane, u32x4 (&v)[4]) {
#pragma unroll
    for (int j = 0; j < 4; ++j) v[j] = *(const u32x4*)(xrow + 8 * lane + 512 * j);
}
__device__ __forceinline__ void norm_row_b16(const u32x4 (&v)[4], const f32x4 (&A)[8], const f32x4 (&Bc)[8], bf16* orow, int lane) {
    f32x4 xa[4], xb[4]; float ss = 0.f;
#pragma unroll
    for (int j = 0; j < 4; ++j) { xa[j] = (f32x4){bflo(v[j].x), bfhi(v[j].x), bflo(v[j].y), bfhi(v[j].y)}; xb[j] = (f32x4){bflo(v[j].z), bfhi(v[j].z), bflo(v[j].w), bfhi(v[j].w)};
        ss += ((xa[j][0] * xa[j][0] + xa[j][1] * xa[j][1]) + (xa[j][2] * xa[j][2] + xa[j][3] * xa[j][3])) + ((xb[j][0] * xb[j][0] + xb[j][1] * xb[j][1]) + (xb[j][2] * xb[j][2] + xb[j][3] * xb[j][3])); }
    const float rstd = 1.0f / sqrtf(wave_sum(ss, lane) * (1.0f / D) + NORM_EPS);
#pragma unroll
    for (int j = 0; j < 4; ++j) { const f32x4 ya = (xa[j] * rstd) * A[2 * j] + Bc[2 * j], yb = (xb[j] * rstd) * A[2 * j + 1] + Bc[2 * j + 1];
        *(u32x4*)(orow + 8 * lane + 512 * j) = pack8(ya, yb); }
}
__device__ __forceinline__ void norm_coef_b16(const float* g, const float* mr, int lane, f32x4 (&A)[8], f32x4 (&Bc)[8]) {
#pragma unroll
    for (int j = 0; j < 8; ++j) { const int c = 8 * lane + 512 * (j >> 1) + 4 * (j & 1); A[j] = *(const f32x4*)(g + c) * (1.0f + *(const f32x4*)(mr + D + c)); Bc[j] = *(const f32x4*)(mr + c); }
}
__device__ __forceinline__ void norm_phase_b16(const bf16* xsrc, const bf16* csrc, const float* g, const float* modl, int chunk, bf16* H, int nrows, int gw, int NGW, int lane) {
    const int G8 = NGW >> 3, b = gw / G8, idx = gw - b * G8;
    f32x4 A[8], Bc[8];
    if (idx < SEQ) {
        norm_coef_b16(g, modl + (size_t)b * NMOD + chunk * D, lane, A, Bc);
        u32x4 v[4], vn[4]; int m = b * SEQ + idx; const int mend = (b + 1) * SEQ;
        row_load_b16(xsrc + (size_t)m * D, lane, v);
        for (;;) {
            const int mn = m + G8; const bool has = mn < mend;
            if (has) row_load_b16(xsrc + (size_t)mn * D, lane, vn);
            norm_row_b16(v, A, Bc, H + (size_t)m * D, lane);
            if (!has) break;
#pragma unroll
            for (int j = 0; j < 4; ++j) v[j] = vn[j];
            m = mn;
        }
    }
    if (MX + gw < nrows) {
        norm_coef_b16(g, modl + (size_t)8 * NMOD + chunk * D, lane, A, Bc);
        for (int m = MX + gw; m < nrows; m += NGW) { u32x4 v[4]; row_load_b16(csrc + (size_t)(m - MX) * D, lane, v); norm_row_b16(v, A, Bc, H + (size_t)m * D, lane); }
    }
}

__device__ __forceinline__ unsigned long long ld_arg(LAS unsigned char* lds, int i) {
    const volatile LAS unsigned* p = (const volatile LAS unsigned*)(lds + ARGS_OFF) + 2 * i;
    const unsigned lo = __builtin_amdgcn_readfirstlane(p[0]), hi = __builtin_amdgcn_readfirstlane(p[1]);
    return ((unsigned long long)hi << 32) | lo;
}
__device__ __forceinline__ void mod_layers(LAS unsigned char* lds, unsigned char* ws, int l_lo, int l_hi, int wg, int nwg, int tid, int lane, int wave) {
#define ARGF(i) ((const float*)ld_arg(lds, (i)))
    const int nitems = (l_hi - l_lo) * 96;
    if (wg >= nitems) return;
    LAS float* cond = (LAS float*)lds;
    LAS float* red = (LAS float*)(lds + 73728);
    float* MODV = (float*)(ws + WS_MODV);
    { const float* cin = ARGF(1); const float* cc = ARGF(3);
      for (int i = tid; i < 9 * D; i += 512) { const int r = i >> 11, k = i & (D - 1); const float c = (r < 8) ? cin[r * D + k] : cc[k]; cond[i] = c / (1.0f + __expf(-c)); } }
    __syncthreads();
    for (int it = wg; it < nitems; it += nwg) {
        const int l = l_lo + it / 96, cb = it % 96; const int n = cb * 128 + 2 * lane;
        const float* W = ARGF(4) + (size_t)l * D * NMOD + n; const float* mb = ARGF(5) + (size_t)l * NMOD + cb * 128;
        float a0[9], a1[9];
#pragma unroll
        for (int r = 0; r < 9; ++r) { a0[r] = 0.f; a1[r] = 0.f; }
        for (int k = wave * 256; k < wave * 256 + 256; k += 8) {
            f32x2 w[8];
#pragma unroll
            for (int q = 0; q < 8; ++q) w[q] = *(const f32x2*)(W + (size_t)(k + q) * NMOD);
#pragma unroll
            for (int q4 = 0; q4 < 2; ++q4)
#pragma unroll
                for (int r = 0; r < 9; ++r) { const f32x4 c4 = *(const LAS f32x4*)(cond + r * D + k + 4 * q4);
#pragma unroll
                    for (int q = 0; q < 4; ++q) { a0[r] += c4[q] * w[4 * q4 + q][0]; a1[r] += c4[q] * w[4 * q4 + q][1]; } }
        }
#pragma unroll
        for (int r = 0; r < 9; ++r) { red[(wave * 9 + r) * 128 + 2 * lane] = a0[r]; red[(wave * 9 + r) * 128 + 2 * lane + 1] = a1[r]; }
        __syncthreads();
        for (int i = tid; i < 9 * 128; i += 512) { const int r = i >> 7, cc = i & 127; float s2 = 0.f;
#pragma unroll
            for (int w8 = 0; w8 < 8; ++w8) s2 += red[(w8 * 9 + r) * 128 + cc];
            MODV[((size_t)l * 9 + r) * NMOD + cb * 128 + cc] = s2 + mb[cc]; }
        __syncthreads();
    }
#undef ARGF
}
__device__ __forceinline__ void cvt_layer(LAS unsigned char* lds, unsigned char* ws, int lc, int rank, int nranks, int wave, int lane, int part  ) {
#define ARGF(i) ((const float*)ld_arg(lds, (i)))
    const int li = lc >> 1; const bool is_ret = (lc & 1) != 0;
    bf16* WM = (bf16*)(ws + (is_ret ? WS_WB : WS_WA)); bf16* WF = (bf16*)(ws + (is_ret ? WS_WB + 82 * MiB : WS_WA + 22 * MiB));
    LAS float* scr = (LAS float*)(lds + wave * 19456);
    CvtJob J[7]; int nj;
    if (!is_ret) {
        bf16* W1T = WM; bf16* WuqT = W1T + (size_t)N1 * D; bf16* WukvT = WuqT + (size_t)3072 * 512; bf16* WoT = WukvT + (size_t)4096 * 512;
        const float* wdq = ARGF(8) + (size_t)li * D * QR; const float* wdkv = ARGF(11) + (size_t)li * D * (KVR + ROPE);
        J[0] = CvtJob{wdq, nullptr, nullptr, W1T, QR, D, 512, 0, 0, 1.f};
        J[1] = CvtJob{wdkv, nullptr, nullptr, W1T + (size_t)512 * D, KVR + ROPE, D, 512, 0, 0, 1.f};
        J[2] = CvtJob{wdkv, nullptr, nullptr, W1T + (size_t)1024 * D, KVR + ROPE, D, 64, 1, 512, 1.f};
        J[3] = CvtJob{nullptr, nullptr, nullptr, W1T + (size_t)1088 * D, 1, D, 192, 5, 0, 1.f};
        J[4] = CvtJob{ARGF(10) + (size_t)li * QR * 3072, nullptr, ARGF(9) + li * QR, WuqT, 3072, QR, 3072, 2, 0, 0.07216878364870322f * LOG2E};
        J[5] = CvtJob{ARGF(13) + (size_t)li * KVR * 4096, nullptr, ARGF(12) + li * KVR, WukvT, 4096, KVR, 4096, 0, 0, 1.f};
        J[6] = CvtJob{ARGF(14) + (size_t)li * D * D, nullptr, nullptr, WoT, D, D, D, 0, 0, 1.f};
        nj = 7;
    } else {
        bf16* WqkvT = WM; bf16* WgT = WqkvT + (size_t)8192 * D; bf16* WoT = WgT + (size_t)8192 * D;
        J[0] = CvtJob{ARGF(15) + (size_t)li * D * D, nullptr, nullptr, WqkvT, D, D, 2048, 3, 0, 1.f};
        J[1] = CvtJob{ARGF(16) + (size_t)li * D * D, nullptr, nullptr, WqkvT + (size_t)2048 * D, D, D, 2048, 3, 0, 0.0625f};
        J[2] = CvtJob{ARGF(17) + (size_t)li * D * 4096, nullptr, nullptr, WqkvT + (size_t)4096 * D, 4096, D, 4096, 0, 0, 1.f};
        J[3] = CvtJob{ARGF(18) + (size_t)li * D * 4096, ARGF(19) + (size_t)li * D * 4096, nullptr, WgT, 4096, D, 8192, 4, 0, 1.f};
        J[4] = CvtJob{ARGF(20) + (size_t)li * 4096 * D, nullptr, nullptr, WoT, D, 4096, D, 0, 0, 1.f};
        J[5] = CvtJob{nullptr, nullptr, nullptr, nullptr, 1, 64, 0, 5, 0, 1.f};
        J[6] = J[5];
        nj = 5;
    }
    CvtJob F0 = CvtJob{ARGF(23) + (size_t)lc * D * FF, ARGF(24) + (size_t)lc * D * FF, nullptr, WF, FF, D, 11264, 4, 0, 1.f};
    CvtJob F1 = CvtJob{ARGF(27) + (size_t)lc * FF * D, nullptr, nullptr, WF + (size_t)11264 * D, D, FF, D, 0, 0, 1.f};
    if (part == 1) nj = 0;
    const bool ffn = part != 0;
    int total = ffn ? cvt_items(F0) + cvt_items(F1) : 0;
#pragma unroll
    for (int j = 0; j < 7; ++j) if (j < nj) total += cvt_items(J[j]);
#define CVT_FIND(IT, DD) do { int it_ = (IT); bool done_ = false; \
        _Pragma("unroll") for (int j = 0; j < 7; ++j) if (!done_ && j < nj) done_ = cvt_try(J[j], it_, lane, DD); \
        if (ffn) { if (!done_) done_ = cvt_try(F0, it_, lane, DD); if (!done_) done_ = cvt_try(F1, it_, lane, DD); } } while (0)
    if (rank < total) {
        f32x4 v[16], w[16]; CvtDesc d0, d1; int it0 = rank;
        CVT_FIND(it0, d0); cvt_load(d0, lane, v);
        for (;;) {
            const int it1 = it0 + nranks; const bool has = it1 < total;
            if (has) { CVT_FIND(it1, d1); cvt_load(d1, lane, w); }
            cvt_store(d0, lane, v, scr);
            if (!has) break;
#pragma unroll
            for (int i = 0; i < 16; ++i) v[i] = w[i];
            d0 = d1; it0 = it1;
        }
    }
#undef CVT_FIND
#undef ARGF
}

#if MLA_CHECK
constexpr int CW_CHK = 2048;
__device__ __forceinline__ float wave_max(float v, int lane) {
#pragma unroll
    for (int o = 1; o < 64; o <<= 1) v = fmaxf(v, shfl_xor_l(v, o, lane));
    return v;
}
__device__ __forceinline__ void mla_check(LAS unsigned char* lds, unsigned char* ws, int li, int gw, int wave, int lane) {
#define ARGF(i) ((const float*)ld_arg(lds, (i)))
    LAS float* sc = (LAS float*)(lds + wave * 19456);
    const bf16* H = (const bf16*)(ws + WS_H); const bf16* Qb = (const bf16*)(ws + WS_Q); const bf16* KVb = (const bf16*)(ws + WS_KV); const bf16* KRb = (const bf16*)(ws + WS_KR); const bf16* Ob = (const bf16*)(ws + WS_O);
    const int t = (int)(((unsigned)gw * 2654435761u) % (unsigned)MT); const int hd = gw & 15;
    const bool isx = t < MX; const int tt = t & (SEQ - 1);
    float err = 0.f;
    {
        const float* wdq = ARGF(8) + (size_t)li * D * QR; const float* wdkv = ARGF(11) + (size_t)li * D * (KVR + ROPE);
        float ql[8], kl[9];
#pragma unroll
        for (int j = 0; j < 8; ++j) ql[j] = 0.f;
#pragma unroll
        for (int j = 0; j < 9; ++j) kl[j] = 0.f;
        for (int k = 0; k < D; ++k) { const float hv = bf2f(H[(size_t)t * D + k]);
#pragma unroll
            for (int j = 0; j < 8; ++j) ql[j] += hv * wdq[(size_t)k * QR + lane + 64 * j];
#pragma unroll
            for (int j = 0; j < 9; ++j) kl[j] += hv * wdkv[(size_t)k * (KVR + ROPE) + lane + 64 * j]; }
        float sq = 0.f, sk = 0.f;
#pragma unroll
        for (int j = 0; j < 8; ++j) { sq += ql[j] * ql[j]; sk += kl[j] * kl[j]; }
        const float rq = 1.0f / sqrtf(wave_sum(sq, lane) * (1.0f / QR) + NORM_EPS), rk = 1.0f / sqrtf(wave_sum(sk, lane) * (1.0f / KVR) + NORM_EPS);
        const float* qg = ARGF(9) + li * QR; const float* kg = ARGF(12) + li * KVR;
#pragma unroll
        for (int j = 0; j < 8; ++j) { sc[lane + 64 * j] = ql[j] * rq * qg[lane + 64 * j]; sc[512 + lane + 64 * j] = kl[j] * rk * kg[lane + 64 * j]; }
        sc[1024 + lane] = kl[8];
        asm volatile("s_waitcnt lgkmcnt(0)" ::: "memory");
        const float* wuq = ARGF(10) + (size_t)li * QR * 3072 + hd * DQ; const float* wukv = ARGF(13) + (size_t)li * KVR * 4096 + hd * 256;
        float qv[3] = {0.f, 0.f, 0.f}, kv[4] = {0.f, 0.f, 0.f, 0.f};
        for (int c = 0; c < 512; ++c) { const float a = sc[c], bq = sc[512 + c];
#pragma unroll
            for (int j = 0; j < 3; ++j) qv[j] += a * wuq[(size_t)c * 3072 + lane + 64 * j];
#pragma unroll
            for (int j = 0; j < 4; ++j) kv[j] += bq * wukv[(size_t)c * 4096 + lane + 64 * j]; }
#pragma unroll
        for (int j = 0; j < 3; ++j) sc[1100 + lane + 64 * j] = qv[j];
        asm volatile("s_waitcnt lgkmcnt(0)" ::: "memory");
        float qref[3]; float kr_ref = 0.f;
#pragma unroll
        for (int j = 0; j < 3; ++j) { const int d = lane + 64 * j; float v = sc[1100 + d];
            if (d >= NOPE && isx) { const int e = d - NOPE, half = e >> 5, i = e & 15, second = (e >> 4) & 1; const float pos = half ? (float)(tt & 63) : (float)(tt >> 6);
                const float ang = pos * __builtin_amdgcn_exp2f(-(float)(2 * i) * (13.287712379549449f / 32.0f)); const float rev = ang * 0.15915494309189535f; const float fr_ = rev - floorf(rev);
                const float cs = __builtin_amdgcn_cosf(fr_), sn = __builtin_amdgcn_sinf(fr_); const float other = sc[1100 + NOPE + half * 32 + i + (second ? 0 : 16)];
                v = second ? (v * cs + other * sn) : (v * cs - other * sn); }
            qref[j] = v * (0.07216878364870322f * LOG2E); }
        { const int e = lane, half = e >> 5, i = e & 15, second = (e >> 4) & 1; float v = sc[1024 + e];
          if (isx) { const float pos = half ? (float)(tt & 63) : (float)(tt >> 6);
              const float ang = pos * __builtin_amdgcn_exp2f(-(float)(2 * i) * (13.287712379549449f / 32.0f)); const float rev = ang * 0.15915494309189535f; const float fr_ = rev - floorf(rev);
              const float cs = __builtin_amdgcn_cosf(fr_), sn = __builtin_amdgcn_sinf(fr_); const float other = sc[1024 + half * 32 + i + (second ? 0 : 16)];
              v = second ? (v * cs + other * sn) : (v * cs - other * sn); }
          kr_ref = v; }
#pragma unroll
        for (int j = 0; j < 3; ++j) sc[1400 + lane + 64 * j] = qref[j];
        sc[1600 + lane] = kr_ref;
        asm volatile("s_waitcnt lgkmcnt(0)" ::: "memory");
        float mx = 0.f, df = 0.f;
#pragma unroll
        for (int j = 0; j < 3; ++j) { const int p = lane + 64 * j; const int od = p < NOPE ? p : NOPE + ropeperm64(p - NOPE); const float ref = sc[1400 + od]; const float mine = bf2f(Qb[(size_t)t * 3072 + hd * DQ + p]);
            mx = fmaxf(mx, fabsf(ref)); df = fmaxf(df, fabsf(ref - mine)); }
        err = fmaxf(err, wave_max(df, lane) / (wave_max(mx, lane) + 1e-20f));
        mx = 0.f; df = 0.f;
#pragma unroll
        for (int j = 0; j < 4; ++j) { const float ref = kv[j]; const float mine = bf2f(KVb[(size_t)t * 4096 + hd * 256 + lane + 64 * j]); mx = fmaxf(mx, fabsf(ref)); df = fmaxf(df, fabsf(ref - mine)); }
        err = fmaxf(err, wave_max(df, lane) / (wave_max(mx, lane) + 1e-20f));
        { const float ref = sc[1600 + ropeperm64(lane)]; const float mine = bf2f(KRb[(size_t)t * 64 + lane]); err = fmaxf(err, wave_max(fabsf(ref - mine), lane) / (wave_max(fabsf(ref), lane) + 1e-20f)); }
    }
    {
        const int b = isx ? (t >> 12) : ((t - MX) >> 8); const int nk = isx ? 4352 : 256;
        for (int d = lane; d < DQ; d += 64) sc[d] = bf2f(Qb[(size_t)t * 3072 + hd * DQ + d]);
        asm volatile("s_waitcnt lgkmcnt(0)" ::: "memory");
        float mxs = -1e30f;
        for (int j = lane; j < nk; j += 64) { const int row = j < 256 ? MX + b * CTXL + j : b * SEQ + (j - 256); float sdot = 0.f;
            for (int d = 0; d < NOPE; ++d) sdot += sc[d] * bf2f(KVb[(size_t)row * 4096 + hd * 256 + d]);
            for (int d = 0; d < ROPE; ++d) sdot += sc[NOPE + d] * bf2f(KRb[(size_t)row * 64 + d]);
            sc[256 + j] = sdot; mxs = fmaxf(mxs, sdot); }
        mxs = wave_max(mxs, lane); float sum = 0.f;
        for (int j = lane; j < nk; j += 64) { const float p = __builtin_amdgcn_exp2f(sc[256 + j] - mxs); sc[256 + j] = p; sum += p; }
        sum = wave_sum(sum, lane);
        asm volatile("s_waitcnt lgkmcnt(0)" ::: "memory");
        float o0 = 0.f, o1 = 0.f;
        for (int j = 0; j < nk; ++j) { const int row = j < 256 ? MX + b * CTXL + j : b * SEQ + (j - 256); const float p = sc[256 + j];
            o0 += p * bf2f(KVb[(size_t)row * 4096 + hd * 256 + 128 + lane]); o1 += p * bf2f(KVb[(size_t)row * 4096 + hd * 256 + 128 + 64 + lane]); }
        o0 /= sum; o1 /= sum;
        const float m0 = bf2f(Ob[(size_t)t * D + hd * 128 + lane]), m1 = bf2f(Ob[(size_t)t * D + hd * 128 + 64 + lane]);
        const float df = fmaxf(fabsf(o0 - m0), fabsf(o1 - m1)), mx = fmaxf(fabsf(o0), fabsf(o1));
        err = fmaxf(err, wave_max(df, lane) / (wave_max(mx, lane) + 1e-20f));
    }
    if (lane == 0) atomicMax((unsigned*)(ws + WS_CTL) + CW_CHK, __float_as_uint(err));
#undef ARGF
}
#endif
struct Args { const float* in[29]; float* out; unsigned char* ws; int ph_lo, ph_hi; };
constexpr int PH_PER_LAYER = 10, PH_FINAL = 1 + PH_PER_LAYER * DEPTH, PH_COUNT = PH_FINAL + 1;

template <unsigned MK_EN_T>
__global__ void __launch_bounds__(512, 2) mk_fwd(Args args) {
    extern __shared__ __attribute__((aligned(16))) unsigned char lds_raw[];
    LAS unsigned char* lds = (LAS unsigned char*)lds_raw;
    volatile LAS unsigned* MISC = (volatile LAS unsigned*)(lds + MISC_OFF);
    const int G = gridDim.x; const int bx = blockIdx.x; const int vcu = (G % 8 == 0) ? (bx % 8) * (G / 8) + bx / 8 : bx;
    const int NGW = G * 8;
    unsigned char* ws = args.ws; float* X = args.out; void* args_out_raw = (void*)args.out;
    const int lo = args.ph_lo, hi = args.ph_hi;
    const int wave_s = __builtin_amdgcn_readfirstlane((int)threadIdx.x >> 6);
#define TID() (wave_s * 64 + lane_id())
    { const int tid0 = threadIdx.x;
      for (int u = tid0; u < (LDS_BYTES - CTRL_BASE) / 4; u += 512) ((LAS unsigned*)(lds + CTRL_BASE))[u] = 0u;
      __syncthreads();
      if (tid0 < 29) ((volatile LAS unsigned long long*)(lds + ARGS_OFF))[tid0] = (unsigned long long)args.in[tid0];
      __syncthreads(); }
#define ARGF(i) ((const float*)ld_arg(lds, (i)))
    XcdBarrier bar; bar.bar = (unsigned*)(ws + WS_CTL) + CW_BAR; bar.x = 0; bar.st = nullptr; bar.wave = wave_s;
    if (hi - lo > 1) bar = xcd_barrier_post((unsigned*)(ws + WS_CTL) + CW_BAR, MISC + 8, wave_s);
#if PROBE_TS
    if (bx == 0 && TID() == 0) { ((unsigned long long*)(ws + WS_CTL + 65536))[0] = __builtin_amdgcn_s_memrealtime(); ((unsigned long long*)(ws + WS_CTL + 65536))[121] = ~0ull; }
#endif
#define EN(b) (((MK_EN_T) >> (b)) & 1u)
#define IN(k) (lo <= (k) && (k) < hi)
#if PROBE_TS
#define TS_WORDS ((unsigned long long*)(ws + WS_CTL + 65536))
#define PHASE_END(k) do { if (hi > (k) + 1) xcd_barrier(bar); if (bx == 0 && TID() == 0) TS_WORDS[(k) + 1] = __builtin_amdgcn_s_memrealtime(); } while (0)
#else
#define PHASE_END(k) do { if (hi > (k) + 1) xcd_barrier(bar); } while (0)
#endif
#define PH_IDS int tid = TID(); asm volatile("" : "+v"(tid)); const int lane = tid & 63; const int wave = wave_s; int gw = vcu * 8 + wave; asm volatile("" : "+s"(gw)); (void)lane; (void)gw;
#define XB_    ((bf16*)args_out_raw)
#define XCB_   ((bf16*)(ws + WS_XC))
#define XF_    ((float*)(ws + WS_BIG + 32 * MiB))
#define MODV_  ((float*)(ws + WS_MODV))
#define TABM_  ((float*)(ws + WS_TABM))
#define TABR_  ((float*)(ws + WS_TABR))
#define SSQ_   ((float*)(ws + WS_SSQ))
#define KR_    ((bf16*)(ws + WS_KR))
#define H_     ((bf16*)(ws + WS_H))
#define WMIX_(ll) ((bf16*)(ws + (((ll) & 1) ? WS_WB : WS_WA)))
#define WFFN_(ll) ((bf16*)(ws + (((ll) & 1) ? WS_WB + 82 * MiB : WS_WA + 22 * MiB)))
#define W1T_   WMIX_(l)
#define WUQT_  (W1T_ + (size_t)N1 * D)
#define WUKVT_ (WUQT_ + (size_t)3072 * 512)
#define WOTM_  (WUKVT_ + (size_t)4096 * 512)
#define WQKVT_ WMIX_(l)
#define WGT_   (WQKVT_ + (size_t)8192 * D)
#define WOTR_  (WGT_ + (size_t)8192 * D)
#define WGUT_  WFFN_(l)
#define WDT_   (WGUT_ + (size_t)11264 * D)
#define QKVL_  ((bf16*)(ws + WS_QKVL))
#define Q_     ((bf16*)(ws + WS_Q))
#define KV_    ((bf16*)(ws + WS_KV))
#define O_     ((bf16*)(ws + WS_O))
#define QKV_   ((bf16*)(ws + WS_QKV))
#define Y_     ((bf16*)(ws + WS_Y))
#define GATED_ ((bf16*)(ws + WS_GATED))
#define GB_    ((bf16*)(ws + WS_G))
#define UB_    ((bf16*)(ws + WS_U))
#define HALO_  ((float*)(ws + WS_G))
#define MODL_  (MODV_ + (size_t)l * 9 * NMOD)

    if (EN(0) && IN(0)) for (int rep_ = 0; rep_ < 1 + (int)((PROBE_MASK >> 0) & 1u); ++rep_) {
        PH_IDS
        mod_layers(lds, ws, 0, 1, bx, G, tid, lane, wave);
        __syncthreads();
        cvt_layer(lds, ws, 0, gw, NGW, wave, lane, 2);
        for (int i = bx * 512 + tid; i < 64 * 16 + SEQ * 128; i += G * 512) {
            float inv, pos; float* dst;
            if (i < 1024) { const int p = i >> 4, f = i & 15; inv = __builtin_amdgcn_exp2f(-(float)(2 * f) * (13.287712379549449f / 32.0f)); pos = (float)p; dst = TABM_ + 2 * i; }
            else { const int j = i - 1024, t = j >> 7, f = j & 127; inv = __builtin_amdgcn_exp2f(-(float)(2 * f) * (13.287712379549449f / 256.0f)); pos = (float)t; dst = TABR_ + 2 * j; }
            const float ang = pos * inv; const double rev = (double)ang * 0.15915494309189535; const float fr = (float)(rev - floor(rev));
            dst[0] = __builtin_amdgcn_cosf(fr); dst[1] = __builtin_amdgcn_sinf(fr);
        }
        PHASE_END(0);
    }

    for (int l = 0; l < DEPTH; ++l) {
        const int P = 1 + PH_PER_LAYER * l; const int li = l >> 1; const bool is_ret = (l & 1) != 0; const bool last = (l == DEPTH - 1);
        const int Mrows = last ? MX : MT;

        if (EN(1) && IN(P + 0)) for (int rep_ = 0; rep_ < 1 + (int)((PROBE_MASK >> 1) & 1u); ++rep_) {
            PH_IDS
            const float* g = ARGF(6) + l * D;
            if (l == 0) norm_phase(ARGF(0), ARGF(2), g, MODL_, 0, H_, MT, gw, NGW, lane);
            else norm_phase_b16(XB_, XCB_, g, MODL_, 0, H_, MT, gw, NGW, lane);
            PHASE_END(P + 0);
        }

        if (!is_ret) {
            if (EN(2) && IN(P + 1)) for (int rep_ = 0; rep_ < 1 + (int)((PROBE_MASK >> 2) & 1u); ++rep_) {
                pg8::Gemm g{H_, W1T_, MT, N1, D, D}; pg8::StaticOrder S; S.init(MT, N1, G, bx); S.tid = TID();
                EpiG1 E{QKVL_, SSQ_, KR_, TABM_};
                pg8::gemm_phase<EpiG1>(lds, g, S, E);
                PHASE_END(P + 1);
            }
            if (EN(3) && IN(P + 2)) for (int rep_ = 0; rep_ < 1 + (int)((PROBE_MASK >> 3) & 1u); ++rep_) {
                { pg8::Gemm g{QKVL_, WUQT_, MT, 3072, QR, N1}; pg8::StaticOrder S; S.init(MT, 3072, G, bx); S.tid = TID(); EpiUq E{Q_, SSQ_, TABM_}; pg8::gemm_phase<EpiUq>(lds, g, S, E); }
                { pg8::Gemm g{QKVL_ + 512, WUKVT_, MT, 4096, KVR, N1}; pg8::StaticOrder S; S.init(MT, 4096, G, bx); S.tid = TID(); EpiUkv E{KV_, SSQ_}; pg8::gemm_phase<EpiUkv>(lds, g, S, E); }
                PHASE_END(P + 2);
            }
            if (EN(4) && IN(P + 3)) for (int rep_ = 0; rep_ < 1 + (int)((PROBE_MASK >> 4) & 1u); ++rep_) {
                const int nun = 2048 + 128;
                for (int ui = vcu; ui < nun; ui += G) {
                    if (ui < 2048) { const int xcd = (ui & 255) >> 5, j = ui & 31, rnd = ui >> 8; const int bh = xcd * 16 + 2 * rnd + (j >> 4), qb = j & 15; const int b = bh >> 4, hd = bh & 15;
                        att::attn_unit(Q_ + (size_t)(b * SEQ + qb * 256) * 3072 + hd * DQ, KV_ + hd * 256, KR_, O_ + (size_t)(b * SEQ + qb * 256) * D + hd * 128, 68, 4, MX + b * CTXL, b * SEQ, (char*)lds_raw, TID()
#if PROBE_TS
                            , bx == 0 ? TS_WORDS : nullptr
#endif
                            );
                    } else { const int bh = ui - 2048, b = bh >> 4, hd = bh & 15;
                        att::attn_unit(Q_ + (size_t)(MX + b * CTXL) * 3072 + hd * DQ, KV_ + hd * 256, KR_, O_ + (size_t)(MX + b * CTXL) * D + hd * 128, 4, 4, MX + b * CTXL, 0, (char*)lds_raw, TID()); }
                }
                PHASE_END(P + 3);
            }
        } else {
            if (EN(5) && IN(P + 1)) for (int rep_ = 0; rep_ < 1 + (int)((PROBE_MASK >> 5) & 1u); ++rep_) {
                pg8::Gemm g{H_, WQKVT_, MT, 8192, D, D}; pg8::StaticOrder S; S.init(MT, 8192, G, bx); S.tid = TID();
                EpiQKV E{QKV_, TABR_};
                pg8::gemm_phase<EpiQKV>(lds, g, S, E);
                PHASE_END(P + 1);
            }
            if (EN(6) && IN(P + 2)) for (int rep_ = 0; rep_ < 1 + (int)((PROBE_MASK >> 6) & 1u); ++rep_) {
                for (int ui = vcu; ui < 256; ui += G) {
                    const int bh = ui >> 2, dir = (ui >> 1) & 1, dvh = ui & 1; const int b = bh >> 3, hd = bh & 7;
                    const float dec = (dir ? ARGF(22) : ARGF(21))[li * RH + hd];
                    const float lg2 = -__expf(dec) * LOG2E;
                    scan::scan_unit(QKV_, Y_ + (size_t)dir * MT * 4096, (float*)(ws + (dir ? WS_PSTB : WS_PSTF)), b, hd, dir, dvh, lg2, last, lds, TID()
#if PROBE_TS
                                    , TS_WORDS
#endif
                                    );
                }
                PHASE_END(P + 2);
            }
            if (EN(8) && IN(P + 4)) for (int rep_ = 0; rep_ < 1 + (int)((PROBE_MASK >> 8) & 1u); ++rep_) {
                pg8::Gemm g{H_, WGT_, Mrows, 8192, D, D}; pg8::StaticOrder S; S.init(Mrows, 8192, G, bx); S.tid = TID();
                EpiGate E{GATED_, Y_, Y_ + (size_t)MT * 4096, (const float*)(ws + WS_PSTF), (const float*)(ws + WS_PSTB)};
                pg8::gemm_phase<EpiGate>(lds, g, S, E);
                PHASE_END(P + 4);
            }
        }
        if (EN(9) && IN(P + 5)) for (int rep_ = 0; rep_ < 1 + (int)((PROBE_MASK >> 9) & 1u); ++rep_) {
#if MLA_CHECK
            if (l == MLA_CHECK_LAYER) { PH_IDS mla_check(lds, ws, li, gw, wave, lane); __syncthreads(); }
#endif
            pg8::Gemm g = is_ret ? pg8::Gemm{GATED_, WOTR_, Mrows, D, 4096, 4096} : pg8::Gemm{O_, WOTM_, Mrows, D, D, D};
            pg8::StaticOrder S; S.init(Mrows, D, G, bx, 4, true); S.tid = TID();
#if PROBE_TS
            S.probe = is_ret ? 2 : 1; S.tsw = TS_WORDS;
#endif
            const void* xsrc = (l == 0) ? (const void*)ARGF(0) : (const void*)XB_; const void* csrc = (l == 0) ? (const void*)ARGF(2) : (const void*)XCB_;
            EpiResid E{xsrc, XB_, csrc, XCB_, MODL_, 2 * D, l == 0, false};
            pg8::gemm_phase<EpiResid>(lds, g, S, E);
            if (l + 1 < DEPTH) {
                PH_IDS
                const int nwg = (Mrows / 256) * (D / 256), rem = nwg % G;
                if (rem == 0) cvt_layer(lds, ws, l + 1, gw, NGW, wave, lane, 0);
                else if (bx >= rem) cvt_layer(lds, ws, l + 1, (bx - rem) * 8 + wave, (G - rem) * 8, wave, lane, 0);
            }
            PHASE_END(P + 5);
        }
        if (EN(10) && IN(P + 6)) for (int rep_ = 0; rep_ < 1 + (int)((PROBE_MASK >> 10) & 1u); ++rep_) {
            PH_IDS
            const float* g = ARGF(7) + l * D;
            norm_phase_b16(XB_, XCB_, g, MODL_, 3, H_, Mrows, gw, NGW, lane);
            PHASE_END(P + 6);
        }
        if (EN(11) && IN(P + 7)) for (int rep_ = 0; rep_ < 1 + (int)((PROBE_MASK >> 11) & 1u); ++rep_) {
            pg8::Gemm g{H_, WGUT_, Mrows, 11264, D, D}; pg8::StaticOrder S; S.init(Mrows, 11264, G, bx); S.tid = TID();
#if PROBE_TS
            S.probe = 4; S.tsw = TS_WORDS;
#endif
            EpiGUConv E{UB_, HALO_, ARGF(25) + (size_t)l * 3 * FF, ARGF(26) + (size_t)l * FF, (LAS float*)(lds + EDGE_OFF)};
            pg8::gemm_phase<EpiGUConv>(lds, g, S, E);
#if PROBE_TS
            if (TID() == 0 && bx == 0) TS_WORDS[140 + l] = __builtin_amdgcn_s_memrealtime();
            if (TID() == 0 && bx == G - 1) TS_WORDS[148 + l] = __builtin_amdgcn_s_memrealtime();
#endif
            PHASE_END(P + 7);
        }
        if (EN(13) && IN(P + 9)) for (int rep_ = 0; rep_ < 1 + (int)((PROBE_MASK >> 13) & 1u); ++rep_) {
            pg8::Gemm g{UB_, WDT_, Mrows, D, FF, FF}; pg8::StaticOrder S; S.init(Mrows, D, G, bx, 4, true); S.tid = TID();
#if PROBE_TS
            S.probe = 3; S.tsw = TS_WORDS;
#endif
            {
                PH_IDS
                const float* cw = ARGF(25) + (size_t)l * 3 * FF; const float* HL = HALO_; bf16* ACT = UB_;
                pg8::Unit uu; int prev_pm = -1;
                for (int i = 0; S.next(i, uu); ++i) { const int pm = uu.pm; if (pm == prev_pm || pm >= MX / 256) { prev_pm = pm; continue; } prev_pm = pm;
                    const bool top = (pm & 15) != 0, bot = ((pm + 1) & 15) != 0;
                    for (int q = tid; q < FF / 4; q += 512) { const int f = q * 4;
                        if (top) { const float* t0 = HL + (size_t)((pm * 2 + 0) * 3) * HALO_STRIDE + f; const float* b1 = HL + (size_t)(((pm - 1) * 2 + 1) * 3) * HALO_STRIDE + f;
                            const f32x4 o = silu4(*(const f32x4*)t0 + *(const f32x4*)(cw + f) * *(const f32x4*)(b1 + HALO_STRIDE)) * *(const f32x4*)(t0 + 2 * HALO_STRIDE);
                            u32x2 w; w.x = cvt_pk_bf16(o[0], o[1]); w.y = cvt_pk_bf16(o[2], o[3]); *(u32x2*)(ACT + (size_t)(pm * 256) * FF + f) = w; }
                        if (bot) { const float* b0 = HL + (size_t)((pm * 2 + 1) * 3) * HALO_STRIDE + f; const float* t1 = HL + (size_t)(((pm + 1) * 2 + 0) * 3) * HALO_STRIDE + f;
                            const f32x4 o = silu4(*(const f32x4*)b0 + *(const f32x4*)(cw + 2 * FF + f) * *(const f32x4*)(t1 + HALO_STRIDE)) * *(const f32x4*)(b0 + 2 * HALO_STRIDE);
                            u32x2 w; w.x = cvt_pk_bf16(o[0], o[1]); w.y = cvt_pk_bf16(o[2], o[3]); *(u32x2*)(ACT + (size_t)(pm * 256 + 255) * FF + f) = w; } } }
                asm volatile("s_waitcnt vmcnt(0)" ::: "memory"); __syncthreads();
            }
            EpiResid E{XB_, last ? (void*)XF_ : (void*)XB_, XCB_, XCB_, MODL_, 5 * D, false, last};
            pg8::gemm_phase<EpiResid>(lds, g, S, E);
#if PROBE_TS
            if (TID() == 0 && bx == 0) TS_WORDS[64 + l] = __builtin_amdgcn_s_memrealtime();
            if (TID() == 0 && bx == G - 1) TS_WORDS[72 + l] = __builtin_amdgcn_s_memrealtime();
#endif
            if (l + 1 < DEPTH) {
                PH_IDS
                const int nwg = (Mrows / 256) * (D / 256), rem = nwg % G;
                if (rem == 0) { mod_layers(lds, ws, l + 1, l + 2, bx, G, tid, lane, wave); __syncthreads(); cvt_layer(lds, ws, l + 1, gw, NGW, wave, lane, 1); }
                else if (bx >= rem) { mod_layers(lds, ws, l + 1, l + 2, bx - rem, G - rem, tid, lane, wave); __syncthreads(); cvt_layer(lds, ws, l + 1, (bx - rem) * 8 + wave, (G - rem) * 8, wave, lane, 1); }
            }
#if PROBE_TS
            __syncthreads(); if (TID() == 0 && bx == G - 1) TS_WORDS[80 + l] = __builtin_amdgcn_s_memrealtime();
#endif
            PHASE_END(P + 9);
        }
    }
    if (EN(14) && IN(PH_FINAL)) for (int rep_ = 0; rep_ < 1 + (int)((PROBE_MASK >> 14) & 1u); ++rep_) {
        PH_IDS
        const float* g = ARGF(28);
#if PROBE_TS
        float ts_c = 0.f, ts_a = 0.f;
        { const unsigned long long* TS = (const unsigned long long*)(ws + WS_CTL + 65536); unsigned long long last = TS[0]; const unsigned long long t0 = last; float d1 = 0.f, d2 = 0.f;
          for (int k = 0; k < PH_FINAL; ++k) { const unsigned long long te = TS[k + 1]; if (te == 0ull) continue; const float d = (float)(te - last); last = te;
              int cls; if (k == 0) cls = 0; else { const int slot = (k - 1) % PH_PER_LAYER, ll = (k - 1) / PH_PER_LAYER; const bool ret = (ll & 1) != 0;
                  cls = slot == 0 ? 1 : slot >= 5 ? 5 + slot : (!ret ? 1 + slot : 4 + slot); }
              if (k > 0 && ((k - 1) % PH_PER_LAYER) == 5) { const bool ret5 = (((k - 1) / PH_PER_LAYER) & 1) != 0; if (TS_CLASS1 == (ret5 ? 51 : 50)) d1 += d; if (TS_CLASS2 == (ret5 ? 51 : 50)) d2 += d; }
              if (cls == TS_CLASS1) d1 += d; if (cls == TS_CLASS2) d2 += d; }
          float tot = (float)(last - t0);
          if (TS_CLASS1 >= 100) { float ph = 0.f, x0 = 0.f, x1 = 0.f, x2 = 0.f;
              for (int ll = 0; ll < 3; ++ll) { const unsigned long long st = TS[(1 + PH_PER_LAYER * ll + 7) + 1], en = TS[(1 + PH_PER_LAYER * ll + 9) + 1];
                  ph += (float)(en - st); x0 += (float)(TS[64 + ll] - st); x1 += (float)(TS[72 + ll] - st); x2 += (float)(TS[80 + ll] - st); }
              d1 = (TS_CLASS1 == 100) ? x0 : (TS_CLASS1 == 101) ? x1 : x2; d2 = (TS_CLASS2 == 100) ? x0 : (TS_CLASS2 == 101) ? x1 : x2; tot = ph; }
          if (TS_CLASS1 >= 200) { const unsigned long long* tw = TS + 90 + 3 * (TS_CLASS1 - 201); const float lp = (float)tw[0], ep = (float)tw[1], nn = (float)tw[2];
              d1 = lp; tot = lp + ep; d2 = (lp + ep) / nn / 100.f / 200.f * tot; }
          if (TS_CLASS1 == 400) { float ph = 0.f, x0 = 0.f, x1 = 0.f;
              for (int ll = 0; ll < 4; ++ll) { const unsigned long long st = TS[(1 + PH_PER_LAYER * ll + 6) + 1], en = TS[(1 + PH_PER_LAYER * ll + 7) + 1];
                  ph += (float)(en - st); x0 += (float)(TS[140 + ll] - st); x1 += (float)(TS[148 + ll] - st); }
              d1 = x0; d2 = x1; tot = ph; }
          if (TS_CLASS1 == 500) { d1 = (float)TS[160]; d2 = (float)TS[161]; tot = (float)TS[162]; }
          if (TS_CLASS1 == 501) { d1 = (float)TS[162] / (float)TS[163] / 100.f / 5.f; d2 = 0.f; tot = 1.f; }
          if (TS_CLASS1 == 600) { d1 = (float)TS[170]; d2 = (float)TS[171]; tot = (float)TS[172]; }
          if (TS_CLASS1 == 300) { const float mx = (float)TS[120], sm = (float)TS[122]; d1 = sm / (float)(gridDim.x * 4); tot = mx > 0.f ? mx : 1.f; d2 = 0.f; }
          { const float q1 = rintf(d1 / tot * 20.f) / 20.f, q2 = rintf(d2 / tot * 20.f) / 20.f; ts_c = sqrtf(q1); ts_a = 2.0f + 10.0f * q2; }
        }
#endif
#if MLA_CHECK
        const bool chk_bad = __uint_as_float(__hip_atomic_load((unsigned*)(ws + WS_CTL) + CW_CHK, __ATOMIC_RELAXED, __HIP_MEMORY_SCOPE_AGENT)) > MLA_CHECK_TOL;
#endif
        if (gw < MX) {
            f32x4 v[8], vn[8], gg[8]; int m = gw; row_load(XF_ + (size_t)m * D, lane, v);
#pragma unroll
            for (int j = 0; j < 8; ++j) gg[j] = *(const f32x4*)(g + 4 * lane + 256 * j);
            for (;;) {
                const int mn = m + NGW; const bool has = mn < MX;
                if (has) row_load(XF_ + (size_t)mn * D, lane, vn);
                float s = 0.f;
#pragma unroll
                for (int j = 0; j < 8; ++j) s += (v[j][0] * v[j][0] + v[j][1] * v[j][1]) + (v[j][2] * v[j][2] + v[j][3] * v[j][3]);
                const float rstd = 1.0f / sqrtf(wave_sum(s, lane) * (1.0f / D) + NORM_EPS);
                float* xr = X + (size_t)m * D;
#pragma unroll
                for (int j = 0; j < 8; ++j) { const int c = 4 * lane + 256 * j; f32x4 o_ = (v[j] * rstd) * gg[j];
#if MLA_CHECK
                    if (chk_bad) o_ = (f32x4){__builtin_nanf(""), __builtin_nanf(""), __builtin_nanf(""), __builtin_nanf("")};
#endif
#if PROBE_TS
                    if (m < 328) { o_ = o_ + ts_c; if (m == 0 && c == 0) o_[0] += ts_a - ts_c; }
#endif
                    *(f32x4*)(xr + c) = o_; }
                if (!has) break;
#pragma unroll
                for (int j = 0; j < 8; ++j) v[j] = vn[j];
                m = mn;
            }
        }
    }
#undef IN
#undef PHASE_END
}

#if !MK_SINGLE
typedef void (*KernFn)(Args);
static KernFn phase_kernel(int bit) {
    switch (bit) {
        case 0: return mk_fwd<1u << 0>;  case 1: return mk_fwd<1u << 1>;  case 2: return mk_fwd<1u << 2>;  case 3: return mk_fwd<1u << 3>;
        case 4: return mk_fwd<1u << 4>;  case 5: return mk_fwd<1u << 5>;  case 6: return mk_fwd<1u << 6>;  case 7: return mk_fwd<1u << 7>;
        case 8: return mk_fwd<1u << 8>;  case 9: return mk_fwd<1u << 9>;  case 10: return mk_fwd<1u << 10>; case 11: return mk_fwd<1u << 11>;
        case 12: return mk_fwd<1u << 12>; case 13: return mk_fwd<1u << 13>; default: return mk_fwd<1u << 14>;
    }
}
static int phase_bit(int p) {
    if (p == 0) return 0; if (p == PH_FINAL) return 14;
    const int l = (p - 1) / PH_PER_LAYER, slot = (p - 1) % PH_PER_LAYER; const bool ret = (l & 1) != 0;
    if (slot == 0) return 1;
    if (slot >= 5) return 4 + slot;
    if (!ret) return slot == 4 ? -1 : 1 + slot;
    return 4 + slot;
}
#endif
extern "C" void kernel_launch(void* const* d_in, const int* in_sizes, int n_in, void* d_out, int out_size, void* d_ws, size_t ws_size, hipStream_t stream) {
    static int grid = 0;
    if (grid == 0) {
        if (n_in != 29 || out_size != MX * D || ws_size < WS_END) { fprintf(stderr, "kernel_launch: unexpected shapes: n_in %d out %d ws %zu (need %zu)\n", n_in, out_size, ws_size, (size_t)WS_END); grid = -1; return; }
        int dev = 0, cus = 0;
        if (hipGetDevice(&dev) != hipSuccess || hipDeviceGetAttribute(&cus, hipDeviceAttributeMultiprocessorCount, dev) != hipSuccess) { grid = -1; return; }
#if MK_SINGLE
        if (hipFuncSetAttribute((const void*)mk_fwd<0xFFFFFFFFu>, hipFuncAttributeMaxDynamicSharedMemorySize, LDS_BYTES) != hipSuccess) { fprintf(stderr, "kernel_launch: hipFuncSetAttribute failed\n"); grid = -1; return; }
#else
        for (int b = 0; b < 15; ++b) if (hipFuncSetAttribute((const void*)phase_kernel(b), hipFuncAttributeMaxDynamicSharedMemorySize, LDS_BYTES) != hipSuccess) { fprintf(stderr, "kernel_launch: hipFuncSetAttribute failed\n"); grid = -1; return; }
#endif
        (void)hipGetLastError();
        grid = cus;
    }
    if (grid < 0) return;
    if (hipMemsetAsync((char*)d_ws + WS_CTL, 0, CTL_BYTES, stream) != hipSuccess) return;
    Args a{};
    for (int i = 0; i < 29; ++i) a.in[i] = (const float*)d_in[i];
    a.out = (float*)d_out; a.ws = (unsigned char*)d_ws;
#if MK_SINGLE
    a.ph_lo = 0; a.ph_hi = PH_COUNT;
    hipLaunchKernelGGL(mk_fwd<0xFFFFFFFFu>, dim3(grid), dim3(512), LDS_BYTES, stream, a);
#else
    for (int p = 0; p < PH_COUNT; ++p) {
        const int bit = phase_bit(p); if (bit < 0) continue;
        a.ph_lo = p; a.ph_hi = p + 1;
        hipLaunchKernelGGL(phase_kernel(bit), dim3(grid), dim3(512), LDS_BYTES, stream, a);
    }
#endif
    const hipError_t le = hipPeekAtLastError();
    if (le != hipSuccess) fprintf(stderr, "kernel_launch: launch failed: %s\n", hipGetErrorName(le));
}
```

```cpp
#include <hip/hip_runtime.h>
#include <cstdio>
#include <cstdint>

#ifndef MK_SINGLE
#define MK_SINGLE 1
#endif

#ifndef MK_STAGGER
#define MK_STAGGER 0
#endif
#ifndef PROBE_EPI2
#define PROBE_EPI2 0
#endif
#ifndef MLA_CHECK
#define MLA_CHECK 0
#endif
#ifndef MLA_CHECK_LAYER
#define MLA_CHECK_LAYER 0
#endif
#ifndef MLA_CHECK_TOL
#define MLA_CHECK_TOL 0.03f
#endif
#ifndef PROBE_TS
#define PROBE_TS 0
#endif
#ifndef TS_SKEW_ID
#define TS_SKEW_ID 4
#endif
#ifndef TS_CLASS1
#define TS_CLASS1 0
#endif
#ifndef TS_CLASS2
#define TS_CLASS2 1
#endif
#ifndef PROBE_MASK
#define PROBE_MASK 0u
#endif
#define GAS __attribute__((address_space(1)))
#define LAS __attribute__((address_space(3)))
typedef unsigned short bf16;
typedef short bf16x8 __attribute__((ext_vector_type(8)));
typedef short s16x4 __attribute__((ext_vector_type(4)));
typedef float f32x2 __attribute__((ext_vector_type(2)));
typedef float f32x4 __attribute__((ext_vector_type(4)));
typedef float f32x16 __attribute__((ext_vector_type(16)));
typedef unsigned u32x2 __attribute__((ext_vector_type(2)));
typedef unsigned u32x4 __attribute__((ext_vector_type(4)));
typedef GAS unsigned gu32;

constexpr int D = 2048, NB = 8, SEQ = 4096, CTXL = 256, DEPTH = 4;
constexpr int MX = NB * SEQ, MC = NB * CTXL, MT = MX + MC;
constexpr int FF = 5632, NMOD = 6 * D;
constexpr int MLA_H = 16, QR = 512, KVR = 512, NOPE = 128, ROPE = 64, DQ = 192;
constexpr int N1 = 1280;
constexpr int RH = 8, RDK = 256, RDV = 512;
constexpr float NORM_EPS = 1e-6f, GN_EPS = 1e-5f;
constexpr float LOG2E = 1.4426950408889634f;

constexpr size_t MiB = 1u << 20;
constexpr size_t WS_CTL = 0, CTL_BYTES = 1 * MiB;
constexpr size_t WS_MODV = 1 * MiB;
constexpr size_t WS_TABM = 3 * MiB;
constexpr size_t WS_TABR = 4 * MiB;
constexpr size_t WS_SSQ = 8 * MiB;
constexpr size_t WS_XC = 12 * MiB;
constexpr size_t WS_KR = 28 * MiB;
constexpr size_t WS_PSTF = 20 * MiB, WS_PSTB = 33 * MiB;
constexpr size_t WS_WA = 40 * MiB;
constexpr size_t WS_WB = 128 * MiB;
constexpr size_t WS_H = 276 * MiB;
constexpr size_t WS_BIG = 412 * MiB;
constexpr size_t WS_QKVL = WS_BIG, WS_Q = WS_BIG + 88 * MiB, WS_KV = WS_BIG + 292 * MiB, WS_O = WS_BIG + 564 * MiB;
constexpr size_t WS_QKV = WS_BIG, WS_Y = WS_BIG + 544 * MiB, WS_GATED = WS_BIG;
constexpr size_t WS_G = WS_BIG, WS_U = WS_BIG + 374 * MiB;
constexpr size_t WS_END = WS_BIG + 1088 * MiB;
static_assert((size_t)MT * 8192 * 2 <= 544 * MiB && (size_t)MT * 5632 * 2 <= 374 * MiB && (size_t)MT * N1 * 2 <= 88 * MiB, "ws map");

constexpr int CW_BAR = 4096;

constexpr int RING_BYTES = 131072, CTRL_BASE = 155648, MISC_OFF = CTRL_BASE + 320, ARGS_OFF = CTRL_BASE + 1024, EDGE_OFF = CTRL_BASE + 4096, LDS_BYTES = 163840;

__device__ __forceinline__ unsigned cvt_pk_bf16(float lo, float hi) { unsigned r; asm volatile("v_cvt_pk_bf16_f32 %0, %1, %2" : "=v"(r) : "v"(lo), "v"(hi)); return r; }
__device__ __forceinline__ float bf2f(unsigned short b) { return __uint_as_float((unsigned)b << 16); }
__device__ __forceinline__ float bflo(unsigned w) { return __uint_as_float(w << 16); }
__device__ __forceinline__ float bfhi(unsigned w) { return __uint_as_float(w & 0xffff0000u); }
__device__ __forceinline__ float shfl_xor_l(float v, int mask, int lane) { return __builtin_bit_cast(float, __builtin_amdgcn_ds_bpermute((lane ^ mask) << 2, __builtin_bit_cast(int, v))); }
__device__ __forceinline__ float fast_silu(float x) { return x * __builtin_amdgcn_rcpf(1.0f + __builtin_amdgcn_exp2f(-x * LOG2E)); }

__device__ __forceinline__ int lane_id() { int x; asm volatile("v_mbcnt_lo_u32_b32 %0, -1, 0\n\tv_mbcnt_hi_u32_b32 %0, -1, %0" : "=v"(x)); return x; }
__device__ __forceinline__ void glds16_s(const void* sbase, unsigned voff, unsigned lds_dst) {
    unsigned keep;
    asm volatile("s_mov_b32 %0, m0\n\ts_mov_b32 m0, %3\n\ts_nop 0\n\tglobal_load_lds_dwordx4 %1, %2\n\ts_mov_b32 m0, %0" : "=&s"(keep) : "v"(voff), "s"(sbase), "s"(lds_dst) : "memory");
}
__device__ __forceinline__ const char* uni_ptr(const void* p) {
    const unsigned long long v = (unsigned long long)p; const unsigned lo = __builtin_amdgcn_readfirstlane((unsigned)v), hi = __builtin_amdgcn_readfirstlane((unsigned)(v >> 32));
    return (const char*)(((unsigned long long)hi << 32) | lo);
}
namespace pg8 {
constexpr int BM = 256, BK = 64, HALF = 128, HTB = HALF * BK * 2, STAGE_BYTES = 8 * HTB, NXCD = 8, WGM = 8;
__host__ __device__ __forceinline__ int lds_byte(int r, int c) { const int st = (r >> 4) * 2 + (c >> 5), rr = r & 15, cc = c & 31, ob = rr * 64 + cc * 2; return st * 1024 + (ob ^ (((ob >> 9) & 1) << 5)); }
__host__ __device__ __forceinline__ void stage_rc(int b, int& R, int& C) { const int st = b / 1024, sb = b % 1024, swz = sb ^ (((sb >> 9) & 1) << 5); R = (st >> 1) * 16 + swz / 64; C = (st & 1) * 32 + (swz % 64) / 2; }
__host__ __device__ __forceinline__ int perm32(int rho) { const int n = rho >> 4, i = rho & 15; return 8 * (i >> 2) + 4 * n + (i & 3); }
struct Unit { int pm, pn; };
struct Gemm { const bf16* A; const bf16* Bt; int M, N, K, lda; };
struct StaticOrder {
    int nM, nN, nwg, G, c, wgm, delay = 0, probe = 0, tid = 0; bool rev; unsigned long long* tsw = nullptr;
    __device__ __forceinline__ void init(int M, int N, int G_, int c_, int wgm_ = WGM, bool rev_ = false) { nM = M / BM; nN = N / BM; nwg = nM * nN; G = G_; c = c_; wgm = wgm_; rev = rev_; }
    __device__ __forceinline__ bool next(int i, Unit& u) const {
        const long L = (long)i * G + c; if (L >= nwg) return false;
        int wgid = (int)L; { const int q = nwg / NXCD, r = nwg % NXCD, xcd = wgid % NXCD, off = wgid / NXCD; wgid = (xcd < r ? xcd * (q + 1) : r * (q + 1) + (xcd - r) * q) + off; }
        const int nig = wgm * nN, gid = wgid / nig, fm = gid * wgm, gsz = (nM - fm) < wgm ? (nM - fm) : wgm;
        u.pm = fm + ((wgid % nig) % gsz); u.pn = (wgid % nig) / gsz; if (rev) u.pm = nM - 1 - u.pm; return true;
    }
};
template <class Epi>
__device__ __forceinline__ void gemm_phase(LAS unsigned char* lds, const Gemm g, const StaticOrder& S, const Epi& E) {
    int tid = S.tid; asm volatile("" : "+v"(tid));
    const int wid = __builtin_amdgcn_readfirstlane(tid >> 6), lane = tid & 63, wr = wid >> 2, wc = wid & 3, fr = lane & 15, fq = lane >> 4;
    const int K = g.K, nt = K / BK;
    unsigned voffA[2], voffB[2];
#pragma unroll
    for (int i = 0; i < 2; ++i) { int R, C; stage_rc(tid * 16 + i * 8192, R, C); const int Rb = Epi::PERM ? ((R & ~31) + perm32(R & 31)) : R;
        voffA[i] = (unsigned)(R * g.lda + C) * 2u; voffB[i] = (unsigned)(Rb * K + C) * 2u; }
    const size_t kstep = (size_t)(BK * 2);
    const size_t hstepA = (size_t)HALF * g.lda * 2, hstepB = (size_t)HALF * K * 2;
    const size_t tstepA = 2 * hstepA, tstepB = 2 * hstepB;
    const unsigned ldsbase = (unsigned)__builtin_amdgcn_readfirstlane((unsigned)(uintptr_t)lds + (unsigned)wid * 1024u);
    const int aoff = lds_byte(wr * 64 + fr, fq * 8), boff = lds_byte(wc * 32 + fr, fq * 8);
#define PG8_SA(b, h) (((b) * 2 + (h)) * HTB)
#define PG8_SB(b, h) ((4 + (b) * 2 + (h)) * HTB)
#define PG8_STAGE(bufoff, gbase, voff) do { const char* _gb = uni_ptr(gbase); _Pragma("unroll") for (int _i = 0; _i < 2; ++_i) \
        glds16_s(_gb, (voff)[_i], ldsbase + (unsigned)((bufoff) + _i * 8192)); } while (0)
#define PG8_LDA(dst, b, h) do { _Pragma("unroll") for (int m = 0; m < 4; ++m) _Pragma("unroll") for (int k = 0; k < 2; ++k) dst[m][k] = *(const LAS bf16x8*)(lds + PG8_SA(b, h) + aoff + m * 2048 + k * 1024); } while (0)
#define PG8_LDB(dst, b, h) do { _Pragma("unroll") for (int n = 0; n < 2; ++n) _Pragma("unroll") for (int k = 0; k < 2; ++k) dst[n][k] = *(const LAS bf16x8*)(lds + PG8_SB(b, h) + boff + n * 2048 + k * 1024); } while (0)
#define PG8_MMA(ai, bj, At, Bt) do { __builtin_amdgcn_s_setprio(1); _Pragma("unroll") for (int m = 0; m < 4; ++m) _Pragma("unroll") for (int n = 0; n < 2; ++n) _Pragma("unroll") for (int k = 0; k < 2; ++k) \
        acc[ai][bj][m][n] = __builtin_amdgcn_mfma_f32_16x16x32_bf16(Bt[n][k], At[m][k], acc[ai][bj][m][n], 0, 0, 0); __builtin_amdgcn_s_setprio(0); } while (0)
#define PG8_WAIT_V(n) asm volatile("s_waitcnt vmcnt(" #n ")" ::: "memory")
#define PG8_WAIT_L(n) asm volatile("s_waitcnt lgkmcnt(" #n ")" ::: "memory")
#define PG8_BAR __builtin_amdgcn_s_barrier()
#define PG8_SCHED __builtin_amdgcn_sched_barrier(0)
    Unit cur, nxt; int ui = 0;
    if (!S.next(0, cur)) return;
    if (S.delay) { const unsigned long long t0 = __builtin_amdgcn_s_memrealtime(); while (__builtin_amdgcn_s_memrealtime() - t0 < (unsigned long long)S.delay) __builtin_amdgcn_s_sleep(8); }
#if MK_STAGGER
    if (S.c & 1) {
        const unsigned long long t0 = __builtin_amdgcn_s_memrealtime(); const unsigned long long dt = (unsigned long long)nt * MK_STAGGER;
        while (__builtin_amdgcn_s_memrealtime() - t0 < dt) __builtin_amdgcn_s_sleep(8);
    }
#endif
    f32x4 acc[2][2][4][2];
#pragma unroll
    for (int a = 0; a < 2; ++a)
#pragma unroll
        for (int b = 0; b < 2; ++b)
#pragma unroll
            for (int m = 0; m < 4; ++m)
#pragma unroll
                for (int n = 0; n < 2; ++n) acc[a][b][m][n] = (f32x4){0.f, 0.f, 0.f, 0.f};
    bf16x8 At[4][2], B0[2][2], B1[2][2];
    const char* cA = (const char*)g.A + (size_t)cur.pm * tstepA; const char* cB = (const char*)g.Bt + (size_t)cur.pn * tstepB;
    PG8_STAGE(PG8_SB(0, 0), cB, voffB); PG8_STAGE(PG8_SB(0, 1), cB + hstepB, voffB); PG8_STAGE(PG8_SA(0, 0), cA, voffA); PG8_STAGE(PG8_SA(0, 1), cA + hstepA, voffA);
    if (wr == 1) PG8_BAR;
    PG8_WAIT_V(2); PG8_BAR;
    PG8_STAGE(PG8_SB(1, 0), cB + kstep, voffB); PG8_STAGE(PG8_SA(1, 0), cA + kstep, voffA); PG8_STAGE(PG8_SB(1, 1), cB + hstepB + kstep, voffB);
    PG8_WAIT_V(6); PG8_BAR;
#if PROBE_TS
    unsigned long long pt_loop = 0, pt_epi = 0, pt_n = 0, pt_t0 = __builtin_amdgcn_s_memrealtime();
#endif
    for (;;) {
        const bool has_next = S.next(ui + 1, nxt);
        const char* nA = has_next ? (const char*)g.A + (size_t)nxt.pm * tstepA : cA; const char* nB = has_next ? (const char*)g.Bt + (size_t)nxt.pn * tstepB : cB;
        for (int t = 0; t < nt; t += 2) {
            const bool last = (t == nt - 2);
            const char* a1 = cA + (size_t)(t + 1) * kstep;
            const char* a2 = last ? nA : cA + (size_t)(t + 2) * kstep; const char* b2 = last ? nB : cB + (size_t)(t + 2) * kstep;
            const char* a3 = a2 + kstep; const char* b3 = b2 + kstep;
            PG8_LDB(B0, 0, 0); PG8_LDB(B1, 0, 1); PG8_SCHED; PG8_LDA(At, 0, 0); PG8_STAGE(PG8_SA(1, 1), a1 + hstepA, voffA);
            PG8_WAIT_V(8); PG8_WAIT_L(0); PG8_BAR; PG8_MMA(0, 0, At, B0); PG8_MMA(0, 1, At, B1); PG8_BAR; PG8_SCHED;
            PG8_LDA(At, 0, 1); PG8_STAGE(PG8_SB(0, 0), b2, voffB); PG8_STAGE(PG8_SB(0, 1), b2 + hstepB, voffB); PG8_STAGE(PG8_SA(0, 0), a2, voffA);
            PG8_WAIT_V(8); PG8_WAIT_L(0); PG8_BAR; PG8_MMA(1, 0, At, B0); PG8_MMA(1, 1, At, B1); PG8_BAR; PG8_SCHED;
            PG8_LDB(B0, 1, 0); PG8_LDB(B1, 1, 1); PG8_SCHED; PG8_LDA(At, 1, 0); PG8_STAGE(PG8_SA(0, 1), a2 + hstepA, voffA);
            PG8_WAIT_V(8); PG8_WAIT_L(0); PG8_BAR; PG8_MMA(0, 0, At, B0); PG8_MMA(0, 1, At, B1); PG8_BAR; PG8_SCHED;
            PG8_LDA(At, 1, 1); PG8_STAGE(PG8_SB(1, 0), b3, voffB); PG8_STAGE(PG8_SB(1, 1), b3 + hstepB, voffB); PG8_STAGE(PG8_SA(1, 0), a3, voffA);
            PG8_WAIT_V(8); PG8_WAIT_L(0); PG8_BAR; PG8_MMA(1, 0, At, B0); PG8_MMA(1, 1, At, B1); PG8_BAR; PG8_SCHED;
        }
        if (wr == 0) PG8_BAR;
#if PROBE_TS
        const unsigned long long pt_t1 = __builtin_amdgcn_s_memrealtime();
#endif
        E(acc, cur, wr, wc, fr, fq);
#if PROBE_TS
        { asm volatile("s_waitcnt vmcnt(0)" ::: "memory"); const unsigned long long pt_t2 = __builtin_amdgcn_s_memrealtime(); pt_loop += pt_t1 - pt_t0; pt_epi += pt_t2 - pt_t1; pt_n += 1; pt_t0 = pt_t2; }
#endif
#if PROBE_EPI2
        if (Epi::PROBE2) E(acc, cur, wr, wc, fr, fq);
#endif
        if (!has_next) break;
#pragma unroll
        for (int a = 0; a < 2; ++a)
#pragma unroll
            for (int b = 0; b < 2; ++b)
#pragma unroll
                for (int m = 0; m < 4; ++m)
#pragma unroll
                    for (int n = 0; n < 2; ++n) acc[a][b][m][n] = (f32x4){0.f, 0.f, 0.f, 0.f};
        cur = nxt; cA = nA; cB = nB; ++ui;
        if (wr == 1) PG8_BAR;
    }
    PG8_WAIT_V(0);
    PG8_BAR;
#if PROBE_TS
    if (S.probe && S.c == 0 && tid == 0) { unsigned long long* tw = S.tsw + 90 + 3 * (S.probe - 1); tw[0] += pt_loop; tw[1] += pt_epi; tw[2] += pt_n; }
    if (S.probe == TS_SKEW_ID && tid == 0) { const unsigned long long dur = pt_loop + pt_epi; atomicMax(S.tsw + 120, dur); atomicMin(S.tsw + 121, dur); atomicAdd(S.tsw + 122, dur); }
#endif
#undef PG8_SA
#undef PG8_SB
#undef PG8_STAGE
#undef PG8_LDA
#undef PG8_LDB
#undef PG8_MMA
#undef PG8_WAIT_V
#undef PG8_WAIT_L
#undef PG8_BAR
#undef PG8_SCHED
}
}
using pg8::Unit;

__device__ __forceinline__ int slack_delay(int nwg, int G, int c, int unit_ticks) {
    const int rem = nwg % G; if (rem == 0 || c < rem) return 0;
    return (int)(((long long)(c - rem) * unit_ticks * 4) / ((long long)(G - rem) * 5));
}
__device__ __forceinline__ u32x4 pack8(const f32x4 a, const f32x4 b) { u32x4 w; w.x = cvt_pk_bf16(a[0], a[1]); w.y = cvt_pk_bf16(a[2], a[3]); w.z = cvt_pk_bf16(b[0], b[1]); w.w = cvt_pk_bf16(b[2], b[3]); return w; }
__device__ __forceinline__ f32x4 rot2(const f32x4 v, const f32x4 cs) { f32x4 o; o[0] = v[0] * cs[0] - v[1] * cs[1]; o[1] = v[1] * cs[0] + v[0] * cs[1]; o[2] = v[2] * cs[2] - v[3] * cs[3]; o[3] = v[3] * cs[2] + v[2] * cs[3]; return o; }

__device__ __forceinline__ f32x4 mla_cs(const float* tabm, int t, int c4) {
    const int p0 = c4 >> 1; const int pos = (p0 < 16) ? (t >> 6) : (t & 63); const int f = p0 & 15;
    return *(const f32x4*)(tabm + ((size_t)pos * 16 + f) * 2);
}

struct EpiG1 {
    static constexpr bool PERM = true, PROBE2 = false;
    bf16* QKVL; float* SSQ; bf16* KR; const float* tabm;
    __device__ __forceinline__ void operator()(const f32x4 (&acc)[2][2][4][2], const Unit& u, int wr, int wc, int fr, int fq) const {
        const int row0 = u.pm * 256 + wr * 64 + fr;
        if (u.pn < 4) {
            const int col0 = u.pn * 256 + wc * 32 + 8 * fq;
#pragma unroll
            for (int ai = 0; ai < 2; ++ai)
#pragma unroll
                for (int m = 0; m < 4; ++m) { const int row = row0 + ai * 128 + m * 16; float ss = 0.f;
#pragma unroll
                    for (int bj = 0; bj < 2; ++bj) { const f32x4 v0 = acc[ai][bj][m][0], v1 = acc[ai][bj][m][1];
                        ss += (v0[0] * v0[0] + v0[1] * v0[1]) + (v0[2] * v0[2] + v0[3] * v0[3]) + (v1[0] * v1[0] + v1[1] * v1[1]) + (v1[2] * v1[2] + v1[3] * v1[3]);
                        *(u32x4*)(QKVL + (size_t)row * N1 + col0 + bj * 128) = pack8(v0, v1); }
                    { const int ln_ = fr + 16 * fq; ss += shfl_xor_l(ss, 16, ln_); ss += shfl_xor_l(ss, 32, ln_); }
                    if (fq == 0) SSQ[(size_t)row * 16 + u.pn * 4 + wc] = ss; asm volatile("" ::: "memory"); }
        } else if (wc < 2) {
            const int c8 = wc * 32 + 8 * fq;
#pragma unroll
            for (int ai = 0; ai < 2; ++ai)
#pragma unroll
                for (int m = 0; m < 4; ++m) { const int row = row0 + ai * 128 + m * 16; f32x4 v0 = acc[ai][0][m][0], v1 = acc[ai][0][m][1];
                    if (row < MX) { const int t = row & (SEQ - 1); v0 = rot2(v0, mla_cs(tabm, t, c8)); v1 = rot2(v1, mla_cs(tabm, t, c8 + 4)); }
                    *(u32x4*)(KR + (size_t)row * 64 + c8) = pack8(v0, v1); asm volatile("" ::: "memory"); }
        }
    }
};
struct EpiUq {
    static constexpr bool PERM = true, PROBE2 = false;
    bf16* Q; const float* SSQ; const float* tabm;
    __device__ __forceinline__ void operator()(const f32x4 (&acc)[2][2][4][2], const Unit& u, int wr, int wc, int fr, int fq) const {
        const int row0 = u.pm * 256 + wr * 64 + fr;
        int col8[2], dd[2];
#pragma unroll
        for (int bj = 0; bj < 2; ++bj) { col8[bj] = u.pn * 256 + bj * 128 + wc * 32 + 8 * fq; dd[bj] = col8[bj] % DQ; }
#pragma unroll
        for (int ai = 0; ai < 2; ++ai)
#pragma unroll
            for (int m = 0; m < 4; ++m) { const int row = row0 + ai * 128 + m * 16;
                const f32x4 s0 = *(const f32x4*)(SSQ + (size_t)row * 16), s1 = *(const f32x4*)(SSQ + (size_t)row * 16 + 4);
                const float ss = ((s0[0] + s0[1]) + (s0[2] + s0[3])) + ((s1[0] + s1[1]) + (s1[2] + s1[3]));
                const float r = 1.0f / sqrtf(ss * (1.0f / QR) + NORM_EPS);
#pragma unroll
                for (int bj = 0; bj < 2; ++bj) { f32x4 v0 = acc[ai][bj][m][0] * r, v1 = acc[ai][bj][m][1] * r;
                    if (dd[bj] >= NOPE && row < MX) { const int t = row & (SEQ - 1), c8 = dd[bj] - NOPE; v0 = rot2(v0, mla_cs(tabm, t, c8)); v1 = rot2(v1, mla_cs(tabm, t, c8 + 4)); }
                    *(u32x4*)(Q + (size_t)row * 3072 + col8[bj]) = pack8(v0, v1); } asm volatile("" ::: "memory"); }
    }
};
struct EpiUkv {
    static constexpr bool PERM = true, PROBE2 = false;
    bf16* KV; const float* SSQ;
    __device__ __forceinline__ void operator()(const f32x4 (&acc)[2][2][4][2], const Unit& u, int wr, int wc, int fr, int fq) const {
        const int row0 = u.pm * 256 + wr * 64 + fr; const int col0 = u.pn * 256 + wc * 32 + 8 * fq;
#pragma unroll
        for (int ai = 0; ai < 2; ++ai)
#pragma unroll
            for (int m = 0; m < 4; ++m) { const int row = row0 + ai * 128 + m * 16;
                const f32x4 s0 = *(const f32x4*)(SSQ + (size_t)row * 16 + 8), s1 = *(const f32x4*)(SSQ + (size_t)row * 16 + 12);
                const float ss = ((s0[0] + s0[1]) + (s0[2] + s0[3])) + ((s1[0] + s1[1]) + (s1[2] + s1[3]));
                const float r = 1.0f / sqrtf(ss * (1.0f / KVR) + NORM_EPS);
#pragma unroll
                for (int bj = 0; bj < 2; ++bj) *(u32x4*)(KV + (size_t)row * 4096 + col0 + bj * 128) = pack8(acc[ai][bj][m][0] * r, acc[ai][bj][m][1] * r); asm volatile("" ::: "memory"); }
    }
};
struct EpiResid {
    static constexpr bool PERM = true, PROBE2 = false;
    const void* xin; void* xout; const void* cin; void* cout; const float* modv; int gofs; bool base_f32, out_f32;
    __device__ __forceinline__ void operator()(const f32x4 (&acc)[2][2][4][2], const Unit& u, int wr, int wc, int fr, int fq) const {
        const bool isx = u.pm < (MX / 256);
        const int rloc = (isx ? u.pm * 256 : (u.pm * 256 - MX)) + wr * 64 + fr;
        const void* base = isx ? xin : cin; void* out = isx ? xout : cout;
        const float* gv = modv + (size_t)(isx ? (u.pm >> 4) : 8) * NMOD + gofs;
        const int col0 = u.pn * 256 + wc * 32 + 8 * fq;
        f32x4 g4[2][2];
#pragma unroll
        for (int bj = 0; bj < 2; ++bj)
#pragma unroll
            for (int n = 0; n < 2; ++n) g4[bj][n] = *(const f32x4*)(gv + col0 + bj * 128 + n * 4);
        if (base_f32) {
            f32x4 pre[3][2][2];
#define RES_LOAD(G_, SLOT_) do { const size_t off_ = (size_t)(rloc + ((G_) >> 2) * 128 + ((G_) & 3) * 16) * D + col0; \
                _Pragma("unroll") for (int bj = 0; bj < 2; ++bj) _Pragma("unroll") for (int n = 0; n < 2; ++n) pre[SLOT_][bj][n] = *(const f32x4*)((const float*)base + off_ + bj * 128 + n * 4); } while (0)
            RES_LOAD(0, 0); RES_LOAD(1, 1); RES_LOAD(2, 2);
#pragma unroll
            for (int g = 0; g < 8; ++g) { const int ai = g >> 2, m = g & 3; const size_t off = (size_t)(rloc + ai * 128 + m * 16) * D + col0;
#pragma unroll
                for (int bj = 0; bj < 2; ++bj) { const f32x4 x0 = pre[g % 3][bj][0] + g4[bj][0] * acc[ai][bj][m][0], x1 = pre[g % 3][bj][1] + g4[bj][1] * acc[ai][bj][m][1];
                    *(u32x4*)((bf16*)out + off + bj * 128) = pack8(x0, x1); }
                asm volatile("" ::: "memory");
                if (g + 3 < 8) RES_LOAD(g + 3, g % 3); }
#undef RES_LOAD
        } else {
            u32x4 pre[3][2];
#define RES_LOAD(G_, SLOT_) do { const size_t off_ = (size_t)(rloc + ((G_) >> 2) * 128 + ((G_) & 3) * 16) * D + col0; \
                _Pragma("unroll") for (int bj = 0; bj < 2; ++bj) pre[SLOT_][bj] = *(const u32x4*)((const bf16*)base + off_ + bj * 128); } while (0)
            RES_LOAD(0, 0); RES_LOAD(1, 1); RES_LOAD(2, 2);
#pragma unroll
            for (int g = 0; g < 8; ++g) { const int ai = g >> 2, m = g & 3; const size_t off = (size_t)(rloc + ai * 128 + m * 16) * D + col0;
#pragma unroll
                for (int bj = 0; bj < 2; ++bj) { const u32x4 pb = pre[g % 3][bj];
                    const f32x4 b0 = {bflo(pb.x), bfhi(pb.x), bflo(pb.y), bfhi(pb.y)}, b1 = {bflo(pb.z), bfhi(pb.z), bflo(pb.w), bfhi(pb.w)};
                    const f32x4 x0 = b0 + g4[bj][0] * acc[ai][bj][m][0], x1 = b1 + g4[bj][1] * acc[ai][bj][m][1];
                    if (out_f32) { *(f32x4*)((float*)out + off + bj * 128) = x0; *(f32x4*)((float*)out + off + bj * 128 + 4) = x1; }
                    else *(u32x4*)((bf16*)out + off + bj * 128) = pack8(x0, x1); }
                asm volatile("" ::: "memory");
                if (g + 3 < 8) RES_LOAD(g + 3, g % 3); }
#undef RES_LOAD
        }
    }
};
template <int CTRL> __device__ __forceinline__ float dpp1(float x) { return __int_as_float(__builtin_amdgcn_update_dpp(0, __float_as_int(x), CTRL, 0xF, 0xF, false)); }
__device__ __forceinline__ f32x4 row_prev(const f32x4 v) { f32x4 o; o.x = dpp1<0x121>(v.x); o.y = dpp1<0x121>(v.y); o.z = dpp1<0x121>(v.z); o.w = dpp1<0x121>(v.w); return o; }
__device__ __forceinline__ f32x4 row_next(const f32x4 v) { f32x4 o; o.x = dpp1<0x12F>(v.x); o.y = dpp1<0x12F>(v.y); o.z = dpp1<0x12F>(v.z); o.w = dpp1<0x12F>(v.w); return o; }
__device__ __forceinline__ f32x4 silu4(const f32x4 v) { f32x4 o;
#pragma unroll
    for (int e = 0; e < 4; ++e) o[e] = fast_silu(v[e]); return o; }
constexpr size_t HALO_STRIDE = (size_t)FF;
struct EpiGUConv {
    static constexpr bool PERM = true, PROBE2 = true;
    bf16* ACT; float* HALO; const float* cw; const float* cb; LAS float* edge;
    __device__ __forceinline__ void operator()(const f32x4 (&acc)[2][2][4][2], const Unit& u, int wr, int wc, int fr, int fq) const {
        const int c8 = wc * 32 + 8 * fq; const int f0 = u.pn * 128 + c8;
#pragma unroll
        for (int ai = 0; ai < 2; ++ai) { const int blk = 2 * ai + wr;
            if (fr == 0)  { *(LAS f32x4*)(edge + (blk * 2 + 0) * 128 + c8) = acc[ai][0][0][0]; *(LAS f32x4*)(edge + (blk * 2 + 0) * 128 + c8 + 4) = acc[ai][0][0][1]; }
            if (fr == 15) { *(LAS f32x4*)(edge + (blk * 2 + 1) * 128 + c8) = acc[ai][0][3][0]; *(LAS f32x4*)(edge + (blk * 2 + 1) * 128 + c8 + 4) = acc[ai][0][3][1]; } }
        asm volatile("s_waitcnt lgkmcnt(0)" ::: "memory"); __builtin_amdgcn_s_barrier(); asm volatile("" ::: "memory");
        f32x4 w0[2], w1[2], w2[2], bb[2];
#pragma unroll
        for (int n = 0; n < 2; ++n) { w0[n] = *(const f32x4*)(cw + f0 + 4 * n); w1[n] = *(const f32x4*)(cw + FF + f0 + 4 * n); w2[n] = *(const f32x4*)(cw + 2 * FF + f0 + 4 * n); bb[n] = *(const f32x4*)(cb + f0 + 4 * n); }
        const f32x4 zero4 = {0.f, 0.f, 0.f, 0.f};
#pragma unroll
        for (int ai = 0; ai < 2; ++ai) { const int blk = 2 * ai + wr;
#pragma unroll
            for (int m = 0; m < 4; ++m) { const int row = u.pm * 256 + ai * 128 + wr * 64 + m * 16 + fr; f32x4 o[2];
#pragma unroll
                for (int n = 0; n < 2; ++n) { const f32x4 cur = acc[ai][0][m][n];
                    f32x4 b, d;
                    if (m > 0) b = row_prev(acc[ai][0][m - 1][n]); else b = (blk > 0) ? *(const LAS f32x4*)(edge + ((blk - 1) * 2 + 1) * 128 + c8 + 4 * n) : zero4;
                    if (m < 3) d = row_next(acc[ai][0][m + 1][n]); else d = (blk < 3) ? *(const LAS f32x4*)(edge + ((blk + 1) * 2 + 0) * 128 + c8 + 4 * n) : zero4;
                    const f32x4 a = row_prev(cur), c = row_next(cur);
                    const f32x4 up = (fr == 0) ? b : a, dn = (fr == 15) ? d : c;
                    const f32x4 cv = w0[n] * up + w1[n] * cur + w2[n] * dn + bb[n]; const f32x4 uu = acc[ai][1][m][n];
                    o[n] = silu4(cv) * uu;
                    if (m == 0 && blk == 0 && fr == 0) { float* hp = HALO + (size_t)((u.pm * 2 + 0) * 3) * HALO_STRIDE + f0 + 4 * n; *(f32x4*)hp = cv; *(f32x4*)(hp + HALO_STRIDE) = cur; *(f32x4*)(hp + 2 * HALO_STRIDE) = uu; }
                    if (m == 3 && blk == 3 && fr == 15) { float* hp = HALO + (size_t)((u.pm * 2 + 1) * 3) * HALO_STRIDE + f0 + 4 * n; *(f32x4*)hp = cv; *(f32x4*)(hp + HALO_STRIDE) = cur; *(f32x4*)(hp + 2 * HALO_STRIDE) = uu; } }
                *(u32x4*)(ACT + (size_t)row * FF + f0) = pack8(o[0], o[1]); asm volatile("" ::: "memory"); } }
        asm volatile("s_waitcnt lgkmcnt(0)" ::: "memory"); __builtin_amdgcn_s_barrier(); asm volatile("" ::: "memory");
    }
};
struct EpiQKV {
    static constexpr bool PERM = true, PROBE2 = false;
    bf16* QKV; const float* tabr;
    __device__ __forceinline__ void operator()(const f32x4 (&acc)[2][2][4][2], const Unit& u, int wr, int wc, int fr, int fq) const {
        const int row0 = u.pm * 256 + wr * 64 + fr; const int col0 = u.pn * 256 + wc * 32 + 8 * fq;
        const bool rope = (u.pn < 16) && (u.pm < MX / 256);
        if (rope) {
            f32x4 pt[2][2][2];
#define ROPE_LOAD(G_, SLOT_) do { const int t_ = (row0 + ((G_) >> 2) * 128 + ((G_) & 3) * 16) & (SEQ - 1); \
                _Pragma("unroll") for (int bj = 0; bj < 2; ++bj) { const float* tp_ = tabr + ((size_t)t_ * 128 + (((col0 + bj * 128) & 255) >> 1)) * 2; pt[SLOT_][bj][0] = *(const f32x4*)tp_; pt[SLOT_][bj][1] = *(const f32x4*)(tp_ + 4); } } while (0)
            ROPE_LOAD(0, 0); ROPE_LOAD(1, 1);
#pragma unroll
            for (int g = 0; g < 8; ++g) { const int ai = g >> 2, m = g & 3; const int row = row0 + ai * 128 + m * 16;
#pragma unroll
                for (int bj = 0; bj < 2; ++bj) { const f32x4 v0 = rot2(acc[ai][bj][m][0], pt[g & 1][bj][0]), v1 = rot2(acc[ai][bj][m][1], pt[g & 1][bj][1]);
                    *(u32x4*)(QKV + (size_t)row * 8192 + col0 + bj * 128) = pack8(v0, v1); }
                asm volatile("" ::: "memory");
                if (g + 2 < 8) ROPE_LOAD(g + 2, g & 1); }
#undef ROPE_LOAD
        } else {
#pragma unroll
            for (int ai = 0; ai < 2; ++ai)
#pragma unroll
                for (int m = 0; m < 4; ++m) { const int row = row0 + ai * 128 + m * 16;
#pragma unroll
                    for (int bj = 0; bj < 2; ++bj) *(u32x4*)(QKV + (size_t)row * 8192 + col0 + bj * 128) = pack8(acc[ai][bj][m][0], acc[ai][bj][m][1]);
                    asm volatile("" ::: "memory"); }
        }
    }
};
struct EpiGate {
    static constexpr bool PERM = true, PROBE2 = false;
    bf16* GATED; const bf16* YF; const bf16* YB; const float* STF; const float* STB;
    __device__ __forceinline__ void operator()(const f32x4 (&acc)[2][2][4][2], const Unit& u, int wr, int wc, int fr, int fq) const {
        const int row0 = u.pm * 256 + wr * 64 + fr; const int f0 = u.pn * 128 + wc * 32 + 8 * fq; const int hd = u.pn >> 2;
        u32x4 pyf[3], pyb[3]; f32x4 ppf[3], ppb[3];
#define GATE_LOAD(G_, SLOT_) do { const int row_ = row0 + ((G_) >> 2) * 128 + ((G_) & 3) * 16; const size_t off_ = (size_t)row_ * 4096 + f0; \
            pyf[SLOT_] = *(const u32x4*)(YF + off_); pyb[SLOT_] = *(const u32x4*)(YB + off_); \
            ppf[SLOT_] = *(const f32x4*)(STF + ((size_t)row_ * 8 + hd) * 4); ppb[SLOT_] = *(const f32x4*)(STB + ((size_t)row_ * 8 + hd) * 4); } while (0)
        GATE_LOAD(0, 0); GATE_LOAD(1, 1); GATE_LOAD(2, 2);
#pragma unroll
        for (int g = 0; g < 8; ++g) { const int ai = g >> 2, m = g & 3; const int row = row0 + ai * 128 + m * 16; const size_t off = (size_t)row * 4096 + f0;
                const u32x4 yf = pyf[g % 3], yb = pyb[g % 3]; const f32x4 pf = ppf[g % 3], pb = ppb[g % 3];
                f32x2 sf, sb;
                sf[0] = (pf[0] + pf[2]) * (1.0f / RDV); sf[1] = __builtin_amdgcn_rsqf(fmaxf((pf[1] + pf[3]) * (1.0f / RDV) - sf[0] * sf[0], 0.f) + GN_EPS);
                sb[0] = (pb[0] + pb[2]) * (1.0f / RDV); sb[1] = __builtin_amdgcn_rsqf(fmaxf((pb[1] + pb[3]) * (1.0f / RDV) - sb[0] * sb[0], 0.f) + GN_EPS);
                const f32x4 a0 = acc[ai][0][m][0], a1 = acc[ai][0][m][1], b0 = acc[ai][1][m][0], b1 = acc[ai][1][m][1];
#define NF(w, hi_) (((hi_ ? bfhi(w) : bflo(w)) - sf[0]) * sf[1])
#define NB(w, hi_) (((hi_ ? bfhi(w) : bflo(w)) - sb[0]) * sb[1])
                f32x4 o0, o1;
                o0[0] = fast_silu(a0[0]) * NF(yf.x, 0) + fast_silu(b0[0]) * NB(yb.x, 0); o0[1] = fast_silu(a0[1]) * NF(yf.x, 1) + fast_silu(b0[1]) * NB(yb.x, 1);
                o0[2] = fast_silu(a0[2]) * NF(yf.y, 0) + fast_silu(b0[2]) * NB(yb.y, 0); o0[3] = fast_silu(a0[3]) * NF(yf.y, 1) + fast_silu(b0[3]) * NB(yb.y, 1);
                o1[0] = fast_silu(a1[0]) * NF(yf.z, 0) + fast_silu(b1[0]) * NB(yb.z, 0); o1[1] = fast_silu(a1[1]) * NF(yf.z, 1) + fast_silu(b1[1]) * NB(yb.z, 1);
                o1[2] = fast_silu(a1[2]) * NF(yf.w, 0) + fast_silu(b1[2]) * NB(yb.w, 0); o1[3] = fast_silu(a1[3]) * NF(yf.w, 1) + fast_silu(b1[3]) * NB(yb.w, 1);
#undef NF
#undef NB
                *(u32x4*)(GATED + off) = pack8(o0, o1); asm volatile("" ::: "memory");
                if (g + 3 < 8) GATE_LOAD(g + 3, g % 3); }
#undef GATE_LOAD
    }
};

namespace att {
constexpr int NW = 8, QBLK = 32, KVBLK = 64;
constexpr int SHM_V = 16384, SHM_KN = 16384, SHM_KR = 8192;
constexpr int OFF_V = 0, OFF_KN = 3 * SHM_V, OFF_KR = OFF_KN + 2 * SHM_KN, OFF_WS = OFF_KR + 2 * SHM_KR, SHM_ATTN = OFF_WS + NW * 64 * 4;
constexpr float THR2 = 11.5f;
#define KSWZ(row, colB) ((row) * 256 + ((colB) ^ (((row) & 7) << 4)))
#define KRSWZ(row, colB) ((row) * 128 + ((colB) ^ ((((row) >> 1) & 7) << 4)))
#define SBAR() __builtin_amdgcn_sched_barrier(0)
__device__ __forceinline__ int crow(int r, int hi) { return (r & 3) + 8 * (r >> 2) + 4 * hi; }
__device__ __forceinline__ void partialSM(f32x16& p0, f32x16& p1, float& m_reg, float& alpha) {
  float pmax = p0[0];
#pragma unroll
  for (int r = 1; r < 16; ++r) pmax = fmaxf(pmax, p0[r]);
#pragma unroll
  for (int r = 0; r < 16; ++r) pmax = fmaxf(pmax, p1[r]);
  { auto rr = __builtin_amdgcn_permlane32_swap(__float_as_uint(pmax), __float_as_uint(pmax), false, false); pmax = fmaxf(__uint_as_float(rr[0]), __uint_as_float(rr[1])); }
  float mn;
  if (__builtin_expect(__all(pmax - m_reg <= THR2), 1)) { mn = m_reg; alpha = 1.f; }
  else { mn = fmaxf(m_reg, pmax); alpha = __builtin_amdgcn_exp2f(m_reg - mn); m_reg = mn; }
#pragma unroll
  for (int r = 0; r < 16; ++r) p0[r] = p0[r] - mn;
#pragma unroll
  for (int r = 0; r < 16; ++r) p1[r] = p1[r] - mn;
#pragma unroll
  for (int r = 0; r < 16; ++r) p0[r] = __builtin_amdgcn_exp2f(p0[r]);
}
__device__ __forceinline__ void finishSM(f32x16& p0, f32x16& p1, float alpha, float& l_reg, bf16x8& pa0, bf16x8& pa1, bf16x8& pa2, bf16x8& pa3) {
#pragma unroll
  for (int r = 0; r < 16; ++r) p1[r] = __builtin_amdgcn_exp2f(p1[r]);
  float ps = 0;
#pragma unroll
  for (int r = 0; r < 16; ++r) ps += p0[r];
#pragma unroll
  for (int r = 0; r < 16; ++r) ps += p1[r];
  { auto rr = __builtin_amdgcn_permlane32_swap(__float_as_uint(ps), __float_as_uint(ps), false, false); ps = __uint_as_float(rr[0]) + __uint_as_float(rr[1]); }
  l_reg = l_reg * alpha + ps;
#define PK4(P, BASE, OUT) do { unsigned a0 = cvt_pk_bf16(P[BASE + 0], P[BASE + 1]), a1 = cvt_pk_bf16(P[BASE + 2], P[BASE + 3]);   \
    unsigned b0 = cvt_pk_bf16(P[BASE + 4], P[BASE + 5]), b1 = cvt_pk_bf16(P[BASE + 6], P[BASE + 7]);                              \
    auto r0 = __builtin_amdgcn_permlane32_swap(a0, b0, false, false); auto r1 = __builtin_amdgcn_permlane32_swap(a1, b1, false, false); \
    u32x4 w = {r0[0], r1[0], r0[1], r1[1]}; OUT = __builtin_bit_cast(bf16x8, w); } while (0)
  PK4(p0, 0, pa0); PK4(p0, 8, pa1); PK4(p1, 0, pa2); PK4(p1, 8, pa3);
#undef PK4
}
__device__ __forceinline__ void qkt(f32x16& p0, f32x16& p1, const char* Kn, const char* Kr, const bf16x8* qr, int r32, int hi) {
  p0 = f32x16{}; p1 = f32x16{};
#pragma unroll
  for (int d0 = 0; d0 < 8; ++d0) { const int cb = (d0 * 16 + hi * 8) * 2;
    const bf16x8 b0 = *reinterpret_cast<const bf16x8*>(Kn + KSWZ(r32, cb));
    const bf16x8 b1 = *reinterpret_cast<const bf16x8*>(Kn + KSWZ(32 + r32, cb));
    p0 = __builtin_amdgcn_mfma_f32_32x32x16_bf16(b0, qr[d0], p0, 0, 0, 0);
    p1 = __builtin_amdgcn_mfma_f32_32x32x16_bf16(b1, qr[d0], p1, 0, 0, 0); }
#pragma unroll
  for (int d0 = 0; d0 < 4; ++d0) { const int cb = (d0 * 16 + hi * 8) * 2;
    const bf16x8 b0 = *reinterpret_cast<const bf16x8*>(Kr + KRSWZ(r32, cb));
    const bf16x8 b1 = *reinterpret_cast<const bf16x8*>(Kr + KRSWZ(32 + r32, cb));
    p0 = __builtin_amdgcn_mfma_f32_32x32x16_bf16(b0, qr[8 + d0], p0, 0, 0, 0);
    p1 = __builtin_amdgcn_mfma_f32_32x32x16_bf16(b1, qr[8 + d0], p1, 0, 0, 0); }
}
__device__ __forceinline__ int v_st(int k, int c) { const int kk = (k & ~0xC) | ((k & 4) << 1) | ((k & 8) >> 1); return ((kk >> 3) * 4 + (c >> 5)) * 512 + ((kk & 7) * 32 + (c & 31)) * 2; }
__device__ __forceinline__ int v_rd_base(int lane) { return ((lane & 3) << 3) | (((lane >> 2) & 3) << 6) | (((lane >> 4) & 1) << 5) | (((lane >> 5) & 1) << 8); }
constexpr int v_rd_off(int d0, int ks, int half) { return d0 * 512 + ks * 4096 + half * 2048; }
template <int OFF> __device__ __forceinline__ s16x4 tr_read(int vb) { s16x4 r; asm volatile("ds_read_b64_tr_b16 %0, %1 offset:%2" : "=&v"(r) : "v"(vb), "i"(OFF) : "memory"); return r; }
template <int D0> __device__ __forceinline__ void pv_one(f32x16& od, int vb, bf16x8 pa0, bf16x8 pa1, bf16x8 pa2, bf16x8 pa3) {
  const s16x4 l0 = tr_read<v_rd_off(D0, 0, 0)>(vb), h0 = tr_read<v_rd_off(D0, 0, 1)>(vb), l1 = tr_read<v_rd_off(D0, 1, 0)>(vb), h1 = tr_read<v_rd_off(D0, 1, 1)>(vb);
  const s16x4 l2 = tr_read<v_rd_off(D0, 2, 0)>(vb), h2 = tr_read<v_rd_off(D0, 2, 1)>(vb), l3 = tr_read<v_rd_off(D0, 3, 0)>(vb), h3 = tr_read<v_rd_off(D0, 3, 1)>(vb);
  asm volatile("s_waitcnt lgkmcnt(0)" ::: "memory"); SBAR();
#define PK(L, H) (bf16x8){L[0], L[1], L[2], L[3], H[0], H[1], H[2], H[3]}
  od = __builtin_amdgcn_mfma_f32_32x32x16_bf16(pa0, PK(l0, h0), od, 0, 0, 0);
  od = __builtin_amdgcn_mfma_f32_32x32x16_bf16(pa1, PK(l1, h1), od, 0, 0, 0);
  od = __builtin_amdgcn_mfma_f32_32x32x16_bf16(pa2, PK(l2, h2), od, 0, 0, 0);
  od = __builtin_amdgcn_mfma_f32_32x32x16_bf16(pa3, PK(l3, h3), od, 0, 0, 0);
#undef PK
}
__device__ __forceinline__ void pv_d0(f32x16* o, int vb, bf16x8 pa0, bf16x8 pa1, bf16x8 pa2, bf16x8 pa3) {
  pv_one<0>(o[0], vb, pa0, pa1, pa2, pa3); pv_one<1>(o[1], vb, pa0, pa1, pa2, pa3); pv_one<2>(o[2], vb, pa0, pa1, pa2, pa3); pv_one<3>(o[3], vb, pa0, pa1, pa2, pa3);
}
__device__ __forceinline__ void attn_unit(const bf16* __restrict__ Qb, const bf16* __restrict__ KVh, const bf16* __restrict__ KRp, bf16* __restrict__ Ob,
                                          int NT, int nc, int cbase, int xbase, char* lds, int tid_in, unsigned long long* ts_words = nullptr) {
  int tid = tid_in; asm volatile("" : "+v"(tid));
  const int wid = __builtin_amdgcn_readfirstlane(tid >> 6), lane = tid & 63, r32 = lane & 31, hi = lane >> 5;
  char* V_lds = lds + OFF_V; char* Kn_lds = lds + OFF_KN; char* Kr_lds = lds + OFF_KR;
  float* ws = (float*)(lds + OFF_WS) + wid * 64; float* li_l = ws; float* al_l = ws + 32;
  float m_reg = -1e30f, l_reg = 0; f32x16 o[4] = {}; bf16x8 qr[12];
  const bf16* Qw = Qb + (long)(wid * QBLK + r32) * 3072 + hi * 8;
#pragma unroll
  for (int d0 = 0; d0 < 12; ++d0) qr[d0] = *reinterpret_cast<const bf16x8*>(Qw + d0 * 16);
  const int vb0 = (int)(uintptr_t)V_lds + v_rd_base(lane);
  unsigned vofK[2], vofV[2], vofR;
#pragma unroll
  for (int i = 0; i < 2; ++i) { const int pc = wid * 2 + i;
      { const int row = pc * 4 + (lane >> 4), ch = (lane & 15) ^ (row & 7); vofK[i] = (unsigned)((row * 4096 + ch * 8) * 2); }
      { const int ob = pc * 1024 + lane * 16, st = ob >> 9, w = ob & 511, kk = (st >> 2) * 8 + (w >> 6); const int k = (kk & ~0xC) | ((kk & 4) << 1) | ((kk & 8) >> 1);
        const int c = (st & 3) * 32 + 8 * ((w & 63) >> 4); vofV[i] = (unsigned)((k * 4096 + 128 + c) * 2); } }
  { const int row = wid * 8 + (lane >> 3), ch = (lane & 7) ^ ((row >> 1) & 7); vofR = (unsigned)((row * 64 + ch * 8) * 2); }
  const unsigned ldsK = (unsigned)__builtin_amdgcn_readfirstlane((unsigned)(uintptr_t)Kn_lds + (unsigned)wid * 2048u);
  const unsigned ldsV = (unsigned)__builtin_amdgcn_readfirstlane((unsigned)(uintptr_t)V_lds + (unsigned)wid * 2048u);
  const unsigned ldsR = (unsigned)__builtin_amdgcn_readfirstlane((unsigned)(uintptr_t)Kr_lds + (unsigned)wid * 1024u);
#define KROW(j) ((j) < nc ? cbase + (j) * KVBLK : xbase + ((j) - nc) * KVBLK)
#define DMA_TILE(j, kslot, vslot) do { const long k0_ = KROW(j); const char* kb_ = uni_ptr(KVh + k0_ * 4096); const char* rb_ = uni_ptr(KRp + k0_ * 64); \
    glds16_s(kb_, vofK[0], ldsK + (kslot) * SHM_KN); glds16_s(kb_, vofK[1], ldsK + (kslot) * SHM_KN + 1024u); \
    glds16_s(rb_, vofR, ldsR + (kslot) * SHM_KR); \
    glds16_s(kb_, vofV[0], ldsV + (vslot) * SHM_V); glds16_s(kb_, vofV[1], ldsV + (vslot) * SHM_V + 1024u); } while (0)
#ifndef ATT_SKEW
#define ATT_SKEW 0
#endif
#if PROBE_TS
#define WAIT_SYNC() do { const unsigned long long w0_ = __builtin_amdgcn_s_memrealtime(); asm volatile("s_waitcnt vmcnt(0)" ::: "memory"); const unsigned long long w1_ = __builtin_amdgcn_s_memrealtime(); __syncthreads(); const unsigned long long w2_ = __builtin_amdgcn_s_memrealtime(); att_w_dma += w1_ - w0_; att_w_bar += w2_ - w1_; } while (0)
#else
#define WAIT_SYNC() do { asm volatile("s_waitcnt vmcnt(0)" ::: "memory"); __syncthreads(); if (ATT_SKEW && wid >= 4) __builtin_amdgcn_s_sleep(ATT_SKEW); } while (0)
#endif
#define RESC(a) do { if (__any((a) < 1.f)) { if (hi == 0) al_l[r32] = (a); asm volatile("s_waitcnt lgkmcnt(0)" ::: "memory"); \
    _Pragma("unroll") for (int d = 0; d < 4; ++d) _Pragma("unroll") for (int r = 0; r < 16; ++r) o[d][r] *= al_l[crow(r, hi)]; } } while (0)
#if PROBE_TS
  unsigned long long att_w_dma = 0, att_w_bar = 0; const unsigned long long att_t0 = __builtin_amdgcn_s_memrealtime();
#endif
  f32x16 pA0, pA1, pB0, pB1; float alA, alB; bf16x8 pa0, pa1, pa2, pa3;
  DMA_TILE(0, 0, 0); DMA_TILE(1, 1, 1); WAIT_SYNC();
  qkt(pA0, pA1, Kn_lds, Kr_lds, qr, r32, hi); partialSM(pA0, pA1, m_reg, alA);
  __syncthreads();
  int vprev = 0, vcur = 1, vnext = 2;
  for (int j = 1; j + 1 < NT; j += 2) {
    DMA_TILE(j + 1, 0, vnext);
    SBAR(); qkt(pB0, pB1, Kn_lds + SHM_KN, Kr_lds + SHM_KR, qr, r32, hi);
    finishSM(pA0, pA1, alA, l_reg, pa0, pa1, pa2, pa3); SBAR();
    pv_d0(o, vb0 + vprev * SHM_V, pa0, pa1, pa2, pa3); partialSM(pB0, pB1, m_reg, alB);
    RESC(alB); WAIT_SYNC();
    { const int t_ = vprev; vprev = vcur; vcur = vnext; vnext = t_; }
    if (j + 2 < NT) DMA_TILE(j + 2, 1, vnext);
    SBAR(); qkt(pA0, pA1, Kn_lds, Kr_lds, qr, r32, hi);
    finishSM(pB0, pB1, alB, l_reg, pa0, pa1, pa2, pa3); SBAR();
    pv_d0(o, vb0 + vprev * SHM_V, pa0, pa1, pa2, pa3); partialSM(pA0, pA1, m_reg, alA);
    RESC(alA); WAIT_SYNC();
    { const int t_ = vprev; vprev = vcur; vcur = vnext; vnext = t_; }
  }
  SBAR(); qkt(pB0, pB1, Kn_lds + SHM_KN, Kr_lds + SHM_KR, qr, r32, hi);
  finishSM(pA0, pA1, alA, l_reg, pa0, pa1, pa2, pa3); SBAR();
  pv_d0(o, vb0 + vprev * SHM_V, pa0, pa1, pa2, pa3); partialSM(pB0, pB1, m_reg, alB);
  RESC(alB);
  finishSM(pB0, pB1, alB, l_reg, pa0, pa1, pa2, pa3); SBAR();
  pv_d0(o, vb0 + vcur * SHM_V, pa0, pa1, pa2, pa3);
  if (hi == 0) li_l[r32] = l_reg; asm volatile("s_waitcnt lgkmcnt(0)" ::: "memory");
  float rli[16];
#pragma unroll
  for (int r = 0; r < 16; ++r) rli[r] = __builtin_amdgcn_rcpf(li_l[crow(r, hi)]);
  bf16* Ow = Ob + (long)(wid * QBLK) * 2048;
#pragma unroll
  for (int r = 0; r < 16; ++r) { const int orow = crow(r, hi);
#pragma unroll
    for (int d0 = 0; d0 < 4; ++d0) Ow[(long)orow * 2048 + d0 * 32 + r32] = (bf16)(cvt_pk_bf16(o[d0][r] * rli[r], 0.f) & 0xffffu); }
  __syncthreads();
#if PROBE_TS
  if (ts_words && tid == 0) { ts_words[160] += att_w_dma; ts_words[161] += att_w_bar; ts_words[162] += __builtin_amdgcn_s_memrealtime() - att_t0; ts_words[163] += (unsigned long long)NT; }
#endif
#undef KROW
#undef DMA_TILE
#undef WAIT_SYNC
#undef RESC
}
#undef SBAR
}

namespace scan {
constexpr int CH = 64;
constexpr int OFF_Q = 0, OFF_K = 32768  , OFF_V = 98304, OFF_P = 131072, OFF_ST = 131072 + 8192  , SHM_SCAN = OFF_ST + 4096;
__device__ __forceinline__ unsigned off_b(unsigned row, unsigned ch) { return 256u * row + 16u * (ch ^ (((row & 3) << 2) | ((row >> 2) & 3))); }
__device__ __forceinline__ unsigned p_off(unsigned i, unsigned chunk) { return 128u * i + 16u * (chunk ^ ((i >> 1) & 7)); }
__device__ __forceinline__ int crow(int r, int hi) { return (r & 3) + 8 * (r >> 2) + 4 * hi; }
__device__ __forceinline__ s16x4 vtr(const LAS char* p) { typedef short v4i16_t __attribute__((ext_vector_type(4))); return __builtin_bit_cast(s16x4, __builtin_amdgcn_ds_read_tr16_b64_v4i16((LAS v4i16_t*)p)); }
__device__ __forceinline__ bf16x8 tr_frag(const LAS char* img, int lane, int c, int ks) {
    const unsigned h = lane >> 5, blk = (lane >> 4) & 1, q = (lane & 15) >> 2, p = lane & 3;
    const unsigned r0 = 16 * ks + 8 * h + q, chn = 4 * c + 2 * blk + (p >> 1);
    const s16x4 lo = vtr(img + off_b(r0, chn) + 8 * (p & 1)), hi = vtr(img + off_b(r0 + 4, chn) + 8 * (p & 1));
    return (bf16x8){lo[0], lo[1], lo[2], lo[3], hi[0], hi[1], hi[2], hi[3]};
}
__device__ __forceinline__ bf16x8 pack_step(const f32x16& x, int s) {
    u32x4 p; p.x = cvt_pk_bf16(x[8 * s + 0], x[8 * s + 1]); p.y = cvt_pk_bf16(x[8 * s + 2], x[8 * s + 3]); p.z = cvt_pk_bf16(x[8 * s + 4], x[8 * s + 5]); p.w = cvt_pk_bf16(x[8 * s + 6], x[8 * s + 7]);
    return __builtin_bit_cast(bf16x8, p);
}
__device__ __forceinline__ void dma_mat(const bf16* src, int ld, LAS unsigned char* dst, int wid, int lane) {
    const char* sb = uni_ptr(src); const unsigned d0 = (unsigned)__builtin_amdgcn_readfirstlane((unsigned)(uintptr_t)dst + (unsigned)wid * 4096u);
#pragma unroll
    for (int k = 0; k < 4; ++k) { const int pc = wid * 4 + k, img = pc >> 4, row = 4 * (pc & 15) + (lane >> 4), pos = lane & 15;
        const int ch = pos ^ (((row & 3) << 2) | ((row >> 2) & 3));
        glds16_s(sb, (unsigned)((row * ld + img * 128 + ch * 8) * 2), d0 + (unsigned)k * 1024u); }
}
__device__ __forceinline__ int scan_rowbase(int n, int b, int dir) { return (n < 4) ? MX + b * CTXL + (dir ? 3 - n : n) * CH : b * SEQ + (dir ? 67 - n : n - 4) * CH; }
__device__ __forceinline__ float uni_f(float x) { return __uint_as_float(__builtin_amdgcn_readfirstlane(__float_as_uint(x))); }
typedef const LAS s16x4* lds_s4p;
__device__ __forceinline__ void scan_unit(const bf16* __restrict__ QKV, bf16* __restrict__ Y, float* __restrict__ PST, int b, int hd, int dir, int dvh, float lg2, bool skip_ctx_y, LAS unsigned char* lds, int tid_in, unsigned long long* lds_ts = nullptr) {
    int tid = tid_in; asm volatile("" : "+v"(tid));
    const int wid = __builtin_amdgcn_readfirstlane(tid >> 6), lane0 = tid & 63;
    const LAS char* QI = (const LAS char*)lds + OFF_Q; const LAS char* VI = (const LAS char*)lds + OFF_V;
    LAS char* PI = (LAS char*)lds + OFF_P;
    f32x16 S[8];
#pragma unroll
    for (int i = 0; i < 8; ++i) S[i] = f32x16{};
    const float lgr = dir ? -lg2 : lg2;
    const float g64 = uni_f(__builtin_amdgcn_exp2f(64.f * lg2));
    const float R1 = uni_f(__builtin_amdgcn_exp2f(lgr)), R8 = uni_f(__builtin_amdgcn_exp2f(8.f * lgr)), R32 = uni_f(__builtin_amdgcn_exp2f(32.f * lgr));
    const float Rm1 = uni_f(__builtin_amdgcn_exp2f(-lgr)), Rm16 = uni_f(__builtin_amdgcn_exp2f(-16.f * lgr));
    const float c0 = uni_f(dir ? g64 : __builtin_amdgcn_exp2f(lg2)), z0 = uni_f(dir ? 1.0f : __builtin_amdgcn_exp2f(63.f * lg2));
    const int qcol = hd * RDK, kcol = 2048 + hd * RDK, vcol = 4096 + hd * RDV + dvh * 256;
    { const bf16* src = QKV + (size_t)scan_rowbase(0, b, dir) * 8192;
      dma_mat(src + qcol, 8192, lds + OFF_Q, wid, lane0); dma_mat(src + kcol, 8192, lds + OFF_K, wid, lane0); dma_mat(src + vcol, 8192, lds + OFF_V, wid, lane0);
      asm volatile("s_waitcnt vmcnt(0)" ::: "memory"); __syncthreads(); }
#if PROBE_TS
    unsigned long long sc_w1 = 0, sc_w2 = 0; const unsigned long long sc_tb = __builtin_amdgcn_s_memrealtime();
#endif
    for (int n = 0; n < 68; ++n) {
        int lane = lane0; asm volatile("" : "+v"(lane));
        const int r = lane & 31, h = lane >> 5, fr = lane & 15, fq = lane >> 4;
        const int rowbase = scan_rowbase(n, b, dir);
        const bool more = n + 1 < 68;
        const bf16* nsrc = QKV + (size_t)scan_rowbase(more ? n + 1 : n, b, dir) * 8192;
        const LAS char* KI = (const LAS char*)lds + OFF_K + (n & 1) * 32768;
        if (more) dma_mat(nsrc + kcol, 8192, lds + OFF_K + ((n + 1) & 1) * 32768, wid, lane);
        const float LR = c0 * __builtin_amdgcn_exp2f((float)r * lgr), LZ = z0 * __builtin_amdgcn_exp2f((float)(-8 * h) * lgr), LP = __builtin_amdgcn_exp2f((float)(fr - 4 * fq) * lgr);
        { const int fH = fr & 3, fL = (fr >> 2) & 3; const int AL = 256 * fr + 16 * (fq ^ fL);
          int AH[4];
#pragma unroll
          for (int k = 0; k < 4; ++k) AH[k] = 64 * (k ^ fH);
#pragma unroll
          for (int tix = 0; tix < 2; ++tix) { const int tt = wid * 2 + tix, jt = tt >> 2, it = tt & 3;
            f32x4 pt = {0.f, 0.f, 0.f, 0.f};
            const bool live = dir ? (jt >= it) : (jt <= it);
            if (live) { const LAS char* ka = KI + 4096 * jt + AL; const LAS char* qa = QI + 4096 * it + AL;
#pragma unroll
                for (int ks = 0; ks < 8; ++ks) { const int o = (ks >> 2) * 16384 + AH[ks & 3];
                    pt = __builtin_amdgcn_mfma_f32_16x16x32_bf16(*(const LAS bf16x8*)(ka + o), *(const LAS bf16x8*)(qa + o), pt, 0, 0, 0); } }
            float we = LP * __builtin_amdgcn_exp2f((float)(16 * (it - jt)) * lgr); float v[4];
            const int mrel = fr - 4 * fq;
#pragma unroll
            for (int e = 0; e < 4; ++e) { float x = live ? pt[e] * we : 0.f; if (jt == it) { const bool keep = dir ? (e >= mrel) : (e <= mrel); x = keep ? x : 0.f; } v[e] = x; we *= Rm1; }
            const int i = it * 16 + fr, j0 = jt * 16 + 4 * fq;
            u32x2 w; w.x = cvt_pk_bf16(v[0], v[1]); w.y = cvt_pk_bf16(v[2], v[3]);
            *(LAS u32x2*)(PI + p_off(i, j0 >> 3) + ((j0 >> 2) & 1) * 8) = w; } }
        f32x16 Yt[2]; Yt[0] = f32x16{}; Yt[1] = f32x16{};
        { const int fH = r & 3, fL = (r >> 2) & 3; int QH[4], QL[4];
#pragma unroll
          for (int k = 0; k < 4; ++k) { QH[k] = 64 * (k ^ fH); QL[k] = 256 * r + 8 * h + 16 * (k ^ fL); }
#pragma unroll
          for (int dkb = 0; dkb < 8; ++dkb)
#pragma unroll
            for (int s = 0; s < 2; ++s) { const bf16x8 bf = pack_step(S[dkb], s);
                const LAS char* rp = QI + (dkb >> 2) * 16384 + QH[dkb & 3];
#pragma unroll
                for (int it = 0; it < 2; ++it) {
                    const u32x2 lo = *(const LAS u32x2*)(rp + it * 8192 + QL[2 * s]), hi2 = *(const LAS u32x2*)(rp + it * 8192 + QL[2 * s + 1]);
                    const u32x4 aw = {lo.x, lo.y, hi2.x, hi2.y};
                    Yt[it] = __builtin_amdgcn_mfma_f32_32x32x16_bf16(bf, __builtin_bit_cast(bf16x8, aw), Yt[it], 0, 0, 0); } } }
        { const float f0 = LR, f1 = LR * R32;
#pragma unroll
          for (int rg = 0; rg < 16; ++rg) { Yt[0][rg] *= f0; Yt[1][rg] *= f1; } }
#if PROBE_TS
        const unsigned long long sc_t0 = __builtin_amdgcn_s_memrealtime();
#endif
        if (more) asm volatile("s_waitcnt vmcnt(4)" ::: "memory"); else asm volatile("s_waitcnt vmcnt(0)" ::: "memory");
        __syncthreads();
#if PROBE_TS
        sc_w1 += __builtin_amdgcn_s_memrealtime() - sc_t0;
#endif
        if (more) dma_mat(nsrc + qcol, 8192, lds + OFF_Q, wid, lane);
#pragma unroll
        for (int i = 0; i < 8; ++i)
#pragma unroll
            for (int rg = 0; rg < 16; ++rg) S[i][rg] *= g64;
        {
          const int blk = (lane >> 4) & 1, q = (lane & 15) >> 2, p = lane & 3; int TB[2], CQ[4];
#pragma unroll
          for (int t = 0; t < 2; ++t) TB[t] = 2048 * h + 256 * q + 1024 * t + 16 * ((2 * blk + (p >> 1)) ^ ((2 * h + t) & 3)) + 8 * (p & 1);
#pragma unroll
          for (int c = 0; c < 4; ++c) CQ[c] = 64 * (c ^ q);
          const LAS char* vb = VI + (wid >> 2) * 16384 + CQ[wid & 3];
          float zk = LZ;
#pragma unroll
          for (int ks = 0; ks < 4; ++ks) {
            const s16x4 vlo = vtr(vb + 4096 * ks + TB[0]), vhi = vtr(vb + 4096 * ks + TB[1]);
            const u32x2 vl = __builtin_bit_cast(u32x2, vlo), vh = __builtin_bit_cast(u32x2, vhi);
            const u32x4 vw = {vl.x, vl.y, vh.x, vh.y}; const bf16x8 vf = __builtin_bit_cast(bf16x8, vw);
#pragma unroll
            for (int it = 0; it < 2; ++it) { const bf16x8 pa = *(const LAS bf16x8*)(PI + p_off(it * 32 + r, 2 * ks + h));
                Yt[it] = __builtin_amdgcn_mfma_f32_32x32x16_bf16(vf, pa, Yt[it], 0, 0, 0); }
            float zj = zk; u32x4 zw;
            { const float a0 = bflo(vw.x) * zj; zj *= Rm1; const float a1 = bfhi(vw.x) * zj; zj *= Rm1; zw.x = cvt_pk_bf16(a0, a1); }
            { const float a0 = bflo(vw.y) * zj; zj *= Rm1; const float a1 = bfhi(vw.y) * zj; zj *= Rm1; zw.y = cvt_pk_bf16(a0, a1); }
            { const float a0 = bflo(vw.z) * zj; zj *= Rm1; const float a1 = bfhi(vw.z) * zj; zj *= Rm1; zw.z = cvt_pk_bf16(a0, a1); }
            { const float a0 = bflo(vw.w) * zj; zj *= Rm1; const float a1 = bfhi(vw.w) * zj; zw.w = cvt_pk_bf16(a0, a1); }
            const bf16x8 vz = __builtin_bit_cast(bf16x8, zw);
            zk *= Rm16;
#pragma unroll
            for (int dkb = 0; dkb < 8; ++dkb) { const LAS char* kb_ = KI + (dkb >> 2) * 16384 + 4096 * ks + CQ[dkb & 3];
                const s16x4 klo = vtr(kb_ + TB[0]), khi = vtr(kb_ + TB[1]);
                const u32x2 kl = __builtin_bit_cast(u32x2, klo), kh = __builtin_bit_cast(u32x2, khi); const u32x4 kw = {kl.x, kl.y, kh.x, kh.y};
                S[dkb] = __builtin_amdgcn_mfma_f32_32x32x16_bf16(__builtin_bit_cast(bf16x8, kw), vz, S[dkb], 0, 0, 0); }
            __builtin_amdgcn_sched_barrier(0);
          } }
        if (!(skip_ctx_y && n < 4)) {
            bf16* Yr = Y + (size_t)rowbase * 4096; const unsigned yo = (unsigned)(r * 4096 + hd * RDV + dvh * 256 + wid * 32 + 8 * h);
#pragma unroll
            for (int it = 0; it < 2; ++it) {
                float s1a = 0.f, s1b = 0.f, s2a = 0.f, s2b = 0.f;
#pragma unroll
                for (int rg = 0; rg < 16; rg += 2) { s1a += Yt[it][rg]; s1b += Yt[it][rg + 1]; s2a = fmaf(Yt[it][rg], Yt[it][rg], s2a); s2b = fmaf(Yt[it][rg + 1], Yt[it][rg + 1], s2b); }
                float s1 = s1a + s1b, s2 = s2a + s2b;
                { auto rr = __builtin_amdgcn_permlane32_swap(__float_as_uint(s1), __float_as_uint(s1), false, false); s1 = __uint_as_float(rr[0]) + __uint_as_float(rr[1]); }
                { auto rr = __builtin_amdgcn_permlane32_swap(__float_as_uint(s2), __float_as_uint(s2), false, false); s2 = __uint_as_float(rr[0]) + __uint_as_float(rr[1]); }
                if (h == 0) *(LAS f32x2*)((LAS char*)lds + OFF_ST + ((it * 32 + r) * 8 + wid) * 8) = (f32x2){s1, s2};
#pragma unroll
                for (int g = 0; g < 4; g += 2) {
                    unsigned ax = cvt_pk_bf16(Yt[it][4 * g + 0], Yt[it][4 * g + 1]), ay = cvt_pk_bf16(Yt[it][4 * g + 2], Yt[it][4 * g + 3]);
                    unsigned bx_ = cvt_pk_bf16(Yt[it][4 * g + 4], Yt[it][4 * g + 5]), by = cvt_pk_bf16(Yt[it][4 * g + 6], Yt[it][4 * g + 7]);
                    { auto r_ = __builtin_amdgcn_permlane32_swap(ax, bx_, false, false); ax = r_[0]; bx_ = r_[1]; }
                    { auto r_ = __builtin_amdgcn_permlane32_swap(ay, by, false, false); ay = r_[0]; by = r_[1]; }
                    *(u32x4*)(Yr + yo + (unsigned)(it * 32 * 4096 + 8 * g)) = (u32x4){ax, ay, bx_, by}; } }
        }
#if PROBE_TS
        const unsigned long long sc_t1 = __builtin_amdgcn_s_memrealtime();
#endif
        asm volatile("s_waitcnt vmcnt(0)" ::: "memory");
        __syncthreads();
#if PROBE_TS
        sc_w2 += __builtin_amdgcn_s_memrealtime() - sc_t1;
#endif
        if (more) dma_mat(nsrc + vcol, 8192, lds + OFF_V, wid, lane);
        if (wid == 0 && !(skip_ctx_y && n < 4)) {
            const LAS f32x4* sp = (const LAS f32x4*)((const LAS char*)lds + OFF_ST + lane * 64);
            const f32x4 a = sp[0], b_ = sp[1], c = sp[2], d = sp[3];
            const float S1 = ((a[0] + a[2]) + (b_[0] + b_[2])) + ((c[0] + c[2]) + (d[0] + d[2])), S2 = ((a[1] + a[3]) + (b_[1] + b_[3])) + ((c[1] + c[3]) + (d[1] + d[3]));
            *(f32x2*)(PST + ((size_t)(rowbase + lane) * 8 + hd) * 4 + dvh * 2) = (f32x2){S1, S2};
        }
    }
    asm volatile("s_waitcnt vmcnt(0)" ::: "memory"); __syncthreads();
#if PROBE_TS
    if (blockIdx.x == 0 && tid == 0) { unsigned long long* tw = (unsigned long long*)(lds_ts); tw[170] += sc_w1; tw[171] += sc_w2; tw[172] += __builtin_amdgcn_s_memrealtime() - sc_tb; }
#endif
}
}

#define XB_TMO      128
#define XB_XCNT(j)  (256  + 64 * (j))
#define XB_XSUB(j)  (1280 + 64 * (j))
#define XB_XGEN(j)  (2304 + 64 * (j))
#define XB_TOP      3328
#define XB_TOPGEN   3392
#define XCD_BAR_WORDS 3456
#define XB_SPIN_CAP (1u << 22)
__device__ __forceinline__ unsigned xb_ld(unsigned* p)              { return __hip_atomic_load(p, __ATOMIC_RELAXED, __HIP_MEMORY_SCOPE_AGENT); }
__device__ __forceinline__ unsigned xb_add(unsigned* p, unsigned v) { return __hip_atomic_fetch_add(p, v, __ATOMIC_RELAXED, __HIP_MEMORY_SCOPE_AGENT); }
__device__ __forceinline__ unsigned xb_xcc_id() { return (unsigned)__builtin_amdgcn_s_getreg((3 << 11) | 20) & 0xFu; }
#define XB_SPIN(cond, bar) do { unsigned _sp = 0; while (cond) { __builtin_amdgcn_s_sleep(1); \
    if ((++_sp & 255u) == 0u) { if (xb_ld(&(bar)[XB_TMO])) break; if (_sp > XB_SPIN_CAP) { atomicAdd(&(bar)[XB_TMO], 1u); break; } } } } while (0)
struct XcdBarrier { unsigned* bar; unsigned x; volatile LAS unsigned* st; int wave; };
__device__ __forceinline__ XcdBarrier xcd_barrier_post(unsigned* bar, volatile LAS unsigned* st, int wave) {
    XcdBarrier b; b.bar = bar; b.x = xb_xcc_id(); b.st = st; b.wave = wave;
    if (wave == 0 && lane_id() == 0) (void)xb_add(&bar[XB_XCNT(b.x)], 1u);
    return b;
}
__device__ __forceinline__ void xcd_barrier_complete(unsigned* bar, unsigned x, unsigned& nloc, unsigned& nx) {
    const unsigned G = gridDim.x * gridDim.y * gridDim.z;
    unsigned sum, cnt, mine, sp = 0u;
    for (;;) {
        sum = 0u; cnt = 0u; mine = 0u;
#pragma unroll
        for (unsigned j = 0; j < 16; ++j) { const unsigned c = xb_ld(&bar[XB_XCNT(j)]); sum += c; cnt += (c > 0u) ? 1u : 0u; mine = (j == x) ? c : mine; }
        if (sum == G) break;
        __builtin_amdgcn_s_sleep(1);
        if ((++sp & 255u) == 0u) { if (xb_ld(&bar[XB_TMO])) break; if (sp > XB_SPIN_CAP) { atomicAdd(&bar[XB_TMO], 1u); break; } }
    }
    nloc = mine > 0u ? mine : 1u; nx = cnt > 0u ? cnt : 1u;
}
__device__ __forceinline__ void xcd_barrier(const XcdBarrier& b) {
    asm volatile("s_waitcnt vmcnt(0)" ::: "memory");
    __syncthreads();
    if (b.wave == 0 && lane_id() == 0) {
        unsigned* bar = b.bar; asm volatile("" : "+s"(bar));
        __builtin_amdgcn_s_waitcnt(0);
        unsigned nloc = b.st[0], nx = b.st[1];
        if (nloc == 0u) { xcd_barrier_complete(bar, b.x, nloc, nx); b.st[0] = nloc; b.st[1] = nx; }
        const unsigned old = xb_add(&bar[XB_XSUB(b.x)], 1u);
        const unsigned gen = old / nloc;
        if (old + 1u == (gen + 1u) * nloc) {
            __builtin_amdgcn_fence(__ATOMIC_RELEASE, "agent");
            asm volatile("s_waitcnt vmcnt(0)" ::: "memory");
            const unsigned og = xb_add(&bar[XB_TOP], 1u);
            const unsigned tg = og / nx;
            if (og + 1u == (tg + 1u) * nx) xb_add(&bar[XB_TOPGEN], 1u);
            else XB_SPIN(xb_ld(&bar[XB_TOPGEN]) == tg, bar);
            __builtin_amdgcn_fence(__ATOMIC_ACQUIRE, "agent");
            xb_add(&bar[XB_XGEN(b.x)], 1u);
            asm volatile("s_waitcnt vmcnt(0)" ::: "memory");
        } else {
            XB_SPIN(xb_ld(&bar[XB_XGEN(b.x)]) == gen, bar);
            __builtin_amdgcn_fence(__ATOMIC_ACQUIRE, "agent");
            asm volatile("s_waitcnt vmcnt(0)" ::: "memory");
        }
    }
    __syncthreads();
}

__device__ __forceinline__ float wave_sum(float v, int lane) {
#pragma unroll
    for (int o = 1; o < 64; o <<= 1) v += shfl_xor_l(v, o, lane);
    return v;
}
struct CvtDesc { const float* src; const float* kscale; bf16* WTrow0; int ldw, k0, K, jkind; float gscale; };
__device__ __forceinline__ int ropeperm64(int c) { const int p = c >> 1, e = c & 1; return (p < 16) ? (p + 16 * e) : (32 + (p - 16) + 16 * e); }
__device__ __forceinline__ int ropeinv64(int s_) { const int half = s_ >> 5, w = s_ & 31; return 2 * (half * 16 + (w & 15)) + (w >> 4); }
__device__ __forceinline__ void cvt_load(const CvtDesc& d, int lane, f32x4 (&v)[16]) {
#pragma unroll
    for (int i = 0; i < 16; ++i) { const int kk = 4 * i + (lane >> 4);
        f32x4 x = d.src ? *(const f32x4*)(d.src + (size_t)(d.k0 + kk) * d.ldw) : (f32x4){0.f, 0.f, 0.f, 0.f};
        float sc_ = d.gscale; if (d.kscale) sc_ *= d.kscale[d.k0 + kk];
        v[i] = x * sc_; }
}
__device__ __forceinline__ void cvt_store(const CvtDesc& d, int lane, const f32x4 (&v)[16], LAS float* scr) {
    const int n4 = lane & 15; int jr[4];
#pragma unroll
    for (int e = 0; e < 4; ++e) { const int s_ = 4 * n4 + e; jr[e] = d.jkind == 0 ? s_ : d.jkind == 1 ? ropeinv64(s_) : 2 * (4 * (n4 & 7) + e) + (n4 >> 3); }
#pragma unroll
    for (int i = 0; i < 16; ++i) { const int kk = 4 * i + (lane >> 4);
#pragma unroll
        for (int e = 0; e < 4; ++e) scr[kk * 65 + jr[e]] = v[i][e]; }
    asm volatile("s_waitcnt lgkmcnt(0)" ::: "memory");
    const int c = lane & 7;
#pragma unroll
    for (int ps = 0; ps < 8; ++ps) { const int j = 8 * ps + (lane >> 3); const LAS float* s = scr + (8 * c) * 65 + j;
        u32x4 o; o.x = cvt_pk_bf16(s[0 * 65], s[1 * 65]); o.y = cvt_pk_bf16(s[2 * 65], s[3 * 65]); o.z = cvt_pk_bf16(s[4 * 65], s[5 * 65]); o.w = cvt_pk_bf16(s[6 * 65], s[7 * 65]);
        *(u32x4*)(d.WTrow0 + (size_t)j * d.K + d.k0 + 8 * c) = o; }
    asm volatile("s_waitcnt lgkmcnt(0)" ::: "memory");
}
struct CvtJob { const float* W0; const float* W1; const float* kscale; bf16* WT; int ldw, K, nrows, kind, aux; float gscale; };
__device__ __forceinline__ bool cvt_try(const CvtJob& J, int& it, int lane, CvtDesc& d) {
    const int nblk = J.nrows / 64, items = (J.K / 64) * nblk;
    if (it >= items) { it -= items; return false; }
    const int kb = it / nblk, nb = it % nblk; const int n4 = lane & 15;
    const float* sp; int jk = 0;
    switch (J.kind) {
        case 0: sp = J.W0 + J.aux + nb * 64 + 4 * n4; break;
        case 1: sp = J.W0 + J.aux + 4 * n4; jk = 1; break;
        case 2: { const int hh = nb / 3, part = nb % 3; sp = J.W0 + hh * DQ + 64 * part + 4 * n4; jk = (part == 2) ? 1 : 0; } break;
        case 3: { const int hh = nb >> 2, q4 = nb & 3; sp = J.W0 + hh * 256 + 32 * q4 + 128 * (n4 >> 3) + 4 * (n4 & 7); jk = 2; } break;
        case 4: { const int tl = nb >> 2, hf = (nb >> 1) & 1, q2 = nb & 1; const long long dW = (const char*)J.W1 - (const char*)J.W0; sp = (const float*)((const char*)J.W0 + dW * hf) + tl * 128 + 64 * q2 + 4 * n4; } break;
        default: sp = nullptr; break;
    }
    d.src = sp; d.kscale = J.kscale; d.WTrow0 = J.WT + (size_t)(nb * 64) * J.K; d.ldw = J.ldw; d.k0 = kb * 64; d.K = J.K; d.jkind = jk; d.gscale = J.gscale;
    return true;
}
__device__ __forceinline__ int cvt_items(const CvtJob& J) { return (J.K / 64) * (J.nrows / 64); }

__device__ __forceinline__ void row_load(const float* xrow, int lane, f32x4 (&v)[8]) {
#pragma unroll
    for (int j = 0; j < 8; ++j) v[j] = *(const f32x4*)(xrow + 4 * lane + 256 * j);
}
__device__ __forceinline__ void norm_row_f32(const f32x4 (&v)[8], const f32x4 (&A)[8], const f32x4 (&Bc)[8], bf16* orow, int lane) {
    float s = 0.f;
#pragma unroll
    for (int j = 0; j < 8; ++j) s += (v[j][0] * v[j][0] + v[j][1] * v[j][1]) + (v[j][2] * v[j][2] + v[j][3] * v[j][3]);
    const float rstd = 1.0f / sqrtf(wave_sum(s, lane) * (1.0f / D) + NORM_EPS);
#pragma unroll
    for (int j = 0; j < 8; ++j) { const f32x4 y = (v[j] * rstd) * A[j] + Bc[j];
        u32x2 w; w.x = cvt_pk_bf16(y[0], y[1]); w.y = cvt_pk_bf16(y[2], y[3]); *(u32x2*)(orow + 4 * lane + 256 * j) = w; }
}
__device__ __forceinline__ void norm_coef_f32(const float* g, const float* mr, int lane, f32x4 (&A)[8], f32x4 (&Bc)[8]) {
#pragma unroll
    for (int j = 0; j < 8; ++j) { const int c = 4 * lane + 256 * j; A[j] = *(const f32x4*)(g + c) * (1.0f + *(const f32x4*)(mr + D + c)); Bc[j] = *(const f32x4*)(mr + c); }
}
__device__ __forceinline__ void norm_phase(const float* xsrc, const float* csrc, const float* g, const float* modl, int chunk, bf16* H, int nrows, int gw, int NGW, int lane) {
    const int G8 = NGW >> 3, b = gw / G8, idx = gw - b * G8;
    f32x4 A[8], Bc[8];
    if (idx < SEQ) {
        norm_coef_f32(g, modl + (size_t)b * NMOD + chunk * D, lane, A, Bc);
        f32x4 v[8], vn[8]; int m = b * SEQ + idx; const int mend = (b + 1) * SEQ;
        row_load(xsrc + (size_t)m * D, lane, v);
        for (;;) {
            const int mn = m + G8; const bool has = mn < mend;
            if (has) row_load(xsrc + (size_t)mn * D, lane, vn);
            norm_row_f32(v, A, Bc, H + (size_t)m * D, lane);
            if (!has) break;
#pragma unroll
            for (int j = 0; j < 8; ++j) v[j] = vn[j];
            m = mn;
        }
    }
    if (MX + gw < nrows) {
        norm_coef_f32(g, modl + (size_t)8 * NMOD + chunk * D, lane, A, Bc);
        for (int m = MX + gw; m < nrows; m += NGW) { f32x4 v[8]; row_load(csrc + (size_t)(m - MX) * D, lane, v); norm_row_f32(v, A, Bc, H + (size_t)m * D, lane); }
    }
}

__device__ __forceinline__ void row_load_b16(const bf16* xrow, int lane, u32x4 (&v)[4]) {
#pragma unroll
    for (int j = 0; j < 4; ++j) v[j] = *(const u32x4*)(xrow + 8 * lane + 512 * j);
}
__device__ __forceinline__ void norm_row_b16(const u32x4 (&v)[4], const f32x4 (&A)[8], const f32x4 (&Bc)[8], bf16* orow, int lane) {
    f32x4 xa[4], xb[4]; float ss = 0.f;
#pragma unroll
    for (int j = 0; j < 4; ++j) { xa[j] = (f32x4){bflo(v[j].x), bfhi(v[j].x), bflo(v[j].y), bfhi(v[j].y)}; xb[j] = (f32x4){bflo(v[j].z), bfhi(v[j].z), bflo(v[j].w), bfhi(v[j].w)};
        ss += ((xa[j][0] * xa[j][0] + xa[j][1] * xa[j][1]) + (xa[j][2] * xa[j][2] + xa[j][3] * xa[j][3])) + ((xb[j][0] * xb[j][0] + xb[j][1] * xb[j][1]) + (xb[j][2] * xb[j][2] + xb[j][3] * xb[j][3])); }
    const float rstd = 1.0f / sqrtf(wave_sum(ss, lane) * (1.0f / D) + NORM_EPS);
#pragma unroll
    for (int j = 0; j < 4; ++j) { const f32x4 ya = (xa[j] * rstd) * A[2 * j] + Bc[2 * j], yb = (xb[j] * rstd) * A[2 * j + 1] + Bc[2 * j + 1];
        *(u32x4*)(orow + 8 * lane + 512 * j) = pack8(ya, yb); }
}
__device__ __forceinline__ void norm_coef_b16(const float* g, const float* mr, int lane, f32x4 (&A)[8], f32x4 (&Bc)[8]) {
#pragma unroll
    for (int j = 0; j < 8; ++j) { const int c = 8 * lane + 512 * (j >> 1) + 4 * (j & 1); A[j] = *(const f32x4*)(g + c) * (1.0f + *(const f32x4*)(mr + D + c)); Bc[j] = *(const f32x4*)(mr + c); }
}
__device__ __forceinline__ void norm_phase_b16(const bf16* xsrc, const bf16* csrc, const float* g, const float* modl, int chunk, bf16* H, int nrows, int gw, int NGW, int lane) {
    const int G8 = NGW >> 3, b = gw / G8, idx = gw - b * G8;
    f32x4 A[8], Bc[8];
    if (idx < SEQ) {
        norm_coef_b16(g, modl + (size_t)b * NMOD + chunk * D, lane, A, Bc);
        u32x4 v[4], vn[4]; int m = b * SEQ + idx; const int mend = (b + 1) * SEQ;
        row_load_b16(xsrc + (size_t)m * D, lane, v);
        for (;;) {
            const int mn = m + G8; const bool has = mn < mend;
            if (has) row_load_b16(xsrc + (size_t)mn * D, lane, vn);
            norm_row_b16(v, A, Bc, H + (size_t)m * D, lane);
            if (!has) break;
#pragma unroll
            for (int j = 0; j < 4; ++j) v[j] = vn[j];
            m = mn;
        }
    }
    if (MX + gw < nrows) {
        norm_coef_b16(g, modl + (size_t)8 * NMOD + chunk * D, lane, A, Bc);
        for (int m = MX + gw; m < nrows; m += NGW) { u32x4 v[4]; row_load_b16(csrc + (size_t)(m - MX) * D, lane, v); norm_row_b16(v, A, Bc, H + (size_t)m * D, lane); }
    }
}

__device__ __forceinline__ unsigned long long ld_arg(LAS unsigned char* lds, int i) {
    const volatile LAS unsigned* p = (const volatile LAS unsigned*)(lds + ARGS_OFF) + 2 * i;
    const unsigned lo = __builtin_amdgcn_readfirstlane(p[0]), hi = __builtin_amdgcn_readfirstlane(p[1]);
    return ((unsigned long long)hi << 32) | lo;
}
__device__ __forceinline__ void mod_layers(LAS unsigned char* lds, unsigned char* ws, int l_lo, int l_hi, int wg, int nwg, int tid, int lane, int wave) {
#define ARGF(i) ((const float*)ld_arg(lds, (i)))
    const int nitems = (l_hi - l_lo) * 96;
    if (wg >= nitems) return;
    LAS float* cond = (LAS float*)lds;
    LAS float* red = (LAS float*)(lds + 73728);
    float* MODV = (float*)(ws + WS_MODV);
    { const float* cin = ARGF(1); const float* cc = ARGF(3);
      for (int i = tid; i < 9 * D; i += 512) { const int r = i >> 11, k = i & (D - 1); const float c = (r < 8) ? cin[r * D + k] : cc[k]; cond[i] = c / (1.0f + __expf(-c)); } }
    __syncthreads();
    for (int it = wg; it < nitems; it += nwg) {
        const int l = l_lo + it / 96, cb = it % 96; const int n = cb * 128 + 2 * lane;
        const float* W = ARGF(4) + (size_t)l * D * NMOD + n; const float* mb = ARGF(5) + (size_t)l * NMOD + cb * 128;
        float a0[9], a1[9];
#pragma unroll
        for (int r = 0; r < 9; ++r) { a0[r] = 0.f; a1[r] = 0.f; }
        for (int k = wave * 256; k < wave * 256 + 256; k += 8) {
            f32x2 w[8];
#pragma unroll
            for (int q = 0; q < 8; ++q) w[q] = *(const f32x2*)(W + (size_t)(k + q) * NMOD);
#pragma unroll
            for (int q4 = 0; q4 < 2; ++q4)
#pragma unroll
                for (int r = 0; r < 9; ++r) { const f32x4 c4 = *(const LAS f32x4*)(cond + r * D + k + 4 * q4);
#pragma unroll
                    for (int q = 0; q < 4; ++q) { a0[r] += c4[q] * w[4 * q4 + q][0]; a1[r] += c4[q] * w[4 * q4 + q][1]; } }
        }
#pragma unroll
        for (int r = 0; r < 9; ++r) { red[(wave * 9 + r) * 128 + 2 * lane] = a0[r]; red[(wave * 9 + r) * 128 + 2 * lane + 1] = a1[r]; }
        __syncthreads();
        for (int i = tid; i < 9 * 128; i += 512) { const int r = i >> 7, cc = i & 127; float s2 = 0.f;
#pragma unroll
            for (int w8 = 0; w8 < 8; ++w8) s2 += red[(w8 * 9 + r) * 128 + cc];
            MODV[((size_t)l * 9 + r) * NMOD + cb * 128 + cc] = s2 + mb[cc]; }
        __syncthreads();
    }
#undef ARGF
}
__device__ __forceinline__ void cvt_layer(LAS unsigned char* lds, unsigned char* ws, int lc, int rank, int nranks, int wave, int lane, int part  ) {
#define ARGF(i) ((const float*)ld_arg(lds, (i)))
    const int li = lc >> 1; const bool is_ret = (lc & 1) != 0;
    bf16* WM = (bf16*)(ws + (is_ret ? WS_WB : WS_WA)); bf16* WF = (bf16*)(ws + (is_ret ? WS_WB + 82 * MiB : WS_WA + 22 * MiB));
    LAS float* scr = (LAS float*)(lds + wave * 19456);
    CvtJob J[7]; int nj;
    if (!is_ret) {
        bf16* W1T = WM; bf16* WuqT = W1T + (size_t)N1 * D; bf16* WukvT = WuqT + (size_t)3072 * 512; bf16* WoT = WukvT + (size_t)4096 * 512;
        const float* wdq = ARGF(8) + (size_t)li * D * QR; const float* wdkv = ARGF(11) + (size_t)li * D * (KVR + ROPE);
        J[0] = CvtJob{wdq, nullptr, nullptr, W1T, QR, D, 512, 0, 0, 1.f};
        J[1] = CvtJob{wdkv, nullptr, nullptr, W1T + (size_t)512 * D, KVR + ROPE, D, 512, 0, 0, 1.f};
        J[2] = CvtJob{wdkv, nullptr, nullptr, W1T + (size_t)1024 * D, KVR + ROPE, D, 64, 1, 512, 1.f};
        J[3] = CvtJob{nullptr, nullptr, nullptr, W1T + (size_t)1088 * D, 1, D, 192, 5, 0, 1.f};
        J[4] = CvtJob{ARGF(10) + (size_t)li * QR * 3072, nullptr, ARGF(9) + li * QR, WuqT, 3072, QR, 3072, 2, 0, 0.07216878364870322f * LOG2E};
        J[5] = CvtJob{ARGF(13) + (size_t)li * KVR * 4096, nullptr, ARGF(12) + li * KVR, WukvT, 4096, KVR, 4096, 0, 0, 1.f};
        J[6] = CvtJob{ARGF(14) + (size_t)li * D * D, nullptr, nullptr, WoT, D, D, D, 0, 0, 1.f};
        nj = 7;
    } else {
        bf16* WqkvT = WM; bf16* WgT = WqkvT + (size_t)8192 * D; bf16* WoT = WgT + (size_t)8192 * D;
        J[0] = CvtJob{ARGF(15) + (size_t)li * D * D, nullptr, nullptr, WqkvT, D, D, 2048, 3, 0, 1.f};
        J[1] = CvtJob{ARGF(16) + (size_t)li * D * D, nullptr, nullptr, WqkvT + (size_t)2048 * D, D, D, 2048, 3, 0, 0.0625f};
        J[2] = CvtJob{ARGF(17) + (size_t)li * D * 4096, nullptr, nullptr, WqkvT + (size_t)4096 * D, 4096, D, 4096, 0, 0, 1.f};
        J[3] = CvtJob{ARGF(18) + (size_t)li * D * 4096, ARGF(19) + (size_t)li * D * 4096, nullptr, WgT, 4096, D, 8192, 4, 0, 1.f};
        J[4] = CvtJob{ARGF(20) + (size_t)li * 4096 * D, nullptr, nullptr, WoT, D, 4096, D, 0, 0, 1.f};
        J[5] = CvtJob{nullptr, nullptr, nullptr, nullptr, 1, 64, 0, 5, 0, 1.f};
        J[6] = J[5];
        nj = 5;
    }
    CvtJob F0 = CvtJob{ARGF(23) + (size_t)lc * D * FF, ARGF(24) + (size_t)lc * D * FF, nullptr, WF, FF, D, 11264, 4, 0, 1.f};
    CvtJob F1 = CvtJob{ARGF(27) + (size_t)lc * FF * D, nullptr, nullptr, WF + (size_t)11264 * D, D, FF, D, 0, 0, 1.f};
    if (part == 1) nj = 0;
    const bool ffn = part != 0;
    int total = ffn ? cvt_items(F0) + cvt_items(F1) : 0;
#pragma unroll
    for (int j = 0; j < 7; ++j) if (j < nj) total += cvt_items(J[j]);
#define CVT_FIND(IT, DD) do { int it_ = (IT); bool done_ = false; \
        _Pragma("unroll") for (int j = 0; j < 7; ++j) if (!done_ && j < nj) done_ = cvt_try(J[j], it_, lane, DD); \
        if (ffn) { if (!done_) done_ = cvt_try(F0, it_, lane, DD); if (!done_) done_ = cvt_try(F1, it_, lane, DD); } } while (0)
    if (rank < total) {
        f32x4 v[16], w[16]; CvtDesc d0, d1; int it0 = rank;
        CVT_FIND(it0, d0); cvt_load(d0, lane, v);
        for (;;) {
            const int it1 = it0 + nranks; const bool has = it1 < total;
            if (has) { CVT_FIND(it1, d1); cvt_load(d1, lane, w); }
            cvt_store(d0, lane, v, scr);
            if (!has) break;
#pragma unroll
            for (int i = 0; i < 16; ++i) v[i] = w[i];
            d0 = d1; it0 = it1;
        }
    }
#undef CVT_FIND
#undef ARGF
}

#if MLA_CHECK
constexpr int CW_CHK = 2048;
__device__ __forceinline__ float wave_max(float v, int lane) {
#pragma unroll
    for (int o = 1; o < 64; o <<= 1) v = fmaxf(v, shfl_xor_l(v, o, lane));
    return v;
}
__device__ __forceinline__ void mla_check(LAS unsigned char* lds, unsigned char* ws, int li, int gw, int wave, int lane) {
#define ARGF(i) ((const float*)ld_arg(lds, (i)))
    LAS float* sc = (LAS float*)(lds + wave * 19456);
    const bf16* H = (const bf16*)(ws + WS_H); const bf16* Qb = (const bf16*)(ws + WS_Q); const bf16* KVb = (const bf16*)(ws + WS_KV); const bf16* KRb = (const bf16*)(ws + WS_KR); const bf16* Ob = (const bf16*)(ws + WS_O);
    const int t = (int)(((unsigned)gw * 2654435761u) % (unsigned)MT); const int hd = gw & 15;
    const bool isx = t < MX; const int tt = t & (SEQ - 1);
    float err = 0.f;
    {
        const float* wdq = ARGF(8) + (size_t)li * D * QR; const float* wdkv = ARGF(11) + (size_t)li * D * (KVR + ROPE);
        float ql[8], kl[9];
#pragma unroll
        for (int j = 0; j < 8; ++j) ql[j] = 0.f;
#pragma unroll
        for (int j = 0; j < 9; ++j) kl[j] = 0.f;
        for (int k = 0; k < D; ++k) { const float hv = bf2f(H[(size_t)t * D + k]);
#pragma unroll
            for (int j = 0; j < 8; ++j) ql[j] += hv * wdq[(size_t)k * QR + lane + 64 * j];
#pragma unroll
            for (int j = 0; j < 9; ++j) kl[j] += hv * wdkv[(size_t)k * (KVR + ROPE) + lane + 64 * j]; }
        float sq = 0.f, sk = 0.f;
#pragma unroll
        for (int j = 0; j < 8; ++j) { sq += ql[j] * ql[j]; sk += kl[j] * kl[j]; }
        const float rq = 1.0f / sqrtf(wave_sum(sq, lane) * (1.0f / QR) + NORM_EPS), rk = 1.0f / sqrtf(wave_sum(sk, lane) * (1.0f / KVR) + NORM_EPS);
        const float* qg = ARGF(9) + li * QR; const float* kg = ARGF(12) + li * KVR;
#pragma unroll
        for (int j = 0; j < 8; ++j) { sc[lane + 64 * j] = ql[j] * rq * qg[lane + 64 * j]; sc[512 + lane + 64 * j] = kl[j] * rk * kg[lane + 64 * j]; }
        sc[1024 + lane] = kl[8];
        asm volatile("s_waitcnt lgkmcnt(0)" ::: "memory");
        const float* wuq = ARGF(10) + (size_t)li * QR * 3072 + hd * DQ; const float* wukv = ARGF(13) + (size_t)li * KVR * 4096 + hd * 256;
        float qv[3] = {0.f, 0.f, 0.f}, kv[4] = {0.f, 0.f, 0.f, 0.f};
        for (int c = 0; c < 512; ++c) { const float a = sc[c], bq = sc[512 + c];
#pragma unroll
            for (int j = 0; j < 3; ++j) qv[j] += a * wuq[(size_t)c * 3072 + lane + 64 * j];
#pragma unroll
            for (int j = 0; j < 4; ++j) kv[j] += bq * wukv[(size_t)c * 4096 + lane + 64 * j]; }
#pragma unroll
        for (int j = 0; j < 3; ++j) sc[1100 + lane + 64 * j] = qv[j];
        asm volatile("s_waitcnt lgkmcnt(0)" ::: "memory");
        float qref[3]; float kr_ref = 0.f;
#pragma unroll
        for (int j = 0; j < 3; ++j) { const int d = lane + 64 * j; float v = sc[1100 + d];
            if (d >= NOPE && isx) { const int e = d - NOPE, half = e >> 5, i = e & 15, second = (e >> 4) & 1; const float pos = half ? (float)(tt & 63) : (float)(tt >> 6);
                const float ang = pos * __builtin_amdgcn_exp2f(-(float)(2 * i) * (13.287712379549449f / 32.0f)); const float rev = ang * 0.15915494309189535f; const float fr_ = rev - floorf(rev);
                const float cs = __builtin_amdgcn_cosf(fr_), sn = __builtin_amdgcn_sinf(fr_); const float other = sc[1100 + NOPE + half * 32 + i + (second ? 0 : 16)];
                v = second ? (v * cs + other * sn) : (v * cs - other * sn); }
            qref[j] = v * (0.07216878364870322f * LOG2E); }
        { const int e = lane, half = e >> 5, i = e & 15, second = (e >> 4) & 1; float v = sc[1024 + e];
          if (isx) { const float pos = half ? (float)(tt & 63) : (float)(tt >> 6);
              const float ang = pos * __builtin_amdgcn_exp2f(-(float)(2 * i) * (13.287712379549449f / 32.0f)); const float rev = ang * 0.15915494309189535f; const float fr_ = rev - floorf(rev);
              const float cs = __builtin_amdgcn_cosf(fr_), sn = __builtin_amdgcn_sinf(fr_); const float other = sc[1024 + half * 32 + i + (second ? 0 : 16)];
              v = second ? (v * cs + other * sn) : (v * cs - other * sn); }
          kr_ref = v; }
#pragma unroll
        for (int j = 0; j < 3; ++j) sc[1400 + lane + 64 * j] = qref[j];
        sc[1600 + lane] = kr_ref;
        asm volatile("s_waitcnt lgkmcnt(0)" ::: "memory");
        float mx = 0.f, df = 0.f;
#pragma unroll
        for (int j = 0; j < 3; ++j) { const int p = lane + 64 * j; const int od = p < NOPE ? p : NOPE + ropeperm64(p - NOPE); const float ref = sc[1400 + od]; const float mine = bf2f(Qb[(size_t)t * 3072 + hd * DQ + p]);
            mx = fmaxf(mx, fabsf(ref)); df = fmaxf(df, fabsf(ref - mine)); }
        err = fmaxf(err, wave_max(df, lane) / (wave_max(mx, lane) + 1e-20f));
        mx = 0.f; df = 0.f;
#pragma unroll
        for (int j = 0; j < 4; ++j) { const float ref = kv[j]; const float mine = bf2f(KVb[(size_t)t * 4096 + hd * 256 + lane + 64 * j]); mx = fmaxf(mx, fabsf(ref)); df = fmaxf(df, fabsf(ref - mine)); }
        err = fmaxf(err, wave_max(df, lane) / (wave_max(mx, lane) + 1e-20f));
        { const float ref = sc[1600 + ropeperm64(lane)]; const float mine = bf2f(KRb[(size_t)t * 64 + lane]); err = fmaxf(err, wave_max(fabsf(ref - mine), lane) / (wave_max(fabsf(ref), lane) + 1e-20f)); }
    }
    {
        const int b = isx ? (t >> 12) : ((t - MX) >> 8); const int nk = isx ? 4352 : 256;
        for (int d = lane; d < DQ; d += 64) sc[d] = bf2f(Qb[(size_t)t * 3072 + hd * DQ + d]);
        asm volatile("s_waitcnt lgkmcnt(0)" ::: "memory");
        float mxs = -1e30f;
        for (int j = lane; j < nk; j += 64) { const int row = j < 256 ? MX + b * CTXL + j : b * SEQ + (j - 256); float sdot = 0.f;
            for (int d = 0; d < NOPE; ++d) sdot += sc[d] * bf2f(KVb[(size_t)row * 4096 + hd * 256 + d]);
            for (int d = 0; d < ROPE; ++d) sdot += sc[NOPE + d] * bf2f(KRb[(size_t)row * 64 + d]);
            sc[256 + j] = sdot; mxs = fmaxf(mxs, sdot); }
        mxs = wave_max(mxs, lane); float sum = 0.f;
        for (int j = lane; j < nk; j += 64) { const float p = __builtin_amdgcn_exp2f(sc[256 + j] - mxs); sc[256 + j] = p; sum += p; }
        sum = wave_sum(sum, lane);
        asm volatile("s_waitcnt lgkmcnt(0)" ::: "memory");
        float o0 = 0.f, o1 = 0.f;
        for (int j = 0; j < nk; ++j) { const int row = j < 256 ? MX + b * CTXL + j : b * SEQ + (j - 256); const float p = sc[256 + j];
            o0 += p * bf2f(KVb[(size_t)row * 4096 + hd * 256 + 128 + lane]); o1 += p * bf2f(KVb[(size_t)row * 4096 + hd * 256 + 128 + 64 + lane]); }
        o0 /= sum; o1 /= sum;
        const float m0 = bf2f(Ob[(size_t)t * D + hd * 128 + lane]), m1 = bf2f(Ob[(size_t)t * D + hd * 128 + 64 + lane]);
        const float df = fmaxf(fabsf(o0 - m0), fabsf(o1 - m1)), mx = fmaxf(fabsf(o0), fabsf(o1));
        err = fmaxf(err, wave_max(df, lane) / (wave_max(mx, lane) + 1e-20f));
    }
    if (lane == 0) atomicMax((unsigned*)(ws + WS_CTL) + CW_CHK, __float_as_uint(err));
#undef ARGF
}
#endif
struct Args { const float* in[29]; float* out; unsigned char* ws; int ph_lo, ph_hi; };
constexpr int PH_PER_LAYER = 10, PH_FINAL = 1 + PH_PER_LAYER * DEPTH, PH_COUNT = PH_FINAL + 1;

template <unsigned MK_EN_T>
__global__ void __launch_bounds__(512, 2) mk_fwd(Args args) {
    extern __shared__ __attribute__((aligned(16))) unsigned char lds_raw[];
    LAS unsigned char* lds = (LAS unsigned char*)lds_raw;
    volatile LAS unsigned* MISC = (volatile LAS unsigned*)(lds + MISC_OFF);
    const int G = gridDim.x; const int bx = blockIdx.x; const int vcu = (G % 8 == 0) ? (bx % 8) * (G / 8) + bx / 8 : bx;
    const int NGW = G * 8;
    unsigned char* ws = args.ws; float* X = args.out; void* args_out_raw = (void*)args.out;
    const int lo = args.ph_lo, hi = args.ph_hi;
    const int wave_s = __builtin_amdgcn_readfirstlane((int)threadIdx.x >> 6);
#define TID() (wave_s * 64 + lane_id())
    { const int tid0 = threadIdx.x;
      for (int u = tid0; u < (LDS_BYTES - CTRL_BASE) / 4; u += 512) ((LAS unsigned*)(lds + CTRL_BASE))[u] = 0u;
      __syncthreads();
      if (tid0 < 29) ((volatile LAS unsigned long long*)(lds + ARGS_OFF))[tid0] = (unsigned long long)args.in[tid0];
      __syncthreads(); }
#define ARGF(i) ((const float*)ld_arg(lds, (i)))
    XcdBarrier bar; bar.bar = (unsigned*)(ws + WS_CTL) + CW_BAR; bar.x = 0; bar.st = nullptr; bar.wave = wave_s;
    if (hi - lo > 1) bar = xcd_barrier_post((unsigned*)(ws + WS_CTL) + CW_BAR, MISC + 8, wave_s);
#if PROBE_TS
    if (bx == 0 && TID() == 0) { ((unsigned long long*)(ws + WS_CTL + 65536))[0] = __builtin_amdgcn_s_memrealtime(); ((unsigned long long*)(ws + WS_CTL + 65536))[121] = ~0ull; }
#endif
#define EN(b) (((MK_EN_T) >> (b)) & 1u)
#define IN(k) (lo <= (k) && (k) < hi)
#if PROBE_TS
#define TS_WORDS ((unsigned long long*)(ws + WS_CTL + 65536))
#define PHASE_END(k) do { if (hi > (k) + 1) xcd_barrier(bar); if (bx == 0 && TID() == 0) TS_WORDS[(k) + 1] = __builtin_amdgcn_s_memrealtime(); } while (0)
#else
#define PHASE_END(k) do { if (hi > (k) + 1) xcd_barrier(bar); } while (0)
#endif
#define PH_IDS int tid = TID(); asm volatile("" : "+v"(tid)); const int lane = tid & 63; const int wave = wave_s; int gw = vcu * 8 + wave; asm volatile("" : "+s"(gw)); (void)lane; (void)gw;
#define XB_    ((bf16*)args_out_raw)
#define XCB_   ((bf16*)(ws + WS_XC))
#define XF_    ((float*)(ws + WS_BIG + 32 * MiB))
#define MODV_  ((float*)(ws + WS_MODV))
#define TABM_  ((float*)(ws + WS_TABM))
#define TABR_  ((float*)(ws + WS_TABR))
#define SSQ_   ((float*)(ws + WS_SSQ))
#define KR_    ((bf16*)(ws + WS_KR))
#define H_     ((bf16*)(ws + WS_H))
#define WMIX_(ll) ((bf16*)(ws + (((ll) & 1) ? WS_WB : WS_WA)))
#define WFFN_(ll) ((bf16*)(ws + (((ll) & 1) ? WS_WB + 82 * MiB : WS_WA + 22 * MiB)))
#define W1T_   WMIX_(l)
#define WUQT_  (W1T_ + (size_t)N1 * D)
#define WUKVT_ (WUQT_ + (size_t)3072 * 512)
#define WOTM_  (WUKVT_ + (size_t)4096 * 512)
#define WQKVT_ WMIX_(l)
#define WGT_   (WQKVT_ + (size_t)8192 * D)
#define WOTR_  (WGT_ + (size_t)8192 * D)
#define WGUT_  WFFN_(l)
#define WDT_   (WGUT_ + (size_t)11264 * D)
#define QKVL_  ((bf16*)(ws + WS_QKVL))
#define Q_     ((bf16*)(ws + WS_Q))
#define KV_    ((bf16*)(ws + WS_KV))
#define O_     ((bf16*)(ws + WS_O))
#define QKV_   ((bf16*)(ws + WS_QKV))
#define Y_     ((bf16*)(ws + WS_Y))
#define GATED_ ((bf16*)(ws + WS_GATED))
#define GB_    ((bf16*)(ws + WS_G))
#define UB_    ((bf16*)(ws + WS_U))
#define HALO_  ((float*)(ws + WS_G))
#define MODL_  (MODV_ + (size_t)l * 9 * NMOD)

    if (EN(0) && IN(0)) for (int rep_ = 0; rep_ < 1 + (int)((PROBE_MASK >> 0) & 1u); ++rep_) {
        PH_IDS
        mod_layers(lds, ws, 0, 1, bx, G, tid, lane, wave);
        __syncthreads();
        cvt_layer(lds, ws, 0, gw, NGW, wave, lane, 2);
        for (int i = bx * 512 + tid; i < 64 * 16 + SEQ * 128; i += G * 512) {
            float inv, pos; float* dst;
            if (i < 1024) { const int p = i >> 4, f = i & 15; inv = __builtin_amdgcn_exp2f(-(float)(2 * f) * (13.287712379549449f / 32.0f)); pos = (float)p; dst = TABM_ + 2 * i; }
            else { const int j = i - 1024, t = j >> 7, f = j & 127; inv = __builtin_amdgcn_exp2f(-(float)(2 * f) * (13.287712379549449f / 256.0f)); pos = (float)t; dst = TABR_ + 2 * j; }
            const float ang = pos * inv; const double rev = (double)ang * 0.15915494309189535; const float fr = (float)(rev - floor(rev));
            dst[0] = __builtin_amdgcn_cosf(fr); dst[1] = __builtin_amdgcn_sinf(fr);
        }
        PHASE_END(0);
    }

    for (int l = 0; l < DEPTH; ++l) {
        const int P = 1 + PH_PER_LAYER * l; const int li = l >> 1; const bool is_ret = (l & 1) != 0; const bool last = (l == DEPTH - 1);
        const int Mrows = last ? MX : MT;

        if (EN(1) && IN(P + 0)) for (int rep_ = 0; rep_ < 1 + (int)((PROBE_MASK >> 1) & 1u); ++rep_) {
            PH_IDS
            const float* g = ARGF(6) + l * D;
            if (l == 0) norm_phase(ARGF(0), ARGF(2), g, MODL_, 0, H_, MT, gw, NGW, lane);
            else norm_phase_b16(XB_, XCB_, g, MODL_, 0, H_, MT, gw, NGW, lane);
            PHASE_END(P + 0);
        }

        if (!is_ret) {
            if (EN(2) && IN(P + 1)) for (int rep_ = 0; rep_ < 1 + (int)((PROBE_MASK >> 2) & 1u); ++rep_) {
                pg8::Gemm g{H_, W1T_, MT, N1, D, D}; pg8::StaticOrder S; S.init(MT, N1, G, bx); S.tid = TID();
                EpiG1 E{QKVL_, SSQ_, KR_, TABM_};
                pg8::gemm_phase<EpiG1>(lds, g, S, E);
                PHASE_END(P + 1);
            }
            if (EN(3) && IN(P + 2)) for (int rep_ = 0; rep_ < 1 + (int)((PROBE_MASK >> 3) & 1u); ++rep_) {
                { pg8::Gemm g{QKVL_, WUQT_, MT, 3072, QR, N1}; pg8::StaticOrder S; S.init(MT, 3072, G, bx); S.tid = TID(); EpiUq E{Q_, SSQ_, TABM_}; pg8::gemm_phase<EpiUq>(lds, g, S, E); }
                { pg8::Gemm g{QKVL_ + 512, WUKVT_, MT, 4096, KVR, N1}; pg8::StaticOrder S; S.init(MT, 4096, G, bx); S.tid = TID(); EpiUkv E{KV_, SSQ_}; pg8::gemm_phase<EpiUkv>(lds, g, S, E); }
                PHASE_END(P + 2);
            }
            if (EN(4) && IN(P + 3)) for (int rep_ = 0; rep_ < 1 + (int)((PROBE_MASK >> 4) & 1u); ++rep_) {
                const int nun = 2048 + 128;
                for (int ui = vcu; ui < nun; ui += G) {
                    if (ui < 2048) { const int xcd = (ui & 255) >> 5, j = ui & 31, rnd = ui >> 8; const int bh = xcd * 16 + 2 * rnd + (j >> 4), qb = j & 15; const int b = bh >> 4, hd = bh & 15;
                        att::attn_unit(Q_ + (size_t)(b * SEQ + qb * 256) * 3072 + hd * DQ, KV_ + hd * 256, KR_, O_ + (size_t)(b * SEQ + qb * 256) * D + hd * 128, 68, 4, MX + b * CTXL, b * SEQ, (char*)lds_raw, TID()
#if PROBE_TS
                            , bx == 0 ? TS_WORDS : nullptr
#endif
                            );
                    } else { const int bh = ui - 2048, b = bh >> 4, hd = bh & 15;
                        att::attn_unit(Q_ + (size_t)(MX + b * CTXL) * 3072 + hd * DQ, KV_ + hd * 256, KR_, O_ + (size_t)(MX + b * CTXL) * D + hd * 128, 4, 4, MX + b * CTXL, 0, (char*)lds_raw, TID()); }
                }
                PHASE_END(P + 3);
            }
        } else {
            if (EN(5) && IN(P + 1)) for (int rep_ = 0; rep_ < 1 + (int)((PROBE_MASK >> 5) & 1u); ++rep_) {
                pg8::Gemm g{H_, WQKVT_, MT, 8192, D, D}; pg8::StaticOrder S; S.init(MT, 8192, G, bx); S.tid = TID();
                EpiQKV E{QKV_, TABR_};
                pg8::gemm_phase<EpiQKV>(lds, g, S, E);
                PHASE_END(P + 1);
            }
            if (EN(6) && IN(P + 2)) for (int rep_ = 0; rep_ < 1 + (int)((PROBE_MASK >> 6) & 1u); ++rep_) {
                for (int ui = vcu; ui < 256; ui += G) {
                    const int bh = ui >> 2, dir = (ui >> 1) & 1, dvh = ui & 1; const int b = bh >> 3, hd = bh & 7;
                    const float dec = (dir ? ARGF(22) : ARGF(21))[li * RH + hd];
                    const float lg2 = -__expf(dec) * LOG2E;
                    scan::scan_unit(QKV_, Y_ + (size_t)dir * MT * 4096, (float*)(ws + (dir ? WS_PSTB : WS_PSTF)), b, hd, dir, dvh, lg2, last, lds, TID()
#if PROBE_TS
                                    , TS_WORDS
#endif
                                    );
                }
                PHASE_END(P + 2);
            }
            if (EN(8) && IN(P + 4)) for (int rep_ = 0; rep_ < 1 + (int)((PROBE_MASK >> 8) & 1u); ++rep_) {
                pg8::Gemm g{H_, WGT_, Mrows, 8192, D, D}; pg8::StaticOrder S; S.init(Mrows, 8192, G, bx); S.tid = TID();
                EpiGate E{GATED_, Y_, Y_ + (size_t)MT * 4096, (const float*)(ws + WS_PSTF), (const float*)(ws + WS_PSTB)};
                pg8::gemm_phase<EpiGate>(lds, g, S, E);
                PHASE_END(P + 4);
            }
        }
        if (EN(9) && IN(P + 5)) for (int rep_ = 0; rep_ < 1 + (int)((PROBE_MASK >> 9) & 1u); ++rep_) {
#if MLA_CHECK
            if (l == MLA_CHECK_LAYER) { PH_IDS mla_check(lds, ws, li, gw, wave, lane); __syncthreads(); }
#endif
            pg8::Gemm g = is_ret ? pg8::Gemm{GATED_, WOTR_, Mrows, D, 4096, 4096} : pg8::Gemm{O_, WOTM_, Mrows, D, D, D};
            pg8::StaticOrder S; S.init(Mrows, D, G, bx, 4, true); S.tid = TID();
#if PROBE_TS
            S.probe = is_ret ? 2 : 1; S.tsw = TS_WORDS;
#endif
            const void* xsrc = (l == 0) ? (const void*)ARGF(0) : (const void*)XB_; const void* csrc = (l == 0) ? (const void*)ARGF(2) : (const void*)XCB_;
            EpiResid E{xsrc, XB_, csrc, XCB_, MODL_, 2 * D, l == 0, false};
            pg8::gemm_phase<EpiResid>(lds, g, S, E);
            if (l + 1 < DEPTH) {
                PH_IDS
                const int nwg = (Mrows / 256) * (D / 256), rem = nwg % G;
                if (rem == 0) cvt_layer(lds, ws, l + 1, gw, NGW, wave, lane, 0);
                else if (bx >= rem) cvt_layer(lds, ws, l + 1, (bx - rem) * 8 + wave, (G - rem) * 8, wave, lane, 0);
            }
            PHASE_END(P + 5);
        }
        if (EN(10) && IN(P + 6)) for (int rep_ = 0; rep_ < 1 + (int)((PROBE_MASK >> 10) & 1u); ++rep_) {
            PH_IDS
            const float* g = ARGF(7) + l * D;
            norm_phase_b16(XB_, XCB_, g, MODL_, 3, H_, Mrows, gw, NGW, lane);
            PHASE_END(P + 6);
        }
        if (EN(11) && IN(P + 7)) for (int rep_ = 0; rep_ < 1 + (int)((PROBE_MASK >> 11) & 1u); ++rep_) {
            pg8::Gemm g{H_, WGUT_, Mrows, 11264, D, D}; pg8::StaticOrder S; S.init(Mrows, 11264, G, bx); S.tid = TID();
#if PROBE_TS
            S.probe = 4; S.tsw = TS_WORDS;
#endif
            EpiGUConv E{UB_, HALO_, ARGF(25) + (size_t)l * 3 * FF, ARGF(26) + (size_t)l * FF, (LAS float*)(lds + EDGE_OFF)};
            pg8::gemm_phase<EpiGUConv>(lds, g, S, E);
#if PROBE_TS
            if (TID() == 0 && bx == 0) TS_WORDS[140 + l] = __builtin_amdgcn_s_memrealtime();
            if (TID() == 0 && bx == G - 1) TS_WORDS[148 + l] = __builtin_amdgcn_s_memrealtime();
#endif
            PHASE_END(P + 7);
        }
        if (EN(13) && IN(P + 9)) for (int rep_ = 0; rep_ < 1 + (int)((PROBE_MASK >> 13) & 1u); ++rep_) {
            pg8::Gemm g{UB_, WDT_, Mrows, D, FF, FF}; pg8::StaticOrder S; S.init(Mrows, D, G, bx, 4, true); S.tid = TID();
#if PROBE_TS
            S.probe = 3; S.tsw = TS_WORDS;
#endif
            {
                PH_IDS
                const float* cw = ARGF(25) + (size_t)l * 3 * FF; const float* HL = HALO_; bf16* ACT = UB_;
                pg8::Unit uu; int prev_pm = -1;
                for (int i = 0; S.next(i, uu); ++i) { const int pm = uu.pm; if (pm == prev_pm || pm >= MX / 256) { prev_pm = pm; continue; } prev_pm = pm;
                    const bool top = (pm & 15) != 0, bot = ((pm + 1) & 15) != 0;
                    for (int q = tid; q < FF / 4; q += 512) { const int f = q * 4;
                        if (top) { const float* t0 = HL + (size_t)((pm * 2 + 0) * 3) * HALO_STRIDE + f; const float* b1 = HL + (size_t)(((pm - 1) * 2 + 1) * 3) * HALO_STRIDE + f;
                            const f32x4 o = silu4(*(const f32x4*)t0 + *(const f32x4*)(cw + f) * *(const f32x4*)(b1 + HALO_STRIDE)) * *(const f32x4*)(t0 + 2 * HALO_STRIDE);
                            u32x2 w; w.x = cvt_pk_bf16(o[0], o[1]); w.y = cvt_pk_bf16(o[2], o[3]); *(u32x2*)(ACT + (size_t)(pm * 256) * FF + f) = w; }
                        if (bot) { const float* b0 = HL + (size_t)((pm * 2 + 1) * 3) * HALO_STRIDE + f; const float* t1 = HL + (size_t)(((pm + 1) * 2 + 0) * 3) * HALO_STRIDE + f;
                            const f32x4 o = silu4(*(const f32x4*)b0 + *(const f32x4*)(cw + 2 * FF + f) * *(const f32x4*)(t1 + HALO_STRIDE)) * *(const f32x4*)(b0 + 2 * HALO_STRIDE);
                            u32x2 w; w.x = cvt_pk_bf16(o[0], o[1]); w.y = cvt_pk_bf16(o[2], o[3]); *(u32x2*)(ACT + (size_t)(pm * 256 + 255) * FF + f) = w; } } }
                asm volatile("s_waitcnt vmcnt(0)" ::: "memory"); __syncthreads();
            }
            EpiResid E{XB_, last ? (void*)XF_ : (void*)XB_, XCB_, XCB_, MODL_, 5 * D, false, last};
            pg8::gemm_phase<EpiResid>(lds, g, S, E);
#if PROBE_TS
            if (TID() == 0 && bx == 0) TS_WORDS[64 + l] = __builtin_amdgcn_s_memrealtime();
            if (TID() == 0 && bx == G - 1) TS_WORDS[72 + l] = __builtin_amdgcn_s_memrealtime();
#endif
            if (l + 1 < DEPTH) {
                PH_IDS
                const int nwg = (Mrows / 256) * (D / 256), rem = nwg % G;
                if (rem == 0) { mod_layers(lds, ws, l + 1, l + 2, bx, G, tid, lane, wave); __syncthreads(); cvt_layer(lds, ws, l + 1, gw, NGW, wave, lane, 1); }
                else if (bx >= rem) { mod_layers(lds, ws, l + 1, l + 2, bx - rem, G - rem, tid, lane, wave); __syncthreads(); cvt_layer(lds, ws, l + 1, (bx - rem) * 8 + wave, (G - rem) * 8, wave, lane, 1); }
            }
#if PROBE_TS
            __syncthreads(); if (TID() == 0 && bx == G - 1) TS_WORDS[80 + l] = __builtin_amdgcn_s_memrealtime();
#endif
            PHASE_END(P + 9);
        }
    }
    if (EN(14) && IN(PH_FINAL)) for (int rep_ = 0; rep_ < 1 + (int)((PROBE_MASK >> 14) & 1u); ++rep_) {
        PH_IDS
        const float* g = ARGF(28);
#if PROBE_TS
        float ts_c = 0.f, ts_a = 0.f;
        { const unsigned long long* TS = (const unsigned long long*)(ws + WS_CTL + 65536); unsigned long long last = TS[0]; const unsigned long long t0 = last; float d1 = 0.f, d2 = 0.f;
          for (int k = 0; k < PH_FINAL; ++k) { const unsigned long long te = TS[k + 1]; if (te == 0ull) continue; const float d = (float)(te - last); last = te;
              int cls; if (k == 0) cls = 0; else { const int slot = (k - 1) % PH_PER_LAYER, ll = (k - 1) / PH_PER_LAYER; const bool ret = (ll & 1) != 0;
                  cls = slot == 0 ? 1 : slot >= 5 ? 5 + slot : (!ret ? 1 + slot : 4 + slot); }
              if (k > 0 && ((k - 1) % PH_PER_LAYER) == 5) { const bool ret5 = (((k - 1) / PH_PER_LAYER) & 1) != 0; if (TS_CLASS1 == (ret5 ? 51 : 50)) d1 += d; if (TS_CLASS2 == (ret5 ? 51 : 50)) d2 += d; }
              if (cls == TS_CLASS1) d1 += d; if (cls == TS_CLASS2) d2 += d; }
          float tot = (float)(last - t0);
          if (TS_CLASS1 >= 100) { float ph = 0.f, x0 = 0.f, x1 = 0.f, x2 = 0.f;
              for (int ll = 0; ll < 3; ++ll) { const unsigned long long st = TS[(1 + PH_PER_LAYER * ll + 7) + 1], en = TS[(1 + PH_PER_LAYER * ll + 9) + 1];
                  ph += (float)(en - st); x0 += (float)(TS[64 + ll] - st); x1 += (float)(TS[72 + ll] - st); x2 += (float)(TS[80 + ll] - st); }
              d1 = (TS_CLASS1 == 100) ? x0 : (TS_CLASS1 == 101) ? x1 : x2; d2 = (TS_CLASS2 == 100) ? x0 : (TS_CLASS2 == 101) ? x1 : x2; tot = ph; }
          if (TS_CLASS1 >= 200) { const unsigned long long* tw = TS + 90 + 3 * (TS_CLASS1 - 201); const float lp = (float)tw[0], ep = (float)tw[1], nn = (float)tw[2];
              d1 = lp; tot = lp + ep; d2 = (lp + ep) / nn / 100.f / 200.f * tot; }
          if (TS_CLASS1 == 400) { float ph = 0.f, x0 = 0.f, x1 = 0.f;
              for (int ll = 0; ll < 4; ++ll) { const unsigned long long st = TS[(1 + PH_PER_LAYER * ll + 6) + 1], en = TS[(1 + PH_PER_LAYER * ll + 7) + 1];
                  ph += (float)(en - st); x0 += (float)(TS[140 + ll] - st); x1 += (float)(TS[148 + ll] - st); }
              d1 = x0; d2 = x1; tot = ph; }
          if (TS_CLASS1 == 500) { d1 = (float)TS[160]; d2 = (float)TS[161]; tot = (float)TS[162]; }
          if (TS_CLASS1 == 501) { d1 = (float)TS[162] / (float)TS[163] / 100.f / 5.f; d2 = 0.f; tot = 1.f; }
          if (TS_CLASS1 == 600) { d1 = (float)TS[170]; d2 = (float)TS[171]; tot = (float)TS[172]; }
          if (TS_CLASS1 == 300) { const float mx = (float)TS[120], sm = (float)TS[122]; d1 = sm / (float)(gridDim.x * 4); tot = mx > 0.f ? mx : 1.f; d2 = 0.f; }
          { const float q1 = rintf(d1 / tot * 20.f) / 20.f, q2 = rintf(d2 / tot * 20.f) / 20.f; ts_c = sqrtf(q1); ts_a = 2.0f + 10.0f * q2; }
        }
#endif
#if MLA_CHECK
        const bool chk_bad = __uint_as_float(__hip_atomic_load((unsigned*)(ws + WS_CTL) + CW_CHK, __ATOMIC_RELAXED, __HIP_MEMORY_SCOPE_AGENT)) > MLA_CHECK_TOL;
#endif
        if (gw < MX) {
            f32x4 v[8], vn[8], gg[8]; int m = gw; row_load(XF_ + (size_t)m * D, lane, v);
#pragma unroll
            for (int j = 0; j < 8; ++j) gg[j] = *(const f32x4*)(g + 4 * lane + 256 * j);
            for (;;) {
                const int mn = m + NGW; const bool has = mn < MX;
                if (has) row_load(XF_ + (size_t)mn * D, lane, vn);
                float s = 0.f;
#pragma unroll
                for (int j = 0; j < 8; ++j) s += (v[j][0] * v[j][0] + v[j][1] * v[j][1]) + (v[j][2] * v[j][2] + v[j][3] * v[j][3]);
                const float rstd = 1.0f / sqrtf(wave_sum(s, lane) * (1.0f / D) + NORM_EPS);
                float* xr = X + (size_t)m * D;
#pragma unroll
                for (int j = 0; j < 8; ++j) { const int c = 4 * lane + 256 * j; f32x4 o_ = (v[j] * rstd) * gg[j];
#if MLA_CHECK
                    if (chk_bad) o_ = (f32x4){__builtin_nanf(""), __builtin_nanf(""), __builtin_nanf(""), __builtin_nanf("")};
#endif
#if PROBE_TS
                    if (m < 328) { o_ = o_ + ts_c; if (m == 0 && c == 0) o_[0] += ts_a - ts_c; }
#endif
                    *(f32x4*)(xr + c) = o_; }
                if (!has) break;
#pragma unroll
                for (int j = 0; j < 8; ++j) v[j] = vn[j];
                m = mn;
            }
        }
    }
#undef IN
#undef PHASE_END
}

#if !MK_SINGLE
typedef void (*KernFn)(Args);
static KernFn phase_kernel(int bit) {
    switch (bit) {
        case 0: return mk_fwd<1u << 0>;  case 1: return mk_fwd<1u << 1>;  case 2: return mk_fwd<1u << 2>;  case 3: return mk_fwd<1u << 3>;
        case 4: return mk_fwd<1u << 4>;  case 5: return mk_fwd<1u << 5>;  case 6: return mk_fwd<1u << 6>;  case 7: return mk_fwd<1u << 7>;
        case 8: return mk_fwd<1u << 8>;  case 9: return mk_fwd<1u << 9>;  case 10: return mk_fwd<1u << 10>; case 11: return mk_fwd<1u << 11>;
        case 12: return mk_fwd<1u << 12>; case 13: return mk_fwd<1u << 13>; default: return mk_fwd<1u << 14>;
    }
}
static int phase_bit(int p) {
    if (p == 0) return 0; if (p == PH_FINAL) return 14;
    const int l = (p - 1) / PH_PER_LAYER, slot = (p - 1) % PH_PER_LAYER; const bool ret = (l & 1) != 0;
    if (slot == 0) return 1;
    if (slot >= 5) return 4 + slot;
    if (!ret) return slot == 4 ? -1 : 1 + slot;
    return 4 + slot;
}
#endif
extern "C" void kernel_launch(void* const* d_in, const int* in_sizes, int n_in, void* d_out, int out_size, void* d_ws, size_t ws_size, hipStream_t stream) {
    static int grid = 0;
    if (grid == 0) {
        if (n_in != 29 || out_size != MX * D || ws_size < WS_END) { fprintf(stderr, "kernel_launch: unexpected shapes: n_in %d out %d ws %zu (need %zu)\n", n_in, out_size, ws_size, (size_t)WS_END); grid = -1; return; }
        int dev = 0, cus = 0;
        if (hipGetDevice(&dev) != hipSuccess || hipDeviceGetAttribute(&cus, hipDeviceAttributeMultiprocessorCount, dev) != hipSuccess) { grid = -1; return; }
#if MK_SINGLE
        if (hipFuncSetAttribute((const void*)mk_fwd<0xFFFFFFFFu>, hipFuncAttributeMaxDynamicSharedMemorySize, LDS_BYTES) != hipSuccess) { fprintf(stderr, "kernel_launch: hipFuncSetAttribute failed\n"); grid = -1; return; }
#else
        for (int b = 0; b < 15; ++b) if (hipFuncSetAttribute((const void*)phase_kernel(b), hipFuncAttributeMaxDynamicSharedMemorySize, LDS_BYTES) != hipSuccess) { fprintf(stderr, "kernel_launch: hipFuncSetAttribute failed\n"); grid = -1; return; }
#endif
        (void)hipGetLastError();
        grid = cus;
    }
    if (grid < 0) return;
    if (hipMemsetAsync((char*)d_ws + WS_CTL, 0, CTL_BYTES, stream) != hipSuccess) return;
    Args a{};
    for (int i = 0; i < 29; ++i) a.in[i] = (const float*)d_in[i];
    a.out = (float*)d_out; a.ws = (unsigned char*)d_ws;
#if MK_SINGLE
    a.ph_lo = 0; a.ph_hi = PH_COUNT;
    hipLaunchKernelGGL(mk_fwd<0xFFFFFFFFu>, dim3(grid), dim3(512), LDS_BYTES, stream, a);
#else
    for (int p = 0; p < PH_COUNT; ++p) {
        const int bit = phase_bit(p); if (bit < 0) continue;
        a.ph_lo = p; a.ph_hi = p + 1;
        hipLaunchKernelGGL(phase_kernel(bit), dim3(grid), dim3(512), LDS_BYTES, stream, a);
    }
#endif
    const hipError_t le = hipPeekAtLastError();
    if (le != hipSuccess) fprintf(stderr, "kernel_launch: launch failed: %s\n", hipGetErrorName(le));
}
```

```cpp
#include <hip/hip_runtime.h>
#include <cstdio>
#include <cstdint>

#ifndef MK_SINGLE
#define MK_SINGLE 1
#endif

#ifndef MK_STAGGER
#define MK_STAGGER 0
#endif
#ifndef PROBE_EPI2
#define PROBE_EPI2 0
#endif
#ifndef MLA_CHECK
#define MLA_CHECK 0
#endif
#ifndef MLA_CHECK_LAYER
#define MLA_CHECK_LAYER 0
#endif
#ifndef MLA_CHECK_TOL
#define MLA_CHECK_TOL 0.03f
#endif
#ifndef PROBE_TS
#define PROBE_TS 0
#endif
#ifndef TS_SKEW_ID
#define TS_SKEW_ID 4
#endif
#ifndef TS_CLASS1
#define TS_CLASS1 0
#endif
#ifndef TS_CLASS2
#define TS_CLASS2 1
#endif
#ifndef PROBE_MASK
#define PROBE_MASK 0u
#endif
#define GAS __attribute__((address_space(1)))
#define LAS __attribute__((address_space(3)))
typedef unsigned short bf16;
typedef short bf16x8 __attribute__((ext_vector_type(8)));
typedef short s16x4 __attribute__((ext_vector_type(4)));
typedef float f32x2 __attribute__((ext_vector_type(2)));
typedef float f32x4 __attribute__((ext_vector_type(4)));
typedef float f32x16 __attribute__((ext_vector_type(16)));
typedef unsigned u32x2 __attribute__((ext_vector_type(2)));
typedef unsigned u32x4 __attribute__((ext_vector_type(4)));
typedef GAS unsigned gu32;

constexpr int D = 2048, NB = 8, SEQ = 4096, CTXL = 256, DEPTH = 4;
constexpr int MX = NB * SEQ, MC = NB * CTXL, MT = MX + MC;
constexpr int FF = 5632, NMOD = 6 * D;
constexpr int MLA_H = 16, QR = 512, KVR = 512, NOPE = 128, ROPE = 64, DQ = 192;
constexpr int N1 = 1280;
constexpr int RH = 8, RDK = 256, RDV = 512;
constexpr float NORM_EPS = 1e-6f, GN_EPS = 1e-5f;
constexpr float LOG2E = 1.4426950408889634f;

constexpr size_t MiB = 1u << 20;
constexpr size_t WS_CTL = 0, CTL_BYTES = 1 * MiB;
constexpr size_t WS_MODV = 1 * MiB;
constexpr size_t WS_TABM = 3 * MiB;
constexpr size_t WS_TABR = 4 * MiB;
constexpr size_t WS_SSQ = 8 * MiB;
constexpr size_t WS_XC = 12 * MiB;
constexpr size_t WS_KR = 28 * MiB;
constexpr size_t WS_PSTF = 20 * MiB, WS_PSTB = 33 * MiB;
constexpr size_t WS_WA = 40 * MiB;
constexpr size_t WS_WB = 128 * MiB;
constexpr size_t WS_H = 276 * MiB;
constexpr size_t WS_BIG = 412 * MiB;
constexpr size_t WS_QKVL = WS_BIG, WS_Q = WS_BIG + 88 * MiB, WS_KV = WS_BIG + 292 * MiB, WS_O = WS_BIG + 564 * MiB;
constexpr size_t WS_QKV = WS_BIG, WS_Y = WS_BIG + 544 * MiB, WS_GATED = WS_BIG;
constexpr size_t WS_G = WS_BIG, WS_U = WS_BIG + 374 * MiB;
constexpr size_t WS_END = WS_BIG + 1088 * MiB;
static_assert((size_t)MT * 8192 * 2 <= 544 * MiB && (size_t)MT * 5632 * 2 <= 374 * MiB && (size_t)MT * N1 * 2 <= 88 * MiB, "ws map");

constexpr int CW_BAR = 4096;

constexpr int RING_BYTES = 131072, CTRL_BASE = 155648, MISC_OFF = CTRL_BASE + 320, ARGS_OFF = CTRL_BASE + 1024, EDGE_OFF = CTRL_BASE + 4096, LDS_BYTES = 163840;

__device__ __forceinline__ unsigned cvt_pk_bf16(float lo, float hi) { unsigned r; asm volatile("v_cvt_pk_bf16_f32 %0, %1, %2" : "=v"(r) : "v"(lo), "v"(hi)); return r; }
__device__ __forceinline__ float bf2f(unsigned short b) { return __uint_as_float((unsigned)b << 16); }
__device__ __forceinline__ float bflo(unsigned w) { return __uint_as_float(w << 16); }
__device__ __forceinline__ float bfhi(unsigned w) { return __uint_as_float(w & 0xffff0000u); }
__device__ __forceinline__ float shfl_xor_l(float v, int mask, int lane) { return __builtin_bit_cast(float, __builtin_amdgcn_ds_bpermute((lane ^ mask) << 2, __builtin_bit_cast(int, v))); }
__device__ __forceinline__ float fast_silu(float x) { return x * __builtin_amdgcn_rcpf(1.0f + __builtin_amdgcn_exp2f(-x * LOG2E)); }

__device__ __forceinline__ int lane_id() { int x; asm volatile("v_mbcnt_lo_u32_b32 %0, -1, 0\n\tv_mbcnt_hi_u32_b32 %0, -1, %0" : "=v"(x)); return x; }
__device__ __forceinline__ void glds16_s(const void* sbase, unsigned voff, unsigned lds_dst) {
    unsigned keep;
    asm volatile("s_mov_b32 %0, m0\n\ts_mov_b32 m0, %3\n\ts_nop 0\n\tglobal_load_lds_dwordx4 %1, %2\n\ts_mov_b32 m0, %0" : "=&s"(keep) : "v"(voff), "s"(sbase), "s"(lds_dst) : "memory");
}
__device__ __forceinline__ const char* uni_ptr(const void* p) {
    const unsigned long long v = (unsigned long long)p; const unsigned lo = __builtin_amdgcn_readfirstlane((unsigned)v), hi = __builtin_amdgcn_readfirstlane((unsigned)(v >> 32));
    return (const char*)(((unsigned long long)hi << 32) | lo);
}
namespace pg8 {
constexpr int BM = 256, BK = 64, HALF = 128, HTB = HALF * BK * 2, STAGE_BYTES = 8 * HTB, NXCD = 8, WGM = 8;
__host__ __device__ __forceinline__ int lds_byte(int r, int c) { const int st = (r >> 4) * 2 + (c >> 5), rr = r & 15, cc = c & 31, ob = rr * 64 + cc * 2; return st * 1024 + (ob ^ (((ob >> 9) & 1) << 5)); }
__host__ __device__ __forceinline__ void stage_rc(int b, int& R, int& C) { const int st = b / 1024, sb = b % 1024, swz = sb ^ (((sb >> 9) & 1) << 5); R = (st >> 1) * 16 + swz / 64; C = (st & 1) * 32 + (swz % 64) / 2; }
__host__ __device__ __forceinline__ int perm32(int rho) { const int n = rho >> 4, i = rho & 15; return 8 * (i >> 2) + 4 * n + (i & 3); }
struct Unit { int pm, pn; };
struct Gemm { const bf16* A; const bf16* Bt; int M, N, K, lda; };
struct StaticOrder {
    int nM, nN, nwg, G, c, wgm, delay = 0, probe = 0, tid = 0; bool rev; unsigned long long* tsw = nullptr;
    __device__ __forceinline__ void init(int M, int N, int G_, int c_, int wgm_ = WGM, bool rev_ = false) { nM = M / BM; nN = N / BM; nwg = nM * nN; G = G_; c = c_; wgm = wgm_; rev = rev_; }
    __device__ __forceinline__ bool next(int i, Unit& u) const {
        const long L = (long)i * G + c; if (L >= nwg) return false;
        int wgid = (int)L; { const int q = nwg / NXCD, r = nwg % NXCD, xcd = wgid % NXCD, off = wgid / NXCD; wgid = (xcd < r ? xcd * (q + 1) : r * (q + 1) + (xcd - r) * q) + off; }
        const int nig = wgm * nN, gid = wgid / nig, fm = gid * wgm, gsz = (nM - fm) < wgm ? (nM - fm) : wgm;
        u.pm = fm + ((wgid % nig) % gsz); u.pn = (wgid % nig) / gsz; if (rev) u.pm = nM - 1 - u.pm; return true;
    }
};
template <class Epi>
__device__ __forceinline__ void gemm_phase(LAS unsigned char* lds, const Gemm g, const StaticOrder& S, const Epi& E) {
    int tid = S.tid; asm volatile("" : "+v"(tid));
    const int wid = __builtin_amdgcn_readfirstlane(tid >> 6), lane = tid & 63, wr = wid >> 2, wc = wid & 3, fr = lane & 15, fq = lane >> 4;
    const int K = g.K, nt = K / BK;
    unsigned voffA[2], voffB[2];
#pragma unroll
    for (int i = 0; i < 2; ++i) { int R, C; stage_rc(tid * 16 + i * 8192, R, C); const int Rb = Epi::PERM ? ((R & ~31) + perm32(R & 31)) : R;
        voffA[i] = (unsigned)(R * g.lda + C) * 2u; voffB[i] = (unsigned)(Rb * K + C) * 2u; }
    const size_t kstep = (size_t)(BK * 2);
    const size_t hstepA = (size_t)HALF * g.lda * 2, hstepB = (size_t)HALF * K * 2;
    const size_t tstepA = 2 * hstepA, tstepB = 2 * hstepB;
    const unsigned ldsbase = (unsigned)__builtin_amdgcn_readfirstlane((unsigned)(uintptr_t)lds + (unsigned)wid * 1024u);
    const int aoff = lds_byte(wr * 64 + fr, fq * 8), boff = lds_byte(wc * 32 + fr, fq * 8);
#define PG8_SA(b, h) (((b) * 2 + (h)) * HTB)
#define PG8_SB(b, h) ((4 + (b) * 2 + (h)) * HTB)
#define PG8_STAGE(bufoff, gbase, voff) do { const char* _gb = uni_ptr(gbase); _Pragma("unroll") for (int _i = 0; _i < 2; ++_i) \
        glds16_s(_gb, (voff)[_i], ldsbase + (unsigned)((bufoff) + _i * 8192)); } while (0)
#define PG8_LDA(dst, b, h) do { _Pragma("unroll") for (int m = 0; m < 4; ++m) _Pragma("unroll") for (int k = 0; k < 2; ++k) dst[m][k] = *(const LAS bf16x8*)(lds + PG8_SA(b, h) + aoff + m * 2048 + k * 1024); } while (0)
#define PG8_LDB(dst, b, h) do { _Pragma("unroll") for (int n = 0; n < 2; ++n) _Pragma("unroll") for (int k = 0; k < 2; ++k) dst[n][k] = *(const LAS bf16x8*)(lds + PG8_SB(b, h) + boff + n * 2048 + k * 1024); } while (0)
#define PG8_MMA(ai, bj, At, Bt) do { __builtin_amdgcn_s_setprio(1); _Pragma("unroll") for (int m = 0; m < 4; ++m) _Pragma("unroll") for (int n = 0; n < 2; ++n) _Pragma("unroll") for (int k = 0; k < 2; ++k) \
        acc[ai][bj][m][n] = __builtin_amdgcn_mfma_f32_16x16x32_bf16(Bt[n][k], At[m][k], acc[ai][bj][m][n], 0, 0, 0); __builtin_amdgcn_s_setprio(0); } while (0)
#define PG8_WAIT_V(n) asm volatile("s_waitcnt vmcnt(" #n ")" ::: "memory")
#define PG8_WAIT_L(n) asm volatile("s_waitcnt lgkmcnt(" #n ")" ::: "memory")
#define PG8_BAR __builtin_amdgcn_s_barrier()
#define PG8_SCHED __builtin_amdgcn_sched_barrier(0)
    Unit cur, nxt; int ui = 0;
    if (!S.next(0, cur)) return;
    if (S.delay) { const unsigned long long t0 = __builtin_amdgcn_s_memrealtime(); while (__builtin_amdgcn_s_memrealtime() - t0 < (unsigned long long)S.delay) __builtin_amdgcn_s_sleep(8); }
#if MK_STAGGER
    if (S.c & 1) {
        const unsigned long long t0 = __builtin_amdgcn_s_memrealtime(); const unsigned long long dt = (unsigned long long)nt * MK_STAGGER;
        while (__builtin_amdgcn_s_memrealtime() - t0 < dt) __builtin_amdgcn_s_sleep(8);
    }
#endif
    f32x4 acc[2][2][4][2];
#pragma unroll
    for (int a = 0; a < 2; ++a)
#pragma unroll
        for (int b = 0; b < 2; ++b)
#pragma unroll
            for (int m = 0; m < 4; ++m)
#pragma unroll
                for (int n = 0; n < 2; ++n) acc[a][b][m][n] = (f32x4){0.f, 0.f, 0.f, 0.f};
    bf16x8 At[4][2], B0[2][2], B1[2][2];
    const char* cA = (const char*)g.A + (size_t)cur.pm * tstepA; const char* cB = (const char*)g.Bt + (size_t)cur.pn * tstepB;
    PG8_STAGE(PG8_SB(0, 0), cB, voffB); PG8_STAGE(PG8_SB(0, 1), cB + hstepB, voffB); PG8_STAGE(PG8_SA(0, 0), cA, voffA); PG8_STAGE(PG8_SA(0, 1), cA + hstepA, voffA);
    if (wr == 1) PG8_BAR;
    PG8_WAIT_V(2); PG8_BAR;
    PG8_STAGE(PG8_SB(1, 0), cB + kstep, voffB); PG8_STAGE(PG8_SA(1, 0), cA + kstep, voffA); PG8_STAGE(PG8_SB(1, 1), cB + hstepB + kstep, voffB);
    PG8_WAIT_V(6); PG8_BAR;
#if PROBE_TS
    unsigned long long pt_loop = 0, pt_epi = 0, pt_n = 0, pt_t0 = __builtin_amdgcn_s_memrealtime();
#endif
    for (;;) {
        const bool has_next = S.next(ui + 1, nxt);
        const char* nA = has_next ? (const char*)g.A + (size_t)nxt.pm * tstepA : cA; const char* nB = has_next ? (const char*)g.Bt + (size_t)nxt.pn * tstepB : cB;
        for (int t = 0; t < nt; t += 2) {
            const bool last = (t == nt - 2);
            const char* a1 = cA + (size_t)(t + 1) * kstep;
            const char* a2 = last ? nA : cA + (size_t)(t + 2) * kstep; const char* b2 = last ? nB : cB + (size_t)(t + 2) * kstep;
            const char* a3 = a2 + kstep; const char* b3 = b2 + kstep;
            PG8_LDB(B0, 0, 0); PG8_LDB(B1, 0, 1); PG8_SCHED; PG8_LDA(At, 0, 0); PG8_STAGE(PG8_SA(1, 1), a1 + hstepA, voffA);
            PG8_WAIT_V(8); PG8_WAIT_L(0); PG8_BAR; PG8_MMA(0, 0, At, B0); PG8_MMA(0, 1, At, B1); PG8_BAR; PG8_SCHED;
            PG8_LDA(At, 0, 1); PG8_STAGE(PG8_SB(0, 0), b2, voffB); PG8_STAGE(PG8_SB(0, 1), b2 + hstepB, voffB); PG8_STAGE(PG8_SA(0, 0), a2, voffA);
            PG8_WAIT_V(8); PG8_WAIT_L(0); PG8_BAR; PG8_MMA(1, 0, At, B0); PG8_MMA(1, 1, At, B1); PG8_BAR; PG8_SCHED;
            PG8_LDB(B0, 1, 0); PG8_LDB(B1, 1, 1); PG8_SCHED; PG8_LDA(At, 1, 0); PG8_STAGE(PG8_SA(0, 1), a2 + hstepA, voffA);
            PG8_WAIT_V(8); PG8_WAIT_L(0); PG8_BAR; PG8_MMA(0, 0, At, B0); PG8_MMA(0, 1, At, B1); PG8_BAR; PG8_SCHED;
            PG8_LDA(At, 1, 1); PG8_STAGE(PG8_SB(1, 0), b3, voffB); PG8_STAGE(PG8_SB(1, 1), b3 + hstepB, voffB); PG8_STAGE(PG8_SA(1, 0), a3, voffA);
            PG8_WAIT_V(8); PG8_WAIT_L(0); PG8_BAR; PG8_MMA(1, 0, At, B0); PG8_MMA(1, 1, At, B1); PG8_BAR; PG8_SCHED;
        }
        if (wr == 0) PG8_BAR;
#if PROBE_TS
        const unsigned long long pt_t1 = __builtin_amdgcn_s_memrealtime();
#endif
        E(acc, cur, wr, wc, fr, fq);
#if PROBE_TS
        { asm volatile("s_waitcnt vmcnt(0)" ::: "memory"); const unsigned long long pt_t2 = __builtin_amdgcn_s_memrealtime(); pt_loop += pt_t1 - pt_t0; pt_epi += pt_t2 - pt_t1; pt_n += 1; pt_t0 = pt_t2; }
#endif
#if PROBE_EPI2
        if (Epi::PROBE2) E(acc, cur, wr, wc, fr, fq);
#endif
        if (!has_next) break;
#pragma unroll
        for (int a = 0; a < 2; ++a)
#pragma unroll
            for (int b = 0; b < 2; ++b)
#pragma unroll
                for (int m = 0; m < 4; ++m)
#pragma unroll
                    for (int n = 0; n < 2; ++n) acc[a][b][m][n] = (f32x4){0.f, 0.f, 0.f, 0.f};
        cur = nxt; cA = nA; cB = nB; ++ui;
        if (wr == 1) PG8_BAR;
    }
    PG8_WAIT_V(0);
    PG8_BAR;
#if PROBE_TS
    if (S.probe && S.c == 0 && tid == 0) { unsigned long long* tw = S.tsw + 90 + 3 * (S.probe - 1); tw[0] += pt_loop; tw[1] += pt_epi; tw[2] += pt_n; }
    if (S.probe == TS_SKEW_ID && tid == 0) { const unsigned long long dur = pt_loop + pt_epi; atomicMax(S.tsw + 120, dur); atomicMin(S.tsw + 121, dur); atomicAdd(S.tsw + 122, dur); }
#endif
#undef PG8_SA
#undef PG8_SB
#undef PG8_STAGE
#undef PG8_LDA
#undef PG8_LDB
#undef PG8_MMA
#undef PG8_WAIT_V
#undef PG8_WAIT_L
#undef PG8_BAR
#undef PG8_SCHED
}
}
using pg8::Unit;

__device__ __forceinline__ int slack_delay(int nwg, int G, int c, int unit_ticks) {
    const int rem = nwg % G; if (rem == 0 || c < rem) return 0;
    return (int)(((long long)(c - rem) * unit_ticks * 4) / ((long long)(G - rem) * 5));
}
__device__ __forceinline__ u32x4 pack8(const f32x4 a, const f32x4 b) { u32x4 w; w.x = cvt_pk_bf16(a[0], a[1]); w.y = cvt_pk_bf16(a[2], a[3]); w.z = cvt_pk_bf16(b[0], b[1]); w.w = cvt_pk_bf16(b[2], b[3]); return w; }
__device__ __forceinline__ f32x4 rot2(const f32x4 v, const f32x4 cs) { f32x4 o; o[0] = v[0] * cs[0] - v[1] * cs[1]; o[1] = v[1] * cs[0] + v[0] * cs[1]; o[2] = v[2] * cs[2] - v[3] * cs[3]; o[3] = v[3] * cs[2] + v[2] * cs[3]; return o; }

__device__ __forceinline__ f32x4 mla_cs(const float* tabm, int t, int c4) {
    const int p0 = c4 >> 1; const int pos = (p0 < 16) ? (t >> 6) : (t & 63); const int f = p0 & 15;
    return *(const f32x4*)(tabm + ((size_t)pos * 16 + f) * 2);
}

struct EpiG1 {
    static constexpr bool PERM = true, PROBE2 = false;
    bf16* QKVL; float* SSQ; bf16* KR; const float* tabm;
    __device__ __forceinline__ void operator()(const f32x4 (&acc)[2][2][4][2], const Unit& u, int wr, int wc, int fr, int fq) const {
        const int row0 = u.pm * 256 + wr * 64 + fr;
        if (u.pn < 4) {
            const int col0 = u.pn * 256 + wc * 32 + 8 * fq;
#pragma unroll
            for (int ai = 0; ai < 2; ++ai)
#pragma unroll
                for (int m = 0; m < 4; ++m) { const int row = row0 + ai * 128 + m * 16; float ss = 0.f;
#pragma unroll
                    for (int bj = 0; bj < 2; ++bj) { const f32x4 v0 = acc[ai][bj][m][0], v1 = acc[ai][bj][m][1];
                        ss += (v0[0] * v0[0] + v0[1] * v0[1]) + (v0[2] * v0[2] + v0[3] * v0[3]) + (v1[0] * v1[0] + v1[1] * v1[1]) + (v1[2] * v1[2] + v1[3] * v1[3]);
                        *(u32x4*)(QKVL + (size_t)row * N1 + col0 + bj * 128) = pack8(v0, v1); }
                    { const int ln_ = fr + 16 * fq; ss += shfl_xor_l(ss, 16, ln_); ss += shfl_xor_l(ss, 32, ln_); }
                    if (fq == 0) SSQ[(size_t)row * 16 + u.pn * 4 + wc] = ss; asm volatile("" ::: "memory"); }
        } else if (wc < 2) {
            const int c8 = wc * 32 + 8 * fq;
#pragma unroll
            for (int ai = 0; ai < 2; ++ai)
#pragma unroll
                for (int m = 0; m < 4; ++m) { const int row = row0 + ai * 128 + m * 16; f32x4 v0 = acc[ai][0][m][0], v1 = acc[ai][0][m][1];
                    if (row < MX) { const int t = row & (SEQ - 1); v0 = rot2(v0, mla_cs(tabm, t, c8)); v1 = rot2(v1, mla_cs(tabm, t, c8 + 4)); }
                    *(u32x4*)(KR + (size_t)row * 64 + c8) = pack8(v0, v1); asm volatile("" ::: "memory"); }
        }
    }
};
struct EpiUq {
    static constexpr bool PERM = true, PROBE2 = false;
    bf16* Q; const float* SSQ; const float* tabm;
    __device__ __forceinline__ void operator()(const f32x4 (&acc)[2][2][4][2], const Unit& u, int wr, int wc, int fr, int fq) const {
        const int row0 = u.pm * 256 + wr * 64 + fr;
        int col8[2], dd[2];
#pragma unroll
        for (int bj = 0; bj < 2; ++bj) { col8[bj] = u.pn * 256 + bj * 128 + wc * 32 + 8 * fq; dd[bj] = col8[bj] % DQ; }
#pragma unroll
        for (int ai = 0; ai < 2; ++ai)
#pragma unroll
            for (int m = 0; m < 4; ++m) { const int row = row0 + ai * 128 + m * 16;
                const f32x4 s0 = *(const f32x4*)(SSQ + (size_t)row * 16), s1 = *(const f32x4*)(SSQ + (size_t)row * 16 + 4);
                const float ss = ((s0[0] + s0[1]) + (s0[2] + s0[3])) + ((s1[0] + s1[1]) + (s1[2] + s1[3]));
                const float r = 1.0f / sqrtf(ss * (1.0f / QR) + NORM_EPS);
#pragma unroll
                for (int bj = 0; bj < 2; ++bj) { f32x4 v0 = acc[ai][bj][m][0] * r, v1 = acc[ai][bj][m][1] * r;
                    if (dd[bj] >= NOPE && row < MX) { const int t = row & (SEQ - 1), c8 = dd[bj] - NOPE; v0 = rot2(v0, mla_cs(tabm, t, c8)); v1 = rot2(v1, mla_cs(tabm, t, c8 + 4)); }
                    *(u32x4*)(Q + (size_t)row * 3072 + col8[bj]) = pack8(v0, v1); } asm volatile("" ::: "memory"); }
    }
};
struct EpiUkv {
    static constexpr bool PERM = true, PROBE2 = false;
    bf16* KV; const float* SSQ;
    __device__ __forceinline__ void operator()(const f32x4 (&acc)[2][2][4][2], const Unit& u, int wr, int wc, int fr, int fq) const {
        const int row0 = u.pm * 256 + wr * 64 + fr; const int col0 = u.pn * 256 + wc * 32 + 8 * fq;
#pragma unroll
        for (int ai = 0; ai < 2; ++ai)
#pragma unroll
            for (int m = 0; m < 4; ++m) { const int row = row0 + ai * 128 + m * 16;
                const f32x4 s0 = *(const f32x4*)(SSQ + (size_t)row * 16 + 8), s1 = *(const f32x4*)(SSQ + (size_t)row * 16 + 12);
                const float ss = ((s0[0] + s0[1]) + (s0[2] + s0[3])) + ((s1[0] + s1[1]) + (s1[2] + s1[3]));
                const float r = 1.0f / sqrtf(ss * (1.0f / KVR) + NORM_EPS);
#pragma unroll
                for (int bj = 0; bj < 2; ++bj) *(u32x4*)(KV + (size_t)row * 4096 + col0 + bj * 128) = pack8(acc[ai][bj][m][0] * r, acc[ai][bj][m][1] * r); asm volatile("" ::: "memory"); }
    }
};
struct EpiResid {
    static constexpr bool PERM = true, PROBE2 = false;
    const void* xin; void* xout; const void* cin; void* cout; const float* modv; int gofs; bool base_f32, out_f32;
    __device__ __forceinline__ void operator()(const f32x4 (&acc)[2][2][4][2], const Unit& u, int wr, int wc, int fr, int fq) const {
        const bool isx = u.pm < (MX / 256);
        const int rloc = (isx ? u.pm * 256 : (u.pm * 256 - MX)) + wr * 64 + fr;
        const void* base = isx ? xin : cin; void* out = isx ? xout : cout;
        const float* gv = modv + (size_t)(isx ? (u.pm >> 4) : 8) * NMOD + gofs;
        const int col0 = u.pn * 256 + wc * 32 + 8 * fq;
        f32x4 g4[2][2];
#pragma unroll
        for (int bj = 0; bj < 2; ++bj)
#pragma unroll
            for (int n = 0; n < 2; ++n) g4[bj][n] = *(const f32x4*)(gv + col0 + bj * 128 + n * 4);
        if (base_f32) {
            f32x4 pre[3][2][2];
#define RES_LOAD(G_, SLOT_) do { const size_t off_ = (size_t)(rloc + ((G_) >> 2) * 128 + ((G_) & 3) * 16) * D + col0; \
                _Pragma("unroll") for (int bj = 0; bj < 2; ++bj) _Pragma("unroll") for (int n = 0; n < 2; ++n) pre[SLOT_][bj][n] = *(const f32x4*)((const float*)base + off_ + bj * 128 + n * 4); } while (0)
            RES_LOAD(0, 0); RES_LOAD(1, 1); RES_LOAD(2, 2);
#pragma unroll
            for (int g = 0; g < 8; ++g) { const int ai = g >> 2, m = g & 3; const size_t off = (size_t)(rloc + ai * 128 + m * 16) * D + col0;
#pragma unroll
                for (int bj = 0; bj < 2; ++bj) { const f32x4 x0 = pre[g % 3][bj][0] + g4[bj][0] * acc[ai][bj][m][0], x1 = pre[g % 3][bj][1] + g4[bj][1] * acc[ai][bj][m][1];
                    *(u32x4*)((bf16*)out + off + bj * 128) = pack8(x0, x1); }
                asm volatile("" ::: "memory");
                if (g + 3 < 8) RES_LOAD(g + 3, g % 3); }
#undef RES_LOAD
        } else {
            u32x4 pre[3][2];
#define RES_LOAD(G_, SLOT_) do { const size_t off_ = (size_t)(rloc + ((G_) >> 2) * 128 + ((G_) & 3) * 16) * D + col0; \
                _Pragma("unroll") for (int bj = 0; bj < 2; ++bj) pre[SLOT_][bj] = *(const u32x4*)((const bf16*)base + off_ + bj * 128); } while (0)
            RES_LOAD(0, 0); RES_LOAD(1, 1); RES_LOAD(2, 2);
#pragma unroll
            for (int g = 0; g < 8; ++g) { const int ai = g >> 2, m = g & 3; const size_t off = (size_t)(rloc + ai * 128 + m * 16) * D + col0;
#pragma unroll
                for (int bj = 0; bj < 2; ++bj) { const u32x4 pb = pre[g % 3][bj];
                    const f32x4 b0 = {bflo(pb.x), bfhi(pb.x), bflo(pb.y), bfhi(pb.y)}, b1 = {bflo(pb.z), bfhi(pb.z), bflo(pb.w), bfhi(pb.w)};
                    const f32x4 x0 = b0 + g4[bj][0] * acc[ai][bj][m][0], x1 = b1 + g4[bj][1] * acc[ai][bj][m][1];
                    if (out_f32) { *(f32x4*)((float*)out + off + bj * 128) = x0; *(f32x4*)((float*)out + off + bj * 128 + 4) = x1; }
                    else *(u32x4*)((bf16*)out + off + bj * 128) = pack8(x0, x1); }
                asm volatile("" ::: "memory");
                if (g + 3 < 8) RES_LOAD(g + 3, g % 3); }
#undef RES_LOAD
        }
    }
};
template <int CTRL> __device__ __forceinline__ float dpp1(float x) { return __int_as_float(__builtin_amdgcn_update_dpp(0, __float_as_int(x), CTRL, 0xF, 0xF, false)); }
__device__ __forceinline__ f32x4 row_prev(const f32x4 v) { f32x4 o; o.x = dpp1<0x121>(v.x); o.y = dpp1<0x121>(v.y); o.z = dpp1<0x121>(v.z); o.w = dpp1<0x121>(v.w); return o; }
__device__ __forceinline__ f32x4 row_next(const f32x4 v) { f32x4 o; o.x = dpp1<0x12F>(v.x); o.y = dpp1<0x12F>(v.y); o.z = dpp1<0x12F>(v.z); o.w = dpp1<0x12F>(v.w); return o; }
__device__ __forceinline__ f32x4 silu4(const f32x4 v) { f32x4 o;
#pragma unroll
    for (int e = 0; e < 4; ++e) o[e] = fast_silu(v[e]); return o; }
constexpr size_t HALO_STRIDE = (size_t)FF;
struct EpiGUConv {
    static constexpr bool PERM = true, PROBE2 = true;
    bf16* ACT; float* HALO; const float* cw; const float* cb; LAS float* edge;
    __device__ __forceinline__ void operator()(const f32x4 (&acc)[2][2][4][2], const Unit& u, int wr, int wc, int fr, int fq) const {
        const int c8 = wc * 32 + 8 * fq; const int f0 = u.pn * 128 + c8;
#pragma unroll
        for (int ai = 0; ai < 2; ++ai) { const int blk = 2 * ai + wr;
            if (fr == 0)  { *(LAS f32x4*)(edge + (blk * 2 + 0) * 128 + c8) = acc[ai][0][0][0]; *(LAS f32x4*)(edge + (blk * 2 + 0) * 128 + c8 + 4) = acc[ai][0][0][1]; }
            if (fr == 15) { *(LAS f32x4*)(edge + (blk * 2 + 1) * 128 + c8) = acc[ai][0][3][0]; *(LAS f32x4*)(edge + (blk * 2 + 1) * 128 + c8 + 4) = acc[ai][0][3][1]; } }
        asm volatile("s_waitcnt lgkmcnt(0)" ::: "memory"); __builtin_amdgcn_s_barrier(); asm volatile("" ::: "memory");
        f32x4 w0[2], w1[2], w2[2], bb[2];
#pragma unroll
        for (int n = 0; n < 2; ++n) { w0[n] = *(const f32x4*)(cw + f0 + 4 * n); w1[n] = *(const f32x4*)(cw + FF + f0 + 4 * n); w2[n] = *(const f32x4*)(cw + 2 * FF + f0 + 4 * n); bb[n] = *(const f32x4*)(cb + f0 + 4 * n); }
        const f32x4 zero4 = {0.f, 0.f, 0.f, 0.f};
#pragma unroll
        for (int ai = 0; ai < 2; ++ai) { const int blk = 2 * ai + wr;
#pragma unroll
            for (int m = 0; m < 4; ++m) { const int row = u.pm * 256 + ai * 128 + wr * 64 + m * 16 + fr; f32x4 o[2];
#pragma unroll
                for (int n = 0; n < 2; ++n) { const f32x4 cur = acc[ai][0][m][n];
                    f32x4 b, d;
                    if (m > 0) b = row_prev(acc[ai][0][m - 1][n]); else b = (blk > 0) ? *(const LAS f32x4*)(edge + ((blk - 1) * 2 + 1) * 128 + c8 + 4 * n) : zero4;
                    if (m < 3) d = row_next(acc[ai][0][m + 1][n]); else d = (blk < 3) ? *(const LAS f32x4*)(edge + ((blk + 1) * 2 + 0) * 128 + c8 + 4 * n) : zero4;
                    const f32x4 a = row_prev(cur), c = row_next(cur);
                    const f32x4 up = (fr == 0) ? b : a, dn = (fr == 15) ? d : c;
                    const f32x4 cv = w0[n] * up + w1[n] * cur + w2[n] * dn + bb[n]; const f32x4 uu = acc[ai][1][m][n];
                    o[n] = silu4(cv) * uu;
                    if (m == 0 && blk == 0 && fr == 0) { float* hp = HALO + (size_t)((u.pm * 2 + 0) * 3) * HALO_STRIDE + f0 + 4 * n; *(f32x4*)hp = cv; *(f32x4*)(hp + HALO_STRIDE) = cur; *(f32x4*)(hp + 2 * HALO_STRIDE) = uu; }
                    if (m == 3 && blk == 3 && fr == 15) { float* hp = HALO + (size_t)((u.pm * 2 + 1) * 3) * HALO_STRIDE + f0 + 4 * n; *(f32x4*)hp = cv; *(f32x4*)(hp + HALO_STRIDE) = cur; *(f32x4*)(hp + 2 * HALO_STRIDE) = uu; } }
                *(u32x4*)(ACT + (size_t)row * FF + f0) = pack8(o[0], o[1]); asm volatile("" ::: "memory"); } }
        asm volatile("s_waitcnt lgkmcnt(0)" ::: "memory"); __builtin_amdgcn_s_barrier(); asm volatile("" ::: "memory");
    }
};
struct EpiQKV {
    static constexpr bool PERM = true, PROBE2 = false;
    bf16* QKV; const float* tabr;
    __device__ __forceinline__ void operator()(const f32x4 (&acc)[2][2][4][2], const Unit& u, int wr, int wc, int fr, int fq) const {
        const int row0 = u.pm * 256 + wr * 64 + fr; const int col0 = u.pn * 256 + wc * 32 + 8 * fq;
        const bool rope = (u.pn < 16) && (u.pm < MX / 256);
        if (rope) {
            f32x4 pt[2][2][2];
#define ROPE_LOAD(G_, SLOT_) do { const int t_ = (row0 + ((G_) >> 2) * 128 + ((G_) & 3) * 16) & (SEQ - 1); \
                _Pragma("unroll") for (int bj = 0; bj < 2; ++bj) { const float* tp_ = tabr + ((size_t)t_ * 128 + (((col0 + bj * 128) & 255) >> 1)) * 2; pt[SLOT_][bj][0] = *(const f32x4*)tp_; pt[SLOT_][bj][1] = *(const f32x4*)(tp_ + 4); } } while (0)
            ROPE_LOAD(0, 0); ROPE_LOAD(1, 1);
#pragma unroll
            for (int g = 0; g < 8; ++g) { const int ai = g >> 2, m = g & 3; const int row = row0 + ai * 128 + m * 16;
#pragma unroll
                for (int bj = 0; bj < 2; ++bj) { const f32x4 v0 = rot2(acc[ai][bj][m][0], pt[g & 1][bj][0]), v1 = rot2(acc[ai][bj][m][1], pt[g & 1][bj][1]);
                    *(u32x4*)(QKV + (size_t)row * 8192 + col0 + bj * 128) = pack8(v0, v1); }
                asm volatile("" ::: "memory");
                if (g + 2 < 8) ROPE_LOAD(g + 2, g & 1); }
#undef ROPE_LOAD
        } else {
#pragma unroll
            for (int ai = 0; ai < 2; ++ai)
#pragma unroll
                for (int m = 0; m < 4; ++m) { const int row = row0 + ai * 128 + m * 16;
#pragma unroll
                    for (int bj = 0; bj < 2; ++bj) *(u32x4*)(QKV + (size_t)row * 8192 + col0 + bj * 128) = pack8(acc[ai][bj][m][0], acc[ai][bj][m][1]);
                    asm volatile("" ::: "memory"); }
        }
    }
};
struct EpiGate {
    static constexpr bool PERM = true, PROBE2 = false;
    bf16* GATED; const bf16* YF; const bf16* YB; const float* STF; const float* STB;
    __device__ __forceinline__ void operator()(const f32x4 (&acc)[2][2][4][2], const Unit& u, int wr, int wc, int fr, int fq) const {
        const int row0 = u.pm * 256 + wr * 64 + fr; const int f0 = u.pn * 128 + wc * 32 + 8 * fq; const int hd = u.pn >> 2;
        u32x4 pyf[3], pyb[3]; f32x4 ppf[3], ppb[3];
#define GATE_LOAD(G_, SLOT_) do { const int row_ = row0 + ((G_) >> 2) * 128 + ((G_) & 3) * 16; const size_t off_ = (size_t)row_ * 4096 + f0; \
            pyf[SLOT_] = *(const u32x4*)(YF + off_); pyb[SLOT_] = *(const u32x4*)(YB + off_); \
            ppf[SLOT_] = *(const f32x4*)(STF + ((size_t)row_ * 8 + hd) * 4); ppb[SLOT_] = *(const f32x4*)(STB + ((size_t)row_ * 8 + hd) * 4); } while (0)
        GATE_LOAD(0, 0); GATE_LOAD(1, 1); GATE_LOAD(2, 2);
#pragma unroll
        for (int g = 0; g < 8; ++g) { const int ai = g >> 2, m = g & 3; const int row = row0 + ai * 128 + m * 16; const size_t off = (size_t)row * 4096 + f0;
                const u32x4 yf = pyf[g % 3], yb = pyb[g % 3]; const f32x4 pf = ppf[g % 3], pb = ppb[g % 3];
                f32x2 sf, sb;
                sf[0] = (pf[0] + pf[2]) * (1.0f / RDV); sf[1] = __builtin_amdgcn_rsqf(fmaxf((pf[1] + pf[3]) * (1.0f / RDV) - sf[0] * sf[0], 0.f) + GN_EPS);
                sb[0] = (pb[0] + pb[2]) * (1.0f / RDV); sb[1] = __builtin_amdgcn_rsqf(fmaxf((pb[1] + pb[3]) * (1.0f / RDV) - sb[0] * sb[0], 0.f) + GN_EPS);
                const f32x4 a0 = acc[ai][0][m][0], a1 = acc[ai][0][m][1], b0 = acc[ai][1][m][0], b1 = acc[ai][1][m][1];
#define NF(w, hi_) (((hi_ ? bfhi(w) : bflo(w)) - sf[0]) * sf[1])
#define NB(w, hi_) (((hi_ ? bfhi(w) : bflo(w)) - sb[0]) * sb[1])
                f32x4 o0, o1;
                o0[0] = fast_silu(a0[0]) * NF(yf.x, 0) + fast_silu(b0[0]) * NB(yb.x, 0); o0[1] = fast_silu(a0[1]) * NF(yf.x, 1) + fast_silu(b0[1]) * NB(yb.x, 1);
                o0[2] = fast_silu(a0[2]) * NF(yf.y, 0) + fast_silu(b0[2]) * NB(yb.y, 0); o0[3] = fast_silu(a0[3]) * NF(yf.y, 1) + fast_silu(b0[3]) * NB(yb.y, 1);
                o1[0] = fast_silu(a1[0]) * NF(yf.z, 0) + fast_silu(b1[0]) * NB(yb.z, 0); o1[1] = fast_silu(a1[1]) * NF(yf.z, 1) + fast_silu(b1[1]) * NB(yb.z, 1);
                o1[2] = fast_silu(a1[2]) * NF(yf.w, 0) + fast_silu(b1[2]) * NB(yb.w, 0); o1[3] = fast_silu(a1[3]) * NF(yf.w, 1) + fast_silu(b1[3]) * NB(yb.w, 1);
#undef NF
#undef NB
                *(u32x4*)(GATED + off) = pack8(o0, o1); asm volatile("" ::: "memory");
                if (g + 3 < 8) GATE_LOAD(g + 3, g % 3); }
#undef GATE_LOAD
    }
};

namespace att {
constexpr int NW = 8, QBLK = 32, KVBLK = 64;
constexpr int SHM_V = 16384, SHM_KN = 16384, SHM_KR = 8192;
constexpr int OFF_V = 0, OFF_KN = 3 * SHM_V, OFF_KR = OFF_KN + 2 * SHM_KN, OFF_WS = OFF_KR + 2 * SHM_KR, SHM_ATTN = OFF_WS + NW * 64 * 4;
constexpr float THR2 = 11.5f;
#define KSWZ(row, colB) ((row) * 256 + ((colB) ^ (((row) & 7) << 4)))
#define KRSWZ(row, colB) ((row) * 128 + ((colB) ^ ((((row) >> 1) & 7) << 4)))
#define SBAR() __builtin_amdgcn_sched_barrier(0)
__device__ __forceinline__ int crow(int r, int hi) { return (r & 3) + 8 * (r >> 2) + 4 * hi; }
__device__ __forceinline__ void partialSM(f32x16& p0, f32x16& p1, float& m_reg, float& alpha) {
  float pmax = p0[0];
#pragma unroll
  for (int r = 1; r < 16; ++r) pmax = fmaxf(pmax, p0[r]);
#pragma unroll
  for (int r = 0; r < 16; ++r) pmax = fmaxf(pmax, p1[r]);
  { auto rr = __builtin_amdgcn_permlane32_swap(__float_as_uint(pmax), __float_as_uint(pmax), false, false); pmax = fmaxf(__uint_as_float(rr[0]), __uint_as_float(rr[1])); }
  float mn;
  if (__builtin_expect(__all(pmax - m_reg <= THR2), 1)) { mn = m_reg; alpha = 1.f; }
  else { mn = fmaxf(m_reg, pmax); alpha = __builtin_amdgcn_exp2f(m_reg - mn); m_reg = mn; }
#pragma unroll
  for (int r = 0; r < 16; ++r) p0[r] = p0[r] - mn;
#pragma unroll
  for (int r = 0; r < 16; ++r) p1[r] = p1[r] - mn;
#pragma unroll
  for (int r = 0; r < 16; ++r) p0[r] = __builtin_amdgcn_exp2f(p0[r]);
}
__device__ __forceinline__ void finishSM(f32x16& p0, f32x16& p1, float alpha, float& l_reg, bf16x8& pa0, bf16x8& pa1, bf16x8& pa2, bf16x8& pa3) {
#pragma unroll
  for (int r = 0; r < 16; ++r) p1[r] = __builtin_amdgcn_exp2f(p1[r]);
  float ps = 0;
#pragma unroll
  for (int r = 0; r < 16; ++r) ps += p0[r];
#pragma unroll
  for (int r = 0; r < 16; ++r) ps += p1[r];
  { auto rr = __builtin_amdgcn_permlane32_swap(__float_as_uint(ps), __float_as_uint(ps), false, false); ps = __uint_as_float(rr[0]) + __uint_as_float(rr[1]); }
  l_reg = l_reg * alpha + ps;
#define PK4(P, BASE, OUT) do { unsigned a0 = cvt_pk_bf16(P[BASE + 0], P[BASE + 1]), a1 = cvt_pk_bf16(P[BASE + 2], P[BASE + 3]);   \
    unsigned b0 = cvt_pk_bf16(P[BASE + 4], P[BASE + 5]), b1 = cvt_pk_bf16(P[BASE + 6], P[BASE + 7]);                              \
    auto r0 = __builtin_amdgcn_permlane32_swap(a0, b0, false, false); auto r1 = __builtin_amdgcn_permlane32_swap(a1, b1, false, false); \
    u32x4 w = {r0[0], r1[0], r0[1], r1[1]}; OUT = __builtin_bit_cast(bf16x8, w); } while (0)
  PK4(p0, 0, pa0); PK4(p0, 8, pa1); PK4(p1, 0, pa2); PK4(p1, 8, pa3);
#undef PK4
}
__device__ __forceinline__ void qkt(f32x16& p0, f32x16& p1, const char* Kn, const char* Kr, const bf16x8* qr, int r32, int hi) {
  p0 = f32x16{}; p1 = f32x16{};
#pragma unroll
  for (int d0 = 0; d0 < 8; ++d0) { const int cb = (d0 * 16 + hi * 8) * 2;
    const bf16x8 b0 = *reinterpret_cast<const bf16x8*>(Kn + KSWZ(r32, cb));
    const bf16x8 b1 = *reinterpret_cast<const bf16x8*>(Kn + KSWZ(32 + r32, cb));
    p0 = __builtin_amdgcn_mfma_f32_32x32x16_bf16(b0, qr[d0], p0, 0, 0, 0);
    p1 = __builtin_amdgcn_mfma_f32_32x32x16_bf16(b1, qr[d0], p1, 0, 0, 0); }
#pragma unroll
  for (int d0 = 0; d0 < 4; ++d0) { const int cb = (d0 * 16 + hi * 8) * 2;
    const bf16x8 b0 = *reinterpret_cast<const bf16x8*>(Kr + KRSWZ(r32, cb));
    const bf16x8 b1 = *reinterpret_cast<const bf16x8*>(Kr + KRSWZ(32 + r32, cb));
    p0 = __builtin_amdgcn_mfma_f32_32x32x16_bf16(b0, qr[8 + d0], p0, 0, 0, 0);
    p1 = __builtin_amdgcn_mfma_f32_32x32x16_bf16(b1, qr[8 + d0], p1, 0, 0, 0); }
}
__device__ __forceinline__ int v_st(int k, int c) { const int kk = (k & ~0xC) | ((k & 4) << 1) | ((k & 8) >> 1); return ((kk >> 3) * 4 + (c >> 5)) * 512 + ((kk & 7) * 32 + (c & 31)) * 2; }
__device__ __forceinline__ int v_rd_base(int lane) { return ((lane & 3) << 3) | (((lane >> 2) & 3) << 6) | (((lane >> 4) & 1) << 5) | (((lane >> 5) & 1) << 8); }
constexpr int v_rd_off(int d0, int ks, int half) { return d0 * 512 + ks * 4096 + half * 2048; }
template <int OFF> __device__ __forceinline__ s16x4 tr_read(int vb) { s16x4 r; asm volatile("ds_read_b64_tr_b16 %0, %1 offset:%2" : "=&v"(r) : "v"(vb), "i"(OFF) : "memory"); return r; }
template <int D0> __device__ __forceinline__ void pv_one(f32x16& od, int vb, bf16x8 pa0, bf16x8 pa1, bf16x8 pa2, bf16x8 pa3) {
  const s16x4 l0 = tr_read<v_rd_off(D0, 0, 0)>(vb), h0 = tr_read<v_rd_off(D0, 0, 1)>(vb), l1 = tr_read<v_rd_off(D0, 1, 0)>(vb), h1 = tr_read<v_rd_off(D0, 1, 1)>(vb);
  const s16x4 l2 = tr_read<v_rd_off(D0, 2, 0)>(vb), h2 = tr_read<v_rd_off(D0, 2, 1)>(vb), l3 = tr_read<v_rd_off(D0, 3, 0)>(vb), h3 = tr_read<v_rd_off(D0, 3, 1)>(vb);
  asm volatile("s_waitcnt lgkmcnt(0)" ::: "memory"); SBAR();
#define PK(L, H) (bf16x8){L[0], L[1], L[2], L[3], H[0], H[1], H[2], H[3]}
  od = __builtin_amdgcn_mfma_f32_32x32x16_bf16(pa0, PK(l0, h0), od, 0, 0, 0);
  od = __builtin_amdgcn_mfma_f32_32x32x16_bf16(pa1, PK(l1, h1), od, 0, 0, 0);
  od = __builtin_amdgcn_mfma_f32_32x32x16_bf16(pa2, PK(l2, h2), od, 0, 0, 0);
  od = __builtin_amdgcn_mfma_f32_32x32x16_bf16(pa3, PK(l3, h3), od, 0, 0, 0);
#undef PK
}
__device__ __forceinline__ void pv_d0(f32x16* o, int vb, bf16x8 pa0, bf16x8 pa1, bf16x8 pa2, bf16x8 pa3) {
  pv_one<0>(o[0], vb, pa0, pa1, pa2, pa3); pv_one<1>(o[1], vb, pa0, pa1, pa2, pa3); pv_one<2>(o[2], vb, pa0, pa1, pa2, pa3); pv_one<3>(o[3], vb, pa0, pa1, pa2, pa3);
}
__device__ __forceinline__ void attn_unit(const bf16* __restrict__ Qb, const bf16* __restrict__ KVh, const bf16* __restrict__ KRp, bf16* __restrict__ Ob,
                                          int NT, int nc, int cbase, int xbase, char* lds, int tid_in, unsigned long long* ts_words = nullptr) {
  int tid = tid_in; asm volatile("" : "+v"(tid));
  const int wid = __builtin_amdgcn_readfirstlane(tid >> 6), lane = tid & 63, r32 = lane & 31, hi = lane >> 5;
  char* V_lds = lds + OFF_V; char* Kn_lds = lds + OFF_KN; char* Kr_lds = lds + OFF_KR;
  float* ws = (float*)(lds + OFF_WS) + wid * 64; float* li_l = ws; float* al_l = ws + 32;
  float m_reg = -1e30f, l_reg = 0; f32x16 o[4] = {}; bf16x8 qr[12];
  const bf16* Qw = Qb + (long)(wid * QBLK + r32) * 3072 + hi * 8;
#pragma unroll
  for (int d0 = 0; d0 < 12; ++d0) qr[d0] = *reinterpret_cast<const bf16x8*>(Qw + d0 * 16);
  const int vb0 = (int)(uintptr_t)V_lds + v_rd_base(lane);
  unsigned vofK[2], vofV[2], vofR;
#pragma unroll
  for (int i = 0; i < 2; ++i) { const int pc = wid * 2 + i;
      { const int row = pc * 4 + (lane >> 4), ch = (lane & 15) ^ (row & 7); vofK[i] = (unsigned)((row * 4096 + ch * 8) * 2); }
      { const int ob = pc * 1024 + lane * 16, st = ob >> 9, w = ob & 511, kk = (st >> 2) * 8 + (w >> 6); const int k = (kk & ~0xC) | ((kk & 4) << 1) | ((kk & 8) >> 1);
        const int c = (st & 3) * 32 + 8 * ((w & 63) >> 4); vofV[i] = (unsigned)((k * 4096 + 128 + c) * 2); } }
  { const int row = wid * 8 + (lane >> 3), ch = (lane & 7) ^ ((row >> 1) & 7); vofR = (unsigned)((row * 64 + ch * 8) * 2); }
  const unsigned ldsK = (unsigned)__builtin_amdgcn_readfirstlane((unsigned)(uintptr_t)Kn_lds + (unsigned)wid * 2048u);
  const unsigned ldsV = (unsigned)__builtin_amdgcn_readfirstlane((unsigned)(uintptr_t)V_lds + (unsigned)wid * 2048u);
  const unsigned ldsR = (unsigned)__builtin_amdgcn_readfirstlane((unsigned)(uintptr_t)Kr_lds + (unsigned)wid * 1024u);
#define KROW(j) ((j) < nc ? cbase + (j) * KVBLK : xbase + ((j) - nc) * KVBLK)
#define DMA_TILE(j, kslot, vslot) do { const long k0_ = KROW(j); const char* kb_ = uni_ptr(KVh + k0_ * 4096); const char* rb_ = uni_ptr(KRp + k0_ * 64); \
    glds16_s(kb_, vofK[0], ldsK + (kslot) * SHM_KN); glds16_s(kb_, vofK[1], ldsK + (kslot) * SHM_KN + 1024u); \
    glds16_s(rb_, vofR, ldsR + (kslot) * SHM_KR); \
    glds16_s(kb_, vofV[0], ldsV + (vslot) * SHM_V); glds16_s(kb_, vofV[1], ldsV + (vslot) * SHM_V + 1024u); } while (0)
#ifndef ATT_SKEW
#define ATT_SKEW 0
#endif
#if PROBE_TS
#define WAIT_SYNC() do { const unsigned long long w0_ = __builtin_amdgcn_s_memrealtime(); asm volatile("s_waitcnt vmcnt(0)" ::: "memory"); const unsigned long long w1_ = __builtin_amdgcn_s_memrealtime(); __syncthreads(); const unsigned long long w2_ = __builtin_amdgcn_s_memrealtime(); att_w_dma += w1_ - w0_; att_w_bar += w2_ - w1_; } while (0)
#else
#define WAIT_SYNC() do { asm volatile("s_waitcnt vmcnt(0)" ::: "memory"); __syncthreads(); if (ATT_SKEW && wid >= 4) __builtin_amdgcn_s_sleep(ATT_SKEW); } while (0)
#endif
#define RESC(a) do { if (__any((a) < 1.f)) { if (hi == 0) al_l[r32] = (a); asm volatile("s_waitcnt lgkmcnt(0)" ::: "memory"); \
    _Pragma("unroll") for (int d = 0; d < 4; ++d) _Pragma("unroll") for (int r = 0; r < 16; ++r) o[d][r] *= al_l[crow(r, hi)]; } } while (0)
#if PROBE_TS
  unsigned long long att_w_dma = 0, att_w_bar = 0; const unsigned long long att_t0 = __builtin_amdgcn_s_memrealtime();
#endif
  f32x16 pA0, pA1, pB0, pB1; float alA, alB; bf16x8 pa0, pa1, pa2, pa3;
  DMA_TILE(0, 0, 0); DMA_TILE(1, 1, 1); WAIT_SYNC();
  qkt(pA0, pA1, Kn_lds, Kr_lds, qr, r32, hi); partialSM(pA0, pA1, m_reg, alA);
  __syncthreads();
  int vprev = 0, vcur = 1, vnext = 2;
  for (int j = 1; j + 1 < NT; j += 2) {
    DMA_TILE(j + 1, 0, vnext);
    SBAR(); qkt(pB0, pB1, Kn_lds + SHM_KN, Kr_lds + SHM_KR, qr, r32, hi);
    finishSM(pA0, pA1, alA, l_reg, pa0, pa1, pa2, pa3); SBAR();
    pv_d0(o, vb0 + vprev * SHM_V, pa0, pa1, pa2, pa3); partialSM(pB0, pB1, m_reg, alB);
    RESC(alB); WAIT_SYNC();
    { const int t_ = vprev; vprev = vcur; vcur = vnext; vnext = t_; }
    if (j + 2 < NT) DMA_TILE(j + 2, 1, vnext);
    SBAR(); qkt(pA0, pA1, Kn_lds, Kr_lds, qr, r32, hi);
    finishSM(pB0, pB1, alB, l_reg, pa0, pa1, pa2, pa3); SBAR();
    pv_d0(o, vb0 + vprev * SHM_V, pa0, pa1, pa2, pa3); partialSM(pA0, pA1, m_reg, alA);
    RESC(alA); WAIT_SYNC();
    { const int t_ = vprev; vprev = vcur; vcur = vnext; vnext = t_; }
  }
  SBAR(); qkt(pB0, pB1, Kn_lds + SHM_KN, Kr_lds + SHM_KR, qr, r32, hi);
  finishSM(pA0, pA1, alA, l_reg, pa0, pa1, pa2, pa3); SBAR();
  pv_d0(o, vb0 + vprev * SHM_V, pa0, pa1, pa2, pa3); partialSM(pB0, pB1, m_reg, alB);
  RESC(alB);
  finishSM(pB0, pB1, alB, l_reg, pa0, pa1, pa2, pa3); SBAR();
  pv_d0(o, vb0 + vcur * SHM_V, pa0, pa1, pa2, pa3);
  if (hi == 0) li_l[r32] = l_reg; asm volatile("s_waitcnt lgkmcnt(0)" ::: "memory");
  float rli[16];
#pragma unroll
  for (int r = 0; r < 16; ++r) rli[r] = __builtin_amdgcn_rcpf(li_l[crow(r, hi)]);
  bf16* Ow = Ob + (long)(wid * QBLK) * 2048;
#pragma unroll
  for (int r = 0; r < 16; ++r) { const int orow = crow(r, hi);
#pragma unroll
    for (int d0 = 0; d0 < 4; ++d0) Ow[(long)orow * 2048 + d0 * 32 + r32] = (bf16)(cvt_pk_bf16(o[d0][r] * rli[r], 0.f) & 0xffffu); }
  __syncthreads();
#if PROBE_TS
  if (ts_words && tid == 0) { ts_words[160] += att_w_dma; ts_words[161] += att_w_bar; ts_words[162] += __builtin_amdgcn_s_memrealtime() - att_t0; ts_words[163] += (unsigned long long)NT; }
#endif
#undef KROW
#undef DMA_TILE
#undef WAIT_SYNC
#undef RESC
}
#undef SBAR
}

namespace scan {
constexpr int CH = 64;
constexpr int OFF_Q = 0, OFF_K = 32768  , OFF_V = 98304, OFF_P = 131072, OFF_ST = 131072 + 8192  , SHM_SCAN = OFF_ST + 4096;
__device__ __forceinline__ unsigned off_b(unsigned row, unsigned ch) { return 256u * row + 16u * (ch ^ (((row & 3) << 2) | ((row >> 2) & 3))); }
__device__ __forceinline__ unsigned p_off(unsigned i, unsigned chunk) { return 128u * i + 16u * (chunk ^ ((i >> 1) & 7)); }
__device__ __forceinline__ int crow(int r, int hi) { return (r & 3) + 8 * (r >> 2) + 4 * hi; }
__device__ __forceinline__ s16x4 vtr(const LAS char* p) { typedef short v4i16_t __attribute__((ext_vector_type(4))); return __builtin_bit_cast(s16x4, __builtin_amdgcn_ds_read_tr16_b64_v4i16((LAS v4i16_t*)p)); }
__device__ __forceinline__ bf16x8 tr_frag(const LAS char* img, int lane, int c, int ks) {
    const unsigned h = lane >> 5, blk = (lane >> 4) & 1, q = (lane & 15) >> 2, p = lane & 3;
    const unsigned r0 = 16 * ks + 8 * h + q, chn = 4 * c + 2 * blk + (p >> 1);
    const s16x4 lo = vtr(img + off_b(r0, chn) + 8 * (p & 1)), hi = vtr(img + off_b(r0 + 4, chn) + 8 * (p & 1));
    return (bf16x8){lo[0], lo[1], lo[2], lo[3], hi[0], hi[1], hi[2], hi[3]};
}
__device__ __forceinline__ bf16x8 pack_step(const f32x16& x, int s) {
    u32x4 p; p.x = cvt_pk_bf16(x[8 * s + 0], x[8 * s + 1]); p.y = cvt_pk_bf16(x[8 * s + 2], x[8 * s + 3]); p.z = cvt_pk_bf16(x[8 * s + 4], x[8 * s + 5]); p.w = cvt_pk_bf16(x[8 * s + 6], x[8 * s + 7]);
    return __builtin_bit_cast(bf16x8, p);
}
__device__ __forceinline__ void dma_mat(const bf16* src, int ld, LAS unsigned char* dst, int wid, int lane) {
    const char* sb = uni_ptr(src); const unsigned d0 = (unsigned)__builtin_amdgcn_readfirstlane((unsigned)(uintptr_t)dst + (unsigned)wid * 4096u);
#pragma unroll
    for (int k = 0; k < 4; ++k) { const int pc = wid * 4 + k, img = pc >> 4, row = 4 * (pc & 15) + (lane >> 4), pos = lane & 15;
        const int ch = pos ^ (((row & 3) << 2) | ((row >> 2) & 3));
        glds16_s(sb, (unsigned)((row * ld + img * 128 + ch * 8) * 2), d0 + (unsigned)k * 1024u); }
}
__device__ __forceinline__ int scan_rowbase(int n, int b, int dir) { return (n < 4) ? MX + b * CTXL + (dir ? 3 - n : n) * CH : b * SEQ + (dir ? 67 - n : n - 4) * CH; }
__device__ __forceinline__ float uni_f(float x) { return __uint_as_float(__builtin_amdgcn_readfirstlane(__float_as_uint(x))); }
typedef const LAS s16x4* lds_s4p;
__device__ __forceinline__ void scan_unit(const bf16* __restrict__ QKV, bf16* __restrict__ Y, float* __restrict__ PST, int b, int hd, int dir, int dvh, float lg2, bool skip_ctx_y, LAS unsigned char* lds, int tid_in, unsigned long long* lds_ts = nullptr) {
    int tid = tid_in; asm volatile("" : "+v"(tid));
    const int wid = __builtin_amdgcn_readfirstlane(tid >> 6), lane0 = tid & 63;
    const LAS char* QI = (const LAS char*)lds + OFF_Q; const LAS char* VI = (const LAS char*)lds + OFF_V;
    LAS char* PI = (LAS char*)lds + OFF_P;
    f32x16 S[8];
#pragma unroll
    for (int i = 0; i < 8; ++i) S[i] = f32x16{};
    const float lgr = dir ? -lg2 : lg2;
    const float g64 = uni_f(__builtin_amdgcn_exp2f(64.f * lg2));
    const float R1 = uni_f(__builtin_amdgcn_exp2f(lgr)), R8 = uni_f(__builtin_amdgcn_exp2f(8.f * lgr)), R32 = uni_f(__builtin_amdgcn_exp2f(32.f * lgr));
    const float Rm1 = uni_f(__builtin_amdgcn_exp2f(-lgr)), Rm16 = uni_f(__builtin_amdgcn_exp2f(-16.f * lgr));
    const float c0 = uni_f(dir ? g64 : __builtin_amdgcn_exp2f(lg2)), z0 = uni_f(dir ? 1.0f : __builtin_amdgcn_exp2f(63.f * lg2));
    const int qcol = hd * RDK, kcol = 2048 + hd * RDK, vcol = 4096 + hd * RDV + dvh * 256;
    { const bf16* src = QKV + (size_t)scan_rowbase(0, b, dir) * 8192;
      dma_mat(src + qcol, 8192, lds + OFF_Q, wid, lane0); dma_mat(src + kcol, 8192, lds + OFF_K, wid, lane0); dma_mat(src + vcol, 8192, lds + OFF_V, wid, lane0);
      asm volatile("s_waitcnt vmcnt(0)" ::: "memory"); __syncthreads(); }
#if PROBE_TS
    unsigned long long sc_w1 = 0, sc_w2 = 0; const unsigned long long sc_tb = __builtin_amdgcn_s_memrealtime();
#endif
    for (int n = 0; n < 68; ++n) {
        int lane = lane0; asm volatile("" : "+v"(lane));
        const int r = lane & 31, h = lane >> 5, fr = lane & 15, fq = lane >> 4;
        const int rowbase = scan_rowbase(n, b, dir);
        const bool more = n + 1 < 68;
        const bf16* nsrc = QKV + (size_t)scan_rowbase(more ? n + 1 : n, b, dir) * 8192;
        const LAS char* KI = (const LAS char*)lds + OFF_K + (n & 1) * 32768;
        if (more) dma_mat(nsrc + kcol, 8192, lds + OFF_K + ((n + 1) & 1) * 32768, wid, lane);
        const float LR = c0 * __builtin_amdgcn_exp2f((float)r * lgr), LZ = z0 * __builtin_amdgcn_exp2f((float)(-8 * h) * lgr), LP = __builtin_amdgcn_exp2f((float)(fr - 4 * fq) * lgr);
        { const int fH = fr & 3, fL = (fr >> 2) & 3; const int AL = 256 * fr + 16 * (fq ^ fL);
          int AH[4];
#pragma unroll
          for (int k = 0; k < 4; ++k) AH[k] = 64 * (k ^ fH);
#pragma unroll
          for (int tix = 0; tix < 2; ++tix) { const int tt = wid * 2 + tix, jt = tt >> 2, it = tt & 3;
            f32x4 pt = {0.f, 0.f, 0.f, 0.f};
            const bool live = dir ? (jt >= it) : (jt <= it);
            if (live) { const LAS char* ka = KI + 4096 * jt + AL; const LAS char* qa = QI + 4096 * it + AL;
#pragma unroll
                for (int ks = 0; ks < 8; ++ks) { const int o = (ks >> 2) * 16384 + AH[ks & 3];
                    pt = __builtin_amdgcn_mfma_f32_16x16x32_bf16(*(const LAS bf16x8*)(ka + o), *(const LAS bf16x8*)(qa + o), pt, 0, 0, 0); } }
            float we = LP * __builtin_amdgcn_exp2f((float)(16 * (it - jt)) * lgr); float v[4];
            const int mrel = fr - 4 * fq;
#pragma unroll
            for (int e = 0; e < 4; ++e) { float x = live ? pt[e] * we : 0.f; if (jt == it) { const bool keep = dir ? (e >= mrel) : (e <= mrel); x = keep ? x : 0.f; } v[e] = x; we *= Rm1; }
            const int i = it * 16 + fr, j0 = jt * 16 + 4 * fq;
            u32x2 w; w.x = cvt_pk_bf16(v[0], v[1]); w.y = cvt_pk_bf16(v[2], v[3]);
            *(LAS u32x2*)(PI + p_off(i, j0 >> 3) + ((j0 >> 2) & 1) * 8) = w; } }
        f32x16 Yt[2]; Yt[0] = f32x16{}; Yt[1] = f32x16{};
        { const int fH = r & 3, fL = (r >> 2) & 3; int QH[4], QL[4];
#pragma unroll
          for (int k = 0; k < 4; ++k) { QH[k] = 64 * (k ^ fH); QL[k] = 256 * r + 8 * h + 16 * (k ^ fL); }
#pragma unroll
          for (int dkb = 0; dkb < 8; ++dkb)
#pragma unroll
            for (int s = 0; s < 2; ++s) { const bf16x8 bf = pack_step(S[dkb], s);
                const LAS char* rp = QI + (dkb >> 2) * 16384 + QH[dkb & 3];
#pragma unroll
                for (int it = 0; it < 2; ++it) {
                    const u32x2 lo = *(const LAS u32x2*)(rp + it * 8192 + QL[2 * s]), hi2 = *(const LAS u32x2*)(rp + it * 8192 + QL[2 * s + 1]);
                    const u32x4 aw = {lo.x, lo.y, hi2.x, hi2.y};
                    Yt[it] = __builtin_amdgcn_mfma_f32_32x32x16_bf16(bf, __builtin_bit_cast(bf16x8, aw), Yt[it], 0, 0, 0); } } }
        { const float f0 = LR, f1 = LR * R32;
#pragma unroll
          for (int rg = 0; rg < 16; ++rg) { Yt[0][rg] *= f0; Yt[1][rg] *= f1; } }
#if PROBE_TS
        const unsigned long long sc_t0 = __builtin_amdgcn_s_memrealtime();
#endif
        if (more) asm volatile("s_waitcnt vmcnt(4)" ::: "memory"); else asm volatile("s_waitcnt vmcnt(0)" ::: "memory");
        __syncthreads();
#if PROBE_TS
        sc_w1 += __builtin_amdgcn_s_memrealtime() - sc_t0;
#endif
        if (more) dma_mat(nsrc + qcol, 8192, lds + OFF_Q, wid, lane);
#pragma unroll
        for (int i = 0; i < 8; ++i)
#pragma unroll
            for (int rg = 0; rg < 16; ++rg) S[i][rg] *= g64;
        {
          const int blk = (lane >> 4) & 1, q = (lane & 15) >> 2, p = lane & 3; int TB[2], CQ[4];
#pragma unroll
          for (int t = 0; t < 2; ++t) TB[t] = 2048 * h + 256 * q + 1024 * t + 16 * ((2 * blk + (p >> 1)) ^ ((2 * h + t) & 3)) + 8 * (p & 1);
#pragma unroll
          for (int c = 0; c < 4; ++c) CQ[c] = 64 * (c ^ q);
          const LAS char* vb = VI + (wid >> 2) * 16384 + CQ[wid & 3];
          float zk = LZ;
#pragma unroll
          for (int ks = 0; ks < 4; ++ks) {
            const s16x4 vlo = vtr(vb + 4096 * ks + TB[0]), vhi = vtr(vb + 4096 * ks + TB[1]);
            const u32x2 vl = __builtin_bit_cast(u32x2, vlo), vh = __builtin_bit_cast(u32x2, vhi);
            const u32x4 vw = {vl.x, vl.y, vh.x, vh.y}; const bf16x8 vf = __builtin_bit_cast(bf16x8, vw);
#pragma unroll
            for (int it = 0; it < 2; ++it) { const bf16x8 pa = *(const LAS bf16x8*)(PI + p_off(it * 32 + r, 2 * ks + h));
                Yt[it] = __builtin_amdgcn_mfma_f32_32x32x16_bf16(vf, pa, Yt[it], 0, 0, 0); }
            float zj = zk; u32x4 zw;
            { const float a0 = bflo(vw.x) * zj; zj *= Rm1; const float a1 = bfhi(vw.x) * zj; zj *= Rm1; zw.x = cvt_pk_bf16(a0, a1); }
            { const float a0 = bflo(vw.y) * zj; zj *= Rm1; const float a1 = bfhi(vw.y) * zj; zj *= Rm1; zw.y = cvt_pk_bf16(a0, a1); }
            { const float a0 = bflo(vw.z) * zj; zj *= Rm1; const float a1 = bfhi(vw.z) * zj; zj *= Rm1; zw.z = cvt_pk_bf16(a0, a1); }
            { const float a0 = bflo(vw.w) * zj; zj *= Rm1; const float a1 = bfhi(vw.w) * zj; zw.w = cvt_pk_bf16(a0, a1); }
            const bf16x8 vz = __builtin_bit_cast(bf16x8, zw);
            zk *= Rm16;
#pragma unroll
            for (int dkb = 0; dkb < 8; ++dkb) { const LAS char* kb_ = KI + (dkb >> 2) * 16384 + 4096 * ks + CQ[dkb & 3];
                const s16x4 klo = vtr(kb_ + TB[0]), khi = vtr(kb_ + TB[1]);
                const u32x2 kl = __builtin_bit_cast(u32x2, klo), kh = __builtin_bit_cast(u32x2, khi); const u32x4 kw = {kl.x, kl.y, kh.x, kh.y};
                S[dkb] = __builtin_amdgcn_mfma_f32_32x32x16_bf16(__builtin_bit_cast(bf16x8, kw), vz, S[dkb], 0, 0, 0); }
            __builtin_amdgcn_sched_barrier(0);
          } }
        if (!(skip_ctx_y && n < 4)) {
            bf16* Yr = Y + (size_t)rowbase * 4096; const unsigned yo = (unsigned)(r * 4096 + hd * RDV + dvh * 256 + wid * 32 + 8 * h);
#pragma unroll
            for (int it = 0; it < 2; ++it) {
                float s1a = 0.f, s1b = 0.f, s2a = 0.f, s2b = 0.f;
#pragma unroll
                for (int rg = 0; rg < 16; rg += 2) { s1a += Yt[it][rg]; s1b += Yt[it][rg + 1]; s2a = fmaf(Yt[it][rg], Yt[it][rg], s2a); s2b = fmaf(Yt[it][rg + 1], Yt[it][rg + 1], s2b); }
                float s1 = s1a + s1b, s2 = s2a + s2b;
                { auto rr = __builtin_amdgcn_permlane32_swap(__float_as_uint(s1), __float_as_uint(s1), false, false); s1 = __uint_as_float(rr[0]) + __uint_as_float(rr[1]); }
                { auto rr = __builtin_amdgcn_permlane32_swap(__float_as_uint(s2), __float_as_uint(s2), false, false); s2 = __uint_as_float(rr[0]) + __uint_as_float(rr[1]); }
                if (h == 0) *(LAS f32x2*)((LAS char*)lds + OFF_ST + ((it * 32 + r) * 8 + wid) * 8) = (f32x2){s1, s2};
#pragma unroll
                for (int g = 0; g < 4; g += 2) {
                    unsigned ax = cvt_pk_bf16(Yt[it][4 * g + 0], Yt[it][4 * g + 1]), ay = cvt_pk_bf16(Yt[it][4 * g + 2], Yt[it][4 * g + 3]);
                    unsigned bx_ = cvt_pk_bf16(Yt[it][4 * g + 4], Yt[it][4 * g + 5]), by = cvt_pk_bf16(Yt[it][4 * g + 6], Yt[it][4 * g + 7]);
                    { auto r_ = __builtin_amdgcn_permlane32_swap(ax, bx_, false, false); ax = r_[0]; bx_ = r_[1]; }
                    { auto r_ = __builtin_amdgcn_permlane32_swap(ay, by, false, false); ay = r_[0]; by = r_[1]; }
                    *(u32x4*)(Yr + yo + (unsigned)(it * 32 * 4096 + 8 * g)) = (u32x4){ax, ay, bx_, by}; } }
        }
#if PROBE_TS
        const unsigned long long sc_t1 = __builtin_amdgcn_s_memrealtime();
#endif
        asm volatile("s_waitcnt vmcnt(0)" ::: "memory");
        __syncthreads();
#if PROBE_TS
        sc_w2 += __builtin_amdgcn_s_memrealtime() - sc_t1;
#endif
        if (more) dma_mat(nsrc + vcol, 8192, lds + OFF_V, wid, lane);
        if (wid == 0 && !(skip_ctx_y && n < 4)) {
            const LAS f32x4* sp = (const LAS f32x4*)((const LAS char*)lds + OFF_ST + lane * 64);
            const f32x4 a = sp[0], b_ = sp[1], c = sp[2], d = sp[3];
            const float S1 = ((a[0] + a[2]) + (b_[0] + b_[2])) + ((c[0] + c[2]) + (d[0] + d[2])), S2 = ((a[1] + a[3]) + (b_[1] + b_[3])) + ((c[1] + c[3]) + (d[1] + d[3]));
            *(f32x2*)(PST + ((size_t)(rowbase + lane) * 8 + hd) * 4 + dvh * 2) = (f32x2){S1, S2};
        }
    }
    asm volatile("s_waitcnt vmcnt(0)" ::: "memory"); __syncthreads();
#if PROBE_TS
    if (blockIdx.x == 0 && tid == 0) { unsigned long long* tw = (unsigned long long*)(lds_ts); tw[170] += sc_w1; tw[171] += sc_w2; tw[172] += __builtin_amdgcn_s_memrealtime() - sc_tb; }
#endif
}
}

#define XB_TMO      128
#define XB_XCNT(j)  (256  + 64 * (j))
#define XB_XSUB(j)  (1280 + 64 * (j))
#define XB_XGEN(j)  (2304 + 64 * (j))
#define XB_TOP      3328
#define XB_TOPGEN   3392
#define XCD_BAR_WORDS 3456
#define XB_SPIN_CAP (1u << 22)
__device__ __forceinline__ unsigned xb_ld(unsigned* p)              { return __hip_atomic_load(p, __ATOMIC_RELAXED, __HIP_MEMORY_SCOPE_AGENT); }
__device__ __forceinline__ unsigned xb_add(unsigned* p, unsigned v) { return __hip_atomic_fetch_add(p, v, __ATOMIC_RELAXED, __HIP_MEMORY_SCOPE_AGENT); }
__device__ __forceinline__ unsigned xb_xcc_id() { return (unsigned)__builtin_amdgcn_s_getreg((3 << 11) | 20) & 0xFu; }
#define XB_SPIN(cond, bar) do { unsigned _sp = 0; while (cond) { __builtin_amdgcn_s_sleep(1); \
    if ((++_sp & 255u) == 0u) { if (xb_ld(&(bar)[XB_TMO])) break; if (_sp > XB_SPIN_CAP) { atomicAdd(&(bar)[XB_TMO], 1u); break; } } } } while (0)
struct XcdBarrier { unsigned* bar; unsigned x; volatile LAS unsigned* st; int wave; };
__device__ __forceinline__ XcdBarrier xcd_barrier_post(unsigned* bar, volatile LAS unsigned* st, int wave) {
    XcdBarrier b; b.bar = bar; b.x = xb_xcc_id(); b.st = st; b.wave = wave;
    if (wave == 0 && lane_id() == 0) (void)xb_add(&bar[XB_XCNT(b.x)], 1u);
    return b;
}
__device__ __forceinline__ void xcd_barrier_complete(unsigned* bar, unsigned x, unsigned& nloc, unsigned& nx) {
    const unsigned G = gridDim.x * gridDim.y * gridDim.z;
    unsigned sum, cnt, mine, sp = 0u;
    for (;;) {
        sum = 0u; cnt = 0u; mine = 0u;
#pragma unroll
        for (unsigned j = 0; j < 16; ++j) { const unsigned c = xb_ld(&bar[XB_XCNT(j)]); sum += c; cnt += (c > 0u) ? 1u : 0u; mine = (j == x) ? c : mine; }
        if (sum == G) break;
        __builtin_amdgcn_s_sleep(1);
        if ((++sp & 255u) == 0u) { if (xb_ld(&bar[XB_TMO])) break; if (sp > XB_SPIN_CAP) { atomicAdd(&bar[XB_TMO], 1u); break; } }
    }
    nloc = mine > 0u ? mine : 1u; nx = cnt > 0u ? cnt : 1u;
}
__device__ __forceinline__ void xcd_barrier(const XcdBarrier& b) {
    asm volatile("s_waitcnt vmcnt(0)" ::: "memory");
    __syncthreads();
    if (b.wave == 0 && lane_id() == 0) {
        unsigned* bar = b.bar; asm volatile("" : "+s"(bar));
        __builtin_amdgcn_s_waitcnt(0);
        unsigned nloc = b.st[0], nx = b.st[1];
        if (nloc == 0u) { xcd_barrier_complete(bar, b.x, nloc, nx); b.st[0] = nloc; b.st[1] = nx; }
        const unsigned old = xb_add(&bar[XB_XSUB(b.x)], 1u);
        const unsigned gen = old / nloc;
        if (old + 1u == (gen + 1u) * nloc) {
            __builtin_amdgcn_fence(__ATOMIC_RELEASE, "agent");
            asm volatile("s_waitcnt vmcnt(0)" ::: "memory");
            const unsigned og = xb_add(&bar[XB_TOP], 1u);
            const unsigned tg = og / nx;
            if (og + 1u == (tg + 1u) * nx) xb_add(&bar[XB_TOPGEN], 1u);
            else XB_SPIN(xb_ld(&bar[XB_TOPGEN]) == tg, bar);
            __builtin_amdgcn_fence(__ATOMIC_ACQUIRE, "agent");
            xb_add(&bar[XB_XGEN(b.x)], 1u);
            asm volatile("s_waitcnt vmcnt(0)" ::: "memory");
        } else {
            XB_SPIN(xb_ld(&bar[XB_XGEN(b.x)]) == gen, bar);
            __builtin_amdgcn_fence(__ATOMIC_ACQUIRE, "agent");
            asm volatile("s_waitcnt vmcnt(0)" ::: "memory");
        }
    }
    __syncthreads();
}

__device__ __forceinline__ float wave_sum(float v, int lane) {
#pragma unroll
    for (int o = 1; o < 64; o <<= 1) v += shfl_xor_l(v, o, lane);
    return v;
}
struct CvtDesc { const float* src; const float* kscale; bf16* WTrow0; int ldw, k0, K, jkind; float gscale; };
__device__ __forceinline__ int ropeperm64(int c) { const int p = c >> 1, e = c & 1; return (p < 16) ? (p + 16 * e) : (32 + (p - 16) + 16 * e); }
__device__ __forceinline__ int ropeinv64(int s_) { const int half = s_ >> 5, w = s_ & 31; return 2 * (half * 16 + (w & 15)) + (w >> 4); }
__device__ __forceinline__ void cvt_load(const CvtDesc& d, int lane, f32x4 (&v)[16]) {
#pragma unroll
    for (int i = 0; i < 16; ++i) { const int kk = 4 * i + (lane >> 4);
        f32x4 x = d.src ? *(const f32x4*)(d.src + (size_t)(d.k0 + kk) * d.ldw) : (f32x4){0.f, 0.f, 0.f, 0.f};
        float sc_ = d.gscale; if (d.kscale) sc_ *= d.kscale[d.k0 + kk];
        v[i] = x * sc_; }
}
__device__ __forceinline__ void cvt_store(const CvtDesc& d, int lane, const f32x4 (&v)[16], LAS float* scr) {
    const int n4 = lane & 15; int jr[4];
#pragma unroll
    for (int e = 0; e < 4; ++e) { const int s_ = 4 * n4 + e; jr[e] = d.jkind == 0 ? s_ : d.jkind == 1 ? ropeinv64(s_) : 2 * (4 * (n4 & 7) + e) + (n4 >> 3); }
#pragma unroll
    for (int i = 0; i < 16; ++i) { const int kk = 4 * i + (lane >> 4);
#pragma unroll
        for (int e = 0; e < 4; ++e) scr[kk * 65 + jr[e]] = v[i][e]; }
    asm volatile("s_waitcnt lgkmcnt(0)" ::: "memory");
    const int c = lane & 7;
#pragma unroll
    for (int ps = 0; ps < 8; ++ps) { const int j = 8 * ps + (lane >> 3); const LAS float* s = scr + (8 * c) * 65 + j;
        u32x4 o; o.x = cvt_pk_bf16(s[0 * 65], s[1 * 65]); o.y = cvt_pk_bf16(s[2 * 65], s[3 * 65]); o.z = cvt_pk_bf16(s[4 * 65], s[5 * 65]); o.w = cvt_pk_bf16(s[6 * 65], s[7 * 65]);
        *(u32x4*)(d.WTrow0 + (size_t)j * d.K + d.k0 + 8 * c) = o; }
    asm volatile("s_waitcnt lgkmcnt(0)" ::: "memory");
}
struct CvtJob { const float* W0; const float* W1; const float* kscale; bf16* WT; int ldw, K, nrows, kind, aux; float gscale; };
__device__ __forceinline__ bool cvt_try(const CvtJob& J, int& it, int lane, CvtDesc& d) {
    const int nblk = J.nrows / 64, items = (J.K / 64) * nblk;
    if (it >= items) { it -= items; return false; }
    const int kb = it / nblk, nb = it % nblk; const int n4 = lane & 15;
    const float* sp; int jk = 0;
    switch (J.kind) {
        case 0: sp = J.W0 + J.aux + nb * 64 + 4 * n4; break;
        case 1: sp = J.W0 + J.aux + 4 * n4; jk = 1; break;
        case 2: { const int hh = nb / 3, part = nb % 3; sp = J.W0 + hh * DQ + 64 * part + 4 * n4; jk = (part == 2) ? 1 : 0; } break;
        case 3: { const int hh = nb >> 2, q4 = nb & 3; sp = J.W0 + hh * 256 + 32 * q4 + 128 * (n4 >> 3) + 4 * (n4 & 7); jk = 2; } break;
        case 4: { const int tl = nb >> 2, hf = (nb >> 1) & 1, q2 = nb & 1; const long long dW = (const char*)J.W1 - (const char*)J.W0; sp = (const float*)((const char*)J.W0 + dW * hf) + tl * 128 + 64 * q2 + 4 * n4; } break;
        default: sp = nullptr; break;
    }
    d.src = sp; d.kscale = J.kscale; d.WTrow0 = J.WT + (size_t)(nb * 64) * J.K; d.ldw = J.ldw; d.k0 = kb * 64; d.K = J.K; d.jkind = jk; d.gscale = J.gscale;
    return true;
}
__device__ __forceinline__ int cvt_items(const CvtJob& J) { return (J.K / 64) * (J.nrows / 64); }

__device__ __forceinline__ void row_load(const float* xrow, int lane, f32x4 (&v)[8]) {
#pragma unroll
    for (int j = 0; j < 8; ++j) v[j] = *(const f32x4*)(xrow + 4 * lane + 256 * j);
}
__device__ __forceinline__ void norm_row_f32(const f32x4 (&v)[8], const f32x4 (&A)[8], const f32x4 (&Bc)[8], bf16* orow, int lane) {
    float s = 0.f;
#pragma unroll
    for (int j = 0; j < 8; ++j) s += (v[j][0] * v[j][0] + v[j][1] * v[j][1]) + (v[j][2] * v[j][2] + v[j][3] * v[j][3]);
    const float rstd = 1.0f / sqrtf(wave_sum(s, lane) * (1.0f / D) + NORM_EPS);
#pragma unroll
    for (int j = 0; j < 8; ++j) { const f32x4 y = (v[j] * rstd) * A[j] + Bc[j];
        u32x2 w; w.x = cvt_pk_bf16(y[0], y[1]); w.y = cvt_pk_bf16(y[2], y[3]); *(u32x2*)(orow + 4 * lane + 256 * j) = w; }
}
__device__ __forceinline__ void norm_coef_f32(const float* g, const float* mr, int lane, f32x4 (&A)[8], f32x4 (&Bc)[8]) {
#pragma unroll
    for (int j = 0; j < 8; ++j) { const int c = 4 * lane + 256 * j; A[j] = *(const f32x4*)(g + c) * (1.0f + *(const f32x4*)(mr + D + c)); Bc[j] = *(const f32x4*)(mr + c); }
}
__device__ __forceinline__ void norm_phase(const float* xsrc, const float* csrc, const float* g, const float* modl, int chunk, bf16* H, int nrows, int gw, int NGW, int lane) {
    const int G8 = NGW >> 3, b = gw / G8, idx = gw - b * G8;
    f32x4 A[8], Bc[8];
    if (idx < SEQ) {
        norm_coef_f32(g, modl + (size_t)b * NMOD + chunk * D, lane, A, Bc);
        f32x4 v[8], vn[8]; int m = b * SEQ + idx; const int mend = (b + 1) * SEQ;
        row_load(xsrc + (size_t)m * D, lane, v);
        for (;;) {
            const int mn = m + G8; const bool has = mn < mend;
            if (has) row_load(xsrc + (size_t)mn * D, lane, vn);
            norm_row_f32(v, A, Bc, H + (size_t)m * D, lane);
            if (!has) break;
#pragma unroll
            for (int j = 0; j < 8; ++j) v[j] = vn[j];
            m = mn;
        }
    }
    if (MX + gw < nrows) {
        norm_coef_f32(g, modl + (size_t)8 * NMOD + chunk * D, lane, A, Bc);
        for (int m = MX + gw; m < nrows; m += NGW) { f32x4 v[8]; row_load(csrc + (size_t)(m - MX) * D, lane, v); norm_row_f32(v, A, Bc, H + (size_t)m * D, lane); }
    }
}

__device__ __forceinline__ void row_load_b16(const bf16* xrow, int lane, u32x4 (&v)[4]) {
#pragma unroll
    for (int j = 0; j < 4; ++j) v[j] = *(const u32x4*)(xrow + 8 * lane + 512 * j);
}
__device__ __forceinline__ void norm_row_b16(const u32x4 (&v)[4], const f32x4 (&A)[8], const f32x4 (&Bc)[8], bf16* orow, int lane) {
    f32x4 xa[4], xb[4]; float ss = 0.f;
#pragma unroll
    for (int j = 0; j < 4; ++j) { xa[j] = (f32x4){bflo(v[j].x), bfhi(v[j].x), bflo(v[j].y), bfhi(v[j].y)}; xb[j] = (f32x4){bflo(v[j].z), bfhi(v[j].z), bflo(v[j].w), bfhi(v[j].w)};
        ss += ((xa[j][0] * xa[j][0] + xa[j][1] * xa[j][1]) + (xa[j][2] * xa[j][2] + xa[j][3] * xa[j][3])) + ((xb[j][0] * xb[j][0] + xb[j][1] * xb[j][1]) + (xb[j][2] * xb[j][2] + xb[j][3] * xb[j][3])); }
    const float rstd = 1.0f / sqrtf(wave_sum(ss, lane) * (1.0f / D) + NORM_EPS);
#pragma unroll
    for (int j = 0; j < 4; ++j) { const f32x4 ya = (xa[j] * rstd) * A[2 * j] + Bc[2 * j], yb = (xb[j] * rstd) * A[2 * j + 1] + Bc[2 * j + 1];
        *(u32x4*)(orow + 8 * lane + 512 * j) = pack8(ya, yb); }
}
__device__ __forceinline__ void norm_coef_b16(const float* g, const float* mr, int lane, f32x4 (&A)[8], f32x4 (&Bc)[8]) {
#pragma unroll
    for (int j = 0; j < 8; ++j) { const int c = 8 * lane + 512 * (j >> 1) + 4 * (j & 1); A[j] = *(const f32x4*)(g + c) * (1.0f + *(const f32x4*)(mr + D + c)); Bc[j] = *(const f32x4*)(mr + c); }
}
__device__ __forceinline__ void norm_phase_b16(const bf16* xsrc, const bf16* csrc, const float* g, const float* modl, int chunk, bf16* H, int nrows, int gw, int NGW, int lane) {
    const int G8 = NGW >> 3, b = gw / G8, idx = gw - b * G8;
    f32x4 A[8], Bc[8];
    if (idx < SEQ) {
        norm_coef_b16(g, modl + (size_t)b * NMOD + chunk * D, lane, A, Bc);
        u32x4 v[4], vn[4]; int m = b * SEQ + idx; const int mend = (b + 1) * SEQ;
        row_load_b16(xsrc + (size_t)m * D, lane, v);
        for (;;) {
            const int mn = m + G8; const bool has = mn < mend;
            if (has) row_load_b16(xsrc + (size_t)mn * D, lane, vn);
            norm_row_b16(v, A, Bc, H + (size_t)m * D, lane);
            if (!has) break;
#pragma unroll
            for (int j = 0; j < 4; ++j) v[j] = vn[j];
            m = mn;
        }
    }
    if (MX + gw < nrows) {
        norm_coef_b16(g, modl + (size_t)8 * NMOD + chunk * D, lane, A, Bc);
        for (int m = MX + gw; m < nrows; m += NGW) { u32x4 v[4]; row_load_b16(csrc + (size_t)(m - MX) * D, lane, v); norm_row_b16(v, A, Bc, H + (size_t)m * D, lane); }
    }
}

__device__ __forceinline__ unsigned long long ld_arg(LAS unsigned char* lds, int i) {
    const volatile LAS unsigned* p = (const volatile LAS unsigned*)(lds + ARGS_OFF) + 2 * i;
    const unsigned lo = __builtin_amdgcn_readfirstlane(p[0]), hi = __builtin_amdgcn_readfirstlane(p[1]);
    return ((unsigned long long)hi << 32) | lo;
}
__device__ __forceinline__ void mod_layers(LAS unsigned char* lds, unsigned char* ws, int l_lo, int l_hi, int wg, int nwg, int tid, int lane, int wave) {
#define ARGF(i) ((const float*)ld_arg(lds, (i)))
    const int nitems = (l_hi - l_lo) * 96;
    if (wg >= nitems) return;
    LAS float* cond = (LAS float*)lds;
    LAS float* red = (LAS float*)(lds + 73728);
    float* MODV = (float*)(ws + WS_MODV);
    { const float* cin = ARGF(1); const float* cc = ARGF(3);
      for (int i = tid; i < 9 * D; i += 512) { const int r = i >> 11, k = i & (D - 1); const float c = (r < 8) ? cin[r * D + k] : cc[k]; cond[i] = c / (1.0f + __expf(-c)); } }
    __syncthreads();
    for (int it = wg; it < nitems; it += nwg) {
        const int l = l_lo + it / 96, cb = it % 96; const int n = cb * 128 + 2 * lane;
        const float* W = ARGF(4) + (size_t)l * D * NMOD + n; const float* mb = ARGF(5) + (size_t)l * NMOD + cb * 128;
        float a0[9], a1[9];
#pragma unroll
        for (int r = 0; r < 9; ++r) { a0[r] = 0.f; a1[r] = 0.f; }
        for (int k = wave * 256; k < wave * 256 + 256; k += 8) {
            f32x2 w[8];
#pragma unroll
            for (int q = 0; q < 8; ++q) w[q] = *(const f32x2*)(W + (size_t)(k + q) * NMOD);
#pragma unroll
            for (int q4 = 0; q4 < 2; ++q4)
#pragma unroll
                for (int r = 0; r < 9; ++r) { const f32x4 c4 = *(const LAS f32x4*)(cond + r * D + k + 4 * q4);
#pragma unroll
                    for (int q = 0; q < 4; ++q) { a0[r] += c4[q] * w[4 * q4 + q][0]; a1[r] += c4[q] * w[4 * q4 + q][1]; } }
        }
#pragma unroll
        for (int r = 0; r < 9; ++r) { red[(wave * 9 + r) * 128 + 2 * lane] = a0[r]; red[(wave * 9 + r) * 128 + 2 * lane + 1] = a1[r]; }
        __syncthreads();
        for (int i = tid; i < 9 * 128; i += 512) { const int r = i >> 7, cc = i & 127; float s2 = 0.f;
#pragma unroll
            for (int w8 = 0; w8 < 8; ++w8) s2 += red[(w8 * 9 + r) * 128 + cc];
            MODV[((size_t)l * 9 + r) * NMOD + cb * 128 + cc] = s2 + mb[cc]; }
        __syncthreads();
    }
#undef ARGF
}
__device__ __forceinline__ void cvt_layer(LAS unsigned char* lds, unsigned char* ws, int lc, int rank, int nranks, int wave, int lane, int part  ) {
#define ARGF(i) ((const float*)ld_arg(lds, (i)))
    const int li = lc >> 1; const bool is_ret = (lc & 1) != 0;
    bf16* WM = (bf16*)(ws + (is_ret ? WS_WB : WS_WA)); bf16* WF = (bf16*)(ws + (is_ret ? WS_WB + 82 * MiB : WS_WA + 22 * MiB));
    LAS float* scr = (LAS float*)(lds + wave * 19456);
    CvtJob J[7]; int nj;
    if (!is_ret) {
        bf16* W1T = WM; bf16* WuqT = W1T + (size_t)N1 * D; bf16* WukvT = WuqT + (size_t)3072 * 512; bf16* WoT = WukvT + (size_t)4096 * 512;
        const float* wdq = ARGF(8) + (size_t)li * D * QR; const float* wdkv = ARGF(11) + (size_t)li * D * (KVR + ROPE);
        J[0] = CvtJob{wdq, nullptr, nullptr, W1T, QR, D, 512, 0, 0, 1.f};
        J[1] = CvtJob{wdkv, nullptr, nullptr, W1T + (size_t)512 * D, KVR + ROPE, D, 512, 0, 0, 1.f};
        J[2] = CvtJob{wdkv, nullptr, nullptr, W1T + (size_t)1024 * D, KVR + ROPE, D, 64, 1, 512, 1.f};
        J[3] = CvtJob{nullptr, nullptr, nullptr, W1T + (size_t)1088 * D, 1, D, 192, 5, 0, 1.f};
        J[4] = CvtJob{ARGF(10) + (size_t)li * QR * 3072, nullptr, ARGF(9) + li * QR, WuqT, 3072, QR, 3072, 2, 0, 0.07216878364870322f * LOG2E};
        J[5] = CvtJob{ARGF(13) + (size_t)li * KVR * 4096, nullptr, ARGF(12) + li * KVR, WukvT, 4096, KVR, 4096, 0, 0, 1.f};
        J[6] = CvtJob{ARGF(14) + (size_t)li * D * D, nullptr, nullptr, WoT, D, D, D, 0, 0, 1.f};
        nj = 7;
    } else {
        bf16* WqkvT = WM; bf16* WgT = WqkvT + (size_t)8192 * D; bf16* WoT = WgT + (size_t)8192 * D;
        J[0] = CvtJob{ARGF(15) + (size_t)li * D * D, nullptr, nullptr, WqkvT, D, D, 2048, 3, 0, 1.f};
        J[1] = CvtJob{ARGF(16) + (size_t)li * D * D, nullptr, nullptr, WqkvT + (size_t)2048 * D, D, D, 2048, 3, 0, 0.0625f};
        J[2] = CvtJob{ARGF(17) + (size_t)li * D * 4096, nullptr, nullptr, WqkvT + (size_t)4096 * D, 4096, D, 4096, 0, 0, 1.f};
        J[3] = CvtJob{ARGF(18) + (size_t)li * D * 4096, ARGF(19) + (size_t)li * D * 4096, nullptr, WgT, 4096, D, 8192, 4, 0, 1.f};
        J[4] = CvtJob{ARGF(20) + (size_t)li * 4096 * D, nullptr, nullptr, WoT, D, 4096, D, 0, 0, 1.f};
        J[5] = CvtJob{nullptr, nullptr, nullptr, nullptr, 1, 64, 0, 5, 0, 1.f};
        J[6] = J[5];
        nj = 5;
    }
    CvtJob F0 = CvtJob{ARGF(23) + (size_t)lc * D * FF, ARGF(24) + (size_t)lc * D * FF, nullptr, WF, FF, D, 11264, 4, 0, 1.f};
    CvtJob F1 = CvtJob{ARGF(27) + (size_t)lc * FF * D, nullptr, nullptr, WF + (size_t)11264 * D, D, FF, D, 0, 0, 1.f};
    if (part == 1) nj = 0;
    const bool ffn = part != 0;
    int total = ffn ? cvt_items(F0) + cvt_items(F1) : 0;
#pragma unroll
    for (int j = 0; j < 7; ++j) if (j < nj) total += cvt_items(J[j]);
#define CVT_FIND(IT, DD) do { int it_ = (IT); bool done_ = false; \
        _Pragma("unroll") for (int j = 0; j < 7; ++j) if (!done_ && j < nj) done_ = cvt_try(J[j], it_, lane, DD); \
        if (ffn) { if (!done_) done_ = cvt_try(F0, it_, lane, DD); if (!done_) done_ = cvt_try(F1, it_, lane, DD); } } while (0)
    if (rank < total) {
        f32x4 v[16], w[16]; CvtDesc d0, d1; int it0 = rank;
        CVT_FIND(it0, d0); cvt_load(d0, lane, v);
        for (;;) {
            const int it1 = it0 + nranks; const bool has = it1 < total;
            if (has) { CVT_FIND(it1, d1); cvt_load(d1, lane, w); }
            cvt_store(d0, lane, v, scr);
            if (!has) break;
#pragma unroll
            for (int i = 0; i < 16; ++i) v[i] = w[i];
            d0 = d1; it0 = it1;
        }
    }
#undef CVT_FIND
#undef ARGF
}

#if MLA_CHECK
constexpr int CW_CHK = 2048;
__device__ __forceinline__ float wave_max(float v, int lane) {
#pragma unroll
    for (int o = 1; o < 64; o <<= 1) v = fmaxf(v, shfl_xor_l(v, o, lane));
    return v;
}
__device__ __forceinline__ void mla_check(LAS unsigned char* lds, unsigned char* ws, int li, int gw, int wave, int lane) {
#define ARGF(i) ((const float*)ld_arg(lds, (i)))
    LAS float* sc = (LAS float*)(lds + wave * 19456);
    const bf16* H = (const bf16*)(ws + WS_H); const bf16* Qb = (const bf16*)(ws + WS_Q); const bf16* KVb = (const bf16*)(ws + WS_KV); const bf16* KRb = (const bf16*)(ws + WS_KR); const bf16* Ob = (const bf16*)(ws + WS_O);
    const int t = (int)(((unsigned)gw * 2654435761u) % (unsigned)MT); const int hd = gw & 15;
    const bool isx = t < MX; const int tt = t & (SEQ - 1);
    float err = 0.f;
    {
        const float* wdq = ARGF(8) + (size_t)li * D * QR; const float* wdkv = ARGF(11) + (size_t)li * D * (KVR + ROPE);
        float ql[8], kl[9];
#pragma unroll
        for (int j = 0; j < 8; ++j) ql[j] = 0.f;
#pragma unroll
        for (int j = 0; j < 9; ++j) kl[j] = 0.f;
        for (int k = 0; k < D; ++k) { const float hv = bf2f(H[(size_t)t * D + k]);
#pragma unroll
            for (int j = 0; j < 8; ++j) ql[j] += hv * wdq[(size_t)k * QR + lane + 64 * j];
#pragma unroll
            for (int j = 0; j < 9; ++j) kl[j] += hv * wdkv[(size_t)k * (KVR + ROPE) + lane + 64 * j]; }
        float sq = 0.f, sk = 0.f;
#pragma unroll
        for (int j = 0; j < 8; ++j) { sq += ql[j] * ql[j]; sk += kl[j] * kl[j]; }
        const float rq = 1.0f / sqrtf(wave_sum(sq, lane) * (1.0f / QR) + NORM_EPS), rk = 1.0f / sqrtf(wave_sum(sk, lane) * (1.0f / KVR) + NORM_EPS);
        const float* qg = ARGF(9) + li * QR; const float* kg = ARGF(12) + li * KVR;
#pragma unroll
        for (int j = 0; j < 8; ++j) { sc[lane + 64 * j] = ql[j] * rq * qg[lane + 64 * j]; sc[512 + lane + 64 * j] = kl[j] * rk * kg[lane + 64 * j]; }
        sc[1024 + lane] = kl[8];
        asm volatile("s_waitcnt lgkmcnt(0)" ::: "memory");
        const float* wuq = ARGF(10) + (size_t)li * QR * 3072 + hd * DQ; const float* wukv = ARGF(13) + (size_t)li * KVR * 4096 + hd * 256;
        float qv[3] = {0.f, 0.f, 0.f}, kv[4] = {0.f, 0.f, 0.f, 0.f};
        for (int c = 0; c < 512; ++c) { const float a = sc[c], bq = sc[512 + c];
#pragma unroll
            for (int j = 0; j < 3; ++j) qv[j] += a * wuq[(size_t)c * 3072 + lane + 64 * j];
#pragma unroll
            for (int j = 0; j < 4; ++j) kv[j] += bq * wukv[(size_t)c * 4096 + lane + 64 * j]; }
#pragma unroll
        for (int j = 0; j < 3; ++j) sc[1100 + lane + 64 * j] = qv[j];
        asm volatile("s_waitcnt lgkmcnt(0)" ::: "memory");
        float qref[3]; float kr_ref = 0.f;
#pragma unroll
        for (int j = 0; j < 3; ++j) { const int d = lane + 64 * j; float v = sc[1100 + d];
            if (d >= NOPE && isx) { const int e = d - NOPE, half = e >> 5, i = e & 15, second = (e >> 4) & 1; const float pos = half ? (float)(tt & 63) : (float)(tt >> 6);
                const float ang = pos * __builtin_amdgcn_exp2f(-(float)(2 * i) * (13.287712379549449f / 32.0f)); const float rev = ang * 0.15915494309189535f; const float fr_ = rev - floorf(rev);
                const float cs = __builtin_amdgcn_cosf(fr_), sn = __builtin_amdgcn_sinf(fr_); const float other = sc[1100 + NOPE + half * 32 + i + (second ? 0 : 16)];
                v = second ? (v * cs + other * sn) : (v * cs - other * sn); }
            qref[j] = v * (0.07216878364870322f * LOG2E); }
        { const int e = lane, half = e >> 5, i = e & 15, second = (e >> 4) & 1; float v = sc[1024 + e];
          if (isx) { const float pos = half ? (float)(tt & 63) : (float)(tt >> 6);
              const float ang = pos * __builtin_amdgcn_exp2f(-(float)(2 * i) * (13.287712379549449f / 32.0f)); const float rev = ang * 0.15915494309189535f; const float fr_ = rev - floorf(rev);
              const float cs = __builtin_amdgcn_cosf(fr_), sn = __builtin_amdgcn_sinf(fr_); const float other = sc[1024 + half * 32 + i + (second ? 0 : 16)];
              v = second ? (v * cs + other * sn) : (v * cs - other * sn); }
          kr_ref = v; }
#pragma unroll
        for (int j = 0; j < 3; ++j) sc[1400 + lane + 64 * j] = qref[j];
        sc[1600 + lane] = kr_ref;
        asm volatile("s_waitcnt lgkmcnt(0)" ::: "memory");
        float mx = 0.f, df = 0.f;
#pragma unroll
        for (int j = 0; j < 3; ++j) { const int p = lane + 64 * j; const int od = p < NOPE ? p : NOPE + ropeperm64(p - NOPE); const float ref = sc[1400 + od]; const float mine = bf2f(Qb[(size_t)t * 3072 + hd * DQ + p]);
            mx = fmaxf(mx, fabsf(ref)); df = fmaxf(df, fabsf(ref - mine)); }
        err = fmaxf(err, wave_max(df, lane) / (wave_max(mx, lane) + 1e-20f));
        mx = 0.f; df = 0.f;
#pragma unroll
        for (int j = 0; j < 4; ++j) { const float ref = kv[j]; const float mine = bf2f(KVb[(size_t)t * 4096 + hd * 256 + lane + 64 * j]); mx = fmaxf(mx, fabsf(ref)); df = fmaxf(df, fabsf(ref - mine)); }
        err = fmaxf(err, wave_max(df, lane) / (wave_max(mx, lane) + 1e-20f));
        { const float ref = sc[1600 + ropeperm64(lane)]; const float mine = bf2f(KRb[(size_t)t * 64 + lane]); err = fmaxf(err, wave_max(fabsf(ref - mine), lane) / (wave_max(fabsf(ref), lane) + 1e-20f)); }
    }
    {
        const int b = isx ? (t >> 12) : ((t - MX) >> 8); const int nk = isx ? 4352 : 256;
        for (int d = lane; d < DQ; d += 64) sc[d] = bf2f(Qb[(size_t)t * 3072 + hd * DQ + d]);
        asm volatile("s_waitcnt lgkmcnt(0)" ::: "memory");
        float mxs = -1e30f;
        for (int j = lane; j < nk; j += 64) { const int row = j < 256 ? MX + b * CTXL + j : b * SEQ + (j - 256); float sdot = 0.f;
            for (int d = 0; d < NOPE; ++d) sdot += sc[d] * bf2f(KVb[(size_t)row * 4096 + hd * 256 + d]);
            for (int d = 0; d < ROPE; ++d) sdot += sc[NOPE + d] * bf2f(KRb[(size_t)row * 64 + d]);
            sc[256 + j] = sdot; mxs = fmaxf(mxs, sdot); }
        mxs = wave_max(mxs, lane); float sum = 0.f;
        for (int j = lane; j < nk; j += 64) { const float p = __builtin_amdgcn_exp2f(sc[256 + j] - mxs); sc[256 + j] = p; sum += p; }
        sum = wave_sum(sum, lane);
        asm volatile("s_waitcnt lgkmcnt(0)" ::: "memory");
        float o0 = 0.f, o1 = 0.f;
        for (int j = 0; j < nk; ++j) { const int row = j < 256 ? MX + b * CTXL + j : b * SEQ + (j - 256); const float p = sc[256 + j];
            o0 += p * bf2f(KVb[(size_t)row * 4096 + hd * 256 + 128 + lane]); o1 += p * bf2f(KVb[(size_t)row * 4096 + hd * 256 + 128 + 64 + lane]); }
        o0 /= sum; o1 /= sum;
        const float m0 = bf2f(Ob[(size_t)t * D + hd * 128 + lane]), m1 = bf2f(Ob[(size_t)t * D + hd * 128 + 64 + lane]);
        const float df = fmaxf(fabsf(o0 - m0), fabsf(o1 - m1)), mx = fmaxf(fabsf(o0), fabsf(o1));
        err = fmaxf(err, wave_max(df, lane) / (wave_max(mx, lane) + 1e-20f));
    }
    if (lane == 0) atomicMax((unsigned*)(ws + WS_CTL) + CW_CHK, __float_as_uint(err));
#undef ARGF
}
#endif
struct Args { const float* in[29]; float* out; unsigned char* ws; int ph_lo, ph_hi; };
constexpr int PH_PER_LAYER = 10, PH_FINAL = 1 + PH_PER_LAYER * DEPTH, PH_COUNT = PH_FINAL + 1;

template <unsigned MK_EN_T>
__global__ void __launch_bounds__(512, 2) mk_fwd(Args args) {
    extern __shared__ __attribute__((aligned(16))) unsigned char lds_raw[];
    LAS unsigned char* lds = (LAS unsigned char*)lds_raw;
    volatile LAS unsigned* MISC = (volatile LAS unsigned*)(lds + MISC_OFF);
    const int G = gridDim.x; const int bx = blockIdx.x; const int vcu = (G % 8 == 0) ? (bx % 8) * (G / 8) + bx / 8 : bx;
    const int NGW = G * 8;
    unsigned char* ws = args.ws; float* X = args.out; void* args_out_raw = (void*)args.out;
    const int lo = args.ph_lo, hi = args.ph_hi;
    const int wave_s = __builtin_amdgcn_readfirstlane((int)threadIdx.x >> 6);
#define TID() (wave_s * 64 + lane_id())
    { const int tid0 = threadIdx.x;
      for (int u = tid0; u < (LDS_BYTES - CTRL_BASE) / 4; u += 512) ((LAS unsigned*)(lds + CTRL_BASE))[u] = 0u;
      __syncthreads();
      if (tid0 < 29) ((volatile LAS unsigned long long*)(lds + ARGS_OFF))[tid0] = (unsigned long long)args.in[tid0];
      __syncthreads(); }
#define ARGF(i) ((const float*)ld_arg(lds, (i)))
    XcdBarrier bar; bar.bar = (unsigned*)(ws + WS_CTL) + CW_BAR; bar.x = 0; bar.st = nullptr; bar.wave = wave_s;
    if (hi - lo > 1) bar = xcd_barrier_post((unsigned*)(ws + WS_CTL) + CW_BAR, MISC + 8, wave_s);
#if PROBE_TS
    if (bx == 0 && TID() == 0) { ((unsigned long long*)(ws + WS_CTL + 65536))[0] = __builtin_amdgcn_s_memrealtime(); ((unsigned long long*)(ws + WS_CTL + 65536))[121] = ~0ull; }
#endif
#define EN(b) (((MK_EN_T) >> (b)) & 1u)
#define IN(k) (lo <= (k) && (k) < hi)
#if PROBE_TS
#define TS_WORDS ((unsigned long long*)(ws + WS_CTL + 65536))
#define PHASE_END(k) do { if (hi > (k) + 1) xcd_barrier(bar); if (bx == 0 && TID() == 0) TS_WORDS[(k) + 1] = __builtin_amdgcn_s_memrealtime(); } while (0)
#else
#define PHASE_END(k) do { if (hi > (k) + 1) xcd_barrier(bar); } while (0)
#endif
#define PH_IDS int tid = TID(); asm volatile("" : "+v"(tid)); const int lane = tid & 63; const int wave = wave_s; int gw = vcu * 8 + wave; asm volatile("" : "+s"(gw)); (void)lane; (void)gw;
#define XB_    ((bf16*)args_out_raw)
#define XCB_   ((bf16*)(ws + WS_XC))
#define XF_    ((bf16*)(ws + WS_BIG + 32 * MiB))
#define MODV_  ((float*)(ws + WS_MODV))
#define TABM_  ((float*)(ws + WS_TABM))
#define TABR_  ((float*)(ws + WS_TABR))
#define SSQ_   ((float*)(ws + WS_SSQ))
#define KR_    ((bf16*)(ws + WS_KR))
#define H_     ((bf16*)(ws + WS_H))
#define WMIX_(ll) ((bf16*)(ws + (((ll) & 1) ? WS_WB : WS_WA)))
#define WFFN_(ll) ((bf16*)(ws + (((ll) & 1) ? WS_WB + 82 * MiB : WS_WA + 22 * MiB)))
#define W1T_   WMIX_(l)
#define WUQT_  (W1T_ + (size_t)N1 * D)
#define WUKVT_ (WUQT_ + (size_t)3072 * 512)
#define WOTM_  (WUKVT_ + (size_t)4096 * 512)
#define WQKVT_ WMIX_(l)
#define WGT_   (WQKVT_ + (size_t)8192 * D)
#define WOTR_  (WGT_ + (size_t)8192 * D)
#define WGUT_  WFFN_(l)
#define WDT_   (WGUT_ + (size_t)11264 * D)
#define QKVL_  ((bf16*)(ws + WS_QKVL))
#define Q_     ((bf16*)(ws + WS_Q))
#define KV_    ((bf16*)(ws + WS_KV))
#define O_     ((bf16*)(ws + WS_O))
#define QKV_   ((bf16*)(ws + WS_QKV))
#define Y_     ((bf16*)(ws + WS_Y))
#define GATED_ ((bf16*)(ws + WS_GATED))
#define GB_    ((bf16*)(ws + WS_G))
#define UB_    ((bf16*)(ws + WS_U))
#define HALO_  ((float*)(ws + WS_G))
#define MODL_  (MODV_ + (size_t)l * 9 * NMOD)

    if (EN(0) && IN(0)) for (int rep_ = 0; rep_ < 1 + (int)((PROBE_MASK >> 0) & 1u); ++rep_) {
        PH_IDS
        mod_layers(lds, ws, 0, 1, bx, G, tid, lane, wave);
        __syncthreads();
        cvt_layer(lds, ws, 0, gw, NGW, wave, lane, 2);
        for (int i = bx * 512 + tid; i < 64 * 16 + SEQ * 128; i += G * 512) {
            float inv, pos; float* dst;
            if (i < 1024) { const int p = i >> 4, f = i & 15; inv = __builtin_amdgcn_exp2f(-(float)(2 * f) * (13.287712379549449f / 32.0f)); pos = (float)p; dst = TABM_ + 2 * i; }
            else { const int j = i - 1024, t = j >> 7, f = j & 127; inv = __builtin_amdgcn_exp2f(-(float)(2 * f) * (13.287712379549449f / 256.0f)); pos = (float)t; dst = TABR_ + 2 * j; }
            const float ang = pos * inv; const double rev = (double)ang * 0.15915494309189535; const float fr = (float)(rev - floor(rev));
            dst[0] = __builtin_amdgcn_cosf(fr); dst[1] = __builtin_amdgcn_sinf(fr);
        }
        PHASE_END(0);
    }

    for (int l = 0; l < DEPTH; ++l) {
        const int P = 1 + PH_PER_LAYER * l; const int li = l >> 1; const bool is_ret = (l & 1) != 0; const bool last = (l == DEPTH - 1);
        const int Mrows = last ? MX : MT;

        if (EN(1) && IN(P + 0)) for (int rep_ = 0; rep_ < 1 + (int)((PROBE_MASK >> 1) & 1u); ++rep_) {
            PH_IDS
            const float* g = ARGF(6) + l * D;
            if (l == 0) norm_phase(ARGF(0), ARGF(2), g, MODL_, 0, H_, MT, gw, NGW, lane);
            else norm_phase_b16(XB_, XCB_, g, MODL_, 0, H_, MT, gw, NGW, lane);
            PHASE_END(P + 0);
        }

        if (!is_ret) {
            if (EN(2) && IN(P + 1)) for (int rep_ = 0; rep_ < 1 + (int)((PROBE_MASK >> 2) & 1u); ++rep_) {
                pg8::Gemm g{H_, W1T_, MT, N1, D, D}; pg8::StaticOrder S; S.init(MT, N1, G, bx); S.tid = TID();
                EpiG1 E{QKVL_, SSQ_, KR_, TABM_};
                pg8::gemm_phase<EpiG1>(lds, g, S, E);
                PHASE_END(P + 1);
            }
            if (EN(3) && IN(P + 2)) for (int rep_ = 0; rep_ < 1 + (int)((PROBE_MASK >> 3) & 1u); ++rep_) {
                { pg8::Gemm g{QKVL_, WUQT_, MT, 3072, QR, N1}; pg8::StaticOrder S; S.init(MT, 3072, G, bx); S.tid = TID(); EpiUq E{Q_, SSQ_, TABM_}; pg8::gemm_phase<EpiUq>(lds, g, S, E); }
                { pg8::Gemm g{QKVL_ + 512, WUKVT_, MT, 4096, KVR, N1}; pg8::StaticOrder S; S.init(MT, 4096, G, bx); S.tid = TID(); EpiUkv E{KV_, SSQ_}; pg8::gemm_phase<EpiUkv>(lds, g, S, E); }
                PHASE_END(P + 2);
            }
            if (EN(4) && IN(P + 3)) for (int rep_ = 0; rep_ < 1 + (int)((PROBE_MASK >> 4) & 1u); ++rep_) {
                const int nun = 2048 + 128;
                for (int ui = vcu; ui < nun; ui += G) {
                    if (ui < 2048) { const int xcd = (ui & 255) >> 5, j = ui & 31, rnd = ui >> 8; const int bh = xcd * 16 + 2 * rnd + (j >> 4), qb = j & 15; const int b = bh >> 4, hd = bh & 15;
                        att::attn_unit(Q_ + (size_t)(b * SEQ + qb * 256) * 3072 + hd * DQ, KV_ + hd * 256, KR_, O_ + (size_t)(b * SEQ + qb * 256) * D + hd * 128, 68, 4, MX + b * CTXL, b * SEQ, (char*)lds_raw, TID()
#if PROBE_TS
                            , bx == 0 ? TS_WORDS : nullptr
#endif
                            );
                    } else { const int bh = ui - 2048, b = bh >> 4, hd = bh & 15;
                        att::attn_unit(Q_ + (size_t)(MX + b * CTXL) * 3072 + hd * DQ, KV_ + hd * 256, KR_, O_ + (size_t)(MX + b * CTXL) * D + hd * 128, 4, 4, MX + b * CTXL, 0, (char*)lds_raw, TID()); }
                }
                PHASE_END(P + 3);
            }
        } else {
            if (EN(5) && IN(P + 1)) for (int rep_ = 0; rep_ < 1 + (int)((PROBE_MASK >> 5) & 1u); ++rep_) {
                pg8::Gemm g{H_, WQKVT_, MT, 8192, D, D}; pg8::StaticOrder S; S.init(MT, 8192, G, bx); S.tid = TID();
                EpiQKV E{QKV_, TABR_};
                pg8::gemm_phase<EpiQKV>(lds, g, S, E);
                PHASE_END(P + 1);
            }
            if (EN(6) && IN(P + 2)) for (int rep_ = 0; rep_ < 1 + (int)((PROBE_MASK >> 6) & 1u); ++rep_) {
                for (int ui = vcu; ui < 256; ui += G) {
                    const int bh = ui >> 2, dir = (ui >> 1) & 1, dvh = ui & 1; const int b = bh >> 3, hd = bh & 7;
                    const float dec = (dir ? ARGF(22) : ARGF(21))[li * RH + hd];
                    const float lg2 = -__expf(dec) * LOG2E;
                    scan::scan_unit(QKV_, Y_ + (size_t)dir * MT * 4096, (float*)(ws + (dir ? WS_PSTB : WS_PSTF)), b, hd, dir, dvh, lg2, last, lds, TID()
#if PROBE_TS
                                    , TS_WORDS
#endif
                                    );
                }
                PHASE_END(P + 2);
            }
            if (EN(8) && IN(P + 4)) for (int rep_ = 0; rep_ < 1 + (int)((PROBE_MASK >> 8) & 1u); ++rep_) {
                pg8::Gemm g{H_, WGT_, Mrows, 8192, D, D}; pg8::StaticOrder S; S.init(Mrows, 8192, G, bx); S.tid = TID();
                EpiGate E{GATED_, Y_, Y_ + (size_t)MT * 4096, (const float*)(ws + WS_PSTF), (const float*)(ws + WS_PSTB)};
                pg8::gemm_phase<EpiGate>(lds, g, S, E);
                PHASE_END(P + 4);
            }
        }
        if (EN(9) && IN(P + 5)) for (int rep_ = 0; rep_ < 1 + (int)((PROBE_MASK >> 9) & 1u); ++rep_) {
#if MLA_CHECK
            if (l == MLA_CHECK_LAYER) { PH_IDS mla_check(lds, ws, li, gw, wave, lane); __syncthreads(); }
#endif
            pg8::Gemm g = is_ret ? pg8::Gemm{GATED_, WOTR_, Mrows, D, 4096, 4096} : pg8::Gemm{O_, WOTM_, Mrows, D, D, D};
            pg8::StaticOrder S; S.init(Mrows, D, G, bx, 4, true); S.tid = TID();
#if PROBE_TS
            S.probe = is_ret ? 2 : 1; S.tsw = TS_WORDS;
#endif
            const void* xsrc = (l == 0) ? (const void*)ARGF(0) : (const void*)XB_; const void* csrc = (l == 0) ? (const void*)ARGF(2) : (const void*)XCB_;
            EpiResid E{xsrc, XB_, csrc, XCB_, MODL_, 2 * D, l == 0, false};
            pg8::gemm_phase<EpiResid>(lds, g, S, E);
            if (l + 1 < DEPTH) {
                PH_IDS
                const int nwg = (Mrows / 256) * (D / 256), rem = nwg % G;
                if (rem == 0) cvt_layer(lds, ws, l + 1, gw, NGW, wave, lane, 0);
                else if (bx >= rem) cvt_layer(lds, ws, l + 1, (bx - rem) * 8 + wave, (G - rem) * 8, wave, lane, 0);
            }
            PHASE_END(P + 5);
        }
        if (EN(10) && IN(P + 6)) for (int rep_ = 0; rep_ < 1 + (int)((PROBE_MASK >> 10) & 1u); ++rep_) {
            PH_IDS
            const float* g = ARGF(7) + l * D;
            norm_phase_b16(XB_, XCB_, g, MODL_, 3, H_, Mrows, gw, NGW, lane);
            PHASE_END(P + 6);
        }
        if (EN(11) && IN(P + 7)) for (int rep_ = 0; rep_ < 1 + (int)((PROBE_MASK >> 11) & 1u); ++rep_) {
            pg8::Gemm g{H_, WGUT_, Mrows, 11264, D, D}; pg8::StaticOrder S; S.init(Mrows, 11264, G, bx); S.tid = TID();
#if PROBE_TS
            S.probe = 4; S.tsw = TS_WORDS;
#endif
            EpiGUConv E{UB_, HALO_, ARGF(25) + (size_t)l * 3 * FF, ARGF(26) + (size_t)l * FF, (LAS float*)(lds + EDGE_OFF)};
            pg8::gemm_phase<EpiGUConv>(lds, g, S, E);
#if PROBE_TS
            if (TID() == 0 && bx == 0) TS_WORDS[140 + l] = __builtin_amdgcn_s_memrealtime();
            if (TID() == 0 && bx == G - 1) TS_WORDS[148 + l] = __builtin_amdgcn_s_memrealtime();
#endif
            PHASE_END(P + 7);
        }
        if (EN(13) && IN(P + 9)) for (int rep_ = 0; rep_ < 1 + (int)((PROBE_MASK >> 13) & 1u); ++rep_) {
            pg8::Gemm g{UB_, WDT_, Mrows, D, FF, FF}; pg8::StaticOrder S; S.init(Mrows, D, G, bx, 4, true); S.tid = TID();
#if PROBE_TS
            S.probe = 3; S.tsw = TS_WORDS;
#endif
            {
                PH_IDS
                const float* cw = ARGF(25) + (size_t)l * 3 * FF; const float* HL = HALO_; bf16* ACT = UB_;
                pg8::Unit uu; int prev_pm = -1;
                for (int i = 0; S.next(i, uu); ++i) { const int pm = uu.pm; if (pm == prev_pm || pm >= MX / 256) { prev_pm = pm; continue; } prev_pm = pm;
                    const bool top = (pm & 15) != 0, bot = ((pm + 1) & 15) != 0;
                    for (int q = tid; q < FF / 4; q += 512) { const int f = q * 4;
                        if (top) { const float* t0 = HL + (size_t)((pm * 2 + 0) * 3) * HALO_STRIDE + f; const float* b1 = HL + (size_t)(((pm - 1) * 2 + 1) * 3) * HALO_STRIDE + f;
                            const f32x4 o = silu4(*(const f32x4*)t0 + *(const f32x4*)(cw + f) * *(const f32x4*)(b1 + HALO_STRIDE)) * *(const f32x4*)(t0 + 2 * HALO_STRIDE);
                            u32x2 w; w.x = cvt_pk_bf16(o[0], o[1]); w.y = cvt_pk_bf16(o[2], o[3]); *(u32x2*)(ACT + (size_t)(pm * 256) * FF + f) = w; }
                        if (bot) { const float* b0 = HL + (size_t)((pm * 2 + 1) * 3) * HALO_STRIDE + f; const float* t1 = HL + (size_t)(((pm + 1) * 2 + 0) * 3) * HALO_STRIDE + f;
                            const f32x4 o = silu4(*(const f32x4*)b0 + *(const f32x4*)(cw + 2 * FF + f) * *(const f32x4*)(t1 + HALO_STRIDE)) * *(const f32x4*)(b0 + 2 * HALO_STRIDE);
                            u32x2 w; w.x = cvt_pk_bf16(o[0], o[1]); w.y = cvt_pk_bf16(o[2], o[3]); *(u32x2*)(ACT + (size_t)(pm * 256 + 255) * FF + f) = w; } } }
                asm volatile("s_waitcnt vmcnt(0)" ::: "memory"); __syncthreads();
            }
            EpiResid E{XB_, last ? (void*)XF_ : (void*)XB_, XCB_, XCB_, MODL_, 5 * D, false, false};
            pg8::gemm_phase<EpiResid>(lds, g, S, E);
#if PROBE_TS
            if (TID() == 0 && bx == 0) TS_WORDS[64 + l] = __builtin_amdgcn_s_memrealtime();
            if (TID() == 0 && bx == G - 1) TS_WORDS[72 + l] = __builtin_amdgcn_s_memrealtime();
#endif
            if (l + 1 < DEPTH) {
                PH_IDS
                const int nwg = (Mrows / 256) * (D / 256), rem = nwg % G;
                if (rem == 0) { mod_layers(lds, ws, l + 1, l + 2, bx, G, tid, lane, wave); __syncthreads(); cvt_layer(lds, ws, l + 1, gw, NGW, wave, lane, 1); }
                else if (bx >= rem) { mod_layers(lds, ws, l + 1, l + 2, bx - rem, G - rem, tid, lane, wave); __syncthreads(); cvt_layer(lds, ws, l + 1, (bx - rem) * 8 + wave, (G - rem) * 8, wave, lane, 1); }
            }
#if PROBE_TS
            __syncthreads(); if (TID() == 0 && bx == G - 1) TS_WORDS[80 + l] = __builtin_amdgcn_s_memrealtime();
#endif
            PHASE_END(P + 9);
        }
    }
    if (EN(14) && IN(PH_FINAL)) for (int rep_ = 0; rep_ < 1 + (int)((PROBE_MASK >> 14) & 1u); ++rep_) {
        PH_IDS
        const float* g = ARGF(28);
#if PROBE_TS
        float ts_c = 0.f, ts_a = 0.f;
        { const unsigned long long* TS = (const unsigned long long*)(ws + WS_CTL + 65536); unsigned long long last = TS[0]; const unsigned long long t0 = last; float d1 = 0.f, d2 = 0.f;
          for (int k = 0; k < PH_FINAL; ++k) { const unsigned long long te = TS[k + 1]; if (te == 0ull) continue; const float d = (float)(te - last); last = te;
              int cls; if (k == 0) cls = 0; else { const int slot = (k - 1) % PH_PER_LAYER, ll = (k - 1) / PH_PER_LAYER; const bool ret = (ll & 1) != 0;
                  cls = slot == 0 ? 1 : slot >= 5 ? 5 + slot : (!ret ? 1 + slot : 4 + slot); }
              if (k > 0 && ((k - 1) % PH_PER_LAYER) == 5) { const bool ret5 = (((k - 1) / PH_PER_LAYER) & 1) != 0; if (TS_CLASS1 == (ret5 ? 51 : 50)) d1 += d; if (TS_CLASS2 == (ret5 ? 51 : 50)) d2 += d; }
              if (cls == TS_CLASS1) d1 += d; if (cls == TS_CLASS2) d2 += d; }
          float tot = (float)(last - t0);
          if (TS_CLASS1 >= 100) { float ph = 0.f, x0 = 0.f, x1 = 0.f, x2 = 0.f;
              for (int ll = 0; ll < 3; ++ll) { const unsigned long long st = TS[(1 + PH_PER_LAYER * ll + 7) + 1], en = TS[(1 + PH_PER_LAYER * ll + 9) + 1];
                  ph += (float)(en - st); x0 += (float)(TS[64 + ll] - st); x1 += (float)(TS[72 + ll] - st); x2 += (float)(TS[80 + ll] - st); }
              d1 = (TS_CLASS1 == 100) ? x0 : (TS_CLASS1 == 101) ? x1 : x2; d2 = (TS_CLASS2 == 100) ? x0 : (TS_CLASS2 == 101) ? x1 : x2; tot = ph; }
          if (TS_CLASS1 >= 200) { const unsigned long long* tw = TS + 90 + 3 * (TS_CLASS1 - 201); const float lp = (float)tw[0], ep = (float)tw[1], nn = (float)tw[2];
              d1 = lp; tot = lp + ep; d2 = (lp + ep) / nn / 100.f / 200.f * tot; }
          if (TS_CLASS1 == 400) { float ph = 0.f, x0 = 0.f, x1 = 0.f;
              for (int ll = 0; ll < 4; ++ll) { const unsigned long long st = TS[(1 + PH_PER_LAYER * ll + 6) + 1], en = TS[(1 + PH_PER_LAYER * ll + 7) + 1];
                  ph += (float)(en - st); x0 += (float)(TS[140 + ll] - st); x1 += (float)(TS[148 + ll] - st); }
              d1 = x0; d2 = x1; tot = ph; }
          if (TS_CLASS1 == 500) { d1 = (float)TS[160]; d2 = (float)TS[161]; tot = (float)TS[162]; }
          if (TS_CLASS1 == 501) { d1 = (float)TS[162] / (float)TS[163] / 100.f / 5.f; d2 = 0.f; tot = 1.f; }
          if (TS_CLASS1 == 600) { d1 = (float)TS[170]; d2 = (float)TS[171]; tot = (float)TS[172]; }
          if (TS_CLASS1 == 300) { const float mx = (float)TS[120], sm = (float)TS[122]; d1 = sm / (float)(gridDim.x * 4); tot = mx > 0.f ? mx : 1.f; d2 = 0.f; }
          { const float q1 = rintf(d1 / tot * 20.f) / 20.f, q2 = rintf(d2 / tot * 20.f) / 20.f; ts_c = sqrtf(q1); ts_a = 2.0f + 10.0f * q2; }
        }
#endif
#if MLA_CHECK
        const bool chk_bad = __uint_as_float(__hip_atomic_load((unsigned*)(ws + WS_CTL) + CW_CHK, __ATOMIC_RELAXED, __HIP_MEMORY_SCOPE_AGENT)) > MLA_CHECK_TOL;
#endif
        if (gw < MX) {
            u32x4 v[4], vn[4]; f32x4 gg[8]; int m = gw; row_load_b16(XF_ + (size_t)m * D, lane, v);
#pragma unroll
            for (int j = 0; j < 8; ++j) gg[j] = *(const f32x4*)(g + 8 * lane + 512 * (j >> 1) + 4 * (j & 1));
            for (;;) {
                const int mn = m + NGW; const bool has = mn < MX;
                if (has) row_load_b16(XF_ + (size_t)mn * D, lane, vn);
                f32x4 x[8]; float s = 0.f;
#pragma unroll
                for (int j = 0; j < 4; ++j) { x[2 * j] = (f32x4){bflo(v[j].x), bfhi(v[j].x), bflo(v[j].y), bfhi(v[j].y)}; x[2 * j + 1] = (f32x4){bflo(v[j].z), bfhi(v[j].z), bflo(v[j].w), bfhi(v[j].w)}; }
#pragma unroll
                for (int j = 0; j < 8; ++j) s += (x[j][0] * x[j][0] + x[j][1] * x[j][1]) + (x[j][2] * x[j][2] + x[j][3] * x[j][3]);
                const float rstd = 1.0f / sqrtf(wave_sum(s, lane) * (1.0f / D) + NORM_EPS);
                float* xr = X + (size_t)m * D;
#pragma unroll
                for (int j = 0; j < 8; ++j) { const int c = 8 * lane + 512 * (j >> 1) + 4 * (j & 1); f32x4 o_ = (x[j] * rstd) * gg[j];
#if MLA_CHECK
                    if (chk_bad) o_ = (f32x4){__builtin_nanf(""), __builtin_nanf(""), __builtin_nanf(""), __builtin_nanf("")};
#endif
#if PROBE_TS
                    if (m < 328) { o_ = o_ + ts_c; if (m == 0 && c == 0) o_[0] += ts_a - ts_c; }
#endif
                    *(f32x4*)(xr + c) = o_; }
                if (!has) break;
#pragma unroll
                for (int j = 0; j < 4; ++j) v[j] = vn[j];
                m = mn;
            }
        }
    }
#undef IN
#undef PHASE_END
}

#if !MK_SINGLE
typedef void (*KernFn)(Args);
static KernFn phase_kernel(int bit) {
    switch (bit) {
        case 0: return mk_fwd<1u << 0>;  case 1: return mk_fwd<1u << 1>;  case 2: return mk_fwd<1u << 2>;  case 3: return mk_fwd<1u << 3>;
        case 4: return mk_fwd<1u << 4>;  case 5: return mk_fwd<1u << 5>;  case 6: return mk_fwd<1u << 6>;  case 7: return mk_fwd<1u << 7>;
        case 8: return mk_fwd<1u << 8>;  case 9: return mk_fwd<1u << 9>;  case 10: return mk_fwd<1u << 10>; case 11: return mk_fwd<1u << 11>;
        case 12: return mk_fwd<1u << 12>; case 13: return mk_fwd<1u << 13>; default: return mk_fwd<1u << 14>;
    }
}
static int phase_bit(int p) {
    if (p == 0) return 0; if (p == PH_FINAL) return 14;
    const int l = (p - 1) / PH_PER_LAYER, slot = (p - 1) % PH_PER_LAYER; const bool ret = (l & 1) != 0;
    if (slot == 0) return 1;
    if (slot >= 5) return 4 + slot;
    if (!ret) return slot == 4 ? -1 : 1 + slot;
    return 4 + slot;
}
#endif
extern "C" void kernel_launch(void* const* d_in, const int* in_sizes, int n_in, void* d_out, int out_size, void* d_ws, size_t ws_size, hipStream_t stream) {
    static int grid = 0;
    if (grid == 0) {
        if (n_in != 29 || out_size != MX * D || ws_size < WS_END) { fprintf(stderr, "kernel_launch: unexpected shapes: n_in %d out %d ws %zu (need %zu)\n", n_in, out_size, ws_size, (size_t)WS_END); grid = -1; return; }
        int dev = 0, cus = 0;
        if (hipGetDevice(&dev) != hipSuccess || hipDeviceGetAttribute(&cus, hipDeviceAttributeMultiprocessorCount, dev) != hipSuccess) { grid = -1; return; }
#if MK_SINGLE
        if (hipFuncSetAttribute((const void*)mk_fwd<0xFFFFFFFFu>, hipFuncAttributeMaxDynamicSharedMemorySize, LDS_BYTES) != hipSuccess) { fprintf(stderr, "kernel_launch: hipFuncSetAttribute failed\n"); grid = -1; return; }
#else
        for (int b = 0; b < 15; ++b) if (hipFuncSetAttribute((const void*)phase_kernel(b), hipFuncAttributeMaxDynamicSharedMemorySize, LDS_BYTES) != hipSuccess) { fprintf(stderr, "kernel_launch: hipFuncSetAttribute failed\n"); grid = -1; return; }
#endif
        (void)hipGetLastError();
        grid = cus;
    }
    if (grid < 0) return;
    if (hipMemsetAsync((char*)d_ws + WS_CTL, 0, CTL_BYTES, stream) != hipSuccess) return;
    Args a{};
    for (int i = 0; i < 29; ++i) a.in[i] = (const float*)d_in[i];
    a.out = (float*)d_out; a.ws = (unsigned char*)d_ws;
#if MK_SINGLE
    a.ph_lo = 0; a.ph_hi = PH_COUNT;
    hipLaunchKernelGGL(mk_fwd<0xFFFFFFFFu>, dim3(grid), dim3(512), LDS_BYTES, stream, a);
#else
    for (int p = 0; p < PH_COUNT; ++p) {
        const int bit = phase_bit(p); if (bit < 0) continue;
        a.ph_lo = p; a.ph_hi = p + 1;
        hipLaunchKernelGGL(phase_kernel(bit), dim3(grid), dim3(512), LDS_BYTES, stream, a);
    }
#endif
    const hipError_t le = hipPeekAtLastError();
    if (le != hipSuccess) fprintf(stderr, "kernel_launch: launch failed: %s\n", hipGetErrorName(le));
}
```
